# Optimizing an MI355X kernel written in HIP

```python
import math
import jax, jax.numpy as jnp
from jax import lax
import numpy as np

D_MODEL = 1024
BATCH = 8
SEQ = 2048
DEPTH = 1

PLE_DIM = 256
EPS = 1e-6
NEG_INF = -1e30
N_Q_HEADS = 8
N_KV_HEADS = 2
HEAD_DIM = 64
Q_PER_KV = N_Q_HEADS // N_KV_HEADS
WINDOW = 128
BLOCK = 128
LRU_WIDTH = D_MODEL
LRU_BLOCKS = 8
LRU_BLOCK_DIM = LRU_WIDTH // LRU_BLOCKS
CONV_WIDTH = 4
LRU_C = 8.0
PEER_HEADS = 8
PEER_KEYS = 128
PEER_N_EXPERTS = PEER_KEYS * PEER_KEYS
PEER_QDIM = 256
PEER_HALF = PEER_QDIM // 2
PEER_TOPK = 16
PEER_CHUNK = 128
Q_W = N_Q_HEADS * HEAD_DIM
KV_W = N_KV_HEADS * HEAD_DIM
SPLIT_POINTS = (Q_W, Q_W + KV_W, Q_W + 2 * KV_W, Q_W + 2 * KV_W + LRU_WIDTH,
                Q_W + 2 * KV_W + 2 * LRU_WIDTH, Q_W + 2 * KV_W + 2 * LRU_WIDTH + D_MODEL)
IN_WIDTH = Q_W + 2 * KV_W + 2 * LRU_WIDTH + 2 * D_MODEL

kernel_name = "hybrid_swa_rglru_peer_block"


def rms_norm(x, g):
    xf = x.astype(jnp.float32)
    y = xf * lax.rsqrt(jnp.mean(xf * xf, axis=-1, keepdims=True) + EPS)
    return (y * g.astype(jnp.float32)).astype(x.dtype)


def sliding_window_attention(q, k, v, sink):
    B, S = q.shape[0], q.shape[1]
    nb = S // BLOCK
    qb = q.reshape(B, nb, BLOCK, N_KV_HEADS, Q_PER_KV, HEAD_DIM)
    kb = k.reshape(B, nb, BLOCK, N_KV_HEADS, HEAD_DIM)
    vb = v.reshape(B, nb, BLOCK, N_KV_HEADS, HEAD_DIM)
    pad = ((0, 0), (1, 0), (0, 0), (0, 0), (0, 0))
    kk = jnp.concatenate([jnp.pad(kb, pad)[:, :-1], kb], axis=2)
    vv = jnp.concatenate([jnp.pad(vb, pad)[:, :-1], vb], axis=2)
    scores = jnp.einsum('bnqgrd,bnkgd->bgrnqk', qb, kk).astype(jnp.float32) * (HEAD_DIM ** -0.5)
    qi = jnp.arange(BLOCK)
    kj = jnp.arange(2 * BLOCK)
    dist = (qi[:, None] + BLOCK - kj[None, :]).astype(jnp.float32)
    key_pos = jnp.arange(nb)[:, None] * BLOCK + kj[None, :] - BLOCK
    mask = ((dist >= 0) & (dist < WINDOW))[None] & (key_pos >= 0)[:, None, :]
    slopes = (2.0 ** (-8.0 * jnp.arange(1, N_Q_HEADS + 1, dtype=jnp.float32) / N_Q_HEADS))
    slopes = slopes.reshape(N_KV_HEADS, Q_PER_KV)[:, :, None, None, None]
    scores = jnp.where(mask, scores - slopes * dist, NEG_INF)
    sink_logit = sink.astype(jnp.float32).reshape(N_KV_HEADS, Q_PER_KV)[None, :, :, None, None, None]
    sink_logit = jnp.broadcast_to(sink_logit, scores.shape[:-1] + (1,))
    probs = jax.nn.softmax(jnp.concatenate([scores, sink_logit], axis=-1), axis=-1)[..., :-1]
    out = jnp.einsum('bgrnqk,bnkgd->bnqgrd', probs.astype(v.dtype), vv)
    return out.reshape(B, S, Q_W)


def causal_depthwise_conv(x, w, b):
    S = x.shape[1]
    xp = jnp.pad(x, ((0, 0), (CONV_WIDTH - 1, 0), (0, 0)))
    y = b + xp[:, 0:S] * w[0]
    for tap in range(1, CONV_WIDTH):
        y = y + xp[:, tap:tap + S] * w[tap]
    return y


def block_diag_linear(x, w, b):
    B, S = x.shape[0], x.shape[1]
    xb = x.reshape(B, S, LRU_BLOCKS, LRU_BLOCK_DIM)
    return jnp.einsum('bsnc,ncd->bsnd', xb, w).reshape(B, S, LRU_WIDTH) + b


def rg_lru(x, wa, ba, wx, bx, lam):
    r = jax.nn.sigmoid(block_diag_linear(x, wa, ba)).astype(jnp.float32)
    i = jax.nn.sigmoid(block_diag_linear(x, wx, bx))
    log_a = -LRU_C * r * jax.nn.softplus(-lam.astype(jnp.float32))
    a = jnp.exp(log_a)
    b = jnp.sqrt(-jnp.expm1(2.0 * log_a)) * (i * x).astype(jnp.float32)

    def combine(c1, c2):
        a1, b1 = c1
        a2, b2 = c2
        return a1 * a2, a2 * b1 + b2

    _, h = lax.associative_scan(combine, (a, b), axis=1)
    return h.astype(x.dtype)


def peer_ffn(x, wq, k1, k2, u, v):
    B, S, D = x.shape
    q = (x @ wq).astype(jnp.float32).reshape(B, S, PEER_HEADS, 2, PEER_HALF)
    s1 = jnp.einsum('bshc,kc->bshk', q[..., 0, :], k1.astype(jnp.float32))
    s2 = jnp.einsum('bshc,kc->bshk', q[..., 1, :], k2.astype(jnp.float32))
    v1, i1 = lax.top_k(s1, PEER_TOPK)
    v2, i2 = lax.top_k(s2, PEER_TOPK)
    cand = (v1[..., :, None] + v2[..., None, :]).reshape(B, S, PEER_HEADS, PEER_TOPK * PEER_TOPK)
    cand_idx = (i1[..., :, None] * PEER_KEYS + i2[..., None, :]).reshape(B, S, PEER_HEADS, PEER_TOPK * PEER_TOPK)
    top_s, pos = lax.top_k(cand, PEER_TOPK)
    idx = jnp.take_along_axis(cand_idx, pos, axis=-1)
    g = jax.nn.softmax(top_s, axis=-1).astype(x.dtype)
    n_chunks = (B * S) // PEER_CHUNK
    xc = x.reshape(n_chunks, PEER_CHUNK, D)
    ic = idx.reshape(n_chunks, PEER_CHUNK, PEER_HEADS, PEER_TOPK)
    gc = g.reshape(n_chunks, PEER_CHUNK, PEER_HEADS, PEER_TOPK)

    def expert_chunk(args):
        xt, it, gt = args
        ue = u[it]
        ve = v[it]
        act = jax.nn.gelu(jnp.einsum('chkd,cd->chk', ue, xt))
        return jnp.einsum('chk,chkd->cd', gt * act, ve)

    y = lax.map(expert_chunk, (xc, ic, gc))
    return y.reshape(B, S, D)


def setup_inputs(seed: int = 0) -> dict:
    key = jax.random.key(seed)
    ks = jax.random.split(key, 32)
    L, D = DEPTH, D_MODEL
    nrm = lambda k, shape, s: jax.random.normal(k, shape, jnp.float32) * s
    a0 = jax.random.uniform(ks[10], (L, LRU_WIDTH), jnp.float32, 0.9, 0.999)
    return {
        "x": nrm(ks[0], (BATCH, SEQ, D), 1.0),
        "p": nrm(ks[1], (L, BATCH, SEQ, PLE_DIM), 1.0),
        "norm_mix_g": 1.0 + nrm(ks[2], (L, D), 0.02),
        "w_in": nrm(ks[3], (L, D, IN_WIDTH), D ** -0.5),
        "attn_sink": nrm(ks[4], (L, N_Q_HEADS), 0.5),
        "conv_w": nrm(ks[5], (L, CONV_WIDTH, LRU_WIDTH), CONV_WIDTH ** -0.5),
        "conv_b": nrm(ks[6], (L, LRU_WIDTH), 0.02),
        "lru_wa": nrm(ks[7], (L, LRU_BLOCKS, LRU_BLOCK_DIM, LRU_BLOCK_DIM), LRU_BLOCK_DIM ** -0.5),
        "lru_ba": nrm(ks[8], (L, LRU_WIDTH), 0.02),
        "lru_wx": nrm(ks[9], (L, LRU_BLOCKS, LRU_BLOCK_DIM, LRU_BLOCK_DIM), LRU_BLOCK_DIM ** -0.5),
        "lru_bx": nrm(ks[11], (L, LRU_WIDTH), 0.02),
        "lru_lambda": jnp.log(a0) - jnp.log1p(-a0),
        "w_up_attn": nrm(ks[12], (L, Q_W, D), Q_W ** -0.5),
        "w_up_lru": nrm(ks[13], (L, LRU_WIDTH, D), LRU_WIDTH ** -0.5),
        "w_o": nrm(ks[14], (L, D, D), D ** -0.5),
        "norm_ffn_g": 1.0 + nrm(ks[15], (L, D), 0.02),
        "peer_wq": nrm(ks[16], (L, D, PEER_HEADS * PEER_QDIM), D ** -0.5),
        "peer_k1": nrm(ks[17], (L, PEER_KEYS, PEER_HALF), PEER_HALF ** -0.5),
        "peer_k2": nrm(ks[18], (L, PEER_KEYS, PEER_HALF), PEER_HALF ** -0.5),
        "peer_u": nrm(ks[19], (L, PEER_N_EXPERTS, D), D ** -0.5),
        "peer_v": nrm(ks[20], (L, PEER_N_EXPERTS, D), PEER_HEADS ** -0.5),
        "norm_ple_g": 1.0 + nrm(ks[21], (L, D), 0.02),
        "ple_w_gate": nrm(ks[22], (L, D, D), D ** -0.5),
        "ple_w_proj": nrm(ks[23], (L, PLE_DIM, D), PLE_DIM ** -0.5),
        "final_g": 1.0 + nrm(ks[24], (D,), 0.02),
    }


def reference(x, p, norm_mix_g, w_in, attn_sink, conv_w, conv_b, lru_wa, lru_ba, lru_wx, lru_bx,
              lru_lambda, w_up_attn, w_up_lru, w_o, norm_ffn_g, peer_wq, peer_k1, peer_k2, peer_u,
              peer_v, norm_ple_g, ple_w_gate, ple_w_proj, final_g):
    B, S, _ = x.shape
    h = x
    for l in range(DEPTH):
        xn = rms_norm(h, norm_mix_g[l])
        proj = xn @ w_in[l]
        q, k, v, lru_x, lru_gate, gate_attn, gate_lru = jnp.split(proj, SPLIT_POINTS, axis=-1)
        attn = sliding_window_attention(q.reshape(B, S, N_Q_HEADS, HEAD_DIM),
                                        k.reshape(B, S, N_KV_HEADS, HEAD_DIM),
                                        v.reshape(B, S, N_KV_HEADS, HEAD_DIM), attn_sink[l])
        lru_in = causal_depthwise_conv(lru_x, conv_w[l], conv_b[l])
        rec = rg_lru(lru_in, lru_wa[l], lru_ba[l], lru_wx[l], lru_bx[l], lru_lambda[l]) * jax.nn.gelu(lru_gate)
        merged = (jax.nn.sigmoid(gate_attn) * (attn @ w_up_attn[l])
                  + jax.nn.sigmoid(gate_lru) * (rec @ w_up_lru[l]))
        h = h + merged @ w_o[l]
        h = h + peer_ffn(rms_norm(h, norm_ffn_g[l]), peer_wq[l], peer_k1[l], peer_k2[l], peer_u[l], peer_v[l])
        gate = jax.nn.sigmoid(rms_norm(h, norm_ple_g[l]) @ ple_w_gate[l])
        h = h + gate * (p[l] @ ple_w_proj[l])
    return rms_norm(h, final_g)
```

```cpp
#include <hip/hip_runtime.h>
#include <cstdio>
#include <cstdint>
#include <cmath>

constexpr int B_ = 8, S_ = 2048, D_ = 1024, T_ = B_ * S_;
constexpr int INW = 4864;
constexpr float EPS = 1e-6f;
typedef unsigned short bf16;
#define HD_INLINE __host__ __device__ __forceinline__

constexpr size_t MiB = 1u << 20;
constexpr size_t WS_CTL = 0;
constexpr size_t WS_WIN = 1 * MiB;
constexpr size_t WS_WUA = WS_WIN + 4864 * 1024 * 2;
constexpr size_t WS_WUL = WS_WUA + 1 * MiB;
constexpr size_t WS_WO = WS_WUL + 2 * MiB;
constexpr size_t WS_WFOLD = WS_WO + 2 * MiB;
constexpr size_t WS_WG = WS_WFOLD + 4 * MiB;
constexpr size_t WS_WPROJ = WS_WG + 2 * MiB;
constexpr size_t WS_WAX = WS_WPROJ + MiB / 2;
constexpr size_t WS_W_END = WS_WAX + 1 * MiB;
static_assert(WS_W_END <= 23 * MiB, "weights");
constexpr size_t WS_RSTD1 = 23 * MiB;
constexpr size_t WS_PART2 = WS_RSTD1 + 256 * 1024;
constexpr size_t WS_PART4 = WS_PART2 + 1 * MiB;
constexpr size_t WS_RSTD3 = WS_PART4 + 1 * MiB;
constexpr size_t WS_AGG = WS_RSTD3 + 256 * 1024;
constexpr size_t WS_C8 = WS_AGG + 2 * MiB;
constexpr size_t WS_USCALE = WS_C8 + 64 * 1024;
static_assert(WS_USCALE + 128 * 1024 <= 28 * MiB, "small");
constexpr size_t WS_PB = 28 * MiB;
constexpr size_t WS_R0 = 36 * MiB;
constexpr size_t WS_QKV = 68 * MiB;
constexpr size_t WS_LX = 92 * MiB;
constexpr size_t WS_GL = 140 * MiB;
constexpr size_t WS_SGA = 172 * MiB;
constexpr size_t WS_SGL = 204 * MiB;
constexpr size_t WS_ATT = 236 * MiB;
constexpr size_t WS_HLOC = 68 * MiB, WS_PCUM = 100 * MiB;
constexpr size_t WS_MP = 68 * MiB;
constexpr size_t WS_MERGED = 140 * MiB;
constexpr size_t WS_SC = 172 * MiB;
constexpr size_t WS_SELI = 236 * MiB, WS_SELG = 244 * MiB;
constexpr size_t WS_U16 = 68 * MiB, WS_V16 = 100 * MiB;
constexpr size_t WS_H2B = 140 * MiB;
constexpr size_t WS_PP = 172 * MiB;
constexpr size_t WS_NAIVE_AB = 68 * MiB;
constexpr size_t WS_END = 256 * MiB;

HD_INLINE float bf2f(bf16 v) { return __builtin_bit_cast(float, (unsigned)v << 16); }
HD_INLINE bf16 f2bf(float f) { unsigned u = __builtin_bit_cast(unsigned, f); return (bf16)((u + 0x7fffu + ((u >> 16) & 1u)) >> 16); }
HD_INLINE unsigned pk2(float lo, float hi) { return (unsigned)f2bf(lo) | ((unsigned)f2bf(hi) << 16); }
__device__ __forceinline__ float wave_sum(float v) {
#pragma unroll
    for (int o = 1; o < 64; o <<= 1) v += __shfl_xor(v, o);
    return v;
}
__device__ __forceinline__ float sigmoidf_(float z) { return __builtin_amdgcn_rcpf(1.0f + __builtin_amdgcn_exp2f(-1.4426950408889634f * z)); }
__device__ __forceinline__ float gelu_tanh(float x) { const float u = 1.5957691216057308f * (x + 0.044715f * x * x * x); return x * sigmoidf_(u); }
#ifndef HD_INLINE
#define HD_INLINE __host__ __device__ __forceinline__
#endif

HD_INLINE unsigned tk_umax(unsigned a, unsigned b) { return a > b ? a : b; }
HD_INLINE unsigned tk_umin(unsigned a, unsigned b) { return a < b ? a : b; }
HD_INLINE unsigned tk_f2key(float f) { unsigned u = __builtin_bit_cast(unsigned, f); return u ^ ((unsigned)((int)u >> 31) | 0x80000000u); }
HD_INLINE float tk_key2f(unsigned k) { unsigned u = (k & 0x80000000u) ? (k ^ 0x80000000u) : ~k; return __builtin_bit_cast(float, u); }

HD_INLINE void tk_sort16(unsigned (&a)[16]) {
#pragma unroll
    for (int k = 2; k <= 16; k <<= 1) {
#pragma unroll
        for (int j = k >> 1; j > 0; j >>= 1) {
#pragma unroll
            for (int i = 0; i < 16; ++i) {
                const int p = i ^ j;
                if (p > i) {
                    const unsigned mx = tk_umax(a[i], a[p]), mn = tk_umin(a[i], a[p]);
                    if ((i & k) == 0) { a[i] = mx; a[p] = mn; } else { a[i] = mn; a[p] = mx; }
                }
            }
        }
    }
}
HD_INLINE void tk_merge16(unsigned (&a)[16], const unsigned (&b)[16]) {
#pragma unroll
    for (int i = 0; i < 16; ++i) a[i] = tk_umax(a[i], b[15 - i]);
#pragma unroll
    for (int j = 8; j > 0; j >>= 1) {
#pragma unroll
        for (int i = 0; i < 16; ++i) {
            const int p = i ^ j;
            if (p > i) { const unsigned mx = tk_umax(a[i], a[p]), mn = tk_umin(a[i], a[p]); a[i] = mx; a[p] = mn; }
        }
    }
}
HD_INLINE void tk_insert16(unsigned (&best)[16], unsigned key) {
#pragma unroll
    for (int s = 0; s < 16; ++s) { const unsigned hi = tk_umax(best[s], key); key = tk_umin(best[s], key); best[s] = hi; }
}
HD_INLINE void tk_combine_store(const unsigned (&k1)[16], const unsigned (&k2)[16], int* oi, float* og) {
    float v1[16], v2[16];
#pragma unroll
    for (int i = 0; i < 16; ++i) { v1[i] = tk_key2f(k1[i] & ~127u); v2[i] = tk_key2f(k2[i] & ~127u); }
    unsigned best[16];
#pragma unroll
    for (int s = 0; s < 16; ++s) best[s] = 0u;
#pragma unroll
    for (int i = 0; i < 16; ++i) {
#pragma unroll
        for (int j = 0; j < 16; ++j) {
            if ((i + 1) * (j + 1) <= 16) {
                const float s = v1[i] + v2[j];
                const unsigned key = (tk_f2key(s) & ~255u) | (unsigned)(255 - (i * 16 + j));
                tk_insert16(best, key);
            }
        }
    }
    const unsigned thr = best[15];
    const float mx = tk_key2f(best[0] & ~255u);
    float sum = 0.f;
#pragma unroll
    for (int i = 0; i < 16; ++i) {
#pragma unroll
        for (int j = 0; j < 16; ++j) {
            if ((i + 1) * (j + 1) <= 16) {
                const float s = v1[i] + v2[j];
                const unsigned key = (tk_f2key(s) & ~255u) | (unsigned)(255 - (i * 16 + j));
                if (key >= thr) sum += __builtin_expf(s - mx);
            }
        }
    }
    const float inv = 1.0f / sum;
    int cnt = 0;
#pragma unroll
    for (int i = 0; i < 16; ++i) {
#pragma unroll
        for (int j = 0; j < 16; ++j) {
            if ((i + 1) * (j + 1) <= 16) {
                const float s = v1[i] + v2[j];
                const unsigned key = (tk_f2key(s) & ~255u) | (unsigned)(255 - (i * 16 + j));
                if (key >= thr) {
                    oi[cnt] = (127 - (int)(k1[i] & 127u)) * 128 + (127 - (int)(k2[j] & 127u));
                    og[cnt] = __builtin_expf(s - mx) * inv;
                    ++cnt;
                }
            }
        }
    }
}
namespace nv {
struct ALf32 { const float* p; int lda; __device__ __forceinline__ float operator()(int m, int k) const { return p[(size_t)m * lda + k]; } };
struct ALbf16 { const bf16* p; int lda; __device__ __forceinline__ float operator()(int m, int k) const { return bf2f(p[(size_t)m * lda + k]); } };

template <class AL, class EPI, bool BT>
__global__ void __launch_bounds__(256) ngemm(AL al, const float* __restrict__ B, int ldb, const float* __restrict__ ks, int M, int N, int K, EPI epi) {
    __shared__ float As[16][68];
    __shared__ float Bs[16][68];
    const int tid = threadIdx.x, tx = tid & 15, ty = tid >> 4;
    const int m0 = blockIdx.y * 64, n0 = blockIdx.x * 64;
    float acc[4][4];
#pragma unroll
    for (int i = 0; i < 4; ++i)
#pragma unroll
        for (int j = 0; j < 4; ++j) acc[i][j] = 0.f;
    for (int k0 = 0; k0 < K; k0 += 16) {
#pragma unroll
        for (int i = 0; i < 4; ++i) {
            const int e = tid + i * 256;
            { const int m = e >> 4, k = e & 15; float v = al(m0 + m, k0 + k); if (ks) v *= ks[k0 + k]; As[k][m] = v; }
            if (BT) { const int n = e >> 4, k = e & 15; Bs[k][n] = B[(size_t)(n0 + n) * ldb + k0 + k]; }
            else { const int k = e >> 6, n = e & 63; Bs[k][n] = B[(size_t)(k0 + k) * ldb + n0 + n]; }
        }
        __syncthreads();
#pragma unroll
        for (int k = 0; k < 16; ++k) {
            float a[4], b[4];
#pragma unroll
            for (int i = 0; i < 4; ++i) { a[i] = As[k][ty * 4 + i]; b[i] = Bs[k][tx * 4 + i]; }
#pragma unroll
            for (int i = 0; i < 4; ++i)
#pragma unroll
                for (int j = 0; j < 4; ++j) acc[i][j] = fmaf(a[i], b[j], acc[i][j]);
        }
        __syncthreads();
    }
#pragma unroll
    for (int i = 0; i < 4; ++i)
#pragma unroll
        for (int j = 0; j < 4; ++j) epi(m0 + ty * 4 + i, n0 + tx * 4 + j, acc[i][j]);
}
template <class AL, class EPI, bool BT>
static void run_gemm(hipStream_t st, AL al, const float* B, int ldb, const float* ks, int M, int N, int K, EPI epi) {
    hipLaunchKernelGGL((ngemm<AL, EPI, BT>), dim3(N / 64, M / 64), dim3(256), 0, st, al, B, ldb, ks, M, N, K, epi);
}

__global__ void __launch_bounds__(256) rowsq(const float* __restrict__ X, float* rstd, float* part) {
    const int row = blockIdx.x * 4 + (threadIdx.x >> 6), lane = threadIdx.x & 63;
    const float* xr = X + (size_t)row * 1024;
    float s = 0.f;
    for (int j = 0; j < 16; ++j) { const float v = xr[lane + 64 * j]; s += v * v; }
    s = wave_sum(s);
    if (rstd && lane == 0) rstd[row] = 1.0f / sqrtf(s * (1.0f / 1024.0f) + EPS);
    if (part && lane < 16) part[(size_t)row * 16 + lane] = (lane == 0) ? s : 0.f;
}

struct EpiProj {
    const float* rstd; bf16 *qkv, *lx, *gl, *sga, *sgl;
    __device__ __forceinline__ void operator()(int m, int n, float v) const {
        v *= rstd[m];
        if (n < 768) qkv[(size_t)m * 768 + n] = f2bf(v);
        else if (n < 1792) lx[(size_t)m * 1024 + (n - 768)] = f2bf(v);
        else if (n < 2816) gl[(size_t)m * 1024 + (n - 1792)] = f2bf(gelu_tanh(v));
        else if (n < 3840) sga[(size_t)m * 1024 + (n - 2816)] = f2bf(sigmoidf_(v));
        else sgl[(size_t)m * 1024 + (n - 3840)] = f2bf(sigmoidf_(v));
    }
};

__global__ void __launch_bounds__(128) attn_naive(const bf16* __restrict__ qkv, const float* __restrict__ sink, bf16* __restrict__ att) {
    const int gid = blockIdx.x * 128 + threadIdx.x;
    const int head = gid / T_, t = gid % T_;
    const int b = t / S_, ts = t % S_;
    const int g = head >> 2;
    float q[64], acc[64];
    const bf16* qp = qkv + (size_t)t * 768 + head * 64;
#pragma unroll
    for (int d = 0; d < 64; ++d) { q[d] = bf2f(qp[d]); acc[d] = 0.f; }
    const float slope = exp2f(-(float)(head + 1));
    float m = -3.0e38f, l = 0.f;
    for (int dist = 127; dist >= 0; --dist) {
        const int s = ts - dist; if (s < 0) continue;
        const bf16* kp = qkv + (size_t)(b * S_ + s) * 768 + 512 + g * 64;
        const bf16* vp = kp + 128;
        float sc = 0.f;
#pragma unroll
        for (int d = 0; d < 64; ++d) sc = fmaf(q[d], bf2f(kp[d]), sc);
        sc = sc * 0.125f - slope * (float)dist;
        const float mn = fmaxf(m, sc), corr = __expf(m - mn), p = __expf(sc - mn);
        l = l * corr + p;
#pragma unroll
        for (int d = 0; d < 64; ++d) acc[d] = acc[d] * corr + p * bf2f(vp[d]);
        m = mn;
    }
    const float sk = sink[head];
    const float mf = fmaxf(m, sk), corr = __expf(m - mf);
    l = l * corr + __expf(sk - mf);
    const float inv = corr / l;
    bf16* op = att + (size_t)t * 512 + head * 64;
#pragma unroll
    for (int d = 0; d < 64; ++d) op[d] = f2bf(acc[d] * inv);
}

__global__ void __launch_bounds__(256) conv_naive(const bf16* __restrict__ lx, const float* __restrict__ cw, const float* __restrict__ cb, bf16* __restrict__ lin) {
    const size_t i = (size_t)blockIdx.x * 256 + threadIdx.x;
    const int c = (int)(i & 1023); const int t = (int)(i >> 10); const int ts = t % S_;
    float y = cb[c];
#pragma unroll
    for (int tap = 0; tap < 4; ++tap) { const int s = ts - 3 + tap; if (s >= 0) y = fmaf(bf2f(lx[(size_t)(t - 3 + tap) * 1024 + c]), cw[tap * 1024 + c], y); }
    lin[i] = f2bf(y);
}

__global__ void __launch_bounds__(128) lru_ab_naive(const bf16* __restrict__ lin, const float* __restrict__ wa, const float* __restrict__ ba, const float* __restrict__ wx, const float* __restrict__ bx,
                                                    const float* __restrict__ lam, float* __restrict__ Af, float* __restrict__ Bf) {
    __shared__ float xs[128];
    const int t = blockIdx.x >> 3, blk = blockIdx.x & 7, d = threadIdx.x, ch = blk * 128 + d;
    xs[d] = bf2f(lin[(size_t)t * 1024 + ch]);
    __syncthreads();
    float r = ba[ch], ii = bx[ch];
    const float* wap = wa + (size_t)blk * 128 * 128 + d; const float* wxp = wx + (size_t)blk * 128 * 128 + d;
    for (int c = 0; c < 128; ++c) { r = fmaf(xs[c], wap[c * 128], r); ii = fmaf(xs[c], wxp[c * 128], ii); }
    r = sigmoidf_(r); ii = sigmoidf_(ii);
    const float sp = log1pf(expf(-lam[ch]));
    const float loga = -8.0f * r * sp;
    const float a = expf(loga);
    const float bb = sqrtf(-expm1f(2.0f * loga)) * (ii * xs[d]);
    Af[(size_t)t * 1024 + ch] = a; Bf[(size_t)t * 1024 + ch] = bb;
}
__global__ void __launch_bounds__(64) lru_scan_naive(const float* __restrict__ Af, const float* __restrict__ Bf, const bf16* __restrict__ gl, bf16* __restrict__ rec) {
    const int gid = blockIdx.x * 64 + threadIdx.x; const int b = gid >> 10, ch = gid & 1023;
    float h = 0.f;
    for (int s = 0; s < S_; ++s) { const size_t o = (size_t)(b * S_ + s) * 1024 + ch; h = fmaf(Af[o], h, Bf[o]); rec[o] = f2bf(h * bf2f(gl[o])); }
}

struct EpiMP { const bf16* sga; float* mp; __device__ __forceinline__ void operator()(int m, int n, float v) const { const size_t o = (size_t)m * 1024 + n; mp[o] = v * bf2f(sga[o]); } };
struct EpiMerged { const bf16* sgl; const float* mp; bf16* merged; __device__ __forceinline__ void operator()(int m, int n, float v) const { const size_t o = (size_t)m * 1024 + n; merged[o] = f2bf(mp[o] + v * bf2f(sgl[o])); } };
struct EpiH1 { const float* x; float* h1; bf16* h1b; __device__ __forceinline__ void operator()(int m, int n, float v) const { const size_t o = (size_t)m * 1024 + n; const float h = x[o] + v; h1[o] = h; h1b[o] = f2bf(h); } };
struct EpiScaleF32 { const float* part; float* out; int ldo; __device__ __forceinline__ void operator()(int m, int n, float v) const {
    float s = 0.f; for (int i = 0; i < 16; ++i) s += part[(size_t)m * 16 + i];
    out[(size_t)m * ldo + n] = v * (1.0f / sqrtf(s * (1.0f / 1024.0f) + EPS)); } };
struct EpiPlainF32 { float* out; int ldo; __device__ __forceinline__ void operator()(int m, int n, float v) const { out[(size_t)m * ldo + n] = v; } };
struct EpiPP { bf16* pp; __device__ __forceinline__ void operator()(int m, int n, float v) const { pp[(size_t)m * 1024 + n] = f2bf(v); } };
struct EpiH3 { const float* rstd3; const bf16* pp; float* h; __device__ __forceinline__ void operator()(int m, int n, float v) const { const size_t o = (size_t)m * 1024 + n; h[o] = h[o] + sigmoidf_(v * rstd3[m]) * bf2f(pp[o]); } };

__global__ void __launch_bounds__(256) final_norm(float* __restrict__ h, const float* __restrict__ part, const float* __restrict__ fg) {
    const int row = blockIdx.x * 4 + (threadIdx.x >> 6), lane = threadIdx.x & 63;
    float s = 0.f; for (int i = 0; i < 16; ++i) s += part[(size_t)row * 16 + i];
    const float r = 1.0f / sqrtf(s * (1.0f / 1024.0f) + EPS);
    float* hr = h + (size_t)row * 1024;
    for (int j = 0; j < 16; ++j) { const int c = lane + 64 * j; hr[c] = hr[c] * r * fg[c]; }
}
}
#define LAS __attribute__((address_space(3)))
typedef float f32x4 __attribute__((ext_vector_type(4)));
typedef unsigned u32x4 __attribute__((ext_vector_type(4)));
typedef int i32x4 __attribute__((ext_vector_type(4)));

constexpr int TK_TOK = 32;
constexpr int TK_LSTRIDE = 132;
constexpr int TK_LDS_BYTES = 256 * TK_LSTRIDE * 4;

__device__ __forceinline__ void topk_item(LAS float* lds, const float* __restrict__ SC, int item, int head_base, int* __restrict__ seli, float* __restrict__ selg) {
    const int tid = threadIdx.x;
    const f32x4* src = (const f32x4*)(SC + (size_t)item * TK_TOK * 1024);
#pragma unroll 4
    for (int i = 0; i < 16; ++i) {
        const int idx = tid + i * 512; const int row = idx >> 8, c4 = idx & 255;
        const f32x4 v = src[idx];
        const int list = row * 8 + (c4 >> 5), elem = (c4 & 31) * 4;
        *(LAS f32x4*)(lds + list * TK_LSTRIDE + elem) = v;
    }
    __syncthreads();
    if (tid < 256) {
        const LAS float* my = lds + tid * TK_LSTRIDE;
        unsigned acc[16];
#pragma unroll
        for (int g = 0; g < 8; ++g) {
            unsigned t[16];
#pragma unroll
            for (int q = 0; q < 4; ++q) {
                const f32x4 v = *(const LAS f32x4*)(my + g * 16 + q * 4);
#pragma unroll
                for (int c = 0; c < 4; ++c) { const int e = g * 16 + q * 4 + c; t[q * 4 + c] = (tk_f2key(v[c]) & ~127u) | (unsigned)(127 - e); }
            }
            tk_sort16(t);
            if (g == 0) {
#pragma unroll
                for (int i = 0; i < 16; ++i) acc[i] = t[i];
            } else tk_merge16(acc, t);
        }
        unsigned oth[16];
#pragma unroll
        for (int i = 0; i < 16; ++i) oth[i] = (unsigned)__shfl_xor((int)acc[i], 1);
        if ((tid & 1) == 0) {
            const int tok = item * TK_TOK + (tid >> 3), head = head_base + ((tid >> 1) & 3);
            tk_combine_store(acc, oth, seli + (size_t)tok * 128 + head * 16, selg + (size_t)tok * 128 + head * 16);
        }
    }
    __syncthreads();
}
__global__ void __launch_bounds__(512) topk_kernel(const float* __restrict__ SC, int head_base, int* __restrict__ seli, float* __restrict__ selg) {
    extern __shared__ __attribute__((aligned(16))) unsigned char dyn_lds[];
    for (int item = blockIdx.x; item < T_ / TK_TOK; item += gridDim.x) topk_item((LAS float*)dyn_lds, SC, item, head_base, seli, selg);
}

template <int MODE>
__device__ __forceinline__ void gather_token(int t, int lane, const void* __restrict__ Utab, const void* __restrict__ Vtab, const float* __restrict__ gffn,
                                             const int* __restrict__ seli, const float* __restrict__ selg, const float* __restrict__ part2,
                                             float* __restrict__ H  , bf16* __restrict__ h2b, float* __restrict__ rstd3) {
    float ps = (lane < 16) ? part2[(size_t)t * 16 + lane] : 0.f;
    ps = wave_sum(ps);
    const float rstd2 = 1.0f / sqrtf(ps * (1.0f / 1024.0f) + EPS);
    const int iA = seli[(size_t)t * 128 + lane], iB = seli[(size_t)t * 128 + 64 + lane];
    const float gA = selg[(size_t)t * 128 + lane], gB = selg[(size_t)t * 128 + 64 + lane];
    float* hr = H + (size_t)t * 1024;
    if constexpr (MODE == 0) {
        f32x4 x[4], y[4], hv[4];
#pragma unroll
        for (int j = 0; j < 4; ++j) { hv[j] = *(const f32x4*)(hr + 256 * j + 4 * lane); const f32x4 g = *(const f32x4*)(gffn + 256 * j + 4 * lane); x[j] = hv[j] * g; y[j] = (f32x4){0.f, 0.f, 0.f, 0.f}; }
        const float* U = (const float*)Utab; const float* V = (const float*)Vtab;
        for (int k = 0; k < 64; ++k) {
#pragma unroll
            for (int hh = 0; hh < 2; ++hh) {
                const int e = __builtin_amdgcn_readlane(hh ? iB : iA, k);
                const float gt = __builtin_bit_cast(float, __builtin_amdgcn_readlane(__builtin_bit_cast(int, hh ? gB : gA), k));
                const float* ur = U + (size_t)e * 1024; const float* vr = V + (size_t)e * 1024;
                f32x4 uv[4], vv[4];
#pragma unroll
                for (int j = 0; j < 4; ++j) { uv[j] = *(const f32x4*)(ur + 256 * j + 4 * lane); vv[j] = *(const f32x4*)(vr + 256 * j + 4 * lane); }
                float d = 0.f;
#pragma unroll
                for (int j = 0; j < 4; ++j) d += (uv[j].x * x[j].x + uv[j].y * x[j].y) + (uv[j].z * x[j].z + uv[j].w * x[j].w);
                d = wave_sum(d);
                const float c = gt * gelu_tanh(d * rstd2);
#pragma unroll
                for (int j = 0; j < 4; ++j) y[j] += vv[j] * c;
            }
        }
        float sq = 0.f;
#pragma unroll
        for (int j = 0; j < 4; ++j) {
            const f32x4 h2 = hv[j] + y[j];
            *(f32x4*)(hr + 256 * j + 4 * lane) = h2;
            sq += (h2.x * h2.x + h2.y * h2.y) + (h2.z * h2.z + h2.w * h2.w);
            uint2 w; w.x = pk2(h2.x, h2.y); w.y = pk2(h2.z, h2.w);
            *(uint2*)(h2b + (size_t)t * 1024 + 256 * j + 4 * lane) = w;
        }
        sq = wave_sum(sq);
        if (lane == 0) rstd3[t] = 1.0f / sqrtf(sq * (1.0f / 1024.0f) + EPS);
    } else {
        float x[2][8], y[2][8], hv[2][8];
#pragma unroll
        for (int j = 0; j < 2; ++j) {
            const f32x4 a = *(const f32x4*)(hr + 512 * j + 8 * lane), b = *(const f32x4*)(hr + 512 * j + 8 * lane + 4);
            hv[j][0] = a.x; hv[j][1] = a.y; hv[j][2] = a.z; hv[j][3] = a.w; hv[j][4] = b.x; hv[j][5] = b.y; hv[j][6] = b.z; hv[j][7] = b.w;
#pragma unroll
            for (int c = 0; c < 8; ++c) { x[j][c] = hv[j][c]; y[j][c] = 0.f; }
        }
        const bf16* U = (const bf16*)Utab; const bf16* V = (const bf16*)Vtab;
        for (int k = 0; k < 64; k += 2) {
            u32x4 uv[4][2], vv[4][2]; float gt[4];
#pragma unroll
            for (int q = 0; q < 4; ++q) {
                const int kk = k + (q >> 1); const int hh = q & 1;
                const int e = __builtin_amdgcn_readlane(hh ? iB : iA, kk);
                gt[q] = __builtin_bit_cast(float, __builtin_amdgcn_readlane(__builtin_bit_cast(int, hh ? gB : gA), kk));
                const bf16* ur = U + (size_t)e * 1024; const bf16* vr = V + (size_t)e * 1024;
#pragma unroll
                for (int j = 0; j < 2; ++j) { uv[q][j] = *(const u32x4*)(ur + 512 * j + 8 * lane); vv[q][j] = *(const u32x4*)(vr + 512 * j + 8 * lane); }
            }
#pragma unroll
            for (int q = 0; q < 4; ++q) {
                float d = 0.f;
#pragma unroll
                for (int j = 0; j < 2; ++j)
#pragma unroll
                    for (int c = 0; c < 4; ++c) { const unsigned w = uv[q][j][c]; d = fmaf(__builtin_bit_cast(float, w << 16), x[j][2 * c], d); d = fmaf(__builtin_bit_cast(float, w & 0xffff0000u), x[j][2 * c + 1], d); }
                d = wave_sum(d);
                const float cf = gt[q] * gelu_tanh(d * rstd2);
#pragma unroll
                for (int j = 0; j < 2; ++j)
#pragma unroll
                    for (int c = 0; c < 4; ++c) { const unsigned w = vv[q][j][c]; y[j][2 * c] = fmaf(__builtin_bit_cast(float, w << 16), cf, y[j][2 * c]); y[j][2 * c + 1] = fmaf(__builtin_bit_cast(float, w & 0xffff0000u), cf, y[j][2 * c + 1]); }
            }
        }
        float sq = 0.f;
#pragma unroll
        for (int j = 0; j < 2; ++j) {
            float h2[8];
#pragma unroll
            for (int c = 0; c < 8; ++c) { h2[c] = hv[j][c] + y[j][c]; sq += h2[c] * h2[c]; }
            *(f32x4*)(hr + 512 * j + 8 * lane) = (f32x4){h2[0], h2[1], h2[2], h2[3]};
            *(f32x4*)(hr + 512 * j + 8 * lane + 4) = (f32x4){h2[4], h2[5], h2[6], h2[7]};
            u32x4 w; w.x = pk2(h2[0], h2[1]); w.y = pk2(h2[2], h2[3]); w.z = pk2(h2[4], h2[5]); w.w = pk2(h2[6], h2[7]);
            *(u32x4*)(h2b + (size_t)t * 1024 + 512 * j + 8 * lane) = w;
        }
        sq = wave_sum(sq);
        if (lane == 0) rstd3[t] = 1.0f / sqrtf(sq * (1.0f / 1024.0f) + EPS);
    }
}
template <int MODE>
__global__ void __launch_bounds__(256) gather_kernel(const void* __restrict__ Utab, const void* __restrict__ Vtab, const float* __restrict__ gffn, const int* __restrict__ seli, const float* __restrict__ selg,
                                                     const float* __restrict__ part2, float* __restrict__ H, bf16* __restrict__ h2b, float* __restrict__ rstd3) {
    const int lane = threadIdx.x & 63; const int w = blockIdx.x * 4 + (threadIdx.x >> 6); const int nw = gridDim.x * 4;
    for (int t = w; t < T_; t += nw) gather_token<MODE>(t, lane, Utab, Vtab, gffn, seli, selg, part2, H, h2b, rstd3);
}
static void launch_naive(void* const* d_in, float* out, unsigned char* ws, hipStream_t st) {
    const float* x = (const float*)d_in[0]; const float* p = (const float*)d_in[1]; const float* g_mix = (const float*)d_in[2]; const float* w_in = (const float*)d_in[3];
    const float* sink = (const float*)d_in[4]; const float* conv_w = (const float*)d_in[5]; const float* conv_b = (const float*)d_in[6];
    const float* wa = (const float*)d_in[7]; const float* ba = (const float*)d_in[8]; const float* wx = (const float*)d_in[9]; const float* bx = (const float*)d_in[10]; const float* lam = (const float*)d_in[11];
    const float* w_ua = (const float*)d_in[12]; const float* w_ul = (const float*)d_in[13]; const float* w_o = (const float*)d_in[14]; const float* g_ffn = (const float*)d_in[15];
    const float* wq = (const float*)d_in[16]; const float* k1 = (const float*)d_in[17]; const float* k2 = (const float*)d_in[18]; const float* pu = (const float*)d_in[19]; const float* pv = (const float*)d_in[20];
    const float* g_ple = (const float*)d_in[21]; const float* w_gate = (const float*)d_in[22]; const float* w_proj = (const float*)d_in[23]; const float* final_g = (const float*)d_in[24];
    float* rstd1 = (float*)(ws + WS_RSTD1); float* part2 = (float*)(ws + WS_PART2); float* part4 = (float*)(ws + WS_PART4); float* rstd3 = (float*)(ws + WS_RSTD3);
    bf16* qkv = (bf16*)(ws + WS_QKV); bf16* lx = (bf16*)(ws + WS_LX); bf16* gl = (bf16*)(ws + WS_GL); bf16* sga = (bf16*)(ws + WS_SGA); bf16* sgl = (bf16*)(ws + WS_SGL);
    bf16* att = (bf16*)(ws + WS_ATT); bf16* r0 = (bf16*)(ws + WS_R0); float* mp = (float*)(ws + WS_MP); bf16* merged = (bf16*)(ws + WS_MERGED);
    float* sc = (float*)(ws + WS_SC); int* seli = (int*)(ws + WS_SELI); float* selg = (float*)(ws + WS_SELG); bf16* h2b = (bf16*)(ws + WS_H2B); bf16* pp = (bf16*)(ws + WS_PP);
    float* tmpf = (float*)(ws + WS_NAIVE_AB);
    hipLaunchKernelGGL(nv::rowsq, dim3(T_ / 4), dim3(256), 0, st, x, rstd1, (float*)nullptr);
    nv::run_gemm<nv::ALf32, nv::EpiProj, false>(st, nv::ALf32{x, 1024}, w_in, INW, g_mix, T_, INW, 1024, nv::EpiProj{rstd1, qkv, lx, gl, sga, sgl});
    hipLaunchKernelGGL(nv::attn_naive, dim3(T_ * 8 / 128), dim3(128), 0, st, qkv, sink, att);
    hipLaunchKernelGGL(nv::conv_naive, dim3(T_ * 1024 / 256), dim3(256), 0, st, lx, conv_w, conv_b, r0);
    hipLaunchKernelGGL(nv::lru_ab_naive, dim3(T_ * 8), dim3(128), 0, st, r0, wa, ba, wx, bx, lam, out, tmpf);
    hipLaunchKernelGGL(nv::lru_scan_naive, dim3(B_ * 1024 / 64), dim3(64), 0, st, out, tmpf, gl, r0);
    nv::run_gemm<nv::ALbf16, nv::EpiMP, false>(st, nv::ALbf16{att, 512}, w_ua, 1024, nullptr, T_, 1024, 512, nv::EpiMP{sga, mp});
    nv::run_gemm<nv::ALbf16, nv::EpiMerged, false>(st, nv::ALbf16{r0, 1024}, w_ul, 1024, nullptr, T_, 1024, 1024, nv::EpiMerged{sgl, mp, merged});
    nv::run_gemm<nv::ALbf16, nv::EpiH1, false>(st, nv::ALbf16{merged, 1024}, w_o, 1024, nullptr, T_, 1024, 1024, nv::EpiH1{x, out, r0});
    hipLaunchKernelGGL(nv::rowsq, dim3(T_ / 4), dim3(256), 0, st, out, (float*)nullptr, part2);
    for (int half = 0; half < 2; ++half) {
        nv::run_gemm<nv::ALf32, nv::EpiScaleF32, false>(st, nv::ALf32{out, 1024}, wq + half * 1024, 2048, g_ffn, T_, 1024, 1024, nv::EpiScaleF32{part2, tmpf, 1024});
        for (int hl = 0; hl < 4; ++hl)
            for (int hf = 0; hf < 2; ++hf)
                nv::run_gemm<nv::ALf32, nv::EpiPlainF32, true>(st, nv::ALf32{tmpf + hl * 256 + hf * 128, 1024}, hf ? k2 : k1, 128, nullptr, T_, 128, 128, nv::EpiPlainF32{sc + hl * 256 + hf * 128, 1024});
        hipLaunchKernelGGL(topk_kernel, dim3(T_ / TK_TOK), dim3(512), TK_LDS_BYTES, st, sc, half * 4, seli, selg);
    }
    hipLaunchKernelGGL(gather_kernel<0>, dim3(1024), dim3(256), 0, st, (const void*)pu, (const void*)pv, g_ffn, seli, selg, part2, out, h2b, rstd3);
    nv::run_gemm<nv::ALf32, nv::EpiPP, false>(st, nv::ALf32{p, 256}, w_proj, 1024, nullptr, T_, 1024, 256, nv::EpiPP{pp});
    nv::run_gemm<nv::ALbf16, nv::EpiH3, false>(st, nv::ALbf16{h2b, 1024}, w_gate, 1024, g_ple, T_, 1024, 1024, nv::EpiH3{rstd3, pp, out});
    hipLaunchKernelGGL(nv::rowsq, dim3(T_ / 4), dim3(256), 0, st, out, (float*)nullptr, part4);
    hipLaunchKernelGGL(nv::final_norm, dim3(T_ / 4), dim3(256), 0, st, out, part4, final_g);
}

extern "C" void kernel_launch(void* const* d_in, const int* in_sizes, int n_in, void* d_out, int out_size, void* d_ws, size_t ws_size, hipStream_t stream) {
    static int inited = 0;
    if (!inited) {
        inited = 1;
        if (n_in != 25 || out_size != T_ * 1024 || ws_size < WS_END) fprintf(stderr, "kernel_launch: unexpected sizes n_in %d out %d ws %zu\n", n_in, out_size, ws_size);
        (void)hipFuncSetAttribute((const void*)topk_kernel, hipFuncAttributeMaxDynamicSharedMemorySize, TK_LDS_BYTES);
    }
    launch_naive(d_in, (float*)d_out, (unsigned char*)d_ws, stream);
}
```

```cpp
#include <hip/hip_runtime.h>
#include <cstdio>
#include <cstdint>
#include <cmath>

constexpr int B_ = 8, S_ = 2048, D_ = 1024, T_ = B_ * S_;
constexpr int INW = 4864;
constexpr float EPS = 1e-6f;
typedef unsigned short bf16;
#define HD_INLINE __host__ __device__ __forceinline__

constexpr size_t MiB = 1u << 20;
constexpr size_t WS_CTL = 0;
constexpr size_t WS_WIN = 1 * MiB;
constexpr size_t WS_WUA = WS_WIN + 4864 * 1024 * 2;
constexpr size_t WS_WUL = WS_WUA + 1 * MiB;
constexpr size_t WS_WO = WS_WUL + 2 * MiB;
constexpr size_t WS_WFOLD = WS_WO + 2 * MiB;
constexpr size_t WS_WG = WS_WFOLD + 4 * MiB;
constexpr size_t WS_WPROJ = WS_WG + 2 * MiB;
constexpr size_t WS_WAX = WS_WPROJ + MiB / 2;
constexpr size_t WS_W_END = WS_WAX + 1 * MiB;
static_assert(WS_W_END <= 23 * MiB, "weights");
constexpr size_t WS_RSTD1 = 23 * MiB;
constexpr size_t WS_PART2 = WS_RSTD1 + 256 * 1024;
constexpr size_t WS_PART4 = WS_PART2 + 1 * MiB;
constexpr size_t WS_RSTD3 = WS_PART4 + 1 * MiB;
constexpr size_t WS_AGG = WS_RSTD3 + 256 * 1024;
constexpr size_t WS_C8 = WS_AGG + 2 * MiB;
constexpr size_t WS_USCALE = WS_C8 + 64 * 1024;
static_assert(WS_USCALE + 128 * 1024 <= 28 * MiB, "small");
constexpr size_t WS_PB = 28 * MiB;
constexpr size_t WS_R0 = 36 * MiB;
constexpr size_t WS_QKV = 68 * MiB;
constexpr size_t WS_LX = 92 * MiB;
constexpr size_t WS_GL = 140 * MiB;
constexpr size_t WS_SGA = 172 * MiB;
constexpr size_t WS_SGL = 204 * MiB;
constexpr size_t WS_ATT = 236 * MiB;
constexpr size_t WS_HLOC = 68 * MiB, WS_PCUM = 100 * MiB;
constexpr size_t WS_MP = 68 * MiB;
constexpr size_t WS_MERGED = 140 * MiB;
constexpr size_t WS_SC = 172 * MiB;
constexpr size_t WS_SELI = 236 * MiB, WS_SELG = 244 * MiB;
constexpr size_t WS_U16 = 68 * MiB, WS_V16 = 100 * MiB;
constexpr size_t WS_H2B = 140 * MiB;
constexpr size_t WS_PP = 172 * MiB;
constexpr size_t WS_NAIVE_AB = 68 * MiB;
constexpr size_t WS_WAXD = 252 * MiB;
constexpr size_t WS_END = 256 * MiB;

HD_INLINE float bf2f(bf16 v) { return __builtin_bit_cast(float, (unsigned)v << 16); }
HD_INLINE bf16 f2bf(float f) { unsigned u = __builtin_bit_cast(unsigned, f); return (bf16)((u + 0x7fffu + ((u >> 16) & 1u)) >> 16); }
HD_INLINE unsigned pk2(float lo, float hi) { return (unsigned)f2bf(lo) | ((unsigned)f2bf(hi) << 16); }
__device__ __forceinline__ float wave_sum(float v) {
#pragma unroll
    for (int o = 1; o < 64; o <<= 1) v += __shfl_xor(v, o);
    return v;
}
__device__ __forceinline__ float sigmoidf_(float z) { return __builtin_amdgcn_rcpf(1.0f + __builtin_amdgcn_exp2f(-1.4426950408889634f * z)); }
__device__ __forceinline__ float gelu_tanh(float x) { const float u = 1.5957691216057308f * (x + 0.044715f * x * x * x); return x * sigmoidf_(u); }
__device__ __forceinline__ int fresh_lane() { int l; asm volatile("v_mbcnt_lo_u32_b32 %0, -1, 0\n\tv_mbcnt_hi_u32_b32 %0, -1, %0" : "=v"(l)); return l; }
#ifndef HD_INLINE
#define HD_INLINE __host__ __device__ __forceinline__
#endif

HD_INLINE unsigned tk_umax(unsigned a, unsigned b) { return a > b ? a : b; }
HD_INLINE unsigned tk_umin(unsigned a, unsigned b) { return a < b ? a : b; }
HD_INLINE unsigned tk_f2key(float f) { unsigned u = __builtin_bit_cast(unsigned, f); return u ^ ((unsigned)((int)u >> 31) | 0x80000000u); }
HD_INLINE float tk_key2f(unsigned k) { unsigned u = (k & 0x80000000u) ? (k ^ 0x80000000u) : ~k; return __builtin_bit_cast(float, u); }

HD_INLINE void tk_sort16(unsigned (&a)[16]) {
#pragma unroll
    for (int k = 2; k <= 16; k <<= 1) {
#pragma unroll
        for (int j = k >> 1; j > 0; j >>= 1) {
#pragma unroll
            for (int i = 0; i < 16; ++i) {
                const int p = i ^ j;
                if (p > i) {
                    const unsigned mx = tk_umax(a[i], a[p]), mn = tk_umin(a[i], a[p]);
                    if ((i & k) == 0) { a[i] = mx; a[p] = mn; } else { a[i] = mn; a[p] = mx; }
                }
            }
        }
    }
}
HD_INLINE void tk_merge16(unsigned (&a)[16], const unsigned (&b)[16]) {
#pragma unroll
    for (int i = 0; i < 16; ++i) a[i] = tk_umax(a[i], b[15 - i]);
#pragma unroll
    for (int j = 8; j > 0; j >>= 1) {
#pragma unroll
        for (int i = 0; i < 16; ++i) {
            const int p = i ^ j;
            if (p > i) { const unsigned mx = tk_umax(a[i], a[p]), mn = tk_umin(a[i], a[p]); a[i] = mx; a[p] = mn; }
        }
    }
}
HD_INLINE void tk_insert16(unsigned (&best)[16], unsigned key) {
#pragma unroll
    for (int s = 0; s < 16; ++s) { const unsigned hi = tk_umax(best[s], key); key = tk_umin(best[s], key); best[s] = hi; }
}
HD_INLINE void tk_combine_store(const unsigned (&k1)[16], const unsigned (&k2)[16], int* oi, float* og) {
    float v1[16], v2[16];
#pragma unroll
    for (int i = 0; i < 16; ++i) { v1[i] = tk_key2f(k1[i] & ~127u); v2[i] = tk_key2f(k2[i] & ~127u); }
    unsigned best[16];
#pragma unroll
    for (int s = 0; s < 16; ++s) best[s] = 0u;
#pragma unroll
    for (int i = 0; i < 16; ++i) {
#pragma unroll
        for (int j = 0; j < 16; ++j) {
            if ((i + 1) * (j + 1) <= 16) {
                const float s = v1[i] + v2[j];
                const unsigned key = (tk_f2key(s) & ~255u) | (unsigned)(255 - (i * 16 + j));
                tk_insert16(best, key);
            }
        }
    }
    const unsigned thr = best[15];
    const float mx = tk_key2f(best[0] & ~255u);
    float sum = 0.f;
#pragma unroll
    for (int i = 0; i < 16; ++i) {
#pragma unroll
        for (int j = 0; j < 16; ++j) {
            if ((i + 1) * (j + 1) <= 16) {
                const float s = v1[i] + v2[j];
                const unsigned key = (tk_f2key(s) & ~255u) | (unsigned)(255 - (i * 16 + j));
                if (key >= thr) sum += __builtin_expf(s - mx);
            }
        }
    }
    const float inv = 1.0f / sum;
    int cnt = 0;
#pragma unroll
    for (int i = 0; i < 16; ++i) {
#pragma unroll
        for (int j = 0; j < 16; ++j) {
            if ((i + 1) * (j + 1) <= 16) {
                const float s = v1[i] + v2[j];
                const unsigned key = (tk_f2key(s) & ~255u) | (unsigned)(255 - (i * 16 + j));
                if (key >= thr) {
                    oi[cnt] = (127 - (int)(k1[i] & 127u)) * 128 + (127 - (int)(k2[j] & 127u));
                    og[cnt] = __builtin_expf(s - mx) * inv;
                    ++cnt;
                }
            }
        }
    }
}
namespace nv {
struct ALf32 { const float* p; int lda; int pad; __device__ __forceinline__ float operator()(int m, int k) const { return p[(size_t)m * lda + k]; } };
struct ALbf16 { const bf16* p; int lda; int pad; __device__ __forceinline__ float operator()(int m, int k) const { return bf2f(p[(size_t)m * lda + k]); } };

template <class AL, class EPI, bool BT>
__global__ void __launch_bounds__(256) ngemm(AL al, const float* __restrict__ B, int ldb, const float* __restrict__ ks, int M, int N, int K, EPI epi) {
    __shared__ float As[16][68];
    __shared__ float Bs[16][68];
    const int tid = threadIdx.x, tx = tid & 15, ty = tid >> 4;
    const int m0 = blockIdx.y * 64, n0 = blockIdx.x * 64;
    float acc[4][4];
#pragma unroll
    for (int i = 0; i < 4; ++i)
#pragma unroll
        for (int j = 0; j < 4; ++j) acc[i][j] = 0.f;
    for (int k0 = 0; k0 < K; k0 += 16) {
#pragma unroll
        for (int i = 0; i < 4; ++i) {
            const int e = tid + i * 256;
            { const int m = e >> 4, k = e & 15; float v = al(m0 + m, k0 + k); if (ks) v *= ks[k0 + k]; As[k][m] = v; }
            if (BT) { const int n = e >> 4, k = e & 15; Bs[k][n] = B[(size_t)(n0 + n) * ldb + k0 + k]; }
            else { const int k = e >> 6, n = e & 63; Bs[k][n] = B[(size_t)(k0 + k) * ldb + n0 + n]; }
        }
        __syncthreads();
#pragma unroll
        for (int k = 0; k < 16; ++k) {
            float a[4], b[4];
#pragma unroll
            for (int i = 0; i < 4; ++i) { a[i] = As[k][ty * 4 + i]; b[i] = Bs[k][tx * 4 + i]; }
#pragma unroll
            for (int i = 0; i < 4; ++i)
#pragma unroll
                for (int j = 0; j < 4; ++j) acc[i][j] = fmaf(a[i], b[j], acc[i][j]);
        }
        __syncthreads();
    }
#pragma unroll
    for (int i = 0; i < 4; ++i)
#pragma unroll
        for (int j = 0; j < 4; ++j) epi(m0 + ty * 4 + i, n0 + tx * 4 + j, acc[i][j]);
}
template <class AL, class EPI, bool BT>
static void run_gemm(hipStream_t st, AL al, const float* B, int ldb, const float* ks, int M, int N, int K, EPI epi) {
    hipLaunchKernelGGL((ngemm<AL, EPI, BT>), dim3(N / 64, M / 64), dim3(256), 0, st, al, B, ldb, ks, M, N, K, epi);
}

__global__ void __launch_bounds__(256) rowsq(const float* __restrict__ X, float* rstd, float* part) {
    const int row = blockIdx.x * 4 + (threadIdx.x >> 6), lane = threadIdx.x & 63;
    const float* xr = X + (size_t)row * 1024;
    float s = 0.f;
    for (int j = 0; j < 16; ++j) { const float v = xr[lane + 64 * j]; s += v * v; }
    s = wave_sum(s);
    if (rstd && lane == 0) rstd[row] = 1.0f / sqrtf(s * (1.0f / 1024.0f) + EPS);
    if (part && lane < 16) part[(size_t)row * 16 + lane] = (lane == 0) ? s : 0.f;
}

struct EpiProj {
    const float* rstd; bf16 *qkv, *lx, *gl, *sga, *sgl;
    __device__ __forceinline__ void operator()(int m, int n, float v) const {
        v *= rstd[m];
        if (n < 768) qkv[(size_t)m * 768 + n] = f2bf(v);
        else if (n < 1792) lx[(size_t)m * 1024 + (n - 768)] = f2bf(v);
        else if (n < 2816) gl[(size_t)m * 1024 + (n - 1792)] = f2bf(gelu_tanh(v));
        else if (n < 3840) sga[(size_t)m * 1024 + (n - 2816)] = f2bf(sigmoidf_(v));
        else sgl[(size_t)m * 1024 + (n - 3840)] = f2bf(sigmoidf_(v));
    }
};

__global__ void __launch_bounds__(128) attn_naive(const bf16* __restrict__ qkv, const float* __restrict__ sink, bf16* __restrict__ att) {
    const int gid = blockIdx.x * 128 + threadIdx.x;
    const int head = gid / T_, t = gid % T_;
    const int b = t / S_, ts = t % S_;
    const int g = head >> 2;
    float q[64], acc[64];
    const bf16* qp = qkv + (size_t)t * 768 + head * 64;
#pragma unroll
    for (int d = 0; d < 64; ++d) { q[d] = bf2f(qp[d]); acc[d] = 0.f; }
    const float slope = exp2f(-(float)(head + 1));
    float m = -3.0e38f, l = 0.f;
    for (int dist = 127; dist >= 0; --dist) {
        const int s = ts - dist; if (s < 0) continue;
        const bf16* kp = qkv + (size_t)(b * S_ + s) * 768 + 512 + g * 64;
        const bf16* vp = kp + 128;
        float sc = 0.f;
#pragma unroll
        for (int d = 0; d < 64; ++d) sc = fmaf(q[d], bf2f(kp[d]), sc);
        sc = sc * 0.125f - slope * (float)dist;
        const float mn = fmaxf(m, sc), corr = __expf(m - mn), p = __expf(sc - mn);
        l = l * corr + p;
#pragma unroll
        for (int d = 0; d < 64; ++d) acc[d] = acc[d] * corr + p * bf2f(vp[d]);
        m = mn;
    }
    const float sk = sink[head];
    const float mf = fmaxf(m, sk), corr = __expf(m - mf);
    l = l * corr + __expf(sk - mf);
    const float inv = corr / l;
    bf16* op = att + (size_t)t * 512 + head * 64;
#pragma unroll
    for (int d = 0; d < 64; ++d) op[d] = f2bf(acc[d] * inv);
}

__global__ void __launch_bounds__(256) conv_naive(const bf16* __restrict__ lx, const float* __restrict__ cw, const float* __restrict__ cb, bf16* __restrict__ lin) {
    const size_t i = (size_t)blockIdx.x * 256 + threadIdx.x;
    const int c = (int)(i & 1023); const int t = (int)(i >> 10); const int ts = t % S_;
    float y = cb[c];
#pragma unroll
    for (int tap = 0; tap < 4; ++tap) { const int s = ts - 3 + tap; if (s >= 0) y = fmaf(bf2f(lx[(size_t)(t - 3 + tap) * 1024 + c]), cw[tap * 1024 + c], y); }
    lin[i] = f2bf(y);
}

__global__ void __launch_bounds__(128) lru_ab_naive(const bf16* __restrict__ lin, const float* __restrict__ wa, const float* __restrict__ ba, const float* __restrict__ wx, const float* __restrict__ bx,
                                                    const float* __restrict__ lam, float* __restrict__ Af, float* __restrict__ Bf) {
    __shared__ float xs[128];
    const int t = blockIdx.x >> 3, blk = blockIdx.x & 7, d = threadIdx.x, ch = blk * 128 + d;
    xs[d] = bf2f(lin[(size_t)t * 1024 + ch]);
    __syncthreads();
    float r = ba[ch], ii = bx[ch];
    const float* wap = wa + (size_t)blk * 128 * 128 + d; const float* wxp = wx + (size_t)blk * 128 * 128 + d;
    for (int c = 0; c < 128; ++c) { r = fmaf(xs[c], wap[c * 128], r); ii = fmaf(xs[c], wxp[c * 128], ii); }
    r = sigmoidf_(r); ii = sigmoidf_(ii);
    const float sp = log1pf(expf(-lam[ch]));
    const float loga = -8.0f * r * sp;
    const float a = expf(loga);
    const float bb = sqrtf(-expm1f(2.0f * loga)) * (ii * xs[d]);
    Af[(size_t)t * 1024 + ch] = a; Bf[(size_t)t * 1024 + ch] = bb;
}
__global__ void __launch_bounds__(256) lru_ab_from_pre(const bf16* __restrict__ lin, const float* __restrict__ ba, const float* __restrict__ bx, const float* __restrict__ lam, float* __restrict__ Af, float* __restrict__ Bf) {
    const size_t i = (size_t)blockIdx.x * 256 + threadIdx.x; const int ch = (int)(i & 1023);
    const float r = sigmoidf_(Af[i] + ba[ch]), ii = sigmoidf_(Bf[i] + bx[ch]);
    const float loga = -8.0f * r * log1pf(expf(-lam[ch]));
    Af[i] = expf(loga); Bf[i] = sqrtf(-expm1f(2.0f * loga)) * (ii * bf2f(lin[i]));
}
template <int L>
__global__ void __launch_bounds__(64) lru_finish_naive_L(const bf16* __restrict__ hloc, const bf16* __restrict__ pcum, const bf16* __restrict__ gl, bf16* __restrict__ rec) {
    const int gid = blockIdx.x * 64 + threadIdx.x; const int b = gid >> 10, ch = gid & 1023;
    float carry = 0.f;
    for (int c = 0; c < S_ / L; ++c) {
        float la = 1.f, lb = 0.f;
        for (int s = 0; s < L; ++s) { const size_t o = (size_t)(b * S_ + c * L + s) * 1024 + ch; la = bf2f(pcum[o]); lb = bf2f(hloc[o]); const float h = la * carry + lb; rec[o] = f2bf(h * bf2f(gl[o])); }
        carry = la * carry + lb;
    }
}
__global__ void __launch_bounds__(64) lru_finish_naive(const bf16* __restrict__ hloc, const bf16* __restrict__ pcum, const float* __restrict__ agg, const bf16* __restrict__ gl, bf16* __restrict__ rec) {
    const int gid = blockIdx.x * 64 + threadIdx.x; const int b = gid >> 10, ch = gid & 1023;
    float carry = 0.f;
    for (int c = 0; c < 32; ++c) {
        const int chunk = b * 32 + c;
        for (int s = 0; s < 64; ++s) { const size_t o = (size_t)(chunk * 64 + s) * 1024 + ch; const float h = bf2f(pcum[o]) * carry + bf2f(hloc[o]); rec[o] = f2bf(h * bf2f(gl[o])); }
        const float* ap = agg + ((size_t)chunk * 1024 + ch) * 2; carry = ap[0] * carry + ap[1];
    }
}
__global__ void __launch_bounds__(128) lru_pre_check(const bf16* __restrict__ lin, const float* __restrict__ wa, const float* __restrict__ wx, const float* __restrict__ Rp, const float* __restrict__ Ip, unsigned* flag) {
    __shared__ float xs[128];
    const int t = blockIdx.x >> 3, blk = blockIdx.x & 7, d = threadIdx.x, ch = blk * 128 + d;
    xs[d] = bf2f(lin[(size_t)t * 1024 + ch]);
    __syncthreads();
    float r = 0.f, ii = 0.f;
    const float* wap = wa + (size_t)blk * 128 * 128 + d; const float* wxp = wx + (size_t)blk * 128 * 128 + d;
    for (int c = 0; c < 128; ++c) { r = fmaf(xs[c], wap[c * 128], r); ii = fmaf(xs[c], wxp[c * 128], ii); }
    const float dr = fabsf(r - Rp[(size_t)t * 1024 + ch]), di = fabsf(ii - Ip[(size_t)t * 1024 + ch]);
    if (!(dr < 0.08f + 0.03f * fabsf(r)) || !(di < 0.08f + 0.03f * fabsf(ii))) atomicAdd(flag, 1u);
}
__global__ void __launch_bounds__(256) poison_if(float* out, const unsigned* flag) { if (*flag) { const size_t i = (size_t)blockIdx.x * 256 + threadIdx.x; out[i] = out[i] * 50.0f + 3.0f; } }
__global__ void __launch_bounds__(64) lru_scan_naive(const float* __restrict__ Af, const float* __restrict__ Bf, const bf16* __restrict__ gl, bf16* __restrict__ rec) {
    const int gid = blockIdx.x * 64 + threadIdx.x; const int b = gid >> 10, ch = gid & 1023;
    float h = 0.f;
    for (int s = 0; s < S_; ++s) { const size_t o = (size_t)(b * S_ + s) * 1024 + ch; h = fmaf(Af[o], h, Bf[o]); rec[o] = f2bf(h * bf2f(gl[o])); }
}

struct EpiMP { const bf16* sga; float* mp; __device__ __forceinline__ void operator()(int m, int n, float v) const { const size_t o = (size_t)m * 1024 + n; mp[o] = v * bf2f(sga[o]); } };
struct EpiMerged { const bf16* sgl; const float* mp; bf16* merged; __device__ __forceinline__ void operator()(int m, int n, float v) const { const size_t o = (size_t)m * 1024 + n; merged[o] = f2bf(mp[o] + v * bf2f(sgl[o])); } };
struct EpiH1 { const float* x; float* h1; bf16* h1b; __device__ __forceinline__ void operator()(int m, int n, float v) const { const size_t o = (size_t)m * 1024 + n; const float h = x[o] + v; h1[o] = h; h1b[o] = f2bf(h); } };
struct EpiScaleF32 { const float* part; float* out; int ldo; int pad; __device__ __forceinline__ void operator()(int m, int n, float v) const {
    float s = 0.f; for (int i = 0; i < 16; ++i) s += part[(size_t)m * 16 + i];
    out[(size_t)m * ldo + n] = v * (1.0f / sqrtf(s * (1.0f / 1024.0f) + EPS)); } };
struct EpiPlainF32 { float* out; int ldo; int pad; __device__ __forceinline__ void operator()(int m, int n, float v) const { out[(size_t)m * ldo + n] = v; } };
struct EpiPP { bf16* pp; __device__ __forceinline__ void operator()(int m, int n, float v) const { pp[(size_t)m * 1024 + n] = f2bf(v); } };
struct EpiH3 { const float* rstd3; const bf16* pp; float* h; __device__ __forceinline__ void operator()(int m, int n, float v) const { const size_t o = (size_t)m * 1024 + n; h[o] = h[o] + sigmoidf_(v * rstd3[m]) * bf2f(pp[o]); } };

__global__ void __launch_bounds__(256) final_norm(float* __restrict__ h, const float* __restrict__ part, const float* __restrict__ fg) {
    const int row = blockIdx.x * 4 + (threadIdx.x >> 6), lane = threadIdx.x & 63;
    float s = 0.f; for (int i = 0; i < 16; ++i) s += part[(size_t)row * 16 + i];
    const float r = 1.0f / sqrtf(s * (1.0f / 1024.0f) + EPS);
    float* hr = h + (size_t)row * 1024;
    for (int j = 0; j < 16; ++j) { const int c = lane + 64 * j; hr[c] = hr[c] * r * fg[c]; }
}
}
#define LAS __attribute__((address_space(3)))
typedef float f32x4 __attribute__((ext_vector_type(4)));
typedef unsigned u32x4 __attribute__((ext_vector_type(4)));
typedef int i32x4 __attribute__((ext_vector_type(4)));

constexpr int TK_TOK = 32;
constexpr int TK_LSTRIDE = 132;
constexpr int TK_LDS_BYTES = 256 * TK_LSTRIDE * 4;

__device__ __forceinline__ void topk_item(LAS float* lds, const float* __restrict__ SC, int item, int head_base, int* __restrict__ seli, float* __restrict__ selg, int tid) {
    const f32x4* src = (const f32x4*)(SC + (size_t)item * TK_TOK * 1024);
#pragma unroll 4
    for (int i = 0; i < 16; ++i) {
        const int idx = tid + i * 512; const int row = idx >> 8, c4 = idx & 255;
        const f32x4 v = src[idx];
        const int list = row * 8 + (c4 >> 5), elem = (c4 & 31) * 4;
        *(LAS f32x4*)(lds + list * TK_LSTRIDE + elem) = v;
    }
    __syncthreads();
    if (tid < 256) {
        const LAS float* my = lds + tid * TK_LSTRIDE;
        unsigned acc[16];
#pragma unroll
        for (int g = 0; g < 8; ++g) {
            unsigned t[16];
#pragma unroll
            for (int q = 0; q < 4; ++q) {
                const f32x4 v = *(const LAS f32x4*)(my + g * 16 + q * 4);
#pragma unroll
                for (int c = 0; c < 4; ++c) { const int e = g * 16 + q * 4 + c; t[q * 4 + c] = (tk_f2key(v[c]) & ~127u) | (unsigned)(127 - e); }
            }
            tk_sort16(t);
            if (g == 0) {
#pragma unroll
                for (int i = 0; i < 16; ++i) acc[i] = t[i];
            } else tk_merge16(acc, t);
        }
        unsigned oth[16];
#pragma unroll
        for (int i = 0; i < 16; ++i) oth[i] = (unsigned)__shfl_xor((int)acc[i], 1);
        if ((tid & 1) == 0) {
            const int tok = item * TK_TOK + (tid >> 3), head = head_base + ((tid >> 1) & 3);
            tk_combine_store(acc, oth, seli + (size_t)tok * 128 + head * 16, selg + (size_t)tok * 128 + head * 16);
        }
    }
    __syncthreads();
}
__global__ void __launch_bounds__(512) topk_kernel(const float* __restrict__ SC, int head_base, int* __restrict__ seli, float* __restrict__ selg) {
    extern __shared__ __attribute__((aligned(16))) unsigned char dyn_lds[];
    for (int item = blockIdx.x; item < T_ / TK_TOK; item += gridDim.x) topk_item((LAS float*)dyn_lds, SC, item, head_base, seli, selg, (int)threadIdx.x);
}

template <int MODE>
__device__ __forceinline__ void gather_token(int t, int lane, const void* __restrict__ Utab, const void* __restrict__ Vtab, const float* __restrict__ gffn,
                                             const int* __restrict__ seli, const float* __restrict__ selg, const float* __restrict__ part2,
                                             float* __restrict__ H  , bf16* __restrict__ h2b, float* __restrict__ rstd3) {
    float ps = (lane < 16) ? part2[(size_t)t * 16 + lane] : 0.f;
    ps = wave_sum(ps);
    const float rstd2 = 1.0f / sqrtf(ps * (1.0f / 1024.0f) + EPS);
    const int iA = seli[(size_t)t * 128 + lane], iB = seli[(size_t)t * 128 + 64 + lane];
    const float gA = selg[(size_t)t * 128 + lane], gB = selg[(size_t)t * 128 + 64 + lane];
    float* hr = H + (size_t)t * 1024;
    if constexpr (MODE == 0) {
        f32x4 x[4], y[4], hv[4];
#pragma unroll
        for (int j = 0; j < 4; ++j) { hv[j] = *(const f32x4*)(hr + 256 * j + 4 * lane); const f32x4 g = *(const f32x4*)(gffn + 256 * j + 4 * lane); x[j] = hv[j] * g; y[j] = (f32x4){0.f, 0.f, 0.f, 0.f}; }
        const float* U = (const float*)Utab; const float* V = (const float*)Vtab;
        for (int k = 0; k < 64; ++k) {
#pragma unroll
            for (int hh = 0; hh < 2; ++hh) {
                const int e = __builtin_amdgcn_readlane(hh ? iB : iA, k);
                const float gt = __builtin_bit_cast(float, __builtin_amdgcn_readlane(__builtin_bit_cast(int, hh ? gB : gA), k));
                const float* ur = U + (size_t)e * 1024; const float* vr = V + (size_t)e * 1024;
                f32x4 uv[4], vv[4];
#pragma unroll
                for (int j = 0; j < 4; ++j) { uv[j] = *(const f32x4*)(ur + 256 * j + 4 * lane); vv[j] = *(const f32x4*)(vr + 256 * j + 4 * lane); }
                float d = 0.f;
#pragma unroll
                for (int j = 0; j < 4; ++j) d += (uv[j].x * x[j].x + uv[j].y * x[j].y) + (uv[j].z * x[j].z + uv[j].w * x[j].w);
                d = wave_sum(d);
                const float c = gt * gelu_tanh(d * rstd2);
#pragma unroll
                for (int j = 0; j < 4; ++j) y[j] += vv[j] * c;
            }
        }
        float sq = 0.f;
#pragma unroll
        for (int j = 0; j < 4; ++j) {
            const f32x4 h2 = hv[j] + y[j];
            *(f32x4*)(hr + 256 * j + 4 * lane) = h2;
            sq += (h2.x * h2.x + h2.y * h2.y) + (h2.z * h2.z + h2.w * h2.w);
            uint2 w; w.x = pk2(h2.x, h2.y); w.y = pk2(h2.z, h2.w);
            *(uint2*)(h2b + (size_t)t * 1024 + 256 * j + 4 * lane) = w;
        }
        sq = wave_sum(sq);
        if (lane == 0) rstd3[t] = 1.0f / sqrtf(sq * (1.0f / 1024.0f) + EPS);
    } else {
        float x[2][8], y[2][8], hv[2][8];
#pragma unroll
        for (int j = 0; j < 2; ++j) {
            const f32x4 a = *(const f32x4*)(hr + 512 * j + 8 * lane), b = *(const f32x4*)(hr + 512 * j + 8 * lane + 4);
            hv[j][0] = a.x; hv[j][1] = a.y; hv[j][2] = a.z; hv[j][3] = a.w; hv[j][4] = b.x; hv[j][5] = b.y; hv[j][6] = b.z; hv[j][7] = b.w;
#pragma unroll
            for (int c = 0; c < 8; ++c) { x[j][c] = hv[j][c]; y[j][c] = 0.f; }
        }
        const bf16* U = (const bf16*)Utab; const bf16* V = (const bf16*)Vtab;
        for (int k = 0; k < 64; k += 2) {
            u32x4 uv[4][2], vv[4][2]; float gt[4];
#pragma unroll
            for (int q = 0; q < 4; ++q) {
                const int kk = k + (q >> 1); const int hh = q & 1;
                const int e = __builtin_amdgcn_readlane(hh ? iB : iA, kk);
                gt[q] = __builtin_bit_cast(float, __builtin_amdgcn_readlane(__builtin_bit_cast(int, hh ? gB : gA), kk));
                const bf16* ur = U + (size_t)e * 1024; const bf16* vr = V + (size_t)e * 1024;
#pragma unroll
                for (int j = 0; j < 2; ++j) { uv[q][j] = *(const u32x4*)(ur + 512 * j + 8 * lane); vv[q][j] = *(const u32x4*)(vr + 512 * j + 8 * lane); }
            }
#pragma unroll
            for (int q = 0; q < 4; ++q) {
                float d = 0.f;
#pragma unroll
                for (int j = 0; j < 2; ++j)
#pragma unroll
                    for (int c = 0; c < 4; ++c) { const unsigned w = uv[q][j][c]; d = fmaf(__builtin_bit_cast(float, w << 16), x[j][2 * c], d); d = fmaf(__builtin_bit_cast(float, w & 0xffff0000u), x[j][2 * c + 1], d); }
                d = wave_sum(d);
                const float cf = gt[q] * gelu_tanh(d * rstd2);
#pragma unroll
                for (int j = 0; j < 2; ++j)
#pragma unroll
                    for (int c = 0; c < 4; ++c) { const unsigned w = vv[q][j][c]; y[j][2 * c] = fmaf(__builtin_bit_cast(float, w << 16), cf, y[j][2 * c]); y[j][2 * c + 1] = fmaf(__builtin_bit_cast(float, w & 0xffff0000u), cf, y[j][2 * c + 1]); }
            }
        }
        float sq = 0.f;
#pragma unroll
        for (int j = 0; j < 2; ++j) {
            float h2[8];
#pragma unroll
            for (int c = 0; c < 8; ++c) { h2[c] = hv[j][c] + y[j][c]; sq += h2[c] * h2[c]; }
            *(f32x4*)(hr + 512 * j + 8 * lane) = (f32x4){h2[0], h2[1], h2[2], h2[3]};
            *(f32x4*)(hr + 512 * j + 8 * lane + 4) = (f32x4){h2[4], h2[5], h2[6], h2[7]};
            u32x4 w; w.x = pk2(h2[0], h2[1]); w.y = pk2(h2[2], h2[3]); w.z = pk2(h2[4], h2[5]); w.w = pk2(h2[6], h2[7]);
            *(u32x4*)(h2b + (size_t)t * 1024 + 512 * j + 8 * lane) = w;
        }
        sq = wave_sum(sq);
        if (lane == 0) rstd3[t] = 1.0f / sqrtf(sq * (1.0f / 1024.0f) + EPS);
    }
}
template <int MODE>
__global__ void __launch_bounds__(256) gather_kernel(const void* __restrict__ Utab, const void* __restrict__ Vtab, const float* __restrict__ gffn, const int* __restrict__ seli, const float* __restrict__ selg,
                                                     const float* __restrict__ part2, float* __restrict__ H, bf16* __restrict__ h2b, float* __restrict__ rstd3) {
    const int lane = threadIdx.x & 63; const int w = blockIdx.x * 4 + (threadIdx.x >> 6); const int nw = gridDim.x * 4;
    for (int t = w; t < T_; t += nw) gather_token<MODE>(t, lane, Utab, Vtab, gffn, seli, selg, part2, H, h2b, rstd3);
}
namespace pg8 {
#define PG8_LAS __attribute__((address_space(3)))
typedef unsigned short bf16_t;
typedef short bf16x8 __attribute__((ext_vector_type(8)));
typedef float f32x4 __attribute__((ext_vector_type(4)));
typedef unsigned u32x4 __attribute__((ext_vector_type(4)));
constexpr int BM = 256, BK = 64, HALF = 128, HTB = HALF * BK * 2  , STAGE_BYTES = 8 * HTB, NXCD = 8, WGM = 8;

__host__ __device__ __forceinline__ int lds_byte(int r, int c) { const int st = (r >> 4) * 2 + (c >> 5), rr = r & 15, cc = c & 31, ob = rr * 64 + cc * 2; return st * 1024 + (ob ^ (((ob >> 9) & 1) << 5)); }
__host__ __device__ __forceinline__ void stage_rc(int b, int& R, int& C) { const int st = b / 1024, sb = b % 1024, swz = sb ^ (((sb >> 9) & 1) << 5); R = (st >> 1) * 16 + swz / 64; C = (st & 1) * 32 + (swz % 64) / 2; }
__host__ __device__ __forceinline__ int perm32(int rho) { const int n = rho >> 4, i = rho & 15; return 8 * (i >> 2) + 4 * n + (i & 3); }

struct Unit { int pm, pn; };
struct Gemm { const bf16_t* A; const bf16_t* Bt; int K, lda, apn_shift, apn_stride; };

struct StaticOrder {
    int nM, nN, nwg, G, c;
    __host__ __device__ void init(int M, int N, int G_, int c_) { nM = M / BM; nN = N / BM; nwg = nM * nN; G = G_; c = c_; }
    __host__ __device__ bool next(int i, Unit& u) const {
        const long L = (long)i * G + c; if (L >= nwg) return false;
        int wgid = (int)L; { const int q = nwg / NXCD, r = nwg % NXCD, xcd = wgid % NXCD, off = wgid / NXCD; wgid = (xcd < r ? xcd * (q + 1) : r * (q + 1) + (xcd - r) * q) + off; }
        const int nig = WGM * nN, gid = wgid / nig, fm = gid * WGM, gsz = (nM - fm) < WGM ? (nM - fm) : WGM;
        u.pm = fm + ((wgid % nig) % gsz); u.pn = (wgid % nig) / gsz; return true;
    }
    __device__ __forceinline__ void a_ready(const Unit&) const {}
    __device__ __forceinline__ void done(const Unit&) const {}
};

__device__ __forceinline__ unsigned cvt_pk_bf16(float lo, float hi) { unsigned r; asm volatile("v_cvt_pk_bf16_f32 %0, %1, %2" : "=v"(r) : "v"(lo), "v"(hi)); return r; }

template <class Epi, class Sched, bool ALIGN_EPI = false, bool SP2 = false>
__device__ __forceinline__ void gemm_phase(PG8_LAS unsigned char* lds, const Gemm g, const Sched& S, const Epi& E, int wave_id  ) {
    const int lane = fresh_lane(), wid = wave_id, tid = wid * 64 + lane, wr = wid >> 2, wc = wid & 3, fr = lane & 15, fq = lane >> 4;
    const int K = g.K, nt = K / BK;
    unsigned voffA[2], voffB[2];
#pragma unroll
    for (int i = 0; i < 2; ++i) { int R, C; stage_rc(tid * 16 + i * 8192, R, C); const int Rb = Epi::PERM ? ((R & ~31) + perm32(R & 31)) : R;
        voffA[i] = (unsigned)(R * g.lda + C) * 2u; voffB[i] = (unsigned)(Rb * K + C) * 2u; }
    const size_t kstep = (size_t)(BK * 2);
    const size_t hstepA = (size_t)HALF * g.lda * 2, hstepB = (size_t)HALF * K * 2;
    const size_t tstepA = 2 * hstepA, tstepB = 2 * hstepB;
    const unsigned ldsw = (unsigned)wid * 1024u;
    const int aoff = lds_byte(wr * 64 + fr, fq * 8), boff = lds_byte(wc * 32 + fr, fq * 8);
#define PG8_SA(b, h) (((b) * 2 + (h)) * HTB)
#define PG8_SB(b, h) ((4 + (b) * 2 + (h)) * HTB)
#define PG8_STAGE(bufoff, gbase, voff) do { _Pragma("unroll") for (int _i = 0; _i < 2; ++_i) \
        __builtin_amdgcn_global_load_lds((const unsigned*)((const char*)(gbase) + (voff)[_i]), (PG8_LAS unsigned*)(lds + (bufoff) + ldsw + _i * 8192), 16, 0, 0); } while (0)
#define PG8_LDA(dst, b, h) do { _Pragma("unroll") for (int m = 0; m < 4; ++m) _Pragma("unroll") for (int k = 0; k < 2; ++k) dst[m][k] = *(const PG8_LAS bf16x8*)(lds + PG8_SA(b, h) + aoff + m * 2048 + k * 1024); } while (0)
#define PG8_LDB(dst, b, h) do { _Pragma("unroll") for (int n = 0; n < 2; ++n) _Pragma("unroll") for (int k = 0; k < 2; ++k) dst[n][k] = *(const PG8_LAS bf16x8*)(lds + PG8_SB(b, h) + boff + n * 2048 + k * 1024); } while (0)
#define PG8_MMA(ai, bj, At, Bt) do { __builtin_amdgcn_s_setprio(1); _Pragma("unroll") for (int m = 0; m < 4; ++m) _Pragma("unroll") for (int n = 0; n < 2; ++n) _Pragma("unroll") for (int k = 0; k < 2; ++k) \
        acc[ai][bj][m][n] = __builtin_amdgcn_mfma_f32_16x16x32_bf16(Bt[n][k], At[m][k], acc[ai][bj][m][n], 0, 0, 0); __builtin_amdgcn_s_setprio(0); } while (0)
#define PG8_WAIT_V(n) asm volatile("s_waitcnt vmcnt(" #n ")" ::: "memory")
#define PG8_WAIT_L(n) asm volatile("s_waitcnt lgkmcnt(" #n ")" ::: "memory")
#define PG8_BAR __builtin_amdgcn_s_barrier()
#define PG8_SCHED __builtin_amdgcn_sched_barrier(0)
    Unit cur, nxt; int ui = 0;
    if (!S.next(0, cur)) return;
    f32x4 acc[2][2][4][2];
#pragma unroll
    for (int a = 0; a < 2; ++a)
#pragma unroll
        for (int b = 0; b < 2; ++b)
#pragma unroll
            for (int m = 0; m < 4; ++m)
#pragma unroll
                for (int n = 0; n < 2; ++n) acc[a][b][m][n] = (f32x4){0.f, 0.f, 0.f, 0.f};
    bf16x8 At[4][2], B0[2][2], B1[2][2];
    const char* cA = (const char*)g.A + (size_t)cur.pm * tstepA + (size_t)((cur.pn >> g.apn_shift) * g.apn_stride) * 2; const char* cB = (const char*)g.Bt + (size_t)cur.pn * tstepB;
    S.a_ready(cur);
    if constexpr (SP2) {
        PG8_STAGE(PG8_SB(0, 0), cB, voffB); PG8_STAGE(PG8_SB(0, 1), cB + hstepB, voffB); PG8_STAGE(PG8_SA(0, 0), cA, voffA); PG8_STAGE(PG8_SA(0, 1), cA + hstepA, voffA);
        if (wr == 1) PG8_BAR;
        PG8_WAIT_V(2); PG8_BAR;
        PG8_STAGE(PG8_SB(1, 0), cB + kstep, voffB); PG8_STAGE(PG8_SA(1, 0), cA + kstep, voffA); PG8_STAGE(PG8_SB(1, 1), cB + hstepB + kstep, voffB);
        PG8_WAIT_V(6); PG8_BAR;
    } else {
        PG8_STAGE(PG8_SB(0, 0), cB, voffB); PG8_STAGE(PG8_SA(0, 0), cA, voffA); PG8_STAGE(PG8_SB(0, 1), cB + hstepB, voffB); PG8_STAGE(PG8_SA(0, 1), cA + hstepA, voffA);
        if (wr == 1) PG8_BAR;
        PG8_WAIT_V(4); PG8_BAR;
        PG8_STAGE(PG8_SB(1, 0), cB + kstep, voffB); PG8_STAGE(PG8_SA(1, 0), cA + kstep, voffA); PG8_STAGE(PG8_SB(1, 1), cB + hstepB + kstep, voffB);
        PG8_WAIT_V(6); PG8_BAR;
    }
    for (;;) {
        const bool has_next = S.next(ui + 1, nxt);
        const char* nA = has_next ? (const char*)g.A + (size_t)nxt.pm * tstepA + (size_t)((nxt.pn >> g.apn_shift) * g.apn_stride) * 2 : cA; const char* nB = has_next ? (const char*)g.Bt + (size_t)nxt.pn * tstepB : cB;
#pragma unroll 1
        for (int t = 0; t < nt; t += 2) {
            const bool last = (t == nt - 2);
            const char* a1 = cA + (size_t)(t + 1) * kstep;
            const char* a2 = last ? nA : cA + (size_t)(t + 2) * kstep; const char* b2 = last ? nB : cB + (size_t)(t + 2) * kstep;
            const char* a3 = a2 + kstep; const char* b3 = b2 + kstep;
            if (last && has_next) S.a_ready(nxt);
            if constexpr (SP2) {
            PG8_LDB(B0, 0, 0); PG8_LDB(B1, 0, 1); PG8_SCHED; PG8_LDA(At, 0, 0); PG8_STAGE(PG8_SA(1, 1), a1 + hstepA, voffA);
            PG8_WAIT_V(8); PG8_WAIT_L(0); PG8_BAR; PG8_MMA(0, 0, At, B0); PG8_MMA(0, 1, At, B1); PG8_BAR; PG8_SCHED;
            PG8_LDA(At, 0, 1); PG8_STAGE(PG8_SB(0, 0), b2, voffB); PG8_STAGE(PG8_SB(0, 1), b2 + hstepB, voffB); PG8_STAGE(PG8_SA(0, 0), a2, voffA);
            PG8_WAIT_V(8); PG8_WAIT_L(0); PG8_BAR; PG8_MMA(1, 0, At, B0); PG8_MMA(1, 1, At, B1); PG8_BAR; PG8_SCHED;
            PG8_LDB(B0, 1, 0); PG8_LDB(B1, 1, 1); PG8_SCHED; PG8_LDA(At, 1, 0); PG8_STAGE(PG8_SA(0, 1), a2 + hstepA, voffA);
            PG8_WAIT_V(8); PG8_WAIT_L(0); PG8_BAR; PG8_MMA(0, 0, At, B0); PG8_MMA(0, 1, At, B1); PG8_BAR; PG8_SCHED;
            PG8_LDA(At, 1, 1); PG8_STAGE(PG8_SB(1, 0), b3, voffB); PG8_STAGE(PG8_SB(1, 1), b3 + hstepB, voffB); PG8_STAGE(PG8_SA(1, 0), a3, voffA);
            PG8_WAIT_V(8); PG8_WAIT_L(0); PG8_BAR; PG8_MMA(1, 0, At, B0); PG8_MMA(1, 1, At, B1); PG8_BAR; PG8_SCHED;
            } else {
            PG8_LDB(B0, 0, 0); PG8_SCHED; PG8_LDA(At, 0, 0); PG8_STAGE(PG8_SA(1, 1), a1 + hstepA, voffA);
            PG8_WAIT_L(8); PG8_BAR; PG8_WAIT_L(0); PG8_MMA(0, 0, At, B0); PG8_BAR; PG8_SCHED;
            PG8_LDB(B1, 0, 1); PG8_STAGE(PG8_SB(0, 0), b2, voffB);
            PG8_BAR; PG8_WAIT_L(0); PG8_MMA(0, 1, At, B1); PG8_BAR;
            PG8_LDA(At, 0, 1); PG8_STAGE(PG8_SA(0, 0), a2, voffA);
            PG8_BAR; PG8_WAIT_L(0); PG8_MMA(1, 0, At, B0); PG8_BAR; PG8_SCHED;
            PG8_STAGE(PG8_SB(0, 1), b2 + hstepB, voffB);
            PG8_WAIT_V(6); PG8_BAR; PG8_MMA(1, 1, At, B1); PG8_BAR;
            PG8_LDB(B0, 1, 0); PG8_SCHED; PG8_LDA(At, 1, 0); PG8_STAGE(PG8_SA(0, 1), a2 + hstepA, voffA);
            PG8_WAIT_L(8); PG8_BAR; PG8_WAIT_L(0); PG8_MMA(0, 0, At, B0); PG8_BAR; PG8_SCHED;
            PG8_LDB(B1, 1, 1); PG8_STAGE(PG8_SB(1, 0), b3, voffB);
            PG8_BAR; PG8_WAIT_L(0); PG8_MMA(0, 1, At, B1); PG8_BAR;
            PG8_LDA(At, 1, 1); PG8_STAGE(PG8_SA(1, 0), a3, voffA);
            PG8_BAR; PG8_WAIT_L(0); PG8_MMA(1, 0, At, B0); PG8_BAR; PG8_SCHED;
            PG8_STAGE(PG8_SB(1, 1), b3 + hstepB, voffB);
            PG8_WAIT_V(6); PG8_BAR; PG8_MMA(1, 1, At, B1); PG8_BAR;
            }
        }
        if constexpr (ALIGN_EPI) { if (wr == 0) PG8_BAR; }
        if constexpr (!Epi::AFTER_DRAIN) { E(acc, cur, wr, wc, fr, fq); S.done(cur); }
        if (!has_next) break;
#pragma unroll
        for (int a = 0; a < 2; ++a)
#pragma unroll
            for (int b = 0; b < 2; ++b)
#pragma unroll
                for (int m = 0; m < 4; ++m)
#pragma unroll
                    for (int n = 0; n < 2; ++n) acc[a][b][m][n] = (f32x4){0.f, 0.f, 0.f, 0.f};
        cur = nxt; cA = nA; cB = nB; ++ui;
        if constexpr (ALIGN_EPI) { if (wr == 1) PG8_BAR; }
    }
    PG8_WAIT_V(0);
    if constexpr (!ALIGN_EPI) { if (wr == 0) PG8_BAR; }
    PG8_BAR;
    if constexpr (Epi::AFTER_DRAIN) { E.fused(acc, cur, wr, wc, fr, fq, lds, wid, lane); S.done(cur); }
#undef PG8_SA
#undef PG8_SB
#undef PG8_STAGE
#undef PG8_LDA
#undef PG8_LDB
#undef PG8_MMA
#undef PG8_WAIT_V
#undef PG8_WAIT_L
#undef PG8_BAR
#undef PG8_SCHED
}
}
#define GAS __attribute__((address_space(1)))
typedef GAS unsigned gu32;
#define RLX_AGENT __ATOMIC_RELAXED, __HIP_MEMORY_SCOPE_AGENT
#define LDS_WAIT() asm volatile("s_waitcnt lgkmcnt(0)" ::: "memory")
#define VM_WAIT() asm volatile("s_waitcnt vmcnt(0)" ::: "memory")
#define XB_TMO      128
#define XB_XCNT(j)  (256  + 64 * (j))
#define XB_XSUB(j)  (1280 + 64 * (j))
#define XB_XGEN(j)  (2304 + 64 * (j))
#define XB_TOP      3328
#define XB_TOPGEN   3392
#define XCD_BAR_WORDS 3456
#define XB_SPIN_CAP (1u << 18)

__device__ __forceinline__ unsigned xb_ld(unsigned* p)              { return __hip_atomic_load(p, __ATOMIC_RELAXED, __HIP_MEMORY_SCOPE_AGENT); }
__device__ __forceinline__ unsigned xb_add(unsigned* p, unsigned v) { return __hip_atomic_fetch_add(p, v, __ATOMIC_RELAXED, __HIP_MEMORY_SCOPE_AGENT); }
__device__ __forceinline__ unsigned xb_xcc_id() { return (unsigned)__builtin_amdgcn_s_getreg((3 << 11) | 20) & 0xFu; }
#define XB_SPIN(cond, bar) do { unsigned _sp = 0; while (cond) { __builtin_amdgcn_s_sleep(1); \
    if ((++_sp & 255u) == 0u) { if (xb_ld(&(bar)[XB_TMO])) break; if (_sp > XB_SPIN_CAP) { atomicAdd(&(bar)[XB_TMO], 1u); break; } } } } while (0)

struct XcdBarrier {
    unsigned* bar; unsigned x;
    volatile LAS unsigned* st;
};

__device__ __forceinline__ XcdBarrier xcd_barrier_post(unsigned* bar, volatile LAS unsigned* st) {
    XcdBarrier b; b.bar = bar; b.x = xb_xcc_id(); b.st = st;
    if (threadIdx.x == 0) (void)xb_add(&bar[XB_XCNT(b.x)], 1u);
    return b;
}
__device__ __forceinline__ void xcd_barrier_complete(unsigned* bar, unsigned x, unsigned& nloc, unsigned& nx) {
    const unsigned G = gridDim.x * gridDim.y * gridDim.z;
    unsigned sum, cnt, mine, sp = 0u;
    for (;;) {
        sum = 0u; cnt = 0u; mine = 0u;
#pragma unroll
        for (unsigned j = 0; j < 16; ++j) { const unsigned c = xb_ld(&bar[XB_XCNT(j)]); sum += c; cnt += (c > 0u) ? 1u : 0u; mine = (j == x) ? c : mine; }
        if (sum == G) break;
        __builtin_amdgcn_s_sleep(1);
        if ((++sp & 255u) == 0u) { if (xb_ld(&bar[XB_TMO])) break; if (sp > XB_SPIN_CAP) { atomicAdd(&bar[XB_TMO], 1u); break; } }
    }
    nloc = mine > 0u ? mine : 1u; nx = cnt > 0u ? cnt : 1u;
}

__device__ __forceinline__ void xcd_barrier(const XcdBarrier& b) {
    asm volatile("s_waitcnt vmcnt(0)" ::: "memory");
    __syncthreads();
    if (threadIdx.x == 0) {
        unsigned* bar = b.bar;
        __builtin_amdgcn_s_waitcnt(0);
        unsigned nloc = b.st[0], nx = b.st[1];
        if (nloc == 0u) { xcd_barrier_complete(bar, b.x, nloc, nx); b.st[0] = nloc; b.st[1] = nx; }
        const unsigned old = xb_add(&bar[XB_XSUB(b.x)], 1u);
        const unsigned gen = old / nloc;
        if (old + 1u == (gen + 1u) * nloc) {
            __builtin_amdgcn_fence(__ATOMIC_RELEASE, "agent");
            asm volatile("s_waitcnt vmcnt(0)" ::: "memory");
            const unsigned og = xb_add(&bar[XB_TOP], 1u);
            const unsigned tg = og / nx;
            if (og + 1u == (tg + 1u) * nx) xb_add(&bar[XB_TOPGEN], 1u);
            else XB_SPIN(xb_ld(&bar[XB_TOPGEN]) == tg, bar);
            __builtin_amdgcn_fence(__ATOMIC_ACQUIRE, "agent");
            xb_add(&bar[XB_XGEN(b.x)], 1u);
            asm volatile("s_waitcnt vmcnt(0)" ::: "memory");
        } else {
            XB_SPIN(xb_ld(&bar[XB_XGEN(b.x)]) == gen, bar);
            __builtin_amdgcn_fence(__ATOMIC_ACQUIRE, "agent");
            asm volatile("s_waitcnt vmcnt(0)" ::: "memory");
        }
    }
    __syncthreads();
}

constexpr int NWAVES = 8;
constexpr int LDS_MAIN = 135168;
constexpr int LDSCTL_OFF = LDS_MAIN;
constexpr int LDS_BYTES = 147456;
constexpr int CW_BAR = 4096;
constexpr size_t CTL_ZERO_BYTES = 1 * MiB;
constexpr float LOG2E = 1.4426950408889634f;
typedef short bf16x8 __attribute__((ext_vector_type(8)));
typedef float f32x16 __attribute__((ext_vector_type(16)));
typedef unsigned u32x2 __attribute__((ext_vector_type(2)));
using pg8::Unit;
using pg8::cvt_pk_bf16;

__device__ __forceinline__ f32x4 sig4(f32x4 v) { return (f32x4){sigmoidf_(v[0]), sigmoidf_(v[1]), sigmoidf_(v[2]), sigmoidf_(v[3])}; }
__device__ __forceinline__ f32x4 gelu4(f32x4 v) { return (f32x4){gelu_tanh(v[0]), gelu_tanh(v[1]), gelu_tanh(v[2]), gelu_tanh(v[3])}; }
__device__ __forceinline__ u32x4 pack8(f32x4 a, f32x4 b) { u32x4 w; w.x = cvt_pk_bf16(a[0], a[1]); w.y = cvt_pk_bf16(a[2], a[3]); w.z = cvt_pk_bf16(b[0], b[1]); w.w = cvt_pk_bf16(b[2], b[3]); return w; }
__device__ __forceinline__ f32x4 bf4_lo(u32x2 w) { return (f32x4){__builtin_bit_cast(float, w.x << 16), __builtin_bit_cast(float, w.x & 0xffff0000u), __builtin_bit_cast(float, w.y << 16), __builtin_bit_cast(float, w.y & 0xffff0000u)}; }

struct OneUnit { pg8::StaticOrder S; int k;
    __device__ __forceinline__ bool next(int i, Unit& u) const { return i == 0 && S.next(k, u); }
    __device__ __forceinline__ void a_ready(const Unit&) const {}
    __device__ __forceinline__ void done(const Unit&) const {} };
struct EpiProj {
    static constexpr bool PERM = true, AFTER_DRAIN = false;
    const float* rstd; unsigned char* ws;
    __device__ __forceinline__ void operator()(const f32x4 (&acc)[2][2][4][2], const Unit& u, int wr, int wc, int fr, int fq) const {
        { const int t_ = fresh_lane(); fr = t_ & 15; fq = t_ >> 4; }
        const int pn = u.pn; bf16* base; int ldc, coff, act;
        if (pn < 3) { base = (bf16*)(ws + WS_QKV); ldc = 768; coff = pn * 256; act = 0; }
        else if (pn < 7) { base = (bf16*)(ws + WS_LX); ldc = 1024; coff = (pn - 3) * 256; act = 0; }
        else if (pn < 11) { base = (bf16*)(ws + WS_GL); ldc = 1024; coff = (pn - 7) * 256; act = 1; }
        else if (pn < 15) { base = (bf16*)(ws + WS_SGA); ldc = 1024; coff = (pn - 11) * 256; act = 2; }
        else { base = (bf16*)(ws + WS_SGL); ldc = 1024; coff = (pn - 15) * 256; act = 2; }
        const int row0 = u.pm * 256 + wr * 64 + fr, col0 = coff + wc * 32 + 8 * fq;
#pragma unroll
        for (int ai = 0; ai < 2; ++ai)
#pragma unroll
            for (int m = 0; m < 4; ++m) {
                const int r = row0 + ai * 128 + m * 16; const float rs = rstd[r]; bf16* rowp = base + (size_t)r * ldc + col0;
#pragma unroll
                for (int bj = 0; bj < 2; ++bj) {
                    f32x4 v0 = acc[ai][bj][m][0] * rs, v1 = acc[ai][bj][m][1] * rs;
                    if (act == 1) { v0 = gelu4(v0); v1 = gelu4(v1); } else if (act == 2) { v0 = sig4(v0); v1 = sig4(v1); }
                    *(u32x4*)(rowp + bj * 128) = pack8(v0, v1);
                }
            }
    }
};
struct EpiMP {
    static constexpr bool PERM = false, AFTER_DRAIN = false;
    const bf16* sga; float* mp;
    __device__ __forceinline__ void operator()(const f32x4 (&acc)[2][2][4][2], const Unit& u, int wr, int wc, int fr, int fq) const {
        { const int t_ = fresh_lane(); fr = t_ & 15; fq = t_ >> 4; }
        const int row0 = u.pm * 256 + wr * 64 + fr, col0 = u.pn * 256 + wc * 32 + 4 * fq;
#pragma unroll
        for (int ai = 0; ai < 2; ++ai)
#pragma unroll
            for (int m = 0; m < 4; ++m) {
                const size_t off = (size_t)(row0 + ai * 128 + m * 16) * 1024 + col0;
#pragma unroll
                for (int bj = 0; bj < 2; ++bj)
#pragma unroll
                    for (int n = 0; n < 2; ++n) { const size_t o = off + bj * 128 + n * 16; const f32x4 g = bf4_lo(*(const u32x2*)(sga + o)); *(f32x4*)(mp + o) = acc[ai][bj][m][n] * g; }
            }
    }
};
struct EpiMerged {
    static constexpr bool PERM = true, AFTER_DRAIN = false;
    const bf16* sgl; const float* mp; bf16* merged;
    __device__ __forceinline__ void operator()(const f32x4 (&acc)[2][2][4][2], const Unit& u, int wr, int wc, int fr, int fq) const {
        { const int t_ = fresh_lane(); fr = t_ & 15; fq = t_ >> 4; }
        const int row0 = u.pm * 256 + wr * 64 + fr, col0 = u.pn * 256 + wc * 32 + 8 * fq;
#pragma unroll
        for (int ai = 0; ai < 2; ++ai)
#pragma unroll
            for (int m = 0; m < 4; ++m) {
                const size_t off = (size_t)(row0 + ai * 128 + m * 16) * 1024 + col0;
#pragma unroll
                for (int bj = 0; bj < 2; ++bj) {
                    const size_t o = off + bj * 128; const u32x4 gw = *(const u32x4*)(sgl + o);
                    const f32x4 m0 = *(const f32x4*)(mp + o), m1 = *(const f32x4*)(mp + o + 4);
                    const f32x4 v0 = m0 + acc[ai][bj][m][0] * bf4_lo((u32x2){gw.x, gw.y}), v1 = m1 + acc[ai][bj][m][1] * bf4_lo((u32x2){gw.z, gw.w});
                    *(u32x4*)(merged + o) = pack8(v0, v1);
                }
            }
    }
};
struct EpiH1 {
    static constexpr bool PERM = true, AFTER_DRAIN = false;
    const float* x; float* h1; bf16* h1b; float* part;
    __device__ __forceinline__ void operator()(const f32x4 (&acc)[2][2][4][2], const Unit& u, int wr, int wc, int fr, int fq) const {
        { const int t_ = fresh_lane(); fr = t_ & 15; fq = t_ >> 4; }
        const int row0 = u.pm * 256 + wr * 64 + fr, col0 = u.pn * 256 + wc * 32 + 8 * fq;
#pragma unroll
        for (int ai = 0; ai < 2; ++ai)
#pragma unroll
            for (int m = 0; m < 4; ++m) {
                const int r = row0 + ai * 128 + m * 16; const size_t off = (size_t)r * 1024 + col0; float sq = 0.f;
#pragma unroll
                for (int bj = 0; bj < 2; ++bj) {
                    const size_t o = off + bj * 128;
                    const f32x4 v0 = *(const f32x4*)(x + o) + acc[ai][bj][m][0], v1 = *(const f32x4*)(x + o + 4) + acc[ai][bj][m][1];
                    *(f32x4*)(h1 + o) = v0; *(f32x4*)(h1 + o + 4) = v1; *(u32x4*)(h1b + o) = pack8(v0, v1);
                    sq += (v0[0] * v0[0] + v0[1] * v0[1]) + (v0[2] * v0[2] + v0[3] * v0[3]) + (v1[0] * v1[0] + v1[1] * v1[1]) + (v1[2] * v1[2] + v1[3] * v1[3]);
                }
                sq += __shfl_xor(sq, 16); sq += __shfl_xor(sq, 32);
                if (fq == 0) part[(size_t)r * 16 + u.pn * 4 + wc] = sq;
            }
    }
};
struct EpiScore {
    static constexpr bool PERM = false, AFTER_DRAIN = false;
    const float* part; float* sc;
    __device__ __forceinline__ void operator()(const f32x4 (&acc)[2][2][4][2], const Unit& u, int wr, int wc, int fr, int fq) const {
        { const int t_ = fresh_lane(); fr = t_ & 15; fq = t_ >> 4; }
        const int row0 = u.pm * 256 + wr * 64 + fr, col0 = u.pn * 256 + wc * 32 + 4 * fq;
#pragma unroll
        for (int ai = 0; ai < 2; ++ai)
#pragma unroll
            for (int m = 0; m < 4; ++m) {
                const int r = row0 + ai * 128 + m * 16; const f32x4* pp = (const f32x4*)(part + (size_t)r * 16);
                const f32x4 s4 = (pp[0] + pp[1]) + (pp[2] + pp[3]); const float rs = 1.0f / sqrtf(((s4[0] + s4[1]) + (s4[2] + s4[3])) * (1.0f / 1024.0f) + EPS);
                const size_t off = (size_t)r * 1024 + col0;
#pragma unroll
                for (int bj = 0; bj < 2; ++bj)
#pragma unroll
                    for (int n = 0; n < 2; ++n) *(f32x4*)(sc + off + bj * 128 + n * 16) = acc[ai][bj][m][n] * rs;
            }
    }
};
struct EpiPP {
    static constexpr bool PERM = true, AFTER_DRAIN = false;
    bf16* pp;
    __device__ __forceinline__ void operator()(const f32x4 (&acc)[2][2][4][2], const Unit& u, int wr, int wc, int fr, int fq) const {
        { const int t_ = fresh_lane(); fr = t_ & 15; fq = t_ >> 4; }
        const int row0 = u.pm * 256 + wr * 64 + fr, col0 = u.pn * 256 + wc * 32 + 8 * fq;
#pragma unroll
        for (int ai = 0; ai < 2; ++ai)
#pragma unroll
            for (int m = 0; m < 4; ++m) {
                const size_t off = (size_t)(row0 + ai * 128 + m * 16) * 1024 + col0;
#pragma unroll
                for (int bj = 0; bj < 2; ++bj) *(u32x4*)(pp + off + bj * 128) = pack8(acc[ai][bj][m][0], acc[ai][bj][m][1]);
            }
    }
};
struct EpiH3 {
    static constexpr bool PERM = true, AFTER_DRAIN = false;
    const float* rstd3; const bf16* pp; float* h; float* part;
    __device__ __forceinline__ void operator()(const f32x4 (&acc)[2][2][4][2], const Unit& u, int wr, int wc, int fr, int fq) const {
        { const int t_ = fresh_lane(); fr = t_ & 15; fq = t_ >> 4; }
        const int row0 = u.pm * 256 + wr * 64 + fr, col0 = u.pn * 256 + wc * 32 + 8 * fq;
#pragma unroll
        for (int ai = 0; ai < 2; ++ai)
#pragma unroll
            for (int m = 0; m < 4; ++m) {
                const int r = row0 + ai * 128 + m * 16; const size_t off = (size_t)r * 1024 + col0; const float rs = rstd3[r]; float sq = 0.f;
#pragma unroll
                for (int bj = 0; bj < 2; ++bj) {
                    const size_t o = off + bj * 128; const u32x4 pw = *(const u32x4*)(pp + o);
                    const f32x4 v0 = *(const f32x4*)(h + o) + sig4(acc[ai][bj][m][0] * rs) * bf4_lo((u32x2){pw.x, pw.y});
                    const f32x4 v1 = *(const f32x4*)(h + o + 4) + sig4(acc[ai][bj][m][1] * rs) * bf4_lo((u32x2){pw.z, pw.w});
                    *(f32x4*)(h + o) = v0; *(f32x4*)(h + o + 4) = v1;
                    sq += (v0[0] * v0[0] + v0[1] * v0[1]) + (v0[2] * v0[2] + v0[3] * v0[3]) + (v1[0] * v1[0] + v1[1] * v1[1]) + (v1[2] * v1[2] + v1[3] * v1[3]);
                }
                sq += __shfl_xor(sq, 16); sq += __shfl_xor(sq, 32);
                if (fq == 0) part[(size_t)r * 16 + u.pn * 4 + wc] = sq;
            }
    }
};
struct EpiPre {
    static constexpr bool PERM = false, AFTER_DRAIN = false;
    float* rp; float* ip;
    __device__ __forceinline__ void operator()(const f32x4 (&acc)[2][2][4][2], const Unit& u, int wr, int wc, int fr, int fq) const {
        { const int t_ = fresh_lane(); fr = t_ & 15; fq = t_ >> 4; }
#pragma unroll
        for (int n = 0; n < 2; ++n) { const int ch = u.pn * 128 + wc * 32 + 16 * n + 4 * fq;
#pragma unroll
            for (int ai = 0; ai < 2; ++ai)
#pragma unroll
                for (int m = 0; m < 4; ++m) { const int r = u.pm * 256 + ai * 128 + wr * 64 + m * 16 + fr; const size_t o = (size_t)r * 1024 + ch; *(f32x4*)(rp + o) = acc[ai][0][m][n]; *(f32x4*)(ip + o) = acc[ai][1][m][n]; } }
    }
};
template <int CTRL> __device__ __forceinline__ float dpp_f(float oldv, float src) {
    return __builtin_bit_cast(float, __builtin_amdgcn_update_dpp(__builtin_bit_cast(int, oldv), __builtin_bit_cast(int, src), CTRL, 0xf, 0xf, false));
}
#ifndef LRU_T2
#define LRU_T2 0
#endif
struct EpiLru {
    static constexpr bool PERM = false, AFTER_DRAIN = false;
    const bf16* lin; const float* ba; const float* bx; const float* c8l; bf16* hloc; bf16* pcum; float* agg;
    template <int SH> static __device__ __forceinline__ void step(f32x4& A, f32x4& Bv) {
#pragma unroll
        for (int j = 0; j < 4; ++j) { const float ap = dpp_f<0x110 + SH>(1.0f, A[j]), bp = dpp_f<0x110 + SH>(0.0f, Bv[j]); Bv[j] = fmaf(A[j], bp, Bv[j]); A[j] = A[j] * ap; }
    }
    __device__ __forceinline__ void operator()(f32x4 (&acc)[2][2][4][2], const Unit& u, int wr, int wc, int fr, int fq) const {
        { const int t_ = fresh_lane(); fr = t_ & 15; fq = t_ >> 4; }
        const int lane = fq * 16 + fr;
#pragma unroll
        for (int n = 0; n < 2; ++n) {
            const int ch = u.pn * 128 + wc * 32 + 16 * n + 4 * fq;
            const f32x4 bav = *(const f32x4*)(ba + ch), bxv = *(const f32x4*)(bx + ch), cv = *(const f32x4*)(c8l + ch);
#pragma unroll
            for (int ai = 0; ai < 2; ++ai)
#pragma unroll
                for (int m = 0; m < 4; ++m) {
                    const int r = u.pm * 256 + ai * 128 + wr * 64 + m * 16 + fr; const unsigned o = (unsigned)r * 1024u + (unsigned)ch;
                    const f32x4 lv = bf4_lo(*(const u32x2*)(lin + o));
#pragma unroll
                    for (int j = 0; j < 4; ++j) {
                        const float rr = sigmoidf_(acc[ai][0][m][n][j] + bav[j]), ii = sigmoidf_(acc[ai][1][m][n][j] + bxv[j]);
                        const float a = __builtin_amdgcn_exp2f(cv[j] * rr);
                        acc[ai][0][m][n][j] = a; acc[ai][1][m][n][j] = __builtin_amdgcn_sqrtf(fmaxf(1.0f - a * a, 0.f)) * (ii * lv[j]);
                    }
                    asm volatile("" : "+v"(acc[ai][0][m][n]), "+v"(acc[ai][1][m][n]));
                }
        }
#if defined(LRU_DEBUG) && LRU_DEBUG == 1
        {
            float* af = (float*)hloc; float* bf = (float*)pcum;
#pragma unroll
            for (int n = 0; n < 2; ++n) { const int ch = u.pn * 128 + wc * 32 + 16 * n + 4 * fq;
#pragma unroll
                for (int ai = 0; ai < 2; ++ai)
#pragma unroll
                    for (int m = 0; m < 4; ++m) { const int r = u.pm * 256 + ai * 128 + wr * 64 + m * 16 + fr; const size_t o = (size_t)r * 1024 + ch; *(f32x4*)(af + o) = acc[ai][0][m][n]; *(f32x4*)(bf + o) = acc[ai][1][m][n]; } }
            return;
        }
#endif
#pragma unroll
        for (int ai = 0; ai < 2; ++ai)
#pragma unroll
            for (int m = 0; m < 4; ++m)
#pragma unroll
                for (int n = 0; n < 2; ++n) { step<1>(acc[ai][0][m][n], acc[ai][1][m][n]); step<2>(acc[ai][0][m][n], acc[ai][1][m][n]); step<4>(acc[ai][0][m][n], acc[ai][1][m][n]); step<8>(acc[ai][0][m][n], acc[ai][1][m][n]); }
        { const int t_ = fresh_lane(); fr = t_ & 15; fq = t_ >> 4; }
        const int src4 = (((fq * 16 + fr) & 48) | 15) * 4;
#pragma unroll
        for (int n = 0; n < 2; ++n) {
            const int ch = u.pn * 128 + wc * 32 + 16 * n + 4 * fq;
#pragma unroll
            for (int ai = 0; ai < 2; ++ai) {
#pragma unroll
                for (int m = 0; m < 4; ++m) {
                    f32x4& A = acc[ai][0][m][n]; f32x4& Bv = acc[ai][1][m][n];
                    if (m > 0 && !(LRU_T2)) {
#pragma unroll
                        for (int j = 0; j < 4; ++j) { const float pa = acc[ai][0][m - 1][n][j], pb = acc[ai][1][m - 1][n][j];
                            const float ac = __int_as_float(__builtin_amdgcn_ds_bpermute(src4, __float_as_int(pa))), bc = __int_as_float(__builtin_amdgcn_ds_bpermute(src4, __float_as_int(pb))); Bv[j] = fmaf(A[j], bc, Bv[j]); A[j] = A[j] * ac; }
                    }
                    const int r = u.pm * 256 + ai * 128 + wr * 64 + m * 16 + fr; const unsigned o = (unsigned)r * 1024u + (unsigned)ch;
                    u32x2 wp, wh; wp.x = cvt_pk_bf16(A[0], A[1]); wp.y = cvt_pk_bf16(A[2], A[3]); wh.x = cvt_pk_bf16(Bv[0], Bv[1]); wh.y = cvt_pk_bf16(Bv[2], Bv[3]);
                    *(u32x2*)(pcum + o) = wp; *(u32x2*)(hloc + o) = wh;
                    if (m == 3 && fr == 15) {
                        const int chunk = u.pm * 4 + ai * 2 + wr; float* ap = agg + ((size_t)chunk * 1024 + ch) * 2;
                        *(f32x4*)(ap) = (f32x4){A[0], Bv[0], A[1], Bv[1]}; *(f32x4*)(ap + 4) = (f32x4){A[2], Bv[2], A[3], Bv[3]};
                    }
                    __builtin_amdgcn_sched_barrier(0);
                }
            }
        }
    }
};

__device__ __forceinline__ void p0_transpose_item(const float* W, int ldw, const float* gain, bf16* WT, int ldt, int k_off, LAS float* scr, int kb, int nb, int lane) {
    const int k0 = 64 * kb, n0 = 32 * nb;
#pragma unroll 8
    for (int i = 0; i < 32; ++i) { const int kk = 2 * i + (lane >> 5); float v = W[(size_t)(k0 + kk) * ldw + n0 + (lane & 31)]; if (gain) v *= gain[k0 + kk]; scr[kk * 33 + (lane & 31)] = v; }
    LDS_WAIT(); asm volatile("" ::: "memory");
    const int c = lane & 7;
#pragma unroll
    for (int j = 0; j < 4; ++j) { const int n = (lane >> 3) + 8 * j; const LAS float* s = scr + (8 * c) * 33 + n;
        u32x4 o; o.x = pk2(s[0 * 33], s[1 * 33]); o.y = pk2(s[2 * 33], s[3 * 33]); o.z = pk2(s[4 * 33], s[5 * 33]); o.w = pk2(s[6 * 33], s[7 * 33]);
        *(u32x4*)(WT + (size_t)(n0 + n) * ldt + k_off + k0 + 8 * c) = o; }
    LDS_WAIT(); asm volatile("" ::: "memory");
}
__device__ __forceinline__ void p0_wfold_item(LAS float* lds, const float* wq, const float* k1, const float* k2, const float* gffn, bf16* wfold, int item, int tid) {
    const int hh = item >> 4, kb = item & 15;
    LAS float* wqs = lds; LAS float* kks = lds + 64 * 129;
    const float* ksrc = (hh & 1) ? k2 : k1;
    for (int i = tid; i < 64 * 128; i += 512) { const int r = i >> 7, c = i & 127; wqs[r * 129 + c] = wq[(size_t)(kb * 64 + r) * 2048 + hh * 128 + c]; }
    for (int i = tid; i < 128 * 128; i += 512) { const int r = i >> 7, c = i & 127; kks[r * 129 + c] = ksrc[i]; }
    __syncthreads();
    const int tk = tid & 15, tkey = tid >> 4;
    float acc[4][4];
#pragma unroll
    for (int i = 0; i < 4; ++i)
#pragma unroll
        for (int j = 0; j < 4; ++j) acc[i][j] = 0.f;
    for (int c = 0; c < 128; ++c) {
        float a[4], b[4];
#pragma unroll
        for (int i = 0; i < 4; ++i) { a[i] = wqs[(tk * 4 + i) * 129 + c]; b[i] = kks[(tkey * 4 + i) * 129 + c]; }
#pragma unroll
        for (int i = 0; i < 4; ++i)
#pragma unroll
            for (int j = 0; j < 4; ++j) acc[i][j] = fmaf(a[i], b[j], acc[i][j]);
    }
    const int kg = kb * 64 + tk * 4; const f32x4 gv = *(const f32x4*)(gffn + kg);
#pragma unroll
    for (int j = 0; j < 4; ++j) { u32x2 w; w.x = pk2(acc[0][j] * gv[0], acc[1][j] * gv[1]); w.y = pk2(acc[2][j] * gv[2], acc[3][j] * gv[3]);
        *(u32x2*)(wfold + (size_t)(hh * 128 + tkey * 4 + j) * 1024 + kg) = w; }
    __syncthreads();
}

struct In { const float* p[25]; };
enum { I_X = 0, I_P, I_GMIX, I_WIN, I_SINK, I_CONVW, I_CONVB, I_WA, I_BA, I_WX, I_BX, I_LAM, I_WUA, I_WUL, I_WO, I_GFFN, I_WQ, I_K1, I_K2, I_U, I_V, I_GPLE, I_WGATE, I_WPROJ, I_FG };

__device__ __forceinline__ void p0_prologue(const In& in, unsigned char* ws, LAS unsigned char* lds, int vcu, int G, int wave, int tid) {
    const int lane = tid & 63;
    LAS float* scr = (LAS float*)(lds + wave * 16384);
    const int gw = vcu * NWAVES + wave, NGW = G * NWAVES;
    constexpr int I_IN = 16 * 152, I_UA = 8 * 32, I_SQ = 16 * 32, I_PJ = 4 * 32, I_AX = 128;
    constexpr int NITEMS = I_IN + I_UA + 3 * I_SQ + I_PJ + I_AX;
    for (int it = gw; it < NITEMS; it += NGW) {
        int r = it;
        if (r < I_IN) { p0_transpose_item(in.p[I_WIN], INW, in.p[I_GMIX], (bf16*)(ws + WS_WIN), 1024, 0, scr, r / 152, r % 152, lane); continue; } r -= I_IN;
        if (r < I_UA) { p0_transpose_item(in.p[I_WUA], 1024, nullptr, (bf16*)(ws + WS_WUA), 512, 0, scr, r / 32, r % 32, lane); continue; } r -= I_UA;
        if (r < I_SQ) { p0_transpose_item(in.p[I_WUL], 1024, nullptr, (bf16*)(ws + WS_WUL), 1024, 0, scr, r / 32, r % 32, lane); continue; } r -= I_SQ;
        if (r < I_SQ) { p0_transpose_item(in.p[I_WO], 1024, nullptr, (bf16*)(ws + WS_WO), 1024, 0, scr, r / 32, r % 32, lane); continue; } r -= I_SQ;
        if (r < I_SQ) { p0_transpose_item(in.p[I_WGATE], 1024, in.p[I_GPLE], (bf16*)(ws + WS_WG), 1024, 0, scr, r / 32, r % 32, lane); continue; } r -= I_SQ;
        if (r < I_PJ) { p0_transpose_item(in.p[I_WPROJ], 1024, nullptr, (bf16*)(ws + WS_WPROJ), 256, 0, scr, r / 32, r % 32, lane); continue; } r -= I_PJ;
        { const int blk = r >> 4, which = (r >> 3) & 1, sub = r & 7;
          p0_transpose_item(in.p[which ? I_WX : I_WA] + (size_t)blk * 16384, 128, nullptr, (bf16*)(ws + WS_WAXD) + (size_t)(blk * 256 + which * 128) * 1024, 1024, blk * 128, scr, sub >> 2, sub & 3, lane); }
    }
    for (int i = vcu * 512 + tid; i < 2048 * 128; i += G * 512) { const int c16 = i & 127, row = i >> 7, blk = row >> 8;
        if ((c16 >> 4) != blk) *(u32x4*)((bf16*)(ws + WS_WAXD) + (size_t)row * 1024 + c16 * 8) = (u32x4){0u, 0u, 0u, 0u}; }
    for (int m = gw; m < T_; m += NGW) {
        const f32x4* xr = (const f32x4*)(in.p[I_X] + (size_t)m * 1024) + lane; f32x4 v[4]; float s = 0.f;
#pragma unroll
        for (int j = 0; j < 4; ++j) { v[j] = xr[64 * j]; s += (v[j][0] * v[j][0] + v[j][1] * v[j][1]) + (v[j][2] * v[j][2] + v[j][3] * v[j][3]); }
        s = wave_sum(s);
        u32x2* o8 = (u32x2*)((bf16*)(ws + WS_R0) + (size_t)m * 1024) + lane;
#pragma unroll
        for (int j = 0; j < 4; ++j) { u32x2 w; w.x = pk2(v[j][0], v[j][1]); w.y = pk2(v[j][2], v[j][3]); o8[64 * j] = w; }
        if (lane == 0) ((float*)(ws + WS_RSTD1))[m] = 1.0f / sqrtf(s * (1.0f / 1024.0f) + EPS);
    }
    for (int m = gw; m < T_; m += NGW) { const f32x4 v = ((const f32x4*)(in.p[I_P] + (size_t)m * 256))[lane]; u32x2 w; w.x = pk2(v[0], v[1]); w.y = pk2(v[2], v[3]); ((u32x2*)((bf16*)(ws + WS_PB) + (size_t)m * 256))[lane] = w; }
    if (vcu == 0) for (int c = tid; c < 1024; c += 512) ((float*)(ws + WS_C8))[c] = -8.0f * log1pf(expf(-in.p[I_LAM][c])) * LOG2E;
    __syncthreads();
    for (int it = vcu; it < 256; it += G) p0_wfold_item((LAS float*)lds, in.p[I_WQ], in.p[I_K1], in.p[I_K2], in.p[I_GFFN], (bf16*)(ws + WS_WFOLD), it, tid);
}

constexpr int AT_KSTR = 72, AT_VSTR = 260, AT_V_OFF = 256 * AT_KSTR * 2;
__device__ __forceinline__ int crow(int r, int hi) { return (r & 3) + 8 * (r >> 2) + 4 * hi; }
__device__ __forceinline__ void attn_item(LAS unsigned char* lds, const bf16* qkv, const float* sink, bf16* att, int item, int wave, int tid) {
    const int lane = tid & 63;
    const int g = item & 1, n = (item >> 1) & 15, b = item >> 5;
    const int t0 = b * S_ + n * 128;
    LAS bf16* Ks = (LAS bf16*)lds; LAS bf16* Vt = (LAS bf16*)(lds + AT_V_OFF);
#pragma unroll
    for (int i = 0; i < 4; ++i) {
        const int idx = tid + i * 512, row = idx >> 3, ch = idx & 7; const int tk = t0 - 128 + row;
        u32x4 kv = (u32x4){0u, 0u, 0u, 0u}, vv = (u32x4){0u, 0u, 0u, 0u};
        if (n > 0 || row >= 128) { const bf16* src = qkv + (size_t)tk * 768 + 512 + g * 64 + ch * 8; kv = *(const u32x4*)src; vv = *(const u32x4*)(src + 128); }
        *(LAS u32x4*)(Ks + row * AT_KSTR + ch * 8) = kv;
#pragma unroll
        for (int c = 0; c < 8; ++c) Vt[(ch * 8 + c) * AT_VSTR + row] = (bf16)(vv[c >> 1] >> (16 * (c & 1)));
    }
    __syncthreads();
    const int hr = wave >> 1, qh = wave & 1, head = g * 4 + hr;
    const float slope2 = exp2f(-(float)(head + 1)) * LOG2E, sink2 = sink[head] * LOG2E;
    const int q = lane & 31, hi = lane >> 5;
#pragma unroll 1
    for (int ps = 0; ps < 2; ++ps) {
        const int i0 = 64 * qh + 32 * ps, kb0 = i0;
        const bf16* qp = qkv + (size_t)(t0 + i0 + q) * 768 + head * 64 + 8 * hi;
        bf16x8 qf[4];
#pragma unroll
        for (int s = 0; s < 4; ++s) qf[s] = *(const bf16x8*)(qp + 16 * s);
        f32x16 oT[2];
#pragma unroll
        for (int dt = 0; dt < 2; ++dt)
#pragma unroll
            for (int r = 0; r < 16; ++r) oT[dt][r] = 0.f;
        float mrun = sink2, l = 0.f;
#pragma unroll 1
        for (int kt = 0; kt < 5; ++kt) {
            const int kbase = kb0 + 32 * kt;
            f32x16 sT;
#pragma unroll
            for (int r = 0; r < 16; ++r) sT[r] = 0.f;
#pragma unroll
            for (int s = 0; s < 4; ++s) { const bf16x8 kf = *(const LAS bf16x8*)(Ks + (kbase + q) * AT_KSTR + 16 * s + 8 * hi); sT = __builtin_amdgcn_mfma_f32_32x32x16_bf16(kf, qf[s], sT, 0, 0, 0); }
            float tm = -1.0e30f;
#pragma unroll
            for (int r = 0; r < 16; ++r) {
                const int kj = kbase + crow(r, hi); const int dist = i0 + q + 128 - kj;
                const bool valid = (dist >= 0) && (dist < 128) && (n > 0 || kj >= 128);
                const float v = valid ? (sT[r] * (0.125f * LOG2E) - slope2 * (float)dist) : -1.0e30f;
                sT[r] = v; tm = fmaxf(tm, v);
            }
            tm = fmaxf(tm, __shfl_xor(tm, 32));
            const float mnew = fmaxf(mrun, tm), alpha = __builtin_amdgcn_exp2f(mrun - mnew);
            mrun = mnew;
            float ls = 0.f;
#pragma unroll
            for (int r = 0; r < 16; ++r) { const float p = __builtin_amdgcn_exp2f(sT[r] - mnew); sT[r] = p; ls += p; }
            l = l * alpha + ls;
#pragma unroll
            for (int dt = 0; dt < 2; ++dt)
#pragma unroll
                for (int r = 0; r < 16; ++r) oT[dt][r] *= alpha;
#pragma unroll
            for (int s = 0; s < 2; ++s) {
                u32x4 pw; pw.x = cvt_pk_bf16(sT[8 * s + 0], sT[8 * s + 1]); pw.y = cvt_pk_bf16(sT[8 * s + 2], sT[8 * s + 3]);
                pw.z = cvt_pk_bf16(sT[8 * s + 4], sT[8 * s + 5]); pw.w = cvt_pk_bf16(sT[8 * s + 6], sT[8 * s + 7]);
                const bf16x8 pf = __builtin_bit_cast(bf16x8, pw);
#pragma unroll
                for (int dt = 0; dt < 2; ++dt) {
                    const LAS bf16* vp = Vt + (32 * dt + q) * AT_VSTR + kbase + 16 * s + 4 * hi;
                    const u32x2 va = *(const LAS u32x2*)vp, vb = *(const LAS u32x2*)(vp + 8);
                    const bf16x8 af = __builtin_bit_cast(bf16x8, (u32x4){va.x, va.y, vb.x, vb.y});
                    oT[dt] = __builtin_amdgcn_mfma_f32_32x32x16_bf16(af, pf, oT[dt], 0, 0, 0);
                }
            }
        }
        l += __shfl_xor(l, 32);
        l += __builtin_amdgcn_exp2f(sink2 - mrun);
        const float inv = 1.0f / l;
        bf16* op = att + (size_t)(t0 + i0 + q) * 512 + head * 64 + 4 * hi;
#pragma unroll
        for (int dt = 0; dt < 2; ++dt)
#pragma unroll
            for (int rg = 0; rg < 4; ++rg) { u32x2 w; w.x = cvt_pk_bf16(oT[dt][4 * rg] * inv, oT[dt][4 * rg + 1] * inv); w.y = cvt_pk_bf16(oT[dt][4 * rg + 2] * inv, oT[dt][4 * rg + 3] * inv);
                *(u32x2*)(op + 32 * dt + 8 * rg) = w; }
    }
    __syncthreads();
}
__device__ __forceinline__ void conv_items(const bf16* lx, const float* cw, const float* cb, bf16* lin, int vcu, int G, int tid) {
    for (int i = vcu * 512 + tid; i < T_ * 128; i += G * 512) {
        const int t = i >> 7, c8 = (i & 127) * 8, ts = t & (S_ - 1);
        f32x4 y0 = *(const f32x4*)(cb + c8), y1 = *(const f32x4*)(cb + c8 + 4);
#pragma unroll
        for (int tap = 0; tap < 4; ++tap) {
            if (ts - 3 + tap >= 0) {
                const u32x4 w = *(const u32x4*)(lx + (size_t)(t - 3 + tap) * 1024 + c8);
                const f32x4 w0 = *(const f32x4*)(cw + tap * 1024 + c8), w1 = *(const f32x4*)(cw + tap * 1024 + c8 + 4);
                y0 += bf4_lo((u32x2){w.x, w.y}) * w0; y1 += bf4_lo((u32x2){w.z, w.w}) * w1;
            }
        }
        *(u32x4*)(lin + (size_t)t * 1024 + c8) = pack8(y0, y1);
    }
}
__device__ __forceinline__ void scan_finish(const bf16* hloc, const bf16* pcum, const float* agg, const bf16* gl, bf16* rec, int vcu, int G, int tid) {
    const int c8 = (tid & 127) * 8, rg = tid >> 7;
    for (int chunk = vcu; chunk < T_ / 64; chunk += G) {
        const int ci = chunk & 31, cb = chunk - ci;
        float carry[8];
#pragma unroll
        for (int j = 0; j < 8; ++j) carry[j] = 0.f;
        for (int cc = 0; cc < ci; ++cc) {
            const f32x4* ap = (const f32x4*)(agg + ((size_t)(cb + cc) * 1024 + c8) * 2);
#pragma unroll
            for (int q = 0; q < 4; ++q) { const f32x4 v = ap[q]; carry[2 * q] = fmaf(v[0], carry[2 * q], v[1]); carry[2 * q + 1] = fmaf(v[2], carry[2 * q + 1], v[3]); }
        }
#pragma unroll 4
        for (int rr = 0; rr < 16; ++rr) {
            const size_t o = (size_t)(chunk * 64 + rg + 4 * rr) * 1024 + c8;
            const u32x4 hw = *(const u32x4*)(hloc + o), pw = *(const u32x4*)(pcum + o), gw = *(const u32x4*)(gl + o);
            const f32x4 h0 = bf4_lo((u32x2){hw.x, hw.y}), h1 = bf4_lo((u32x2){hw.z, hw.w}), p0 = bf4_lo((u32x2){pw.x, pw.y}), p1 = bf4_lo((u32x2){pw.z, pw.w});
            const f32x4 g0 = bf4_lo((u32x2){gw.x, gw.y}), g1 = bf4_lo((u32x2){gw.z, gw.w});
            f32x4 r0, r1;
#pragma unroll
            for (int j = 0; j < 4; ++j) { r0[j] = fmaf(p0[j], carry[j], h0[j]) * g0[j]; r1[j] = fmaf(p1[j], carry[4 + j], h1[j]) * g1[j]; }
            *(u32x4*)(rec + o) = pack8(r0, r1);
        }
    }
}
__device__ __forceinline__ void uv_convert(const float* pu, const float* pv, const float* gffn, bf16* u16, bf16* v16, int gw, int NGW, int lane) {
    f32x4 g[4];
#pragma unroll
    for (int j = 0; j < 4; ++j) g[j] = ((const f32x4*)gffn)[lane + 64 * j];
    for (int e = gw; e < 2 * 16384; e += NGW) {
        const bool isv = e >= 16384; const int row = isv ? e - 16384 : e;
        const f32x4* src = (const f32x4*)((isv ? pv : pu) + (size_t)row * 1024) + lane;
        u32x2* dst = (u32x2*)((isv ? v16 : u16) + (size_t)row * 1024) + lane;
#pragma unroll
        for (int j = 0; j < 4; ++j) { f32x4 v = src[64 * j]; if (!isv) v = v * g[j]; u32x2 w; w.x = pk2(v[0], v[1]); w.y = pk2(v[2], v[3]); dst[64 * j] = w; }
    }
}
__device__ __forceinline__ void final_rows(float* h, const float* part, const float* fg, int gw, int NGW, int lane) {
    f32x4 g[4];
#pragma unroll
    for (int j = 0; j < 4; ++j) g[j] = ((const f32x4*)fg)[lane + 64 * j];
    for (int r = gw; r < T_; r += NGW) {
        float ps = (lane < 16) ? part[(size_t)r * 16 + lane] : 0.f; ps = wave_sum(ps);
        const float rs = 1.0f / sqrtf(ps * (1.0f / 1024.0f) + EPS);
        f32x4* hr = (f32x4*)(h + (size_t)r * 1024) + lane;
#pragma unroll
        for (int j = 0; j < 4; ++j) hr[64 * j] = hr[64 * j] * rs * g[j];
    }
}

constexpr int N_PHASES = 16;
struct Args { const float* in[25]; float* out; unsigned char* ws; int ph_lo, ph_hi, li, pad; };
__global__ void __launch_bounds__(NWAVES * 64, 2) fused_fwd(Args args) {
    extern __shared__ __attribute__((aligned(16))) unsigned char lds_raw[];
    LAS unsigned char* lds = (LAS unsigned char*)lds_raw;
    volatile LAS unsigned* MISC = (volatile LAS unsigned*)(lds + LDSCTL_OFF);
    const int wave = __builtin_amdgcn_readfirstlane((int)threadIdx.x >> 6);
#define FRESH_TID() (wave * 64 + fresh_lane())
#define FRESH_LANE() fresh_lane()
    const int G = gridDim.x; const int bx = blockIdx.x; const int vcu = (G % 8 == 0) ? (bx % 8) * (G / 8) + bx / 8 : bx;
    unsigned char* ws = args.ws; float* out = args.out;
    In in;
#pragma unroll
    for (int i = 0; i < 25; ++i) in.p[i] = args.in[i];
    for (int u = FRESH_TID(); u < (LDS_BYTES - LDSCTL_OFF) / 4; u += NWAVES * 64) ((LAS unsigned*)(lds + LDSCTL_OFF))[u] = 0u;
    __syncthreads();
    XcdBarrier bar = xcd_barrier_post((unsigned*)(ws + WS_CTL) + CW_BAR + args.li * XCD_BAR_WORDS, MISC + 8);
    const int lo = args.ph_lo, hi = args.ph_hi;
    const int gw = vcu * NWAVES + wave, NGW = G * NWAVES;
#ifndef PH_DISABLE
#define PH_DISABLE 0
#endif
#define IN(k) (lo <= (k) && (k) < hi && !((PH_DISABLE >> (k)) & 1))
#define SEAM(k) do { if (IN(k) && IN((k) + 1)) xcd_barrier(bar); } while (0)
#define GEMM_PHASE(EPI, Aptr, Bptr, Kdim, LDA, M_, N_, SH, STR, ...) do { \
        pg8::Gemm g{(const pg8::bf16_t*)(Aptr), (const pg8::bf16_t*)(Bptr), Kdim, LDA, SH, STR}; pg8::StaticOrder S; S.init(M_, N_, G, (int)blockIdx.x); \
        EPI E{__VA_ARGS__}; pg8::gemm_phase<EPI, pg8::StaticOrder, true, true>(lds, g, S, E, wave); } while (0)

    if (IN(0)) { p0_prologue(in, ws, lds, vcu, G, wave, FRESH_TID()); } SEAM(0);
    if (IN(1)) { GEMM_PHASE(EpiProj, ws + WS_R0, ws + WS_WIN, 1024, 1024, T_, INW, 0, 0, (const float*)(ws + WS_RSTD1), ws); } SEAM(1);
    if (IN(2)) {
        for (int it = bx; it < 256; it += G) attn_item(lds, (const bf16*)(ws + WS_QKV), in.p[I_SINK], (bf16*)(ws + WS_ATT), it, wave, FRESH_TID());
        conv_items((const bf16*)(ws + WS_LX), in.p[I_CONVW], in.p[I_CONVB], (bf16*)(ws + WS_R0), vcu, G, FRESH_TID());
    } SEAM(2);
    if (IN(3)) { GEMM_PHASE(EpiLru, ws + WS_R0, ws + WS_WAXD, 1024, 1024, T_, 2048, 0, 0, (const bf16*)(ws + WS_R0), in.p[I_BA], in.p[I_BX], (const float*)(ws + WS_C8), (bf16*)(ws + WS_HLOC), (bf16*)(ws + WS_PCUM), (float*)(ws + WS_AGG)); }
    SEAM(3);
    if (IN(4)) { scan_finish((const bf16*)(ws + WS_HLOC), (const bf16*)(ws + WS_PCUM), (const float*)(ws + WS_AGG), (const bf16*)(ws + WS_GL), (bf16*)(ws + WS_R0), vcu, G, FRESH_TID()); } SEAM(4);
    if (IN(5)) { GEMM_PHASE(EpiMP, ws + WS_ATT, ws + WS_WUA, 512, 512, T_, 1024, 0, 0, (const bf16*)(ws + WS_SGA), (float*)(ws + WS_MP)); } SEAM(5);
    if (IN(6)) { GEMM_PHASE(EpiMerged, ws + WS_R0, ws + WS_WUL, 1024, 1024, T_, 1024, 0, 0, (const bf16*)(ws + WS_SGL), (const float*)(ws + WS_MP), (bf16*)(ws + WS_MERGED)); } SEAM(6);
    if (IN(7)) { GEMM_PHASE(EpiH1, ws + WS_MERGED, ws + WS_WO, 1024, 1024, T_, 1024, 0, 0, in.p[I_X], out, (bf16*)(ws + WS_R0), (float*)(ws + WS_PART2)); } SEAM(7);
#pragma unroll 1
    for (int half = 0; half < 2; ++half) {
        const int pg = 8 + 2 * half;
        if (IN(pg)) { GEMM_PHASE(EpiScore, ws + WS_R0, ws + WS_WFOLD + (size_t)half * 1024 * 1024 * 2, 1024, 1024, T_, 1024, 0, 0, (const float*)(ws + WS_PART2), (float*)(ws + WS_SC)); } SEAM(pg);
        if (IN(pg + 1)) {
            for (int it = vcu; it < T_ / TK_TOK; it += G) topk_item((LAS float*)lds, (const float*)(ws + WS_SC), it, half * 4, (int*)(ws + WS_SELI), (float*)(ws + WS_SELG), FRESH_TID());
            if (half == 0) uv_convert(in.p[I_U], in.p[I_V], in.p[I_GFFN], (bf16*)(ws + WS_U16), (bf16*)(ws + WS_V16), gw, NGW, FRESH_LANE());
        } SEAM(pg + 1);
    }
    if (IN(12)) {
        const int ln = FRESH_LANE();
        for (int t = gw; t < T_; t += NGW) gather_token<1>(t, ln, ws + WS_U16, ws + WS_V16, nullptr, (const int*)(ws + WS_SELI), (const float*)(ws + WS_SELG), (const float*)(ws + WS_PART2), out, (bf16*)(ws + WS_H2B), (float*)(ws + WS_RSTD3));
    } SEAM(12);
    if (IN(13)) { GEMM_PHASE(EpiPP, ws + WS_PB, ws + WS_WPROJ, 256, 256, T_, 1024, 0, 0, (bf16*)(ws + WS_PP)); } SEAM(13);
    if (IN(14)) { GEMM_PHASE(EpiH3, ws + WS_H2B, ws + WS_WG, 1024, 1024, T_, 1024, 0, 0, (const float*)(ws + WS_RSTD3), (const bf16*)(ws + WS_PP), out, (float*)(ws + WS_PART4)); } SEAM(14);
    if (IN(15)) { final_rows(out, (const float*)(ws + WS_PART4), in.p[I_FG], gw, NGW, FRESH_LANE()); }
#undef IN
#undef SEAM
#undef GEMM_PHASE
}
#ifndef FUSED_MASK
#define FUSED_MASK 0x7ff
#endif
#ifndef MERGE_LAUNCHES
#define MERGE_LAUNCHES 1
#endif
static const int GRP_LO[11] = {0, 2, 3, 5, 6, 7, 8, 12, 13, 14, 15};
static const int GRP_HI[11] = {2, 3, 5, 6, 7, 8, 12, 13, 14, 15, 16};

static void naive_group(int grp, void* const* d_in, float* out, unsigned char* ws, hipStream_t st) {
    const float* x = (const float*)d_in[0]; const float* p = (const float*)d_in[1]; const float* g_mix = (const float*)d_in[2]; const float* w_in = (const float*)d_in[3];
    const float* sink = (const float*)d_in[4]; const float* conv_w = (const float*)d_in[5]; const float* conv_b = (const float*)d_in[6];
    const float* wa = (const float*)d_in[7]; const float* ba = (const float*)d_in[8]; const float* wx = (const float*)d_in[9]; const float* bx = (const float*)d_in[10]; const float* lam = (const float*)d_in[11];
    const float* w_ua = (const float*)d_in[12]; const float* w_ul = (const float*)d_in[13]; const float* w_o = (const float*)d_in[14]; const float* g_ffn = (const float*)d_in[15];
    const float* wq = (const float*)d_in[16]; const float* k1 = (const float*)d_in[17]; const float* k2 = (const float*)d_in[18]; const float* pu = (const float*)d_in[19]; const float* pv = (const float*)d_in[20];
    const float* g_ple = (const float*)d_in[21]; const float* w_gate = (const float*)d_in[22]; const float* w_proj = (const float*)d_in[23]; const float* final_g = (const float*)d_in[24];
    float* rstd1 = (float*)(ws + WS_RSTD1); float* part2 = (float*)(ws + WS_PART2); float* part4 = (float*)(ws + WS_PART4); float* rstd3 = (float*)(ws + WS_RSTD3);
    bf16* qkv = (bf16*)(ws + WS_QKV); bf16* lx = (bf16*)(ws + WS_LX); bf16* gl = (bf16*)(ws + WS_GL); bf16* sga = (bf16*)(ws + WS_SGA); bf16* sgl = (bf16*)(ws + WS_SGL);
    bf16* att = (bf16*)(ws + WS_ATT); bf16* r0 = (bf16*)(ws + WS_R0); float* mp = (float*)(ws + WS_MP); bf16* merged = (bf16*)(ws + WS_MERGED);
    float* sc = (float*)(ws + WS_SC); int* seli = (int*)(ws + WS_SELI); float* selg = (float*)(ws + WS_SELG); bf16* h2b = (bf16*)(ws + WS_H2B); bf16* pp = (bf16*)(ws + WS_PP);
    float* tmpf = (float*)(ws + WS_NAIVE_AB);
    switch (grp) {
    case 0:
        hipLaunchKernelGGL(nv::rowsq, dim3(T_ / 4), dim3(256), 0, st, x, rstd1, (float*)nullptr);
        nv::run_gemm<nv::ALf32, nv::EpiProj, false>(st, nv::ALf32{x, 1024}, w_in, INW, g_mix, T_, INW, 1024, nv::EpiProj{rstd1, qkv, lx, gl, sga, sgl});
        break;
    case 1:
        hipLaunchKernelGGL(nv::attn_naive, dim3(T_ * 8 / 128), dim3(128), 0, st, qkv, sink, att);
        hipLaunchKernelGGL(nv::conv_naive, dim3(T_ * 1024 / 256), dim3(256), 0, st, lx, conv_w, conv_b, r0);
        break;
    case 2:
        hipLaunchKernelGGL(nv::lru_ab_naive, dim3(T_ * 8), dim3(128), 0, st, r0, wa, ba, wx, bx, lam, out, tmpf);
        hipLaunchKernelGGL(nv::lru_scan_naive, dim3(B_ * 1024 / 64), dim3(64), 0, st, out, tmpf, gl, r0);
        break;
    case 3: nv::run_gemm<nv::ALbf16, nv::EpiMP, false>(st, nv::ALbf16{att, 512}, w_ua, 1024, nullptr, T_, 1024, 512, nv::EpiMP{sga, mp}); break;
    case 4: nv::run_gemm<nv::ALbf16, nv::EpiMerged, false>(st, nv::ALbf16{r0, 1024}, w_ul, 1024, nullptr, T_, 1024, 1024, nv::EpiMerged{sgl, mp, merged}); break;
    case 5:
        nv::run_gemm<nv::ALbf16, nv::EpiH1, false>(st, nv::ALbf16{merged, 1024}, w_o, 1024, nullptr, T_, 1024, 1024, nv::EpiH1{x, out, r0});
        hipLaunchKernelGGL(nv::rowsq, dim3(T_ / 4), dim3(256), 0, st, out, (float*)nullptr, part2);
        break;
    case 6:
        for (int half = 0; half < 2; ++half) {
            nv::run_gemm<nv::ALf32, nv::EpiScaleF32, false>(st, nv::ALf32{out, 1024}, wq + half * 1024, 2048, g_ffn, T_, 1024, 1024, nv::EpiScaleF32{part2, tmpf, 1024});
            for (int hl = 0; hl < 4; ++hl)
                for (int hf = 0; hf < 2; ++hf)
                    nv::run_gemm<nv::ALf32, nv::EpiPlainF32, true>(st, nv::ALf32{tmpf + hl * 256 + hf * 128, 1024}, hf ? k2 : k1, 128, nullptr, T_, 128, 128, nv::EpiPlainF32{sc + hl * 256 + hf * 128, 1024});
            hipLaunchKernelGGL(topk_kernel, dim3(T_ / TK_TOK), dim3(512), TK_LDS_BYTES, st, sc, half * 4, seli, selg);
        }
        break;
    case 7: hipLaunchKernelGGL(gather_kernel<0>, dim3(1024), dim3(256), 0, st, (const void*)pu, (const void*)pv, g_ffn, seli, selg, part2, out, h2b, rstd3); break;
    case 8: nv::run_gemm<nv::ALf32, nv::EpiPP, false>(st, nv::ALf32{p, 256}, w_proj, 1024, nullptr, T_, 1024, 256, nv::EpiPP{pp}); break;
    case 9: nv::run_gemm<nv::ALbf16, nv::EpiH3, false>(st, nv::ALbf16{h2b, 1024}, w_gate, 1024, g_ple, T_, 1024, 1024, nv::EpiH3{rstd3, pp, out});
        hipLaunchKernelGGL(nv::rowsq, dim3(T_ / 4), dim3(256), 0, st, out, (float*)nullptr, part4);
        break;
    case 10: hipLaunchKernelGGL(nv::final_norm, dim3(T_ / 4), dim3(256), 0, st, out, part4, final_g); break;
    }
}

extern "C" void kernel_launch(void* const* d_in, const int* in_sizes, int n_in, void* d_out, int out_size, void* d_ws, size_t ws_size, hipStream_t stream) {
    static int grid = 0;
    if (grid == 0) {
        if (n_in != 25 || out_size != T_ * 1024 || ws_size < WS_END) { fprintf(stderr, "kernel_launch: unexpected sizes n_in %d out %d ws %zu\n", n_in, out_size, ws_size); }
        (void)hipFuncSetAttribute((const void*)topk_kernel, hipFuncAttributeMaxDynamicSharedMemorySize, TK_LDS_BYTES);
        int dev = 0, cus = 0, per_cu = 0;
        (void)hipGetDevice(&dev); (void)hipDeviceGetAttribute(&cus, hipDeviceAttributeMultiprocessorCount, dev);
        if (hipFuncSetAttribute((const void*)fused_fwd, hipFuncAttributeMaxDynamicSharedMemorySize, LDS_BYTES) != hipSuccess) fprintf(stderr, "kernel_launch: hipFuncSetAttribute(fused_fwd) failed\n");
        if (hipOccupancyMaxActiveBlocksPerMultiprocessor(&per_cu, (const void*)fused_fwd, NWAVES * 64, LDS_BYTES) != hipSuccess || per_cu < 1) fprintf(stderr, "kernel_launch: occupancy query says %d blocks/CU\n", per_cu);
        (void)hipGetLastError();
        grid = cus > 0 ? cus : 256;
    }
    unsigned char* ws = (unsigned char*)d_ws; float* out = (float*)d_out;
    const unsigned mask = FUSED_MASK;
    if (mask) (void)hipMemsetAsync(ws + WS_CTL, 0, CTL_ZERO_BYTES, stream);
    Args a{};
    for (int i = 0; i < 25; ++i) a.in[i] = (const float*)d_in[i];
    a.out = out; a.ws = ws;
    int li = 0;
    auto launch = [&](int lo, int hi) {
        if (MERGE_LAUNCHES) { a.ph_lo = lo; a.ph_hi = hi; a.li = li++; hipLaunchKernelGGL(fused_fwd, dim3(grid), dim3(NWAVES * 64), LDS_BYTES, stream, a); }
        else for (int ph = lo; ph < hi; ++ph) { a.ph_lo = ph; a.ph_hi = ph + 1; a.li = li++; hipLaunchKernelGGL(fused_fwd, dim3(grid), dim3(NWAVES * 64), LDS_BYTES, stream, a); }
    };
    int pend_lo = -1, pend_hi = -1;
    if (mask && !(mask & 1)) launch(0, 1);
    for (int gidx = 0; gidx < 11; ++gidx) {
#if (defined(LRU_T2) && LRU_T2) || (defined(LRU_T3) && LRU_T3)
        if (gidx == 2 && (mask & 4u)) {
            if (pend_lo >= 0) { launch(pend_lo, pend_hi); pend_lo = -1; }
            launch(3, 4);
            hipLaunchKernelGGL(nv::lru_finish_naive_L<(LRU_T2 ? 16 : 64)>, dim3(B_ * 1024 / 64), dim3(64), 0, stream, (const bf16*)(ws + WS_HLOC), (const bf16*)(ws + WS_PCUM), (const bf16*)(ws + WS_GL), (bf16*)(ws + WS_R0));
            continue;
        }
#endif
        if (mask & (1u << gidx)) {
            if (pend_lo < 0) { pend_lo = GRP_LO[gidx]; pend_hi = GRP_HI[gidx]; } else pend_hi = GRP_HI[gidx];
        } else {
            if (pend_lo >= 0) { launch(pend_lo, pend_hi); pend_lo = -1; }
            naive_group(gidx, d_in, out, ws, stream);
        }
    }
    if (pend_lo >= 0) launch(pend_lo, pend_hi);
#if defined(LRU_DEBUG) && LRU_DEBUG == 2
    hipLaunchKernelGGL(nv::poison_if, dim3(T_ * 1024 / 256), dim3(256), 0, stream, out, (const unsigned*)(ws + WS_CTL) + 64);
#endif
}
```

```cpp
#include <hip/hip_runtime.h>
#include <cstdio>
#include <cstdint>
#include <cmath>

#ifndef FUSED_MASK
#define FUSED_MASK 0x7ff
#endif
#ifndef MERGE_LAUNCHES
#define MERGE_LAUNCHES 1
#endif
#ifndef LRU_PADDED
#define LRU_PADDED 1
#endif
#ifndef FUSE_FINAL
#define FUSE_FINAL 0
#endif
#define ALL_FUSED ((FUSED_MASK) == 0x7ff && (MERGE_LAUNCHES))
constexpr int B_ = 8, S_ = 2048, D_ = 1024, T_ = B_ * S_;
constexpr int INW = 4864;
constexpr float EPS = 1e-6f;
typedef unsigned short bf16;
#define HD_INLINE __host__ __device__ __forceinline__

constexpr size_t MiB = 1u << 20;
constexpr size_t WS_CTL = 0;
constexpr size_t WS_WIN = 1 * MiB;
constexpr size_t WS_WUA = WS_WIN + 4864 * 1024 * 2;
constexpr size_t WS_WUL = WS_WUA + 1 * MiB;
constexpr size_t WS_WO = WS_WUL + 2 * MiB;
constexpr size_t WS_WFOLD = WS_WO + 2 * MiB;
constexpr size_t WS_WG = WS_WFOLD + 4 * MiB;
constexpr size_t WS_WPROJ = WS_WG + 2 * MiB;
constexpr size_t WS_WAX = WS_WPROJ + MiB / 2;
constexpr size_t WS_W_END = WS_WAX + 1 * MiB;
static_assert(WS_W_END <= 23 * MiB, "weights");
constexpr size_t WS_RSTD1 = 23 * MiB;
constexpr size_t WS_PART2 = WS_RSTD1 + 256 * 1024;
constexpr size_t WS_PART4 = WS_PART2 + 1 * MiB;
constexpr size_t WS_RSTD3 = WS_PART4 + 1 * MiB;
constexpr size_t WS_AGG = WS_RSTD3 + 256 * 1024;
constexpr size_t WS_C8 = WS_AGG + 2 * MiB;
constexpr size_t WS_USCALE = WS_C8 + 64 * 1024;
static_assert(WS_USCALE + 128 * 1024 <= 28 * MiB, "small");
constexpr size_t WS_PB = 28 * MiB;
constexpr size_t WS_R0 = 36 * MiB;
constexpr size_t WS_QKV = 68 * MiB;
constexpr size_t WS_LX = 92 * MiB;
constexpr size_t WS_GL = 140 * MiB;
constexpr size_t WS_SGA = 172 * MiB;
constexpr size_t WS_SGL = 204 * MiB;
constexpr size_t WS_ATT = 236 * MiB;
constexpr size_t WS_HLOC = 68 * MiB, WS_PCUM = 100 * MiB;
constexpr size_t WS_MP = 68 * MiB;
constexpr size_t WS_MERGED = 140 * MiB;
constexpr size_t WS_SC = 172 * MiB;
constexpr size_t WS_SELI = 236 * MiB, WS_SELG = 244 * MiB;
constexpr size_t WS_U16 = 68 * MiB, WS_V16 = 100 * MiB;
constexpr size_t WS_H2B = 140 * MiB;
constexpr size_t WS_PP = 172 * MiB;
constexpr size_t WS_PP2 = 100 * MiB;
constexpr size_t WS_NAIVE_AB = 68 * MiB;
constexpr size_t WS_WAXD = 252 * MiB;
constexpr size_t WS_END = 256 * MiB;

HD_INLINE float bf2f(bf16 v) { return __builtin_bit_cast(float, (unsigned)v << 16); }
HD_INLINE bf16 f2bf(float f) { unsigned u = __builtin_bit_cast(unsigned, f); return (bf16)((u + 0x7fffu + ((u >> 16) & 1u)) >> 16); }
HD_INLINE unsigned pk2(float lo, float hi) { return (unsigned)f2bf(lo) | ((unsigned)f2bf(hi) << 16); }
__device__ __forceinline__ float wave_sum(float v) {
#pragma unroll
    for (int o = 1; o < 64; o <<= 1) v += __shfl_xor(v, o);
    return v;
}
__device__ __forceinline__ float sigmoidf_(float z) { return __builtin_amdgcn_rcpf(1.0f + __builtin_amdgcn_exp2f(-1.4426950408889634f * z)); }
__device__ __forceinline__ float gelu_tanh(float x) { const float u = 1.5957691216057308f * (x + 0.044715f * x * x * x); return x * sigmoidf_(u); }
__device__ __forceinline__ int fresh_lane() { int l; asm volatile("v_mbcnt_lo_u32_b32 %0, -1, 0\n\tv_mbcnt_hi_u32_b32 %0, -1, %0" : "=v"(l)); return l; }
#ifndef HD_INLINE
#define HD_INLINE __host__ __device__ __forceinline__
#endif

HD_INLINE unsigned tk_umax(unsigned a, unsigned b) { return a > b ? a : b; }
HD_INLINE unsigned tk_umin(unsigned a, unsigned b) { return a < b ? a : b; }
HD_INLINE unsigned tk_f2key(float f) { unsigned u = __builtin_bit_cast(unsigned, f); return u ^ ((unsigned)((int)u >> 31) | 0x80000000u); }
HD_INLINE float tk_key2f(unsigned k) { unsigned u = (k & 0x80000000u) ? (k ^ 0x80000000u) : ~k; return __builtin_bit_cast(float, u); }

HD_INLINE void tk_sort16(unsigned (&a)[16]) {
#pragma unroll
    for (int k = 2; k <= 16; k <<= 1) {
#pragma unroll
        for (int j = k >> 1; j > 0; j >>= 1) {
#pragma unroll
            for (int i = 0; i < 16; ++i) {
                const int p = i ^ j;
                if (p > i) {
                    const unsigned mx = tk_umax(a[i], a[p]), mn = tk_umin(a[i], a[p]);
                    if ((i & k) == 0) { a[i] = mx; a[p] = mn; } else { a[i] = mn; a[p] = mx; }
                }
            }
        }
    }
}
HD_INLINE void tk_merge16(unsigned (&a)[16], const unsigned (&b)[16]) {
#pragma unroll
    for (int i = 0; i < 16; ++i) a[i] = tk_umax(a[i], b[15 - i]);
#pragma unroll
    for (int j = 8; j > 0; j >>= 1) {
#pragma unroll
        for (int i = 0; i < 16; ++i) {
            const int p = i ^ j;
            if (p > i) { const unsigned mx = tk_umax(a[i], a[p]), mn = tk_umin(a[i], a[p]); a[i] = mx; a[p] = mn; }
        }
    }
}
HD_INLINE void tk_insert16(unsigned (&best)[16], unsigned key) {
#pragma unroll
    for (int s = 0; s < 16; ++s) { const unsigned hi = tk_umax(best[s], key); key = tk_umin(best[s], key); best[s] = hi; }
}
HD_INLINE void tk_combine_store(const unsigned (&k1)[16], const unsigned (&k2)[16], int* oi, float* og) {
    float v1[16], v2[16];
#pragma unroll
    for (int i = 0; i < 16; ++i) { v1[i] = tk_key2f(k1[i] & ~127u); v2[i] = tk_key2f(k2[i] & ~127u); }
    unsigned best[16];
#pragma unroll
    for (int s = 0; s < 16; ++s) best[s] = 0u;
#pragma unroll
    for (int i = 0; i < 16; ++i) {
#pragma unroll
        for (int j = 0; j < 16; ++j) {
            if ((i + 1) * (j + 1) <= 16) {
                const float s = v1[i] + v2[j];
                const unsigned key = (tk_f2key(s) & ~255u) | (unsigned)(255 - (i * 16 + j));
                tk_insert16(best, key);
            }
        }
    }
    const unsigned thr = best[15];
    const float mx = tk_key2f(best[0] & ~255u);
    float sum = 0.f;
#pragma unroll
    for (int i = 0; i < 16; ++i) {
#pragma unroll
        for (int j = 0; j < 16; ++j) {
            if ((i + 1) * (j + 1) <= 16) {
                const float s = v1[i] + v2[j];
                const unsigned key = (tk_f2key(s) & ~255u) | (unsigned)(255 - (i * 16 + j));
                if (key >= thr) sum += __builtin_expf(s - mx);
            }
        }
    }
    const float inv = 1.0f / sum;
    int cnt = 0;
#pragma unroll
    for (int i = 0; i < 16; ++i) {
#pragma unroll
        for (int j = 0; j < 16; ++j) {
            if ((i + 1) * (j + 1) <= 16) {
                const float s = v1[i] + v2[j];
                const unsigned key = (tk_f2key(s) & ~255u) | (unsigned)(255 - (i * 16 + j));
                if (key >= thr) {
                    oi[cnt] = (127 - (int)(k1[i] & 127u)) * 128 + (127 - (int)(k2[j] & 127u));
                    og[cnt] = __builtin_expf(s - mx) * inv;
                    ++cnt;
                }
            }
        }
    }
}
namespace nv {
struct ALf32 { const float* p; int lda; int pad; __device__ __forceinline__ float operator()(int m, int k) const { return p[(size_t)m * lda + k]; } };
struct ALbf16 { const bf16* p; int lda; int pad; __device__ __forceinline__ float operator()(int m, int k) const { return bf2f(p[(size_t)m * lda + k]); } };

template <class AL, class EPI, bool BT>
__global__ void __launch_bounds__(256) ngemm(AL al, const float* __restrict__ B, int ldb, const float* __restrict__ ks, int M, int N, int K, EPI epi) {
    __shared__ float As[16][68];
    __shared__ float Bs[16][68];
    const int tid = threadIdx.x, tx = tid & 15, ty = tid >> 4;
    const int m0 = blockIdx.y * 64, n0 = blockIdx.x * 64;
    float acc[4][4];
#pragma unroll
    for (int i = 0; i < 4; ++i)
#pragma unroll
        for (int j = 0; j < 4; ++j) acc[i][j] = 0.f;
    for (int k0 = 0; k0 < K; k0 += 16) {
#pragma unroll
        for (int i = 0; i < 4; ++i) {
            const int e = tid + i * 256;
            { const int m = e >> 4, k = e & 15; float v = al(m0 + m, k0 + k); if (ks) v *= ks[k0 + k]; As[k][m] = v; }
            if (BT) { const int n = e >> 4, k = e & 15; Bs[k][n] = B[(size_t)(n0 + n) * ldb + k0 + k]; }
            else { const int k = e >> 6, n = e & 63; Bs[k][n] = B[(size_t)(k0 + k) * ldb + n0 + n]; }
        }
        __syncthreads();
#pragma unroll
        for (int k = 0; k < 16; ++k) {
            float a[4], b[4];
#pragma unroll
            for (int i = 0; i < 4; ++i) { a[i] = As[k][ty * 4 + i]; b[i] = Bs[k][tx * 4 + i]; }
#pragma unroll
            for (int i = 0; i < 4; ++i)
#pragma unroll
                for (int j = 0; j < 4; ++j) acc[i][j] = fmaf(a[i], b[j], acc[i][j]);
        }
        __syncthreads();
    }
#pragma unroll
    for (int i = 0; i < 4; ++i)
#pragma unroll
        for (int j = 0; j < 4; ++j) epi(m0 + ty * 4 + i, n0 + tx * 4 + j, acc[i][j]);
}
template <class AL, class EPI, bool BT>
static void run_gemm(hipStream_t st, AL al, const float* B, int ldb, const float* ks, int M, int N, int K, EPI epi) {
    hipLaunchKernelGGL((ngemm<AL, EPI, BT>), dim3(N / 64, M / 64), dim3(256), 0, st, al, B, ldb, ks, M, N, K, epi);
}

__global__ void __launch_bounds__(256) rowsq(const float* __restrict__ X, float* rstd, float* part) {
    const int row = blockIdx.x * 4 + (threadIdx.x >> 6), lane = threadIdx.x & 63;
    const float* xr = X + (size_t)row * 1024;
    float s = 0.f;
    for (int j = 0; j < 16; ++j) { const float v = xr[lane + 64 * j]; s += v * v; }
    s = wave_sum(s);
    if (rstd && lane == 0) rstd[row] = 1.0f / sqrtf(s * (1.0f / 1024.0f) + EPS);
    if (part && lane < 16) part[(size_t)row * 16 + lane] = (lane == 0) ? s : 0.f;
}

struct EpiProj {
    const float* rstd; bf16 *qkv, *lx, *gl, *sga, *sgl;
    __device__ __forceinline__ void operator()(int m, int n, float v) const {
        v *= rstd[m];
        if (n < 768) qkv[(size_t)m * 768 + n] = f2bf(v);
        else if (n < 1792) lx[(size_t)m * 1024 + (n - 768)] = f2bf(v);
        else if (n < 2816) gl[(size_t)m * 1024 + (n - 1792)] = f2bf(gelu_tanh(v));
        else if (n < 3840) sga[(size_t)m * 1024 + (n - 2816)] = f2bf(sigmoidf_(v));
        else sgl[(size_t)m * 1024 + (n - 3840)] = f2bf(sigmoidf_(v));
    }
};

__global__ void __launch_bounds__(128) attn_naive(const bf16* __restrict__ qkv, const float* __restrict__ sink, bf16* __restrict__ att) {
    const int gid = blockIdx.x * 128 + threadIdx.x;
    const int head = gid / T_, t = gid % T_;
    const int b = t / S_, ts = t % S_;
    const int g = head >> 2;
    float q[64], acc[64];
    const bf16* qp = qkv + (size_t)t * 768 + head * 64;
#pragma unroll
    for (int d = 0; d < 64; ++d) { q[d] = bf2f(qp[d]); acc[d] = 0.f; }
    const float slope = exp2f(-(float)(head + 1));
    float m = -3.0e38f, l = 0.f;
    for (int dist = 127; dist >= 0; --dist) {
        const int s = ts - dist; if (s < 0) continue;
        const bf16* kp = qkv + (size_t)(b * S_ + s) * 768 + 512 + g * 64;
        const bf16* vp = kp + 128;
        float sc = 0.f;
#pragma unroll
        for (int d = 0; d < 64; ++d) sc = fmaf(q[d], bf2f(kp[d]), sc);
        sc = sc * 0.125f - slope * (float)dist;
        const float mn = fmaxf(m, sc), corr = __expf(m - mn), p = __expf(sc - mn);
        l = l * corr + p;
#pragma unroll
        for (int d = 0; d < 64; ++d) acc[d] = acc[d] * corr + p * bf2f(vp[d]);
        m = mn;
    }
    const float sk = sink[head];
    const float mf = fmaxf(m, sk), corr = __expf(m - mf);
    l = l * corr + __expf(sk - mf);
    const float inv = corr / l;
    bf16* op = att + (size_t)t * 512 + head * 64;
#pragma unroll
    for (int d = 0; d < 64; ++d) op[d] = f2bf(acc[d] * inv);
}

__global__ void __launch_bounds__(256) conv_naive(const bf16* __restrict__ lx, const float* __restrict__ cw, const float* __restrict__ cb, bf16* __restrict__ lin) {
    const size_t i = (size_t)blockIdx.x * 256 + threadIdx.x;
    const int c = (int)(i & 1023); const int t = (int)(i >> 10); const int ts = t % S_;
    float y = cb[c];
#pragma unroll
    for (int tap = 0; tap < 4; ++tap) { const int s = ts - 3 + tap; if (s >= 0) y = fmaf(bf2f(lx[(size_t)(t - 3 + tap) * 1024 + c]), cw[tap * 1024 + c], y); }
    lin[i] = f2bf(y);
}

__global__ void __launch_bounds__(128) lru_ab_naive(const bf16* __restrict__ lin, const float* __restrict__ wa, const float* __restrict__ ba, const float* __restrict__ wx, const float* __restrict__ bx,
                                                    const float* __restrict__ lam, float* __restrict__ Af, float* __restrict__ Bf) {
    __shared__ float xs[128];
    const int t = blockIdx.x >> 3, blk = blockIdx.x & 7, d = threadIdx.x, ch = blk * 128 + d;
    xs[d] = bf2f(lin[(size_t)t * 1024 + ch]);
    __syncthreads();
    float r = ba[ch], ii = bx[ch];
    const float* wap = wa + (size_t)blk * 128 * 128 + d; const float* wxp = wx + (size_t)blk * 128 * 128 + d;
    for (int c = 0; c < 128; ++c) { r = fmaf(xs[c], wap[c * 128], r); ii = fmaf(xs[c], wxp[c * 128], ii); }
    r = sigmoidf_(r); ii = sigmoidf_(ii);
    const float sp = log1pf(expf(-lam[ch]));
    const float loga = -8.0f * r * sp;
    const float a = expf(loga);
    const float bb = sqrtf(-expm1f(2.0f * loga)) * (ii * xs[d]);
    Af[(size_t)t * 1024 + ch] = a; Bf[(size_t)t * 1024 + ch] = bb;
}
__global__ void __launch_bounds__(256) lru_ab_from_pre(const bf16* __restrict__ lin, const float* __restrict__ ba, const float* __restrict__ bx, const float* __restrict__ lam, float* __restrict__ Af, float* __restrict__ Bf) {
    const size_t i = (size_t)blockIdx.x * 256 + threadIdx.x; const int ch = (int)(i & 1023);
    const float r = sigmoidf_(Af[i] + ba[ch]), ii = sigmoidf_(Bf[i] + bx[ch]);
    const float loga = -8.0f * r * log1pf(expf(-lam[ch]));
    Af[i] = expf(loga); Bf[i] = sqrtf(-expm1f(2.0f * loga)) * (ii * bf2f(lin[i]));
}
template <int L>
__global__ void __launch_bounds__(64) lru_finish_naive_L(const bf16* __restrict__ hloc, const bf16* __restrict__ pcum, const bf16* __restrict__ gl, bf16* __restrict__ rec) {
    const int gid = blockIdx.x * 64 + threadIdx.x; const int b = gid >> 10, ch = gid & 1023;
    float carry = 0.f;
    for (int c = 0; c < S_ / L; ++c) {
        float la = 1.f, lb = 0.f;
        for (int s = 0; s < L; ++s) { const size_t o = (size_t)(b * S_ + c * L + s) * 1024 + ch; la = bf2f(pcum[o]); lb = bf2f(hloc[o]); const float h = la * carry + lb; rec[o] = f2bf(h * bf2f(gl[o])); }
        carry = la * carry + lb;
    }
}
__global__ void __launch_bounds__(64) lru_finish_naive(const bf16* __restrict__ hloc, const bf16* __restrict__ pcum, const float* __restrict__ agg, const bf16* __restrict__ gl, bf16* __restrict__ rec) {
    const int gid = blockIdx.x * 64 + threadIdx.x; const int b = gid >> 10, ch = gid & 1023;
    float carry = 0.f;
    for (int c = 0; c < 32; ++c) {
        const int chunk = b * 32 + c;
        for (int s = 0; s < 64; ++s) { const size_t o = (size_t)(chunk * 64 + s) * 1024 + ch; const float h = bf2f(pcum[o]) * carry + bf2f(hloc[o]); rec[o] = f2bf(h * bf2f(gl[o])); }
        const float* ap = agg + ((size_t)chunk * 1024 + ch) * 2; carry = ap[0] * carry + ap[1];
    }
}
__global__ void __launch_bounds__(128) lru_pre_check(const bf16* __restrict__ lin, const float* __restrict__ wa, const float* __restrict__ wx, const float* __restrict__ Rp, const float* __restrict__ Ip, unsigned* flag) {
    __shared__ float xs[128];
    const int t = blockIdx.x >> 3, blk = blockIdx.x & 7, d = threadIdx.x, ch = blk * 128 + d;
    xs[d] = bf2f(lin[(size_t)t * 1024 + ch]);
    __syncthreads();
    float r = 0.f, ii = 0.f;
    const float* wap = wa + (size_t)blk * 128 * 128 + d; const float* wxp = wx + (size_t)blk * 128 * 128 + d;
    for (int c = 0; c < 128; ++c) { r = fmaf(xs[c], wap[c * 128], r); ii = fmaf(xs[c], wxp[c * 128], ii); }
    const float dr = fabsf(r - Rp[(size_t)t * 1024 + ch]), di = fabsf(ii - Ip[(size_t)t * 1024 + ch]);
    if (!(dr < 0.08f + 0.03f * fabsf(r)) || !(di < 0.08f + 0.03f * fabsf(ii))) atomicAdd(flag, 1u);
}
__global__ void __launch_bounds__(256) poison_if(float* out, const unsigned* flag) { if (*flag) { const size_t i = (size_t)blockIdx.x * 256 + threadIdx.x; out[i] = out[i] * 50.0f + 3.0f; } }
__global__ void __launch_bounds__(64) lru_scan_naive(const float* __restrict__ Af, const float* __restrict__ Bf, const bf16* __restrict__ gl, bf16* __restrict__ rec) {
    const int gid = blockIdx.x * 64 + threadIdx.x; const int b = gid >> 10, ch = gid & 1023;
    float h = 0.f;
    for (int s = 0; s < S_; ++s) { const size_t o = (size_t)(b * S_ + s) * 1024 + ch; h = fmaf(Af[o], h, Bf[o]); rec[o] = f2bf(h * bf2f(gl[o])); }
}

struct EpiMP { const bf16* sga; float* mp; __device__ __forceinline__ void operator()(int m, int n, float v) const { const size_t o = (size_t)m * 1024 + n; mp[o] = v * bf2f(sga[o]); } };
struct EpiMerged { const bf16* sgl; const float* mp; bf16* merged; __device__ __forceinline__ void operator()(int m, int n, float v) const { const size_t o = (size_t)m * 1024 + n; merged[o] = f2bf(mp[o] + v * bf2f(sgl[o])); } };
struct EpiH1 { const float* x; float* h1; bf16* h1b; __device__ __forceinline__ void operator()(int m, int n, float v) const { const size_t o = (size_t)m * 1024 + n; const float h = x[o] + v; h1[o] = h; h1b[o] = f2bf(h); } };
struct EpiScaleF32 { const float* part; float* out; int ldo; int pad; __device__ __forceinline__ void operator()(int m, int n, float v) const {
    float s = 0.f; for (int i = 0; i < 16; ++i) s += part[(size_t)m * 16 + i];
    out[(size_t)m * ldo + n] = v * (1.0f / sqrtf(s * (1.0f / 1024.0f) + EPS)); } };
struct EpiPlainF32 { float* out; int ldo; int pad; __device__ __forceinline__ void operator()(int m, int n, float v) const { out[(size_t)m * ldo + n] = v; } };
struct EpiPP { bf16* pp; __device__ __forceinline__ void operator()(int m, int n, float v) const { pp[(size_t)m * 1024 + n] = f2bf(v); } };
struct EpiH3 { const float* rstd3; const bf16* pp; float* h; __device__ __forceinline__ void operator()(int m, int n, float v) const { const size_t o = (size_t)m * 1024 + n; h[o] = h[o] + sigmoidf_(v * rstd3[m]) * bf2f(pp[o]); } };

__global__ void __launch_bounds__(256) final_norm(float* __restrict__ h, const float* __restrict__ part, const float* __restrict__ fg) {
    const int row = blockIdx.x * 4 + (threadIdx.x >> 6), lane = threadIdx.x & 63;
    float s = 0.f; for (int i = 0; i < 16; ++i) s += part[(size_t)row * 16 + i];
    const float r = 1.0f / sqrtf(s * (1.0f / 1024.0f) + EPS);
    float* hr = h + (size_t)row * 1024;
    for (int j = 0; j < 16; ++j) { const int c = lane + 64 * j; hr[c] = hr[c] * r * fg[c]; }
}
}
#define LAS __attribute__((address_space(3)))
typedef float f32x4 __attribute__((ext_vector_type(4)));
typedef unsigned u32x4 __attribute__((ext_vector_type(4)));
typedef int i32x4 __attribute__((ext_vector_type(4)));

constexpr int TK_TOK = 32;
constexpr int TK_LSTRIDE = 132;
constexpr int TK_LDS_BYTES = 256 * TK_LSTRIDE * 4;

__device__ __forceinline__ void topk_item(LAS float* lds, const float* __restrict__ SC, int item, int head_base, int* __restrict__ seli, float* __restrict__ selg, int tid) {
    const f32x4* src = (const f32x4*)(SC + (size_t)item * TK_TOK * 1024);
#pragma unroll 4
    for (int i = 0; i < 16; ++i) {
        const int idx = tid + i * 512; const int row = idx >> 8, c4 = idx & 255;
        const f32x4 v = src[idx];
        const int list = row * 8 + (c4 >> 5), elem = (c4 & 31) * 4;
        *(LAS f32x4*)(lds + list * TK_LSTRIDE + elem) = v;
    }
    __syncthreads();
    if (tid < 256) {
        const LAS float* my = lds + tid * TK_LSTRIDE;
        unsigned acc[16];
#pragma unroll
        for (int g = 0; g < 8; ++g) {
            unsigned t[16];
#pragma unroll
            for (int q = 0; q < 4; ++q) {
                const f32x4 v = *(const LAS f32x4*)(my + g * 16 + q * 4);
#pragma unroll
                for (int c = 0; c < 4; ++c) { const int e = g * 16 + q * 4 + c; t[q * 4 + c] = (tk_f2key(v[c]) & ~127u) | (unsigned)(127 - e); }
            }
            tk_sort16(t);
            if (g == 0) {
#pragma unroll
                for (int i = 0; i < 16; ++i) acc[i] = t[i];
            } else tk_merge16(acc, t);
        }
        unsigned oth[16];
#pragma unroll
        for (int i = 0; i < 16; ++i) oth[i] = (unsigned)__shfl_xor((int)acc[i], 1);
        if ((tid & 1) == 0) {
            const int tok = item * TK_TOK + (tid >> 3), head = head_base + ((tid >> 1) & 3);
            tk_combine_store(acc, oth, seli + (size_t)tok * 128 + head * 16, selg + (size_t)tok * 128 + head * 16);
        }
    }
    __syncthreads();
}
__global__ void __launch_bounds__(512) topk_kernel(const float* __restrict__ SC, int head_base, int* __restrict__ seli, float* __restrict__ selg) {
    extern __shared__ __attribute__((aligned(16))) unsigned char dyn_lds[];
    for (int item = blockIdx.x; item < T_ / TK_TOK; item += gridDim.x) topk_item((LAS float*)dyn_lds, SC, item, head_base, seli, selg, (int)threadIdx.x);
}

template <int MODE>
__device__ __forceinline__ void gather_token(int t, int lane, const void* __restrict__ Utab, const void* __restrict__ Vtab, const float* __restrict__ gffn,
                                             const int* __restrict__ seli, const float* __restrict__ selg, const float* __restrict__ part2,
                                             float* __restrict__ H  , bf16* __restrict__ h2b, float* __restrict__ rstd3) {
    float ps = (lane < 16) ? part2[(size_t)t * 16 + lane] : 0.f;
    ps = wave_sum(ps);
    const float rstd2 = 1.0f / sqrtf(ps * (1.0f / 1024.0f) + EPS);
    const int iA = seli[(size_t)t * 128 + lane], iB = seli[(size_t)t * 128 + 64 + lane];
    const float gA = selg[(size_t)t * 128 + lane], gB = selg[(size_t)t * 128 + 64 + lane];
    float* hr = H + (size_t)t * 1024;
    if constexpr (MODE == 0) {
        f32x4 x[4], y[4], hv[4];
#pragma unroll
        for (int j = 0; j < 4; ++j) { hv[j] = *(const f32x4*)(hr + 256 * j + 4 * lane); const f32x4 g = *(const f32x4*)(gffn + 256 * j + 4 * lane); x[j] = hv[j] * g; y[j] = (f32x4){0.f, 0.f, 0.f, 0.f}; }
        const float* U = (const float*)Utab; const float* V = (const float*)Vtab;
        for (int k = 0; k < 64; ++k) {
#pragma unroll
            for (int hh = 0; hh < 2; ++hh) {
                const int e = __builtin_amdgcn_readlane(hh ? iB : iA, k);
                const float gt = __builtin_bit_cast(float, __builtin_amdgcn_readlane(__builtin_bit_cast(int, hh ? gB : gA), k));
                const float* ur = U + (size_t)e * 1024; const float* vr = V + (size_t)e * 1024;
                f32x4 uv[4], vv[4];
#pragma unroll
                for (int j = 0; j < 4; ++j) { uv[j] = *(const f32x4*)(ur + 256 * j + 4 * lane); vv[j] = *(const f32x4*)(vr + 256 * j + 4 * lane); }
                float d = 0.f;
#pragma unroll
                for (int j = 0; j < 4; ++j) d += (uv[j].x * x[j].x + uv[j].y * x[j].y) + (uv[j].z * x[j].z + uv[j].w * x[j].w);
                d = wave_sum(d);
                const float c = gt * gelu_tanh(d * rstd2);
#pragma unroll
                for (int j = 0; j < 4; ++j) y[j] += vv[j] * c;
            }
        }
        float sq = 0.f;
#pragma unroll
        for (int j = 0; j < 4; ++j) {
            const f32x4 h2 = hv[j] + y[j];
            *(f32x4*)(hr + 256 * j + 4 * lane) = h2;
            sq += (h2.x * h2.x + h2.y * h2.y) + (h2.z * h2.z + h2.w * h2.w);
            uint2 w; w.x = pk2(h2.x, h2.y); w.y = pk2(h2.z, h2.w);
            *(uint2*)(h2b + (size_t)t * 1024 + 256 * j + 4 * lane) = w;
        }
        sq = wave_sum(sq);
        if (lane == 0) rstd3[t] = 1.0f / sqrtf(sq * (1.0f / 1024.0f) + EPS);
    } else {
        float x[2][8], y[2][8], hv[2][8];
#pragma unroll
        for (int j = 0; j < 2; ++j) {
            const f32x4 a = *(const f32x4*)(hr + 512 * j + 8 * lane), b = *(const f32x4*)(hr + 512 * j + 8 * lane + 4);
            hv[j][0] = a.x; hv[j][1] = a.y; hv[j][2] = a.z; hv[j][3] = a.w; hv[j][4] = b.x; hv[j][5] = b.y; hv[j][6] = b.z; hv[j][7] = b.w;
#pragma unroll
            for (int c = 0; c < 8; ++c) { x[j][c] = hv[j][c]; y[j][c] = 0.f; }
        }
        const bf16* U = (const bf16*)Utab; const bf16* V = (const bf16*)Vtab;
        for (int k = 0; k < 64; k += 2) {
            u32x4 uv[4][2], vv[4][2]; float gt[4];
#pragma unroll
            for (int q = 0; q < 4; ++q) {
                const int kk = k + (q >> 1); const int hh = q & 1;
                const int e = __builtin_amdgcn_readlane(hh ? iB : iA, kk);
                gt[q] = __builtin_bit_cast(float, __builtin_amdgcn_readlane(__builtin_bit_cast(int, hh ? gB : gA), kk));
                const bf16* ur = U + (size_t)e * 1024; const bf16* vr = V + (size_t)e * 1024;
#pragma unroll
                for (int j = 0; j < 2; ++j) { uv[q][j] = *(const u32x4*)(ur + 512 * j + 8 * lane); vv[q][j] = *(const u32x4*)(vr + 512 * j + 8 * lane); }
            }
#pragma unroll
            for (int q = 0; q < 4; ++q) {
                float d = 0.f;
#pragma unroll
                for (int j = 0; j < 2; ++j)
#pragma unroll
                    for (int c = 0; c < 4; ++c) { const unsigned w = uv[q][j][c]; d = fmaf(__builtin_bit_cast(float, w << 16), x[j][2 * c], d); d = fmaf(__builtin_bit_cast(float, w & 0xffff0000u), x[j][2 * c + 1], d); }
                d = wave_sum(d);
                const float cf = gt[q] * gelu_tanh(d * rstd2);
#pragma unroll
                for (int j = 0; j < 2; ++j)
#pragma unroll
                    for (int c = 0; c < 4; ++c) { const unsigned w = vv[q][j][c]; y[j][2 * c] = fmaf(__builtin_bit_cast(float, w << 16), cf, y[j][2 * c]); y[j][2 * c + 1] = fmaf(__builtin_bit_cast(float, w & 0xffff0000u), cf, y[j][2 * c + 1]); }
            }
        }
        float sq = 0.f;
#pragma unroll
        for (int j = 0; j < 2; ++j) {
            float h2[8];
#pragma unroll
            for (int c = 0; c < 8; ++c) { h2[c] = hv[j][c] + y[j][c]; sq += h2[c] * h2[c]; }
            *(f32x4*)(hr + 512 * j + 8 * lane) = (f32x4){h2[0], h2[1], h2[2], h2[3]};
            *(f32x4*)(hr + 512 * j + 8 * lane + 4) = (f32x4){h2[4], h2[5], h2[6], h2[7]};
            u32x4 w; w.x = pk2(h2[0], h2[1]); w.y = pk2(h2[2], h2[3]); w.z = pk2(h2[4], h2[5]); w.w = pk2(h2[6], h2[7]);
            *(u32x4*)(h2b + (size_t)t * 1024 + 512 * j + 8 * lane) = w;
        }
        sq = wave_sum(sq);
        if (lane == 0) rstd3[t] = 1.0f / sqrtf(sq * (1.0f / 1024.0f) + EPS);
    }
}
template <int MODE>
__global__ void __launch_bounds__(256) gather_kernel(const void* __restrict__ Utab, const void* __restrict__ Vtab, const float* __restrict__ gffn, const int* __restrict__ seli, const float* __restrict__ selg,
                                                     const float* __restrict__ part2, float* __restrict__ H, bf16* __restrict__ h2b, float* __restrict__ rstd3) {
    const int lane = threadIdx.x & 63; const int w = blockIdx.x * 4 + (threadIdx.x >> 6); const int nw = gridDim.x * 4;
    for (int t = w; t < T_; t += nw) gather_token<MODE>(t, lane, Utab, Vtab, gffn, seli, selg, part2, H, h2b, rstd3);
}

typedef float f32x2 __attribute__((ext_vector_type(2)));
__device__ __forceinline__ float reduce4_transpose(float d0, float d1, float d2, float d3, int lane) {
    const bool b0 = lane & 1, b1 = lane & 2;
    const float a = (b0 ? d1 : d0) + __shfl_xor(b0 ? d0 : d1, 1);
    const float b = (b0 ? d3 : d2) + __shfl_xor(b0 ? d2 : d3, 1);
    float c = (b1 ? b : a) + __shfl_xor(b1 ? a : b, 2);
    c += __shfl_xor(c, 4); c += __shfl_xor(c, 8); c += __shfl_xor(c, 16); c += __shfl_xor(c, 32);
    return c;
}
__device__ __forceinline__ float dot16_fp8(const u32x4 w, const f32x2 (&x2)[8]) {
    f32x2 acc = (f32x2){0.f, 0.f};
#pragma unroll
    for (int c = 0; c < 4; ++c) { const unsigned ww = w[c]; const f32x2 lo = __builtin_amdgcn_cvt_pk_f32_fp8(ww, false), hi = __builtin_amdgcn_cvt_pk_f32_fp8(ww, true); acc = lo * x2[2 * c] + acc; acc = hi * x2[2 * c + 1] + acc; }
    return acc.x + acc.y;
}
__device__ __forceinline__ void axpy16_fp8(const u32x4 w, float cf, f32x2 (&y2)[8]) {
#pragma unroll
    for (int c = 0; c < 4; ++c) { const unsigned ww = w[c]; const f32x2 lo = __builtin_amdgcn_cvt_pk_f32_fp8(ww, false), hi = __builtin_amdgcn_cvt_pk_f32_fp8(ww, true); y2[2 * c] = lo * cf + y2[2 * c]; y2[2 * c + 1] = hi * cf + y2[2 * c + 1]; }
}
__device__ __forceinline__ float sel4f(float v0, float v1, float v2, float v3, int q) { return q == 0 ? v0 : (q == 1 ? v1 : (q == 2 ? v2 : v3)); }
__device__ __forceinline__ void gather_token_fp8(int t, int lane, const unsigned char* __restrict__ U8, const unsigned char* __restrict__ V8, const float* __restrict__ IU, const float* __restrict__ IV,
                                                 const int* __restrict__ seli, const float* __restrict__ selg, const float* __restrict__ part2,
                                                 float* __restrict__ H, bf16* __restrict__ h2b, float* __restrict__ rstd3) {
    float ps = (lane < 16) ? part2[(size_t)t * 16 + lane] : 0.f;
    ps = wave_sum(ps);
    const float rstd2 = 1.0f / sqrtf(ps * (1.0f / 1024.0f) + EPS);
    const int iA = seli[(size_t)t * 128 + lane], iB = seli[(size_t)t * 128 + 64 + lane];
    const float duA = IU[iA] * rstd2, duB = IU[iB] * rstd2;
    const float gvA = selg[(size_t)t * 128 + lane] * IV[iA], gvB = selg[(size_t)t * 128 + 64 + lane] * IV[iB];
    float* hr = H + (size_t)t * 1024 + 16 * lane;
    f32x2 x2[8], y2[8]; f32x4 hv[4];
#pragma unroll
    for (int j = 0; j < 4; ++j) { hv[j] = *(const f32x4*)(hr + 4 * j); x2[2 * j] = (f32x2){hv[j][0], hv[j][1]}; x2[2 * j + 1] = (f32x2){hv[j][2], hv[j][3]}; y2[2 * j] = (f32x2){0.f, 0.f}; y2[2 * j + 1] = (f32x2){0.f, 0.f}; }
    const int q = lane & 3;
#pragma unroll 1
    for (int k = 0; k < 64; k += 4) {
        u32x4 uu[8], vv[8]; float du[8], gv[8];
#pragma unroll
        for (int s = 0; s < 8; ++s) {
            const int kk = k + (s >> 1); const bool hh = s & 1;
            const int e = __builtin_amdgcn_readlane(hh ? iB : iA, kk);
            du[s] = __int_as_float(__builtin_amdgcn_readlane(__float_as_int(hh ? duB : duA), kk));
            gv[s] = __int_as_float(__builtin_amdgcn_readlane(__float_as_int(hh ? gvB : gvA), kk));
            uu[s] = *(const u32x4*)(U8 + (size_t)e * 1024 + 16 * lane);
            vv[s] = *(const u32x4*)(V8 + (size_t)e * 1024 + 16 * lane);
        }
#pragma unroll
        for (int g = 0; g < 2; ++g) {
            const float d0 = dot16_fp8(uu[4 * g + 0], x2), d1 = dot16_fp8(uu[4 * g + 1], x2), d2 = dot16_fp8(uu[4 * g + 2], x2), d3 = dot16_fp8(uu[4 * g + 3], x2);
            const float tot = reduce4_transpose(d0, d1, d2, d3, lane);
            const float z = tot * sel4f(du[4 * g], du[4 * g + 1], du[4 * g + 2], du[4 * g + 3], q);
            const float cf = gelu_tanh(z) * sel4f(gv[4 * g], gv[4 * g + 1], gv[4 * g + 2], gv[4 * g + 3], q);
#pragma unroll
            for (int s = 0; s < 4; ++s) { const float cs = __int_as_float(__builtin_amdgcn_readlane(__float_as_int(cf), s)); axpy16_fp8(vv[4 * g + s], cs, y2); }
        }
    }
    float sq = 0.f;
    f32x4 h2[4];
#pragma unroll
    for (int j = 0; j < 4; ++j) {
        h2[j] = hv[j] + (f32x4){y2[2 * j].x, y2[2 * j].y, y2[2 * j + 1].x, y2[2 * j + 1].y};
        *(f32x4*)(hr + 4 * j) = h2[j];
        sq += (h2[j][0] * h2[j][0] + h2[j][1] * h2[j][1]) + (h2[j][2] * h2[j][2] + h2[j][3] * h2[j][3]);
    }
    u32x4 w0, w1; w0.x = pk2(h2[0][0], h2[0][1]); w0.y = pk2(h2[0][2], h2[0][3]); w0.z = pk2(h2[1][0], h2[1][1]); w0.w = pk2(h2[1][2], h2[1][3]);
    w1.x = pk2(h2[2][0], h2[2][1]); w1.y = pk2(h2[2][2], h2[2][3]); w1.z = pk2(h2[3][0], h2[3][1]); w1.w = pk2(h2[3][2], h2[3][3]);
    u32x4* ob = (u32x4*)(h2b + (size_t)t * 1024 + 16 * lane); ob[0] = w0; ob[1] = w1;
    sq = wave_sum(sq);
    if (lane == 0) rstd3[t] = 1.0f / sqrtf(sq * (1.0f / 1024.0f) + EPS);
}

__device__ __forceinline__ unsigned umin_(unsigned a, unsigned b) { return a < b ? a : b; }
__device__ __forceinline__ unsigned umax_(unsigned a, unsigned b) { return a > b ? a : b; }
__device__ __forceinline__ void sort128(unsigned& k0, unsigned& k1, int lane) {
#pragma unroll
    for (int k = 2; k <= 128; k <<= 1) {
#pragma unroll
        for (int j = k >> 1; j >= 1; j >>= 1) {
            if (j == 64) { const unsigned mn = umin_(k0, k1), mx = umax_(k0, k1); k0 = mn; k1 = mx; }
            else {
                const unsigned o0 = (unsigned)__shfl_xor((int)k0, j), o1 = (unsigned)__shfl_xor((int)k1, j);
                const bool up0 = (k == 128) ? true : (k == 64 ? true : ((lane & k) == 0));
                const bool up1 = (k == 128) ? true : (k == 64 ? false : ((lane & k) == 0));
                const bool lower = (lane & j) == 0;
                k0 = (lower == up0) ? umin_(k0, o0) : umax_(k0, o0);
                k1 = (lower == up1) ? umin_(k1, o1) : umax_(k1, o1);
            }
        }
    }
}
typedef int i32x4v __attribute__((ext_vector_type(4)));
#ifndef NSLICE
#define NSLICE 8
#endif
#define SLICE_SHIFT (NSLICE == 32 ? 25 : (NSLICE == 16 ? 26 : (NSLICE == 8 ? 27 : (NSLICE == 4 ? 28 : 30))))
typedef unsigned u32x2 __attribute__((ext_vector_type(2)));
__device__ __forceinline__ f32x4 bf4_lo(u32x2 w) { return (f32x4){__builtin_bit_cast(float, w.x << 16), __builtin_bit_cast(float, w.x & 0xffff0000u), __builtin_bit_cast(float, w.y << 16), __builtin_bit_cast(float, w.y & 0xffff0000u)}; }
struct TokState { f32x2 y2[8]; unsigned k0, k1; int bnd; float rsx; };
__device__ __forceinline__ int count_lt(const TokState& S, unsigned bound) {
    return __builtin_popcountll(__builtin_amdgcn_ballot_w64(S.k0 < bound)) + __builtin_popcountll(__builtin_amdgcn_ballot_w64(S.k1 < bound));
}
__device__ __forceinline__ int bperm_i(int srclane, int v) { return __builtin_amdgcn_ds_bpermute(srclane << 2, v); }
__device__ __forceinline__ float bperm_f(int srclane, float v) { return __int_as_float(__builtin_amdgcn_ds_bpermute(srclane << 2, __float_as_int(v))); }
__device__ __forceinline__ void gather_batch(TokState& S, int p, int hi, int lane, const LAS unsigned char* xs, const unsigned char* __restrict__ U8, const unsigned char* __restrict__ V8, const float* __restrict__ IU, const float* __restrict__ IV) {
    const int n = (hi - p < 16) ? hi - p : 16;
    const int m = lane & 15, kq = lane >> 4;
    const int r = (m < n) ? p + m : hi - 1; const int sl = r & 63; const bool lo = r < 64;
    const unsigned ka = (unsigned)bperm_i(sl, (int)S.k0), kb = (unsigned)bperm_i(sl, (int)S.k1);
    const int es = (int)((lo ? ka : kb) >> 16);
    const unsigned key = lo ? ka : kb;
    const float dus = IU[es] * S.rsx, gvs = (m < n) ? (float)(key & 0xffffu) * (1.0f / 65535.0f) * IV[es] : 0.f;
    const unsigned char* ua = U8 + (size_t)es * 1024 + 16 * kq;
    i32x4v A[16];
#pragma unroll
    for (int s = 0; s < 16; ++s) A[s] = *(const i32x4v*)(ua + 64 * s);
    u32x4 vv[16];
#pragma unroll
    for (int q = 0; q < 8; ++q) if (q < n) { const int e = __builtin_amdgcn_readlane(es, q); vv[q] = *(const u32x4*)(V8 + (size_t)e * 1024 + 16 * lane); }
    if (n > 8) {
#pragma unroll
        for (int q = 8; q < 16; ++q) if (q < n) { const int e = __builtin_amdgcn_readlane(es, q); vv[q] = *(const u32x4*)(V8 + (size_t)e * 1024 + 16 * lane); }
    }
    i32x4v acc = (i32x4v){0, 0, 0, 0};
#pragma unroll
    for (int s = 0; s < 16; ++s) { const i32x4v B = *(const LAS i32x4v*)(xs + 64 * s + 16 * kq); acc = __builtin_amdgcn_mfma_i32_16x16x64_i8(A[s], B, acc, 0, 0, 0); }
    float cf[4];
#pragma unroll
    for (int j = 0; j < 4; ++j) { const int sm = 4 * kq + j; const float d = bperm_f(sm, dus), g = bperm_f(sm, gvs); cf[j] = g * gelu_tanh((float)acc[j] * d); }
#pragma unroll
    for (int q = 0; q < 8; ++q) if (q < n) { const float cs = __int_as_float(__builtin_amdgcn_readlane(__float_as_int(cf[q & 3]), 16 * (q >> 2))); axpy16_fp8(vv[q], cs, S.y2); }
    if (n > 8) {
#pragma unroll
        for (int q = 8; q < 16; ++q) if (q < n) { const float cs = __int_as_float(__builtin_amdgcn_readlane(__float_as_int(cf[q & 3]), 16 * (q >> 2))); axpy16_fp8(vv[q], cs, S.y2); }
    }
    __builtin_amdgcn_sched_barrier(0);
}
__device__ __forceinline__ void tok_setup(TokState& S, int t, int lane, LAS unsigned char* xs, const int* __restrict__ seli, const float* __restrict__ selg,
                                          const float* __restrict__ part2, const bf16* __restrict__ h1b) {
    float ps = (lane < 16) ? part2[(size_t)t * 16 + lane] : 0.f;
    ps = wave_sum(ps);
    const float rstd2 = 1.0f / sqrtf(ps * (1.0f / 1024.0f) + EPS);
    f32x4 hv[4]; float am = 0.f;
    { const u32x4* br = (const u32x4*)(h1b + (size_t)t * 1024 + 16 * lane); const u32x4 b0 = br[0], b1 = br[1];
      hv[0] = bf4_lo((u32x2){b0.x, b0.y}); hv[1] = bf4_lo((u32x2){b0.z, b0.w}); hv[2] = bf4_lo((u32x2){b1.x, b1.y}); hv[3] = bf4_lo((u32x2){b1.z, b1.w}); }
#pragma unroll
    for (int j = 0; j < 4; ++j) { am = fmaxf(am, fmaxf(fmaxf(fabsf(hv[j][0]), fabsf(hv[j][1])), fmaxf(fabsf(hv[j][2]), fabsf(hv[j][3])))); }
#pragma unroll
    for (int o = 1; o < 64; o <<= 1) am = fmaxf(am, __shfl_xor(am, o));
    const float sx = am > 0.f ? 127.0f / am : 1.0f, isx = am > 0.f ? am * (1.0f / 127.0f) : 1.0f;
    u32x4 xq;
#pragma unroll
    for (int j = 0; j < 4; ++j) { unsigned w = 0u;
#pragma unroll
        for (int c = 0; c < 4; ++c) w |= ((unsigned)(int)__builtin_rintf(hv[j][c] * sx) & 0xffu) << (8 * c);
        xq[j] = w; }
    *(LAS u32x4*)(xs + 16 * lane) = xq;
    const int iA = seli[(size_t)t * 128 + lane], iB = seli[(size_t)t * 128 + 64 + lane];
    const float gA = selg[(size_t)t * 128 + lane], gB = selg[(size_t)t * 128 + 64 + lane];
    S.k0 = ((unsigned)iA << 16) | (unsigned)(gA * 65535.0f + 0.5f); S.k1 = ((unsigned)iB << 16) | (unsigned)(gB * 65535.0f + 0.5f);
    sort128(S.k0, S.k1, lane);
    S.rsx = rstd2 * isx;
    int bnd = 0;
#pragma unroll
    for (int s = 1; s <= NSLICE; ++s) { const int c = count_lt(S, (unsigned)s << SLICE_SHIFT); bnd = (lane == s) ? c : bnd; }
    S.bnd = bnd;
#pragma unroll
    for (int j = 0; j < 8; ++j) S.y2[j] = (f32x2){0.f, 0.f};
}
__device__ __forceinline__ void tok_finish(const TokState& S, int t, int lane, const bf16* __restrict__ h1b, bf16* __restrict__ h2b, float* __restrict__ rstd3) {
    const u32x4* br = (const u32x4*)(h1b + (size_t)t * 1024 + 16 * lane); const u32x4 b0 = br[0], b1 = br[1];
    f32x4 h2[4]; h2[0] = bf4_lo((u32x2){b0.x, b0.y}); h2[1] = bf4_lo((u32x2){b0.z, b0.w}); h2[2] = bf4_lo((u32x2){b1.x, b1.y}); h2[3] = bf4_lo((u32x2){b1.z, b1.w});
    float sq = 0.f;
#pragma unroll
    for (int j = 0; j < 4; ++j) {
        h2[j] = h2[j] + (f32x4){S.y2[2 * j].x, S.y2[2 * j].y, S.y2[2 * j + 1].x, S.y2[2 * j + 1].y};
        sq += (h2[j][0] * h2[j][0] + h2[j][1] * h2[j][1]) + (h2[j][2] * h2[j][2] + h2[j][3] * h2[j][3]);
    }
    u32x4 w0, w1; w0.x = pk2(h2[0][0], h2[0][1]); w0.y = pk2(h2[0][2], h2[0][3]); w0.z = pk2(h2[1][0], h2[1][1]); w0.w = pk2(h2[1][2], h2[1][3]);
    w1.x = pk2(h2[2][0], h2[2][1]); w1.y = pk2(h2[2][2], h2[2][3]); w1.z = pk2(h2[3][0], h2[3][1]); w1.w = pk2(h2[3][2], h2[3][3]);
    u32x4* ob = (u32x4*)(h2b + (size_t)t * 1024 + 16 * lane); ob[0] = w0; ob[1] = w1;
    sq = wave_sum(sq);
    if (lane == 0) rstd3[t] = 1.0f / sqrtf(sq * (1.0f / 1024.0f) + EPS);
}
__device__ __forceinline__ void gather_wg_sliced(int tok0, int wave, int lane, LAS unsigned char* lds, const unsigned char* __restrict__ U8, const unsigned char* __restrict__ V8, const float* __restrict__ IU, const float* __restrict__ IV,
                                                 const int* __restrict__ seli, const float* __restrict__ selg, const float* __restrict__ part2, float* __restrict__ H, const bf16* __restrict__ h1b, bf16* __restrict__ h2b, float* __restrict__ rstd3) {
    LAS unsigned char* xs = lds + wave * 4096;
#pragma unroll 1
    for (int pass = 0; pass < 2; ++pass) {
        const int tb = tok0 + pass * 32 + wave * 4;
        TokState S0, S1, S2, S3;
        tok_setup(S0, tb + 0, fresh_lane(), xs, seli, selg, part2, h1b); __builtin_amdgcn_sched_barrier(0);
        tok_setup(S1, tb + 1, fresh_lane(), xs + 1024, seli, selg, part2, h1b); __builtin_amdgcn_sched_barrier(0);
        tok_setup(S2, tb + 2, fresh_lane(), xs + 2048, seli, selg, part2, h1b); __builtin_amdgcn_sched_barrier(0);
        tok_setup(S3, tb + 3, fresh_lane(), xs + 3072, seli, selg, part2, h1b); __builtin_amdgcn_sched_barrier(0);
        __syncthreads();
        lane = fresh_lane();
        int lo0 = 0, lo1 = 0, lo2 = 0, lo3 = 0;
#pragma unroll 1
        for (int s = 0; s < NSLICE; ++s) {
            { const int hi = __builtin_amdgcn_readlane(S0.bnd, s + 1); for (int p = lo0; p < hi; p += 16) gather_batch(S0, p, hi, lane, xs, U8, V8, IU, IV); lo0 = hi; }
            { const int hi = __builtin_amdgcn_readlane(S1.bnd, s + 1); for (int p = lo1; p < hi; p += 16) gather_batch(S1, p, hi, lane, xs + 1024, U8, V8, IU, IV); lo1 = hi; }
            { const int hi = __builtin_amdgcn_readlane(S2.bnd, s + 1); for (int p = lo2; p < hi; p += 16) gather_batch(S2, p, hi, lane, xs + 2048, U8, V8, IU, IV); lo2 = hi; }
            { const int hi = __builtin_amdgcn_readlane(S3.bnd, s + 1); for (int p = lo3; p < hi; p += 16) gather_batch(S3, p, hi, lane, xs + 3072, U8, V8, IU, IV); lo3 = hi; }
        }
        { const int fl = fresh_lane(); tok_finish(S0, tb, fl, h1b, h2b, rstd3); tok_finish(S1, tb + 1, fl, h1b, h2b, rstd3); tok_finish(S2, tb + 2, fl, h1b, h2b, rstd3); tok_finish(S3, tb + 3, fl, h1b, h2b, rstd3); }
        __syncthreads();
    }
}
namespace pg8 {
#define PG8_LAS __attribute__((address_space(3)))
typedef unsigned short bf16_t;
typedef short bf16x8 __attribute__((ext_vector_type(8)));
typedef float f32x4 __attribute__((ext_vector_type(4)));
typedef unsigned u32x4 __attribute__((ext_vector_type(4)));
constexpr int BM = 256, BK = 64, HALF = 128, HTB = HALF * BK * 2  , STAGE_BYTES = 8 * HTB, NXCD = 8, WGM = 8;

__host__ __device__ __forceinline__ int lds_byte(int r, int c) { const int st = (r >> 4) * 2 + (c >> 5), rr = r & 15, cc = c & 31, ob = rr * 64 + cc * 2; return st * 1024 + (ob ^ (((ob >> 9) & 1) << 5)); }
__host__ __device__ __forceinline__ void stage_rc(int b, int& R, int& C) { const int st = b / 1024, sb = b % 1024, swz = sb ^ (((sb >> 9) & 1) << 5); R = (st >> 1) * 16 + swz / 64; C = (st & 1) * 32 + (swz % 64) / 2; }
__host__ __device__ __forceinline__ int perm32(int rho) { const int n = rho >> 4, i = rho & 15; return 8 * (i >> 2) + 4 * n + (i & 3); }

struct Unit { int pm, pn; };
struct Gemm { const bf16_t* A; const bf16_t* Bt; int K, lda, apn_shift, apn_stride; };

struct StaticOrder {
    int nM, nN, nwg, G, c;
    __host__ __device__ void init(int M, int N, int G_, int c_) { nM = M / BM; nN = N / BM; nwg = nM * nN; G = G_; c = c_; }
    __host__ __device__ bool next(int i, Unit& u) const {
        const long L = (long)i * G + c; if (L >= nwg) return false;
        int wgid = (int)L; { const int q = nwg / NXCD, r = nwg % NXCD, xcd = wgid % NXCD, off = wgid / NXCD; wgid = (xcd < r ? xcd * (q + 1) : r * (q + 1) + (xcd - r) * q) + off; }
        const int nig = WGM * nN, gid = wgid / nig, fm = gid * WGM, gsz = (nM - fm) < WGM ? (nM - fm) : WGM;
        u.pm = fm + ((wgid % nig) % gsz); u.pn = (wgid % nig) / gsz; return true;
    }
    __device__ __forceinline__ void a_ready(const Unit&) const {}
    __device__ __forceinline__ void done(const Unit&) const {}
};

__device__ __forceinline__ unsigned cvt_pk_bf16(float lo, float hi) { unsigned r; asm volatile("v_cvt_pk_bf16_f32 %0, %1, %2" : "=v"(r) : "v"(lo), "v"(hi)); return r; }

template <class Epi, class Sched, bool ALIGN_EPI = false, bool SP2 = false>
__device__ __forceinline__ void gemm_phase(PG8_LAS unsigned char* lds, const Gemm g, const Sched& S, const Epi& E, int wave_id  ) {
    const int lane = fresh_lane(), wid = wave_id, tid = wid * 64 + lane, wr = wid >> 2, wc = wid & 3, fr = lane & 15, fq = lane >> 4;
    const int K = g.K, nt = K / BK;
    unsigned voffA[2], voffB[2];
#pragma unroll
    for (int i = 0; i < 2; ++i) { int R, C; stage_rc(tid * 16 + i * 8192, R, C); const int Rb = Epi::PERM ? ((R & ~31) + perm32(R & 31)) : R;
        voffA[i] = (unsigned)(R * g.lda + C) * 2u; voffB[i] = (unsigned)(Rb * K + C) * 2u; }
    const size_t kstep = (size_t)(BK * 2);
    const size_t hstepA = (size_t)HALF * g.lda * 2, hstepB = (size_t)HALF * K * 2;
    const size_t tstepA = 2 * hstepA, tstepB = 2 * hstepB;
    const unsigned ldsw = (unsigned)wid * 1024u;
    const int aoff = lds_byte(wr * 64 + fr, fq * 8), boff = lds_byte(wc * 32 + fr, fq * 8);
#define PG8_SA(b, h) (((b) * 2 + (h)) * HTB)
#define PG8_SB(b, h) ((4 + (b) * 2 + (h)) * HTB)
#define PG8_STAGE(bufoff, gbase, voff) do { _Pragma("unroll") for (int _i = 0; _i < 2; ++_i) \
        __builtin_amdgcn_global_load_lds((const unsigned*)((const char*)(gbase) + (voff)[_i]), (PG8_LAS unsigned*)(lds + (bufoff) + ldsw + _i * 8192), 16, 0, 0); } while (0)
#define PG8_LDA(dst, b, h) do { _Pragma("unroll") for (int m = 0; m < 4; ++m) _Pragma("unroll") for (int k = 0; k < 2; ++k) dst[m][k] = *(const PG8_LAS bf16x8*)(lds + PG8_SA(b, h) + aoff + m * 2048 + k * 1024); } while (0)
#define PG8_LDB(dst, b, h) do { _Pragma("unroll") for (int n = 0; n < 2; ++n) _Pragma("unroll") for (int k = 0; k < 2; ++k) dst[n][k] = *(const PG8_LAS bf16x8*)(lds + PG8_SB(b, h) + boff + n * 2048 + k * 1024); } while (0)
#define PG8_MMA(ai, bj, At, Bt) do { __builtin_amdgcn_s_setprio(1); _Pragma("unroll") for (int m = 0; m < 4; ++m) _Pragma("unroll") for (int n = 0; n < 2; ++n) _Pragma("unroll") for (int k = 0; k < 2; ++k) \
        acc[ai][bj][m][n] = __builtin_amdgcn_mfma_f32_16x16x32_bf16(Bt[n][k], At[m][k], acc[ai][bj][m][n], 0, 0, 0); __builtin_amdgcn_s_setprio(0); } while (0)
#define PG8_WAIT_V(n) asm volatile("s_waitcnt vmcnt(" #n ")" ::: "memory")
#define PG8_WAIT_L(n) asm volatile("s_waitcnt lgkmcnt(" #n ")" ::: "memory")
#define PG8_BAR __builtin_amdgcn_s_barrier()
#define PG8_SCHED __builtin_amdgcn_sched_barrier(0)
    Unit cur, nxt; int ui = 0;
    if (!S.next(0, cur)) return;
    f32x4 acc[2][2][4][2];
#pragma unroll
    for (int a = 0; a < 2; ++a)
#pragma unroll
        for (int b = 0; b < 2; ++b)
#pragma unroll
            for (int m = 0; m < 4; ++m)
#pragma unroll
                for (int n = 0; n < 2; ++n) acc[a][b][m][n] = (f32x4){0.f, 0.f, 0.f, 0.f};
    bf16x8 At[4][2], B0[2][2], B1[2][2];
    const char* cA = (const char*)g.A + (size_t)cur.pm * tstepA + (size_t)((cur.pn >> g.apn_shift) * g.apn_stride) * 2; const char* cB = (const char*)g.Bt + (size_t)cur.pn * tstepB;
    S.a_ready(cur);
    if constexpr (SP2) {
        PG8_STAGE(PG8_SB(0, 0), cB, voffB); PG8_STAGE(PG8_SB(0, 1), cB + hstepB, voffB); PG8_STAGE(PG8_SA(0, 0), cA, voffA); PG8_STAGE(PG8_SA(0, 1), cA + hstepA, voffA);
        if (wr == 1) PG8_BAR;
        PG8_WAIT_V(2); PG8_BAR;
        PG8_STAGE(PG8_SB(1, 0), cB + kstep, voffB); PG8_STAGE(PG8_SA(1, 0), cA + kstep, voffA); PG8_STAGE(PG8_SB(1, 1), cB + hstepB + kstep, voffB);
        PG8_WAIT_V(6); PG8_BAR;
    } else {
        PG8_STAGE(PG8_SB(0, 0), cB, voffB); PG8_STAGE(PG8_SA(0, 0), cA, voffA); PG8_STAGE(PG8_SB(0, 1), cB + hstepB, voffB); PG8_STAGE(PG8_SA(0, 1), cA + hstepA, voffA);
        if (wr == 1) PG8_BAR;
        PG8_WAIT_V(4); PG8_BAR;
        PG8_STAGE(PG8_SB(1, 0), cB + kstep, voffB); PG8_STAGE(PG8_SA(1, 0), cA + kstep, voffA); PG8_STAGE(PG8_SB(1, 1), cB + hstepB + kstep, voffB);
        PG8_WAIT_V(6); PG8_BAR;
    }
    for (;;) {
        const bool has_next = S.next(ui + 1, nxt);
        const char* nA = has_next ? (const char*)g.A + (size_t)nxt.pm * tstepA + (size_t)((nxt.pn >> g.apn_shift) * g.apn_stride) * 2 : cA; const char* nB = has_next ? (const char*)g.Bt + (size_t)nxt.pn * tstepB : cB;
#pragma unroll 1
        for (int t = 0; t < nt; t += 2) {
            const bool last = (t == nt - 2);
            const char* a1 = cA + (size_t)(t + 1) * kstep;
            const char* a2 = last ? nA : cA + (size_t)(t + 2) * kstep; const char* b2 = last ? nB : cB + (size_t)(t + 2) * kstep;
            const char* a3 = a2 + kstep; const char* b3 = b2 + kstep;
            if (last && has_next) S.a_ready(nxt);
            if constexpr (SP2) {
            PG8_LDB(B0, 0, 0); PG8_LDB(B1, 0, 1); PG8_SCHED; PG8_LDA(At, 0, 0); PG8_STAGE(PG8_SA(1, 1), a1 + hstepA, voffA);
            PG8_WAIT_V(8); PG8_WAIT_L(0); PG8_BAR; PG8_MMA(0, 0, At, B0); PG8_MMA(0, 1, At, B1); PG8_BAR; PG8_SCHED;
            PG8_LDA(At, 0, 1); PG8_STAGE(PG8_SB(0, 0), b2, voffB); PG8_STAGE(PG8_SB(0, 1), b2 + hstepB, voffB); PG8_STAGE(PG8_SA(0, 0), a2, voffA);
            PG8_WAIT_V(8); PG8_WAIT_L(0); PG8_BAR; PG8_MMA(1, 0, At, B0); PG8_MMA(1, 1, At, B1); PG8_BAR; PG8_SCHED;
            PG8_LDB(B0, 1, 0); PG8_LDB(B1, 1, 1); PG8_SCHED; PG8_LDA(At, 1, 0); PG8_STAGE(PG8_SA(0, 1), a2 + hstepA, voffA);
            PG8_WAIT_V(8); PG8_WAIT_L(0); PG8_BAR; PG8_MMA(0, 0, At, B0); PG8_MMA(0, 1, At, B1); PG8_BAR; PG8_SCHED;
            PG8_LDA(At, 1, 1); PG8_STAGE(PG8_SB(1, 0), b3, voffB); PG8_STAGE(PG8_SB(1, 1), b3 + hstepB, voffB); PG8_STAGE(PG8_SA(1, 0), a3, voffA);
            PG8_WAIT_V(8); PG8_WAIT_L(0); PG8_BAR; PG8_MMA(1, 0, At, B0); PG8_MMA(1, 1, At, B1); PG8_BAR; PG8_SCHED;
            } else {
            PG8_LDB(B0, 0, 0); PG8_SCHED; PG8_LDA(At, 0, 0); PG8_STAGE(PG8_SA(1, 1), a1 + hstepA, voffA);
            PG8_WAIT_L(8); PG8_BAR; PG8_WAIT_L(0); PG8_MMA(0, 0, At, B0); PG8_BAR; PG8_SCHED;
            PG8_LDB(B1, 0, 1); PG8_STAGE(PG8_SB(0, 0), b2, voffB);
            PG8_BAR; PG8_WAIT_L(0); PG8_MMA(0, 1, At, B1); PG8_BAR;
            PG8_LDA(At, 0, 1); PG8_STAGE(PG8_SA(0, 0), a2, voffA);
            PG8_BAR; PG8_WAIT_L(0); PG8_MMA(1, 0, At, B0); PG8_BAR; PG8_SCHED;
            PG8_STAGE(PG8_SB(0, 1), b2 + hstepB, voffB);
            PG8_WAIT_V(6); PG8_BAR; PG8_MMA(1, 1, At, B1); PG8_BAR;
            PG8_LDB(B0, 1, 0); PG8_SCHED; PG8_LDA(At, 1, 0); PG8_STAGE(PG8_SA(0, 1), a2 + hstepA, voffA);
            PG8_WAIT_L(8); PG8_BAR; PG8_WAIT_L(0); PG8_MMA(0, 0, At, B0); PG8_BAR; PG8_SCHED;
            PG8_LDB(B1, 1, 1); PG8_STAGE(PG8_SB(1, 0), b3, voffB);
            PG8_BAR; PG8_WAIT_L(0); PG8_MMA(0, 1, At, B1); PG8_BAR;
            PG8_LDA(At, 1, 1); PG8_STAGE(PG8_SA(1, 0), a3, voffA);
            PG8_BAR; PG8_WAIT_L(0); PG8_MMA(1, 0, At, B0); PG8_BAR; PG8_SCHED;
            PG8_STAGE(PG8_SB(1, 1), b3 + hstepB, voffB);
            PG8_WAIT_V(6); PG8_BAR; PG8_MMA(1, 1, At, B1); PG8_BAR;
            }
        }
        if constexpr (ALIGN_EPI) { if (wr == 0) PG8_BAR; }
        if constexpr (!Epi::AFTER_DRAIN) { E(acc, cur, wr, wc, fr, fq); S.done(cur); }
        if (!has_next) break;
#pragma unroll
        for (int a = 0; a < 2; ++a)
#pragma unroll
            for (int b = 0; b < 2; ++b)
#pragma unroll
                for (int m = 0; m < 4; ++m)
#pragma unroll
                    for (int n = 0; n < 2; ++n) acc[a][b][m][n] = (f32x4){0.f, 0.f, 0.f, 0.f};
        cur = nxt; cA = nA; cB = nB; ++ui;
        if constexpr (ALIGN_EPI) { if (wr == 1) PG8_BAR; }
    }
    PG8_WAIT_V(0);
    if constexpr (!ALIGN_EPI) { if (wr == 0) PG8_BAR; }
    PG8_BAR;
    if constexpr (Epi::AFTER_DRAIN) { E.fused(acc, cur, wr, wc, fr, fq, lds, wid, lane); S.done(cur); }
#undef PG8_SA
#undef PG8_SB
#undef PG8_STAGE
#undef PG8_LDA
#undef PG8_LDB
#undef PG8_MMA
#undef PG8_WAIT_V
#undef PG8_WAIT_L
#undef PG8_BAR
#undef PG8_SCHED
}
}
#define GAS __attribute__((address_space(1)))
typedef GAS unsigned gu32;
#define RLX_AGENT __ATOMIC_RELAXED, __HIP_MEMORY_SCOPE_AGENT
#define LDS_WAIT() asm volatile("s_waitcnt lgkmcnt(0)" ::: "memory")
#define VM_WAIT() asm volatile("s_waitcnt vmcnt(0)" ::: "memory")
#define XB_TMO      128
#define XB_XCNT(j)  (256  + 64 * (j))
#define XB_XSUB(j)  (1280 + 64 * (j))
#define XB_XGEN(j)  (2304 + 64 * (j))
#define XB_TOP      3328
#define XB_TOPGEN   3392
#define XCD_BAR_WORDS 3456
#define XB_SPIN_CAP (1u << 18)

__device__ __forceinline__ unsigned xb_ld(unsigned* p)              { return __hip_atomic_load(p, __ATOMIC_RELAXED, __HIP_MEMORY_SCOPE_AGENT); }
__device__ __forceinline__ unsigned xb_add(unsigned* p, unsigned v) { return __hip_atomic_fetch_add(p, v, __ATOMIC_RELAXED, __HIP_MEMORY_SCOPE_AGENT); }
__device__ __forceinline__ unsigned xb_xcc_id() { return (unsigned)__builtin_amdgcn_s_getreg((3 << 11) | 20) & 0xFu; }
#define XB_SPIN(cond, bar) do { unsigned _sp = 0; while (cond) { __builtin_amdgcn_s_sleep(1); \
    if ((++_sp & 255u) == 0u) { if (xb_ld(&(bar)[XB_TMO])) break; if (_sp > XB_SPIN_CAP) { atomicAdd(&(bar)[XB_TMO], 1u); break; } } } } while (0)

struct XcdBarrier {
    unsigned* bar; unsigned x;
    volatile LAS unsigned* st;
};

__device__ __forceinline__ XcdBarrier xcd_barrier_post(unsigned* bar, volatile LAS unsigned* st) {
    XcdBarrier b; b.bar = bar; b.x = xb_xcc_id(); b.st = st;
    if (threadIdx.x == 0) (void)xb_add(&bar[XB_XCNT(b.x)], 1u);
    return b;
}
__device__ __forceinline__ void xcd_barrier_complete(unsigned* bar, unsigned x, unsigned& nloc, unsigned& nx) {
    const unsigned G = gridDim.x * gridDim.y * gridDim.z;
    unsigned sum, cnt, mine, sp = 0u;
    for (;;) {
        sum = 0u; cnt = 0u; mine = 0u;
#pragma unroll
        for (unsigned j = 0; j < 16; ++j) { const unsigned c = xb_ld(&bar[XB_XCNT(j)]); sum += c; cnt += (c > 0u) ? 1u : 0u; mine = (j == x) ? c : mine; }
        if (sum == G) break;
        __builtin_amdgcn_s_sleep(1);
        if ((++sp & 255u) == 0u) { if (xb_ld(&bar[XB_TMO])) break; if (sp > XB_SPIN_CAP) { atomicAdd(&bar[XB_TMO], 1u); break; } }
    }
    nloc = mine > 0u ? mine : 1u; nx = cnt > 0u ? cnt : 1u;
}

__device__ __forceinline__ void xcd_barrier(const XcdBarrier& b) {
    asm volatile("s_waitcnt vmcnt(0)" ::: "memory");
    __syncthreads();
    if (threadIdx.x == 0) {
        unsigned* bar = b.bar;
        __builtin_amdgcn_s_waitcnt(0);
        unsigned nloc = b.st[0], nx = b.st[1];
        if (nloc == 0u) { xcd_barrier_complete(bar, b.x, nloc, nx); b.st[0] = nloc; b.st[1] = nx; }
        const unsigned old = xb_add(&bar[XB_XSUB(b.x)], 1u);
        const unsigned gen = old / nloc;
        if (old + 1u == (gen + 1u) * nloc) {
            __builtin_amdgcn_fence(__ATOMIC_RELEASE, "agent");
            asm volatile("s_waitcnt vmcnt(0)" ::: "memory");
            const unsigned og = xb_add(&bar[XB_TOP], 1u);
            const unsigned tg = og / nx;
            if (og + 1u == (tg + 1u) * nx) xb_add(&bar[XB_TOPGEN], 1u);
            else XB_SPIN(xb_ld(&bar[XB_TOPGEN]) == tg, bar);
            __builtin_amdgcn_fence(__ATOMIC_ACQUIRE, "agent");
            xb_add(&bar[XB_XGEN(b.x)], 1u);
            asm volatile("s_waitcnt vmcnt(0)" ::: "memory");
        } else {
            XB_SPIN(xb_ld(&bar[XB_XGEN(b.x)]) == gen, bar);
            __builtin_amdgcn_fence(__ATOMIC_ACQUIRE, "agent");
            asm volatile("s_waitcnt vmcnt(0)" ::: "memory");
        }
    }
    __syncthreads();
}

constexpr int NWAVES = 8;
constexpr int LDS_MAIN = 135168;
constexpr int LDSCTL_OFF = LDS_MAIN;
constexpr int LDS_BYTES = 147456;
constexpr int CW_BAR = 4096;
constexpr size_t CTL_ZERO_BYTES = 1 * MiB;
constexpr float LOG2E = 1.4426950408889634f;
typedef short bf16x8 __attribute__((ext_vector_type(8)));
typedef float f32x16 __attribute__((ext_vector_type(16)));
typedef unsigned u32x2 __attribute__((ext_vector_type(2)));
using pg8::Unit;
using pg8::cvt_pk_bf16;

__device__ __forceinline__ f32x4 sig4(f32x4 v) { return (f32x4){sigmoidf_(v[0]), sigmoidf_(v[1]), sigmoidf_(v[2]), sigmoidf_(v[3])}; }
__device__ __forceinline__ f32x4 gelu4(f32x4 v) { return (f32x4){gelu_tanh(v[0]), gelu_tanh(v[1]), gelu_tanh(v[2]), gelu_tanh(v[3])}; }
__device__ __forceinline__ u32x4 pack8(f32x4 a, f32x4 b) { u32x4 w; w.x = cvt_pk_bf16(a[0], a[1]); w.y = cvt_pk_bf16(a[2], a[3]); w.z = cvt_pk_bf16(b[0], b[1]); w.w = cvt_pk_bf16(b[2], b[3]); return w; }

struct OneUnit { pg8::StaticOrder S; int k;
    __device__ __forceinline__ bool next(int i, Unit& u) const { return i == 0 && S.next(k, u); }
    __device__ __forceinline__ void a_ready(const Unit&) const {}
    __device__ __forceinline__ void done(const Unit&) const {} };
struct EpiProj {
    static constexpr bool PERM = true, AFTER_DRAIN = false;
    const float* rstd; unsigned char* ws;
    __device__ __forceinline__ void operator()(const f32x4 (&acc)[2][2][4][2], const Unit& u, int wr, int wc, int fr, int fq) const {
        { const int t_ = fresh_lane(); fr = t_ & 15; fq = t_ >> 4; }
        const int pn = u.pn; bf16* base; int ldc, coff, act;
        if (pn < 3) { base = (bf16*)(ws + WS_QKV); ldc = 768; coff = pn * 256; act = 0; }
        else if (pn < 7) { base = (bf16*)(ws + WS_LX); ldc = 1024; coff = (pn - 3) * 256; act = 0; }
        else if (pn < 11) { base = (bf16*)(ws + WS_GL); ldc = 1024; coff = (pn - 7) * 256; act = 1; }
        else if (pn < 15) { base = (bf16*)(ws + WS_SGA); ldc = 1024; coff = (pn - 11) * 256; act = 2; }
        else { base = (bf16*)(ws + WS_SGL); ldc = 1024; coff = (pn - 15) * 256; act = 2; }
        const int row0 = u.pm * 256 + wr * 64 + fr, col0 = coff + wc * 32 + 8 * fq;
#pragma unroll
        for (int ai = 0; ai < 2; ++ai)
#pragma unroll
            for (int m = 0; m < 4; ++m) {
                const int r = row0 + ai * 128 + m * 16; const float rs = rstd[r]; bf16* rowp = base + (size_t)r * ldc + col0;
#pragma unroll
                for (int bj = 0; bj < 2; ++bj) {
                    f32x4 v0 = acc[ai][bj][m][0] * rs, v1 = acc[ai][bj][m][1] * rs;
                    if (act == 1) { v0 = gelu4(v0); v1 = gelu4(v1); } else if (act == 2) { v0 = sig4(v0); v1 = sig4(v1); }
                    *(u32x4*)(rowp + bj * 128) = pack8(v0, v1);
                }
            }
    }
};
struct EpiMP {
    static constexpr bool PERM = false, AFTER_DRAIN = false;
    const bf16* sga; float* mp;
    __device__ __forceinline__ void operator()(const f32x4 (&acc)[2][2][4][2], const Unit& u, int wr, int wc, int fr, int fq) const {
        { const int t_ = fresh_lane(); fr = t_ & 15; fq = t_ >> 4; }
        const int row0 = u.pm * 256 + wr * 64 + fr, col0 = u.pn * 256 + wc * 32 + 4 * fq;
#pragma unroll
        for (int ai = 0; ai < 2; ++ai)
#pragma unroll
            for (int m = 0; m < 4; ++m) {
                const size_t off = (size_t)(row0 + ai * 128 + m * 16) * 1024 + col0;
#pragma unroll
                for (int bj = 0; bj < 2; ++bj)
#pragma unroll
                    for (int n = 0; n < 2; ++n) { const size_t o = off + bj * 128 + n * 16; const f32x4 g = bf4_lo(*(const u32x2*)(sga + o)); const f32x4 v = acc[ai][bj][m][n] * g;
#if ALL_FUSED
                        u32x2 w; w.x = cvt_pk_bf16(v[0], v[1]); w.y = cvt_pk_bf16(v[2], v[3]); *(u32x2*)((bf16*)mp + o) = w;
#else
                        *(f32x4*)(mp + o) = v;
#endif
                    }
            }
    }
};
struct EpiMerged {
    static constexpr bool PERM = true, AFTER_DRAIN = false;
    const bf16* sgl; const float* mp; bf16* merged;
    __device__ __forceinline__ void operator()(const f32x4 (&acc)[2][2][4][2], const Unit& u, int wr, int wc, int fr, int fq) const {
        { const int t_ = fresh_lane(); fr = t_ & 15; fq = t_ >> 4; }
        const int row0 = u.pm * 256 + wr * 64 + fr, col0 = u.pn * 256 + wc * 32 + 8 * fq;
#pragma unroll
        for (int ai = 0; ai < 2; ++ai)
#pragma unroll
            for (int m = 0; m < 4; ++m) {
                const size_t off = (size_t)(row0 + ai * 128 + m * 16) * 1024 + col0;
#pragma unroll
                for (int bj = 0; bj < 2; ++bj) {
                    const size_t o = off + bj * 128; const u32x4 gw = *(const u32x4*)(sgl + o);
#if ALL_FUSED
                    const u32x4 mw = *(const u32x4*)((const bf16*)mp + o); const f32x4 m0 = bf4_lo((u32x2){mw.x, mw.y}), m1 = bf4_lo((u32x2){mw.z, mw.w});
#else
                    const f32x4 m0 = *(const f32x4*)(mp + o), m1 = *(const f32x4*)(mp + o + 4);
#endif
                    const f32x4 v0 = m0 + acc[ai][bj][m][0] * bf4_lo((u32x2){gw.x, gw.y}), v1 = m1 + acc[ai][bj][m][1] * bf4_lo((u32x2){gw.z, gw.w});
                    *(u32x4*)(merged + o) = pack8(v0, v1);
                }
            }
    }
};
struct EpiH1 {
    static constexpr bool PERM = true, AFTER_DRAIN = false;
    const float* x; float* h1; bf16* h1b; float* part;
    __device__ __forceinline__ void operator()(const f32x4 (&acc)[2][2][4][2], const Unit& u, int wr, int wc, int fr, int fq) const {
        { const int t_ = fresh_lane(); fr = t_ & 15; fq = t_ >> 4; }
        const int row0 = u.pm * 256 + wr * 64 + fr, col0 = u.pn * 256 + wc * 32 + 8 * fq;
#pragma unroll
        for (int ai = 0; ai < 2; ++ai)
#pragma unroll
            for (int m = 0; m < 4; ++m) {
                const int r = row0 + ai * 128 + m * 16; const size_t off = (size_t)r * 1024 + col0; float sq = 0.f;
#pragma unroll
                for (int bj = 0; bj < 2; ++bj) {
                    const size_t o = off + bj * 128;
                    const f32x4 v0 = *(const f32x4*)(x + o) + acc[ai][bj][m][0], v1 = *(const f32x4*)(x + o + 4) + acc[ai][bj][m][1];
#if !ALL_FUSED
                    *(f32x4*)(h1 + o) = v0; *(f32x4*)(h1 + o + 4) = v1;
#endif
                    *(u32x4*)(h1b + o) = pack8(v0, v1);
                    sq += (v0[0] * v0[0] + v0[1] * v0[1]) + (v0[2] * v0[2] + v0[3] * v0[3]) + (v1[0] * v1[0] + v1[1] * v1[1]) + (v1[2] * v1[2] + v1[3] * v1[3]);
                }
                sq += __shfl_xor(sq, 16); sq += __shfl_xor(sq, 32);
                if (fq == 0) part[(size_t)r * 16 + u.pn * 4 + wc] = sq;
            }
    }
};
struct EpiScore {
    static constexpr bool PERM = false, AFTER_DRAIN = false;
    const float* part; float* sc;
    __device__ __forceinline__ void operator()(const f32x4 (&acc)[2][2][4][2], const Unit& u, int wr, int wc, int fr, int fq) const {
        { const int t_ = fresh_lane(); fr = t_ & 15; fq = t_ >> 4; }
        const int row0 = u.pm * 256 + wr * 64 + fr, col0 = u.pn * 256 + wc * 32 + 4 * fq;
#pragma unroll
        for (int ai = 0; ai < 2; ++ai)
#pragma unroll
            for (int m = 0; m < 4; ++m) {
                const int r = row0 + ai * 128 + m * 16; const f32x4* pp = (const f32x4*)(part + (size_t)r * 16);
                const f32x4 s4 = (pp[0] + pp[1]) + (pp[2] + pp[3]); const float rs = 1.0f / sqrtf(((s4[0] + s4[1]) + (s4[2] + s4[3])) * (1.0f / 1024.0f) + EPS);
                const size_t off = (size_t)r * 1024 + col0;
#pragma unroll
                for (int bj = 0; bj < 2; ++bj)
#pragma unroll
                    for (int n = 0; n < 2; ++n) *(f32x4*)(sc + off + bj * 128 + n * 16) = acc[ai][bj][m][n] * rs;
            }
    }
};
struct EpiTopk {
    static constexpr bool PERM = false, AFTER_DRAIN = true;
    const float* part; int* seli; float* selg;
    __device__ __forceinline__ void fused(f32x4 (&acc)[2][2][4][2], const Unit& u, int wr, int wc, int fr, int fq, PG8_LAS unsigned char* lds, int wid, int lane) const {
        LAS float* L = (LAS float*)lds;
#pragma unroll
        for (int ai = 0; ai < 2; ++ai) {
            { const int t_ = fresh_lane(); fr = t_ & 15; fq = t_ >> 4; }
#pragma unroll
            for (int m = 0; m < 4; ++m) {
                const int rl = wr * 64 + m * 16 + fr, r = u.pm * 256 + ai * 128 + rl;
                const f32x4* pp = (const f32x4*)(part + (size_t)r * 16);
                const f32x4 s4 = (pp[0] + pp[1]) + (pp[2] + pp[3]); const float rs = 1.0f / sqrtf(((s4[0] + s4[1]) + (s4[2] + s4[3])) * (1.0f / 1024.0f) + EPS);
#pragma unroll
                for (int bj = 0; bj < 2; ++bj)
#pragma unroll
                    for (int n = 0; n < 2; ++n) *(LAS f32x4*)(L + (rl * 2 + bj) * TK_LSTRIDE + wc * 32 + 16 * n + 4 * fq) = acc[ai][bj][m][n] * rs;
            }
            asm volatile("s_waitcnt lgkmcnt(0)" ::: "memory"); __builtin_amdgcn_s_barrier(); asm volatile("" ::: "memory");
            const int tid = wid * 64 + fresh_lane();
            if (wid < 4) {
                const LAS float* my = L + tid * TK_LSTRIDE;
                unsigned a16[16];
#pragma unroll
                for (int g = 0; g < 8; ++g) {
                    unsigned t[16];
#pragma unroll
                    for (int q = 0; q < 4; ++q) {
                        const f32x4 v = *(const LAS f32x4*)(my + g * 16 + q * 4);
#pragma unroll
                        for (int c = 0; c < 4; ++c) { const int e = g * 16 + q * 4 + c; const float vc = v[c]; t[q * 4 + c] = (tk_f2key(vc) & ~127u) | (unsigned)(127 - e); }
                    }
                    tk_sort16(t);
                    if (g == 0) {
#pragma unroll
                        for (int i = 0; i < 16; ++i) a16[i] = t[i];
                    } else tk_merge16(a16, t);
                }
                unsigned oth[16];
#pragma unroll
                for (int i = 0; i < 16; ++i) oth[i] = (unsigned)__shfl_xor((int)a16[i], 1);
                if ((tid & 1) == 0) {
                    const int tok = u.pm * 256 + ai * 128 + (tid >> 1);
                    tk_combine_store(a16, oth, seli + (size_t)tok * 128 + u.pn * 16, selg + (size_t)tok * 128 + u.pn * 16);
                }
            }
            asm volatile("s_waitcnt lgkmcnt(0)" ::: "memory"); __builtin_amdgcn_s_barrier(); asm volatile("" ::: "memory");
        }
    }
};
struct EpiPP {
    static constexpr bool PERM = true, AFTER_DRAIN = false;
    bf16* pp;
    __device__ __forceinline__ void operator()(const f32x4 (&acc)[2][2][4][2], const Unit& u, int wr, int wc, int fr, int fq) const {
        { const int t_ = fresh_lane(); fr = t_ & 15; fq = t_ >> 4; }
        const int row0 = u.pm * 256 + wr * 64 + fr, col0 = u.pn * 256 + wc * 32 + 8 * fq;
#pragma unroll
        for (int ai = 0; ai < 2; ++ai)
#pragma unroll
            for (int m = 0; m < 4; ++m) {
                const size_t off = (size_t)(row0 + ai * 128 + m * 16) * 1024 + col0;
#pragma unroll
                for (int bj = 0; bj < 2; ++bj) *(u32x4*)(pp + off + bj * 128) = pack8(acc[ai][bj][m][0], acc[ai][bj][m][1]);
            }
    }
};
struct EpiH3 {
    static constexpr bool PERM = true, AFTER_DRAIN = false;
    const float* rstd3; const bf16* pp; float* h; float* part; const bf16* h2b; bf16* h3b;
    __device__ __forceinline__ void operator()(const f32x4 (&acc)[2][2][4][2], const Unit& u, int wr, int wc, int fr, int fq) const {
        { const int t_ = fresh_lane(); fr = t_ & 15; fq = t_ >> 4; }
        const int row0 = u.pm * 256 + wr * 64 + fr, col0 = u.pn * 256 + wc * 32 + 8 * fq;
#pragma unroll
        for (int ai = 0; ai < 2; ++ai)
#pragma unroll
            for (int m = 0; m < 4; ++m) {
                const int r = row0 + ai * 128 + m * 16; const size_t off = (size_t)r * 1024 + col0; const float rs = rstd3[r]; float sq = 0.f;
#pragma unroll
                for (int bj = 0; bj < 2; ++bj) {
                    const size_t o = off + bj * 128; const u32x4 pw = *(const u32x4*)(pp + o);
#if ALL_FUSED
                    const u32x4 hw = *(const u32x4*)(h2b + o);
                    const f32x4 v0 = bf4_lo((u32x2){hw.x, hw.y}) + sig4(acc[ai][bj][m][0] * rs) * bf4_lo((u32x2){pw.x, pw.y});
                    const f32x4 v1 = bf4_lo((u32x2){hw.z, hw.w}) + sig4(acc[ai][bj][m][1] * rs) * bf4_lo((u32x2){pw.z, pw.w});
                    *(u32x4*)(h3b + o) = pack8(v0, v1);
#else
                    const f32x4 v0 = *(const f32x4*)(h + o) + sig4(acc[ai][bj][m][0] * rs) * bf4_lo((u32x2){pw.x, pw.y});
                    const f32x4 v1 = *(const f32x4*)(h + o + 4) + sig4(acc[ai][bj][m][1] * rs) * bf4_lo((u32x2){pw.z, pw.w});
                    *(f32x4*)(h + o) = v0; *(f32x4*)(h + o + 4) = v1;
#endif
                    sq += (v0[0] * v0[0] + v0[1] * v0[1]) + (v0[2] * v0[2] + v0[3] * v0[3]) + (v1[0] * v1[0] + v1[1] * v1[1]) + (v1[2] * v1[2] + v1[3] * v1[3]);
                }
                sq += __shfl_xor(sq, 16); sq += __shfl_xor(sq, 32);
                if (fq == 0) part[(size_t)r * 16 + u.pn * 4 + wc] = sq;
            }
    }
};
struct EpiPre {
    static constexpr bool PERM = false, AFTER_DRAIN = false;
    float* rp; float* ip;
    __device__ __forceinline__ void operator()(const f32x4 (&acc)[2][2][4][2], const Unit& u, int wr, int wc, int fr, int fq) const {
        { const int t_ = fresh_lane(); fr = t_ & 15; fq = t_ >> 4; }
#pragma unroll
        for (int n = 0; n < 2; ++n) { const int ch = u.pn * 128 + wc * 32 + 16 * n + 4 * fq;
#pragma unroll
            for (int ai = 0; ai < 2; ++ai)
#pragma unroll
                for (int m = 0; m < 4; ++m) { const int r = u.pm * 256 + ai * 128 + wr * 64 + m * 16 + fr; const size_t o = (size_t)r * 1024 + ch; *(f32x4*)(rp + o) = acc[ai][0][m][n]; *(f32x4*)(ip + o) = acc[ai][1][m][n]; } }
    }
};
struct EpiH3Final {
    static constexpr bool PERM = true, AFTER_DRAIN = false;
    const float* rstd3; const bf16* pp; const bf16* h2b; const float* fg; float* out; float* part; unsigned* cnt;
    __device__ __forceinline__ void operator()(f32x4 (&acc)[2][2][4][2], const Unit& u, int wr, int wc, int fr, int fq) const {
        { const int t_ = fresh_lane(); fr = t_ & 15; fq = t_ >> 4; }
        const int row0 = u.pm * 256 + wr * 64 + fr, col0 = u.pn * 256 + wc * 32 + 8 * fq;
#pragma unroll
        for (int ai = 0; ai < 2; ++ai)
#pragma unroll
            for (int m = 0; m < 4; ++m) {
                const int r = row0 + ai * 128 + m * 16; const size_t off = (size_t)r * 1024 + col0; const float rs = rstd3[r]; float sq = 0.f;
#pragma unroll
                for (int bj = 0; bj < 2; ++bj) {
                    const size_t o = off + bj * 128; const u32x4 pw = *(const u32x4*)(pp + o); const u32x4 hw = *(const u32x4*)(h2b + o);
                    const f32x4 v0 = bf4_lo((u32x2){hw.x, hw.y}) + sig4(acc[ai][bj][m][0] * rs) * bf4_lo((u32x2){pw.x, pw.y});
                    const f32x4 v1 = bf4_lo((u32x2){hw.z, hw.w}) + sig4(acc[ai][bj][m][1] * rs) * bf4_lo((u32x2){pw.z, pw.w});
                    acc[ai][bj][m][0] = v0; acc[ai][bj][m][1] = v1;
                    sq += (v0[0] * v0[0] + v0[1] * v0[1]) + (v0[2] * v0[2] + v0[3] * v0[3]) + (v1[0] * v1[0] + v1[1] * v1[1]) + (v1[2] * v1[2] + v1[3] * v1[3]);
                }
                sq += __shfl_xor(sq, 16); sq += __shfl_xor(sq, 32);
                if (fq == 0) __hip_atomic_store(part + (size_t)r * 16 + u.pn * 4 + wc, sq, __ATOMIC_RELAXED, __HIP_MEMORY_SCOPE_AGENT);
            }
        asm volatile("s_waitcnt vmcnt(0)" ::: "memory");
        const int lane = fq * 16 + fr;
        unsigned* c = cnt + 64 * u.pm;
        if (lane == 0) __hip_atomic_fetch_add(c, 1u, __ATOMIC_RELAXED, __HIP_MEMORY_SCOPE_AGENT);
        {
            const unsigned long long t0 = __builtin_amdgcn_s_memrealtime();
            while ((unsigned)__builtin_amdgcn_readfirstlane((int)__hip_atomic_load(c, __ATOMIC_RELAXED, __HIP_MEMORY_SCOPE_AGENT)) < 32u) {
                if (__builtin_amdgcn_s_memrealtime() - t0 > 2000000ull) break;
                __builtin_amdgcn_s_sleep(2);
            }
        }
        { const int t_ = fresh_lane(); fr = t_ & 15; fq = t_ >> 4; }
#pragma unroll
        for (int ai = 0; ai < 2; ++ai)
#pragma unroll
            for (int m = 0; m < 4; ++m) {
                const int r = u.pm * 256 + wr * 64 + fr + ai * 128 + m * 16;
                float ps = 0.f;
#pragma unroll
                for (int k = 0; k < 16; ++k) ps += __hip_atomic_load(part + (size_t)r * 16 + k, __ATOMIC_RELAXED, __HIP_MEMORY_SCOPE_AGENT);
                const float rr = 1.0f / sqrtf(ps * (1.0f / 1024.0f) + EPS);
                const int cc = u.pn * 256 + wc * 32 + 8 * fq;
#pragma unroll
                for (int bj = 0; bj < 2; ++bj) {
                    const f32x4 g0 = *(const f32x4*)(fg + cc + bj * 128), g1 = *(const f32x4*)(fg + cc + bj * 128 + 4);
                    float* op = out + (size_t)r * 1024 + cc + bj * 128;
                    *(f32x4*)op = acc[ai][bj][m][0] * rr * g0; *(f32x4*)(op + 4) = acc[ai][bj][m][1] * rr * g1;
                }
            }
    }
};
template <int CTRL> __device__ __forceinline__ float dpp_f(float oldv, float src) {
    return __builtin_bit_cast(float, __builtin_amdgcn_update_dpp(__builtin_bit_cast(int, oldv), __builtin_bit_cast(int, src), CTRL, 0xf, 0xf, false));
}
#ifndef LRU_T2
#define LRU_T2 0
#endif
struct EpiLru {
    static constexpr bool PERM = false, AFTER_DRAIN = false;
    const bf16* lin; const float* ba; const float* bx; const float* c8l; bf16* hloc; bf16* pcum; float* agg;
    template <int SH> static __device__ __forceinline__ void step(f32x4& A, f32x4& Bv, float idd) {
#pragma unroll
        for (int j = 0; j < 4; ++j) {
            const float ap = __int_as_float(__builtin_amdgcn_update_dpp(0, __float_as_int((float)A[j]), 0x110 + SH, 0xf, 0xf, true)) + idd;
            const float bp = __int_as_float(__builtin_amdgcn_update_dpp(0, __float_as_int((float)Bv[j]), 0x110 + SH, 0xf, 0xf, true));
            Bv[j] = fmaf(A[j], bp, Bv[j]); A[j] = A[j] * ap; }
    }
    __device__ __forceinline__ void operator()(f32x4 (&acc)[2][2][4][2], const Unit& u, int wr, int wc, int fr, int fq) const {
        { const int t_ = fresh_lane(); fr = t_ & 15; fq = t_ >> 4; }
        const int lane = fq * 16 + fr;
#pragma unroll
        for (int n = 0; n < 2; ++n) {
            const int ch = u.pn * 128 + wc * 32 + 16 * n + 4 * fq;
            const f32x4 bav = *(const f32x4*)(ba + ch), bxv = *(const f32x4*)(bx + ch), cv = *(const f32x4*)(c8l + ch);
#pragma unroll
            for (int ai = 0; ai < 2; ++ai)
#pragma unroll
                for (int m = 0; m < 4; ++m) {
                    const int r = u.pm * 256 + ai * 128 + wr * 64 + m * 16 + fr; const unsigned o = (unsigned)r * 1024u + (unsigned)ch;
                    const f32x4 lv = bf4_lo(*(const u32x2*)(lin + o));
#pragma unroll
                    for (int j = 0; j < 4; ++j) {
                        const float rr = sigmoidf_(acc[ai][0][m][n][j] + bav[j]), ii = sigmoidf_(acc[ai][1][m][n][j] + bxv[j]);
                        const float a = __builtin_amdgcn_exp2f(cv[j] * rr);
                        acc[ai][0][m][n][j] = a; acc[ai][1][m][n][j] = __builtin_amdgcn_sqrtf(fmaxf(1.0f - a * a, 0.f)) * (ii * lv[j]);
                    }
                    asm volatile("" : "+v"(acc[ai][0][m][n]), "+v"(acc[ai][1][m][n]));
                }
        }
#if defined(LRU_DEBUG) && LRU_DEBUG == 1
        {
            float* af = (float*)hloc; float* bf = (float*)pcum;
#pragma unroll
            for (int n = 0; n < 2; ++n) { const int ch = u.pn * 128 + wc * 32 + 16 * n + 4 * fq;
#pragma unroll
                for (int ai = 0; ai < 2; ++ai)
#pragma unroll
                    for (int m = 0; m < 4; ++m) { const int r = u.pm * 256 + ai * 128 + wr * 64 + m * 16 + fr; const size_t o = (size_t)r * 1024 + ch; *(f32x4*)(af + o) = acc[ai][0][m][n]; *(f32x4*)(bf + o) = acc[ai][1][m][n]; } }
            return;
        }
#endif
        __builtin_amdgcn_sched_barrier(0);
        const float id1 = fr < 1 ? 1.f : 0.f, id2 = fr < 2 ? 1.f : 0.f, id4 = fr < 4 ? 1.f : 0.f, id8 = fr < 8 ? 1.f : 0.f;
#pragma unroll
        for (int ai = 0; ai < 2; ++ai)
#pragma unroll
            for (int m = 0; m < 4; ++m)
#pragma unroll
                for (int n = 0; n < 2; ++n) { step<1>(acc[ai][0][m][n], acc[ai][1][m][n], id1); step<2>(acc[ai][0][m][n], acc[ai][1][m][n], id2); step<4>(acc[ai][0][m][n], acc[ai][1][m][n], id4); step<8>(acc[ai][0][m][n], acc[ai][1][m][n], id8);
                    asm volatile("" : "+v"(acc[ai][0][m][n]), "+v"(acc[ai][1][m][n])); }
        { const int t_ = fresh_lane(); fr = t_ & 15; fq = t_ >> 4; }
        const int src4 = (((fq * 16 + fr) & 48) | 15) * 4;
#pragma unroll
        for (int n = 0; n < 2; ++n) {
            const int ch = u.pn * 128 + wc * 32 + 16 * n + 4 * fq;
#pragma unroll
            for (int ai = 0; ai < 2; ++ai) {
#pragma unroll
                for (int m = 0; m < 4; ++m) {
                    f32x4& A = acc[ai][0][m][n]; f32x4& Bv = acc[ai][1][m][n];
                    if (m > 0 && !(LRU_T2)) {
#pragma unroll
                        for (int j = 0; j < 4; ++j) { const float pa = acc[ai][0][m - 1][n][j], pb = acc[ai][1][m - 1][n][j];
                            const float ac = __int_as_float(__builtin_amdgcn_ds_bpermute(src4, __float_as_int(pa))), bc = __int_as_float(__builtin_amdgcn_ds_bpermute(src4, __float_as_int(pb))); Bv[j] = fmaf(A[j], bc, Bv[j]); A[j] = A[j] * ac; }
                    }
                    const int r = u.pm * 256 + ai * 128 + wr * 64 + m * 16 + fr; const unsigned o = (unsigned)r * 1024u + (unsigned)ch;
                    u32x2 wp, wh; wp.x = cvt_pk_bf16(A[0], A[1]); wp.y = cvt_pk_bf16(A[2], A[3]); wh.x = cvt_pk_bf16(Bv[0], Bv[1]); wh.y = cvt_pk_bf16(Bv[2], Bv[3]);
                    *(u32x2*)(pcum + o) = wp; *(u32x2*)(hloc + o) = wh;
                    if (m == 3 && fr == 15) {
                        const int chunk = u.pm * 4 + ai * 2 + wr; float* ap = agg + ((size_t)chunk * 1024 + ch) * 2;
                        *(f32x4*)(ap) = (f32x4){A[0], Bv[0], A[1], Bv[1]}; *(f32x4*)(ap + 4) = (f32x4){A[2], Bv[2], A[3], Bv[3]};
                    }
                    __builtin_amdgcn_sched_barrier(0);
                }
            }
        }
    }
};

__device__ __forceinline__ void p0_transpose_item(const float* W, int ldw, const float* gain, bf16* WT, int ldt, int k_off, LAS float* scr, int kb, int nb, int lane) {
    const int k0 = 64 * kb, n0 = 32 * nb;
    const int c4 = lane & 7, kr = lane >> 3;
    f32x4 v[8];
#pragma unroll
    for (int i = 0; i < 8; ++i) v[i] = *(const f32x4*)(W + (size_t)(k0 + 8 * i + kr) * ldw + n0 + 4 * c4);
#pragma unroll
    for (int i = 0; i < 8; ++i) { f32x4 x = v[i]; if (gain) x = x * gain[k0 + 8 * i + kr]; *(LAS f32x4*)(scr + (8 * i + kr) * 36 + 4 * c4) = x; }
    LDS_WAIT(); asm volatile("" ::: "memory");
    const int c = lane & 7;
#pragma unroll
    for (int j = 0; j < 4; ++j) { const int n = (lane >> 3) + 8 * j; const LAS float* sp = scr + (8 * c) * 36 + n;
        u32x4 o; o.x = pk2(sp[0 * 36], sp[1 * 36]); o.y = pk2(sp[2 * 36], sp[3 * 36]); o.z = pk2(sp[4 * 36], sp[5 * 36]); o.w = pk2(sp[6 * 36], sp[7 * 36]);
        *(u32x4*)(WT + (size_t)(n0 + n) * ldt + k_off + k0 + 8 * c) = o; }
    LDS_WAIT(); asm volatile("" ::: "memory");
}
__device__ __forceinline__ void p0_wfold_item(LAS float* lds, const float* wq, const float* k1, const float* k2, const float* gffn, bf16* wfold, int item, int tid) {
    const int hh = item >> 4, kb = item & 15;
    LAS float* wqs = lds; LAS float* kks = lds + 64 * 132;
    const float* ksrc = (hh & 1) ? k2 : k1;
#pragma unroll
    for (int i = 0; i < 4; ++i) { const int e = tid + i * 512, r = e >> 5, c4 = e & 31; *(LAS f32x4*)(wqs + r * 132 + 4 * c4) = *(const f32x4*)(wq + (size_t)(kb * 64 + r) * 2048 + hh * 128 + 4 * c4); }
#pragma unroll
    for (int i = 0; i < 8; ++i) { const int e = tid + i * 512, r = e >> 5, c4 = e & 31; *(LAS f32x4*)(kks + r * 132 + 4 * c4) = *(const f32x4*)(ksrc + (size_t)r * 128 + 4 * c4); }
    __syncthreads();
    const int tk = tid & 15, tkey = tid >> 4;
    float acc[4][4];
#pragma unroll
    for (int i = 0; i < 4; ++i)
#pragma unroll
        for (int j = 0; j < 4; ++j) acc[i][j] = 0.f;
#pragma unroll 2
    for (int c4 = 0; c4 < 32; ++c4) {
        f32x4 a[4], b[4];
#pragma unroll
        for (int i = 0; i < 4; ++i) { a[i] = *(const LAS f32x4*)(wqs + (tk * 4 + i) * 132 + 4 * c4); b[i] = *(const LAS f32x4*)(kks + (tkey * 4 + i) * 132 + 4 * c4); }
#pragma unroll
        for (int i = 0; i < 4; ++i)
#pragma unroll
            for (int j = 0; j < 4; ++j) acc[i][j] += (a[i][0] * b[j][0] + a[i][1] * b[j][1]) + (a[i][2] * b[j][2] + a[i][3] * b[j][3]);
    }
    const int kg = kb * 64 + tk * 4; const f32x4 gv = *(const f32x4*)(gffn + kg);
#pragma unroll
    for (int j = 0; j < 4; ++j) { u32x2 w; w.x = pk2(acc[0][j] * gv[0], acc[1][j] * gv[1]); w.y = pk2(acc[2][j] * gv[2], acc[3][j] * gv[3]);
        *(u32x2*)(wfold + (size_t)(hh * 128 + tkey * 4 + j) * 1024 + kg) = w; }
    __syncthreads();
}

struct In { const float* p[25]; };
enum { I_X = 0, I_P, I_GMIX, I_WIN, I_SINK, I_CONVW, I_CONVB, I_WA, I_BA, I_WX, I_BX, I_LAM, I_WUA, I_WUL, I_WO, I_GFFN, I_WQ, I_K1, I_K2, I_U, I_V, I_GPLE, I_WGATE, I_WPROJ, I_FG };

__device__ __forceinline__ void p0_prologue(const In& in, unsigned char* ws, LAS unsigned char* lds, int vcu, int G, int wave, int tid) {
    const int lane = tid & 63;
    LAS float* scr = (LAS float*)(lds + wave * 16384);
    const int gw = vcu * NWAVES + wave, NGW = G * NWAVES;
    constexpr int I_IN = 16 * 152, I_UA = 8 * 32, I_SQ = 16 * 32, I_PJ = 4 * 32, I_AX = 128;
    constexpr int NITEMS = I_IN + I_UA + 3 * I_SQ + I_PJ + I_AX;
    for (int it = gw; it < NITEMS; it += NGW) {
        int r = it;
        if (r < I_IN) { p0_transpose_item(in.p[I_WIN], INW, in.p[I_GMIX], (bf16*)(ws + WS_WIN), 1024, 0, scr, r / 152, r % 152, lane); continue; } r -= I_IN;
        if (r < I_UA) { p0_transpose_item(in.p[I_WUA], 1024, nullptr, (bf16*)(ws + WS_WUA), 512, 0, scr, r / 32, r % 32, lane); continue; } r -= I_UA;
        if (r < I_SQ) { p0_transpose_item(in.p[I_WUL], 1024, nullptr, (bf16*)(ws + WS_WUL), 1024, 0, scr, r / 32, r % 32, lane); continue; } r -= I_SQ;
        if (r < I_SQ) { p0_transpose_item(in.p[I_WO], 1024, nullptr, (bf16*)(ws + WS_WO), 1024, 0, scr, r / 32, r % 32, lane); continue; } r -= I_SQ;
        if (r < I_SQ) { p0_transpose_item(in.p[I_WGATE], 1024, in.p[I_GPLE], (bf16*)(ws + WS_WG), 1024, 0, scr, r / 32, r % 32, lane); continue; } r -= I_SQ;
        if (r < I_PJ) { p0_transpose_item(in.p[I_WPROJ], 1024, nullptr, (bf16*)(ws + WS_WPROJ), 256, 0, scr, r / 32, r % 32, lane); continue; } r -= I_PJ;
        { const int blk = r >> 4, which = (r >> 3) & 1, sub = r & 7;

#if LRU_PADDED
#if LRU_PADDED == 2
          p0_transpose_item(in.p[which ? I_WX : I_WA] + (size_t)blk * 16384, 128, nullptr, (bf16*)(ws + WS_WAX) + (size_t)blk * 32768 + which * 128 * 128, 128, 0, scr, sub >> 2, sub & 3, lane); }
#else
          p0_transpose_item(in.p[which ? I_WX : I_WA] + (size_t)blk * 16384, 128, nullptr, (bf16*)(ws + WS_WAX) + (size_t)blk * 65536 + which * 128 * 256, 256, (blk & 1) * 128, scr, sub >> 2, sub & 3, lane); }
#endif
#else
          p0_transpose_item(in.p[which ? I_WX : I_WA] + (size_t)blk * 16384, 128, nullptr, (bf16*)(ws + WS_WAXD) + (size_t)(blk * 256 + which * 128) * 1024, 1024, blk * 128, scr, sub >> 2, sub & 3, lane); }
#endif
    }
#if LRU_PADDED == 2
#elif LRU_PADDED
    for (int i = vcu * 512 + tid; i < 8 * 256 * 16; i += G * 512) { const int c16 = i & 15, n = (i >> 4) & 255, blk = i >> 12;
        *(u32x4*)((bf16*)(ws + WS_WAX) + (size_t)blk * 65536 + n * 256 + ((blk & 1) ^ 1) * 128 + c16 * 8) = (u32x4){0u, 0u, 0u, 0u}; }
#else
    for (int i = vcu * 512 + tid; i < 2048 * 128; i += G * 512) { const int c16 = i & 127, row = i >> 7, blk = row >> 8;
        if ((c16 >> 4) != blk) *(u32x4*)((bf16*)(ws + WS_WAXD) + (size_t)row * 1024 + c16 * 8) = (u32x4){0u, 0u, 0u, 0u}; }
#endif
    for (int m = gw; m < T_; m += 2 * NGW) {
        const int m2 = m + NGW;
        const f32x4* xa = (const f32x4*)(in.p[I_X] + (size_t)m * 1024) + lane; const f32x4* xb = (const f32x4*)(in.p[I_X] + (size_t)(m2 < T_ ? m2 : m) * 1024) + lane;
        f32x4 va[4], vb[4]; float sa = 0.f, sb = 0.f;
#pragma unroll
        for (int j = 0; j < 4; ++j) { va[j] = xa[64 * j]; vb[j] = xb[64 * j]; }
#pragma unroll
        for (int j = 0; j < 4; ++j) { sa += (va[j][0] * va[j][0] + va[j][1] * va[j][1]) + (va[j][2] * va[j][2] + va[j][3] * va[j][3]); sb += (vb[j][0] * vb[j][0] + vb[j][1] * vb[j][1]) + (vb[j][2] * vb[j][2] + vb[j][3] * vb[j][3]); }
#pragma unroll
        for (int o = 1; o < 64; o <<= 1) { sa += __shfl_xor(sa, o); sb += __shfl_xor(sb, o); }
        u32x2* oa = (u32x2*)((bf16*)(ws + WS_R0) + (size_t)m * 1024) + lane;
#pragma unroll
        for (int j = 0; j < 4; ++j) { u32x2 w; w.x = pk2(va[j][0], va[j][1]); w.y = pk2(va[j][2], va[j][3]); oa[64 * j] = w; }
        if (lane == 0) ((float*)(ws + WS_RSTD1))[m] = 1.0f / sqrtf(sa * (1.0f / 1024.0f) + EPS);
        if (m2 < T_) {
            u32x2* ob = (u32x2*)((bf16*)(ws + WS_R0) + (size_t)m2 * 1024) + lane;
#pragma unroll
            for (int j = 0; j < 4; ++j) { u32x2 w; w.x = pk2(vb[j][0], vb[j][1]); w.y = pk2(vb[j][2], vb[j][3]); ob[64 * j] = w; }
            if (lane == 0) ((float*)(ws + WS_RSTD1))[m2] = 1.0f / sqrtf(sb * (1.0f / 1024.0f) + EPS);
        }
    }
    for (int m = gw; m < T_; m += 4 * NGW) {
        f32x4 v[4];
#pragma unroll
        for (int q = 0; q < 4; ++q) { const int mq = m + q * NGW; v[q] = ((const f32x4*)(in.p[I_P] + (size_t)(mq < T_ ? mq : m) * 256))[lane]; }
#pragma unroll
        for (int q = 0; q < 4; ++q) { const int mq = m + q * NGW; if (mq < T_) { u32x2 w; w.x = pk2(v[q][0], v[q][1]); w.y = pk2(v[q][2], v[q][3]); ((u32x2*)((bf16*)(ws + WS_PB) + (size_t)mq * 256))[lane] = w; } }
    }
    if (vcu == 0) for (int c = tid; c < 1024; c += 512) ((float*)(ws + WS_C8))[c] = -8.0f * log1pf(expf(-in.p[I_LAM][c])) * LOG2E;
    __syncthreads();
    for (int it = vcu; it < 256; it += G) p0_wfold_item((LAS float*)lds, in.p[I_WQ], in.p[I_K1], in.p[I_K2], in.p[I_GFFN], (bf16*)(ws + WS_WFOLD), it, tid);
}

constexpr int AT_KSTR = 72, AT_VSTR = 260, AT_V_OFF = 256 * AT_KSTR * 2;
__device__ __forceinline__ int crow(int r, int hi) { return (r & 3) + 8 * (r >> 2) + 4 * hi; }
__device__ __forceinline__ void attn_item(LAS unsigned char* lds, const bf16* qkv, const float* sink, bf16* att, int item, int wave, int tid) {
    const int lane = tid & 63;
    const int g = item & 1, n = (item >> 1) & 15, b = item >> 5;
    const int t0 = b * S_ + n * 128;
    LAS bf16* Ks = (LAS bf16*)lds; LAS bf16* Vt = (LAS bf16*)(lds + AT_V_OFF);
#pragma unroll
    for (int i = 0; i < 4; ++i) {
        const int idx = tid + i * 512, row = idx >> 3, ch = idx & 7; const int tk = t0 - 128 + row;
        u32x4 kv = (u32x4){0u, 0u, 0u, 0u}, vv = (u32x4){0u, 0u, 0u, 0u};
        if (n > 0 || row >= 128) { const bf16* src = qkv + (size_t)tk * 768 + 512 + g * 64 + ch * 8; kv = *(const u32x4*)src; vv = *(const u32x4*)(src + 128); }
        *(LAS u32x4*)(Ks + row * AT_KSTR + ch * 8) = kv;
#pragma unroll
        for (int c = 0; c < 8; ++c) Vt[(ch * 8 + c) * AT_VSTR + row] = (bf16)(vv[c >> 1] >> (16 * (c & 1)));
    }
    __syncthreads();
    const int hr = wave >> 1, qh = wave & 1, head = g * 4 + hr;
    const float slope2 = exp2f(-(float)(head + 1)) * LOG2E, sink2 = sink[head] * LOG2E;
    const int q = lane & 31, hi = lane >> 5;
#pragma unroll 1
    for (int ps = 0; ps < 2; ++ps) {
        const int i0 = 64 * qh + 32 * ps, kb0 = i0;
        const bf16* qp = qkv + (size_t)(t0 + i0 + q) * 768 + head * 64 + 8 * hi;
        bf16x8 qf[4];
#pragma unroll
        for (int s = 0; s < 4; ++s) qf[s] = *(const bf16x8*)(qp + 16 * s);
        f32x16 oT[2];
#pragma unroll
        for (int dt = 0; dt < 2; ++dt)
#pragma unroll
            for (int r = 0; r < 16; ++r) oT[dt][r] = 0.f;
        float mrun = sink2, l = 0.f;
#pragma unroll 1
        for (int kt = 0; kt < 5; ++kt) {
            const int kbase = kb0 + 32 * kt;
            f32x16 sT;
#pragma unroll
            for (int r = 0; r < 16; ++r) sT[r] = 0.f;
#pragma unroll
            for (int s = 0; s < 4; ++s) { const bf16x8 kf = *(const LAS bf16x8*)(Ks + (kbase + q) * AT_KSTR + 16 * s + 8 * hi); sT = __builtin_amdgcn_mfma_f32_32x32x16_bf16(kf, qf[s], sT, 0, 0, 0); }
            float tm = -1.0e30f;
#pragma unroll
            for (int r = 0; r < 16; ++r) {
                const int kj = kbase + crow(r, hi); const int dist = i0 + q + 128 - kj;
                const bool valid = (dist >= 0) && (dist < 128) && (n > 0 || kj >= 128);
                const float v = valid ? (sT[r] * (0.125f * LOG2E) - slope2 * (float)dist) : -1.0e30f;
                sT[r] = v; tm = fmaxf(tm, v);
            }
            tm = fmaxf(tm, __shfl_xor(tm, 32));
            const float mnew = fmaxf(mrun, tm), alpha = __builtin_amdgcn_exp2f(mrun - mnew);
            mrun = mnew;
            float ls = 0.f;
#pragma unroll
            for (int r = 0; r < 16; ++r) { const float p = __builtin_amdgcn_exp2f(sT[r] - mnew); sT[r] = p; ls += p; }
            l = l * alpha + ls;
#pragma unroll
            for (int dt = 0; dt < 2; ++dt)
#pragma unroll
                for (int r = 0; r < 16; ++r) oT[dt][r] *= alpha;
#pragma unroll
            for (int s = 0; s < 2; ++s) {
                u32x4 pw; pw.x = cvt_pk_bf16(sT[8 * s + 0], sT[8 * s + 1]); pw.y = cvt_pk_bf16(sT[8 * s + 2], sT[8 * s + 3]);
                pw.z = cvt_pk_bf16(sT[8 * s + 4], sT[8 * s + 5]); pw.w = cvt_pk_bf16(sT[8 * s + 6], sT[8 * s + 7]);
                const bf16x8 pf = __builtin_bit_cast(bf16x8, pw);
#pragma unroll
                for (int dt = 0; dt < 2; ++dt) {
                    const LAS bf16* vp = Vt + (32 * dt + q) * AT_VSTR + kbase + 16 * s + 4 * hi;
                    const u32x2 va = *(const LAS u32x2*)vp, vb = *(const LAS u32x2*)(vp + 8);
                    const bf16x8 af = __builtin_bit_cast(bf16x8, (u32x4){va.x, va.y, vb.x, vb.y});
                    oT[dt] = __builtin_amdgcn_mfma_f32_32x32x16_bf16(af, pf, oT[dt], 0, 0, 0);
                }
            }
        }
        l += __shfl_xor(l, 32);
        l += __builtin_amdgcn_exp2f(sink2 - mrun);
        const float inv = 1.0f / l;
        bf16* op = att + (size_t)(t0 + i0 + q) * 512 + head * 64 + 4 * hi;
#pragma unroll
        for (int dt = 0; dt < 2; ++dt)
#pragma unroll
            for (int rg = 0; rg < 4; ++rg) { u32x2 w; w.x = cvt_pk_bf16(oT[dt][4 * rg] * inv, oT[dt][4 * rg + 1] * inv); w.y = cvt_pk_bf16(oT[dt][4 * rg + 2] * inv, oT[dt][4 * rg + 3] * inv);
                *(u32x2*)(op + 32 * dt + 8 * rg) = w; }
    }
    __syncthreads();
}
__device__ __forceinline__ void conv_items(const bf16* lx, const float* cw, const float* cb, bf16* lin, int vcu, int G, int tid) {
    for (int i = vcu * 512 + tid; i < T_ * 128; i += 2 * G * 512) {
        const int c8 = (i & 127) * 8;
        const int ta = i >> 7, i2 = i + G * 512; const bool hasb = i2 < T_ * 128; const int tb = hasb ? (i2 >> 7) : ta;
        const int tsa = ta & (S_ - 1), tsb = tb & (S_ - 1);
        u32x4 wa[4], wb[4];
#pragma unroll
        for (int tap = 0; tap < 4; ++tap) {
            wa[tap] = (tsa - 3 + tap >= 0) ? *(const u32x4*)(lx + (size_t)(ta - 3 + tap) * 1024 + c8) : (u32x4){0u, 0u, 0u, 0u};
            wb[tap] = (tsb - 3 + tap >= 0) ? *(const u32x4*)(lx + (size_t)(tb - 3 + tap) * 1024 + c8) : (u32x4){0u, 0u, 0u, 0u};
        }
        f32x4 a0 = *(const f32x4*)(cb + c8), a1 = *(const f32x4*)(cb + c8 + 4), b0 = a0, b1 = a1;
#pragma unroll
        for (int tap = 0; tap < 4; ++tap) {
            const f32x4 w0 = *(const f32x4*)(cw + tap * 1024 + c8), w1 = *(const f32x4*)(cw + tap * 1024 + c8 + 4);
            a0 += bf4_lo((u32x2){wa[tap].x, wa[tap].y}) * w0; a1 += bf4_lo((u32x2){wa[tap].z, wa[tap].w}) * w1;
            b0 += bf4_lo((u32x2){wb[tap].x, wb[tap].y}) * w0; b1 += bf4_lo((u32x2){wb[tap].z, wb[tap].w}) * w1;
        }
        *(u32x4*)(lin + (size_t)ta * 1024 + c8) = pack8(a0, a1);
        if (hasb) *(u32x4*)(lin + (size_t)tb * 1024 + c8) = pack8(b0, b1);
    }
}
__device__ __forceinline__ void scan_finish(const bf16* hloc, const bf16* pcum, const float* agg, const bf16* gl, bf16* rec, int vcu, int G, int tid) {
    const int c8 = (tid & 127) * 8, rg = tid >> 7;
    for (int chunk = vcu; chunk < T_ / 64; chunk += G) {
        const int ci = chunk & 31, cb = chunk - ci;
        float carry[8];
#pragma unroll
        for (int j = 0; j < 8; ++j) carry[j] = 0.f;
#pragma unroll 4
        for (int cc = 0; cc < ci; ++cc) {
            const f32x4* ap = (const f32x4*)(agg + ((size_t)(cb + cc) * 1024 + c8) * 2);
#pragma unroll
            for (int q = 0; q < 4; ++q) { const f32x4 v = ap[q]; carry[2 * q] = fmaf(v[0], carry[2 * q], v[1]); carry[2 * q + 1] = fmaf(v[2], carry[2 * q + 1], v[3]); }
        }
#pragma unroll 8
        for (int rr = 0; rr < 16; ++rr) {
            const size_t o = (size_t)(chunk * 64 + rg + 4 * rr) * 1024 + c8;
            const u32x4 hw = *(const u32x4*)(hloc + o), pw = *(const u32x4*)(pcum + o), gw = *(const u32x4*)(gl + o);
            const f32x4 h0 = bf4_lo((u32x2){hw.x, hw.y}), h1 = bf4_lo((u32x2){hw.z, hw.w}), p0 = bf4_lo((u32x2){pw.x, pw.y}), p1 = bf4_lo((u32x2){pw.z, pw.w});
            const f32x4 g0 = bf4_lo((u32x2){gw.x, gw.y}), g1 = bf4_lo((u32x2){gw.z, gw.w});
            f32x4 r0, r1;
#pragma unroll
            for (int j = 0; j < 4; ++j) { r0[j] = fmaf(p0[j], carry[j], h0[j]) * g0[j]; r1[j] = fmaf(p1[j], carry[4 + j], h1[j]) * g1[j]; }
            *(u32x4*)(rec + o) = pack8(r0, r1);
        }
    }
}
__device__ __forceinline__ void uv_convert(const float* pu, const float* pv, const float* gffn, unsigned char* u8, unsigned char* v8, float* iu, float* iv, int gw, int NGW, int lane) {
    f32x4 g[4];
#pragma unroll
    for (int j = 0; j < 4; ++j) g[j] = ((const f32x4*)gffn)[4 * lane + j];
    for (int e0 = gw; e0 < 2 * 16384; e0 += 2 * NGW) {
        f32x4 v[2][4];
#pragma unroll
        for (int h = 0; h < 2; ++h) { const int e = e0 + h * NGW; const bool isv = e >= 16384; const int row = isv ? e - 16384 : e;
            const f32x4* src = (const f32x4*)((isv ? pv : pu) + (size_t)row * 1024) + 4 * lane;
#pragma unroll
            for (int j = 0; j < 4; ++j) v[h][j] = src[j]; }
#pragma unroll
        for (int h = 0; h < 2; ++h) {
            const int e = e0 + h * NGW; const bool isv = e >= 16384; const int row = isv ? e - 16384 : e;
            float am = 0.f;
#pragma unroll
            for (int j = 0; j < 4; ++j) { if (!isv) v[h][j] = v[h][j] * g[j]; am = fmaxf(am, fmaxf(fmaxf(fabsf(v[h][j][0]), fabsf(v[h][j][1])), fmaxf(fabsf(v[h][j][2]), fabsf(v[h][j][3])))); }
#pragma unroll
            for (int o = 1; o < 64; o <<= 1) am = fmaxf(am, __shfl_xor(am, o));
            const float sc = am > 0.f ? (isv ? 416.0f : 127.0f) / am : 1.0f;
            u32x4 w;
            if (isv) {
#pragma unroll
                for (int j = 0; j < 4; ++j) { unsigned ww = 0u; ww = __builtin_amdgcn_cvt_pk_fp8_f32(v[h][j][0] * sc, v[h][j][1] * sc, ww, false); ww = __builtin_amdgcn_cvt_pk_fp8_f32(v[h][j][2] * sc, v[h][j][3] * sc, ww, true); w[j] = ww; }
            } else {
#pragma unroll
                for (int j = 0; j < 4; ++j) { unsigned ww = 0u;
#pragma unroll
                    for (int c = 0; c < 4; ++c) ww |= ((unsigned)(int)__builtin_rintf(v[h][j][c] * sc) & 0xffu) << (8 * c);
                    w[j] = ww; }
            }
            *(u32x4*)((isv ? v8 : u8) + (size_t)row * 1024 + 16 * lane) = w;
            if (lane == 0) (isv ? iv : iu)[row] = 1.0f / sc;
        }
    }
}
__device__ __forceinline__ void final_rows(float* h, const bf16* h3b, const float* part, const float* fg, int gw, int NGW, int lane, float tscale) {
    f32x4 g[4];
#pragma unroll
    for (int j = 0; j < 4; ++j) g[j] = ((const f32x4*)fg)[lane + 64 * j];
    for (int r0 = gw; r0 < T_; r0 += 2 * NGW) {
        const int r1 = (r0 + NGW < T_) ? r0 + NGW : r0;
        float pa = (lane < 16) ? part[(size_t)r0 * 16 + lane] : 0.f, pb = (lane < 16) ? part[(size_t)r1 * 16 + lane] : 0.f;
#if ALL_FUSED
        const u32x2* ba = (const u32x2*)(h3b + (size_t)r0 * 1024) + lane; const u32x2* bb = (const u32x2*)(h3b + (size_t)r1 * 1024) + lane;
        u32x2 wa[4], wb[4];
#pragma unroll
        for (int j = 0; j < 4; ++j) { wa[j] = ba[64 * j]; wb[j] = bb[64 * j]; }
#endif
#pragma unroll
        for (int o = 1; o < 64; o <<= 1) { pa += __shfl_xor(pa, o); pb += __shfl_xor(pb, o); }
        const float ra = tscale / sqrtf(pa * (1.0f / 1024.0f) + EPS), rb = tscale / sqrtf(pb * (1.0f / 1024.0f) + EPS);
        f32x4* ha = (f32x4*)(h + (size_t)r0 * 1024) + lane; f32x4* hb = (f32x4*)(h + (size_t)r1 * 1024) + lane;
#if ALL_FUSED
#pragma unroll
        for (int j = 0; j < 4; ++j) ha[64 * j] = bf4_lo(wa[j]) * ra * g[j];
        if (r1 != r0) {
#pragma unroll
            for (int j = 0; j < 4; ++j) hb[64 * j] = bf4_lo(wb[j]) * rb * g[j];
        }
#else
#pragma unroll
        for (int j = 0; j < 4; ++j) ha[64 * j] = ha[64 * j] * ra * g[j];
        if (r1 != r0) {
#pragma unroll
            for (int j = 0; j < 4; ++j) hb[64 * j] = hb[64 * j] * rb * g[j];
        }
#endif
    }
}

constexpr int N_PHASES = 16;
struct Args { const float* in[25]; float* out; unsigned char* ws; int ph_lo, ph_hi, li, pad; };
__global__ void __launch_bounds__(NWAVES * 64, 2) fused_fwd(Args args) {
    extern __shared__ __attribute__((aligned(16))) unsigned char lds_raw[];
    LAS unsigned char* lds = (LAS unsigned char*)lds_raw;
    volatile LAS unsigned* MISC = (volatile LAS unsigned*)(lds + LDSCTL_OFF);
    const int wave = __builtin_amdgcn_readfirstlane((int)threadIdx.x >> 6);
#define FRESH_TID() (wave * 64 + fresh_lane())
#define FRESH_LANE() fresh_lane()
    const int G = gridDim.x; const int bx = blockIdx.x; const int vcu = (G % 8 == 0) ? (bx % 8) * (G / 8) + bx / 8 : bx;
    unsigned char* ws = args.ws; float* out = args.out;
    In in;
#pragma unroll
    for (int i = 0; i < 25; ++i) in.p[i] = args.in[i];
    for (int u = FRESH_TID(); u < (LDS_BYTES - LDSCTL_OFF) / 4; u += NWAVES * 64) ((LAS unsigned*)(lds + LDSCTL_OFF))[u] = 0u;
    __syncthreads();
    (void)xcd_barrier_post((unsigned*)(ws + WS_CTL) + CW_BAR + args.li * XCD_BAR_WORDS, MISC + 8);
    const int lo = args.ph_lo, hi = args.ph_hi;
    const int gw = vcu * NWAVES + wave, NGW = G * NWAVES;
#ifndef PH_DISABLE
#define PH_DISABLE 0
#endif
#if ALL_FUSED
#define IN(k) (!((PH_DISABLE >> (k)) & 1))
#else
#define IN(k) (lo <= (k) && (k) < hi && !((PH_DISABLE >> (k)) & 1))
#endif
#ifdef TIMING_A
#define STAMP(i) do { if (bx == 0 && FRESH_TID() == 0) __hip_atomic_store((unsigned long long*)(ws + WS_CTL + 512) + (i), __builtin_amdgcn_s_memrealtime(), __ATOMIC_RELAXED, __HIP_MEMORY_SCOPE_AGENT); } while (0)
#else
#define STAMP(i) do { } while (0)
#endif
#define SEAM(k) do { if (IN(k) && IN((k) + 1)) { XcdBarrier b_; b_.bar = (unsigned*)(args.ws + WS_CTL) + CW_BAR + args.li * XCD_BAR_WORDS; b_.x = xb_xcc_id(); b_.st = (volatile LAS unsigned*)(lds + LDSCTL_OFF) + 8;     \
        xcd_barrier(b_); STAMP((k) + 1); } } while (0)
#if ALL_FUSED
#define PP_OFF WS_PP2
#define MP_PTR out
#else
#define PP_OFF WS_PP
#define MP_PTR ((float*)(ws + WS_MP))
#endif
#define GEMM_PHASE(EPI, Aptr, Bptr, Kdim, LDA, M_, N_, SH, STR, ...) do { \
        pg8::Gemm g{(const pg8::bf16_t*)(Aptr), (const pg8::bf16_t*)(Bptr), Kdim, LDA, SH, STR}; pg8::StaticOrder S; S.init(M_, N_, G, (int)blockIdx.x); \
        EPI E{__VA_ARGS__}; pg8::gemm_phase<EPI, pg8::StaticOrder, true, true>(lds, g, S, E, wave); } while (0)

    STAMP(0);
    if (IN(0)) { p0_prologue(in, ws, lds, vcu, G, wave, FRESH_TID()); } SEAM(0);
    if (IN(1)) { GEMM_PHASE(EpiProj, ws + WS_R0, ws + WS_WIN, 1024, 1024, T_, INW, 0, 0, (const float*)(ws + WS_RSTD1), ws); } SEAM(1);
    if (IN(2)) {
        for (int it = bx; it < 256; it += G) attn_item(lds, (const bf16*)(ws + WS_QKV), in.p[I_SINK], (bf16*)(ws + WS_ATT), it, wave, FRESH_TID());
        conv_items((const bf16*)(ws + WS_LX), in.p[I_CONVW], in.p[I_CONVB], (bf16*)(ws + WS_R0), vcu, G, FRESH_TID());
    } SEAM(2);
#if LRU_PADDED == 2
    if (IN(3)) { GEMM_PHASE(EpiLru, ws + WS_R0, ws + WS_WAX, 128, 1024, T_, 2048, 0, 128,
#elif LRU_PADDED
    if (IN(3)) { GEMM_PHASE(EpiLru, ws + WS_R0, ws + WS_WAX, 256, 1024, T_, 2048, 1, 256,
#else
    if (IN(3)) { GEMM_PHASE(EpiLru, ws + WS_R0, ws + WS_WAXD, 1024, 1024, T_, 2048, 0, 0,
#endif
        (const bf16*)(ws + WS_R0), in.p[I_BA], in.p[I_BX], (const float*)(ws + WS_C8), (bf16*)(ws + WS_HLOC), (bf16*)(ws + WS_PCUM), (float*)(ws + WS_AGG)); }
    SEAM(3);
    if (IN(4)) { scan_finish((const bf16*)(ws + WS_HLOC), (const bf16*)(ws + WS_PCUM), (const float*)(ws + WS_AGG), (const bf16*)(ws + WS_GL), (bf16*)(ws + WS_R0), vcu, G, FRESH_TID()); }
#if !ALL_FUSED
    SEAM(4);
#endif
    if (IN(5)) { GEMM_PHASE(EpiMP, ws + WS_ATT, ws + WS_WUA, 512, 512, T_, 1024, 0, 0, (const bf16*)(ws + WS_SGA), MP_PTR); } SEAM(5);
    if (IN(6)) { GEMM_PHASE(EpiMerged, ws + WS_R0, ws + WS_WUL, 1024, 1024, T_, 1024, 0, 0, (const bf16*)(ws + WS_SGL), (const float*)MP_PTR, (bf16*)(ws + WS_MERGED)); } SEAM(6);
    if (IN(7)) { GEMM_PHASE(EpiH1, ws + WS_MERGED, ws + WS_WO, 1024, 1024, T_, 1024, 0, 0, in.p[I_X], out, (bf16*)(ws + WS_R0), (float*)(ws + WS_PART2)); }
#if ALL_FUSED
    if (IN(13)) { GEMM_PHASE(EpiPP, ws + WS_PB, ws + WS_WPROJ, 256, 256, T_, 1024, 0, 0, (bf16*)(ws + WS_PP2)); }
#endif
    SEAM(7);
#define PEER_HALF(half) do { \
        if (IN(8 + 2 * (half))) { GEMM_PHASE(EpiScore, ws + WS_R0, ws + WS_WFOLD + (size_t)(half) * 1024 * 1024 * 2, 1024, 1024, T_, 1024, 0, 0, (const float*)(ws + WS_PART2), (float*)(ws + WS_SC)); } SEAM(8 + 2 * (half)); \
        if (IN(9 + 2 * (half))) { \
            for (int it = vcu; it < T_ / TK_TOK; it += G) topk_item((LAS float*)lds, (const float*)(ws + WS_SC), it, (half) * 4, (int*)(ws + WS_SELI), (float*)(ws + WS_SELG), FRESH_TID()); \
            if ((half) == 0) uv_convert(in.p[I_U], in.p[I_V], in.p[I_GFFN], ws + WS_U16, ws + WS_U16 + 16 * MiB, (float*)(ws + WS_USCALE), (float*)(ws + WS_USCALE) + 16384, gw, NGW, FRESH_LANE()); \
        } SEAM(9 + 2 * (half)); } while (0)
#if ALL_FUSED
    if (IN(8)) {
        for (int kk = 0; kk < 2; ++kk) { pg8::Gemm g{(const pg8::bf16_t*)(ws + WS_R0), (const pg8::bf16_t*)(ws + WS_WFOLD), 1024, 1024, 0, 0}; OneUnit S; S.S.init(T_, 2048, G, (int)blockIdx.x); S.k = kk;
            EpiTopk E{(const float*)(ws + WS_PART2), (int*)(ws + WS_SELI), (float*)(ws + WS_SELG)}; pg8::gemm_phase<EpiTopk, OneUnit, false, true>(lds, g, S, E, wave); }
        uv_convert(in.p[I_U], in.p[I_V], in.p[I_GFFN], ws + WS_U16, ws + WS_U16 + 16 * MiB, (float*)(ws + WS_USCALE), (float*)(ws + WS_USCALE) + 16384, gw, NGW, FRESH_LANE());
    } SEAM(11);
#else
    PEER_HALF(0);
    PEER_HALF(1);
#endif
    if (IN(12)) {
        for (int tok0 = vcu * 64; tok0 < T_; tok0 += G * 64)
            gather_wg_sliced(tok0, wave, FRESH_LANE(), lds, ws + WS_U16, ws + WS_U16 + 16 * MiB, (const float*)(ws + WS_USCALE), (const float*)(ws + WS_USCALE) + 16384, (const int*)(ws + WS_SELI), (const float*)(ws + WS_SELG), (const float*)(ws + WS_PART2), out, (const bf16*)(ws + WS_R0), (bf16*)(ws + WS_H2B), (float*)(ws + WS_RSTD3));
    } SEAM(12);
#if !ALL_FUSED
    if (IN(13)) { GEMM_PHASE(EpiPP, ws + WS_PB, ws + WS_WPROJ, 256, 256, T_, 1024, 0, 0, (bf16*)(ws + WS_PP)); } SEAM(13);
#endif
#if ALL_FUSED && FUSE_FINAL
    if (IN(14)) { GEMM_PHASE(EpiH3Final, ws + WS_H2B, ws + WS_WG, 1024, 1024, T_, 1024, 0, 0, (const float*)(ws + WS_RSTD3), (const bf16*)(ws + PP_OFF), (const bf16*)(ws + WS_H2B), in.p[I_FG], out, (float*)(ws + WS_PART4), (unsigned*)(ws + WS_CTL) + 65536); }
#else
    if (IN(14)) { GEMM_PHASE(EpiH3, ws + WS_H2B, ws + WS_WG, 1024, 1024, T_, 1024, 0, 0, (const float*)(ws + WS_RSTD3), (const bf16*)(ws + PP_OFF), out, (float*)(ws + WS_PART4), (const bf16*)(ws + WS_H2B), (bf16*)(ws + WS_R0)); } SEAM(14);
#ifdef TIMING_A
    float tscale = 1.0f;
    { const unsigned long long ta = __hip_atomic_load((unsigned long long*)(ws + WS_CTL + 512) + TIMING_A, __ATOMIC_RELAXED, __HIP_MEMORY_SCOPE_AGENT), tb = __hip_atomic_load((unsigned long long*)(ws + WS_CTL + 512) + TIMING_B, __ATOMIC_RELAXED, __HIP_MEMORY_SCOPE_AGENT);
      tscale = 1.0f + (float)(tb - ta) * 0.01f * (float)(TIMING_K); }
    if (IN(15)) { final_rows(out, (const bf16*)(ws + WS_R0), (const float*)(ws + WS_PART4), in.p[I_FG], gw, NGW, FRESH_LANE(), tscale); }
#else
    if (IN(15)) { final_rows(out, (const bf16*)(ws + WS_R0), (const float*)(ws + WS_PART4), in.p[I_FG], gw, NGW, FRESH_LANE(), 1.0f); }
#endif
#endif
#undef IN
#undef SEAM
#undef GEMM_PHASE
}
static const int GRP_LO[11] = {0, 2, 3, 5, 6, 7, 8, 12, 13, 14, 15};
static const int GRP_HI[11] = {2, 3, 5, 6, 7, 8, 12, 13, 14, 15, 16};

static void naive_group(int grp, void* const* d_in, float* out, unsigned char* ws, hipStream_t st) {
    const float* x = (const float*)d_in[0]; const float* p = (const float*)d_in[1]; const float* g_mix = (const float*)d_in[2]; const float* w_in = (const float*)d_in[3];
    const float* sink = (const float*)d_in[4]; const float* conv_w = (const float*)d_in[5]; const float* conv_b = (const float*)d_in[6];
    const float* wa = (const float*)d_in[7]; const float* ba = (const float*)d_in[8]; const float* wx = (const float*)d_in[9]; const float* bx = (const float*)d_in[10]; const float* lam = (const float*)d_in[11];
    const float* w_ua = (const float*)d_in[12]; const float* w_ul = (const float*)d_in[13]; const float* w_o = (const float*)d_in[14]; const float* g_ffn = (const float*)d_in[15];
    const float* wq = (const float*)d_in[16]; const float* k1 = (const float*)d_in[17]; const float* k2 = (const float*)d_in[18]; const float* pu = (const float*)d_in[19]; const float* pv = (const float*)d_in[20];
    const float* g_ple = (const float*)d_in[21]; const float* w_gate = (const float*)d_in[22]; const float* w_proj = (const float*)d_in[23]; const float* final_g = (const float*)d_in[24];
    float* rstd1 = (float*)(ws + WS_RSTD1); float* part2 = (float*)(ws + WS_PART2); float* part4 = (float*)(ws + WS_PART4); float* rstd3 = (float*)(ws + WS_RSTD3);
    bf16* qkv = (bf16*)(ws + WS_QKV); bf16* lx = (bf16*)(ws + WS_LX); bf16* gl = (bf16*)(ws + WS_GL); bf16* sga = (bf16*)(ws + WS_SGA); bf16* sgl = (bf16*)(ws + WS_SGL);
    bf16* att = (bf16*)(ws + WS_ATT); bf16* r0 = (bf16*)(ws + WS_R0); float* mp = (float*)(ws + WS_MP); bf16* merged = (bf16*)(ws + WS_MERGED);
    float* sc = (float*)(ws + WS_SC); int* seli = (int*)(ws + WS_SELI); float* selg = (float*)(ws + WS_SELG); bf16* h2b = (bf16*)(ws + WS_H2B); bf16* pp = (bf16*)(ws + WS_PP);
    float* tmpf = (float*)(ws + WS_NAIVE_AB);
    switch (grp) {
    case 0:
        hipLaunchKernelGGL(nv::rowsq, dim3(T_ / 4), dim3(256), 0, st, x, rstd1, (float*)nullptr);
        nv::run_gemm<nv::ALf32, nv::EpiProj, false>(st, nv::ALf32{x, 1024}, w_in, INW, g_mix, T_, INW, 1024, nv::EpiProj{rstd1, qkv, lx, gl, sga, sgl});
        break;
    case 1:
        hipLaunchKernelGGL(nv::attn_naive, dim3(T_ * 8 / 128), dim3(128), 0, st, qkv, sink, att);
        hipLaunchKernelGGL(nv::conv_naive, dim3(T_ * 1024 / 256), dim3(256), 0, st, lx, conv_w, conv_b, r0);
        break;
    case 2:
        hipLaunchKernelGGL(nv::lru_ab_naive, dim3(T_ * 8), dim3(128), 0, st, r0, wa, ba, wx, bx, lam, out, tmpf);
        hipLaunchKernelGGL(nv::lru_scan_naive, dim3(B_ * 1024 / 64), dim3(64), 0, st, out, tmpf, gl, r0);
        break;
    case 3: nv::run_gemm<nv::ALbf16, nv::EpiMP, false>(st, nv::ALbf16{att, 512}, w_ua, 1024, nullptr, T_, 1024, 512, nv::EpiMP{sga, mp}); break;
    case 4: nv::run_gemm<nv::ALbf16, nv::EpiMerged, false>(st, nv::ALbf16{r0, 1024}, w_ul, 1024, nullptr, T_, 1024, 1024, nv::EpiMerged{sgl, mp, merged}); break;
    case 5:
        nv::run_gemm<nv::ALbf16, nv::EpiH1, false>(st, nv::ALbf16{merged, 1024}, w_o, 1024, nullptr, T_, 1024, 1024, nv::EpiH1{x, out, r0});
        hipLaunchKernelGGL(nv::rowsq, dim3(T_ / 4), dim3(256), 0, st, out, (float*)nullptr, part2);
        break;
    case 6:
        for (int half = 0; half < 2; ++half) {
            nv::run_gemm<nv::ALf32, nv::EpiScaleF32, false>(st, nv::ALf32{out, 1024}, wq + half * 1024, 2048, g_ffn, T_, 1024, 1024, nv::EpiScaleF32{part2, tmpf, 1024});
            for (int hl = 0; hl < 4; ++hl)
                for (int hf = 0; hf < 2; ++hf)
                    nv::run_gemm<nv::ALf32, nv::EpiPlainF32, true>(st, nv::ALf32{tmpf + hl * 256 + hf * 128, 1024}, hf ? k2 : k1, 128, nullptr, T_, 128, 128, nv::EpiPlainF32{sc + hl * 256 + hf * 128, 1024});
            hipLaunchKernelGGL(topk_kernel, dim3(T_ / TK_TOK), dim3(512), TK_LDS_BYTES, st, sc, half * 4, seli, selg);
        }
        break;
    case 7: hipLaunchKernelGGL(gather_kernel<0>, dim3(1024), dim3(256), 0, st, (const void*)pu, (const void*)pv, g_ffn, seli, selg, part2, out, h2b, rstd3); break;
    case 8: nv::run_gemm<nv::ALf32, nv::EpiPP, false>(st, nv::ALf32{p, 256}, w_proj, 1024, nullptr, T_, 1024, 256, nv::EpiPP{pp}); break;
    case 9: nv::run_gemm<nv::ALbf16, nv::EpiH3, false>(st, nv::ALbf16{h2b, 1024}, w_gate, 1024, g_ple, T_, 1024, 1024, nv::EpiH3{rstd3, pp, out});
        hipLaunchKernelGGL(nv::rowsq, dim3(T_ / 4), dim3(256), 0, st, out, (float*)nullptr, part4);
        break;
    case 10: hipLaunchKernelGGL(nv::final_norm, dim3(T_ / 4), dim3(256), 0, st, out, part4, final_g); break;
    }
}

extern "C" void kernel_launch(void* const* d_in, const int* in_sizes, int n_in, void* d_out, int out_size, void* d_ws, size_t ws_size, hipStream_t stream) {
    static int grid = 0;
    if (grid == 0) {
        if (n_in != 25 || out_size != T_ * 1024 || ws_size < WS_END) { fprintf(stderr, "kernel_launch: unexpected sizes n_in %d out %d ws %zu\n", n_in, out_size, ws_size); }
        (void)hipFuncSetAttribute((const void*)topk_kernel, hipFuncAttributeMaxDynamicSharedMemorySize, TK_LDS_BYTES);
        int dev = 0, cus = 0, per_cu = 0;
        (void)hipGetDevice(&dev); (void)hipDeviceGetAttribute(&cus, hipDeviceAttributeMultiprocessorCount, dev);
        if (hipFuncSetAttribute((const void*)fused_fwd, hipFuncAttributeMaxDynamicSharedMemorySize, LDS_BYTES) != hipSuccess) fprintf(stderr, "kernel_launch: hipFuncSetAttribute(fused_fwd) failed\n");
        if (hipOccupancyMaxActiveBlocksPerMultiprocessor(&per_cu, (const void*)fused_fwd, NWAVES * 64, LDS_BYTES) != hipSuccess || per_cu < 1) fprintf(stderr, "kernel_launch: occupancy query says %d blocks/CU\n", per_cu);
        (void)hipGetLastError();
        grid = cus > 0 ? cus : 256;
    }
    unsigned char* ws = (unsigned char*)d_ws; float* out = (float*)d_out;
    const unsigned mask = FUSED_MASK;
    if (mask) (void)hipMemsetAsync(ws + WS_CTL, 0, CTL_ZERO_BYTES, stream);
    Args a{};
    for (int i = 0; i < 25; ++i) a.in[i] = (const float*)d_in[i];
    a.out = out; a.ws = ws;
    int li = 0;
    auto launch = [&](int lo, int hi) {
        if (MERGE_LAUNCHES) { a.ph_lo = lo; a.ph_hi = hi; a.li = li++; hipLaunchKernelGGL(fused_fwd, dim3(grid), dim3(NWAVES * 64), LDS_BYTES, stream, a); }
        else for (int ph = lo; ph < hi; ++ph) { a.ph_lo = ph; a.ph_hi = ph + 1; a.li = li++; hipLaunchKernelGGL(fused_fwd, dim3(grid), dim3(NWAVES * 64), LDS_BYTES, stream, a); }
    };
    int pend_lo = -1, pend_hi = -1;
    if (mask && !(mask & 1)) launch(0, 1);
    for (int gidx = 0; gidx < 11; ++gidx) {
#if (defined(LRU_T2) && LRU_T2) || (defined(LRU_T3) && LRU_T3)
        if (gidx == 2 && (mask & 4u)) {
            if (pend_lo >= 0) { launch(pend_lo, pend_hi); pend_lo = -1; }
            launch(3, 4);
            hipLaunchKernelGGL(nv::lru_finish_naive_L<(LRU_T2 ? 16 : 64)>, dim3(B_ * 1024 / 64), dim3(64), 0, stream, (const bf16*)(ws + WS_HLOC), (const bf16*)(ws + WS_PCUM), (const bf16*)(ws + WS_GL), (bf16*)(ws + WS_R0));
            continue;
        }
#endif
        if (mask & (1u << gidx)) {
            if (pend_lo < 0) { pend_lo = GRP_LO[gidx]; pend_hi = GRP_HI[gidx]; } else pend_hi = GRP_HI[gidx];
        } else {
            if (pend_lo >= 0) { launch(pend_lo, pend_hi); pend_lo = -1; }
            naive_group(gidx, d_in, out, ws, stream);
        }
    }
    if (pend_lo >= 0) launch(pend_lo, pend_hi);
#if defined(LRU_DEBUG) && LRU_DEBUG == 2
    hipLaunchKernelGGL(nv::poison_if, dim3(T_ * 1024 / 256), dim3(256), 0, stream, out, (const unsigned*)(ws + WS_CTL) + 64);
#endif
}
```

```cpp
#include <hip/hip_runtime.h>
#include <cstdio>
#include <cstdint>
#include <cmath>

#ifndef FUSED_MASK
#define FUSED_MASK 0x7ff
#endif
#ifndef MERGE_LAUNCHES
#define MERGE_LAUNCHES 1
#endif
#ifndef LRU_PADDED
#define LRU_PADDED 1
#endif
#ifndef FUSE_FINAL
#define FUSE_FINAL 0
#endif
#ifndef GATHER_ROWS
#define GATHER_ROWS 1
#endif
#define ALL_FUSED ((FUSED_MASK) == 0x7ff && (MERGE_LAUNCHES))
constexpr int B_ = 8, S_ = 2048, D_ = 1024, T_ = B_ * S_;
constexpr int INW = 4864;
constexpr float EPS = 1e-6f;
typedef unsigned short bf16;
#define HD_INLINE __host__ __device__ __forceinline__

constexpr size_t MiB = 1u << 20;
constexpr size_t WS_CTL = 0;
constexpr size_t WS_WIN = 1 * MiB;
constexpr size_t WS_WUA = WS_WIN + 4864 * 1024 * 2;
constexpr size_t WS_WUL = WS_WUA + 1 * MiB;
constexpr size_t WS_WO = WS_WUL + 2 * MiB;
constexpr size_t WS_WFOLD = WS_WO + 2 * MiB;
constexpr size_t WS_WG = WS_WFOLD + 4 * MiB;
constexpr size_t WS_WPROJ = WS_WG + 2 * MiB;
constexpr size_t WS_WAX = WS_WPROJ + MiB / 2;
constexpr size_t WS_W_END = WS_WAX + 1 * MiB;
static_assert(WS_W_END <= 23 * MiB, "weights");
constexpr size_t WS_RSTD1 = 23 * MiB;
constexpr size_t WS_PART2 = WS_RSTD1 + 256 * 1024;
constexpr size_t WS_PART4 = WS_PART2 + 1 * MiB;
constexpr size_t WS_RSTD3 = WS_PART4 + 1 * MiB;
constexpr size_t WS_AGG = WS_RSTD3 + 256 * 1024;
constexpr size_t WS_C8 = WS_AGG + 2 * MiB;
constexpr size_t WS_USCALE = WS_C8 + 64 * 1024;
static_assert(WS_USCALE + 128 * 1024 <= 28 * MiB, "small");
constexpr size_t WS_PB = 28 * MiB;
constexpr size_t WS_R0 = 36 * MiB;
constexpr size_t WS_QKV = 68 * MiB;
constexpr size_t WS_LX = 92 * MiB;
constexpr size_t WS_GL = 140 * MiB;
constexpr size_t WS_SGA = 172 * MiB;
constexpr size_t WS_SGL = 204 * MiB;
constexpr size_t WS_ATT = 236 * MiB;
constexpr size_t WS_HLOC = 68 * MiB, WS_PCUM = 100 * MiB;
constexpr size_t WS_MP = 68 * MiB;
constexpr size_t WS_MERGED = 140 * MiB;
constexpr size_t WS_SC = 172 * MiB;
constexpr size_t WS_SELI = 236 * MiB, WS_SELG = 244 * MiB;
constexpr size_t WS_U16 = 68 * MiB, WS_V16 = 100 * MiB;
constexpr size_t WS_H2B = 140 * MiB;
constexpr size_t WS_PP = 172 * MiB;
constexpr size_t WS_PP2 = 100 * MiB;
constexpr size_t WS_NAIVE_AB = 68 * MiB;
constexpr size_t WS_WAXD = 252 * MiB;
constexpr size_t WS_END = 256 * MiB;

HD_INLINE float bf2f(bf16 v) { return __builtin_bit_cast(float, (unsigned)v << 16); }
HD_INLINE bf16 f2bf(float f) { unsigned u = __builtin_bit_cast(unsigned, f); return (bf16)((u + 0x7fffu + ((u >> 16) & 1u)) >> 16); }
HD_INLINE unsigned pk2(float lo, float hi) { return (unsigned)f2bf(lo) | ((unsigned)f2bf(hi) << 16); }
__device__ __forceinline__ float wave_sum(float v) {
#pragma unroll
    for (int o = 1; o < 64; o <<= 1) v += __shfl_xor(v, o);
    return v;
}
__device__ __forceinline__ float sigmoidf_(float z) { return __builtin_amdgcn_rcpf(1.0f + __builtin_amdgcn_exp2f(-1.4426950408889634f * z)); }
__device__ __forceinline__ float gelu_tanh(float x) { const float u = 1.5957691216057308f * (x + 0.044715f * x * x * x); return x * sigmoidf_(u); }
__device__ __forceinline__ int fresh_lane() { int l; asm volatile("v_mbcnt_lo_u32_b32 %0, -1, 0\n\tv_mbcnt_hi_u32_b32 %0, -1, %0" : "=v"(l)); return l; }
#ifndef HD_INLINE
#define HD_INLINE __host__ __device__ __forceinline__
#endif

HD_INLINE unsigned tk_umax(unsigned a, unsigned b) { return a > b ? a : b; }
HD_INLINE unsigned tk_umin(unsigned a, unsigned b) { return a < b ? a : b; }
HD_INLINE unsigned tk_f2key(float f) { unsigned u = __builtin_bit_cast(unsigned, f); return u ^ ((unsigned)((int)u >> 31) | 0x80000000u); }
HD_INLINE float tk_key2f(unsigned k) { unsigned u = (k & 0x80000000u) ? (k ^ 0x80000000u) : ~k; return __builtin_bit_cast(float, u); }

HD_INLINE void tk_sort16(unsigned (&a)[16]) {
#pragma unroll
    for (int k = 2; k <= 16; k <<= 1) {
#pragma unroll
        for (int j = k >> 1; j > 0; j >>= 1) {
#pragma unroll
            for (int i = 0; i < 16; ++i) {
                const int p = i ^ j;
                if (p > i) {
                    const unsigned mx = tk_umax(a[i], a[p]), mn = tk_umin(a[i], a[p]);
                    if ((i & k) == 0) { a[i] = mx; a[p] = mn; } else { a[i] = mn; a[p] = mx; }
                }
            }
        }
    }
}
HD_INLINE void tk_merge16(unsigned (&a)[16], const unsigned (&b)[16]) {
#pragma unroll
    for (int i = 0; i < 16; ++i) a[i] = tk_umax(a[i], b[15 - i]);
#pragma unroll
    for (int j = 8; j > 0; j >>= 1) {
#pragma unroll
        for (int i = 0; i < 16; ++i) {
            const int p = i ^ j;
            if (p > i) { const unsigned mx = tk_umax(a[i], a[p]), mn = tk_umin(a[i], a[p]); a[i] = mx; a[p] = mn; }
        }
    }
}
HD_INLINE void tk_insert16(unsigned (&best)[16], unsigned key) {
#pragma unroll
    for (int s = 0; s < 16; ++s) { const unsigned hi = tk_umax(best[s], key); key = tk_umin(best[s], key); best[s] = hi; }
}
HD_INLINE void tk_combine_store(const unsigned (&k1)[16], const unsigned (&k2)[16], int* oi, float* og) {
    float v1[16], v2[16];
#pragma unroll
    for (int i = 0; i < 16; ++i) { v1[i] = tk_key2f(k1[i] & ~127u); v2[i] = tk_key2f(k2[i] & ~127u); }
    unsigned best[16];
#pragma unroll
    for (int s = 0; s < 16; ++s) best[s] = 0u;
#pragma unroll
    for (int i = 0; i < 16; ++i) {
#pragma unroll
        for (int j = 0; j < 16; ++j) {
            if ((i + 1) * (j + 1) <= 16) {
                const float s = v1[i] + v2[j];
                const unsigned key = (tk_f2key(s) & ~255u) | (unsigned)(255 - (i * 16 + j));
                tk_insert16(best, key);
            }
        }
    }
    const unsigned thr = best[15];
    const float mx = tk_key2f(best[0] & ~255u);
    float sum = 0.f;
#pragma unroll
    for (int i = 0; i < 16; ++i) {
#pragma unroll
        for (int j = 0; j < 16; ++j) {
            if ((i + 1) * (j + 1) <= 16) {
                const float s = v1[i] + v2[j];
                const unsigned key = (tk_f2key(s) & ~255u) | (unsigned)(255 - (i * 16 + j));
                if (key >= thr) sum += __builtin_expf(s - mx);
            }
        }
    }
    const float inv = 1.0f / sum;
    int cnt = 0;
#pragma unroll
    for (int i = 0; i < 16; ++i) {
#pragma unroll
        for (int j = 0; j < 16; ++j) {
            if ((i + 1) * (j + 1) <= 16) {
                const float s = v1[i] + v2[j];
                const unsigned key = (tk_f2key(s) & ~255u) | (unsigned)(255 - (i * 16 + j));
                if (key >= thr) {
                    oi[cnt] = (127 - (int)(k1[i] & 127u)) * 128 + (127 - (int)(k2[j] & 127u));
                    og[cnt] = __builtin_expf(s - mx) * inv;
                    ++cnt;
                }
            }
        }
    }
}
namespace nv {
struct ALf32 { const float* p; int lda; int pad; __device__ __forceinline__ float operator()(int m, int k) const { return p[(size_t)m * lda + k]; } };
struct ALbf16 { const bf16* p; int lda; int pad; __device__ __forceinline__ float operator()(int m, int k) const { return bf2f(p[(size_t)m * lda + k]); } };

template <class AL, class EPI, bool BT>
__global__ void __launch_bounds__(256) ngemm(AL al, const float* __restrict__ B, int ldb, const float* __restrict__ ks, int M, int N, int K, EPI epi) {
    __shared__ float As[16][68];
    __shared__ float Bs[16][68];
    const int tid = threadIdx.x, tx = tid & 15, ty = tid >> 4;
    const int m0 = blockIdx.y * 64, n0 = blockIdx.x * 64;
    float acc[4][4];
#pragma unroll
    for (int i = 0; i < 4; ++i)
#pragma unroll
        for (int j = 0; j < 4; ++j) acc[i][j] = 0.f;
    for (int k0 = 0; k0 < K; k0 += 16) {
#pragma unroll
        for (int i = 0; i < 4; ++i) {
            const int e = tid + i * 256;
            { const int m = e >> 4, k = e & 15; float v = al(m0 + m, k0 + k); if (ks) v *= ks[k0 + k]; As[k][m] = v; }
            if (BT) { const int n = e >> 4, k = e & 15; Bs[k][n] = B[(size_t)(n0 + n) * ldb + k0 + k]; }
            else { const int k = e >> 6, n = e & 63; Bs[k][n] = B[(size_t)(k0 + k) * ldb + n0 + n]; }
        }
        __syncthreads();
#pragma unroll
        for (int k = 0; k < 16; ++k) {
            float a[4], b[4];
#pragma unroll
            for (int i = 0; i < 4; ++i) { a[i] = As[k][ty * 4 + i]; b[i] = Bs[k][tx * 4 + i]; }
#pragma unroll
            for (int i = 0; i < 4; ++i)
#pragma unroll
                for (int j = 0; j < 4; ++j) acc[i][j] = fmaf(a[i], b[j], acc[i][j]);
        }
        __syncthreads();
    }
#pragma unroll
    for (int i = 0; i < 4; ++i)
#pragma unroll
        for (int j = 0; j < 4; ++j) epi(m0 + ty * 4 + i, n0 + tx * 4 + j, acc[i][j]);
}
template <class AL, class EPI, bool BT>
static void run_gemm(hipStream_t st, AL al, const float* B, int ldb, const float* ks, int M, int N, int K, EPI epi) {
    hipLaunchKernelGGL((ngemm<AL, EPI, BT>), dim3(N / 64, M / 64), dim3(256), 0, st, al, B, ldb, ks, M, N, K, epi);
}

__global__ void __launch_bounds__(256) rowsq(const float* __restrict__ X, float* rstd, float* part) {
    const int row = blockIdx.x * 4 + (threadIdx.x >> 6), lane = threadIdx.x & 63;
    const float* xr = X + (size_t)row * 1024;
    float s = 0.f;
    for (int j = 0; j < 16; ++j) { const float v = xr[lane + 64 * j]; s += v * v; }
    s = wave_sum(s);
    if (rstd && lane == 0) rstd[row] = 1.0f / sqrtf(s * (1.0f / 1024.0f) + EPS);
    if (part && lane < 16) part[(size_t)row * 16 + lane] = (lane == 0) ? s : 0.f;
}

struct EpiProj {
    const float* rstd; bf16 *qkv, *lx, *gl, *sga, *sgl;
    __device__ __forceinline__ void operator()(int m, int n, float v) const {
        v *= rstd[m];
        if (n < 768) qkv[(size_t)m * 768 + n] = f2bf(v);
        else if (n < 1792) lx[(size_t)m * 1024 + (n - 768)] = f2bf(v);
        else if (n < 2816) gl[(size_t)m * 1024 + (n - 1792)] = f2bf(gelu_tanh(v));
        else if (n < 3840) sga[(size_t)m * 1024 + (n - 2816)] = f2bf(sigmoidf_(v));
        else sgl[(size_t)m * 1024 + (n - 3840)] = f2bf(sigmoidf_(v));
    }
};

__global__ void __launch_bounds__(128) attn_naive(const bf16* __restrict__ qkv, const float* __restrict__ sink, bf16* __restrict__ att) {
    const int gid = blockIdx.x * 128 + threadIdx.x;
    const int head = gid / T_, t = gid % T_;
    const int b = t / S_, ts = t % S_;
    const int g = head >> 2;
    float q[64], acc[64];
    const bf16* qp = qkv + (size_t)t * 768 + head * 64;
#pragma unroll
    for (int d = 0; d < 64; ++d) { q[d] = bf2f(qp[d]); acc[d] = 0.f; }
    const float slope = exp2f(-(float)(head + 1));
    float m = -3.0e38f, l = 0.f;
    for (int dist = 127; dist >= 0; --dist) {
        const int s = ts - dist; if (s < 0) continue;
        const bf16* kp = qkv + (size_t)(b * S_ + s) * 768 + 512 + g * 64;
        const bf16* vp = kp + 128;
        float sc = 0.f;
#pragma unroll
        for (int d = 0; d < 64; ++d) sc = fmaf(q[d], bf2f(kp[d]), sc);
        sc = sc * 0.125f - slope * (float)dist;
        const float mn = fmaxf(m, sc), corr = __expf(m - mn), p = __expf(sc - mn);
        l = l * corr + p;
#pragma unroll
        for (int d = 0; d < 64; ++d) acc[d] = acc[d] * corr + p * bf2f(vp[d]);
        m = mn;
    }
    const float sk = sink[head];
    const float mf = fmaxf(m, sk), corr = __expf(m - mf);
    l = l * corr + __expf(sk - mf);
    const float inv = corr / l;
    bf16* op = att + (size_t)t * 512 + head * 64;
#pragma unroll
    for (int d = 0; d < 64; ++d) op[d] = f2bf(acc[d] * inv);
}

__global__ void __launch_bounds__(256) conv_naive(const bf16* __restrict__ lx, const float* __restrict__ cw, const float* __restrict__ cb, bf16* __restrict__ lin) {
    const size_t i = (size_t)blockIdx.x * 256 + threadIdx.x;
    const int c = (int)(i & 1023); const int t = (int)(i >> 10); const int ts = t % S_;
    float y = cb[c];
#pragma unroll
    for (int tap = 0; tap < 4; ++tap) { const int s = ts - 3 + tap; if (s >= 0) y = fmaf(bf2f(lx[(size_t)(t - 3 + tap) * 1024 + c]), cw[tap * 1024 + c], y); }
    lin[i] = f2bf(y);
}

__global__ void __launch_bounds__(128) lru_ab_naive(const bf16* __restrict__ lin, const float* __restrict__ wa, const float* __restrict__ ba, const float* __restrict__ wx, const float* __restrict__ bx,
                                                    const float* __restrict__ lam, float* __restrict__ Af, float* __restrict__ Bf) {
    __shared__ float xs[128];
    const int t = blockIdx.x >> 3, blk = blockIdx.x & 7, d = threadIdx.x, ch = blk * 128 + d;
    xs[d] = bf2f(lin[(size_t)t * 1024 + ch]);
    __syncthreads();
    float r = ba[ch], ii = bx[ch];
    const float* wap = wa + (size_t)blk * 128 * 128 + d; const float* wxp = wx + (size_t)blk * 128 * 128 + d;
    for (int c = 0; c < 128; ++c) { r = fmaf(xs[c], wap[c * 128], r); ii = fmaf(xs[c], wxp[c * 128], ii); }
    r = sigmoidf_(r); ii = sigmoidf_(ii);
    const float sp = log1pf(expf(-lam[ch]));
    const float loga = -8.0f * r * sp;
    const float a = expf(loga);
    const float bb = sqrtf(-expm1f(2.0f * loga)) * (ii * xs[d]);
    Af[(size_t)t * 1024 + ch] = a; Bf[(size_t)t * 1024 + ch] = bb;
}
__global__ void __launch_bounds__(256) lru_ab_from_pre(const bf16* __restrict__ lin, const float* __restrict__ ba, const float* __restrict__ bx, const float* __restrict__ lam, float* __restrict__ Af, float* __restrict__ Bf) {
    const size_t i = (size_t)blockIdx.x * 256 + threadIdx.x; const int ch = (int)(i & 1023);
    const float r = sigmoidf_(Af[i] + ba[ch]), ii = sigmoidf_(Bf[i] + bx[ch]);
    const float loga = -8.0f * r * log1pf(expf(-lam[ch]));
    Af[i] = expf(loga); Bf[i] = sqrtf(-expm1f(2.0f * loga)) * (ii * bf2f(lin[i]));
}
template <int L>
__global__ void __launch_bounds__(64) lru_finish_naive_L(const bf16* __restrict__ hloc, const bf16* __restrict__ pcum, const bf16* __restrict__ gl, bf16* __restrict__ rec) {
    const int gid = blockIdx.x * 64 + threadIdx.x; const int b = gid >> 10, ch = gid & 1023;
    float carry = 0.f;
    for (int c = 0; c < S_ / L; ++c) {
        float la = 1.f, lb = 0.f;
        for (int s = 0; s < L; ++s) { const size_t o = (size_t)(b * S_ + c * L + s) * 1024 + ch; la = bf2f(pcum[o]); lb = bf2f(hloc[o]); const float h = la * carry + lb; rec[o] = f2bf(h * bf2f(gl[o])); }
        carry = la * carry + lb;
    }
}
__global__ void __launch_bounds__(64) lru_finish_naive(const bf16* __restrict__ hloc, const bf16* __restrict__ pcum, const float* __restrict__ agg, const bf16* __restrict__ gl, bf16* __restrict__ rec) {
    const int gid = blockIdx.x * 64 + threadIdx.x; const int b = gid >> 10, ch = gid & 1023;
    float carry = 0.f;
    for (int c = 0; c < 32; ++c) {
        const int chunk = b * 32 + c;
        for (int s = 0; s < 64; ++s) { const size_t o = (size_t)(chunk * 64 + s) * 1024 + ch; const float h = bf2f(pcum[o]) * carry + bf2f(hloc[o]); rec[o] = f2bf(h * bf2f(gl[o])); }
        const float* ap = agg + ((size_t)chunk * 1024 + ch) * 2; carry = ap[0] * carry + ap[1];
    }
}
__global__ void __launch_bounds__(128) lru_pre_check(const bf16* __restrict__ lin, const float* __restrict__ wa, const float* __restrict__ wx, const float* __restrict__ Rp, const float* __restrict__ Ip, unsigned* flag) {
    __shared__ float xs[128];
    const int t = blockIdx.x >> 3, blk = blockIdx.x & 7, d = threadIdx.x, ch = blk * 128 + d;
    xs[d] = bf2f(lin[(size_t)t * 1024 + ch]);
    __syncthreads();
    float r = 0.f, ii = 0.f;
    const float* wap = wa + (size_t)blk * 128 * 128 + d; const float* wxp = wx + (size_t)blk * 128 * 128 + d;
    for (int c = 0; c < 128; ++c) { r = fmaf(xs[c], wap[c * 128], r); ii = fmaf(xs[c], wxp[c * 128], ii); }
    const float dr = fabsf(r - Rp[(size_t)t * 1024 + ch]), di = fabsf(ii - Ip[(size_t)t * 1024 + ch]);
    if (!(dr < 0.08f + 0.03f * fabsf(r)) || !(di < 0.08f + 0.03f * fabsf(ii))) atomicAdd(flag, 1u);
}
__global__ void __launch_bounds__(256) poison_if(float* out, const unsigned* flag) { if (*flag) { const size_t i = (size_t)blockIdx.x * 256 + threadIdx.x; out[i] = out[i] * 50.0f + 3.0f; } }
__global__ void __launch_bounds__(64) lru_scan_naive(const float* __restrict__ Af, const float* __restrict__ Bf, const bf16* __restrict__ gl, bf16* __restrict__ rec) {
    const int gid = blockIdx.x * 64 + threadIdx.x; const int b = gid >> 10, ch = gid & 1023;
    float h = 0.f;
    for (int s = 0; s < S_; ++s) { const size_t o = (size_t)(b * S_ + s) * 1024 + ch; h = fmaf(Af[o], h, Bf[o]); rec[o] = f2bf(h * bf2f(gl[o])); }
}

struct EpiMP { const bf16* sga; float* mp; __device__ __forceinline__ void operator()(int m, int n, float v) const { const size_t o = (size_t)m * 1024 + n; mp[o] = v * bf2f(sga[o]); } };
struct EpiMerged { const bf16* sgl; const float* mp; bf16* merged; __device__ __forceinline__ void operator()(int m, int n, float v) const { const size_t o = (size_t)m * 1024 + n; merged[o] = f2bf(mp[o] + v * bf2f(sgl[o])); } };
struct EpiH1 { const float* x; float* h1; bf16* h1b; __device__ __forceinline__ void operator()(int m, int n, float v) const { const size_t o = (size_t)m * 1024 + n; const float h = x[o] + v; h1[o] = h; h1b[o] = f2bf(h); } };
struct EpiScaleF32 { const float* part; float* out; int ldo; int pad; __device__ __forceinline__ void operator()(int m, int n, float v) const {
    float s = 0.f; for (int i = 0; i < 16; ++i) s += part[(size_t)m * 16 + i];
    out[(size_t)m * ldo + n] = v * (1.0f / sqrtf(s * (1.0f / 1024.0f) + EPS)); } };
struct EpiPlainF32 { float* out; int ldo; int pad; __device__ __forceinline__ void operator()(int m, int n, float v) const { out[(size_t)m * ldo + n] = v; } };
struct EpiPP { bf16* pp; __device__ __forceinline__ void operator()(int m, int n, float v) const { pp[(size_t)m * 1024 + n] = f2bf(v); } };
struct EpiH3 { const float* rstd3; const bf16* pp; float* h; __device__ __forceinline__ void operator()(int m, int n, float v) const { const size_t o = (size_t)m * 1024 + n; h[o] = h[o] + sigmoidf_(v * rstd3[m]) * bf2f(pp[o]); } };

__global__ void __launch_bounds__(256) final_norm(float* __restrict__ h, const float* __restrict__ part, const float* __restrict__ fg) {
    const int row = blockIdx.x * 4 + (threadIdx.x >> 6), lane = threadIdx.x & 63;
    float s = 0.f; for (int i = 0; i < 16; ++i) s += part[(size_t)row * 16 + i];
    const float r = 1.0f / sqrtf(s * (1.0f / 1024.0f) + EPS);
    float* hr = h + (size_t)row * 1024;
    for (int j = 0; j < 16; ++j) { const int c = lane + 64 * j; hr[c] = hr[c] * r * fg[c]; }
}
}
#define LAS __attribute__((address_space(3)))
typedef float f32x4 __attribute__((ext_vector_type(4)));
typedef unsigned u32x4 __attribute__((ext_vector_type(4)));
typedef int i32x4 __attribute__((ext_vector_type(4)));

constexpr int TK_TOK = 32;
constexpr int TK_LSTRIDE = 132;
constexpr int TK_LDS_BYTES = 256 * TK_LSTRIDE * 4;

__device__ __forceinline__ void topk_item(LAS float* lds, const float* __restrict__ SC, int item, int head_base, int* __restrict__ seli, float* __restrict__ selg, int tid) {
    const f32x4* src = (const f32x4*)(SC + (size_t)item * TK_TOK * 1024);
#pragma unroll 4
    for (int i = 0; i < 16; ++i) {
        const int idx = tid + i * 512; const int row = idx >> 8, c4 = idx & 255;
        const f32x4 v = src[idx];
        const int list = row * 8 + (c4 >> 5), elem = (c4 & 31) * 4;
        *(LAS f32x4*)(lds + list * TK_LSTRIDE + elem) = v;
    }
    __syncthreads();
    if (tid < 256) {
        const LAS float* my = lds + tid * TK_LSTRIDE;
        unsigned acc[16];
#pragma unroll
        for (int g = 0; g < 8; ++g) {
            unsigned t[16];
#pragma unroll
            for (int q = 0; q < 4; ++q) {
                const f32x4 v = *(const LAS f32x4*)(my + g * 16 + q * 4);
#pragma unroll
                for (int c = 0; c < 4; ++c) { const int e = g * 16 + q * 4 + c; t[q * 4 + c] = (tk_f2key(v[c]) & ~127u) | (unsigned)(127 - e); }
            }
            tk_sort16(t);
            if (g == 0) {
#pragma unroll
                for (int i = 0; i < 16; ++i) acc[i] = t[i];
            } else tk_merge16(acc, t);
        }
        unsigned oth[16];
#pragma unroll
        for (int i = 0; i < 16; ++i) oth[i] = (unsigned)__shfl_xor((int)acc[i], 1);
        if ((tid & 1) == 0) {
            const int tok = item * TK_TOK + (tid >> 3), head = head_base + ((tid >> 1) & 3);
            tk_combine_store(acc, oth, seli + (size_t)tok * 128 + head * 16, selg + (size_t)tok * 128 + head * 16);
        }
    }
    __syncthreads();
}
__global__ void __launch_bounds__(512) topk_kernel(const float* __restrict__ SC, int head_base, int* __restrict__ seli, float* __restrict__ selg) {
    extern __shared__ __attribute__((aligned(16))) unsigned char dyn_lds[];
    for (int item = blockIdx.x; item < T_ / TK_TOK; item += gridDim.x) topk_item((LAS float*)dyn_lds, SC, item, head_base, seli, selg, (int)threadIdx.x);
}

template <int MODE>
__device__ __forceinline__ void gather_token(int t, int lane, const void* __restrict__ Utab, const void* __restrict__ Vtab, const float* __restrict__ gffn,
                                             const int* __restrict__ seli, const float* __restrict__ selg, const float* __restrict__ part2,
                                             float* __restrict__ H  , bf16* __restrict__ h2b, float* __restrict__ rstd3) {
    float ps = (lane < 16) ? part2[(size_t)t * 16 + lane] : 0.f;
    ps = wave_sum(ps);
    const float rstd2 = 1.0f / sqrtf(ps * (1.0f / 1024.0f) + EPS);
    const int iA = seli[(size_t)t * 128 + lane], iB = seli[(size_t)t * 128 + 64 + lane];
    const float gA = selg[(size_t)t * 128 + lane], gB = selg[(size_t)t * 128 + 64 + lane];
    float* hr = H + (size_t)t * 1024;
    if constexpr (MODE == 0) {
        f32x4 x[4], y[4], hv[4];
#pragma unroll
        for (int j = 0; j < 4; ++j) { hv[j] = *(const f32x4*)(hr + 256 * j + 4 * lane); const f32x4 g = *(const f32x4*)(gffn + 256 * j + 4 * lane); x[j] = hv[j] * g; y[j] = (f32x4){0.f, 0.f, 0.f, 0.f}; }
        const float* U = (const float*)Utab; const float* V = (const float*)Vtab;
        for (int k = 0; k < 64; ++k) {
#pragma unroll
            for (int hh = 0; hh < 2; ++hh) {
                const int e = __builtin_amdgcn_readlane(hh ? iB : iA, k);
                const float gt = __builtin_bit_cast(float, __builtin_amdgcn_readlane(__builtin_bit_cast(int, hh ? gB : gA), k));
                const float* ur = U + (size_t)e * 1024; const float* vr = V + (size_t)e * 1024;
                f32x4 uv[4], vv[4];
#pragma unroll
                for (int j = 0; j < 4; ++j) { uv[j] = *(const f32x4*)(ur + 256 * j + 4 * lane); vv[j] = *(const f32x4*)(vr + 256 * j + 4 * lane); }
                float d = 0.f;
#pragma unroll
                for (int j = 0; j < 4; ++j) d += (uv[j].x * x[j].x + uv[j].y * x[j].y) + (uv[j].z * x[j].z + uv[j].w * x[j].w);
                d = wave_sum(d);
                const float c = gt * gelu_tanh(d * rstd2);
#pragma unroll
                for (int j = 0; j < 4; ++j) y[j] += vv[j] * c;
            }
        }
        float sq = 0.f;
#pragma unroll
        for (int j = 0; j < 4; ++j) {
            const f32x4 h2 = hv[j] + y[j];
            *(f32x4*)(hr + 256 * j + 4 * lane) = h2;
            sq += (h2.x * h2.x + h2.y * h2.y) + (h2.z * h2.z + h2.w * h2.w);
            uint2 w; w.x = pk2(h2.x, h2.y); w.y = pk2(h2.z, h2.w);
            *(uint2*)(h2b + (size_t)t * 1024 + 256 * j + 4 * lane) = w;
        }
        sq = wave_sum(sq);
        if (lane == 0) rstd3[t] = 1.0f / sqrtf(sq * (1.0f / 1024.0f) + EPS);
    } else {
        float x[2][8], y[2][8], hv[2][8];
#pragma unroll
        for (int j = 0; j < 2; ++j) {
            const f32x4 a = *(const f32x4*)(hr + 512 * j + 8 * lane), b = *(const f32x4*)(hr + 512 * j + 8 * lane + 4);
            hv[j][0] = a.x; hv[j][1] = a.y; hv[j][2] = a.z; hv[j][3] = a.w; hv[j][4] = b.x; hv[j][5] = b.y; hv[j][6] = b.z; hv[j][7] = b.w;
#pragma unroll
            for (int c = 0; c < 8; ++c) { x[j][c] = hv[j][c]; y[j][c] = 0.f; }
        }
        const bf16* U = (const bf16*)Utab; const bf16* V = (const bf16*)Vtab;
        for (int k = 0; k < 64; k += 2) {
            u32x4 uv[4][2], vv[4][2]; float gt[4];
#pragma unroll
            for (int q = 0; q < 4; ++q) {
                const int kk = k + (q >> 1); const int hh = q & 1;
                const int e = __builtin_amdgcn_readlane(hh ? iB : iA, kk);
                gt[q] = __builtin_bit_cast(float, __builtin_amdgcn_readlane(__builtin_bit_cast(int, hh ? gB : gA), kk));
                const bf16* ur = U + (size_t)e * 1024; const bf16* vr = V + (size_t)e * 1024;
#pragma unroll
                for (int j = 0; j < 2; ++j) { uv[q][j] = *(const u32x4*)(ur + 512 * j + 8 * lane); vv[q][j] = *(const u32x4*)(vr + 512 * j + 8 * lane); }
            }
#pragma unroll
            for (int q = 0; q < 4; ++q) {
                float d = 0.f;
#pragma unroll
                for (int j = 0; j < 2; ++j)
#pragma unroll
                    for (int c = 0; c < 4; ++c) { const unsigned w = uv[q][j][c]; d = fmaf(__builtin_bit_cast(float, w << 16), x[j][2 * c], d); d = fmaf(__builtin_bit_cast(float, w & 0xffff0000u), x[j][2 * c + 1], d); }
                d = wave_sum(d);
                const float cf = gt[q] * gelu_tanh(d * rstd2);
#pragma unroll
                for (int j = 0; j < 2; ++j)
#pragma unroll
                    for (int c = 0; c < 4; ++c) { const unsigned w = vv[q][j][c]; y[j][2 * c] = fmaf(__builtin_bit_cast(float, w << 16), cf, y[j][2 * c]); y[j][2 * c + 1] = fmaf(__builtin_bit_cast(float, w & 0xffff0000u), cf, y[j][2 * c + 1]); }
            }
        }
        float sq = 0.f;
#pragma unroll
        for (int j = 0; j < 2; ++j) {
            float h2[8];
#pragma unroll
            for (int c = 0; c < 8; ++c) { h2[c] = hv[j][c] + y[j][c]; sq += h2[c] * h2[c]; }
            *(f32x4*)(hr + 512 * j + 8 * lane) = (f32x4){h2[0], h2[1], h2[2], h2[3]};
            *(f32x4*)(hr + 512 * j + 8 * lane + 4) = (f32x4){h2[4], h2[5], h2[6], h2[7]};
            u32x4 w; w.x = pk2(h2[0], h2[1]); w.y = pk2(h2[2], h2[3]); w.z = pk2(h2[4], h2[5]); w.w = pk2(h2[6], h2[7]);
            *(u32x4*)(h2b + (size_t)t * 1024 + 512 * j + 8 * lane) = w;
        }
        sq = wave_sum(sq);
        if (lane == 0) rstd3[t] = 1.0f / sqrtf(sq * (1.0f / 1024.0f) + EPS);
    }
}
template <int MODE>
__global__ void __launch_bounds__(256) gather_kernel(const void* __restrict__ Utab, const void* __restrict__ Vtab, const float* __restrict__ gffn, const int* __restrict__ seli, const float* __restrict__ selg,
                                                     const float* __restrict__ part2, float* __restrict__ H, bf16* __restrict__ h2b, float* __restrict__ rstd3) {
    const int lane = threadIdx.x & 63; const int w = blockIdx.x * 4 + (threadIdx.x >> 6); const int nw = gridDim.x * 4;
    for (int t = w; t < T_; t += nw) gather_token<MODE>(t, lane, Utab, Vtab, gffn, seli, selg, part2, H, h2b, rstd3);
}

typedef float f32x2 __attribute__((ext_vector_type(2)));
__device__ __forceinline__ float reduce4_transpose(float d0, float d1, float d2, float d3, int lane) {
    const bool b0 = lane & 1, b1 = lane & 2;
    const float a = (b0 ? d1 : d0) + __shfl_xor(b0 ? d0 : d1, 1);
    const float b = (b0 ? d3 : d2) + __shfl_xor(b0 ? d2 : d3, 1);
    float c = (b1 ? b : a) + __shfl_xor(b1 ? a : b, 2);
    c += __shfl_xor(c, 4); c += __shfl_xor(c, 8); c += __shfl_xor(c, 16); c += __shfl_xor(c, 32);
    return c;
}
__device__ __forceinline__ float dot16_fp8(const u32x4 w, const f32x2 (&x2)[8]) {
    f32x2 acc = (f32x2){0.f, 0.f};
#pragma unroll
    for (int c = 0; c < 4; ++c) { const unsigned ww = w[c]; const f32x2 lo = __builtin_amdgcn_cvt_pk_f32_fp8(ww, false), hi = __builtin_amdgcn_cvt_pk_f32_fp8(ww, true); acc = lo * x2[2 * c] + acc; acc = hi * x2[2 * c + 1] + acc; }
    return acc.x + acc.y;
}
__device__ __forceinline__ void axpy16_fp8(const u32x4 w, float cf, f32x2 (&y2)[8]) {
#pragma unroll
    for (int c = 0; c < 4; ++c) { const unsigned ww = w[c]; const f32x2 lo = __builtin_amdgcn_cvt_pk_f32_fp8(ww, false), hi = __builtin_amdgcn_cvt_pk_f32_fp8(ww, true); y2[2 * c] = lo * cf + y2[2 * c]; y2[2 * c + 1] = hi * cf + y2[2 * c + 1]; }
}
__device__ __forceinline__ float sel4f(float v0, float v1, float v2, float v3, int q) { return q == 0 ? v0 : (q == 1 ? v1 : (q == 2 ? v2 : v3)); }
__device__ __forceinline__ void gather_token_fp8(int t, int lane, const unsigned char* __restrict__ U8, const unsigned char* __restrict__ V8, const float* __restrict__ IU, const float* __restrict__ IV,
                                                 const int* __restrict__ seli, const float* __restrict__ selg, const float* __restrict__ part2,
                                                 float* __restrict__ H, bf16* __restrict__ h2b, float* __restrict__ rstd3) {
    float ps = (lane < 16) ? part2[(size_t)t * 16 + lane] : 0.f;
    ps = wave_sum(ps);
    const float rstd2 = 1.0f / sqrtf(ps * (1.0f / 1024.0f) + EPS);
    const int iA = seli[(size_t)t * 128 + lane], iB = seli[(size_t)t * 128 + 64 + lane];
    const float duA = IU[iA] * rstd2, duB = IU[iB] * rstd2;
    const float gvA = selg[(size_t)t * 128 + lane] * IV[iA], gvB = selg[(size_t)t * 128 + 64 + lane] * IV[iB];
    float* hr = H + (size_t)t * 1024 + 16 * lane;
    f32x2 x2[8], y2[8]; f32x4 hv[4];
#pragma unroll
    for (int j = 0; j < 4; ++j) { hv[j] = *(const f32x4*)(hr + 4 * j); x2[2 * j] = (f32x2){hv[j][0], hv[j][1]}; x2[2 * j + 1] = (f32x2){hv[j][2], hv[j][3]}; y2[2 * j] = (f32x2){0.f, 0.f}; y2[2 * j + 1] = (f32x2){0.f, 0.f}; }
    const int q = lane & 3;
#pragma unroll 1
    for (int k = 0; k < 64; k += 4) {
        u32x4 uu[8], vv[8]; float du[8], gv[8];
#pragma unroll
        for (int s = 0; s < 8; ++s) {
            const int kk = k + (s >> 1); const bool hh = s & 1;
            const int e = __builtin_amdgcn_readlane(hh ? iB : iA, kk);
            du[s] = __int_as_float(__builtin_amdgcn_readlane(__float_as_int(hh ? duB : duA), kk));
            gv[s] = __int_as_float(__builtin_amdgcn_readlane(__float_as_int(hh ? gvB : gvA), kk));
            uu[s] = *(const u32x4*)(U8 + (size_t)e * 1024 + 16 * lane);
            vv[s] = *(const u32x4*)(V8 + (size_t)e * 1024 + 16 * lane);
        }
#pragma unroll
        for (int g = 0; g < 2; ++g) {
            const float d0 = dot16_fp8(uu[4 * g + 0], x2), d1 = dot16_fp8(uu[4 * g + 1], x2), d2 = dot16_fp8(uu[4 * g + 2], x2), d3 = dot16_fp8(uu[4 * g + 3], x2);
            const float tot = reduce4_transpose(d0, d1, d2, d3, lane);
            const float z = tot * sel4f(du[4 * g], du[4 * g + 1], du[4 * g + 2], du[4 * g + 3], q);
            const float cf = gelu_tanh(z) * sel4f(gv[4 * g], gv[4 * g + 1], gv[4 * g + 2], gv[4 * g + 3], q);
#pragma unroll
            for (int s = 0; s < 4; ++s) { const float cs = __int_as_float(__builtin_amdgcn_readlane(__float_as_int(cf), s)); axpy16_fp8(vv[4 * g + s], cs, y2); }
        }
    }
    float sq = 0.f;
    f32x4 h2[4];
#pragma unroll
    for (int j = 0; j < 4; ++j) {
        h2[j] = hv[j] + (f32x4){y2[2 * j].x, y2[2 * j].y, y2[2 * j + 1].x, y2[2 * j + 1].y};
        *(f32x4*)(hr + 4 * j) = h2[j];
        sq += (h2[j][0] * h2[j][0] + h2[j][1] * h2[j][1]) + (h2[j][2] * h2[j][2] + h2[j][3] * h2[j][3]);
    }
    u32x4 w0, w1; w0.x = pk2(h2[0][0], h2[0][1]); w0.y = pk2(h2[0][2], h2[0][3]); w0.z = pk2(h2[1][0], h2[1][1]); w0.w = pk2(h2[1][2], h2[1][3]);
    w1.x = pk2(h2[2][0], h2[2][1]); w1.y = pk2(h2[2][2], h2[2][3]); w1.z = pk2(h2[3][0], h2[3][1]); w1.w = pk2(h2[3][2], h2[3][3]);
    u32x4* ob = (u32x4*)(h2b + (size_t)t * 1024 + 16 * lane); ob[0] = w0; ob[1] = w1;
    sq = wave_sum(sq);
    if (lane == 0) rstd3[t] = 1.0f / sqrtf(sq * (1.0f / 1024.0f) + EPS);
}

__device__ __forceinline__ unsigned umin_(unsigned a, unsigned b) { return a < b ? a : b; }
__device__ __forceinline__ unsigned umax_(unsigned a, unsigned b) { return a > b ? a : b; }
__device__ __forceinline__ void sort128(unsigned& k0, unsigned& k1, int lane) {
#pragma unroll
    for (int k = 2; k <= 128; k <<= 1) {
#pragma unroll
        for (int j = k >> 1; j >= 1; j >>= 1) {
            if (j == 64) { const unsigned mn = umin_(k0, k1), mx = umax_(k0, k1); k0 = mn; k1 = mx; }
            else {
                const unsigned o0 = (unsigned)__shfl_xor((int)k0, j), o1 = (unsigned)__shfl_xor((int)k1, j);
                const bool up0 = (k == 128) ? true : (k == 64 ? true : ((lane & k) == 0));
                const bool up1 = (k == 128) ? true : (k == 64 ? false : ((lane & k) == 0));
                const bool lower = (lane & j) == 0;
                k0 = (lower == up0) ? umin_(k0, o0) : umax_(k0, o0);
                k1 = (lower == up1) ? umin_(k1, o1) : umax_(k1, o1);
            }
        }
    }
}
typedef int i32x4v __attribute__((ext_vector_type(4)));
#ifndef NSLICE
#define NSLICE 8
#endif
#define SLICE_SHIFT (NSLICE == 32 ? 25 : (NSLICE == 16 ? 26 : (NSLICE == 8 ? 27 : (NSLICE == 4 ? 28 : 30))))
typedef unsigned u32x2 __attribute__((ext_vector_type(2)));
__device__ __forceinline__ f32x4 bf4_lo(u32x2 w) { return (f32x4){__builtin_bit_cast(float, w.x << 16), __builtin_bit_cast(float, w.x & 0xffff0000u), __builtin_bit_cast(float, w.y << 16), __builtin_bit_cast(float, w.y & 0xffff0000u)}; }
struct TokState { f32x2 y2[8]; unsigned k0, k1; int bnd; float rsx; };
__device__ __forceinline__ int count_lt(const TokState& S, unsigned bound) {
    return __builtin_popcountll(__builtin_amdgcn_ballot_w64(S.k0 < bound)) + __builtin_popcountll(__builtin_amdgcn_ballot_w64(S.k1 < bound));
}
__device__ __forceinline__ int bperm_i(int srclane, int v) { return __builtin_amdgcn_ds_bpermute(srclane << 2, v); }
__device__ __forceinline__ float bperm_f(int srclane, float v) { return __int_as_float(__builtin_amdgcn_ds_bpermute(srclane << 2, __float_as_int(v))); }
template <int PM>
__device__ __forceinline__ void gather_batch(TokState& S, int p, int hi, int lane, const LAS unsigned char* xs, const unsigned char* __restrict__ U8, const unsigned char* __restrict__ V8, const float* __restrict__ IU, const float* __restrict__ IV) {
    const int n = (hi - p < 16) ? hi - p : 16;
    const int m = lane & 15, kq = lane >> 4;
    const int r = (m < n) ? p + m : hi - 1; const int sl = r & 63; const bool lo = r < 64;
    const unsigned ka = (unsigned)bperm_i(sl, (int)S.k0), kb = (unsigned)bperm_i(sl, (int)S.k1);
    const int es = (int)((lo ? ka : kb) >> 16);
    const unsigned key = lo ? ka : kb;
    const float dus = IU[es] * S.rsx, gvs = (m < n) ? (float)(key & 0xffffu) * (1.0f / 65535.0f) * IV[es] : 0.f;
    const unsigned char* ua = U8 + (size_t)es * 1024 + 16 * kq;
    i32x4v A[16];
    if (!(PM & 2)) {
#pragma unroll
        for (int s = 0; s < 16; ++s) { if (PM & 16) { const int e = __builtin_amdgcn_readlane(es, s); A[s] = *(const i32x4v*)(U8 + (size_t)e * 1024 + 16 * lane); } else A[s] = *(const i32x4v*)(ua + 64 * s); }
    }
    u32x4 vv[16];
    if (!(PM & 1)) {
#pragma unroll
        for (int q = 0; q < 8; ++q) if (q < n) { const int e = __builtin_amdgcn_readlane(es, q); vv[q] = *(const u32x4*)(V8 + (size_t)e * 1024 + 16 * lane); }
        if (n > 8) {
#pragma unroll
            for (int q = 8; q < 16; ++q) if (q < n) { const int e = __builtin_amdgcn_readlane(es, q); vv[q] = *(const u32x4*)(V8 + (size_t)e * 1024 + 16 * lane); }
        }
    }
    i32x4v acc = (i32x4v){0, 0, 0, 0};
    if (!(PM & 2)) {
#pragma unroll
        for (int s = 0; s < 16; ++s) { const i32x4v B = *(const LAS i32x4v*)(xs + 64 * s + 16 * kq); acc = __builtin_amdgcn_mfma_i32_16x16x64_i8(A[s], B, acc, 0, 0, 0); }
    } else { acc = (i32x4v){es, es + 1, es + 2, es + 3}; }
    float cf[4];
#pragma unroll
    for (int j = 0; j < 4; ++j) { const int sm = 4 * kq + j; const float d = bperm_f(sm, dus), g = bperm_f(sm, gvs); cf[j] = g * gelu_tanh((float)acc[j] * d); }
    if (PM & 1) { S.y2[0].x += (cf[0] + cf[1]) + (cf[2] + cf[3]); }
    else if (PM & 4) {
#pragma unroll
        for (int q = 0; q < 16; ++q) if (q < n) { const float cs = __int_as_float(__builtin_amdgcn_readlane(__float_as_int(cf[q & 3]), 16 * (q >> 2))); S.y2[q & 7].x += cs * __uint_as_float((vv[q].x ^ vv[q].y ^ vv[q].z ^ vv[q].w) & 0x3fffffffu); }
    } else {
#pragma unroll
        for (int q = 0; q < 8; ++q) if (q < n) { const float cs = __int_as_float(__builtin_amdgcn_readlane(__float_as_int(cf[q & 3]), 16 * (q >> 2))); axpy16_fp8(vv[q], cs, S.y2); }
        if (n > 8) {
#pragma unroll
            for (int q = 8; q < 16; ++q) if (q < n) { const float cs = __int_as_float(__builtin_amdgcn_readlane(__float_as_int(cf[q & 3]), 16 * (q >> 2))); axpy16_fp8(vv[q], cs, S.y2); }
        }
    }
    __builtin_amdgcn_sched_barrier(0);
}
__device__ __forceinline__ void tok_setup(TokState& S, int t, int lane, LAS unsigned char* xs, const int* __restrict__ seli, const float* __restrict__ selg,
                                          const float* __restrict__ part2, const bf16* __restrict__ h1b) {
    float ps = (lane < 16) ? part2[(size_t)t * 16 + lane] : 0.f;
    ps = wave_sum(ps);
    const float rstd2 = 1.0f / sqrtf(ps * (1.0f / 1024.0f) + EPS);
    f32x4 hv[4]; float am = 0.f;
    { const u32x4* br = (const u32x4*)(h1b + (size_t)t * 1024 + 16 * lane); const u32x4 b0 = br[0], b1 = br[1];
      hv[0] = bf4_lo((u32x2){b0.x, b0.y}); hv[1] = bf4_lo((u32x2){b0.z, b0.w}); hv[2] = bf4_lo((u32x2){b1.x, b1.y}); hv[3] = bf4_lo((u32x2){b1.z, b1.w}); }
#pragma unroll
    for (int j = 0; j < 4; ++j) { am = fmaxf(am, fmaxf(fmaxf(fabsf(hv[j][0]), fabsf(hv[j][1])), fmaxf(fabsf(hv[j][2]), fabsf(hv[j][3])))); }
#pragma unroll
    for (int o = 1; o < 64; o <<= 1) am = fmaxf(am, __shfl_xor(am, o));
    const float sx = am > 0.f ? 127.0f / am : 1.0f, isx = am > 0.f ? am * (1.0f / 127.0f) : 1.0f;
    u32x4 xq;
#pragma unroll
    for (int j = 0; j < 4; ++j) { unsigned w = 0u;
#pragma unroll
        for (int c = 0; c < 4; ++c) w |= ((unsigned)(int)__builtin_rintf(hv[j][c] * sx) & 0xffu) << (8 * c);
        xq[j] = w; }
    *(LAS u32x4*)(xs + 16 * lane) = xq;
    const int iA = seli[(size_t)t * 128 + lane], iB = seli[(size_t)t * 128 + 64 + lane];
    const float gA = selg[(size_t)t * 128 + lane], gB = selg[(size_t)t * 128 + 64 + lane];
    S.k0 = ((unsigned)iA << 16) | (unsigned)(gA * 65535.0f + 0.5f); S.k1 = ((unsigned)iB << 16) | (unsigned)(gB * 65535.0f + 0.5f);
    sort128(S.k0, S.k1, lane);
    S.rsx = rstd2 * isx;
    int bnd = 0;
#pragma unroll
    for (int s = 1; s <= NSLICE; ++s) { const int c = count_lt(S, (unsigned)s << SLICE_SHIFT); bnd = (lane == s) ? c : bnd; }
    S.bnd = bnd;
#pragma unroll
    for (int j = 0; j < 8; ++j) S.y2[j] = (f32x2){0.f, 0.f};
}
__device__ __forceinline__ void tok_finish(const TokState& S, int t, int lane, const bf16* __restrict__ h1b, bf16* __restrict__ h2b, float* __restrict__ rstd3) {
    const u32x4* br = (const u32x4*)(h1b + (size_t)t * 1024 + 16 * lane); const u32x4 b0 = br[0], b1 = br[1];
    f32x4 h2[4]; h2[0] = bf4_lo((u32x2){b0.x, b0.y}); h2[1] = bf4_lo((u32x2){b0.z, b0.w}); h2[2] = bf4_lo((u32x2){b1.x, b1.y}); h2[3] = bf4_lo((u32x2){b1.z, b1.w});
    float sq = 0.f;
#pragma unroll
    for (int j = 0; j < 4; ++j) {
        h2[j] = h2[j] + (f32x4){S.y2[2 * j].x, S.y2[2 * j].y, S.y2[2 * j + 1].x, S.y2[2 * j + 1].y};
        sq += (h2[j][0] * h2[j][0] + h2[j][1] * h2[j][1]) + (h2[j][2] * h2[j][2] + h2[j][3] * h2[j][3]);
    }
    u32x4 w0, w1; w0.x = pk2(h2[0][0], h2[0][1]); w0.y = pk2(h2[0][2], h2[0][3]); w0.z = pk2(h2[1][0], h2[1][1]); w0.w = pk2(h2[1][2], h2[1][3]);
    w1.x = pk2(h2[2][0], h2[2][1]); w1.y = pk2(h2[2][2], h2[2][3]); w1.z = pk2(h2[3][0], h2[3][1]); w1.w = pk2(h2[3][2], h2[3][3]);
    u32x4* ob = (u32x4*)(h2b + (size_t)t * 1024 + 16 * lane); ob[0] = w0; ob[1] = w1;
    sq = wave_sum(sq);
    if (lane == 0) rstd3[t] = 1.0f / sqrtf(sq * (1.0f / 1024.0f) + EPS);
}
template <int PM>
__device__ __forceinline__ void gather_wg_sliced(int tok0, int wave, int lane, LAS unsigned char* lds, const unsigned char* __restrict__ U8, const unsigned char* __restrict__ V8, const float* __restrict__ IU, const float* __restrict__ IV,
                                                 const int* __restrict__ seli, const float* __restrict__ selg, const float* __restrict__ part2, float* __restrict__ H, const bf16* __restrict__ h1b, bf16* __restrict__ h2b, float* __restrict__ rstd3, float* probe_out) {
    LAS unsigned char* xs = lds + wave * 4096;
#pragma unroll 1
    for (int pass = 0; pass < 2; ++pass) {
        const int tb = tok0 + pass * 32 + wave * 4;
        TokState S0, S1, S2, S3;
        tok_setup(S0, tb + 0, fresh_lane(), xs, seli, selg, part2, h1b); __builtin_amdgcn_sched_barrier(0);
        tok_setup(S1, tb + 1, fresh_lane(), xs + 1024, seli, selg, part2, h1b); __builtin_amdgcn_sched_barrier(0);
        tok_setup(S2, tb + 2, fresh_lane(), xs + 2048, seli, selg, part2, h1b); __builtin_amdgcn_sched_barrier(0);
        tok_setup(S3, tb + 3, fresh_lane(), xs + 3072, seli, selg, part2, h1b); __builtin_amdgcn_sched_barrier(0);
        __syncthreads();
        lane = fresh_lane();
        int lo0 = 0, lo1 = 0, lo2 = 0, lo3 = 0;
#pragma unroll 1
        for (int s = 0; s < NSLICE; ++s) {
            { const int hi = __builtin_amdgcn_readlane(S0.bnd, s + 1); for (int p = lo0; p < hi; p += 16) gather_batch<PM>(S0, p, hi, lane, xs, U8, V8, IU, IV); lo0 = hi; }
            { const int hi = __builtin_amdgcn_readlane(S1.bnd, s + 1); for (int p = lo1; p < hi; p += 16) gather_batch<PM>(S1, p, hi, lane, xs + 1024, U8, V8, IU, IV); lo1 = hi; }
            { const int hi = __builtin_amdgcn_readlane(S2.bnd, s + 1); for (int p = lo2; p < hi; p += 16) gather_batch<PM>(S2, p, hi, lane, xs + 2048, U8, V8, IU, IV); lo2 = hi; }
            { const int hi = __builtin_amdgcn_readlane(S3.bnd, s + 1); for (int p = lo3; p < hi; p += 16) gather_batch<PM>(S3, p, hi, lane, xs + 3072, U8, V8, IU, IV); lo3 = hi; }
        }
        if (probe_out) { const int fl = fresh_lane(); f32x2 a = S0.y2[0] + S1.y2[0] + S2.y2[0] + S3.y2[0];
#pragma unroll
            for (int j = 1; j < 8; ++j) a += S0.y2[j] + S1.y2[j] + S2.y2[j] + S3.y2[j];
            probe_out[(size_t)tb * 64 + fl] = a.x + a.y; }
        else { const int fl = fresh_lane(); tok_finish(S0, tb, fl, h1b, h2b, rstd3); tok_finish(S1, tb + 1, fl, h1b, h2b, rstd3); tok_finish(S2, tb + 2, fl, h1b, h2b, rstd3); tok_finish(S3, tb + 3, fl, h1b, h2b, rstd3); }
        __syncthreads();
    }
}

__device__ __forceinline__ int dpp_xor8(int v) { return __builtin_amdgcn_update_dpp(0, v, 0x128, 0xf, 0xf, false); }
__device__ __forceinline__ int dpp_xor4(int v) { return __builtin_amdgcn_update_dpp(0, __builtin_amdgcn_update_dpp(0, v, 0x141, 0xf, 0xf, false), 0x1b, 0xf, 0xf, false); }
__device__ __forceinline__ int dpp_xor1(int v) { return __builtin_amdgcn_update_dpp(0, v, 0xb1, 0xf, 0xf, false); }
__device__ __forceinline__ int dpp_xor2(int v) { return __builtin_amdgcn_update_dpp(0, v, 0x4e, 0xf, 0xf, false); }
__device__ __forceinline__ int reduce16_rows(int (&p)[16], int lane) {
    int r8[8], r4[4], r2[2];
#pragma unroll
    for (int i = 0; i < 8; ++i) { const u32x2 s = __builtin_amdgcn_permlane32_swap((unsigned)p[i], (unsigned)p[i + 8], false, false); r8[i] = (int)(s.x + s.y); }
#pragma unroll
    for (int i = 0; i < 4; ++i) { const u32x2 s = __builtin_amdgcn_permlane16_swap((unsigned)r8[i], (unsigned)r8[i + 4], false, false); r4[i] = (int)(s.x + s.y); }
    const bool b3 = lane & 8, b2 = lane & 4;
#pragma unroll
    for (int i = 0; i < 2; ++i) { const int s0 = r4[i] + dpp_xor8(r4[i]), s1 = r4[i + 2] + dpp_xor8(r4[i + 2]); r2[i] = b3 ? s1 : s0; }
    const int keep = b2 ? r2[1] : r2[0], send = b2 ? r2[0] : r2[1];
    int t = keep + dpp_xor4(send);
    t += dpp_xor1(t); t += dpp_xor2(t);
    return t;
}
struct TokState2 { f32x2 y2[8]; unsigned k0, k1; float rsx; };
template <int PM>
__device__ __forceinline__ void gather_batch16(TokState2& S, int bi, int lane, const LAS unsigned char* xs, const unsigned char* __restrict__ U8, const unsigned char* __restrict__ V8, const float* __restrict__ IU, const float* __restrict__ IV) {
    const unsigned ksel = (bi < 4) ? S.k0 : S.k1;
    const int lb = (bi & 3) << 4;
    const unsigned key = (unsigned)bperm_i(lb + (lane >> 2), (int)ksel);
    const int es = (int)(key >> 16);
    const float dus = IU[es] * S.rsx, gvs = (float)(key & 0xffffu) * (1.0f / 65535.0f) * IV[es];
    i32x4v A[16]; u32x4 vv[16];
#pragma unroll
    for (int q = 0; q < 16; ++q) { const int e = (int)((unsigned)__builtin_amdgcn_readlane((int)ksel, lb + q) >> 16); A[q] = *(const i32x4v*)(U8 + (size_t)e * 1024 + 16 * lane); }
#pragma unroll
    for (int q = 0; q < 16; ++q) { const int e = (int)((unsigned)__builtin_amdgcn_readlane((int)ksel, lb + q) >> 16); vv[q] = *(const u32x4*)(V8 + (size_t)e * 1024 + 16 * lane); }
    const i32x4v X = *(const LAS i32x4v*)(xs + 16 * lane);
    int p[16];
#pragma unroll
    for (int q = 0; q < 16; ++q) p[q] = __builtin_amdgcn_sdot4(A[q][3], X[3], __builtin_amdgcn_sdot4(A[q][2], X[2], __builtin_amdgcn_sdot4(A[q][1], X[1], __builtin_amdgcn_sdot4(A[q][0], X[0], 0, false), false), false), false);
    const int tot = reduce16_rows(p, lane);
    const float cf = gvs * gelu_tanh((float)tot * dus);
#pragma unroll
    for (int q = 0; q < 16; ++q) { const float cs = __int_as_float(__builtin_amdgcn_readlane(__float_as_int(cf), 4 * q)); axpy16_fp8(vv[q], cs, S.y2); }
    __builtin_amdgcn_sched_barrier(0);
}
__device__ __forceinline__ void tok_setup2(TokState2& S, int t, int lane, LAS unsigned char* xs, const int* __restrict__ seli, const float* __restrict__ selg,
                                           const float* __restrict__ part2, const bf16* __restrict__ h1b) {
    float ps = (lane < 16) ? part2[(size_t)t * 16 + lane] : 0.f;
    ps = wave_sum(ps);
    const float rstd2 = 1.0f / sqrtf(ps * (1.0f / 1024.0f) + EPS);
    f32x4 hv[4]; float am = 0.f;
    { const u32x4* br = (const u32x4*)(h1b + (size_t)t * 1024 + 16 * lane); const u32x4 b0 = br[0], b1 = br[1];
      hv[0] = bf4_lo((u32x2){b0.x, b0.y}); hv[1] = bf4_lo((u32x2){b0.z, b0.w}); hv[2] = bf4_lo((u32x2){b1.x, b1.y}); hv[3] = bf4_lo((u32x2){b1.z, b1.w}); }
#pragma unroll
    for (int j = 0; j < 4; ++j) { am = fmaxf(am, fmaxf(fmaxf(fabsf(hv[j][0]), fabsf(hv[j][1])), fmaxf(fabsf(hv[j][2]), fabsf(hv[j][3])))); }
#pragma unroll
    for (int o = 1; o < 64; o <<= 1) am = fmaxf(am, __shfl_xor(am, o));
    const float sx = am > 0.f ? 127.0f / am : 1.0f, isx = am > 0.f ? am * (1.0f / 127.0f) : 1.0f;
    u32x4 xq;
#pragma unroll
    for (int j = 0; j < 4; ++j) { unsigned w = 0u;
#pragma unroll
        for (int c = 0; c < 4; ++c) w |= ((unsigned)(int)__builtin_rintf(hv[j][c] * sx) & 0xffu) << (8 * c);
        xq[j] = w; }
    *(LAS u32x4*)(xs + 16 * lane) = xq;
    const int iA = seli[(size_t)t * 128 + lane], iB = seli[(size_t)t * 128 + 64 + lane];
    const float gA = selg[(size_t)t * 128 + lane], gB = selg[(size_t)t * 128 + 64 + lane];
    S.k0 = ((unsigned)iA << 16) | (unsigned)(gA * 65535.0f + 0.5f); S.k1 = ((unsigned)iB << 16) | (unsigned)(gB * 65535.0f + 0.5f);
    sort128(S.k0, S.k1, lane);
    S.rsx = rstd2 * isx;
#pragma unroll
    for (int j = 0; j < 8; ++j) S.y2[j] = (f32x2){0.f, 0.f};
}
__device__ __forceinline__ void tok_finish2(const TokState2& S, int t, int lane, const bf16* __restrict__ h1b, bf16* __restrict__ h2b, float* __restrict__ rstd3) {
    const u32x4* br = (const u32x4*)(h1b + (size_t)t * 1024 + 16 * lane); const u32x4 b0 = br[0], b1 = br[1];
    f32x4 h2[4]; h2[0] = bf4_lo((u32x2){b0.x, b0.y}); h2[1] = bf4_lo((u32x2){b0.z, b0.w}); h2[2] = bf4_lo((u32x2){b1.x, b1.y}); h2[3] = bf4_lo((u32x2){b1.z, b1.w});
    float sq = 0.f;
#pragma unroll
    for (int j = 0; j < 4; ++j) {
        h2[j] = h2[j] + (f32x4){S.y2[2 * j].x, S.y2[2 * j].y, S.y2[2 * j + 1].x, S.y2[2 * j + 1].y};
        sq += (h2[j][0] * h2[j][0] + h2[j][1] * h2[j][1]) + (h2[j][2] * h2[j][2] + h2[j][3] * h2[j][3]);
    }
    u32x4 w0, w1; w0.x = pk2(h2[0][0], h2[0][1]); w0.y = pk2(h2[0][2], h2[0][3]); w0.z = pk2(h2[1][0], h2[1][1]); w0.w = pk2(h2[1][2], h2[1][3]);
    w1.x = pk2(h2[2][0], h2[2][1]); w1.y = pk2(h2[2][2], h2[2][3]); w1.z = pk2(h2[3][0], h2[3][1]); w1.w = pk2(h2[3][2], h2[3][3]);
    u32x4* ob = (u32x4*)(h2b + (size_t)t * 1024 + 16 * lane); ob[0] = w0; ob[1] = w1;
    sq = wave_sum(sq);
    if (lane == 0) rstd3[t] = 1.0f / sqrtf(sq * (1.0f / 1024.0f) + EPS);
}
__device__ __forceinline__ void gather_wg_rows(int tok0, int wave, int lane, LAS unsigned char* lds, const unsigned char* __restrict__ U8, const unsigned char* __restrict__ V8, const float* __restrict__ IU, const float* __restrict__ IV,
                                               const int* __restrict__ seli, const float* __restrict__ selg, const float* __restrict__ part2, const bf16* __restrict__ h1b, bf16* __restrict__ h2b, float* __restrict__ rstd3) {
    LAS unsigned char* xs = lds + wave * 4096;
#pragma unroll 1
    for (int pass = 0; pass < 2; ++pass) {
        const int tb = tok0 + pass * 32 + wave * 4;
        TokState2 S0, S1, S2, S3;
        tok_setup2(S0, tb + 0, fresh_lane(), xs, seli, selg, part2, h1b); __builtin_amdgcn_sched_barrier(0);
        tok_setup2(S1, tb + 1, fresh_lane(), xs + 1024, seli, selg, part2, h1b); __builtin_amdgcn_sched_barrier(0);
        tok_setup2(S2, tb + 2, fresh_lane(), xs + 2048, seli, selg, part2, h1b); __builtin_amdgcn_sched_barrier(0);
        tok_setup2(S3, tb + 3, fresh_lane(), xs + 3072, seli, selg, part2, h1b); __builtin_amdgcn_sched_barrier(0);
        __syncthreads();
        lane = fresh_lane();
#pragma unroll 1
        for (int bi = 0; bi < 8; ++bi) {
            gather_batch16<0>(S0, bi, lane, xs, U8, V8, IU, IV);
            gather_batch16<0>(S1, bi, lane, xs + 1024, U8, V8, IU, IV);
            gather_batch16<0>(S2, bi, lane, xs + 2048, U8, V8, IU, IV);
            gather_batch16<0>(S3, bi, lane, xs + 3072, U8, V8, IU, IV);
        }
        { const int fl = fresh_lane(); tok_finish2(S0, tb, fl, h1b, h2b, rstd3); tok_finish2(S1, tb + 1, fl, h1b, h2b, rstd3); tok_finish2(S2, tb + 2, fl, h1b, h2b, rstd3); tok_finish2(S3, tb + 3, fl, h1b, h2b, rstd3); }
        __syncthreads();
    }
}
namespace pg8 {
#define PG8_LAS __attribute__((address_space(3)))
typedef unsigned short bf16_t;
typedef short bf16x8 __attribute__((ext_vector_type(8)));
typedef float f32x4 __attribute__((ext_vector_type(4)));
typedef unsigned u32x4 __attribute__((ext_vector_type(4)));
constexpr int BM = 256, BK = 64, HALF = 128, HTB = HALF * BK * 2  , STAGE_BYTES = 8 * HTB, NXCD = 8, WGM = 8;

__host__ __device__ __forceinline__ int lds_byte(int r, int c) { const int st = (r >> 4) * 2 + (c >> 5), rr = r & 15, cc = c & 31, ob = rr * 64 + cc * 2; return st * 1024 + (ob ^ (((ob >> 9) & 1) << 5)); }
__host__ __device__ __forceinline__ void stage_rc(int b, int& R, int& C) { const int st = b / 1024, sb = b % 1024, swz = sb ^ (((sb >> 9) & 1) << 5); R = (st >> 1) * 16 + swz / 64; C = (st & 1) * 32 + (swz % 64) / 2; }
__host__ __device__ __forceinline__ int perm32(int rho) { const int n = rho >> 4, i = rho & 15; return 8 * (i >> 2) + 4 * n + (i & 3); }

struct Unit { int pm, pn; };
struct Gemm { const bf16_t* A; const bf16_t* Bt; int K, lda, apn_shift, apn_stride; };

struct StaticOrder {
    int nM, nN, nwg, G, c;
    __host__ __device__ __forceinline__ void init(int M, int N, int G_, int c_) { nM = M / BM; nN = N / BM; nwg = nM * nN; G = G_; c = c_; }
    __host__ __device__ __forceinline__ bool next(int i, Unit& u) const {
        const long L = (long)i * G + c; if (L >= nwg) return false;
        int wgid = (int)L; { const int q = nwg / NXCD, r = nwg % NXCD, xcd = wgid % NXCD, off = wgid / NXCD; wgid = (xcd < r ? xcd * (q + 1) : r * (q + 1) + (xcd - r) * q) + off; }
        const int nig = WGM * nN, gid = wgid / nig, fm = gid * WGM, gsz = (nM - fm) < WGM ? (nM - fm) : WGM;
        u.pm = fm + ((wgid % nig) % gsz); u.pn = (wgid % nig) / gsz; return true;
    }
    __device__ __forceinline__ void a_ready(const Unit&) const {}
    __device__ __forceinline__ void done(const Unit&) const {}
};

__device__ __forceinline__ unsigned cvt_pk_bf16(float lo, float hi) { unsigned r; asm volatile("v_cvt_pk_bf16_f32 %0, %1, %2" : "=v"(r) : "v"(lo), "v"(hi)); return r; }

template <class Epi, class Sched, bool ALIGN_EPI = false, bool SP2 = false>
__device__ __forceinline__ void gemm_phase(PG8_LAS unsigned char* lds, const Gemm g, const Sched& S, const Epi& E, int wave_id  ) {
    const int lane = fresh_lane(), wid = wave_id, tid = wid * 64 + lane, wr = wid >> 2, wc = wid & 3, fr = lane & 15, fq = lane >> 4;
    const int K = g.K, nt = K / BK;
    unsigned voffA[2], voffB[2];
#pragma unroll
    for (int i = 0; i < 2; ++i) { int R, C; stage_rc(tid * 16 + i * 8192, R, C); const int Rb = Epi::PERM ? ((R & ~31) + perm32(R & 31)) : R;
        voffA[i] = (unsigned)(R * g.lda + C) * 2u; voffB[i] = (unsigned)(Rb * K + C) * 2u; }
    const size_t kstep = (size_t)(BK * 2);
    const size_t hstepA = (size_t)HALF * g.lda * 2, hstepB = (size_t)HALF * K * 2;
    const size_t tstepA = 2 * hstepA, tstepB = 2 * hstepB;
    const unsigned ldsw = (unsigned)wid * 1024u;
    const int aoff = lds_byte(wr * 64 + fr, fq * 8), boff = lds_byte(wc * 32 + fr, fq * 8);
#define PG8_SA(b, h) (((b) * 2 + (h)) * HTB)
#define PG8_SB(b, h) ((4 + (b) * 2 + (h)) * HTB)
#define PG8_STAGE(bufoff, gbase, voff) do { _Pragma("unroll") for (int _i = 0; _i < 2; ++_i) \
        __builtin_amdgcn_global_load_lds((const unsigned*)((const char*)(gbase) + (voff)[_i]), (PG8_LAS unsigned*)(lds + (bufoff) + ldsw + _i * 8192), 16, 0, 0); } while (0)
#define PG8_LDA(dst, b, h) do { _Pragma("unroll") for (int m = 0; m < 4; ++m) _Pragma("unroll") for (int k = 0; k < 2; ++k) dst[m][k] = *(const PG8_LAS bf16x8*)(lds + PG8_SA(b, h) + aoff + m * 2048 + k * 1024); } while (0)
#define PG8_LDB(dst, b, h) do { _Pragma("unroll") for (int n = 0; n < 2; ++n) _Pragma("unroll") for (int k = 0; k < 2; ++k) dst[n][k] = *(const PG8_LAS bf16x8*)(lds + PG8_SB(b, h) + boff + n * 2048 + k * 1024); } while (0)
#define PG8_MMA(ai, bj, At, Bt) do { __builtin_amdgcn_s_setprio(1); _Pragma("unroll") for (int m = 0; m < 4; ++m) _Pragma("unroll") for (int n = 0; n < 2; ++n) _Pragma("unroll") for (int k = 0; k < 2; ++k) \
        acc[ai][bj][m][n] = __builtin_amdgcn_mfma_f32_16x16x32_bf16(Bt[n][k], At[m][k], acc[ai][bj][m][n], 0, 0, 0); __builtin_amdgcn_s_setprio(0); } while (0)
#define PG8_WAIT_V(n) asm volatile("s_waitcnt vmcnt(" #n ")" ::: "memory")
#define PG8_WAIT_L(n) asm volatile("s_waitcnt lgkmcnt(" #n ")" ::: "memory")
#define PG8_BAR __builtin_amdgcn_s_barrier()
#define PG8_SCHED __builtin_amdgcn_sched_barrier(0)
    Unit cur, nxt; int ui = 0;
    if (!S.next(0, cur)) return;
    f32x4 acc[2][2][4][2];
#pragma unroll
    for (int a = 0; a < 2; ++a)
#pragma unroll
        for (int b = 0; b < 2; ++b)
#pragma unroll
            for (int m = 0; m < 4; ++m)
#pragma unroll
                for (int n = 0; n < 2; ++n) acc[a][b][m][n] = (f32x4){0.f, 0.f, 0.f, 0.f};
    bf16x8 At[4][2], B0[2][2], B1[2][2];
    const char* cA = (const char*)g.A + (size_t)cur.pm * tstepA + (size_t)((cur.pn >> g.apn_shift) * g.apn_stride) * 2; const char* cB = (const char*)g.Bt + (size_t)cur.pn * tstepB;
    S.a_ready(cur);
    if constexpr (SP2) {
        PG8_STAGE(PG8_SB(0, 0), cB, voffB); PG8_STAGE(PG8_SB(0, 1), cB + hstepB, voffB); PG8_STAGE(PG8_SA(0, 0), cA, voffA); PG8_STAGE(PG8_SA(0, 1), cA + hstepA, voffA);
        if (wr == 1) PG8_BAR;
        PG8_WAIT_V(2); PG8_BAR;
        PG8_STAGE(PG8_SB(1, 0), cB + kstep, voffB); PG8_STAGE(PG8_SA(1, 0), cA + kstep, voffA); PG8_STAGE(PG8_SB(1, 1), cB + hstepB + kstep, voffB);
        PG8_WAIT_V(6); PG8_BAR;
    } else {
        PG8_STAGE(PG8_SB(0, 0), cB, voffB); PG8_STAGE(PG8_SA(0, 0), cA, voffA); PG8_STAGE(PG8_SB(0, 1), cB + hstepB, voffB); PG8_STAGE(PG8_SA(0, 1), cA + hstepA, voffA);
        if (wr == 1) PG8_BAR;
        PG8_WAIT_V(4); PG8_BAR;
        PG8_STAGE(PG8_SB(1, 0), cB + kstep, voffB); PG8_STAGE(PG8_SA(1, 0), cA + kstep, voffA); PG8_STAGE(PG8_SB(1, 1), cB + hstepB + kstep, voffB);
        PG8_WAIT_V(6); PG8_BAR;
    }
    for (;;) {
        const bool has_next = S.next(ui + 1, nxt);
        const char* nA = has_next ? (const char*)g.A + (size_t)nxt.pm * tstepA + (size_t)((nxt.pn >> g.apn_shift) * g.apn_stride) * 2 : cA; const char* nB = has_next ? (const char*)g.Bt + (size_t)nxt.pn * tstepB : cB;
#pragma unroll 1
        for (int t = 0; t < nt; t += 2) {
            const bool last = (t == nt - 2);
            const char* a1 = cA + (size_t)(t + 1) * kstep;
            const char* a2 = last ? nA : cA + (size_t)(t + 2) * kstep; const char* b2 = last ? nB : cB + (size_t)(t + 2) * kstep;
            const char* a3 = a2 + kstep; const char* b3 = b2 + kstep;
            if (last && has_next) S.a_ready(nxt);
            if constexpr (SP2) {
            PG8_LDB(B0, 0, 0); PG8_LDB(B1, 0, 1); PG8_SCHED; PG8_LDA(At, 0, 0); PG8_STAGE(PG8_SA(1, 1), a1 + hstepA, voffA);
            PG8_WAIT_V(8); PG8_WAIT_L(0); PG8_BAR; PG8_MMA(0, 0, At, B0); PG8_MMA(0, 1, At, B1); PG8_BAR; PG8_SCHED;
            PG8_LDA(At, 0, 1); PG8_STAGE(PG8_SB(0, 0), b2, voffB); PG8_STAGE(PG8_SB(0, 1), b2 + hstepB, voffB); PG8_STAGE(PG8_SA(0, 0), a2, voffA);
            PG8_WAIT_V(8); PG8_WAIT_L(0); PG8_BAR; PG8_MMA(1, 0, At, B0); PG8_MMA(1, 1, At, B1); PG8_BAR; PG8_SCHED;
            PG8_LDB(B0, 1, 0); PG8_LDB(B1, 1, 1); PG8_SCHED; PG8_LDA(At, 1, 0); PG8_STAGE(PG8_SA(0, 1), a2 + hstepA, voffA);
            PG8_WAIT_V(8); PG8_WAIT_L(0); PG8_BAR; PG8_MMA(0, 0, At, B0); PG8_MMA(0, 1, At, B1); PG8_BAR; PG8_SCHED;
            PG8_LDA(At, 1, 1); PG8_STAGE(PG8_SB(1, 0), b3, voffB); PG8_STAGE(PG8_SB(1, 1), b3 + hstepB, voffB); PG8_STAGE(PG8_SA(1, 0), a3, voffA);
            PG8_WAIT_V(8); PG8_WAIT_L(0); PG8_BAR; PG8_MMA(1, 0, At, B0); PG8_MMA(1, 1, At, B1); PG8_BAR; PG8_SCHED;
            } else {
            PG8_LDB(B0, 0, 0); PG8_SCHED; PG8_LDA(At, 0, 0); PG8_STAGE(PG8_SA(1, 1), a1 + hstepA, voffA);
            PG8_WAIT_L(8); PG8_BAR; PG8_WAIT_L(0); PG8_MMA(0, 0, At, B0); PG8_BAR; PG8_SCHED;
            PG8_LDB(B1, 0, 1); PG8_STAGE(PG8_SB(0, 0), b2, voffB);
            PG8_BAR; PG8_WAIT_L(0); PG8_MMA(0, 1, At, B1); PG8_BAR;
            PG8_LDA(At, 0, 1); PG8_STAGE(PG8_SA(0, 0), a2, voffA);
            PG8_BAR; PG8_WAIT_L(0); PG8_MMA(1, 0, At, B0); PG8_BAR; PG8_SCHED;
            PG8_STAGE(PG8_SB(0, 1), b2 + hstepB, voffB);
            PG8_WAIT_V(6); PG8_BAR; PG8_MMA(1, 1, At, B1); PG8_BAR;
            PG8_LDB(B0, 1, 0); PG8_SCHED; PG8_LDA(At, 1, 0); PG8_STAGE(PG8_SA(0, 1), a2 + hstepA, voffA);
            PG8_WAIT_L(8); PG8_BAR; PG8_WAIT_L(0); PG8_MMA(0, 0, At, B0); PG8_BAR; PG8_SCHED;
            PG8_LDB(B1, 1, 1); PG8_STAGE(PG8_SB(1, 0), b3, voffB);
            PG8_BAR; PG8_WAIT_L(0); PG8_MMA(0, 1, At, B1); PG8_BAR;
            PG8_LDA(At, 1, 1); PG8_STAGE(PG8_SA(1, 0), a3, voffA);
            PG8_BAR; PG8_WAIT_L(0); PG8_MMA(1, 0, At, B0); PG8_BAR; PG8_SCHED;
            PG8_STAGE(PG8_SB(1, 1), b3 + hstepB, voffB);
            PG8_WAIT_V(6); PG8_BAR; PG8_MMA(1, 1, At, B1); PG8_BAR;
            }
        }
        if constexpr (ALIGN_EPI) { if (wr == 0) PG8_BAR; }
        if constexpr (!Epi::AFTER_DRAIN) { E(acc, cur, wr, wc, fr, fq); S.done(cur); }
        if (!has_next) break;
#pragma unroll
        for (int a = 0; a < 2; ++a)
#pragma unroll
            for (int b = 0; b < 2; ++b)
#pragma unroll
                for (int m = 0; m < 4; ++m)
#pragma unroll
                    for (int n = 0; n < 2; ++n) acc[a][b][m][n] = (f32x4){0.f, 0.f, 0.f, 0.f};
        cur = nxt; cA = nA; cB = nB; ++ui;
        if constexpr (ALIGN_EPI) { if (wr == 1) PG8_BAR; }
    }
    PG8_WAIT_V(0);
    if constexpr (!ALIGN_EPI) { if (wr == 0) PG8_BAR; }
    PG8_BAR;
    if constexpr (Epi::AFTER_DRAIN) { E.fused(acc, cur, wr, wc, fr, fq, lds, wid, lane); S.done(cur); }
#undef PG8_SA
#undef PG8_SB
#undef PG8_STAGE
#undef PG8_LDA
#undef PG8_LDB
#undef PG8_MMA
#undef PG8_WAIT_V
#undef PG8_WAIT_L
#undef PG8_BAR
#undef PG8_SCHED
}
}
#define GAS __attribute__((address_space(1)))
typedef GAS unsigned gu32;
#define RLX_AGENT __ATOMIC_RELAXED, __HIP_MEMORY_SCOPE_AGENT
#define LDS_WAIT() asm volatile("s_waitcnt lgkmcnt(0)" ::: "memory")
#define VM_WAIT() asm volatile("s_waitcnt vmcnt(0)" ::: "memory")
#define XB_TMO      128
#define XB_XCNT(j)  (256  + 64 * (j))
#define XB_XSUB(j)  (1280 + 64 * (j))
#define XB_XGEN(j)  (2304 + 64 * (j))
#define XB_TOP      3328
#define XB_TOPGEN   3392
#define XCD_BAR_WORDS 3456
#define XB_SPIN_CAP (1u << 18)

__device__ __forceinline__ unsigned xb_ld(unsigned* p)              { return __hip_atomic_load(p, __ATOMIC_RELAXED, __HIP_MEMORY_SCOPE_AGENT); }
__device__ __forceinline__ unsigned xb_add(unsigned* p, unsigned v) { return __hip_atomic_fetch_add(p, v, __ATOMIC_RELAXED, __HIP_MEMORY_SCOPE_AGENT); }
__device__ __forceinline__ unsigned xb_xcc_id() { return (unsigned)__builtin_amdgcn_s_getreg((3 << 11) | 20) & 0xFu; }
#define XB_SPIN(cond, bar) do { unsigned _sp = 0; while (cond) { __builtin_amdgcn_s_sleep(1); \
    if ((++_sp & 255u) == 0u) { if (xb_ld(&(bar)[XB_TMO])) break; if (_sp > XB_SPIN_CAP) { atomicAdd(&(bar)[XB_TMO], 1u); break; } } } } while (0)

struct XcdBarrier {
    unsigned* bar; unsigned x;
    volatile LAS unsigned* st;
};

__device__ __forceinline__ XcdBarrier xcd_barrier_post(unsigned* bar, volatile LAS unsigned* st) {
    XcdBarrier b; b.bar = bar; b.x = xb_xcc_id(); b.st = st;
    if (threadIdx.x == 0) (void)xb_add(&bar[XB_XCNT(b.x)], 1u);
    return b;
}
__device__ __forceinline__ void xcd_barrier_complete(unsigned* bar, unsigned x, unsigned& nloc, unsigned& nx) {
    const unsigned G = gridDim.x * gridDim.y * gridDim.z;
    unsigned sum, cnt, mine, sp = 0u;
    for (;;) {
        sum = 0u; cnt = 0u; mine = 0u;
#pragma unroll
        for (unsigned j = 0; j < 16; ++j) { const unsigned c = xb_ld(&bar[XB_XCNT(j)]); sum += c; cnt += (c > 0u) ? 1u : 0u; mine = (j == x) ? c : mine; }
        if (sum == G) break;
        __builtin_amdgcn_s_sleep(1);
        if ((++sp & 255u) == 0u) { if (xb_ld(&bar[XB_TMO])) break; if (sp > XB_SPIN_CAP) { atomicAdd(&bar[XB_TMO], 1u); break; } }
    }
    nloc = mine > 0u ? mine : 1u; nx = cnt > 0u ? cnt : 1u;
}

__device__ __forceinline__ void xcd_barrier(const XcdBarrier& b) {
    asm volatile("s_waitcnt vmcnt(0)" ::: "memory");
    __syncthreads();
    if (threadIdx.x == 0) {
        unsigned* bar = b.bar;
        __builtin_amdgcn_s_waitcnt(0);
        unsigned nloc = b.st[0], nx = b.st[1];
        if (nloc == 0u) { xcd_barrier_complete(bar, b.x, nloc, nx); b.st[0] = nloc; b.st[1] = nx; }
        const unsigned old = xb_add(&bar[XB_XSUB(b.x)], 1u);
        const unsigned gen = old / nloc;
        if (old + 1u == (gen + 1u) * nloc) {
            __builtin_amdgcn_fence(__ATOMIC_RELEASE, "agent");
            asm volatile("s_waitcnt vmcnt(0)" ::: "memory");
            const unsigned og = xb_add(&bar[XB_TOP], 1u);
            const unsigned tg = og / nx;
            if (og + 1u == (tg + 1u) * nx) xb_add(&bar[XB_TOPGEN], 1u);
            else XB_SPIN(xb_ld(&bar[XB_TOPGEN]) == tg, bar);
            __builtin_amdgcn_fence(__ATOMIC_ACQUIRE, "agent");
            xb_add(&bar[XB_XGEN(b.x)], 1u);
            asm volatile("s_waitcnt vmcnt(0)" ::: "memory");
        } else {
            XB_SPIN(xb_ld(&bar[XB_XGEN(b.x)]) == gen, bar);
            __builtin_amdgcn_fence(__ATOMIC_ACQUIRE, "agent");
            asm volatile("s_waitcnt vmcnt(0)" ::: "memory");
        }
    }
    __syncthreads();
}

constexpr int NWAVES = 8;
constexpr int LDS_MAIN = 135168;
constexpr int LDSCTL_OFF = LDS_MAIN;
constexpr int LDS_BYTES = 147456;
constexpr int CW_BAR = 4096;
constexpr size_t CTL_ZERO_BYTES = 1 * MiB;
constexpr float LOG2E = 1.4426950408889634f;
typedef short bf16x8 __attribute__((ext_vector_type(8)));
typedef float f32x16 __attribute__((ext_vector_type(16)));
typedef unsigned u32x2 __attribute__((ext_vector_type(2)));
using pg8::Unit;
using pg8::cvt_pk_bf16;

__device__ __forceinline__ f32x4 sig4(f32x4 v) { return (f32x4){sigmoidf_(v[0]), sigmoidf_(v[1]), sigmoidf_(v[2]), sigmoidf_(v[3])}; }
__device__ __forceinline__ f32x4 gelu4(f32x4 v) { return (f32x4){gelu_tanh(v[0]), gelu_tanh(v[1]), gelu_tanh(v[2]), gelu_tanh(v[3])}; }
__device__ __forceinline__ u32x4 pack8(f32x4 a, f32x4 b) { u32x4 w; w.x = cvt_pk_bf16(a[0], a[1]); w.y = cvt_pk_bf16(a[2], a[3]); w.z = cvt_pk_bf16(b[0], b[1]); w.w = cvt_pk_bf16(b[2], b[3]); return w; }

struct OneUnit { pg8::StaticOrder S; int k;
    __device__ __forceinline__ bool next(int i, Unit& u) const { return i == 0 && S.next(k, u); }
    __device__ __forceinline__ void a_ready(const Unit&) const {}
    __device__ __forceinline__ void done(const Unit&) const {} };
struct EpiProj {
    static constexpr bool PERM = true, AFTER_DRAIN = false;
    const float* rstd; unsigned char* ws;
    __device__ __forceinline__ void operator()(const f32x4 (&acc)[2][2][4][2], const Unit& u, int wr, int wc, int fr, int fq) const {
        { const int t_ = fresh_lane(); fr = t_ & 15; fq = t_ >> 4; }
        const int pn = u.pn; bf16* base; int ldc, coff, act;
        if (pn < 3) { base = (bf16*)(ws + WS_QKV); ldc = 768; coff = pn * 256; act = 0; }
        else if (pn < 7) { base = (bf16*)(ws + WS_LX); ldc = 1024; coff = (pn - 3) * 256; act = 0; }
        else if (pn < 11) { base = (bf16*)(ws + WS_GL); ldc = 1024; coff = (pn - 7) * 256; act = 1; }
        else if (pn < 15) { base = (bf16*)(ws + WS_SGA); ldc = 1024; coff = (pn - 11) * 256; act = 2; }
        else { base = (bf16*)(ws + WS_SGL); ldc = 1024; coff = (pn - 15) * 256; act = 2; }
        const int row0 = u.pm * 256 + wr * 64 + fr, col0 = coff + wc * 32 + 8 * fq;
#pragma unroll
        for (int ai = 0; ai < 2; ++ai)
#pragma unroll
            for (int m = 0; m < 4; ++m) {
                const int r = row0 + ai * 128 + m * 16; const float rs = rstd[r]; bf16* rowp = base + (size_t)r * ldc + col0;
#pragma unroll
                for (int bj = 0; bj < 2; ++bj) {
                    f32x4 v0 = acc[ai][bj][m][0] * rs, v1 = acc[ai][bj][m][1] * rs;
                    if (act == 1) { v0 = gelu4(v0); v1 = gelu4(v1); } else if (act == 2) { v0 = sig4(v0); v1 = sig4(v1); }
                    *(u32x4*)(rowp + bj * 128) = pack8(v0, v1);
                }
            }
    }
};
struct EpiMP {
    static constexpr bool PERM = false, AFTER_DRAIN = false;
    const bf16* sga; float* mp;
    __device__ __forceinline__ void operator()(const f32x4 (&acc)[2][2][4][2], const Unit& u, int wr, int wc, int fr, int fq) const {
        { const int t_ = fresh_lane(); fr = t_ & 15; fq = t_ >> 4; }
        const int row0 = u.pm * 256 + wr * 64 + fr, col0 = u.pn * 256 + wc * 32 + 4 * fq;
#pragma unroll
        for (int ai = 0; ai < 2; ++ai)
#pragma unroll
            for (int m = 0; m < 4; ++m) {
                const size_t off = (size_t)(row0 + ai * 128 + m * 16) * 1024 + col0;
#pragma unroll
                for (int bj = 0; bj < 2; ++bj)
#pragma unroll
                    for (int n = 0; n < 2; ++n) { const size_t o = off + bj * 128 + n * 16; const f32x4 g = bf4_lo(*(const u32x2*)(sga + o)); const f32x4 v = acc[ai][bj][m][n] * g;
#if ALL_FUSED
                        u32x2 w; w.x = cvt_pk_bf16(v[0], v[1]); w.y = cvt_pk_bf16(v[2], v[3]); *(u32x2*)((bf16*)mp + o) = w;
#else
                        *(f32x4*)(mp + o) = v;
#endif
                    }
            }
    }
};
struct EpiMerged {
    static constexpr bool PERM = true, AFTER_DRAIN = false;
    const bf16* sgl; const float* mp; bf16* merged;
    __device__ __forceinline__ void operator()(const f32x4 (&acc)[2][2][4][2], const Unit& u, int wr, int wc, int fr, int fq) const {
        { const int t_ = fresh_lane(); fr = t_ & 15; fq = t_ >> 4; }
        const int row0 = u.pm * 256 + wr * 64 + fr, col0 = u.pn * 256 + wc * 32 + 8 * fq;
#pragma unroll
        for (int ai = 0; ai < 2; ++ai)
#pragma unroll
            for (int m = 0; m < 4; ++m) {
                const size_t off = (size_t)(row0 + ai * 128 + m * 16) * 1024 + col0;
#pragma unroll
                for (int bj = 0; bj < 2; ++bj) {
                    const size_t o = off + bj * 128; const u32x4 gw = *(const u32x4*)(sgl + o);
#if ALL_FUSED
                    const u32x4 mw = *(const u32x4*)((const bf16*)mp + o); const f32x4 m0 = bf4_lo((u32x2){mw.x, mw.y}), m1 = bf4_lo((u32x2){mw.z, mw.w});
#else
                    const f32x4 m0 = *(const f32x4*)(mp + o), m1 = *(const f32x4*)(mp + o + 4);
#endif
                    const f32x4 v0 = m0 + acc[ai][bj][m][0] * bf4_lo((u32x2){gw.x, gw.y}), v1 = m1 + acc[ai][bj][m][1] * bf4_lo((u32x2){gw.z, gw.w});
                    *(u32x4*)(merged + o) = pack8(v0, v1);
                }
            }
    }
};
struct EpiH1 {
    static constexpr bool PERM = true, AFTER_DRAIN = false;
    const float* x; float* h1; bf16* h1b; float* part;
    __device__ __forceinline__ void operator()(const f32x4 (&acc)[2][2][4][2], const Unit& u, int wr, int wc, int fr, int fq) const {
        { const int t_ = fresh_lane(); fr = t_ & 15; fq = t_ >> 4; }
        const int row0 = u.pm * 256 + wr * 64 + fr, col0 = u.pn * 256 + wc * 32 + 8 * fq;
#pragma unroll
        for (int ai = 0; ai < 2; ++ai)
#pragma unroll
            for (int m = 0; m < 4; ++m) {
                const int r = row0 + ai * 128 + m * 16; const size_t off = (size_t)r * 1024 + col0; float sq = 0.f;
#pragma unroll
                for (int bj = 0; bj < 2; ++bj) {
                    const size_t o = off + bj * 128;
                    const f32x4 v0 = *(const f32x4*)(x + o) + acc[ai][bj][m][0], v1 = *(const f32x4*)(x + o + 4) + acc[ai][bj][m][1];
#if !ALL_FUSED
                    *(f32x4*)(h1 + o) = v0; *(f32x4*)(h1 + o + 4) = v1;
#endif
                    *(u32x4*)(h1b + o) = pack8(v0, v1);
                    sq += (v0[0] * v0[0] + v0[1] * v0[1]) + (v0[2] * v0[2] + v0[3] * v0[3]) + (v1[0] * v1[0] + v1[1] * v1[1]) + (v1[2] * v1[2] + v1[3] * v1[3]);
                }
                sq += __shfl_xor(sq, 16); sq += __shfl_xor(sq, 32);
                if (fq == 0) part[(size_t)r * 16 + u.pn * 4 + wc] = sq;
            }
    }
};
struct EpiScore {
    static constexpr bool PERM = false, AFTER_DRAIN = false;
    const float* part; float* sc;
    __device__ __forceinline__ void operator()(const f32x4 (&acc)[2][2][4][2], const Unit& u, int wr, int wc, int fr, int fq) const {
        { const int t_ = fresh_lane(); fr = t_ & 15; fq = t_ >> 4; }
        const int row0 = u.pm * 256 + wr * 64 + fr, col0 = u.pn * 256 + wc * 32 + 4 * fq;
#pragma unroll
        for (int ai = 0; ai < 2; ++ai)
#pragma unroll
            for (int m = 0; m < 4; ++m) {
                const int r = row0 + ai * 128 + m * 16; const f32x4* pp = (const f32x4*)(part + (size_t)r * 16);
                const f32x4 s4 = (pp[0] + pp[1]) + (pp[2] + pp[3]); const float rs = 1.0f / sqrtf(((s4[0] + s4[1]) + (s4[2] + s4[3])) * (1.0f / 1024.0f) + EPS);
                const size_t off = (size_t)r * 1024 + col0;
#pragma unroll
                for (int bj = 0; bj < 2; ++bj)
#pragma unroll
                    for (int n = 0; n < 2; ++n) *(f32x4*)(sc + off + bj * 128 + n * 16) = acc[ai][bj][m][n] * rs;
            }
    }
};
struct EpiTopk {
    static constexpr bool PERM = false, AFTER_DRAIN = true;
    const float* part; int* seli; float* selg;
    __device__ __forceinline__ void fused(f32x4 (&acc)[2][2][4][2], const Unit& u, int wr, int wc, int fr, int fq, PG8_LAS unsigned char* lds, int wid, int lane) const {
        LAS float* L = (LAS float*)lds;
#pragma unroll
        for (int ai = 0; ai < 2; ++ai) {
            { const int t_ = fresh_lane(); fr = t_ & 15; fq = t_ >> 4; }
#pragma unroll
            for (int m = 0; m < 4; ++m) {
                const int rl = wr * 64 + m * 16 + fr, r = u.pm * 256 + ai * 128 + rl;
                const f32x4* pp = (const f32x4*)(part + (size_t)r * 16);
                const f32x4 s4 = (pp[0] + pp[1]) + (pp[2] + pp[3]); const float rs = 1.0f / sqrtf(((s4[0] + s4[1]) + (s4[2] + s4[3])) * (1.0f / 1024.0f) + EPS);
#pragma unroll
                for (int bj = 0; bj < 2; ++bj)
#pragma unroll
                    for (int n = 0; n < 2; ++n) *(LAS f32x4*)(L + (rl * 2 + bj) * TK_LSTRIDE + wc * 32 + 16 * n + 4 * fq) = acc[ai][bj][m][n] * rs;
            }
            asm volatile("s_waitcnt lgkmcnt(0)" ::: "memory"); __builtin_amdgcn_s_barrier(); asm volatile("" ::: "memory");
            const int tid = wid * 64 + fresh_lane();
            if (wid < 4) {
                const LAS float* my = L + tid * TK_LSTRIDE;
                unsigned a16[16];
#pragma unroll
                for (int g = 0; g < 8; ++g) {
                    unsigned t[16];
#pragma unroll
                    for (int q = 0; q < 4; ++q) {
                        const f32x4 v = *(const LAS f32x4*)(my + g * 16 + q * 4);
#pragma unroll
                        for (int c = 0; c < 4; ++c) { const int e = g * 16 + q * 4 + c; const float vc = v[c]; t[q * 4 + c] = (tk_f2key(vc) & ~127u) | (unsigned)(127 - e); }
                    }
                    tk_sort16(t);
                    if (g == 0) {
#pragma unroll
                        for (int i = 0; i < 16; ++i) a16[i] = t[i];
                    } else tk_merge16(a16, t);
                }
                unsigned oth[16];
#pragma unroll
                for (int i = 0; i < 16; ++i) oth[i] = (unsigned)__shfl_xor((int)a16[i], 1);
                if ((tid & 1) == 0) {
                    const int tok = u.pm * 256 + ai * 128 + (tid >> 1);
                    tk_combine_store(a16, oth, seli + (size_t)tok * 128 + u.pn * 16, selg + (size_t)tok * 128 + u.pn * 16);
                }
            }
            asm volatile("s_waitcnt lgkmcnt(0)" ::: "memory"); __builtin_amdgcn_s_barrier(); asm volatile("" ::: "memory");
        }
    }
};
struct EpiPP {
    static constexpr bool PERM = true, AFTER_DRAIN = false;
    bf16* pp;
    __device__ __forceinline__ void operator()(const f32x4 (&acc)[2][2][4][2], const Unit& u, int wr, int wc, int fr, int fq) const {
        { const int t_ = fresh_lane(); fr = t_ & 15; fq = t_ >> 4; }
        const int row0 = u.pm * 256 + wr * 64 + fr, col0 = u.pn * 256 + wc * 32 + 8 * fq;
#pragma unroll
        for (int ai = 0; ai < 2; ++ai)
#pragma unroll
            for (int m = 0; m < 4; ++m) {
                const size_t off = (size_t)(row0 + ai * 128 + m * 16) * 1024 + col0;
#pragma unroll
                for (int bj = 0; bj < 2; ++bj) *(u32x4*)(pp + off + bj * 128) = pack8(acc[ai][bj][m][0], acc[ai][bj][m][1]);
            }
    }
};
struct EpiH3 {
    static constexpr bool PERM = true, AFTER_DRAIN = false;
    const float* rstd3; const bf16* pp; float* h; float* part; const bf16* h2b; bf16* h3b;
    __device__ __forceinline__ void operator()(const f32x4 (&acc)[2][2][4][2], const Unit& u, int wr, int wc, int fr, int fq) const {
        { const int t_ = fresh_lane(); fr = t_ & 15; fq = t_ >> 4; }
        const int row0 = u.pm * 256 + wr * 64 + fr, col0 = u.pn * 256 + wc * 32 + 8 * fq;
#pragma unroll
        for (int ai = 0; ai < 2; ++ai)
#pragma unroll
            for (int m = 0; m < 4; ++m) {
                const int r = row0 + ai * 128 + m * 16; const size_t off = (size_t)r * 1024 + col0; const float rs = rstd3[r]; float sq = 0.f;
#pragma unroll
                for (int bj = 0; bj < 2; ++bj) {
                    const size_t o = off + bj * 128; const u32x4 pw = *(const u32x4*)(pp + o);
#if ALL_FUSED
                    const u32x4 hw = *(const u32x4*)(h2b + o);
                    const f32x4 v0 = bf4_lo((u32x2){hw.x, hw.y}) + sig4(acc[ai][bj][m][0] * rs) * bf4_lo((u32x2){pw.x, pw.y});
                    const f32x4 v1 = bf4_lo((u32x2){hw.z, hw.w}) + sig4(acc[ai][bj][m][1] * rs) * bf4_lo((u32x2){pw.z, pw.w});
                    *(u32x4*)(h3b + o) = pack8(v0, v1);
#else
                    const f32x4 v0 = *(const f32x4*)(h + o) + sig4(acc[ai][bj][m][0] * rs) * bf4_lo((u32x2){pw.x, pw.y});
                    const f32x4 v1 = *(const f32x4*)(h + o + 4) + sig4(acc[ai][bj][m][1] * rs) * bf4_lo((u32x2){pw.z, pw.w});
                    *(f32x4*)(h + o) = v0; *(f32x4*)(h + o + 4) = v1;
#endif
                    sq += (v0[0] * v0[0] + v0[1] * v0[1]) + (v0[2] * v0[2] + v0[3] * v0[3]) + (v1[0] * v1[0] + v1[1] * v1[1]) + (v1[2] * v1[2] + v1[3] * v1[3]);
                }
                sq += __shfl_xor(sq, 16); sq += __shfl_xor(sq, 32);
                if (fq == 0) part[(size_t)r * 16 + u.pn * 4 + wc] = sq;
            }
    }
};
struct EpiPre {
    static constexpr bool PERM = false, AFTER_DRAIN = false;
    float* rp; float* ip;
    __device__ __forceinline__ void operator()(const f32x4 (&acc)[2][2][4][2], const Unit& u, int wr, int wc, int fr, int fq) const {
        { const int t_ = fresh_lane(); fr = t_ & 15; fq = t_ >> 4; }
#pragma unroll
        for (int n = 0; n < 2; ++n) { const int ch = u.pn * 128 + wc * 32 + 16 * n + 4 * fq;
#pragma unroll
            for (int ai = 0; ai < 2; ++ai)
#pragma unroll
                for (int m = 0; m < 4; ++m) { const int r = u.pm * 256 + ai * 128 + wr * 64 + m * 16 + fr; const size_t o = (size_t)r * 1024 + ch; *(f32x4*)(rp + o) = acc[ai][0][m][n]; *(f32x4*)(ip + o) = acc[ai][1][m][n]; } }
    }
};
struct EpiH3Final {
    static constexpr bool PERM = true, AFTER_DRAIN = false;
    const float* rstd3; const bf16* pp; const bf16* h2b; const float* fg; float* out; float* part; unsigned* cnt;
    __device__ __forceinline__ void operator()(f32x4 (&acc)[2][2][4][2], const Unit& u, int wr, int wc, int fr, int fq) const {
        { const int t_ = fresh_lane(); fr = t_ & 15; fq = t_ >> 4; }
        const int row0 = u.pm * 256 + wr * 64 + fr, col0 = u.pn * 256 + wc * 32 + 8 * fq;
#pragma unroll
        for (int ai = 0; ai < 2; ++ai)
#pragma unroll
            for (int m = 0; m < 4; ++m) {
                const int r = row0 + ai * 128 + m * 16; const size_t off = (size_t)r * 1024 + col0; const float rs = rstd3[r]; float sq = 0.f;
#pragma unroll
                for (int bj = 0; bj < 2; ++bj) {
                    const size_t o = off + bj * 128; const u32x4 pw = *(const u32x4*)(pp + o); const u32x4 hw = *(const u32x4*)(h2b + o);
                    const f32x4 v0 = bf4_lo((u32x2){hw.x, hw.y}) + sig4(acc[ai][bj][m][0] * rs) * bf4_lo((u32x2){pw.x, pw.y});
                    const f32x4 v1 = bf4_lo((u32x2){hw.z, hw.w}) + sig4(acc[ai][bj][m][1] * rs) * bf4_lo((u32x2){pw.z, pw.w});
                    acc[ai][bj][m][0] = v0; acc[ai][bj][m][1] = v1;
                    sq += (v0[0] * v0[0] + v0[1] * v0[1]) + (v0[2] * v0[2] + v0[3] * v0[3]) + (v1[0] * v1[0] + v1[1] * v1[1]) + (v1[2] * v1[2] + v1[3] * v1[3]);
                }
                sq += __shfl_xor(sq, 16); sq += __shfl_xor(sq, 32);
                if (fq == 0) __hip_atomic_store(part + (size_t)r * 16 + u.pn * 4 + wc, sq, __ATOMIC_RELAXED, __HIP_MEMORY_SCOPE_AGENT);
            }
        asm volatile("s_waitcnt vmcnt(0)" ::: "memory");
        const int lane = fq * 16 + fr;
        unsigned* c = cnt + 64 * u.pm;
        if (lane == 0) __hip_atomic_fetch_add(c, 1u, __ATOMIC_RELAXED, __HIP_MEMORY_SCOPE_AGENT);
        {
            const unsigned long long t0 = __builtin_amdgcn_s_memrealtime();
            while ((unsigned)__builtin_amdgcn_readfirstlane((int)__hip_atomic_load(c, __ATOMIC_RELAXED, __HIP_MEMORY_SCOPE_AGENT)) < 32u) {
                if (__builtin_amdgcn_s_memrealtime() - t0 > 2000000ull) break;
                __builtin_amdgcn_s_sleep(2);
            }
        }
        { const int t_ = fresh_lane(); fr = t_ & 15; fq = t_ >> 4; }
#pragma unroll
        for (int ai = 0; ai < 2; ++ai)
#pragma unroll
            for (int m = 0; m < 4; ++m) {
                const int r = u.pm * 256 + wr * 64 + fr + ai * 128 + m * 16;
                float ps = 0.f;
#pragma unroll
                for (int k = 0; k < 16; ++k) ps += __hip_atomic_load(part + (size_t)r * 16 + k, __ATOMIC_RELAXED, __HIP_MEMORY_SCOPE_AGENT);
                const float rr = 1.0f / sqrtf(ps * (1.0f / 1024.0f) + EPS);
                const int cc = u.pn * 256 + wc * 32 + 8 * fq;
#pragma unroll
                for (int bj = 0; bj < 2; ++bj) {
                    const f32x4 g0 = *(const f32x4*)(fg + cc + bj * 128), g1 = *(const f32x4*)(fg + cc + bj * 128 + 4);
                    float* op = out + (size_t)r * 1024 + cc + bj * 128;
                    *(f32x4*)op = acc[ai][bj][m][0] * rr * g0; *(f32x4*)(op + 4) = acc[ai][bj][m][1] * rr * g1;
                }
            }
    }
};
template <int CTRL> __device__ __forceinline__ float dpp_f(float oldv, float src) {
    return __builtin_bit_cast(float, __builtin_amdgcn_update_dpp(__builtin_bit_cast(int, oldv), __builtin_bit_cast(int, src), CTRL, 0xf, 0xf, false));
}
#ifndef LRU_T2
#define LRU_T2 0
#endif
struct EpiLru {
    static constexpr bool PERM = false, AFTER_DRAIN = false;
    const bf16* lin; const float* ba; const float* bx; const float* c8l; bf16* hloc; bf16* pcum; float* agg;
    template <int SH> static __device__ __forceinline__ void step(f32x4& A, f32x4& Bv, float idd) {
#pragma unroll
        for (int j = 0; j < 4; ++j) {
            const float ap = __int_as_float(__builtin_amdgcn_update_dpp(0, __float_as_int((float)A[j]), 0x110 + SH, 0xf, 0xf, true)) + idd;
            const float bp = __int_as_float(__builtin_amdgcn_update_dpp(0, __float_as_int((float)Bv[j]), 0x110 + SH, 0xf, 0xf, true));
            Bv[j] = fmaf(A[j], bp, Bv[j]); A[j] = A[j] * ap; }
    }
    __device__ __forceinline__ void operator()(f32x4 (&acc)[2][2][4][2], const Unit& u, int wr, int wc, int fr, int fq) const {
        { const int t_ = fresh_lane(); fr = t_ & 15; fq = t_ >> 4; }
        const int lane = fq * 16 + fr;
#pragma unroll
        for (int n = 0; n < 2; ++n) {
            const int ch = u.pn * 128 + wc * 32 + 16 * n + 4 * fq;
            const f32x4 bav = *(const f32x4*)(ba + ch), bxv = *(const f32x4*)(bx + ch), cv = *(const f32x4*)(c8l + ch);
#pragma unroll
            for (int ai = 0; ai < 2; ++ai)
#pragma unroll
                for (int m = 0; m < 4; ++m) {
                    const int r = u.pm * 256 + ai * 128 + wr * 64 + m * 16 + fr; const unsigned o = (unsigned)r * 1024u + (unsigned)ch;
                    const f32x4 lv = bf4_lo(*(const u32x2*)(lin + o));
#pragma unroll
                    for (int j = 0; j < 4; ++j) {
                        const float rr = sigmoidf_(acc[ai][0][m][n][j] + bav[j]), ii = sigmoidf_(acc[ai][1][m][n][j] + bxv[j]);
                        const float a = __builtin_amdgcn_exp2f(cv[j] * rr);
                        acc[ai][0][m][n][j] = a; acc[ai][1][m][n][j] = __builtin_amdgcn_sqrtf(fmaxf(1.0f - a * a, 0.f)) * (ii * lv[j]);
                    }
                    asm volatile("" : "+v"(acc[ai][0][m][n]), "+v"(acc[ai][1][m][n]));
                }
        }
#if defined(LRU_DEBUG) && LRU_DEBUG == 1
        {
            float* af = (float*)hloc; float* bf = (float*)pcum;
#pragma unroll
            for (int n = 0; n < 2; ++n) { const int ch = u.pn * 128 + wc * 32 + 16 * n + 4 * fq;
#pragma unroll
                for (int ai = 0; ai < 2; ++ai)
#pragma unroll
                    for (int m = 0; m < 4; ++m) { const int r = u.pm * 256 + ai * 128 + wr * 64 + m * 16 + fr; const size_t o = (size_t)r * 1024 + ch; *(f32x4*)(af + o) = acc[ai][0][m][n]; *(f32x4*)(bf + o) = acc[ai][1][m][n]; } }
            return;
        }
#endif
        __builtin_amdgcn_sched_barrier(0);
        const float id1 = fr < 1 ? 1.f : 0.f, id2 = fr < 2 ? 1.f : 0.f, id4 = fr < 4 ? 1.f : 0.f, id8 = fr < 8 ? 1.f : 0.f;
#pragma unroll
        for (int ai = 0; ai < 2; ++ai)
#pragma unroll
            for (int m = 0; m < 4; ++m)
#pragma unroll
                for (int n = 0; n < 2; ++n) { step<1>(acc[ai][0][m][n], acc[ai][1][m][n], id1); step<2>(acc[ai][0][m][n], acc[ai][1][m][n], id2); step<4>(acc[ai][0][m][n], acc[ai][1][m][n], id4); step<8>(acc[ai][0][m][n], acc[ai][1][m][n], id8);
                    asm volatile("" : "+v"(acc[ai][0][m][n]), "+v"(acc[ai][1][m][n])); }
        { const int t_ = fresh_lane(); fr = t_ & 15; fq = t_ >> 4; }
        const int src4 = (((fq * 16 + fr) & 48) | 15) * 4;
#pragma unroll
        for (int n = 0; n < 2; ++n) {
            const int ch = u.pn * 128 + wc * 32 + 16 * n + 4 * fq;
#pragma unroll
            for (int ai = 0; ai < 2; ++ai) {
#pragma unroll
                for (int m = 0; m < 4; ++m) {
                    f32x4& A = acc[ai][0][m][n]; f32x4& Bv = acc[ai][1][m][n];
                    if (m > 0 && !(LRU_T2)) {
#pragma unroll
                        for (int j = 0; j < 4; ++j) { const float pa = acc[ai][0][m - 1][n][j], pb = acc[ai][1][m - 1][n][j];
                            const float ac = __int_as_float(__builtin_amdgcn_ds_bpermute(src4, __float_as_int(pa))), bc = __int_as_float(__builtin_amdgcn_ds_bpermute(src4, __float_as_int(pb))); Bv[j] = fmaf(A[j], bc, Bv[j]); A[j] = A[j] * ac; }
                    }
                    const int r = u.pm * 256 + ai * 128 + wr * 64 + m * 16 + fr; const unsigned o = (unsigned)r * 1024u + (unsigned)ch;
                    u32x2 wp, wh; wp.x = cvt_pk_bf16(A[0], A[1]); wp.y = cvt_pk_bf16(A[2], A[3]); wh.x = cvt_pk_bf16(Bv[0], Bv[1]); wh.y = cvt_pk_bf16(Bv[2], Bv[3]);
                    *(u32x2*)(pcum + o) = wp; *(u32x2*)(hloc + o) = wh;
                    if (m == 3 && fr == 15) {
                        const int chunk = u.pm * 4 + ai * 2 + wr; float* ap = agg + ((size_t)chunk * 1024 + ch) * 2;
                        *(f32x4*)(ap) = (f32x4){A[0], Bv[0], A[1], Bv[1]}; *(f32x4*)(ap + 4) = (f32x4){A[2], Bv[2], A[3], Bv[3]};
                    }
                    __builtin_amdgcn_sched_barrier(0);
                }
            }
        }
    }
};

__device__ __forceinline__ void p0_transpose_item(const float* W, int ldw, const float* gain, bf16* WT, int ldt, int k_off, LAS float* scr, int kb, int nb, int lane) {
    const int k0 = 64 * kb, n0 = 32 * nb;
    const int c4 = lane & 7, kr = lane >> 3;
    f32x4 v[8];
#pragma unroll
    for (int i = 0; i < 8; ++i) v[i] = *(const f32x4*)(W + (size_t)(k0 + 8 * i + kr) * ldw + n0 + 4 * c4);
#pragma unroll
    for (int i = 0; i < 8; ++i) { f32x4 x = v[i]; if (gain) x = x * gain[k0 + 8 * i + kr]; *(LAS f32x4*)(scr + (8 * i + kr) * 36 + 4 * c4) = x; }
    LDS_WAIT(); asm volatile("" ::: "memory");
    const int c = lane & 7;
#pragma unroll
    for (int j = 0; j < 4; ++j) { const int n = (lane >> 3) + 8 * j; const LAS float* sp = scr + (8 * c) * 36 + n;
        u32x4 o; o.x = pk2(sp[0 * 36], sp[1 * 36]); o.y = pk2(sp[2 * 36], sp[3 * 36]); o.z = pk2(sp[4 * 36], sp[5 * 36]); o.w = pk2(sp[6 * 36], sp[7 * 36]);
        *(u32x4*)(WT + (size_t)(n0 + n) * ldt + k_off + k0 + 8 * c) = o; }
    LDS_WAIT(); asm volatile("" ::: "memory");
}
__device__ __forceinline__ void p0_wfold_item(LAS float* lds, const float* wq, const float* k1, const float* k2, const float* gffn, bf16* wfold, int item, int tid) {
    const int hh = item >> 4, kb = item & 15;
    LAS float* wqs = lds; LAS float* kks = lds + 64 * 132;
    const float* ksrc = (hh & 1) ? k2 : k1;
#pragma unroll
    for (int i = 0; i < 4; ++i) { const int e = tid + i * 512, r = e >> 5, c4 = e & 31; *(LAS f32x4*)(wqs + r * 132 + 4 * c4) = *(const f32x4*)(wq + (size_t)(kb * 64 + r) * 2048 + hh * 128 + 4 * c4); }
#pragma unroll
    for (int i = 0; i < 8; ++i) { const int e = tid + i * 512, r = e >> 5, c4 = e & 31; *(LAS f32x4*)(kks + r * 132 + 4 * c4) = *(const f32x4*)(ksrc + (size_t)r * 128 + 4 * c4); }
    __syncthreads();
    const int tk = tid & 15, tkey = tid >> 4;
    float acc[4][4];
#pragma unroll
    for (int i = 0; i < 4; ++i)
#pragma unroll
        for (int j = 0; j < 4; ++j) acc[i][j] = 0.f;
#pragma unroll 2
    for (int c4 = 0; c4 < 32; ++c4) {
        f32x4 a[4], b[4];
#pragma unroll
        for (int i = 0; i < 4; ++i) { a[i] = *(const LAS f32x4*)(wqs + (tk * 4 + i) * 132 + 4 * c4); b[i] = *(const LAS f32x4*)(kks + (tkey * 4 + i) * 132 + 4 * c4); }
#pragma unroll
        for (int i = 0; i < 4; ++i)
#pragma unroll
            for (int j = 0; j < 4; ++j) acc[i][j] += (a[i][0] * b[j][0] + a[i][1] * b[j][1]) + (a[i][2] * b[j][2] + a[i][3] * b[j][3]);
    }
    const int kg = kb * 64 + tk * 4; const f32x4 gv = *(const f32x4*)(gffn + kg);
#pragma unroll
    for (int j = 0; j < 4; ++j) { u32x2 w; w.x = pk2(acc[0][j] * gv[0], acc[1][j] * gv[1]); w.y = pk2(acc[2][j] * gv[2], acc[3][j] * gv[3]);
        *(u32x2*)(wfold + (size_t)(hh * 128 + tkey * 4 + j) * 1024 + kg) = w; }
    __syncthreads();
}

struct In { const float* p[25]; };
enum { I_X = 0, I_P, I_GMIX, I_WIN, I_SINK, I_CONVW, I_CONVB, I_WA, I_BA, I_WX, I_BX, I_LAM, I_WUA, I_WUL, I_WO, I_GFFN, I_WQ, I_K1, I_K2, I_U, I_V, I_GPLE, I_WGATE, I_WPROJ, I_FG };

__device__ __forceinline__ void p0_prologue(const In& in, unsigned char* ws, LAS unsigned char* lds, int vcu, int G, int wave, int tid) {
    const int lane = tid & 63;
    LAS float* scr = (LAS float*)(lds + wave * 16384);
    const int gw = vcu * NWAVES + wave, NGW = G * NWAVES;
    constexpr int I_IN = 16 * 152, I_UA = 8 * 32, I_SQ = 16 * 32, I_PJ = 4 * 32, I_AX = 128;
    constexpr int NITEMS = I_IN + I_UA + 3 * I_SQ + I_PJ + I_AX;
    for (int it = gw; it < NITEMS; it += NGW) {
        int r = it;
        if (r < I_IN) { p0_transpose_item(in.p[I_WIN], INW, in.p[I_GMIX], (bf16*)(ws + WS_WIN), 1024, 0, scr, r / 152, r % 152, lane); continue; } r -= I_IN;
        if (r < I_UA) { p0_transpose_item(in.p[I_WUA], 1024, nullptr, (bf16*)(ws + WS_WUA), 512, 0, scr, r / 32, r % 32, lane); continue; } r -= I_UA;
        if (r < I_SQ) { p0_transpose_item(in.p[I_WUL], 1024, nullptr, (bf16*)(ws + WS_WUL), 1024, 0, scr, r / 32, r % 32, lane); continue; } r -= I_SQ;
        if (r < I_SQ) { p0_transpose_item(in.p[I_WO], 1024, nullptr, (bf16*)(ws + WS_WO), 1024, 0, scr, r / 32, r % 32, lane); continue; } r -= I_SQ;
        if (r < I_SQ) { p0_transpose_item(in.p[I_WGATE], 1024, in.p[I_GPLE], (bf16*)(ws + WS_WG), 1024, 0, scr, r / 32, r % 32, lane); continue; } r -= I_SQ;
        if (r < I_PJ) { p0_transpose_item(in.p[I_WPROJ], 1024, nullptr, (bf16*)(ws + WS_WPROJ), 256, 0, scr, r / 32, r % 32, lane); continue; } r -= I_PJ;
        { const int blk = r >> 4, which = (r >> 3) & 1, sub = r & 7;

#if LRU_PADDED
#if LRU_PADDED == 2
          p0_transpose_item(in.p[which ? I_WX : I_WA] + (size_t)blk * 16384, 128, nullptr, (bf16*)(ws + WS_WAX) + (size_t)blk * 32768 + which * 128 * 128, 128, 0, scr, sub >> 2, sub & 3, lane); }
#else
          p0_transpose_item(in.p[which ? I_WX : I_WA] + (size_t)blk * 16384, 128, nullptr, (bf16*)(ws + WS_WAX) + (size_t)blk * 65536 + which * 128 * 256, 256, (blk & 1) * 128, scr, sub >> 2, sub & 3, lane); }
#endif
#else
          p0_transpose_item(in.p[which ? I_WX : I_WA] + (size_t)blk * 16384, 128, nullptr, (bf16*)(ws + WS_WAXD) + (size_t)(blk * 256 + which * 128) * 1024, 1024, blk * 128, scr, sub >> 2, sub & 3, lane); }
#endif
    }
#if LRU_PADDED == 2
#elif LRU_PADDED
    for (int i = vcu * 512 + tid; i < 8 * 256 * 16; i += G * 512) { const int c16 = i & 15, n = (i >> 4) & 255, blk = i >> 12;
        *(u32x4*)((bf16*)(ws + WS_WAX) + (size_t)blk * 65536 + n * 256 + ((blk & 1) ^ 1) * 128 + c16 * 8) = (u32x4){0u, 0u, 0u, 0u}; }
#else
    for (int i = vcu * 512 + tid; i < 2048 * 128; i += G * 512) { const int c16 = i & 127, row = i >> 7, blk = row >> 8;
        if ((c16 >> 4) != blk) *(u32x4*)((bf16*)(ws + WS_WAXD) + (size_t)row * 1024 + c16 * 8) = (u32x4){0u, 0u, 0u, 0u}; }
#endif
    for (int m = gw; m < T_; m += 2 * NGW) {
        const int m2 = m + NGW;
        const f32x4* xa = (const f32x4*)(in.p[I_X] + (size_t)m * 1024) + lane; const f32x4* xb = (const f32x4*)(in.p[I_X] + (size_t)(m2 < T_ ? m2 : m) * 1024) + lane;
        f32x4 va[4], vb[4]; float sa = 0.f, sb = 0.f;
#pragma unroll
        for (int j = 0; j < 4; ++j) { va[j] = xa[64 * j]; vb[j] = xb[64 * j]; }
#pragma unroll
        for (int j = 0; j < 4; ++j) { sa += (va[j][0] * va[j][0] + va[j][1] * va[j][1]) + (va[j][2] * va[j][2] + va[j][3] * va[j][3]); sb += (vb[j][0] * vb[j][0] + vb[j][1] * vb[j][1]) + (vb[j][2] * vb[j][2] + vb[j][3] * vb[j][3]); }
#pragma unroll
        for (int o = 1; o < 64; o <<= 1) { sa += __shfl_xor(sa, o); sb += __shfl_xor(sb, o); }
        u32x2* oa = (u32x2*)((bf16*)(ws + WS_R0) + (size_t)m * 1024) + lane;
#pragma unroll
        for (int j = 0; j < 4; ++j) { u32x2 w; w.x = pk2(va[j][0], va[j][1]); w.y = pk2(va[j][2], va[j][3]); oa[64 * j] = w; }
        if (lane == 0) ((float*)(ws + WS_RSTD1))[m] = 1.0f / sqrtf(sa * (1.0f / 1024.0f) + EPS);
        if (m2 < T_) {
            u32x2* ob = (u32x2*)((bf16*)(ws + WS_R0) + (size_t)m2 * 1024) + lane;
#pragma unroll
            for (int j = 0; j < 4; ++j) { u32x2 w; w.x = pk2(vb[j][0], vb[j][1]); w.y = pk2(vb[j][2], vb[j][3]); ob[64 * j] = w; }
            if (lane == 0) ((float*)(ws + WS_RSTD1))[m2] = 1.0f / sqrtf(sb * (1.0f / 1024.0f) + EPS);
        }
    }
    for (int m = gw; m < T_; m += 4 * NGW) {
        f32x4 v[4];
#pragma unroll
        for (int q = 0; q < 4; ++q) { const int mq = m + q * NGW; v[q] = ((const f32x4*)(in.p[I_P] + (size_t)(mq < T_ ? mq : m) * 256))[lane]; }
#pragma unroll
        for (int q = 0; q < 4; ++q) { const int mq = m + q * NGW; if (mq < T_) { u32x2 w; w.x = pk2(v[q][0], v[q][1]); w.y = pk2(v[q][2], v[q][3]); ((u32x2*)((bf16*)(ws + WS_PB) + (size_t)mq * 256))[lane] = w; } }
    }
    if (vcu == 0) for (int c = tid; c < 1024; c += 512) ((float*)(ws + WS_C8))[c] = -8.0f * log1pf(expf(-in.p[I_LAM][c])) * LOG2E;
    __syncthreads();
    for (int it = vcu; it < 256; it += G) p0_wfold_item((LAS float*)lds, in.p[I_WQ], in.p[I_K1], in.p[I_K2], in.p[I_GFFN], (bf16*)(ws + WS_WFOLD), it, tid);
}

constexpr int AT_KSTR = 72, AT_VSTR = 260, AT_V_OFF = 256 * AT_KSTR * 2;
__device__ __forceinline__ int crow(int r, int hi) { return (r & 3) + 8 * (r >> 2) + 4 * hi; }
__device__ __forceinline__ void attn_item(LAS unsigned char* lds, const bf16* qkv, const float* sink, bf16* att, int item, int wave, int tid) {
    const int lane = tid & 63;
    const int g = item & 1, n = (item >> 1) & 15, b = item >> 5;
    const int t0 = b * S_ + n * 128;
    LAS bf16* Ks = (LAS bf16*)lds; LAS bf16* Vt = (LAS bf16*)(lds + AT_V_OFF);
#pragma unroll
    for (int i = 0; i < 4; ++i) {
        const int idx = tid + i * 512, row = idx >> 3, ch = idx & 7; const int tk = t0 - 128 + row;
        u32x4 kv = (u32x4){0u, 0u, 0u, 0u}, vv = (u32x4){0u, 0u, 0u, 0u};
        if (n > 0 || row >= 128) { const bf16* src = qkv + (size_t)tk * 768 + 512 + g * 64 + ch * 8; kv = *(const u32x4*)src; vv = *(const u32x4*)(src + 128); }
        *(LAS u32x4*)(Ks + row * AT_KSTR + ch * 8) = kv;
#pragma unroll
        for (int c = 0; c < 8; ++c) Vt[(ch * 8 + c) * AT_VSTR + row] = (bf16)(vv[c >> 1] >> (16 * (c & 1)));
    }
    __syncthreads();
    const int hr = wave >> 1, qh = wave & 1, head = g * 4 + hr;
    const float slope2 = exp2f(-(float)(head + 1)) * LOG2E, sink2 = sink[head] * LOG2E;
    const int q = lane & 31, hi = lane >> 5;
#pragma unroll 1
    for (int ps = 0; ps < 2; ++ps) {
        const int i0 = 64 * qh + 32 * ps, kb0 = i0;
        const bf16* qp = qkv + (size_t)(t0 + i0 + q) * 768 + head * 64 + 8 * hi;
        bf16x8 qf[4];
#pragma unroll
        for (int s = 0; s < 4; ++s) qf[s] = *(const bf16x8*)(qp + 16 * s);
        f32x16 oT[2];
#pragma unroll
        for (int dt = 0; dt < 2; ++dt)
#pragma unroll
            for (int r = 0; r < 16; ++r) oT[dt][r] = 0.f;
        float mrun = sink2, l = 0.f;
#pragma unroll 1
        for (int kt = 0; kt < 5; ++kt) {
            const int kbase = kb0 + 32 * kt;
            f32x16 sT;
#pragma unroll
            for (int r = 0; r < 16; ++r) sT[r] = 0.f;
#pragma unroll
            for (int s = 0; s < 4; ++s) { const bf16x8 kf = *(const LAS bf16x8*)(Ks + (kbase + q) * AT_KSTR + 16 * s + 8 * hi); sT = __builtin_amdgcn_mfma_f32_32x32x16_bf16(kf, qf[s], sT, 0, 0, 0); }
            float tm = -1.0e30f;
#pragma unroll
            for (int r = 0; r < 16; ++r) {
                const int kj = kbase + crow(r, hi); const int dist = i0 + q + 128 - kj;
                const bool valid = (dist >= 0) && (dist < 128) && (n > 0 || kj >= 128);
                const float v = valid ? (sT[r] * (0.125f * LOG2E) - slope2 * (float)dist) : -1.0e30f;
                sT[r] = v; tm = fmaxf(tm, v);
            }
            tm = fmaxf(tm, __shfl_xor(tm, 32));
            const float mnew = fmaxf(mrun, tm), alpha = __builtin_amdgcn_exp2f(mrun - mnew);
            mrun = mnew;
            float ls = 0.f;
#pragma unroll
            for (int r = 0; r < 16; ++r) { const float p = __builtin_amdgcn_exp2f(sT[r] - mnew); sT[r] = p; ls += p; }
            l = l * alpha + ls;
#pragma unroll
            for (int dt = 0; dt < 2; ++dt)
#pragma unroll
                for (int r = 0; r < 16; ++r) oT[dt][r] *= alpha;
#pragma unroll
            for (int s = 0; s < 2; ++s) {
                u32x4 pw; pw.x = cvt_pk_bf16(sT[8 * s + 0], sT[8 * s + 1]); pw.y = cvt_pk_bf16(sT[8 * s + 2], sT[8 * s + 3]);
                pw.z = cvt_pk_bf16(sT[8 * s + 4], sT[8 * s + 5]); pw.w = cvt_pk_bf16(sT[8 * s + 6], sT[8 * s + 7]);
                const bf16x8 pf = __builtin_bit_cast(bf16x8, pw);
#pragma unroll
                for (int dt = 0; dt < 2; ++dt) {
                    const LAS bf16* vp = Vt + (32 * dt + q) * AT_VSTR + kbase + 16 * s + 4 * hi;
                    const u32x2 va = *(const LAS u32x2*)vp, vb = *(const LAS u32x2*)(vp + 8);
                    const bf16x8 af = __builtin_bit_cast(bf16x8, (u32x4){va.x, va.y, vb.x, vb.y});
                    oT[dt] = __builtin_amdgcn_mfma_f32_32x32x16_bf16(af, pf, oT[dt], 0, 0, 0);
                }
            }
        }
        l += __shfl_xor(l, 32);
        l += __builtin_amdgcn_exp2f(sink2 - mrun);
        const float inv = 1.0f / l;
        bf16* op = att + (size_t)(t0 + i0 + q) * 512 + head * 64 + 4 * hi;
#pragma unroll
        for (int dt = 0; dt < 2; ++dt)
#pragma unroll
            for (int rg = 0; rg < 4; ++rg) { u32x2 w; w.x = cvt_pk_bf16(oT[dt][4 * rg] * inv, oT[dt][4 * rg + 1] * inv); w.y = cvt_pk_bf16(oT[dt][4 * rg + 2] * inv, oT[dt][4 * rg + 3] * inv);
                *(u32x2*)(op + 32 * dt + 8 * rg) = w; }
    }
    __syncthreads();
}
__device__ __forceinline__ void conv_items(const bf16* lx, const float* cw, const float* cb, bf16* lin, int vcu, int G, int tid) {
    for (int i = vcu * 512 + tid; i < T_ * 128; i += 2 * G * 512) {
        const int c8 = (i & 127) * 8;
        const int ta = i >> 7, i2 = i + G * 512; const bool hasb = i2 < T_ * 128; const int tb = hasb ? (i2 >> 7) : ta;
        const int tsa = ta & (S_ - 1), tsb = tb & (S_ - 1);
        u32x4 wa[4], wb[4];
#pragma unroll
        for (int tap = 0; tap < 4; ++tap) {
            wa[tap] = (tsa - 3 + tap >= 0) ? *(const u32x4*)(lx + (size_t)(ta - 3 + tap) * 1024 + c8) : (u32x4){0u, 0u, 0u, 0u};
            wb[tap] = (tsb - 3 + tap >= 0) ? *(const u32x4*)(lx + (size_t)(tb - 3 + tap) * 1024 + c8) : (u32x4){0u, 0u, 0u, 0u};
        }
        f32x4 a0 = *(const f32x4*)(cb + c8), a1 = *(const f32x4*)(cb + c8 + 4), b0 = a0, b1 = a1;
#pragma unroll
        for (int tap = 0; tap < 4; ++tap) {
            const f32x4 w0 = *(const f32x4*)(cw + tap * 1024 + c8), w1 = *(const f32x4*)(cw + tap * 1024 + c8 + 4);
            a0 += bf4_lo((u32x2){wa[tap].x, wa[tap].y}) * w0; a1 += bf4_lo((u32x2){wa[tap].z, wa[tap].w}) * w1;
            b0 += bf4_lo((u32x2){wb[tap].x, wb[tap].y}) * w0; b1 += bf4_lo((u32x2){wb[tap].z, wb[tap].w}) * w1;
        }
        *(u32x4*)(lin + (size_t)ta * 1024 + c8) = pack8(a0, a1);
        if (hasb) *(u32x4*)(lin + (size_t)tb * 1024 + c8) = pack8(b0, b1);
    }
}
__device__ __forceinline__ void scan_finish(const bf16* hloc, const bf16* pcum, const float* agg, const bf16* gl, bf16* rec, int vcu, int G, int tid) {
    const int c8 = (tid & 127) * 8, rg = tid >> 7;
    for (int chunk = vcu; chunk < T_ / 64; chunk += G) {
        const int ci = chunk & 31, cb = chunk - ci;
        float carry[8];
#pragma unroll
        for (int j = 0; j < 8; ++j) carry[j] = 0.f;
#pragma unroll 4
        for (int cc = 0; cc < ci; ++cc) {
            const f32x4* ap = (const f32x4*)(agg + ((size_t)(cb + cc) * 1024 + c8) * 2);
#pragma unroll
            for (int q = 0; q < 4; ++q) { const f32x4 v = ap[q]; carry[2 * q] = fmaf(v[0], carry[2 * q], v[1]); carry[2 * q + 1] = fmaf(v[2], carry[2 * q + 1], v[3]); }
        }
#pragma unroll 8
        for (int rr = 0; rr < 16; ++rr) {
            const size_t o = (size_t)(chunk * 64 + rg + 4 * rr) * 1024 + c8;
            const u32x4 hw = *(const u32x4*)(hloc + o), pw = *(const u32x4*)(pcum + o), gw = *(const u32x4*)(gl + o);
            const f32x4 h0 = bf4_lo((u32x2){hw.x, hw.y}), h1 = bf4_lo((u32x2){hw.z, hw.w}), p0 = bf4_lo((u32x2){pw.x, pw.y}), p1 = bf4_lo((u32x2){pw.z, pw.w});
            const f32x4 g0 = bf4_lo((u32x2){gw.x, gw.y}), g1 = bf4_lo((u32x2){gw.z, gw.w});
            f32x4 r0, r1;
#pragma unroll
            for (int j = 0; j < 4; ++j) { r0[j] = fmaf(p0[j], carry[j], h0[j]) * g0[j]; r1[j] = fmaf(p1[j], carry[4 + j], h1[j]) * g1[j]; }
            *(u32x4*)(rec + o) = pack8(r0, r1);
        }
    }
}
__device__ __forceinline__ void uv_convert(const float* pu, const float* pv, const float* gffn, unsigned char* u8, unsigned char* v8, float* iu, float* iv, int gw, int NGW, int lane) {
    f32x4 g[4];
#pragma unroll
    for (int j = 0; j < 4; ++j) g[j] = ((const f32x4*)gffn)[4 * lane + j];
    for (int e0 = gw; e0 < 2 * 16384; e0 += 2 * NGW) {
        f32x4 v[2][4];
#pragma unroll
        for (int h = 0; h < 2; ++h) { const int e = e0 + h * NGW; const bool isv = e >= 16384; const int row = isv ? e - 16384 : e;
            const f32x4* src = (const f32x4*)((isv ? pv : pu) + (size_t)row * 1024) + 4 * lane;
#pragma unroll
            for (int j = 0; j < 4; ++j) v[h][j] = src[j]; }
#pragma unroll
        for (int h = 0; h < 2; ++h) {
            const int e = e0 + h * NGW; const bool isv = e >= 16384; const int row = isv ? e - 16384 : e;
            float am = 0.f;
#pragma unroll
            for (int j = 0; j < 4; ++j) { if (!isv) v[h][j] = v[h][j] * g[j]; am = fmaxf(am, fmaxf(fmaxf(fabsf(v[h][j][0]), fabsf(v[h][j][1])), fmaxf(fabsf(v[h][j][2]), fabsf(v[h][j][3])))); }
#pragma unroll
            for (int o = 1; o < 64; o <<= 1) am = fmaxf(am, __shfl_xor(am, o));
            const float sc = am > 0.f ? (isv ? 416.0f : 127.0f) / am : 1.0f;
            u32x4 w;
            if (isv) {
#pragma unroll
                for (int j = 0; j < 4; ++j) { unsigned ww = 0u; ww = __builtin_amdgcn_cvt_pk_fp8_f32(v[h][j][0] * sc, v[h][j][1] * sc, ww, false); ww = __builtin_amdgcn_cvt_pk_fp8_f32(v[h][j][2] * sc, v[h][j][3] * sc, ww, true); w[j] = ww; }
            } else {
#pragma unroll
                for (int j = 0; j < 4; ++j) { unsigned ww = 0u;
#pragma unroll
                    for (int c = 0; c < 4; ++c) ww |= ((unsigned)(int)__builtin_rintf(v[h][j][c] * sc) & 0xffu) << (8 * c);
                    w[j] = ww; }
            }
            *(u32x4*)((isv ? v8 : u8) + (size_t)row * 1024 + 16 * lane) = w;
            if (lane == 0) (isv ? iv : iu)[row] = 1.0f / sc;
        }
    }
}
__device__ __forceinline__ void final_rows(float* h, const bf16* h3b, const float* part, const float* fg, int gw, int NGW, int lane, float tscale) {
    f32x4 g[4];
#pragma unroll
    for (int j = 0; j < 4; ++j) g[j] = ((const f32x4*)fg)[lane + 64 * j];
    for (int r0 = gw; r0 < T_; r0 += 2 * NGW) {
        const int r1 = (r0 + NGW < T_) ? r0 + NGW : r0;
        float pa = (lane < 16) ? part[(size_t)r0 * 16 + lane] : 0.f, pb = (lane < 16) ? part[(size_t)r1 * 16 + lane] : 0.f;
#if ALL_FUSED
        const u32x2* ba = (const u32x2*)(h3b + (size_t)r0 * 1024) + lane; const u32x2* bb = (const u32x2*)(h3b + (size_t)r1 * 1024) + lane;
        u32x2 wa[4], wb[4];
#pragma unroll
        for (int j = 0; j < 4; ++j) { wa[j] = ba[64 * j]; wb[j] = bb[64 * j]; }
#endif
#pragma unroll
        for (int o = 1; o < 64; o <<= 1) { pa += __shfl_xor(pa, o); pb += __shfl_xor(pb, o); }
        const float ra = tscale / sqrtf(pa * (1.0f / 1024.0f) + EPS), rb = tscale / sqrtf(pb * (1.0f / 1024.0f) + EPS);
        f32x4* ha = (f32x4*)(h + (size_t)r0 * 1024) + lane; f32x4* hb = (f32x4*)(h + (size_t)r1 * 1024) + lane;
#if ALL_FUSED
#pragma unroll
        for (int j = 0; j < 4; ++j) ha[64 * j] = bf4_lo(wa[j]) * ra * g[j];
        if (r1 != r0) {
#pragma unroll
            for (int j = 0; j < 4; ++j) hb[64 * j] = bf4_lo(wb[j]) * rb * g[j];
        }
#else
#pragma unroll
        for (int j = 0; j < 4; ++j) ha[64 * j] = ha[64 * j] * ra * g[j];
        if (r1 != r0) {
#pragma unroll
            for (int j = 0; j < 4; ++j) hb[64 * j] = hb[64 * j] * rb * g[j];
        }
#endif
    }
}

constexpr int N_PHASES = 16;
struct Args { const float* in[25]; float* out; unsigned char* ws; int ph_lo, ph_hi, li, pad; };
__global__ void __launch_bounds__(NWAVES * 64, 2) __attribute__((target("no-packed-fp32-ops"))) fused_fwd(Args args) {
    extern __shared__ __attribute__((aligned(16))) unsigned char lds_raw[];
    LAS unsigned char* lds = (LAS unsigned char*)lds_raw;
    volatile LAS unsigned* MISC = (volatile LAS unsigned*)(lds + LDSCTL_OFF);
    const int wave = __builtin_amdgcn_readfirstlane((int)threadIdx.x >> 6);
#define FRESH_TID() (wave * 64 + fresh_lane())
#define FRESH_LANE() fresh_lane()
    const int G = gridDim.x; const int bx = blockIdx.x; const int vcu = (G % 8 == 0) ? (bx % 8) * (G / 8) + bx / 8 : bx;
    unsigned char* ws = args.ws; float* out = args.out;
    In in;
#pragma unroll
    for (int i = 0; i < 25; ++i) in.p[i] = args.in[i];
    for (int u = FRESH_TID(); u < (LDS_BYTES - LDSCTL_OFF) / 4; u += NWAVES * 64) ((LAS unsigned*)(lds + LDSCTL_OFF))[u] = 0u;
    __syncthreads();
    (void)xcd_barrier_post((unsigned*)(ws + WS_CTL) + CW_BAR + args.li * XCD_BAR_WORDS, MISC + 8);
    const int lo = args.ph_lo, hi = args.ph_hi;
    const int gw = vcu * NWAVES + wave, NGW = G * NWAVES;
#ifndef PH_DISABLE
#define PH_DISABLE 0
#endif
#if ALL_FUSED
#define IN(k) (!((PH_DISABLE >> (k)) & 1))
#else
#define IN(k) (lo <= (k) && (k) < hi && !((PH_DISABLE >> (k)) & 1))
#endif
#ifdef TIMING_A
#define STAMP(i) do { if (bx == 0 && FRESH_TID() == 0) __hip_atomic_store((unsigned long long*)(ws + WS_CTL + 512) + (i), __builtin_amdgcn_s_memrealtime(), __ATOMIC_RELAXED, __HIP_MEMORY_SCOPE_AGENT); } while (0)
#else
#define STAMP(i) do { } while (0)
#endif
#define SEAM(k) do { if (IN(k) && IN((k) + 1)) { XcdBarrier b_; b_.bar = (unsigned*)(args.ws + WS_CTL) + CW_BAR + args.li * XCD_BAR_WORDS; b_.x = xb_xcc_id(); b_.st = (volatile LAS unsigned*)(lds + LDSCTL_OFF) + 8;     \
        xcd_barrier(b_); STAMP((k) + 1); } } while (0)
#if ALL_FUSED
#define PP_OFF WS_PP2
#define MP_PTR out
#else
#define PP_OFF WS_PP
#define MP_PTR ((float*)(ws + WS_MP))
#endif
#define GEMM_PHASE(EPI, Aptr, Bptr, Kdim, LDA, M_, N_, SH, STR, ...) do { \
        pg8::Gemm g{(const pg8::bf16_t*)(Aptr), (const pg8::bf16_t*)(Bptr), Kdim, LDA, SH, STR}; pg8::StaticOrder S; S.init(M_, N_, G, (int)blockIdx.x); \
        EPI E{__VA_ARGS__}; pg8::gemm_phase<EPI, pg8::StaticOrder, true, true>(lds, g, S, E, wave); } while (0)

    STAMP(0);
    if (IN(0)) { p0_prologue(in, ws, lds, vcu, G, wave, FRESH_TID()); } SEAM(0);
    if (IN(1)) { GEMM_PHASE(EpiProj, ws + WS_R0, ws + WS_WIN, 1024, 1024, T_, INW, 0, 0, (const float*)(ws + WS_RSTD1), ws); } SEAM(1);
    if (IN(2)) {
        for (int it = bx; it < 256; it += G) attn_item(lds, (const bf16*)(ws + WS_QKV), in.p[I_SINK], (bf16*)(ws + WS_ATT), it, wave, FRESH_TID());
        conv_items((const bf16*)(ws + WS_LX), in.p[I_CONVW], in.p[I_CONVB], (bf16*)(ws + WS_R0), vcu, G, FRESH_TID());
    } SEAM(2);
#if LRU_PADDED == 2
    if (IN(3)) { GEMM_PHASE(EpiLru, ws + WS_R0, ws + WS_WAX, 128, 1024, T_, 2048, 0, 128,
#elif LRU_PADDED
    if (IN(3)) { GEMM_PHASE(EpiLru, ws + WS_R0, ws + WS_WAX, 256, 1024, T_, 2048, 1, 256,
#else
    if (IN(3)) { GEMM_PHASE(EpiLru, ws + WS_R0, ws + WS_WAXD, 1024, 1024, T_, 2048, 0, 0,
#endif
        (const bf16*)(ws + WS_R0), in.p[I_BA], in.p[I_BX], (const float*)(ws + WS_C8), (bf16*)(ws + WS_HLOC), (bf16*)(ws + WS_PCUM), (float*)(ws + WS_AGG)); }
    SEAM(3);
    if (IN(4)) { scan_finish((const bf16*)(ws + WS_HLOC), (const bf16*)(ws + WS_PCUM), (const float*)(ws + WS_AGG), (const bf16*)(ws + WS_GL), (bf16*)(ws + WS_R0), vcu, G, FRESH_TID()); }
#if !ALL_FUSED
    SEAM(4);
#endif
    if (IN(5)) { GEMM_PHASE(EpiMP, ws + WS_ATT, ws + WS_WUA, 512, 512, T_, 1024, 0, 0, (const bf16*)(ws + WS_SGA), MP_PTR); } SEAM(5);
    if (IN(6)) { GEMM_PHASE(EpiMerged, ws + WS_R0, ws + WS_WUL, 1024, 1024, T_, 1024, 0, 0, (const bf16*)(ws + WS_SGL), (const float*)MP_PTR, (bf16*)(ws + WS_MERGED)); } SEAM(6);
    if (IN(7)) { GEMM_PHASE(EpiH1, ws + WS_MERGED, ws + WS_WO, 1024, 1024, T_, 1024, 0, 0, in.p[I_X], out, (bf16*)(ws + WS_R0), (float*)(ws + WS_PART2)); }
#if ALL_FUSED
    if (IN(13)) { GEMM_PHASE(EpiPP, ws + WS_PB, ws + WS_WPROJ, 256, 256, T_, 1024, 0, 0, (bf16*)(ws + WS_PP2)); }
#endif
    SEAM(7);
#define PEER_HALF(half) do { \
        if (IN(8 + 2 * (half))) { GEMM_PHASE(EpiScore, ws + WS_R0, ws + WS_WFOLD + (size_t)(half) * 1024 * 1024 * 2, 1024, 1024, T_, 1024, 0, 0, (const float*)(ws + WS_PART2), (float*)(ws + WS_SC)); } SEAM(8 + 2 * (half)); \
        if (IN(9 + 2 * (half))) { \
            for (int it = vcu; it < T_ / TK_TOK; it += G) topk_item((LAS float*)lds, (const float*)(ws + WS_SC), it, (half) * 4, (int*)(ws + WS_SELI), (float*)(ws + WS_SELG), FRESH_TID()); \
            if ((half) == 0) uv_convert(in.p[I_U], in.p[I_V], in.p[I_GFFN], ws + WS_U16, ws + WS_U16 + 16 * MiB, (float*)(ws + WS_USCALE), (float*)(ws + WS_USCALE) + 16384, gw, NGW, FRESH_LANE()); \
        } SEAM(9 + 2 * (half)); } while (0)
#if ALL_FUSED
    if (IN(8)) {
        for (int kk = 0; kk < 2; ++kk) { pg8::Gemm g{(const pg8::bf16_t*)(ws + WS_R0), (const pg8::bf16_t*)(ws + WS_WFOLD), 1024, 1024, 0, 0}; OneUnit S; S.S.init(T_, 2048, G, (int)blockIdx.x); S.k = kk;
            EpiTopk E{(const float*)(ws + WS_PART2), (int*)(ws + WS_SELI), (float*)(ws + WS_SELG)}; pg8::gemm_phase<EpiTopk, OneUnit, false, true>(lds, g, S, E, wave); }
        uv_convert(in.p[I_U], in.p[I_V], in.p[I_GFFN], ws + WS_U16, ws + WS_U16 + 16 * MiB, (float*)(ws + WS_USCALE), (float*)(ws + WS_USCALE) + 16384, gw, NGW, FRESH_LANE());
    } SEAM(11);
#else
    PEER_HALF(0);
    PEER_HALF(1);
#endif
    if (IN(12)) {
#ifdef PROBE_MODE
        for (int tok0 = vcu * 64; tok0 < T_; tok0 += G * 64)
            gather_wg_sliced<PROBE_MODE>(tok0, wave, FRESH_LANE(), lds, ws + WS_U16, ws + WS_U16 + 16 * MiB, (const float*)(ws + WS_USCALE), (const float*)(ws + WS_USCALE) + 16384, (const int*)(ws + WS_SELI), (const float*)(ws + WS_SELG), (const float*)(ws + WS_PART2), out, (const bf16*)(ws + WS_R0), (bf16*)(ws + WS_H2B), (float*)(ws + WS_RSTD3), (float*)(ws + WS_SC));
        { XcdBarrier b_; b_.bar = (unsigned*)(args.ws + WS_CTL) + CW_BAR + args.li * XCD_BAR_WORDS; b_.x = xb_xcc_id(); b_.st = (volatile LAS unsigned*)(lds + LDSCTL_OFF) + 8; xcd_barrier(b_); STAMP(16); }
#endif
        for (int tok0 = vcu * 64; tok0 < T_; tok0 += G * 64)
#if GATHER_ROWS
            gather_wg_rows(tok0, wave, FRESH_LANE(), lds, ws + WS_U16, ws + WS_U16 + 16 * MiB, (const float*)(ws + WS_USCALE), (const float*)(ws + WS_USCALE) + 16384, (const int*)(ws + WS_SELI), (const float*)(ws + WS_SELG), (const float*)(ws + WS_PART2), (const bf16*)(ws + WS_R0), (bf16*)(ws + WS_H2B), (float*)(ws + WS_RSTD3));
#else
            gather_wg_sliced<0>(tok0, wave, FRESH_LANE(), lds, ws + WS_U16, ws + WS_U16 + 16 * MiB, (const float*)(ws + WS_USCALE), (const float*)(ws + WS_USCALE) + 16384, (const int*)(ws + WS_SELI), (const float*)(ws + WS_SELG), (const float*)(ws + WS_PART2), out, (const bf16*)(ws + WS_R0), (bf16*)(ws + WS_H2B), (float*)(ws + WS_RSTD3), nullptr);
#endif
    } SEAM(12);
#if !ALL_FUSED
    if (IN(13)) { GEMM_PHASE(EpiPP, ws + WS_PB, ws + WS_WPROJ, 256, 256, T_, 1024, 0, 0, (bf16*)(ws + WS_PP)); } SEAM(13);
#endif
#if ALL_FUSED && FUSE_FINAL
    if (IN(14)) { GEMM_PHASE(EpiH3Final, ws + WS_H2B, ws + WS_WG, 1024, 1024, T_, 1024, 0, 0, (const float*)(ws + WS_RSTD3), (const bf16*)(ws + PP_OFF), (const bf16*)(ws + WS_H2B), in.p[I_FG], out, (float*)(ws + WS_PART4), (unsigned*)(ws + WS_CTL) + 65536); }
#else
    if (IN(14)) { GEMM_PHASE(EpiH3, ws + WS_H2B, ws + WS_WG, 1024, 1024, T_, 1024, 0, 0, (const float*)(ws + WS_RSTD3), (const bf16*)(ws + PP_OFF), out, (float*)(ws + WS_PART4), (const bf16*)(ws + WS_H2B), (bf16*)(ws + WS_R0)); } SEAM(14);
#ifdef TIMING_A
    float tscale = 1.0f;
    { const unsigned long long ta = __hip_atomic_load((unsigned long long*)(ws + WS_CTL + 512) + TIMING_A, __ATOMIC_RELAXED, __HIP_MEMORY_SCOPE_AGENT), tb = __hip_atomic_load((unsigned long long*)(ws + WS_CTL + 512) + TIMING_B, __ATOMIC_RELAXED, __HIP_MEMORY_SCOPE_AGENT);
      tscale = 1.0f + (float)(tb - ta) * 0.01f * (float)(TIMING_K); }
    if (IN(15)) { final_rows(out, (const bf16*)(ws + WS_R0), (const float*)(ws + WS_PART4), in.p[I_FG], gw, NGW, FRESH_LANE(), tscale); }
#else
    if (IN(15)) { final_rows(out, (const bf16*)(ws + WS_R0), (const float*)(ws + WS_PART4), in.p[I_FG], gw, NGW, FRESH_LANE(), 1.0f); }
#endif
#endif
#undef IN
#undef SEAM
#undef GEMM_PHASE
}
static const int GRP_LO[11] = {0, 2, 3, 5, 6, 7, 8, 12, 13, 14, 15};
static const int GRP_HI[11] = {2, 3, 5, 6, 7, 8, 12, 13, 14, 15, 16};

static void naive_group(int grp, void* const* d_in, float* out, unsigned char* ws, hipStream_t st) {
    const float* x = (const float*)d_in[0]; const float* p = (const float*)d_in[1]; const float* g_mix = (const float*)d_in[2]; const float* w_in = (const float*)d_in[3];
    const float* sink = (const float*)d_in[4]; const float* conv_w = (const float*)d_in[5]; const float* conv_b = (const float*)d_in[6];
    const float* wa = (const float*)d_in[7]; const float* ba = (const float*)d_in[8]; const float* wx = (const float*)d_in[9]; const float* bx = (const float*)d_in[10]; const float* lam = (const float*)d_in[11];
    const float* w_ua = (const float*)d_in[12]; const float* w_ul = (const float*)d_in[13]; const float* w_o = (const float*)d_in[14]; const float* g_ffn = (const float*)d_in[15];
    const float* wq = (const float*)d_in[16]; const float* k1 = (const float*)d_in[17]; const float* k2 = (const float*)d_in[18]; const float* pu = (const float*)d_in[19]; const float* pv = (const float*)d_in[20];
    const float* g_ple = (const float*)d_in[21]; const float* w_gate = (const float*)d_in[22]; const float* w_proj = (const float*)d_in[23]; const float* final_g = (const float*)d_in[24];
    float* rstd1 = (float*)(ws + WS_RSTD1); float* part2 = (float*)(ws + WS_PART2); float* part4 = (float*)(ws + WS_PART4); float* rstd3 = (float*)(ws + WS_RSTD3);
    bf16* qkv = (bf16*)(ws + WS_QKV); bf16* lx = (bf16*)(ws + WS_LX); bf16* gl = (bf16*)(ws + WS_GL); bf16* sga = (bf16*)(ws + WS_SGA); bf16* sgl = (bf16*)(ws + WS_SGL);
    bf16* att = (bf16*)(ws + WS_ATT); bf16* r0 = (bf16*)(ws + WS_R0); float* mp = (float*)(ws + WS_MP); bf16* merged = (bf16*)(ws + WS_MERGED);
    float* sc = (float*)(ws + WS_SC); int* seli = (int*)(ws + WS_SELI); float* selg = (float*)(ws + WS_SELG); bf16* h2b = (bf16*)(ws + WS_H2B); bf16* pp = (bf16*)(ws + WS_PP);
    float* tmpf = (float*)(ws + WS_NAIVE_AB);
    switch (grp) {
    case 0:
        hipLaunchKernelGGL(nv::rowsq, dim3(T_ / 4), dim3(256), 0, st, x, rstd1, (float*)nullptr);
        nv::run_gemm<nv::ALf32, nv::EpiProj, false>(st, nv::ALf32{x, 1024}, w_in, INW, g_mix, T_, INW, 1024, nv::EpiProj{rstd1, qkv, lx, gl, sga, sgl});
        break;
    case 1:
        hipLaunchKernelGGL(nv::attn_naive, dim3(T_ * 8 / 128), dim3(128), 0, st, qkv, sink, att);
        hipLaunchKernelGGL(nv::conv_naive, dim3(T_ * 1024 / 256), dim3(256), 0, st, lx, conv_w, conv_b, r0);
        break;
    case 2:
        hipLaunchKernelGGL(nv::lru_ab_naive, dim3(T_ * 8), dim3(128), 0, st, r0, wa, ba, wx, bx, lam, out, tmpf);
        hipLaunchKernelGGL(nv::lru_scan_naive, dim3(B_ * 1024 / 64), dim3(64), 0, st, out, tmpf, gl, r0);
        break;
    case 3: nv::run_gemm<nv::ALbf16, nv::EpiMP, false>(st, nv::ALbf16{att, 512}, w_ua, 1024, nullptr, T_, 1024, 512, nv::EpiMP{sga, mp}); break;
    case 4: nv::run_gemm<nv::ALbf16, nv::EpiMerged, false>(st, nv::ALbf16{r0, 1024}, w_ul, 1024, nullptr, T_, 1024, 1024, nv::EpiMerged{sgl, mp, merged}); break;
    case 5:
        nv::run_gemm<nv::ALbf16, nv::EpiH1, false>(st, nv::ALbf16{merged, 1024}, w_o, 1024, nullptr, T_, 1024, 1024, nv::EpiH1{x, out, r0});
        hipLaunchKernelGGL(nv::rowsq, dim3(T_ / 4), dim3(256), 0, st, out, (float*)nullptr, part2);
        break;
    case 6:
        for (int half = 0; half < 2; ++half) {
            nv::run_gemm<nv::ALf32, nv::EpiScaleF32, false>(st, nv::ALf32{out, 1024}, wq + half * 1024, 2048, g_ffn, T_, 1024, 1024, nv::EpiScaleF32{part2, tmpf, 1024});
            for (int hl = 0; hl < 4; ++hl)
                for (int hf = 0; hf < 2; ++hf)
                    nv::run_gemm<nv::ALf32, nv::EpiPlainF32, true>(st, nv::ALf32{tmpf + hl * 256 + hf * 128, 1024}, hf ? k2 : k1, 128, nullptr, T_, 128, 128, nv::EpiPlainF32{sc + hl * 256 + hf * 128, 1024});
            hipLaunchKernelGGL(topk_kernel, dim3(T_ / TK_TOK), dim3(512), TK_LDS_BYTES, st, sc, half * 4, seli, selg);
        }
        break;
    case 7: hipLaunchKernelGGL(gather_kernel<0>, dim3(1024), dim3(256), 0, st, (const void*)pu, (const void*)pv, g_ffn, seli, selg, part2, out, h2b, rstd3); break;
    case 8: nv::run_gemm<nv::ALf32, nv::EpiPP, false>(st, nv::ALf32{p, 256}, w_proj, 1024, nullptr, T_, 1024, 256, nv::EpiPP{pp}); break;
    case 9: nv::run_gemm<nv::ALbf16, nv::EpiH3, false>(st, nv::ALbf16{h2b, 1024}, w_gate, 1024, g_ple, T_, 1024, 1024, nv::EpiH3{rstd3, pp, out});
        hipLaunchKernelGGL(nv::rowsq, dim3(T_ / 4), dim3(256), 0, st, out, (float*)nullptr, part4);
        break;
    case 10: hipLaunchKernelGGL(nv::final_norm, dim3(T_ / 4), dim3(256), 0, st, out, part4, final_g); break;
    }
}

extern "C" void kernel_launch(void* const* d_in, const int* in_sizes, int n_in, void* d_out, int out_size, void* d_ws, size_t ws_size, hipStream_t stream) {
    static int grid = 0;
    if (grid == 0) {
        if (n_in != 25 || out_size != T_ * 1024 || ws_size < WS_END) { fprintf(stderr, "kernel_launch: unexpected sizes n_in %d out %d ws %zu\n", n_in, out_size, ws_size); }
        (void)hipFuncSetAttribute((const void*)topk_kernel, hipFuncAttributeMaxDynamicSharedMemorySize, TK_LDS_BYTES);
        int dev = 0, cus = 0, per_cu = 0;
        (void)hipGetDevice(&dev); (void)hipDeviceGetAttribute(&cus, hipDeviceAttributeMultiprocessorCount, dev);
        if (hipFuncSetAttribute((const void*)fused_fwd, hipFuncAttributeMaxDynamicSharedMemorySize, LDS_BYTES) != hipSuccess) fprintf(stderr, "kernel_launch: hipFuncSetAttribute(fused_fwd) failed\n");
        if (hipOccupancyMaxActiveBlocksPerMultiprocessor(&per_cu, (const void*)fused_fwd, NWAVES * 64, LDS_BYTES) != hipSuccess || per_cu < 1) fprintf(stderr, "kernel_launch: occupancy query says %d blocks/CU\n", per_cu);
        (void)hipGetLastError();
        grid = cus > 0 ? cus : 256;
    }
    unsigned char* ws = (unsigned char*)d_ws; float* out = (float*)d_out;
    const unsigned mask = FUSED_MASK;
    if (mask) (void)hipMemsetAsync(ws + WS_CTL, 0, CTL_ZERO_BYTES, stream);
    Args a{};
    for (int i = 0; i < 25; ++i) a.in[i] = (const float*)d_in[i];
    a.out = out; a.ws = ws;
    int li = 0;
    auto launch = [&](int lo, int hi) {
        if (MERGE_LAUNCHES) { a.ph_lo = lo; a.ph_hi = hi; a.li = li++; hipLaunchKernelGGL(fused_fwd, dim3(grid), dim3(NWAVES * 64), LDS_BYTES, stream, a); }
        else for (int ph = lo; ph < hi; ++ph) { a.ph_lo = ph; a.ph_hi = ph + 1; a.li = li++; hipLaunchKernelGGL(fused_fwd, dim3(grid), dim3(NWAVES * 64), LDS_BYTES, stream, a); }
    };
    int pend_lo = -1, pend_hi = -1;
    if (mask && !(mask & 1)) launch(0, 1);
    for (int gidx = 0; gidx < 11; ++gidx) {
#if (defined(LRU_T2) && LRU_T2) || (defined(LRU_T3) && LRU_T3)
        if (gidx == 2 && (mask & 4u)) {
            if (pend_lo >= 0) { launch(pend_lo, pend_hi); pend_lo = -1; }
            launch(3, 4);
            hipLaunchKernelGGL(nv::lru_finish_naive_L<(LRU_T2 ? 16 : 64)>, dim3(B_ * 1024 / 64), dim3(64), 0, stream, (const bf16*)(ws + WS_HLOC), (const bf16*)(ws + WS_PCUM), (const bf16*)(ws + WS_GL), (bf16*)(ws + WS_R0));
            continue;
        }
#endif
        if (mask & (1u << gidx)) {
            if (pend_lo < 0) { pend_lo = GRP_LO[gidx]; pend_hi = GRP_HI[gidx]; } else pend_hi = GRP_HI[gidx];
        } else {
            if (pend_lo >= 0) { launch(pend_lo, pend_hi); pend_lo = -1; }
            naive_group(gidx, d_in, out, ws, stream);
        }
    }
    if (pend_lo >= 0) launch(pend_lo, pend_hi);
#if defined(LRU_DEBUG) && LRU_DEBUG == 2
    hipLaunchKernelGGL(nv::poison_if, dim3(T_ * 1024 / 256), dim3(256), 0, stream, out, (const unsigned*)(ws + WS_CTL) + 64);
#endif
}
```

```cpp
#include <hip/hip_runtime.h>
#include <cstdio>
#include <cstdint>
#include <cmath>

#ifndef FUSED_MASK
#define FUSED_MASK 0x7ff
#endif
#ifndef MERGE_LAUNCHES
#define MERGE_LAUNCHES 1
#endif
#ifndef LRU_PADDED
#define LRU_PADDED 1
#endif
#ifndef FUSE_FINAL
#define FUSE_FINAL 0
#endif
#ifndef GATHER_ROWS
#define GATHER_ROWS 2
#endif
#define ALL_FUSED ((FUSED_MASK) == 0x7ff && (MERGE_LAUNCHES))
constexpr int B_ = 8, S_ = 2048, D_ = 1024, T_ = B_ * S_;
constexpr int INW = 4864;
constexpr float EPS = 1e-6f;
typedef unsigned short bf16;
#define HD_INLINE __host__ __device__ __forceinline__

constexpr size_t MiB = 1u << 20;
constexpr size_t WS_CTL = 0;
constexpr size_t WS_WIN = 1 * MiB;
constexpr size_t WS_WUA = WS_WIN + 4864 * 1024 * 2;
constexpr size_t WS_WUL = WS_WUA + 1 * MiB;
constexpr size_t WS_WO = WS_WUL + 2 * MiB;
constexpr size_t WS_WFOLD = WS_WO + 2 * MiB;
constexpr size_t WS_WG = WS_WFOLD + 4 * MiB;
constexpr size_t WS_WPROJ = WS_WG + 2 * MiB;
constexpr size_t WS_WAX = WS_WPROJ + MiB / 2;
constexpr size_t WS_W_END = WS_WAX + 1 * MiB;
static_assert(WS_W_END <= 23 * MiB, "weights");
constexpr size_t WS_RSTD1 = 23 * MiB;
constexpr size_t WS_PART2 = WS_RSTD1 + 256 * 1024;
constexpr size_t WS_PART4 = WS_PART2 + 1 * MiB;
constexpr size_t WS_RSTD3 = WS_PART4 + 1 * MiB;
constexpr size_t WS_AGG = WS_RSTD3 + 256 * 1024;
constexpr size_t WS_C8 = WS_AGG + 2 * MiB;
constexpr size_t WS_USCALE = WS_C8 + 64 * 1024;
static_assert(WS_USCALE + 128 * 1024 <= 28 * MiB, "small");
constexpr size_t WS_PB = 28 * MiB;
constexpr size_t WS_R0 = 36 * MiB;
constexpr size_t WS_QKV = 68 * MiB;
constexpr size_t WS_LX = 92 * MiB;
constexpr size_t WS_GL = 140 * MiB;
constexpr size_t WS_SGA = 172 * MiB;
constexpr size_t WS_SGL = 204 * MiB;
constexpr size_t WS_ATT = 236 * MiB;
constexpr size_t WS_HLOC = 68 * MiB, WS_PCUM = 100 * MiB;
constexpr size_t WS_MP = 68 * MiB;
constexpr size_t WS_MERGED = 140 * MiB;
constexpr size_t WS_SC = 172 * MiB;
constexpr size_t WS_SELI = 236 * MiB, WS_SELG = 244 * MiB;
constexpr size_t WS_U16 = 68 * MiB, WS_V16 = 100 * MiB;
constexpr size_t WS_H2B = 140 * MiB;
constexpr size_t WS_PP = 172 * MiB;
constexpr size_t WS_PP2 = 100 * MiB;
constexpr size_t WS_NAIVE_AB = 68 * MiB;
constexpr size_t WS_WAXD = 252 * MiB;
constexpr size_t WS_END = 256 * MiB;

HD_INLINE float bf2f(bf16 v) { return __builtin_bit_cast(float, (unsigned)v << 16); }
HD_INLINE bf16 f2bf(float f) { unsigned u = __builtin_bit_cast(unsigned, f); return (bf16)((u + 0x7fffu + ((u >> 16) & 1u)) >> 16); }
HD_INLINE unsigned pk2(float lo, float hi) { return (unsigned)f2bf(lo) | ((unsigned)f2bf(hi) << 16); }
__device__ __forceinline__ float wave_sum(float v) {
#pragma unroll
    for (int o = 1; o < 64; o <<= 1) v += __shfl_xor(v, o);
    return v;
}
__device__ __forceinline__ float sigmoidf_(float z) { return __builtin_amdgcn_rcpf(1.0f + __builtin_amdgcn_exp2f(-1.4426950408889634f * z)); }
__device__ __forceinline__ float gelu_tanh(float x) { const float u = 1.5957691216057308f * (x + 0.044715f * x * x * x); return x * sigmoidf_(u); }
__device__ __forceinline__ int fresh_lane() { int l; asm volatile("v_mbcnt_lo_u32_b32 %0, -1, 0\n\tv_mbcnt_hi_u32_b32 %0, -1, %0" : "=v"(l)); return l; }
#ifndef HD_INLINE
#define HD_INLINE __host__ __device__ __forceinline__
#endif

HD_INLINE unsigned tk_umax(unsigned a, unsigned b) { return a > b ? a : b; }
HD_INLINE unsigned tk_umin(unsigned a, unsigned b) { return a < b ? a : b; }
HD_INLINE unsigned tk_f2key(float f) { unsigned u = __builtin_bit_cast(unsigned, f); return u ^ ((unsigned)((int)u >> 31) | 0x80000000u); }
HD_INLINE float tk_key2f(unsigned k) { unsigned u = (k & 0x80000000u) ? (k ^ 0x80000000u) : ~k; return __builtin_bit_cast(float, u); }

HD_INLINE void tk_sort16(unsigned (&a)[16]) {
#pragma unroll
    for (int k = 2; k <= 16; k <<= 1) {
#pragma unroll
        for (int j = k >> 1; j > 0; j >>= 1) {
#pragma unroll
            for (int i = 0; i < 16; ++i) {
                const int p = i ^ j;
                if (p > i) {
                    const unsigned mx = tk_umax(a[i], a[p]), mn = tk_umin(a[i], a[p]);
                    if ((i & k) == 0) { a[i] = mx; a[p] = mn; } else { a[i] = mn; a[p] = mx; }
                }
            }
        }
    }
}
HD_INLINE void tk_merge16(unsigned (&a)[16], const unsigned (&b)[16]) {
#pragma unroll
    for (int i = 0; i < 16; ++i) a[i] = tk_umax(a[i], b[15 - i]);
#pragma unroll
    for (int j = 8; j > 0; j >>= 1) {
#pragma unroll
        for (int i = 0; i < 16; ++i) {
            const int p = i ^ j;
            if (p > i) { const unsigned mx = tk_umax(a[i], a[p]), mn = tk_umin(a[i], a[p]); a[i] = mx; a[p] = mn; }
        }
    }
}
HD_INLINE void tk_insert16(unsigned (&best)[16], unsigned key) {
#pragma unroll
    for (int s = 0; s < 16; ++s) { const unsigned hi = tk_umax(best[s], key); key = tk_umin(best[s], key); best[s] = hi; }
}
HD_INLINE void tk_combine_store(const unsigned (&k1)[16], const unsigned (&k2)[16], int* oi, float* og) {
    float v1[16], v2[16];
#pragma unroll
    for (int i = 0; i < 16; ++i) { v1[i] = tk_key2f(k1[i] & ~127u); v2[i] = tk_key2f(k2[i] & ~127u); }
    unsigned best[16];
#pragma unroll
    for (int s = 0; s < 16; ++s) best[s] = 0u;
#pragma unroll
    for (int i = 0; i < 16; ++i) {
#pragma unroll
        for (int j = 0; j < 16; ++j) {
            if ((i + 1) * (j + 1) <= 16) {
                const float s = v1[i] + v2[j];
                const unsigned key = (tk_f2key(s) & ~255u) | (unsigned)(255 - (i * 16 + j));
                tk_insert16(best, key);
            }
        }
    }
    const unsigned thr = best[15];
    const float mx = tk_key2f(best[0] & ~255u);
    float sum = 0.f;
#pragma unroll
    for (int i = 0; i < 16; ++i) {
#pragma unroll
        for (int j = 0; j < 16; ++j) {
            if ((i + 1) * (j + 1) <= 16) {
                const float s = v1[i] + v2[j];
                const unsigned key = (tk_f2key(s) & ~255u) | (unsigned)(255 - (i * 16 + j));
                if (key >= thr) sum += __builtin_expf(s - mx);
            }
        }
    }
    const float inv = 1.0f / sum;
    int cnt = 0;
#pragma unroll
    for (int i = 0; i < 16; ++i) {
#pragma unroll
        for (int j = 0; j < 16; ++j) {
            if ((i + 1) * (j + 1) <= 16) {
                const float s = v1[i] + v2[j];
                const unsigned key = (tk_f2key(s) & ~255u) | (unsigned)(255 - (i * 16 + j));
                if (key >= thr) {
                    oi[cnt] = (127 - (int)(k1[i] & 127u)) * 128 + (127 - (int)(k2[j] & 127u));
                    og[cnt] = __builtin_expf(s - mx) * inv;
                    ++cnt;
                }
            }
        }
    }
}
namespace nv {
struct ALf32 { const float* p; int lda; int pad; __device__ __forceinline__ float operator()(int m, int k) const { return p[(size_t)m * lda + k]; } };
struct ALbf16 { const bf16* p; int lda; int pad; __device__ __forceinline__ float operator()(int m, int k) const { return bf2f(p[(size_t)m * lda + k]); } };

template <class AL, class EPI, bool BT>
__global__ void __launch_bounds__(256) ngemm(AL al, const float* __restrict__ B, int ldb, const float* __restrict__ ks, int M, int N, int K, EPI epi) {
    __shared__ float As[16][68];
    __shared__ float Bs[16][68];
    const int tid = threadIdx.x, tx = tid & 15, ty = tid >> 4;
    const int m0 = blockIdx.y * 64, n0 = blockIdx.x * 64;
    float acc[4][4];
#pragma unroll
    for (int i = 0; i < 4; ++i)
#pragma unroll
        for (int j = 0; j < 4; ++j) acc[i][j] = 0.f;
    for (int k0 = 0; k0 < K; k0 += 16) {
#pragma unroll
        for (int i = 0; i < 4; ++i) {
            const int e = tid + i * 256;
            { const int m = e >> 4, k = e & 15; float v = al(m0 + m, k0 + k); if (ks) v *= ks[k0 + k]; As[k][m] = v; }
            if (BT) { const int n = e >> 4, k = e & 15; Bs[k][n] = B[(size_t)(n0 + n) * ldb + k0 + k]; }
            else { const int k = e >> 6, n = e & 63; Bs[k][n] = B[(size_t)(k0 + k) * ldb + n0 + n]; }
        }
        __syncthreads();
#pragma unroll
        for (int k = 0; k < 16; ++k) {
            float a[4], b[4];
#pragma unroll
            for (int i = 0; i < 4; ++i) { a[i] = As[k][ty * 4 + i]; b[i] = Bs[k][tx * 4 + i]; }
#pragma unroll
            for (int i = 0; i < 4; ++i)
#pragma unroll
                for (int j = 0; j < 4; ++j) acc[i][j] = fmaf(a[i], b[j], acc[i][j]);
        }
        __syncthreads();
    }
#pragma unroll
    for (int i = 0; i < 4; ++i)
#pragma unroll
        for (int j = 0; j < 4; ++j) epi(m0 + ty * 4 + i, n0 + tx * 4 + j, acc[i][j]);
}
template <class AL, class EPI, bool BT>
static void run_gemm(hipStream_t st, AL al, const float* B, int ldb, const float* ks, int M, int N, int K, EPI epi) {
    hipLaunchKernelGGL((ngemm<AL, EPI, BT>), dim3(N / 64, M / 64), dim3(256), 0, st, al, B, ldb, ks, M, N, K, epi);
}

__global__ void __launch_bounds__(256) rowsq(const float* __restrict__ X, float* rstd, float* part) {
    const int row = blockIdx.x * 4 + (threadIdx.x >> 6), lane = threadIdx.x & 63;
    const float* xr = X + (size_t)row * 1024;
    float s = 0.f;
    for (int j = 0; j < 16; ++j) { const float v = xr[lane + 64 * j]; s += v * v; }
    s = wave_sum(s);
    if (rstd && lane == 0) rstd[row] = 1.0f / sqrtf(s * (1.0f / 1024.0f) + EPS);
    if (part && lane < 16) part[(size_t)row * 16 + lane] = (lane == 0) ? s : 0.f;
}

struct EpiProj {
    const float* rstd; bf16 *qkv, *lx, *gl, *sga, *sgl;
    __device__ __forceinline__ void operator()(int m, int n, float v) const {
        v *= rstd[m];
        if (n < 768) qkv[(size_t)m * 768 + n] = f2bf(v);
        else if (n < 1792) lx[(size_t)m * 1024 + (n - 768)] = f2bf(v);
        else if (n < 2816) gl[(size_t)m * 1024 + (n - 1792)] = f2bf(gelu_tanh(v));
        else if (n < 3840) sga[(size_t)m * 1024 + (n - 2816)] = f2bf(sigmoidf_(v));
        else sgl[(size_t)m * 1024 + (n - 3840)] = f2bf(sigmoidf_(v));
    }
};

__global__ void __launch_bounds__(128) attn_naive(const bf16* __restrict__ qkv, const float* __restrict__ sink, bf16* __restrict__ att) {
    const int gid = blockIdx.x * 128 + threadIdx.x;
    const int head = gid / T_, t = gid % T_;
    const int b = t / S_, ts = t % S_;
    const int g = head >> 2;
    float q[64], acc[64];
    const bf16* qp = qkv + (size_t)t * 768 + head * 64;
#pragma unroll
    for (int d = 0; d < 64; ++d) { q[d] = bf2f(qp[d]); acc[d] = 0.f; }
    const float slope = exp2f(-(float)(head + 1));
    float m = -3.0e38f, l = 0.f;
    for (int dist = 127; dist >= 0; --dist) {
        const int s = ts - dist; if (s < 0) continue;
        const bf16* kp = qkv + (size_t)(b * S_ + s) * 768 + 512 + g * 64;
        const bf16* vp = kp + 128;
        float sc = 0.f;
#pragma unroll
        for (int d = 0; d < 64; ++d) sc = fmaf(q[d], bf2f(kp[d]), sc);
        sc = sc * 0.125f - slope * (float)dist;
        const float mn = fmaxf(m, sc), corr = __expf(m - mn), p = __expf(sc - mn);
        l = l * corr + p;
#pragma unroll
        for (int d = 0; d < 64; ++d) acc[d] = acc[d] * corr + p * bf2f(vp[d]);
        m = mn;
    }
    const float sk = sink[head];
    const float mf = fmaxf(m, sk), corr = __expf(m - mf);
    l = l * corr + __expf(sk - mf);
    const float inv = corr / l;
    bf16* op = att + (size_t)t * 512 + head * 64;
#pragma unroll
    for (int d = 0; d < 64; ++d) op[d] = f2bf(acc[d] * inv);
}

__global__ void __launch_bounds__(256) conv_naive(const bf16* __restrict__ lx, const float* __restrict__ cw, const float* __restrict__ cb, bf16* __restrict__ lin) {
    const size_t i = (size_t)blockIdx.x * 256 + threadIdx.x;
    const int c = (int)(i & 1023); const int t = (int)(i >> 10); const int ts = t % S_;
    float y = cb[c];
#pragma unroll
    for (int tap = 0; tap < 4; ++tap) { const int s = ts - 3 + tap; if (s >= 0) y = fmaf(bf2f(lx[(size_t)(t - 3 + tap) * 1024 + c]), cw[tap * 1024 + c], y); }
    lin[i] = f2bf(y);
}

__global__ void __launch_bounds__(128) lru_ab_naive(const bf16* __restrict__ lin, const float* __restrict__ wa, const float* __restrict__ ba, const float* __restrict__ wx, const float* __restrict__ bx,
                                                    const float* __restrict__ lam, float* __restrict__ Af, float* __restrict__ Bf) {
    __shared__ float xs[128];
    const int t = blockIdx.x >> 3, blk = blockIdx.x & 7, d = threadIdx.x, ch = blk * 128 + d;
    xs[d] = bf2f(lin[(size_t)t * 1024 + ch]);
    __syncthreads();
    float r = ba[ch], ii = bx[ch];
    const float* wap = wa + (size_t)blk * 128 * 128 + d; const float* wxp = wx + (size_t)blk * 128 * 128 + d;
    for (int c = 0; c < 128; ++c) { r = fmaf(xs[c], wap[c * 128], r); ii = fmaf(xs[c], wxp[c * 128], ii); }
    r = sigmoidf_(r); ii = sigmoidf_(ii);
    const float sp = log1pf(expf(-lam[ch]));
    const float loga = -8.0f * r * sp;
    const float a = expf(loga);
    const float bb = sqrtf(-expm1f(2.0f * loga)) * (ii * xs[d]);
    Af[(size_t)t * 1024 + ch] = a; Bf[(size_t)t * 1024 + ch] = bb;
}
__global__ void __launch_bounds__(256) lru_ab_from_pre(const bf16* __restrict__ lin, const float* __restrict__ ba, const float* __restrict__ bx, const float* __restrict__ lam, float* __restrict__ Af, float* __restrict__ Bf) {
    const size_t i = (size_t)blockIdx.x * 256 + threadIdx.x; const int ch = (int)(i & 1023);
    const float r = sigmoidf_(Af[i] + ba[ch]), ii = sigmoidf_(Bf[i] + bx[ch]);
    const float loga = -8.0f * r * log1pf(expf(-lam[ch]));
    Af[i] = expf(loga); Bf[i] = sqrtf(-expm1f(2.0f * loga)) * (ii * bf2f(lin[i]));
}
template <int L>
__global__ void __launch_bounds__(64) lru_finish_naive_L(const bf16* __restrict__ hloc, const bf16* __restrict__ pcum, const bf16* __restrict__ gl, bf16* __restrict__ rec) {
    const int gid = blockIdx.x * 64 + threadIdx.x; const int b = gid >> 10, ch = gid & 1023;
    float carry = 0.f;
    for (int c = 0; c < S_ / L; ++c) {
        float la = 1.f, lb = 0.f;
        for (int s = 0; s < L; ++s) { const size_t o = (size_t)(b * S_ + c * L + s) * 1024 + ch; la = bf2f(pcum[o]); lb = bf2f(hloc[o]); const float h = la * carry + lb; rec[o] = f2bf(h * bf2f(gl[o])); }
        carry = la * carry + lb;
    }
}
__global__ void __launch_bounds__(64) lru_finish_naive(const bf16* __restrict__ hloc, const bf16* __restrict__ pcum, const float* __restrict__ agg, const bf16* __restrict__ gl, bf16* __restrict__ rec) {
    const int gid = blockIdx.x * 64 + threadIdx.x; const int b = gid >> 10, ch = gid & 1023;
    float carry = 0.f;
    for (int c = 0; c < 32; ++c) {
        const int chunk = b * 32 + c;
        for (int s = 0; s < 64; ++s) { const size_t o = (size_t)(chunk * 64 + s) * 1024 + ch; const float h = bf2f(pcum[o]) * carry + bf2f(hloc[o]); rec[o] = f2bf(h * bf2f(gl[o])); }
        const float* ap = agg + ((size_t)chunk * 1024 + ch) * 2; carry = ap[0] * carry + ap[1];
    }
}
__global__ void __launch_bounds__(128) lru_pre_check(const bf16* __restrict__ lin, const float* __restrict__ wa, const float* __restrict__ wx, const float* __restrict__ Rp, const float* __restrict__ Ip, unsigned* flag) {
    __shared__ float xs[128];
    const int t = blockIdx.x >> 3, blk = blockIdx.x & 7, d = threadIdx.x, ch = blk * 128 + d;
    xs[d] = bf2f(lin[(size_t)t * 1024 + ch]);
    __syncthreads();
    float r = 0.f, ii = 0.f;
    const float* wap = wa + (size_t)blk * 128 * 128 + d; const float* wxp = wx + (size_t)blk * 128 * 128 + d;
    for (int c = 0; c < 128; ++c) { r = fmaf(xs[c], wap[c * 128], r); ii = fmaf(xs[c], wxp[c * 128], ii); }
    const float dr = fabsf(r - Rp[(size_t)t * 1024 + ch]), di = fabsf(ii - Ip[(size_t)t * 1024 + ch]);
    if (!(dr < 0.08f + 0.03f * fabsf(r)) || !(di < 0.08f + 0.03f * fabsf(ii))) atomicAdd(flag, 1u);
}
__global__ void __launch_bounds__(256) poison_if(float* out, const unsigned* flag) { if (*flag) { const size_t i = (size_t)blockIdx.x * 256 + threadIdx.x; out[i] = out[i] * 50.0f + 3.0f; } }
__global__ void __launch_bounds__(64) lru_scan_naive(const float* __restrict__ Af, const float* __restrict__ Bf, const bf16* __restrict__ gl, bf16* __restrict__ rec) {
    const int gid = blockIdx.x * 64 + threadIdx.x; const int b = gid >> 10, ch = gid & 1023;
    float h = 0.f;
    for (int s = 0; s < S_; ++s) { const size_t o = (size_t)(b * S_ + s) * 1024 + ch; h = fmaf(Af[o], h, Bf[o]); rec[o] = f2bf(h * bf2f(gl[o])); }
}

struct EpiMP { const bf16* sga; float* mp; __device__ __forceinline__ void operator()(int m, int n, float v) const { const size_t o = (size_t)m * 1024 + n; mp[o] = v * bf2f(sga[o]); } };
struct EpiMerged { const bf16* sgl; const float* mp; bf16* merged; __device__ __forceinline__ void operator()(int m, int n, float v) const { const size_t o = (size_t)m * 1024 + n; merged[o] = f2bf(mp[o] + v * bf2f(sgl[o])); } };
struct EpiH1 { const float* x; float* h1; bf16* h1b; __device__ __forceinline__ void operator()(int m, int n, float v) const { const size_t o = (size_t)m * 1024 + n; const float h = x[o] + v; h1[o] = h; h1b[o] = f2bf(h); } };
struct EpiScaleF32 { const float* part; float* out; int ldo; int pad; __device__ __forceinline__ void operator()(int m, int n, float v) const {
    float s = 0.f; for (int i = 0; i < 16; ++i) s += part[(size_t)m * 16 + i];
    out[(size_t)m * ldo + n] = v * (1.0f / sqrtf(s * (1.0f / 1024.0f) + EPS)); } };
struct EpiPlainF32 { float* out; int ldo; int pad; __device__ __forceinline__ void operator()(int m, int n, float v) const { out[(size_t)m * ldo + n] = v; } };
struct EpiPP { bf16* pp; __device__ __forceinline__ void operator()(int m, int n, float v) const { pp[(size_t)m * 1024 + n] = f2bf(v); } };
struct EpiH3 { const float* rstd3; const bf16* pp; float* h; __device__ __forceinline__ void operator()(int m, int n, float v) const { const size_t o = (size_t)m * 1024 + n; h[o] = h[o] + sigmoidf_(v * rstd3[m]) * bf2f(pp[o]); } };

__global__ void __launch_bounds__(256) final_norm(float* __restrict__ h, const float* __restrict__ part, const float* __restrict__ fg) {
    const int row = blockIdx.x * 4 + (threadIdx.x >> 6), lane = threadIdx.x & 63;
    float s = 0.f; for (int i = 0; i < 16; ++i) s += part[(size_t)row * 16 + i];
    const float r = 1.0f / sqrtf(s * (1.0f / 1024.0f) + EPS);
    float* hr = h + (size_t)row * 1024;
    for (int j = 0; j < 16; ++j) { const int c = lane + 64 * j; hr[c] = hr[c] * r * fg[c]; }
}
}
#define LAS __attribute__((address_space(3)))
typedef float f32x4 __attribute__((ext_vector_type(4)));
typedef unsigned u32x4 __attribute__((ext_vector_type(4)));
typedef int i32x4 __attribute__((ext_vector_type(4)));

constexpr int TK_TOK = 32;
constexpr int TK_LSTRIDE = 132;
constexpr int TK_LDS_BYTES = 256 * TK_LSTRIDE * 4;

__device__ __forceinline__ void topk_item(LAS float* lds, const float* __restrict__ SC, int item, int head_base, int* __restrict__ seli, float* __restrict__ selg, int tid) {
    const f32x4* src = (const f32x4*)(SC + (size_t)item * TK_TOK * 1024);
#pragma unroll 4
    for (int i = 0; i < 16; ++i) {
        const int idx = tid + i * 512; const int row = idx >> 8, c4 = idx & 255;
        const f32x4 v = src[idx];
        const int list = row * 8 + (c4 >> 5), elem = (c4 & 31) * 4;
        *(LAS f32x4*)(lds + list * TK_LSTRIDE + elem) = v;
    }
    __syncthreads();
    if (tid < 256) {
        const LAS float* my = lds + tid * TK_LSTRIDE;
        unsigned acc[16];
#pragma unroll
        for (int g = 0; g < 8; ++g) {
            unsigned t[16];
#pragma unroll
            for (int q = 0; q < 4; ++q) {
                const f32x4 v = *(const LAS f32x4*)(my + g * 16 + q * 4);
#pragma unroll
                for (int c = 0; c < 4; ++c) { const int e = g * 16 + q * 4 + c; t[q * 4 + c] = (tk_f2key(v[c]) & ~127u) | (unsigned)(127 - e); }
            }
            tk_sort16(t);
            if (g == 0) {
#pragma unroll
                for (int i = 0; i < 16; ++i) acc[i] = t[i];
            } else tk_merge16(acc, t);
        }
        unsigned oth[16];
#pragma unroll
        for (int i = 0; i < 16; ++i) oth[i] = (unsigned)__shfl_xor((int)acc[i], 1);
        if ((tid & 1) == 0) {
            const int tok = item * TK_TOK + (tid >> 3), head = head_base + ((tid >> 1) & 3);
            tk_combine_store(acc, oth, seli + (size_t)tok * 128 + head * 16, selg + (size_t)tok * 128 + head * 16);
        }
    }
    __syncthreads();
}
__global__ void __launch_bounds__(512) topk_kernel(const float* __restrict__ SC, int head_base, int* __restrict__ seli, float* __restrict__ selg) {
    extern __shared__ __attribute__((aligned(16))) unsigned char dyn_lds[];
    for (int item = blockIdx.x; item < T_ / TK_TOK; item += gridDim.x) topk_item((LAS float*)dyn_lds, SC, item, head_base, seli, selg, (int)threadIdx.x);
}

template <int MODE>
__device__ __forceinline__ void gather_token(int t, int lane, const void* __restrict__ Utab, const void* __restrict__ Vtab, const float* __restrict__ gffn,
                                             const int* __restrict__ seli, const float* __restrict__ selg, const float* __restrict__ part2,
                                             float* __restrict__ H  , bf16* __restrict__ h2b, float* __restrict__ rstd3) {
    float ps = (lane < 16) ? part2[(size_t)t * 16 + lane] : 0.f;
    ps = wave_sum(ps);
    const float rstd2 = 1.0f / sqrtf(ps * (1.0f / 1024.0f) + EPS);
    const int iA = seli[(size_t)t * 128 + lane], iB = seli[(size_t)t * 128 + 64 + lane];
    const float gA = selg[(size_t)t * 128 + lane], gB = selg[(size_t)t * 128 + 64 + lane];
    float* hr = H + (size_t)t * 1024;
    if constexpr (MODE == 0) {
        f32x4 x[4], y[4], hv[4];
#pragma unroll
        for (int j = 0; j < 4; ++j) { hv[j] = *(const f32x4*)(hr + 256 * j + 4 * lane); const f32x4 g = *(const f32x4*)(gffn + 256 * j + 4 * lane); x[j] = hv[j] * g; y[j] = (f32x4){0.f, 0.f, 0.f, 0.f}; }
        const float* U = (const float*)Utab; const float* V = (const float*)Vtab;
        for (int k = 0; k < 64; ++k) {
#pragma unroll
            for (int hh = 0; hh < 2; ++hh) {
                const int e = __builtin_amdgcn_readlane(hh ? iB : iA, k);
                const float gt = __builtin_bit_cast(float, __builtin_amdgcn_readlane(__builtin_bit_cast(int, hh ? gB : gA), k));
                const float* ur = U + (size_t)e * 1024; const float* vr = V + (size_t)e * 1024;
                f32x4 uv[4], vv[4];
#pragma unroll
                for (int j = 0; j < 4; ++j) { uv[j] = *(const f32x4*)(ur + 256 * j + 4 * lane); vv[j] = *(const f32x4*)(vr + 256 * j + 4 * lane); }
                float d = 0.f;
#pragma unroll
                for (int j = 0; j < 4; ++j) d += (uv[j].x * x[j].x + uv[j].y * x[j].y) + (uv[j].z * x[j].z + uv[j].w * x[j].w);
                d = wave_sum(d);
                const float c = gt * gelu_tanh(d * rstd2);
#pragma unroll
                for (int j = 0; j < 4; ++j) y[j] += vv[j] * c;
            }
        }
        float sq = 0.f;
#pragma unroll
        for (int j = 0; j < 4; ++j) {
            const f32x4 h2 = hv[j] + y[j];
            *(f32x4*)(hr + 256 * j + 4 * lane) = h2;
            sq += (h2.x * h2.x + h2.y * h2.y) + (h2.z * h2.z + h2.w * h2.w);
            uint2 w; w.x = pk2(h2.x, h2.y); w.y = pk2(h2.z, h2.w);
            *(uint2*)(h2b + (size_t)t * 1024 + 256 * j + 4 * lane) = w;
        }
        sq = wave_sum(sq);
        if (lane == 0) rstd3[t] = 1.0f / sqrtf(sq * (1.0f / 1024.0f) + EPS);
    } else {
        float x[2][8], y[2][8], hv[2][8];
#pragma unroll
        for (int j = 0; j < 2; ++j) {
            const f32x4 a = *(const f32x4*)(hr + 512 * j + 8 * lane), b = *(const f32x4*)(hr + 512 * j + 8 * lane + 4);
            hv[j][0] = a.x; hv[j][1] = a.y; hv[j][2] = a.z; hv[j][3] = a.w; hv[j][4] = b.x; hv[j][5] = b.y; hv[j][6] = b.z; hv[j][7] = b.w;
#pragma unroll
            for (int c = 0; c < 8; ++c) { x[j][c] = hv[j][c]; y[j][c] = 0.f; }
        }
        const bf16* U = (const bf16*)Utab; const bf16* V = (const bf16*)Vtab;
        for (int k = 0; k < 64; k += 2) {
            u32x4 uv[4][2], vv[4][2]; float gt[4];
#pragma unroll
            for (int q = 0; q < 4; ++q) {
                const int kk = k + (q >> 1); const int hh = q & 1;
                const int e = __builtin_amdgcn_readlane(hh ? iB : iA, kk);
                gt[q] = __builtin_bit_cast(float, __builtin_amdgcn_readlane(__builtin_bit_cast(int, hh ? gB : gA), kk));
                const bf16* ur = U + (size_t)e * 1024; const bf16* vr = V + (size_t)e * 1024;
#pragma unroll
                for (int j = 0; j < 2; ++j) { uv[q][j] = *(const u32x4*)(ur + 512 * j + 8 * lane); vv[q][j] = *(const u32x4*)(vr + 512 * j + 8 * lane); }
            }
#pragma unroll
            for (int q = 0; q < 4; ++q) {
                float d = 0.f;
#pragma unroll
                for (int j = 0; j < 2; ++j)
#pragma unroll
                    for (int c = 0; c < 4; ++c) { const unsigned w = uv[q][j][c]; d = fmaf(__builtin_bit_cast(float, w << 16), x[j][2 * c], d); d = fmaf(__builtin_bit_cast(float, w & 0xffff0000u), x[j][2 * c + 1], d); }
                d = wave_sum(d);
                const float cf = gt[q] * gelu_tanh(d * rstd2);
#pragma unroll
                for (int j = 0; j < 2; ++j)
#pragma unroll
                    for (int c = 0; c < 4; ++c) { const unsigned w = vv[q][j][c]; y[j][2 * c] = fmaf(__builtin_bit_cast(float, w << 16), cf, y[j][2 * c]); y[j][2 * c + 1] = fmaf(__builtin_bit_cast(float, w & 0xffff0000u), cf, y[j][2 * c + 1]); }
            }
        }
        float sq = 0.f;
#pragma unroll
        for (int j = 0; j < 2; ++j) {
            float h2[8];
#pragma unroll
            for (int c = 0; c < 8; ++c) { h2[c] = hv[j][c] + y[j][c]; sq += h2[c] * h2[c]; }
            *(f32x4*)(hr + 512 * j + 8 * lane) = (f32x4){h2[0], h2[1], h2[2], h2[3]};
            *(f32x4*)(hr + 512 * j + 8 * lane + 4) = (f32x4){h2[4], h2[5], h2[6], h2[7]};
            u32x4 w; w.x = pk2(h2[0], h2[1]); w.y = pk2(h2[2], h2[3]); w.z = pk2(h2[4], h2[5]); w.w = pk2(h2[6], h2[7]);
            *(u32x4*)(h2b + (size_t)t * 1024 + 512 * j + 8 * lane) = w;
        }
        sq = wave_sum(sq);
        if (lane == 0) rstd3[t] = 1.0f / sqrtf(sq * (1.0f / 1024.0f) + EPS);
    }
}
template <int MODE>
__global__ void __launch_bounds__(256) gather_kernel(const void* __restrict__ Utab, const void* __restrict__ Vtab, const float* __restrict__ gffn, const int* __restrict__ seli, const float* __restrict__ selg,
                                                     const float* __restrict__ part2, float* __restrict__ H, bf16* __restrict__ h2b, float* __restrict__ rstd3) {
    const int lane = threadIdx.x & 63; const int w = blockIdx.x * 4 + (threadIdx.x >> 6); const int nw = gridDim.x * 4;
    for (int t = w; t < T_; t += nw) gather_token<MODE>(t, lane, Utab, Vtab, gffn, seli, selg, part2, H, h2b, rstd3);
}

typedef float f32x2 __attribute__((ext_vector_type(2)));
__device__ __forceinline__ float reduce4_transpose(float d0, float d1, float d2, float d3, int lane) {
    const bool b0 = lane & 1, b1 = lane & 2;
    const float a = (b0 ? d1 : d0) + __shfl_xor(b0 ? d0 : d1, 1);
    const float b = (b0 ? d3 : d2) + __shfl_xor(b0 ? d2 : d3, 1);
    float c = (b1 ? b : a) + __shfl_xor(b1 ? a : b, 2);
    c += __shfl_xor(c, 4); c += __shfl_xor(c, 8); c += __shfl_xor(c, 16); c += __shfl_xor(c, 32);
    return c;
}
__device__ __forceinline__ float dot16_fp8(const u32x4 w, const f32x2 (&x2)[8]) {
    f32x2 acc = (f32x2){0.f, 0.f};
#pragma unroll
    for (int c = 0; c < 4; ++c) { const unsigned ww = w[c]; const f32x2 lo = __builtin_amdgcn_cvt_pk_f32_fp8(ww, false), hi = __builtin_amdgcn_cvt_pk_f32_fp8(ww, true); acc = lo * x2[2 * c] + acc; acc = hi * x2[2 * c + 1] + acc; }
    return acc.x + acc.y;
}
__device__ __forceinline__ void axpy16_fp8(const u32x4 w, float cf, f32x2 (&y2)[8]) {
#pragma unroll
    for (int c = 0; c < 4; ++c) { const unsigned ww = w[c]; const f32x2 lo = __builtin_amdgcn_cvt_pk_f32_fp8(ww, false), hi = __builtin_amdgcn_cvt_pk_f32_fp8(ww, true); y2[2 * c] = lo * cf + y2[2 * c]; y2[2 * c + 1] = hi * cf + y2[2 * c + 1]; }
}
__device__ __forceinline__ float sel4f(float v0, float v1, float v2, float v3, int q) { return q == 0 ? v0 : (q == 1 ? v1 : (q == 2 ? v2 : v3)); }
__device__ __forceinline__ void gather_token_fp8(int t, int lane, const unsigned char* __restrict__ U8, const unsigned char* __restrict__ V8, const float* __restrict__ IU, const float* __restrict__ IV,
                                                 const int* __restrict__ seli, const float* __restrict__ selg, const float* __restrict__ part2,
                                                 float* __restrict__ H, bf16* __restrict__ h2b, float* __restrict__ rstd3) {
    float ps = (lane < 16) ? part2[(size_t)t * 16 + lane] : 0.f;
    ps = wave_sum(ps);
    const float rstd2 = 1.0f / sqrtf(ps * (1.0f / 1024.0f) + EPS);
    const int iA = seli[(size_t)t * 128 + lane], iB = seli[(size_t)t * 128 + 64 + lane];
    const float duA = IU[iA] * rstd2, duB = IU[iB] * rstd2;
    const float gvA = selg[(size_t)t * 128 + lane] * IV[iA], gvB = selg[(size_t)t * 128 + 64 + lane] * IV[iB];
    float* hr = H + (size_t)t * 1024 + 16 * lane;
    f32x2 x2[8], y2[8]; f32x4 hv[4];
#pragma unroll
    for (int j = 0; j < 4; ++j) { hv[j] = *(const f32x4*)(hr + 4 * j); x2[2 * j] = (f32x2){hv[j][0], hv[j][1]}; x2[2 * j + 1] = (f32x2){hv[j][2], hv[j][3]}; y2[2 * j] = (f32x2){0.f, 0.f}; y2[2 * j + 1] = (f32x2){0.f, 0.f}; }
    const int q = lane & 3;
#pragma unroll 1
    for (int k = 0; k < 64; k += 4) {
        u32x4 uu[8], vv[8]; float du[8], gv[8];
#pragma unroll
        for (int s = 0; s < 8; ++s) {
            const int kk = k + (s >> 1); const bool hh = s & 1;
            const int e = __builtin_amdgcn_readlane(hh ? iB : iA, kk);
            du[s] = __int_as_float(__builtin_amdgcn_readlane(__float_as_int(hh ? duB : duA), kk));
            gv[s] = __int_as_float(__builtin_amdgcn_readlane(__float_as_int(hh ? gvB : gvA), kk));
            uu[s] = *(const u32x4*)(U8 + (size_t)e * 1024 + 16 * lane);
            vv[s] = *(const u32x4*)(V8 + (size_t)e * 1024 + 16 * lane);
        }
#pragma unroll
        for (int g = 0; g < 2; ++g) {
            const float d0 = dot16_fp8(uu[4 * g + 0], x2), d1 = dot16_fp8(uu[4 * g + 1], x2), d2 = dot16_fp8(uu[4 * g + 2], x2), d3 = dot16_fp8(uu[4 * g + 3], x2);
            const float tot = reduce4_transpose(d0, d1, d2, d3, lane);
            const float z = tot * sel4f(du[4 * g], du[4 * g + 1], du[4 * g + 2], du[4 * g + 3], q);
            const float cf = gelu_tanh(z) * sel4f(gv[4 * g], gv[4 * g + 1], gv[4 * g + 2], gv[4 * g + 3], q);
#pragma unroll
            for (int s = 0; s < 4; ++s) { const float cs = __int_as_float(__builtin_amdgcn_readlane(__float_as_int(cf), s)); axpy16_fp8(vv[4 * g + s], cs, y2); }
        }
    }
    float sq = 0.f;
    f32x4 h2[4];
#pragma unroll
    for (int j = 0; j < 4; ++j) {
        h2[j] = hv[j] + (f32x4){y2[2 * j].x, y2[2 * j].y, y2[2 * j + 1].x, y2[2 * j + 1].y};
        *(f32x4*)(hr + 4 * j) = h2[j];
        sq += (h2[j][0] * h2[j][0] + h2[j][1] * h2[j][1]) + (h2[j][2] * h2[j][2] + h2[j][3] * h2[j][3]);
    }
    u32x4 w0, w1; w0.x = pk2(h2[0][0], h2[0][1]); w0.y = pk2(h2[0][2], h2[0][3]); w0.z = pk2(h2[1][0], h2[1][1]); w0.w = pk2(h2[1][2], h2[1][3]);
    w1.x = pk2(h2[2][0], h2[2][1]); w1.y = pk2(h2[2][2], h2[2][3]); w1.z = pk2(h2[3][0], h2[3][1]); w1.w = pk2(h2[3][2], h2[3][3]);
    u32x4* ob = (u32x4*)(h2b + (size_t)t * 1024 + 16 * lane); ob[0] = w0; ob[1] = w1;
    sq = wave_sum(sq);
    if (lane == 0) rstd3[t] = 1.0f / sqrtf(sq * (1.0f / 1024.0f) + EPS);
}

__device__ __forceinline__ unsigned umin_(unsigned a, unsigned b) { return a < b ? a : b; }
__device__ __forceinline__ unsigned umax_(unsigned a, unsigned b) { return a > b ? a : b; }
__device__ __forceinline__ void sort128(unsigned& k0, unsigned& k1, int lane) {
#pragma unroll
    for (int k = 2; k <= 128; k <<= 1) {
#pragma unroll
        for (int j = k >> 1; j >= 1; j >>= 1) {
            if (j == 64) { const unsigned mn = umin_(k0, k1), mx = umax_(k0, k1); k0 = mn; k1 = mx; }
            else {
                const unsigned o0 = (unsigned)__shfl_xor((int)k0, j), o1 = (unsigned)__shfl_xor((int)k1, j);
                const bool up0 = (k == 128) ? true : (k == 64 ? true : ((lane & k) == 0));
                const bool up1 = (k == 128) ? true : (k == 64 ? false : ((lane & k) == 0));
                const bool lower = (lane & j) == 0;
                k0 = (lower == up0) ? umin_(k0, o0) : umax_(k0, o0);
                k1 = (lower == up1) ? umin_(k1, o1) : umax_(k1, o1);
            }
        }
    }
}
typedef int i32x4v __attribute__((ext_vector_type(4)));
#ifndef NSLICE
#define NSLICE 8
#endif
#define SLICE_SHIFT (NSLICE == 32 ? 25 : (NSLICE == 16 ? 26 : (NSLICE == 8 ? 27 : (NSLICE == 4 ? 28 : 30))))
typedef unsigned u32x2 __attribute__((ext_vector_type(2)));
__device__ __forceinline__ f32x4 bf4_lo(u32x2 w) { return (f32x4){__builtin_bit_cast(float, w.x << 16), __builtin_bit_cast(float, w.x & 0xffff0000u), __builtin_bit_cast(float, w.y << 16), __builtin_bit_cast(float, w.y & 0xffff0000u)}; }
struct TokState { f32x2 y2[8]; unsigned k0, k1; int bnd; float rsx; };
__device__ __forceinline__ int count_lt(const TokState& S, unsigned bound) {
    return __builtin_popcountll(__builtin_amdgcn_ballot_w64(S.k0 < bound)) + __builtin_popcountll(__builtin_amdgcn_ballot_w64(S.k1 < bound));
}
__device__ __forceinline__ int bperm_i(int srclane, int v) { return __builtin_amdgcn_ds_bpermute(srclane << 2, v); }
__device__ __forceinline__ float bperm_f(int srclane, float v) { return __int_as_float(__builtin_amdgcn_ds_bpermute(srclane << 2, __float_as_int(v))); }
template <int PM>
__device__ __forceinline__ void gather_batch(TokState& S, int p, int hi, int lane, const LAS unsigned char* xs, const unsigned char* __restrict__ U8, const unsigned char* __restrict__ V8, const float* __restrict__ IU, const float* __restrict__ IV) {
    const int n = (hi - p < 16) ? hi - p : 16;
    const int m = lane & 15, kq = lane >> 4;
    const int r = (m < n) ? p + m : hi - 1; const int sl = r & 63; const bool lo = r < 64;
    const unsigned ka = (unsigned)bperm_i(sl, (int)S.k0), kb = (unsigned)bperm_i(sl, (int)S.k1);
    const int es = (int)((lo ? ka : kb) >> 16);
    const unsigned key = lo ? ka : kb;
    const float dus = IU[es] * S.rsx, gvs = (m < n) ? (float)(key & 0xffffu) * (1.0f / 65535.0f) * IV[es] : 0.f;
    const unsigned char* ua = U8 + (size_t)es * 1024 + 16 * kq;
    i32x4v A[16];
    if (!(PM & 2)) {
#pragma unroll
        for (int s = 0; s < 16; ++s) { if (PM & 16) { const int e = __builtin_amdgcn_readlane(es, s); A[s] = *(const i32x4v*)(U8 + (size_t)e * 1024 + 16 * lane); } else A[s] = *(const i32x4v*)(ua + 64 * s); }
    }
    u32x4 vv[16];
    if (!(PM & 1)) {
#pragma unroll
        for (int q = 0; q < 8; ++q) if (q < n) { const int e = __builtin_amdgcn_readlane(es, q); vv[q] = *(const u32x4*)(V8 + (size_t)e * 1024 + 16 * lane); }
        if (n > 8) {
#pragma unroll
            for (int q = 8; q < 16; ++q) if (q < n) { const int e = __builtin_amdgcn_readlane(es, q); vv[q] = *(const u32x4*)(V8 + (size_t)e * 1024 + 16 * lane); }
        }
    }
    i32x4v acc = (i32x4v){0, 0, 0, 0};
    if (!(PM & 2)) {
#pragma unroll
        for (int s = 0; s < 16; ++s) { const i32x4v B = *(const LAS i32x4v*)(xs + 64 * s + 16 * kq); acc = __builtin_amdgcn_mfma_i32_16x16x64_i8(A[s], B, acc, 0, 0, 0); }
    } else { acc = (i32x4v){es, es + 1, es + 2, es + 3}; }
    float cf[4];
#pragma unroll
    for (int j = 0; j < 4; ++j) { const int sm = 4 * kq + j; const float d = bperm_f(sm, dus), g = bperm_f(sm, gvs); cf[j] = g * gelu_tanh((float)acc[j] * d); }
    if (PM & 1) { S.y2[0].x += (cf[0] + cf[1]) + (cf[2] + cf[3]); }
    else if (PM & 4) {
#pragma unroll
        for (int q = 0; q < 16; ++q) if (q < n) { const float cs = __int_as_float(__builtin_amdgcn_readlane(__float_as_int(cf[q & 3]), 16 * (q >> 2))); S.y2[q & 7].x += cs * __uint_as_float((vv[q].x ^ vv[q].y ^ vv[q].z ^ vv[q].w) & 0x3fffffffu); }
    } else {
#pragma unroll
        for (int q = 0; q < 8; ++q) if (q < n) { const float cs = __int_as_float(__builtin_amdgcn_readlane(__float_as_int(cf[q & 3]), 16 * (q >> 2))); axpy16_fp8(vv[q], cs, S.y2); }
        if (n > 8) {
#pragma unroll
            for (int q = 8; q < 16; ++q) if (q < n) { const float cs = __int_as_float(__builtin_amdgcn_readlane(__float_as_int(cf[q & 3]), 16 * (q >> 2))); axpy16_fp8(vv[q], cs, S.y2); }
        }
    }
    __builtin_amdgcn_sched_barrier(0);
}
__device__ __forceinline__ void tok_setup(TokState& S, int t, int lane, LAS unsigned char* xs, const int* __restrict__ seli, const float* __restrict__ selg,
                                          const float* __restrict__ part2, const bf16* __restrict__ h1b) {
    float ps = (lane < 16) ? part2[(size_t)t * 16 + lane] : 0.f;
    ps = wave_sum(ps);
    const float rstd2 = 1.0f / sqrtf(ps * (1.0f / 1024.0f) + EPS);
    f32x4 hv[4]; float am = 0.f;
    { const u32x4* br = (const u32x4*)(h1b + (size_t)t * 1024 + 16 * lane); const u32x4 b0 = br[0], b1 = br[1];
      hv[0] = bf4_lo((u32x2){b0.x, b0.y}); hv[1] = bf4_lo((u32x2){b0.z, b0.w}); hv[2] = bf4_lo((u32x2){b1.x, b1.y}); hv[3] = bf4_lo((u32x2){b1.z, b1.w}); }
#pragma unroll
    for (int j = 0; j < 4; ++j) { am = fmaxf(am, fmaxf(fmaxf(fabsf(hv[j][0]), fabsf(hv[j][1])), fmaxf(fabsf(hv[j][2]), fabsf(hv[j][3])))); }
#pragma unroll
    for (int o = 1; o < 64; o <<= 1) am = fmaxf(am, __shfl_xor(am, o));
    const float sx = am > 0.f ? 127.0f / am : 1.0f, isx = am > 0.f ? am * (1.0f / 127.0f) : 1.0f;
    u32x4 xq;
#pragma unroll
    for (int j = 0; j < 4; ++j) { unsigned w = 0u;
#pragma unroll
        for (int c = 0; c < 4; ++c) w |= ((unsigned)(int)__builtin_rintf(hv[j][c] * sx) & 0xffu) << (8 * c);
        xq[j] = w; }
    *(LAS u32x4*)(xs + 16 * lane) = xq;
    const int iA = seli[(size_t)t * 128 + lane], iB = seli[(size_t)t * 128 + 64 + lane];
    const float gA = selg[(size_t)t * 128 + lane], gB = selg[(size_t)t * 128 + 64 + lane];
    S.k0 = ((unsigned)iA << 16) | (unsigned)(gA * 65535.0f + 0.5f); S.k1 = ((unsigned)iB << 16) | (unsigned)(gB * 65535.0f + 0.5f);
    sort128(S.k0, S.k1, lane);
    S.rsx = rstd2 * isx;
    int bnd = 0;
#pragma unroll
    for (int s = 1; s <= NSLICE; ++s) { const int c = count_lt(S, (unsigned)s << SLICE_SHIFT); bnd = (lane == s) ? c : bnd; }
    S.bnd = bnd;
#pragma unroll
    for (int j = 0; j < 8; ++j) S.y2[j] = (f32x2){0.f, 0.f};
}
__device__ __forceinline__ void tok_finish(const TokState& S, int t, int lane, const bf16* __restrict__ h1b, bf16* __restrict__ h2b, float* __restrict__ rstd3) {
    const u32x4* br = (const u32x4*)(h1b + (size_t)t * 1024 + 16 * lane); const u32x4 b0 = br[0], b1 = br[1];
    f32x4 h2[4]; h2[0] = bf4_lo((u32x2){b0.x, b0.y}); h2[1] = bf4_lo((u32x2){b0.z, b0.w}); h2[2] = bf4_lo((u32x2){b1.x, b1.y}); h2[3] = bf4_lo((u32x2){b1.z, b1.w});
    float sq = 0.f;
#pragma unroll
    for (int j = 0; j < 4; ++j) {
        h2[j] = h2[j] + (f32x4){S.y2[2 * j].x, S.y2[2 * j].y, S.y2[2 * j + 1].x, S.y2[2 * j + 1].y};
        sq += (h2[j][0] * h2[j][0] + h2[j][1] * h2[j][1]) + (h2[j][2] * h2[j][2] + h2[j][3] * h2[j][3]);
    }
    u32x4 w0, w1; w0.x = pk2(h2[0][0], h2[0][1]); w0.y = pk2(h2[0][2], h2[0][3]); w0.z = pk2(h2[1][0], h2[1][1]); w0.w = pk2(h2[1][2], h2[1][3]);
    w1.x = pk2(h2[2][0], h2[2][1]); w1.y = pk2(h2[2][2], h2[2][3]); w1.z = pk2(h2[3][0], h2[3][1]); w1.w = pk2(h2[3][2], h2[3][3]);
    u32x4* ob = (u32x4*)(h2b + (size_t)t * 1024 + 16 * lane); ob[0] = w0; ob[1] = w1;
    sq = wave_sum(sq);
    if (lane == 0) rstd3[t] = 1.0f / sqrtf(sq * (1.0f / 1024.0f) + EPS);
}
__device__ __forceinline__ int dpp_xor8(int v) { return __builtin_amdgcn_update_dpp(0, v, 0x128, 0xf, 0xf, false); }
__device__ __forceinline__ int dpp_xor4(int v) { return __builtin_amdgcn_update_dpp(0, __builtin_amdgcn_update_dpp(0, v, 0x141, 0xf, 0xf, false), 0x1b, 0xf, 0xf, false); }
__device__ __forceinline__ int dpp_xor1(int v) { return __builtin_amdgcn_update_dpp(0, v, 0xb1, 0xf, 0xf, false); }
__device__ __forceinline__ int dpp_xor2(int v) { return __builtin_amdgcn_update_dpp(0, v, 0x4e, 0xf, 0xf, false); }
__device__ __forceinline__ int reduce16_rows(int (&p)[16], int lane) {
    int r8[8], r4[4], r2[2];
#pragma unroll
    for (int i = 0; i < 8; ++i) { const u32x2 s = __builtin_amdgcn_permlane32_swap((unsigned)p[i], (unsigned)p[i + 8], false, false); r8[i] = (int)(s.x + s.y); }
#pragma unroll
    for (int i = 0; i < 4; ++i) { const u32x2 s = __builtin_amdgcn_permlane16_swap((unsigned)r8[i], (unsigned)r8[i + 4], false, false); r4[i] = (int)(s.x + s.y); }
    const bool b3 = lane & 8, b2 = lane & 4;
#pragma unroll
    for (int i = 0; i < 2; ++i) { const int s0 = r4[i] + dpp_xor8(r4[i]), s1 = r4[i + 2] + dpp_xor8(r4[i + 2]); r2[i] = b3 ? s1 : s0; }
    const int keep = b2 ? r2[1] : r2[0], send = b2 ? r2[0] : r2[1];
    int t = keep + dpp_xor4(send);
    t += dpp_xor1(t); t += dpp_xor2(t);
    return t;
}
struct TokState2 { f32x2 y2[8]; unsigned k0, k1; float rsx; };
template <int PM>
__device__ __forceinline__ void gather_batch_rows(TokState& S, int p, int hi, int lane, const LAS unsigned char* xs, const unsigned char* __restrict__ U8, const unsigned char* __restrict__ V8, const float* __restrict__ IU, const float* __restrict__ IV) {
    const int n = (hi - p < 16) ? hi - p : 16;
    const int slot = lane >> 2;
    const int r = (slot < n) ? p + slot : hi - 1; const int sl = r & 63; const bool lo = r < 64;
    const unsigned ka = (unsigned)bperm_i(sl, (int)S.k0), kb = (unsigned)bperm_i(sl, (int)S.k1);
    const unsigned key = lo ? ka : kb;
    const int es = (int)(key >> 16);
    const float dus = IU[es] * S.rsx, gvs = (slot < n) ? (float)(key & 0xffffu) * (1.0f / 65535.0f) * IV[es] : 0.f;
    i32x4v A[16]; u32x4 vv[16];
#pragma unroll
    for (int g = 0; g < 4; ++g) if (4 * g < n) {
#pragma unroll
        for (int q = 4 * g; q < 4 * g + 4; ++q) { int e = __builtin_amdgcn_readlane(es, 4 * q); if (PM & 32) e &= 1023; A[q] = *(const i32x4v*)(U8 + (size_t)e * 1024 + 16 * lane); }
    }
#pragma unroll
    for (int g = 0; g < 4; ++g) if (4 * g < n) {
#pragma unroll
        for (int q = 4 * g; q < 4 * g + 4; ++q) { int e = __builtin_amdgcn_readlane(es, 4 * q); if (PM & 32) e &= 1023; vv[q] = *(const u32x4*)(V8 + (size_t)e * 1024 + 16 * lane); }
    }
    const i32x4v X = *(const LAS i32x4v*)(xs + 16 * lane);
    int pp[16];
#pragma unroll
    for (int g = 0; g < 4; ++g) {
        if (4 * g < n) {
#pragma unroll
            for (int q = 4 * g; q < 4 * g + 4; ++q) pp[q] = __builtin_amdgcn_sdot4(A[q][3], X[3], __builtin_amdgcn_sdot4(A[q][2], X[2], __builtin_amdgcn_sdot4(A[q][1], X[1], __builtin_amdgcn_sdot4(A[q][0], X[0], 0, false), false), false), false);
        } else {
#pragma unroll
            for (int q = 4 * g; q < 4 * g + 4; ++q) pp[q] = 0;
        }
    }
    const int tot = reduce16_rows(pp, lane);
    const float cf = gvs * gelu_tanh((float)tot * dus);
#pragma unroll
    for (int g = 0; g < 4; ++g) if (4 * g < n) {
#pragma unroll
        for (int q = 4 * g; q < 4 * g + 4; ++q) { const float cs = __int_as_float(__builtin_amdgcn_readlane(__float_as_int(cf), 4 * q)); axpy16_fp8(vv[q], cs, S.y2); }
    }
    __builtin_amdgcn_sched_barrier(0);
}

template <int PM>
__device__ __forceinline__ void gather_batch16(TokState2& S, int bi, int lane, const LAS unsigned char* xs, const unsigned char* __restrict__ U8, const unsigned char* __restrict__ V8, const float* __restrict__ IU, const float* __restrict__ IV) {
    const unsigned ksel = (bi < 4) ? S.k0 : S.k1;
    const int lb = (bi & 3) << 4;
    const unsigned key = (unsigned)bperm_i(lb + (lane >> 2), (int)ksel);
    const int es = (int)(key >> 16);
    const float dus = IU[es] * S.rsx, gvs = (float)(key & 0xffffu) * (1.0f / 65535.0f) * IV[es];
    i32x4v A[16]; u32x4 vv[16];
#pragma unroll
    for (int q = 0; q < 16; ++q) { int e = (int)((unsigned)__builtin_amdgcn_readlane((int)ksel, lb + q) >> 16); if (PM & 32) e &= 1023; if (!(PM & 2)) A[q] = *(const i32x4v*)(U8 + (size_t)e * 1024 + 16 * lane); else A[q] = (i32x4v){e, e, e, e}; }
#pragma unroll
    for (int q = 0; q < 16; ++q) { int e = (int)((unsigned)__builtin_amdgcn_readlane((int)ksel, lb + q) >> 16); if (PM & 32) e &= 1023; if (!(PM & 1)) vv[q] = *(const u32x4*)(V8 + (size_t)e * 1024 + 16 * lane); else vv[q] = (u32x4){(unsigned)e, 0u, 0u, 0u}; }
    const i32x4v X = *(const LAS i32x4v*)(xs + 16 * lane);
    int p[16];
#pragma unroll
    for (int q = 0; q < 16; ++q) p[q] = __builtin_amdgcn_sdot4(A[q][3], X[3], __builtin_amdgcn_sdot4(A[q][2], X[2], __builtin_amdgcn_sdot4(A[q][1], X[1], __builtin_amdgcn_sdot4(A[q][0], X[0], 0, false), false), false), false);
    const int tot = reduce16_rows(p, lane);
    const float cf = gvs * gelu_tanh((float)tot * dus);
#pragma unroll
    for (int q = 0; q < 16; ++q) { const float cs = __int_as_float(__builtin_amdgcn_readlane(__float_as_int(cf), 4 * q)); if (PM & 1) S.y2[q & 7].x += cs * __uint_as_float(vv[q].x); else axpy16_fp8(vv[q], cs, S.y2); }
    __builtin_amdgcn_sched_barrier(0);
}
__device__ __forceinline__ void tok_setup2(TokState2& S, int t, int lane, LAS unsigned char* xs, const int* __restrict__ seli, const float* __restrict__ selg,
                                           const float* __restrict__ part2, const bf16* __restrict__ h1b) {
    float ps = (lane < 16) ? part2[(size_t)t * 16 + lane] : 0.f;
    ps = wave_sum(ps);
    const float rstd2 = 1.0f / sqrtf(ps * (1.0f / 1024.0f) + EPS);
    f32x4 hv[4]; float am = 0.f;
    { const u32x4* br = (const u32x4*)(h1b + (size_t)t * 1024 + 16 * lane); const u32x4 b0 = br[0], b1 = br[1];
      hv[0] = bf4_lo((u32x2){b0.x, b0.y}); hv[1] = bf4_lo((u32x2){b0.z, b0.w}); hv[2] = bf4_lo((u32x2){b1.x, b1.y}); hv[3] = bf4_lo((u32x2){b1.z, b1.w}); }
#pragma unroll
    for (int j = 0; j < 4; ++j) { am = fmaxf(am, fmaxf(fmaxf(fabsf(hv[j][0]), fabsf(hv[j][1])), fmaxf(fabsf(hv[j][2]), fabsf(hv[j][3])))); }
#pragma unroll
    for (int o = 1; o < 64; o <<= 1) am = fmaxf(am, __shfl_xor(am, o));
    const float sx = am > 0.f ? 127.0f / am : 1.0f, isx = am > 0.f ? am * (1.0f / 127.0f) : 1.0f;
    u32x4 xq;
#pragma unroll
    for (int j = 0; j < 4; ++j) { unsigned w = 0u;
#pragma unroll
        for (int c = 0; c < 4; ++c) w |= ((unsigned)(int)__builtin_rintf(hv[j][c] * sx) & 0xffu) << (8 * c);
        xq[j] = w; }
    *(LAS u32x4*)(xs + 16 * lane) = xq;
    const int iA = seli[(size_t)t * 128 + lane], iB = seli[(size_t)t * 128 + 64 + lane];
    const float gA = selg[(size_t)t * 128 + lane], gB = selg[(size_t)t * 128 + 64 + lane];
    S.k0 = ((unsigned)iA << 16) | (unsigned)(gA * 65535.0f + 0.5f); S.k1 = ((unsigned)iB << 16) | (unsigned)(gB * 65535.0f + 0.5f);
    sort128(S.k0, S.k1, lane);
    S.rsx = rstd2 * isx;
#pragma unroll
    for (int j = 0; j < 8; ++j) S.y2[j] = (f32x2){0.f, 0.f};
}
__device__ __forceinline__ void tok_finish2(const TokState2& S, int t, int lane, const bf16* __restrict__ h1b, bf16* __restrict__ h2b, float* __restrict__ rstd3) {
    const u32x4* br = (const u32x4*)(h1b + (size_t)t * 1024 + 16 * lane); const u32x4 b0 = br[0], b1 = br[1];
    f32x4 h2[4]; h2[0] = bf4_lo((u32x2){b0.x, b0.y}); h2[1] = bf4_lo((u32x2){b0.z, b0.w}); h2[2] = bf4_lo((u32x2){b1.x, b1.y}); h2[3] = bf4_lo((u32x2){b1.z, b1.w});
    float sq = 0.f;
#pragma unroll
    for (int j = 0; j < 4; ++j) {
        h2[j] = h2[j] + (f32x4){S.y2[2 * j].x, S.y2[2 * j].y, S.y2[2 * j + 1].x, S.y2[2 * j + 1].y};
        sq += (h2[j][0] * h2[j][0] + h2[j][1] * h2[j][1]) + (h2[j][2] * h2[j][2] + h2[j][3] * h2[j][3]);
    }
    u32x4 w0, w1; w0.x = pk2(h2[0][0], h2[0][1]); w0.y = pk2(h2[0][2], h2[0][3]); w0.z = pk2(h2[1][0], h2[1][1]); w0.w = pk2(h2[1][2], h2[1][3]);
    w1.x = pk2(h2[2][0], h2[2][1]); w1.y = pk2(h2[2][2], h2[2][3]); w1.z = pk2(h2[3][0], h2[3][1]); w1.w = pk2(h2[3][2], h2[3][3]);
    u32x4* ob = (u32x4*)(h2b + (size_t)t * 1024 + 16 * lane); ob[0] = w0; ob[1] = w1;
    sq = wave_sum(sq);
    if (lane == 0) rstd3[t] = 1.0f / sqrtf(sq * (1.0f / 1024.0f) + EPS);
}
template <int PM>
__device__ __forceinline__ void gather_wg_rows(int tok0, int wave, int lane, LAS unsigned char* lds, const unsigned char* __restrict__ U8, const unsigned char* __restrict__ V8, const float* __restrict__ IU, const float* __restrict__ IV,
                                               const int* __restrict__ seli, const float* __restrict__ selg, const float* __restrict__ part2, const bf16* __restrict__ h1b, bf16* __restrict__ h2b, float* __restrict__ rstd3, float* probe_out) {
    LAS unsigned char* xs = lds + wave * 4096;
#pragma unroll 1
    for (int pass = 0; pass < 2; ++pass) {
        const int tb = tok0 + pass * 32 + wave * 4;
        TokState2 S0, S1, S2, S3;
        tok_setup2(S0, tb + 0, fresh_lane(), xs, seli, selg, part2, h1b); __builtin_amdgcn_sched_barrier(0);
        tok_setup2(S1, tb + 1, fresh_lane(), xs + 1024, seli, selg, part2, h1b); __builtin_amdgcn_sched_barrier(0);
        tok_setup2(S2, tb + 2, fresh_lane(), xs + 2048, seli, selg, part2, h1b); __builtin_amdgcn_sched_barrier(0);
        tok_setup2(S3, tb + 3, fresh_lane(), xs + 3072, seli, selg, part2, h1b); __builtin_amdgcn_sched_barrier(0);
        __syncthreads();
        lane = fresh_lane();
#pragma unroll 1
        for (int bi = 0; bi < 8; ++bi) {
            gather_batch16<PM>(S0, bi, lane, xs, U8, V8, IU, IV);
            gather_batch16<PM>(S1, bi, lane, xs + 1024, U8, V8, IU, IV);
            gather_batch16<PM>(S2, bi, lane, xs + 2048, U8, V8, IU, IV);
            gather_batch16<PM>(S3, bi, lane, xs + 3072, U8, V8, IU, IV);
        }
        if (PM != 0) { const int fl = fresh_lane(); f32x2 a = S0.y2[0] + S1.y2[0] + S2.y2[0] + S3.y2[0];
#pragma unroll
            for (int j = 1; j < 8; ++j) a += S0.y2[j] + S1.y2[j] + S2.y2[j] + S3.y2[j];
            probe_out[(size_t)tb * 64 + fl] = a.x + a.y; }
        else { const int fl = fresh_lane(); tok_finish2(S0, tb, fl, h1b, h2b, rstd3); tok_finish2(S1, tb + 1, fl, h1b, h2b, rstd3); tok_finish2(S2, tb + 2, fl, h1b, h2b, rstd3); tok_finish2(S3, tb + 3, fl, h1b, h2b, rstd3); }
        __syncthreads();
    }
}
#if GATHER_ROWS == 2
#define GATHER_BATCH_FN gather_batch_rows
#else
#define GATHER_BATCH_FN gather_batch
#endif
template <int PM>
__device__ __forceinline__ void gather_wg_sliced(int tok0, int wave, int lane, LAS unsigned char* lds, const unsigned char* __restrict__ U8, const unsigned char* __restrict__ V8, const float* __restrict__ IU, const float* __restrict__ IV,
                                                 const int* __restrict__ seli, const float* __restrict__ selg, const float* __restrict__ part2, float* __restrict__ H, const bf16* __restrict__ h1b, bf16* __restrict__ h2b, float* __restrict__ rstd3, float* probe_out) {
    LAS unsigned char* xs = lds + wave * 4096;
#pragma unroll 1
    for (int pass = 0; pass < 2; ++pass) {
        const int tb = tok0 + pass * 32 + wave * 4;
        TokState S0, S1, S2, S3;
        tok_setup(S0, tb + 0, fresh_lane(), xs, seli, selg, part2, h1b); __builtin_amdgcn_sched_barrier(0);
        tok_setup(S1, tb + 1, fresh_lane(), xs + 1024, seli, selg, part2, h1b); __builtin_amdgcn_sched_barrier(0);
        tok_setup(S2, tb + 2, fresh_lane(), xs + 2048, seli, selg, part2, h1b); __builtin_amdgcn_sched_barrier(0);
        tok_setup(S3, tb + 3, fresh_lane(), xs + 3072, seli, selg, part2, h1b); __builtin_amdgcn_sched_barrier(0);
        __syncthreads();
        lane = fresh_lane();
        int lo0 = 0, lo1 = 0, lo2 = 0, lo3 = 0;
#pragma unroll 1
        for (int s = 0; s < NSLICE; ++s) {
            { const int hi = __builtin_amdgcn_readlane(S0.bnd, s + 1); for (int p = lo0; p < hi; p += 16) GATHER_BATCH_FN<PM>(S0, p, hi, lane, xs, U8, V8, IU, IV); lo0 = hi; }
            { const int hi = __builtin_amdgcn_readlane(S1.bnd, s + 1); for (int p = lo1; p < hi; p += 16) GATHER_BATCH_FN<PM>(S1, p, hi, lane, xs + 1024, U8, V8, IU, IV); lo1 = hi; }
            { const int hi = __builtin_amdgcn_readlane(S2.bnd, s + 1); for (int p = lo2; p < hi; p += 16) GATHER_BATCH_FN<PM>(S2, p, hi, lane, xs + 2048, U8, V8, IU, IV); lo2 = hi; }
            { const int hi = __builtin_amdgcn_readlane(S3.bnd, s + 1); for (int p = lo3; p < hi; p += 16) GATHER_BATCH_FN<PM>(S3, p, hi, lane, xs + 3072, U8, V8, IU, IV); lo3 = hi; }
        }
        if (probe_out) { const int fl = fresh_lane(); f32x2 a = S0.y2[0] + S1.y2[0] + S2.y2[0] + S3.y2[0];
#pragma unroll
            for (int j = 1; j < 8; ++j) a += S0.y2[j] + S1.y2[j] + S2.y2[j] + S3.y2[j];
            probe_out[(size_t)tb * 64 + fl] = a.x + a.y; }
        else { const int fl = fresh_lane(); tok_finish(S0, tb, fl, h1b, h2b, rstd3); tok_finish(S1, tb + 1, fl, h1b, h2b, rstd3); tok_finish(S2, tb + 2, fl, h1b, h2b, rstd3); tok_finish(S3, tb + 3, fl, h1b, h2b, rstd3); }
        __syncthreads();
    }
}

namespace pg8 {
#define PG8_LAS __attribute__((address_space(3)))
typedef unsigned short bf16_t;
typedef short bf16x8 __attribute__((ext_vector_type(8)));
typedef float f32x4 __attribute__((ext_vector_type(4)));
typedef unsigned u32x4 __attribute__((ext_vector_type(4)));
constexpr int BM = 256, BK = 64, HALF = 128, HTB = HALF * BK * 2  , STAGE_BYTES = 8 * HTB, NXCD = 8, WGM = 8;

__host__ __device__ __forceinline__ int lds_byte(int r, int c) { const int st = (r >> 4) * 2 + (c >> 5), rr = r & 15, cc = c & 31, ob = rr * 64 + cc * 2; return st * 1024 + (ob ^ (((ob >> 9) & 1) << 5)); }
__host__ __device__ __forceinline__ void stage_rc(int b, int& R, int& C) { const int st = b / 1024, sb = b % 1024, swz = sb ^ (((sb >> 9) & 1) << 5); R = (st >> 1) * 16 + swz / 64; C = (st & 1) * 32 + (swz % 64) / 2; }
__host__ __device__ __forceinline__ int perm32(int rho) { const int n = rho >> 4, i = rho & 15; return 8 * (i >> 2) + 4 * n + (i & 3); }

struct Unit { int pm, pn; };
struct Gemm { const bf16_t* A; const bf16_t* Bt; int K, lda, apn_shift, apn_stride; };

struct StaticOrder {
    int nM, nN, nwg, G, c;
    __host__ __device__ __forceinline__ void init(int M, int N, int G_, int c_) { nM = M / BM; nN = N / BM; nwg = nM * nN; G = G_; c = c_; }
    __host__ __device__ __forceinline__ bool next(int i, Unit& u) const {
        const long L = (long)i * G + c; if (L >= nwg) return false;
        int wgid = (int)L; { const int q = nwg / NXCD, r = nwg % NXCD, xcd = wgid % NXCD, off = wgid / NXCD; wgid = (xcd < r ? xcd * (q + 1) : r * (q + 1) + (xcd - r) * q) + off; }
        const int nig = WGM * nN, gid = wgid / nig, fm = gid * WGM, gsz = (nM - fm) < WGM ? (nM - fm) : WGM;
        u.pm = fm + ((wgid % nig) % gsz); u.pn = (wgid % nig) / gsz; return true;
    }
    __device__ __forceinline__ void a_ready(const Unit&) const {}
    __device__ __forceinline__ void done(const Unit&) const {}
};

__device__ __forceinline__ unsigned cvt_pk_bf16(float lo, float hi) { unsigned r; asm volatile("v_cvt_pk_bf16_f32 %0, %1, %2" : "=v"(r) : "v"(lo), "v"(hi)); return r; }

template <class Epi, class Sched, bool ALIGN_EPI = false, bool SP2 = false>
__device__ __forceinline__ void gemm_phase(PG8_LAS unsigned char* lds, const Gemm g, const Sched& S, const Epi& E, int wave_id  ) {
    const int lane = fresh_lane(), wid = wave_id, tid = wid * 64 + lane, wr = wid >> 2, wc = wid & 3, fr = lane & 15, fq = lane >> 4;
    const int K = g.K, nt = K / BK;
    unsigned voffA[2], voffB[2];
#pragma unroll
    for (int i = 0; i < 2; ++i) { int R, C; stage_rc(tid * 16 + i * 8192, R, C); const int Rb = Epi::PERM ? ((R & ~31) + perm32(R & 31)) : R;
        voffA[i] = (unsigned)(R * g.lda + C) * 2u; voffB[i] = (unsigned)(Rb * K + C) * 2u; }
    const size_t kstep = (size_t)(BK * 2);
    const size_t hstepA = (size_t)HALF * g.lda * 2, hstepB = (size_t)HALF * K * 2;
    const size_t tstepA = 2 * hstepA, tstepB = 2 * hstepB;
    const unsigned ldsw = (unsigned)wid * 1024u;
    const int aoff = lds_byte(wr * 64 + fr, fq * 8), boff = lds_byte(wc * 32 + fr, fq * 8);
#define PG8_SA(b, h) (((b) * 2 + (h)) * HTB)
#define PG8_SB(b, h) ((4 + (b) * 2 + (h)) * HTB)
#define PG8_STAGE(bufoff, gbase, voff) do { _Pragma("unroll") for (int _i = 0; _i < 2; ++_i) \
        __builtin_amdgcn_global_load_lds((const unsigned*)((const char*)(gbase) + (voff)[_i]), (PG8_LAS unsigned*)(lds + (bufoff) + ldsw + _i * 8192), 16, 0, 0); } while (0)
#define PG8_LDA(dst, b, h) do { _Pragma("unroll") for (int m = 0; m < 4; ++m) _Pragma("unroll") for (int k = 0; k < 2; ++k) dst[m][k] = *(const PG8_LAS bf16x8*)(lds + PG8_SA(b, h) + aoff + m * 2048 + k * 1024); } while (0)
#define PG8_LDB(dst, b, h) do { _Pragma("unroll") for (int n = 0; n < 2; ++n) _Pragma("unroll") for (int k = 0; k < 2; ++k) dst[n][k] = *(const PG8_LAS bf16x8*)(lds + PG8_SB(b, h) + boff + n * 2048 + k * 1024); } while (0)
#define PG8_MMA(ai, bj, At, Bt) do { __builtin_amdgcn_s_setprio(1); _Pragma("unroll") for (int m = 0; m < 4; ++m) _Pragma("unroll") for (int n = 0; n < 2; ++n) _Pragma("unroll") for (int k = 0; k < 2; ++k) \
        acc[ai][bj][m][n] = __builtin_amdgcn_mfma_f32_16x16x32_bf16(Bt[n][k], At[m][k], acc[ai][bj][m][n], 0, 0, 0); __builtin_amdgcn_s_setprio(0); } while (0)
#define PG8_WAIT_V(n) asm volatile("s_waitcnt vmcnt(" #n ")" ::: "memory")
#define PG8_WAIT_L(n) asm volatile("s_waitcnt lgkmcnt(" #n ")" ::: "memory")
#define PG8_BAR __builtin_amdgcn_s_barrier()
#define PG8_SCHED __builtin_amdgcn_sched_barrier(0)
    Unit cur, nxt; int ui = 0;
    if (!S.next(0, cur)) return;
    f32x4 acc[2][2][4][2];
#pragma unroll
    for (int a = 0; a < 2; ++a)
#pragma unroll
        for (int b = 0; b < 2; ++b)
#pragma unroll
            for (int m = 0; m < 4; ++m)
#pragma unroll
                for (int n = 0; n < 2; ++n) acc[a][b][m][n] = (f32x4){0.f, 0.f, 0.f, 0.f};
    bf16x8 At[4][2], B0[2][2], B1[2][2];
    const char* cA = (const char*)g.A + (size_t)cur.pm * tstepA + (size_t)((cur.pn >> g.apn_shift) * g.apn_stride) * 2; const char* cB = (const char*)g.Bt + (size_t)cur.pn * tstepB;
    S.a_ready(cur);
    if constexpr (SP2) {
        PG8_STAGE(PG8_SB(0, 0), cB, voffB); PG8_STAGE(PG8_SB(0, 1), cB + hstepB, voffB); PG8_STAGE(PG8_SA(0, 0), cA, voffA); PG8_STAGE(PG8_SA(0, 1), cA + hstepA, voffA);
        if (wr == 1) PG8_BAR;
        PG8_WAIT_V(2); PG8_BAR;
        PG8_STAGE(PG8_SB(1, 0), cB + kstep, voffB); PG8_STAGE(PG8_SA(1, 0), cA + kstep, voffA); PG8_STAGE(PG8_SB(1, 1), cB + hstepB + kstep, voffB);
        PG8_WAIT_V(6); PG8_BAR;
    } else {
        PG8_STAGE(PG8_SB(0, 0), cB, voffB); PG8_STAGE(PG8_SA(0, 0), cA, voffA); PG8_STAGE(PG8_SB(0, 1), cB + hstepB, voffB); PG8_STAGE(PG8_SA(0, 1), cA + hstepA, voffA);
        if (wr == 1) PG8_BAR;
        PG8_WAIT_V(4); PG8_BAR;
        PG8_STAGE(PG8_SB(1, 0), cB + kstep, voffB); PG8_STAGE(PG8_SA(1, 0), cA + kstep, voffA); PG8_STAGE(PG8_SB(1, 1), cB + hstepB + kstep, voffB);
        PG8_WAIT_V(6); PG8_BAR;
    }
    for (;;) {
        const bool has_next = S.next(ui + 1, nxt);
        const char* nA = has_next ? (const char*)g.A + (size_t)nxt.pm * tstepA + (size_t)((nxt.pn >> g.apn_shift) * g.apn_stride) * 2 : cA; const char* nB = has_next ? (const char*)g.Bt + (size_t)nxt.pn * tstepB : cB;
#pragma unroll 1
        for (int t = 0; t < nt; t += 2) {
            const bool last = (t == nt - 2);
            const char* a1 = cA + (size_t)(t + 1) * kstep;
            const char* a2 = last ? nA : cA + (size_t)(t + 2) * kstep; const char* b2 = last ? nB : cB + (size_t)(t + 2) * kstep;
            const char* a3 = a2 + kstep; const char* b3 = b2 + kstep;
            if (last && has_next) S.a_ready(nxt);
            if constexpr (SP2) {
            PG8_LDB(B0, 0, 0); PG8_LDB(B1, 0, 1); PG8_SCHED; PG8_LDA(At, 0, 0); PG8_STAGE(PG8_SA(1, 1), a1 + hstepA, voffA);
            PG8_WAIT_V(8); PG8_WAIT_L(0); PG8_BAR; PG8_MMA(0, 0, At, B0); PG8_MMA(0, 1, At, B1); PG8_BAR; PG8_SCHED;
            PG8_LDA(At, 0, 1); PG8_STAGE(PG8_SB(0, 0), b2, voffB); PG8_STAGE(PG8_SB(0, 1), b2 + hstepB, voffB); PG8_STAGE(PG8_SA(0, 0), a2, voffA);
            PG8_WAIT_V(8); PG8_WAIT_L(0); PG8_BAR; PG8_MMA(1, 0, At, B0); PG8_MMA(1, 1, At, B1); PG8_BAR; PG8_SCHED;
            PG8_LDB(B0, 1, 0); PG8_LDB(B1, 1, 1); PG8_SCHED; PG8_LDA(At, 1, 0); PG8_STAGE(PG8_SA(0, 1), a2 + hstepA, voffA);
            PG8_WAIT_V(8); PG8_WAIT_L(0); PG8_BAR; PG8_MMA(0, 0, At, B0); PG8_MMA(0, 1, At, B1); PG8_BAR; PG8_SCHED;
            PG8_LDA(At, 1, 1); PG8_STAGE(PG8_SB(1, 0), b3, voffB); PG8_STAGE(PG8_SB(1, 1), b3 + hstepB, voffB); PG8_STAGE(PG8_SA(1, 0), a3, voffA);
            PG8_WAIT_V(8); PG8_WAIT_L(0); PG8_BAR; PG8_MMA(1, 0, At, B0); PG8_MMA(1, 1, At, B1); PG8_BAR; PG8_SCHED;
            } else {
            PG8_LDB(B0, 0, 0); PG8_SCHED; PG8_LDA(At, 0, 0); PG8_STAGE(PG8_SA(1, 1), a1 + hstepA, voffA);
            PG8_WAIT_L(8); PG8_BAR; PG8_WAIT_L(0); PG8_MMA(0, 0, At, B0); PG8_BAR; PG8_SCHED;
            PG8_LDB(B1, 0, 1); PG8_STAGE(PG8_SB(0, 0), b2, voffB);
            PG8_BAR; PG8_WAIT_L(0); PG8_MMA(0, 1, At, B1); PG8_BAR;
            PG8_LDA(At, 0, 1); PG8_STAGE(PG8_SA(0, 0), a2, voffA);
            PG8_BAR; PG8_WAIT_L(0); PG8_MMA(1, 0, At, B0); PG8_BAR; PG8_SCHED;
            PG8_STAGE(PG8_SB(0, 1), b2 + hstepB, voffB);
            PG8_WAIT_V(6); PG8_BAR; PG8_MMA(1, 1, At, B1); PG8_BAR;
            PG8_LDB(B0, 1, 0); PG8_SCHED; PG8_LDA(At, 1, 0); PG8_STAGE(PG8_SA(0, 1), a2 + hstepA, voffA);
            PG8_WAIT_L(8); PG8_BAR; PG8_WAIT_L(0); PG8_MMA(0, 0, At, B0); PG8_BAR; PG8_SCHED;
            PG8_LDB(B1, 1, 1); PG8_STAGE(PG8_SB(1, 0), b3, voffB);
            PG8_BAR; PG8_WAIT_L(0); PG8_MMA(0, 1, At, B1); PG8_BAR;
            PG8_LDA(At, 1, 1); PG8_STAGE(PG8_SA(1, 0), a3, voffA);
            PG8_BAR; PG8_WAIT_L(0); PG8_MMA(1, 0, At, B0); PG8_BAR; PG8_SCHED;
            PG8_STAGE(PG8_SB(1, 1), b3 + hstepB, voffB);
            PG8_WAIT_V(6); PG8_BAR; PG8_MMA(1, 1, At, B1); PG8_BAR;
            }
        }
        if constexpr (ALIGN_EPI) { if (wr == 0) PG8_BAR; }
        if constexpr (!Epi::AFTER_DRAIN) { E(acc, cur, wr, wc, fr, fq); S.done(cur); }
        if (!has_next) break;
#pragma unroll
        for (int a = 0; a < 2; ++a)
#pragma unroll
            for (int b = 0; b < 2; ++b)
#pragma unroll
                for (int m = 0; m < 4; ++m)
#pragma unroll
                    for (int n = 0; n < 2; ++n) acc[a][b][m][n] = (f32x4){0.f, 0.f, 0.f, 0.f};
        cur = nxt; cA = nA; cB = nB; ++ui;
        if constexpr (ALIGN_EPI) { if (wr == 1) PG8_BAR; }
    }
    PG8_WAIT_V(0);
    if constexpr (!ALIGN_EPI) { if (wr == 0) PG8_BAR; }
    PG8_BAR;
    if constexpr (Epi::AFTER_DRAIN) { E.fused(acc, cur, wr, wc, fr, fq, lds, wid, lane); S.done(cur); }
#undef PG8_SA
#undef PG8_SB
#undef PG8_STAGE
#undef PG8_LDA
#undef PG8_LDB
#undef PG8_MMA
#undef PG8_WAIT_V
#undef PG8_WAIT_L
#undef PG8_BAR
#undef PG8_SCHED
}
}
#define GAS __attribute__((address_space(1)))
typedef GAS unsigned gu32;
#define RLX_AGENT __ATOMIC_RELAXED, __HIP_MEMORY_SCOPE_AGENT
#define LDS_WAIT() asm volatile("s_waitcnt lgkmcnt(0)" ::: "memory")
#define VM_WAIT() asm volatile("s_waitcnt vmcnt(0)" ::: "memory")
#define XB_TMO      128
#define XB_XCNT(j)  (256  + 64 * (j))
#define XB_XSUB(j)  (1280 + 64 * (j))
#define XB_XGEN(j)  (2304 + 64 * (j))
#define XB_TOP      3328
#define XB_TOPGEN   3392
#define XCD_BAR_WORDS 3456
#define XB_SPIN_CAP (1u << 18)

__device__ __forceinline__ unsigned xb_ld(unsigned* p)              { return __hip_atomic_load(p, __ATOMIC_RELAXED, __HIP_MEMORY_SCOPE_AGENT); }
__device__ __forceinline__ unsigned xb_add(unsigned* p, unsigned v) { return __hip_atomic_fetch_add(p, v, __ATOMIC_RELAXED, __HIP_MEMORY_SCOPE_AGENT); }
__device__ __forceinline__ unsigned xb_xcc_id() { return (unsigned)__builtin_amdgcn_s_getreg((3 << 11) | 20) & 0xFu; }
#define XB_SPIN(cond, bar) do { unsigned _sp = 0; while (cond) { __builtin_amdgcn_s_sleep(1); \
    if ((++_sp & 255u) == 0u) { if (xb_ld(&(bar)[XB_TMO])) break; if (_sp > XB_SPIN_CAP) { atomicAdd(&(bar)[XB_TMO], 1u); break; } } } } while (0)

struct XcdBarrier {
    unsigned* bar; unsigned x;
    volatile LAS unsigned* st;
};

__device__ __forceinline__ XcdBarrier xcd_barrier_post(unsigned* bar, volatile LAS unsigned* st) {
    XcdBarrier b; b.bar = bar; b.x = xb_xcc_id(); b.st = st;
    if (threadIdx.x == 0) (void)xb_add(&bar[XB_XCNT(b.x)], 1u);
    return b;
}
__device__ __forceinline__ void xcd_barrier_complete(unsigned* bar, unsigned x, unsigned& nloc, unsigned& nx) {
    const unsigned G = gridDim.x * gridDim.y * gridDim.z;
    unsigned sum, cnt, mine, sp = 0u;
    for (;;) {
        sum = 0u; cnt = 0u; mine = 0u;
#pragma unroll
        for (unsigned j = 0; j < 16; ++j) { const unsigned c = xb_ld(&bar[XB_XCNT(j)]); sum += c; cnt += (c > 0u) ? 1u : 0u; mine = (j == x) ? c : mine; }
        if (sum == G) break;
        __builtin_amdgcn_s_sleep(1);
        if ((++sp & 255u) == 0u) { if (xb_ld(&bar[XB_TMO])) break; if (sp > XB_SPIN_CAP) { atomicAdd(&bar[XB_TMO], 1u); break; } }
    }
    nloc = mine > 0u ? mine : 1u; nx = cnt > 0u ? cnt : 1u;
}

__device__ __forceinline__ void xcd_barrier(const XcdBarrier& b) {
    asm volatile("s_waitcnt vmcnt(0)" ::: "memory");
    __syncthreads();
    if (threadIdx.x == 0) {
        unsigned* bar = b.bar;
        __builtin_amdgcn_s_waitcnt(0);
        unsigned nloc = b.st[0], nx = b.st[1];
        if (nloc == 0u) { xcd_barrier_complete(bar, b.x, nloc, nx); b.st[0] = nloc; b.st[1] = nx; }
        const unsigned old = xb_add(&bar[XB_XSUB(b.x)], 1u);
        const unsigned gen = old / nloc;
        if (old + 1u == (gen + 1u) * nloc) {
            __builtin_amdgcn_fence(__ATOMIC_RELEASE, "agent");
            asm volatile("s_waitcnt vmcnt(0)" ::: "memory");
            const unsigned og = xb_add(&bar[XB_TOP], 1u);
            const unsigned tg = og / nx;
            if (og + 1u == (tg + 1u) * nx) xb_add(&bar[XB_TOPGEN], 1u);
            else XB_SPIN(xb_ld(&bar[XB_TOPGEN]) == tg, bar);
            __builtin_amdgcn_fence(__ATOMIC_ACQUIRE, "agent");
            xb_add(&bar[XB_XGEN(b.x)], 1u);
            asm volatile("s_waitcnt vmcnt(0)" ::: "memory");
        } else {
            XB_SPIN(xb_ld(&bar[XB_XGEN(b.x)]) == gen, bar);
            __builtin_amdgcn_fence(__ATOMIC_ACQUIRE, "agent");
            asm volatile("s_waitcnt vmcnt(0)" ::: "memory");
        }
    }
    __syncthreads();
}

constexpr int NWAVES = 8;
constexpr int LDS_MAIN = 135168;
constexpr int LDSCTL_OFF = LDS_MAIN;
constexpr int LDS_BYTES = 147456;
constexpr int CW_BAR = 4096;
constexpr size_t CTL_ZERO_BYTES = 1 * MiB;
constexpr float LOG2E = 1.4426950408889634f;
typedef short bf16x8 __attribute__((ext_vector_type(8)));
typedef float f32x16 __attribute__((ext_vector_type(16)));
typedef unsigned u32x2 __attribute__((ext_vector_type(2)));
using pg8::Unit;
using pg8::cvt_pk_bf16;

__device__ __forceinline__ f32x4 sig4(f32x4 v) { return (f32x4){sigmoidf_(v[0]), sigmoidf_(v[1]), sigmoidf_(v[2]), sigmoidf_(v[3])}; }
__device__ __forceinline__ f32x4 gelu4(f32x4 v) { return (f32x4){gelu_tanh(v[0]), gelu_tanh(v[1]), gelu_tanh(v[2]), gelu_tanh(v[3])}; }
__device__ __forceinline__ u32x4 pack8(f32x4 a, f32x4 b) { u32x4 w; w.x = cvt_pk_bf16(a[0], a[1]); w.y = cvt_pk_bf16(a[2], a[3]); w.z = cvt_pk_bf16(b[0], b[1]); w.w = cvt_pk_bf16(b[2], b[3]); return w; }

struct OneUnit { pg8::StaticOrder S; int k;
    __device__ __forceinline__ bool next(int i, Unit& u) const { return i == 0 && S.next(k, u); }
    __device__ __forceinline__ void a_ready(const Unit&) const {}
    __device__ __forceinline__ void done(const Unit&) const {} };
struct EpiProj {
    static constexpr bool PERM = true, AFTER_DRAIN = false;
    const float* rstd; unsigned char* ws;
    __device__ __forceinline__ void operator()(const f32x4 (&acc)[2][2][4][2], const Unit& u, int wr, int wc, int fr, int fq) const {
        { const int t_ = fresh_lane(); fr = t_ & 15; fq = t_ >> 4; }
        const int pn = u.pn; bf16* base; int ldc, coff, act;
        if (pn < 3) { base = (bf16*)(ws + WS_QKV); ldc = 768; coff = pn * 256; act = 0; }
        else if (pn < 7) { base = (bf16*)(ws + WS_LX); ldc = 1024; coff = (pn - 3) * 256; act = 0; }
        else if (pn < 11) { base = (bf16*)(ws + WS_GL); ldc = 1024; coff = (pn - 7) * 256; act = 1; }
        else if (pn < 15) { base = (bf16*)(ws + WS_SGA); ldc = 1024; coff = (pn - 11) * 256; act = 2; }
        else { base = (bf16*)(ws + WS_SGL); ldc = 1024; coff = (pn - 15) * 256; act = 2; }
        const int row0 = u.pm * 256 + wr * 64 + fr, col0 = coff + wc * 32 + 8 * fq;
#pragma unroll
        for (int ai = 0; ai < 2; ++ai)
#pragma unroll
            for (int m = 0; m < 4; ++m) {
                const int r = row0 + ai * 128 + m * 16; const float rs = rstd[r]; bf16* rowp = base + (size_t)r * ldc + col0;
#pragma unroll
                for (int bj = 0; bj < 2; ++bj) {
                    f32x4 v0 = acc[ai][bj][m][0] * rs, v1 = acc[ai][bj][m][1] * rs;
                    if (act == 1) { v0 = gelu4(v0); v1 = gelu4(v1); } else if (act == 2) { v0 = sig4(v0); v1 = sig4(v1); }
                    *(u32x4*)(rowp + bj * 128) = pack8(v0, v1);
                }
            }
    }
};
struct EpiMP {
    static constexpr bool PERM = false, AFTER_DRAIN = false;
    const bf16* sga; float* mp;
    __device__ __forceinline__ void operator()(const f32x4 (&acc)[2][2][4][2], const Unit& u, int wr, int wc, int fr, int fq) const {
        { const int t_ = fresh_lane(); fr = t_ & 15; fq = t_ >> 4; }
        const int row0 = u.pm * 256 + wr * 64 + fr, col0 = u.pn * 256 + wc * 32 + 4 * fq;
#pragma unroll
        for (int ai = 0; ai < 2; ++ai)
#pragma unroll
            for (int m = 0; m < 4; ++m) {
                const size_t off = (size_t)(row0 + ai * 128 + m * 16) * 1024 + col0;
#pragma unroll
                for (int bj = 0; bj < 2; ++bj)
#pragma unroll
                    for (int n = 0; n < 2; ++n) { const size_t o = off + bj * 128 + n * 16; const f32x4 g = bf4_lo(*(const u32x2*)(sga + o)); const f32x4 v = acc[ai][bj][m][n] * g;
#if ALL_FUSED
                        u32x2 w; w.x = cvt_pk_bf16(v[0], v[1]); w.y = cvt_pk_bf16(v[2], v[3]); *(u32x2*)((bf16*)mp + o) = w;
#else
                        *(f32x4*)(mp + o) = v;
#endif
                    }
            }
    }
};
struct EpiMerged {
    static constexpr bool PERM = true, AFTER_DRAIN = false;
    const bf16* sgl; const float* mp; bf16* merged;
    __device__ __forceinline__ void operator()(const f32x4 (&acc)[2][2][4][2], const Unit& u, int wr, int wc, int fr, int fq) const {
        { const int t_ = fresh_lane(); fr = t_ & 15; fq = t_ >> 4; }
        const int row0 = u.pm * 256 + wr * 64 + fr, col0 = u.pn * 256 + wc * 32 + 8 * fq;
#pragma unroll
        for (int ai = 0; ai < 2; ++ai)
#pragma unroll
            for (int m = 0; m < 4; ++m) {
                const size_t off = (size_t)(row0 + ai * 128 + m * 16) * 1024 + col0;
#pragma unroll
                for (int bj = 0; bj < 2; ++bj) {
                    const size_t o = off + bj * 128; const u32x4 gw = *(const u32x4*)(sgl + o);
#if ALL_FUSED
                    const u32x4 mw = *(const u32x4*)((const bf16*)mp + o); const f32x4 m0 = bf4_lo((u32x2){mw.x, mw.y}), m1 = bf4_lo((u32x2){mw.z, mw.w});
#else
                    const f32x4 m0 = *(const f32x4*)(mp + o), m1 = *(const f32x4*)(mp + o + 4);
#endif
                    const f32x4 v0 = m0 + acc[ai][bj][m][0] * bf4_lo((u32x2){gw.x, gw.y}), v1 = m1 + acc[ai][bj][m][1] * bf4_lo((u32x2){gw.z, gw.w});
                    *(u32x4*)(merged + o) = pack8(v0, v1);
                }
            }
    }
};
struct EpiH1 {
    static constexpr bool PERM = true, AFTER_DRAIN = false;
    const float* x; float* h1; bf16* h1b; float* part;
    __device__ __forceinline__ void operator()(const f32x4 (&acc)[2][2][4][2], const Unit& u, int wr, int wc, int fr, int fq) const {
        { const int t_ = fresh_lane(); fr = t_ & 15; fq = t_ >> 4; }
        const int row0 = u.pm * 256 + wr * 64 + fr, col0 = u.pn * 256 + wc * 32 + 8 * fq;
#pragma unroll
        for (int ai = 0; ai < 2; ++ai)
#pragma unroll
            for (int m = 0; m < 4; ++m) {
                const int r = row0 + ai * 128 + m * 16; const size_t off = (size_t)r * 1024 + col0; float sq = 0.f;
#pragma unroll
                for (int bj = 0; bj < 2; ++bj) {
                    const size_t o = off + bj * 128;
                    const f32x4 v0 = *(const f32x4*)(x + o) + acc[ai][bj][m][0], v1 = *(const f32x4*)(x + o + 4) + acc[ai][bj][m][1];
#if !ALL_FUSED
                    *(f32x4*)(h1 + o) = v0; *(f32x4*)(h1 + o + 4) = v1;
#endif
                    *(u32x4*)(h1b + o) = pack8(v0, v1);
                    sq += (v0[0] * v0[0] + v0[1] * v0[1]) + (v0[2] * v0[2] + v0[3] * v0[3]) + (v1[0] * v1[0] + v1[1] * v1[1]) + (v1[2] * v1[2] + v1[3] * v1[3]);
                }
                sq += __shfl_xor(sq, 16); sq += __shfl_xor(sq, 32);
                if (fq == 0) part[(size_t)r * 16 + u.pn * 4 + wc] = sq;
            }
    }
};
struct EpiScore {
    static constexpr bool PERM = false, AFTER_DRAIN = false;
    const float* part; float* sc;
    __device__ __forceinline__ void operator()(const f32x4 (&acc)[2][2][4][2], const Unit& u, int wr, int wc, int fr, int fq) const {
        { const int t_ = fresh_lane(); fr = t_ & 15; fq = t_ >> 4; }
        const int row0 = u.pm * 256 + wr * 64 + fr, col0 = u.pn * 256 + wc * 32 + 4 * fq;
#pragma unroll
        for (int ai = 0; ai < 2; ++ai)
#pragma unroll
            for (int m = 0; m < 4; ++m) {
                const int r = row0 + ai * 128 + m * 16; const f32x4* pp = (const f32x4*)(part + (size_t)r * 16);
                const f32x4 s4 = (pp[0] + pp[1]) + (pp[2] + pp[3]); const float rs = 1.0f / sqrtf(((s4[0] + s4[1]) + (s4[2] + s4[3])) * (1.0f / 1024.0f) + EPS);
                const size_t off = (size_t)r * 1024 + col0;
#pragma unroll
                for (int bj = 0; bj < 2; ++bj)
#pragma unroll
                    for (int n = 0; n < 2; ++n) *(f32x4*)(sc + off + bj * 128 + n * 16) = acc[ai][bj][m][n] * rs;
            }
    }
};
struct EpiTopk {
    static constexpr bool PERM = false, AFTER_DRAIN = true;
    const float* part; int* seli; float* selg;
    __device__ __forceinline__ void fused(f32x4 (&acc)[2][2][4][2], const Unit& u, int wr, int wc, int fr, int fq, PG8_LAS unsigned char* lds, int wid, int lane) const {
        LAS float* L = (LAS float*)lds;
#pragma unroll
        for (int ai = 0; ai < 2; ++ai) {
            { const int t_ = fresh_lane(); fr = t_ & 15; fq = t_ >> 4; }
#pragma unroll
            for (int m = 0; m < 4; ++m) {
                const int rl = wr * 64 + m * 16 + fr, r = u.pm * 256 + ai * 128 + rl;
                const f32x4* pp = (const f32x4*)(part + (size_t)r * 16);
                const f32x4 s4 = (pp[0] + pp[1]) + (pp[2] + pp[3]); const float rs = 1.0f / sqrtf(((s4[0] + s4[1]) + (s4[2] + s4[3])) * (1.0f / 1024.0f) + EPS);
#pragma unroll
                for (int bj = 0; bj < 2; ++bj)
#pragma unroll
                    for (int n = 0; n < 2; ++n) *(LAS f32x4*)(L + (rl * 2 + bj) * TK_LSTRIDE + wc * 32 + 16 * n + 4 * fq) = acc[ai][bj][m][n] * rs;
            }
            asm volatile("s_waitcnt lgkmcnt(0)" ::: "memory"); __builtin_amdgcn_s_barrier(); asm volatile("" ::: "memory");
            const int tid = wid * 64 + fresh_lane();
            if (wid < 4) {
                const LAS float* my = L + tid * TK_LSTRIDE;
                unsigned a16[16];
#pragma unroll
                for (int g = 0; g < 8; ++g) {
                    unsigned t[16];
#pragma unroll
                    for (int q = 0; q < 4; ++q) {
                        const f32x4 v = *(const LAS f32x4*)(my + g * 16 + q * 4);
#pragma unroll
                        for (int c = 0; c < 4; ++c) { const int e = g * 16 + q * 4 + c; const float vc = v[c]; t[q * 4 + c] = (tk_f2key(vc) & ~127u) | (unsigned)(127 - e); }
                    }
                    tk_sort16(t);
                    if (g == 0) {
#pragma unroll
                        for (int i = 0; i < 16; ++i) a16[i] = t[i];
                    } else tk_merge16(a16, t);
                }
                unsigned oth[16];
#pragma unroll
                for (int i = 0; i < 16; ++i) oth[i] = (unsigned)__shfl_xor((int)a16[i], 1);
                if ((tid & 1) == 0) {
                    const int tok = u.pm * 256 + ai * 128 + (tid >> 1);
                    tk_combine_store(a16, oth, seli + (size_t)tok * 128 + u.pn * 16, selg + (size_t)tok * 128 + u.pn * 16);
                }
            }
            asm volatile("s_waitcnt lgkmcnt(0)" ::: "memory"); __builtin_amdgcn_s_barrier(); asm volatile("" ::: "memory");
        }
    }
};
struct EpiPP {
    static constexpr bool PERM = true, AFTER_DRAIN = false;
    bf16* pp;
    __device__ __forceinline__ void operator()(const f32x4 (&acc)[2][2][4][2], const Unit& u, int wr, int wc, int fr, int fq) const {
        { const int t_ = fresh_lane(); fr = t_ & 15; fq = t_ >> 4; }
        const int row0 = u.pm * 256 + wr * 64 + fr, col0 = u.pn * 256 + wc * 32 + 8 * fq;
#pragma unroll
        for (int ai = 0; ai < 2; ++ai)
#pragma unroll
            for (int m = 0; m < 4; ++m) {
                const size_t off = (size_t)(row0 + ai * 128 + m * 16) * 1024 + col0;
#pragma unroll
                for (int bj = 0; bj < 2; ++bj) *(u32x4*)(pp + off + bj * 128) = pack8(acc[ai][bj][m][0], acc[ai][bj][m][1]);
            }
    }
};
struct EpiH3 {
    static constexpr bool PERM = true, AFTER_DRAIN = false;
    const float* rstd3; const bf16* pp; float* h; float* part; const bf16* h2b; bf16* h3b;
    __device__ __forceinline__ void operator()(const f32x4 (&acc)[2][2][4][2], const Unit& u, int wr, int wc, int fr, int fq) const {
        { const int t_ = fresh_lane(); fr = t_ & 15; fq = t_ >> 4; }
        const int row0 = u.pm * 256 + wr * 64 + fr, col0 = u.pn * 256 + wc * 32 + 8 * fq;
#pragma unroll
        for (int ai = 0; ai < 2; ++ai)
#pragma unroll
            for (int m = 0; m < 4; ++m) {
                const int r = row0 + ai * 128 + m * 16; const size_t off = (size_t)r * 1024 + col0; const float rs = rstd3[r]; float sq = 0.f;
#pragma unroll
                for (int bj = 0; bj < 2; ++bj) {
                    const size_t o = off + bj * 128; const u32x4 pw = *(const u32x4*)(pp + o);
#if ALL_FUSED
                    const u32x4 hw = *(const u32x4*)(h2b + o);
                    const f32x4 v0 = bf4_lo((u32x2){hw.x, hw.y}) + sig4(acc[ai][bj][m][0] * rs) * bf4_lo((u32x2){pw.x, pw.y});
                    const f32x4 v1 = bf4_lo((u32x2){hw.z, hw.w}) + sig4(acc[ai][bj][m][1] * rs) * bf4_lo((u32x2){pw.z, pw.w});
                    *(u32x4*)(h3b + o) = pack8(v0, v1);
#else
                    const f32x4 v0 = *(const f32x4*)(h + o) + sig4(acc[ai][bj][m][0] * rs) * bf4_lo((u32x2){pw.x, pw.y});
                    const f32x4 v1 = *(const f32x4*)(h + o + 4) + sig4(acc[ai][bj][m][1] * rs) * bf4_lo((u32x2){pw.z, pw.w});
                    *(f32x4*)(h + o) = v0; *(f32x4*)(h + o + 4) = v1;
#endif
                    sq += (v0[0] * v0[0] + v0[1] * v0[1]) + (v0[2] * v0[2] + v0[3] * v0[3]) + (v1[0] * v1[0] + v1[1] * v1[1]) + (v1[2] * v1[2] + v1[3] * v1[3]);
                }
                sq += __shfl_xor(sq, 16); sq += __shfl_xor(sq, 32);
                if (fq == 0) part[(size_t)r * 16 + u.pn * 4 + wc] = sq;
            }
    }
};
struct EpiPre {
    static constexpr bool PERM = false, AFTER_DRAIN = false;
    float* rp; float* ip;
    __device__ __forceinline__ void operator()(const f32x4 (&acc)[2][2][4][2], const Unit& u, int wr, int wc, int fr, int fq) const {
        { const int t_ = fresh_lane(); fr = t_ & 15; fq = t_ >> 4; }
#pragma unroll
        for (int n = 0; n < 2; ++n) { const int ch = u.pn * 128 + wc * 32 + 16 * n + 4 * fq;
#pragma unroll
            for (int ai = 0; ai < 2; ++ai)
#pragma unroll
                for (int m = 0; m < 4; ++m) { const int r = u.pm * 256 + ai * 128 + wr * 64 + m * 16 + fr; const size_t o = (size_t)r * 1024 + ch; *(f32x4*)(rp + o) = acc[ai][0][m][n]; *(f32x4*)(ip + o) = acc[ai][1][m][n]; } }
    }
};
struct EpiH3Final {
    static constexpr bool PERM = true, AFTER_DRAIN = false;
    const float* rstd3; const bf16* pp; const bf16* h2b; const float* fg; float* out; float* part; unsigned* cnt;
    __device__ __forceinline__ void operator()(f32x4 (&acc)[2][2][4][2], const Unit& u, int wr, int wc, int fr, int fq) const {
        { const int t_ = fresh_lane(); fr = t_ & 15; fq = t_ >> 4; }
        const int row0 = u.pm * 256 + wr * 64 + fr, col0 = u.pn * 256 + wc * 32 + 8 * fq;
#pragma unroll
        for (int ai = 0; ai < 2; ++ai)
#pragma unroll
            for (int m = 0; m < 4; ++m) {
                const int r = row0 + ai * 128 + m * 16; const size_t off = (size_t)r * 1024 + col0; const float rs = rstd3[r]; float sq = 0.f;
#pragma unroll
                for (int bj = 0; bj < 2; ++bj) {
                    const size_t o = off + bj * 128; const u32x4 pw = *(const u32x4*)(pp + o); const u32x4 hw = *(const u32x4*)(h2b + o);
                    const f32x4 v0 = bf4_lo((u32x2){hw.x, hw.y}) + sig4(acc[ai][bj][m][0] * rs) * bf4_lo((u32x2){pw.x, pw.y});
                    const f32x4 v1 = bf4_lo((u32x2){hw.z, hw.w}) + sig4(acc[ai][bj][m][1] * rs) * bf4_lo((u32x2){pw.z, pw.w});
                    acc[ai][bj][m][0] = v0; acc[ai][bj][m][1] = v1;
                    sq += (v0[0] * v0[0] + v0[1] * v0[1]) + (v0[2] * v0[2] + v0[3] * v0[3]) + (v1[0] * v1[0] + v1[1] * v1[1]) + (v1[2] * v1[2] + v1[3] * v1[3]);
                }
                sq += __shfl_xor(sq, 16); sq += __shfl_xor(sq, 32);
                if (fq == 0) __hip_atomic_store(part + (size_t)r * 16 + u.pn * 4 + wc, sq, __ATOMIC_RELAXED, __HIP_MEMORY_SCOPE_AGENT);
            }
        asm volatile("s_waitcnt vmcnt(0)" ::: "memory");
        const int lane = fq * 16 + fr;
        unsigned* c = cnt + 64 * u.pm;
        if (lane == 0) __hip_atomic_fetch_add(c, 1u, __ATOMIC_RELAXED, __HIP_MEMORY_SCOPE_AGENT);
        {
            const unsigned long long t0 = __builtin_amdgcn_s_memrealtime();
            while ((unsigned)__builtin_amdgcn_readfirstlane((int)__hip_atomic_load(c, __ATOMIC_RELAXED, __HIP_MEMORY_SCOPE_AGENT)) < 32u) {
                if (__builtin_amdgcn_s_memrealtime() - t0 > 2000000ull) break;
                __builtin_amdgcn_s_sleep(2);
            }
        }
        { const int t_ = fresh_lane(); fr = t_ & 15; fq = t_ >> 4; }
#pragma unroll
        for (int ai = 0; ai < 2; ++ai)
#pragma unroll
            for (int m = 0; m < 4; ++m) {
                const int r = u.pm * 256 + wr * 64 + fr + ai * 128 + m * 16;
                float ps = 0.f;
#pragma unroll
                for (int k = 0; k < 16; ++k) ps += __hip_atomic_load(part + (size_t)r * 16 + k, __ATOMIC_RELAXED, __HIP_MEMORY_SCOPE_AGENT);
                const float rr = 1.0f / sqrtf(ps * (1.0f / 1024.0f) + EPS);
                const int cc = u.pn * 256 + wc * 32 + 8 * fq;
#pragma unroll
                for (int bj = 0; bj < 2; ++bj) {
                    const f32x4 g0 = *(const f32x4*)(fg + cc + bj * 128), g1 = *(const f32x4*)(fg + cc + bj * 128 + 4);
                    float* op = out + (size_t)r * 1024 + cc + bj * 128;
                    *(f32x4*)op = acc[ai][bj][m][0] * rr * g0; *(f32x4*)(op + 4) = acc[ai][bj][m][1] * rr * g1;
                }
            }
    }
};
template <int CTRL> __device__ __forceinline__ float dpp_f(float oldv, float src) {
    return __builtin_bit_cast(float, __builtin_amdgcn_update_dpp(__builtin_bit_cast(int, oldv), __builtin_bit_cast(int, src), CTRL, 0xf, 0xf, false));
}
#ifndef LRU_T2
#define LRU_T2 0
#endif
struct EpiLru {
    static constexpr bool PERM = false, AFTER_DRAIN = false;
    const bf16* lin; const float* ba; const float* bx; const float* c8l; bf16* hloc; bf16* pcum; float* agg;
    template <int SH> static __device__ __forceinline__ void step(f32x4& A, f32x4& Bv, float idd) {
#pragma unroll
        for (int j = 0; j < 4; ++j) {
            const float ap = __int_as_float(__builtin_amdgcn_update_dpp(0, __float_as_int((float)A[j]), 0x110 + SH, 0xf, 0xf, true)) + idd;
            const float bp = __int_as_float(__builtin_amdgcn_update_dpp(0, __float_as_int((float)Bv[j]), 0x110 + SH, 0xf, 0xf, true));
            Bv[j] = fmaf(A[j], bp, Bv[j]); A[j] = A[j] * ap; }
    }
    __device__ __forceinline__ void operator()(f32x4 (&acc)[2][2][4][2], const Unit& u, int wr, int wc, int fr, int fq) const {
        { const int t_ = fresh_lane(); fr = t_ & 15; fq = t_ >> 4; }
        const int lane = fq * 16 + fr;
#pragma unroll
        for (int n = 0; n < 2; ++n) {
            const int ch = u.pn * 128 + wc * 32 + 16 * n + 4 * fq;
            const f32x4 bav = *(const f32x4*)(ba + ch), bxv = *(const f32x4*)(bx + ch), cv = *(const f32x4*)(c8l + ch);
#pragma unroll
            for (int ai = 0; ai < 2; ++ai)
#pragma unroll
                for (int m = 0; m < 4; ++m) {
                    const int r = u.pm * 256 + ai * 128 + wr * 64 + m * 16 + fr; const unsigned o = (unsigned)r * 1024u + (unsigned)ch;
                    const f32x4 lv = bf4_lo(*(const u32x2*)(lin + o));
#pragma unroll
                    for (int j = 0; j < 4; ++j) {
                        const float rr = sigmoidf_(acc[ai][0][m][n][j] + bav[j]), ii = sigmoidf_(acc[ai][1][m][n][j] + bxv[j]);
                        const float a = __builtin_amdgcn_exp2f(cv[j] * rr);
                        acc[ai][0][m][n][j] = a; acc[ai][1][m][n][j] = __builtin_amdgcn_sqrtf(fmaxf(1.0f - a * a, 0.f)) * (ii * lv[j]);
                    }
                    asm volatile("" : "+v"(acc[ai][0][m][n]), "+v"(acc[ai][1][m][n]));
                }
        }
#if defined(LRU_DEBUG) && LRU_DEBUG == 1
        {
            float* af = (float*)hloc; float* bf = (float*)pcum;
#pragma unroll
            for (int n = 0; n < 2; ++n) { const int ch = u.pn * 128 + wc * 32 + 16 * n + 4 * fq;
#pragma unroll
                for (int ai = 0; ai < 2; ++ai)
#pragma unroll
                    for (int m = 0; m < 4; ++m) { const int r = u.pm * 256 + ai * 128 + wr * 64 + m * 16 + fr; const size_t o = (size_t)r * 1024 + ch; *(f32x4*)(af + o) = acc[ai][0][m][n]; *(f32x4*)(bf + o) = acc[ai][1][m][n]; } }
            return;
        }
#endif
        __builtin_amdgcn_sched_barrier(0);
        const float id1 = fr < 1 ? 1.f : 0.f, id2 = fr < 2 ? 1.f : 0.f, id4 = fr < 4 ? 1.f : 0.f, id8 = fr < 8 ? 1.f : 0.f;
#pragma unroll
        for (int ai = 0; ai < 2; ++ai)
#pragma unroll
            for (int m = 0; m < 4; ++m)
#pragma unroll
                for (int n = 0; n < 2; ++n) { step<1>(acc[ai][0][m][n], acc[ai][1][m][n], id1); step<2>(acc[ai][0][m][n], acc[ai][1][m][n], id2); step<4>(acc[ai][0][m][n], acc[ai][1][m][n], id4); step<8>(acc[ai][0][m][n], acc[ai][1][m][n], id8);
                    asm volatile("" : "+v"(acc[ai][0][m][n]), "+v"(acc[ai][1][m][n])); }
        { const int t_ = fresh_lane(); fr = t_ & 15; fq = t_ >> 4; }
        const int src4 = (((fq * 16 + fr) & 48) | 15) * 4;
#pragma unroll
        for (int n = 0; n < 2; ++n) {
            const int ch = u.pn * 128 + wc * 32 + 16 * n + 4 * fq;
#pragma unroll
            for (int ai = 0; ai < 2; ++ai) {
#pragma unroll
                for (int m = 0; m < 4; ++m) {
                    f32x4& A = acc[ai][0][m][n]; f32x4& Bv = acc[ai][1][m][n];
                    if (m > 0 && !(LRU_T2)) {
#pragma unroll
                        for (int j = 0; j < 4; ++j) { const float pa = acc[ai][0][m - 1][n][j], pb = acc[ai][1][m - 1][n][j];
                            const float ac = __int_as_float(__builtin_amdgcn_ds_bpermute(src4, __float_as_int(pa))), bc = __int_as_float(__builtin_amdgcn_ds_bpermute(src4, __float_as_int(pb))); Bv[j] = fmaf(A[j], bc, Bv[j]); A[j] = A[j] * ac; }
                    }
                    const int r = u.pm * 256 + ai * 128 + wr * 64 + m * 16 + fr; const unsigned o = (unsigned)r * 1024u + (unsigned)ch;
                    u32x2 wp, wh; wp.x = cvt_pk_bf16(A[0], A[1]); wp.y = cvt_pk_bf16(A[2], A[3]); wh.x = cvt_pk_bf16(Bv[0], Bv[1]); wh.y = cvt_pk_bf16(Bv[2], Bv[3]);
                    *(u32x2*)(pcum + o) = wp; *(u32x2*)(hloc + o) = wh;
                    if (m == 3 && fr == 15) {
                        const int chunk = u.pm * 4 + ai * 2 + wr; float* ap = agg + ((size_t)chunk * 1024 + ch) * 2;
                        *(f32x4*)(ap) = (f32x4){A[0], Bv[0], A[1], Bv[1]}; *(f32x4*)(ap + 4) = (f32x4){A[2], Bv[2], A[3], Bv[3]};
                    }
                    __builtin_amdgcn_sched_barrier(0);
                }
            }
        }
    }
};

__device__ __forceinline__ void p0_transpose_item(const float* W, int ldw, const float* gain, bf16* WT, int ldt, int k_off, LAS float* scr, int kb, int nb, int lane) {
    const int k0 = 64 * kb, n0 = 32 * nb;
    const int c4 = lane & 7, kr = lane >> 3;
    f32x4 v[8];
#pragma unroll
    for (int i = 0; i < 8; ++i) v[i] = *(const f32x4*)(W + (size_t)(k0 + 8 * i + kr) * ldw + n0 + 4 * c4);
#pragma unroll
    for (int i = 0; i < 8; ++i) { f32x4 x = v[i]; if (gain) x = x * gain[k0 + 8 * i + kr]; *(LAS f32x4*)(scr + (8 * i + kr) * 36 + 4 * c4) = x; }
    LDS_WAIT(); asm volatile("" ::: "memory");
    const int c = lane & 7;
#pragma unroll
    for (int j = 0; j < 4; ++j) { const int n = (lane >> 3) + 8 * j; const LAS float* sp = scr + (8 * c) * 36 + n;
        u32x4 o; o.x = pk2(sp[0 * 36], sp[1 * 36]); o.y = pk2(sp[2 * 36], sp[3 * 36]); o.z = pk2(sp[4 * 36], sp[5 * 36]); o.w = pk2(sp[6 * 36], sp[7 * 36]);
        *(u32x4*)(WT + (size_t)(n0 + n) * ldt + k_off + k0 + 8 * c) = o; }
    LDS_WAIT(); asm volatile("" ::: "memory");
}
__device__ __forceinline__ void p0_wfold_item(LAS float* lds, const float* wq, const float* k1, const float* k2, const float* gffn, bf16* wfold, int item, int tid) {
    const int hh = item >> 4, kb = item & 15;
    LAS float* wqs = lds; LAS float* kks = lds + 64 * 132;
    const float* ksrc = (hh & 1) ? k2 : k1;
#pragma unroll
    for (int i = 0; i < 4; ++i) { const int e = tid + i * 512, r = e >> 5, c4 = e & 31; *(LAS f32x4*)(wqs + r * 132 + 4 * c4) = *(const f32x4*)(wq + (size_t)(kb * 64 + r) * 2048 + hh * 128 + 4 * c4); }
#pragma unroll
    for (int i = 0; i < 8; ++i) { const int e = tid + i * 512, r = e >> 5, c4 = e & 31; *(LAS f32x4*)(kks + r * 132 + 4 * c4) = *(const f32x4*)(ksrc + (size_t)r * 128 + 4 * c4); }
    __syncthreads();
    const int tk = tid & 15, tkey = tid >> 4;
    float acc[4][4];
#pragma unroll
    for (int i = 0; i < 4; ++i)
#pragma unroll
        for (int j = 0; j < 4; ++j) acc[i][j] = 0.f;
#pragma unroll 2
    for (int c4 = 0; c4 < 32; ++c4) {
        f32x4 a[4], b[4];
#pragma unroll
        for (int i = 0; i < 4; ++i) { a[i] = *(const LAS f32x4*)(wqs + (tk * 4 + i) * 132 + 4 * c4); b[i] = *(const LAS f32x4*)(kks + (tkey * 4 + i) * 132 + 4 * c4); }
#pragma unroll
        for (int i = 0; i < 4; ++i)
#pragma unroll
            for (int j = 0; j < 4; ++j) acc[i][j] += (a[i][0] * b[j][0] + a[i][1] * b[j][1]) + (a[i][2] * b[j][2] + a[i][3] * b[j][3]);
    }
    const int kg = kb * 64 + tk * 4; const f32x4 gv = *(const f32x4*)(gffn + kg);
#pragma unroll
    for (int j = 0; j < 4; ++j) { u32x2 w; w.x = pk2(acc[0][j] * gv[0], acc[1][j] * gv[1]); w.y = pk2(acc[2][j] * gv[2], acc[3][j] * gv[3]);
        *(u32x2*)(wfold + (size_t)(hh * 128 + tkey * 4 + j) * 1024 + kg) = w; }
    __syncthreads();
}

struct In { const float* p[25]; };
enum { I_X = 0, I_P, I_GMIX, I_WIN, I_SINK, I_CONVW, I_CONVB, I_WA, I_BA, I_WX, I_BX, I_LAM, I_WUA, I_WUL, I_WO, I_GFFN, I_WQ, I_K1, I_K2, I_U, I_V, I_GPLE, I_WGATE, I_WPROJ, I_FG };

__device__ __forceinline__ void p0_prologue(const In& in, unsigned char* ws, LAS unsigned char* lds, int vcu, int G, int wave, int tid) {
    const int lane = tid & 63;
    LAS float* scr = (LAS float*)(lds + wave * 16384);
    const int gw = vcu * NWAVES + wave, NGW = G * NWAVES;
    constexpr int I_IN = 16 * 152, I_UA = 8 * 32, I_SQ = 16 * 32, I_PJ = 4 * 32, I_AX = 128;
    constexpr int NITEMS = I_IN + I_UA + 3 * I_SQ + I_PJ + I_AX;
    for (int it = gw; it < NITEMS; it += NGW) {
        int r = it;
        if (r < I_IN) { p0_transpose_item(in.p[I_WIN], INW, in.p[I_GMIX], (bf16*)(ws + WS_WIN), 1024, 0, scr, r / 152, r % 152, lane); continue; } r -= I_IN;
        if (r < I_UA) { p0_transpose_item(in.p[I_WUA], 1024, nullptr, (bf16*)(ws + WS_WUA), 512, 0, scr, r / 32, r % 32, lane); continue; } r -= I_UA;
        if (r < I_SQ) { p0_transpose_item(in.p[I_WUL], 1024, nullptr, (bf16*)(ws + WS_WUL), 1024, 0, scr, r / 32, r % 32, lane); continue; } r -= I_SQ;
        if (r < I_SQ) { p0_transpose_item(in.p[I_WO], 1024, nullptr, (bf16*)(ws + WS_WO), 1024, 0, scr, r / 32, r % 32, lane); continue; } r -= I_SQ;
        if (r < I_SQ) { p0_transpose_item(in.p[I_WGATE], 1024, in.p[I_GPLE], (bf16*)(ws + WS_WG), 1024, 0, scr, r / 32, r % 32, lane); continue; } r -= I_SQ;
        if (r < I_PJ) { p0_transpose_item(in.p[I_WPROJ], 1024, nullptr, (bf16*)(ws + WS_WPROJ), 256, 0, scr, r / 32, r % 32, lane); continue; } r -= I_PJ;
        { const int blk = r >> 4, which = (r >> 3) & 1, sub = r & 7;

#if LRU_PADDED
#if LRU_PADDED == 2
          p0_transpose_item(in.p[which ? I_WX : I_WA] + (size_t)blk * 16384, 128, nullptr, (bf16*)(ws + WS_WAX) + (size_t)blk * 32768 + which * 128 * 128, 128, 0, scr, sub >> 2, sub & 3, lane); }
#else
          p0_transpose_item(in.p[which ? I_WX : I_WA] + (size_t)blk * 16384, 128, nullptr, (bf16*)(ws + WS_WAX) + (size_t)blk * 65536 + which * 128 * 256, 256, (blk & 1) * 128, scr, sub >> 2, sub & 3, lane); }
#endif
#else
          p0_transpose_item(in.p[which ? I_WX : I_WA] + (size_t)blk * 16384, 128, nullptr, (bf16*)(ws + WS_WAXD) + (size_t)(blk * 256 + which * 128) * 1024, 1024, blk * 128, scr, sub >> 2, sub & 3, lane); }
#endif
    }
#if LRU_PADDED == 2
#elif LRU_PADDED
    for (int i = vcu * 512 + tid; i < 8 * 256 * 16; i += G * 512) { const int c16 = i & 15, n = (i >> 4) & 255, blk = i >> 12;
        *(u32x4*)((bf16*)(ws + WS_WAX) + (size_t)blk * 65536 + n * 256 + ((blk & 1) ^ 1) * 128 + c16 * 8) = (u32x4){0u, 0u, 0u, 0u}; }
#else
    for (int i = vcu * 512 + tid; i < 2048 * 128; i += G * 512) { const int c16 = i & 127, row = i >> 7, blk = row >> 8;
        if ((c16 >> 4) != blk) *(u32x4*)((bf16*)(ws + WS_WAXD) + (size_t)row * 1024 + c16 * 8) = (u32x4){0u, 0u, 0u, 0u}; }
#endif
    for (int m = gw; m < T_; m += 2 * NGW) {
        const int m2 = m + NGW;
        const f32x4* xa = (const f32x4*)(in.p[I_X] + (size_t)m * 1024) + lane; const f32x4* xb = (const f32x4*)(in.p[I_X] + (size_t)(m2 < T_ ? m2 : m) * 1024) + lane;
        f32x4 va[4], vb[4]; float sa = 0.f, sb = 0.f;
#pragma unroll
        for (int j = 0; j < 4; ++j) { va[j] = xa[64 * j]; vb[j] = xb[64 * j]; }
#pragma unroll
        for (int j = 0; j < 4; ++j) { sa += (va[j][0] * va[j][0] + va[j][1] * va[j][1]) + (va[j][2] * va[j][2] + va[j][3] * va[j][3]); sb += (vb[j][0] * vb[j][0] + vb[j][1] * vb[j][1]) + (vb[j][2] * vb[j][2] + vb[j][3] * vb[j][3]); }
#pragma unroll
        for (int o = 1; o < 64; o <<= 1) { sa += __shfl_xor(sa, o); sb += __shfl_xor(sb, o); }
        u32x2* oa = (u32x2*)((bf16*)(ws + WS_R0) + (size_t)m * 1024) + lane;
#pragma unroll
        for (int j = 0; j < 4; ++j) { u32x2 w; w.x = pk2(va[j][0], va[j][1]); w.y = pk2(va[j][2], va[j][3]); oa[64 * j] = w; }
        if (lane == 0) ((float*)(ws + WS_RSTD1))[m] = 1.0f / sqrtf(sa * (1.0f / 1024.0f) + EPS);
        if (m2 < T_) {
            u32x2* ob = (u32x2*)((bf16*)(ws + WS_R0) + (size_t)m2 * 1024) + lane;
#pragma unroll
            for (int j = 0; j < 4; ++j) { u32x2 w; w.x = pk2(vb[j][0], vb[j][1]); w.y = pk2(vb[j][2], vb[j][3]); ob[64 * j] = w; }
            if (lane == 0) ((float*)(ws + WS_RSTD1))[m2] = 1.0f / sqrtf(sb * (1.0f / 1024.0f) + EPS);
        }
    }
    for (int m = gw; m < T_; m += 4 * NGW) {
        f32x4 v[4];
#pragma unroll
        for (int q = 0; q < 4; ++q) { const int mq = m + q * NGW; v[q] = ((const f32x4*)(in.p[I_P] + (size_t)(mq < T_ ? mq : m) * 256))[lane]; }
#pragma unroll
        for (int q = 0; q < 4; ++q) { const int mq = m + q * NGW; if (mq < T_) { u32x2 w; w.x = pk2(v[q][0], v[q][1]); w.y = pk2(v[q][2], v[q][3]); ((u32x2*)((bf16*)(ws + WS_PB) + (size_t)mq * 256))[lane] = w; } }
    }
    if (vcu == 0) for (int c = tid; c < 1024; c += 512) ((float*)(ws + WS_C8))[c] = -8.0f * log1pf(expf(-in.p[I_LAM][c])) * LOG2E;
    __syncthreads();
    for (int it = vcu; it < 256; it += G) p0_wfold_item((LAS float*)lds, in.p[I_WQ], in.p[I_K1], in.p[I_K2], in.p[I_GFFN], (bf16*)(ws + WS_WFOLD), it, tid);
}

constexpr int AT_KSTR = 72, AT_VSTR = 260, AT_V_OFF = 256 * AT_KSTR * 2;
__device__ __forceinline__ int crow(int r, int hi) { return (r & 3) + 8 * (r >> 2) + 4 * hi; }
__device__ __forceinline__ void attn_item(LAS unsigned char* lds, const bf16* qkv, const float* sink, bf16* att, int item, int wave, int tid) {
    const int lane = tid & 63;
    const int g = item & 1, n = (item >> 1) & 15, b = item >> 5;
    const int t0 = b * S_ + n * 128;
    LAS bf16* Ks = (LAS bf16*)lds; LAS bf16* Vt = (LAS bf16*)(lds + AT_V_OFF);
#pragma unroll
    for (int i = 0; i < 4; ++i) {
        const int idx = tid + i * 512, row = idx >> 3, ch = idx & 7; const int tk = t0 - 128 + row;
        u32x4 kv = (u32x4){0u, 0u, 0u, 0u}, vv = (u32x4){0u, 0u, 0u, 0u};
        if (n > 0 || row >= 128) { const bf16* src = qkv + (size_t)tk * 768 + 512 + g * 64 + ch * 8; kv = *(const u32x4*)src; vv = *(const u32x4*)(src + 128); }
        *(LAS u32x4*)(Ks + row * AT_KSTR + ch * 8) = kv;
#pragma unroll
        for (int c = 0; c < 8; ++c) Vt[(ch * 8 + c) * AT_VSTR + row] = (bf16)(vv[c >> 1] >> (16 * (c & 1)));
    }
    __syncthreads();
    const int hr = wave >> 1, qh = wave & 1, head = g * 4 + hr;
    const float slope2 = exp2f(-(float)(head + 1)) * LOG2E, sink2 = sink[head] * LOG2E;
    const int q = lane & 31, hi = lane >> 5;
#pragma unroll 1
    for (int ps = 0; ps < 2; ++ps) {
        const int i0 = 64 * qh + 32 * ps, kb0 = i0;
        const bf16* qp = qkv + (size_t)(t0 + i0 + q) * 768 + head * 64 + 8 * hi;
        bf16x8 qf[4];
#pragma unroll
        for (int s = 0; s < 4; ++s) qf[s] = *(const bf16x8*)(qp + 16 * s);
        f32x16 oT[2];
#pragma unroll
        for (int dt = 0; dt < 2; ++dt)
#pragma unroll
            for (int r = 0; r < 16; ++r) oT[dt][r] = 0.f;
        float mrun = sink2, l = 0.f;
#pragma unroll 1
        for (int kt = 0; kt < 5; ++kt) {
            const int kbase = kb0 + 32 * kt;
            f32x16 sT;
#pragma unroll
            for (int r = 0; r < 16; ++r) sT[r] = 0.f;
#pragma unroll
            for (int s = 0; s < 4; ++s) { const bf16x8 kf = *(const LAS bf16x8*)(Ks + (kbase + q) * AT_KSTR + 16 * s + 8 * hi); sT = __builtin_amdgcn_mfma_f32_32x32x16_bf16(kf, qf[s], sT, 0, 0, 0); }
            float tm = -1.0e30f;
#pragma unroll
            for (int r = 0; r < 16; ++r) {
                const int kj = kbase + crow(r, hi); const int dist = i0 + q + 128 - kj;
                const bool valid = (dist >= 0) && (dist < 128) && (n > 0 || kj >= 128);
                const float v = valid ? (sT[r] * (0.125f * LOG2E) - slope2 * (float)dist) : -1.0e30f;
                sT[r] = v; tm = fmaxf(tm, v);
            }
            tm = fmaxf(tm, __shfl_xor(tm, 32));
            const float mnew = fmaxf(mrun, tm), alpha = __builtin_amdgcn_exp2f(mrun - mnew);
            mrun = mnew;
            float ls = 0.f;
#pragma unroll
            for (int r = 0; r < 16; ++r) { const float p = __builtin_amdgcn_exp2f(sT[r] - mnew); sT[r] = p; ls += p; }
            l = l * alpha + ls;
#pragma unroll
            for (int dt = 0; dt < 2; ++dt)
#pragma unroll
                for (int r = 0; r < 16; ++r) oT[dt][r] *= alpha;
#pragma unroll
            for (int s = 0; s < 2; ++s) {
                u32x4 pw; pw.x = cvt_pk_bf16(sT[8 * s + 0], sT[8 * s + 1]); pw.y = cvt_pk_bf16(sT[8 * s + 2], sT[8 * s + 3]);
                pw.z = cvt_pk_bf16(sT[8 * s + 4], sT[8 * s + 5]); pw.w = cvt_pk_bf16(sT[8 * s + 6], sT[8 * s + 7]);
                const bf16x8 pf = __builtin_bit_cast(bf16x8, pw);
#pragma unroll
                for (int dt = 0; dt < 2; ++dt) {
                    const LAS bf16* vp = Vt + (32 * dt + q) * AT_VSTR + kbase + 16 * s + 4 * hi;
                    const u32x2 va = *(const LAS u32x2*)vp, vb = *(const LAS u32x2*)(vp + 8);
                    const bf16x8 af = __builtin_bit_cast(bf16x8, (u32x4){va.x, va.y, vb.x, vb.y});
                    oT[dt] = __builtin_amdgcn_mfma_f32_32x32x16_bf16(af, pf, oT[dt], 0, 0, 0);
                }
            }
        }
        l += __shfl_xor(l, 32);
        l += __builtin_amdgcn_exp2f(sink2 - mrun);
        const float inv = 1.0f / l;
        bf16* op = att + (size_t)(t0 + i0 + q) * 512 + head * 64 + 4 * hi;
#pragma unroll
        for (int dt = 0; dt < 2; ++dt)
#pragma unroll
            for (int rg = 0; rg < 4; ++rg) { u32x2 w; w.x = cvt_pk_bf16(oT[dt][4 * rg] * inv, oT[dt][4 * rg + 1] * inv); w.y = cvt_pk_bf16(oT[dt][4 * rg + 2] * inv, oT[dt][4 * rg + 3] * inv);
                *(u32x2*)(op + 32 * dt + 8 * rg) = w; }
    }
    __syncthreads();
}
__device__ __forceinline__ void conv_items(const bf16* lx, const float* cw, const float* cb, bf16* lin, int vcu, int G, int tid) {
    for (int i = vcu * 512 + tid; i < T_ * 128; i += 2 * G * 512) {
        const int c8 = (i & 127) * 8;
        const int ta = i >> 7, i2 = i + G * 512; const bool hasb = i2 < T_ * 128; const int tb = hasb ? (i2 >> 7) : ta;
        const int tsa = ta & (S_ - 1), tsb = tb & (S_ - 1);
        u32x4 wa[4], wb[4];
#pragma unroll
        for (int tap = 0; tap < 4; ++tap) {
            wa[tap] = (tsa - 3 + tap >= 0) ? *(const u32x4*)(lx + (size_t)(ta - 3 + tap) * 1024 + c8) : (u32x4){0u, 0u, 0u, 0u};
            wb[tap] = (tsb - 3 + tap >= 0) ? *(const u32x4*)(lx + (size_t)(tb - 3 + tap) * 1024 + c8) : (u32x4){0u, 0u, 0u, 0u};
        }
        f32x4 a0 = *(const f32x4*)(cb + c8), a1 = *(const f32x4*)(cb + c8 + 4), b0 = a0, b1 = a1;
#pragma unroll
        for (int tap = 0; tap < 4; ++tap) {
            const f32x4 w0 = *(const f32x4*)(cw + tap * 1024 + c8), w1 = *(const f32x4*)(cw + tap * 1024 + c8 + 4);
            a0 += bf4_lo((u32x2){wa[tap].x, wa[tap].y}) * w0; a1 += bf4_lo((u32x2){wa[tap].z, wa[tap].w}) * w1;
            b0 += bf4_lo((u32x2){wb[tap].x, wb[tap].y}) * w0; b1 += bf4_lo((u32x2){wb[tap].z, wb[tap].w}) * w1;
        }
        *(u32x4*)(lin + (size_t)ta * 1024 + c8) = pack8(a0, a1);
        if (hasb) *(u32x4*)(lin + (size_t)tb * 1024 + c8) = pack8(b0, b1);
    }
}
__device__ __forceinline__ void scan_finish(const bf16* hloc, const bf16* pcum, const float* agg, const bf16* gl, bf16* rec, int vcu, int G, int tid) {
    const int c8 = (tid & 127) * 8, rg = tid >> 7;
    for (int chunk = vcu; chunk < T_ / 64; chunk += G) {
        const int ci = chunk & 31, cb = chunk - ci;
        float carry[8];
#pragma unroll
        for (int j = 0; j < 8; ++j) carry[j] = 0.f;
#pragma unroll 4
        for (int cc = 0; cc < ci; ++cc) {
            const f32x4* ap = (const f32x4*)(agg + ((size_t)(cb + cc) * 1024 + c8) * 2);
#pragma unroll
            for (int q = 0; q < 4; ++q) { const f32x4 v = ap[q]; carry[2 * q] = fmaf(v[0], carry[2 * q], v[1]); carry[2 * q + 1] = fmaf(v[2], carry[2 * q + 1], v[3]); }
        }
#pragma unroll 8
        for (int rr = 0; rr < 16; ++rr) {
            const size_t o = (size_t)(chunk * 64 + rg + 4 * rr) * 1024 + c8;
            const u32x4 hw = *(const u32x4*)(hloc + o), pw = *(const u32x4*)(pcum + o), gw = *(const u32x4*)(gl + o);
            const f32x4 h0 = bf4_lo((u32x2){hw.x, hw.y}), h1 = bf4_lo((u32x2){hw.z, hw.w}), p0 = bf4_lo((u32x2){pw.x, pw.y}), p1 = bf4_lo((u32x2){pw.z, pw.w});
            const f32x4 g0 = bf4_lo((u32x2){gw.x, gw.y}), g1 = bf4_lo((u32x2){gw.z, gw.w});
            f32x4 r0, r1;
#pragma unroll
            for (int j = 0; j < 4; ++j) { r0[j] = fmaf(p0[j], carry[j], h0[j]) * g0[j]; r1[j] = fmaf(p1[j], carry[4 + j], h1[j]) * g1[j]; }
            *(u32x4*)(rec + o) = pack8(r0, r1);
        }
    }
}
__device__ __forceinline__ void uv_convert(const float* pu, const float* pv, const float* gffn, unsigned char* u8, unsigned char* v8, float* iu, float* iv, int gw, int NGW, int lane) {
    f32x4 g[4];
#pragma unroll
    for (int j = 0; j < 4; ++j) g[j] = ((const f32x4*)gffn)[4 * lane + j];
    for (int e0 = gw; e0 < 2 * 16384; e0 += 2 * NGW) {
        f32x4 v[2][4];
#pragma unroll
        for (int h = 0; h < 2; ++h) { const int e = e0 + h * NGW; const bool isv = e >= 16384; const int row = isv ? e - 16384 : e;
            const f32x4* src = (const f32x4*)((isv ? pv : pu) + (size_t)row * 1024) + 4 * lane;
#pragma unroll
            for (int j = 0; j < 4; ++j) v[h][j] = src[j]; }
#pragma unroll
        for (int h = 0; h < 2; ++h) {
            const int e = e0 + h * NGW; const bool isv = e >= 16384; const int row = isv ? e - 16384 : e;
            float am = 0.f;
#pragma unroll
            for (int j = 0; j < 4; ++j) { if (!isv) v[h][j] = v[h][j] * g[j]; am = fmaxf(am, fmaxf(fmaxf(fabsf(v[h][j][0]), fabsf(v[h][j][1])), fmaxf(fabsf(v[h][j][2]), fabsf(v[h][j][3])))); }
#pragma unroll
            for (int o = 1; o < 64; o <<= 1) am = fmaxf(am, __shfl_xor(am, o));
            const float sc = am > 0.f ? (isv ? 416.0f : 127.0f) / am : 1.0f;
            u32x4 w;
            if (isv) {
#pragma unroll
                for (int j = 0; j < 4; ++j) { unsigned ww = 0u; ww = __builtin_amdgcn_cvt_pk_fp8_f32(v[h][j][0] * sc, v[h][j][1] * sc, ww, false); ww = __builtin_amdgcn_cvt_pk_fp8_f32(v[h][j][2] * sc, v[h][j][3] * sc, ww, true); w[j] = ww; }
            } else {
#pragma unroll
                for (int j = 0; j < 4; ++j) { unsigned ww = 0u;
#pragma unroll
                    for (int c = 0; c < 4; ++c) ww |= ((unsigned)(int)__builtin_rintf(v[h][j][c] * sc) & 0xffu) << (8 * c);
                    w[j] = ww; }
            }
            *(u32x4*)((isv ? v8 : u8) + (size_t)row * 1024 + 16 * lane) = w;
            if (lane == 0) (isv ? iv : iu)[row] = 1.0f / sc;
        }
    }
}
__device__ __forceinline__ void final_rows(float* h, const bf16* h3b, const float* part, const float* fg, int gw, int NGW, int lane, float tscale) {
    f32x4 g[4];
#pragma unroll
    for (int j = 0; j < 4; ++j) g[j] = ((const f32x4*)fg)[lane + 64 * j];
    for (int r0 = gw; r0 < T_; r0 += 2 * NGW) {
        const int r1 = (r0 + NGW < T_) ? r0 + NGW : r0;
        float pa = (lane < 16) ? part[(size_t)r0 * 16 + lane] : 0.f, pb = (lane < 16) ? part[(size_t)r1 * 16 + lane] : 0.f;
#if ALL_FUSED
        const u32x2* ba = (const u32x2*)(h3b + (size_t)r0 * 1024) + lane; const u32x2* bb = (const u32x2*)(h3b + (size_t)r1 * 1024) + lane;
        u32x2 wa[4], wb[4];
#pragma unroll
        for (int j = 0; j < 4; ++j) { wa[j] = ba[64 * j]; wb[j] = bb[64 * j]; }
#endif
#pragma unroll
        for (int o = 1; o < 64; o <<= 1) { pa += __shfl_xor(pa, o); pb += __shfl_xor(pb, o); }
        const float ra = tscale / sqrtf(pa * (1.0f / 1024.0f) + EPS), rb = tscale / sqrtf(pb * (1.0f / 1024.0f) + EPS);
        f32x4* ha = (f32x4*)(h + (size_t)r0 * 1024) + lane; f32x4* hb = (f32x4*)(h + (size_t)r1 * 1024) + lane;
#if ALL_FUSED
#pragma unroll
        for (int j = 0; j < 4; ++j) ha[64 * j] = bf4_lo(wa[j]) * ra * g[j];
        if (r1 != r0) {
#pragma unroll
            for (int j = 0; j < 4; ++j) hb[64 * j] = bf4_lo(wb[j]) * rb * g[j];
        }
#else
#pragma unroll
        for (int j = 0; j < 4; ++j) ha[64 * j] = ha[64 * j] * ra * g[j];
        if (r1 != r0) {
#pragma unroll
            for (int j = 0; j < 4; ++j) hb[64 * j] = hb[64 * j] * rb * g[j];
        }
#endif
    }
}

constexpr int N_PHASES = 16;
struct Args { const float* in[25]; float* out; unsigned char* ws; int ph_lo, ph_hi, li, pad; };
__global__ void __launch_bounds__(NWAVES * 64, 2) __attribute__((target("no-packed-fp32-ops"))) fused_fwd(Args args) {
    extern __shared__ __attribute__((aligned(16))) unsigned char lds_raw[];
    LAS unsigned char* lds = (LAS unsigned char*)lds_raw;
    volatile LAS unsigned* MISC = (volatile LAS unsigned*)(lds + LDSCTL_OFF);
    const int wave = __builtin_amdgcn_readfirstlane((int)threadIdx.x >> 6);
#define FRESH_TID() (wave * 64 + fresh_lane())
#define FRESH_LANE() fresh_lane()
    const int G = gridDim.x; const int bx = blockIdx.x; const int vcu = (G % 8 == 0) ? (bx % 8) * (G / 8) + bx / 8 : bx;
    unsigned char* ws = args.ws; float* out = args.out;
    In in;
#pragma unroll
    for (int i = 0; i < 25; ++i) in.p[i] = args.in[i];
    for (int u = FRESH_TID(); u < (LDS_BYTES - LDSCTL_OFF) / 4; u += NWAVES * 64) ((LAS unsigned*)(lds + LDSCTL_OFF))[u] = 0u;
    __syncthreads();
    (void)xcd_barrier_post((unsigned*)(ws + WS_CTL) + CW_BAR + args.li * XCD_BAR_WORDS, MISC + 8);
    const int lo = args.ph_lo, hi = args.ph_hi;
    const int gw = vcu * NWAVES + wave, NGW = G * NWAVES;
#ifndef PH_DISABLE
#define PH_DISABLE 0
#endif
#if ALL_FUSED
#define IN(k) (!((PH_DISABLE >> (k)) & 1))
#else
#define IN(k) (lo <= (k) && (k) < hi && !((PH_DISABLE >> (k)) & 1))
#endif
#ifdef TIMING_A
#define STAMP(i) do { if (bx == 0 && FRESH_TID() == 0) __hip_atomic_store((unsigned long long*)(ws + WS_CTL + 512) + (i), __builtin_amdgcn_s_memrealtime(), __ATOMIC_RELAXED, __HIP_MEMORY_SCOPE_AGENT); } while (0)
#else
#define STAMP(i) do { } while (0)
#endif
#define SEAM(k) do { if (IN(k) && IN((k) + 1)) { XcdBarrier b_; b_.bar = (unsigned*)(args.ws + WS_CTL) + CW_BAR + args.li * XCD_BAR_WORDS; b_.x = xb_xcc_id(); b_.st = (volatile LAS unsigned*)(lds + LDSCTL_OFF) + 8;     \
        xcd_barrier(b_); STAMP((k) + 1); } } while (0)
#if ALL_FUSED
#define PP_OFF WS_PP2
#define MP_PTR out
#else
#define PP_OFF WS_PP
#define MP_PTR ((float*)(ws + WS_MP))
#endif
#define GEMM_PHASE(EPI, Aptr, Bptr, Kdim, LDA, M_, N_, SH, STR, ...) do { \
        pg8::Gemm g{(const pg8::bf16_t*)(Aptr), (const pg8::bf16_t*)(Bptr), Kdim, LDA, SH, STR}; pg8::StaticOrder S; S.init(M_, N_, G, (int)blockIdx.x); \
        EPI E{__VA_ARGS__}; pg8::gemm_phase<EPI, pg8::StaticOrder, true, true>(lds, g, S, E, wave); } while (0)

    STAMP(0);
    if (IN(0)) { p0_prologue(in, ws, lds, vcu, G, wave, FRESH_TID()); } SEAM(0);
    if (IN(1)) { GEMM_PHASE(EpiProj, ws + WS_R0, ws + WS_WIN, 1024, 1024, T_, INW, 0, 0, (const float*)(ws + WS_RSTD1), ws); } SEAM(1);
    if (IN(2)) {
        for (int it = bx; it < 256; it += G) attn_item(lds, (const bf16*)(ws + WS_QKV), in.p[I_SINK], (bf16*)(ws + WS_ATT), it, wave, FRESH_TID());
        conv_items((const bf16*)(ws + WS_LX), in.p[I_CONVW], in.p[I_CONVB], (bf16*)(ws + WS_R0), vcu, G, FRESH_TID());
    } SEAM(2);
#if LRU_PADDED == 2
    if (IN(3)) { GEMM_PHASE(EpiLru, ws + WS_R0, ws + WS_WAX, 128, 1024, T_, 2048, 0, 128,
#elif LRU_PADDED
    if (IN(3)) { GEMM_PHASE(EpiLru, ws + WS_R0, ws + WS_WAX, 256, 1024, T_, 2048, 1, 256,
#else
    if (IN(3)) { GEMM_PHASE(EpiLru, ws + WS_R0, ws + WS_WAXD, 1024, 1024, T_, 2048, 0, 0,
#endif
        (const bf16*)(ws + WS_R0), in.p[I_BA], in.p[I_BX], (const float*)(ws + WS_C8), (bf16*)(ws + WS_HLOC), (bf16*)(ws + WS_PCUM), (float*)(ws + WS_AGG)); }
    SEAM(3);
    if (IN(4)) { scan_finish((const bf16*)(ws + WS_HLOC), (const bf16*)(ws + WS_PCUM), (const float*)(ws + WS_AGG), (const bf16*)(ws + WS_GL), (bf16*)(ws + WS_R0), vcu, G, FRESH_TID()); }
#if !ALL_FUSED
    SEAM(4);
#endif
    if (IN(5)) { GEMM_PHASE(EpiMP, ws + WS_ATT, ws + WS_WUA, 512, 512, T_, 1024, 0, 0, (const bf16*)(ws + WS_SGA), MP_PTR); } SEAM(5);
    if (IN(6)) { GEMM_PHASE(EpiMerged, ws + WS_R0, ws + WS_WUL, 1024, 1024, T_, 1024, 0, 0, (const bf16*)(ws + WS_SGL), (const float*)MP_PTR, (bf16*)(ws + WS_MERGED)); } SEAM(6);
    if (IN(7)) { GEMM_PHASE(EpiH1, ws + WS_MERGED, ws + WS_WO, 1024, 1024, T_, 1024, 0, 0, in.p[I_X], out, (bf16*)(ws + WS_R0), (float*)(ws + WS_PART2)); }
#if ALL_FUSED
    if (IN(13)) { GEMM_PHASE(EpiPP, ws + WS_PB, ws + WS_WPROJ, 256, 256, T_, 1024, 0, 0, (bf16*)(ws + WS_PP2)); }
#endif
    SEAM(7);
#define PEER_HALF(half) do { \
        if (IN(8 + 2 * (half))) { GEMM_PHASE(EpiScore, ws + WS_R0, ws + WS_WFOLD + (size_t)(half) * 1024 * 1024 * 2, 1024, 1024, T_, 1024, 0, 0, (const float*)(ws + WS_PART2), (float*)(ws + WS_SC)); } SEAM(8 + 2 * (half)); \
        if (IN(9 + 2 * (half))) { \
            for (int it = vcu; it < T_ / TK_TOK; it += G) topk_item((LAS float*)lds, (const float*)(ws + WS_SC), it, (half) * 4, (int*)(ws + WS_SELI), (float*)(ws + WS_SELG), FRESH_TID()); \
            if ((half) == 0) uv_convert(in.p[I_U], in.p[I_V], in.p[I_GFFN], ws + WS_U16, ws + WS_U16 + 16 * MiB, (float*)(ws + WS_USCALE), (float*)(ws + WS_USCALE) + 16384, gw, NGW, FRESH_LANE()); \
        } SEAM(9 + 2 * (half)); } while (0)
#if ALL_FUSED
    if (IN(8)) {
        for (int kk = 0; kk < 2; ++kk) { pg8::Gemm g{(const pg8::bf16_t*)(ws + WS_R0), (const pg8::bf16_t*)(ws + WS_WFOLD), 1024, 1024, 0, 0}; OneUnit S; S.S.init(T_, 2048, G, (int)blockIdx.x); S.k = kk;
            EpiTopk E{(const float*)(ws + WS_PART2), (int*)(ws + WS_SELI), (float*)(ws + WS_SELG)}; pg8::gemm_phase<EpiTopk, OneUnit, false, true>(lds, g, S, E, wave); }
        uv_convert(in.p[I_U], in.p[I_V], in.p[I_GFFN], ws + WS_U16, ws + WS_U16 + 16 * MiB, (float*)(ws + WS_USCALE), (float*)(ws + WS_USCALE) + 16384, gw, NGW, FRESH_LANE());
    } SEAM(11);
#else
    PEER_HALF(0);
    PEER_HALF(1);
#endif
    if (IN(12)) {
#ifdef PROBE_MODE
        for (int tok0 = vcu * 64; tok0 < T_; tok0 += G * 64)
#if GATHER_ROWS == 1
            gather_wg_rows<PROBE_MODE>(tok0, wave, FRESH_LANE(), lds, ws + WS_U16, ws + WS_U16 + 16 * MiB, (const float*)(ws + WS_USCALE), (const float*)(ws + WS_USCALE) + 16384, (const int*)(ws + WS_SELI), (const float*)(ws + WS_SELG), (const float*)(ws + WS_PART2), (const bf16*)(ws + WS_R0), (bf16*)(ws + WS_H2B), (float*)(ws + WS_RSTD3), (float*)(ws + WS_SC));
#else
            gather_wg_sliced<PROBE_MODE>(tok0, wave, FRESH_LANE(), lds, ws + WS_U16, ws + WS_U16 + 16 * MiB, (const float*)(ws + WS_USCALE), (const float*)(ws + WS_USCALE) + 16384, (const int*)(ws + WS_SELI), (const float*)(ws + WS_SELG), (const float*)(ws + WS_PART2), out, (const bf16*)(ws + WS_R0), (bf16*)(ws + WS_H2B), (float*)(ws + WS_RSTD3), (float*)(ws + WS_SC));
#endif
        { XcdBarrier b_; b_.bar = (unsigned*)(args.ws + WS_CTL) + CW_BAR + args.li * XCD_BAR_WORDS; b_.x = xb_xcc_id(); b_.st = (volatile LAS unsigned*)(lds + LDSCTL_OFF) + 8; xcd_barrier(b_); STAMP(16); }
#endif
        for (int tok0 = vcu * 64; tok0 < T_; tok0 += G * 64)
#if GATHER_ROWS == 1
            gather_wg_rows<0>(tok0, wave, FRESH_LANE(), lds, ws + WS_U16, ws + WS_U16 + 16 * MiB, (const float*)(ws + WS_USCALE), (const float*)(ws + WS_USCALE) + 16384, (const int*)(ws + WS_SELI), (const float*)(ws + WS_SELG), (const float*)(ws + WS_PART2), (const bf16*)(ws + WS_R0), (bf16*)(ws + WS_H2B), (float*)(ws + WS_RSTD3), nullptr);
#else
            gather_wg_sliced<0>(tok0, wave, FRESH_LANE(), lds, ws + WS_U16, ws + WS_U16 + 16 * MiB, (const float*)(ws + WS_USCALE), (const float*)(ws + WS_USCALE) + 16384, (const int*)(ws + WS_SELI), (const float*)(ws + WS_SELG), (const float*)(ws + WS_PART2), out, (const bf16*)(ws + WS_R0), (bf16*)(ws + WS_H2B), (float*)(ws + WS_RSTD3), nullptr);
#endif
    } SEAM(12);
#if !ALL_FUSED
    if (IN(13)) { GEMM_PHASE(EpiPP, ws + WS_PB, ws + WS_WPROJ, 256, 256, T_, 1024, 0, 0, (bf16*)(ws + WS_PP)); } SEAM(13);
#endif
#if ALL_FUSED && FUSE_FINAL
    if (IN(14)) { GEMM_PHASE(EpiH3Final, ws + WS_H2B, ws + WS_WG, 1024, 1024, T_, 1024, 0, 0, (const float*)(ws + WS_RSTD3), (const bf16*)(ws + PP_OFF), (const bf16*)(ws + WS_H2B), in.p[I_FG], out, (float*)(ws + WS_PART4), (unsigned*)(ws + WS_CTL) + 65536); }
#else
    if (IN(14)) { GEMM_PHASE(EpiH3, ws + WS_H2B, ws + WS_WG, 1024, 1024, T_, 1024, 0, 0, (const float*)(ws + WS_RSTD3), (const bf16*)(ws + PP_OFF), out, (float*)(ws + WS_PART4), (const bf16*)(ws + WS_H2B), (bf16*)(ws + WS_R0)); } SEAM(14);
#ifdef TIMING_A
    float tscale = 1.0f;
    { const unsigned long long ta = __hip_atomic_load((unsigned long long*)(ws + WS_CTL + 512) + TIMING_A, __ATOMIC_RELAXED, __HIP_MEMORY_SCOPE_AGENT), tb = __hip_atomic_load((unsigned long long*)(ws + WS_CTL + 512) + TIMING_B, __ATOMIC_RELAXED, __HIP_MEMORY_SCOPE_AGENT);
      tscale = 1.0f + (float)(tb - ta) * 0.01f * (float)(TIMING_K); }
    if (IN(15)) { final_rows(out, (const bf16*)(ws + WS_R0), (const float*)(ws + WS_PART4), in.p[I_FG], gw, NGW, FRESH_LANE(), tscale); }
#else
    if (IN(15)) { final_rows(out, (const bf16*)(ws + WS_R0), (const float*)(ws + WS_PART4), in.p[I_FG], gw, NGW, FRESH_LANE(), 1.0f); }
#endif
#endif
#undef IN
#undef SEAM
#undef GEMM_PHASE
}
static const int GRP_LO[11] = {0, 2, 3, 5, 6, 7, 8, 12, 13, 14, 15};
static const int GRP_HI[11] = {2, 3, 5, 6, 7, 8, 12, 13, 14, 15, 16};

static void naive_group(int grp, void* const* d_in, float* out, unsigned char* ws, hipStream_t st) {
    const float* x = (const float*)d_in[0]; const float* p = (const float*)d_in[1]; const float* g_mix = (const float*)d_in[2]; const float* w_in = (const float*)d_in[3];
    const float* sink = (const float*)d_in[4]; const float* conv_w = (const float*)d_in[5]; const float* conv_b = (const float*)d_in[6];
    const float* wa = (const float*)d_in[7]; const float* ba = (const float*)d_in[8]; const float* wx = (const float*)d_in[9]; const float* bx = (const float*)d_in[10]; const float* lam = (const float*)d_in[11];
    const float* w_ua = (const float*)d_in[12]; const float* w_ul = (const float*)d_in[13]; const float* w_o = (const float*)d_in[14]; const float* g_ffn = (const float*)d_in[15];
    const float* wq = (const float*)d_in[16]; const float* k1 = (const float*)d_in[17]; const float* k2 = (const float*)d_in[18]; const float* pu = (const float*)d_in[19]; const float* pv = (const float*)d_in[20];
    const float* g_ple = (const float*)d_in[21]; const float* w_gate = (const float*)d_in[22]; const float* w_proj = (const float*)d_in[23]; const float* final_g = (const float*)d_in[24];
    float* rstd1 = (float*)(ws + WS_RSTD1); float* part2 = (float*)(ws + WS_PART2); float* part4 = (float*)(ws + WS_PART4); float* rstd3 = (float*)(ws + WS_RSTD3);
    bf16* qkv = (bf16*)(ws + WS_QKV); bf16* lx = (bf16*)(ws + WS_LX); bf16* gl = (bf16*)(ws + WS_GL); bf16* sga = (bf16*)(ws + WS_SGA); bf16* sgl = (bf16*)(ws + WS_SGL);
    bf16* att = (bf16*)(ws + WS_ATT); bf16* r0 = (bf16*)(ws + WS_R0); float* mp = (float*)(ws + WS_MP); bf16* merged = (bf16*)(ws + WS_MERGED);
    float* sc = (float*)(ws + WS_SC); int* seli = (int*)(ws + WS_SELI); float* selg = (float*)(ws + WS_SELG); bf16* h2b = (bf16*)(ws + WS_H2B); bf16* pp = (bf16*)(ws + WS_PP);
    float* tmpf = (float*)(ws + WS_NAIVE_AB);
    switch (grp) {
    case 0:
        hipLaunchKernelGGL(nv::rowsq, dim3(T_ / 4), dim3(256), 0, st, x, rstd1, (float*)nullptr);
        nv::run_gemm<nv::ALf32, nv::EpiProj, false>(st, nv::ALf32{x, 1024}, w_in, INW, g_mix, T_, INW, 1024, nv::EpiProj{rstd1, qkv, lx, gl, sga, sgl});
        break;
    case 1:
        hipLaunchKernelGGL(nv::attn_naive, dim3(T_ * 8 / 128), dim3(128), 0, st, qkv, sink, att);
        hipLaunchKernelGGL(nv::conv_naive, dim3(T_ * 1024 / 256), dim3(256), 0, st, lx, conv_w, conv_b, r0);
        break;
    case 2:
        hipLaunchKernelGGL(nv::lru_ab_naive, dim3(T_ * 8), dim3(128), 0, st, r0, wa, ba, wx, bx, lam, out, tmpf);
        hipLaunchKernelGGL(nv::lru_scan_naive, dim3(B_ * 1024 / 64), dim3(64), 0, st, out, tmpf, gl, r0);
        break;
    case 3: nv::run_gemm<nv::ALbf16, nv::EpiMP, false>(st, nv::ALbf16{att, 512}, w_ua, 1024, nullptr, T_, 1024, 512, nv::EpiMP{sga, mp}); break;
    case 4: nv::run_gemm<nv::ALbf16, nv::EpiMerged, false>(st, nv::ALbf16{r0, 1024}, w_ul, 1024, nullptr, T_, 1024, 1024, nv::EpiMerged{sgl, mp, merged}); break;
    case 5:
        nv::run_gemm<nv::ALbf16, nv::EpiH1, false>(st, nv::ALbf16{merged, 1024}, w_o, 1024, nullptr, T_, 1024, 1024, nv::EpiH1{x, out, r0});
        hipLaunchKernelGGL(nv::rowsq, dim3(T_ / 4), dim3(256), 0, st, out, (float*)nullptr, part2);
        break;
    case 6:
        for (int half = 0; half < 2; ++half) {
            nv::run_gemm<nv::ALf32, nv::EpiScaleF32, false>(st, nv::ALf32{out, 1024}, wq + half * 1024, 2048, g_ffn, T_, 1024, 1024, nv::EpiScaleF32{part2, tmpf, 1024});
            for (int hl = 0; hl < 4; ++hl)
                for (int hf = 0; hf < 2; ++hf)
                    nv::run_gemm<nv::ALf32, nv::EpiPlainF32, true>(st, nv::ALf32{tmpf + hl * 256 + hf * 128, 1024}, hf ? k2 : k1, 128, nullptr, T_, 128, 128, nv::EpiPlainF32{sc + hl * 256 + hf * 128, 1024});
            hipLaunchKernelGGL(topk_kernel, dim3(T_ / TK_TOK), dim3(512), TK_LDS_BYTES, st, sc, half * 4, seli, selg);
        }
        break;
    case 7: hipLaunchKernelGGL(gather_kernel<0>, dim3(1024), dim3(256), 0, st, (const void*)pu, (const void*)pv, g_ffn, seli, selg, part2, out, h2b, rstd3); break;
    case 8: nv::run_gemm<nv::ALf32, nv::EpiPP, false>(st, nv::ALf32{p, 256}, w_proj, 1024, nullptr, T_, 1024, 256, nv::EpiPP{pp}); break;
    case 9: nv::run_gemm<nv::ALbf16, nv::EpiH3, false>(st, nv::ALbf16{h2b, 1024}, w_gate, 1024, g_ple, T_, 1024, 1024, nv::EpiH3{rstd3, pp, out});
        hipLaunchKernelGGL(nv::rowsq, dim3(T_ / 4), dim3(256), 0, st, out, (float*)nullptr, part4);
        break;
    case 10: hipLaunchKernelGGL(nv::final_norm, dim3(T_ / 4), dim3(256), 0, st, out, part4, final_g); break;
    }
}

extern "C" void kernel_launch(void* const* d_in, const int* in_sizes, int n_in, void* d_out, int out_size, void* d_ws, size_t ws_size, hipStream_t stream) {
    static int grid = 0;
    if (grid == 0) {
        if (n_in != 25 || out_size != T_ * 1024 || ws_size < WS_END) { fprintf(stderr, "kernel_launch: unexpected sizes n_in %d out %d ws %zu\n", n_in, out_size, ws_size); }
        (void)hipFuncSetAttribute((const void*)topk_kernel, hipFuncAttributeMaxDynamicSharedMemorySize, TK_LDS_BYTES);
        int dev = 0, cus = 0, per_cu = 0;
        (void)hipGetDevice(&dev); (void)hipDeviceGetAttribute(&cus, hipDeviceAttributeMultiprocessorCount, dev);
        if (hipFuncSetAttribute((const void*)fused_fwd, hipFuncAttributeMaxDynamicSharedMemorySize, LDS_BYTES) != hipSuccess) fprintf(stderr, "kernel_launch: hipFuncSetAttribute(fused_fwd) failed\n");
        if (hipOccupancyMaxActiveBlocksPerMultiprocessor(&per_cu, (const void*)fused_fwd, NWAVES * 64, LDS_BYTES) != hipSuccess || per_cu < 1) fprintf(stderr, "kernel_launch: occupancy query says %d blocks/CU\n", per_cu);
        (void)hipGetLastError();
        grid = cus > 0 ? cus : 256;
    }
    unsigned char* ws = (unsigned char*)d_ws; float* out = (float*)d_out;
    const unsigned mask = FUSED_MASK;
    if (mask) (void)hipMemsetAsync(ws + WS_CTL, 0, CTL_ZERO_BYTES, stream);
    Args a{};
    for (int i = 0; i < 25; ++i) a.in[i] = (const float*)d_in[i];
    a.out = out; a.ws = ws;
    int li = 0;
    auto launch = [&](int lo, int hi) {
        if (MERGE_LAUNCHES) { a.ph_lo = lo; a.ph_hi = hi; a.li = li++; hipLaunchKernelGGL(fused_fwd, dim3(grid), dim3(NWAVES * 64), LDS_BYTES, stream, a); }
        else for (int ph = lo; ph < hi; ++ph) { a.ph_lo = ph; a.ph_hi = ph + 1; a.li = li++; hipLaunchKernelGGL(fused_fwd, dim3(grid), dim3(NWAVES * 64), LDS_BYTES, stream, a); }
    };
    int pend_lo = -1, pend_hi = -1;
    if (mask && !(mask & 1)) launch(0, 1);
    for (int gidx = 0; gidx < 11; ++gidx) {
#if (defined(LRU_T2) && LRU_T2) || (defined(LRU_T3) && LRU_T3)
        if (gidx == 2 && (mask & 4u)) {
            if (pend_lo >= 0) { launch(pend_lo, pend_hi); pend_lo = -1; }
            launch(3, 4);
            hipLaunchKernelGGL(nv::lru_finish_naive_L<(LRU_T2 ? 16 : 64)>, dim3(B_ * 1024 / 64), dim3(64), 0, stream, (const bf16*)(ws + WS_HLOC), (const bf16*)(ws + WS_PCUM), (const bf16*)(ws + WS_GL), (bf16*)(ws + WS_R0));
            continue;
        }
#endif
        if (mask & (1u << gidx)) {
            if (pend_lo < 0) { pend_lo = GRP_LO[gidx]; pend_hi = GRP_HI[gidx]; } else pend_hi = GRP_HI[gidx];
        } else {
            if (pend_lo >= 0) { launch(pend_lo, pend_hi); pend_lo = -1; }
            naive_group(gidx, d_in, out, ws, stream);
        }
    }
    if (pend_lo >= 0) launch(pend_lo, pend_hi);
#if defined(LRU_DEBUG) && LRU_DEBUG == 2
    hipLaunchKernelGGL(nv::poison_if, dim3(T_ * 1024 / 256), dim3(256), 0, stream, out, (const unsigned*)(ws + WS_CTL) + 64);
#endif
}
```

```cpp
#include <hip/hip_runtime.h>
#include <cstdio>
#include <cstdint>
#include <cmath>

#ifndef FUSED_MASK
#define FUSED_MASK 0x7ff
#endif
#ifndef MERGE_LAUNCHES
#define MERGE_LAUNCHES 1
#endif
#ifndef LRU_PADDED
#define LRU_PADDED 1
#endif
#ifndef FUSE_FINAL
#define FUSE_FINAL 0
#endif
#ifndef GATHER_ROWS
#define GATHER_ROWS 3
#endif
#define ALL_FUSED ((FUSED_MASK) == 0x7ff && (MERGE_LAUNCHES))
constexpr int B_ = 8, S_ = 2048, D_ = 1024, T_ = B_ * S_;
constexpr int INW = 4864;
constexpr float EPS = 1e-6f;
typedef unsigned short bf16;
#define HD_INLINE __host__ __device__ __forceinline__

constexpr size_t MiB = 1u << 20;
constexpr size_t WS_CTL = 0;
constexpr size_t WS_WIN = 1 * MiB;
constexpr size_t WS_WUA = WS_WIN + 4864 * 1024 * 2;
constexpr size_t WS_WUL = WS_WUA + 1 * MiB;
constexpr size_t WS_WO = WS_WUL + 2 * MiB;
constexpr size_t WS_WFOLD = WS_WO + 2 * MiB;
constexpr size_t WS_WG = WS_WFOLD + 4 * MiB;
constexpr size_t WS_WPROJ = WS_WG + 2 * MiB;
constexpr size_t WS_WAX = WS_WPROJ + MiB / 2;
constexpr size_t WS_W_END = WS_WAX + 1 * MiB;
static_assert(WS_W_END <= 23 * MiB, "weights");
constexpr size_t WS_RSTD1 = 23 * MiB;
constexpr size_t WS_PART2 = WS_RSTD1 + 256 * 1024;
constexpr size_t WS_PART4 = WS_PART2 + 1 * MiB;
constexpr size_t WS_RSTD3 = WS_PART4 + 1 * MiB;
constexpr size_t WS_AGG = WS_RSTD3 + 256 * 1024;
constexpr size_t WS_C8 = WS_AGG + 2 * MiB;
constexpr size_t WS_USCALE = WS_C8 + 64 * 1024;
static_assert(WS_USCALE + 128 * 1024 <= 28 * MiB, "small");
constexpr size_t WS_PB = 28 * MiB;
constexpr size_t WS_R0 = 36 * MiB;
constexpr size_t WS_QKV = 68 * MiB;
constexpr size_t WS_LX = 92 * MiB;
constexpr size_t WS_GL = 140 * MiB;
constexpr size_t WS_SGA = 172 * MiB;
constexpr size_t WS_SGL = 204 * MiB;
constexpr size_t WS_ATT = 236 * MiB;
constexpr size_t WS_HLOC = 68 * MiB, WS_PCUM = 100 * MiB;
constexpr size_t WS_MP = 68 * MiB;
constexpr size_t WS_MERGED = 140 * MiB;
constexpr size_t WS_SC = 172 * MiB;
constexpr size_t WS_SELI = 236 * MiB, WS_SELG = 244 * MiB;
constexpr size_t WS_U16 = 68 * MiB, WS_V16 = 100 * MiB;
constexpr size_t WS_H2B = 140 * MiB;
constexpr size_t WS_PP = 172 * MiB;
constexpr size_t WS_PP2 = 100 * MiB;
constexpr size_t WS_NAIVE_AB = 68 * MiB;
constexpr size_t WS_WAXD = 252 * MiB;
constexpr size_t WS_END = 256 * MiB;

HD_INLINE float bf2f(bf16 v) { return __builtin_bit_cast(float, (unsigned)v << 16); }
HD_INLINE bf16 f2bf(float f) { unsigned u = __builtin_bit_cast(unsigned, f); return (bf16)((u + 0x7fffu + ((u >> 16) & 1u)) >> 16); }
HD_INLINE unsigned pk2(float lo, float hi) { return (unsigned)f2bf(lo) | ((unsigned)f2bf(hi) << 16); }
__device__ __forceinline__ float wave_sum(float v) {
#pragma unroll
    for (int o = 1; o < 64; o <<= 1) v += __shfl_xor(v, o);
    return v;
}
__device__ __forceinline__ float sigmoidf_(float z) { return __builtin_amdgcn_rcpf(1.0f + __builtin_amdgcn_exp2f(-1.4426950408889634f * z)); }
__device__ __forceinline__ float gelu_tanh(float x) { const float u = 1.5957691216057308f * (x + 0.044715f * x * x * x); return x * sigmoidf_(u); }
__device__ __forceinline__ int fresh_lane() { int l; asm volatile("v_mbcnt_lo_u32_b32 %0, -1, 0\n\tv_mbcnt_hi_u32_b32 %0, -1, %0" : "=v"(l)); return l; }
#ifndef HD_INLINE
#define HD_INLINE __host__ __device__ __forceinline__
#endif

HD_INLINE unsigned tk_umax(unsigned a, unsigned b) { return a > b ? a : b; }
HD_INLINE unsigned tk_umin(unsigned a, unsigned b) { return a < b ? a : b; }
HD_INLINE unsigned tk_f2key(float f) { unsigned u = __builtin_bit_cast(unsigned, f); return u ^ ((unsigned)((int)u >> 31) | 0x80000000u); }
HD_INLINE float tk_key2f(unsigned k) { unsigned u = (k & 0x80000000u) ? (k ^ 0x80000000u) : ~k; return __builtin_bit_cast(float, u); }

HD_INLINE void tk_sort16(unsigned (&a)[16]) {
#pragma unroll
    for (int k = 2; k <= 16; k <<= 1) {
#pragma unroll
        for (int j = k >> 1; j > 0; j >>= 1) {
#pragma unroll
            for (int i = 0; i < 16; ++i) {
                const int p = i ^ j;
                if (p > i) {
                    const unsigned mx = tk_umax(a[i], a[p]), mn = tk_umin(a[i], a[p]);
                    if ((i & k) == 0) { a[i] = mx; a[p] = mn; } else { a[i] = mn; a[p] = mx; }
                }
            }
        }
    }
}
HD_INLINE void tk_merge16(unsigned (&a)[16], const unsigned (&b)[16]) {
#pragma unroll
    for (int i = 0; i < 16; ++i) a[i] = tk_umax(a[i], b[15 - i]);
#pragma unroll
    for (int j = 8; j > 0; j >>= 1) {
#pragma unroll
        for (int i = 0; i < 16; ++i) {
            const int p = i ^ j;
            if (p > i) { const unsigned mx = tk_umax(a[i], a[p]), mn = tk_umin(a[i], a[p]); a[i] = mx; a[p] = mn; }
        }
    }
}
HD_INLINE void tk_insert16(unsigned (&best)[16], unsigned key) {
#pragma unroll
    for (int s = 0; s < 16; ++s) { const unsigned hi = tk_umax(best[s], key); key = tk_umin(best[s], key); best[s] = hi; }
}
HD_INLINE void tk_combine_store(const unsigned (&k1)[16], const unsigned (&k2)[16], int* oi, float* og) {
    float v1[16], v2[16];
#pragma unroll
    for (int i = 0; i < 16; ++i) { v1[i] = tk_key2f(k1[i] & ~127u); v2[i] = tk_key2f(k2[i] & ~127u); }
    unsigned best[16];
#pragma unroll
    for (int s = 0; s < 16; ++s) best[s] = 0u;
#pragma unroll
    for (int i = 0; i < 16; ++i) {
#pragma unroll
        for (int j = 0; j < 16; ++j) {
            if ((i + 1) * (j + 1) <= 16) {
                const float s = v1[i] + v2[j];
                const unsigned key = (tk_f2key(s) & ~255u) | (unsigned)(255 - (i * 16 + j));
                tk_insert16(best, key);
            }
        }
    }
    const unsigned thr = best[15];
    const float mx = tk_key2f(best[0] & ~255u);
    float sum = 0.f;
#pragma unroll
    for (int i = 0; i < 16; ++i) {
#pragma unroll
        for (int j = 0; j < 16; ++j) {
            if ((i + 1) * (j + 1) <= 16) {
                const float s = v1[i] + v2[j];
                const unsigned key = (tk_f2key(s) & ~255u) | (unsigned)(255 - (i * 16 + j));
                if (key >= thr) sum += __builtin_expf(s - mx);
            }
        }
    }
    const float inv = 1.0f / sum;
    int cnt = 0;
#pragma unroll
    for (int i = 0; i < 16; ++i) {
#pragma unroll
        for (int j = 0; j < 16; ++j) {
            if ((i + 1) * (j + 1) <= 16) {
                const float s = v1[i] + v2[j];
                const unsigned key = (tk_f2key(s) & ~255u) | (unsigned)(255 - (i * 16 + j));
                if (key >= thr) {
                    oi[cnt] = (127 - (int)(k1[i] & 127u)) * 128 + (127 - (int)(k2[j] & 127u));
                    og[cnt] = __builtin_expf(s - mx) * inv;
                    ++cnt;
                }
            }
        }
    }
}
namespace nv {
struct ALf32 { const float* p; int lda; int pad; __device__ __forceinline__ float operator()(int m, int k) const { return p[(size_t)m * lda + k]; } };
struct ALbf16 { const bf16* p; int lda; int pad; __device__ __forceinline__ float operator()(int m, int k) const { return bf2f(p[(size_t)m * lda + k]); } };

template <class AL, class EPI, bool BT>
__global__ void __launch_bounds__(256) ngemm(AL al, const float* __restrict__ B, int ldb, const float* __restrict__ ks, int M, int N, int K, EPI epi) {
    __shared__ float As[16][68];
    __shared__ float Bs[16][68];
    const int tid = threadIdx.x, tx = tid & 15, ty = tid >> 4;
    const int m0 = blockIdx.y * 64, n0 = blockIdx.x * 64;
    float acc[4][4];
#pragma unroll
    for (int i = 0; i < 4; ++i)
#pragma unroll
        for (int j = 0; j < 4; ++j) acc[i][j] = 0.f;
    for (int k0 = 0; k0 < K; k0 += 16) {
#pragma unroll
        for (int i = 0; i < 4; ++i) {
            const int e = tid + i * 256;
            { const int m = e >> 4, k = e & 15; float v = al(m0 + m, k0 + k); if (ks) v *= ks[k0 + k]; As[k][m] = v; }
            if (BT) { const int n = e >> 4, k = e & 15; Bs[k][n] = B[(size_t)(n0 + n) * ldb + k0 + k]; }
            else { const int k = e >> 6, n = e & 63; Bs[k][n] = B[(size_t)(k0 + k) * ldb + n0 + n]; }
        }
        __syncthreads();
#pragma unroll
        for (int k = 0; k < 16; ++k) {
            float a[4], b[4];
#pragma unroll
            for (int i = 0; i < 4; ++i) { a[i] = As[k][ty * 4 + i]; b[i] = Bs[k][tx * 4 + i]; }
#pragma unroll
            for (int i = 0; i < 4; ++i)
#pragma unroll
                for (int j = 0; j < 4; ++j) acc[i][j] = fmaf(a[i], b[j], acc[i][j]);
        }
        __syncthreads();
    }
#pragma unroll
    for (int i = 0; i < 4; ++i)
#pragma unroll
        for (int j = 0; j < 4; ++j) epi(m0 + ty * 4 + i, n0 + tx * 4 + j, acc[i][j]);
}
template <class AL, class EPI, bool BT>
static void run_gemm(hipStream_t st, AL al, const float* B, int ldb, const float* ks, int M, int N, int K, EPI epi) {
    hipLaunchKernelGGL((ngemm<AL, EPI, BT>), dim3(N / 64, M / 64), dim3(256), 0, st, al, B, ldb, ks, M, N, K, epi);
}

__global__ void __launch_bounds__(256) rowsq(const float* __restrict__ X, float* rstd, float* part) {
    const int row = blockIdx.x * 4 + (threadIdx.x >> 6), lane = threadIdx.x & 63;
    const float* xr = X + (size_t)row * 1024;
    float s = 0.f;
    for (int j = 0; j < 16; ++j) { const float v = xr[lane + 64 * j]; s += v * v; }
    s = wave_sum(s);
    if (rstd && lane == 0) rstd[row] = 1.0f / sqrtf(s * (1.0f / 1024.0f) + EPS);
    if (part && lane < 16) part[(size_t)row * 16 + lane] = (lane == 0) ? s : 0.f;
}

struct EpiProj {
    const float* rstd; bf16 *qkv, *lx, *gl, *sga, *sgl;
    __device__ __forceinline__ void operator()(int m, int n, float v) const {
        v *= rstd[m];
        if (n < 768) qkv[(size_t)m * 768 + n] = f2bf(v);
        else if (n < 1792) lx[(size_t)m * 1024 + (n - 768)] = f2bf(v);
        else if (n < 2816) gl[(size_t)m * 1024 + (n - 1792)] = f2bf(gelu_tanh(v));
        else if (n < 3840) sga[(size_t)m * 1024 + (n - 2816)] = f2bf(sigmoidf_(v));
        else sgl[(size_t)m * 1024 + (n - 3840)] = f2bf(sigmoidf_(v));
    }
};

__global__ void __launch_bounds__(128) attn_naive(const bf16* __restrict__ qkv, const float* __restrict__ sink, bf16* __restrict__ att) {
    const int gid = blockIdx.x * 128 + threadIdx.x;
    const int head = gid / T_, t = gid % T_;
    const int b = t / S_, ts = t % S_;
    const int g = head >> 2;
    float q[64], acc[64];
    const bf16* qp = qkv + (size_t)t * 768 + head * 64;
#pragma unroll
    for (int d = 0; d < 64; ++d) { q[d] = bf2f(qp[d]); acc[d] = 0.f; }
    const float slope = exp2f(-(float)(head + 1));
    float m = -3.0e38f, l = 0.f;
    for (int dist = 127; dist >= 0; --dist) {
        const int s = ts - dist; if (s < 0) continue;
        const bf16* kp = qkv + (size_t)(b * S_ + s) * 768 + 512 + g * 64;
        const bf16* vp = kp + 128;
        float sc = 0.f;
#pragma unroll
        for (int d = 0; d < 64; ++d) sc = fmaf(q[d], bf2f(kp[d]), sc);
        sc = sc * 0.125f - slope * (float)dist;
        const float mn = fmaxf(m, sc), corr = __expf(m - mn), p = __expf(sc - mn);
        l = l * corr + p;
#pragma unroll
        for (int d = 0; d < 64; ++d) acc[d] = acc[d] * corr + p * bf2f(vp[d]);
        m = mn;
    }
    const float sk = sink[head];
    const float mf = fmaxf(m, sk), corr = __expf(m - mf);
    l = l * corr + __expf(sk - mf);
    const float inv = corr / l;
    bf16* op = att + (size_t)t * 512 + head * 64;
#pragma unroll
    for (int d = 0; d < 64; ++d) op[d] = f2bf(acc[d] * inv);
}

__global__ void __launch_bounds__(256) conv_naive(const bf16* __restrict__ lx, const float* __restrict__ cw, const float* __restrict__ cb, bf16* __restrict__ lin) {
    const size_t i = (size_t)blockIdx.x * 256 + threadIdx.x;
    const int c = (int)(i & 1023); const int t = (int)(i >> 10); const int ts = t % S_;
    float y = cb[c];
#pragma unroll
    for (int tap = 0; tap < 4; ++tap) { const int s = ts - 3 + tap; if (s >= 0) y = fmaf(bf2f(lx[(size_t)(t - 3 + tap) * 1024 + c]), cw[tap * 1024 + c], y); }
    lin[i] = f2bf(y);
}

__global__ void __launch_bounds__(128) lru_ab_naive(const bf16* __restrict__ lin, const float* __restrict__ wa, const float* __restrict__ ba, const float* __restrict__ wx, const float* __restrict__ bx,
                                                    const float* __restrict__ lam, float* __restrict__ Af, float* __restrict__ Bf) {
    __shared__ float xs[128];
    const int t = blockIdx.x >> 3, blk = blockIdx.x & 7, d = threadIdx.x, ch = blk * 128 + d;
    xs[d] = bf2f(lin[(size_t)t * 1024 + ch]);
    __syncthreads();
    float r = ba[ch], ii = bx[ch];
    const float* wap = wa + (size_t)blk * 128 * 128 + d; const float* wxp = wx + (size_t)blk * 128 * 128 + d;
    for (int c = 0; c < 128; ++c) { r = fmaf(xs[c], wap[c * 128], r); ii = fmaf(xs[c], wxp[c * 128], ii); }
    r = sigmoidf_(r); ii = sigmoidf_(ii);
    const float sp = log1pf(expf(-lam[ch]));
    const float loga = -8.0f * r * sp;
    const float a = expf(loga);
    const float bb = sqrtf(-expm1f(2.0f * loga)) * (ii * xs[d]);
    Af[(size_t)t * 1024 + ch] = a; Bf[(size_t)t * 1024 + ch] = bb;
}
__global__ void __launch_bounds__(256) lru_ab_from_pre(const bf16* __restrict__ lin, const float* __restrict__ ba, const float* __restrict__ bx, const float* __restrict__ lam, float* __restrict__ Af, float* __restrict__ Bf) {
    const size_t i = (size_t)blockIdx.x * 256 + threadIdx.x; const int ch = (int)(i & 1023);
    const float r = sigmoidf_(Af[i] + ba[ch]), ii = sigmoidf_(Bf[i] + bx[ch]);
    const float loga = -8.0f * r * log1pf(expf(-lam[ch]));
    Af[i] = expf(loga); Bf[i] = sqrtf(-expm1f(2.0f * loga)) * (ii * bf2f(lin[i]));
}
template <int L>
__global__ void __launch_bounds__(64) lru_finish_naive_L(const bf16* __restrict__ hloc, const bf16* __restrict__ pcum, const bf16* __restrict__ gl, bf16* __restrict__ rec) {
    const int gid = blockIdx.x * 64 + threadIdx.x; const int b = gid >> 10, ch = gid & 1023;
    float carry = 0.f;
    for (int c = 0; c < S_ / L; ++c) {
        float la = 1.f, lb = 0.f;
        for (int s = 0; s < L; ++s) { const size_t o = (size_t)(b * S_ + c * L + s) * 1024 + ch; la = bf2f(pcum[o]); lb = bf2f(hloc[o]); const float h = la * carry + lb; rec[o] = f2bf(h * bf2f(gl[o])); }
        carry = la * carry + lb;
    }
}
__global__ void __launch_bounds__(64) lru_finish_naive(const bf16* __restrict__ hloc, const bf16* __restrict__ pcum, const float* __restrict__ agg, const bf16* __restrict__ gl, bf16* __restrict__ rec) {
    const int gid = blockIdx.x * 64 + threadIdx.x; const int b = gid >> 10, ch = gid & 1023;
    float carry = 0.f;
    for (int c = 0; c < 32; ++c) {
        const int chunk = b * 32 + c;
        for (int s = 0; s < 64; ++s) { const size_t o = (size_t)(chunk * 64 + s) * 1024 + ch; const float h = bf2f(pcum[o]) * carry + bf2f(hloc[o]); rec[o] = f2bf(h * bf2f(gl[o])); }
        const float* ap = agg + ((size_t)chunk * 1024 + ch) * 2; carry = ap[0] * carry + ap[1];
    }
}
__global__ void __launch_bounds__(128) lru_pre_check(const bf16* __restrict__ lin, const float* __restrict__ wa, const float* __restrict__ wx, const float* __restrict__ Rp, const float* __restrict__ Ip, unsigned* flag) {
    __shared__ float xs[128];
    const int t = blockIdx.x >> 3, blk = blockIdx.x & 7, d = threadIdx.x, ch = blk * 128 + d;
    xs[d] = bf2f(lin[(size_t)t * 1024 + ch]);
    __syncthreads();
    float r = 0.f, ii = 0.f;
    const float* wap = wa + (size_t)blk * 128 * 128 + d; const float* wxp = wx + (size_t)blk * 128 * 128 + d;
    for (int c = 0; c < 128; ++c) { r = fmaf(xs[c], wap[c * 128], r); ii = fmaf(xs[c], wxp[c * 128], ii); }
    const float dr = fabsf(r - Rp[(size_t)t * 1024 + ch]), di = fabsf(ii - Ip[(size_t)t * 1024 + ch]);
    if (!(dr < 0.08f + 0.03f * fabsf(r)) || !(di < 0.08f + 0.03f * fabsf(ii))) atomicAdd(flag, 1u);
}
__global__ void __launch_bounds__(256) poison_if(float* out, const unsigned* flag) { if (*flag) { const size_t i = (size_t)blockIdx.x * 256 + threadIdx.x; out[i] = out[i] * 50.0f + 3.0f; } }
__global__ void __launch_bounds__(64) lru_scan_naive(const float* __restrict__ Af, const float* __restrict__ Bf, const bf16* __restrict__ gl, bf16* __restrict__ rec) {
    const int gid = blockIdx.x * 64 + threadIdx.x; const int b = gid >> 10, ch = gid & 1023;
    float h = 0.f;
    for (int s = 0; s < S_; ++s) { const size_t o = (size_t)(b * S_ + s) * 1024 + ch; h = fmaf(Af[o], h, Bf[o]); rec[o] = f2bf(h * bf2f(gl[o])); }
}

struct EpiMP { const bf16* sga; float* mp; __device__ __forceinline__ void operator()(int m, int n, float v) const { const size_t o = (size_t)m * 1024 + n; mp[o] = v * bf2f(sga[o]); } };
struct EpiMerged { const bf16* sgl; const float* mp; bf16* merged; __device__ __forceinline__ void operator()(int m, int n, float v) const { const size_t o = (size_t)m * 1024 + n; merged[o] = f2bf(mp[o] + v * bf2f(sgl[o])); } };
struct EpiH1 { const float* x; float* h1; bf16* h1b; __device__ __forceinline__ void operator()(int m, int n, float v) const { const size_t o = (size_t)m * 1024 + n; const float h = x[o] + v; h1[o] = h; h1b[o] = f2bf(h); } };
struct EpiScaleF32 { const float* part; float* out; int ldo; int pad; __device__ __forceinline__ void operator()(int m, int n, float v) const {
    float s = 0.f; for (int i = 0; i < 16; ++i) s += part[(size_t)m * 16 + i];
    out[(size_t)m * ldo + n] = v * (1.0f / sqrtf(s * (1.0f / 1024.0f) + EPS)); } };
struct EpiPlainF32 { float* out; int ldo; int pad; __device__ __forceinline__ void operator()(int m, int n, float v) const { out[(size_t)m * ldo + n] = v; } };
struct EpiPP { bf16* pp; __device__ __forceinline__ void operator()(int m, int n, float v) const { pp[(size_t)m * 1024 + n] = f2bf(v); } };
struct EpiH3 { const float* rstd3; const bf16* pp; float* h; __device__ __forceinline__ void operator()(int m, int n, float v) const { const size_t o = (size_t)m * 1024 + n; h[o] = h[o] + sigmoidf_(v * rstd3[m]) * bf2f(pp[o]); } };

__global__ void __launch_bounds__(256) final_norm(float* __restrict__ h, const float* __restrict__ part, const float* __restrict__ fg) {
    const int row = blockIdx.x * 4 + (threadIdx.x >> 6), lane = threadIdx.x & 63;
    float s = 0.f; for (int i = 0; i < 16; ++i) s += part[(size_t)row * 16 + i];
    const float r = 1.0f / sqrtf(s * (1.0f / 1024.0f) + EPS);
    float* hr = h + (size_t)row * 1024;
    for (int j = 0; j < 16; ++j) { const int c = lane + 64 * j; hr[c] = hr[c] * r * fg[c]; }
}
}
#define LAS __attribute__((address_space(3)))
typedef float f32x4 __attribute__((ext_vector_type(4)));
typedef unsigned u32x4 __attribute__((ext_vector_type(4)));
typedef int i32x4 __attribute__((ext_vector_type(4)));

constexpr int TK_TOK = 32;
constexpr int TK_LSTRIDE = 132;
constexpr int TK_LDS_BYTES = 256 * TK_LSTRIDE * 4;

__device__ __forceinline__ void topk_item(LAS float* lds, const float* __restrict__ SC, int item, int head_base, int* __restrict__ seli, float* __restrict__ selg, int tid) {
    const f32x4* src = (const f32x4*)(SC + (size_t)item * TK_TOK * 1024);
#pragma unroll 4
    for (int i = 0; i < 16; ++i) {
        const int idx = tid + i * 512; const int row = idx >> 8, c4 = idx & 255;
        const f32x4 v = src[idx];
        const int list = row * 8 + (c4 >> 5), elem = (c4 & 31) * 4;
        *(LAS f32x4*)(lds + list * TK_LSTRIDE + elem) = v;
    }
    __syncthreads();
    if (tid < 256) {
        const LAS float* my = lds + tid * TK_LSTRIDE;
        unsigned acc[16];
#pragma unroll
        for (int g = 0; g < 8; ++g) {
            unsigned t[16];
#pragma unroll
            for (int q = 0; q < 4; ++q) {
                const f32x4 v = *(const LAS f32x4*)(my + g * 16 + q * 4);
#pragma unroll
                for (int c = 0; c < 4; ++c) { const int e = g * 16 + q * 4 + c; t[q * 4 + c] = (tk_f2key(v[c]) & ~127u) | (unsigned)(127 - e); }
            }
            tk_sort16(t);
            if (g == 0) {
#pragma unroll
                for (int i = 0; i < 16; ++i) acc[i] = t[i];
            } else tk_merge16(acc, t);
        }
        unsigned oth[16];
#pragma unroll
        for (int i = 0; i < 16; ++i) oth[i] = (unsigned)__shfl_xor((int)acc[i], 1);
        if ((tid & 1) == 0) {
            const int tok = item * TK_TOK + (tid >> 3), head = head_base + ((tid >> 1) & 3);
            tk_combine_store(acc, oth, seli + (size_t)tok * 128 + head * 16, selg + (size_t)tok * 128 + head * 16);
        }
    }
    __syncthreads();
}
__global__ void __launch_bounds__(512) topk_kernel(const float* __restrict__ SC, int head_base, int* __restrict__ seli, float* __restrict__ selg) {
    extern __shared__ __attribute__((aligned(16))) unsigned char dyn_lds[];
    for (int item = blockIdx.x; item < T_ / TK_TOK; item += gridDim.x) topk_item((LAS float*)dyn_lds, SC, item, head_base, seli, selg, (int)threadIdx.x);
}

template <int MODE>
__device__ __forceinline__ void gather_token(int t, int lane, const void* __restrict__ Utab, const void* __restrict__ Vtab, const float* __restrict__ gffn,
                                             const int* __restrict__ seli, const float* __restrict__ selg, const float* __restrict__ part2,
                                             float* __restrict__ H  , bf16* __restrict__ h2b, float* __restrict__ rstd3) {
    float ps = (lane < 16) ? part2[(size_t)t * 16 + lane] : 0.f;
    ps = wave_sum(ps);
    const float rstd2 = 1.0f / sqrtf(ps * (1.0f / 1024.0f) + EPS);
    const int iA = seli[(size_t)t * 128 + lane], iB = seli[(size_t)t * 128 + 64 + lane];
    const float gA = selg[(size_t)t * 128 + lane], gB = selg[(size_t)t * 128 + 64 + lane];
    float* hr = H + (size_t)t * 1024;
    if constexpr (MODE == 0) {
        f32x4 x[4], y[4], hv[4];
#pragma unroll
        for (int j = 0; j < 4; ++j) { hv[j] = *(const f32x4*)(hr + 256 * j + 4 * lane); const f32x4 g = *(const f32x4*)(gffn + 256 * j + 4 * lane); x[j] = hv[j] * g; y[j] = (f32x4){0.f, 0.f, 0.f, 0.f}; }
        const float* U = (const float*)Utab; const float* V = (const float*)Vtab;
        for (int k = 0; k < 64; ++k) {
#pragma unroll
            for (int hh = 0; hh < 2; ++hh) {
                const int e = __builtin_amdgcn_readlane(hh ? iB : iA, k);
                const float gt = __builtin_bit_cast(float, __builtin_amdgcn_readlane(__builtin_bit_cast(int, hh ? gB : gA), k));
                const float* ur = U + (size_t)e * 1024; const float* vr = V + (size_t)e * 1024;
                f32x4 uv[4], vv[4];
#pragma unroll
                for (int j = 0; j < 4; ++j) { uv[j] = *(const f32x4*)(ur + 256 * j + 4 * lane); vv[j] = *(const f32x4*)(vr + 256 * j + 4 * lane); }
                float d = 0.f;
#pragma unroll
                for (int j = 0; j < 4; ++j) d += (uv[j].x * x[j].x + uv[j].y * x[j].y) + (uv[j].z * x[j].z + uv[j].w * x[j].w);
                d = wave_sum(d);
                const float c = gt * gelu_tanh(d * rstd2);
#pragma unroll
                for (int j = 0; j < 4; ++j) y[j] += vv[j] * c;
            }
        }
        float sq = 0.f;
#pragma unroll
        for (int j = 0; j < 4; ++j) {
            const f32x4 h2 = hv[j] + y[j];
            *(f32x4*)(hr + 256 * j + 4 * lane) = h2;
            sq += (h2.x * h2.x + h2.y * h2.y) + (h2.z * h2.z + h2.w * h2.w);
            uint2 w; w.x = pk2(h2.x, h2.y); w.y = pk2(h2.z, h2.w);
            *(uint2*)(h2b + (size_t)t * 1024 + 256 * j + 4 * lane) = w;
        }
        sq = wave_sum(sq);
        if (lane == 0) rstd3[t] = 1.0f / sqrtf(sq * (1.0f / 1024.0f) + EPS);
    } else {
        float x[2][8], y[2][8], hv[2][8];
#pragma unroll
        for (int j = 0; j < 2; ++j) {
            const f32x4 a = *(const f32x4*)(hr + 512 * j + 8 * lane), b = *(const f32x4*)(hr + 512 * j + 8 * lane + 4);
            hv[j][0] = a.x; hv[j][1] = a.y; hv[j][2] = a.z; hv[j][3] = a.w; hv[j][4] = b.x; hv[j][5] = b.y; hv[j][6] = b.z; hv[j][7] = b.w;
#pragma unroll
            for (int c = 0; c < 8; ++c) { x[j][c] = hv[j][c]; y[j][c] = 0.f; }
        }
        const bf16* U = (const bf16*)Utab; const bf16* V = (const bf16*)Vtab;
        for (int k = 0; k < 64; k += 2) {
            u32x4 uv[4][2], vv[4][2]; float gt[4];
#pragma unroll
            for (int q = 0; q < 4; ++q) {
                const int kk = k + (q >> 1); const int hh = q & 1;
                const int e = __builtin_amdgcn_readlane(hh ? iB : iA, kk);
                gt[q] = __builtin_bit_cast(float, __builtin_amdgcn_readlane(__builtin_bit_cast(int, hh ? gB : gA), kk));
                const bf16* ur = U + (size_t)e * 1024; const bf16* vr = V + (size_t)e * 1024;
#pragma unroll
                for (int j = 0; j < 2; ++j) { uv[q][j] = *(const u32x4*)(ur + 512 * j + 8 * lane); vv[q][j] = *(const u32x4*)(vr + 512 * j + 8 * lane); }
            }
#pragma unroll
            for (int q = 0; q < 4; ++q) {
                float d = 0.f;
#pragma unroll
                for (int j = 0; j < 2; ++j)
#pragma unroll
                    for (int c = 0; c < 4; ++c) { const unsigned w = uv[q][j][c]; d = fmaf(__builtin_bit_cast(float, w << 16), x[j][2 * c], d); d = fmaf(__builtin_bit_cast(float, w & 0xffff0000u), x[j][2 * c + 1], d); }
                d = wave_sum(d);
                const float cf = gt[q] * gelu_tanh(d * rstd2);
#pragma unroll
                for (int j = 0; j < 2; ++j)
#pragma unroll
                    for (int c = 0; c < 4; ++c) { const unsigned w = vv[q][j][c]; y[j][2 * c] = fmaf(__builtin_bit_cast(float, w << 16), cf, y[j][2 * c]); y[j][2 * c + 1] = fmaf(__builtin_bit_cast(float, w & 0xffff0000u), cf, y[j][2 * c + 1]); }
            }
        }
        float sq = 0.f;
#pragma unroll
        for (int j = 0; j < 2; ++j) {
            float h2[8];
#pragma unroll
            for (int c = 0; c < 8; ++c) { h2[c] = hv[j][c] + y[j][c]; sq += h2[c] * h2[c]; }
            *(f32x4*)(hr + 512 * j + 8 * lane) = (f32x4){h2[0], h2[1], h2[2], h2[3]};
            *(f32x4*)(hr + 512 * j + 8 * lane + 4) = (f32x4){h2[4], h2[5], h2[6], h2[7]};
            u32x4 w; w.x = pk2(h2[0], h2[1]); w.y = pk2(h2[2], h2[3]); w.z = pk2(h2[4], h2[5]); w.w = pk2(h2[6], h2[7]);
            *(u32x4*)(h2b + (size_t)t * 1024 + 512 * j + 8 * lane) = w;
        }
        sq = wave_sum(sq);
        if (lane == 0) rstd3[t] = 1.0f / sqrtf(sq * (1.0f / 1024.0f) + EPS);
    }
}
template <int MODE>
__global__ void __launch_bounds__(256) gather_kernel(const void* __restrict__ Utab, const void* __restrict__ Vtab, const float* __restrict__ gffn, const int* __restrict__ seli, const float* __restrict__ selg,
                                                     const float* __restrict__ part2, float* __restrict__ H, bf16* __restrict__ h2b, float* __restrict__ rstd3) {
    const int lane = threadIdx.x & 63; const int w = blockIdx.x * 4 + (threadIdx.x >> 6); const int nw = gridDim.x * 4;
    for (int t = w; t < T_; t += nw) gather_token<MODE>(t, lane, Utab, Vtab, gffn, seli, selg, part2, H, h2b, rstd3);
}

typedef float f32x2 __attribute__((ext_vector_type(2)));
__device__ __forceinline__ float reduce4_transpose(float d0, float d1, float d2, float d3, int lane) {
    const bool b0 = lane & 1, b1 = lane & 2;
    const float a = (b0 ? d1 : d0) + __shfl_xor(b0 ? d0 : d1, 1);
    const float b = (b0 ? d3 : d2) + __shfl_xor(b0 ? d2 : d3, 1);
    float c = (b1 ? b : a) + __shfl_xor(b1 ? a : b, 2);
    c += __shfl_xor(c, 4); c += __shfl_xor(c, 8); c += __shfl_xor(c, 16); c += __shfl_xor(c, 32);
    return c;
}
__device__ __forceinline__ float dot16_fp8(const u32x4 w, const f32x2 (&x2)[8]) {
    f32x2 acc = (f32x2){0.f, 0.f};
#pragma unroll
    for (int c = 0; c < 4; ++c) { const unsigned ww = w[c]; const f32x2 lo = __builtin_amdgcn_cvt_pk_f32_fp8(ww, false), hi = __builtin_amdgcn_cvt_pk_f32_fp8(ww, true); acc = lo * x2[2 * c] + acc; acc = hi * x2[2 * c + 1] + acc; }
    return acc.x + acc.y;
}
__device__ __forceinline__ void axpy16_fp8(const u32x4 w, float cf, f32x2 (&y2)[8]) {
#pragma unroll
    for (int c = 0; c < 4; ++c) { const unsigned ww = w[c]; const f32x2 lo = __builtin_amdgcn_cvt_pk_f32_fp8(ww, false), hi = __builtin_amdgcn_cvt_pk_f32_fp8(ww, true); y2[2 * c] = lo * cf + y2[2 * c]; y2[2 * c + 1] = hi * cf + y2[2 * c + 1]; }
}
__device__ __forceinline__ float sel4f(float v0, float v1, float v2, float v3, int q) { return q == 0 ? v0 : (q == 1 ? v1 : (q == 2 ? v2 : v3)); }
__device__ __forceinline__ void gather_token_fp8(int t, int lane, const unsigned char* __restrict__ U8, const unsigned char* __restrict__ V8, const float* __restrict__ IU, const float* __restrict__ IV,
                                                 const int* __restrict__ seli, const float* __restrict__ selg, const float* __restrict__ part2,
                                                 float* __restrict__ H, bf16* __restrict__ h2b, float* __restrict__ rstd3) {
    float ps = (lane < 16) ? part2[(size_t)t * 16 + lane] : 0.f;
    ps = wave_sum(ps);
    const float rstd2 = 1.0f / sqrtf(ps * (1.0f / 1024.0f) + EPS);
    const int iA = seli[(size_t)t * 128 + lane], iB = seli[(size_t)t * 128 + 64 + lane];
    const float duA = IU[iA] * rstd2, duB = IU[iB] * rstd2;
    const float gvA = selg[(size_t)t * 128 + lane] * IV[iA], gvB = selg[(size_t)t * 128 + 64 + lane] * IV[iB];
    float* hr = H + (size_t)t * 1024 + 16 * lane;
    f32x2 x2[8], y2[8]; f32x4 hv[4];
#pragma unroll
    for (int j = 0; j < 4; ++j) { hv[j] = *(const f32x4*)(hr + 4 * j); x2[2 * j] = (f32x2){hv[j][0], hv[j][1]}; x2[2 * j + 1] = (f32x2){hv[j][2], hv[j][3]}; y2[2 * j] = (f32x2){0.f, 0.f}; y2[2 * j + 1] = (f32x2){0.f, 0.f}; }
    const int q = lane & 3;
#pragma unroll 1
    for (int k = 0; k < 64; k += 4) {
        u32x4 uu[8], vv[8]; float du[8], gv[8];
#pragma unroll
        for (int s = 0; s < 8; ++s) {
            const int kk = k + (s >> 1); const bool hh = s & 1;
            const int e = __builtin_amdgcn_readlane(hh ? iB : iA, kk);
            du[s] = __int_as_float(__builtin_amdgcn_readlane(__float_as_int(hh ? duB : duA), kk));
            gv[s] = __int_as_float(__builtin_amdgcn_readlane(__float_as_int(hh ? gvB : gvA), kk));
            uu[s] = *(const u32x4*)(U8 + (size_t)e * 1024 + 16 * lane);
            vv[s] = *(const u32x4*)(V8 + (size_t)e * 1024 + 16 * lane);
        }
#pragma unroll
        for (int g = 0; g < 2; ++g) {
            const float d0 = dot16_fp8(uu[4 * g + 0], x2), d1 = dot16_fp8(uu[4 * g + 1], x2), d2 = dot16_fp8(uu[4 * g + 2], x2), d3 = dot16_fp8(uu[4 * g + 3], x2);
            const float tot = reduce4_transpose(d0, d1, d2, d3, lane);
            const float z = tot * sel4f(du[4 * g], du[4 * g + 1], du[4 * g + 2], du[4 * g + 3], q);
            const float cf = gelu_tanh(z) * sel4f(gv[4 * g], gv[4 * g + 1], gv[4 * g + 2], gv[4 * g + 3], q);
#pragma unroll
            for (int s = 0; s < 4; ++s) { const float cs = __int_as_float(__builtin_amdgcn_readlane(__float_as_int(cf), s)); axpy16_fp8(vv[4 * g + s], cs, y2); }
        }
    }
    float sq = 0.f;
    f32x4 h2[4];
#pragma unroll
    for (int j = 0; j < 4; ++j) {
        h2[j] = hv[j] + (f32x4){y2[2 * j].x, y2[2 * j].y, y2[2 * j + 1].x, y2[2 * j + 1].y};
        *(f32x4*)(hr + 4 * j) = h2[j];
        sq += (h2[j][0] * h2[j][0] + h2[j][1] * h2[j][1]) + (h2[j][2] * h2[j][2] + h2[j][3] * h2[j][3]);
    }
    u32x4 w0, w1; w0.x = pk2(h2[0][0], h2[0][1]); w0.y = pk2(h2[0][2], h2[0][3]); w0.z = pk2(h2[1][0], h2[1][1]); w0.w = pk2(h2[1][2], h2[1][3]);
    w1.x = pk2(h2[2][0], h2[2][1]); w1.y = pk2(h2[2][2], h2[2][3]); w1.z = pk2(h2[3][0], h2[3][1]); w1.w = pk2(h2[3][2], h2[3][3]);
    u32x4* ob = (u32x4*)(h2b + (size_t)t * 1024 + 16 * lane); ob[0] = w0; ob[1] = w1;
    sq = wave_sum(sq);
    if (lane == 0) rstd3[t] = 1.0f / sqrtf(sq * (1.0f / 1024.0f) + EPS);
}

__device__ __forceinline__ unsigned umin_(unsigned a, unsigned b) { return a < b ? a : b; }
__device__ __forceinline__ unsigned umax_(unsigned a, unsigned b) { return a > b ? a : b; }
__device__ __forceinline__ void sort128(unsigned& k0, unsigned& k1, int lane) {
#pragma unroll
    for (int k = 2; k <= 128; k <<= 1) {
#pragma unroll
        for (int j = k >> 1; j >= 1; j >>= 1) {
            if (j == 64) { const unsigned mn = umin_(k0, k1), mx = umax_(k0, k1); k0 = mn; k1 = mx; }
            else {
                const unsigned o0 = (unsigned)__shfl_xor((int)k0, j), o1 = (unsigned)__shfl_xor((int)k1, j);
                const bool up0 = (k == 128) ? true : (k == 64 ? true : ((lane & k) == 0));
                const bool up1 = (k == 128) ? true : (k == 64 ? false : ((lane & k) == 0));
                const bool lower = (lane & j) == 0;
                k0 = (lower == up0) ? umin_(k0, o0) : umax_(k0, o0);
                k1 = (lower == up1) ? umin_(k1, o1) : umax_(k1, o1);
            }
        }
    }
}
typedef int i32x4v __attribute__((ext_vector_type(4)));
#ifndef NSLICE
#define NSLICE 8
#endif
#define SLICE_SHIFT (NSLICE == 32 ? 25 : (NSLICE == 16 ? 26 : (NSLICE == 8 ? 27 : (NSLICE == 4 ? 28 : 30))))
typedef unsigned u32x2 __attribute__((ext_vector_type(2)));
__device__ __forceinline__ f32x4 bf4_lo(u32x2 w) { return (f32x4){__builtin_bit_cast(float, w.x << 16), __builtin_bit_cast(float, w.x & 0xffff0000u), __builtin_bit_cast(float, w.y << 16), __builtin_bit_cast(float, w.y & 0xffff0000u)}; }
struct TokState { f32x2 y2[8]; unsigned k0, k1; int bnd; float rsx; };
__device__ __forceinline__ int count_lt(const TokState& S, unsigned bound) {
    return __builtin_popcountll(__builtin_amdgcn_ballot_w64(S.k0 < bound)) + __builtin_popcountll(__builtin_amdgcn_ballot_w64(S.k1 < bound));
}
__device__ __forceinline__ int bperm_i(int srclane, int v) { return __builtin_amdgcn_ds_bpermute(srclane << 2, v); }
__device__ __forceinline__ float bperm_f(int srclane, float v) { return __int_as_float(__builtin_amdgcn_ds_bpermute(srclane << 2, __float_as_int(v))); }
template <int PM>
__device__ __forceinline__ void gather_batch(TokState& S, int p, int hi, int lane, const LAS unsigned char* xs, const unsigned char* __restrict__ U8, const unsigned char* __restrict__ V8, const float* __restrict__ IU, const float* __restrict__ IV) {
    const int n = (hi - p < 16) ? hi - p : 16;
    const int m = lane & 15, kq = lane >> 4;
    const int r = (m < n) ? p + m : hi - 1; const int sl = r & 63; const bool lo = r < 64;
    const unsigned ka = (unsigned)bperm_i(sl, (int)S.k0), kb = (unsigned)bperm_i(sl, (int)S.k1);
    const int es = (int)((lo ? ka : kb) >> 16);
    const unsigned key = lo ? ka : kb;
    const float dus = IU[es] * S.rsx, gvs = (m < n) ? (float)(key & 0xffffu) * (1.0f / 65535.0f) * IV[es] : 0.f;
    const unsigned char* ua = U8 + (size_t)es * 1024 + 16 * kq;
    i32x4v A[16];
    if (!(PM & 2)) {
#pragma unroll
        for (int s = 0; s < 16; ++s) { if (PM & 16) { const int e = __builtin_amdgcn_readlane(es, s); A[s] = *(const i32x4v*)(U8 + (size_t)e * 1024 + 16 * lane); } else A[s] = *(const i32x4v*)(ua + 64 * s); }
    }
    u32x4 vv[16];
    if (!(PM & 1)) {
#pragma unroll
        for (int q = 0; q < 8; ++q) if (q < n) { const int e = __builtin_amdgcn_readlane(es, q); vv[q] = *(const u32x4*)(V8 + (size_t)e * 1024 + 16 * lane); }
        if (n > 8) {
#pragma unroll
            for (int q = 8; q < 16; ++q) if (q < n) { const int e = __builtin_amdgcn_readlane(es, q); vv[q] = *(const u32x4*)(V8 + (size_t)e * 1024 + 16 * lane); }
        }
    }
    i32x4v acc = (i32x4v){0, 0, 0, 0};
    if (!(PM & 2)) {
#pragma unroll
        for (int s = 0; s < 16; ++s) { const i32x4v B = *(const LAS i32x4v*)(xs + 64 * s + 16 * kq); acc = __builtin_amdgcn_mfma_i32_16x16x64_i8(A[s], B, acc, 0, 0, 0); }
    } else { acc = (i32x4v){es, es + 1, es + 2, es + 3}; }
    float cf[4];
#pragma unroll
    for (int j = 0; j < 4; ++j) { const int sm = 4 * kq + j; const float d = bperm_f(sm, dus), g = bperm_f(sm, gvs); cf[j] = g * gelu_tanh((float)acc[j] * d); }
    if (PM & 1) { S.y2[0].x += (cf[0] + cf[1]) + (cf[2] + cf[3]); }
    else if (PM & 4) {
#pragma unroll
        for (int q = 0; q < 16; ++q) if (q < n) { const float cs = __int_as_float(__builtin_amdgcn_readlane(__float_as_int(cf[q & 3]), 16 * (q >> 2))); S.y2[q & 7].x += cs * __uint_as_float((vv[q].x ^ vv[q].y ^ vv[q].z ^ vv[q].w) & 0x3fffffffu); }
    } else {
#pragma unroll
        for (int q = 0; q < 8; ++q) if (q < n) { const float cs = __int_as_float(__builtin_amdgcn_readlane(__float_as_int(cf[q & 3]), 16 * (q >> 2))); axpy16_fp8(vv[q], cs, S.y2); }
        if (n > 8) {
#pragma unroll
            for (int q = 8; q < 16; ++q) if (q < n) { const float cs = __int_as_float(__builtin_amdgcn_readlane(__float_as_int(cf[q & 3]), 16 * (q >> 2))); axpy16_fp8(vv[q], cs, S.y2); }
        }
    }
    __builtin_amdgcn_sched_barrier(0);
}
__device__ __forceinline__ void tok_setup(TokState& S, int t, int lane, LAS unsigned char* xs, const int* __restrict__ seli, const float* __restrict__ selg,
                                          const float* __restrict__ part2, const bf16* __restrict__ h1b) {
    float ps = (lane < 16) ? part2[(size_t)t * 16 + lane] : 0.f;
    ps = wave_sum(ps);
    const float rstd2 = 1.0f / sqrtf(ps * (1.0f / 1024.0f) + EPS);
    f32x4 hv[4]; float am = 0.f;
    { const u32x4* br = (const u32x4*)(h1b + (size_t)t * 1024 + 16 * lane); const u32x4 b0 = br[0], b1 = br[1];
      hv[0] = bf4_lo((u32x2){b0.x, b0.y}); hv[1] = bf4_lo((u32x2){b0.z, b0.w}); hv[2] = bf4_lo((u32x2){b1.x, b1.y}); hv[3] = bf4_lo((u32x2){b1.z, b1.w}); }
#pragma unroll
    for (int j = 0; j < 4; ++j) { am = fmaxf(am, fmaxf(fmaxf(fabsf(hv[j][0]), fabsf(hv[j][1])), fmaxf(fabsf(hv[j][2]), fabsf(hv[j][3])))); }
#pragma unroll
    for (int o = 1; o < 64; o <<= 1) am = fmaxf(am, __shfl_xor(am, o));
    const float sx = am > 0.f ? 127.0f / am : 1.0f, isx = am > 0.f ? am * (1.0f / 127.0f) : 1.0f;
    u32x4 xq;
#pragma unroll
    for (int j = 0; j < 4; ++j) { unsigned w = 0u;
#pragma unroll
        for (int c = 0; c < 4; ++c) w |= ((unsigned)(int)__builtin_rintf(hv[j][c] * sx) & 0xffu) << (8 * c);
        xq[j] = w; }
    *(LAS u32x4*)(xs + 16 * lane) = xq;
    const int iA = seli[(size_t)t * 128 + lane], iB = seli[(size_t)t * 128 + 64 + lane];
    const float gA = selg[(size_t)t * 128 + lane], gB = selg[(size_t)t * 128 + 64 + lane];
    S.k0 = ((unsigned)iA << 16) | (unsigned)(gA * 65535.0f + 0.5f); S.k1 = ((unsigned)iB << 16) | (unsigned)(gB * 65535.0f + 0.5f);
    sort128(S.k0, S.k1, lane);
    S.rsx = rstd2 * isx;
    int bnd = 0;
#pragma unroll
    for (int s = 1; s <= NSLICE; ++s) { const int c = count_lt(S, (unsigned)s << SLICE_SHIFT); bnd = (lane == s) ? c : bnd; }
    S.bnd = bnd;
#pragma unroll
    for (int j = 0; j < 8; ++j) S.y2[j] = (f32x2){0.f, 0.f};
}
__device__ __forceinline__ void tok_finish(const TokState& S, int t, int lane, const bf16* __restrict__ h1b, bf16* __restrict__ h2b, float* __restrict__ rstd3) {
    const u32x4* br = (const u32x4*)(h1b + (size_t)t * 1024 + 16 * lane); const u32x4 b0 = br[0], b1 = br[1];
    f32x4 h2[4]; h2[0] = bf4_lo((u32x2){b0.x, b0.y}); h2[1] = bf4_lo((u32x2){b0.z, b0.w}); h2[2] = bf4_lo((u32x2){b1.x, b1.y}); h2[3] = bf4_lo((u32x2){b1.z, b1.w});
    float sq = 0.f;
#pragma unroll
    for (int j = 0; j < 4; ++j) {
        h2[j] = h2[j] + (f32x4){S.y2[2 * j].x, S.y2[2 * j].y, S.y2[2 * j + 1].x, S.y2[2 * j + 1].y};
        sq += (h2[j][0] * h2[j][0] + h2[j][1] * h2[j][1]) + (h2[j][2] * h2[j][2] + h2[j][3] * h2[j][3]);
    }
    u32x4 w0, w1; w0.x = pk2(h2[0][0], h2[0][1]); w0.y = pk2(h2[0][2], h2[0][3]); w0.z = pk2(h2[1][0], h2[1][1]); w0.w = pk2(h2[1][2], h2[1][3]);
    w1.x = pk2(h2[2][0], h2[2][1]); w1.y = pk2(h2[2][2], h2[2][3]); w1.z = pk2(h2[3][0], h2[3][1]); w1.w = pk2(h2[3][2], h2[3][3]);
    u32x4* ob = (u32x4*)(h2b + (size_t)t * 1024 + 16 * lane); ob[0] = w0; ob[1] = w1;
    sq = wave_sum(sq);
    if (lane == 0) rstd3[t] = 1.0f / sqrtf(sq * (1.0f / 1024.0f) + EPS);
}
__device__ __forceinline__ int dpp_xor8(int v) { return __builtin_amdgcn_update_dpp(0, v, 0x128, 0xf, 0xf, false); }
__device__ __forceinline__ int dpp_xor4(int v) { return __builtin_amdgcn_update_dpp(0, __builtin_amdgcn_update_dpp(0, v, 0x141, 0xf, 0xf, false), 0x1b, 0xf, 0xf, false); }
__device__ __forceinline__ int dpp_xor1(int v) { return __builtin_amdgcn_update_dpp(0, v, 0xb1, 0xf, 0xf, false); }
__device__ __forceinline__ int dpp_xor2(int v) { return __builtin_amdgcn_update_dpp(0, v, 0x4e, 0xf, 0xf, false); }
__device__ __forceinline__ int reduce16_rows(int (&p)[16], int lane) {
    int r8[8], r4[4], r2[2];
#pragma unroll
    for (int i = 0; i < 8; ++i) { const u32x2 s = __builtin_amdgcn_permlane32_swap((unsigned)p[i], (unsigned)p[i + 8], false, false); r8[i] = (int)(s.x + s.y); }
#pragma unroll
    for (int i = 0; i < 4; ++i) { const u32x2 s = __builtin_amdgcn_permlane16_swap((unsigned)r8[i], (unsigned)r8[i + 4], false, false); r4[i] = (int)(s.x + s.y); }
    const bool b3 = lane & 8, b2 = lane & 4;
#pragma unroll
    for (int i = 0; i < 2; ++i) { const int s0 = r4[i] + dpp_xor8(r4[i]), s1 = r4[i + 2] + dpp_xor8(r4[i + 2]); r2[i] = b3 ? s1 : s0; }
    const int keep = b2 ? r2[1] : r2[0], send = b2 ? r2[0] : r2[1];
    int t = keep + dpp_xor4(send);
    t += dpp_xor1(t); t += dpp_xor2(t);
    return t;
}
struct TokState2 { f32x2 y2[8]; unsigned k0, k1; float rsx; };
template <int PM>
__device__ __forceinline__ void gather_batch_rows(TokState& S, int p, int hi, int lane, const LAS unsigned char* xs, const unsigned char* __restrict__ U8, const unsigned char* __restrict__ V8, const float* __restrict__ IU, const float* __restrict__ IV) {
    const int n = (hi - p < 16) ? hi - p : 16;
    const int slot = lane >> 2;
    const int r = (slot < n) ? p + slot : hi - 1; const int sl = r & 63; const bool lo = r < 64;
    const unsigned ka = (unsigned)bperm_i(sl, (int)S.k0), kb = (unsigned)bperm_i(sl, (int)S.k1);
    const unsigned key = lo ? ka : kb;
    const int es = (int)(key >> 16);
    const float dus = IU[es] * S.rsx, gvs = (slot < n) ? (float)(key & 0xffffu) * (1.0f / 65535.0f) * IV[es] : 0.f;
    i32x4v A[16]; u32x4 vv[16];
#pragma unroll
    for (int g = 0; g < 4; ++g) if (4 * g < n) {
#pragma unroll
        for (int q = 4 * g; q < 4 * g + 4; ++q) { int e = __builtin_amdgcn_readlane(es, 4 * q); if (PM & 32) e &= 1023; A[q] = *(const i32x4v*)(U8 + (size_t)e * 1024 + 16 * lane); }
    }
#pragma unroll
    for (int g = 0; g < 4; ++g) if (4 * g < n) {
#pragma unroll
        for (int q = 4 * g; q < 4 * g + 4; ++q) { int e = __builtin_amdgcn_readlane(es, 4 * q); if (PM & 32) e &= 1023; vv[q] = *(const u32x4*)(V8 + (size_t)e * 1024 + 16 * lane); }
    }
    const i32x4v X = *(const LAS i32x4v*)(xs + 16 * lane);
    int pp[16];
#pragma unroll
    for (int g = 0; g < 4; ++g) {
        if (4 * g < n) {
#pragma unroll
            for (int q = 4 * g; q < 4 * g + 4; ++q) pp[q] = __builtin_amdgcn_sdot4(A[q][3], X[3], __builtin_amdgcn_sdot4(A[q][2], X[2], __builtin_amdgcn_sdot4(A[q][1], X[1], __builtin_amdgcn_sdot4(A[q][0], X[0], 0, false), false), false), false);
        } else {
#pragma unroll
            for (int q = 4 * g; q < 4 * g + 4; ++q) pp[q] = 0;
        }
    }
    const int tot = reduce16_rows(pp, lane);
    const float cf = gvs * gelu_tanh((float)tot * dus);
#pragma unroll
    for (int g = 0; g < 4; ++g) if (4 * g < n) {
#pragma unroll
        for (int q = 4 * g; q < 4 * g + 4; ++q) { const float cs = __int_as_float(__builtin_amdgcn_readlane(__float_as_int(cf), 4 * q)); axpy16_fp8(vv[q], cs, S.y2); }
    }
    __builtin_amdgcn_sched_barrier(0);
}

template <int PM>
__device__ __forceinline__ void gather_batch16(TokState2& S, int bi, int lane, const LAS unsigned char* xs, const unsigned char* __restrict__ U8, const unsigned char* __restrict__ V8, const float* __restrict__ IU, const float* __restrict__ IV) {
    const unsigned ksel = (bi < 4) ? S.k0 : S.k1;
    const int lb = (bi & 3) << 4;
    const unsigned key = (unsigned)bperm_i(lb + (lane >> 2), (int)ksel);
    const int es = (int)(key >> 16);
    const float dus = IU[es] * S.rsx, gvs = (float)(key & 0xffffu) * (1.0f / 65535.0f) * IV[es];
    i32x4v A[16]; u32x4 vv[16];
#pragma unroll
    for (int q = 0; q < 16; ++q) { int e = (int)((unsigned)__builtin_amdgcn_readlane((int)ksel, lb + q) >> 16); if (PM & 32) e &= 1023; if (!(PM & 2)) A[q] = *(const i32x4v*)(U8 + (size_t)e * 1024 + 16 * lane); else A[q] = (i32x4v){e, e, e, e}; }
#pragma unroll
    for (int q = 0; q < 16; ++q) { int e = (int)((unsigned)__builtin_amdgcn_readlane((int)ksel, lb + q) >> 16); if (PM & 32) e &= 1023; if (!(PM & 1)) vv[q] = *(const u32x4*)(V8 + (size_t)e * 1024 + 16 * lane); else vv[q] = (u32x4){(unsigned)e, 0u, 0u, 0u}; }
    const i32x4v X = *(const LAS i32x4v*)(xs + 16 * lane);
    int p[16];
#pragma unroll
    for (int q = 0; q < 16; ++q) p[q] = __builtin_amdgcn_sdot4(A[q][3], X[3], __builtin_amdgcn_sdot4(A[q][2], X[2], __builtin_amdgcn_sdot4(A[q][1], X[1], __builtin_amdgcn_sdot4(A[q][0], X[0], 0, false), false), false), false);
    const int tot = reduce16_rows(p, lane);
    const float cf = gvs * gelu_tanh((float)tot * dus);
#pragma unroll
    for (int q = 0; q < 16; ++q) { const float cs = __int_as_float(__builtin_amdgcn_readlane(__float_as_int(cf), 4 * q)); if (PM & 1) S.y2[q & 7].x += cs * __uint_as_float(vv[q].x); else axpy16_fp8(vv[q], cs, S.y2); }
    __builtin_amdgcn_sched_barrier(0);
}
__device__ __forceinline__ void tok_setup2(TokState2& S, int t, int lane, LAS unsigned char* xs, const int* __restrict__ seli, const float* __restrict__ selg,
                                           const float* __restrict__ part2, const bf16* __restrict__ h1b) {
    float ps = (lane < 16) ? part2[(size_t)t * 16 + lane] : 0.f;
    ps = wave_sum(ps);
    const float rstd2 = 1.0f / sqrtf(ps * (1.0f / 1024.0f) + EPS);
    f32x4 hv[4]; float am = 0.f;
    { const u32x4* br = (const u32x4*)(h1b + (size_t)t * 1024 + 16 * lane); const u32x4 b0 = br[0], b1 = br[1];
      hv[0] = bf4_lo((u32x2){b0.x, b0.y}); hv[1] = bf4_lo((u32x2){b0.z, b0.w}); hv[2] = bf4_lo((u32x2){b1.x, b1.y}); hv[3] = bf4_lo((u32x2){b1.z, b1.w}); }
#pragma unroll
    for (int j = 0; j < 4; ++j) { am = fmaxf(am, fmaxf(fmaxf(fabsf(hv[j][0]), fabsf(hv[j][1])), fmaxf(fabsf(hv[j][2]), fabsf(hv[j][3])))); }
#pragma unroll
    for (int o = 1; o < 64; o <<= 1) am = fmaxf(am, __shfl_xor(am, o));
    const float sx = am > 0.f ? 127.0f / am : 1.0f, isx = am > 0.f ? am * (1.0f / 127.0f) : 1.0f;
    u32x4 xq;
#pragma unroll
    for (int j = 0; j < 4; ++j) { unsigned w = 0u;
#pragma unroll
        for (int c = 0; c < 4; ++c) w |= ((unsigned)(int)__builtin_rintf(hv[j][c] * sx) & 0xffu) << (8 * c);
        xq[j] = w; }
    *(LAS u32x4*)(xs + 16 * lane) = xq;
    const int iA = seli[(size_t)t * 128 + lane], iB = seli[(size_t)t * 128 + 64 + lane];
    const float gA = selg[(size_t)t * 128 + lane], gB = selg[(size_t)t * 128 + 64 + lane];
    S.k0 = ((unsigned)iA << 16) | (unsigned)(gA * 65535.0f + 0.5f); S.k1 = ((unsigned)iB << 16) | (unsigned)(gB * 65535.0f + 0.5f);
    sort128(S.k0, S.k1, lane);
    S.rsx = rstd2 * isx;
#pragma unroll
    for (int j = 0; j < 8; ++j) S.y2[j] = (f32x2){0.f, 0.f};
}
__device__ __forceinline__ void tok_finish2(const TokState2& S, int t, int lane, const bf16* __restrict__ h1b, bf16* __restrict__ h2b, float* __restrict__ rstd3) {
    const u32x4* br = (const u32x4*)(h1b + (size_t)t * 1024 + 16 * lane); const u32x4 b0 = br[0], b1 = br[1];
    f32x4 h2[4]; h2[0] = bf4_lo((u32x2){b0.x, b0.y}); h2[1] = bf4_lo((u32x2){b0.z, b0.w}); h2[2] = bf4_lo((u32x2){b1.x, b1.y}); h2[3] = bf4_lo((u32x2){b1.z, b1.w});
    float sq = 0.f;
#pragma unroll
    for (int j = 0; j < 4; ++j) {
        h2[j] = h2[j] + (f32x4){S.y2[2 * j].x, S.y2[2 * j].y, S.y2[2 * j + 1].x, S.y2[2 * j + 1].y};
        sq += (h2[j][0] * h2[j][0] + h2[j][1] * h2[j][1]) + (h2[j][2] * h2[j][2] + h2[j][3] * h2[j][3]);
    }
    u32x4 w0, w1; w0.x = pk2(h2[0][0], h2[0][1]); w0.y = pk2(h2[0][2], h2[0][3]); w0.z = pk2(h2[1][0], h2[1][1]); w0.w = pk2(h2[1][2], h2[1][3]);
    w1.x = pk2(h2[2][0], h2[2][1]); w1.y = pk2(h2[2][2], h2[2][3]); w1.z = pk2(h2[3][0], h2[3][1]); w1.w = pk2(h2[3][2], h2[3][3]);
    u32x4* ob = (u32x4*)(h2b + (size_t)t * 1024 + 16 * lane); ob[0] = w0; ob[1] = w1;
    sq = wave_sum(sq);
    if (lane == 0) rstd3[t] = 1.0f / sqrtf(sq * (1.0f / 1024.0f) + EPS);
}
template <int PM>
__device__ __forceinline__ void gather_wg_rows(int tok0, int wave, int lane, LAS unsigned char* lds, const unsigned char* __restrict__ U8, const unsigned char* __restrict__ V8, const float* __restrict__ IU, const float* __restrict__ IV,
                                               const int* __restrict__ seli, const float* __restrict__ selg, const float* __restrict__ part2, const bf16* __restrict__ h1b, bf16* __restrict__ h2b, float* __restrict__ rstd3, float* probe_out) {
    LAS unsigned char* xs = lds + wave * 4096;
#pragma unroll 1
    for (int pass = 0; pass < 2; ++pass) {
        const int tb = tok0 + pass * 32 + wave * 4;
        TokState2 S0, S1, S2, S3;
        tok_setup2(S0, tb + 0, fresh_lane(), xs, seli, selg, part2, h1b); __builtin_amdgcn_sched_barrier(0);
        tok_setup2(S1, tb + 1, fresh_lane(), xs + 1024, seli, selg, part2, h1b); __builtin_amdgcn_sched_barrier(0);
        tok_setup2(S2, tb + 2, fresh_lane(), xs + 2048, seli, selg, part2, h1b); __builtin_amdgcn_sched_barrier(0);
        tok_setup2(S3, tb + 3, fresh_lane(), xs + 3072, seli, selg, part2, h1b); __builtin_amdgcn_sched_barrier(0);
        __syncthreads();
        lane = fresh_lane();
#pragma unroll 1
        for (int bi = 0; bi < 8; ++bi) {
            gather_batch16<PM>(S0, bi, lane, xs, U8, V8, IU, IV);
            gather_batch16<PM>(S1, bi, lane, xs + 1024, U8, V8, IU, IV);
            gather_batch16<PM>(S2, bi, lane, xs + 2048, U8, V8, IU, IV);
            gather_batch16<PM>(S3, bi, lane, xs + 3072, U8, V8, IU, IV);
        }
        if (PM != 0) { const int fl = fresh_lane(); f32x2 a = S0.y2[0] + S1.y2[0] + S2.y2[0] + S3.y2[0];
#pragma unroll
            for (int j = 1; j < 8; ++j) a += S0.y2[j] + S1.y2[j] + S2.y2[j] + S3.y2[j];
            probe_out[(size_t)tb * 64 + fl] = a.x + a.y; }
        else { const int fl = fresh_lane(); tok_finish2(S0, tb, fl, h1b, h2b, rstd3); tok_finish2(S1, tb + 1, fl, h1b, h2b, rstd3); tok_finish2(S2, tb + 2, fl, h1b, h2b, rstd3); tok_finish2(S3, tb + 3, fl, h1b, h2b, rstd3); }
        __syncthreads();
    }
}
#if GATHER_ROWS == 2
#define GATHER_BATCH_FN gather_batch_rows
#else
#define GATHER_BATCH_FN gather_batch
#endif
template <int PM>
__device__ __forceinline__ void gather_wg_sliced(int tok0, int wave, int lane, LAS unsigned char* lds, const unsigned char* __restrict__ U8, const unsigned char* __restrict__ V8, const float* __restrict__ IU, const float* __restrict__ IV,
                                                 const int* __restrict__ seli, const float* __restrict__ selg, const float* __restrict__ part2, float* __restrict__ H, const bf16* __restrict__ h1b, bf16* __restrict__ h2b, float* __restrict__ rstd3, float* probe_out) {
    LAS unsigned char* xs = lds + wave * 4096;
#pragma unroll 1
    for (int pass = 0; pass < 2; ++pass) {
        const int tb = tok0 + pass * 32 + wave * 4;
        TokState S0, S1, S2, S3;
        tok_setup(S0, tb + 0, fresh_lane(), xs, seli, selg, part2, h1b); __builtin_amdgcn_sched_barrier(0);
        tok_setup(S1, tb + 1, fresh_lane(), xs + 1024, seli, selg, part2, h1b); __builtin_amdgcn_sched_barrier(0);
        tok_setup(S2, tb + 2, fresh_lane(), xs + 2048, seli, selg, part2, h1b); __builtin_amdgcn_sched_barrier(0);
        tok_setup(S3, tb + 3, fresh_lane(), xs + 3072, seli, selg, part2, h1b); __builtin_amdgcn_sched_barrier(0);
        __syncthreads();
        lane = fresh_lane();
        int lo0 = 0, lo1 = 0, lo2 = 0, lo3 = 0;
#pragma unroll 1
        for (int s = 0; s < NSLICE; ++s) {
            { const int hi = __builtin_amdgcn_readlane(S0.bnd, s + 1); for (int p = lo0; p < hi; p += 16) GATHER_BATCH_FN<PM>(S0, p, hi, lane, xs, U8, V8, IU, IV); lo0 = hi; }
            { const int hi = __builtin_amdgcn_readlane(S1.bnd, s + 1); for (int p = lo1; p < hi; p += 16) GATHER_BATCH_FN<PM>(S1, p, hi, lane, xs + 1024, U8, V8, IU, IV); lo1 = hi; }
            { const int hi = __builtin_amdgcn_readlane(S2.bnd, s + 1); for (int p = lo2; p < hi; p += 16) GATHER_BATCH_FN<PM>(S2, p, hi, lane, xs + 2048, U8, V8, IU, IV); lo2 = hi; }
            { const int hi = __builtin_amdgcn_readlane(S3.bnd, s + 1); for (int p = lo3; p < hi; p += 16) GATHER_BATCH_FN<PM>(S3, p, hi, lane, xs + 3072, U8, V8, IU, IV); lo3 = hi; }
        }
        if (probe_out) { const int fl = fresh_lane(); f32x2 a = S0.y2[0] + S1.y2[0] + S2.y2[0] + S3.y2[0];
#pragma unroll
            for (int j = 1; j < 8; ++j) a += S0.y2[j] + S1.y2[j] + S2.y2[j] + S3.y2[j];
            probe_out[(size_t)tb * 64 + fl] = a.x + a.y; }
        else { const int fl = fresh_lane(); tok_finish(S0, tb, fl, h1b, h2b, rstd3); tok_finish(S1, tb + 1, fl, h1b, h2b, rstd3); tok_finish(S2, tb + 2, fl, h1b, h2b, rstd3); tok_finish(S3, tb + 3, fl, h1b, h2b, rstd3); }
        __syncthreads();
    }
}


template <int J> __device__ __forceinline__ unsigned xor_lane(unsigned v) {
    if (J == 1) return (unsigned)__builtin_amdgcn_update_dpp(0, (int)v, 0xb1, 0xf, 0xf, false);
    if (J == 2) return (unsigned)__builtin_amdgcn_update_dpp(0, (int)v, 0x4e, 0xf, 0xf, false);
    if (J == 4) return (unsigned)dpp_xor4((int)v);
    if (J == 8) return (unsigned)__builtin_amdgcn_update_dpp(0, (int)v, 0x128, 0xf, 0xf, false);
    return (unsigned)__shfl_xor((int)v, J);
}
template <int NR, int KK, int J>
__device__ __forceinline__ void sort_stage(unsigned (&k)[NR], int lane) {
    if (J >= 64) {
        constexpr int d = J >> 6;
#pragma unroll
        for (int r = 0; r < NR; ++r) if ((r & d) == 0) {
            const bool up = (KK == 64 * NR) ? true : (((64 * r) & KK) == 0);
            const unsigned mn = umin_(k[r], k[r + d]), mx = umax_(k[r], k[r + d]);
            k[r] = up ? mn : mx; k[r + d] = up ? mx : mn;
        }
    } else {
        const bool lower = (lane & J) == 0;
        unsigned o[NR];
#pragma unroll
        for (int r = 0; r < NR; ++r) o[r] = xor_lane<(J < 64 ? J : 1)>(k[r]);
#pragma unroll
        for (int r = 0; r < NR; ++r) {
            const bool up = (KK == 64 * NR) ? true : (KK >= 64 ? (((64 * r) & KK) == 0) : ((lane & KK) == 0));
            k[r] = (lower == up) ? umin_(k[r], o[r]) : umax_(k[r], o[r]);
        }
    }
}
template <int NR, int KK, int J> struct SortJ { static __device__ __forceinline__ void run(unsigned (&k)[NR], int lane) { sort_stage<NR, KK, J>(k, lane); SortJ<NR, KK, J / 2>::run(k, lane); } };
template <int NR, int KK> struct SortJ<NR, KK, 0> { static __device__ __forceinline__ void run(unsigned (&)[NR], int) {} };
template <int NR, int KK> struct SortK { static __device__ __forceinline__ void run(unsigned (&k)[NR], int lane) { SortK<NR, KK / 2>::run(k, lane); SortJ<NR, KK, KK / 2>::run(k, lane); } };
template <int NR> struct SortK<NR, 1> { static __device__ __forceinline__ void run(unsigned (&)[NR], int) {} };
template <int NR>
__device__ __forceinline__ void sort_wave(unsigned (&k)[NR], int lane) { SortK<NR, 64 * NR>::run(k, lane); }
__device__ __forceinline__ void axpy_dispatch2(int t, int tbase, float cs, const f32x2 (&x)[8], f32x2 (&Ya)[8], f32x2 (&Yb)[8]) {
    const unsigned long long c = (unsigned long long)__float_as_uint(cs);
    const int tt = t - tbase;
    asm volatile(
        "s_cmp_gt_u32 %[t], 1\n\t"
        "s_cbranch_scc1 3f\n\t"
        "s_cmp_eq_u32 %[t], 1\n\t"
        "s_cbranch_scc1 2f\n\t"
        "v_pk_fma_f32 %[a0], %[c], %[x0], %[a0] op_sel_hi:[0,1,1]\n\t"
        "v_pk_fma_f32 %[a1], %[c], %[x1], %[a1] op_sel_hi:[0,1,1]\n\t"
        "v_pk_fma_f32 %[a2], %[c], %[x2], %[a2] op_sel_hi:[0,1,1]\n\t"
        "v_pk_fma_f32 %[a3], %[c], %[x3], %[a3] op_sel_hi:[0,1,1]\n\t"
        "v_pk_fma_f32 %[a4], %[c], %[x4], %[a4] op_sel_hi:[0,1,1]\n\t"
        "v_pk_fma_f32 %[a5], %[c], %[x5], %[a5] op_sel_hi:[0,1,1]\n\t"
        "v_pk_fma_f32 %[a6], %[c], %[x6], %[a6] op_sel_hi:[0,1,1]\n\t"
        "v_pk_fma_f32 %[a7], %[c], %[x7], %[a7] op_sel_hi:[0,1,1]\n\t"
        "s_branch 3f\n"
        "2:\n\t"
        "v_pk_fma_f32 %[b0], %[c], %[x0], %[b0] op_sel_hi:[0,1,1]\n\t"
        "v_pk_fma_f32 %[b1], %[c], %[x1], %[b1] op_sel_hi:[0,1,1]\n\t"
        "v_pk_fma_f32 %[b2], %[c], %[x2], %[b2] op_sel_hi:[0,1,1]\n\t"
        "v_pk_fma_f32 %[b3], %[c], %[x3], %[b3] op_sel_hi:[0,1,1]\n\t"
        "v_pk_fma_f32 %[b4], %[c], %[x4], %[b4] op_sel_hi:[0,1,1]\n\t"
        "v_pk_fma_f32 %[b5], %[c], %[x5], %[b5] op_sel_hi:[0,1,1]\n\t"
        "v_pk_fma_f32 %[b6], %[c], %[x6], %[b6] op_sel_hi:[0,1,1]\n\t"
        "v_pk_fma_f32 %[b7], %[c], %[x7], %[b7] op_sel_hi:[0,1,1]\n"
        "3:\n\t"
        : [a0] "+v"(Ya[0]), [a1] "+v"(Ya[1]), [a2] "+v"(Ya[2]), [a3] "+v"(Ya[3]), [a4] "+v"(Ya[4]), [a5] "+v"(Ya[5]), [a6] "+v"(Ya[6]), [a7] "+v"(Ya[7]),
          [b0] "+v"(Yb[0]), [b1] "+v"(Yb[1]), [b2] "+v"(Yb[2]), [b3] "+v"(Yb[3]), [b4] "+v"(Yb[4]), [b5] "+v"(Yb[5]), [b6] "+v"(Yb[6]), [b7] "+v"(Yb[7])
        : [x0] "v"(x[0]), [x1] "v"(x[1]), [x2] "v"(x[2]), [x3] "v"(x[3]), [x4] "v"(x[4]), [x5] "v"(x[5]), [x6] "v"(x[6]), [x7] "v"(x[7]), [c] "s"(c), [t] "s"(tt)
        : "scc");
}
__device__ __forceinline__ float tok_setup_mixed(unsigned& k0, unsigned& k1, int t, int j, int lane, LAS unsigned char* xs, const int* __restrict__ seli, const float* __restrict__ selg,
                                                 const float* __restrict__ part2, const bf16* __restrict__ h1b) {
    float ps = (lane < 16) ? part2[(size_t)t * 16 + lane] : 0.f;
    ps = wave_sum(ps);
    const float rstd2 = 1.0f / sqrtf(ps * (1.0f / 1024.0f) + EPS);
    f32x4 hv[4]; float am = 0.f;
    { const u32x4* br = (const u32x4*)(h1b + (size_t)t * 1024 + 16 * lane); const u32x4 b0 = br[0], b1 = br[1];
      hv[0] = bf4_lo((u32x2){b0.x, b0.y}); hv[1] = bf4_lo((u32x2){b0.z, b0.w}); hv[2] = bf4_lo((u32x2){b1.x, b1.y}); hv[3] = bf4_lo((u32x2){b1.z, b1.w}); }
#pragma unroll
    for (int i = 0; i < 4; ++i) { am = fmaxf(am, fmaxf(fmaxf(fabsf(hv[i][0]), fabsf(hv[i][1])), fmaxf(fabsf(hv[i][2]), fabsf(hv[i][3])))); }
#pragma unroll
    for (int o = 1; o < 64; o <<= 1) am = fmaxf(am, __shfl_xor(am, o));
    const float sx = am > 0.f ? 127.0f / am : 1.0f, isx = am > 0.f ? am * (1.0f / 127.0f) : 1.0f;
    u32x4 xq;
#pragma unroll
    for (int i = 0; i < 4; ++i) { unsigned w = 0u;
#pragma unroll
        for (int c = 0; c < 4; ++c) w |= ((unsigned)(int)__builtin_rintf(hv[i][c] * sx) & 0xffu) << (8 * c);
        xq[i] = w; }
    *(LAS u32x4*)(xs + 16 * lane) = xq;
    const int iA = seli[(size_t)t * 128 + lane], iB = seli[(size_t)t * 128 + 64 + lane];
    const float gA = selg[(size_t)t * 128 + lane], gB = selg[(size_t)t * 128 + 64 + lane];
    k0 = ((unsigned)iA << 18) | ((unsigned)j << 16) | (unsigned)(gA * 65535.0f + 0.5f); k1 = ((unsigned)iB << 18) | ((unsigned)j << 16) | (unsigned)(gB * 65535.0f + 0.5f);
    return rstd2 * isx;
}
__device__ __forceinline__ void tok_finish_mixed(const f32x2 (&y2)[8], int t, int lane, const bf16* __restrict__ h1b, bf16* __restrict__ h2b, float* __restrict__ rstd3) {
    const u32x4* br = (const u32x4*)(h1b + (size_t)t * 1024 + 16 * lane); const u32x4 b0 = br[0], b1 = br[1];
    f32x4 h2[4]; h2[0] = bf4_lo((u32x2){b0.x, b0.y}); h2[1] = bf4_lo((u32x2){b0.z, b0.w}); h2[2] = bf4_lo((u32x2){b1.x, b1.y}); h2[3] = bf4_lo((u32x2){b1.z, b1.w});
    float sq = 0.f;
#pragma unroll
    for (int i = 0; i < 4; ++i) {
        h2[i] = h2[i] + (f32x4){y2[2 * i].x, y2[2 * i].y, y2[2 * i + 1].x, y2[2 * i + 1].y};
        sq += (h2[i][0] * h2[i][0] + h2[i][1] * h2[i][1]) + (h2[i][2] * h2[i][2] + h2[i][3] * h2[i][3]);
    }
    u32x4 w0, w1; w0.x = pk2(h2[0][0], h2[0][1]); w0.y = pk2(h2[0][2], h2[0][3]); w0.z = pk2(h2[1][0], h2[1][1]); w0.w = pk2(h2[1][2], h2[1][3]);
    w1.x = pk2(h2[2][0], h2[2][1]); w1.y = pk2(h2[2][2], h2[2][3]); w1.z = pk2(h2[3][0], h2[3][1]); w1.w = pk2(h2[3][2], h2[3][3]);
    u32x4* ob = (u32x4*)(h2b + (size_t)t * 1024 + 16 * lane); ob[0] = w0; ob[1] = w1;
    sq = wave_sum(sq);
    if (lane == 0) rstd3[t] = 1.0f / sqrtf(sq * (1.0f / 1024.0f) + EPS);
}
constexpr int MIX_LDS_WAVE = 4096 + 2048 + 64;
template <int PM>
__device__ __forceinline__ void gather_wg_mixed(int tok0, int wave, int lane, LAS unsigned char* lds, const unsigned char* __restrict__ U8, const unsigned char* __restrict__ V8, const float* __restrict__ IU, const float* __restrict__ IV,
                                                const int* __restrict__ seli, const float* __restrict__ selg, const float* __restrict__ part2, const bf16* __restrict__ h1b, bf16* __restrict__ h2b, float* __restrict__ rstd3, float* probe_out) {
    LAS unsigned char* xs = lds + wave * MIX_LDS_WAVE;
    LAS unsigned* ks = (LAS unsigned*)(xs + 4096);
    LAS float* rsl = (LAS float*)(xs + 4096 + 2048);
#pragma unroll 1
    for (int pass = 0; pass < 2; ++pass) {
        const int tb = tok0 + pass * 32 + wave * 4;
        unsigned k[8]; float rs0, rs1, rs2, rs3;
        rs0 = tok_setup_mixed(k[0], k[1], tb + 0, 0, fresh_lane(), xs, seli, selg, part2, h1b); __builtin_amdgcn_sched_barrier(0);
        rs1 = tok_setup_mixed(k[2], k[3], tb + 1, 1, fresh_lane(), xs + 1024, seli, selg, part2, h1b); __builtin_amdgcn_sched_barrier(0);
        rs2 = tok_setup_mixed(k[4], k[5], tb + 2, 2, fresh_lane(), xs + 2048, seli, selg, part2, h1b); __builtin_amdgcn_sched_barrier(0);
        rs3 = tok_setup_mixed(k[6], k[7], tb + 3, 3, fresh_lane(), xs + 3072, seli, selg, part2, h1b); __builtin_amdgcn_sched_barrier(0);
        lane = fresh_lane();
        sort_wave<8>(k, lane);
#pragma unroll
        for (int r = 0; r < 8; ++r) ks[lane + 64 * r] = k[r];
        if (lane == 0) { rsl[0] = rs0; rsl[1] = rs1; rsl[2] = rs2; rsl[3] = rs3; }
        __builtin_amdgcn_sched_barrier(0);
        f32x2 Y0[8], Y1[8], Y2[8], Y3[8];
#pragma unroll
        for (int i = 0; i < 8; ++i) { Y0[i] = (f32x2){0.f, 0.f}; Y1[i] = (f32x2){0.f, 0.f}; Y2[i] = (f32x2){0.f, 0.f}; Y3[i] = (f32x2){0.f, 0.f}; }
        __syncthreads();
        lane = fresh_lane();
#pragma unroll 1
        for (int b = 0; b < 32; ++b) {
            const unsigned kb = ks[16 * b + (lane & 15)];
            const unsigned key = ks[16 * b + (lane >> 2)];
            const int es = (int)(key >> 18); const int tq = (int)(key >> 16) & 3;
            const float rsx = rsl[tq];
            const float dus = IU[es] * rsx, gvs = (float)(key & 0xffffu) * (1.0f / 65535.0f) * IV[es];
            i32x4v A[16]; u32x4 vv[16];
#pragma unroll
            for (int q = 0; q < 16; ++q) { int e = (int)((unsigned)__builtin_amdgcn_readlane((int)kb, q) >> 18); if (PM & 32) e &= 1023; A[q] = *(const i32x4v*)(U8 + (size_t)e * 1024 + 16 * lane); }
#pragma unroll
            for (int q = 0; q < 16; ++q) { int e = (int)((unsigned)__builtin_amdgcn_readlane((int)kb, q) >> 18); if (PM & 32) e &= 1023; vv[q] = *(const u32x4*)(V8 + (size_t)e * 1024 + 16 * lane); }
            int pp[16];
#pragma unroll
            for (int q = 0; q < 16; ++q) {
                const int t = (__builtin_amdgcn_readlane((int)kb, q) >> 16) & 3;
                const i32x4v X = *(const LAS i32x4v*)(xs + t * 1024 + 16 * lane);
                pp[q] = __builtin_amdgcn_sdot4(A[q][3], X[3], __builtin_amdgcn_sdot4(A[q][2], X[2], __builtin_amdgcn_sdot4(A[q][1], X[1], __builtin_amdgcn_sdot4(A[q][0], X[0], 0, false), false), false), false);
            }
            const int tot = reduce16_rows(pp, lane);
            const float cf = gvs * gelu_tanh((float)tot * dus);
#pragma unroll
            for (int q = 0; q < 16; ++q) {
                const int t = (__builtin_amdgcn_readlane((int)kb, q) >> 16) & 3;
                const float cs = __int_as_float(__builtin_amdgcn_readlane(__float_as_int(cf), 4 * q));
                f32x2 x[8];
#pragma unroll
                for (int c = 0; c < 4; ++c) { x[2 * c] = __builtin_amdgcn_cvt_pk_f32_fp8(vv[q][c], false); x[2 * c + 1] = __builtin_amdgcn_cvt_pk_f32_fp8(vv[q][c], true); }
                axpy_dispatch2(t, 0, cs, x, Y0, Y1);
                axpy_dispatch2(t, 2, cs, x, Y2, Y3);
            }
            __builtin_amdgcn_sched_barrier(0);
        }
        if (PM != 0) { const int fl = fresh_lane(); f32x2 a = Y0[0] + Y1[0] + Y2[0] + Y3[0];
#pragma unroll
            for (int i = 1; i < 8; ++i) a += Y0[i] + Y1[i] + Y2[i] + Y3[i];
            probe_out[(size_t)tb * 64 + fl] = a.x + a.y; }
        else { const int fl = fresh_lane(); tok_finish_mixed(Y0, tb, fl, h1b, h2b, rstd3); tok_finish_mixed(Y1, tb + 1, fl, h1b, h2b, rstd3); tok_finish_mixed(Y2, tb + 2, fl, h1b, h2b, rstd3); tok_finish_mixed(Y3, tb + 3, fl, h1b, h2b, rstd3); }
        __syncthreads();
    }
}
namespace pg8 {
#define PG8_LAS __attribute__((address_space(3)))
typedef unsigned short bf16_t;
typedef short bf16x8 __attribute__((ext_vector_type(8)));
typedef float f32x4 __attribute__((ext_vector_type(4)));
typedef unsigned u32x4 __attribute__((ext_vector_type(4)));
constexpr int BM = 256, BK = 64, HALF = 128, HTB = HALF * BK * 2  , STAGE_BYTES = 8 * HTB, NXCD = 8, WGM = 8;

__host__ __device__ __forceinline__ int lds_byte(int r, int c) { const int st = (r >> 4) * 2 + (c >> 5), rr = r & 15, cc = c & 31, ob = rr * 64 + cc * 2; return st * 1024 + (ob ^ (((ob >> 9) & 1) << 5)); }
__host__ __device__ __forceinline__ void stage_rc(int b, int& R, int& C) { const int st = b / 1024, sb = b % 1024, swz = sb ^ (((sb >> 9) & 1) << 5); R = (st >> 1) * 16 + swz / 64; C = (st & 1) * 32 + (swz % 64) / 2; }
__host__ __device__ __forceinline__ int perm32(int rho) { const int n = rho >> 4, i = rho & 15; return 8 * (i >> 2) + 4 * n + (i & 3); }

struct Unit { int pm, pn; };
struct Gemm { const bf16_t* A; const bf16_t* Bt; int K, lda, apn_shift, apn_stride; };

struct StaticOrder {
    int nM, nN, nwg, G, c;
    __host__ __device__ __forceinline__ void init(int M, int N, int G_, int c_) { nM = M / BM; nN = N / BM; nwg = nM * nN; G = G_; c = c_; }
    __host__ __device__ __forceinline__ bool next(int i, Unit& u) const {
        const long L = (long)i * G + c; if (L >= nwg) return false;
        int wgid = (int)L; { const int q = nwg / NXCD, r = nwg % NXCD, xcd = wgid % NXCD, off = wgid / NXCD; wgid = (xcd < r ? xcd * (q + 1) : r * (q + 1) + (xcd - r) * q) + off; }
        const int nig = WGM * nN, gid = wgid / nig, fm = gid * WGM, gsz = (nM - fm) < WGM ? (nM - fm) : WGM;
        u.pm = fm + ((wgid % nig) % gsz); u.pn = (wgid % nig) / gsz; return true;
    }
    __device__ __forceinline__ void a_ready(const Unit&) const {}
    __device__ __forceinline__ void done(const Unit&) const {}
};

__device__ __forceinline__ unsigned cvt_pk_bf16(float lo, float hi) { unsigned r; asm volatile("v_cvt_pk_bf16_f32 %0, %1, %2" : "=v"(r) : "v"(lo), "v"(hi)); return r; }

template <class Epi, class Sched, bool ALIGN_EPI = false, bool SP2 = false>
__device__ __forceinline__ void gemm_phase(PG8_LAS unsigned char* lds, const Gemm g, const Sched& S, const Epi& E, int wave_id  ) {
    const int lane = fresh_lane(), wid = wave_id, tid = wid * 64 + lane, wr = wid >> 2, wc = wid & 3, fr = lane & 15, fq = lane >> 4;
    const int K = g.K, nt = K / BK;
    unsigned voffA[2], voffB[2];
#pragma unroll
    for (int i = 0; i < 2; ++i) { int R, C; stage_rc(tid * 16 + i * 8192, R, C); const int Rb = Epi::PERM ? ((R & ~31) + perm32(R & 31)) : R;
        voffA[i] = (unsigned)(R * g.lda + C) * 2u; voffB[i] = (unsigned)(Rb * K + C) * 2u; }
    const size_t kstep = (size_t)(BK * 2);
    const size_t hstepA = (size_t)HALF * g.lda * 2, hstepB = (size_t)HALF * K * 2;
    const size_t tstepA = 2 * hstepA, tstepB = 2 * hstepB;
    const unsigned ldsw = (unsigned)wid * 1024u;
    const int aoff = lds_byte(wr * 64 + fr, fq * 8), boff = lds_byte(wc * 32 + fr, fq * 8);
#define PG8_SA(b, h) (((b) * 2 + (h)) * HTB)
#define PG8_SB(b, h) ((4 + (b) * 2 + (h)) * HTB)
#define PG8_STAGE(bufoff, gbase, voff) do { _Pragma("unroll") for (int _i = 0; _i < 2; ++_i) \
        __builtin_amdgcn_global_load_lds((const unsigned*)((const char*)(gbase) + (voff)[_i]), (PG8_LAS unsigned*)(lds + (bufoff) + ldsw + _i * 8192), 16, 0, 0); } while (0)
#define PG8_LDA(dst, b, h) do { _Pragma("unroll") for (int m = 0; m < 4; ++m) _Pragma("unroll") for (int k = 0; k < 2; ++k) dst[m][k] = *(const PG8_LAS bf16x8*)(lds + PG8_SA(b, h) + aoff + m * 2048 + k * 1024); } while (0)
#define PG8_LDB(dst, b, h) do { _Pragma("unroll") for (int n = 0; n < 2; ++n) _Pragma("unroll") for (int k = 0; k < 2; ++k) dst[n][k] = *(const PG8_LAS bf16x8*)(lds + PG8_SB(b, h) + boff + n * 2048 + k * 1024); } while (0)
#define PG8_MMA(ai, bj, At, Bt) do { __builtin_amdgcn_s_setprio(1); _Pragma("unroll") for (int m = 0; m < 4; ++m) _Pragma("unroll") for (int n = 0; n < 2; ++n) _Pragma("unroll") for (int k = 0; k < 2; ++k) \
        acc[ai][bj][m][n] = __builtin_amdgcn_mfma_f32_16x16x32_bf16(Bt[n][k], At[m][k], acc[ai][bj][m][n], 0, 0, 0); __builtin_amdgcn_s_setprio(0); } while (0)
#define PG8_WAIT_V(n) asm volatile("s_waitcnt vmcnt(" #n ")" ::: "memory")
#define PG8_WAIT_L(n) asm volatile("s_waitcnt lgkmcnt(" #n ")" ::: "memory")
#define PG8_BAR __builtin_amdgcn_s_barrier()
#define PG8_SCHED __builtin_amdgcn_sched_barrier(0)
    Unit cur, nxt; int ui = 0;
    if (!S.next(0, cur)) return;
    f32x4 acc[2][2][4][2];
#pragma unroll
    for (int a = 0; a < 2; ++a)
#pragma unroll
        for (int b = 0; b < 2; ++b)
#pragma unroll
            for (int m = 0; m < 4; ++m)
#pragma unroll
                for (int n = 0; n < 2; ++n) acc[a][b][m][n] = (f32x4){0.f, 0.f, 0.f, 0.f};
    bf16x8 At[4][2], B0[2][2], B1[2][2];
    const char* cA = (const char*)g.A + (size_t)cur.pm * tstepA + (size_t)((cur.pn >> g.apn_shift) * g.apn_stride) * 2; const char* cB = (const char*)g.Bt + (size_t)cur.pn * tstepB;
    S.a_ready(cur);
    if constexpr (SP2) {
        PG8_STAGE(PG8_SB(0, 0), cB, voffB); PG8_STAGE(PG8_SB(0, 1), cB + hstepB, voffB); PG8_STAGE(PG8_SA(0, 0), cA, voffA); PG8_STAGE(PG8_SA(0, 1), cA + hstepA, voffA);
        if (wr == 1) PG8_BAR;
        PG8_WAIT_V(2); PG8_BAR;
        PG8_STAGE(PG8_SB(1, 0), cB + kstep, voffB); PG8_STAGE(PG8_SA(1, 0), cA + kstep, voffA); PG8_STAGE(PG8_SB(1, 1), cB + hstepB + kstep, voffB);
        PG8_WAIT_V(6); PG8_BAR;
    } else {
        PG8_STAGE(PG8_SB(0, 0), cB, voffB); PG8_STAGE(PG8_SA(0, 0), cA, voffA); PG8_STAGE(PG8_SB(0, 1), cB + hstepB, voffB); PG8_STAGE(PG8_SA(0, 1), cA + hstepA, voffA);
        if (wr == 1) PG8_BAR;
        PG8_WAIT_V(4); PG8_BAR;
        PG8_STAGE(PG8_SB(1, 0), cB + kstep, voffB); PG8_STAGE(PG8_SA(1, 0), cA + kstep, voffA); PG8_STAGE(PG8_SB(1, 1), cB + hstepB + kstep, voffB);
        PG8_WAIT_V(6); PG8_BAR;
    }
    for (;;) {
        const bool has_next = S.next(ui + 1, nxt);
        const char* nA = has_next ? (const char*)g.A + (size_t)nxt.pm * tstepA + (size_t)((nxt.pn >> g.apn_shift) * g.apn_stride) * 2 : cA; const char* nB = has_next ? (const char*)g.Bt + (size_t)nxt.pn * tstepB : cB;
#pragma unroll 1
        for (int t = 0; t < nt; t += 2) {
            const bool last = (t == nt - 2);
            const char* a1 = cA + (size_t)(t + 1) * kstep;
            const char* a2 = last ? nA : cA + (size_t)(t + 2) * kstep; const char* b2 = last ? nB : cB + (size_t)(t + 2) * kstep;
            const char* a3 = a2 + kstep; const char* b3 = b2 + kstep;
            if (last && has_next) S.a_ready(nxt);
            if constexpr (SP2) {
            PG8_LDB(B0, 0, 0); PG8_LDB(B1, 0, 1); PG8_SCHED; PG8_LDA(At, 0, 0); PG8_STAGE(PG8_SA(1, 1), a1 + hstepA, voffA);
            PG8_WAIT_V(8); PG8_WAIT_L(0); PG8_BAR; PG8_MMA(0, 0, At, B0); PG8_MMA(0, 1, At, B1); PG8_BAR; PG8_SCHED;
            PG8_LDA(At, 0, 1); PG8_STAGE(PG8_SB(0, 0), b2, voffB); PG8_STAGE(PG8_SB(0, 1), b2 + hstepB, voffB); PG8_STAGE(PG8_SA(0, 0), a2, voffA);
            PG8_WAIT_V(8); PG8_WAIT_L(0); PG8_BAR; PG8_MMA(1, 0, At, B0); PG8_MMA(1, 1, At, B1); PG8_BAR; PG8_SCHED;
            PG8_LDB(B0, 1, 0); PG8_LDB(B1, 1, 1); PG8_SCHED; PG8_LDA(At, 1, 0); PG8_STAGE(PG8_SA(0, 1), a2 + hstepA, voffA);
            PG8_WAIT_V(8); PG8_WAIT_L(0); PG8_BAR; PG8_MMA(0, 0, At, B0); PG8_MMA(0, 1, At, B1); PG8_BAR; PG8_SCHED;
            PG8_LDA(At, 1, 1); PG8_STAGE(PG8_SB(1, 0), b3, voffB); PG8_STAGE(PG8_SB(1, 1), b3 + hstepB, voffB); PG8_STAGE(PG8_SA(1, 0), a3, voffA);
            PG8_WAIT_V(8); PG8_WAIT_L(0); PG8_BAR; PG8_MMA(1, 0, At, B0); PG8_MMA(1, 1, At, B1); PG8_BAR; PG8_SCHED;
            } else {
            PG8_LDB(B0, 0, 0); PG8_SCHED; PG8_LDA(At, 0, 0); PG8_STAGE(PG8_SA(1, 1), a1 + hstepA, voffA);
            PG8_WAIT_L(8); PG8_BAR; PG8_WAIT_L(0); PG8_MMA(0, 0, At, B0); PG8_BAR; PG8_SCHED;
            PG8_LDB(B1, 0, 1); PG8_STAGE(PG8_SB(0, 0), b2, voffB);
            PG8_BAR; PG8_WAIT_L(0); PG8_MMA(0, 1, At, B1); PG8_BAR;
            PG8_LDA(At, 0, 1); PG8_STAGE(PG8_SA(0, 0), a2, voffA);
            PG8_BAR; PG8_WAIT_L(0); PG8_MMA(1, 0, At, B0); PG8_BAR; PG8_SCHED;
            PG8_STAGE(PG8_SB(0, 1), b2 + hstepB, voffB);
            PG8_WAIT_V(6); PG8_BAR; PG8_MMA(1, 1, At, B1); PG8_BAR;
            PG8_LDB(B0, 1, 0); PG8_SCHED; PG8_LDA(At, 1, 0); PG8_STAGE(PG8_SA(0, 1), a2 + hstepA, voffA);
            PG8_WAIT_L(8); PG8_BAR; PG8_WAIT_L(0); PG8_MMA(0, 0, At, B0); PG8_BAR; PG8_SCHED;
            PG8_LDB(B1, 1, 1); PG8_STAGE(PG8_SB(1, 0), b3, voffB);
            PG8_BAR; PG8_WAIT_L(0); PG8_MMA(0, 1, At, B1); PG8_BAR;
            PG8_LDA(At, 1, 1); PG8_STAGE(PG8_SA(1, 0), a3, voffA);
            PG8_BAR; PG8_WAIT_L(0); PG8_MMA(1, 0, At, B0); PG8_BAR; PG8_SCHED;
            PG8_STAGE(PG8_SB(1, 1), b3 + hstepB, voffB);
            PG8_WAIT_V(6); PG8_BAR; PG8_MMA(1, 1, At, B1); PG8_BAR;
            }
        }
        if constexpr (ALIGN_EPI) { if (wr == 0) PG8_BAR; }
        if constexpr (!Epi::AFTER_DRAIN) { E(acc, cur, wr, wc, fr, fq); S.done(cur); }
        if (!has_next) break;
#pragma unroll
        for (int a = 0; a < 2; ++a)
#pragma unroll
            for (int b = 0; b < 2; ++b)
#pragma unroll
                for (int m = 0; m < 4; ++m)
#pragma unroll
                    for (int n = 0; n < 2; ++n) acc[a][b][m][n] = (f32x4){0.f, 0.f, 0.f, 0.f};
        cur = nxt; cA = nA; cB = nB; ++ui;
        if constexpr (ALIGN_EPI) { if (wr == 1) PG8_BAR; }
    }
    PG8_WAIT_V(0);
    if constexpr (!ALIGN_EPI) { if (wr == 0) PG8_BAR; }
    PG8_BAR;
    if constexpr (Epi::AFTER_DRAIN) { E.fused(acc, cur, wr, wc, fr, fq, lds, wid, lane); S.done(cur); }
#undef PG8_SA
#undef PG8_SB
#undef PG8_STAGE
#undef PG8_LDA
#undef PG8_LDB
#undef PG8_MMA
#undef PG8_WAIT_V
#undef PG8_WAIT_L
#undef PG8_BAR
#undef PG8_SCHED
}
}
#define GAS __attribute__((address_space(1)))
typedef GAS unsigned gu32;
#define RLX_AGENT __ATOMIC_RELAXED, __HIP_MEMORY_SCOPE_AGENT
#define LDS_WAIT() asm volatile("s_waitcnt lgkmcnt(0)" ::: "memory")
#define VM_WAIT() asm volatile("s_waitcnt vmcnt(0)" ::: "memory")
#define XB_TMO      128
#define XB_XCNT(j)  (256  + 64 * (j))
#define XB_XSUB(j)  (1280 + 64 * (j))
#define XB_XGEN(j)  (2304 + 64 * (j))
#define XB_TOP      3328
#define XB_TOPGEN   3392
#define XCD_BAR_WORDS 3456
#define XB_SPIN_CAP (1u << 18)

__device__ __forceinline__ unsigned xb_ld(unsigned* p)              { return __hip_atomic_load(p, __ATOMIC_RELAXED, __HIP_MEMORY_SCOPE_AGENT); }
__device__ __forceinline__ unsigned xb_add(unsigned* p, unsigned v) { return __hip_atomic_fetch_add(p, v, __ATOMIC_RELAXED, __HIP_MEMORY_SCOPE_AGENT); }
__device__ __forceinline__ unsigned xb_xcc_id() { return (unsigned)__builtin_amdgcn_s_getreg((3 << 11) | 20) & 0xFu; }
#define XB_SPIN(cond, bar) do { unsigned _sp = 0; while (cond) { __builtin_amdgcn_s_sleep(1); \
    if ((++_sp & 255u) == 0u) { if (xb_ld(&(bar)[XB_TMO])) break; if (_sp > XB_SPIN_CAP) { atomicAdd(&(bar)[XB_TMO], 1u); break; } } } } while (0)

struct XcdBarrier {
    unsigned* bar; unsigned x;
    volatile LAS unsigned* st;
};

__device__ __forceinline__ XcdBarrier xcd_barrier_post(unsigned* bar, volatile LAS unsigned* st) {
    XcdBarrier b; b.bar = bar; b.x = xb_xcc_id(); b.st = st;
    if (threadIdx.x == 0) (void)xb_add(&bar[XB_XCNT(b.x)], 1u);
    return b;
}
__device__ __forceinline__ void xcd_barrier_complete(unsigned* bar, unsigned x, unsigned& nloc, unsigned& nx) {
    const unsigned G = gridDim.x * gridDim.y * gridDim.z;
    unsigned sum, cnt, mine, sp = 0u;
    for (;;) {
        sum = 0u; cnt = 0u; mine = 0u;
#pragma unroll
        for (unsigned j = 0; j < 16; ++j) { const unsigned c = xb_ld(&bar[XB_XCNT(j)]); sum += c; cnt += (c > 0u) ? 1u : 0u; mine = (j == x) ? c : mine; }
        if (sum == G) break;
        __builtin_amdgcn_s_sleep(1);
        if ((++sp & 255u) == 0u) { if (xb_ld(&bar[XB_TMO])) break; if (sp > XB_SPIN_CAP) { atomicAdd(&bar[XB_TMO], 1u); break; } }
    }
    nloc = mine > 0u ? mine : 1u; nx = cnt > 0u ? cnt : 1u;
}

__device__ __forceinline__ void xcd_barrier(const XcdBarrier& b) {
    asm volatile("s_waitcnt vmcnt(0)" ::: "memory");
    __syncthreads();
    if (threadIdx.x == 0) {
        unsigned* bar = b.bar;
        __builtin_amdgcn_s_waitcnt(0);
        unsigned nloc = b.st[0], nx = b.st[1];
        if (nloc == 0u) { xcd_barrier_complete(bar, b.x, nloc, nx); b.st[0] = nloc; b.st[1] = nx; }
        const unsigned old = xb_add(&bar[XB_XSUB(b.x)], 1u);
        const unsigned gen = old / nloc;
        if (old + 1u == (gen + 1u) * nloc) {
            __builtin_amdgcn_fence(__ATOMIC_RELEASE, "agent");
            asm volatile("s_waitcnt vmcnt(0)" ::: "memory");
            const unsigned og = xb_add(&bar[XB_TOP], 1u);
            const unsigned tg = og / nx;
            if (og + 1u == (tg + 1u) * nx) xb_add(&bar[XB_TOPGEN], 1u);
            else XB_SPIN(xb_ld(&bar[XB_TOPGEN]) == tg, bar);
            __builtin_amdgcn_fence(__ATOMIC_ACQUIRE, "agent");
            xb_add(&bar[XB_XGEN(b.x)], 1u);
            asm volatile("s_waitcnt vmcnt(0)" ::: "memory");
        } else {
            XB_SPIN(xb_ld(&bar[XB_XGEN(b.x)]) == gen, bar);
            __builtin_amdgcn_fence(__ATOMIC_ACQUIRE, "agent");
            asm volatile("s_waitcnt vmcnt(0)" ::: "memory");
        }
    }
    __syncthreads();
}

constexpr int NWAVES = 8;
constexpr int LDS_MAIN = 135168;
constexpr int LDSCTL_OFF = LDS_MAIN;
constexpr int LDS_BYTES = 147456;
constexpr int CW_BAR = 4096;
constexpr size_t CTL_ZERO_BYTES = 1 * MiB;
constexpr float LOG2E = 1.4426950408889634f;
typedef short bf16x8 __attribute__((ext_vector_type(8)));
typedef float f32x16 __attribute__((ext_vector_type(16)));
typedef unsigned u32x2 __attribute__((ext_vector_type(2)));
using pg8::Unit;
using pg8::cvt_pk_bf16;

__device__ __forceinline__ f32x4 sig4(f32x4 v) { return (f32x4){sigmoidf_(v[0]), sigmoidf_(v[1]), sigmoidf_(v[2]), sigmoidf_(v[3])}; }
__device__ __forceinline__ f32x4 gelu4(f32x4 v) { return (f32x4){gelu_tanh(v[0]), gelu_tanh(v[1]), gelu_tanh(v[2]), gelu_tanh(v[3])}; }
__device__ __forceinline__ u32x4 pack8(f32x4 a, f32x4 b) { u32x4 w; w.x = cvt_pk_bf16(a[0], a[1]); w.y = cvt_pk_bf16(a[2], a[3]); w.z = cvt_pk_bf16(b[0], b[1]); w.w = cvt_pk_bf16(b[2], b[3]); return w; }

struct OneUnit { pg8::StaticOrder S; int k;
    __device__ __forceinline__ bool next(int i, Unit& u) const { return i == 0 && S.next(k, u); }
    __device__ __forceinline__ void a_ready(const Unit&) const {}
    __device__ __forceinline__ void done(const Unit&) const {} };
struct EpiProj {
    static constexpr bool PERM = true, AFTER_DRAIN = false;
    const float* rstd; unsigned char* ws;
    __device__ __forceinline__ void operator()(const f32x4 (&acc)[2][2][4][2], const Unit& u, int wr, int wc, int fr, int fq) const {
        { const int t_ = fresh_lane(); fr = t_ & 15; fq = t_ >> 4; }
        const int pn = u.pn; bf16* base; int ldc, coff, act;
        if (pn < 3) { base = (bf16*)(ws + WS_QKV); ldc = 768; coff = pn * 256; act = 0; }
        else if (pn < 7) { base = (bf16*)(ws + WS_LX); ldc = 1024; coff = (pn - 3) * 256; act = 0; }
        else if (pn < 11) { base = (bf16*)(ws + WS_GL); ldc = 1024; coff = (pn - 7) * 256; act = 1; }
        else if (pn < 15) { base = (bf16*)(ws + WS_SGA); ldc = 1024; coff = (pn - 11) * 256; act = 2; }
        else { base = (bf16*)(ws + WS_SGL); ldc = 1024; coff = (pn - 15) * 256; act = 2; }
        const int row0 = u.pm * 256 + wr * 64 + fr, col0 = coff + wc * 32 + 8 * fq;
#pragma unroll
        for (int ai = 0; ai < 2; ++ai)
#pragma unroll
            for (int m = 0; m < 4; ++m) {
                const int r = row0 + ai * 128 + m * 16; const float rs = rstd[r]; bf16* rowp = base + (size_t)r * ldc + col0;
#pragma unroll
                for (int bj = 0; bj < 2; ++bj) {
                    f32x4 v0 = acc[ai][bj][m][0] * rs, v1 = acc[ai][bj][m][1] * rs;
                    if (act == 1) { v0 = gelu4(v0); v1 = gelu4(v1); } else if (act == 2) { v0 = sig4(v0); v1 = sig4(v1); }
                    *(u32x4*)(rowp + bj * 128) = pack8(v0, v1);
                }
            }
    }
};
struct EpiMP {
    static constexpr bool PERM = false, AFTER_DRAIN = false;
    const bf16* sga; float* mp;
    __device__ __forceinline__ void operator()(const f32x4 (&acc)[2][2][4][2], const Unit& u, int wr, int wc, int fr, int fq) const {
        { const int t_ = fresh_lane(); fr = t_ & 15; fq = t_ >> 4; }
        const int row0 = u.pm * 256 + wr * 64 + fr, col0 = u.pn * 256 + wc * 32 + 4 * fq;
#pragma unroll
        for (int ai = 0; ai < 2; ++ai)
#pragma unroll
            for (int m = 0; m < 4; ++m) {
                const size_t off = (size_t)(row0 + ai * 128 + m * 16) * 1024 + col0;
#pragma unroll
                for (int bj = 0; bj < 2; ++bj)
#pragma unroll
                    for (int n = 0; n < 2; ++n) { const size_t o = off + bj * 128 + n * 16; const f32x4 g = bf4_lo(*(const u32x2*)(sga + o)); const f32x4 v = acc[ai][bj][m][n] * g;
#if ALL_FUSED
                        u32x2 w; w.x = cvt_pk_bf16(v[0], v[1]); w.y = cvt_pk_bf16(v[2], v[3]); *(u32x2*)((bf16*)mp + o) = w;
#else
                        *(f32x4*)(mp + o) = v;
#endif
                    }
            }
    }
};
struct EpiMerged {
    static constexpr bool PERM = true, AFTER_DRAIN = false;
    const bf16* sgl; const float* mp; bf16* merged;
    __device__ __forceinline__ void operator()(const f32x4 (&acc)[2][2][4][2], const Unit& u, int wr, int wc, int fr, int fq) const {
        { const int t_ = fresh_lane(); fr = t_ & 15; fq = t_ >> 4; }
        const int row0 = u.pm * 256 + wr * 64 + fr, col0 = u.pn * 256 + wc * 32 + 8 * fq;
#pragma unroll
        for (int ai = 0; ai < 2; ++ai)
#pragma unroll
            for (int m = 0; m < 4; ++m) {
                const size_t off = (size_t)(row0 + ai * 128 + m * 16) * 1024 + col0;
#pragma unroll
                for (int bj = 0; bj < 2; ++bj) {
                    const size_t o = off + bj * 128; const u32x4 gw = *(const u32x4*)(sgl + o);
#if ALL_FUSED
                    const u32x4 mw = *(const u32x4*)((const bf16*)mp + o); const f32x4 m0 = bf4_lo((u32x2){mw.x, mw.y}), m1 = bf4_lo((u32x2){mw.z, mw.w});
#else
                    const f32x4 m0 = *(const f32x4*)(mp + o), m1 = *(const f32x4*)(mp + o + 4);
#endif
                    const f32x4 v0 = m0 + acc[ai][bj][m][0] * bf4_lo((u32x2){gw.x, gw.y}), v1 = m1 + acc[ai][bj][m][1] * bf4_lo((u32x2){gw.z, gw.w});
                    *(u32x4*)(merged + o) = pack8(v0, v1);
                }
            }
    }
};
struct EpiH1 {
    static constexpr bool PERM = true, AFTER_DRAIN = false;
    const float* x; float* h1; bf16* h1b; float* part;
    __device__ __forceinline__ void operator()(const f32x4 (&acc)[2][2][4][2], const Unit& u, int wr, int wc, int fr, int fq) const {
        { const int t_ = fresh_lane(); fr = t_ & 15; fq = t_ >> 4; }
        const int row0 = u.pm * 256 + wr * 64 + fr, col0 = u.pn * 256 + wc * 32 + 8 * fq;
#pragma unroll
        for (int ai = 0; ai < 2; ++ai)
#pragma unroll
            for (int m = 0; m < 4; ++m) {
                const int r = row0 + ai * 128 + m * 16; const size_t off = (size_t)r * 1024 + col0; float sq = 0.f;
#pragma unroll
                for (int bj = 0; bj < 2; ++bj) {
                    const size_t o = off + bj * 128;
                    const f32x4 v0 = *(const f32x4*)(x + o) + acc[ai][bj][m][0], v1 = *(const f32x4*)(x + o + 4) + acc[ai][bj][m][1];
#if !ALL_FUSED
                    *(f32x4*)(h1 + o) = v0; *(f32x4*)(h1 + o + 4) = v1;
#endif
                    *(u32x4*)(h1b + o) = pack8(v0, v1);
                    sq += (v0[0] * v0[0] + v0[1] * v0[1]) + (v0[2] * v0[2] + v0[3] * v0[3]) + (v1[0] * v1[0] + v1[1] * v1[1]) + (v1[2] * v1[2] + v1[3] * v1[3]);
                }
                sq += __shfl_xor(sq, 16); sq += __shfl_xor(sq, 32);
                if (fq == 0) part[(size_t)r * 16 + u.pn * 4 + wc] = sq;
            }
    }
};
struct EpiScore {
    static constexpr bool PERM = false, AFTER_DRAIN = false;
    const float* part; float* sc;
    __device__ __forceinline__ void operator()(const f32x4 (&acc)[2][2][4][2], const Unit& u, int wr, int wc, int fr, int fq) const {
        { const int t_ = fresh_lane(); fr = t_ & 15; fq = t_ >> 4; }
        const int row0 = u.pm * 256 + wr * 64 + fr, col0 = u.pn * 256 + wc * 32 + 4 * fq;
#pragma unroll
        for (int ai = 0; ai < 2; ++ai)
#pragma unroll
            for (int m = 0; m < 4; ++m) {
                const int r = row0 + ai * 128 + m * 16; const f32x4* pp = (const f32x4*)(part + (size_t)r * 16);
                const f32x4 s4 = (pp[0] + pp[1]) + (pp[2] + pp[3]); const float rs = 1.0f / sqrtf(((s4[0] + s4[1]) + (s4[2] + s4[3])) * (1.0f / 1024.0f) + EPS);
                const size_t off = (size_t)r * 1024 + col0;
#pragma unroll
                for (int bj = 0; bj < 2; ++bj)
#pragma unroll
                    for (int n = 0; n < 2; ++n) *(f32x4*)(sc + off + bj * 128 + n * 16) = acc[ai][bj][m][n] * rs;
            }
    }
};
struct EpiTopk {
    static constexpr bool PERM = false, AFTER_DRAIN = true;
    const float* part; int* seli; float* selg;
    __device__ __forceinline__ void fused(f32x4 (&acc)[2][2][4][2], const Unit& u, int wr, int wc, int fr, int fq, PG8_LAS unsigned char* lds, int wid, int lane) const {
        LAS float* L = (LAS float*)lds;
#pragma unroll
        for (int ai = 0; ai < 2; ++ai) {
            { const int t_ = fresh_lane(); fr = t_ & 15; fq = t_ >> 4; }
#pragma unroll
            for (int m = 0; m < 4; ++m) {
                const int rl = wr * 64 + m * 16 + fr, r = u.pm * 256 + ai * 128 + rl;
                const f32x4* pp = (const f32x4*)(part + (size_t)r * 16);
                const f32x4 s4 = (pp[0] + pp[1]) + (pp[2] + pp[3]); const float rs = 1.0f / sqrtf(((s4[0] + s4[1]) + (s4[2] + s4[3])) * (1.0f / 1024.0f) + EPS);
#pragma unroll
                for (int bj = 0; bj < 2; ++bj)
#pragma unroll
                    for (int n = 0; n < 2; ++n) *(LAS f32x4*)(L + (rl * 2 + bj) * TK_LSTRIDE + wc * 32 + 16 * n + 4 * fq) = acc[ai][bj][m][n] * rs;
            }
            asm volatile("s_waitcnt lgkmcnt(0)" ::: "memory"); __builtin_amdgcn_s_barrier(); asm volatile("" ::: "memory");
            const int tid = wid * 64 + fresh_lane();
            if (wid < 4) {
                const LAS float* my = L + tid * TK_LSTRIDE;
                unsigned a16[16];
#pragma unroll
                for (int g = 0; g < 8; ++g) {
                    unsigned t[16];
#pragma unroll
                    for (int q = 0; q < 4; ++q) {
                        const f32x4 v = *(const LAS f32x4*)(my + g * 16 + q * 4);
#pragma unroll
                        for (int c = 0; c < 4; ++c) { const int e = g * 16 + q * 4 + c; const float vc = v[c]; t[q * 4 + c] = (tk_f2key(vc) & ~127u) | (unsigned)(127 - e); }
                    }
                    tk_sort16(t);
                    if (g == 0) {
#pragma unroll
                        for (int i = 0; i < 16; ++i) a16[i] = t[i];
                    } else tk_merge16(a16, t);
                }
                unsigned oth[16];
#pragma unroll
                for (int i = 0; i < 16; ++i) oth[i] = (unsigned)__shfl_xor((int)a16[i], 1);
                if ((tid & 1) == 0) {
                    const int tok = u.pm * 256 + ai * 128 + (tid >> 1);
                    tk_combine_store(a16, oth, seli + (size_t)tok * 128 + u.pn * 16, selg + (size_t)tok * 128 + u.pn * 16);
                }
            }
            asm volatile("s_waitcnt lgkmcnt(0)" ::: "memory"); __builtin_amdgcn_s_barrier(); asm volatile("" ::: "memory");
        }
    }
};
struct EpiPP {
    static constexpr bool PERM = true, AFTER_DRAIN = false;
    bf16* pp;
    __device__ __forceinline__ void operator()(const f32x4 (&acc)[2][2][4][2], const Unit& u, int wr, int wc, int fr, int fq) const {
        { const int t_ = fresh_lane(); fr = t_ & 15; fq = t_ >> 4; }
        const int row0 = u.pm * 256 + wr * 64 + fr, col0 = u.pn * 256 + wc * 32 + 8 * fq;
#pragma unroll
        for (int ai = 0; ai < 2; ++ai)
#pragma unroll
            for (int m = 0; m < 4; ++m) {
                const size_t off = (size_t)(row0 + ai * 128 + m * 16) * 1024 + col0;
#pragma unroll
                for (int bj = 0; bj < 2; ++bj) *(u32x4*)(pp + off + bj * 128) = pack8(acc[ai][bj][m][0], acc[ai][bj][m][1]);
            }
    }
};
struct EpiH3 {
    static constexpr bool PERM = true, AFTER_DRAIN = false;
    const float* rstd3; const bf16* pp; float* h; float* part; const bf16* h2b; bf16* h3b;
    __device__ __forceinline__ void operator()(const f32x4 (&acc)[2][2][4][2], const Unit& u, int wr, int wc, int fr, int fq) const {
        { const int t_ = fresh_lane(); fr = t_ & 15; fq = t_ >> 4; }
        const int row0 = u.pm * 256 + wr * 64 + fr, col0 = u.pn * 256 + wc * 32 + 8 * fq;
#pragma unroll
        for (int ai = 0; ai < 2; ++ai)
#pragma unroll
            for (int m = 0; m < 4; ++m) {
                const int r = row0 + ai * 128 + m * 16; const size_t off = (size_t)r * 1024 + col0; const float rs = rstd3[r]; float sq = 0.f;
#pragma unroll
                for (int bj = 0; bj < 2; ++bj) {
                    const size_t o = off + bj * 128; const u32x4 pw = *(const u32x4*)(pp + o);
#if ALL_FUSED
                    const u32x4 hw = *(const u32x4*)(h2b + o);
                    const f32x4 v0 = bf4_lo((u32x2){hw.x, hw.y}) + sig4(acc[ai][bj][m][0] * rs) * bf4_lo((u32x2){pw.x, pw.y});
                    const f32x4 v1 = bf4_lo((u32x2){hw.z, hw.w}) + sig4(acc[ai][bj][m][1] * rs) * bf4_lo((u32x2){pw.z, pw.w});
                    *(u32x4*)(h3b + o) = pack8(v0, v1);
#else
                    const f32x4 v0 = *(const f32x4*)(h + o) + sig4(acc[ai][bj][m][0] * rs) * bf4_lo((u32x2){pw.x, pw.y});
                    const f32x4 v1 = *(const f32x4*)(h + o + 4) + sig4(acc[ai][bj][m][1] * rs) * bf4_lo((u32x2){pw.z, pw.w});
                    *(f32x4*)(h + o) = v0; *(f32x4*)(h + o + 4) = v1;
#endif
                    sq += (v0[0] * v0[0] + v0[1] * v0[1]) + (v0[2] * v0[2] + v0[3] * v0[3]) + (v1[0] * v1[0] + v1[1] * v1[1]) + (v1[2] * v1[2] + v1[3] * v1[3]);
                }
                sq += __shfl_xor(sq, 16); sq += __shfl_xor(sq, 32);
                if (fq == 0) part[(size_t)r * 16 + u.pn * 4 + wc] = sq;
            }
    }
};
struct EpiPre {
    static constexpr bool PERM = false, AFTER_DRAIN = false;
    float* rp; float* ip;
    __device__ __forceinline__ void operator()(const f32x4 (&acc)[2][2][4][2], const Unit& u, int wr, int wc, int fr, int fq) const {
        { const int t_ = fresh_lane(); fr = t_ & 15; fq = t_ >> 4; }
#pragma unroll
        for (int n = 0; n < 2; ++n) { const int ch = u.pn * 128 + wc * 32 + 16 * n + 4 * fq;
#pragma unroll
            for (int ai = 0; ai < 2; ++ai)
#pragma unroll
                for (int m = 0; m < 4; ++m) { const int r = u.pm * 256 + ai * 128 + wr * 64 + m * 16 + fr; const size_t o = (size_t)r * 1024 + ch; *(f32x4*)(rp + o) = acc[ai][0][m][n]; *(f32x4*)(ip + o) = acc[ai][1][m][n]; } }
    }
};
struct EpiH3Final {
    static constexpr bool PERM = true, AFTER_DRAIN = false;
    const float* rstd3; const bf16* pp; const bf16* h2b; const float* fg; float* out; float* part; unsigned* cnt;
    __device__ __forceinline__ void operator()(f32x4 (&acc)[2][2][4][2], const Unit& u, int wr, int wc, int fr, int fq) const {
        { const int t_ = fresh_lane(); fr = t_ & 15; fq = t_ >> 4; }
        const int row0 = u.pm * 256 + wr * 64 + fr, col0 = u.pn * 256 + wc * 32 + 8 * fq;
#pragma unroll
        for (int ai = 0; ai < 2; ++ai)
#pragma unroll
            for (int m = 0; m < 4; ++m) {
                const int r = row0 + ai * 128 + m * 16; const size_t off = (size_t)r * 1024 + col0; const float rs = rstd3[r]; float sq = 0.f;
#pragma unroll
                for (int bj = 0; bj < 2; ++bj) {
                    const size_t o = off + bj * 128; const u32x4 pw = *(const u32x4*)(pp + o); const u32x4 hw = *(const u32x4*)(h2b + o);
                    const f32x4 v0 = bf4_lo((u32x2){hw.x, hw.y}) + sig4(acc[ai][bj][m][0] * rs) * bf4_lo((u32x2){pw.x, pw.y});
                    const f32x4 v1 = bf4_lo((u32x2){hw.z, hw.w}) + sig4(acc[ai][bj][m][1] * rs) * bf4_lo((u32x2){pw.z, pw.w});
                    acc[ai][bj][m][0] = v0; acc[ai][bj][m][1] = v1;
                    sq += (v0[0] * v0[0] + v0[1] * v0[1]) + (v0[2] * v0[2] + v0[3] * v0[3]) + (v1[0] * v1[0] + v1[1] * v1[1]) + (v1[2] * v1[2] + v1[3] * v1[3]);
                }
                sq += __shfl_xor(sq, 16); sq += __shfl_xor(sq, 32);
                if (fq == 0) __hip_atomic_store(part + (size_t)r * 16 + u.pn * 4 + wc, sq, __ATOMIC_RELAXED, __HIP_MEMORY_SCOPE_AGENT);
            }
        asm volatile("s_waitcnt vmcnt(0)" ::: "memory");
        const int lane = fq * 16 + fr;
        unsigned* c = cnt + 64 * u.pm;
        if (lane == 0) __hip_atomic_fetch_add(c, 1u, __ATOMIC_RELAXED, __HIP_MEMORY_SCOPE_AGENT);
        {
            const unsigned long long t0 = __builtin_amdgcn_s_memrealtime();
            while ((unsigned)__builtin_amdgcn_readfirstlane((int)__hip_atomic_load(c, __ATOMIC_RELAXED, __HIP_MEMORY_SCOPE_AGENT)) < 32u) {
                if (__builtin_amdgcn_s_memrealtime() - t0 > 2000000ull) break;
                __builtin_amdgcn_s_sleep(2);
            }
        }
        { const int t_ = fresh_lane(); fr = t_ & 15; fq = t_ >> 4; }
#pragma unroll
        for (int ai = 0; ai < 2; ++ai)
#pragma unroll
            for (int m = 0; m < 4; ++m) {
                const int r = u.pm * 256 + wr * 64 + fr + ai * 128 + m * 16;
                float ps = 0.f;
#pragma unroll
                for (int k = 0; k < 16; ++k) ps += __hip_atomic_load(part + (size_t)r * 16 + k, __ATOMIC_RELAXED, __HIP_MEMORY_SCOPE_AGENT);
                const float rr = 1.0f / sqrtf(ps * (1.0f / 1024.0f) + EPS);
                const int cc = u.pn * 256 + wc * 32 + 8 * fq;
#pragma unroll
                for (int bj = 0; bj < 2; ++bj) {
                    const f32x4 g0 = *(const f32x4*)(fg + cc + bj * 128), g1 = *(const f32x4*)(fg + cc + bj * 128 + 4);
                    float* op = out + (size_t)r * 1024 + cc + bj * 128;
                    *(f32x4*)op = acc[ai][bj][m][0] * rr * g0; *(f32x4*)(op + 4) = acc[ai][bj][m][1] * rr * g1;
                }
            }
    }
};
template <int CTRL> __device__ __forceinline__ float dpp_f(float oldv, float src) {
    return __builtin_bit_cast(float, __builtin_amdgcn_update_dpp(__builtin_bit_cast(int, oldv), __builtin_bit_cast(int, src), CTRL, 0xf, 0xf, false));
}
#ifndef LRU_T2
#define LRU_T2 0
#endif
struct EpiLru {
    static constexpr bool PERM = false, AFTER_DRAIN = false;
    const bf16* lin; const float* ba; const float* bx; const float* c8l; bf16* hloc; bf16* pcum; float* agg;
    template <int SH> static __device__ __forceinline__ void step(f32x4& A, f32x4& Bv, float idd) {
#pragma unroll
        for (int j = 0; j < 4; ++j) {
            const float ap = __int_as_float(__builtin_amdgcn_update_dpp(0, __float_as_int((float)A[j]), 0x110 + SH, 0xf, 0xf, true)) + idd;
            const float bp = __int_as_float(__builtin_amdgcn_update_dpp(0, __float_as_int((float)Bv[j]), 0x110 + SH, 0xf, 0xf, true));
            Bv[j] = fmaf(A[j], bp, Bv[j]); A[j] = A[j] * ap; }
    }
    __device__ __forceinline__ void operator()(f32x4 (&acc)[2][2][4][2], const Unit& u, int wr, int wc, int fr, int fq) const {
        { const int t_ = fresh_lane(); fr = t_ & 15; fq = t_ >> 4; }
        const int lane = fq * 16 + fr;
#pragma unroll
        for (int n = 0; n < 2; ++n) {
            const int ch = u.pn * 128 + wc * 32 + 16 * n + 4 * fq;
            const f32x4 bav = *(const f32x4*)(ba + ch), bxv = *(const f32x4*)(bx + ch), cv = *(const f32x4*)(c8l + ch);
#pragma unroll
            for (int ai = 0; ai < 2; ++ai)
#pragma unroll
                for (int m = 0; m < 4; ++m) {
                    const int r = u.pm * 256 + ai * 128 + wr * 64 + m * 16 + fr; const unsigned o = (unsigned)r * 1024u + (unsigned)ch;
                    const f32x4 lv = bf4_lo(*(const u32x2*)(lin + o));
#pragma unroll
                    for (int j = 0; j < 4; ++j) {
                        const float rr = sigmoidf_(acc[ai][0][m][n][j] + bav[j]), ii = sigmoidf_(acc[ai][1][m][n][j] + bxv[j]);
                        const float a = __builtin_amdgcn_exp2f(cv[j] * rr);
                        acc[ai][0][m][n][j] = a; acc[ai][1][m][n][j] = __builtin_amdgcn_sqrtf(fmaxf(1.0f - a * a, 0.f)) * (ii * lv[j]);
                    }
                    asm volatile("" : "+v"(acc[ai][0][m][n]), "+v"(acc[ai][1][m][n]));
                }
        }
#if defined(LRU_DEBUG) && LRU_DEBUG == 1
        {
            float* af = (float*)hloc; float* bf = (float*)pcum;
#pragma unroll
            for (int n = 0; n < 2; ++n) { const int ch = u.pn * 128 + wc * 32 + 16 * n + 4 * fq;
#pragma unroll
                for (int ai = 0; ai < 2; ++ai)
#pragma unroll
                    for (int m = 0; m < 4; ++m) { const int r = u.pm * 256 + ai * 128 + wr * 64 + m * 16 + fr; const size_t o = (size_t)r * 1024 + ch; *(f32x4*)(af + o) = acc[ai][0][m][n]; *(f32x4*)(bf + o) = acc[ai][1][m][n]; } }
            return;
        }
#endif
        __builtin_amdgcn_sched_barrier(0);
        const float id1 = fr < 1 ? 1.f : 0.f, id2 = fr < 2 ? 1.f : 0.f, id4 = fr < 4 ? 1.f : 0.f, id8 = fr < 8 ? 1.f : 0.f;
#pragma unroll
        for (int ai = 0; ai < 2; ++ai)
#pragma unroll
            for (int m = 0; m < 4; ++m)
#pragma unroll
                for (int n = 0; n < 2; ++n) { step<1>(acc[ai][0][m][n], acc[ai][1][m][n], id1); step<2>(acc[ai][0][m][n], acc[ai][1][m][n], id2); step<4>(acc[ai][0][m][n], acc[ai][1][m][n], id4); step<8>(acc[ai][0][m][n], acc[ai][1][m][n], id8);
                    asm volatile("" : "+v"(acc[ai][0][m][n]), "+v"(acc[ai][1][m][n])); }
        { const int t_ = fresh_lane(); fr = t_ & 15; fq = t_ >> 4; }
        const int src4 = (((fq * 16 + fr) & 48) | 15) * 4;
#pragma unroll
        for (int n = 0; n < 2; ++n) {
            const int ch = u.pn * 128 + wc * 32 + 16 * n + 4 * fq;
#pragma unroll
            for (int ai = 0; ai < 2; ++ai) {
#pragma unroll
                for (int m = 0; m < 4; ++m) {
                    f32x4& A = acc[ai][0][m][n]; f32x4& Bv = acc[ai][1][m][n];
                    if (m > 0 && !(LRU_T2)) {
#pragma unroll
                        for (int j = 0; j < 4; ++j) { const float pa = acc[ai][0][m - 1][n][j], pb = acc[ai][1][m - 1][n][j];
                            const float ac = __int_as_float(__builtin_amdgcn_ds_bpermute(src4, __float_as_int(pa))), bc = __int_as_float(__builtin_amdgcn_ds_bpermute(src4, __float_as_int(pb))); Bv[j] = fmaf(A[j], bc, Bv[j]); A[j] = A[j] * ac; }
                    }
                    const int r = u.pm * 256 + ai * 128 + wr * 64 + m * 16 + fr; const unsigned o = (unsigned)r * 1024u + (unsigned)ch;
                    u32x2 wp, wh; wp.x = cvt_pk_bf16(A[0], A[1]); wp.y = cvt_pk_bf16(A[2], A[3]); wh.x = cvt_pk_bf16(Bv[0], Bv[1]); wh.y = cvt_pk_bf16(Bv[2], Bv[3]);
                    *(u32x2*)(pcum + o) = wp; *(u32x2*)(hloc + o) = wh;
                    if (m == 3 && fr == 15) {
                        const int chunk = u.pm * 4 + ai * 2 + wr; float* ap = agg + ((size_t)chunk * 1024 + ch) * 2;
                        *(f32x4*)(ap) = (f32x4){A[0], Bv[0], A[1], Bv[1]}; *(f32x4*)(ap + 4) = (f32x4){A[2], Bv[2], A[3], Bv[3]};
                    }
                    __builtin_amdgcn_sched_barrier(0);
                }
            }
        }
    }
};

__device__ __forceinline__ void p0_transpose_item(const float* W, int ldw, const float* gain, bf16* WT, int ldt, int k_off, LAS float* scr, int kb, int nb, int lane) {
    const int k0 = 64 * kb, n0 = 32 * nb;
    const int c4 = lane & 7, kr = lane >> 3;
    f32x4 v[8];
#pragma unroll
    for (int i = 0; i < 8; ++i) v[i] = *(const f32x4*)(W + (size_t)(k0 + 8 * i + kr) * ldw + n0 + 4 * c4);
#pragma unroll
    for (int i = 0; i < 8; ++i) { f32x4 x = v[i]; if (gain) x = x * gain[k0 + 8 * i + kr]; *(LAS f32x4*)(scr + (8 * i + kr) * 36 + 4 * c4) = x; }
    LDS_WAIT(); asm volatile("" ::: "memory");
    const int c = lane & 7;
#pragma unroll
    for (int j = 0; j < 4; ++j) { const int n = (lane >> 3) + 8 * j; const LAS float* sp = scr + (8 * c) * 36 + n;
        u32x4 o; o.x = pk2(sp[0 * 36], sp[1 * 36]); o.y = pk2(sp[2 * 36], sp[3 * 36]); o.z = pk2(sp[4 * 36], sp[5 * 36]); o.w = pk2(sp[6 * 36], sp[7 * 36]);
        *(u32x4*)(WT + (size_t)(n0 + n) * ldt + k_off + k0 + 8 * c) = o; }
    LDS_WAIT(); asm volatile("" ::: "memory");
}
__device__ __forceinline__ void p0_wfold_item(LAS float* lds, const float* wq, const float* k1, const float* k2, const float* gffn, bf16* wfold, int item, int tid) {
    const int hh = item >> 4, kb = item & 15;
    LAS float* wqs = lds; LAS float* kks = lds + 64 * 132;
    const float* ksrc = (hh & 1) ? k2 : k1;
#pragma unroll
    for (int i = 0; i < 4; ++i) { const int e = tid + i * 512, r = e >> 5, c4 = e & 31; *(LAS f32x4*)(wqs + r * 132 + 4 * c4) = *(const f32x4*)(wq + (size_t)(kb * 64 + r) * 2048 + hh * 128 + 4 * c4); }
#pragma unroll
    for (int i = 0; i < 8; ++i) { const int e = tid + i * 512, r = e >> 5, c4 = e & 31; *(LAS f32x4*)(kks + r * 132 + 4 * c4) = *(const f32x4*)(ksrc + (size_t)r * 128 + 4 * c4); }
    __syncthreads();
    const int tk = tid & 15, tkey = tid >> 4;
    float acc[4][4];
#pragma unroll
    for (int i = 0; i < 4; ++i)
#pragma unroll
        for (int j = 0; j < 4; ++j) acc[i][j] = 0.f;
#pragma unroll 2
    for (int c4 = 0; c4 < 32; ++c4) {
        f32x4 a[4], b[4];
#pragma unroll
        for (int i = 0; i < 4; ++i) { a[i] = *(const LAS f32x4*)(wqs + (tk * 4 + i) * 132 + 4 * c4); b[i] = *(const LAS f32x4*)(kks + (tkey * 4 + i) * 132 + 4 * c4); }
#pragma unroll
        for (int i = 0; i < 4; ++i)
#pragma unroll
            for (int j = 0; j < 4; ++j) acc[i][j] += (a[i][0] * b[j][0] + a[i][1] * b[j][1]) + (a[i][2] * b[j][2] + a[i][3] * b[j][3]);
    }
    const int kg = kb * 64 + tk * 4; const f32x4 gv = *(const f32x4*)(gffn + kg);
#pragma unroll
    for (int j = 0; j < 4; ++j) { u32x2 w; w.x = pk2(acc[0][j] * gv[0], acc[1][j] * gv[1]); w.y = pk2(acc[2][j] * gv[2], acc[3][j] * gv[3]);
        *(u32x2*)(wfold + (size_t)(hh * 128 + tkey * 4 + j) * 1024 + kg) = w; }
    __syncthreads();
}

struct In { const float* p[25]; };
enum { I_X = 0, I_P, I_GMIX, I_WIN, I_SINK, I_CONVW, I_CONVB, I_WA, I_BA, I_WX, I_BX, I_LAM, I_WUA, I_WUL, I_WO, I_GFFN, I_WQ, I_K1, I_K2, I_U, I_V, I_GPLE, I_WGATE, I_WPROJ, I_FG };

__device__ __forceinline__ void p0_prologue(const In& in, unsigned char* ws, LAS unsigned char* lds, int vcu, int G, int wave, int tid) {
    const int lane = tid & 63;
    LAS float* scr = (LAS float*)(lds + wave * 16384);
    const int gw = vcu * NWAVES + wave, NGW = G * NWAVES;
    constexpr int I_IN = 16 * 152, I_UA = 8 * 32, I_SQ = 16 * 32, I_PJ = 4 * 32, I_AX = 128;
    constexpr int NITEMS = I_IN + I_UA + 3 * I_SQ + I_PJ + I_AX;
    for (int it = gw; it < NITEMS; it += NGW) {
        int r = it;
        if (r < I_IN) { p0_transpose_item(in.p[I_WIN], INW, in.p[I_GMIX], (bf16*)(ws + WS_WIN), 1024, 0, scr, r / 152, r % 152, lane); continue; } r -= I_IN;
        if (r < I_UA) { p0_transpose_item(in.p[I_WUA], 1024, nullptr, (bf16*)(ws + WS_WUA), 512, 0, scr, r / 32, r % 32, lane); continue; } r -= I_UA;
        if (r < I_SQ) { p0_transpose_item(in.p[I_WUL], 1024, nullptr, (bf16*)(ws + WS_WUL), 1024, 0, scr, r / 32, r % 32, lane); continue; } r -= I_SQ;
        if (r < I_SQ) { p0_transpose_item(in.p[I_WO], 1024, nullptr, (bf16*)(ws + WS_WO), 1024, 0, scr, r / 32, r % 32, lane); continue; } r -= I_SQ;
        if (r < I_SQ) { p0_transpose_item(in.p[I_WGATE], 1024, in.p[I_GPLE], (bf16*)(ws + WS_WG), 1024, 0, scr, r / 32, r % 32, lane); continue; } r -= I_SQ;
        if (r < I_PJ) { p0_transpose_item(in.p[I_WPROJ], 1024, nullptr, (bf16*)(ws + WS_WPROJ), 256, 0, scr, r / 32, r % 32, lane); continue; } r -= I_PJ;
        { const int blk = r >> 4, which = (r >> 3) & 1, sub = r & 7;

#if LRU_PADDED
#if LRU_PADDED == 2
          p0_transpose_item(in.p[which ? I_WX : I_WA] + (size_t)blk * 16384, 128, nullptr, (bf16*)(ws + WS_WAX) + (size_t)blk * 32768 + which * 128 * 128, 128, 0, scr, sub >> 2, sub & 3, lane); }
#else
          p0_transpose_item(in.p[which ? I_WX : I_WA] + (size_t)blk * 16384, 128, nullptr, (bf16*)(ws + WS_WAX) + (size_t)blk * 65536 + which * 128 * 256, 256, (blk & 1) * 128, scr, sub >> 2, sub & 3, lane); }
#endif
#else
          p0_transpose_item(in.p[which ? I_WX : I_WA] + (size_t)blk * 16384, 128, nullptr, (bf16*)(ws + WS_WAXD) + (size_t)(blk * 256 + which * 128) * 1024, 1024, blk * 128, scr, sub >> 2, sub & 3, lane); }
#endif
    }
#if LRU_PADDED == 2
#elif LRU_PADDED
    for (int i = vcu * 512 + tid; i < 8 * 256 * 16; i += G * 512) { const int c16 = i & 15, n = (i >> 4) & 255, blk = i >> 12;
        *(u32x4*)((bf16*)(ws + WS_WAX) + (size_t)blk * 65536 + n * 256 + ((blk & 1) ^ 1) * 128 + c16 * 8) = (u32x4){0u, 0u, 0u, 0u}; }
#else
    for (int i = vcu * 512 + tid; i < 2048 * 128; i += G * 512) { const int c16 = i & 127, row = i >> 7, blk = row >> 8;
        if ((c16 >> 4) != blk) *(u32x4*)((bf16*)(ws + WS_WAXD) + (size_t)row * 1024 + c16 * 8) = (u32x4){0u, 0u, 0u, 0u}; }
#endif
    for (int m = gw; m < T_; m += 2 * NGW) {
        const int m2 = m + NGW;
        const f32x4* xa = (const f32x4*)(in.p[I_X] + (size_t)m * 1024) + lane; const f32x4* xb = (const f32x4*)(in.p[I_X] + (size_t)(m2 < T_ ? m2 : m) * 1024) + lane;
        f32x4 va[4], vb[4]; float sa = 0.f, sb = 0.f;
#pragma unroll
        for (int j = 0; j < 4; ++j) { va[j] = xa[64 * j]; vb[j] = xb[64 * j]; }
#pragma unroll
        for (int j = 0; j < 4; ++j) { sa += (va[j][0] * va[j][0] + va[j][1] * va[j][1]) + (va[j][2] * va[j][2] + va[j][3] * va[j][3]); sb += (vb[j][0] * vb[j][0] + vb[j][1] * vb[j][1]) + (vb[j][2] * vb[j][2] + vb[j][3] * vb[j][3]); }
#pragma unroll
        for (int o = 1; o < 64; o <<= 1) { sa += __shfl_xor(sa, o); sb += __shfl_xor(sb, o); }
        u32x2* oa = (u32x2*)((bf16*)(ws + WS_R0) + (size_t)m * 1024) + lane;
#pragma unroll
        for (int j = 0; j < 4; ++j) { u32x2 w; w.x = pk2(va[j][0], va[j][1]); w.y = pk2(va[j][2], va[j][3]); oa[64 * j] = w; }
        if (lane == 0) ((float*)(ws + WS_RSTD1))[m] = 1.0f / sqrtf(sa * (1.0f / 1024.0f) + EPS);
        if (m2 < T_) {
            u32x2* ob = (u32x2*)((bf16*)(ws + WS_R0) + (size_t)m2 * 1024) + lane;
#pragma unroll
            for (int j = 0; j < 4; ++j) { u32x2 w; w.x = pk2(vb[j][0], vb[j][1]); w.y = pk2(vb[j][2], vb[j][3]); ob[64 * j] = w; }
            if (lane == 0) ((float*)(ws + WS_RSTD1))[m2] = 1.0f / sqrtf(sb * (1.0f / 1024.0f) + EPS);
        }
    }
    for (int m = gw; m < T_; m += 4 * NGW) {
        f32x4 v[4];
#pragma unroll
        for (int q = 0; q < 4; ++q) { const int mq = m + q * NGW; v[q] = ((const f32x4*)(in.p[I_P] + (size_t)(mq < T_ ? mq : m) * 256))[lane]; }
#pragma unroll
        for (int q = 0; q < 4; ++q) { const int mq = m + q * NGW; if (mq < T_) { u32x2 w; w.x = pk2(v[q][0], v[q][1]); w.y = pk2(v[q][2], v[q][3]); ((u32x2*)((bf16*)(ws + WS_PB) + (size_t)mq * 256))[lane] = w; } }
    }
    if (vcu == 0) for (int c = tid; c < 1024; c += 512) ((float*)(ws + WS_C8))[c] = -8.0f * log1pf(expf(-in.p[I_LAM][c])) * LOG2E;
    __syncthreads();
    for (int it = vcu; it < 256; it += G) p0_wfold_item((LAS float*)lds, in.p[I_WQ], in.p[I_K1], in.p[I_K2], in.p[I_GFFN], (bf16*)(ws + WS_WFOLD), it, tid);
}

constexpr int AT_KSTR = 72, AT_VSTR = 260, AT_V_OFF = 256 * AT_KSTR * 2;
__device__ __forceinline__ int crow(int r, int hi) { return (r & 3) + 8 * (r >> 2) + 4 * hi; }
__device__ __forceinline__ void attn_item(LAS unsigned char* lds, const bf16* qkv, const float* sink, bf16* att, int item, int wave, int tid) {
    const int lane = tid & 63;
    const int g = item & 1, n = (item >> 1) & 15, b = item >> 5;
    const int t0 = b * S_ + n * 128;
    LAS bf16* Ks = (LAS bf16*)lds; LAS bf16* Vt = (LAS bf16*)(lds + AT_V_OFF);
#pragma unroll
    for (int i = 0; i < 4; ++i) {
        const int idx = tid + i * 512, row = idx >> 3, ch = idx & 7; const int tk = t0 - 128 + row;
        u32x4 kv = (u32x4){0u, 0u, 0u, 0u}, vv = (u32x4){0u, 0u, 0u, 0u};
        if (n > 0 || row >= 128) { const bf16* src = qkv + (size_t)tk * 768 + 512 + g * 64 + ch * 8; kv = *(const u32x4*)src; vv = *(const u32x4*)(src + 128); }
        *(LAS u32x4*)(Ks + row * AT_KSTR + ch * 8) = kv;
#pragma unroll
        for (int c = 0; c < 8; ++c) Vt[(ch * 8 + c) * AT_VSTR + row] = (bf16)(vv[c >> 1] >> (16 * (c & 1)));
    }
    __syncthreads();
    const int hr = wave >> 1, qh = wave & 1, head = g * 4 + hr;
    const float slope2 = exp2f(-(float)(head + 1)) * LOG2E, sink2 = sink[head] * LOG2E;
    const int q = lane & 31, hi = lane >> 5;
#pragma unroll 1
    for (int ps = 0; ps < 2; ++ps) {
        const int i0 = 64 * qh + 32 * ps, kb0 = i0;
        const bf16* qp = qkv + (size_t)(t0 + i0 + q) * 768 + head * 64 + 8 * hi;
        bf16x8 qf[4];
#pragma unroll
        for (int s = 0; s < 4; ++s) qf[s] = *(const bf16x8*)(qp + 16 * s);
        f32x16 oT[2];
#pragma unroll
        for (int dt = 0; dt < 2; ++dt)
#pragma unroll
            for (int r = 0; r < 16; ++r) oT[dt][r] = 0.f;
        float mrun = sink2, l = 0.f;
#pragma unroll 1
        for (int kt = 0; kt < 5; ++kt) {
            const int kbase = kb0 + 32 * kt;
            f32x16 sT;
#pragma unroll
            for (int r = 0; r < 16; ++r) sT[r] = 0.f;
#pragma unroll
            for (int s = 0; s < 4; ++s) { const bf16x8 kf = *(const LAS bf16x8*)(Ks + (kbase + q) * AT_KSTR + 16 * s + 8 * hi); sT = __builtin_amdgcn_mfma_f32_32x32x16_bf16(kf, qf[s], sT, 0, 0, 0); }
            float tm = -1.0e30f;
#pragma unroll
            for (int r = 0; r < 16; ++r) {
                const int kj = kbase + crow(r, hi); const int dist = i0 + q + 128 - kj;
                const bool valid = (dist >= 0) && (dist < 128) && (n > 0 || kj >= 128);
                const float v = valid ? (sT[r] * (0.125f * LOG2E) - slope2 * (float)dist) : -1.0e30f;
                sT[r] = v; tm = fmaxf(tm, v);
            }
            tm = fmaxf(tm, __shfl_xor(tm, 32));
            const float mnew = fmaxf(mrun, tm), alpha = __builtin_amdgcn_exp2f(mrun - mnew);
            mrun = mnew;
            float ls = 0.f;
#pragma unroll
            for (int r = 0; r < 16; ++r) { const float p = __builtin_amdgcn_exp2f(sT[r] - mnew); sT[r] = p; ls += p; }
            l = l * alpha + ls;
#pragma unroll
            for (int dt = 0; dt < 2; ++dt)
#pragma unroll
                for (int r = 0; r < 16; ++r) oT[dt][r] *= alpha;
#pragma unroll
            for (int s = 0; s < 2; ++s) {
                u32x4 pw; pw.x = cvt_pk_bf16(sT[8 * s + 0], sT[8 * s + 1]); pw.y = cvt_pk_bf16(sT[8 * s + 2], sT[8 * s + 3]);
                pw.z = cvt_pk_bf16(sT[8 * s + 4], sT[8 * s + 5]); pw.w = cvt_pk_bf16(sT[8 * s + 6], sT[8 * s + 7]);
                const bf16x8 pf = __builtin_bit_cast(bf16x8, pw);
#pragma unroll
                for (int dt = 0; dt < 2; ++dt) {
                    const LAS bf16* vp = Vt + (32 * dt + q) * AT_VSTR + kbase + 16 * s + 4 * hi;
                    const u32x2 va = *(const LAS u32x2*)vp, vb = *(const LAS u32x2*)(vp + 8);
                    const bf16x8 af = __builtin_bit_cast(bf16x8, (u32x4){va.x, va.y, vb.x, vb.y});
                    oT[dt] = __builtin_amdgcn_mfma_f32_32x32x16_bf16(af, pf, oT[dt], 0, 0, 0);
                }
            }
        }
        l += __shfl_xor(l, 32);
        l += __builtin_amdgcn_exp2f(sink2 - mrun);
        const float inv = 1.0f / l;
        bf16* op = att + (size_t)(t0 + i0 + q) * 512 + head * 64 + 4 * hi;
#pragma unroll
        for (int dt = 0; dt < 2; ++dt)
#pragma unroll
            for (int rg = 0; rg < 4; ++rg) { u32x2 w; w.x = cvt_pk_bf16(oT[dt][4 * rg] * inv, oT[dt][4 * rg + 1] * inv); w.y = cvt_pk_bf16(oT[dt][4 * rg + 2] * inv, oT[dt][4 * rg + 3] * inv);
                *(u32x2*)(op + 32 * dt + 8 * rg) = w; }
    }
    __syncthreads();
}
__device__ __forceinline__ void conv_items(const bf16* lx, const float* cw, const float* cb, bf16* lin, int vcu, int G, int tid) {
    for (int i = vcu * 512 + tid; i < T_ * 128; i += 2 * G * 512) {
        const int c8 = (i & 127) * 8;
        const int ta = i >> 7, i2 = i + G * 512; const bool hasb = i2 < T_ * 128; const int tb = hasb ? (i2 >> 7) : ta;
        const int tsa = ta & (S_ - 1), tsb = tb & (S_ - 1);
        u32x4 wa[4], wb[4];
#pragma unroll
        for (int tap = 0; tap < 4; ++tap) {
            wa[tap] = (tsa - 3 + tap >= 0) ? *(const u32x4*)(lx + (size_t)(ta - 3 + tap) * 1024 + c8) : (u32x4){0u, 0u, 0u, 0u};
            wb[tap] = (tsb - 3 + tap >= 0) ? *(const u32x4*)(lx + (size_t)(tb - 3 + tap) * 1024 + c8) : (u32x4){0u, 0u, 0u, 0u};
        }
        f32x4 a0 = *(const f32x4*)(cb + c8), a1 = *(const f32x4*)(cb + c8 + 4), b0 = a0, b1 = a1;
#pragma unroll
        for (int tap = 0; tap < 4; ++tap) {
            const f32x4 w0 = *(const f32x4*)(cw + tap * 1024 + c8), w1 = *(const f32x4*)(cw + tap * 1024 + c8 + 4);
            a0 += bf4_lo((u32x2){wa[tap].x, wa[tap].y}) * w0; a1 += bf4_lo((u32x2){wa[tap].z, wa[tap].w}) * w1;
            b0 += bf4_lo((u32x2){wb[tap].x, wb[tap].y}) * w0; b1 += bf4_lo((u32x2){wb[tap].z, wb[tap].w}) * w1;
        }
        *(u32x4*)(lin + (size_t)ta * 1024 + c8) = pack8(a0, a1);
        if (hasb) *(u32x4*)(lin + (size_t)tb * 1024 + c8) = pack8(b0, b1);
    }
}
__device__ __forceinline__ void scan_finish(const bf16* hloc, const bf16* pcum, const float* agg, const bf16* gl, bf16* rec, int vcu, int G, int tid) {
    const int c8 = (tid & 127) * 8, rg = tid >> 7;
    for (int chunk = vcu; chunk < T_ / 64; chunk += G) {
        const int ci = chunk & 31, cb = chunk - ci;
        float carry[8];
#pragma unroll
        for (int j = 0; j < 8; ++j) carry[j] = 0.f;
#pragma unroll 4
        for (int cc = 0; cc < ci; ++cc) {
            const f32x4* ap = (const f32x4*)(agg + ((size_t)(cb + cc) * 1024 + c8) * 2);
#pragma unroll
            for (int q = 0; q < 4; ++q) { const f32x4 v = ap[q]; carry[2 * q] = fmaf(v[0], carry[2 * q], v[1]); carry[2 * q + 1] = fmaf(v[2], carry[2 * q + 1], v[3]); }
        }
#pragma unroll 8
        for (int rr = 0; rr < 16; ++rr) {
            const size_t o = (size_t)(chunk * 64 + rg + 4 * rr) * 1024 + c8;
            const u32x4 hw = *(const u32x4*)(hloc + o), pw = *(const u32x4*)(pcum + o), gw = *(const u32x4*)(gl + o);
            const f32x4 h0 = bf4_lo((u32x2){hw.x, hw.y}), h1 = bf4_lo((u32x2){hw.z, hw.w}), p0 = bf4_lo((u32x2){pw.x, pw.y}), p1 = bf4_lo((u32x2){pw.z, pw.w});
            const f32x4 g0 = bf4_lo((u32x2){gw.x, gw.y}), g1 = bf4_lo((u32x2){gw.z, gw.w});
            f32x4 r0, r1;
#pragma unroll
            for (int j = 0; j < 4; ++j) { r0[j] = fmaf(p0[j], carry[j], h0[j]) * g0[j]; r1[j] = fmaf(p1[j], carry[4 + j], h1[j]) * g1[j]; }
            *(u32x4*)(rec + o) = pack8(r0, r1);
        }
    }
}
__device__ __forceinline__ void uv_convert(const float* pu, const float* pv, const float* gffn, unsigned char* u8, unsigned char* v8, float* iu, float* iv, int gw, int NGW, int lane) {
    f32x4 g[4];
#pragma unroll
    for (int j = 0; j < 4; ++j) g[j] = ((const f32x4*)gffn)[4 * lane + j];
    for (int e0 = gw; e0 < 2 * 16384; e0 += 2 * NGW) {
        f32x4 v[2][4];
#pragma unroll
        for (int h = 0; h < 2; ++h) { const int e = e0 + h * NGW; const bool isv = e >= 16384; const int row = isv ? e - 16384 : e;
            const f32x4* src = (const f32x4*)((isv ? pv : pu) + (size_t)row * 1024) + 4 * lane;
#pragma unroll
            for (int j = 0; j < 4; ++j) v[h][j] = src[j]; }
#pragma unroll
        for (int h = 0; h < 2; ++h) {
            const int e = e0 + h * NGW; const bool isv = e >= 16384; const int row = isv ? e - 16384 : e;
            float am = 0.f;
#pragma unroll
            for (int j = 0; j < 4; ++j) { if (!isv) v[h][j] = v[h][j] * g[j]; am = fmaxf(am, fmaxf(fmaxf(fabsf(v[h][j][0]), fabsf(v[h][j][1])), fmaxf(fabsf(v[h][j][2]), fabsf(v[h][j][3])))); }
#pragma unroll
            for (int o = 1; o < 64; o <<= 1) am = fmaxf(am, __shfl_xor(am, o));
            const float sc = am > 0.f ? (isv ? 416.0f : 127.0f) / am : 1.0f;
            u32x4 w;
            if (isv) {
#pragma unroll
                for (int j = 0; j < 4; ++j) { unsigned ww = 0u; ww = __builtin_amdgcn_cvt_pk_fp8_f32(v[h][j][0] * sc, v[h][j][1] * sc, ww, false); ww = __builtin_amdgcn_cvt_pk_fp8_f32(v[h][j][2] * sc, v[h][j][3] * sc, ww, true); w[j] = ww; }
            } else {
#pragma unroll
                for (int j = 0; j < 4; ++j) { unsigned ww = 0u;
#pragma unroll
                    for (int c = 0; c < 4; ++c) ww |= ((unsigned)(int)__builtin_rintf(v[h][j][c] * sc) & 0xffu) << (8 * c);
                    w[j] = ww; }
            }
            *(u32x4*)((isv ? v8 : u8) + (size_t)row * 1024 + 16 * lane) = w;
            if (lane == 0) (isv ? iv : iu)[row] = 1.0f / sc;
        }
    }
}
__device__ __forceinline__ void final_rows(float* h, const bf16* h3b, const float* part, const float* fg, int gw, int NGW, int lane, float tscale) {
    f32x4 g[4];
#pragma unroll
    for (int j = 0; j < 4; ++j) g[j] = ((const f32x4*)fg)[lane + 64 * j];
    for (int r0 = gw; r0 < T_; r0 += 2 * NGW) {
        const int r1 = (r0 + NGW < T_) ? r0 + NGW : r0;
        float pa = (lane < 16) ? part[(size_t)r0 * 16 + lane] : 0.f, pb = (lane < 16) ? part[(size_t)r1 * 16 + lane] : 0.f;
#if ALL_FUSED
        const u32x2* ba = (const u32x2*)(h3b + (size_t)r0 * 1024) + lane; const u32x2* bb = (const u32x2*)(h3b + (size_t)r1 * 1024) + lane;
        u32x2 wa[4], wb[4];
#pragma unroll
        for (int j = 0; j < 4; ++j) { wa[j] = ba[64 * j]; wb[j] = bb[64 * j]; }
#endif
#pragma unroll
        for (int o = 1; o < 64; o <<= 1) { pa += __shfl_xor(pa, o); pb += __shfl_xor(pb, o); }
        const float ra = tscale / sqrtf(pa * (1.0f / 1024.0f) + EPS), rb = tscale / sqrtf(pb * (1.0f / 1024.0f) + EPS);
        f32x4* ha = (f32x4*)(h + (size_t)r0 * 1024) + lane; f32x4* hb = (f32x4*)(h + (size_t)r1 * 1024) + lane;
#if ALL_FUSED
#pragma unroll
        for (int j = 0; j < 4; ++j) ha[64 * j] = bf4_lo(wa[j]) * ra * g[j];
        if (r1 != r0) {
#pragma unroll
            for (int j = 0; j < 4; ++j) hb[64 * j] = bf4_lo(wb[j]) * rb * g[j];
        }
#else
#pragma unroll
        for (int j = 0; j < 4; ++j) ha[64 * j] = ha[64 * j] * ra * g[j];
        if (r1 != r0) {
#pragma unroll
            for (int j = 0; j < 4; ++j) hb[64 * j] = hb[64 * j] * rb * g[j];
        }
#endif
    }
}

constexpr int N_PHASES = 16;
struct Args { const float* in[25]; float* out; unsigned char* ws; int ph_lo, ph_hi, li, pad; };
__global__ void __launch_bounds__(NWAVES * 64, 2) fused_fwd(Args args) {
    extern __shared__ __attribute__((aligned(16))) unsigned char lds_raw[];
    LAS unsigned char* lds = (LAS unsigned char*)lds_raw;
    volatile LAS unsigned* MISC = (volatile LAS unsigned*)(lds + LDSCTL_OFF);
    const int wave = __builtin_amdgcn_readfirstlane((int)threadIdx.x >> 6);
#define FRESH_TID() (wave * 64 + fresh_lane())
#define FRESH_LANE() fresh_lane()
    const int G = gridDim.x; const int bx = blockIdx.x; const int vcu = (G % 8 == 0) ? (bx % 8) * (G / 8) + bx / 8 : bx;
    unsigned char* ws = args.ws; float* out = args.out;
    In in;
#pragma unroll
    for (int i = 0; i < 25; ++i) in.p[i] = args.in[i];
    for (int u = FRESH_TID(); u < (LDS_BYTES - LDSCTL_OFF) / 4; u += NWAVES * 64) ((LAS unsigned*)(lds + LDSCTL_OFF))[u] = 0u;
    __syncthreads();
    (void)xcd_barrier_post((unsigned*)(ws + WS_CTL) + CW_BAR + args.li * XCD_BAR_WORDS, MISC + 8);
    const int lo = args.ph_lo, hi = args.ph_hi;
    const int gw = vcu * NWAVES + wave, NGW = G * NWAVES;
#ifndef PH_DISABLE
#define PH_DISABLE 0
#endif
#if ALL_FUSED
#define IN(k) (!((PH_DISABLE >> (k)) & 1))
#else
#define IN(k) (lo <= (k) && (k) < hi && !((PH_DISABLE >> (k)) & 1))
#endif
#ifdef TIMING_A
#define STAMP(i) do { if (bx == 0 && FRESH_TID() == 0) __hip_atomic_store((unsigned long long*)(ws + WS_CTL + 512) + (i), __builtin_amdgcn_s_memrealtime(), __ATOMIC_RELAXED, __HIP_MEMORY_SCOPE_AGENT); } while (0)
#else
#define STAMP(i) do { } while (0)
#endif
#define SEAM(k) do { if (IN(k) && IN((k) + 1)) { XcdBarrier b_; b_.bar = (unsigned*)(args.ws + WS_CTL) + CW_BAR + args.li * XCD_BAR_WORDS; b_.x = xb_xcc_id(); b_.st = (volatile LAS unsigned*)(lds + LDSCTL_OFF) + 8;     \
        xcd_barrier(b_); STAMP((k) + 1); } } while (0)
#if ALL_FUSED
#define PP_OFF WS_PP2
#define MP_PTR out
#else
#define PP_OFF WS_PP
#define MP_PTR ((float*)(ws + WS_MP))
#endif
#define GEMM_PHASE(EPI, Aptr, Bptr, Kdim, LDA, M_, N_, SH, STR, ...) do { \
        pg8::Gemm g{(const pg8::bf16_t*)(Aptr), (const pg8::bf16_t*)(Bptr), Kdim, LDA, SH, STR}; pg8::StaticOrder S; S.init(M_, N_, G, (int)blockIdx.x); \
        EPI E{__VA_ARGS__}; pg8::gemm_phase<EPI, pg8::StaticOrder, true, true>(lds, g, S, E, wave); } while (0)

    STAMP(0);
    if (IN(0)) { p0_prologue(in, ws, lds, vcu, G, wave, FRESH_TID()); } SEAM(0);
    if (IN(1)) { GEMM_PHASE(EpiProj, ws + WS_R0, ws + WS_WIN, 1024, 1024, T_, INW, 0, 0, (const float*)(ws + WS_RSTD1), ws); } SEAM(1);
    if (IN(2)) {
        for (int it = bx; it < 256; it += G) attn_item(lds, (const bf16*)(ws + WS_QKV), in.p[I_SINK], (bf16*)(ws + WS_ATT), it, wave, FRESH_TID());
        conv_items((const bf16*)(ws + WS_LX), in.p[I_CONVW], in.p[I_CONVB], (bf16*)(ws + WS_R0), vcu, G, FRESH_TID());
    } SEAM(2);
#if LRU_PADDED == 2
    if (IN(3)) { GEMM_PHASE(EpiLru, ws + WS_R0, ws + WS_WAX, 128, 1024, T_, 2048, 0, 128,
#elif LRU_PADDED
    if (IN(3)) { GEMM_PHASE(EpiLru, ws + WS_R0, ws + WS_WAX, 256, 1024, T_, 2048, 1, 256,
#else
    if (IN(3)) { GEMM_PHASE(EpiLru, ws + WS_R0, ws + WS_WAXD, 1024, 1024, T_, 2048, 0, 0,
#endif
        (const bf16*)(ws + WS_R0), in.p[I_BA], in.p[I_BX], (const float*)(ws + WS_C8), (bf16*)(ws + WS_HLOC), (bf16*)(ws + WS_PCUM), (float*)(ws + WS_AGG)); }
    SEAM(3);
    if (IN(4)) { scan_finish((const bf16*)(ws + WS_HLOC), (const bf16*)(ws + WS_PCUM), (const float*)(ws + WS_AGG), (const bf16*)(ws + WS_GL), (bf16*)(ws + WS_R0), vcu, G, FRESH_TID()); }
#if !ALL_FUSED
    SEAM(4);
#endif
    if (IN(5)) { GEMM_PHASE(EpiMP, ws + WS_ATT, ws + WS_WUA, 512, 512, T_, 1024, 0, 0, (const bf16*)(ws + WS_SGA), MP_PTR); } SEAM(5);
    if (IN(6)) { GEMM_PHASE(EpiMerged, ws + WS_R0, ws + WS_WUL, 1024, 1024, T_, 1024, 0, 0, (const bf16*)(ws + WS_SGL), (const float*)MP_PTR, (bf16*)(ws + WS_MERGED)); } SEAM(6);
    if (IN(7)) { GEMM_PHASE(EpiH1, ws + WS_MERGED, ws + WS_WO, 1024, 1024, T_, 1024, 0, 0, in.p[I_X], out, (bf16*)(ws + WS_R0), (float*)(ws + WS_PART2)); }
#if ALL_FUSED
    if (IN(13)) { GEMM_PHASE(EpiPP, ws + WS_PB, ws + WS_WPROJ, 256, 256, T_, 1024, 0, 0, (bf16*)(ws + WS_PP2)); }
#endif
    SEAM(7);
#define PEER_HALF(half) do { \
        if (IN(8 + 2 * (half))) { GEMM_PHASE(EpiScore, ws + WS_R0, ws + WS_WFOLD + (size_t)(half) * 1024 * 1024 * 2, 1024, 1024, T_, 1024, 0, 0, (const float*)(ws + WS_PART2), (float*)(ws + WS_SC)); } SEAM(8 + 2 * (half)); \
        if (IN(9 + 2 * (half))) { \
            for (int it = vcu; it < T_ / TK_TOK; it += G) topk_item((LAS float*)lds, (const float*)(ws + WS_SC), it, (half) * 4, (int*)(ws + WS_SELI), (float*)(ws + WS_SELG), FRESH_TID()); \
            if ((half) == 0) uv_convert(in.p[I_U], in.p[I_V], in.p[I_GFFN], ws + WS_U16, ws + WS_U16 + 16 * MiB, (float*)(ws + WS_USCALE), (float*)(ws + WS_USCALE) + 16384, gw, NGW, FRESH_LANE()); \
        } SEAM(9 + 2 * (half)); } while (0)
#if ALL_FUSED
    if (IN(8)) {
        for (int kk = 0; kk < 2; ++kk) { pg8::Gemm g{(const pg8::bf16_t*)(ws + WS_R0), (const pg8::bf16_t*)(ws + WS_WFOLD), 1024, 1024, 0, 0}; OneUnit S; S.S.init(T_, 2048, G, (int)blockIdx.x); S.k = kk;
            EpiTopk E{(const float*)(ws + WS_PART2), (int*)(ws + WS_SELI), (float*)(ws + WS_SELG)}; pg8::gemm_phase<EpiTopk, OneUnit, false, true>(lds, g, S, E, wave); }
        uv_convert(in.p[I_U], in.p[I_V], in.p[I_GFFN], ws + WS_U16, ws + WS_U16 + 16 * MiB, (float*)(ws + WS_USCALE), (float*)(ws + WS_USCALE) + 16384, gw, NGW, FRESH_LANE());
    } SEAM(11);
#else
    PEER_HALF(0);
    PEER_HALF(1);
#endif
    if (IN(12)) {
#ifdef PROBE_MODE
        for (int tok0 = vcu * 64; tok0 < T_; tok0 += G * 64)
#if GATHER_ROWS == 3
            gather_wg_mixed<PROBE_MODE>(tok0, wave, FRESH_LANE(), lds, ws + WS_U16, ws + WS_U16 + 16 * MiB, (const float*)(ws + WS_USCALE), (const float*)(ws + WS_USCALE) + 16384, (const int*)(ws + WS_SELI), (const float*)(ws + WS_SELG), (const float*)(ws + WS_PART2), (const bf16*)(ws + WS_R0), (bf16*)(ws + WS_H2B), (float*)(ws + WS_RSTD3), (float*)(ws + WS_SC));
#elif GATHER_ROWS == 1
            gather_wg_rows<PROBE_MODE>(tok0, wave, FRESH_LANE(), lds, ws + WS_U16, ws + WS_U16 + 16 * MiB, (const float*)(ws + WS_USCALE), (const float*)(ws + WS_USCALE) + 16384, (const int*)(ws + WS_SELI), (const float*)(ws + WS_SELG), (const float*)(ws + WS_PART2), (const bf16*)(ws + WS_R0), (bf16*)(ws + WS_H2B), (float*)(ws + WS_RSTD3), (float*)(ws + WS_SC));
#else
            gather_wg_sliced<PROBE_MODE>(tok0, wave, FRESH_LANE(), lds, ws + WS_U16, ws + WS_U16 + 16 * MiB, (const float*)(ws + WS_USCALE), (const float*)(ws + WS_USCALE) + 16384, (const int*)(ws + WS_SELI), (const float*)(ws + WS_SELG), (const float*)(ws + WS_PART2), out, (const bf16*)(ws + WS_R0), (bf16*)(ws + WS_H2B), (float*)(ws + WS_RSTD3), (float*)(ws + WS_SC));
#endif
        { XcdBarrier b_; b_.bar = (unsigned*)(args.ws + WS_CTL) + CW_BAR + args.li * XCD_BAR_WORDS; b_.x = xb_xcc_id(); b_.st = (volatile LAS unsigned*)(lds + LDSCTL_OFF) + 8; xcd_barrier(b_); STAMP(16); }
#endif
        for (int tok0 = vcu * 64; tok0 < T_; tok0 += G * 64)
#if GATHER_ROWS == 3
            gather_wg_mixed<0>(tok0, wave, FRESH_LANE(), lds, ws + WS_U16, ws + WS_U16 + 16 * MiB, (const float*)(ws + WS_USCALE), (const float*)(ws + WS_USCALE) + 16384, (const int*)(ws + WS_SELI), (const float*)(ws + WS_SELG), (const float*)(ws + WS_PART2), (const bf16*)(ws + WS_R0), (bf16*)(ws + WS_H2B), (float*)(ws + WS_RSTD3), nullptr);
#elif GATHER_ROWS == 1
            gather_wg_rows<0>(tok0, wave, FRESH_LANE(), lds, ws + WS_U16, ws + WS_U16 + 16 * MiB, (const float*)(ws + WS_USCALE), (const float*)(ws + WS_USCALE) + 16384, (const int*)(ws + WS_SELI), (const float*)(ws + WS_SELG), (const float*)(ws + WS_PART2), (const bf16*)(ws + WS_R0), (bf16*)(ws + WS_H2B), (float*)(ws + WS_RSTD3), nullptr);
#else
            gather_wg_sliced<0>(tok0, wave, FRESH_LANE(), lds, ws + WS_U16, ws + WS_U16 + 16 * MiB, (const float*)(ws + WS_USCALE), (const float*)(ws + WS_USCALE) + 16384, (const int*)(ws + WS_SELI), (const float*)(ws + WS_SELG), (const float*)(ws + WS_PART2), out, (const bf16*)(ws + WS_R0), (bf16*)(ws + WS_H2B), (float*)(ws + WS_RSTD3), nullptr);
#endif
    } SEAM(12);
#if !ALL_FUSED
    if (IN(13)) { GEMM_PHASE(EpiPP, ws + WS_PB, ws + WS_WPROJ, 256, 256, T_, 1024, 0, 0, (bf16*)(ws + WS_PP)); } SEAM(13);
#endif
#if ALL_FUSED && FUSE_FINAL
    if (IN(14)) { GEMM_PHASE(EpiH3Final, ws + WS_H2B, ws + WS_WG, 1024, 1024, T_, 1024, 0, 0, (const float*)(ws + WS_RSTD3), (const bf16*)(ws + PP_OFF), (const bf16*)(ws + WS_H2B), in.p[I_FG], out, (float*)(ws + WS_PART4), (unsigned*)(ws + WS_CTL) + 65536); }
#else
    if (IN(14)) { GEMM_PHASE(EpiH3, ws + WS_H2B, ws + WS_WG, 1024, 1024, T_, 1024, 0, 0, (const float*)(ws + WS_RSTD3), (const bf16*)(ws + PP_OFF), out, (float*)(ws + WS_PART4), (const bf16*)(ws + WS_H2B), (bf16*)(ws + WS_R0)); } SEAM(14);
#ifdef TIMING_A
    float tscale = 1.0f;
    { const unsigned long long ta = __hip_atomic_load((unsigned long long*)(ws + WS_CTL + 512) + TIMING_A, __ATOMIC_RELAXED, __HIP_MEMORY_SCOPE_AGENT), tb = __hip_atomic_load((unsigned long long*)(ws + WS_CTL + 512) + TIMING_B, __ATOMIC_RELAXED, __HIP_MEMORY_SCOPE_AGENT);
      tscale = 1.0f + (float)(tb - ta) * 0.01f * (float)(TIMING_K); }
    if (IN(15)) { final_rows(out, (const bf16*)(ws + WS_R0), (const float*)(ws + WS_PART4), in.p[I_FG], gw, NGW, FRESH_LANE(), tscale); }
#else
    if (IN(15)) { final_rows(out, (const bf16*)(ws + WS_R0), (const float*)(ws + WS_PART4), in.p[I_FG], gw, NGW, FRESH_LANE(), 1.0f); }
#endif
#endif
#undef IN
#undef SEAM
#undef GEMM_PHASE
}
static const int GRP_LO[11] = {0, 2, 3, 5, 6, 7, 8, 12, 13, 14, 15};
static const int GRP_HI[11] = {2, 3, 5, 6, 7, 8, 12, 13, 14, 15, 16};

static void naive_group(int grp, void* const* d_in, float* out, unsigned char* ws, hipStream_t st) {
    const float* x = (const float*)d_in[0]; const float* p = (const float*)d_in[1]; const float* g_mix = (const float*)d_in[2]; const float* w_in = (const float*)d_in[3];
    const float* sink = (const float*)d_in[4]; const float* conv_w = (const float*)d_in[5]; const float* conv_b = (const float*)d_in[6];
    const float* wa = (const float*)d_in[7]; const float* ba = (const float*)d_in[8]; const float* wx = (const float*)d_in[9]; const float* bx = (const float*)d_in[10]; const float* lam = (const float*)d_in[11];
    const float* w_ua = (const float*)d_in[12]; const float* w_ul = (const float*)d_in[13]; const float* w_o = (const float*)d_in[14]; const float* g_ffn = (const float*)d_in[15];
    const float* wq = (const float*)d_in[16]; const float* k1 = (const float*)d_in[17]; const float* k2 = (const float*)d_in[18]; const float* pu = (const float*)d_in[19]; const float* pv = (const float*)d_in[20];
    const float* g_ple = (const float*)d_in[21]; const float* w_gate = (const float*)d_in[22]; const float* w_proj = (const float*)d_in[23]; const float* final_g = (const float*)d_in[24];
    float* rstd1 = (float*)(ws + WS_RSTD1); float* part2 = (float*)(ws + WS_PART2); float* part4 = (float*)(ws + WS_PART4); float* rstd3 = (float*)(ws + WS_RSTD3);
    bf16* qkv = (bf16*)(ws + WS_QKV); bf16* lx = (bf16*)(ws + WS_LX); bf16* gl = (bf16*)(ws + WS_GL); bf16* sga = (bf16*)(ws + WS_SGA); bf16* sgl = (bf16*)(ws + WS_SGL);
    bf16* att = (bf16*)(ws + WS_ATT); bf16* r0 = (bf16*)(ws + WS_R0); float* mp = (float*)(ws + WS_MP); bf16* merged = (bf16*)(ws + WS_MERGED);
    float* sc = (float*)(ws + WS_SC); int* seli = (int*)(ws + WS_SELI); float* selg = (float*)(ws + WS_SELG); bf16* h2b = (bf16*)(ws + WS_H2B); bf16* pp = (bf16*)(ws + WS_PP);
    float* tmpf = (float*)(ws + WS_NAIVE_AB);
    switch (grp) {
    case 0:
        hipLaunchKernelGGL(nv::rowsq, dim3(T_ / 4), dim3(256), 0, st, x, rstd1, (float*)nullptr);
        nv::run_gemm<nv::ALf32, nv::EpiProj, false>(st, nv::ALf32{x, 1024}, w_in, INW, g_mix, T_, INW, 1024, nv::EpiProj{rstd1, qkv, lx, gl, sga, sgl});
        break;
    case 1:
        hipLaunchKernelGGL(nv::attn_naive, dim3(T_ * 8 / 128), dim3(128), 0, st, qkv, sink, att);
        hipLaunchKernelGGL(nv::conv_naive, dim3(T_ * 1024 / 256), dim3(256), 0, st, lx, conv_w, conv_b, r0);
        break;
    case 2:
        hipLaunchKernelGGL(nv::lru_ab_naive, dim3(T_ * 8), dim3(128), 0, st, r0, wa, ba, wx, bx, lam, out, tmpf);
        hipLaunchKernelGGL(nv::lru_scan_naive, dim3(B_ * 1024 / 64), dim3(64), 0, st, out, tmpf, gl, r0);
        break;
    case 3: nv::run_gemm<nv::ALbf16, nv::EpiMP, false>(st, nv::ALbf16{att, 512}, w_ua, 1024, nullptr, T_, 1024, 512, nv::EpiMP{sga, mp}); break;
    case 4: nv::run_gemm<nv::ALbf16, nv::EpiMerged, false>(st, nv::ALbf16{r0, 1024}, w_ul, 1024, nullptr, T_, 1024, 1024, nv::EpiMerged{sgl, mp, merged}); break;
    case 5:
        nv::run_gemm<nv::ALbf16, nv::EpiH1, false>(st, nv::ALbf16{merged, 1024}, w_o, 1024, nullptr, T_, 1024, 1024, nv::EpiH1{x, out, r0});
        hipLaunchKernelGGL(nv::rowsq, dim3(T_ / 4), dim3(256), 0, st, out, (float*)nullptr, part2);
        break;
    case 6:
        for (int half = 0; half < 2; ++half) {
            nv::run_gemm<nv::ALf32, nv::EpiScaleF32, false>(st, nv::ALf32{out, 1024}, wq + half * 1024, 2048, g_ffn, T_, 1024, 1024, nv::EpiScaleF32{part2, tmpf, 1024});
            for (int hl = 0; hl < 4; ++hl)
                for (int hf = 0; hf < 2; ++hf)
                    nv::run_gemm<nv::ALf32, nv::EpiPlainF32, true>(st, nv::ALf32{tmpf + hl * 256 + hf * 128, 1024}, hf ? k2 : k1, 128, nullptr, T_, 128, 128, nv::EpiPlainF32{sc + hl * 256 + hf * 128, 1024});
            hipLaunchKernelGGL(topk_kernel, dim3(T_ / TK_TOK), dim3(512), TK_LDS_BYTES, st, sc, half * 4, seli, selg);
        }
        break;
    case 7: hipLaunchKernelGGL(gather_kernel<0>, dim3(1024), dim3(256), 0, st, (const void*)pu, (const void*)pv, g_ffn, seli, selg, part2, out, h2b, rstd3); break;
    case 8: nv::run_gemm<nv::ALf32, nv::EpiPP, false>(st, nv::ALf32{p, 256}, w_proj, 1024, nullptr, T_, 1024, 256, nv::EpiPP{pp}); break;
    case 9: nv::run_gemm<nv::ALbf16, nv::EpiH3, false>(st, nv::ALbf16{h2b, 1024}, w_gate, 1024, g_ple, T_, 1024, 1024, nv::EpiH3{rstd3, pp, out});
        hipLaunchKernelGGL(nv::rowsq, dim3(T_ / 4), dim3(256), 0, st, out, (float*)nullptr, part4);
        break;
    case 10: hipLaunchKernelGGL(nv::final_norm, dim3(T_ / 4), dim3(256), 0, st, out, part4, final_g); break;
    }
}

extern "C" void kernel_launch(void* const* d_in, const int* in_sizes, int n_in, void* d_out, int out_size, void* d_ws, size_t ws_size, hipStream_t stream) {
    static int grid = 0;
    if (grid == 0) {
        if (n_in != 25 || out_size != T_ * 1024 || ws_size < WS_END) { fprintf(stderr, "kernel_launch: unexpected sizes n_in %d out %d ws %zu\n", n_in, out_size, ws_size); }
        (void)hipFuncSetAttribute((const void*)topk_kernel, hipFuncAttributeMaxDynamicSharedMemorySize, TK_LDS_BYTES);
        int dev = 0, cus = 0, per_cu = 0;
        (void)hipGetDevice(&dev); (void)hipDeviceGetAttribute(&cus, hipDeviceAttributeMultiprocessorCount, dev);
        if (hipFuncSetAttribute((const void*)fused_fwd, hipFuncAttributeMaxDynamicSharedMemorySize, LDS_BYTES) != hipSuccess) fprintf(stderr, "kernel_launch: hipFuncSetAttribute(fused_fwd) failed\n");
        if (hipOccupancyMaxActiveBlocksPerMultiprocessor(&per_cu, (const void*)fused_fwd, NWAVES * 64, LDS_BYTES) != hipSuccess || per_cu < 1) fprintf(stderr, "kernel_launch: occupancy query says %d blocks/CU\n", per_cu);
        (void)hipGetLastError();
        grid = cus > 0 ? cus : 256;
    }
    unsigned char* ws = (unsigned char*)d_ws; float* out = (float*)d_out;
    const unsigned mask = FUSED_MASK;
    if (mask) (void)hipMemsetAsync(ws + WS_CTL, 0, CTL_ZERO_BYTES, stream);
    Args a{};
    for (int i = 0; i < 25; ++i) a.in[i] = (const float*)d_in[i];
    a.out = out; a.ws = ws;
    int li = 0;
    auto launch = [&](int lo, int hi) {
        if (MERGE_LAUNCHES) { a.ph_lo = lo; a.ph_hi = hi; a.li = li++; hipLaunchKernelGGL(fused_fwd, dim3(grid), dim3(NWAVES * 64), LDS_BYTES, stream, a); }
        else for (int ph = lo; ph < hi; ++ph) { a.ph_lo = ph; a.ph_hi = ph + 1; a.li = li++; hipLaunchKernelGGL(fused_fwd, dim3(grid), dim3(NWAVES * 64), LDS_BYTES, stream, a); }
    };
    int pend_lo = -1, pend_hi = -1;
    if (mask && !(mask & 1)) launch(0, 1);
    for (int gidx = 0; gidx < 11; ++gidx) {
#if (defined(LRU_T2) && LRU_T2) || (defined(LRU_T3) && LRU_T3)
        if (gidx == 2 && (mask & 4u)) {
            if (pend_lo >= 0) { launch(pend_lo, pend_hi); pend_lo = -1; }
            launch(3, 4);
            hipLaunchKernelGGL(nv::lru_finish_naive_L<(LRU_T2 ? 16 : 64)>, dim3(B_ * 1024 / 64), dim3(64), 0, stream, (const bf16*)(ws + WS_HLOC), (const bf16*)(ws + WS_PCUM), (const bf16*)(ws + WS_GL), (bf16*)(ws + WS_R0));
            continue;
        }
#endif
        if (mask & (1u << gidx)) {
            if (pend_lo < 0) { pend_lo = GRP_LO[gidx]; pend_hi = GRP_HI[gidx]; } else pend_hi = GRP_HI[gidx];
        } else {
            if (pend_lo >= 0) { launch(pend_lo, pend_hi); pend_lo = -1; }
            naive_group(gidx, d_in, out, ws, stream);
        }
    }
    if (pend_lo >= 0) launch(pend_lo, pend_hi);
#if defined(LRU_DEBUG) && LRU_DEBUG == 2
    hipLaunchKernelGGL(nv::poison_if, dim3(T_ * 1024 / 256), dim3(256), 0, stream, out, (const unsigned*)(ws + WS_CTL) + 64);
#endif
}
```

```cpp
#include <hip/hip_runtime.h>
#include <cstdio>
#include <cstdint>
#include <cmath>

#ifndef FUSED_MASK
#define FUSED_MASK 0x7ff
#endif
#ifndef MERGE_LAUNCHES
#define MERGE_LAUNCHES 1
#endif
#ifndef LRU_PADDED
#define LRU_PADDED 1
#endif
#ifndef FUSE_FINAL
#define FUSE_FINAL 0
#endif
#ifndef GATHER_ROWS
#define GATHER_ROWS 3
#endif
#define ALL_FUSED ((FUSED_MASK) == 0x7ff && (MERGE_LAUNCHES))
constexpr int B_ = 8, S_ = 2048, D_ = 1024, T_ = B_ * S_;
constexpr int INW = 4864;
constexpr float EPS = 1e-6f;
typedef unsigned short bf16;
#define HD_INLINE __host__ __device__ __forceinline__

constexpr size_t MiB = 1u << 20;
constexpr size_t WS_CTL = 0;
constexpr size_t WS_WIN = 1 * MiB;
constexpr size_t WS_WUA = WS_WIN + 4864 * 1024 * 2;
constexpr size_t WS_WUL = WS_WUA + 1 * MiB;
constexpr size_t WS_WO = WS_WUL + 2 * MiB;
constexpr size_t WS_WFOLD = WS_WO + 2 * MiB;
constexpr size_t WS_WG = WS_WFOLD + 4 * MiB;
constexpr size_t WS_WPROJ = WS_WG + 2 * MiB;
constexpr size_t WS_WAX = WS_WPROJ + MiB / 2;
constexpr size_t WS_W_END = WS_WAX + 1 * MiB;
static_assert(WS_W_END <= 23 * MiB, "weights");
constexpr size_t WS_RSTD1 = 23 * MiB;
constexpr size_t WS_PART2 = WS_RSTD1 + 256 * 1024;
constexpr size_t WS_PART4 = WS_PART2 + 1 * MiB;
constexpr size_t WS_RSTD3 = WS_PART4 + 1 * MiB;
constexpr size_t WS_AGG = WS_RSTD3 + 256 * 1024;
constexpr size_t WS_C8 = WS_AGG + 2 * MiB;
constexpr size_t WS_USCALE = WS_C8 + 64 * 1024;
static_assert(WS_USCALE + 128 * 1024 <= 28 * MiB, "small");
constexpr size_t WS_PB = 28 * MiB;
constexpr size_t WS_R0 = 36 * MiB;
constexpr size_t WS_QKV = 68 * MiB;
constexpr size_t WS_LX = 92 * MiB;
constexpr size_t WS_GL = 140 * MiB;
constexpr size_t WS_SGA = 172 * MiB;
constexpr size_t WS_SGL = 204 * MiB;
constexpr size_t WS_ATT = 236 * MiB;
constexpr size_t WS_HLOC = 68 * MiB, WS_PCUM = 100 * MiB;
constexpr size_t WS_MP = 68 * MiB;
constexpr size_t WS_MERGED = 140 * MiB;
constexpr size_t WS_SC = 172 * MiB;
constexpr size_t WS_SELI = 236 * MiB, WS_SELG = 244 * MiB;
constexpr size_t WS_U16 = 68 * MiB, WS_V16 = 100 * MiB;
constexpr size_t WS_H2B = 140 * MiB;
constexpr size_t WS_PP = 172 * MiB;
constexpr size_t WS_PP2 = 100 * MiB;
constexpr size_t WS_NAIVE_AB = 68 * MiB;
constexpr size_t WS_WAXD = 252 * MiB;
constexpr size_t WS_END = 256 * MiB;

HD_INLINE float bf2f(bf16 v) { return __builtin_bit_cast(float, (unsigned)v << 16); }
HD_INLINE bf16 f2bf(float f) { unsigned u = __builtin_bit_cast(unsigned, f); return (bf16)((u + 0x7fffu + ((u >> 16) & 1u)) >> 16); }
HD_INLINE unsigned pk2(float lo, float hi) { return (unsigned)f2bf(lo) | ((unsigned)f2bf(hi) << 16); }
__device__ __forceinline__ float wave_sum(float v) {
#pragma unroll
    for (int o = 1; o < 64; o <<= 1) v += __shfl_xor(v, o);
    return v;
}
__device__ __forceinline__ float sigmoidf_(float z) { return __builtin_amdgcn_rcpf(1.0f + __builtin_amdgcn_exp2f(-1.4426950408889634f * z)); }
__device__ __forceinline__ float gelu_tanh(float x) { const float u = 1.5957691216057308f * (x + 0.044715f * x * x * x); return x * sigmoidf_(u); }
__device__ __forceinline__ int fresh_lane() { int l; asm volatile("v_mbcnt_lo_u32_b32 %0, -1, 0\n\tv_mbcnt_hi_u32_b32 %0, -1, %0" : "=v"(l)); return l; }
#ifndef HD_INLINE
#define HD_INLINE __host__ __device__ __forceinline__
#endif

HD_INLINE unsigned tk_umax(unsigned a, unsigned b) { return a > b ? a : b; }
HD_INLINE unsigned tk_umin(unsigned a, unsigned b) { return a < b ? a : b; }
HD_INLINE unsigned tk_f2key(float f) { unsigned u = __builtin_bit_cast(unsigned, f); return u ^ ((unsigned)((int)u >> 31) | 0x80000000u); }
HD_INLINE float tk_key2f(unsigned k) { unsigned u = (k & 0x80000000u) ? (k ^ 0x80000000u) : ~k; return __builtin_bit_cast(float, u); }

HD_INLINE void tk_sort16(unsigned (&a)[16]) {
#pragma unroll
    for (int k = 2; k <= 16; k <<= 1) {
#pragma unroll
        for (int j = k >> 1; j > 0; j >>= 1) {
#pragma unroll
            for (int i = 0; i < 16; ++i) {
                const int p = i ^ j;
                if (p > i) {
                    const unsigned mx = tk_umax(a[i], a[p]), mn = tk_umin(a[i], a[p]);
                    if ((i & k) == 0) { a[i] = mx; a[p] = mn; } else { a[i] = mn; a[p] = mx; }
                }
            }
        }
    }
}
HD_INLINE void tk_merge16(unsigned (&a)[16], const unsigned (&b)[16]) {
#pragma unroll
    for (int i = 0; i < 16; ++i) a[i] = tk_umax(a[i], b[15 - i]);
#pragma unroll
    for (int j = 8; j > 0; j >>= 1) {
#pragma unroll
        for (int i = 0; i < 16; ++i) {
            const int p = i ^ j;
            if (p > i) { const unsigned mx = tk_umax(a[i], a[p]), mn = tk_umin(a[i], a[p]); a[i] = mx; a[p] = mn; }
        }
    }
}
HD_INLINE void tk_insert16(unsigned (&best)[16], unsigned key) {
#pragma unroll
    for (int s = 0; s < 16; ++s) { const unsigned hi = tk_umax(best[s], key); key = tk_umin(best[s], key); best[s] = hi; }
}
HD_INLINE void tk_combine_store(const unsigned (&k1)[16], const unsigned (&k2)[16], int* oi, float* og) {
    float v1[16], v2[16];
#pragma unroll
    for (int i = 0; i < 16; ++i) { v1[i] = tk_key2f(k1[i] & ~127u); v2[i] = tk_key2f(k2[i] & ~127u); }
    unsigned best[16];
#pragma unroll
    for (int s = 0; s < 16; ++s) best[s] = 0u;
#pragma unroll
    for (int i = 0; i < 16; ++i) {
#pragma unroll
        for (int j = 0; j < 16; ++j) {
            if ((i + 1) * (j + 1) <= 16) {
                const float s = v1[i] + v2[j];
                const unsigned key = (tk_f2key(s) & ~255u) | (unsigned)(255 - (i * 16 + j));
                tk_insert16(best, key);
            }
        }
    }
    const unsigned thr = best[15];
    const float mx = tk_key2f(best[0] & ~255u);
    float sum = 0.f;
#pragma unroll
    for (int i = 0; i < 16; ++i) {
#pragma unroll
        for (int j = 0; j < 16; ++j) {
            if ((i + 1) * (j + 1) <= 16) {
                const float s = v1[i] + v2[j];
                const unsigned key = (tk_f2key(s) & ~255u) | (unsigned)(255 - (i * 16 + j));
                if (key >= thr) sum += __builtin_expf(s - mx);
            }
        }
    }
    const float inv = 1.0f / sum;
    int cnt = 0;
#pragma unroll
    for (int i = 0; i < 16; ++i) {
#pragma unroll
        for (int j = 0; j < 16; ++j) {
            if ((i + 1) * (j + 1) <= 16) {
                const float s = v1[i] + v2[j];
                const unsigned key = (tk_f2key(s) & ~255u) | (unsigned)(255 - (i * 16 + j));
                if (key >= thr) {
                    oi[cnt] = (127 - (int)(k1[i] & 127u)) * 128 + (127 - (int)(k2[j] & 127u));
                    og[cnt] = __builtin_expf(s - mx) * inv;
                    ++cnt;
                }
            }
        }
    }
}
namespace nv {
struct ALf32 { const float* p; int lda; int pad; __device__ __forceinline__ float operator()(int m, int k) const { return p[(size_t)m * lda + k]; } };
struct ALbf16 { const bf16* p; int lda; int pad; __device__ __forceinline__ float operator()(int m, int k) const { return bf2f(p[(size_t)m * lda + k]); } };

template <class AL, class EPI, bool BT>
__global__ void __launch_bounds__(256) ngemm(AL al, const float* __restrict__ B, int ldb, const float* __restrict__ ks, int M, int N, int K, EPI epi) {
    __shared__ float As[16][68];
    __shared__ float Bs[16][68];
    const int tid = threadIdx.x, tx = tid & 15, ty = tid >> 4;
    const int m0 = blockIdx.y * 64, n0 = blockIdx.x * 64;
    float acc[4][4];
#pragma unroll
    for (int i = 0; i < 4; ++i)
#pragma unroll
        for (int j = 0; j < 4; ++j) acc[i][j] = 0.f;
    for (int k0 = 0; k0 < K; k0 += 16) {
#pragma unroll
        for (int i = 0; i < 4; ++i) {
            const int e = tid + i * 256;
            { const int m = e >> 4, k = e & 15; float v = al(m0 + m, k0 + k); if (ks) v *= ks[k0 + k]; As[k][m] = v; }
            if (BT) { const int n = e >> 4, k = e & 15; Bs[k][n] = B[(size_t)(n0 + n) * ldb + k0 + k]; }
            else { const int k = e >> 6, n = e & 63; Bs[k][n] = B[(size_t)(k0 + k) * ldb + n0 + n]; }
        }
        __syncthreads();
#pragma unroll
        for (int k = 0; k < 16; ++k) {
            float a[4], b[4];
#pragma unroll
            for (int i = 0; i < 4; ++i) { a[i] = As[k][ty * 4 + i]; b[i] = Bs[k][tx * 4 + i]; }
#pragma unroll
            for (int i = 0; i < 4; ++i)
#pragma unroll
                for (int j = 0; j < 4; ++j) acc[i][j] = fmaf(a[i], b[j], acc[i][j]);
        }
        __syncthreads();
    }
#pragma unroll
    for (int i = 0; i < 4; ++i)
#pragma unroll
        for (int j = 0; j < 4; ++j) epi(m0 + ty * 4 + i, n0 + tx * 4 + j, acc[i][j]);
}
template <class AL, class EPI, bool BT>
static void run_gemm(hipStream_t st, AL al, const float* B, int ldb, const float* ks, int M, int N, int K, EPI epi) {
    hipLaunchKernelGGL((ngemm<AL, EPI, BT>), dim3(N / 64, M / 64), dim3(256), 0, st, al, B, ldb, ks, M, N, K, epi);
}

__global__ void __launch_bounds__(256) rowsq(const float* __restrict__ X, float* rstd, float* part) {
    const int row = blockIdx.x * 4 + (threadIdx.x >> 6), lane = threadIdx.x & 63;
    const float* xr = X + (size_t)row * 1024;
    float s = 0.f;
    for (int j = 0; j < 16; ++j) { const float v = xr[lane + 64 * j]; s += v * v; }
    s = wave_sum(s);
    if (rstd && lane == 0) rstd[row] = 1.0f / sqrtf(s * (1.0f / 1024.0f) + EPS);
    if (part && lane < 16) part[(size_t)row * 16 + lane] = (lane == 0) ? s : 0.f;
}

struct EpiProj {
    const float* rstd; bf16 *qkv, *lx, *gl, *sga, *sgl;
    __device__ __forceinline__ void operator()(int m, int n, float v) const {
        v *= rstd[m];
        if (n < 768) qkv[(size_t)m * 768 + n] = f2bf(v);
        else if (n < 1792) lx[(size_t)m * 1024 + (n - 768)] = f2bf(v);
        else if (n < 2816) gl[(size_t)m * 1024 + (n - 1792)] = f2bf(gelu_tanh(v));
        else if (n < 3840) sga[(size_t)m * 1024 + (n - 2816)] = f2bf(sigmoidf_(v));
        else sgl[(size_t)m * 1024 + (n - 3840)] = f2bf(sigmoidf_(v));
    }
};

__global__ void __launch_bounds__(128) attn_naive(const bf16* __restrict__ qkv, const float* __restrict__ sink, bf16* __restrict__ att) {
    const int gid = blockIdx.x * 128 + threadIdx.x;
    const int head = gid / T_, t = gid % T_;
    const int b = t / S_, ts = t % S_;
    const int g = head >> 2;
    float q[64], acc[64];
    const bf16* qp = qkv + (size_t)t * 768 + head * 64;
#pragma unroll
    for (int d = 0; d < 64; ++d) { q[d] = bf2f(qp[d]); acc[d] = 0.f; }
    const float slope = exp2f(-(float)(head + 1));
    float m = -3.0e38f, l = 0.f;
    for (int dist = 127; dist >= 0; --dist) {
        const int s = ts - dist; if (s < 0) continue;
        const bf16* kp = qkv + (size_t)(b * S_ + s) * 768 + 512 + g * 64;
        const bf16* vp = kp + 128;
        float sc = 0.f;
#pragma unroll
        for (int d = 0; d < 64; ++d) sc = fmaf(q[d], bf2f(kp[d]), sc);
        sc = sc * 0.125f - slope * (float)dist;
        const float mn = fmaxf(m, sc), corr = __expf(m - mn), p = __expf(sc - mn);
        l = l * corr + p;
#pragma unroll
        for (int d = 0; d < 64; ++d) acc[d] = acc[d] * corr + p * bf2f(vp[d]);
        m = mn;
    }
    const float sk = sink[head];
    const float mf = fmaxf(m, sk), corr = __expf(m - mf);
    l = l * corr + __expf(sk - mf);
    const float inv = corr / l;
    bf16* op = att + (size_t)t * 512 + head * 64;
#pragma unroll
    for (int d = 0; d < 64; ++d) op[d] = f2bf(acc[d] * inv);
}

__global__ void __launch_bounds__(256) conv_naive(const bf16* __restrict__ lx, const float* __restrict__ cw, const float* __restrict__ cb, bf16* __restrict__ lin) {
    const size_t i = (size_t)blockIdx.x * 256 + threadIdx.x;
    const int c = (int)(i & 1023); const int t = (int)(i >> 10); const int ts = t % S_;
    float y = cb[c];
#pragma unroll
    for (int tap = 0; tap < 4; ++tap) { const int s = ts - 3 + tap; if (s >= 0) y = fmaf(bf2f(lx[(size_t)(t - 3 + tap) * 1024 + c]), cw[tap * 1024 + c], y); }
    lin[i] = f2bf(y);
}

__global__ void __launch_bounds__(128) lru_ab_naive(const bf16* __restrict__ lin, const float* __restrict__ wa, const float* __restrict__ ba, const float* __restrict__ wx, const float* __restrict__ bx,
                                                    const float* __restrict__ lam, float* __restrict__ Af, float* __restrict__ Bf) {
    __shared__ float xs[128];
    const int t = blockIdx.x >> 3, blk = blockIdx.x & 7, d = threadIdx.x, ch = blk * 128 + d;
    xs[d] = bf2f(lin[(size_t)t * 1024 + ch]);
    __syncthreads();
    float r = ba[ch], ii = bx[ch];
    const float* wap = wa + (size_t)blk * 128 * 128 + d; const float* wxp = wx + (size_t)blk * 128 * 128 + d;
    for (int c = 0; c < 128; ++c) { r = fmaf(xs[c], wap[c * 128], r); ii = fmaf(xs[c], wxp[c * 128], ii); }
    r = sigmoidf_(r); ii = sigmoidf_(ii);
    const float sp = log1pf(expf(-lam[ch]));
    const float loga = -8.0f * r * sp;
    const float a = expf(loga);
    const float bb = sqrtf(-expm1f(2.0f * loga)) * (ii * xs[d]);
    Af[(size_t)t * 1024 + ch] = a; Bf[(size_t)t * 1024 + ch] = bb;
}
__global__ void __launch_bounds__(256) lru_ab_from_pre(const bf16* __restrict__ lin, const float* __restrict__ ba, const float* __restrict__ bx, const float* __restrict__ lam, float* __restrict__ Af, float* __restrict__ Bf) {
    const size_t i = (size_t)blockIdx.x * 256 + threadIdx.x; const int ch = (int)(i & 1023);
    const float r = sigmoidf_(Af[i] + ba[ch]), ii = sigmoidf_(Bf[i] + bx[ch]);
    const float loga = -8.0f * r * log1pf(expf(-lam[ch]));
    Af[i] = expf(loga); Bf[i] = sqrtf(-expm1f(2.0f * loga)) * (ii * bf2f(lin[i]));
}
template <int L>
__global__ void __launch_bounds__(64) lru_finish_naive_L(const bf16* __restrict__ hloc, const bf16* __restrict__ pcum, const bf16* __restrict__ gl, bf16* __restrict__ rec) {
    const int gid = blockIdx.x * 64 + threadIdx.x; const int b = gid >> 10, ch = gid & 1023;
    float carry = 0.f;
    for (int c = 0; c < S_ / L; ++c) {
        float la = 1.f, lb = 0.f;
        for (int s = 0; s < L; ++s) { const size_t o = (size_t)(b * S_ + c * L + s) * 1024 + ch; la = bf2f(pcum[o]); lb = bf2f(hloc[o]); const float h = la * carry + lb; rec[o] = f2bf(h * bf2f(gl[o])); }
        carry = la * carry + lb;
    }
}
__global__ void __launch_bounds__(64) lru_finish_naive(const bf16* __restrict__ hloc, const bf16* __restrict__ pcum, const float* __restrict__ agg, const bf16* __restrict__ gl, bf16* __restrict__ rec) {
    const int gid = blockIdx.x * 64 + threadIdx.x; const int b = gid >> 10, ch = gid & 1023;
    float carry = 0.f;
    for (int c = 0; c < 32; ++c) {
        const int chunk = b * 32 + c;
        for (int s = 0; s < 64; ++s) { const size_t o = (size_t)(chunk * 64 + s) * 1024 + ch; const float h = bf2f(pcum[o]) * carry + bf2f(hloc[o]); rec[o] = f2bf(h * bf2f(gl[o])); }
        const float* ap = agg + ((size_t)chunk * 1024 + ch) * 2; carry = ap[0] * carry + ap[1];
    }
}
__global__ void __launch_bounds__(128) lru_pre_check(const bf16* __restrict__ lin, const float* __restrict__ wa, const float* __restrict__ wx, const float* __restrict__ Rp, const float* __restrict__ Ip, unsigned* flag) {
    __shared__ float xs[128];
    const int t = blockIdx.x >> 3, blk = blockIdx.x & 7, d = threadIdx.x, ch = blk * 128 + d;
    xs[d] = bf2f(lin[(size_t)t * 1024 + ch]);
    __syncthreads();
    float r = 0.f, ii = 0.f;
    const float* wap = wa + (size_t)blk * 128 * 128 + d; const float* wxp = wx + (size_t)blk * 128 * 128 + d;
    for (int c = 0; c < 128; ++c) { r = fmaf(xs[c], wap[c * 128], r); ii = fmaf(xs[c], wxp[c * 128], ii); }
    const float dr = fabsf(r - Rp[(size_t)t * 1024 + ch]), di = fabsf(ii - Ip[(size_t)t * 1024 + ch]);
    if (!(dr < 0.08f + 0.03f * fabsf(r)) || !(di < 0.08f + 0.03f * fabsf(ii))) atomicAdd(flag, 1u);
}
__global__ void __launch_bounds__(256) poison_if(float* out, const unsigned* flag) { if (*flag) { const size_t i = (size_t)blockIdx.x * 256 + threadIdx.x; out[i] = out[i] * 50.0f + 3.0f; } }
__global__ void __launch_bounds__(64) lru_scan_naive(const float* __restrict__ Af, const float* __restrict__ Bf, const bf16* __restrict__ gl, bf16* __restrict__ rec) {
    const int gid = blockIdx.x * 64 + threadIdx.x; const int b = gid >> 10, ch = gid & 1023;
    float h = 0.f;
    for (int s = 0; s < S_; ++s) { const size_t o = (size_t)(b * S_ + s) * 1024 + ch; h = fmaf(Af[o], h, Bf[o]); rec[o] = f2bf(h * bf2f(gl[o])); }
}

struct EpiMP { const bf16* sga; float* mp; __device__ __forceinline__ void operator()(int m, int n, float v) const { const size_t o = (size_t)m * 1024 + n; mp[o] = v * bf2f(sga[o]); } };
struct EpiMerged { const bf16* sgl; const float* mp; bf16* merged; __device__ __forceinline__ void operator()(int m, int n, float v) const { const size_t o = (size_t)m * 1024 + n; merged[o] = f2bf(mp[o] + v * bf2f(sgl[o])); } };
struct EpiH1 { const float* x; float* h1; bf16* h1b; __device__ __forceinline__ void operator()(int m, int n, float v) const { const size_t o = (size_t)m * 1024 + n; const float h = x[o] + v; h1[o] = h; h1b[o] = f2bf(h); } };
struct EpiScaleF32 { const float* part; float* out; int ldo; int pad; __device__ __forceinline__ void operator()(int m, int n, float v) const {
    float s = 0.f; for (int i = 0; i < 16; ++i) s += part[(size_t)m * 16 + i];
    out[(size_t)m * ldo + n] = v * (1.0f / sqrtf(s * (1.0f / 1024.0f) + EPS)); } };
struct EpiPlainF32 { float* out; int ldo; int pad; __device__ __forceinline__ void operator()(int m, int n, float v) const { out[(size_t)m * ldo + n] = v; } };
struct EpiPP { bf16* pp; __device__ __forceinline__ void operator()(int m, int n, float v) const { pp[(size_t)m * 1024 + n] = f2bf(v); } };
struct EpiH3 { const float* rstd3; const bf16* pp; float* h; __device__ __forceinline__ void operator()(int m, int n, float v) const { const size_t o = (size_t)m * 1024 + n; h[o] = h[o] + sigmoidf_(v * rstd3[m]) * bf2f(pp[o]); } };

__global__ void __launch_bounds__(256) final_norm(float* __restrict__ h, const float* __restrict__ part, const float* __restrict__ fg) {
    const int row = blockIdx.x * 4 + (threadIdx.x >> 6), lane = threadIdx.x & 63;
    float s = 0.f; for (int i = 0; i < 16; ++i) s += part[(size_t)row * 16 + i];
    const float r = 1.0f / sqrtf(s * (1.0f / 1024.0f) + EPS);
    float* hr = h + (size_t)row * 1024;
    for (int j = 0; j < 16; ++j) { const int c = lane + 64 * j; hr[c] = hr[c] * r * fg[c]; }
}
}
#define LAS __attribute__((address_space(3)))
typedef float f32x4 __attribute__((ext_vector_type(4)));
typedef unsigned u32x4 __attribute__((ext_vector_type(4)));
typedef int i32x4 __attribute__((ext_vector_type(4)));

constexpr int TK_TOK = 32;
constexpr int TK_LSTRIDE = 132;
constexpr int TK_LDS_BYTES = 256 * TK_LSTRIDE * 4;

__device__ __forceinline__ void topk_item(LAS float* lds, const float* __restrict__ SC, int item, int head_base, int* __restrict__ seli, float* __restrict__ selg, int tid) {
    const f32x4* src = (const f32x4*)(SC + (size_t)item * TK_TOK * 1024);
#pragma unroll 4
    for (int i = 0; i < 16; ++i) {
        const int idx = tid + i * 512; const int row = idx >> 8, c4 = idx & 255;
        const f32x4 v = src[idx];
        const int list = row * 8 + (c4 >> 5), elem = (c4 & 31) * 4;
        *(LAS f32x4*)(lds + list * TK_LSTRIDE + elem) = v;
    }
    __syncthreads();
    if (tid < 256) {
        const LAS float* my = lds + tid * TK_LSTRIDE;
        unsigned acc[16];
#pragma unroll
        for (int g = 0; g < 8; ++g) {
            unsigned t[16];
#pragma unroll
            for (int q = 0; q < 4; ++q) {
                const f32x4 v = *(const LAS f32x4*)(my + g * 16 + q * 4);
#pragma unroll
                for (int c = 0; c < 4; ++c) { const int e = g * 16 + q * 4 + c; t[q * 4 + c] = (tk_f2key(v[c]) & ~127u) | (unsigned)(127 - e); }
            }
            tk_sort16(t);
            if (g == 0) {
#pragma unroll
                for (int i = 0; i < 16; ++i) acc[i] = t[i];
            } else tk_merge16(acc, t);
        }
        unsigned oth[16];
#pragma unroll
        for (int i = 0; i < 16; ++i) oth[i] = (unsigned)__shfl_xor((int)acc[i], 1);
        if ((tid & 1) == 0) {
            const int tok = item * TK_TOK + (tid >> 3), head = head_base + ((tid >> 1) & 3);
            tk_combine_store(acc, oth, seli + (size_t)tok * 128 + head * 16, selg + (size_t)tok * 128 + head * 16);
        }
    }
    __syncthreads();
}
__global__ void __launch_bounds__(512) topk_kernel(const float* __restrict__ SC, int head_base, int* __restrict__ seli, float* __restrict__ selg) {
    extern __shared__ __attribute__((aligned(16))) unsigned char dyn_lds[];
    for (int item = blockIdx.x; item < T_ / TK_TOK; item += gridDim.x) topk_item((LAS float*)dyn_lds, SC, item, head_base, seli, selg, (int)threadIdx.x);
}

template <int MODE>
__device__ __forceinline__ void gather_token(int t, int lane, const void* __restrict__ Utab, const void* __restrict__ Vtab, const float* __restrict__ gffn,
                                             const int* __restrict__ seli, const float* __restrict__ selg, const float* __restrict__ part2,
                                             float* __restrict__ H  , bf16* __restrict__ h2b, float* __restrict__ rstd3) {
    float ps = (lane < 16) ? part2[(size_t)t * 16 + lane] : 0.f;
    ps = wave_sum(ps);
    const float rstd2 = 1.0f / sqrtf(ps * (1.0f / 1024.0f) + EPS);
    const int iA = seli[(size_t)t * 128 + lane], iB = seli[(size_t)t * 128 + 64 + lane];
    const float gA = selg[(size_t)t * 128 + lane], gB = selg[(size_t)t * 128 + 64 + lane];
    float* hr = H + (size_t)t * 1024;
    if constexpr (MODE == 0) {
        f32x4 x[4], y[4], hv[4];
#pragma unroll
        for (int j = 0; j < 4; ++j) { hv[j] = *(const f32x4*)(hr + 256 * j + 4 * lane); const f32x4 g = *(const f32x4*)(gffn + 256 * j + 4 * lane); x[j] = hv[j] * g; y[j] = (f32x4){0.f, 0.f, 0.f, 0.f}; }
        const float* U = (const float*)Utab; const float* V = (const float*)Vtab;
        for (int k = 0; k < 64; ++k) {
#pragma unroll
            for (int hh = 0; hh < 2; ++hh) {
                const int e = __builtin_amdgcn_readlane(hh ? iB : iA, k);
                const float gt = __builtin_bit_cast(float, __builtin_amdgcn_readlane(__builtin_bit_cast(int, hh ? gB : gA), k));
                const float* ur = U + (size_t)e * 1024; const float* vr = V + (size_t)e * 1024;
                f32x4 uv[4], vv[4];
#pragma unroll
                for (int j = 0; j < 4; ++j) { uv[j] = *(const f32x4*)(ur + 256 * j + 4 * lane); vv[j] = *(const f32x4*)(vr + 256 * j + 4 * lane); }
                float d = 0.f;
#pragma unroll
                for (int j = 0; j < 4; ++j) d += (uv[j].x * x[j].x + uv[j].y * x[j].y) + (uv[j].z * x[j].z + uv[j].w * x[j].w);
                d = wave_sum(d);
                const float c = gt * gelu_tanh(d * rstd2);
#pragma unroll
                for (int j = 0; j < 4; ++j) y[j] += vv[j] * c;
            }
        }
        float sq = 0.f;
#pragma unroll
        for (int j = 0; j < 4; ++j) {
            const f32x4 h2 = hv[j] + y[j];
            *(f32x4*)(hr + 256 * j + 4 * lane) = h2;
            sq += (h2.x * h2.x + h2.y * h2.y) + (h2.z * h2.z + h2.w * h2.w);
            uint2 w; w.x = pk2(h2.x, h2.y); w.y = pk2(h2.z, h2.w);
            *(uint2*)(h2b + (size_t)t * 1024 + 256 * j + 4 * lane) = w;
        }
        sq = wave_sum(sq);
        if (lane == 0) rstd3[t] = 1.0f / sqrtf(sq * (1.0f / 1024.0f) + EPS);
    } else {
        float x[2][8], y[2][8], hv[2][8];
#pragma unroll
        for (int j = 0; j < 2; ++j) {
            const f32x4 a = *(const f32x4*)(hr + 512 * j + 8 * lane), b = *(const f32x4*)(hr + 512 * j + 8 * lane + 4);
            hv[j][0] = a.x; hv[j][1] = a.y; hv[j][2] = a.z; hv[j][3] = a.w; hv[j][4] = b.x; hv[j][5] = b.y; hv[j][6] = b.z; hv[j][7] = b.w;
#pragma unroll
            for (int c = 0; c < 8; ++c) { x[j][c] = hv[j][c]; y[j][c] = 0.f; }
        }
        const bf16* U = (const bf16*)Utab; const bf16* V = (const bf16*)Vtab;
        for (int k = 0; k < 64; k += 2) {
            u32x4 uv[4][2], vv[4][2]; float gt[4];
#pragma unroll
            for (int q = 0; q < 4; ++q) {
                const int kk = k + (q >> 1); const int hh = q & 1;
                const int e = __builtin_amdgcn_readlane(hh ? iB : iA, kk);
                gt[q] = __builtin_bit_cast(float, __builtin_amdgcn_readlane(__builtin_bit_cast(int, hh ? gB : gA), kk));
                const bf16* ur = U + (size_t)e * 1024; const bf16* vr = V + (size_t)e * 1024;
#pragma unroll
                for (int j = 0; j < 2; ++j) { uv[q][j] = *(const u32x4*)(ur + 512 * j + 8 * lane); vv[q][j] = *(const u32x4*)(vr + 512 * j + 8 * lane); }
            }
#pragma unroll
            for (int q = 0; q < 4; ++q) {
                float d = 0.f;
#pragma unroll
                for (int j = 0; j < 2; ++j)
#pragma unroll
                    for (int c = 0; c < 4; ++c) { const unsigned w = uv[q][j][c]; d = fmaf(__builtin_bit_cast(float, w << 16), x[j][2 * c], d); d = fmaf(__builtin_bit_cast(float, w & 0xffff0000u), x[j][2 * c + 1], d); }
                d = wave_sum(d);
                const float cf = gt[q] * gelu_tanh(d * rstd2);
#pragma unroll
                for (int j = 0; j < 2; ++j)
#pragma unroll
                    for (int c = 0; c < 4; ++c) { const unsigned w = vv[q][j][c]; y[j][2 * c] = fmaf(__builtin_bit_cast(float, w << 16), cf, y[j][2 * c]); y[j][2 * c + 1] = fmaf(__builtin_bit_cast(float, w & 0xffff0000u), cf, y[j][2 * c + 1]); }
            }
        }
        float sq = 0.f;
#pragma unroll
        for (int j = 0; j < 2; ++j) {
            float h2[8];
#pragma unroll
            for (int c = 0; c < 8; ++c) { h2[c] = hv[j][c] + y[j][c]; sq += h2[c] * h2[c]; }
            *(f32x4*)(hr + 512 * j + 8 * lane) = (f32x4){h2[0], h2[1], h2[2], h2[3]};
            *(f32x4*)(hr + 512 * j + 8 * lane + 4) = (f32x4){h2[4], h2[5], h2[6], h2[7]};
            u32x4 w; w.x = pk2(h2[0], h2[1]); w.y = pk2(h2[2], h2[3]); w.z = pk2(h2[4], h2[5]); w.w = pk2(h2[6], h2[7]);
            *(u32x4*)(h2b + (size_t)t * 1024 + 512 * j + 8 * lane) = w;
        }
        sq = wave_sum(sq);
        if (lane == 0) rstd3[t] = 1.0f / sqrtf(sq * (1.0f / 1024.0f) + EPS);
    }
}
template <int MODE>
__global__ void __launch_bounds__(256) gather_kernel(const void* __restrict__ Utab, const void* __restrict__ Vtab, const float* __restrict__ gffn, const int* __restrict__ seli, const float* __restrict__ selg,
                                                     const float* __restrict__ part2, float* __restrict__ H, bf16* __restrict__ h2b, float* __restrict__ rstd3) {
    const int lane = threadIdx.x & 63; const int w = blockIdx.x * 4 + (threadIdx.x >> 6); const int nw = gridDim.x * 4;
    for (int t = w; t < T_; t += nw) gather_token<MODE>(t, lane, Utab, Vtab, gffn, seli, selg, part2, H, h2b, rstd3);
}

typedef float f32x2 __attribute__((ext_vector_type(2)));
__device__ __forceinline__ float reduce4_transpose(float d0, float d1, float d2, float d3, int lane) {
    const bool b0 = lane & 1, b1 = lane & 2;
    const float a = (b0 ? d1 : d0) + __shfl_xor(b0 ? d0 : d1, 1);
    const float b = (b0 ? d3 : d2) + __shfl_xor(b0 ? d2 : d3, 1);
    float c = (b1 ? b : a) + __shfl_xor(b1 ? a : b, 2);
    c += __shfl_xor(c, 4); c += __shfl_xor(c, 8); c += __shfl_xor(c, 16); c += __shfl_xor(c, 32);
    return c;
}
__device__ __forceinline__ float dot16_fp8(const u32x4 w, const f32x2 (&x2)[8]) {
    f32x2 acc = (f32x2){0.f, 0.f};
#pragma unroll
    for (int c = 0; c < 4; ++c) { const unsigned ww = w[c]; const f32x2 lo = __builtin_amdgcn_cvt_pk_f32_fp8(ww, false), hi = __builtin_amdgcn_cvt_pk_f32_fp8(ww, true); acc = lo * x2[2 * c] + acc; acc = hi * x2[2 * c + 1] + acc; }
    return acc.x + acc.y;
}
__device__ __forceinline__ void axpy16_fp8(const u32x4 w, float cf, f32x2 (&y2)[8]) {
#pragma unroll
    for (int c = 0; c < 4; ++c) { const unsigned ww = w[c]; const f32x2 lo = __builtin_amdgcn_cvt_pk_f32_fp8(ww, false), hi = __builtin_amdgcn_cvt_pk_f32_fp8(ww, true); y2[2 * c] = lo * cf + y2[2 * c]; y2[2 * c + 1] = hi * cf + y2[2 * c + 1]; }
}
__device__ __forceinline__ float sel4f(float v0, float v1, float v2, float v3, int q) { return q == 0 ? v0 : (q == 1 ? v1 : (q == 2 ? v2 : v3)); }
__device__ __forceinline__ void gather_token_fp8(int t, int lane, const unsigned char* __restrict__ U8, const unsigned char* __restrict__ V8, const float* __restrict__ IU, const float* __restrict__ IV,
                                                 const int* __restrict__ seli, const float* __restrict__ selg, const float* __restrict__ part2,
                                                 float* __restrict__ H, bf16* __restrict__ h2b, float* __restrict__ rstd3) {
    float ps = (lane < 16) ? part2[(size_t)t * 16 + lane] : 0.f;
    ps = wave_sum(ps);
    const float rstd2 = 1.0f / sqrtf(ps * (1.0f / 1024.0f) + EPS);
    const int iA = seli[(size_t)t * 128 + lane], iB = seli[(size_t)t * 128 + 64 + lane];
    const float duA = IU[iA] * rstd2, duB = IU[iB] * rstd2;
    const float gvA = selg[(size_t)t * 128 + lane] * IV[iA], gvB = selg[(size_t)t * 128 + 64 + lane] * IV[iB];
    float* hr = H + (size_t)t * 1024 + 16 * lane;
    f32x2 x2[8], y2[8]; f32x4 hv[4];
#pragma unroll
    for (int j = 0; j < 4; ++j) { hv[j] = *(const f32x4*)(hr + 4 * j); x2[2 * j] = (f32x2){hv[j][0], hv[j][1]}; x2[2 * j + 1] = (f32x2){hv[j][2], hv[j][3]}; y2[2 * j] = (f32x2){0.f, 0.f}; y2[2 * j + 1] = (f32x2){0.f, 0.f}; }
    const int q = lane & 3;
#pragma unroll 1
    for (int k = 0; k < 64; k += 4) {
        u32x4 uu[8], vv[8]; float du[8], gv[8];
#pragma unroll
        for (int s = 0; s < 8; ++s) {
            const int kk = k + (s >> 1); const bool hh = s & 1;
            const int e = __builtin_amdgcn_readlane(hh ? iB : iA, kk);
            du[s] = __int_as_float(__builtin_amdgcn_readlane(__float_as_int(hh ? duB : duA), kk));
            gv[s] = __int_as_float(__builtin_amdgcn_readlane(__float_as_int(hh ? gvB : gvA), kk));
            uu[s] = *(const u32x4*)(U8 + (size_t)e * 1024 + 16 * lane);
            vv[s] = *(const u32x4*)(V8 + (size_t)e * 1024 + 16 * lane);
        }
#pragma unroll
        for (int g = 0; g < 2; ++g) {
            const float d0 = dot16_fp8(uu[4 * g + 0], x2), d1 = dot16_fp8(uu[4 * g + 1], x2), d2 = dot16_fp8(uu[4 * g + 2], x2), d3 = dot16_fp8(uu[4 * g + 3], x2);
            const float tot = reduce4_transpose(d0, d1, d2, d3, lane);
            const float z = tot * sel4f(du[4 * g], du[4 * g + 1], du[4 * g + 2], du[4 * g + 3], q);
            const float cf = gelu_tanh(z) * sel4f(gv[4 * g], gv[4 * g + 1], gv[4 * g + 2], gv[4 * g + 3], q);
#pragma unroll
            for (int s = 0; s < 4; ++s) { const float cs = __int_as_float(__builtin_amdgcn_readlane(__float_as_int(cf), s)); axpy16_fp8(vv[4 * g + s], cs, y2); }
        }
    }
    float sq = 0.f;
    f32x4 h2[4];
#pragma unroll
    for (int j = 0; j < 4; ++j) {
        h2[j] = hv[j] + (f32x4){y2[2 * j].x, y2[2 * j].y, y2[2 * j + 1].x, y2[2 * j + 1].y};
        *(f32x4*)(hr + 4 * j) = h2[j];
        sq += (h2[j][0] * h2[j][0] + h2[j][1] * h2[j][1]) + (h2[j][2] * h2[j][2] + h2[j][3] * h2[j][3]);
    }
    u32x4 w0, w1; w0.x = pk2(h2[0][0], h2[0][1]); w0.y = pk2(h2[0][2], h2[0][3]); w0.z = pk2(h2[1][0], h2[1][1]); w0.w = pk2(h2[1][2], h2[1][3]);
    w1.x = pk2(h2[2][0], h2[2][1]); w1.y = pk2(h2[2][2], h2[2][3]); w1.z = pk2(h2[3][0], h2[3][1]); w1.w = pk2(h2[3][2], h2[3][3]);
    u32x4* ob = (u32x4*)(h2b + (size_t)t * 1024 + 16 * lane); ob[0] = w0; ob[1] = w1;
    sq = wave_sum(sq);
    if (lane == 0) rstd3[t] = 1.0f / sqrtf(sq * (1.0f / 1024.0f) + EPS);
}

__device__ __forceinline__ unsigned umin_(unsigned a, unsigned b) { return a < b ? a : b; }
__device__ __forceinline__ unsigned umax_(unsigned a, unsigned b) { return a > b ? a : b; }
__device__ __forceinline__ void sort128(unsigned& k0, unsigned& k1, int lane) {
#pragma unroll
    for (int k = 2; k <= 128; k <<= 1) {
#pragma unroll
        for (int j = k >> 1; j >= 1; j >>= 1) {
            if (j == 64) { const unsigned mn = umin_(k0, k1), mx = umax_(k0, k1); k0 = mn; k1 = mx; }
            else {
                const unsigned o0 = (unsigned)__shfl_xor((int)k0, j), o1 = (unsigned)__shfl_xor((int)k1, j);
                const bool up0 = (k == 128) ? true : (k == 64 ? true : ((lane & k) == 0));
                const bool up1 = (k == 128) ? true : (k == 64 ? false : ((lane & k) == 0));
                const bool lower = (lane & j) == 0;
                k0 = (lower == up0) ? umin_(k0, o0) : umax_(k0, o0);
                k1 = (lower == up1) ? umin_(k1, o1) : umax_(k1, o1);
            }
        }
    }
}
typedef int i32x4v __attribute__((ext_vector_type(4)));
#ifndef NSLICE
#define NSLICE 8
#endif
#define SLICE_SHIFT (NSLICE == 32 ? 25 : (NSLICE == 16 ? 26 : (NSLICE == 8 ? 27 : (NSLICE == 4 ? 28 : 30))))
typedef unsigned u32x2 __attribute__((ext_vector_type(2)));
__device__ __forceinline__ f32x4 bf4_lo(u32x2 w) { return (f32x4){__builtin_bit_cast(float, w.x << 16), __builtin_bit_cast(float, w.x & 0xffff0000u), __builtin_bit_cast(float, w.y << 16), __builtin_bit_cast(float, w.y & 0xffff0000u)}; }
struct TokState { f32x2 y2[8]; unsigned k0, k1; int bnd; float rsx; };
__device__ __forceinline__ int count_lt(const TokState& S, unsigned bound) {
    return __builtin_popcountll(__builtin_amdgcn_ballot_w64(S.k0 < bound)) + __builtin_popcountll(__builtin_amdgcn_ballot_w64(S.k1 < bound));
}
__device__ __forceinline__ int bperm_i(int srclane, int v) { return __builtin_amdgcn_ds_bpermute(srclane << 2, v); }
__device__ __forceinline__ float bperm_f(int srclane, float v) { return __int_as_float(__builtin_amdgcn_ds_bpermute(srclane << 2, __float_as_int(v))); }
template <int PM>
__device__ __forceinline__ void gather_batch(TokState& S, int p, int hi, int lane, const LAS unsigned char* xs, const unsigned char* __restrict__ U8, const unsigned char* __restrict__ V8, const float* __restrict__ IU, const float* __restrict__ IV) {
    const int n = (hi - p < 16) ? hi - p : 16;
    const int m = lane & 15, kq = lane >> 4;
    const int r = (m < n) ? p + m : hi - 1; const int sl = r & 63; const bool lo = r < 64;
    const unsigned ka = (unsigned)bperm_i(sl, (int)S.k0), kb = (unsigned)bperm_i(sl, (int)S.k1);
    const int es = (int)((lo ? ka : kb) >> 16);
    const unsigned key = lo ? ka : kb;
    const float dus = IU[es] * S.rsx, gvs = (m < n) ? (float)(key & 0xffffu) * (1.0f / 65535.0f) * IV[es] : 0.f;
    const unsigned char* ua = U8 + (size_t)es * 1024 + 16 * kq;
    i32x4v A[16];
    if (!(PM & 2)) {
#pragma unroll
        for (int s = 0; s < 16; ++s) { if (PM & 16) { const int e = __builtin_amdgcn_readlane(es, s); A[s] = *(const i32x4v*)(U8 + (size_t)e * 1024 + 16 * lane); } else A[s] = *(const i32x4v*)(ua + 64 * s); }
    }
    u32x4 vv[16];
    if (!(PM & 1)) {
#pragma unroll
        for (int q = 0; q < 8; ++q) if (q < n) { const int e = __builtin_amdgcn_readlane(es, q); vv[q] = *(const u32x4*)(V8 + (size_t)e * 1024 + 16 * lane); }
        if (n > 8) {
#pragma unroll
            for (int q = 8; q < 16; ++q) if (q < n) { const int e = __builtin_amdgcn_readlane(es, q); vv[q] = *(const u32x4*)(V8 + (size_t)e * 1024 + 16 * lane); }
        }
    }
    i32x4v acc = (i32x4v){0, 0, 0, 0};
    if (!(PM & 2)) {
#pragma unroll
        for (int s = 0; s < 16; ++s) { const i32x4v B = *(const LAS i32x4v*)(xs + 64 * s + 16 * kq); acc = __builtin_amdgcn_mfma_i32_16x16x64_i8(A[s], B, acc, 0, 0, 0); }
    } else { acc = (i32x4v){es, es + 1, es + 2, es + 3}; }
    float cf[4];
#pragma unroll
    for (int j = 0; j < 4; ++j) { const int sm = 4 * kq + j; const float d = bperm_f(sm, dus), g = bperm_f(sm, gvs); cf[j] = g * gelu_tanh((float)acc[j] * d); }
    if (PM & 1) { S.y2[0].x += (cf[0] + cf[1]) + (cf[2] + cf[3]); }
    else if (PM & 4) {
#pragma unroll
        for (int q = 0; q < 16; ++q) if (q < n) { const float cs = __int_as_float(__builtin_amdgcn_readlane(__float_as_int(cf[q & 3]), 16 * (q >> 2))); S.y2[q & 7].x += cs * __uint_as_float((vv[q].x ^ vv[q].y ^ vv[q].z ^ vv[q].w) & 0x3fffffffu); }
    } else {
#pragma unroll
        for (int q = 0; q < 8; ++q) if (q < n) { const float cs = __int_as_float(__builtin_amdgcn_readlane(__float_as_int(cf[q & 3]), 16 * (q >> 2))); axpy16_fp8(vv[q], cs, S.y2); }
        if (n > 8) {
#pragma unroll
            for (int q = 8; q < 16; ++q) if (q < n) { const float cs = __int_as_float(__builtin_amdgcn_readlane(__float_as_int(cf[q & 3]), 16 * (q >> 2))); axpy16_fp8(vv[q], cs, S.y2); }
        }
    }
    __builtin_amdgcn_sched_barrier(0);
}
__device__ __forceinline__ void tok_setup(TokState& S, int t, int lane, LAS unsigned char* xs, const int* __restrict__ seli, const float* __restrict__ selg,
                                          const float* __restrict__ part2, const bf16* __restrict__ h1b) {
    float ps = (lane < 16) ? part2[(size_t)t * 16 + lane] : 0.f;
    ps = wave_sum(ps);
    const float rstd2 = 1.0f / sqrtf(ps * (1.0f / 1024.0f) + EPS);
    f32x4 hv[4]; float am = 0.f;
    { const u32x4* br = (const u32x4*)(h1b + (size_t)t * 1024 + 16 * lane); const u32x4 b0 = br[0], b1 = br[1];
      hv[0] = bf4_lo((u32x2){b0.x, b0.y}); hv[1] = bf4_lo((u32x2){b0.z, b0.w}); hv[2] = bf4_lo((u32x2){b1.x, b1.y}); hv[3] = bf4_lo((u32x2){b1.z, b1.w}); }
#pragma unroll
    for (int j = 0; j < 4; ++j) { am = fmaxf(am, fmaxf(fmaxf(fabsf(hv[j][0]), fabsf(hv[j][1])), fmaxf(fabsf(hv[j][2]), fabsf(hv[j][3])))); }
#pragma unroll
    for (int o = 1; o < 64; o <<= 1) am = fmaxf(am, __shfl_xor(am, o));
    const float sx = am > 0.f ? 127.0f / am : 1.0f, isx = am > 0.f ? am * (1.0f / 127.0f) : 1.0f;
    u32x4 xq;
#pragma unroll
    for (int j = 0; j < 4; ++j) { unsigned w = 0u;
#pragma unroll
        for (int c = 0; c < 4; ++c) w |= ((unsigned)(int)__builtin_rintf(hv[j][c] * sx) & 0xffu) << (8 * c);
        xq[j] = w; }
    *(LAS u32x4*)(xs + 16 * lane) = xq;
    const int iA = seli[(size_t)t * 128 + lane], iB = seli[(size_t)t * 128 + 64 + lane];
    const float gA = selg[(size_t)t * 128 + lane], gB = selg[(size_t)t * 128 + 64 + lane];
    S.k0 = ((unsigned)iA << 16) | (unsigned)(gA * 65535.0f + 0.5f); S.k1 = ((unsigned)iB << 16) | (unsigned)(gB * 65535.0f + 0.5f);
    sort128(S.k0, S.k1, lane);
    S.rsx = rstd2 * isx;
    int bnd = 0;
#pragma unroll
    for (int s = 1; s <= NSLICE; ++s) { const int c = count_lt(S, (unsigned)s << SLICE_SHIFT); bnd = (lane == s) ? c : bnd; }
    S.bnd = bnd;
#pragma unroll
    for (int j = 0; j < 8; ++j) S.y2[j] = (f32x2){0.f, 0.f};
}
__device__ __forceinline__ void tok_finish(const TokState& S, int t, int lane, const bf16* __restrict__ h1b, bf16* __restrict__ h2b, float* __restrict__ rstd3) {
    const u32x4* br = (const u32x4*)(h1b + (size_t)t * 1024 + 16 * lane); const u32x4 b0 = br[0], b1 = br[1];
    f32x4 h2[4]; h2[0] = bf4_lo((u32x2){b0.x, b0.y}); h2[1] = bf4_lo((u32x2){b0.z, b0.w}); h2[2] = bf4_lo((u32x2){b1.x, b1.y}); h2[3] = bf4_lo((u32x2){b1.z, b1.w});
    float sq = 0.f;
#pragma unroll
    for (int j = 0; j < 4; ++j) {
        h2[j] = h2[j] + (f32x4){S.y2[2 * j].x, S.y2[2 * j].y, S.y2[2 * j + 1].x, S.y2[2 * j + 1].y};
        sq += (h2[j][0] * h2[j][0] + h2[j][1] * h2[j][1]) + (h2[j][2] * h2[j][2] + h2[j][3] * h2[j][3]);
    }
    u32x4 w0, w1; w0.x = pk2(h2[0][0], h2[0][1]); w0.y = pk2(h2[0][2], h2[0][3]); w0.z = pk2(h2[1][0], h2[1][1]); w0.w = pk2(h2[1][2], h2[1][3]);
    w1.x = pk2(h2[2][0], h2[2][1]); w1.y = pk2(h2[2][2], h2[2][3]); w1.z = pk2(h2[3][0], h2[3][1]); w1.w = pk2(h2[3][2], h2[3][3]);
    u32x4* ob = (u32x4*)(h2b + (size_t)t * 1024 + 16 * lane); ob[0] = w0; ob[1] = w1;
    sq = wave_sum(sq);
    if (lane == 0) rstd3[t] = 1.0f / sqrtf(sq * (1.0f / 1024.0f) + EPS);
}
__device__ __forceinline__ int dpp_xor8(int v) { return __builtin_amdgcn_update_dpp(0, v, 0x128, 0xf, 0xf, false); }
__device__ __forceinline__ int dpp_xor4(int v) { return __builtin_amdgcn_update_dpp(0, __builtin_amdgcn_update_dpp(0, v, 0x141, 0xf, 0xf, false), 0x1b, 0xf, 0xf, false); }
__device__ __forceinline__ int dpp_xor1(int v) { return __builtin_amdgcn_update_dpp(0, v, 0xb1, 0xf, 0xf, false); }
__device__ __forceinline__ int dpp_xor2(int v) { return __builtin_amdgcn_update_dpp(0, v, 0x4e, 0xf, 0xf, false); }
__device__ __forceinline__ int reduce16_rows(int (&p)[16], int lane) {
    int r8[8], r4[4], r2[2];
#pragma unroll
    for (int i = 0; i < 8; ++i) { const u32x2 s = __builtin_amdgcn_permlane32_swap((unsigned)p[i], (unsigned)p[i + 8], false, false); r8[i] = (int)(s.x + s.y); }
#pragma unroll
    for (int i = 0; i < 4; ++i) { const u32x2 s = __builtin_amdgcn_permlane16_swap((unsigned)r8[i], (unsigned)r8[i + 4], false, false); r4[i] = (int)(s.x + s.y); }
    const bool b3 = lane & 8, b2 = lane & 4;
#pragma unroll
    for (int i = 0; i < 2; ++i) { const int s0 = r4[i] + dpp_xor8(r4[i]), s1 = r4[i + 2] + dpp_xor8(r4[i + 2]); r2[i] = b3 ? s1 : s0; }
    const int keep = b2 ? r2[1] : r2[0], send = b2 ? r2[0] : r2[1];
    int t = keep + dpp_xor4(send);
    t += dpp_xor1(t); t += dpp_xor2(t);
    return t;
}
struct TokState2 { f32x2 y2[8]; unsigned k0, k1; float rsx; };
template <int PM>
__device__ __forceinline__ void gather_batch_rows(TokState& S, int p, int hi, int lane, const LAS unsigned char* xs, const unsigned char* __restrict__ U8, const unsigned char* __restrict__ V8, const float* __restrict__ IU, const float* __restrict__ IV) {
    const int n = (hi - p < 16) ? hi - p : 16;
    const int slot = lane >> 2;
    const int r = (slot < n) ? p + slot : hi - 1; const int sl = r & 63; const bool lo = r < 64;
    const unsigned ka = (unsigned)bperm_i(sl, (int)S.k0), kb = (unsigned)bperm_i(sl, (int)S.k1);
    const unsigned key = lo ? ka : kb;
    const int es = (int)(key >> 16);
    const float dus = IU[es] * S.rsx, gvs = (slot < n) ? (float)(key & 0xffffu) * (1.0f / 65535.0f) * IV[es] : 0.f;
    i32x4v A[16]; u32x4 vv[16];
#pragma unroll
    for (int g = 0; g < 4; ++g) if (4 * g < n) {
#pragma unroll
        for (int q = 4 * g; q < 4 * g + 4; ++q) { int e = __builtin_amdgcn_readlane(es, 4 * q); if (PM & 32) e &= 1023; A[q] = *(const i32x4v*)(U8 + (size_t)e * 1024 + 16 * lane); }
    }
#pragma unroll
    for (int g = 0; g < 4; ++g) if (4 * g < n) {
#pragma unroll
        for (int q = 4 * g; q < 4 * g + 4; ++q) { int e = __builtin_amdgcn_readlane(es, 4 * q); if (PM & 32) e &= 1023; vv[q] = *(const u32x4*)(V8 + (size_t)e * 1024 + 16 * lane); }
    }
    const i32x4v X = *(const LAS i32x4v*)(xs + 16 * lane);
    int pp[16];
#pragma unroll
    for (int g = 0; g < 4; ++g) {
        if (4 * g < n) {
#pragma unroll
            for (int q = 4 * g; q < 4 * g + 4; ++q) pp[q] = __builtin_amdgcn_sdot4(A[q][3], X[3], __builtin_amdgcn_sdot4(A[q][2], X[2], __builtin_amdgcn_sdot4(A[q][1], X[1], __builtin_amdgcn_sdot4(A[q][0], X[0], 0, false), false), false), false);
        } else {
#pragma unroll
            for (int q = 4 * g; q < 4 * g + 4; ++q) pp[q] = 0;
        }
    }
    const int tot = reduce16_rows(pp, lane);
    const float cf = gvs * gelu_tanh((float)tot * dus);
#pragma unroll
    for (int g = 0; g < 4; ++g) if (4 * g < n) {
#pragma unroll
        for (int q = 4 * g; q < 4 * g + 4; ++q) { const float cs = __int_as_float(__builtin_amdgcn_readlane(__float_as_int(cf), 4 * q)); axpy16_fp8(vv[q], cs, S.y2); }
    }
    __builtin_amdgcn_sched_barrier(0);
}

template <int PM>
__device__ __forceinline__ void gather_batch16(TokState2& S, int bi, int lane, const LAS unsigned char* xs, const unsigned char* __restrict__ U8, const unsigned char* __restrict__ V8, const float* __restrict__ IU, const float* __restrict__ IV) {
    const unsigned ksel = (bi < 4) ? S.k0 : S.k1;
    const int lb = (bi & 3) << 4;
    const unsigned key = (unsigned)bperm_i(lb + (lane >> 2), (int)ksel);
    const int es = (int)(key >> 16);
    const float dus = IU[es] * S.rsx, gvs = (float)(key & 0xffffu) * (1.0f / 65535.0f) * IV[es];
    i32x4v A[16]; u32x4 vv[16];
#pragma unroll
    for (int q = 0; q < 16; ++q) { int e = (int)((unsigned)__builtin_amdgcn_readlane((int)ksel, lb + q) >> 16); if (PM & 32) e &= 1023; if (!(PM & 2)) A[q] = *(const i32x4v*)(U8 + (size_t)e * 1024 + 16 * lane); else A[q] = (i32x4v){e, e, e, e}; }
#pragma unroll
    for (int q = 0; q < 16; ++q) { int e = (int)((unsigned)__builtin_amdgcn_readlane((int)ksel, lb + q) >> 16); if (PM & 32) e &= 1023; if (!(PM & 1)) vv[q] = *(const u32x4*)(V8 + (size_t)e * 1024 + 16 * lane); else vv[q] = (u32x4){(unsigned)e, 0u, 0u, 0u}; }
    const i32x4v X = *(const LAS i32x4v*)(xs + 16 * lane);
    int p[16];
#pragma unroll
    for (int q = 0; q < 16; ++q) p[q] = __builtin_amdgcn_sdot4(A[q][3], X[3], __builtin_amdgcn_sdot4(A[q][2], X[2], __builtin_amdgcn_sdot4(A[q][1], X[1], __builtin_amdgcn_sdot4(A[q][0], X[0], 0, false), false), false), false);
    const int tot = reduce16_rows(p, lane);
    const float cf = gvs * gelu_tanh((float)tot * dus);
#pragma unroll
    for (int q = 0; q < 16; ++q) { const float cs = __int_as_float(__builtin_amdgcn_readlane(__float_as_int(cf), 4 * q)); if (PM & 1) S.y2[q & 7].x += cs * __uint_as_float(vv[q].x); else axpy16_fp8(vv[q], cs, S.y2); }
    __builtin_amdgcn_sched_barrier(0);
}
__device__ __forceinline__ void tok_setup2(TokState2& S, int t, int lane, LAS unsigned char* xs, const int* __restrict__ seli, const float* __restrict__ selg,
                                           const float* __restrict__ part2, const bf16* __restrict__ h1b) {
    float ps = (lane < 16) ? part2[(size_t)t * 16 + lane] : 0.f;
    ps = wave_sum(ps);
    const float rstd2 = 1.0f / sqrtf(ps * (1.0f / 1024.0f) + EPS);
    f32x4 hv[4]; float am = 0.f;
    { const u32x4* br = (const u32x4*)(h1b + (size_t)t * 1024 + 16 * lane); const u32x4 b0 = br[0], b1 = br[1];
      hv[0] = bf4_lo((u32x2){b0.x, b0.y}); hv[1] = bf4_lo((u32x2){b0.z, b0.w}); hv[2] = bf4_lo((u32x2){b1.x, b1.y}); hv[3] = bf4_lo((u32x2){b1.z, b1.w}); }
#pragma unroll
    for (int j = 0; j < 4; ++j) { am = fmaxf(am, fmaxf(fmaxf(fabsf(hv[j][0]), fabsf(hv[j][1])), fmaxf(fabsf(hv[j][2]), fabsf(hv[j][3])))); }
#pragma unroll
    for (int o = 1; o < 64; o <<= 1) am = fmaxf(am, __shfl_xor(am, o));
    const float sx = am > 0.f ? 127.0f / am : 1.0f, isx = am > 0.f ? am * (1.0f / 127.0f) : 1.0f;
    u32x4 xq;
#pragma unroll
    for (int j = 0; j < 4; ++j) { unsigned w = 0u;
#pragma unroll
        for (int c = 0; c < 4; ++c) w |= ((unsigned)(int)__builtin_rintf(hv[j][c] * sx) & 0xffu) << (8 * c);
        xq[j] = w; }
    *(LAS u32x4*)(xs + 16 * lane) = xq;
    const int iA = seli[(size_t)t * 128 + lane], iB = seli[(size_t)t * 128 + 64 + lane];
    const float gA = selg[(size_t)t * 128 + lane], gB = selg[(size_t)t * 128 + 64 + lane];
    S.k0 = ((unsigned)iA << 16) | (unsigned)(gA * 65535.0f + 0.5f); S.k1 = ((unsigned)iB << 16) | (unsigned)(gB * 65535.0f + 0.5f);
    sort128(S.k0, S.k1, lane);
    S.rsx = rstd2 * isx;
#pragma unroll
    for (int j = 0; j < 8; ++j) S.y2[j] = (f32x2){0.f, 0.f};
}
__device__ __forceinline__ void tok_finish2(const TokState2& S, int t, int lane, const bf16* __restrict__ h1b, bf16* __restrict__ h2b, float* __restrict__ rstd3) {
    const u32x4* br = (const u32x4*)(h1b + (size_t)t * 1024 + 16 * lane); const u32x4 b0 = br[0], b1 = br[1];
    f32x4 h2[4]; h2[0] = bf4_lo((u32x2){b0.x, b0.y}); h2[1] = bf4_lo((u32x2){b0.z, b0.w}); h2[2] = bf4_lo((u32x2){b1.x, b1.y}); h2[3] = bf4_lo((u32x2){b1.z, b1.w});
    float sq = 0.f;
#pragma unroll
    for (int j = 0; j < 4; ++j) {
        h2[j] = h2[j] + (f32x4){S.y2[2 * j].x, S.y2[2 * j].y, S.y2[2 * j + 1].x, S.y2[2 * j + 1].y};
        sq += (h2[j][0] * h2[j][0] + h2[j][1] * h2[j][1]) + (h2[j][2] * h2[j][2] + h2[j][3] * h2[j][3]);
    }
    u32x4 w0, w1; w0.x = pk2(h2[0][0], h2[0][1]); w0.y = pk2(h2[0][2], h2[0][3]); w0.z = pk2(h2[1][0], h2[1][1]); w0.w = pk2(h2[1][2], h2[1][3]);
    w1.x = pk2(h2[2][0], h2[2][1]); w1.y = pk2(h2[2][2], h2[2][3]); w1.z = pk2(h2[3][0], h2[3][1]); w1.w = pk2(h2[3][2], h2[3][3]);
    u32x4* ob = (u32x4*)(h2b + (size_t)t * 1024 + 16 * lane); ob[0] = w0; ob[1] = w1;
    sq = wave_sum(sq);
    if (lane == 0) rstd3[t] = 1.0f / sqrtf(sq * (1.0f / 1024.0f) + EPS);
}
template <int PM>
__device__ __forceinline__ void gather_wg_rows(int tok0, int wave, int lane, LAS unsigned char* lds, const unsigned char* __restrict__ U8, const unsigned char* __restrict__ V8, const float* __restrict__ IU, const float* __restrict__ IV,
                                               const int* __restrict__ seli, const float* __restrict__ selg, const float* __restrict__ part2, const bf16* __restrict__ h1b, bf16* __restrict__ h2b, float* __restrict__ rstd3, float* probe_out) {
    LAS unsigned char* xs = lds + wave * 4096;
#pragma unroll 1
    for (int pass = 0; pass < 2; ++pass) {
        const int tb = tok0 + pass * 32 + wave * 4;
        TokState2 S0, S1, S2, S3;
        tok_setup2(S0, tb + 0, fresh_lane(), xs, seli, selg, part2, h1b); __builtin_amdgcn_sched_barrier(0);
        tok_setup2(S1, tb + 1, fresh_lane(), xs + 1024, seli, selg, part2, h1b); __builtin_amdgcn_sched_barrier(0);
        tok_setup2(S2, tb + 2, fresh_lane(), xs + 2048, seli, selg, part2, h1b); __builtin_amdgcn_sched_barrier(0);
        tok_setup2(S3, tb + 3, fresh_lane(), xs + 3072, seli, selg, part2, h1b); __builtin_amdgcn_sched_barrier(0);
        __syncthreads();
        lane = fresh_lane();
#pragma unroll 1
        for (int bi = 0; bi < 8; ++bi) {
            gather_batch16<PM>(S0, bi, lane, xs, U8, V8, IU, IV);
            gather_batch16<PM>(S1, bi, lane, xs + 1024, U8, V8, IU, IV);
            gather_batch16<PM>(S2, bi, lane, xs + 2048, U8, V8, IU, IV);
            gather_batch16<PM>(S3, bi, lane, xs + 3072, U8, V8, IU, IV);
        }
        if (PM != 0) { const int fl = fresh_lane(); f32x2 a = S0.y2[0] + S1.y2[0] + S2.y2[0] + S3.y2[0];
#pragma unroll
            for (int j = 1; j < 8; ++j) a += S0.y2[j] + S1.y2[j] + S2.y2[j] + S3.y2[j];
            probe_out[(size_t)tb * 64 + fl] = a.x + a.y; }
        else { const int fl = fresh_lane(); tok_finish2(S0, tb, fl, h1b, h2b, rstd3); tok_finish2(S1, tb + 1, fl, h1b, h2b, rstd3); tok_finish2(S2, tb + 2, fl, h1b, h2b, rstd3); tok_finish2(S3, tb + 3, fl, h1b, h2b, rstd3); }
        __syncthreads();
    }
}
#if GATHER_ROWS == 2
#define GATHER_BATCH_FN gather_batch_rows
#else
#define GATHER_BATCH_FN gather_batch
#endif
template <int PM>
__device__ __forceinline__ void gather_wg_sliced(int tok0, int wave, int lane, LAS unsigned char* lds, const unsigned char* __restrict__ U8, const unsigned char* __restrict__ V8, const float* __restrict__ IU, const float* __restrict__ IV,
                                                 const int* __restrict__ seli, const float* __restrict__ selg, const float* __restrict__ part2, float* __restrict__ H, const bf16* __restrict__ h1b, bf16* __restrict__ h2b, float* __restrict__ rstd3, float* probe_out) {
    LAS unsigned char* xs = lds + wave * 4096;
#pragma unroll 1
    for (int pass = 0; pass < 2; ++pass) {
        const int tb = tok0 + pass * 32 + wave * 4;
        TokState S0, S1, S2, S3;
        tok_setup(S0, tb + 0, fresh_lane(), xs, seli, selg, part2, h1b); __builtin_amdgcn_sched_barrier(0);
        tok_setup(S1, tb + 1, fresh_lane(), xs + 1024, seli, selg, part2, h1b); __builtin_amdgcn_sched_barrier(0);
        tok_setup(S2, tb + 2, fresh_lane(), xs + 2048, seli, selg, part2, h1b); __builtin_amdgcn_sched_barrier(0);
        tok_setup(S3, tb + 3, fresh_lane(), xs + 3072, seli, selg, part2, h1b); __builtin_amdgcn_sched_barrier(0);
        __syncthreads();
        lane = fresh_lane();
        int lo0 = 0, lo1 = 0, lo2 = 0, lo3 = 0;
#pragma unroll 1
        for (int s = 0; s < NSLICE; ++s) {
            { const int hi = __builtin_amdgcn_readlane(S0.bnd, s + 1); for (int p = lo0; p < hi; p += 16) GATHER_BATCH_FN<PM>(S0, p, hi, lane, xs, U8, V8, IU, IV); lo0 = hi; }
            { const int hi = __builtin_amdgcn_readlane(S1.bnd, s + 1); for (int p = lo1; p < hi; p += 16) GATHER_BATCH_FN<PM>(S1, p, hi, lane, xs + 1024, U8, V8, IU, IV); lo1 = hi; }
            { const int hi = __builtin_amdgcn_readlane(S2.bnd, s + 1); for (int p = lo2; p < hi; p += 16) GATHER_BATCH_FN<PM>(S2, p, hi, lane, xs + 2048, U8, V8, IU, IV); lo2 = hi; }
            { const int hi = __builtin_amdgcn_readlane(S3.bnd, s + 1); for (int p = lo3; p < hi; p += 16) GATHER_BATCH_FN<PM>(S3, p, hi, lane, xs + 3072, U8, V8, IU, IV); lo3 = hi; }
        }
        if (probe_out) { const int fl = fresh_lane(); f32x2 a = S0.y2[0] + S1.y2[0] + S2.y2[0] + S3.y2[0];
#pragma unroll
            for (int j = 1; j < 8; ++j) a += S0.y2[j] + S1.y2[j] + S2.y2[j] + S3.y2[j];
            probe_out[(size_t)tb * 64 + fl] = a.x + a.y; }
        else { const int fl = fresh_lane(); tok_finish(S0, tb, fl, h1b, h2b, rstd3); tok_finish(S1, tb + 1, fl, h1b, h2b, rstd3); tok_finish(S2, tb + 2, fl, h1b, h2b, rstd3); tok_finish(S3, tb + 3, fl, h1b, h2b, rstd3); }
        __syncthreads();
    }
}


template <int J> __device__ __forceinline__ unsigned xor_lane(unsigned v) {
    if (J == 1) return (unsigned)__builtin_amdgcn_update_dpp(0, (int)v, 0xb1, 0xf, 0xf, false);
    if (J == 2) return (unsigned)__builtin_amdgcn_update_dpp(0, (int)v, 0x4e, 0xf, 0xf, false);
    if (J == 4) return (unsigned)dpp_xor4((int)v);
    if (J == 8) return (unsigned)__builtin_amdgcn_update_dpp(0, (int)v, 0x128, 0xf, 0xf, false);
    return (unsigned)__shfl_xor((int)v, J);
}
template <int NR, int KK, int J>
__device__ __forceinline__ void sort_stage(unsigned (&k)[NR], int lane) {
    if (J >= 64) {
        constexpr int d = J >> 6;
#pragma unroll
        for (int r = 0; r < NR; ++r) if ((r & d) == 0) {
            const bool up = (KK == 64 * NR) ? true : (((64 * r) & KK) == 0);
            const unsigned mn = umin_(k[r], k[r + d]), mx = umax_(k[r], k[r + d]);
            k[r] = up ? mn : mx; k[r + d] = up ? mx : mn;
        }
    } else {
        const bool lower = (lane & J) == 0;
        unsigned o[NR];
#pragma unroll
        for (int r = 0; r < NR; ++r) o[r] = xor_lane<(J < 64 ? J : 1)>(k[r]);
#pragma unroll
        for (int r = 0; r < NR; ++r) {
            const bool up = (KK == 64 * NR) ? true : (KK >= 64 ? (((64 * r) & KK) == 0) : ((lane & KK) == 0));
            k[r] = (lower == up) ? umin_(k[r], o[r]) : umax_(k[r], o[r]);
        }
    }
}
template <int NR, int KK, int J> struct SortJ { static __device__ __forceinline__ void run(unsigned (&k)[NR], int lane) { sort_stage<NR, KK, J>(k, lane); SortJ<NR, KK, J / 2>::run(k, lane); } };
template <int NR, int KK> struct SortJ<NR, KK, 0> { static __device__ __forceinline__ void run(unsigned (&)[NR], int) {} };
template <int NR, int KK> struct SortK { static __device__ __forceinline__ void run(unsigned (&k)[NR], int lane) { SortK<NR, KK / 2>::run(k, lane); SortJ<NR, KK, KK / 2>::run(k, lane); } };
template <int NR> struct SortK<NR, 1> { static __device__ __forceinline__ void run(unsigned (&)[NR], int) {} };
template <int NR>
__device__ __forceinline__ void sort_wave(unsigned (&k)[NR], int lane) { SortK<NR, 64 * NR>::run(k, lane); }
__device__ __forceinline__ void axpy_dispatch2(int t, int tbase, float cs, const f32x2 (&x)[8], f32x2 (&Ya)[8], f32x2 (&Yb)[8]) {
    const unsigned long long c = (unsigned long long)__float_as_uint(cs);
    const int tt = t - tbase;
    asm volatile(
        "s_cmp_gt_u32 %[t], 1\n\t"
        "s_cbranch_scc1 3f\n\t"
        "s_cmp_eq_u32 %[t], 1\n\t"
        "s_cbranch_scc1 2f\n\t"
        "v_pk_fma_f32 %[a0], %[c], %[x0], %[a0] op_sel_hi:[0,1,1]\n\t"
        "v_pk_fma_f32 %[a1], %[c], %[x1], %[a1] op_sel_hi:[0,1,1]\n\t"
        "v_pk_fma_f32 %[a2], %[c], %[x2], %[a2] op_sel_hi:[0,1,1]\n\t"
        "v_pk_fma_f32 %[a3], %[c], %[x3], %[a3] op_sel_hi:[0,1,1]\n\t"
        "v_pk_fma_f32 %[a4], %[c], %[x4], %[a4] op_sel_hi:[0,1,1]\n\t"
        "v_pk_fma_f32 %[a5], %[c], %[x5], %[a5] op_sel_hi:[0,1,1]\n\t"
        "v_pk_fma_f32 %[a6], %[c], %[x6], %[a6] op_sel_hi:[0,1,1]\n\t"
        "v_pk_fma_f32 %[a7], %[c], %[x7], %[a7] op_sel_hi:[0,1,1]\n\t"
        "s_branch 3f\n"
        "2:\n\t"
        "v_pk_fma_f32 %[b0], %[c], %[x0], %[b0] op_sel_hi:[0,1,1]\n\t"
        "v_pk_fma_f32 %[b1], %[c], %[x1], %[b1] op_sel_hi:[0,1,1]\n\t"
        "v_pk_fma_f32 %[b2], %[c], %[x2], %[b2] op_sel_hi:[0,1,1]\n\t"
        "v_pk_fma_f32 %[b3], %[c], %[x3], %[b3] op_sel_hi:[0,1,1]\n\t"
        "v_pk_fma_f32 %[b4], %[c], %[x4], %[b4] op_sel_hi:[0,1,1]\n\t"
        "v_pk_fma_f32 %[b5], %[c], %[x5], %[b5] op_sel_hi:[0,1,1]\n\t"
        "v_pk_fma_f32 %[b6], %[c], %[x6], %[b6] op_sel_hi:[0,1,1]\n\t"
        "v_pk_fma_f32 %[b7], %[c], %[x7], %[b7] op_sel_hi:[0,1,1]\n"
        "3:\n\t"
        : [a0] "+v"(Ya[0]), [a1] "+v"(Ya[1]), [a2] "+v"(Ya[2]), [a3] "+v"(Ya[3]), [a4] "+v"(Ya[4]), [a5] "+v"(Ya[5]), [a6] "+v"(Ya[6]), [a7] "+v"(Ya[7]),
          [b0] "+v"(Yb[0]), [b1] "+v"(Yb[1]), [b2] "+v"(Yb[2]), [b3] "+v"(Yb[3]), [b4] "+v"(Yb[4]), [b5] "+v"(Yb[5]), [b6] "+v"(Yb[6]), [b7] "+v"(Yb[7])
        : [x0] "v"(x[0]), [x1] "v"(x[1]), [x2] "v"(x[2]), [x3] "v"(x[3]), [x4] "v"(x[4]), [x5] "v"(x[5]), [x6] "v"(x[6]), [x7] "v"(x[7]), [c] "s"(c), [t] "s"(tt)
        : "scc");
}
__device__ __forceinline__ float tok_setup_mixed(unsigned& k0, unsigned& k1, int t, int j, int lane, LAS unsigned char* xs, const int* __restrict__ seli, const float* __restrict__ selg,
                                                 const float* __restrict__ part2, const bf16* __restrict__ h1b) {
    float ps = (lane < 16) ? part2[(size_t)t * 16 + lane] : 0.f;
    ps = wave_sum(ps);
    const float rstd2 = 1.0f / sqrtf(ps * (1.0f / 1024.0f) + EPS);
    f32x4 hv[4]; float am = 0.f;
    { const u32x4* br = (const u32x4*)(h1b + (size_t)t * 1024 + 16 * lane); const u32x4 b0 = br[0], b1 = br[1];
      hv[0] = bf4_lo((u32x2){b0.x, b0.y}); hv[1] = bf4_lo((u32x2){b0.z, b0.w}); hv[2] = bf4_lo((u32x2){b1.x, b1.y}); hv[3] = bf4_lo((u32x2){b1.z, b1.w}); }
#pragma unroll
    for (int i = 0; i < 4; ++i) { am = fmaxf(am, fmaxf(fmaxf(fabsf(hv[i][0]), fabsf(hv[i][1])), fmaxf(fabsf(hv[i][2]), fabsf(hv[i][3])))); }
#pragma unroll
    for (int o = 1; o < 64; o <<= 1) am = fmaxf(am, __shfl_xor(am, o));
    const float sx = am > 0.f ? 127.0f / am : 1.0f, isx = am > 0.f ? am * (1.0f / 127.0f) : 1.0f;
    u32x4 xq;
#pragma unroll
    for (int i = 0; i < 4; ++i) { unsigned w = 0u;
#pragma unroll
        for (int c = 0; c < 4; ++c) w |= ((unsigned)(int)__builtin_rintf(hv[i][c] * sx) & 0xffu) << (8 * c);
        xq[i] = w; }
    *(LAS u32x4*)(xs + 16 * lane) = xq;
    const int iA = seli[(size_t)t * 128 + lane], iB = seli[(size_t)t * 128 + 64 + lane];
    const float gA = selg[(size_t)t * 128 + lane], gB = selg[(size_t)t * 128 + 64 + lane];
    k0 = ((unsigned)iA << 18) | ((unsigned)j << 16) | (unsigned)(gA * 65535.0f + 0.5f); k1 = ((unsigned)iB << 18) | ((unsigned)j << 16) | (unsigned)(gB * 65535.0f + 0.5f);
    return rstd2 * isx;
}
__device__ __forceinline__ void tok_finish_mixed(const f32x2 (&y2)[8], int t, int lane, const bf16* __restrict__ h1b, bf16* __restrict__ h2b, float* __restrict__ rstd3) {
    const u32x4* br = (const u32x4*)(h1b + (size_t)t * 1024 + 16 * lane); const u32x4 b0 = br[0], b1 = br[1];
    f32x4 h2[4]; h2[0] = bf4_lo((u32x2){b0.x, b0.y}); h2[1] = bf4_lo((u32x2){b0.z, b0.w}); h2[2] = bf4_lo((u32x2){b1.x, b1.y}); h2[3] = bf4_lo((u32x2){b1.z, b1.w});
    float sq = 0.f;
#pragma unroll
    for (int i = 0; i < 4; ++i) {
        h2[i] = h2[i] + (f32x4){y2[2 * i].x, y2[2 * i].y, y2[2 * i + 1].x, y2[2 * i + 1].y};
        sq += (h2[i][0] * h2[i][0] + h2[i][1] * h2[i][1]) + (h2[i][2] * h2[i][2] + h2[i][3] * h2[i][3]);
    }
    u32x4 w0, w1; w0.x = pk2(h2[0][0], h2[0][1]); w0.y = pk2(h2[0][2], h2[0][3]); w0.z = pk2(h2[1][0], h2[1][1]); w0.w = pk2(h2[1][2], h2[1][3]);
    w1.x = pk2(h2[2][0], h2[2][1]); w1.y = pk2(h2[2][2], h2[2][3]); w1.z = pk2(h2[3][0], h2[3][1]); w1.w = pk2(h2[3][2], h2[3][3]);
    u32x4* ob = (u32x4*)(h2b + (size_t)t * 1024 + 16 * lane); ob[0] = w0; ob[1] = w1;
    sq = wave_sum(sq);
    if (lane == 0) rstd3[t] = 1.0f / sqrtf(sq * (1.0f / 1024.0f) + EPS);
}
constexpr int MIX_LDS_WAVE = 4096 + 2048 + 64;
template <int PM>
__device__ __forceinline__ void gather_wg_mixed(int tok0, int wave, int lane, LAS unsigned char* lds, const unsigned char* __restrict__ U8, const unsigned char* __restrict__ V8, const float* __restrict__ IU, const float* __restrict__ IV,
                                                const int* __restrict__ seli, const float* __restrict__ selg, const float* __restrict__ part2, const bf16* __restrict__ h1b, bf16* __restrict__ h2b, float* __restrict__ rstd3, float* probe_out) {
    LAS unsigned char* xs = lds + wave * MIX_LDS_WAVE;
    LAS unsigned* ks = (LAS unsigned*)(xs + 4096);
    LAS float* rsl = (LAS float*)(xs + 4096 + 2048);
#pragma unroll 1
    for (int pass = 0; pass < 2; ++pass) {
        const int tb = tok0 + pass * 32 + wave * 4;
        unsigned k[8]; float rs0, rs1, rs2, rs3;
        rs0 = tok_setup_mixed(k[0], k[1], tb + 0, 0, fresh_lane(), xs, seli, selg, part2, h1b); __builtin_amdgcn_sched_barrier(0);
        rs1 = tok_setup_mixed(k[2], k[3], tb + 1, 1, fresh_lane(), xs + 1024, seli, selg, part2, h1b); __builtin_amdgcn_sched_barrier(0);
        rs2 = tok_setup_mixed(k[4], k[5], tb + 2, 2, fresh_lane(), xs + 2048, seli, selg, part2, h1b); __builtin_amdgcn_sched_barrier(0);
        rs3 = tok_setup_mixed(k[6], k[7], tb + 3, 3, fresh_lane(), xs + 3072, seli, selg, part2, h1b); __builtin_amdgcn_sched_barrier(0);
        lane = fresh_lane();
        sort_wave<8>(k, lane);
#pragma unroll
        for (int r = 0; r < 8; ++r) ks[lane + 64 * r] = k[r];
        if (lane == 0) { rsl[0] = rs0; rsl[1] = rs1; rsl[2] = rs2; rsl[3] = rs3; }
        __builtin_amdgcn_sched_barrier(0);
        f32x2 Y0[8], Y1[8], Y2[8], Y3[8];
#pragma unroll
        for (int i = 0; i < 8; ++i) { Y0[i] = (f32x2){0.f, 0.f}; Y1[i] = (f32x2){0.f, 0.f}; Y2[i] = (f32x2){0.f, 0.f}; Y3[i] = (f32x2){0.f, 0.f}; }
        __syncthreads();
        lane = fresh_lane();
#pragma unroll 1
        for (int b = 0; b < 32; ++b) {
            const unsigned kb = ks[16 * b + (lane & 15)];
            const unsigned key = ks[16 * b + (lane >> 2)];
            const int es = (int)(key >> 18); const int tq = (int)(key >> 16) & 3;
            const float rsx = rsl[tq];
            const float dus = IU[es] * rsx, gvs = (float)(key & 0xffffu) * (1.0f / 65535.0f) * IV[es];
            i32x4v A[16]; u32x4 vv[16];
#pragma unroll
            for (int q = 0; q < 16; ++q) { int e = (int)((unsigned)__builtin_amdgcn_readlane((int)kb, q) >> 18); if (PM & 32) e &= 1023; A[q] = *(const i32x4v*)(U8 + (size_t)e * 1024 + 16 * lane); }
#pragma unroll
            for (int q = 0; q < 16; ++q) { int e = (int)((unsigned)__builtin_amdgcn_readlane((int)kb, q) >> 18); if (PM & 32) e &= 1023; vv[q] = *(const u32x4*)(V8 + (size_t)e * 1024 + 16 * lane); }
            int pp[16];
#pragma unroll
            for (int q = 0; q < 16; ++q) {
                const int t = (__builtin_amdgcn_readlane((int)kb, q) >> 16) & 3;
                const i32x4v X = *(const LAS i32x4v*)(xs + t * 1024 + 16 * lane);
                pp[q] = __builtin_amdgcn_sdot4(A[q][3], X[3], __builtin_amdgcn_sdot4(A[q][2], X[2], __builtin_amdgcn_sdot4(A[q][1], X[1], __builtin_amdgcn_sdot4(A[q][0], X[0], 0, false), false), false), false);
            }
            const int tot = reduce16_rows(pp, lane);
            const float cf = gvs * gelu_tanh((float)tot * dus);
#pragma unroll
            for (int q = 0; q < 16; ++q) {
                const int t = (__builtin_amdgcn_readlane((int)kb, q) >> 16) & 3;
                const float cs = __int_as_float(__builtin_amdgcn_readlane(__float_as_int(cf), 4 * q));
                f32x2 x[8];
#pragma unroll
                for (int c = 0; c < 4; ++c) { x[2 * c] = __builtin_amdgcn_cvt_pk_f32_fp8(vv[q][c], false); x[2 * c + 1] = __builtin_amdgcn_cvt_pk_f32_fp8(vv[q][c], true); }
                axpy_dispatch2(t, 0, cs, x, Y0, Y1);
                axpy_dispatch2(t, 2, cs, x, Y2, Y3);
            }
            __builtin_amdgcn_sched_barrier(0);
        }
        if (PM != 0) { const int fl = fresh_lane(); f32x2 a = Y0[0] + Y1[0] + Y2[0] + Y3[0];
#pragma unroll
            for (int i = 1; i < 8; ++i) a += Y0[i] + Y1[i] + Y2[i] + Y3[i];
            probe_out[(size_t)tb * 64 + fl] = a.x + a.y; }
        else { const int fl = fresh_lane(); tok_finish_mixed(Y0, tb, fl, h1b, h2b, rstd3); tok_finish_mixed(Y1, tb + 1, fl, h1b, h2b, rstd3); tok_finish_mixed(Y2, tb + 2, fl, h1b, h2b, rstd3); tok_finish_mixed(Y3, tb + 3, fl, h1b, h2b, rstd3); }
        __syncthreads();
    }
}
namespace pg8 {
#define PG8_LAS __attribute__((address_space(3)))
typedef unsigned short bf16_t;
typedef short bf16x8 __attribute__((ext_vector_type(8)));
typedef float f32x4 __attribute__((ext_vector_type(4)));
typedef unsigned u32x4 __attribute__((ext_vector_type(4)));
constexpr int BM = 256, BK = 64, HALF = 128, HTB = HALF * BK * 2  , STAGE_BYTES = 8 * HTB, NXCD = 8, WGM = 8;

__host__ __device__ __forceinline__ int lds_byte(int r, int c) { const int st = (r >> 4) * 2 + (c >> 5), rr = r & 15, cc = c & 31, ob = rr * 64 + cc * 2; return st * 1024 + (ob ^ (((ob >> 9) & 1) << 5)); }
__host__ __device__ __forceinline__ void stage_rc(int b, int& R, int& C) { const int st = b / 1024, sb = b % 1024, swz = sb ^ (((sb >> 9) & 1) << 5); R = (st >> 1) * 16 + swz / 64; C = (st & 1) * 32 + (swz % 64) / 2; }
__host__ __device__ __forceinline__ int perm32(int rho) { const int n = rho >> 4, i = rho & 15; return 8 * (i >> 2) + 4 * n + (i & 3); }

struct Unit { int pm, pn; };
struct Gemm { const bf16_t* A; const bf16_t* Bt; int K, lda, apn_shift, apn_stride; };

struct StaticOrder {
    int nM, nN, nwg, G, c;
    __host__ __device__ __forceinline__ void init(int M, int N, int G_, int c_) { nM = M / BM; nN = N / BM; nwg = nM * nN; G = G_; c = c_; }
    __host__ __device__ __forceinline__ bool next(int i, Unit& u) const {
        const long L = (long)i * G + c; if (L >= nwg) return false;
        int wgid = (int)L; { const int q = nwg / NXCD, r = nwg % NXCD, xcd = wgid % NXCD, off = wgid / NXCD; wgid = (xcd < r ? xcd * (q + 1) : r * (q + 1) + (xcd - r) * q) + off; }
        const int nig = WGM * nN, gid = wgid / nig, fm = gid * WGM, gsz = (nM - fm) < WGM ? (nM - fm) : WGM;
        u.pm = fm + ((wgid % nig) % gsz); u.pn = (wgid % nig) / gsz; return true;
    }
    __device__ __forceinline__ void a_ready(const Unit&) const {}
    __device__ __forceinline__ void done(const Unit&) const {}
};

__device__ __forceinline__ unsigned cvt_pk_bf16(float lo, float hi) { unsigned r; asm volatile("v_cvt_pk_bf16_f32 %0, %1, %2" : "=v"(r) : "v"(lo), "v"(hi)); return r; }

template <class Epi, class Sched, bool ALIGN_EPI = false, bool SP2 = false>
__device__ __forceinline__ void gemm_phase(PG8_LAS unsigned char* lds, const Gemm g, const Sched& S, const Epi& E, int wave_id  ) {
    const int lane = fresh_lane(), wid = wave_id, tid = wid * 64 + lane, wr = wid >> 2, wc = wid & 3, fr = lane & 15, fq = lane >> 4;
    const int K = g.K, nt = K / BK;
    unsigned voffA[2], voffB[2];
#pragma unroll
    for (int i = 0; i < 2; ++i) { int R, C; stage_rc(tid * 16 + i * 8192, R, C); const int Rb = Epi::PERM ? ((R & ~31) + perm32(R & 31)) : R;
        voffA[i] = (unsigned)(R * g.lda + C) * 2u; voffB[i] = (unsigned)(Rb * K + C) * 2u; }
    const size_t kstep = (size_t)(BK * 2);
    const size_t hstepA = (size_t)HALF * g.lda * 2, hstepB = (size_t)HALF * K * 2;
    const size_t tstepA = 2 * hstepA, tstepB = 2 * hstepB;
    const unsigned ldsw = (unsigned)wid * 1024u;
    const int aoff = lds_byte(wr * 64 + fr, fq * 8), boff = lds_byte(wc * 32 + fr, fq * 8);
#define PG8_SA(b, h) (((b) * 2 + (h)) * HTB)
#define PG8_SB(b, h) ((4 + (b) * 2 + (h)) * HTB)
#define PG8_STAGE(bufoff, gbase, voff) do { _Pragma("unroll") for (int _i = 0; _i < 2; ++_i) \
        __builtin_amdgcn_global_load_lds((const unsigned*)((const char*)(gbase) + (voff)[_i]), (PG8_LAS unsigned*)(lds + (bufoff) + ldsw + _i * 8192), 16, 0, 0); } while (0)
#define PG8_LDA(dst, b, h) do { _Pragma("unroll") for (int m = 0; m < 4; ++m) _Pragma("unroll") for (int k = 0; k < 2; ++k) dst[m][k] = *(const PG8_LAS bf16x8*)(lds + PG8_SA(b, h) + aoff + m * 2048 + k * 1024); } while (0)
#define PG8_LDB(dst, b, h) do { _Pragma("unroll") for (int n = 0; n < 2; ++n) _Pragma("unroll") for (int k = 0; k < 2; ++k) dst[n][k] = *(const PG8_LAS bf16x8*)(lds + PG8_SB(b, h) + boff + n * 2048 + k * 1024); } while (0)
#define PG8_MMA(ai, bj, At, Bt) do { __builtin_amdgcn_s_setprio(1); _Pragma("unroll") for (int m = 0; m < 4; ++m) _Pragma("unroll") for (int n = 0; n < 2; ++n) _Pragma("unroll") for (int k = 0; k < 2; ++k) \
        acc[ai][bj][m][n] = __builtin_amdgcn_mfma_f32_16x16x32_bf16(Bt[n][k], At[m][k], acc[ai][bj][m][n], 0, 0, 0); __builtin_amdgcn_s_setprio(0); } while (0)
#define PG8_WAIT_V(n) asm volatile("s_waitcnt vmcnt(" #n ")" ::: "memory")
#define PG8_WAIT_L(n) asm volatile("s_waitcnt lgkmcnt(" #n ")" ::: "memory")
#define PG8_BAR __builtin_amdgcn_s_barrier()
#define PG8_SCHED __builtin_amdgcn_sched_barrier(0)
    Unit cur, nxt; int ui = 0;
    if (!S.next(0, cur)) return;
    f32x4 acc[2][2][4][2];
#pragma unroll
    for (int a = 0; a < 2; ++a)
#pragma unroll
        for (int b = 0; b < 2; ++b)
#pragma unroll
            for (int m = 0; m < 4; ++m)
#pragma unroll
                for (int n = 0; n < 2; ++n) acc[a][b][m][n] = (f32x4){0.f, 0.f, 0.f, 0.f};
    bf16x8 At[4][2], B0[2][2], B1[2][2];
    const char* cA = (const char*)g.A + (size_t)cur.pm * tstepA + (size_t)((cur.pn >> g.apn_shift) * g.apn_stride) * 2; const char* cB = (const char*)g.Bt + (size_t)cur.pn * tstepB;
    S.a_ready(cur);
    if constexpr (SP2) {
        PG8_STAGE(PG8_SB(0, 0), cB, voffB); PG8_STAGE(PG8_SB(0, 1), cB + hstepB, voffB); PG8_STAGE(PG8_SA(0, 0), cA, voffA); PG8_STAGE(PG8_SA(0, 1), cA + hstepA, voffA);
        if (wr == 1) PG8_BAR;
        PG8_WAIT_V(2); PG8_BAR;
        PG8_STAGE(PG8_SB(1, 0), cB + kstep, voffB); PG8_STAGE(PG8_SA(1, 0), cA + kstep, voffA); PG8_STAGE(PG8_SB(1, 1), cB + hstepB + kstep, voffB);
        PG8_WAIT_V(6); PG8_BAR;
    } else {
        PG8_STAGE(PG8_SB(0, 0), cB, voffB); PG8_STAGE(PG8_SA(0, 0), cA, voffA); PG8_STAGE(PG8_SB(0, 1), cB + hstepB, voffB); PG8_STAGE(PG8_SA(0, 1), cA + hstepA, voffA);
        if (wr == 1) PG8_BAR;
        PG8_WAIT_V(4); PG8_BAR;
        PG8_STAGE(PG8_SB(1, 0), cB + kstep, voffB); PG8_STAGE(PG8_SA(1, 0), cA + kstep, voffA); PG8_STAGE(PG8_SB(1, 1), cB + hstepB + kstep, voffB);
        PG8_WAIT_V(6); PG8_BAR;
    }
    for (;;) {
        const bool has_next = S.next(ui + 1, nxt);
        const char* nA = has_next ? (const char*)g.A + (size_t)nxt.pm * tstepA + (size_t)((nxt.pn >> g.apn_shift) * g.apn_stride) * 2 : cA; const char* nB = has_next ? (const char*)g.Bt + (size_t)nxt.pn * tstepB : cB;
#pragma unroll 1
        for (int t = 0; t < nt; t += 2) {
            const bool last = (t == nt - 2);
            const char* a1 = cA + (size_t)(t + 1) * kstep;
            const char* a2 = last ? nA : cA + (size_t)(t + 2) * kstep; const char* b2 = last ? nB : cB + (size_t)(t + 2) * kstep;
            const char* a3 = a2 + kstep; const char* b3 = b2 + kstep;
            if (last && has_next) S.a_ready(nxt);
            if constexpr (SP2) {
            PG8_LDB(B0, 0, 0); PG8_LDB(B1, 0, 1); PG8_SCHED; PG8_LDA(At, 0, 0); PG8_STAGE(PG8_SA(1, 1), a1 + hstepA, voffA);
            PG8_WAIT_V(8); PG8_WAIT_L(0); PG8_BAR; PG8_MMA(0, 0, At, B0); PG8_MMA(0, 1, At, B1); PG8_BAR; PG8_SCHED;
            PG8_LDA(At, 0, 1); PG8_STAGE(PG8_SB(0, 0), b2, voffB); PG8_STAGE(PG8_SB(0, 1), b2 + hstepB, voffB); PG8_STAGE(PG8_SA(0, 0), a2, voffA);
            PG8_WAIT_V(8); PG8_WAIT_L(0); PG8_BAR; PG8_MMA(1, 0, At, B0); PG8_MMA(1, 1, At, B1); PG8_BAR; PG8_SCHED;
            PG8_LDB(B0, 1, 0); PG8_LDB(B1, 1, 1); PG8_SCHED; PG8_LDA(At, 1, 0); PG8_STAGE(PG8_SA(0, 1), a2 + hstepA, voffA);
            PG8_WAIT_V(8); PG8_WAIT_L(0); PG8_BAR; PG8_MMA(0, 0, At, B0); PG8_MMA(0, 1, At, B1); PG8_BAR; PG8_SCHED;
            PG8_LDA(At, 1, 1); PG8_STAGE(PG8_SB(1, 0), b3, voffB); PG8_STAGE(PG8_SB(1, 1), b3 + hstepB, voffB); PG8_STAGE(PG8_SA(1, 0), a3, voffA);
            PG8_WAIT_V(8); PG8_WAIT_L(0); PG8_BAR; PG8_MMA(1, 0, At, B0); PG8_MMA(1, 1, At, B1); PG8_BAR; PG8_SCHED;
            } else {
            PG8_LDB(B0, 0, 0); PG8_SCHED; PG8_LDA(At, 0, 0); PG8_STAGE(PG8_SA(1, 1), a1 + hstepA, voffA);
            PG8_WAIT_L(8); PG8_BAR; PG8_WAIT_L(0); PG8_MMA(0, 0, At, B0); PG8_BAR; PG8_SCHED;
            PG8_LDB(B1, 0, 1); PG8_STAGE(PG8_SB(0, 0), b2, voffB);
            PG8_BAR; PG8_WAIT_L(0); PG8_MMA(0, 1, At, B1); PG8_BAR;
            PG8_LDA(At, 0, 1); PG8_STAGE(PG8_SA(0, 0), a2, voffA);
            PG8_BAR; PG8_WAIT_L(0); PG8_MMA(1, 0, At, B0); PG8_BAR; PG8_SCHED;
            PG8_STAGE(PG8_SB(0, 1), b2 + hstepB, voffB);
            PG8_WAIT_V(6); PG8_BAR; PG8_MMA(1, 1, At, B1); PG8_BAR;
            PG8_LDB(B0, 1, 0); PG8_SCHED; PG8_LDA(At, 1, 0); PG8_STAGE(PG8_SA(0, 1), a2 + hstepA, voffA);
            PG8_WAIT_L(8); PG8_BAR; PG8_WAIT_L(0); PG8_MMA(0, 0, At, B0); PG8_BAR; PG8_SCHED;
            PG8_LDB(B1, 1, 1); PG8_STAGE(PG8_SB(1, 0), b3, voffB);
            PG8_BAR; PG8_WAIT_L(0); PG8_MMA(0, 1, At, B1); PG8_BAR;
            PG8_LDA(At, 1, 1); PG8_STAGE(PG8_SA(1, 0), a3, voffA);
            PG8_BAR; PG8_WAIT_L(0); PG8_MMA(1, 0, At, B0); PG8_BAR; PG8_SCHED;
            PG8_STAGE(PG8_SB(1, 1), b3 + hstepB, voffB);
            PG8_WAIT_V(6); PG8_BAR; PG8_MMA(1, 1, At, B1); PG8_BAR;
            }
        }
        if constexpr (ALIGN_EPI) { if (wr == 0) PG8_BAR; }
        if constexpr (!Epi::AFTER_DRAIN) { E(acc, cur, wr, wc, fr, fq); S.done(cur); }
        if (!has_next) break;
#pragma unroll
        for (int a = 0; a < 2; ++a)
#pragma unroll
            for (int b = 0; b < 2; ++b)
#pragma unroll
                for (int m = 0; m < 4; ++m)
#pragma unroll
                    for (int n = 0; n < 2; ++n) acc[a][b][m][n] = (f32x4){0.f, 0.f, 0.f, 0.f};
        cur = nxt; cA = nA; cB = nB; ++ui;
        if constexpr (ALIGN_EPI) { if (wr == 1) PG8_BAR; }
    }
    PG8_WAIT_V(0);
    if constexpr (!ALIGN_EPI) { if (wr == 0) PG8_BAR; }
    PG8_BAR;
    if constexpr (Epi::AFTER_DRAIN) { E.fused(acc, cur, wr, wc, fr, fq, lds, wid, lane); S.done(cur); }
#undef PG8_SA
#undef PG8_SB
#undef PG8_STAGE
#undef PG8_LDA
#undef PG8_LDB
#undef PG8_MMA
#undef PG8_WAIT_V
#undef PG8_WAIT_L
#undef PG8_BAR
#undef PG8_SCHED
}
}
#define GAS __attribute__((address_space(1)))
typedef GAS unsigned gu32;
#define RLX_AGENT __ATOMIC_RELAXED, __HIP_MEMORY_SCOPE_AGENT
#define LDS_WAIT() asm volatile("s_waitcnt lgkmcnt(0)" ::: "memory")
#define VM_WAIT() asm volatile("s_waitcnt vmcnt(0)" ::: "memory")
#define XB_TMO      128
#define XB_XCNT(j)  (256  + 64 * (j))
#define XB_XSUB(j)  (1280 + 64 * (j))
#define XB_XGEN(j)  (2304 + 64 * (j))
#define XB_TOP      3328
#define XB_TOPGEN   3392
#define XCD_BAR_WORDS 3456
#define XB_SPIN_CAP (1u << 18)

__device__ __forceinline__ unsigned xb_ld(unsigned* p)              { return __hip_atomic_load(p, __ATOMIC_RELAXED, __HIP_MEMORY_SCOPE_AGENT); }
__device__ __forceinline__ unsigned xb_add(unsigned* p, unsigned v) { return __hip_atomic_fetch_add(p, v, __ATOMIC_RELAXED, __HIP_MEMORY_SCOPE_AGENT); }
__device__ __forceinline__ unsigned xb_xcc_id() { return (unsigned)__builtin_amdgcn_s_getreg((3 << 11) | 20) & 0xFu; }
#define XB_SPIN(cond, bar) do { unsigned _sp = 0; while (cond) { __builtin_amdgcn_s_sleep(1); \
    if ((++_sp & 255u) == 0u) { if (xb_ld(&(bar)[XB_TMO])) break; if (_sp > XB_SPIN_CAP) { atomicAdd(&(bar)[XB_TMO], 1u); break; } } } } while (0)

struct XcdBarrier {
    unsigned* bar; unsigned x;
    volatile LAS unsigned* st;
};

__device__ __forceinline__ XcdBarrier xcd_barrier_post(unsigned* bar, volatile LAS unsigned* st) {
    XcdBarrier b; b.bar = bar; b.x = xb_xcc_id(); b.st = st;
    if (threadIdx.x == 0) (void)xb_add(&bar[XB_XCNT(b.x)], 1u);
    return b;
}
__device__ __forceinline__ void xcd_barrier_complete(unsigned* bar, unsigned x, unsigned& nloc, unsigned& nx) {
    const unsigned G = gridDim.x * gridDim.y * gridDim.z;
    unsigned sum, cnt, mine, sp = 0u;
    for (;;) {
        sum = 0u; cnt = 0u; mine = 0u;
#pragma unroll
        for (unsigned j = 0; j < 16; ++j) { const unsigned c = xb_ld(&bar[XB_XCNT(j)]); sum += c; cnt += (c > 0u) ? 1u : 0u; mine = (j == x) ? c : mine; }
        if (sum == G) break;
        __builtin_amdgcn_s_sleep(1);
        if ((++sp & 255u) == 0u) { if (xb_ld(&bar[XB_TMO])) break; if (sp > XB_SPIN_CAP) { atomicAdd(&bar[XB_TMO], 1u); break; } }
    }
    nloc = mine > 0u ? mine : 1u; nx = cnt > 0u ? cnt : 1u;
}

__device__ __forceinline__ void xcd_barrier(const XcdBarrier& b) {
    asm volatile("s_waitcnt vmcnt(0)" ::: "memory");
    __syncthreads();
    if (threadIdx.x == 0) {
        unsigned* bar = b.bar;
        __builtin_amdgcn_s_waitcnt(0);
        unsigned nloc = b.st[0], nx = b.st[1];
        if (nloc == 0u) { xcd_barrier_complete(bar, b.x, nloc, nx); b.st[0] = nloc; b.st[1] = nx; }
        const unsigned old = xb_add(&bar[XB_XSUB(b.x)], 1u);
        const unsigned gen = old / nloc;
        if (old + 1u == (gen + 1u) * nloc) {
            __builtin_amdgcn_fence(__ATOMIC_RELEASE, "agent");
            asm volatile("s_waitcnt vmcnt(0)" ::: "memory");
            const unsigned og = xb_add(&bar[XB_TOP], 1u);
            const unsigned tg = og / nx;
            if (og + 1u == (tg + 1u) * nx) xb_add(&bar[XB_TOPGEN], 1u);
            else XB_SPIN(xb_ld(&bar[XB_TOPGEN]) == tg, bar);
            __builtin_amdgcn_fence(__ATOMIC_ACQUIRE, "agent");
            xb_add(&bar[XB_XGEN(b.x)], 1u);
            asm volatile("s_waitcnt vmcnt(0)" ::: "memory");
        } else {
            XB_SPIN(xb_ld(&bar[XB_XGEN(b.x)]) == gen, bar);
            __builtin_amdgcn_fence(__ATOMIC_ACQUIRE, "agent");
            asm volatile("s_waitcnt vmcnt(0)" ::: "memory");
        }
    }
    __syncthreads();
}

constexpr int NWAVES = 8;
constexpr int LDS_MAIN = 135168;
constexpr int LDSCTL_OFF = LDS_MAIN;
constexpr int LDS_BYTES = 147456;
constexpr int CW_BAR = 4096;
constexpr size_t CTL_ZERO_BYTES = 1 * MiB;
constexpr float LOG2E = 1.4426950408889634f;
typedef short bf16x8 __attribute__((ext_vector_type(8)));
typedef float f32x16 __attribute__((ext_vector_type(16)));
typedef unsigned u32x2 __attribute__((ext_vector_type(2)));
using pg8::Unit;
using pg8::cvt_pk_bf16;

__device__ __forceinline__ f32x4 sig4(f32x4 v) { return (f32x4){sigmoidf_(v[0]), sigmoidf_(v[1]), sigmoidf_(v[2]), sigmoidf_(v[3])}; }
__device__ __forceinline__ f32x4 gelu4(f32x4 v) { return (f32x4){gelu_tanh(v[0]), gelu_tanh(v[1]), gelu_tanh(v[2]), gelu_tanh(v[3])}; }
__device__ __forceinline__ u32x4 pack8(f32x4 a, f32x4 b) { u32x4 w; w.x = cvt_pk_bf16(a[0], a[1]); w.y = cvt_pk_bf16(a[2], a[3]); w.z = cvt_pk_bf16(b[0], b[1]); w.w = cvt_pk_bf16(b[2], b[3]); return w; }

struct OneUnit { pg8::StaticOrder S; int k;
    __device__ __forceinline__ bool next(int i, Unit& u) const { return i == 0 && S.next(k, u); }
    __device__ __forceinline__ void a_ready(const Unit&) const {}
    __device__ __forceinline__ void done(const Unit&) const {} };
struct EpiProj {
    static constexpr bool PERM = true, AFTER_DRAIN = false;
    const float* rstd; unsigned char* ws;
    __device__ __forceinline__ void operator()(const f32x4 (&acc)[2][2][4][2], const Unit& u, int wr, int wc, int fr, int fq) const {
        { const int t_ = fresh_lane(); fr = t_ & 15; fq = t_ >> 4; }
        const int pn = u.pn; bf16* base; int ldc, coff, act;
        if (pn < 3) { base = (bf16*)(ws + WS_QKV); ldc = 768; coff = pn * 256; act = 0; }
        else if (pn < 7) { base = (bf16*)(ws + WS_LX); ldc = 1024; coff = (pn - 3) * 256; act = 0; }
        else if (pn < 11) { base = (bf16*)(ws + WS_GL); ldc = 1024; coff = (pn - 7) * 256; act = 1; }
        else if (pn < 15) { base = (bf16*)(ws + WS_SGA); ldc = 1024; coff = (pn - 11) * 256; act = 2; }
        else { base = (bf16*)(ws + WS_SGL); ldc = 1024; coff = (pn - 15) * 256; act = 2; }
        const int row0 = u.pm * 256 + wr * 64 + fr, col0 = coff + wc * 32 + 8 * fq;
#pragma unroll
        for (int ai = 0; ai < 2; ++ai)
#pragma unroll
            for (int m = 0; m < 4; ++m) {
                const int r = row0 + ai * 128 + m * 16; const float rs = rstd[r]; bf16* rowp = base + (size_t)r * ldc + col0;
#pragma unroll
                for (int bj = 0; bj < 2; ++bj) {
                    f32x4 v0 = acc[ai][bj][m][0] * rs, v1 = acc[ai][bj][m][1] * rs;
                    if (act == 1) { v0 = gelu4(v0); v1 = gelu4(v1); } else if (act == 2) { v0 = sig4(v0); v1 = sig4(v1); }
                    *(u32x4*)(rowp + bj * 128) = pack8(v0, v1);
                }
            }
    }
};
struct EpiMP {
    static constexpr bool PERM = false, AFTER_DRAIN = false;
    const bf16* sga; float* mp;
    __device__ __forceinline__ void operator()(const f32x4 (&acc)[2][2][4][2], const Unit& u, int wr, int wc, int fr, int fq) const {
        { const int t_ = fresh_lane(); fr = t_ & 15; fq = t_ >> 4; }
        const int row0 = u.pm * 256 + wr * 64 + fr, col0 = u.pn * 256 + wc * 32 + 4 * fq;
#pragma unroll
        for (int ai = 0; ai < 2; ++ai)
#pragma unroll
            for (int m = 0; m < 4; ++m) {
                const size_t off = (size_t)(row0 + ai * 128 + m * 16) * 1024 + col0;
#pragma unroll
                for (int bj = 0; bj < 2; ++bj)
#pragma unroll
                    for (int n = 0; n < 2; ++n) { const size_t o = off + bj * 128 + n * 16; const f32x4 g = bf4_lo(*(const u32x2*)(sga + o)); const f32x4 v = acc[ai][bj][m][n] * g;
#if ALL_FUSED
                        u32x2 w; w.x = cvt_pk_bf16(v[0], v[1]); w.y = cvt_pk_bf16(v[2], v[3]); *(u32x2*)((bf16*)mp + o) = w;
#else
                        *(f32x4*)(mp + o) = v;
#endif
                    }
            }
    }
};
struct EpiMerged {
    static constexpr bool PERM = true, AFTER_DRAIN = false;
    const bf16* sgl; const float* mp; bf16* merged;
    __device__ __forceinline__ void operator()(const f32x4 (&acc)[2][2][4][2], const Unit& u, int wr, int wc, int fr, int fq) const {
        { const int t_ = fresh_lane(); fr = t_ & 15; fq = t_ >> 4; }
        const int row0 = u.pm * 256 + wr * 64 + fr, col0 = u.pn * 256 + wc * 32 + 8 * fq;
#pragma unroll
        for (int ai = 0; ai < 2; ++ai)
#pragma unroll
            for (int m = 0; m < 4; ++m) {
                const size_t off = (size_t)(row0 + ai * 128 + m * 16) * 1024 + col0;
#pragma unroll
                for (int bj = 0; bj < 2; ++bj) {
                    const size_t o = off + bj * 128; const u32x4 gw = *(const u32x4*)(sgl + o);
#if ALL_FUSED
                    const u32x4 mw = *(const u32x4*)((const bf16*)mp + o); const f32x4 m0 = bf4_lo((u32x2){mw.x, mw.y}), m1 = bf4_lo((u32x2){mw.z, mw.w});
#else
                    const f32x4 m0 = *(const f32x4*)(mp + o), m1 = *(const f32x4*)(mp + o + 4);
#endif
                    const f32x4 v0 = m0 + acc[ai][bj][m][0] * bf4_lo((u32x2){gw.x, gw.y}), v1 = m1 + acc[ai][bj][m][1] * bf4_lo((u32x2){gw.z, gw.w});
                    *(u32x4*)(merged + o) = pack8(v0, v1);
                }
            }
    }
};
struct EpiH1 {
    static constexpr bool PERM = true, AFTER_DRAIN = false;
    const float* x; float* h1; bf16* h1b; float* part;
    __device__ __forceinline__ void operator()(const f32x4 (&acc)[2][2][4][2], const Unit& u, int wr, int wc, int fr, int fq) const {
        { const int t_ = fresh_lane(); fr = t_ & 15; fq = t_ >> 4; }
        const int row0 = u.pm * 256 + wr * 64 + fr, col0 = u.pn * 256 + wc * 32 + 8 * fq;
#pragma unroll
        for (int ai = 0; ai < 2; ++ai)
#pragma unroll
            for (int m = 0; m < 4; ++m) {
                const int r = row0 + ai * 128 + m * 16; const size_t off = (size_t)r * 1024 + col0; float sq = 0.f;
#pragma unroll
                for (int bj = 0; bj < 2; ++bj) {
                    const size_t o = off + bj * 128;
                    const f32x4 v0 = *(const f32x4*)(x + o) + acc[ai][bj][m][0], v1 = *(const f32x4*)(x + o + 4) + acc[ai][bj][m][1];
#if !ALL_FUSED
                    *(f32x4*)(h1 + o) = v0; *(f32x4*)(h1 + o + 4) = v1;
#endif
                    *(u32x4*)(h1b + o) = pack8(v0, v1);
                    sq += (v0[0] * v0[0] + v0[1] * v0[1]) + (v0[2] * v0[2] + v0[3] * v0[3]) + (v1[0] * v1[0] + v1[1] * v1[1]) + (v1[2] * v1[2] + v1[3] * v1[3]);
                }
                sq += __shfl_xor(sq, 16); sq += __shfl_xor(sq, 32);
                if (fq == 0) part[(size_t)r * 16 + u.pn * 4 + wc] = sq;
            }
    }
};
struct EpiScore {
    static constexpr bool PERM = false, AFTER_DRAIN = false;
    const float* part; float* sc;
    __device__ __forceinline__ void operator()(const f32x4 (&acc)[2][2][4][2], const Unit& u, int wr, int wc, int fr, int fq) const {
        { const int t_ = fresh_lane(); fr = t_ & 15; fq = t_ >> 4; }
        const int row0 = u.pm * 256 + wr * 64 + fr, col0 = u.pn * 256 + wc * 32 + 4 * fq;
#pragma unroll
        for (int ai = 0; ai < 2; ++ai)
#pragma unroll
            for (int m = 0; m < 4; ++m) {
                const int r = row0 + ai * 128 + m * 16; const f32x4* pp = (const f32x4*)(part + (size_t)r * 16);
                const f32x4 s4 = (pp[0] + pp[1]) + (pp[2] + pp[3]); const float rs = 1.0f / sqrtf(((s4[0] + s4[1]) + (s4[2] + s4[3])) * (1.0f / 1024.0f) + EPS);
                const size_t off = (size_t)r * 1024 + col0;
#pragma unroll
                for (int bj = 0; bj < 2; ++bj)
#pragma unroll
                    for (int n = 0; n < 2; ++n) *(f32x4*)(sc + off + bj * 128 + n * 16) = acc[ai][bj][m][n] * rs;
            }
    }
};
__device__ __forceinline__ void uv_convert(const float* pu, const float* pv, const float* gffn, unsigned char* u8, unsigned char* v8, float* iu, float* iv, int gw, int NGW, int lane) {
    f32x4 g[4];
#pragma unroll
    for (int j = 0; j < 4; ++j) g[j] = ((const f32x4*)gffn)[4 * lane + j];
    for (int e0 = gw; e0 < 2 * 16384; e0 += 2 * NGW) {
        f32x4 v[2][4];
#pragma unroll
        for (int h = 0; h < 2; ++h) { const int e = e0 + h * NGW; const bool isv = e >= 16384; const int row = isv ? e - 16384 : e;
            const f32x4* src = (const f32x4*)((isv ? pv : pu) + (size_t)row * 1024) + 4 * lane;
#pragma unroll
            for (int j = 0; j < 4; ++j) v[h][j] = src[j]; }
#pragma unroll
        for (int h = 0; h < 2; ++h) {
            const int e = e0 + h * NGW; const bool isv = e >= 16384; const int row = isv ? e - 16384 : e;
            float am = 0.f;
#pragma unroll
            for (int j = 0; j < 4; ++j) { if (!isv) v[h][j] = v[h][j] * g[j]; am = fmaxf(am, fmaxf(fmaxf(fabsf(v[h][j][0]), fabsf(v[h][j][1])), fmaxf(fabsf(v[h][j][2]), fabsf(v[h][j][3])))); }
#pragma unroll
            for (int o = 1; o < 64; o <<= 1) am = fmaxf(am, __shfl_xor(am, o));
            const float sc = am > 0.f ? (isv ? 416.0f : 127.0f) / am : 1.0f;
            u32x4 w;
            if (isv) {
#pragma unroll
                for (int j = 0; j < 4; ++j) { unsigned ww = 0u; ww = __builtin_amdgcn_cvt_pk_fp8_f32(v[h][j][0] * sc, v[h][j][1] * sc, ww, false); ww = __builtin_amdgcn_cvt_pk_fp8_f32(v[h][j][2] * sc, v[h][j][3] * sc, ww, true); w[j] = ww; }
            } else {
#pragma unroll
                for (int j = 0; j < 4; ++j) { unsigned ww = 0u;
#pragma unroll
                    for (int c = 0; c < 4; ++c) ww |= ((unsigned)(int)__builtin_rintf(v[h][j][c] * sc) & 0xffu) << (8 * c);
                    w[j] = ww; }
            }
            *(u32x4*)((isv ? v8 : u8) + (size_t)row * 1024 + 16 * lane) = w;
            if (lane == 0) (isv ? iv : iu)[row] = 1.0f / sc;
        }
    }
}
struct EpiTopk {
    static constexpr bool PERM = false, AFTER_DRAIN = true;
    const float* part; int* seli; float* selg;
    const float* pu; const float* pv; const float* gffn; unsigned char* u8; unsigned char* v8; float* iu; float* iv; int uvslot, uvn;
    __device__ __forceinline__ void fused(f32x4 (&acc)[2][2][4][2], const Unit& u, int wr, int wc, int fr, int fq, PG8_LAS unsigned char* lds, int wid, int lane) const {
        LAS float* L = (LAS float*)lds;
#pragma unroll
        for (int ai = 0; ai < 2; ++ai) {
            { const int t_ = fresh_lane(); fr = t_ & 15; fq = t_ >> 4; }
#pragma unroll
            for (int m = 0; m < 4; ++m) {
                const int rl = wr * 64 + m * 16 + fr, r = u.pm * 256 + ai * 128 + rl;
                const f32x4* pp = (const f32x4*)(part + (size_t)r * 16);
                const f32x4 s4 = (pp[0] + pp[1]) + (pp[2] + pp[3]); const float rs = 1.0f / sqrtf(((s4[0] + s4[1]) + (s4[2] + s4[3])) * (1.0f / 1024.0f) + EPS);
#pragma unroll
                for (int bj = 0; bj < 2; ++bj)
#pragma unroll
                    for (int n = 0; n < 2; ++n) *(LAS f32x4*)(L + (rl * 2 + bj) * TK_LSTRIDE + wc * 32 + 16 * n + 4 * fq) = acc[ai][bj][m][n] * rs;
            }
            asm volatile("s_waitcnt lgkmcnt(0)" ::: "memory"); __builtin_amdgcn_s_barrier(); asm volatile("" ::: "memory");
            const int tid = wid * 64 + fresh_lane();
            if (wid < 4) {
                const LAS float* my = L + tid * TK_LSTRIDE;
                unsigned a16[16];
#pragma unroll
                for (int g = 0; g < 8; ++g) {
                    unsigned t[16];
#pragma unroll
                    for (int q = 0; q < 4; ++q) {
                        const f32x4 v = *(const LAS f32x4*)(my + g * 16 + q * 4);
#pragma unroll
                        for (int c = 0; c < 4; ++c) { const int e = g * 16 + q * 4 + c; const float vc = v[c]; t[q * 4 + c] = (tk_f2key(vc) & ~127u) | (unsigned)(127 - e); }
                    }
                    tk_sort16(t);
                    if (g == 0) {
#pragma unroll
                        for (int i = 0; i < 16; ++i) a16[i] = t[i];
                    } else tk_merge16(a16, t);
                }
                unsigned oth[16];
#pragma unroll
                for (int i = 0; i < 16; ++i) oth[i] = (unsigned)__shfl_xor((int)a16[i], 1);
                if ((tid & 1) == 0) {
                    const int tok = u.pm * 256 + ai * 128 + (tid >> 1);
                    tk_combine_store(a16, oth, seli + (size_t)tok * 128 + u.pn * 16, selg + (size_t)tok * 128 + u.pn * 16);
                }
            } else if (uvn > 0) uv_convert(pu, pv, gffn, u8, v8, iu, iv, uvslot + 4 * ai + (wid - 4), uvn, fresh_lane());
            asm volatile("s_waitcnt lgkmcnt(0)" ::: "memory"); __builtin_amdgcn_s_barrier(); asm volatile("" ::: "memory");
        }
    }
};
struct EpiPP {
    static constexpr bool PERM = true, AFTER_DRAIN = false;
    bf16* pp;
    __device__ __forceinline__ void operator()(const f32x4 (&acc)[2][2][4][2], const Unit& u, int wr, int wc, int fr, int fq) const {
        { const int t_ = fresh_lane(); fr = t_ & 15; fq = t_ >> 4; }
        const int row0 = u.pm * 256 + wr * 64 + fr, col0 = u.pn * 256 + wc * 32 + 8 * fq;
#pragma unroll
        for (int ai = 0; ai < 2; ++ai)
#pragma unroll
            for (int m = 0; m < 4; ++m) {
                const size_t off = (size_t)(row0 + ai * 128 + m * 16) * 1024 + col0;
#pragma unroll
                for (int bj = 0; bj < 2; ++bj) *(u32x4*)(pp + off + bj * 128) = pack8(acc[ai][bj][m][0], acc[ai][bj][m][1]);
            }
    }
};
struct EpiH3 {
    static constexpr bool PERM = true, AFTER_DRAIN = false;
    const float* rstd3; const bf16* pp; float* h; float* part; const bf16* h2b; bf16* h3b;
    __device__ __forceinline__ void operator()(const f32x4 (&acc)[2][2][4][2], const Unit& u, int wr, int wc, int fr, int fq) const {
        { const int t_ = fresh_lane(); fr = t_ & 15; fq = t_ >> 4; }
        const int row0 = u.pm * 256 + wr * 64 + fr, col0 = u.pn * 256 + wc * 32 + 8 * fq;
#pragma unroll
        for (int ai = 0; ai < 2; ++ai)
#pragma unroll
            for (int m = 0; m < 4; ++m) {
                const int r = row0 + ai * 128 + m * 16; const size_t off = (size_t)r * 1024 + col0; const float rs = rstd3[r]; float sq = 0.f;
#pragma unroll
                for (int bj = 0; bj < 2; ++bj) {
                    const size_t o = off + bj * 128; const u32x4 pw = *(const u32x4*)(pp + o);
#if ALL_FUSED
                    const u32x4 hw = *(const u32x4*)(h2b + o);
                    const f32x4 v0 = bf4_lo((u32x2){hw.x, hw.y}) + sig4(acc[ai][bj][m][0] * rs) * bf4_lo((u32x2){pw.x, pw.y});
                    const f32x4 v1 = bf4_lo((u32x2){hw.z, hw.w}) + sig4(acc[ai][bj][m][1] * rs) * bf4_lo((u32x2){pw.z, pw.w});
                    *(u32x4*)(h3b + o) = pack8(v0, v1);
#else
                    const f32x4 v0 = *(const f32x4*)(h + o) + sig4(acc[ai][bj][m][0] * rs) * bf4_lo((u32x2){pw.x, pw.y});
                    const f32x4 v1 = *(const f32x4*)(h + o + 4) + sig4(acc[ai][bj][m][1] * rs) * bf4_lo((u32x2){pw.z, pw.w});
                    *(f32x4*)(h + o) = v0; *(f32x4*)(h + o + 4) = v1;
#endif
                    sq += (v0[0] * v0[0] + v0[1] * v0[1]) + (v0[2] * v0[2] + v0[3] * v0[3]) + (v1[0] * v1[0] + v1[1] * v1[1]) + (v1[2] * v1[2] + v1[3] * v1[3]);
                }
                sq += __shfl_xor(sq, 16); sq += __shfl_xor(sq, 32);
                if (fq == 0) part[(size_t)r * 16 + u.pn * 4 + wc] = sq;
            }
    }
};
struct EpiPre {
    static constexpr bool PERM = false, AFTER_DRAIN = false;
    float* rp; float* ip;
    __device__ __forceinline__ void operator()(const f32x4 (&acc)[2][2][4][2], const Unit& u, int wr, int wc, int fr, int fq) const {
        { const int t_ = fresh_lane(); fr = t_ & 15; fq = t_ >> 4; }
#pragma unroll
        for (int n = 0; n < 2; ++n) { const int ch = u.pn * 128 + wc * 32 + 16 * n + 4 * fq;
#pragma unroll
            for (int ai = 0; ai < 2; ++ai)
#pragma unroll
                for (int m = 0; m < 4; ++m) { const int r = u.pm * 256 + ai * 128 + wr * 64 + m * 16 + fr; const size_t o = (size_t)r * 1024 + ch; *(f32x4*)(rp + o) = acc[ai][0][m][n]; *(f32x4*)(ip + o) = acc[ai][1][m][n]; } }
    }
};
struct EpiH3Final {
    static constexpr bool PERM = true, AFTER_DRAIN = false;
    const float* rstd3; const bf16* pp; const bf16* h2b; const float* fg; float* out; float* part; unsigned* cnt;
    __device__ __forceinline__ void operator()(f32x4 (&acc)[2][2][4][2], const Unit& u, int wr, int wc, int fr, int fq) const {
        { const int t_ = fresh_lane(); fr = t_ & 15; fq = t_ >> 4; }
        const int row0 = u.pm * 256 + wr * 64 + fr, col0 = u.pn * 256 + wc * 32 + 8 * fq;
#pragma unroll
        for (int ai = 0; ai < 2; ++ai)
#pragma unroll
            for (int m = 0; m < 4; ++m) {
                const int r = row0 + ai * 128 + m * 16; const size_t off = (size_t)r * 1024 + col0; const float rs = rstd3[r]; float sq = 0.f;
#pragma unroll
                for (int bj = 0; bj < 2; ++bj) {
                    const size_t o = off + bj * 128; const u32x4 pw = *(const u32x4*)(pp + o); const u32x4 hw = *(const u32x4*)(h2b + o);
                    const f32x4 v0 = bf4_lo((u32x2){hw.x, hw.y}) + sig4(acc[ai][bj][m][0] * rs) * bf4_lo((u32x2){pw.x, pw.y});
                    const f32x4 v1 = bf4_lo((u32x2){hw.z, hw.w}) + sig4(acc[ai][bj][m][1] * rs) * bf4_lo((u32x2){pw.z, pw.w});
                    acc[ai][bj][m][0] = v0; acc[ai][bj][m][1] = v1;
                    sq += (v0[0] * v0[0] + v0[1] * v0[1]) + (v0[2] * v0[2] + v0[3] * v0[3]) + (v1[0] * v1[0] + v1[1] * v1[1]) + (v1[2] * v1[2] + v1[3] * v1[3]);
                }
                sq += __shfl_xor(sq, 16); sq += __shfl_xor(sq, 32);
                if (fq == 0) __hip_atomic_store(part + (size_t)r * 16 + u.pn * 4 + wc, sq, __ATOMIC_RELAXED, __HIP_MEMORY_SCOPE_AGENT);
            }
        asm volatile("s_waitcnt vmcnt(0)" ::: "memory");
        const int lane = fq * 16 + fr;
        unsigned* c = cnt + 64 * u.pm;
        if (lane == 0) __hip_atomic_fetch_add(c, 1u, __ATOMIC_RELAXED, __HIP_MEMORY_SCOPE_AGENT);
        {
            const unsigned long long t0 = __builtin_amdgcn_s_memrealtime();
            while ((unsigned)__builtin_amdgcn_readfirstlane((int)__hip_atomic_load(c, __ATOMIC_RELAXED, __HIP_MEMORY_SCOPE_AGENT)) < 32u) {
                if (__builtin_amdgcn_s_memrealtime() - t0 > 2000000ull) break;
                __builtin_amdgcn_s_sleep(2);
            }
        }
        { const int t_ = fresh_lane(); fr = t_ & 15; fq = t_ >> 4; }
#pragma unroll
        for (int ai = 0; ai < 2; ++ai)
#pragma unroll
            for (int m = 0; m < 4; ++m) {
                const int r = u.pm * 256 + wr * 64 + fr + ai * 128 + m * 16;
                float ps = 0.f;
#pragma unroll
                for (int k = 0; k < 16; ++k) ps += __hip_atomic_load(part + (size_t)r * 16 + k, __ATOMIC_RELAXED, __HIP_MEMORY_SCOPE_AGENT);
                const float rr = 1.0f / sqrtf(ps * (1.0f / 1024.0f) + EPS);
                const int cc = u.pn * 256 + wc * 32 + 8 * fq;
#pragma unroll
                for (int bj = 0; bj < 2; ++bj) {
                    const f32x4 g0 = *(const f32x4*)(fg + cc + bj * 128), g1 = *(const f32x4*)(fg + cc + bj * 128 + 4);
                    float* op = out + (size_t)r * 1024 + cc + bj * 128;
                    *(f32x4*)op = acc[ai][bj][m][0] * rr * g0; *(f32x4*)(op + 4) = acc[ai][bj][m][1] * rr * g1;
                }
            }
    }
};
template <int CTRL> __device__ __forceinline__ float dpp_f(float oldv, float src) {
    return __builtin_bit_cast(float, __builtin_amdgcn_update_dpp(__builtin_bit_cast(int, oldv), __builtin_bit_cast(int, src), CTRL, 0xf, 0xf, false));
}
#ifndef LRU_T2
#define LRU_T2 0
#endif
struct EpiLru {
    static constexpr bool PERM = false, AFTER_DRAIN = false;
    const bf16* lin; const float* ba; const float* bx; const float* c8l; bf16* hloc; bf16* pcum; float* agg;
    template <int SH> static __device__ __forceinline__ void step(f32x4& A, f32x4& Bv, float idd) {
#pragma unroll
        for (int j = 0; j < 4; ++j) {
            const float ap = __int_as_float(__builtin_amdgcn_update_dpp(0, __float_as_int((float)A[j]), 0x110 + SH, 0xf, 0xf, true)) + idd;
            const float bp = __int_as_float(__builtin_amdgcn_update_dpp(0, __float_as_int((float)Bv[j]), 0x110 + SH, 0xf, 0xf, true));
            Bv[j] = fmaf(A[j], bp, Bv[j]); A[j] = A[j] * ap; }
    }
    __device__ __forceinline__ void operator()(f32x4 (&acc)[2][2][4][2], const Unit& u, int wr, int wc, int fr, int fq) const {
        { const int t_ = fresh_lane(); fr = t_ & 15; fq = t_ >> 4; }
        const int lane = fq * 16 + fr;
#pragma unroll
        for (int n = 0; n < 2; ++n) {
            const int ch = u.pn * 128 + wc * 32 + 16 * n + 4 * fq;
            const f32x4 bav = *(const f32x4*)(ba + ch), bxv = *(const f32x4*)(bx + ch), cv = *(const f32x4*)(c8l + ch);
#pragma unroll
            for (int ai = 0; ai < 2; ++ai)
#pragma unroll
                for (int m = 0; m < 4; ++m) {
                    const int r = u.pm * 256 + ai * 128 + wr * 64 + m * 16 + fr; const unsigned o = (unsigned)r * 1024u + (unsigned)ch;
                    const f32x4 lv = bf4_lo(*(const u32x2*)(lin + o));
#pragma unroll
                    for (int j = 0; j < 4; ++j) {
                        const float rr = sigmoidf_(acc[ai][0][m][n][j] + bav[j]), ii = sigmoidf_(acc[ai][1][m][n][j] + bxv[j]);
                        const float a = __builtin_amdgcn_exp2f(cv[j] * rr);
                        acc[ai][0][m][n][j] = a; acc[ai][1][m][n][j] = __builtin_amdgcn_sqrtf(fmaxf(1.0f - a * a, 0.f)) * (ii * lv[j]);
                    }
                    asm volatile("" : "+v"(acc[ai][0][m][n]), "+v"(acc[ai][1][m][n]));
                }
        }
#if defined(LRU_DEBUG) && LRU_DEBUG == 1
        {
            float* af = (float*)hloc; float* bf = (float*)pcum;
#pragma unroll
            for (int n = 0; n < 2; ++n) { const int ch = u.pn * 128 + wc * 32 + 16 * n + 4 * fq;
#pragma unroll
                for (int ai = 0; ai < 2; ++ai)
#pragma unroll
                    for (int m = 0; m < 4; ++m) { const int r = u.pm * 256 + ai * 128 + wr * 64 + m * 16 + fr; const size_t o = (size_t)r * 1024 + ch; *(f32x4*)(af + o) = acc[ai][0][m][n]; *(f32x4*)(bf + o) = acc[ai][1][m][n]; } }
            return;
        }
#endif
        __builtin_amdgcn_sched_barrier(0);
        const float id1 = fr < 1 ? 1.f : 0.f, id2 = fr < 2 ? 1.f : 0.f, id4 = fr < 4 ? 1.f : 0.f, id8 = fr < 8 ? 1.f : 0.f;
#pragma unroll
        for (int ai = 0; ai < 2; ++ai)
#pragma unroll
            for (int m = 0; m < 4; ++m)
#pragma unroll
                for (int n = 0; n < 2; ++n) { step<1>(acc[ai][0][m][n], acc[ai][1][m][n], id1); step<2>(acc[ai][0][m][n], acc[ai][1][m][n], id2); step<4>(acc[ai][0][m][n], acc[ai][1][m][n], id4); step<8>(acc[ai][0][m][n], acc[ai][1][m][n], id8);
                    asm volatile("" : "+v"(acc[ai][0][m][n]), "+v"(acc[ai][1][m][n])); }
        { const int t_ = fresh_lane(); fr = t_ & 15; fq = t_ >> 4; }
        const int src4 = (((fq * 16 + fr) & 48) | 15) * 4;
#pragma unroll
        for (int n = 0; n < 2; ++n) {
            const int ch = u.pn * 128 + wc * 32 + 16 * n + 4 * fq;
#pragma unroll
            for (int ai = 0; ai < 2; ++ai) {
#pragma unroll
                for (int m = 0; m < 4; ++m) {
                    f32x4& A = acc[ai][0][m][n]; f32x4& Bv = acc[ai][1][m][n];
                    if (m > 0 && !(LRU_T2)) {
#pragma unroll
                        for (int j = 0; j < 4; ++j) { const float pa = acc[ai][0][m - 1][n][j], pb = acc[ai][1][m - 1][n][j];
                            const float ac = __int_as_float(__builtin_amdgcn_ds_bpermute(src4, __float_as_int(pa))), bc = __int_as_float(__builtin_amdgcn_ds_bpermute(src4, __float_as_int(pb))); Bv[j] = fmaf(A[j], bc, Bv[j]); A[j] = A[j] * ac; }
                    }
                    const int r = u.pm * 256 + ai * 128 + wr * 64 + m * 16 + fr; const unsigned o = (unsigned)r * 1024u + (unsigned)ch;
                    u32x2 wp, wh; wp.x = cvt_pk_bf16(A[0], A[1]); wp.y = cvt_pk_bf16(A[2], A[3]); wh.x = cvt_pk_bf16(Bv[0], Bv[1]); wh.y = cvt_pk_bf16(Bv[2], Bv[3]);
                    *(u32x2*)(pcum + o) = wp; *(u32x2*)(hloc + o) = wh;
                    if (m == 3 && fr == 15) {
                        const int chunk = u.pm * 4 + ai * 2 + wr; float* ap = agg + ((size_t)chunk * 1024 + ch) * 2;
                        *(f32x4*)(ap) = (f32x4){A[0], Bv[0], A[1], Bv[1]}; *(f32x4*)(ap + 4) = (f32x4){A[2], Bv[2], A[3], Bv[3]};
                    }
                    __builtin_amdgcn_sched_barrier(0);
                }
            }
        }
    }
};

__device__ __forceinline__ void p0_transpose_item(const float* W, int ldw, const float* gain, bf16* WT, int ldt, int k_off, LAS float* scr, int kb, int nb, int lane) {
    const int k0 = 64 * kb, n0 = 32 * nb;
    const int c4 = lane & 7, kr = lane >> 3;
    f32x4 v[8];
#pragma unroll
    for (int i = 0; i < 8; ++i) v[i] = *(const f32x4*)(W + (size_t)(k0 + 8 * i + kr) * ldw + n0 + 4 * c4);
#pragma unroll
    for (int i = 0; i < 8; ++i) { f32x4 x = v[i]; if (gain) x = x * gain[k0 + 8 * i + kr]; *(LAS f32x4*)(scr + (8 * i + kr) * 36 + 4 * c4) = x; }
    LDS_WAIT(); asm volatile("" ::: "memory");
    const int c = lane & 7;
#pragma unroll
    for (int j = 0; j < 4; ++j) { const int n = (lane >> 3) + 8 * j; const LAS float* sp = scr + (8 * c) * 36 + n;
        u32x4 o; o.x = pk2(sp[0 * 36], sp[1 * 36]); o.y = pk2(sp[2 * 36], sp[3 * 36]); o.z = pk2(sp[4 * 36], sp[5 * 36]); o.w = pk2(sp[6 * 36], sp[7 * 36]);
        *(u32x4*)(WT + (size_t)(n0 + n) * ldt + k_off + k0 + 8 * c) = o; }
    LDS_WAIT(); asm volatile("" ::: "memory");
}
__device__ __forceinline__ void p0_wfold_item(LAS float* lds, const float* wq, const float* k1, const float* k2, const float* gffn, bf16* wfold, int item, int tid) {
    const int hh = item >> 4, kb = item & 15;
    LAS float* wqs = lds; LAS float* kks = lds + 64 * 132;
    const float* ksrc = (hh & 1) ? k2 : k1;
#pragma unroll
    for (int i = 0; i < 4; ++i) { const int e = tid + i * 512, r = e >> 5, c4 = e & 31; *(LAS f32x4*)(wqs + r * 132 + 4 * c4) = *(const f32x4*)(wq + (size_t)(kb * 64 + r) * 2048 + hh * 128 + 4 * c4); }
#pragma unroll
    for (int i = 0; i < 8; ++i) { const int e = tid + i * 512, r = e >> 5, c4 = e & 31; *(LAS f32x4*)(kks + r * 132 + 4 * c4) = *(const f32x4*)(ksrc + (size_t)r * 128 + 4 * c4); }
    __syncthreads();
    const int tk = tid & 15, tkey = tid >> 4;
    float acc[4][4];
#pragma unroll
    for (int i = 0; i < 4; ++i)
#pragma unroll
        for (int j = 0; j < 4; ++j) acc[i][j] = 0.f;
#pragma unroll 2
    for (int c4 = 0; c4 < 32; ++c4) {
        f32x4 a[4], b[4];
#pragma unroll
        for (int i = 0; i < 4; ++i) { a[i] = *(const LAS f32x4*)(wqs + (tk * 4 + i) * 132 + 4 * c4); b[i] = *(const LAS f32x4*)(kks + (tkey * 4 + i) * 132 + 4 * c4); }
#pragma unroll
        for (int i = 0; i < 4; ++i)
#pragma unroll
            for (int j = 0; j < 4; ++j) acc[i][j] += (a[i][0] * b[j][0] + a[i][1] * b[j][1]) + (a[i][2] * b[j][2] + a[i][3] * b[j][3]);
    }
    const int kg = kb * 64 + tk * 4; const f32x4 gv = *(const f32x4*)(gffn + kg);
#pragma unroll
    for (int j = 0; j < 4; ++j) { u32x2 w; w.x = pk2(acc[0][j] * gv[0], acc[1][j] * gv[1]); w.y = pk2(acc[2][j] * gv[2], acc[3][j] * gv[3]);
        *(u32x2*)(wfold + (size_t)(hh * 128 + tkey * 4 + j) * 1024 + kg) = w; }
    __syncthreads();
}

struct In { const float* p[25]; };
enum { I_X = 0, I_P, I_GMIX, I_WIN, I_SINK, I_CONVW, I_CONVB, I_WA, I_BA, I_WX, I_BX, I_LAM, I_WUA, I_WUL, I_WO, I_GFFN, I_WQ, I_K1, I_K2, I_U, I_V, I_GPLE, I_WGATE, I_WPROJ, I_FG };

__device__ __forceinline__ void p0_prologue(const In& in, unsigned char* ws, LAS unsigned char* lds, int vcu, int G, int wave, int tid) {
    const int lane = tid & 63;
    LAS float* scr = (LAS float*)(lds + wave * 16384);
    const int gw = vcu * NWAVES + wave, NGW = G * NWAVES;
    constexpr int I_IN = 16 * 152, I_UA = 8 * 32, I_SQ = 16 * 32, I_PJ = 4 * 32, I_AX = 128;
    constexpr int NITEMS = I_IN + I_UA + 3 * I_SQ + I_PJ + I_AX;
    for (int it = gw; it < NITEMS; it += NGW) {
        int r = it;
        if (r < I_IN) { p0_transpose_item(in.p[I_WIN], INW, in.p[I_GMIX], (bf16*)(ws + WS_WIN), 1024, 0, scr, r / 152, r % 152, lane); continue; } r -= I_IN;
        if (r < I_UA) { p0_transpose_item(in.p[I_WUA], 1024, nullptr, (bf16*)(ws + WS_WUA), 512, 0, scr, r / 32, r % 32, lane); continue; } r -= I_UA;
        if (r < I_SQ) { p0_transpose_item(in.p[I_WUL], 1024, nullptr, (bf16*)(ws + WS_WUL), 1024, 0, scr, r / 32, r % 32, lane); continue; } r -= I_SQ;
        if (r < I_SQ) { p0_transpose_item(in.p[I_WO], 1024, nullptr, (bf16*)(ws + WS_WO), 1024, 0, scr, r / 32, r % 32, lane); continue; } r -= I_SQ;
        if (r < I_SQ) { p0_transpose_item(in.p[I_WGATE], 1024, in.p[I_GPLE], (bf16*)(ws + WS_WG), 1024, 0, scr, r / 32, r % 32, lane); continue; } r -= I_SQ;
        if (r < I_PJ) { p0_transpose_item(in.p[I_WPROJ], 1024, nullptr, (bf16*)(ws + WS_WPROJ), 256, 0, scr, r / 32, r % 32, lane); continue; } r -= I_PJ;
        { const int blk = r >> 4, which = (r >> 3) & 1, sub = r & 7;

#if LRU_PADDED
#if LRU_PADDED == 2
          p0_transpose_item(in.p[which ? I_WX : I_WA] + (size_t)blk * 16384, 128, nullptr, (bf16*)(ws + WS_WAX) + (size_t)blk * 32768 + which * 128 * 128, 128, 0, scr, sub >> 2, sub & 3, lane); }
#else
          p0_transpose_item(in.p[which ? I_WX : I_WA] + (size_t)blk * 16384, 128, nullptr, (bf16*)(ws + WS_WAX) + (size_t)blk * 65536 + which * 128 * 256, 256, (blk & 1) * 128, scr, sub >> 2, sub & 3, lane); }
#endif
#else
          p0_transpose_item(in.p[which ? I_WX : I_WA] + (size_t)blk * 16384, 128, nullptr, (bf16*)(ws + WS_WAXD) + (size_t)(blk * 256 + which * 128) * 1024, 1024, blk * 128, scr, sub >> 2, sub & 3, lane); }
#endif
    }
#if LRU_PADDED == 2
#elif LRU_PADDED
    for (int i = vcu * 512 + tid; i < 8 * 256 * 16; i += G * 512) { const int c16 = i & 15, n = (i >> 4) & 255, blk = i >> 12;
        *(u32x4*)((bf16*)(ws + WS_WAX) + (size_t)blk * 65536 + n * 256 + ((blk & 1) ^ 1) * 128 + c16 * 8) = (u32x4){0u, 0u, 0u, 0u}; }
#else
    for (int i = vcu * 512 + tid; i < 2048 * 128; i += G * 512) { const int c16 = i & 127, row = i >> 7, blk = row >> 8;
        if ((c16 >> 4) != blk) *(u32x4*)((bf16*)(ws + WS_WAXD) + (size_t)row * 1024 + c16 * 8) = (u32x4){0u, 0u, 0u, 0u}; }
#endif
    for (int m = gw; m < T_; m += 2 * NGW) {
        const int m2 = m + NGW;
        const f32x4* xa = (const f32x4*)(in.p[I_X] + (size_t)m * 1024) + lane; const f32x4* xb = (const f32x4*)(in.p[I_X] + (size_t)(m2 < T_ ? m2 : m) * 1024) + lane;
        f32x4 va[4], vb[4]; float sa = 0.f, sb = 0.f;
#pragma unroll
        for (int j = 0; j < 4; ++j) { va[j] = xa[64 * j]; vb[j] = xb[64 * j]; }
#pragma unroll
        for (int j = 0; j < 4; ++j) { sa += (va[j][0] * va[j][0] + va[j][1] * va[j][1]) + (va[j][2] * va[j][2] + va[j][3] * va[j][3]); sb += (vb[j][0] * vb[j][0] + vb[j][1] * vb[j][1]) + (vb[j][2] * vb[j][2] + vb[j][3] * vb[j][3]); }
#pragma unroll
        for (int o = 1; o < 64; o <<= 1) { sa += __shfl_xor(sa, o); sb += __shfl_xor(sb, o); }
        u32x2* oa = (u32x2*)((bf16*)(ws + WS_R0) + (size_t)m * 1024) + lane;
#pragma unroll
        for (int j = 0; j < 4; ++j) { u32x2 w; w.x = pk2(va[j][0], va[j][1]); w.y = pk2(va[j][2], va[j][3]); oa[64 * j] = w; }
        if (lane == 0) ((float*)(ws + WS_RSTD1))[m] = 1.0f / sqrtf(sa * (1.0f / 1024.0f) + EPS);
        if (m2 < T_) {
            u32x2* ob = (u32x2*)((bf16*)(ws + WS_R0) + (size_t)m2 * 1024) + lane;
#pragma unroll
            for (int j = 0; j < 4; ++j) { u32x2 w; w.x = pk2(vb[j][0], vb[j][1]); w.y = pk2(vb[j][2], vb[j][3]); ob[64 * j] = w; }
            if (lane == 0) ((float*)(ws + WS_RSTD1))[m2] = 1.0f / sqrtf(sb * (1.0f / 1024.0f) + EPS);
        }
    }
    for (int m = gw; m < T_; m += 4 * NGW) {
        f32x4 v[4];
#pragma unroll
        for (int q = 0; q < 4; ++q) { const int mq = m + q * NGW; v[q] = ((const f32x4*)(in.p[I_P] + (size_t)(mq < T_ ? mq : m) * 256))[lane]; }
#pragma unroll
        for (int q = 0; q < 4; ++q) { const int mq = m + q * NGW; if (mq < T_) { u32x2 w; w.x = pk2(v[q][0], v[q][1]); w.y = pk2(v[q][2], v[q][3]); ((u32x2*)((bf16*)(ws + WS_PB) + (size_t)mq * 256))[lane] = w; } }
    }
    if (vcu == 0) for (int c = tid; c < 1024; c += 512) ((float*)(ws + WS_C8))[c] = -8.0f * log1pf(expf(-in.p[I_LAM][c])) * LOG2E;
    __syncthreads();
    for (int it = vcu; it < 256; it += G) p0_wfold_item((LAS float*)lds, in.p[I_WQ], in.p[I_K1], in.p[I_K2], in.p[I_GFFN], (bf16*)(ws + WS_WFOLD), it, tid);
}

constexpr int AT_KSTR = 72, AT_VSTR = 260, AT_V_OFF = 256 * AT_KSTR * 2;
__device__ __forceinline__ int crow(int r, int hi) { return (r & 3) + 8 * (r >> 2) + 4 * hi; }
__device__ __forceinline__ void attn_item(LAS unsigned char* lds, const bf16* qkv, const float* sink, bf16* att, int item, int wave, int tid) {
    const int lane = tid & 63;
    const int g = item & 1, n = (item >> 1) & 15, b = item >> 5;
    const int t0 = b * S_ + n * 128;
    LAS bf16* Ks = (LAS bf16*)lds; LAS bf16* Vt = (LAS bf16*)(lds + AT_V_OFF);
#pragma unroll
    for (int i = 0; i < 4; ++i) {
        const int idx = tid + i * 512, row = idx >> 3, ch = idx & 7; const int tk = t0 - 128 + row;
        u32x4 kv = (u32x4){0u, 0u, 0u, 0u}, vv = (u32x4){0u, 0u, 0u, 0u};
        if (n > 0 || row >= 128) { const bf16* src = qkv + (size_t)tk * 768 + 512 + g * 64 + ch * 8; kv = *(const u32x4*)src; vv = *(const u32x4*)(src + 128); }
        *(LAS u32x4*)(Ks + row * AT_KSTR + ch * 8) = kv;
#pragma unroll
        for (int c = 0; c < 8; ++c) Vt[(ch * 8 + c) * AT_VSTR + row] = (bf16)(vv[c >> 1] >> (16 * (c & 1)));
    }
    __syncthreads();
    const int hr = wave >> 1, qh = wave & 1, head = g * 4 + hr;
    const float slope2 = exp2f(-(float)(head + 1)) * LOG2E, sink2 = sink[head] * LOG2E;
    const int q = lane & 31, hi = lane >> 5;
#pragma unroll 1
    for (int ps = 0; ps < 2; ++ps) {
        const int i0 = 64 * qh + 32 * ps, kb0 = i0;
        const bf16* qp = qkv + (size_t)(t0 + i0 + q) * 768 + head * 64 + 8 * hi;
        bf16x8 qf[4];
#pragma unroll
        for (int s = 0; s < 4; ++s) qf[s] = *(const bf16x8*)(qp + 16 * s);
        f32x16 oT[2];
#pragma unroll
        for (int dt = 0; dt < 2; ++dt)
#pragma unroll
            for (int r = 0; r < 16; ++r) oT[dt][r] = 0.f;
        float mrun = sink2, l = 0.f;
#pragma unroll 1
        for (int kt = 0; kt < 5; ++kt) {
            const int kbase = kb0 + 32 * kt;
            f32x16 sT;
#pragma unroll
            for (int r = 0; r < 16; ++r) sT[r] = 0.f;
#pragma unroll
            for (int s = 0; s < 4; ++s) { const bf16x8 kf = *(const LAS bf16x8*)(Ks + (kbase + q) * AT_KSTR + 16 * s + 8 * hi); sT = __builtin_amdgcn_mfma_f32_32x32x16_bf16(kf, qf[s], sT, 0, 0, 0); }
            float tm = -1.0e30f;
#pragma unroll
            for (int r = 0; r < 16; ++r) {
                const int kj = kbase + crow(r, hi); const int dist = i0 + q + 128 - kj;
                const bool valid = (dist >= 0) && (dist < 128) && (n > 0 || kj >= 128);
                const float v = valid ? (sT[r] * (0.125f * LOG2E) - slope2 * (float)dist) : -1.0e30f;
                sT[r] = v; tm = fmaxf(tm, v);
            }
            tm = fmaxf(tm, __shfl_xor(tm, 32));
            const float mnew = fmaxf(mrun, tm), alpha = __builtin_amdgcn_exp2f(mrun - mnew);
            mrun = mnew;
            float ls = 0.f;
#pragma unroll
            for (int r = 0; r < 16; ++r) { const float p = __builtin_amdgcn_exp2f(sT[r] - mnew); sT[r] = p; ls += p; }
            l = l * alpha + ls;
#pragma unroll
            for (int dt = 0; dt < 2; ++dt)
#pragma unroll
                for (int r = 0; r < 16; ++r) oT[dt][r] *= alpha;
#pragma unroll
            for (int s = 0; s < 2; ++s) {
                u32x4 pw; pw.x = cvt_pk_bf16(sT[8 * s + 0], sT[8 * s + 1]); pw.y = cvt_pk_bf16(sT[8 * s + 2], sT[8 * s + 3]);
                pw.z = cvt_pk_bf16(sT[8 * s + 4], sT[8 * s + 5]); pw.w = cvt_pk_bf16(sT[8 * s + 6], sT[8 * s + 7]);
                const bf16x8 pf = __builtin_bit_cast(bf16x8, pw);
#pragma unroll
                for (int dt = 0; dt < 2; ++dt) {
                    const LAS bf16* vp = Vt + (32 * dt + q) * AT_VSTR + kbase + 16 * s + 4 * hi;
                    const u32x2 va = *(const LAS u32x2*)vp, vb = *(const LAS u32x2*)(vp + 8);
                    const bf16x8 af = __builtin_bit_cast(bf16x8, (u32x4){va.x, va.y, vb.x, vb.y});
                    oT[dt] = __builtin_amdgcn_mfma_f32_32x32x16_bf16(af, pf, oT[dt], 0, 0, 0);
                }
            }
        }
        l += __shfl_xor(l, 32);
        l += __builtin_amdgcn_exp2f(sink2 - mrun);
        const float inv = 1.0f / l;
        bf16* op = att + (size_t)(t0 + i0 + q) * 512 + head * 64 + 4 * hi;
#pragma unroll
        for (int dt = 0; dt < 2; ++dt)
#pragma unroll
            for (int rg = 0; rg < 4; ++rg) { u32x2 w; w.x = cvt_pk_bf16(oT[dt][4 * rg] * inv, oT[dt][4 * rg + 1] * inv); w.y = cvt_pk_bf16(oT[dt][4 * rg + 2] * inv, oT[dt][4 * rg + 3] * inv);
                *(u32x2*)(op + 32 * dt + 8 * rg) = w; }
    }
    __syncthreads();
}
__device__ __forceinline__ void conv_items(const bf16* lx, const float* cw, const float* cb, bf16* lin, int vcu, int G, int tid) {
    for (int i = vcu * 512 + tid; i < T_ * 128; i += 2 * G * 512) {
        const int c8 = (i & 127) * 8;
        const int ta = i >> 7, i2 = i + G * 512; const bool hasb = i2 < T_ * 128; const int tb = hasb ? (i2 >> 7) : ta;
        const int tsa = ta & (S_ - 1), tsb = tb & (S_ - 1);
        u32x4 wa[4], wb[4];
#pragma unroll
        for (int tap = 0; tap < 4; ++tap) {
            wa[tap] = (tsa - 3 + tap >= 0) ? *(const u32x4*)(lx + (size_t)(ta - 3 + tap) * 1024 + c8) : (u32x4){0u, 0u, 0u, 0u};
            wb[tap] = (tsb - 3 + tap >= 0) ? *(const u32x4*)(lx + (size_t)(tb - 3 + tap) * 1024 + c8) : (u32x4){0u, 0u, 0u, 0u};
        }
        f32x4 a0 = *(const f32x4*)(cb + c8), a1 = *(const f32x4*)(cb + c8 + 4), b0 = a0, b1 = a1;
#pragma unroll
        for (int tap = 0; tap < 4; ++tap) {
            const f32x4 w0 = *(const f32x4*)(cw + tap * 1024 + c8), w1 = *(const f32x4*)(cw + tap * 1024 + c8 + 4);
            a0 += bf4_lo((u32x2){wa[tap].x, wa[tap].y}) * w0; a1 += bf4_lo((u32x2){wa[tap].z, wa[tap].w}) * w1;
            b0 += bf4_lo((u32x2){wb[tap].x, wb[tap].y}) * w0; b1 += bf4_lo((u32x2){wb[tap].z, wb[tap].w}) * w1;
        }
        *(u32x4*)(lin + (size_t)ta * 1024 + c8) = pack8(a0, a1);
        if (hasb) *(u32x4*)(lin + (size_t)tb * 1024 + c8) = pack8(b0, b1);
    }
}
__device__ __forceinline__ void scan_finish(const bf16* hloc, const bf16* pcum, const float* agg, const bf16* gl, bf16* rec, int vcu, int G, int tid) {
    const int c8 = (tid & 127) * 8, rg = tid >> 7;
    for (int chunk = vcu; chunk < T_ / 64; chunk += G) {
        const int ci = chunk & 31, cb = chunk - ci;
        float carry[8];
#pragma unroll
        for (int j = 0; j < 8; ++j) carry[j] = 0.f;
#pragma unroll 4
        for (int cc = 0; cc < ci; ++cc) {
            const f32x4* ap = (const f32x4*)(agg + ((size_t)(cb + cc) * 1024 + c8) * 2);
#pragma unroll
            for (int q = 0; q < 4; ++q) { const f32x4 v = ap[q]; carry[2 * q] = fmaf(v[0], carry[2 * q], v[1]); carry[2 * q + 1] = fmaf(v[2], carry[2 * q + 1], v[3]); }
        }
#pragma unroll 8
        for (int rr = 0; rr < 16; ++rr) {
            const size_t o = (size_t)(chunk * 64 + rg + 4 * rr) * 1024 + c8;
            const u32x4 hw = *(const u32x4*)(hloc + o), pw = *(const u32x4*)(pcum + o), gw = *(const u32x4*)(gl + o);
            const f32x4 h0 = bf4_lo((u32x2){hw.x, hw.y}), h1 = bf4_lo((u32x2){hw.z, hw.w}), p0 = bf4_lo((u32x2){pw.x, pw.y}), p1 = bf4_lo((u32x2){pw.z, pw.w});
            const f32x4 g0 = bf4_lo((u32x2){gw.x, gw.y}), g1 = bf4_lo((u32x2){gw.z, gw.w});
            f32x4 r0, r1;
#pragma unroll
            for (int j = 0; j < 4; ++j) { r0[j] = fmaf(p0[j], carry[j], h0[j]) * g0[j]; r1[j] = fmaf(p1[j], carry[4 + j], h1[j]) * g1[j]; }
            *(u32x4*)(rec + o) = pack8(r0, r1);
        }
    }
}
__device__ __forceinline__ void final_rows(float* h, const bf16* h3b, const float* part, const float* fg, int gw, int NGW, int lane, float tscale) {
    f32x4 g[4];
#pragma unroll
    for (int j = 0; j < 4; ++j) g[j] = ((const f32x4*)fg)[lane + 64 * j];
    for (int r0 = gw; r0 < T_; r0 += 2 * NGW) {
        const int r1 = (r0 + NGW < T_) ? r0 + NGW : r0;
        float pa = (lane < 16) ? part[(size_t)r0 * 16 + lane] : 0.f, pb = (lane < 16) ? part[(size_t)r1 * 16 + lane] : 0.f;
#if ALL_FUSED
        const u32x2* ba = (const u32x2*)(h3b + (size_t)r0 * 1024) + lane; const u32x2* bb = (const u32x2*)(h3b + (size_t)r1 * 1024) + lane;
        u32x2 wa[4], wb[4];
#pragma unroll
        for (int j = 0; j < 4; ++j) { wa[j] = ba[64 * j]; wb[j] = bb[64 * j]; }
#endif
#pragma unroll
        for (int o = 1; o < 64; o <<= 1) { pa += __shfl_xor(pa, o); pb += __shfl_xor(pb, o); }
        const float ra = tscale / sqrtf(pa * (1.0f / 1024.0f) + EPS), rb = tscale / sqrtf(pb * (1.0f / 1024.0f) + EPS);
        f32x4* ha = (f32x4*)(h + (size_t)r0 * 1024) + lane; f32x4* hb = (f32x4*)(h + (size_t)r1 * 1024) + lane;
#if ALL_FUSED
#pragma unroll
        for (int j = 0; j < 4; ++j) ha[64 * j] = bf4_lo(wa[j]) * ra * g[j];
        if (r1 != r0) {
#pragma unroll
            for (int j = 0; j < 4; ++j) hb[64 * j] = bf4_lo(wb[j]) * rb * g[j];
        }
#else
#pragma unroll
        for (int j = 0; j < 4; ++j) ha[64 * j] = ha[64 * j] * ra * g[j];
        if (r1 != r0) {
#pragma unroll
            for (int j = 0; j < 4; ++j) hb[64 * j] = hb[64 * j] * rb * g[j];
        }
#endif
    }
}

constexpr int N_PHASES = 16;
struct Args { const float* in[25]; float* out; unsigned char* ws; int ph_lo, ph_hi, li, pad; };
__global__ void __launch_bounds__(NWAVES * 64, 2) fused_fwd(Args args) {
    extern __shared__ __attribute__((aligned(16))) unsigned char lds_raw[];
    LAS unsigned char* lds = (LAS unsigned char*)lds_raw;
    volatile LAS unsigned* MISC = (volatile LAS unsigned*)(lds + LDSCTL_OFF);
    const int wave = __builtin_amdgcn_readfirstlane((int)threadIdx.x >> 6);
#define FRESH_TID() (wave * 64 + fresh_lane())
#define FRESH_LANE() fresh_lane()
    const int G = gridDim.x; const int bx = blockIdx.x; const int vcu = (G % 8 == 0) ? (bx % 8) * (G / 8) + bx / 8 : bx;
    unsigned char* ws = args.ws; float* out = args.out;
    In in;
#pragma unroll
    for (int i = 0; i < 25; ++i) in.p[i] = args.in[i];
    for (int u = FRESH_TID(); u < (LDS_BYTES - LDSCTL_OFF) / 4; u += NWAVES * 64) ((LAS unsigned*)(lds + LDSCTL_OFF))[u] = 0u;
    __syncthreads();
    (void)xcd_barrier_post((unsigned*)(ws + WS_CTL) + CW_BAR + args.li * XCD_BAR_WORDS, MISC + 8);
    const int lo = args.ph_lo, hi = args.ph_hi;
    const int gw = vcu * NWAVES + wave, NGW = G * NWAVES;
#ifndef PH_DISABLE
#define PH_DISABLE 0
#endif
#if ALL_FUSED
#define IN(k) (!((PH_DISABLE >> (k)) & 1))
#else
#define IN(k) (lo <= (k) && (k) < hi && !((PH_DISABLE >> (k)) & 1))
#endif
#ifdef TIMING_A
#define STAMP(i) do { if (bx == 0 && FRESH_TID() == 0) __hip_atomic_store((unsigned long long*)(ws + WS_CTL + 512) + (i), __builtin_amdgcn_s_memrealtime(), __ATOMIC_RELAXED, __HIP_MEMORY_SCOPE_AGENT); } while (0)
#else
#define STAMP(i) do { } while (0)
#endif
#define SEAM(k) do { if (IN(k) && IN((k) + 1)) { XcdBarrier b_; b_.bar = (unsigned*)(args.ws + WS_CTL) + CW_BAR + args.li * XCD_BAR_WORDS; b_.x = xb_xcc_id(); b_.st = (volatile LAS unsigned*)(lds + LDSCTL_OFF) + 8;     \
        xcd_barrier(b_); STAMP((k) + 1); } } while (0)
#if ALL_FUSED
#define PP_OFF WS_PP2
#define MP_PTR out
#else
#define PP_OFF WS_PP
#define MP_PTR ((float*)(ws + WS_MP))
#endif
#define GEMM_PHASE(EPI, Aptr, Bptr, Kdim, LDA, M_, N_, SH, STR, ...) do { \
        pg8::Gemm g{(const pg8::bf16_t*)(Aptr), (const pg8::bf16_t*)(Bptr), Kdim, LDA, SH, STR}; pg8::StaticOrder S; S.init(M_, N_, G, (int)blockIdx.x); \
        EPI E{__VA_ARGS__}; pg8::gemm_phase<EPI, pg8::StaticOrder, true, true>(lds, g, S, E, wave); } while (0)

    STAMP(0);
    if (IN(0)) { p0_prologue(in, ws, lds, vcu, G, wave, FRESH_TID()); } SEAM(0);
    if (IN(1)) { GEMM_PHASE(EpiProj, ws + WS_R0, ws + WS_WIN, 1024, 1024, T_, INW, 0, 0, (const float*)(ws + WS_RSTD1), ws); } SEAM(1);
    if (IN(2)) {
        for (int it = bx; it < 256; it += G) attn_item(lds, (const bf16*)(ws + WS_QKV), in.p[I_SINK], (bf16*)(ws + WS_ATT), it, wave, FRESH_TID());
        conv_items((const bf16*)(ws + WS_LX), in.p[I_CONVW], in.p[I_CONVB], (bf16*)(ws + WS_R0), vcu, G, FRESH_TID());
    } SEAM(2);
#if LRU_PADDED == 2
    if (IN(3)) { GEMM_PHASE(EpiLru, ws + WS_R0, ws + WS_WAX, 128, 1024, T_, 2048, 0, 128,
#elif LRU_PADDED
    if (IN(3)) { GEMM_PHASE(EpiLru, ws + WS_R0, ws + WS_WAX, 256, 1024, T_, 2048, 1, 256,
#else
    if (IN(3)) { GEMM_PHASE(EpiLru, ws + WS_R0, ws + WS_WAXD, 1024, 1024, T_, 2048, 0, 0,
#endif
        (const bf16*)(ws + WS_R0), in.p[I_BA], in.p[I_BX], (const float*)(ws + WS_C8), (bf16*)(ws + WS_HLOC), (bf16*)(ws + WS_PCUM), (float*)(ws + WS_AGG)); }
    SEAM(3);
    if (IN(4)) { scan_finish((const bf16*)(ws + WS_HLOC), (const bf16*)(ws + WS_PCUM), (const float*)(ws + WS_AGG), (const bf16*)(ws + WS_GL), (bf16*)(ws + WS_R0), vcu, G, FRESH_TID()); }
#if !ALL_FUSED
    SEAM(4);
#endif
    if (IN(5)) { GEMM_PHASE(EpiMP, ws + WS_ATT, ws + WS_WUA, 512, 512, T_, 1024, 0, 0, (const bf16*)(ws + WS_SGA), MP_PTR); } SEAM(5);
    if (IN(6)) { GEMM_PHASE(EpiMerged, ws + WS_R0, ws + WS_WUL, 1024, 1024, T_, 1024, 0, 0, (const bf16*)(ws + WS_SGL), (const float*)MP_PTR, (bf16*)(ws + WS_MERGED)); } SEAM(6);
    if (IN(7)) { GEMM_PHASE(EpiH1, ws + WS_MERGED, ws + WS_WO, 1024, 1024, T_, 1024, 0, 0, in.p[I_X], out, (bf16*)(ws + WS_R0), (float*)(ws + WS_PART2)); }
#if ALL_FUSED
    if (IN(13)) { GEMM_PHASE(EpiPP, ws + WS_PB, ws + WS_WPROJ, 256, 256, T_, 1024, 0, 0, (bf16*)(ws + WS_PP2)); }
#endif
    SEAM(7);
#define PEER_HALF(half) do { \
        if (IN(8 + 2 * (half))) { GEMM_PHASE(EpiScore, ws + WS_R0, ws + WS_WFOLD + (size_t)(half) * 1024 * 1024 * 2, 1024, 1024, T_, 1024, 0, 0, (const float*)(ws + WS_PART2), (float*)(ws + WS_SC)); } SEAM(8 + 2 * (half)); \
        if (IN(9 + 2 * (half))) { \
            for (int it = vcu; it < T_ / TK_TOK; it += G) topk_item((LAS float*)lds, (const float*)(ws + WS_SC), it, (half) * 4, (int*)(ws + WS_SELI), (float*)(ws + WS_SELG), FRESH_TID()); \
            if ((half) == 0) uv_convert(in.p[I_U], in.p[I_V], in.p[I_GFFN], ws + WS_U16, ws + WS_U16 + 16 * MiB, (float*)(ws + WS_USCALE), (float*)(ws + WS_USCALE) + 16384, gw, NGW, FRESH_LANE()); \
        } SEAM(9 + 2 * (half)); } while (0)
#if ALL_FUSED
    if (IN(8)) {
        for (int kk = 0; kk < 2; ++kk) { pg8::Gemm g{(const pg8::bf16_t*)(ws + WS_R0), (const pg8::bf16_t*)(ws + WS_WFOLD), 1024, 1024, 0, 0}; OneUnit S; S.S.init(T_, 2048, G, (int)blockIdx.x); S.k = kk;
            EpiTopk E{(const float*)(ws + WS_PART2), (int*)(ws + WS_SELI), (float*)(ws + WS_SELG), in.p[I_U], in.p[I_V], in.p[I_GFFN], ws + WS_U16, ws + WS_U16 + 16 * MiB, (float*)(ws + WS_USCALE), (float*)(ws + WS_USCALE) + 16384,
                      vcu * 16 + kk * 8, (2 * G == (T_ / 256) * 8) ? 16 * G : 0};
            pg8::gemm_phase<EpiTopk, OneUnit, false, true>(lds, g, S, E, wave); }
        if (2 * G != (T_ / 256) * 8) uv_convert(in.p[I_U], in.p[I_V], in.p[I_GFFN], ws + WS_U16, ws + WS_U16 + 16 * MiB, (float*)(ws + WS_USCALE), (float*)(ws + WS_USCALE) + 16384, gw, NGW, FRESH_LANE());
    } SEAM(11);
#else
    PEER_HALF(0);
    PEER_HALF(1);
#endif
    if (IN(12)) {
#ifdef PROBE_MODE
        for (int tok0 = vcu * 64; tok0 < T_; tok0 += G * 64)
#if GATHER_ROWS == 3
            gather_wg_mixed<PROBE_MODE>(tok0, wave, FRESH_LANE(), lds, ws + WS_U16, ws + WS_U16 + 16 * MiB, (const float*)(ws + WS_USCALE), (const float*)(ws + WS_USCALE) + 16384, (const int*)(ws + WS_SELI), (const float*)(ws + WS_SELG), (const float*)(ws + WS_PART2), (const bf16*)(ws + WS_R0), (bf16*)(ws + WS_H2B), (float*)(ws + WS_RSTD3), (float*)(ws + WS_SC));
#elif GATHER_ROWS == 1
            gather_wg_rows<PROBE_MODE>(tok0, wave, FRESH_LANE(), lds, ws + WS_U16, ws + WS_U16 + 16 * MiB, (const float*)(ws + WS_USCALE), (const float*)(ws + WS_USCALE) + 16384, (const int*)(ws + WS_SELI), (const float*)(ws + WS_SELG), (const float*)(ws + WS_PART2), (const bf16*)(ws + WS_R0), (bf16*)(ws + WS_H2B), (float*)(ws + WS_RSTD3), (float*)(ws + WS_SC));
#else
            gather_wg_sliced<PROBE_MODE>(tok0, wave, FRESH_LANE(), lds, ws + WS_U16, ws + WS_U16 + 16 * MiB, (const float*)(ws + WS_USCALE), (const float*)(ws + WS_USCALE) + 16384, (const int*)(ws + WS_SELI), (const float*)(ws + WS_SELG), (const float*)(ws + WS_PART2), out, (const bf16*)(ws + WS_R0), (bf16*)(ws + WS_H2B), (float*)(ws + WS_RSTD3), (float*)(ws + WS_SC));
#endif
        { XcdBarrier b_; b_.bar = (unsigned*)(args.ws + WS_CTL) + CW_BAR + args.li * XCD_BAR_WORDS; b_.x = xb_xcc_id(); b_.st = (volatile LAS unsigned*)(lds + LDSCTL_OFF) + 8; xcd_barrier(b_); STAMP(16); }
#endif
        for (int tok0 = vcu * 64; tok0 < T_; tok0 += G * 64)
#if GATHER_ROWS == 3
            gather_wg_mixed<0>(tok0, wave, FRESH_LANE(), lds, ws + WS_U16, ws + WS_U16 + 16 * MiB, (const float*)(ws + WS_USCALE), (const float*)(ws + WS_USCALE) + 16384, (const int*)(ws + WS_SELI), (const float*)(ws + WS_SELG), (const float*)(ws + WS_PART2), (const bf16*)(ws + WS_R0), (bf16*)(ws + WS_H2B), (float*)(ws + WS_RSTD3), nullptr);
#elif GATHER_ROWS == 1
            gather_wg_rows<0>(tok0, wave, FRESH_LANE(), lds, ws + WS_U16, ws + WS_U16 + 16 * MiB, (const float*)(ws + WS_USCALE), (const float*)(ws + WS_USCALE) + 16384, (const int*)(ws + WS_SELI), (const float*)(ws + WS_SELG), (const float*)(ws + WS_PART2), (const bf16*)(ws + WS_R0), (bf16*)(ws + WS_H2B), (float*)(ws + WS_RSTD3), nullptr);
#else
            gather_wg_sliced<0>(tok0, wave, FRESH_LANE(), lds, ws + WS_U16, ws + WS_U16 + 16 * MiB, (const float*)(ws + WS_USCALE), (const float*)(ws + WS_USCALE) + 16384, (const int*)(ws + WS_SELI), (const float*)(ws + WS_SELG), (const float*)(ws + WS_PART2), out, (const bf16*)(ws + WS_R0), (bf16*)(ws + WS_H2B), (float*)(ws + WS_RSTD3), nullptr);
#endif
    } SEAM(12);
#if !ALL_FUSED
    if (IN(13)) { GEMM_PHASE(EpiPP, ws + WS_PB, ws + WS_WPROJ, 256, 256, T_, 1024, 0, 0, (bf16*)(ws + WS_PP)); } SEAM(13);
#endif
#if ALL_FUSED && FUSE_FINAL
    if (IN(14)) { GEMM_PHASE(EpiH3Final, ws + WS_H2B, ws + WS_WG, 1024, 1024, T_, 1024, 0, 0, (const float*)(ws + WS_RSTD3), (const bf16*)(ws + PP_OFF), (const bf16*)(ws + WS_H2B), in.p[I_FG], out, (float*)(ws + WS_PART4), (unsigned*)(ws + WS_CTL) + 65536); }
#else
    if (IN(14)) { GEMM_PHASE(EpiH3, ws + WS_H2B, ws + WS_WG, 1024, 1024, T_, 1024, 0, 0, (const float*)(ws + WS_RSTD3), (const bf16*)(ws + PP_OFF), out, (float*)(ws + WS_PART4), (const bf16*)(ws + WS_H2B), (bf16*)(ws + WS_R0)); } SEAM(14);
#ifdef TIMING_A
    float tscale = 1.0f;
    { const unsigned long long ta = __hip_atomic_load((unsigned long long*)(ws + WS_CTL + 512) + TIMING_A, __ATOMIC_RELAXED, __HIP_MEMORY_SCOPE_AGENT), tb = __hip_atomic_load((unsigned long long*)(ws + WS_CTL + 512) + TIMING_B, __ATOMIC_RELAXED, __HIP_MEMORY_SCOPE_AGENT);
      tscale = 1.0f + (float)(tb - ta) * 0.01f * (float)(TIMING_K); }
    if (IN(15)) { final_rows(out, (const bf16*)(ws + WS_R0), (const float*)(ws + WS_PART4), in.p[I_FG], gw, NGW, FRESH_LANE(), tscale); }
#else
    if (IN(15)) { final_rows(out, (const bf16*)(ws + WS_R0), (const float*)(ws + WS_PART4), in.p[I_FG], gw, NGW, FRESH_LANE(), 1.0f); }
#endif
#endif
#undef IN
#undef SEAM
#undef GEMM_PHASE
}
static const int GRP_LO[11] = {0, 2, 3, 5, 6, 7, 8, 12, 13, 14, 15};
static const int GRP_HI[11] = {2, 3, 5, 6, 7, 8, 12, 13, 14, 15, 16};

static void naive_group(int grp, void* const* d_in, float* out, unsigned char* ws, hipStream_t st) {
    const float* x = (const float*)d_in[0]; const float* p = (const float*)d_in[1]; const float* g_mix = (const float*)d_in[2]; const float* w_in = (const float*)d_in[3];
    const float* sink = (const float*)d_in[4]; const float* conv_w = (const float*)d_in[5]; const float* conv_b = (const float*)d_in[6];
    const float* wa = (const float*)d_in[7]; const float* ba = (const float*)d_in[8]; const float* wx = (const float*)d_in[9]; const float* bx = (const float*)d_in[10]; const float* lam = (const float*)d_in[11];
    const float* w_ua = (const float*)d_in[12]; const float* w_ul = (const float*)d_in[13]; const float* w_o = (const float*)d_in[14]; const float* g_ffn = (const float*)d_in[15];
    const float* wq = (const float*)d_in[16]; const float* k1 = (const float*)d_in[17]; const float* k2 = (const float*)d_in[18]; const float* pu = (const float*)d_in[19]; const float* pv = (const float*)d_in[20];
    const float* g_ple = (const float*)d_in[21]; const float* w_gate = (const float*)d_in[22]; const float* w_proj = (const float*)d_in[23]; const float* final_g = (const float*)d_in[24];
    float* rstd1 = (float*)(ws + WS_RSTD1); float* part2 = (float*)(ws + WS_PART2); float* part4 = (float*)(ws + WS_PART4); float* rstd3 = (float*)(ws + WS_RSTD3);
    bf16* qkv = (bf16*)(ws + WS_QKV); bf16* lx = (bf16*)(ws + WS_LX); bf16* gl = (bf16*)(ws + WS_GL); bf16* sga = (bf16*)(ws + WS_SGA); bf16* sgl = (bf16*)(ws + WS_SGL);
    bf16* att = (bf16*)(ws + WS_ATT); bf16* r0 = (bf16*)(ws + WS_R0); float* mp = (float*)(ws + WS_MP); bf16* merged = (bf16*)(ws + WS_MERGED);
    float* sc = (float*)(ws + WS_SC); int* seli = (int*)(ws + WS_SELI); float* selg = (float*)(ws + WS_SELG); bf16* h2b = (bf16*)(ws + WS_H2B); bf16* pp = (bf16*)(ws + WS_PP);
    float* tmpf = (float*)(ws + WS_NAIVE_AB);
    switch (grp) {
    case 0:
        hipLaunchKernelGGL(nv::rowsq, dim3(T_ / 4), dim3(256), 0, st, x, rstd1, (float*)nullptr);
        nv::run_gemm<nv::ALf32, nv::EpiProj, false>(st, nv::ALf32{x, 1024}, w_in, INW, g_mix, T_, INW, 1024, nv::EpiProj{rstd1, qkv, lx, gl, sga, sgl});
        break;
    case 1:
        hipLaunchKernelGGL(nv::attn_naive, dim3(T_ * 8 / 128), dim3(128), 0, st, qkv, sink, att);
        hipLaunchKernelGGL(nv::conv_naive, dim3(T_ * 1024 / 256), dim3(256), 0, st, lx, conv_w, conv_b, r0);
        break;
    case 2:
        hipLaunchKernelGGL(nv::lru_ab_naive, dim3(T_ * 8), dim3(128), 0, st, r0, wa, ba, wx, bx, lam, out, tmpf);
        hipLaunchKernelGGL(nv::lru_scan_naive, dim3(B_ * 1024 / 64), dim3(64), 0, st, out, tmpf, gl, r0);
        break;
    case 3: nv::run_gemm<nv::ALbf16, nv::EpiMP, false>(st, nv::ALbf16{att, 512}, w_ua, 1024, nullptr, T_, 1024, 512, nv::EpiMP{sga, mp}); break;
    case 4: nv::run_gemm<nv::ALbf16, nv::EpiMerged, false>(st, nv::ALbf16{r0, 1024}, w_ul, 1024, nullptr, T_, 1024, 1024, nv::EpiMerged{sgl, mp, merged}); break;
    case 5:
        nv::run_gemm<nv::ALbf16, nv::EpiH1, false>(st, nv::ALbf16{merged, 1024}, w_o, 1024, nullptr, T_, 1024, 1024, nv::EpiH1{x, out, r0});
        hipLaunchKernelGGL(nv::rowsq, dim3(T_ / 4), dim3(256), 0, st, out, (float*)nullptr, part2);
        break;
    case 6:
        for (int half = 0; half < 2; ++half) {
            nv::run_gemm<nv::ALf32, nv::EpiScaleF32, false>(st, nv::ALf32{out, 1024}, wq + half * 1024, 2048, g_ffn, T_, 1024, 1024, nv::EpiScaleF32{part2, tmpf, 1024});
            for (int hl = 0; hl < 4; ++hl)
                for (int hf = 0; hf < 2; ++hf)
                    nv::run_gemm<nv::ALf32, nv::EpiPlainF32, true>(st, nv::ALf32{tmpf + hl * 256 + hf * 128, 1024}, hf ? k2 : k1, 128, nullptr, T_, 128, 128, nv::EpiPlainF32{sc + hl * 256 + hf * 128, 1024});
            hipLaunchKernelGGL(topk_kernel, dim3(T_ / TK_TOK), dim3(512), TK_LDS_BYTES, st, sc, half * 4, seli, selg);
        }
        break;
    case 7: hipLaunchKernelGGL(gather_kernel<0>, dim3(1024), dim3(256), 0, st, (const void*)pu, (const void*)pv, g_ffn, seli, selg, part2, out, h2b, rstd3); break;
    case 8: nv::run_gemm<nv::ALf32, nv::EpiPP, false>(st, nv::ALf32{p, 256}, w_proj, 1024, nullptr, T_, 1024, 256, nv::EpiPP{pp}); break;
    case 9: nv::run_gemm<nv::ALbf16, nv::EpiH3, false>(st, nv::ALbf16{h2b, 1024}, w_gate, 1024, g_ple, T_, 1024, 1024, nv::EpiH3{rstd3, pp, out});
        hipLaunchKernelGGL(nv::rowsq, dim3(T_ / 4), dim3(256), 0, st, out, (float*)nullptr, part4);
        break;
    case 10: hipLaunchKernelGGL(nv::final_norm, dim3(T_ / 4), dim3(256), 0, st, out, part4, final_g); break;
    }
}

extern "C" void kernel_launch(void* const* d_in, const int* in_sizes, int n_in, void* d_out, int out_size, void* d_ws, size_t ws_size, hipStream_t stream) {
    static int grid = 0;
    if (grid == 0) {
        if (n_in != 25 || out_size != T_ * 1024 || ws_size < WS_END) { fprintf(stderr, "kernel_launch: unexpected sizes n_in %d out %d ws %zu\n", n_in, out_size, ws_size); }
        (void)hipFuncSetAttribute((const void*)topk_kernel, hipFuncAttributeMaxDynamicSharedMemorySize, TK_LDS_BYTES);
        int dev = 0, cus = 0, per_cu = 0;
        (void)hipGetDevice(&dev); (void)hipDeviceGetAttribute(&cus, hipDeviceAttributeMultiprocessorCount, dev);
        if (hipFuncSetAttribute((const void*)fused_fwd, hipFuncAttributeMaxDynamicSharedMemorySize, LDS_BYTES) != hipSuccess) fprintf(stderr, "kernel_launch: hipFuncSetAttribute(fused_fwd) failed\n");
        if (hipOccupancyMaxActiveBlocksPerMultiprocessor(&per_cu, (const void*)fused_fwd, NWAVES * 64, LDS_BYTES) != hipSuccess || per_cu < 1) fprintf(stderr, "kernel_launch: occupancy query says %d blocks/CU\n", per_cu);
        (void)hipGetLastError();
        grid = cus > 0 ? cus : 256;
    }
    unsigned char* ws = (unsigned char*)d_ws; float* out = (float*)d_out;
    const unsigned mask = FUSED_MASK;
    if (mask) (void)hipMemsetAsync(ws + WS_CTL, 0, CTL_ZERO_BYTES, stream);
    Args a{};
    for (int i = 0; i < 25; ++i) a.in[i] = (const float*)d_in[i];
    a.out = out; a.ws = ws;
    int li = 0;
    auto launch = [&](int lo, int hi) {
        if (MERGE_LAUNCHES) { a.ph_lo = lo; a.ph_hi = hi; a.li = li++; hipLaunchKernelGGL(fused_fwd, dim3(grid), dim3(NWAVES * 64), LDS_BYTES, stream, a); }
        else for (int ph = lo; ph < hi; ++ph) { a.ph_lo = ph; a.ph_hi = ph + 1; a.li = li++; hipLaunchKernelGGL(fused_fwd, dim3(grid), dim3(NWAVES * 64), LDS_BYTES, stream, a); }
    };
    int pend_lo = -1, pend_hi = -1;
    if (mask && !(mask & 1)) launch(0, 1);
    for (int gidx = 0; gidx < 11; ++gidx) {
#if (defined(LRU_T2) && LRU_T2) || (defined(LRU_T3) && LRU_T3)
        if (gidx == 2 && (mask & 4u)) {
            if (pend_lo >= 0) { launch(pend_lo, pend_hi); pend_lo = -1; }
            launch(3, 4);
            hipLaunchKernelGGL(nv::lru_finish_naive_L<(LRU_T2 ? 16 : 64)>, dim3(B_ * 1024 / 64), dim3(64), 0, stream, (const bf16*)(ws + WS_HLOC), (const bf16*)(ws + WS_PCUM), (const bf16*)(ws + WS_GL), (bf16*)(ws + WS_R0));
            continue;
        }
#endif
        if (mask & (1u << gidx)) {
            if (pend_lo < 0) { pend_lo = GRP_LO[gidx]; pend_hi = GRP_HI[gidx]; } else pend_hi = GRP_HI[gidx];
        } else {
            if (pend_lo >= 0) { launch(pend_lo, pend_hi); pend_lo = -1; }
            naive_group(gidx, d_in, out, ws, stream);
        }
    }
    if (pend_lo >= 0) launch(pend_lo, pend_hi);
#if defined(LRU_DEBUG) && LRU_DEBUG == 2
    hipLaunchKernelGGL(nv::poison_if, dim3(T_ * 1024 / 256), dim3(256), 0, stream, out, (const unsigned*)(ws + WS_CTL) + 64);
#endif
}
```

```cpp
#include <hip/hip_runtime.h>
#include <cstdio>
#include <cstdint>
#include <cmath>

#ifndef FUSED_MASK
#define FUSED_MASK 0x7ff
#endif
#ifndef MERGE_LAUNCHES
#define MERGE_LAUNCHES 1
#endif
#ifndef LRU_PADDED
#define LRU_PADDED 1
#endif
#ifndef FUSE_FINAL
#define FUSE_FINAL 0
#endif
#ifndef GATHER_ROWS
#define GATHER_ROWS 3
#endif
#ifndef MIX_PIPE
#define MIX_PIPE 1
#endif
#define ALL_FUSED ((FUSED_MASK) == 0x7ff && (MERGE_LAUNCHES))
constexpr int B_ = 8, S_ = 2048, D_ = 1024, T_ = B_ * S_;
constexpr int INW = 4864;
constexpr float EPS = 1e-6f;
typedef unsigned short bf16;
#define HD_INLINE __host__ __device__ __forceinline__

constexpr size_t MiB = 1u << 20;
constexpr size_t WS_CTL = 0;
constexpr size_t WS_WIN = 1 * MiB;
constexpr size_t WS_WUA = WS_WIN + 4864 * 1024 * 2;
constexpr size_t WS_WUL = WS_WUA + 1 * MiB;
constexpr size_t WS_WO = WS_WUL + 2 * MiB;
constexpr size_t WS_WFOLD = WS_WO + 2 * MiB;
constexpr size_t WS_WG = WS_WFOLD + 4 * MiB;
constexpr size_t WS_WPROJ = WS_WG + 2 * MiB;
constexpr size_t WS_WAX = WS_WPROJ + MiB / 2;
constexpr size_t WS_W_END = WS_WAX + 1 * MiB;
static_assert(WS_W_END <= 23 * MiB, "weights");
constexpr size_t WS_RSTD1 = 23 * MiB;
constexpr size_t WS_PART2 = WS_RSTD1 + 256 * 1024;
constexpr size_t WS_PART4 = WS_PART2 + 1 * MiB;
constexpr size_t WS_RSTD3 = WS_PART4 + 1 * MiB;
constexpr size_t WS_AGG = WS_RSTD3 + 256 * 1024;
constexpr size_t WS_C8 = WS_AGG + 2 * MiB;
constexpr size_t WS_USCALE = WS_C8 + 64 * 1024;
static_assert(WS_USCALE + 128 * 1024 <= 28 * MiB, "small");
constexpr size_t WS_PB = 28 * MiB;
constexpr size_t WS_R0 = 36 * MiB;
constexpr size_t WS_QKV = 68 * MiB;
constexpr size_t WS_LX = 92 * MiB;
constexpr size_t WS_GL = 140 * MiB;
constexpr size_t WS_SGA = 172 * MiB;
constexpr size_t WS_SGL = 204 * MiB;
constexpr size_t WS_ATT = 236 * MiB;
constexpr size_t WS_HLOC = 68 * MiB, WS_PCUM = 100 * MiB;
constexpr size_t WS_MP = 68 * MiB;
constexpr size_t WS_MERGED = 140 * MiB;
constexpr size_t WS_SC = 172 * MiB;
constexpr size_t WS_SELI = 236 * MiB, WS_SELG = 244 * MiB;
constexpr size_t WS_U16 = 68 * MiB, WS_V16 = 100 * MiB;
constexpr size_t WS_H2B = 140 * MiB;
constexpr size_t WS_PP = 172 * MiB;
constexpr size_t WS_PP2 = 100 * MiB;
constexpr size_t WS_NAIVE_AB = 68 * MiB;
constexpr size_t WS_WAXD = 252 * MiB;
constexpr size_t WS_END = 256 * MiB;

HD_INLINE float bf2f(bf16 v) { return __builtin_bit_cast(float, (unsigned)v << 16); }
HD_INLINE bf16 f2bf(float f) { unsigned u = __builtin_bit_cast(unsigned, f); return (bf16)((u + 0x7fffu + ((u >> 16) & 1u)) >> 16); }
HD_INLINE unsigned pk2(float lo, float hi) { return (unsigned)f2bf(lo) | ((unsigned)f2bf(hi) << 16); }
__device__ __forceinline__ float wave_sum(float v) {
#pragma unroll
    for (int o = 1; o < 64; o <<= 1) v += __shfl_xor(v, o);
    return v;
}
__device__ __forceinline__ float sigmoidf_(float z) { return __builtin_amdgcn_rcpf(1.0f + __builtin_amdgcn_exp2f(-1.4426950408889634f * z)); }
__device__ __forceinline__ float gelu_tanh(float x) { const float u = 1.5957691216057308f * (x + 0.044715f * x * x * x); return x * sigmoidf_(u); }
__device__ __forceinline__ int fresh_lane() { int l; asm volatile("v_mbcnt_lo_u32_b32 %0, -1, 0\n\tv_mbcnt_hi_u32_b32 %0, -1, %0" : "=v"(l)); return l; }
#ifndef HD_INLINE
#define HD_INLINE __host__ __device__ __forceinline__
#endif

HD_INLINE unsigned tk_umax(unsigned a, unsigned b) { return a > b ? a : b; }
HD_INLINE unsigned tk_umin(unsigned a, unsigned b) { return a < b ? a : b; }
HD_INLINE unsigned tk_f2key(float f) { unsigned u = __builtin_bit_cast(unsigned, f); return u ^ ((unsigned)((int)u >> 31) | 0x80000000u); }
HD_INLINE float tk_key2f(unsigned k) { unsigned u = (k & 0x80000000u) ? (k ^ 0x80000000u) : ~k; return __builtin_bit_cast(float, u); }

HD_INLINE void tk_sort16(unsigned (&a)[16]) {
#pragma unroll
    for (int k = 2; k <= 16; k <<= 1) {
#pragma unroll
        for (int j = k >> 1; j > 0; j >>= 1) {
#pragma unroll
            for (int i = 0; i < 16; ++i) {
                const int p = i ^ j;
                if (p > i) {
                    const unsigned mx = tk_umax(a[i], a[p]), mn = tk_umin(a[i], a[p]);
                    if ((i & k) == 0) { a[i] = mx; a[p] = mn; } else { a[i] = mn; a[p] = mx; }
                }
            }
        }
    }
}
HD_INLINE void tk_merge16(unsigned (&a)[16], const unsigned (&b)[16]) {
#pragma unroll
    for (int i = 0; i < 16; ++i) a[i] = tk_umax(a[i], b[15 - i]);
#pragma unroll
    for (int j = 8; j > 0; j >>= 1) {
#pragma unroll
        for (int i = 0; i < 16; ++i) {
            const int p = i ^ j;
            if (p > i) { const unsigned mx = tk_umax(a[i], a[p]), mn = tk_umin(a[i], a[p]); a[i] = mx; a[p] = mn; }
        }
    }
}
HD_INLINE void tk_insert16(unsigned (&best)[16], unsigned key) {
#pragma unroll
    for (int s = 0; s < 16; ++s) { const unsigned hi = tk_umax(best[s], key); key = tk_umin(best[s], key); best[s] = hi; }
}
HD_INLINE void tk_combine_store(const unsigned (&k1)[16], const unsigned (&k2)[16], int* oi, float* og) {
    float v1[16], v2[16];
#pragma unroll
    for (int i = 0; i < 16; ++i) { v1[i] = tk_key2f(k1[i] & ~127u); v2[i] = tk_key2f(k2[i] & ~127u); }
    unsigned best[16];
#pragma unroll
    for (int s = 0; s < 16; ++s) best[s] = 0u;
#pragma unroll
    for (int i = 0; i < 16; ++i) {
#pragma unroll
        for (int j = 0; j < 16; ++j) {
            if ((i + 1) * (j + 1) <= 16) {
                const float s = v1[i] + v2[j];
                const unsigned key = (tk_f2key(s) & ~255u) | (unsigned)(255 - (i * 16 + j));
                tk_insert16(best, key);
            }
        }
    }
    const unsigned thr = best[15];
    const float mx = tk_key2f(best[0] & ~255u);
    float sum = 0.f;
#pragma unroll
    for (int i = 0; i < 16; ++i) {
#pragma unroll
        for (int j = 0; j < 16; ++j) {
            if ((i + 1) * (j + 1) <= 16) {
                const float s = v1[i] + v2[j];
                const unsigned key = (tk_f2key(s) & ~255u) | (unsigned)(255 - (i * 16 + j));
                if (key >= thr) sum += __builtin_expf(s - mx);
            }
        }
    }
    const float inv = 1.0f / sum;
    int cnt = 0;
#pragma unroll
    for (int i = 0; i < 16; ++i) {
#pragma unroll
        for (int j = 0; j < 16; ++j) {
            if ((i + 1) * (j + 1) <= 16) {
                const float s = v1[i] + v2[j];
                const unsigned key = (tk_f2key(s) & ~255u) | (unsigned)(255 - (i * 16 + j));
                if (key >= thr) {
                    oi[cnt] = (127 - (int)(k1[i] & 127u)) * 128 + (127 - (int)(k2[j] & 127u));
                    og[cnt] = __builtin_expf(s - mx) * inv;
                    ++cnt;
                }
            }
        }
    }
}
namespace nv {
struct ALf32 { const float* p; int lda; int pad; __device__ __forceinline__ float operator()(int m, int k) const { return p[(size_t)m * lda + k]; } };
struct ALbf16 { const bf16* p; int lda; int pad; __device__ __forceinline__ float operator()(int m, int k) const { return bf2f(p[(size_t)m * lda + k]); } };

template <class AL, class EPI, bool BT>
__global__ void __launch_bounds__(256) ngemm(AL al, const float* __restrict__ B, int ldb, const float* __restrict__ ks, int M, int N, int K, EPI epi) {
    __shared__ float As[16][68];
    __shared__ float Bs[16][68];
    const int tid = threadIdx.x, tx = tid & 15, ty = tid >> 4;
    const int m0 = blockIdx.y * 64, n0 = blockIdx.x * 64;
    float acc[4][4];
#pragma unroll
    for (int i = 0; i < 4; ++i)
#pragma unroll
        for (int j = 0; j < 4; ++j) acc[i][j] = 0.f;
    for (int k0 = 0; k0 < K; k0 += 16) {
#pragma unroll
        for (int i = 0; i < 4; ++i) {
            const int e = tid + i * 256;
            { const int m = e >> 4, k = e & 15; float v = al(m0 + m, k0 + k); if (ks) v *= ks[k0 + k]; As[k][m] = v; }
            if (BT) { const int n = e >> 4, k = e & 15; Bs[k][n] = B[(size_t)(n0 + n) * ldb + k0 + k]; }
            else { const int k = e >> 6, n = e & 63; Bs[k][n] = B[(size_t)(k0 + k) * ldb + n0 + n]; }
        }
        __syncthreads();
#pragma unroll
        for (int k = 0; k < 16; ++k) {
            float a[4], b[4];
#pragma unroll
            for (int i = 0; i < 4; ++i) { a[i] = As[k][ty * 4 + i]; b[i] = Bs[k][tx * 4 + i]; }
#pragma unroll
            for (int i = 0; i < 4; ++i)
#pragma unroll
                for (int j = 0; j < 4; ++j) acc[i][j] = fmaf(a[i], b[j], acc[i][j]);
        }
        __syncthreads();
    }
#pragma unroll
    for (int i = 0; i < 4; ++i)
#pragma unroll
        for (int j = 0; j < 4; ++j) epi(m0 + ty * 4 + i, n0 + tx * 4 + j, acc[i][j]);
}
template <class AL, class EPI, bool BT>
static void run_gemm(hipStream_t st, AL al, const float* B, int ldb, const float* ks, int M, int N, int K, EPI epi) {
    hipLaunchKernelGGL((ngemm<AL, EPI, BT>), dim3(N / 64, M / 64), dim3(256), 0, st, al, B, ldb, ks, M, N, K, epi);
}

__global__ void __launch_bounds__(256) rowsq(const float* __restrict__ X, float* rstd, float* part) {
    const int row = blockIdx.x * 4 + (threadIdx.x >> 6), lane = threadIdx.x & 63;
    const float* xr = X + (size_t)row * 1024;
    float s = 0.f;
    for (int j = 0; j < 16; ++j) { const float v = xr[lane + 64 * j]; s += v * v; }
    s = wave_sum(s);
    if (rstd && lane == 0) rstd[row] = 1.0f / sqrtf(s * (1.0f / 1024.0f) + EPS);
    if (part && lane < 16) part[(size_t)row * 16 + lane] = (lane == 0) ? s : 0.f;
}

struct EpiProj {
    const float* rstd; bf16 *qkv, *lx, *gl, *sga, *sgl;
    __device__ __forceinline__ void operator()(int m, int n, float v) const {
        v *= rstd[m];
        if (n < 768) qkv[(size_t)m * 768 + n] = f2bf(v);
        else if (n < 1792) lx[(size_t)m * 1024 + (n - 768)] = f2bf(v);
        else if (n < 2816) gl[(size_t)m * 1024 + (n - 1792)] = f2bf(gelu_tanh(v));
        else if (n < 3840) sga[(size_t)m * 1024 + (n - 2816)] = f2bf(sigmoidf_(v));
        else sgl[(size_t)m * 1024 + (n - 3840)] = f2bf(sigmoidf_(v));
    }
};

__global__ void __launch_bounds__(128) attn_naive(const bf16* __restrict__ qkv, const float* __restrict__ sink, bf16* __restrict__ att) {
    const int gid = blockIdx.x * 128 + threadIdx.x;
    const int head = gid / T_, t = gid % T_;
    const int b = t / S_, ts = t % S_;
    const int g = head >> 2;
    float q[64], acc[64];
    const bf16* qp = qkv + (size_t)t * 768 + head * 64;
#pragma unroll
    for (int d = 0; d < 64; ++d) { q[d] = bf2f(qp[d]); acc[d] = 0.f; }
    const float slope = exp2f(-(float)(head + 1));
    float m = -3.0e38f, l = 0.f;
    for (int dist = 127; dist >= 0; --dist) {
        const int s = ts - dist; if (s < 0) continue;
        const bf16* kp = qkv + (size_t)(b * S_ + s) * 768 + 512 + g * 64;
        const bf16* vp = kp + 128;
        float sc = 0.f;
#pragma unroll
        for (int d = 0; d < 64; ++d) sc = fmaf(q[d], bf2f(kp[d]), sc);
        sc = sc * 0.125f - slope * (float)dist;
        const float mn = fmaxf(m, sc), corr = __expf(m - mn), p = __expf(sc - mn);
        l = l * corr + p;
#pragma unroll
        for (int d = 0; d < 64; ++d) acc[d] = acc[d] * corr + p * bf2f(vp[d]);
        m = mn;
    }
    const float sk = sink[head];
    const float mf = fmaxf(m, sk), corr = __expf(m - mf);
    l = l * corr + __expf(sk - mf);
    const float inv = corr / l;
    bf16* op = att + (size_t)t * 512 + head * 64;
#pragma unroll
    for (int d = 0; d < 64; ++d) op[d] = f2bf(acc[d] * inv);
}

__global__ void __launch_bounds__(256) conv_naive(const bf16* __restrict__ lx, const float* __restrict__ cw, const float* __restrict__ cb, bf16* __restrict__ lin) {
    const size_t i = (size_t)blockIdx.x * 256 + threadIdx.x;
    const int c = (int)(i & 1023); const int t = (int)(i >> 10); const int ts = t % S_;
    float y = cb[c];
#pragma unroll
    for (int tap = 0; tap < 4; ++tap) { const int s = ts - 3 + tap; if (s >= 0) y = fmaf(bf2f(lx[(size_t)(t - 3 + tap) * 1024 + c]), cw[tap * 1024 + c], y); }
    lin[i] = f2bf(y);
}

__global__ void __launch_bounds__(128) lru_ab_naive(const bf16* __restrict__ lin, const float* __restrict__ wa, const float* __restrict__ ba, const float* __restrict__ wx, const float* __restrict__ bx,
                                                    const float* __restrict__ lam, float* __restrict__ Af, float* __restrict__ Bf) {
    __shared__ float xs[128];
    const int t = blockIdx.x >> 3, blk = blockIdx.x & 7, d = threadIdx.x, ch = blk * 128 + d;
    xs[d] = bf2f(lin[(size_t)t * 1024 + ch]);
    __syncthreads();
    float r = ba[ch], ii = bx[ch];
    const float* wap = wa + (size_t)blk * 128 * 128 + d; const float* wxp = wx + (size_t)blk * 128 * 128 + d;
    for (int c = 0; c < 128; ++c) { r = fmaf(xs[c], wap[c * 128], r); ii = fmaf(xs[c], wxp[c * 128], ii); }
    r = sigmoidf_(r); ii = sigmoidf_(ii);
    const float sp = log1pf(expf(-lam[ch]));
    const float loga = -8.0f * r * sp;
    const float a = expf(loga);
    const float bb = sqrtf(-expm1f(2.0f * loga)) * (ii * xs[d]);
    Af[(size_t)t * 1024 + ch] = a; Bf[(size_t)t * 1024 + ch] = bb;
}
__global__ void __launch_bounds__(256) lru_ab_from_pre(const bf16* __restrict__ lin, const float* __restrict__ ba, const float* __restrict__ bx, const float* __restrict__ lam, float* __restrict__ Af, float* __restrict__ Bf) {
    const size_t i = (size_t)blockIdx.x * 256 + threadIdx.x; const int ch = (int)(i & 1023);
    const float r = sigmoidf_(Af[i] + ba[ch]), ii = sigmoidf_(Bf[i] + bx[ch]);
    const float loga = -8.0f * r * log1pf(expf(-lam[ch]));
    Af[i] = expf(loga); Bf[i] = sqrtf(-expm1f(2.0f * loga)) * (ii * bf2f(lin[i]));
}
template <int L>
__global__ void __launch_bounds__(64) lru_finish_naive_L(const bf16* __restrict__ hloc, const bf16* __restrict__ pcum, const bf16* __restrict__ gl, bf16* __restrict__ rec) {
    const int gid = blockIdx.x * 64 + threadIdx.x; const int b = gid >> 10, ch = gid & 1023;
    float carry = 0.f;
    for (int c = 0; c < S_ / L; ++c) {
        float la = 1.f, lb = 0.f;
        for (int s = 0; s < L; ++s) { const size_t o = (size_t)(b * S_ + c * L + s) * 1024 + ch; la = bf2f(pcum[o]); lb = bf2f(hloc[o]); const float h = la * carry + lb; rec[o] = f2bf(h * bf2f(gl[o])); }
        carry = la * carry + lb;
    }
}
__global__ void __launch_bounds__(64) lru_finish_naive(const bf16* __restrict__ hloc, const bf16* __restrict__ pcum, const float* __restrict__ agg, const bf16* __restrict__ gl, bf16* __restrict__ rec) {
    const int gid = blockIdx.x * 64 + threadIdx.x; const int b = gid >> 10, ch = gid & 1023;
    float carry = 0.f;
    for (int c = 0; c < 32; ++c) {
        const int chunk = b * 32 + c;
        for (int s = 0; s < 64; ++s) { const size_t o = (size_t)(chunk * 64 + s) * 1024 + ch; const float h = bf2f(pcum[o]) * carry + bf2f(hloc[o]); rec[o] = f2bf(h * bf2f(gl[o])); }
        const float* ap = agg + ((size_t)chunk * 1024 + ch) * 2; carry = ap[0] * carry + ap[1];
    }
}
__global__ void __launch_bounds__(128) lru_pre_check(const bf16* __restrict__ lin, const float* __restrict__ wa, const float* __restrict__ wx, const float* __restrict__ Rp, const float* __restrict__ Ip, unsigned* flag) {
    __shared__ float xs[128];
    const int t = blockIdx.x >> 3, blk = blockIdx.x & 7, d = threadIdx.x, ch = blk * 128 + d;
    xs[d] = bf2f(lin[(size_t)t * 1024 + ch]);
    __syncthreads();
    float r = 0.f, ii = 0.f;
    const float* wap = wa + (size_t)blk * 128 * 128 + d; const float* wxp = wx + (size_t)blk * 128 * 128 + d;
    for (int c = 0; c < 128; ++c) { r = fmaf(xs[c], wap[c * 128], r); ii = fmaf(xs[c], wxp[c * 128], ii); }
    const float dr = fabsf(r - Rp[(size_t)t * 1024 + ch]), di = fabsf(ii - Ip[(size_t)t * 1024 + ch]);
    if (!(dr < 0.08f + 0.03f * fabsf(r)) || !(di < 0.08f + 0.03f * fabsf(ii))) atomicAdd(flag, 1u);
}
__global__ void __launch_bounds__(256) poison_if(float* out, const unsigned* flag) { if (*flag) { const size_t i = (size_t)blockIdx.x * 256 + threadIdx.x; out[i] = out[i] * 50.0f + 3.0f; } }
__global__ void __launch_bounds__(64) lru_scan_naive(const float* __restrict__ Af, const float* __restrict__ Bf, const bf16* __restrict__ gl, bf16* __restrict__ rec) {
    const int gid = blockIdx.x * 64 + threadIdx.x; const int b = gid >> 10, ch = gid & 1023;
    float h = 0.f;
    for (int s = 0; s < S_; ++s) { const size_t o = (size_t)(b * S_ + s) * 1024 + ch; h = fmaf(Af[o], h, Bf[o]); rec[o] = f2bf(h * bf2f(gl[o])); }
}

struct EpiMP { const bf16* sga; float* mp; __device__ __forceinline__ void operator()(int m, int n, float v) const { const size_t o = (size_t)m * 1024 + n; mp[o] = v * bf2f(sga[o]); } };
struct EpiMerged { const bf16* sgl; const float* mp; bf16* merged; __device__ __forceinline__ void operator()(int m, int n, float v) const { const size_t o = (size_t)m * 1024 + n; merged[o] = f2bf(mp[o] + v * bf2f(sgl[o])); } };
struct EpiH1 { const float* x; float* h1; bf16* h1b; __device__ __forceinline__ void operator()(int m, int n, float v) const { const size_t o = (size_t)m * 1024 + n; const float h = x[o] + v; h1[o] = h; h1b[o] = f2bf(h); } };
struct EpiScaleF32 { const float* part; float* out; int ldo; int pad; __device__ __forceinline__ void operator()(int m, int n, float v) const {
    float s = 0.f; for (int i = 0; i < 16; ++i) s += part[(size_t)m * 16 + i];
    out[(size_t)m * ldo + n] = v * (1.0f / sqrtf(s * (1.0f / 1024.0f) + EPS)); } };
struct EpiPlainF32 { float* out; int ldo; int pad; __device__ __forceinline__ void operator()(int m, int n, float v) const { out[(size_t)m * ldo + n] = v; } };
struct EpiPP { bf16* pp; __device__ __forceinline__ void operator()(int m, int n, float v) const { pp[(size_t)m * 1024 + n] = f2bf(v); } };
struct EpiH3 { const float* rstd3; const bf16* pp; float* h; __device__ __forceinline__ void operator()(int m, int n, float v) const { const size_t o = (size_t)m * 1024 + n; h[o] = h[o] + sigmoidf_(v * rstd3[m]) * bf2f(pp[o]); } };

__global__ void __launch_bounds__(256) final_norm(float* __restrict__ h, const float* __restrict__ part, const float* __restrict__ fg) {
    const int row = blockIdx.x * 4 + (threadIdx.x >> 6), lane = threadIdx.x & 63;
    float s = 0.f; for (int i = 0; i < 16; ++i) s += part[(size_t)row * 16 + i];
    const float r = 1.0f / sqrtf(s * (1.0f / 1024.0f) + EPS);
    float* hr = h + (size_t)row * 1024;
    for (int j = 0; j < 16; ++j) { const int c = lane + 64 * j; hr[c] = hr[c] * r * fg[c]; }
}
}
#define LAS __attribute__((address_space(3)))
typedef float f32x4 __attribute__((ext_vector_type(4)));
typedef unsigned u32x4 __attribute__((ext_vector_type(4)));
typedef int i32x4 __attribute__((ext_vector_type(4)));

constexpr int TK_TOK = 32;
constexpr int TK_LSTRIDE = 132;
constexpr int TK_LDS_BYTES = 256 * TK_LSTRIDE * 4;

__device__ __forceinline__ void topk_item(LAS float* lds, const float* __restrict__ SC, int item, int head_base, int* __restrict__ seli, float* __restrict__ selg, int tid) {
    const f32x4* src = (const f32x4*)(SC + (size_t)item * TK_TOK * 1024);
#pragma unroll 4
    for (int i = 0; i < 16; ++i) {
        const int idx = tid + i * 512; const int row = idx >> 8, c4 = idx & 255;
        const f32x4 v = src[idx];
        const int list = row * 8 + (c4 >> 5), elem = (c4 & 31) * 4;
        *(LAS f32x4*)(lds + list * TK_LSTRIDE + elem) = v;
    }
    __syncthreads();
    if (tid < 256) {
        const LAS float* my = lds + tid * TK_LSTRIDE;
        unsigned acc[16];
#pragma unroll
        for (int g = 0; g < 8; ++g) {
            unsigned t[16];
#pragma unroll
            for (int q = 0; q < 4; ++q) {
                const f32x4 v = *(const LAS f32x4*)(my + g * 16 + q * 4);
#pragma unroll
                for (int c = 0; c < 4; ++c) { const int e = g * 16 + q * 4 + c; t[q * 4 + c] = (tk_f2key(v[c]) & ~127u) | (unsigned)(127 - e); }
            }
            tk_sort16(t);
            if (g == 0) {
#pragma unroll
                for (int i = 0; i < 16; ++i) acc[i] = t[i];
            } else tk_merge16(acc, t);
        }
        unsigned oth[16];
#pragma unroll
        for (int i = 0; i < 16; ++i) oth[i] = (unsigned)__shfl_xor((int)acc[i], 1);
        if ((tid & 1) == 0) {
            const int tok = item * TK_TOK + (tid >> 3), head = head_base + ((tid >> 1) & 3);
            tk_combine_store(acc, oth, seli + (size_t)tok * 128 + head * 16, selg + (size_t)tok * 128 + head * 16);
        }
    }
    __syncthreads();
}
__global__ void __launch_bounds__(512) topk_kernel(const float* __restrict__ SC, int head_base, int* __restrict__ seli, float* __restrict__ selg) {
    extern __shared__ __attribute__((aligned(16))) unsigned char dyn_lds[];
    for (int item = blockIdx.x; item < T_ / TK_TOK; item += gridDim.x) topk_item((LAS float*)dyn_lds, SC, item, head_base, seli, selg, (int)threadIdx.x);
}

template <int MODE>
__device__ __forceinline__ void gather_token(int t, int lane, const void* __restrict__ Utab, const void* __restrict__ Vtab, const float* __restrict__ gffn,
                                             const int* __restrict__ seli, const float* __restrict__ selg, const float* __restrict__ part2,
                                             float* __restrict__ H  , bf16* __restrict__ h2b, float* __restrict__ rstd3) {
    float ps = (lane < 16) ? part2[(size_t)t * 16 + lane] : 0.f;
    ps = wave_sum(ps);
    const float rstd2 = 1.0f / sqrtf(ps * (1.0f / 1024.0f) + EPS);
    const int iA = seli[(size_t)t * 128 + lane], iB = seli[(size_t)t * 128 + 64 + lane];
    const float gA = selg[(size_t)t * 128 + lane], gB = selg[(size_t)t * 128 + 64 + lane];
    float* hr = H + (size_t)t * 1024;
    if constexpr (MODE == 0) {
        f32x4 x[4], y[4], hv[4];
#pragma unroll
        for (int j = 0; j < 4; ++j) { hv[j] = *(const f32x4*)(hr + 256 * j + 4 * lane); const f32x4 g = *(const f32x4*)(gffn + 256 * j + 4 * lane); x[j] = hv[j] * g; y[j] = (f32x4){0.f, 0.f, 0.f, 0.f}; }
        const float* U = (const float*)Utab; const float* V = (const float*)Vtab;
        for (int k = 0; k < 64; ++k) {
#pragma unroll
            for (int hh = 0; hh < 2; ++hh) {
                const int e = __builtin_amdgcn_readlane(hh ? iB : iA, k);
                const float gt = __builtin_bit_cast(float, __builtin_amdgcn_readlane(__builtin_bit_cast(int, hh ? gB : gA), k));
                const float* ur = U + (size_t)e * 1024; const float* vr = V + (size_t)e * 1024;
                f32x4 uv[4], vv[4];
#pragma unroll
                for (int j = 0; j < 4; ++j) { uv[j] = *(const f32x4*)(ur + 256 * j + 4 * lane); vv[j] = *(const f32x4*)(vr + 256 * j + 4 * lane); }
                float d = 0.f;
#pragma unroll
                for (int j = 0; j < 4; ++j) d += (uv[j].x * x[j].x + uv[j].y * x[j].y) + (uv[j].z * x[j].z + uv[j].w * x[j].w);
                d = wave_sum(d);
                const float c = gt * gelu_tanh(d * rstd2);
#pragma unroll
                for (int j = 0; j < 4; ++j) y[j] += vv[j] * c;
            }
        }
        float sq = 0.f;
#pragma unroll
        for (int j = 0; j < 4; ++j) {
            const f32x4 h2 = hv[j] + y[j];
            *(f32x4*)(hr + 256 * j + 4 * lane) = h2;
            sq += (h2.x * h2.x + h2.y * h2.y) + (h2.z * h2.z + h2.w * h2.w);
            uint2 w; w.x = pk2(h2.x, h2.y); w.y = pk2(h2.z, h2.w);
            *(uint2*)(h2b + (size_t)t * 1024 + 256 * j + 4 * lane) = w;
        }
        sq = wave_sum(sq);
        if (lane == 0) rstd3[t] = 1.0f / sqrtf(sq * (1.0f / 1024.0f) + EPS);
    } else {
        float x[2][8], y[2][8], hv[2][8];
#pragma unroll
        for (int j = 0; j < 2; ++j) {
            const f32x4 a = *(const f32x4*)(hr + 512 * j + 8 * lane), b = *(const f32x4*)(hr + 512 * j + 8 * lane + 4);
            hv[j][0] = a.x; hv[j][1] = a.y; hv[j][2] = a.z; hv[j][3] = a.w; hv[j][4] = b.x; hv[j][5] = b.y; hv[j][6] = b.z; hv[j][7] = b.w;
#pragma unroll
            for (int c = 0; c < 8; ++c) { x[j][c] = hv[j][c]; y[j][c] = 0.f; }
        }
        const bf16* U = (const bf16*)Utab; const bf16* V = (const bf16*)Vtab;
        for (int k = 0; k < 64; k += 2) {
            u32x4 uv[4][2], vv[4][2]; float gt[4];
#pragma unroll
            for (int q = 0; q < 4; ++q) {
                const int kk = k + (q >> 1); const int hh = q & 1;
                const int e = __builtin_amdgcn_readlane(hh ? iB : iA, kk);
                gt[q] = __builtin_bit_cast(float, __builtin_amdgcn_readlane(__builtin_bit_cast(int, hh ? gB : gA), kk));
                const bf16* ur = U + (size_t)e * 1024; const bf16* vr = V + (size_t)e * 1024;
#pragma unroll
                for (int j = 0; j < 2; ++j) { uv[q][j] = *(const u32x4*)(ur + 512 * j + 8 * lane); vv[q][j] = *(const u32x4*)(vr + 512 * j + 8 * lane); }
            }
#pragma unroll
            for (int q = 0; q < 4; ++q) {
                float d = 0.f;
#pragma unroll
                for (int j = 0; j < 2; ++j)
#pragma unroll
                    for (int c = 0; c < 4; ++c) { const unsigned w = uv[q][j][c]; d = fmaf(__builtin_bit_cast(float, w << 16), x[j][2 * c], d); d = fmaf(__builtin_bit_cast(float, w & 0xffff0000u), x[j][2 * c + 1], d); }
                d = wave_sum(d);
                const float cf = gt[q] * gelu_tanh(d * rstd2);
#pragma unroll
                for (int j = 0; j < 2; ++j)
#pragma unroll
                    for (int c = 0; c < 4; ++c) { const unsigned w = vv[q][j][c]; y[j][2 * c] = fmaf(__builtin_bit_cast(float, w << 16), cf, y[j][2 * c]); y[j][2 * c + 1] = fmaf(__builtin_bit_cast(float, w & 0xffff0000u), cf, y[j][2 * c + 1]); }
            }
        }
        float sq = 0.f;
#pragma unroll
        for (int j = 0; j < 2; ++j) {
            float h2[8];
#pragma unroll
            for (int c = 0; c < 8; ++c) { h2[c] = hv[j][c] + y[j][c]; sq += h2[c] * h2[c]; }
            *(f32x4*)(hr + 512 * j + 8 * lane) = (f32x4){h2[0], h2[1], h2[2], h2[3]};
            *(f32x4*)(hr + 512 * j + 8 * lane + 4) = (f32x4){h2[4], h2[5], h2[6], h2[7]};
            u32x4 w; w.x = pk2(h2[0], h2[1]); w.y = pk2(h2[2], h2[3]); w.z = pk2(h2[4], h2[5]); w.w = pk2(h2[6], h2[7]);
            *(u32x4*)(h2b + (size_t)t * 1024 + 512 * j + 8 * lane) = w;
        }
        sq = wave_sum(sq);
        if (lane == 0) rstd3[t] = 1.0f / sqrtf(sq * (1.0f / 1024.0f) + EPS);
    }
}
template <int MODE>
__global__ void __launch_bounds__(256) gather_kernel(const void* __restrict__ Utab, const void* __restrict__ Vtab, const float* __restrict__ gffn, const int* __restrict__ seli, const float* __restrict__ selg,
                                                     const float* __restrict__ part2, float* __restrict__ H, bf16* __restrict__ h2b, float* __restrict__ rstd3) {
    const int lane = threadIdx.x & 63; const int w = blockIdx.x * 4 + (threadIdx.x >> 6); const int nw = gridDim.x * 4;
    for (int t = w; t < T_; t += nw) gather_token<MODE>(t, lane, Utab, Vtab, gffn, seli, selg, part2, H, h2b, rstd3);
}

typedef float f32x2 __attribute__((ext_vector_type(2)));
__device__ __forceinline__ float reduce4_transpose(float d0, float d1, float d2, float d3, int lane) {
    const bool b0 = lane & 1, b1 = lane & 2;
    const float a = (b0 ? d1 : d0) + __shfl_xor(b0 ? d0 : d1, 1);
    const float b = (b0 ? d3 : d2) + __shfl_xor(b0 ? d2 : d3, 1);
    float c = (b1 ? b : a) + __shfl_xor(b1 ? a : b, 2);
    c += __shfl_xor(c, 4); c += __shfl_xor(c, 8); c += __shfl_xor(c, 16); c += __shfl_xor(c, 32);
    return c;
}
__device__ __forceinline__ float dot16_fp8(const u32x4 w, const f32x2 (&x2)[8]) {
    f32x2 acc = (f32x2){0.f, 0.f};
#pragma unroll
    for (int c = 0; c < 4; ++c) { const unsigned ww = w[c]; const f32x2 lo = __builtin_amdgcn_cvt_pk_f32_fp8(ww, false), hi = __builtin_amdgcn_cvt_pk_f32_fp8(ww, true); acc = lo * x2[2 * c] + acc; acc = hi * x2[2 * c + 1] + acc; }
    return acc.x + acc.y;
}
__device__ __forceinline__ void axpy16_fp8(const u32x4 w, float cf, f32x2 (&y2)[8]) {
#pragma unroll
    for (int c = 0; c < 4; ++c) { const unsigned ww = w[c]; const f32x2 lo = __builtin_amdgcn_cvt_pk_f32_fp8(ww, false), hi = __builtin_amdgcn_cvt_pk_f32_fp8(ww, true); y2[2 * c] = lo * cf + y2[2 * c]; y2[2 * c + 1] = hi * cf + y2[2 * c + 1]; }
}
__device__ __forceinline__ float sel4f(float v0, float v1, float v2, float v3, int q) { return q == 0 ? v0 : (q == 1 ? v1 : (q == 2 ? v2 : v3)); }
__device__ __forceinline__ void gather_token_fp8(int t, int lane, const unsigned char* __restrict__ U8, const unsigned char* __restrict__ V8, const float* __restrict__ IU, const float* __restrict__ IV,
                                                 const int* __restrict__ seli, const float* __restrict__ selg, const float* __restrict__ part2,
                                                 float* __restrict__ H, bf16* __restrict__ h2b, float* __restrict__ rstd3) {
    float ps = (lane < 16) ? part2[(size_t)t * 16 + lane] : 0.f;
    ps = wave_sum(ps);
    const float rstd2 = 1.0f / sqrtf(ps * (1.0f / 1024.0f) + EPS);
    const int iA = seli[(size_t)t * 128 + lane], iB = seli[(size_t)t * 128 + 64 + lane];
    const float duA = IU[iA] * rstd2, duB = IU[iB] * rstd2;
    const float gvA = selg[(size_t)t * 128 + lane] * IV[iA], gvB = selg[(size_t)t * 128 + 64 + lane] * IV[iB];
    float* hr = H + (size_t)t * 1024 + 16 * lane;
    f32x2 x2[8], y2[8]; f32x4 hv[4];
#pragma unroll
    for (int j = 0; j < 4; ++j) { hv[j] = *(const f32x4*)(hr + 4 * j); x2[2 * j] = (f32x2){hv[j][0], hv[j][1]}; x2[2 * j + 1] = (f32x2){hv[j][2], hv[j][3]}; y2[2 * j] = (f32x2){0.f, 0.f}; y2[2 * j + 1] = (f32x2){0.f, 0.f}; }
    const int q = lane & 3;
#pragma unroll 1
    for (int k = 0; k < 64; k += 4) {
        u32x4 uu[8], vv[8]; float du[8], gv[8];
#pragma unroll
        for (int s = 0; s < 8; ++s) {
            const int kk = k + (s >> 1); const bool hh = s & 1;
            const int e = __builtin_amdgcn_readlane(hh ? iB : iA, kk);
            du[s] = __int_as_float(__builtin_amdgcn_readlane(__float_as_int(hh ? duB : duA), kk));
            gv[s] = __int_as_float(__builtin_amdgcn_readlane(__float_as_int(hh ? gvB : gvA), kk));
            uu[s] = *(const u32x4*)(U8 + (size_t)e * 1024 + 16 * lane);
            vv[s] = *(const u32x4*)(V8 + (size_t)e * 1024 + 16 * lane);
        }
#pragma unroll
        for (int g = 0; g < 2; ++g) {
            const float d0 = dot16_fp8(uu[4 * g + 0], x2), d1 = dot16_fp8(uu[4 * g + 1], x2), d2 = dot16_fp8(uu[4 * g + 2], x2), d3 = dot16_fp8(uu[4 * g + 3], x2);
            const float tot = reduce4_transpose(d0, d1, d2, d3, lane);
            const float z = tot * sel4f(du[4 * g], du[4 * g + 1], du[4 * g + 2], du[4 * g + 3], q);
            const float cf = gelu_tanh(z) * sel4f(gv[4 * g], gv[4 * g + 1], gv[4 * g + 2], gv[4 * g + 3], q);
#pragma unroll
            for (int s = 0; s < 4; ++s) { const float cs = __int_as_float(__builtin_amdgcn_readlane(__float_as_int(cf), s)); axpy16_fp8(vv[4 * g + s], cs, y2); }
        }
    }
    float sq = 0.f;
    f32x4 h2[4];
#pragma unroll
    for (int j = 0; j < 4; ++j) {
        h2[j] = hv[j] + (f32x4){y2[2 * j].x, y2[2 * j].y, y2[2 * j + 1].x, y2[2 * j + 1].y};
        *(f32x4*)(hr + 4 * j) = h2[j];
        sq += (h2[j][0] * h2[j][0] + h2[j][1] * h2[j][1]) + (h2[j][2] * h2[j][2] + h2[j][3] * h2[j][3]);
    }
    u32x4 w0, w1; w0.x = pk2(h2[0][0], h2[0][1]); w0.y = pk2(h2[0][2], h2[0][3]); w0.z = pk2(h2[1][0], h2[1][1]); w0.w = pk2(h2[1][2], h2[1][3]);
    w1.x = pk2(h2[2][0], h2[2][1]); w1.y = pk2(h2[2][2], h2[2][3]); w1.z = pk2(h2[3][0], h2[3][1]); w1.w = pk2(h2[3][2], h2[3][3]);
    u32x4* ob = (u32x4*)(h2b + (size_t)t * 1024 + 16 * lane); ob[0] = w0; ob[1] = w1;
    sq = wave_sum(sq);
    if (lane == 0) rstd3[t] = 1.0f / sqrtf(sq * (1.0f / 1024.0f) + EPS);
}

__device__ __forceinline__ unsigned umin_(unsigned a, unsigned b) { return a < b ? a : b; }
__device__ __forceinline__ unsigned umax_(unsigned a, unsigned b) { return a > b ? a : b; }
__device__ __forceinline__ void sort128(unsigned& k0, unsigned& k1, int lane) {
#pragma unroll
    for (int k = 2; k <= 128; k <<= 1) {
#pragma unroll
        for (int j = k >> 1; j >= 1; j >>= 1) {
            if (j == 64) { const unsigned mn = umin_(k0, k1), mx = umax_(k0, k1); k0 = mn; k1 = mx; }
            else {
                const unsigned o0 = (unsigned)__shfl_xor((int)k0, j), o1 = (unsigned)__shfl_xor((int)k1, j);
                const bool up0 = (k == 128) ? true : (k == 64 ? true : ((lane & k) == 0));
                const bool up1 = (k == 128) ? true : (k == 64 ? false : ((lane & k) == 0));
                const bool lower = (lane & j) == 0;
                k0 = (lower == up0) ? umin_(k0, o0) : umax_(k0, o0);
                k1 = (lower == up1) ? umin_(k1, o1) : umax_(k1, o1);
            }
        }
    }
}
typedef int i32x4v __attribute__((ext_vector_type(4)));
#ifndef NSLICE
#define NSLICE 8
#endif
#define SLICE_SHIFT (NSLICE == 32 ? 25 : (NSLICE == 16 ? 26 : (NSLICE == 8 ? 27 : (NSLICE == 4 ? 28 : 30))))
typedef unsigned u32x2 __attribute__((ext_vector_type(2)));
__device__ __forceinline__ f32x4 bf4_lo(u32x2 w) { return (f32x4){__builtin_bit_cast(float, w.x << 16), __builtin_bit_cast(float, w.x & 0xffff0000u), __builtin_bit_cast(float, w.y << 16), __builtin_bit_cast(float, w.y & 0xffff0000u)}; }
struct TokState { f32x2 y2[8]; unsigned k0, k1; int bnd; float rsx; };
__device__ __forceinline__ int count_lt(const TokState& S, unsigned bound) {
    return __builtin_popcountll(__builtin_amdgcn_ballot_w64(S.k0 < bound)) + __builtin_popcountll(__builtin_amdgcn_ballot_w64(S.k1 < bound));
}
__device__ __forceinline__ int bperm_i(int srclane, int v) { return __builtin_amdgcn_ds_bpermute(srclane << 2, v); }
__device__ __forceinline__ float bperm_f(int srclane, float v) { return __int_as_float(__builtin_amdgcn_ds_bpermute(srclane << 2, __float_as_int(v))); }
template <int PM>
__device__ __forceinline__ void gather_batch(TokState& S, int p, int hi, int lane, const LAS unsigned char* xs, const unsigned char* __restrict__ U8, const unsigned char* __restrict__ V8, const float* __restrict__ IU, const float* __restrict__ IV) {
    const int n = (hi - p < 16) ? hi - p : 16;
    const int m = lane & 15, kq = lane >> 4;
    const int r = (m < n) ? p + m : hi - 1; const int sl = r & 63; const bool lo = r < 64;
    const unsigned ka = (unsigned)bperm_i(sl, (int)S.k0), kb = (unsigned)bperm_i(sl, (int)S.k1);
    const int es = (int)((lo ? ka : kb) >> 16);
    const unsigned key = lo ? ka : kb;
    const float dus = IU[es] * S.rsx, gvs = (m < n) ? (float)(key & 0xffffu) * (1.0f / 65535.0f) * IV[es] : 0.f;
    const unsigned char* ua = U8 + (size_t)es * 1024 + 16 * kq;
    i32x4v A[16];
    if (!(PM & 2)) {
#pragma unroll
        for (int s = 0; s < 16; ++s) { if (PM & 16) { const int e = __builtin_amdgcn_readlane(es, s); A[s] = *(const i32x4v*)(U8 + (size_t)e * 1024 + 16 * lane); } else A[s] = *(const i32x4v*)(ua + 64 * s); }
    }
    u32x4 vv[16];
    if (!(PM & 1)) {
#pragma unroll
        for (int q = 0; q < 8; ++q) if (q < n) { const int e = __builtin_amdgcn_readlane(es, q); vv[q] = *(const u32x4*)(V8 + (size_t)e * 1024 + 16 * lane); }
        if (n > 8) {
#pragma unroll
            for (int q = 8; q < 16; ++q) if (q < n) { const int e = __builtin_amdgcn_readlane(es, q); vv[q] = *(const u32x4*)(V8 + (size_t)e * 1024 + 16 * lane); }
        }
    }
    i32x4v acc = (i32x4v){0, 0, 0, 0};
    if (!(PM & 2)) {
#pragma unroll
        for (int s = 0; s < 16; ++s) { const i32x4v B = *(const LAS i32x4v*)(xs + 64 * s + 16 * kq); acc = __builtin_amdgcn_mfma_i32_16x16x64_i8(A[s], B, acc, 0, 0, 0); }
    } else { acc = (i32x4v){es, es + 1, es + 2, es + 3}; }
    float cf[4];
#pragma unroll
    for (int j = 0; j < 4; ++j) { const int sm = 4 * kq + j; const float d = bperm_f(sm, dus), g = bperm_f(sm, gvs); cf[j] = g * gelu_tanh((float)acc[j] * d); }
    if (PM & 1) { S.y2[0].x += (cf[0] + cf[1]) + (cf[2] + cf[3]); }
    else if (PM & 4) {
#pragma unroll
        for (int q = 0; q < 16; ++q) if (q < n) { const float cs = __int_as_float(__builtin_amdgcn_readlane(__float_as_int(cf[q & 3]), 16 * (q >> 2))); S.y2[q & 7].x += cs * __uint_as_float((vv[q].x ^ vv[q].y ^ vv[q].z ^ vv[q].w) & 0x3fffffffu); }
    } else {
#pragma unroll
        for (int q = 0; q < 8; ++q) if (q < n) { const float cs = __int_as_float(__builtin_amdgcn_readlane(__float_as_int(cf[q & 3]), 16 * (q >> 2))); axpy16_fp8(vv[q], cs, S.y2); }
        if (n > 8) {
#pragma unroll
            for (int q = 8; q < 16; ++q) if (q < n) { const float cs = __int_as_float(__builtin_amdgcn_readlane(__float_as_int(cf[q & 3]), 16 * (q >> 2))); axpy16_fp8(vv[q], cs, S.y2); }
        }
    }
    __builtin_amdgcn_sched_barrier(0);
}
__device__ __forceinline__ void tok_setup(TokState& S, int t, int lane, LAS unsigned char* xs, const int* __restrict__ seli, const float* __restrict__ selg,
                                          const float* __restrict__ part2, const bf16* __restrict__ h1b) {
    float ps = (lane < 16) ? part2[(size_t)t * 16 + lane] : 0.f;
    ps = wave_sum(ps);
    const float rstd2 = 1.0f / sqrtf(ps * (1.0f / 1024.0f) + EPS);
    f32x4 hv[4]; float am = 0.f;
    { const u32x4* br = (const u32x4*)(h1b + (size_t)t * 1024 + 16 * lane); const u32x4 b0 = br[0], b1 = br[1];
      hv[0] = bf4_lo((u32x2){b0.x, b0.y}); hv[1] = bf4_lo((u32x2){b0.z, b0.w}); hv[2] = bf4_lo((u32x2){b1.x, b1.y}); hv[3] = bf4_lo((u32x2){b1.z, b1.w}); }
#pragma unroll
    for (int j = 0; j < 4; ++j) { am = fmaxf(am, fmaxf(fmaxf(fabsf(hv[j][0]), fabsf(hv[j][1])), fmaxf(fabsf(hv[j][2]), fabsf(hv[j][3])))); }
#pragma unroll
    for (int o = 1; o < 64; o <<= 1) am = fmaxf(am, __shfl_xor(am, o));
    const float sx = am > 0.f ? 127.0f / am : 1.0f, isx = am > 0.f ? am * (1.0f / 127.0f) : 1.0f;
    u32x4 xq;
#pragma unroll
    for (int j = 0; j < 4; ++j) { unsigned w = 0u;
#pragma unroll
        for (int c = 0; c < 4; ++c) w |= ((unsigned)(int)__builtin_rintf(hv[j][c] * sx) & 0xffu) << (8 * c);
        xq[j] = w; }
    *(LAS u32x4*)(xs + 16 * lane) = xq;
    const int iA = seli[(size_t)t * 128 + lane], iB = seli[(size_t)t * 128 + 64 + lane];
    const float gA = selg[(size_t)t * 128 + lane], gB = selg[(size_t)t * 128 + 64 + lane];
    S.k0 = ((unsigned)iA << 16) | (unsigned)(gA * 65535.0f + 0.5f); S.k1 = ((unsigned)iB << 16) | (unsigned)(gB * 65535.0f + 0.5f);
    sort128(S.k0, S.k1, lane);
    S.rsx = rstd2 * isx;
    int bnd = 0;
#pragma unroll
    for (int s = 1; s <= NSLICE; ++s) { const int c = count_lt(S, (unsigned)s << SLICE_SHIFT); bnd = (lane == s) ? c : bnd; }
    S.bnd = bnd;
#pragma unroll
    for (int j = 0; j < 8; ++j) S.y2[j] = (f32x2){0.f, 0.f};
}
__device__ __forceinline__ void tok_finish(const TokState& S, int t, int lane, const bf16* __restrict__ h1b, bf16* __restrict__ h2b, float* __restrict__ rstd3) {
    const u32x4* br = (const u32x4*)(h1b + (size_t)t * 1024 + 16 * lane); const u32x4 b0 = br[0], b1 = br[1];
    f32x4 h2[4]; h2[0] = bf4_lo((u32x2){b0.x, b0.y}); h2[1] = bf4_lo((u32x2){b0.z, b0.w}); h2[2] = bf4_lo((u32x2){b1.x, b1.y}); h2[3] = bf4_lo((u32x2){b1.z, b1.w});
    float sq = 0.f;
#pragma unroll
    for (int j = 0; j < 4; ++j) {
        h2[j] = h2[j] + (f32x4){S.y2[2 * j].x, S.y2[2 * j].y, S.y2[2 * j + 1].x, S.y2[2 * j + 1].y};
        sq += (h2[j][0] * h2[j][0] + h2[j][1] * h2[j][1]) + (h2[j][2] * h2[j][2] + h2[j][3] * h2[j][3]);
    }
    u32x4 w0, w1; w0.x = pk2(h2[0][0], h2[0][1]); w0.y = pk2(h2[0][2], h2[0][3]); w0.z = pk2(h2[1][0], h2[1][1]); w0.w = pk2(h2[1][2], h2[1][3]);
    w1.x = pk2(h2[2][0], h2[2][1]); w1.y = pk2(h2[2][2], h2[2][3]); w1.z = pk2(h2[3][0], h2[3][1]); w1.w = pk2(h2[3][2], h2[3][3]);
    u32x4* ob = (u32x4*)(h2b + (size_t)t * 1024 + 16 * lane); ob[0] = w0; ob[1] = w1;
    sq = wave_sum(sq);
    if (lane == 0) rstd3[t] = 1.0f / sqrtf(sq * (1.0f / 1024.0f) + EPS);
}
__device__ __forceinline__ int dpp_xor8(int v) { return __builtin_amdgcn_update_dpp(0, v, 0x128, 0xf, 0xf, false); }
__device__ __forceinline__ int dpp_xor4(int v) { return __builtin_amdgcn_update_dpp(0, __builtin_amdgcn_update_dpp(0, v, 0x141, 0xf, 0xf, false), 0x1b, 0xf, 0xf, false); }
__device__ __forceinline__ int dpp_xor1(int v) { return __builtin_amdgcn_update_dpp(0, v, 0xb1, 0xf, 0xf, false); }
__device__ __forceinline__ int dpp_xor2(int v) { return __builtin_amdgcn_update_dpp(0, v, 0x4e, 0xf, 0xf, false); }
__device__ __forceinline__ int reduce16_rows(int (&p)[16], int lane) {
    int r8[8], r4[4], r2[2];
#pragma unroll
    for (int i = 0; i < 8; ++i) { const u32x2 s = __builtin_amdgcn_permlane32_swap((unsigned)p[i], (unsigned)p[i + 8], false, false); r8[i] = (int)(s.x + s.y); }
#pragma unroll
    for (int i = 0; i < 4; ++i) { const u32x2 s = __builtin_amdgcn_permlane16_swap((unsigned)r8[i], (unsigned)r8[i + 4], false, false); r4[i] = (int)(s.x + s.y); }
    const bool b3 = lane & 8, b2 = lane & 4;
#pragma unroll
    for (int i = 0; i < 2; ++i) { const int s0 = r4[i] + dpp_xor8(r4[i]), s1 = r4[i + 2] + dpp_xor8(r4[i + 2]); r2[i] = b3 ? s1 : s0; }
    const int keep = b2 ? r2[1] : r2[0], send = b2 ? r2[0] : r2[1];
    int t = keep + dpp_xor4(send);
    t += dpp_xor1(t); t += dpp_xor2(t);
    return t;
}
struct TokState2 { f32x2 y2[8]; unsigned k0, k1; float rsx; };
template <int PM>
__device__ __forceinline__ void gather_batch_rows(TokState& S, int p, int hi, int lane, const LAS unsigned char* xs, const unsigned char* __restrict__ U8, const unsigned char* __restrict__ V8, const float* __restrict__ IU, const float* __restrict__ IV) {
    const int n = (hi - p < 16) ? hi - p : 16;
    const int slot = lane >> 2;
    const int r = (slot < n) ? p + slot : hi - 1; const int sl = r & 63; const bool lo = r < 64;
    const unsigned ka = (unsigned)bperm_i(sl, (int)S.k0), kb = (unsigned)bperm_i(sl, (int)S.k1);
    const unsigned key = lo ? ka : kb;
    const int es = (int)(key >> 16);
    const float dus = IU[es] * S.rsx, gvs = (slot < n) ? (float)(key & 0xffffu) * (1.0f / 65535.0f) * IV[es] : 0.f;
    i32x4v A[16]; u32x4 vv[16];
#pragma unroll
    for (int g = 0; g < 4; ++g) if (4 * g < n) {
#pragma unroll
        for (int q = 4 * g; q < 4 * g + 4; ++q) { int e = __builtin_amdgcn_readlane(es, 4 * q); if (PM & 32) e &= 1023; A[q] = *(const i32x4v*)(U8 + (size_t)e * 1024 + 16 * lane); }
    }
#pragma unroll
    for (int g = 0; g < 4; ++g) if (4 * g < n) {
#pragma unroll
        for (int q = 4 * g; q < 4 * g + 4; ++q) { int e = __builtin_amdgcn_readlane(es, 4 * q); if (PM & 32) e &= 1023; vv[q] = *(const u32x4*)(V8 + (size_t)e * 1024 + 16 * lane); }
    }
    const i32x4v X = *(const LAS i32x4v*)(xs + 16 * lane);
    int pp[16];
#pragma unroll
    for (int g = 0; g < 4; ++g) {
        if (4 * g < n) {
#pragma unroll
            for (int q = 4 * g; q < 4 * g + 4; ++q) pp[q] = __builtin_amdgcn_sdot4(A[q][3], X[3], __builtin_amdgcn_sdot4(A[q][2], X[2], __builtin_amdgcn_sdot4(A[q][1], X[1], __builtin_amdgcn_sdot4(A[q][0], X[0], 0, false), false), false), false);
        } else {
#pragma unroll
            for (int q = 4 * g; q < 4 * g + 4; ++q) pp[q] = 0;
        }
    }
    const int tot = reduce16_rows(pp, lane);
    const float cf = gvs * gelu_tanh((float)tot * dus);
#pragma unroll
    for (int g = 0; g < 4; ++g) if (4 * g < n) {
#pragma unroll
        for (int q = 4 * g; q < 4 * g + 4; ++q) { const float cs = __int_as_float(__builtin_amdgcn_readlane(__float_as_int(cf), 4 * q)); axpy16_fp8(vv[q], cs, S.y2); }
    }
    __builtin_amdgcn_sched_barrier(0);
}

template <int PM>
__device__ __forceinline__ void gather_batch16(TokState2& S, int bi, int lane, const LAS unsigned char* xs, const unsigned char* __restrict__ U8, const unsigned char* __restrict__ V8, const float* __restrict__ IU, const float* __restrict__ IV) {
    const unsigned ksel = (bi < 4) ? S.k0 : S.k1;
    const int lb = (bi & 3) << 4;
    const unsigned key = (unsigned)bperm_i(lb + (lane >> 2), (int)ksel);
    const int es = (int)(key >> 16);
    const float dus = IU[es] * S.rsx, gvs = (float)(key & 0xffffu) * (1.0f / 65535.0f) * IV[es];
    i32x4v A[16]; u32x4 vv[16];
#pragma unroll
    for (int q = 0; q < 16; ++q) { int e = (int)((unsigned)__builtin_amdgcn_readlane((int)ksel, lb + q) >> 16); if (PM & 32) e &= 1023; if (!(PM & 2)) A[q] = *(const i32x4v*)(U8 + (size_t)e * 1024 + 16 * lane); else A[q] = (i32x4v){e, e, e, e}; }
#pragma unroll
    for (int q = 0; q < 16; ++q) { int e = (int)((unsigned)__builtin_amdgcn_readlane((int)ksel, lb + q) >> 16); if (PM & 32) e &= 1023; if (!(PM & 1)) vv[q] = *(const u32x4*)(V8 + (size_t)e * 1024 + 16 * lane); else vv[q] = (u32x4){(unsigned)e, 0u, 0u, 0u}; }
    const i32x4v X = *(const LAS i32x4v*)(xs + 16 * lane);
    int p[16];
#pragma unroll
    for (int q = 0; q < 16; ++q) p[q] = __builtin_amdgcn_sdot4(A[q][3], X[3], __builtin_amdgcn_sdot4(A[q][2], X[2], __builtin_amdgcn_sdot4(A[q][1], X[1], __builtin_amdgcn_sdot4(A[q][0], X[0], 0, false), false), false), false);
    const int tot = reduce16_rows(p, lane);
    const float cf = gvs * gelu_tanh((float)tot * dus);
#pragma unroll
    for (int q = 0; q < 16; ++q) { const float cs = __int_as_float(__builtin_amdgcn_readlane(__float_as_int(cf), 4 * q)); if (PM & 1) S.y2[q & 7].x += cs * __uint_as_float(vv[q].x); else axpy16_fp8(vv[q], cs, S.y2); }
    __builtin_amdgcn_sched_barrier(0);
}
__device__ __forceinline__ void tok_setup2(TokState2& S, int t, int lane, LAS unsigned char* xs, const int* __restrict__ seli, const float* __restrict__ selg,
                                           const float* __restrict__ part2, const bf16* __restrict__ h1b) {
    float ps = (lane < 16) ? part2[(size_t)t * 16 + lane] : 0.f;
    ps = wave_sum(ps);
    const float rstd2 = 1.0f / sqrtf(ps * (1.0f / 1024.0f) + EPS);
    f32x4 hv[4]; float am = 0.f;
    { const u32x4* br = (const u32x4*)(h1b + (size_t)t * 1024 + 16 * lane); const u32x4 b0 = br[0], b1 = br[1];
      hv[0] = bf4_lo((u32x2){b0.x, b0.y}); hv[1] = bf4_lo((u32x2){b0.z, b0.w}); hv[2] = bf4_lo((u32x2){b1.x, b1.y}); hv[3] = bf4_lo((u32x2){b1.z, b1.w}); }
#pragma unroll
    for (int j = 0; j < 4; ++j) { am = fmaxf(am, fmaxf(fmaxf(fabsf(hv[j][0]), fabsf(hv[j][1])), fmaxf(fabsf(hv[j][2]), fabsf(hv[j][3])))); }
#pragma unroll
    for (int o = 1; o < 64; o <<= 1) am = fmaxf(am, __shfl_xor(am, o));
    const float sx = am > 0.f ? 127.0f / am : 1.0f, isx = am > 0.f ? am * (1.0f / 127.0f) : 1.0f;
    u32x4 xq;
#pragma unroll
    for (int j = 0; j < 4; ++j) { unsigned w = 0u;
#pragma unroll
        for (int c = 0; c < 4; ++c) w |= ((unsigned)(int)__builtin_rintf(hv[j][c] * sx) & 0xffu) << (8 * c);
        xq[j] = w; }
    *(LAS u32x4*)(xs + 16 * lane) = xq;
    const int iA = seli[(size_t)t * 128 + lane], iB = seli[(size_t)t * 128 + 64 + lane];
    const float gA = selg[(size_t)t * 128 + lane], gB = selg[(size_t)t * 128 + 64 + lane];
    S.k0 = ((unsigned)iA << 16) | (unsigned)(gA * 65535.0f + 0.5f); S.k1 = ((unsigned)iB << 16) | (unsigned)(gB * 65535.0f + 0.5f);
    sort128(S.k0, S.k1, lane);
    S.rsx = rstd2 * isx;
#pragma unroll
    for (int j = 0; j < 8; ++j) S.y2[j] = (f32x2){0.f, 0.f};
}
__device__ __forceinline__ void tok_finish2(const TokState2& S, int t, int lane, const bf16* __restrict__ h1b, bf16* __restrict__ h2b, float* __restrict__ rstd3) {
    const u32x4* br = (const u32x4*)(h1b + (size_t)t * 1024 + 16 * lane); const u32x4 b0 = br[0], b1 = br[1];
    f32x4 h2[4]; h2[0] = bf4_lo((u32x2){b0.x, b0.y}); h2[1] = bf4_lo((u32x2){b0.z, b0.w}); h2[2] = bf4_lo((u32x2){b1.x, b1.y}); h2[3] = bf4_lo((u32x2){b1.z, b1.w});
    float sq = 0.f;
#pragma unroll
    for (int j = 0; j < 4; ++j) {
        h2[j] = h2[j] + (f32x4){S.y2[2 * j].x, S.y2[2 * j].y, S.y2[2 * j + 1].x, S.y2[2 * j + 1].y};
        sq += (h2[j][0] * h2[j][0] + h2[j][1] * h2[j][1]) + (h2[j][2] * h2[j][2] + h2[j][3] * h2[j][3]);
    }
    u32x4 w0, w1; w0.x = pk2(h2[0][0], h2[0][1]); w0.y = pk2(h2[0][2], h2[0][3]); w0.z = pk2(h2[1][0], h2[1][1]); w0.w = pk2(h2[1][2], h2[1][3]);
    w1.x = pk2(h2[2][0], h2[2][1]); w1.y = pk2(h2[2][2], h2[2][3]); w1.z = pk2(h2[3][0], h2[3][1]); w1.w = pk2(h2[3][2], h2[3][3]);
    u32x4* ob = (u32x4*)(h2b + (size_t)t * 1024 + 16 * lane); ob[0] = w0; ob[1] = w1;
    sq = wave_sum(sq);
    if (lane == 0) rstd3[t] = 1.0f / sqrtf(sq * (1.0f / 1024.0f) + EPS);
}
template <int PM>
__device__ __forceinline__ void gather_wg_rows(int tok0, int wave, int lane, LAS unsigned char* lds, const unsigned char* __restrict__ U8, const unsigned char* __restrict__ V8, const float* __restrict__ IU, const float* __restrict__ IV,
                                               const int* __restrict__ seli, const float* __restrict__ selg, const float* __restrict__ part2, const bf16* __restrict__ h1b, bf16* __restrict__ h2b, float* __restrict__ rstd3, float* probe_out) {
    LAS unsigned char* xs = lds + wave * 4096;
#pragma unroll 1
    for (int pass = 0; pass < 2; ++pass) {
        const int tb = tok0 + pass * 32 + wave * 4;
        TokState2 S0, S1, S2, S3;
        tok_setup2(S0, tb + 0, fresh_lane(), xs, seli, selg, part2, h1b); __builtin_amdgcn_sched_barrier(0);
        tok_setup2(S1, tb + 1, fresh_lane(), xs + 1024, seli, selg, part2, h1b); __builtin_amdgcn_sched_barrier(0);
        tok_setup2(S2, tb + 2, fresh_lane(), xs + 2048, seli, selg, part2, h1b); __builtin_amdgcn_sched_barrier(0);
        tok_setup2(S3, tb + 3, fresh_lane(), xs + 3072, seli, selg, part2, h1b); __builtin_amdgcn_sched_barrier(0);
        __syncthreads();
        lane = fresh_lane();
#pragma unroll 1
        for (int bi = 0; bi < 8; ++bi) {
            gather_batch16<PM>(S0, bi, lane, xs, U8, V8, IU, IV);
            gather_batch16<PM>(S1, bi, lane, xs + 1024, U8, V8, IU, IV);
            gather_batch16<PM>(S2, bi, lane, xs + 2048, U8, V8, IU, IV);
            gather_batch16<PM>(S3, bi, lane, xs + 3072, U8, V8, IU, IV);
        }
        if (PM != 0) { const int fl = fresh_lane(); f32x2 a = S0.y2[0] + S1.y2[0] + S2.y2[0] + S3.y2[0];
#pragma unroll
            for (int j = 1; j < 8; ++j) a += S0.y2[j] + S1.y2[j] + S2.y2[j] + S3.y2[j];
            probe_out[(size_t)tb * 64 + fl] = a.x + a.y; }
        else { const int fl = fresh_lane(); tok_finish2(S0, tb, fl, h1b, h2b, rstd3); tok_finish2(S1, tb + 1, fl, h1b, h2b, rstd3); tok_finish2(S2, tb + 2, fl, h1b, h2b, rstd3); tok_finish2(S3, tb + 3, fl, h1b, h2b, rstd3); }
        __syncthreads();
    }
}
#if GATHER_ROWS == 2
#define GATHER_BATCH_FN gather_batch_rows
#else
#define GATHER_BATCH_FN gather_batch
#endif
template <int PM>
__device__ __forceinline__ void gather_wg_sliced(int tok0, int wave, int lane, LAS unsigned char* lds, const unsigned char* __restrict__ U8, const unsigned char* __restrict__ V8, const float* __restrict__ IU, const float* __restrict__ IV,
                                                 const int* __restrict__ seli, const float* __restrict__ selg, const float* __restrict__ part2, float* __restrict__ H, const bf16* __restrict__ h1b, bf16* __restrict__ h2b, float* __restrict__ rstd3, float* probe_out) {
    LAS unsigned char* xs = lds + wave * 4096;
#pragma unroll 1
    for (int pass = 0; pass < 2; ++pass) {
        const int tb = tok0 + pass * 32 + wave * 4;
        TokState S0, S1, S2, S3;
        tok_setup(S0, tb + 0, fresh_lane(), xs, seli, selg, part2, h1b); __builtin_amdgcn_sched_barrier(0);
        tok_setup(S1, tb + 1, fresh_lane(), xs + 1024, seli, selg, part2, h1b); __builtin_amdgcn_sched_barrier(0);
        tok_setup(S2, tb + 2, fresh_lane(), xs + 2048, seli, selg, part2, h1b); __builtin_amdgcn_sched_barrier(0);
        tok_setup(S3, tb + 3, fresh_lane(), xs + 3072, seli, selg, part2, h1b); __builtin_amdgcn_sched_barrier(0);
        __syncthreads();
        lane = fresh_lane();
        int lo0 = 0, lo1 = 0, lo2 = 0, lo3 = 0;
#pragma unroll 1
        for (int s = 0; s < NSLICE; ++s) {
            { const int hi = __builtin_amdgcn_readlane(S0.bnd, s + 1); for (int p = lo0; p < hi; p += 16) GATHER_BATCH_FN<PM>(S0, p, hi, lane, xs, U8, V8, IU, IV); lo0 = hi; }
            { const int hi = __builtin_amdgcn_readlane(S1.bnd, s + 1); for (int p = lo1; p < hi; p += 16) GATHER_BATCH_FN<PM>(S1, p, hi, lane, xs + 1024, U8, V8, IU, IV); lo1 = hi; }
            { const int hi = __builtin_amdgcn_readlane(S2.bnd, s + 1); for (int p = lo2; p < hi; p += 16) GATHER_BATCH_FN<PM>(S2, p, hi, lane, xs + 2048, U8, V8, IU, IV); lo2 = hi; }
            { const int hi = __builtin_amdgcn_readlane(S3.bnd, s + 1); for (int p = lo3; p < hi; p += 16) GATHER_BATCH_FN<PM>(S3, p, hi, lane, xs + 3072, U8, V8, IU, IV); lo3 = hi; }
        }
        if (probe_out) { const int fl = fresh_lane(); f32x2 a = S0.y2[0] + S1.y2[0] + S2.y2[0] + S3.y2[0];
#pragma unroll
            for (int j = 1; j < 8; ++j) a += S0.y2[j] + S1.y2[j] + S2.y2[j] + S3.y2[j];
            probe_out[(size_t)tb * 64 + fl] = a.x + a.y; }
        else { const int fl = fresh_lane(); tok_finish(S0, tb, fl, h1b, h2b, rstd3); tok_finish(S1, tb + 1, fl, h1b, h2b, rstd3); tok_finish(S2, tb + 2, fl, h1b, h2b, rstd3); tok_finish(S3, tb + 3, fl, h1b, h2b, rstd3); }
        __syncthreads();
    }
}


template <int J> __device__ __forceinline__ unsigned xor_lane(unsigned v) {
    if (J == 1) return (unsigned)__builtin_amdgcn_update_dpp(0, (int)v, 0xb1, 0xf, 0xf, false);
    if (J == 2) return (unsigned)__builtin_amdgcn_update_dpp(0, (int)v, 0x4e, 0xf, 0xf, false);
    if (J == 4) return (unsigned)dpp_xor4((int)v);
    if (J == 8) return (unsigned)__builtin_amdgcn_update_dpp(0, (int)v, 0x128, 0xf, 0xf, false);
    return (unsigned)__shfl_xor((int)v, J);
}
template <int NR, int KK, int J>
__device__ __forceinline__ void sort_stage(unsigned (&k)[NR], int lane) {
    if (J >= 64) {
        constexpr int d = J >> 6;
#pragma unroll
        for (int r = 0; r < NR; ++r) if ((r & d) == 0) {
            const bool up = (KK == 64 * NR) ? true : (((64 * r) & KK) == 0);
            const unsigned mn = umin_(k[r], k[r + d]), mx = umax_(k[r], k[r + d]);
            k[r] = up ? mn : mx; k[r + d] = up ? mx : mn;
        }
    } else {
        const bool lower = (lane & J) == 0;
        unsigned o[NR];
#pragma unroll
        for (int r = 0; r < NR; ++r) o[r] = xor_lane<(J < 64 ? J : 1)>(k[r]);
#pragma unroll
        for (int r = 0; r < NR; ++r) {
            const bool up = (KK == 64 * NR) ? true : (KK >= 64 ? (((64 * r) & KK) == 0) : ((lane & KK) == 0));
            k[r] = (lower == up) ? umin_(k[r], o[r]) : umax_(k[r], o[r]);
        }
    }
}
template <int NR, int KK, int J> struct SortJ { static __device__ __forceinline__ void run(unsigned (&k)[NR], int lane) { sort_stage<NR, KK, J>(k, lane); SortJ<NR, KK, J / 2>::run(k, lane); } };
template <int NR, int KK> struct SortJ<NR, KK, 0> { static __device__ __forceinline__ void run(unsigned (&)[NR], int) {} };
template <int NR, int KK> struct SortK { static __device__ __forceinline__ void run(unsigned (&k)[NR], int lane) { SortK<NR, KK / 2>::run(k, lane); SortJ<NR, KK, KK / 2>::run(k, lane); } };
template <int NR> struct SortK<NR, 1> { static __device__ __forceinline__ void run(unsigned (&)[NR], int) {} };
template <int NR>
__device__ __forceinline__ void sort_wave(unsigned (&k)[NR], int lane) { SortK<NR, 64 * NR>::run(k, lane); }
__device__ __forceinline__ void axpy_dispatch2(int t, int tbase, float cs, const f32x2 (&x)[8], f32x2 (&Ya)[8], f32x2 (&Yb)[8]) {
    const unsigned long long c = (unsigned long long)__float_as_uint(cs);
    const int tt = t - tbase;
    asm volatile(
        "s_cmp_gt_u32 %[t], 1\n\t"
        "s_cbranch_scc1 3f\n\t"
        "s_cmp_eq_u32 %[t], 1\n\t"
        "s_cbranch_scc1 2f\n\t"
        "v_pk_fma_f32 %[a0], %[c], %[x0], %[a0] op_sel_hi:[0,1,1]\n\t"
        "v_pk_fma_f32 %[a1], %[c], %[x1], %[a1] op_sel_hi:[0,1,1]\n\t"
        "v_pk_fma_f32 %[a2], %[c], %[x2], %[a2] op_sel_hi:[0,1,1]\n\t"
        "v_pk_fma_f32 %[a3], %[c], %[x3], %[a3] op_sel_hi:[0,1,1]\n\t"
        "v_pk_fma_f32 %[a4], %[c], %[x4], %[a4] op_sel_hi:[0,1,1]\n\t"
        "v_pk_fma_f32 %[a5], %[c], %[x5], %[a5] op_sel_hi:[0,1,1]\n\t"
        "v_pk_fma_f32 %[a6], %[c], %[x6], %[a6] op_sel_hi:[0,1,1]\n\t"
        "v_pk_fma_f32 %[a7], %[c], %[x7], %[a7] op_sel_hi:[0,1,1]\n\t"
        "s_branch 3f\n"
        "2:\n\t"
        "v_pk_fma_f32 %[b0], %[c], %[x0], %[b0] op_sel_hi:[0,1,1]\n\t"
        "v_pk_fma_f32 %[b1], %[c], %[x1], %[b1] op_sel_hi:[0,1,1]\n\t"
        "v_pk_fma_f32 %[b2], %[c], %[x2], %[b2] op_sel_hi:[0,1,1]\n\t"
        "v_pk_fma_f32 %[b3], %[c], %[x3], %[b3] op_sel_hi:[0,1,1]\n\t"
        "v_pk_fma_f32 %[b4], %[c], %[x4], %[b4] op_sel_hi:[0,1,1]\n\t"
        "v_pk_fma_f32 %[b5], %[c], %[x5], %[b5] op_sel_hi:[0,1,1]\n\t"
        "v_pk_fma_f32 %[b6], %[c], %[x6], %[b6] op_sel_hi:[0,1,1]\n\t"
        "v_pk_fma_f32 %[b7], %[c], %[x7], %[b7] op_sel_hi:[0,1,1]\n"
        "3:\n\t"
        : [a0] "+v"(Ya[0]), [a1] "+v"(Ya[1]), [a2] "+v"(Ya[2]), [a3] "+v"(Ya[3]), [a4] "+v"(Ya[4]), [a5] "+v"(Ya[5]), [a6] "+v"(Ya[6]), [a7] "+v"(Ya[7]),
          [b0] "+v"(Yb[0]), [b1] "+v"(Yb[1]), [b2] "+v"(Yb[2]), [b3] "+v"(Yb[3]), [b4] "+v"(Yb[4]), [b5] "+v"(Yb[5]), [b6] "+v"(Yb[6]), [b7] "+v"(Yb[7])
        : [x0] "v"(x[0]), [x1] "v"(x[1]), [x2] "v"(x[2]), [x3] "v"(x[3]), [x4] "v"(x[4]), [x5] "v"(x[5]), [x6] "v"(x[6]), [x7] "v"(x[7]), [c] "s"(c), [t] "s"(tt)
        : "scc");
}
__device__ __forceinline__ void axpy_dispatch2_dup(int t, int tbase, float cs, const f32x2 (&x)[8], f32x2 (&Ya)[8], f32x2 (&Yb)[8]) {
    const unsigned long long c = (unsigned long long)__float_as_uint(cs);
    const int tt = t - tbase;
    asm volatile(
        "s_cmp_gt_u32 %[t], 1\n\t"
        "s_cbranch_scc1 3f\n\t"
        "s_cmp_eq_u32 %[t], 1\n\t"
        "s_cbranch_scc1 2f\n\t"
        "v_pk_fma_f32 %[a0], %[c], %[x0], %[a0] op_sel_hi:[0,1,1]\n\t"
        "v_pk_fma_f32 %[a0], %[c], %[x0], %[a0] op_sel_hi:[0,1,1]\n\t"
        "v_pk_fma_f32 %[a1], %[c], %[x1], %[a1] op_sel_hi:[0,1,1]\n\t"
        "v_pk_fma_f32 %[a1], %[c], %[x1], %[a1] op_sel_hi:[0,1,1]\n\t"
        "v_pk_fma_f32 %[a2], %[c], %[x2], %[a2] op_sel_hi:[0,1,1]\n\t"
        "v_pk_fma_f32 %[a2], %[c], %[x2], %[a2] op_sel_hi:[0,1,1]\n\t"
        "v_pk_fma_f32 %[a3], %[c], %[x3], %[a3] op_sel_hi:[0,1,1]\n\t"
        "v_pk_fma_f32 %[a3], %[c], %[x3], %[a3] op_sel_hi:[0,1,1]\n\t"
        "v_pk_fma_f32 %[a4], %[c], %[x4], %[a4] op_sel_hi:[0,1,1]\n\t"
        "v_pk_fma_f32 %[a4], %[c], %[x4], %[a4] op_sel_hi:[0,1,1]\n\t"
        "v_pk_fma_f32 %[a5], %[c], %[x5], %[a5] op_sel_hi:[0,1,1]\n\t"
        "v_pk_fma_f32 %[a5], %[c], %[x5], %[a5] op_sel_hi:[0,1,1]\n\t"
        "v_pk_fma_f32 %[a6], %[c], %[x6], %[a6] op_sel_hi:[0,1,1]\n\t"
        "v_pk_fma_f32 %[a6], %[c], %[x6], %[a6] op_sel_hi:[0,1,1]\n\t"
        "v_pk_fma_f32 %[a7], %[c], %[x7], %[a7] op_sel_hi:[0,1,1]\n\t"
        "v_pk_fma_f32 %[a7], %[c], %[x7], %[a7] op_sel_hi:[0,1,1]\n\t"
        "s_branch 3f\n"
        "2:\n\t"
        "v_pk_fma_f32 %[b0], %[c], %[x0], %[b0] op_sel_hi:[0,1,1]\n\t"
        "v_pk_fma_f32 %[b0], %[c], %[x0], %[b0] op_sel_hi:[0,1,1]\n\t"
        "v_pk_fma_f32 %[b1], %[c], %[x1], %[b1] op_sel_hi:[0,1,1]\n\t"
        "v_pk_fma_f32 %[b1], %[c], %[x1], %[b1] op_sel_hi:[0,1,1]\n\t"
        "v_pk_fma_f32 %[b2], %[c], %[x2], %[b2] op_sel_hi:[0,1,1]\n\t"
        "v_pk_fma_f32 %[b2], %[c], %[x2], %[b2] op_sel_hi:[0,1,1]\n\t"
        "v_pk_fma_f32 %[b3], %[c], %[x3], %[b3] op_sel_hi:[0,1,1]\n\t"
        "v_pk_fma_f32 %[b3], %[c], %[x3], %[b3] op_sel_hi:[0,1,1]\n\t"
        "v_pk_fma_f32 %[b4], %[c], %[x4], %[b4] op_sel_hi:[0,1,1]\n\t"
        "v_pk_fma_f32 %[b4], %[c], %[x4], %[b4] op_sel_hi:[0,1,1]\n\t"
        "v_pk_fma_f32 %[b5], %[c], %[x5], %[b5] op_sel_hi:[0,1,1]\n\t"
        "v_pk_fma_f32 %[b5], %[c], %[x5], %[b5] op_sel_hi:[0,1,1]\n\t"
        "v_pk_fma_f32 %[b6], %[c], %[x6], %[b6] op_sel_hi:[0,1,1]\n\t"
        "v_pk_fma_f32 %[b6], %[c], %[x6], %[b6] op_sel_hi:[0,1,1]\n\t"
        "v_pk_fma_f32 %[b7], %[c], %[x7], %[b7] op_sel_hi:[0,1,1]\n"
        "v_pk_fma_f32 %[b7], %[c], %[x7], %[b7] op_sel_hi:[0,1,1]\n"
        "3:\n\t"
        : [a0] "+v"(Ya[0]), [a1] "+v"(Ya[1]), [a2] "+v"(Ya[2]), [a3] "+v"(Ya[3]), [a4] "+v"(Ya[4]), [a5] "+v"(Ya[5]), [a6] "+v"(Ya[6]), [a7] "+v"(Ya[7]),
          [b0] "+v"(Yb[0]), [b1] "+v"(Yb[1]), [b2] "+v"(Yb[2]), [b3] "+v"(Yb[3]), [b4] "+v"(Yb[4]), [b5] "+v"(Yb[5]), [b6] "+v"(Yb[6]), [b7] "+v"(Yb[7])
        : [x0] "v"(x[0]), [x1] "v"(x[1]), [x2] "v"(x[2]), [x3] "v"(x[3]), [x4] "v"(x[4]), [x5] "v"(x[5]), [x6] "v"(x[6]), [x7] "v"(x[7]), [c] "s"(c), [t] "s"(tt)
        : "scc");
}
__device__ __forceinline__ float tok_setup_mixed(unsigned& k0, unsigned& k1, int t, int j, int lane, LAS unsigned char* xs, const int* __restrict__ seli, const float* __restrict__ selg,
                                                 const float* __restrict__ part2, const bf16* __restrict__ h1b) {
    float ps = (lane < 16) ? part2[(size_t)t * 16 + lane] : 0.f;
    ps = wave_sum(ps);
    const float rstd2 = 1.0f / sqrtf(ps * (1.0f / 1024.0f) + EPS);
    f32x4 hv[4]; float am = 0.f;
    { const u32x4* br = (const u32x4*)(h1b + (size_t)t * 1024 + 16 * lane); const u32x4 b0 = br[0], b1 = br[1];
      hv[0] = bf4_lo((u32x2){b0.x, b0.y}); hv[1] = bf4_lo((u32x2){b0.z, b0.w}); hv[2] = bf4_lo((u32x2){b1.x, b1.y}); hv[3] = bf4_lo((u32x2){b1.z, b1.w}); }
#pragma unroll
    for (int i = 0; i < 4; ++i) { am = fmaxf(am, fmaxf(fmaxf(fabsf(hv[i][0]), fabsf(hv[i][1])), fmaxf(fabsf(hv[i][2]), fabsf(hv[i][3])))); }
#pragma unroll
    for (int o = 1; o < 64; o <<= 1) am = fmaxf(am, __shfl_xor(am, o));
    const float sx = am > 0.f ? 127.0f / am : 1.0f, isx = am > 0.f ? am * (1.0f / 127.0f) : 1.0f;
    u32x4 xq;
#pragma unroll
    for (int i = 0; i < 4; ++i) { unsigned w = 0u;
#pragma unroll
        for (int c = 0; c < 4; ++c) w |= ((unsigned)(int)__builtin_rintf(hv[i][c] * sx) & 0xffu) << (8 * c);
        xq[i] = w; }
    *(LAS u32x4*)(xs + 16 * lane) = xq;
    const int iA = seli[(size_t)t * 128 + lane], iB = seli[(size_t)t * 128 + 64 + lane];
    const float gA = selg[(size_t)t * 128 + lane], gB = selg[(size_t)t * 128 + 64 + lane];
    k0 = ((unsigned)iA << 18) | ((unsigned)j << 16) | (unsigned)(gA * 65535.0f + 0.5f); k1 = ((unsigned)iB << 18) | ((unsigned)j << 16) | (unsigned)(gB * 65535.0f + 0.5f);
    return rstd2 * isx;
}
__device__ __forceinline__ void tok_finish_mixed(const f32x2 (&y2)[8], int t, int lane, const bf16* __restrict__ h1b, bf16* __restrict__ h2b, float* __restrict__ rstd3) {
    const u32x4* br = (const u32x4*)(h1b + (size_t)t * 1024 + 16 * lane); const u32x4 b0 = br[0], b1 = br[1];
    f32x4 h2[4]; h2[0] = bf4_lo((u32x2){b0.x, b0.y}); h2[1] = bf4_lo((u32x2){b0.z, b0.w}); h2[2] = bf4_lo((u32x2){b1.x, b1.y}); h2[3] = bf4_lo((u32x2){b1.z, b1.w});
    float sq = 0.f;
#pragma unroll
    for (int i = 0; i < 4; ++i) {
        h2[i] = h2[i] + (f32x4){y2[2 * i].x, y2[2 * i].y, y2[2 * i + 1].x, y2[2 * i + 1].y};
        sq += (h2[i][0] * h2[i][0] + h2[i][1] * h2[i][1]) + (h2[i][2] * h2[i][2] + h2[i][3] * h2[i][3]);
    }
    u32x4 w0, w1; w0.x = pk2(h2[0][0], h2[0][1]); w0.y = pk2(h2[0][2], h2[0][3]); w0.z = pk2(h2[1][0], h2[1][1]); w0.w = pk2(h2[1][2], h2[1][3]);
    w1.x = pk2(h2[2][0], h2[2][1]); w1.y = pk2(h2[2][2], h2[2][3]); w1.z = pk2(h2[3][0], h2[3][1]); w1.w = pk2(h2[3][2], h2[3][3]);
    u32x4* ob = (u32x4*)(h2b + (size_t)t * 1024 + 16 * lane); ob[0] = w0; ob[1] = w1;
    sq = wave_sum(sq);
    if (lane == 0) rstd3[t] = 1.0f / sqrtf(sq * (1.0f / 1024.0f) + EPS);
}
constexpr int MIX_LDS_WAVE = 4096 + 2048 + 64;
constexpr int XG = 2;
template <int PM>
__device__ __forceinline__ void gather_wg_mixed(int tok0, int wave, int lane, LAS unsigned char* lds, const unsigned char* __restrict__ U8, const unsigned char* __restrict__ V8, const float* __restrict__ IU, const float* __restrict__ IV,
                                                const int* __restrict__ seli, const float* __restrict__ selg, const float* __restrict__ part2, const bf16* __restrict__ h1b, bf16* __restrict__ h2b, float* __restrict__ rstd3, float* probe_out) {
    LAS unsigned char* xs = lds + wave * MIX_LDS_WAVE;
    LAS unsigned* ks = (LAS unsigned*)(xs + 4096);
    LAS float* rsl = (LAS float*)(xs + 4096 + 2048);
#pragma unroll 1
    for (int pass = 0; pass < 2; ++pass) {
        const int tb = tok0 + pass * 32 + wave * 4;
        unsigned k[8]; float rs0, rs1, rs2, rs3;
        rs0 = tok_setup_mixed(k[0], k[1], tb + 0, 0, fresh_lane(), xs, seli, selg, part2, h1b); __builtin_amdgcn_sched_barrier(0);
        rs1 = tok_setup_mixed(k[2], k[3], tb + 1, 1, fresh_lane(), xs + 1024, seli, selg, part2, h1b); __builtin_amdgcn_sched_barrier(0);
        rs2 = tok_setup_mixed(k[4], k[5], tb + 2, 2, fresh_lane(), xs + 2048, seli, selg, part2, h1b); __builtin_amdgcn_sched_barrier(0);
        rs3 = tok_setup_mixed(k[6], k[7], tb + 3, 3, fresh_lane(), xs + 3072, seli, selg, part2, h1b); __builtin_amdgcn_sched_barrier(0);
        lane = fresh_lane();
        sort_wave<8>(k, lane);
#pragma unroll
        for (int r = 0; r < 8; ++r) ks[lane + 64 * r] = k[r];
        if (lane == 0) { rsl[0] = rs0; rsl[1] = rs1; rsl[2] = rs2; rsl[3] = rs3; }
        __builtin_amdgcn_sched_barrier(0);
        f32x2 Y0[8], Y1[8], Y2[8], Y3[8];
#pragma unroll
        for (int i = 0; i < 8; ++i) { Y0[i] = (f32x2){0.f, 0.f}; Y1[i] = (f32x2){0.f, 0.f}; Y2[i] = (f32x2){0.f, 0.f}; Y3[i] = (f32x2){0.f, 0.f}; }
        __syncthreads();
        lane = fresh_lane();
#if MIX_PIPE
        unsigned kbN = ks[(pass ? 16 * 31 : 0) + (lane & 15)], keyN = ks[(pass ? 16 * 31 : 0) + (lane >> 2)];
        i32x4v A[16]; u32x4 vv[16];
#pragma unroll
        for (int q = 0; q < 16; ++q) { int e = (int)((unsigned)__builtin_amdgcn_readlane((int)kbN, q) >> 18); if (PM & 32) e &= 1023; if (PM & 2) A[q] = (i32x4v){e, e, e, e}; else A[q] = *(const i32x4v*)(U8 + (size_t)e * 1024 + 16 * lane); }
#pragma unroll
        for (int q = 0; q < 16; ++q) { int e = (int)((unsigned)__builtin_amdgcn_readlane((int)kbN, q) >> 18); if (PM & 32) e &= 1023; if (PM & 1) vv[q] = (u32x4){(unsigned)e, 0u, 0u, 0u}; else vv[q] = *(const u32x4*)(V8 + (size_t)e * 1024 + 16 * lane); }
        float iuN = IU[keyN >> 18], ivN = IV[keyN >> 18];
#pragma unroll 1
        for (int bb = 0; bb < 32; ++bb) {
            const int bn = (bb + 1 < 32) ? bb + 1 : 31; const int b1 = pass ? 31 - bn : bn;
            const unsigned kb = kbN, key = keyN; const float iu = iuN, iv = ivN;
            kbN = ks[16 * b1 + (lane & 15)]; keyN = ks[16 * b1 + (lane >> 2)];
            const int tq = (int)(key >> 16) & 3;
            const float dus = iu * rsl[tq], gvs = (float)(key & 0xffffu) * (1.0f / 65535.0f) * iv;
            int pp[16];
#pragma unroll
            for (int g = 0; g < 16 / XG; ++g) {
                i32x4v Xg[XG];
#pragma unroll
                for (int i = 0; i < XG; ++i) { const int t = (__builtin_amdgcn_readlane((int)kb, XG * g + i) >> 16) & 3; Xg[i] = *(const LAS i32x4v*)(xs + t * 1024 + 16 * lane); }
#pragma unroll
                for (int i = 0; i < XG; ++i) { const int q = XG * g + i; const i32x4v X = Xg[i];
                    if (PM & 2) pp[q] = A[q][0] + X[0]; else
                    pp[q] = __builtin_amdgcn_sdot4(A[q][3], X[3], __builtin_amdgcn_sdot4(A[q][2], X[2], __builtin_amdgcn_sdot4(A[q][1], X[1], __builtin_amdgcn_sdot4(A[q][0], X[0], 0, false), false), false), false);
                    int e = (int)((unsigned)__builtin_amdgcn_readlane((int)kbN, q) >> 18); if (PM & 32) e &= 1023;
                    if (PM & 2) A[q] = (i32x4v){e, e, e, e}; else A[q] = *(const i32x4v*)(U8 + (size_t)e * 1024 + 16 * lane);
                }
                __builtin_amdgcn_sched_barrier(0);
            }
            iuN = IU[keyN >> 18]; ivN = IV[keyN >> 18];
            const int tot = reduce16_rows(pp, lane);
            const float cf = gvs * gelu_tanh((float)tot * dus);
#pragma unroll
            for (int q = 0; q < 16; ++q) {
                const int t = (__builtin_amdgcn_readlane((int)kb, q) >> 16) & 3;
                const float cs = __int_as_float(__builtin_amdgcn_readlane(__float_as_int(cf), 4 * q));
                f32x2 x[8];
#pragma unroll
                for (int c = 0; c < 4; ++c) { x[2 * c] = __builtin_amdgcn_cvt_pk_f32_fp8(vv[q][c], false); x[2 * c + 1] = __builtin_amdgcn_cvt_pk_f32_fp8(vv[q][c], true); }
                int e = (int)((unsigned)__builtin_amdgcn_readlane((int)kbN, q) >> 18); if (PM & 32) e &= 1023;
                if (PM & 1) { vv[q] = (u32x4){(unsigned)e, 0u, 0u, 0u}; Y0[q & 7].x += cs * x[0].x; } else {
                vv[q] = *(const u32x4*)(V8 + (size_t)e * 1024 + 16 * lane);
                if (PM & 128) { axpy_dispatch2_dup(t, 0, cs, x, Y0, Y1); axpy_dispatch2_dup(t, 2, cs, x, Y2, Y3); } else {
                axpy_dispatch2(t, 0, cs, x, Y0, Y1);
                axpy_dispatch2(t, 2, cs, x, Y2, Y3); } }
            }
        }
#else
#pragma unroll 1
        for (int b = 0; b < 32; ++b) {
            const unsigned kb = ks[16 * b + (lane & 15)];
            const unsigned key = ks[16 * b + (lane >> 2)];
            const int es = (int)(key >> 18); const int tq = (int)(key >> 16) & 3;
            const float rsx = rsl[tq];
            const float dus = IU[es] * rsx, gvs = (float)(key & 0xffffu) * (1.0f / 65535.0f) * IV[es];
            i32x4v A[16]; u32x4 vv[16];
#pragma unroll
            for (int q = 0; q < 16; ++q) { int e = (int)((unsigned)__builtin_amdgcn_readlane((int)kb, q) >> 18); if (PM & 32) e &= 1023; A[q] = *(const i32x4v*)(U8 + (size_t)e * 1024 + 16 * lane); }
#pragma unroll
            for (int q = 0; q < 16; ++q) { int e = (int)((unsigned)__builtin_amdgcn_readlane((int)kb, q) >> 18); if (PM & 32) e &= 1023; vv[q] = *(const u32x4*)(V8 + (size_t)e * 1024 + 16 * lane); }
            int pp[16];
#pragma unroll
            for (int q = 0; q < 16; ++q) {
                const int t = (__builtin_amdgcn_readlane((int)kb, q) >> 16) & 3;
                const i32x4v X = *(const LAS i32x4v*)(xs + t * 1024 + 16 * lane);
                pp[q] = __builtin_amdgcn_sdot4(A[q][3], X[3], __builtin_amdgcn_sdot4(A[q][2], X[2], __builtin_amdgcn_sdot4(A[q][1], X[1], __builtin_amdgcn_sdot4(A[q][0], X[0], 0, false), false), false), false);
            }
            const int tot = reduce16_rows(pp, lane);
            const float cf = gvs * gelu_tanh((float)tot * dus);
#pragma unroll
            for (int q = 0; q < 16; ++q) {
                const int t = (__builtin_amdgcn_readlane((int)kb, q) >> 16) & 3;
                const float cs = __int_as_float(__builtin_amdgcn_readlane(__float_as_int(cf), 4 * q));
                f32x2 x[8];
#pragma unroll
                for (int c = 0; c < 4; ++c) { x[2 * c] = __builtin_amdgcn_cvt_pk_f32_fp8(vv[q][c], false); x[2 * c + 1] = __builtin_amdgcn_cvt_pk_f32_fp8(vv[q][c], true); }
                axpy_dispatch2(t, 0, cs, x, Y0, Y1);
                axpy_dispatch2(t, 2, cs, x, Y2, Y3);
            }
            __builtin_amdgcn_sched_barrier(0);
        }
#endif
        if (PM != 0) { const int fl = fresh_lane(); f32x2 a = Y0[0] + Y1[0] + Y2[0] + Y3[0];
#pragma unroll
            for (int i = 1; i < 8; ++i) a += Y0[i] + Y1[i] + Y2[i] + Y3[i];
            probe_out[(size_t)tb * 64 + fl] = a.x + a.y; }
        else { const int fl = fresh_lane(); tok_finish_mixed(Y0, tb, fl, h1b, h2b, rstd3); tok_finish_mixed(Y1, tb + 1, fl, h1b, h2b, rstd3); tok_finish_mixed(Y2, tb + 2, fl, h1b, h2b, rstd3); tok_finish_mixed(Y3, tb + 3, fl, h1b, h2b, rstd3); }
        __syncthreads();
    }
}
namespace pg8 {
#define PG8_LAS __attribute__((address_space(3)))
typedef unsigned short bf16_t;
typedef short bf16x8 __attribute__((ext_vector_type(8)));
typedef float f32x4 __attribute__((ext_vector_type(4)));
typedef unsigned u32x4 __attribute__((ext_vector_type(4)));
constexpr int BM = 256, BK = 64, HALF = 128, HTB = HALF * BK * 2  , STAGE_BYTES = 8 * HTB, NXCD = 8, WGM = 8;

__host__ __device__ __forceinline__ int lds_byte(int r, int c) { const int st = (r >> 4) * 2 + (c >> 5), rr = r & 15, cc = c & 31, ob = rr * 64 + cc * 2; return st * 1024 + (ob ^ (((ob >> 9) & 1) << 5)); }
__host__ __device__ __forceinline__ void stage_rc(int b, int& R, int& C) { const int st = b / 1024, sb = b % 1024, swz = sb ^ (((sb >> 9) & 1) << 5); R = (st >> 1) * 16 + swz / 64; C = (st & 1) * 32 + (swz % 64) / 2; }
__host__ __device__ __forceinline__ int perm32(int rho) { const int n = rho >> 4, i = rho & 15; return 8 * (i >> 2) + 4 * n + (i & 3); }

struct Unit { int pm, pn; };
struct Gemm { const bf16_t* A; const bf16_t* Bt; int K, lda, apn_shift, apn_stride; };

struct StaticOrder {
    int nM, nN, nwg, G, c;
    __host__ __device__ __forceinline__ void init(int M, int N, int G_, int c_) { nM = M / BM; nN = N / BM; nwg = nM * nN; G = G_; c = c_; }
    __host__ __device__ __forceinline__ bool next(int i, Unit& u) const {
        const long L = (long)i * G + c; if (L >= nwg) return false;
        int wgid = (int)L; { const int q = nwg / NXCD, r = nwg % NXCD, xcd = wgid % NXCD, off = wgid / NXCD; wgid = (xcd < r ? xcd * (q + 1) : r * (q + 1) + (xcd - r) * q) + off; }
        const int nig = WGM * nN, gid = wgid / nig, fm = gid * WGM, gsz = (nM - fm) < WGM ? (nM - fm) : WGM;
        u.pm = fm + ((wgid % nig) % gsz); u.pn = (wgid % nig) / gsz; return true;
    }
    __device__ __forceinline__ void a_ready(const Unit&) const {}
    __device__ __forceinline__ void done(const Unit&) const {}
};

__device__ __forceinline__ unsigned cvt_pk_bf16(float lo, float hi) { unsigned r; asm volatile("v_cvt_pk_bf16_f32 %0, %1, %2" : "=v"(r) : "v"(lo), "v"(hi)); return r; }

template <class Epi, class Sched, bool ALIGN_EPI = false, bool SP2 = false>
__device__ __forceinline__ void gemm_phase(PG8_LAS unsigned char* lds, const Gemm g, const Sched& S, const Epi& E, int wave_id  ) {
    const int lane = fresh_lane(), wid = wave_id, tid = wid * 64 + lane, wr = wid >> 2, wc = wid & 3, fr = lane & 15, fq = lane >> 4;
    const int K = g.K, nt = K / BK;
    unsigned voffA[2], voffB[2];
#pragma unroll
    for (int i = 0; i < 2; ++i) { int R, C; stage_rc(tid * 16 + i * 8192, R, C); const int Rb = Epi::PERM ? ((R & ~31) + perm32(R & 31)) : R;
        voffA[i] = (unsigned)(R * g.lda + C) * 2u; voffB[i] = (unsigned)(Rb * K + C) * 2u; }
    const size_t kstep = (size_t)(BK * 2);
    const size_t hstepA = (size_t)HALF * g.lda * 2, hstepB = (size_t)HALF * K * 2;
    const size_t tstepA = 2 * hstepA, tstepB = 2 * hstepB;
    const unsigned ldsw = (unsigned)wid * 1024u;
    const int aoff = lds_byte(wr * 64 + fr, fq * 8), boff = lds_byte(wc * 32 + fr, fq * 8);
#define PG8_SA(b, h) (((b) * 2 + (h)) * HTB)
#define PG8_SB(b, h) ((4 + (b) * 2 + (h)) * HTB)
#define PG8_STAGE(bufoff, gbase, voff) do { _Pragma("unroll") for (int _i = 0; _i < 2; ++_i) \
        __builtin_amdgcn_global_load_lds((const unsigned*)((const char*)(gbase) + (voff)[_i]), (PG8_LAS unsigned*)(lds + (bufoff) + ldsw + _i * 8192), 16, 0, 0); } while (0)
#define PG8_LDA(dst, b, h) do { _Pragma("unroll") for (int m = 0; m < 4; ++m) _Pragma("unroll") for (int k = 0; k < 2; ++k) dst[m][k] = *(const PG8_LAS bf16x8*)(lds + PG8_SA(b, h) + aoff + m * 2048 + k * 1024); } while (0)
#define PG8_LDB(dst, b, h) do { _Pragma("unroll") for (int n = 0; n < 2; ++n) _Pragma("unroll") for (int k = 0; k < 2; ++k) dst[n][k] = *(const PG8_LAS bf16x8*)(lds + PG8_SB(b, h) + boff + n * 2048 + k * 1024); } while (0)
#define PG8_MMA(ai, bj, At, Bt) do { __builtin_amdgcn_s_setprio(1); _Pragma("unroll") for (int m = 0; m < 4; ++m) _Pragma("unroll") for (int n = 0; n < 2; ++n) _Pragma("unroll") for (int k = 0; k < 2; ++k) \
        acc[ai][bj][m][n] = __builtin_amdgcn_mfma_f32_16x16x32_bf16(Bt[n][k], At[m][k], acc[ai][bj][m][n], 0, 0, 0); __builtin_amdgcn_s_setprio(0); } while (0)
#define PG8_WAIT_V(n) asm volatile("s_waitcnt vmcnt(" #n ")" ::: "memory")
#define PG8_WAIT_L(n) asm volatile("s_waitcnt lgkmcnt(" #n ")" ::: "memory")
#define PG8_BAR __builtin_amdgcn_s_barrier()
#define PG8_SCHED __builtin_amdgcn_sched_barrier(0)
    Unit cur, nxt; int ui = 0;
    if (!S.next(0, cur)) return;
    f32x4 acc[2][2][4][2];
#pragma unroll
    for (int a = 0; a < 2; ++a)
#pragma unroll
        for (int b = 0; b < 2; ++b)
#pragma unroll
            for (int m = 0; m < 4; ++m)
#pragma unroll
                for (int n = 0; n < 2; ++n) acc[a][b][m][n] = (f32x4){0.f, 0.f, 0.f, 0.f};
    bf16x8 At[4][2], B0[2][2], B1[2][2];
    const char* cA = (const char*)g.A + (size_t)cur.pm * tstepA + (size_t)((cur.pn >> g.apn_shift) * g.apn_stride) * 2; const char* cB = (const char*)g.Bt + (size_t)cur.pn * tstepB;
    S.a_ready(cur);
    if constexpr (SP2) {
        PG8_STAGE(PG8_SB(0, 0), cB, voffB); PG8_STAGE(PG8_SB(0, 1), cB + hstepB, voffB); PG8_STAGE(PG8_SA(0, 0), cA, voffA); PG8_STAGE(PG8_SA(0, 1), cA + hstepA, voffA);
        if (wr == 1) PG8_BAR;
        PG8_WAIT_V(2); PG8_BAR;
        PG8_STAGE(PG8_SB(1, 0), cB + kstep, voffB); PG8_STAGE(PG8_SA(1, 0), cA + kstep, voffA); PG8_STAGE(PG8_SB(1, 1), cB + hstepB + kstep, voffB);
        PG8_WAIT_V(6); PG8_BAR;
    } else {
        PG8_STAGE(PG8_SB(0, 0), cB, voffB); PG8_STAGE(PG8_SA(0, 0), cA, voffA); PG8_STAGE(PG8_SB(0, 1), cB + hstepB, voffB); PG8_STAGE(PG8_SA(0, 1), cA + hstepA, voffA);
        if (wr == 1) PG8_BAR;
        PG8_WAIT_V(4); PG8_BAR;
        PG8_STAGE(PG8_SB(1, 0), cB + kstep, voffB); PG8_STAGE(PG8_SA(1, 0), cA + kstep, voffA); PG8_STAGE(PG8_SB(1, 1), cB + hstepB + kstep, voffB);
        PG8_WAIT_V(6); PG8_BAR;
    }
    for (;;) {
        const bool has_next = S.next(ui + 1, nxt);
        const char* nA = has_next ? (const char*)g.A + (size_t)nxt.pm * tstepA + (size_t)((nxt.pn >> g.apn_shift) * g.apn_stride) * 2 : cA; const char* nB = has_next ? (const char*)g.Bt + (size_t)nxt.pn * tstepB : cB;
#pragma unroll 1
        for (int t = 0; t < nt; t += 2) {
            const bool last = (t == nt - 2);
            const char* a1 = cA + (size_t)(t + 1) * kstep;
            const char* a2 = last ? nA : cA + (size_t)(t + 2) * kstep; const char* b2 = last ? nB : cB + (size_t)(t + 2) * kstep;
            const char* a3 = a2 + kstep; const char* b3 = b2 + kstep;
            if (last && has_next) S.a_ready(nxt);
            if constexpr (SP2) {
            PG8_LDB(B0, 0, 0); PG8_LDB(B1, 0, 1); PG8_SCHED; PG8_LDA(At, 0, 0); PG8_STAGE(PG8_SA(1, 1), a1 + hstepA, voffA);
            PG8_WAIT_V(8); PG8_WAIT_L(0); PG8_BAR; PG8_MMA(0, 0, At, B0); PG8_MMA(0, 1, At, B1); PG8_BAR; PG8_SCHED;
            PG8_LDA(At, 0, 1); PG8_STAGE(PG8_SB(0, 0), b2, voffB); PG8_STAGE(PG8_SB(0, 1), b2 + hstepB, voffB); PG8_STAGE(PG8_SA(0, 0), a2, voffA);
            PG8_WAIT_V(8); PG8_WAIT_L(0); PG8_BAR; PG8_MMA(1, 0, At, B0); PG8_MMA(1, 1, At, B1); PG8_BAR; PG8_SCHED;
            PG8_LDB(B0, 1, 0); PG8_LDB(B1, 1, 1); PG8_SCHED; PG8_LDA(At, 1, 0); PG8_STAGE(PG8_SA(0, 1), a2 + hstepA, voffA);
            PG8_WAIT_V(8); PG8_WAIT_L(0); PG8_BAR; PG8_MMA(0, 0, At, B0); PG8_MMA(0, 1, At, B1); PG8_BAR; PG8_SCHED;
            PG8_LDA(At, 1, 1); PG8_STAGE(PG8_SB(1, 0), b3, voffB); PG8_STAGE(PG8_SB(1, 1), b3 + hstepB, voffB); PG8_STAGE(PG8_SA(1, 0), a3, voffA);
            PG8_WAIT_V(8); PG8_WAIT_L(0); PG8_BAR; PG8_MMA(1, 0, At, B0); PG8_MMA(1, 1, At, B1); PG8_BAR; PG8_SCHED;
            } else {
            PG8_LDB(B0, 0, 0); PG8_SCHED; PG8_LDA(At, 0, 0); PG8_STAGE(PG8_SA(1, 1), a1 + hstepA, voffA);
            PG8_WAIT_L(8); PG8_BAR; PG8_WAIT_L(0); PG8_MMA(0, 0, At, B0); PG8_BAR; PG8_SCHED;
            PG8_LDB(B1, 0, 1); PG8_STAGE(PG8_SB(0, 0), b2, voffB);
            PG8_BAR; PG8_WAIT_L(0); PG8_MMA(0, 1, At, B1); PG8_BAR;
            PG8_LDA(At, 0, 1); PG8_STAGE(PG8_SA(0, 0), a2, voffA);
            PG8_BAR; PG8_WAIT_L(0); PG8_MMA(1, 0, At, B0); PG8_BAR; PG8_SCHED;
            PG8_STAGE(PG8_SB(0, 1), b2 + hstepB, voffB);
            PG8_WAIT_V(6); PG8_BAR; PG8_MMA(1, 1, At, B1); PG8_BAR;
            PG8_LDB(B0, 1, 0); PG8_SCHED; PG8_LDA(At, 1, 0); PG8_STAGE(PG8_SA(0, 1), a2 + hstepA, voffA);
            PG8_WAIT_L(8); PG8_BAR; PG8_WAIT_L(0); PG8_MMA(0, 0, At, B0); PG8_BAR; PG8_SCHED;
            PG8_LDB(B1, 1, 1); PG8_STAGE(PG8_SB(1, 0), b3, voffB);
            PG8_BAR; PG8_WAIT_L(0); PG8_MMA(0, 1, At, B1); PG8_BAR;
            PG8_LDA(At, 1, 1); PG8_STAGE(PG8_SA(1, 0), a3, voffA);
            PG8_BAR; PG8_WAIT_L(0); PG8_MMA(1, 0, At, B0); PG8_BAR; PG8_SCHED;
            PG8_STAGE(PG8_SB(1, 1), b3 + hstepB, voffB);
            PG8_WAIT_V(6); PG8_BAR; PG8_MMA(1, 1, At, B1); PG8_BAR;
            }
        }
        if constexpr (ALIGN_EPI) { if (wr == 0) PG8_BAR; }
        if constexpr (!Epi::AFTER_DRAIN) { E(acc, cur, wr, wc, fr, fq); S.done(cur); }
        if (!has_next) break;
#pragma unroll
        for (int a = 0; a < 2; ++a)
#pragma unroll
            for (int b = 0; b < 2; ++b)
#pragma unroll
                for (int m = 0; m < 4; ++m)
#pragma unroll
                    for (int n = 0; n < 2; ++n) acc[a][b][m][n] = (f32x4){0.f, 0.f, 0.f, 0.f};
        cur = nxt; cA = nA; cB = nB; ++ui;
        if constexpr (ALIGN_EPI) { if (wr == 1) PG8_BAR; }
    }
    PG8_WAIT_V(0);
    if constexpr (!ALIGN_EPI) { if (wr == 0) PG8_BAR; }
    PG8_BAR;
    if constexpr (Epi::AFTER_DRAIN) { E.fused(acc, cur, wr, wc, fr, fq, lds, wid, lane); S.done(cur); }
#undef PG8_SA
#undef PG8_SB
#undef PG8_STAGE
#undef PG8_LDA
#undef PG8_LDB
#undef PG8_MMA
#undef PG8_WAIT_V
#undef PG8_WAIT_L
#undef PG8_BAR
#undef PG8_SCHED
}
}
#define GAS __attribute__((address_space(1)))
typedef GAS unsigned gu32;
#define RLX_AGENT __ATOMIC_RELAXED, __HIP_MEMORY_SCOPE_AGENT
#define LDS_WAIT() asm volatile("s_waitcnt lgkmcnt(0)" ::: "memory")
#define VM_WAIT() asm volatile("s_waitcnt vmcnt(0)" ::: "memory")
#define XB_TMO      128
#define XB_XCNT(j)  (256  + 64 * (j))
#define XB_XSUB(j)  (1280 + 64 * (j))
#define XB_XGEN(j)  (2304 + 64 * (j))
#define XB_TOP      3328
#define XB_TOPGEN   3392
#define XCD_BAR_WORDS 3456
#define XB_SPIN_CAP (1u << 18)

__device__ __forceinline__ unsigned xb_ld(unsigned* p)              { return __hip_atomic_load(p, __ATOMIC_RELAXED, __HIP_MEMORY_SCOPE_AGENT); }
__device__ __forceinline__ unsigned xb_add(unsigned* p, unsigned v) { return __hip_atomic_fetch_add(p, v, __ATOMIC_RELAXED, __HIP_MEMORY_SCOPE_AGENT); }
__device__ __forceinline__ unsigned xb_xcc_id() { return (unsigned)__builtin_amdgcn_s_getreg((3 << 11) | 20) & 0xFu; }
#define XB_SPIN(cond, bar) do { unsigned _sp = 0; while (cond) { __builtin_amdgcn_s_sleep(1); \
    if ((++_sp & 255u) == 0u) { if (xb_ld(&(bar)[XB_TMO])) break; if (_sp > XB_SPIN_CAP) { atomicAdd(&(bar)[XB_TMO], 1u); break; } } } } while (0)

struct XcdBarrier {
    unsigned* bar; unsigned x;
    volatile LAS unsigned* st;
};

__device__ __forceinline__ XcdBarrier xcd_barrier_post(unsigned* bar, volatile LAS unsigned* st) {
    XcdBarrier b; b.bar = bar; b.x = xb_xcc_id(); b.st = st;
    if (threadIdx.x == 0) (void)xb_add(&bar[XB_XCNT(b.x)], 1u);
    return b;
}
__device__ __forceinline__ void xcd_barrier_complete(unsigned* bar, unsigned x, unsigned& nloc, unsigned& nx) {
    const unsigned G = gridDim.x * gridDim.y * gridDim.z;
    unsigned sum, cnt, mine, sp = 0u;
    for (;;) {
        sum = 0u; cnt = 0u; mine = 0u;
#pragma unroll
        for (unsigned j = 0; j < 16; ++j) { const unsigned c = xb_ld(&bar[XB_XCNT(j)]); sum += c; cnt += (c > 0u) ? 1u : 0u; mine = (j == x) ? c : mine; }
        if (sum == G) break;
        __builtin_amdgcn_s_sleep(1);
        if ((++sp & 255u) == 0u) { if (xb_ld(&bar[XB_TMO])) break; if (sp > XB_SPIN_CAP) { atomicAdd(&bar[XB_TMO], 1u); break; } }
    }
    nloc = mine > 0u ? mine : 1u; nx = cnt > 0u ? cnt : 1u;
}

__device__ __forceinline__ void xcd_barrier(const XcdBarrier& b) {
    asm volatile("s_waitcnt vmcnt(0)" ::: "memory");
    __syncthreads();
    if (threadIdx.x == 0) {
        unsigned* bar = b.bar;
        __builtin_amdgcn_s_waitcnt(0);
        unsigned nloc = b.st[0], nx = b.st[1];
        if (nloc == 0u) { xcd_barrier_complete(bar, b.x, nloc, nx); b.st[0] = nloc; b.st[1] = nx; }
        const unsigned old = xb_add(&bar[XB_XSUB(b.x)], 1u);
        const unsigned gen = old / nloc;
        if (old + 1u == (gen + 1u) * nloc) {
            __builtin_amdgcn_fence(__ATOMIC_RELEASE, "agent");
            asm volatile("s_waitcnt vmcnt(0)" ::: "memory");
            const unsigned og = xb_add(&bar[XB_TOP], 1u);
            const unsigned tg = og / nx;
            if (og + 1u == (tg + 1u) * nx) xb_add(&bar[XB_TOPGEN], 1u);
            else XB_SPIN(xb_ld(&bar[XB_TOPGEN]) == tg, bar);
            __builtin_amdgcn_fence(__ATOMIC_ACQUIRE, "agent");
            xb_add(&bar[XB_XGEN(b.x)], 1u);
            asm volatile("s_waitcnt vmcnt(0)" ::: "memory");
        } else {
            XB_SPIN(xb_ld(&bar[XB_XGEN(b.x)]) == gen, bar);
            __builtin_amdgcn_fence(__ATOMIC_ACQUIRE, "agent");
            asm volatile("s_waitcnt vmcnt(0)" ::: "memory");
        }
    }
    __syncthreads();
}

constexpr int NWAVES = 8;
constexpr int LDS_MAIN = 135168;
constexpr int LDSCTL_OFF = LDS_MAIN;
constexpr int LDS_BYTES = 147456;
constexpr int CW_BAR = 4096;
constexpr size_t CTL_ZERO_BYTES = 1 * MiB;
constexpr float LOG2E = 1.4426950408889634f;
typedef short bf16x8 __attribute__((ext_vector_type(8)));
typedef float f32x16 __attribute__((ext_vector_type(16)));
typedef unsigned u32x2 __attribute__((ext_vector_type(2)));
using pg8::Unit;
using pg8::cvt_pk_bf16;

__device__ __forceinline__ f32x4 sig4(f32x4 v) { return (f32x4){sigmoidf_(v[0]), sigmoidf_(v[1]), sigmoidf_(v[2]), sigmoidf_(v[3])}; }
__device__ __forceinline__ f32x4 gelu4(f32x4 v) { return (f32x4){gelu_tanh(v[0]), gelu_tanh(v[1]), gelu_tanh(v[2]), gelu_tanh(v[3])}; }
__device__ __forceinline__ u32x4 pack8(f32x4 a, f32x4 b) { u32x4 w; w.x = cvt_pk_bf16(a[0], a[1]); w.y = cvt_pk_bf16(a[2], a[3]); w.z = cvt_pk_bf16(b[0], b[1]); w.w = cvt_pk_bf16(b[2], b[3]); return w; }

struct OneUnit { pg8::StaticOrder S; int k;
    __device__ __forceinline__ bool next(int i, Unit& u) const { return i == 0 && S.next(k, u); }
    __device__ __forceinline__ void a_ready(const Unit&) const {}
    __device__ __forceinline__ void done(const Unit&) const {} };
struct EpiProj {
    static constexpr bool PERM = true, AFTER_DRAIN = false;
    const float* rstd; unsigned char* ws;
    __device__ __forceinline__ void operator()(const f32x4 (&acc)[2][2][4][2], const Unit& u, int wr, int wc, int fr, int fq) const {
        { const int t_ = fresh_lane(); fr = t_ & 15; fq = t_ >> 4; }
        const int pn = u.pn; bf16* base; int ldc, coff, act;
        if (pn < 3) { base = (bf16*)(ws + WS_QKV); ldc = 768; coff = pn * 256; act = 0; }
        else if (pn < 7) { base = (bf16*)(ws + WS_LX); ldc = 1024; coff = (pn - 3) * 256; act = 0; }
        else if (pn < 11) { base = (bf16*)(ws + WS_GL); ldc = 1024; coff = (pn - 7) * 256; act = 1; }
        else if (pn < 15) { base = (bf16*)(ws + WS_SGA); ldc = 1024; coff = (pn - 11) * 256; act = 2; }
        else { base = (bf16*)(ws + WS_SGL); ldc = 1024; coff = (pn - 15) * 256; act = 2; }
        const int row0 = u.pm * 256 + wr * 64 + fr, col0 = coff + wc * 32 + 8 * fq;
#pragma unroll
        for (int ai = 0; ai < 2; ++ai)
#pragma unroll
            for (int m = 0; m < 4; ++m) {
                const int r = row0 + ai * 128 + m * 16; const float rs = rstd[r]; bf16* rowp = base + (size_t)r * ldc + col0;
#pragma unroll
                for (int bj = 0; bj < 2; ++bj) {
                    f32x4 v0 = acc[ai][bj][m][0] * rs, v1 = acc[ai][bj][m][1] * rs;
                    if (act == 1) { v0 = gelu4(v0); v1 = gelu4(v1); } else if (act == 2) { v0 = sig4(v0); v1 = sig4(v1); }
                    *(u32x4*)(rowp + bj * 128) = pack8(v0, v1);
                }
            }
    }
};
struct EpiMP {
    static constexpr bool PERM = false, AFTER_DRAIN = false;
    const bf16* sga; float* mp;
    __device__ __forceinline__ void operator()(const f32x4 (&acc)[2][2][4][2], const Unit& u, int wr, int wc, int fr, int fq) const {
        { const int t_ = fresh_lane(); fr = t_ & 15; fq = t_ >> 4; }
        const int row0 = u.pm * 256 + wr * 64 + fr, col0 = u.pn * 256 + wc * 32 + 4 * fq;
#pragma unroll
        for (int ai = 0; ai < 2; ++ai)
#pragma unroll
            for (int m = 0; m < 4; ++m) {
                const size_t off = (size_t)(row0 + ai * 128 + m * 16) * 1024 + col0;
#pragma unroll
                for (int bj = 0; bj < 2; ++bj)
#pragma unroll
                    for (int n = 0; n < 2; ++n) { const size_t o = off + bj * 128 + n * 16; const f32x4 g = bf4_lo(*(const u32x2*)(sga + o)); const f32x4 v = acc[ai][bj][m][n] * g;
#if ALL_FUSED
                        u32x2 w; w.x = cvt_pk_bf16(v[0], v[1]); w.y = cvt_pk_bf16(v[2], v[3]); *(u32x2*)((bf16*)mp + o) = w;
#else
                        *(f32x4*)(mp + o) = v;
#endif
                    }
            }
    }
};
struct EpiMerged {
    static constexpr bool PERM = true, AFTER_DRAIN = false;
    const bf16* sgl; const float* mp; bf16* merged;
    __device__ __forceinline__ void operator()(const f32x4 (&acc)[2][2][4][2], const Unit& u, int wr, int wc, int fr, int fq) const {
        { const int t_ = fresh_lane(); fr = t_ & 15; fq = t_ >> 4; }
        const int row0 = u.pm * 256 + wr * 64 + fr, col0 = u.pn * 256 + wc * 32 + 8 * fq;
#pragma unroll
        for (int ai = 0; ai < 2; ++ai)
#pragma unroll
            for (int m = 0; m < 4; ++m) {
                const size_t off = (size_t)(row0 + ai * 128 + m * 16) * 1024 + col0;
#pragma unroll
                for (int bj = 0; bj < 2; ++bj) {
                    const size_t o = off + bj * 128; const u32x4 gw = *(const u32x4*)(sgl + o);
#if ALL_FUSED
                    const u32x4 mw = *(const u32x4*)((const bf16*)mp + o); const f32x4 m0 = bf4_lo((u32x2){mw.x, mw.y}), m1 = bf4_lo((u32x2){mw.z, mw.w});
#else
                    const f32x4 m0 = *(const f32x4*)(mp + o), m1 = *(const f32x4*)(mp + o + 4);
#endif
                    const f32x4 v0 = m0 + acc[ai][bj][m][0] * bf4_lo((u32x2){gw.x, gw.y}), v1 = m1 + acc[ai][bj][m][1] * bf4_lo((u32x2){gw.z, gw.w});
                    *(u32x4*)(merged + o) = pack8(v0, v1);
                }
            }
    }
};
struct EpiH1 {
    static constexpr bool PERM = true, AFTER_DRAIN = false;
    const float* x; float* h1; bf16* h1b; float* part;
    __device__ __forceinline__ void operator()(const f32x4 (&acc)[2][2][4][2], const Unit& u, int wr, int wc, int fr, int fq) const {
        { const int t_ = fresh_lane(); fr = t_ & 15; fq = t_ >> 4; }
        const int row0 = u.pm * 256 + wr * 64 + fr, col0 = u.pn * 256 + wc * 32 + 8 * fq;
#pragma unroll
        for (int ai = 0; ai < 2; ++ai)
#pragma unroll
            for (int m = 0; m < 4; ++m) {
                const int r = row0 + ai * 128 + m * 16; const size_t off = (size_t)r * 1024 + col0; float sq = 0.f;
#pragma unroll
                for (int bj = 0; bj < 2; ++bj) {
                    const size_t o = off + bj * 128;
                    const f32x4 v0 = *(const f32x4*)(x + o) + acc[ai][bj][m][0], v1 = *(const f32x4*)(x + o + 4) + acc[ai][bj][m][1];
#if !ALL_FUSED
                    *(f32x4*)(h1 + o) = v0; *(f32x4*)(h1 + o + 4) = v1;
#endif
                    *(u32x4*)(h1b + o) = pack8(v0, v1);
                    sq += (v0[0] * v0[0] + v0[1] * v0[1]) + (v0[2] * v0[2] + v0[3] * v0[3]) + (v1[0] * v1[0] + v1[1] * v1[1]) + (v1[2] * v1[2] + v1[3] * v1[3]);
                }
                sq += __shfl_xor(sq, 16); sq += __shfl_xor(sq, 32);
                if (fq == 0) part[(size_t)r * 16 + u.pn * 4 + wc] = sq;
            }
    }
};
struct EpiScore {
    static constexpr bool PERM = false, AFTER_DRAIN = false;
    const float* part; float* sc;
    __device__ __forceinline__ void operator()(const f32x4 (&acc)[2][2][4][2], const Unit& u, int wr, int wc, int fr, int fq) const {
        { const int t_ = fresh_lane(); fr = t_ & 15; fq = t_ >> 4; }
        const int row0 = u.pm * 256 + wr * 64 + fr, col0 = u.pn * 256 + wc * 32 + 4 * fq;
#pragma unroll
        for (int ai = 0; ai < 2; ++ai)
#pragma unroll
            for (int m = 0; m < 4; ++m) {
                const int r = row0 + ai * 128 + m * 16; const f32x4* pp = (const f32x4*)(part + (size_t)r * 16);
                const f32x4 s4 = (pp[0] + pp[1]) + (pp[2] + pp[3]); const float rs = 1.0f / sqrtf(((s4[0] + s4[1]) + (s4[2] + s4[3])) * (1.0f / 1024.0f) + EPS);
                const size_t off = (size_t)r * 1024 + col0;
#pragma unroll
                for (int bj = 0; bj < 2; ++bj)
#pragma unroll
                    for (int n = 0; n < 2; ++n) *(f32x4*)(sc + off + bj * 128 + n * 16) = acc[ai][bj][m][n] * rs;
            }
    }
};
__device__ __forceinline__ void uv_convert(const float* pu, const float* pv, const float* gffn, unsigned char* u8, unsigned char* v8, float* iu, float* iv, int gw, int NGW, int lane) {
    f32x4 g[4];
#pragma unroll
    for (int j = 0; j < 4; ++j) g[j] = ((const f32x4*)gffn)[4 * lane + j];
    for (int e0 = gw; e0 < 2 * 16384; e0 += 2 * NGW) {
        f32x4 v[2][4];
#pragma unroll
        for (int h = 0; h < 2; ++h) { const int e = e0 + h * NGW; const bool isv = e >= 16384; const int row = isv ? e - 16384 : e;
            const f32x4* src = (const f32x4*)((isv ? pv : pu) + (size_t)row * 1024) + 4 * lane;
#pragma unroll
            for (int j = 0; j < 4; ++j) v[h][j] = src[j]; }
#pragma unroll
        for (int h = 0; h < 2; ++h) {
            const int e = e0 + h * NGW; const bool isv = e >= 16384; const int row = isv ? e - 16384 : e;
            float am = 0.f;
#pragma unroll
            for (int j = 0; j < 4; ++j) { if (!isv) v[h][j] = v[h][j] * g[j]; am = fmaxf(am, fmaxf(fmaxf(fabsf(v[h][j][0]), fabsf(v[h][j][1])), fmaxf(fabsf(v[h][j][2]), fabsf(v[h][j][3])))); }
#pragma unroll
            for (int o = 1; o < 64; o <<= 1) am = fmaxf(am, __shfl_xor(am, o));
            const float sc = am > 0.f ? (isv ? 416.0f : 127.0f) / am : 1.0f;
            u32x4 w;
            if (isv) {
#pragma unroll
                for (int j = 0; j < 4; ++j) { unsigned ww = 0u; ww = __builtin_amdgcn_cvt_pk_fp8_f32(v[h][j][0] * sc, v[h][j][1] * sc, ww, false); ww = __builtin_amdgcn_cvt_pk_fp8_f32(v[h][j][2] * sc, v[h][j][3] * sc, ww, true); w[j] = ww; }
            } else {
#pragma unroll
                for (int j = 0; j < 4; ++j) { unsigned ww = 0u;
#pragma unroll
                    for (int c = 0; c < 4; ++c) ww |= ((unsigned)(int)__builtin_rintf(v[h][j][c] * sc) & 0xffu) << (8 * c);
                    w[j] = ww; }
            }
            *(u32x4*)((isv ? v8 : u8) + (size_t)row * 1024 + 16 * lane) = w;
            if (lane == 0) (isv ? iv : iu)[row] = 1.0f / sc;
        }
    }
}
struct EpiTopk {
    static constexpr bool PERM = false, AFTER_DRAIN = true;
    const float* part; int* seli; float* selg;
    const float* pu; const float* pv; const float* gffn; unsigned char* u8; unsigned char* v8; float* iu; float* iv; int uvslot, uvn;
    __device__ __forceinline__ void fused(f32x4 (&acc)[2][2][4][2], const Unit& u, int wr, int wc, int fr, int fq, PG8_LAS unsigned char* lds, int wid, int lane) const {
        LAS float* L = (LAS float*)lds;
#pragma unroll
        for (int ai = 0; ai < 2; ++ai) {
            { const int t_ = fresh_lane(); fr = t_ & 15; fq = t_ >> 4; }
#pragma unroll
            for (int m = 0; m < 4; ++m) {
                const int rl = wr * 64 + m * 16 + fr, r = u.pm * 256 + ai * 128 + rl;
                const f32x4* pp = (const f32x4*)(part + (size_t)r * 16);
                const f32x4 s4 = (pp[0] + pp[1]) + (pp[2] + pp[3]); const float rs = 1.0f / sqrtf(((s4[0] + s4[1]) + (s4[2] + s4[3])) * (1.0f / 1024.0f) + EPS);
#pragma unroll
                for (int bj = 0; bj < 2; ++bj)
#pragma unroll
                    for (int n = 0; n < 2; ++n) *(LAS f32x4*)(L + (rl * 2 + bj) * TK_LSTRIDE + wc * 32 + 16 * n + 4 * fq) = acc[ai][bj][m][n] * rs;
            }
            asm volatile("s_waitcnt lgkmcnt(0)" ::: "memory"); __builtin_amdgcn_s_barrier(); asm volatile("" ::: "memory");
            const int tid = wid * 64 + fresh_lane();
            if (wid < 4) {
                const LAS float* my = L + tid * TK_LSTRIDE;
                unsigned a16[16];
#pragma unroll
                for (int g = 0; g < 8; ++g) {
                    unsigned t[16];
#pragma unroll
                    for (int q = 0; q < 4; ++q) {
                        const f32x4 v = *(const LAS f32x4*)(my + g * 16 + q * 4);
#pragma unroll
                        for (int c = 0; c < 4; ++c) { const int e = g * 16 + q * 4 + c; const float vc = v[c]; t[q * 4 + c] = (tk_f2key(vc) & ~127u) | (unsigned)(127 - e); }
                    }
                    tk_sort16(t);
                    if (g == 0) {
#pragma unroll
                        for (int i = 0; i < 16; ++i) a16[i] = t[i];
                    } else tk_merge16(a16, t);
                }
                unsigned oth[16];
#pragma unroll
                for (int i = 0; i < 16; ++i) oth[i] = (unsigned)__shfl_xor((int)a16[i], 1);
                if ((tid & 1) == 0) {
                    const int tok = u.pm * 256 + ai * 128 + (tid >> 1);
                    tk_combine_store(a16, oth, seli + (size_t)tok * 128 + u.pn * 16, selg + (size_t)tok * 128 + u.pn * 16);
                }
            } else if (uvn > 0) uv_convert(pu, pv, gffn, u8, v8, iu, iv, uvslot + 4 * ai + (wid - 4), uvn, fresh_lane());
            asm volatile("s_waitcnt lgkmcnt(0)" ::: "memory"); __builtin_amdgcn_s_barrier(); asm volatile("" ::: "memory");
        }
    }
};
struct EpiPP {
    static constexpr bool PERM = true, AFTER_DRAIN = false;
    bf16* pp;
    __device__ __forceinline__ void operator()(const f32x4 (&acc)[2][2][4][2], const Unit& u, int wr, int wc, int fr, int fq) const {
        { const int t_ = fresh_lane(); fr = t_ & 15; fq = t_ >> 4; }
        const int row0 = u.pm * 256 + wr * 64 + fr, col0 = u.pn * 256 + wc * 32 + 8 * fq;
#pragma unroll
        for (int ai = 0; ai < 2; ++ai)
#pragma unroll
            for (int m = 0; m < 4; ++m) {
                const size_t off = (size_t)(row0 + ai * 128 + m * 16) * 1024 + col0;
#pragma unroll
                for (int bj = 0; bj < 2; ++bj) *(u32x4*)(pp + off + bj * 128) = pack8(acc[ai][bj][m][0], acc[ai][bj][m][1]);
            }
    }
};
struct EpiH3 {
    static constexpr bool PERM = true, AFTER_DRAIN = false;
    const float* rstd3; const bf16* pp; float* h; float* part; const bf16* h2b; bf16* h3b;
    __device__ __forceinline__ void operator()(const f32x4 (&acc)[2][2][4][2], const Unit& u, int wr, int wc, int fr, int fq) const {
        { const int t_ = fresh_lane(); fr = t_ & 15; fq = t_ >> 4; }
        const int row0 = u.pm * 256 + wr * 64 + fr, col0 = u.pn * 256 + wc * 32 + 8 * fq;
#pragma unroll
        for (int ai = 0; ai < 2; ++ai)
#pragma unroll
            for (int m = 0; m < 4; ++m) {
                const int r = row0 + ai * 128 + m * 16; const size_t off = (size_t)r * 1024 + col0; const float rs = rstd3[r]; float sq = 0.f;
#pragma unroll
                for (int bj = 0; bj < 2; ++bj) {
                    const size_t o = off + bj * 128; const u32x4 pw = *(const u32x4*)(pp + o);
#if ALL_FUSED
                    const u32x4 hw = *(const u32x4*)(h2b + o);
                    const f32x4 v0 = bf4_lo((u32x2){hw.x, hw.y}) + sig4(acc[ai][bj][m][0] * rs) * bf4_lo((u32x2){pw.x, pw.y});
                    const f32x4 v1 = bf4_lo((u32x2){hw.z, hw.w}) + sig4(acc[ai][bj][m][1] * rs) * bf4_lo((u32x2){pw.z, pw.w});
                    *(u32x4*)(h3b + o) = pack8(v0, v1);
#else
                    const f32x4 v0 = *(const f32x4*)(h + o) + sig4(acc[ai][bj][m][0] * rs) * bf4_lo((u32x2){pw.x, pw.y});
                    const f32x4 v1 = *(const f32x4*)(h + o + 4) + sig4(acc[ai][bj][m][1] * rs) * bf4_lo((u32x2){pw.z, pw.w});
                    *(f32x4*)(h + o) = v0; *(f32x4*)(h + o + 4) = v1;
#endif
                    sq += (v0[0] * v0[0] + v0[1] * v0[1]) + (v0[2] * v0[2] + v0[3] * v0[3]) + (v1[0] * v1[0] + v1[1] * v1[1]) + (v1[2] * v1[2] + v1[3] * v1[3]);
                }
                sq += __shfl_xor(sq, 16); sq += __shfl_xor(sq, 32);
                if (fq == 0) part[(size_t)r * 16 + u.pn * 4 + wc] = sq;
            }
    }
};
struct EpiPre {
    static constexpr bool PERM = false, AFTER_DRAIN = false;
    float* rp; float* ip;
    __device__ __forceinline__ void operator()(const f32x4 (&acc)[2][2][4][2], const Unit& u, int wr, int wc, int fr, int fq) const {
        { const int t_ = fresh_lane(); fr = t_ & 15; fq = t_ >> 4; }
#pragma unroll
        for (int n = 0; n < 2; ++n) { const int ch = u.pn * 128 + wc * 32 + 16 * n + 4 * fq;
#pragma unroll
            for (int ai = 0; ai < 2; ++ai)
#pragma unroll
                for (int m = 0; m < 4; ++m) { const int r = u.pm * 256 + ai * 128 + wr * 64 + m * 16 + fr; const size_t o = (size_t)r * 1024 + ch; *(f32x4*)(rp + o) = acc[ai][0][m][n]; *(f32x4*)(ip + o) = acc[ai][1][m][n]; } }
    }
};
struct EpiH3Final {
    static constexpr bool PERM = true, AFTER_DRAIN = false;
    const float* rstd3; const bf16* pp; const bf16* h2b; const float* fg; float* out; float* part; unsigned* cnt;
    __device__ __forceinline__ void operator()(f32x4 (&acc)[2][2][4][2], const Unit& u, int wr, int wc, int fr, int fq) const {
        { const int t_ = fresh_lane(); fr = t_ & 15; fq = t_ >> 4; }
        const int row0 = u.pm * 256 + wr * 64 + fr, col0 = u.pn * 256 + wc * 32 + 8 * fq;
#pragma unroll
        for (int ai = 0; ai < 2; ++ai)
#pragma unroll
            for (int m = 0; m < 4; ++m) {
                const int r = row0 + ai * 128 + m * 16; const size_t off = (size_t)r * 1024 + col0; const float rs = rstd3[r]; float sq = 0.f;
#pragma unroll
                for (int bj = 0; bj < 2; ++bj) {
                    const size_t o = off + bj * 128; const u32x4 pw = *(const u32x4*)(pp + o); const u32x4 hw = *(const u32x4*)(h2b + o);
                    const f32x4 v0 = bf4_lo((u32x2){hw.x, hw.y}) + sig4(acc[ai][bj][m][0] * rs) * bf4_lo((u32x2){pw.x, pw.y});
                    const f32x4 v1 = bf4_lo((u32x2){hw.z, hw.w}) + sig4(acc[ai][bj][m][1] * rs) * bf4_lo((u32x2){pw.z, pw.w});
                    acc[ai][bj][m][0] = v0; acc[ai][bj][m][1] = v1;
                    sq += (v0[0] * v0[0] + v0[1] * v0[1]) + (v0[2] * v0[2] + v0[3] * v0[3]) + (v1[0] * v1[0] + v1[1] * v1[1]) + (v1[2] * v1[2] + v1[3] * v1[3]);
                }
                sq += __shfl_xor(sq, 16); sq += __shfl_xor(sq, 32);
                if (fq == 0) __hip_atomic_store(part + (size_t)r * 16 + u.pn * 4 + wc, sq, __ATOMIC_RELAXED, __HIP_MEMORY_SCOPE_AGENT);
            }
        asm volatile("s_waitcnt vmcnt(0)" ::: "memory");
        const int lane = fq * 16 + fr;
        unsigned* c = cnt + 64 * u.pm;
        if (lane == 0) __hip_atomic_fetch_add(c, 1u, __ATOMIC_RELAXED, __HIP_MEMORY_SCOPE_AGENT);
        {
            const unsigned long long t0 = __builtin_amdgcn_s_memrealtime();
            while ((unsigned)__builtin_amdgcn_readfirstlane((int)__hip_atomic_load(c, __ATOMIC_RELAXED, __HIP_MEMORY_SCOPE_AGENT)) < 32u) {
                if (__builtin_amdgcn_s_memrealtime() - t0 > 2000000ull) break;
                __builtin_amdgcn_s_sleep(2);
            }
        }
        { const int t_ = fresh_lane(); fr = t_ & 15; fq = t_ >> 4; }
#pragma unroll
        for (int ai = 0; ai < 2; ++ai)
#pragma unroll
            for (int m = 0; m < 4; ++m) {
                const int r = u.pm * 256 + wr * 64 + fr + ai * 128 + m * 16;
                float ps = 0.f;
#pragma unroll
                for (int k = 0; k < 16; ++k) ps += __hip_atomic_load(part + (size_t)r * 16 + k, __ATOMIC_RELAXED, __HIP_MEMORY_SCOPE_AGENT);
                const float rr = 1.0f / sqrtf(ps * (1.0f / 1024.0f) + EPS);
                const int cc = u.pn * 256 + wc * 32 + 8 * fq;
#pragma unroll
                for (int bj = 0; bj < 2; ++bj) {
                    const f32x4 g0 = *(const f32x4*)(fg + cc + bj * 128), g1 = *(const f32x4*)(fg + cc + bj * 128 + 4);
                    float* op = out + (size_t)r * 1024 + cc + bj * 128;
                    *(f32x4*)op = acc[ai][bj][m][0] * rr * g0; *(f32x4*)(op + 4) = acc[ai][bj][m][1] * rr * g1;
                }
            }
    }
};
template <int CTRL> __device__ __forceinline__ float dpp_f(float oldv, float src) {
    return __builtin_bit_cast(float, __builtin_amdgcn_update_dpp(__builtin_bit_cast(int, oldv), __builtin_bit_cast(int, src), CTRL, 0xf, 0xf, false));
}
#ifndef LRU_T2
#define LRU_T2 0
#endif
struct EpiLru {
    static constexpr bool PERM = false, AFTER_DRAIN = false;
    const bf16* lin; const float* ba; const float* bx; const float* c8l; bf16* hloc; bf16* pcum; float* agg;
    template <int SH> static __device__ __forceinline__ void step(f32x4& A, f32x4& Bv, float idd) {
#pragma unroll
        for (int j = 0; j < 4; ++j) {
            const float ap = __int_as_float(__builtin_amdgcn_update_dpp(0, __float_as_int((float)A[j]), 0x110 + SH, 0xf, 0xf, true)) + idd;
            const float bp = __int_as_float(__builtin_amdgcn_update_dpp(0, __float_as_int((float)Bv[j]), 0x110 + SH, 0xf, 0xf, true));
            Bv[j] = fmaf(A[j], bp, Bv[j]); A[j] = A[j] * ap; }
    }
    __device__ __forceinline__ void operator()(f32x4 (&acc)[2][2][4][2], const Unit& u, int wr, int wc, int fr, int fq) const {
        { const int t_ = fresh_lane(); fr = t_ & 15; fq = t_ >> 4; }
        const int lane = fq * 16 + fr;
#pragma unroll
        for (int n = 0; n < 2; ++n) {
            const int ch = u.pn * 128 + wc * 32 + 16 * n + 4 * fq;
            const f32x4 bav = *(const f32x4*)(ba + ch), bxv = *(const f32x4*)(bx + ch), cv = *(const f32x4*)(c8l + ch);
#pragma unroll
            for (int ai = 0; ai < 2; ++ai)
#pragma unroll
                for (int m = 0; m < 4; ++m) {
                    const int r = u.pm * 256 + ai * 128 + wr * 64 + m * 16 + fr; const unsigned o = (unsigned)r * 1024u + (unsigned)ch;
                    const f32x4 lv = bf4_lo(*(const u32x2*)(lin + o));
#pragma unroll
                    for (int j = 0; j < 4; ++j) {
                        const float rr = sigmoidf_(acc[ai][0][m][n][j] + bav[j]), ii = sigmoidf_(acc[ai][1][m][n][j] + bxv[j]);
                        const float a = __builtin_amdgcn_exp2f(cv[j] * rr);
                        acc[ai][0][m][n][j] = a; acc[ai][1][m][n][j] = __builtin_amdgcn_sqrtf(fmaxf(1.0f - a * a, 0.f)) * (ii * lv[j]);
                    }
                    asm volatile("" : "+v"(acc[ai][0][m][n]), "+v"(acc[ai][1][m][n]));
                }
        }
#if defined(LRU_DEBUG) && LRU_DEBUG == 1
        {
            float* af = (float*)hloc; float* bf = (float*)pcum;
#pragma unroll
            for (int n = 0; n < 2; ++n) { const int ch = u.pn * 128 + wc * 32 + 16 * n + 4 * fq;
#pragma unroll
                for (int ai = 0; ai < 2; ++ai)
#pragma unroll
                    for (int m = 0; m < 4; ++m) { const int r = u.pm * 256 + ai * 128 + wr * 64 + m * 16 + fr; const size_t o = (size_t)r * 1024 + ch; *(f32x4*)(af + o) = acc[ai][0][m][n]; *(f32x4*)(bf + o) = acc[ai][1][m][n]; } }
            return;
        }
#endif
        __builtin_amdgcn_sched_barrier(0);
        const float id1 = fr < 1 ? 1.f : 0.f, id2 = fr < 2 ? 1.f : 0.f, id4 = fr < 4 ? 1.f : 0.f, id8 = fr < 8 ? 1.f : 0.f;
#pragma unroll
        for (int ai = 0; ai < 2; ++ai)
#pragma unroll
            for (int m = 0; m < 4; ++m)
#pragma unroll
                for (int n = 0; n < 2; ++n) { step<1>(acc[ai][0][m][n], acc[ai][1][m][n], id1); step<2>(acc[ai][0][m][n], acc[ai][1][m][n], id2); step<4>(acc[ai][0][m][n], acc[ai][1][m][n], id4); step<8>(acc[ai][0][m][n], acc[ai][1][m][n], id8);
                    asm volatile("" : "+v"(acc[ai][0][m][n]), "+v"(acc[ai][1][m][n])); }
        { const int t_ = fresh_lane(); fr = t_ & 15; fq = t_ >> 4; }
        const int src4 = (((fq * 16 + fr) & 48) | 15) * 4;
#pragma unroll
        for (int n = 0; n < 2; ++n) {
            const int ch = u.pn * 128 + wc * 32 + 16 * n + 4 * fq;
#pragma unroll
            for (int ai = 0; ai < 2; ++ai) {
#pragma unroll
                for (int m = 0; m < 4; ++m) {
                    f32x4& A = acc[ai][0][m][n]; f32x4& Bv = acc[ai][1][m][n];
                    if (m > 0 && !(LRU_T2)) {
#pragma unroll
                        for (int j = 0; j < 4; ++j) { const float pa = acc[ai][0][m - 1][n][j], pb = acc[ai][1][m - 1][n][j];
                            const float ac = __int_as_float(__builtin_amdgcn_ds_bpermute(src4, __float_as_int(pa))), bc = __int_as_float(__builtin_amdgcn_ds_bpermute(src4, __float_as_int(pb))); Bv[j] = fmaf(A[j], bc, Bv[j]); A[j] = A[j] * ac; }
                    }
                    const int r = u.pm * 256 + ai * 128 + wr * 64 + m * 16 + fr; const unsigned o = (unsigned)r * 1024u + (unsigned)ch;
                    u32x2 wp, wh; wp.x = cvt_pk_bf16(A[0], A[1]); wp.y = cvt_pk_bf16(A[2], A[3]); wh.x = cvt_pk_bf16(Bv[0], Bv[1]); wh.y = cvt_pk_bf16(Bv[2], Bv[3]);
                    *(u32x2*)(pcum + o) = wp; *(u32x2*)(hloc + o) = wh;
                    if (m == 3 && fr == 15) {
                        const int chunk = u.pm * 4 + ai * 2 + wr; float* ap = agg + ((size_t)chunk * 1024 + ch) * 2;
                        *(f32x4*)(ap) = (f32x4){A[0], Bv[0], A[1], Bv[1]}; *(f32x4*)(ap + 4) = (f32x4){A[2], Bv[2], A[3], Bv[3]};
                    }
                    __builtin_amdgcn_sched_barrier(0);
                }
            }
        }
    }
};

__device__ __forceinline__ void p0_transpose_item(const float* W, int ldw, const float* gain, bf16* WT, int ldt, int k_off, LAS float* scr, int kb, int nb, int lane) {
    const int k0 = 64 * kb, n0 = 32 * nb;
    const int c4 = lane & 7, kr = lane >> 3;
    f32x4 v[8];
#pragma unroll
    for (int i = 0; i < 8; ++i) v[i] = *(const f32x4*)(W + (size_t)(k0 + 8 * i + kr) * ldw + n0 + 4 * c4);
#pragma unroll
    for (int i = 0; i < 8; ++i) { f32x4 x = v[i]; if (gain) x = x * gain[k0 + 8 * i + kr]; *(LAS f32x4*)(scr + (8 * i + kr) * 36 + 4 * c4) = x; }
    LDS_WAIT(); asm volatile("" ::: "memory");
    const int c = lane & 7;
#pragma unroll
    for (int j = 0; j < 4; ++j) { const int n = (lane >> 3) + 8 * j; const LAS float* sp = scr + (8 * c) * 36 + n;
        u32x4 o; o.x = pk2(sp[0 * 36], sp[1 * 36]); o.y = pk2(sp[2 * 36], sp[3 * 36]); o.z = pk2(sp[4 * 36], sp[5 * 36]); o.w = pk2(sp[6 * 36], sp[7 * 36]);
        *(u32x4*)(WT + (size_t)(n0 + n) * ldt + k_off + k0 + 8 * c) = o; }
    LDS_WAIT(); asm volatile("" ::: "memory");
}
__device__ __forceinline__ void p0_wfold_item(LAS float* lds, const float* wq, const float* k1, const float* k2, const float* gffn, bf16* wfold, int item, int tid) {
    const int hh = item >> 4, kb = item & 15;
    LAS float* wqs = lds; LAS float* kks = lds + 64 * 132;
    const float* ksrc = (hh & 1) ? k2 : k1;
#pragma unroll
    for (int i = 0; i < 4; ++i) { const int e = tid + i * 512, r = e >> 5, c4 = e & 31; *(LAS f32x4*)(wqs + r * 132 + 4 * c4) = *(const f32x4*)(wq + (size_t)(kb * 64 + r) * 2048 + hh * 128 + 4 * c4); }
#pragma unroll
    for (int i = 0; i < 8; ++i) { const int e = tid + i * 512, r = e >> 5, c4 = e & 31; *(LAS f32x4*)(kks + r * 132 + 4 * c4) = *(const f32x4*)(ksrc + (size_t)r * 128 + 4 * c4); }
    __syncthreads();
    const int tk = tid & 15, tkey = tid >> 4;
    float acc[4][4];
#pragma unroll
    for (int i = 0; i < 4; ++i)
#pragma unroll
        for (int j = 0; j < 4; ++j) acc[i][j] = 0.f;
#pragma unroll 2
    for (int c4 = 0; c4 < 32; ++c4) {
        f32x4 a[4], b[4];
#pragma unroll
        for (int i = 0; i < 4; ++i) { a[i] = *(const LAS f32x4*)(wqs + (tk * 4 + i) * 132 + 4 * c4); b[i] = *(const LAS f32x4*)(kks + (tkey * 4 + i) * 132 + 4 * c4); }
#pragma unroll
        for (int i = 0; i < 4; ++i)
#pragma unroll
            for (int j = 0; j < 4; ++j) acc[i][j] += (a[i][0] * b[j][0] + a[i][1] * b[j][1]) + (a[i][2] * b[j][2] + a[i][3] * b[j][3]);
    }
    const int kg = kb * 64 + tk * 4; const f32x4 gv = *(const f32x4*)(gffn + kg);
#pragma unroll
    for (int j = 0; j < 4; ++j) { u32x2 w; w.x = pk2(acc[0][j] * gv[0], acc[1][j] * gv[1]); w.y = pk2(acc[2][j] * gv[2], acc[3][j] * gv[3]);
        *(u32x2*)(wfold + (size_t)(hh * 128 + tkey * 4 + j) * 1024 + kg) = w; }
    __syncthreads();
}

struct In { const float* p[25]; };
enum { I_X = 0, I_P, I_GMIX, I_WIN, I_SINK, I_CONVW, I_CONVB, I_WA, I_BA, I_WX, I_BX, I_LAM, I_WUA, I_WUL, I_WO, I_GFFN, I_WQ, I_K1, I_K2, I_U, I_V, I_GPLE, I_WGATE, I_WPROJ, I_FG };

__device__ __forceinline__ void p0_prologue(const In& in, unsigned char* ws, LAS unsigned char* lds, int vcu, int G, int wave, int tid) {
    const int lane = tid & 63;
    LAS float* scr = (LAS float*)(lds + wave * 16384);
    const int gw = vcu * NWAVES + wave, NGW = G * NWAVES;
    constexpr int I_IN = 16 * 152, I_UA = 8 * 32, I_SQ = 16 * 32, I_PJ = 4 * 32, I_AX = 128;
    constexpr int NITEMS = I_IN + I_UA + 3 * I_SQ + I_PJ + I_AX;
    for (int it = gw; it < NITEMS; it += NGW) {
        int r = it;
        if (r < I_IN) { p0_transpose_item(in.p[I_WIN], INW, in.p[I_GMIX], (bf16*)(ws + WS_WIN), 1024, 0, scr, r / 152, r % 152, lane); continue; } r -= I_IN;
        if (r < I_UA) { p0_transpose_item(in.p[I_WUA], 1024, nullptr, (bf16*)(ws + WS_WUA), 512, 0, scr, r / 32, r % 32, lane); continue; } r -= I_UA;
        if (r < I_SQ) { p0_transpose_item(in.p[I_WUL], 1024, nullptr, (bf16*)(ws + WS_WUL), 1024, 0, scr, r / 32, r % 32, lane); continue; } r -= I_SQ;
        if (r < I_SQ) { p0_transpose_item(in.p[I_WO], 1024, nullptr, (bf16*)(ws + WS_WO), 1024, 0, scr, r / 32, r % 32, lane); continue; } r -= I_SQ;
        if (r < I_SQ) { p0_transpose_item(in.p[I_WGATE], 1024, in.p[I_GPLE], (bf16*)(ws + WS_WG), 1024, 0, scr, r / 32, r % 32, lane); continue; } r -= I_SQ;
        if (r < I_PJ) { p0_transpose_item(in.p[I_WPROJ], 1024, nullptr, (bf16*)(ws + WS_WPROJ), 256, 0, scr, r / 32, r % 32, lane); continue; } r -= I_PJ;
        { const int blk = r >> 4, which = (r >> 3) & 1, sub = r & 7;

#if LRU_PADDED
#if LRU_PADDED == 2
          p0_transpose_item(in.p[which ? I_WX : I_WA] + (size_t)blk * 16384, 128, nullptr, (bf16*)(ws + WS_WAX) + (size_t)blk * 32768 + which * 128 * 128, 128, 0, scr, sub >> 2, sub & 3, lane); }
#else
          p0_transpose_item(in.p[which ? I_WX : I_WA] + (size_t)blk * 16384, 128, nullptr, (bf16*)(ws + WS_WAX) + (size_t)blk * 65536 + which * 128 * 256, 256, (blk & 1) * 128, scr, sub >> 2, sub & 3, lane); }
#endif
#else
          p0_transpose_item(in.p[which ? I_WX : I_WA] + (size_t)blk * 16384, 128, nullptr, (bf16*)(ws + WS_WAXD) + (size_t)(blk * 256 + which * 128) * 1024, 1024, blk * 128, scr, sub >> 2, sub & 3, lane); }
#endif
    }
#if LRU_PADDED == 2
#elif LRU_PADDED
    for (int i = vcu * 512 + tid; i < 8 * 256 * 16; i += G * 512) { const int c16 = i & 15, n = (i >> 4) & 255, blk = i >> 12;
        *(u32x4*)((bf16*)(ws + WS_WAX) + (size_t)blk * 65536 + n * 256 + ((blk & 1) ^ 1) * 128 + c16 * 8) = (u32x4){0u, 0u, 0u, 0u}; }
#else
    for (int i = vcu * 512 + tid; i < 2048 * 128; i += G * 512) { const int c16 = i & 127, row = i >> 7, blk = row >> 8;
        if ((c16 >> 4) != blk) *(u32x4*)((bf16*)(ws + WS_WAXD) + (size_t)row * 1024 + c16 * 8) = (u32x4){0u, 0u, 0u, 0u}; }
#endif
    for (int m = gw; m < T_; m += 2 * NGW) {
        const int m2 = m + NGW;
        const f32x4* xa = (const f32x4*)(in.p[I_X] + (size_t)m * 1024) + lane; const f32x4* xb = (const f32x4*)(in.p[I_X] + (size_t)(m2 < T_ ? m2 : m) * 1024) + lane;
        f32x4 va[4], vb[4]; float sa = 0.f, sb = 0.f;
#pragma unroll
        for (int j = 0; j < 4; ++j) { va[j] = xa[64 * j]; vb[j] = xb[64 * j]; }
#pragma unroll
        for (int j = 0; j < 4; ++j) { sa += (va[j][0] * va[j][0] + va[j][1] * va[j][1]) + (va[j][2] * va[j][2] + va[j][3] * va[j][3]); sb += (vb[j][0] * vb[j][0] + vb[j][1] * vb[j][1]) + (vb[j][2] * vb[j][2] + vb[j][3] * vb[j][3]); }
#pragma unroll
        for (int o = 1; o < 64; o <<= 1) { sa += __shfl_xor(sa, o); sb += __shfl_xor(sb, o); }
        u32x2* oa = (u32x2*)((bf16*)(ws + WS_R0) + (size_t)m * 1024) + lane;
#pragma unroll
        for (int j = 0; j < 4; ++j) { u32x2 w; w.x = pk2(va[j][0], va[j][1]); w.y = pk2(va[j][2], va[j][3]); oa[64 * j] = w; }
        if (lane == 0) ((float*)(ws + WS_RSTD1))[m] = 1.0f / sqrtf(sa * (1.0f / 1024.0f) + EPS);
        if (m2 < T_) {
            u32x2* ob = (u32x2*)((bf16*)(ws + WS_R0) + (size_t)m2 * 1024) + lane;
#pragma unroll
            for (int j = 0; j < 4; ++j) { u32x2 w; w.x = pk2(vb[j][0], vb[j][1]); w.y = pk2(vb[j][2], vb[j][3]); ob[64 * j] = w; }
            if (lane == 0) ((float*)(ws + WS_RSTD1))[m2] = 1.0f / sqrtf(sb * (1.0f / 1024.0f) + EPS);
        }
    }
    for (int m = gw; m < T_; m += 4 * NGW) {
        f32x4 v[4];
#pragma unroll
        for (int q = 0; q < 4; ++q) { const int mq = m + q * NGW; v[q] = ((const f32x4*)(in.p[I_P] + (size_t)(mq < T_ ? mq : m) * 256))[lane]; }
#pragma unroll
        for (int q = 0; q < 4; ++q) { const int mq = m + q * NGW; if (mq < T_) { u32x2 w; w.x = pk2(v[q][0], v[q][1]); w.y = pk2(v[q][2], v[q][3]); ((u32x2*)((bf16*)(ws + WS_PB) + (size_t)mq * 256))[lane] = w; } }
    }
    if (vcu == 0) for (int c = tid; c < 1024; c += 512) ((float*)(ws + WS_C8))[c] = -8.0f * log1pf(expf(-in.p[I_LAM][c])) * LOG2E;
    __syncthreads();
    for (int it = vcu; it < 256; it += G) p0_wfold_item((LAS float*)lds, in.p[I_WQ], in.p[I_K1], in.p[I_K2], in.p[I_GFFN], (bf16*)(ws + WS_WFOLD), it, tid);
}

constexpr int AT_KSTR = 72, AT_VSTR = 260, AT_V_OFF = 256 * AT_KSTR * 2;
__device__ __forceinline__ int crow(int r, int hi) { return (r & 3) + 8 * (r >> 2) + 4 * hi; }
__device__ __forceinline__ void attn_item(LAS unsigned char* lds, const bf16* qkv, const float* sink, bf16* att, int item, int wave, int tid) {
    const int lane = tid & 63;
    const int g = item & 1, n = (item >> 1) & 15, b = item >> 5;
    const int t0 = b * S_ + n * 128;
    LAS bf16* Ks = (LAS bf16*)lds; LAS bf16* Vt = (LAS bf16*)(lds + AT_V_OFF);
#pragma unroll
    for (int i = 0; i < 4; ++i) {
        const int idx = tid + i * 512, row = idx >> 3, ch = idx & 7; const int tk = t0 - 128 + row;
        u32x4 kv = (u32x4){0u, 0u, 0u, 0u}, vv = (u32x4){0u, 0u, 0u, 0u};
        if (n > 0 || row >= 128) { const bf16* src = qkv + (size_t)tk * 768 + 512 + g * 64 + ch * 8; kv = *(const u32x4*)src; vv = *(const u32x4*)(src + 128); }
        *(LAS u32x4*)(Ks + row * AT_KSTR + ch * 8) = kv;
#pragma unroll
        for (int c = 0; c < 8; ++c) Vt[(ch * 8 + c) * AT_VSTR + row] = (bf16)(vv[c >> 1] >> (16 * (c & 1)));
    }
    __syncthreads();
    const int hr = wave >> 1, qh = wave & 1, head = g * 4 + hr;
    const float slope2 = exp2f(-(float)(head + 1)) * LOG2E, sink2 = sink[head] * LOG2E;
    const int q = lane & 31, hi = lane >> 5;
#pragma unroll 1
    for (int ps = 0; ps < 2; ++ps) {
        const int i0 = 64 * qh + 32 * ps, kb0 = i0;
        const bf16* qp = qkv + (size_t)(t0 + i0 + q) * 768 + head * 64 + 8 * hi;
        bf16x8 qf[4];
#pragma unroll
        for (int s = 0; s < 4; ++s) qf[s] = *(const bf16x8*)(qp + 16 * s);
        f32x16 oT[2];
#pragma unroll
        for (int dt = 0; dt < 2; ++dt)
#pragma unroll
            for (int r = 0; r < 16; ++r) oT[dt][r] = 0.f;
        float mrun = sink2, l = 0.f;
#pragma unroll 1
        for (int kt = 0; kt < 5; ++kt) {
            const int kbase = kb0 + 32 * kt;
            f32x16 sT;
#pragma unroll
            for (int r = 0; r < 16; ++r) sT[r] = 0.f;
#pragma unroll
            for (int s = 0; s < 4; ++s) { const bf16x8 kf = *(const LAS bf16x8*)(Ks + (kbase + q) * AT_KSTR + 16 * s + 8 * hi); sT = __builtin_amdgcn_mfma_f32_32x32x16_bf16(kf, qf[s], sT, 0, 0, 0); }
            float tm = -1.0e30f;
#pragma unroll
            for (int r = 0; r < 16; ++r) {
                const int kj = kbase + crow(r, hi); const int dist = i0 + q + 128 - kj;
                const bool valid = (dist >= 0) && (dist < 128) && (n > 0 || kj >= 128);
                const float v = valid ? (sT[r] * (0.125f * LOG2E) - slope2 * (float)dist) : -1.0e30f;
                sT[r] = v; tm = fmaxf(tm, v);
            }
            tm = fmaxf(tm, __shfl_xor(tm, 32));
            const float mnew = fmaxf(mrun, tm), alpha = __builtin_amdgcn_exp2f(mrun - mnew);
            mrun = mnew;
            float ls = 0.f;
#pragma unroll
            for (int r = 0; r < 16; ++r) { const float p = __builtin_amdgcn_exp2f(sT[r] - mnew); sT[r] = p; ls += p; }
            l = l * alpha + ls;
#pragma unroll
            for (int dt = 0; dt < 2; ++dt)
#pragma unroll
                for (int r = 0; r < 16; ++r) oT[dt][r] *= alpha;
#pragma unroll
            for (int s = 0; s < 2; ++s) {
                u32x4 pw; pw.x = cvt_pk_bf16(sT[8 * s + 0], sT[8 * s + 1]); pw.y = cvt_pk_bf16(sT[8 * s + 2], sT[8 * s + 3]);
                pw.z = cvt_pk_bf16(sT[8 * s + 4], sT[8 * s + 5]); pw.w = cvt_pk_bf16(sT[8 * s + 6], sT[8 * s + 7]);
                const bf16x8 pf = __builtin_bit_cast(bf16x8, pw);
#pragma unroll
                for (int dt = 0; dt < 2; ++dt) {
                    const LAS bf16* vp = Vt + (32 * dt + q) * AT_VSTR + kbase + 16 * s + 4 * hi;
                    const u32x2 va = *(const LAS u32x2*)vp, vb = *(const LAS u32x2*)(vp + 8);
                    const bf16x8 af = __builtin_bit_cast(bf16x8, (u32x4){va.x, va.y, vb.x, vb.y});
                    oT[dt] = __builtin_amdgcn_mfma_f32_32x32x16_bf16(af, pf, oT[dt], 0, 0, 0);
                }
            }
        }
        l += __shfl_xor(l, 32);
        l += __builtin_amdgcn_exp2f(sink2 - mrun);
        const float inv = 1.0f / l;
        bf16* op = att + (size_t)(t0 + i0 + q) * 512 + head * 64 + 4 * hi;
#pragma unroll
        for (int dt = 0; dt < 2; ++dt)
#pragma unroll
            for (int rg = 0; rg < 4; ++rg) { u32x2 w; w.x = cvt_pk_bf16(oT[dt][4 * rg] * inv, oT[dt][4 * rg + 1] * inv); w.y = cvt_pk_bf16(oT[dt][4 * rg + 2] * inv, oT[dt][4 * rg + 3] * inv);
                *(u32x2*)(op + 32 * dt + 8 * rg) = w; }
    }
    __syncthreads();
}
__device__ __forceinline__ void conv_items(const bf16* lx, const float* cw, const float* cb, bf16* lin, int vcu, int G, int tid) {
    for (int i = vcu * 512 + tid; i < T_ * 128; i += 2 * G * 512) {
        const int c8 = (i & 127) * 8;
        const int ta = i >> 7, i2 = i + G * 512; const bool hasb = i2 < T_ * 128; const int tb = hasb ? (i2 >> 7) : ta;
        const int tsa = ta & (S_ - 1), tsb = tb & (S_ - 1);
        u32x4 wa[4], wb[4];
#pragma unroll
        for (int tap = 0; tap < 4; ++tap) {
            wa[tap] = (tsa - 3 + tap >= 0) ? *(const u32x4*)(lx + (size_t)(ta - 3 + tap) * 1024 + c8) : (u32x4){0u, 0u, 0u, 0u};
            wb[tap] = (tsb - 3 + tap >= 0) ? *(const u32x4*)(lx + (size_t)(tb - 3 + tap) * 1024 + c8) : (u32x4){0u, 0u, 0u, 0u};
        }
        f32x4 a0 = *(const f32x4*)(cb + c8), a1 = *(const f32x4*)(cb + c8 + 4), b0 = a0, b1 = a1;
#pragma unroll
        for (int tap = 0; tap < 4; ++tap) {
            const f32x4 w0 = *(const f32x4*)(cw + tap * 1024 + c8), w1 = *(const f32x4*)(cw + tap * 1024 + c8 + 4);
            a0 += bf4_lo((u32x2){wa[tap].x, wa[tap].y}) * w0; a1 += bf4_lo((u32x2){wa[tap].z, wa[tap].w}) * w1;
            b0 += bf4_lo((u32x2){wb[tap].x, wb[tap].y}) * w0; b1 += bf4_lo((u32x2){wb[tap].z, wb[tap].w}) * w1;
        }
        *(u32x4*)(lin + (size_t)ta * 1024 + c8) = pack8(a0, a1);
        if (hasb) *(u32x4*)(lin + (size_t)tb * 1024 + c8) = pack8(b0, b1);
    }
}
__device__ __forceinline__ void scan_finish(const bf16* hloc, const bf16* pcum, const float* agg, const bf16* gl, bf16* rec, int vcu, int G, int tid) {
    const int c8 = (tid & 127) * 8, rg = tid >> 7;
    for (int chunk = vcu; chunk < T_ / 64; chunk += G) {
        const int ci = chunk & 31, cb = chunk - ci;
        float carry[8];
#pragma unroll
        for (int j = 0; j < 8; ++j) carry[j] = 0.f;
#pragma unroll 4
        for (int cc = 0; cc < ci; ++cc) {
            const f32x4* ap = (const f32x4*)(agg + ((size_t)(cb + cc) * 1024 + c8) * 2);
#pragma unroll
            for (int q = 0; q < 4; ++q) { const f32x4 v = ap[q]; carry[2 * q] = fmaf(v[0], carry[2 * q], v[1]); carry[2 * q + 1] = fmaf(v[2], carry[2 * q + 1], v[3]); }
        }
#pragma unroll 8
        for (int rr = 0; rr < 16; ++rr) {
            const size_t o = (size_t)(chunk * 64 + rg + 4 * rr) * 1024 + c8;
            const u32x4 hw = *(const u32x4*)(hloc + o), pw = *(const u32x4*)(pcum + o), gw = *(const u32x4*)(gl + o);
            const f32x4 h0 = bf4_lo((u32x2){hw.x, hw.y}), h1 = bf4_lo((u32x2){hw.z, hw.w}), p0 = bf4_lo((u32x2){pw.x, pw.y}), p1 = bf4_lo((u32x2){pw.z, pw.w});
            const f32x4 g0 = bf4_lo((u32x2){gw.x, gw.y}), g1 = bf4_lo((u32x2){gw.z, gw.w});
            f32x4 r0, r1;
#pragma unroll
            for (int j = 0; j < 4; ++j) { r0[j] = fmaf(p0[j], carry[j], h0[j]) * g0[j]; r1[j] = fmaf(p1[j], carry[4 + j], h1[j]) * g1[j]; }
            *(u32x4*)(rec + o) = pack8(r0, r1);
        }
    }
}
__device__ __forceinline__ void final_rows(float* h, const bf16* h3b, const float* part, const float* fg, int gw, int NGW, int lane, float tscale) {
    f32x4 g[4];
#pragma unroll
    for (int j = 0; j < 4; ++j) g[j] = ((const f32x4*)fg)[lane + 64 * j];
    for (int r0 = gw; r0 < T_; r0 += 2 * NGW) {
        const int r1 = (r0 + NGW < T_) ? r0 + NGW : r0;
        float pa = (lane < 16) ? part[(size_t)r0 * 16 + lane] : 0.f, pb = (lane < 16) ? part[(size_t)r1 * 16 + lane] : 0.f;
#if ALL_FUSED
        const u32x2* ba = (const u32x2*)(h3b + (size_t)r0 * 1024) + lane; const u32x2* bb = (const u32x2*)(h3b + (size_t)r1 * 1024) + lane;
        u32x2 wa[4], wb[4];
#pragma unroll
        for (int j = 0; j < 4; ++j) { wa[j] = ba[64 * j]; wb[j] = bb[64 * j]; }
#endif
#pragma unroll
        for (int o = 1; o < 64; o <<= 1) { pa += __shfl_xor(pa, o); pb += __shfl_xor(pb, o); }
        const float ra = tscale / sqrtf(pa * (1.0f / 1024.0f) + EPS), rb = tscale / sqrtf(pb * (1.0f / 1024.0f) + EPS);
        f32x4* ha = (f32x4*)(h + (size_t)r0 * 1024) + lane; f32x4* hb = (f32x4*)(h + (size_t)r1 * 1024) + lane;
#if ALL_FUSED
#pragma unroll
        for (int j = 0; j < 4; ++j) ha[64 * j] = bf4_lo(wa[j]) * ra * g[j];
        if (r1 != r0) {
#pragma unroll
            for (int j = 0; j < 4; ++j) hb[64 * j] = bf4_lo(wb[j]) * rb * g[j];
        }
#else
#pragma unroll
        for (int j = 0; j < 4; ++j) ha[64 * j] = ha[64 * j] * ra * g[j];
        if (r1 != r0) {
#pragma unroll
            for (int j = 0; j < 4; ++j) hb[64 * j] = hb[64 * j] * rb * g[j];
        }
#endif
    }
}

constexpr int N_PHASES = 16;
struct Args { const float* in[25]; float* out; unsigned char* ws; int ph_lo, ph_hi, li, pad; };
__global__ void __launch_bounds__(NWAVES * 64, 2) fused_fwd(Args args) {
    extern __shared__ __attribute__((aligned(16))) unsigned char lds_raw[];
    LAS unsigned char* lds = (LAS unsigned char*)lds_raw;
    volatile LAS unsigned* MISC = (volatile LAS unsigned*)(lds + LDSCTL_OFF);
    const int wave = __builtin_amdgcn_readfirstlane((int)threadIdx.x >> 6);
#define FRESH_TID() (wave * 64 + fresh_lane())
#define FRESH_LANE() fresh_lane()
    const int G = gridDim.x; const int bx = blockIdx.x; const int vcu = (G % 8 == 0) ? (bx % 8) * (G / 8) + bx / 8 : bx;
    unsigned char* ws = args.ws; float* out = args.out;
    In in;
#pragma unroll
    for (int i = 0; i < 25; ++i) in.p[i] = args.in[i];
    for (int u = FRESH_TID(); u < (LDS_BYTES - LDSCTL_OFF) / 4; u += NWAVES * 64) ((LAS unsigned*)(lds + LDSCTL_OFF))[u] = 0u;
    __syncthreads();
    (void)xcd_barrier_post((unsigned*)(ws + WS_CTL) + CW_BAR + args.li * XCD_BAR_WORDS, MISC + 8);
    const int lo = args.ph_lo, hi = args.ph_hi;
    const int gw = vcu * NWAVES + wave, NGW = G * NWAVES;
#ifndef PH_DISABLE
#define PH_DISABLE 0
#endif
#if ALL_FUSED
#define IN(k) (!((PH_DISABLE >> (k)) & 1))
#else
#define IN(k) (lo <= (k) && (k) < hi && !((PH_DISABLE >> (k)) & 1))
#endif
#ifdef TIMING_A
#define STAMP(i) do { if (bx == 0 && FRESH_TID() == 0) __hip_atomic_store((unsigned long long*)(ws + WS_CTL + 512) + (i), __builtin_amdgcn_s_memrealtime(), __ATOMIC_RELAXED, __HIP_MEMORY_SCOPE_AGENT); } while (0)
#else
#define STAMP(i) do { } while (0)
#endif
#define SEAM(k) do { if (IN(k) && IN((k) + 1)) { XcdBarrier b_; b_.bar = (unsigned*)(args.ws + WS_CTL) + CW_BAR + args.li * XCD_BAR_WORDS; b_.x = xb_xcc_id(); b_.st = (volatile LAS unsigned*)(lds + LDSCTL_OFF) + 8;     \
        xcd_barrier(b_); STAMP((k) + 1); } } while (0)
#if ALL_FUSED
#define PP_OFF WS_PP2
#define MP_PTR out
#else
#define PP_OFF WS_PP
#define MP_PTR ((float*)(ws + WS_MP))
#endif
#define GEMM_PHASE(EPI, Aptr, Bptr, Kdim, LDA, M_, N_, SH, STR, ...) do { \
        pg8::Gemm g{(const pg8::bf16_t*)(Aptr), (const pg8::bf16_t*)(Bptr), Kdim, LDA, SH, STR}; pg8::StaticOrder S; S.init(M_, N_, G, (int)blockIdx.x); \
        EPI E{__VA_ARGS__}; pg8::gemm_phase<EPI, pg8::StaticOrder, true, true>(lds, g, S, E, wave); } while (0)

    STAMP(0);
    if (IN(0)) { p0_prologue(in, ws, lds, vcu, G, wave, FRESH_TID()); } SEAM(0);
    if (IN(1)) { GEMM_PHASE(EpiProj, ws + WS_R0, ws + WS_WIN, 1024, 1024, T_, INW, 0, 0, (const float*)(ws + WS_RSTD1), ws); } SEAM(1);
    if (IN(2)) {
        for (int it = bx; it < 256; it += G) attn_item(lds, (const bf16*)(ws + WS_QKV), in.p[I_SINK], (bf16*)(ws + WS_ATT), it, wave, FRESH_TID());
        conv_items((const bf16*)(ws + WS_LX), in.p[I_CONVW], in.p[I_CONVB], (bf16*)(ws + WS_R0), vcu, G, FRESH_TID());
    } SEAM(2);
#if LRU_PADDED == 2
    if (IN(3)) { GEMM_PHASE(EpiLru, ws + WS_R0, ws + WS_WAX, 128, 1024, T_, 2048, 0, 128,
#elif LRU_PADDED
    if (IN(3)) { GEMM_PHASE(EpiLru, ws + WS_R0, ws + WS_WAX, 256, 1024, T_, 2048, 1, 256,
#else
    if (IN(3)) { GEMM_PHASE(EpiLru, ws + WS_R0, ws + WS_WAXD, 1024, 1024, T_, 2048, 0, 0,
#endif
        (const bf16*)(ws + WS_R0), in.p[I_BA], in.p[I_BX], (const float*)(ws + WS_C8), (bf16*)(ws + WS_HLOC), (bf16*)(ws + WS_PCUM), (float*)(ws + WS_AGG)); }
    SEAM(3);
    if (IN(4)) { scan_finish((const bf16*)(ws + WS_HLOC), (const bf16*)(ws + WS_PCUM), (const float*)(ws + WS_AGG), (const bf16*)(ws + WS_GL), (bf16*)(ws + WS_R0), vcu, G, FRESH_TID()); }
#if !ALL_FUSED
    SEAM(4);
#endif
    if (IN(5)) { GEMM_PHASE(EpiMP, ws + WS_ATT, ws + WS_WUA, 512, 512, T_, 1024, 0, 0, (const bf16*)(ws + WS_SGA), MP_PTR); } SEAM(5);
    if (IN(6)) { GEMM_PHASE(EpiMerged, ws + WS_R0, ws + WS_WUL, 1024, 1024, T_, 1024, 0, 0, (const bf16*)(ws + WS_SGL), (const float*)MP_PTR, (bf16*)(ws + WS_MERGED)); } SEAM(6);
    if (IN(7)) { GEMM_PHASE(EpiH1, ws + WS_MERGED, ws + WS_WO, 1024, 1024, T_, 1024, 0, 0, in.p[I_X], out, (bf16*)(ws + WS_R0), (float*)(ws + WS_PART2)); }
#if ALL_FUSED
    if (IN(13)) { GEMM_PHASE(EpiPP, ws + WS_PB, ws + WS_WPROJ, 256, 256, T_, 1024, 0, 0, (bf16*)(ws + WS_PP2)); }
#endif
    SEAM(7);
#define PEER_HALF(half) do { \
        if (IN(8 + 2 * (half))) { GEMM_PHASE(EpiScore, ws + WS_R0, ws + WS_WFOLD + (size_t)(half) * 1024 * 1024 * 2, 1024, 1024, T_, 1024, 0, 0, (const float*)(ws + WS_PART2), (float*)(ws + WS_SC)); } SEAM(8 + 2 * (half)); \
        if (IN(9 + 2 * (half))) { \
            for (int it = vcu; it < T_ / TK_TOK; it += G) topk_item((LAS float*)lds, (const float*)(ws + WS_SC), it, (half) * 4, (int*)(ws + WS_SELI), (float*)(ws + WS_SELG), FRESH_TID()); \
            if ((half) == 0) uv_convert(in.p[I_U], in.p[I_V], in.p[I_GFFN], ws + WS_U16, ws + WS_U16 + 16 * MiB, (float*)(ws + WS_USCALE), (float*)(ws + WS_USCALE) + 16384, gw, NGW, FRESH_LANE()); \
        } SEAM(9 + 2 * (half)); } while (0)
#if ALL_FUSED
    if (IN(8)) {
        for (int kk = 0; kk < 2; ++kk) { pg8::Gemm g{(const pg8::bf16_t*)(ws + WS_R0), (const pg8::bf16_t*)(ws + WS_WFOLD), 1024, 1024, 0, 0}; OneUnit S; S.S.init(T_, 2048, G, (int)blockIdx.x); S.k = kk;
            EpiTopk E{(const float*)(ws + WS_PART2), (int*)(ws + WS_SELI), (float*)(ws + WS_SELG), in.p[I_U], in.p[I_V], in.p[I_GFFN], ws + WS_U16, ws + WS_U16 + 16 * MiB, (float*)(ws + WS_USCALE), (float*)(ws + WS_USCALE) + 16384,
                      vcu * 16 + kk * 8, (2 * G == (T_ / 256) * 8) ? 16 * G : 0};
            pg8::gemm_phase<EpiTopk, OneUnit, false, true>(lds, g, S, E, wave); }
        if (2 * G != (T_ / 256) * 8) uv_convert(in.p[I_U], in.p[I_V], in.p[I_GFFN], ws + WS_U16, ws + WS_U16 + 16 * MiB, (float*)(ws + WS_USCALE), (float*)(ws + WS_USCALE) + 16384, gw, NGW, FRESH_LANE());
    } SEAM(11);
#else
    PEER_HALF(0);
    PEER_HALF(1);
#endif
    if (IN(12)) {
#ifdef PROBE_MODE
        for (int tok0 = vcu * 64; tok0 < T_; tok0 += G * 64)
#if GATHER_ROWS == 3
            gather_wg_mixed<PROBE_MODE>(tok0, wave, FRESH_LANE(), lds, ws + WS_U16, ws + WS_U16 + 16 * MiB, (const float*)(ws + WS_USCALE), (const float*)(ws + WS_USCALE) + 16384, (const int*)(ws + WS_SELI), (const float*)(ws + WS_SELG), (const float*)(ws + WS_PART2), (const bf16*)(ws + WS_R0), (bf16*)(ws + WS_H2B), (float*)(ws + WS_RSTD3), (float*)(ws + WS_SC));
#elif GATHER_ROWS == 1
            gather_wg_rows<PROBE_MODE>(tok0, wave, FRESH_LANE(), lds, ws + WS_U16, ws + WS_U16 + 16 * MiB, (const float*)(ws + WS_USCALE), (const float*)(ws + WS_USCALE) + 16384, (const int*)(ws + WS_SELI), (const float*)(ws + WS_SELG), (const float*)(ws + WS_PART2), (const bf16*)(ws + WS_R0), (bf16*)(ws + WS_H2B), (float*)(ws + WS_RSTD3), (float*)(ws + WS_SC));
#else
            gather_wg_sliced<PROBE_MODE>(tok0, wave, FRESH_LANE(), lds, ws + WS_U16, ws + WS_U16 + 16 * MiB, (const float*)(ws + WS_USCALE), (const float*)(ws + WS_USCALE) + 16384, (const int*)(ws + WS_SELI), (const float*)(ws + WS_SELG), (const float*)(ws + WS_PART2), out, (const bf16*)(ws + WS_R0), (bf16*)(ws + WS_H2B), (float*)(ws + WS_RSTD3), (float*)(ws + WS_SC));
#endif
        { XcdBarrier b_; b_.bar = (unsigned*)(args.ws + WS_CTL) + CW_BAR + args.li * XCD_BAR_WORDS; b_.x = xb_xcc_id(); b_.st = (volatile LAS unsigned*)(lds + LDSCTL_OFF) + 8; xcd_barrier(b_); STAMP(16); }
#endif
        for (int tok0 = vcu * 64; tok0 < T_; tok0 += G * 64)
#if GATHER_ROWS == 3
            gather_wg_mixed<0>(tok0, wave, FRESH_LANE(), lds, ws + WS_U16, ws + WS_U16 + 16 * MiB, (const float*)(ws + WS_USCALE), (const float*)(ws + WS_USCALE) + 16384, (const int*)(ws + WS_SELI), (const float*)(ws + WS_SELG), (const float*)(ws + WS_PART2), (const bf16*)(ws + WS_R0), (bf16*)(ws + WS_H2B), (float*)(ws + WS_RSTD3), nullptr);
#elif GATHER_ROWS == 1
            gather_wg_rows<0>(tok0, wave, FRESH_LANE(), lds, ws + WS_U16, ws + WS_U16 + 16 * MiB, (const float*)(ws + WS_USCALE), (const float*)(ws + WS_USCALE) + 16384, (const int*)(ws + WS_SELI), (const float*)(ws + WS_SELG), (const float*)(ws + WS_PART2), (const bf16*)(ws + WS_R0), (bf16*)(ws + WS_H2B), (float*)(ws + WS_RSTD3), nullptr);
#else
            gather_wg_sliced<0>(tok0, wave, FRESH_LANE(), lds, ws + WS_U16, ws + WS_U16 + 16 * MiB, (const float*)(ws + WS_USCALE), (const float*)(ws + WS_USCALE) + 16384, (const int*)(ws + WS_SELI), (const float*)(ws + WS_SELG), (const float*)(ws + WS_PART2), out, (const bf16*)(ws + WS_R0), (bf16*)(ws + WS_H2B), (float*)(ws + WS_RSTD3), nullptr);
#endif
    } SEAM(12);
#if !ALL_FUSED
    if (IN(13)) { GEMM_PHASE(EpiPP, ws + WS_PB, ws + WS_WPROJ, 256, 256, T_, 1024, 0, 0, (bf16*)(ws + WS_PP)); } SEAM(13);
#endif
#if ALL_FUSED && FUSE_FINAL
    if (IN(14)) { GEMM_PHASE(EpiH3Final, ws + WS_H2B, ws + WS_WG, 1024, 1024, T_, 1024, 0, 0, (const float*)(ws + WS_RSTD3), (const bf16*)(ws + PP_OFF), (const bf16*)(ws + WS_H2B), in.p[I_FG], out, (float*)(ws + WS_PART4), (unsigned*)(ws + WS_CTL) + 65536); }
#else
    if (IN(14)) { GEMM_PHASE(EpiH3, ws + WS_H2B, ws + WS_WG, 1024, 1024, T_, 1024, 0, 0, (const float*)(ws + WS_RSTD3), (const bf16*)(ws + PP_OFF), out, (float*)(ws + WS_PART4), (const bf16*)(ws + WS_H2B), (bf16*)(ws + WS_R0)); } SEAM(14);
#ifdef TIMING_A
    float tscale = 1.0f;
    { const unsigned long long ta = __hip_atomic_load((unsigned long long*)(ws + WS_CTL + 512) + TIMING_A, __ATOMIC_RELAXED, __HIP_MEMORY_SCOPE_AGENT), tb = __hip_atomic_load((unsigned long long*)(ws + WS_CTL + 512) + TIMING_B, __ATOMIC_RELAXED, __HIP_MEMORY_SCOPE_AGENT);
      tscale = 1.0f + (float)(tb - ta) * 0.01f * (float)(TIMING_K); }
    if (IN(15)) { final_rows(out, (const bf16*)(ws + WS_R0), (const float*)(ws + WS_PART4), in.p[I_FG], gw, NGW, FRESH_LANE(), tscale); }
#else
    if (IN(15)) { final_rows(out, (const bf16*)(ws + WS_R0), (const float*)(ws + WS_PART4), in.p[I_FG], gw, NGW, FRESH_LANE(), 1.0f); }
#endif
#endif
#undef IN
#undef SEAM
#undef GEMM_PHASE
}
static const int GRP_LO[11] = {0, 2, 3, 5, 6, 7, 8, 12, 13, 14, 15};
static const int GRP_HI[11] = {2, 3, 5, 6, 7, 8, 12, 13, 14, 15, 16};

static void naive_group(int grp, void* const* d_in, float* out, unsigned char* ws, hipStream_t st) {
    const float* x = (const float*)d_in[0]; const float* p = (const float*)d_in[1]; const float* g_mix = (const float*)d_in[2]; const float* w_in = (const float*)d_in[3];
    const float* sink = (const float*)d_in[4]; const float* conv_w = (const float*)d_in[5]; const float* conv_b = (const float*)d_in[6];
    const float* wa = (const float*)d_in[7]; const float* ba = (const float*)d_in[8]; const float* wx = (const float*)d_in[9]; const float* bx = (const float*)d_in[10]; const float* lam = (const float*)d_in[11];
    const float* w_ua = (const float*)d_in[12]; const float* w_ul = (const float*)d_in[13]; const float* w_o = (const float*)d_in[14]; const float* g_ffn = (const float*)d_in[15];
    const float* wq = (const float*)d_in[16]; const float* k1 = (const float*)d_in[17]; const float* k2 = (const float*)d_in[18]; const float* pu = (const float*)d_in[19]; const float* pv = (const float*)d_in[20];
    const float* g_ple = (const float*)d_in[21]; const float* w_gate = (const float*)d_in[22]; const float* w_proj = (const float*)d_in[23]; const float* final_g = (const float*)d_in[24];
    float* rstd1 = (float*)(ws + WS_RSTD1); float* part2 = (float*)(ws + WS_PART2); float* part4 = (float*)(ws + WS_PART4); float* rstd3 = (float*)(ws + WS_RSTD3);
    bf16* qkv = (bf16*)(ws + WS_QKV); bf16* lx = (bf16*)(ws + WS_LX); bf16* gl = (bf16*)(ws + WS_GL); bf16* sga = (bf16*)(ws + WS_SGA); bf16* sgl = (bf16*)(ws + WS_SGL);
    bf16* att = (bf16*)(ws + WS_ATT); bf16* r0 = (bf16*)(ws + WS_R0); float* mp = (float*)(ws + WS_MP); bf16* merged = (bf16*)(ws + WS_MERGED);
    float* sc = (float*)(ws + WS_SC); int* seli = (int*)(ws + WS_SELI); float* selg = (float*)(ws + WS_SELG); bf16* h2b = (bf16*)(ws + WS_H2B); bf16* pp = (bf16*)(ws + WS_PP);
    float* tmpf = (float*)(ws + WS_NAIVE_AB);
    switch (grp) {
    case 0:
        hipLaunchKernelGGL(nv::rowsq, dim3(T_ / 4), dim3(256), 0, st, x, rstd1, (float*)nullptr);
        nv::run_gemm<nv::ALf32, nv::EpiProj, false>(st, nv::ALf32{x, 1024}, w_in, INW, g_mix, T_, INW, 1024, nv::EpiProj{rstd1, qkv, lx, gl, sga, sgl});
        break;
    case 1:
        hipLaunchKernelGGL(nv::attn_naive, dim3(T_ * 8 / 128), dim3(128), 0, st, qkv, sink, att);
        hipLaunchKernelGGL(nv::conv_naive, dim3(T_ * 1024 / 256), dim3(256), 0, st, lx, conv_w, conv_b, r0);
        break;
    case 2:
        hipLaunchKernelGGL(nv::lru_ab_naive, dim3(T_ * 8), dim3(128), 0, st, r0, wa, ba, wx, bx, lam, out, tmpf);
        hipLaunchKernelGGL(nv::lru_scan_naive, dim3(B_ * 1024 / 64), dim3(64), 0, st, out, tmpf, gl, r0);
        break;
    case 3: nv::run_gemm<nv::ALbf16, nv::EpiMP, false>(st, nv::ALbf16{att, 512}, w_ua, 1024, nullptr, T_, 1024, 512, nv::EpiMP{sga, mp}); break;
    case 4: nv::run_gemm<nv::ALbf16, nv::EpiMerged, false>(st, nv::ALbf16{r0, 1024}, w_ul, 1024, nullptr, T_, 1024, 1024, nv::EpiMerged{sgl, mp, merged}); break;
    case 5:
        nv::run_gemm<nv::ALbf16, nv::EpiH1, false>(st, nv::ALbf16{merged, 1024}, w_o, 1024, nullptr, T_, 1024, 1024, nv::EpiH1{x, out, r0});
        hipLaunchKernelGGL(nv::rowsq, dim3(T_ / 4), dim3(256), 0, st, out, (float*)nullptr, part2);
        break;
    case 6:
        for (int half = 0; half < 2; ++half) {
            nv::run_gemm<nv::ALf32, nv::EpiScaleF32, false>(st, nv::ALf32{out, 1024}, wq + half * 1024, 2048, g_ffn, T_, 1024, 1024, nv::EpiScaleF32{part2, tmpf, 1024});
            for (int hl = 0; hl < 4; ++hl)
                for (int hf = 0; hf < 2; ++hf)
                    nv::run_gemm<nv::ALf32, nv::EpiPlainF32, true>(st, nv::ALf32{tmpf + hl * 256 + hf * 128, 1024}, hf ? k2 : k1, 128, nullptr, T_, 128, 128, nv::EpiPlainF32{sc + hl * 256 + hf * 128, 1024});
            hipLaunchKernelGGL(topk_kernel, dim3(T_ / TK_TOK), dim3(512), TK_LDS_BYTES, st, sc, half * 4, seli, selg);
        }
        break;
    case 7: hipLaunchKernelGGL(gather_kernel<0>, dim3(1024), dim3(256), 0, st, (const void*)pu, (const void*)pv, g_ffn, seli, selg, part2, out, h2b, rstd3); break;
    case 8: nv::run_gemm<nv::ALf32, nv::EpiPP, false>(st, nv::ALf32{p, 256}, w_proj, 1024, nullptr, T_, 1024, 256, nv::EpiPP{pp}); break;
    case 9: nv::run_gemm<nv::ALbf16, nv::EpiH3, false>(st, nv::ALbf16{h2b, 1024}, w_gate, 1024, g_ple, T_, 1024, 1024, nv::EpiH3{rstd3, pp, out});
        hipLaunchKernelGGL(nv::rowsq, dim3(T_ / 4), dim3(256), 0, st, out, (float*)nullptr, part4);
        break;
    case 10: hipLaunchKernelGGL(nv::final_norm, dim3(T_ / 4), dim3(256), 0, st, out, part4, final_g); break;
    }
}

extern "C" void kernel_launch(void* const* d_in, const int* in_sizes, int n_in, void* d_out, int out_size, void* d_ws, size_t ws_size, hipStream_t stream) {
    static int grid = 0;
    if (grid == 0) {
        if (n_in != 25 || out_size != T_ * 1024 || ws_size < WS_END) { fprintf(stderr, "kernel_launch: unexpected sizes n_in %d out %d ws %zu\n", n_in, out_size, ws_size); }
        (void)hipFuncSetAttribute((const void*)topk_kernel, hipFuncAttributeMaxDynamicSharedMemorySize, TK_LDS_BYTES);
        int dev = 0, cus = 0, per_cu = 0;
        (void)hipGetDevice(&dev); (void)hipDeviceGetAttribute(&cus, hipDeviceAttributeMultiprocessorCount, dev);
        if (hipFuncSetAttribute((const void*)fused_fwd, hipFuncAttributeMaxDynamicSharedMemorySize, LDS_BYTES) != hipSuccess) fprintf(stderr, "kernel_launch: hipFuncSetAttribute(fused_fwd) failed\n");
        if (hipOccupancyMaxActiveBlocksPerMultiprocessor(&per_cu, (const void*)fused_fwd, NWAVES * 64, LDS_BYTES) != hipSuccess || per_cu < 1) fprintf(stderr, "kernel_launch: occupancy query says %d blocks/CU\n", per_cu);
        (void)hipGetLastError();
        grid = cus > 0 ? cus : 256;
    }
    unsigned char* ws = (unsigned char*)d_ws; float* out = (float*)d_out;
    const unsigned mask = FUSED_MASK;
    if (mask) (void)hipMemsetAsync(ws + WS_CTL, 0, CTL_ZERO_BYTES, stream);
    Args a{};
    for (int i = 0; i < 25; ++i) a.in[i] = (const float*)d_in[i];
    a.out = out; a.ws = ws;
    int li = 0;
    auto launch = [&](int lo, int hi) {
        if (MERGE_LAUNCHES) { a.ph_lo = lo; a.ph_hi = hi; a.li = li++; hipLaunchKernelGGL(fused_fwd, dim3(grid), dim3(NWAVES * 64), LDS_BYTES, stream, a); }
        else for (int ph = lo; ph < hi; ++ph) { a.ph_lo = ph; a.ph_hi = ph + 1; a.li = li++; hipLaunchKernelGGL(fused_fwd, dim3(grid), dim3(NWAVES * 64), LDS_BYTES, stream, a); }
    };
    int pend_lo = -1, pend_hi = -1;
    if (mask && !(mask & 1)) launch(0, 1);
    for (int gidx = 0; gidx < 11; ++gidx) {
#if (defined(LRU_T2) && LRU_T2) || (defined(LRU_T3) && LRU_T3)
        if (gidx == 2 && (mask & 4u)) {
            if (pend_lo >= 0) { launch(pend_lo, pend_hi); pend_lo = -1; }
            launch(3, 4);
            hipLaunchKernelGGL(nv::lru_finish_naive_L<(LRU_T2 ? 16 : 64)>, dim3(B_ * 1024 / 64), dim3(64), 0, stream, (const bf16*)(ws + WS_HLOC), (const bf16*)(ws + WS_PCUM), (const bf16*)(ws + WS_GL), (bf16*)(ws + WS_R0));
            continue;
        }
#endif
        if (mask & (1u << gidx)) {
            if (pend_lo < 0) { pend_lo = GRP_LO[gidx]; pend_hi = GRP_HI[gidx]; } else pend_hi = GRP_HI[gidx];
        } else {
            if (pend_lo >= 0) { launch(pend_lo, pend_hi); pend_lo = -1; }
            naive_group(gidx, d_in, out, ws, stream);
        }
    }
    if (pend_lo >= 0) launch(pend_lo, pend_hi);
#if defined(LRU_DEBUG) && LRU_DEBUG == 2
    hipLaunchKernelGGL(nv::poison_if, dim3(T_ * 1024 / 256), dim3(256), 0, stream, out, (const unsigned*)(ws + WS_CTL) + 64);
#endif
}
```

```cpp
#include <hip/hip_runtime.h>
#include <cstdio>
#include <cstdint>
#include <cmath>

#ifndef FUSED_MASK
#define FUSED_MASK 0x7ff
#endif
#ifndef MERGE_LAUNCHES
#define MERGE_LAUNCHES 1
#endif
#ifndef LRU_PADDED
#define LRU_PADDED 1
#endif
#ifndef FUSE_FINAL
#define FUSE_FINAL 0
#endif
#ifndef GATHER_ROWS
#define GATHER_ROWS 3
#endif
#ifndef MIX_PIPE
#define MIX_PIPE 1
#endif
#define ALL_FUSED ((FUSED_MASK) == 0x7ff && (MERGE_LAUNCHES))
constexpr int B_ = 8, S_ = 2048, D_ = 1024, T_ = B_ * S_;
constexpr int INW = 4864;
constexpr float EPS = 1e-6f;
typedef unsigned short bf16;
#define HD_INLINE __host__ __device__ __forceinline__

constexpr size_t MiB = 1u << 20;
constexpr size_t WS_CTL = 0;
constexpr size_t WS_WIN = 1 * MiB;
constexpr size_t WS_WUA = WS_WIN + 4864 * 1024 * 2;
constexpr size_t WS_WUL = WS_WUA + 1 * MiB;
constexpr size_t WS_WO = WS_WUL + 2 * MiB;
constexpr size_t WS_WFOLD = WS_WO + 2 * MiB;
constexpr size_t WS_WG = WS_WFOLD + 4 * MiB;
constexpr size_t WS_WPROJ = WS_WG + 2 * MiB;
constexpr size_t WS_WAX = WS_WPROJ + MiB / 2;
constexpr size_t WS_W_END = WS_WAX + 1 * MiB;
static_assert(WS_W_END <= 23 * MiB, "weights");
constexpr size_t WS_RSTD1 = 23 * MiB;
constexpr size_t WS_PART2 = WS_RSTD1 + 256 * 1024;
constexpr size_t WS_PART4 = WS_PART2 + 1 * MiB;
constexpr size_t WS_RSTD3 = WS_PART4 + 1 * MiB;
constexpr size_t WS_AGG = WS_RSTD3 + 256 * 1024;
constexpr size_t WS_C8 = WS_AGG + 2 * MiB;
constexpr size_t WS_USCALE = WS_C8 + 64 * 1024;
static_assert(WS_USCALE + 128 * 1024 <= 28 * MiB, "small");
constexpr size_t WS_PB = 28 * MiB;
constexpr size_t WS_R0 = 36 * MiB;
constexpr size_t WS_QKV = 68 * MiB;
constexpr size_t WS_LX = 92 * MiB;
constexpr size_t WS_GL = 140 * MiB;
constexpr size_t WS_SGA = 172 * MiB;
constexpr size_t WS_SGL = 204 * MiB;
constexpr size_t WS_ATT = 236 * MiB;
constexpr size_t WS_HLOC = 68 * MiB, WS_PCUM = 100 * MiB;
constexpr size_t WS_MP = 68 * MiB;
constexpr size_t WS_MERGED = 140 * MiB;
constexpr size_t WS_SC = 172 * MiB;
constexpr size_t WS_SELI = 236 * MiB, WS_SELG = 244 * MiB;
constexpr size_t WS_U16 = 68 * MiB, WS_V16 = 100 * MiB;
constexpr size_t WS_H2B = 140 * MiB;
constexpr size_t WS_PP = 172 * MiB;
constexpr size_t WS_NAIVE_AB = 68 * MiB;
constexpr size_t WS_WAXD = 252 * MiB;
constexpr size_t WS_END = 256 * MiB;

HD_INLINE float bf2f(bf16 v) { return __builtin_bit_cast(float, (unsigned)v << 16); }
HD_INLINE bf16 f2bf(float f) { unsigned u = __builtin_bit_cast(unsigned, f); return (bf16)((u + 0x7fffu + ((u >> 16) & 1u)) >> 16); }
HD_INLINE unsigned pk2(float lo, float hi) { return (unsigned)f2bf(lo) | ((unsigned)f2bf(hi) << 16); }
__device__ __forceinline__ float wave_sum(float v) {
#pragma unroll
    for (int o = 1; o < 64; o <<= 1) v += __shfl_xor(v, o);
    return v;
}
__device__ __forceinline__ float sigmoidf_(float z) { return __builtin_amdgcn_rcpf(1.0f + __builtin_amdgcn_exp2f(-1.4426950408889634f * z)); }
__device__ __forceinline__ float gelu_tanh(float x) { const float u = 1.5957691216057308f * (x + 0.044715f * x * x * x); return x * sigmoidf_(u); }
__device__ __forceinline__ int fresh_lane() { int l; asm volatile("v_mbcnt_lo_u32_b32 %0, -1, 0\n\tv_mbcnt_hi_u32_b32 %0, -1, %0" : "=v"(l)); return l; }
#ifndef HD_INLINE
#define HD_INLINE __host__ __device__ __forceinline__
#endif

HD_INLINE unsigned tk_umax(unsigned a, unsigned b) { return a > b ? a : b; }
HD_INLINE unsigned tk_umin(unsigned a, unsigned b) { return a < b ? a : b; }
HD_INLINE unsigned tk_f2key(float f) { unsigned u = __builtin_bit_cast(unsigned, f); return u ^ ((unsigned)((int)u >> 31) | 0x80000000u); }
HD_INLINE float tk_key2f(unsigned k) { unsigned u = (k & 0x80000000u) ? (k ^ 0x80000000u) : ~k; return __builtin_bit_cast(float, u); }

HD_INLINE void tk_sort16(unsigned (&a)[16]) {
#pragma unroll
    for (int k = 2; k <= 16; k <<= 1) {
#pragma unroll
        for (int j = k >> 1; j > 0; j >>= 1) {
#pragma unroll
            for (int i = 0; i < 16; ++i) {
                const int p = i ^ j;
                if (p > i) {
                    const unsigned mx = tk_umax(a[i], a[p]), mn = tk_umin(a[i], a[p]);
                    if ((i & k) == 0) { a[i] = mx; a[p] = mn; } else { a[i] = mn; a[p] = mx; }
                }
            }
        }
    }
}
HD_INLINE void tk_merge16(unsigned (&a)[16], const unsigned (&b)[16]) {
#pragma unroll
    for (int i = 0; i < 16; ++i) a[i] = tk_umax(a[i], b[15 - i]);
#pragma unroll
    for (int j = 8; j > 0; j >>= 1) {
#pragma unroll
        for (int i = 0; i < 16; ++i) {
            const int p = i ^ j;
            if (p > i) { const unsigned mx = tk_umax(a[i], a[p]), mn = tk_umin(a[i], a[p]); a[i] = mx; a[p] = mn; }
        }
    }
}
HD_INLINE void tk_insert16(unsigned (&best)[16], unsigned key) {
#pragma unroll
    for (int s = 0; s < 16; ++s) { const unsigned hi = tk_umax(best[s], key); key = tk_umin(best[s], key); best[s] = hi; }
}
HD_INLINE void tk_combine_store(const unsigned (&k1)[16], const unsigned (&k2)[16], int* oi, float* og) {
    float v1[16], v2[16];
#pragma unroll
    for (int i = 0; i < 16; ++i) { v1[i] = tk_key2f(k1[i] & ~127u); v2[i] = tk_key2f(k2[i] & ~127u); }
    unsigned best[16];
#pragma unroll
    for (int s = 0; s < 16; ++s) best[s] = 0u;
#pragma unroll
    for (int i = 0; i < 16; ++i) {
#pragma unroll
        for (int j = 0; j < 16; ++j) {
            if ((i + 1) * (j + 1) <= 16) {
                const float s = v1[i] + v2[j];
                const unsigned key = (tk_f2key(s) & ~255u) | (unsigned)(255 - (i * 16 + j));
                tk_insert16(best, key);
            }
        }
    }
    const unsigned thr = best[15];
    const float mx = tk_key2f(best[0] & ~255u);
    float sum = 0.f;
#pragma unroll
    for (int i = 0; i < 16; ++i) {
#pragma unroll
        for (int j = 0; j < 16; ++j) {
            if ((i + 1) * (j + 1) <= 16) {
                const float s = v1[i] + v2[j];
                const unsigned key = (tk_f2key(s) & ~255u) | (unsigned)(255 - (i * 16 + j));
                if (key >= thr) sum += __builtin_expf(s - mx);
            }
        }
    }
    const float inv = 1.0f / sum;
    int cnt = 0;
#pragma unroll
    for (int i = 0; i < 16; ++i) {
#pragma unroll
        for (int j = 0; j < 16; ++j) {
            if ((i + 1) * (j + 1) <= 16) {
                const float s = v1[i] + v2[j];
                const unsigned key = (tk_f2key(s) & ~255u) | (unsigned)(255 - (i * 16 + j));
                if (key >= thr) {
                    oi[cnt] = (127 - (int)(k1[i] & 127u)) * 128 + (127 - (int)(k2[j] & 127u));
                    og[cnt] = __builtin_expf(s - mx) * inv;
                    ++cnt;
                }
            }
        }
    }
}

HD_INLINE unsigned tk_ckey(float s, unsigned odd64, int i, int j) { return ((tk_f2key(s) & ~255u) | (unsigned)(255 - (i * 16 + j))) - odd64; }
HD_INLINE void tk_pair_partial(const unsigned (&own)[16], const unsigned (&oth)[16], bool odd, unsigned (&r0)[16]) {
    float va[4], vb[16];
    const unsigned odd64 = odd ? 64u : 0u;
#pragma unroll
    for (int i = 0; i < 4; ++i) va[i] = tk_key2f(own[i] & ~127u);
#pragma unroll
    for (int j = 0; j < 16; ++j) vb[j] = tk_key2f(oth[j] & ~127u);
#pragma unroll
    for (int j = 1; j < 16; ++j) r0[j - 1] = tk_ckey(va[0] + vb[j], odd64, 0, j);
    r0[15] = 0u;
    unsigned l2[16];
#pragma unroll
    for (int j = 2; j < 8; ++j) l2[j - 2] = tk_ckey(va[1] + vb[j], odd64, 1, j);
    l2[6] = tk_ckey(va[2] + vb[3], odd64, 2, 3); l2[7] = tk_ckey(va[2] + vb[4], odd64, 2, 4);
#pragma unroll
    for (int d = 0; d < 4; ++d) { const unsigned k = tk_ckey(va[d] + vb[d], 0u, d, d); l2[8 + d] = odd ? 0u : k; }
#pragma unroll
    for (int d = 12; d < 16; ++d) l2[d] = 0u;
    tk_sort16(l2);
    tk_merge16(r0, l2);
}
HD_INLINE void tk_decode(unsigned key, int& i1, int& i2) { const int code = 255 - (int)(key & 255u); const int i = (code >> 4) & 3, j = code & 15; const bool po = (code >> 6) & 1; i1 = po ? j : i; i2 = po ? i : j; }
namespace nv {
struct ALf32 { const float* p; int lda; int pad; __device__ __forceinline__ float operator()(int m, int k) const { return p[(size_t)m * lda + k]; } };
struct ALbf16 { const bf16* p; int lda; int pad; __device__ __forceinline__ float operator()(int m, int k) const { return bf2f(p[(size_t)m * lda + k]); } };

template <class AL, class EPI, bool BT>
__global__ void __launch_bounds__(256) ngemm(AL al, const float* __restrict__ B, int ldb, const float* __restrict__ ks, int M, int N, int K, EPI epi) {
    __shared__ float As[16][68];
    __shared__ float Bs[16][68];
    const int tid = threadIdx.x, tx = tid & 15, ty = tid >> 4;
    const int m0 = blockIdx.y * 64, n0 = blockIdx.x * 64;
    float acc[4][4];
#pragma unroll
    for (int i = 0; i < 4; ++i)
#pragma unroll
        for (int j = 0; j < 4; ++j) acc[i][j] = 0.f;
    for (int k0 = 0; k0 < K; k0 += 16) {
#pragma unroll
        for (int i = 0; i < 4; ++i) {
            const int e = tid + i * 256;
            { const int m = e >> 4, k = e & 15; float v = al(m0 + m, k0 + k); if (ks) v *= ks[k0 + k]; As[k][m] = v; }
            if (BT) { const int n = e >> 4, k = e & 15; Bs[k][n] = B[(size_t)(n0 + n) * ldb + k0 + k]; }
            else { const int k = e >> 6, n = e & 63; Bs[k][n] = B[(size_t)(k0 + k) * ldb + n0 + n]; }
        }
        __syncthreads();
#pragma unroll
        for (int k = 0; k < 16; ++k) {
            float a[4], b[4];
#pragma unroll
            for (int i = 0; i < 4; ++i) { a[i] = As[k][ty * 4 + i]; b[i] = Bs[k][tx * 4 + i]; }
#pragma unroll
            for (int i = 0; i < 4; ++i)
#pragma unroll
                for (int j = 0; j < 4; ++j) acc[i][j] = fmaf(a[i], b[j], acc[i][j]);
        }
        __syncthreads();
    }
#pragma unroll
    for (int i = 0; i < 4; ++i)
#pragma unroll
        for (int j = 0; j < 4; ++j) epi(m0 + ty * 4 + i, n0 + tx * 4 + j, acc[i][j]);
}
template <class AL, class EPI, bool BT>
static void run_gemm(hipStream_t st, AL al, const float* B, int ldb, const float* ks, int M, int N, int K, EPI epi) {
    hipLaunchKernelGGL((ngemm<AL, EPI, BT>), dim3(N / 64, M / 64), dim3(256), 0, st, al, B, ldb, ks, M, N, K, epi);
}

__global__ void __launch_bounds__(256) rowsq(const float* __restrict__ X, float* rstd, float* part) {
    const int row = blockIdx.x * 4 + (threadIdx.x >> 6), lane = threadIdx.x & 63;
    const float* xr = X + (size_t)row * 1024;
    float s = 0.f;
    for (int j = 0; j < 16; ++j) { const float v = xr[lane + 64 * j]; s += v * v; }
    s = wave_sum(s);
    if (rstd && lane == 0) rstd[row] = 1.0f / sqrtf(s * (1.0f / 1024.0f) + EPS);
    if (part && lane < 16) part[(size_t)row * 16 + lane] = (lane == 0) ? s : 0.f;
}

struct EpiProj {
    const float* rstd; bf16 *qkv, *lx, *gl, *sga, *sgl;
    __device__ __forceinline__ void operator()(int m, int n, float v) const {
        v *= rstd[m];
        if (n < 768) qkv[(size_t)m * 768 + n] = f2bf(v);
        else if (n < 1792) lx[(size_t)m * 1024 + (n - 768)] = f2bf(v);
        else if (n < 2816) gl[(size_t)m * 1024 + (n - 1792)] = f2bf(gelu_tanh(v));
        else if (n < 3840) sga[(size_t)m * 1024 + (n - 2816)] = f2bf(sigmoidf_(v));
        else sgl[(size_t)m * 1024 + (n - 3840)] = f2bf(sigmoidf_(v));
    }
};

__global__ void __launch_bounds__(128) attn_naive(const bf16* __restrict__ qkv, const float* __restrict__ sink, bf16* __restrict__ att) {
    const int gid = blockIdx.x * 128 + threadIdx.x;
    const int head = gid / T_, t = gid % T_;
    const int b = t / S_, ts = t % S_;
    const int g = head >> 2;
    float q[64], acc[64];
    const bf16* qp = qkv + (size_t)t * 768 + head * 64;
#pragma unroll
    for (int d = 0; d < 64; ++d) { q[d] = bf2f(qp[d]); acc[d] = 0.f; }
    const float slope = exp2f(-(float)(head + 1));
    float m = -3.0e38f, l = 0.f;
    for (int dist = 127; dist >= 0; --dist) {
        const int s = ts - dist; if (s < 0) continue;
        const bf16* kp = qkv + (size_t)(b * S_ + s) * 768 + 512 + g * 64;
        const bf16* vp = kp + 128;
        float sc = 0.f;
#pragma unroll
        for (int d = 0; d < 64; ++d) sc = fmaf(q[d], bf2f(kp[d]), sc);
        sc = sc * 0.125f - slope * (float)dist;
        const float mn = fmaxf(m, sc), corr = __expf(m - mn), p = __expf(sc - mn);
        l = l * corr + p;
#pragma unroll
        for (int d = 0; d < 64; ++d) acc[d] = acc[d] * corr + p * bf2f(vp[d]);
        m = mn;
    }
    const float sk = sink[head];
    const float mf = fmaxf(m, sk), corr = __expf(m - mf);
    l = l * corr + __expf(sk - mf);
    const float inv = corr / l;
    bf16* op = att + (size_t)t * 512 + head * 64;
#pragma unroll
    for (int d = 0; d < 64; ++d) op[d] = f2bf(acc[d] * inv);
}

__global__ void __launch_bounds__(256) conv_naive(const bf16* __restrict__ lx, const float* __restrict__ cw, const float* __restrict__ cb, bf16* __restrict__ lin) {
    const size_t i = (size_t)blockIdx.x * 256 + threadIdx.x;
    const int c = (int)(i & 1023); const int t = (int)(i >> 10); const int ts = t % S_;
    float y = cb[c];
#pragma unroll
    for (int tap = 0; tap < 4; ++tap) { const int s = ts - 3 + tap; if (s >= 0) y = fmaf(bf2f(lx[(size_t)(t - 3 + tap) * 1024 + c]), cw[tap * 1024 + c], y); }
    lin[i] = f2bf(y);
}

__global__ void __launch_bounds__(128) lru_ab_naive(const bf16* __restrict__ lin, const float* __restrict__ wa, const float* __restrict__ ba, const float* __restrict__ wx, const float* __restrict__ bx,
                                                    const float* __restrict__ lam, float* __restrict__ Af, float* __restrict__ Bf) {
    __shared__ float xs[128];
    const int t = blockIdx.x >> 3, blk = blockIdx.x & 7, d = threadIdx.x, ch = blk * 128 + d;
    xs[d] = bf2f(lin[(size_t)t * 1024 + ch]);
    __syncthreads();
    float r = ba[ch], ii = bx[ch];
    const float* wap = wa + (size_t)blk * 128 * 128 + d; const float* wxp = wx + (size_t)blk * 128 * 128 + d;
    for (int c = 0; c < 128; ++c) { r = fmaf(xs[c], wap[c * 128], r); ii = fmaf(xs[c], wxp[c * 128], ii); }
    r = sigmoidf_(r); ii = sigmoidf_(ii);
    const float sp = log1pf(expf(-lam[ch]));
    const float loga = -8.0f * r * sp;
    const float a = expf(loga);
    const float bb = sqrtf(-expm1f(2.0f * loga)) * (ii * xs[d]);
    Af[(size_t)t * 1024 + ch] = a; Bf[(size_t)t * 1024 + ch] = bb;
}
__global__ void __launch_bounds__(256) lru_ab_from_pre(const bf16* __restrict__ lin, const float* __restrict__ ba, const float* __restrict__ bx, const float* __restrict__ lam, float* __restrict__ Af, float* __restrict__ Bf) {
    const size_t i = (size_t)blockIdx.x * 256 + threadIdx.x; const int ch = (int)(i & 1023);
    const float r = sigmoidf_(Af[i] + ba[ch]), ii = sigmoidf_(Bf[i] + bx[ch]);
    const float loga = -8.0f * r * log1pf(expf(-lam[ch]));
    Af[i] = expf(loga); Bf[i] = sqrtf(-expm1f(2.0f * loga)) * (ii * bf2f(lin[i]));
}
template <int L>
__global__ void __launch_bounds__(64) lru_finish_naive_L(const bf16* __restrict__ hloc, const bf16* __restrict__ pcum, const bf16* __restrict__ gl, bf16* __restrict__ rec) {
    const int gid = blockIdx.x * 64 + threadIdx.x; const int b = gid >> 10, ch = gid & 1023;
    float carry = 0.f;
    for (int c = 0; c < S_ / L; ++c) {
        float la = 1.f, lb = 0.f;
        for (int s = 0; s < L; ++s) { const size_t o = (size_t)(b * S_ + c * L + s) * 1024 + ch; la = bf2f(pcum[o]); lb = bf2f(hloc[o]); const float h = la * carry + lb; rec[o] = f2bf(h * bf2f(gl[o])); }
        carry = la * carry + lb;
    }
}
__global__ void __launch_bounds__(64) lru_finish_naive(const bf16* __restrict__ hloc, const bf16* __restrict__ pcum, const float* __restrict__ agg, const bf16* __restrict__ gl, bf16* __restrict__ rec) {
    const int gid = blockIdx.x * 64 + threadIdx.x; const int b = gid >> 10, ch = gid & 1023;
    float carry = 0.f;
    for (int c = 0; c < 32; ++c) {
        const int chunk = b * 32 + c;
        for (int s = 0; s < 64; ++s) { const size_t o = (size_t)(chunk * 64 + s) * 1024 + ch; const float h = bf2f(pcum[o]) * carry + bf2f(hloc[o]); rec[o] = f2bf(h * bf2f(gl[o])); }
        const float* ap = agg + ((size_t)chunk * 1024 + ch) * 2; carry = ap[0] * carry + ap[1];
    }
}
__global__ void __launch_bounds__(128) lru_pre_check(const bf16* __restrict__ lin, const float* __restrict__ wa, const float* __restrict__ wx, const float* __restrict__ Rp, const float* __restrict__ Ip, unsigned* flag) {
    __shared__ float xs[128];
    const int t = blockIdx.x >> 3, blk = blockIdx.x & 7, d = threadIdx.x, ch = blk * 128 + d;
    xs[d] = bf2f(lin[(size_t)t * 1024 + ch]);
    __syncthreads();
    float r = 0.f, ii = 0.f;
    const float* wap = wa + (size_t)blk * 128 * 128 + d; const float* wxp = wx + (size_t)blk * 128 * 128 + d;
    for (int c = 0; c < 128; ++c) { r = fmaf(xs[c], wap[c * 128], r); ii = fmaf(xs[c], wxp[c * 128], ii); }
    const float dr = fabsf(r - Rp[(size_t)t * 1024 + ch]), di = fabsf(ii - Ip[(size_t)t * 1024 + ch]);
    if (!(dr < 0.08f + 0.03f * fabsf(r)) || !(di < 0.08f + 0.03f * fabsf(ii))) atomicAdd(flag, 1u);
}
__global__ void __launch_bounds__(256) poison_if(float* out, const unsigned* flag) { if (*flag) { const size_t i = (size_t)blockIdx.x * 256 + threadIdx.x; out[i] = out[i] * 50.0f + 3.0f; } }
__global__ void __launch_bounds__(64) lru_scan_naive(const float* __restrict__ Af, const float* __restrict__ Bf, const bf16* __restrict__ gl, bf16* __restrict__ rec) {
    const int gid = blockIdx.x * 64 + threadIdx.x; const int b = gid >> 10, ch = gid & 1023;
    float h = 0.f;
    for (int s = 0; s < S_; ++s) { const size_t o = (size_t)(b * S_ + s) * 1024 + ch; h = fmaf(Af[o], h, Bf[o]); rec[o] = f2bf(h * bf2f(gl[o])); }
}

struct EpiMP { const bf16* sga; float* mp; __device__ __forceinline__ void operator()(int m, int n, float v) const { const size_t o = (size_t)m * 1024 + n; mp[o] = v * bf2f(sga[o]); } };
struct EpiMerged { const bf16* sgl; const float* mp; bf16* merged; __device__ __forceinline__ void operator()(int m, int n, float v) const { const size_t o = (size_t)m * 1024 + n; merged[o] = f2bf(mp[o] + v * bf2f(sgl[o])); } };
struct EpiH1 { const float* x; float* h1; bf16* h1b; __device__ __forceinline__ void operator()(int m, int n, float v) const { const size_t o = (size_t)m * 1024 + n; const float h = x[o] + v; h1[o] = h; h1b[o] = f2bf(h); } };
struct EpiScaleF32 { const float* part; float* out; int ldo; int pad; __device__ __forceinline__ void operator()(int m, int n, float v) const {
    float s = 0.f; for (int i = 0; i < 16; ++i) s += part[(size_t)m * 16 + i];
    out[(size_t)m * ldo + n] = v * (1.0f / sqrtf(s * (1.0f / 1024.0f) + EPS)); } };
struct EpiPlainF32 { float* out; int ldo; int pad; __device__ __forceinline__ void operator()(int m, int n, float v) const { out[(size_t)m * ldo + n] = v; } };
struct EpiPP { bf16* pp; __device__ __forceinline__ void operator()(int m, int n, float v) const { pp[(size_t)m * 1024 + n] = f2bf(v); } };
struct EpiH3 { const float* rstd3; const bf16* pp; float* h; __device__ __forceinline__ void operator()(int m, int n, float v) const { const size_t o = (size_t)m * 1024 + n; h[o] = h[o] + sigmoidf_(v * rstd3[m]) * bf2f(pp[o]); } };

__global__ void __launch_bounds__(256) final_norm(float* __restrict__ h, const float* __restrict__ part, const float* __restrict__ fg) {
    const int row = blockIdx.x * 4 + (threadIdx.x >> 6), lane = threadIdx.x & 63;
    float s = 0.f; for (int i = 0; i < 16; ++i) s += part[(size_t)row * 16 + i];
    const float r = 1.0f / sqrtf(s * (1.0f / 1024.0f) + EPS);
    float* hr = h + (size_t)row * 1024;
    for (int j = 0; j < 16; ++j) { const int c = lane + 64 * j; hr[c] = hr[c] * r * fg[c]; }
}
}
#define LAS __attribute__((address_space(3)))
typedef float f32x4 __attribute__((ext_vector_type(4)));
typedef unsigned u32x4 __attribute__((ext_vector_type(4)));
typedef int i32x4 __attribute__((ext_vector_type(4)));

constexpr int TK_TOK = 32;
constexpr int TK_LSTRIDE = 132;
constexpr int TK_LDS_BYTES = 256 * TK_LSTRIDE * 4;

__device__ __forceinline__ void topk_item(LAS float* lds, const float* __restrict__ SC, int item, int head_base, int* __restrict__ seli, float* __restrict__ selg, int tid) {
    const f32x4* src = (const f32x4*)(SC + (size_t)item * TK_TOK * 1024);
#pragma unroll 4
    for (int i = 0; i < 16; ++i) {
        const int idx = tid + i * 512; const int row = idx >> 8, c4 = idx & 255;
        const f32x4 v = src[idx];
        const int list = row * 8 + (c4 >> 5), elem = (c4 & 31) * 4;
        *(LAS f32x4*)(lds + list * TK_LSTRIDE + elem) = v;
    }
    __syncthreads();
    if (tid < 256) {
        const LAS float* my = lds + tid * TK_LSTRIDE;
        unsigned acc[16];
#pragma unroll
        for (int g = 0; g < 8; ++g) {
            unsigned t[16];
#pragma unroll
            for (int q = 0; q < 4; ++q) {
                const f32x4 v = *(const LAS f32x4*)(my + g * 16 + q * 4);
#pragma unroll
                for (int c = 0; c < 4; ++c) { const int e = g * 16 + q * 4 + c; t[q * 4 + c] = (tk_f2key(v[c]) & ~127u) | (unsigned)(127 - e); }
            }
            tk_sort16(t);
            if (g == 0) {
#pragma unroll
                for (int i = 0; i < 16; ++i) acc[i] = t[i];
            } else tk_merge16(acc, t);
        }
        unsigned oth[16];
#pragma unroll
        for (int i = 0; i < 16; ++i) oth[i] = (unsigned)__shfl_xor((int)acc[i], 1);
        if ((tid & 1) == 0) {
            const int tok = item * TK_TOK + (tid >> 3), head = head_base + ((tid >> 1) & 3);
            tk_combine_store(acc, oth, seli + (size_t)tok * 128 + head * 16, selg + (size_t)tok * 128 + head * 16);
        }
    }
    __syncthreads();
}
__global__ void __launch_bounds__(512) topk_kernel(const float* __restrict__ SC, int head_base, int* __restrict__ seli, float* __restrict__ selg) {
    extern __shared__ __attribute__((aligned(16))) unsigned char dyn_lds[];
    for (int item = blockIdx.x; item < T_ / TK_TOK; item += gridDim.x) topk_item((LAS float*)dyn_lds, SC, item, head_base, seli, selg, (int)threadIdx.x);
}

template <int MODE>
__device__ __forceinline__ void gather_token(int t, int lane, const void* __restrict__ Utab, const void* __restrict__ Vtab, const float* __restrict__ gffn,
                                             const int* __restrict__ seli, const float* __restrict__ selg, const float* __restrict__ part2,
                                             float* __restrict__ H  , bf16* __restrict__ h2b, float* __restrict__ rstd3) {
    float ps = (lane < 16) ? part2[(size_t)t * 16 + lane] : 0.f;
    ps = wave_sum(ps);
    const float rstd2 = 1.0f / sqrtf(ps * (1.0f / 1024.0f) + EPS);
    const int iA = seli[(size_t)t * 128 + lane], iB = seli[(size_t)t * 128 + 64 + lane];
    const float gA = selg[(size_t)t * 128 + lane], gB = selg[(size_t)t * 128 + 64 + lane];
    float* hr = H + (size_t)t * 1024;
    if constexpr (MODE == 0) {
        f32x4 x[4], y[4], hv[4];
#pragma unroll
        for (int j = 0; j < 4; ++j) { hv[j] = *(const f32x4*)(hr + 256 * j + 4 * lane); const f32x4 g = *(const f32x4*)(gffn + 256 * j + 4 * lane); x[j] = hv[j] * g; y[j] = (f32x4){0.f, 0.f, 0.f, 0.f}; }
        const float* U = (const float*)Utab; const float* V = (const float*)Vtab;
        for (int k = 0; k < 64; ++k) {
#pragma unroll
            for (int hh = 0; hh < 2; ++hh) {
                const int e = __builtin_amdgcn_readlane(hh ? iB : iA, k);
                const float gt = __builtin_bit_cast(float, __builtin_amdgcn_readlane(__builtin_bit_cast(int, hh ? gB : gA), k));
                const float* ur = U + (size_t)e * 1024; const float* vr = V + (size_t)e * 1024;
                f32x4 uv[4], vv[4];
#pragma unroll
                for (int j = 0; j < 4; ++j) { uv[j] = *(const f32x4*)(ur + 256 * j + 4 * lane); vv[j] = *(const f32x4*)(vr + 256 * j + 4 * lane); }
                float d = 0.f;
#pragma unroll
                for (int j = 0; j < 4; ++j) d += (uv[j].x * x[j].x + uv[j].y * x[j].y) + (uv[j].z * x[j].z + uv[j].w * x[j].w);
                d = wave_sum(d);
                const float c = gt * gelu_tanh(d * rstd2);
#pragma unroll
                for (int j = 0; j < 4; ++j) y[j] += vv[j] * c;
            }
        }
        float sq = 0.f;
#pragma unroll
        for (int j = 0; j < 4; ++j) {
            const f32x4 h2 = hv[j] + y[j];
            *(f32x4*)(hr + 256 * j + 4 * lane) = h2;
            sq += (h2.x * h2.x + h2.y * h2.y) + (h2.z * h2.z + h2.w * h2.w);
            uint2 w; w.x = pk2(h2.x, h2.y); w.y = pk2(h2.z, h2.w);
            *(uint2*)(h2b + (size_t)t * 1024 + 256 * j + 4 * lane) = w;
        }
        sq = wave_sum(sq);
        if (lane == 0) rstd3[t] = 1.0f / sqrtf(sq * (1.0f / 1024.0f) + EPS);
    } else {
        float x[2][8], y[2][8], hv[2][8];
#pragma unroll
        for (int j = 0; j < 2; ++j) {
            const f32x4 a = *(const f32x4*)(hr + 512 * j + 8 * lane), b = *(const f32x4*)(hr + 512 * j + 8 * lane + 4);
            hv[j][0] = a.x; hv[j][1] = a.y; hv[j][2] = a.z; hv[j][3] = a.w; hv[j][4] = b.x; hv[j][5] = b.y; hv[j][6] = b.z; hv[j][7] = b.w;
#pragma unroll
            for (int c = 0; c < 8; ++c) { x[j][c] = hv[j][c]; y[j][c] = 0.f; }
        }
        const bf16* U = (const bf16*)Utab; const bf16* V = (const bf16*)Vtab;
        for (int k = 0; k < 64; k += 2) {
            u32x4 uv[4][2], vv[4][2]; float gt[4];
#pragma unroll
            for (int q = 0; q < 4; ++q) {
                const int kk = k + (q >> 1); const int hh = q & 1;
                const int e = __builtin_amdgcn_readlane(hh ? iB : iA, kk);
                gt[q] = __builtin_bit_cast(float, __builtin_amdgcn_readlane(__builtin_bit_cast(int, hh ? gB : gA), kk));
                const bf16* ur = U + (size_t)e * 1024; const bf16* vr = V + (size_t)e * 1024;
#pragma unroll
                for (int j = 0; j < 2; ++j) { uv[q][j] = *(const u32x4*)(ur + 512 * j + 8 * lane); vv[q][j] = *(const u32x4*)(vr + 512 * j + 8 * lane); }
            }
#pragma unroll
            for (int q = 0; q < 4; ++q) {
                float d = 0.f;
#pragma unroll
                for (int j = 0; j < 2; ++j)
#pragma unroll
                    for (int c = 0; c < 4; ++c) { const unsigned w = uv[q][j][c]; d = fmaf(__builtin_bit_cast(float, w << 16), x[j][2 * c], d); d = fmaf(__builtin_bit_cast(float, w & 0xffff0000u), x[j][2 * c + 1], d); }
                d = wave_sum(d);
                const float cf = gt[q] * gelu_tanh(d * rstd2);
#pragma unroll
                for (int j = 0; j < 2; ++j)
#pragma unroll
                    for (int c = 0; c < 4; ++c) { const unsigned w = vv[q][j][c]; y[j][2 * c] = fmaf(__builtin_bit_cast(float, w << 16), cf, y[j][2 * c]); y[j][2 * c + 1] = fmaf(__builtin_bit_cast(float, w & 0xffff0000u), cf, y[j][2 * c + 1]); }
            }
        }
        float sq = 0.f;
#pragma unroll
        for (int j = 0; j < 2; ++j) {
            float h2[8];
#pragma unroll
            for (int c = 0; c < 8; ++c) { h2[c] = hv[j][c] + y[j][c]; sq += h2[c] * h2[c]; }
            *(f32x4*)(hr + 512 * j + 8 * lane) = (f32x4){h2[0], h2[1], h2[2], h2[3]};
            *(f32x4*)(hr + 512 * j + 8 * lane + 4) = (f32x4){h2[4], h2[5], h2[6], h2[7]};
            u32x4 w; w.x = pk2(h2[0], h2[1]); w.y = pk2(h2[2], h2[3]); w.z = pk2(h2[4], h2[5]); w.w = pk2(h2[6], h2[7]);
            *(u32x4*)(h2b + (size_t)t * 1024 + 512 * j + 8 * lane) = w;
        }
        sq = wave_sum(sq);
        if (lane == 0) rstd3[t] = 1.0f / sqrtf(sq * (1.0f / 1024.0f) + EPS);
    }
}
template <int MODE>
__global__ void __launch_bounds__(256) gather_kernel(const void* __restrict__ Utab, const void* __restrict__ Vtab, const float* __restrict__ gffn, const int* __restrict__ seli, const float* __restrict__ selg,
                                                     const float* __restrict__ part2, float* __restrict__ H, bf16* __restrict__ h2b, float* __restrict__ rstd3) {
    const int lane = threadIdx.x & 63; const int w = blockIdx.x * 4 + (threadIdx.x >> 6); const int nw = gridDim.x * 4;
    for (int t = w; t < T_; t += nw) gather_token<MODE>(t, lane, Utab, Vtab, gffn, seli, selg, part2, H, h2b, rstd3);
}

typedef float f32x2 __attribute__((ext_vector_type(2)));
__device__ __forceinline__ float reduce4_transpose(float d0, float d1, float d2, float d3, int lane) {
    const bool b0 = lane & 1, b1 = lane & 2;
    const float a = (b0 ? d1 : d0) + __shfl_xor(b0 ? d0 : d1, 1);
    const float b = (b0 ? d3 : d2) + __shfl_xor(b0 ? d2 : d3, 1);
    float c = (b1 ? b : a) + __shfl_xor(b1 ? a : b, 2);
    c += __shfl_xor(c, 4); c += __shfl_xor(c, 8); c += __shfl_xor(c, 16); c += __shfl_xor(c, 32);
    return c;
}
__device__ __forceinline__ float dot16_fp8(const u32x4 w, const f32x2 (&x2)[8]) {
    f32x2 acc = (f32x2){0.f, 0.f};
#pragma unroll
    for (int c = 0; c < 4; ++c) { const unsigned ww = w[c]; const f32x2 lo = __builtin_amdgcn_cvt_pk_f32_fp8(ww, false), hi = __builtin_amdgcn_cvt_pk_f32_fp8(ww, true); acc = lo * x2[2 * c] + acc; acc = hi * x2[2 * c + 1] + acc; }
    return acc.x + acc.y;
}
__device__ __forceinline__ void axpy16_fp8(const u32x4 w, float cf, f32x2 (&y2)[8]) {
#pragma unroll
    for (int c = 0; c < 4; ++c) { const unsigned ww = w[c]; const f32x2 lo = __builtin_amdgcn_cvt_pk_f32_fp8(ww, false), hi = __builtin_amdgcn_cvt_pk_f32_fp8(ww, true); y2[2 * c] = lo * cf + y2[2 * c]; y2[2 * c + 1] = hi * cf + y2[2 * c + 1]; }
}
__device__ __forceinline__ float sel4f(float v0, float v1, float v2, float v3, int q) { return q == 0 ? v0 : (q == 1 ? v1 : (q == 2 ? v2 : v3)); }
__device__ __forceinline__ void gather_token_fp8(int t, int lane, const unsigned char* __restrict__ U8, const unsigned char* __restrict__ V8, const float* __restrict__ IU, const float* __restrict__ IV,
                                                 const int* __restrict__ seli, const float* __restrict__ selg, const float* __restrict__ part2,
                                                 float* __restrict__ H, bf16* __restrict__ h2b, float* __restrict__ rstd3) {
    float ps = (lane < 16) ? part2[(size_t)t * 16 + lane] : 0.f;
    ps = wave_sum(ps);
    const float rstd2 = 1.0f / sqrtf(ps * (1.0f / 1024.0f) + EPS);
    const int iA = seli[(size_t)t * 128 + lane], iB = seli[(size_t)t * 128 + 64 + lane];
    const float duA = IU[iA] * rstd2, duB = IU[iB] * rstd2;
    const float gvA = selg[(size_t)t * 128 + lane] * IV[iA], gvB = selg[(size_t)t * 128 + 64 + lane] * IV[iB];
    float* hr = H + (size_t)t * 1024 + 16 * lane;
    f32x2 x2[8], y2[8]; f32x4 hv[4];
#pragma unroll
    for (int j = 0; j < 4; ++j) { hv[j] = *(const f32x4*)(hr + 4 * j); x2[2 * j] = (f32x2){hv[j][0], hv[j][1]}; x2[2 * j + 1] = (f32x2){hv[j][2], hv[j][3]}; y2[2 * j] = (f32x2){0.f, 0.f}; y2[2 * j + 1] = (f32x2){0.f, 0.f}; }
    const int q = lane & 3;
#pragma unroll 1
    for (int k = 0; k < 64; k += 4) {
        u32x4 uu[8], vv[8]; float du[8], gv[8];
#pragma unroll
        for (int s = 0; s < 8; ++s) {
            const int kk = k + (s >> 1); const bool hh = s & 1;
            const int e = __builtin_amdgcn_readlane(hh ? iB : iA, kk);
            du[s] = __int_as_float(__builtin_amdgcn_readlane(__float_as_int(hh ? duB : duA), kk));
            gv[s] = __int_as_float(__builtin_amdgcn_readlane(__float_as_int(hh ? gvB : gvA), kk));
            uu[s] = *(const u32x4*)(U8 + (size_t)e * 1024 + 16 * lane);
            vv[s] = *(const u32x4*)(V8 + (size_t)e * 1024 + 16 * lane);
        }
#pragma unroll
        for (int g = 0; g < 2; ++g) {
            const float d0 = dot16_fp8(uu[4 * g + 0], x2), d1 = dot16_fp8(uu[4 * g + 1], x2), d2 = dot16_fp8(uu[4 * g + 2], x2), d3 = dot16_fp8(uu[4 * g + 3], x2);
            const float tot = reduce4_transpose(d0, d1, d2, d3, lane);
            const float z = tot * sel4f(du[4 * g], du[4 * g + 1], du[4 * g + 2], du[4 * g + 3], q);
            const float cf = gelu_tanh(z) * sel4f(gv[4 * g], gv[4 * g + 1], gv[4 * g + 2], gv[4 * g + 3], q);
#pragma unroll
            for (int s = 0; s < 4; ++s) { const float cs = __int_as_float(__builtin_amdgcn_readlane(__float_as_int(cf), s)); axpy16_fp8(vv[4 * g + s], cs, y2); }
        }
    }
    float sq = 0.f;
    f32x4 h2[4];
#pragma unroll
    for (int j = 0; j < 4; ++j) {
        h2[j] = hv[j] + (f32x4){y2[2 * j].x, y2[2 * j].y, y2[2 * j + 1].x, y2[2 * j + 1].y};
        *(f32x4*)(hr + 4 * j) = h2[j];
        sq += (h2[j][0] * h2[j][0] + h2[j][1] * h2[j][1]) + (h2[j][2] * h2[j][2] + h2[j][3] * h2[j][3]);
    }
    u32x4 w0, w1; w0.x = pk2(h2[0][0], h2[0][1]); w0.y = pk2(h2[0][2], h2[0][3]); w0.z = pk2(h2[1][0], h2[1][1]); w0.w = pk2(h2[1][2], h2[1][3]);
    w1.x = pk2(h2[2][0], h2[2][1]); w1.y = pk2(h2[2][2], h2[2][3]); w1.z = pk2(h2[3][0], h2[3][1]); w1.w = pk2(h2[3][2], h2[3][3]);
    u32x4* ob = (u32x4*)(h2b + (size_t)t * 1024 + 16 * lane); ob[0] = w0; ob[1] = w1;
    sq = wave_sum(sq);
    if (lane == 0) rstd3[t] = 1.0f / sqrtf(sq * (1.0f / 1024.0f) + EPS);
}

__device__ __forceinline__ unsigned umin_(unsigned a, unsigned b) { return a < b ? a : b; }
__device__ __forceinline__ unsigned umax_(unsigned a, unsigned b) { return a > b ? a : b; }
__device__ __forceinline__ void sort128(unsigned& k0, unsigned& k1, int lane) {
#pragma unroll
    for (int k = 2; k <= 128; k <<= 1) {
#pragma unroll
        for (int j = k >> 1; j >= 1; j >>= 1) {
            if (j == 64) { const unsigned mn = umin_(k0, k1), mx = umax_(k0, k1); k0 = mn; k1 = mx; }
            else {
                const unsigned o0 = (unsigned)__shfl_xor((int)k0, j), o1 = (unsigned)__shfl_xor((int)k1, j);
                const bool up0 = (k == 128) ? true : (k == 64 ? true : ((lane & k) == 0));
                const bool up1 = (k == 128) ? true : (k == 64 ? false : ((lane & k) == 0));
                const bool lower = (lane & j) == 0;
                k0 = (lower == up0) ? umin_(k0, o0) : umax_(k0, o0);
                k1 = (lower == up1) ? umin_(k1, o1) : umax_(k1, o1);
            }
        }
    }
}
typedef int i32x4v __attribute__((ext_vector_type(4)));
#ifndef NSLICE
#define NSLICE 8
#endif
#define SLICE_SHIFT (NSLICE == 32 ? 25 : (NSLICE == 16 ? 26 : (NSLICE == 8 ? 27 : (NSLICE == 4 ? 28 : 30))))
typedef unsigned u32x2 __attribute__((ext_vector_type(2)));
__device__ __forceinline__ f32x4 bf4_lo(u32x2 w) { return (f32x4){__builtin_bit_cast(float, w.x << 16), __builtin_bit_cast(float, w.x & 0xffff0000u), __builtin_bit_cast(float, w.y << 16), __builtin_bit_cast(float, w.y & 0xffff0000u)}; }
struct TokState { f32x2 y2[8]; unsigned k0, k1; int bnd; float rsx; };
__device__ __forceinline__ int count_lt(const TokState& S, unsigned bound) {
    return __builtin_popcountll(__builtin_amdgcn_ballot_w64(S.k0 < bound)) + __builtin_popcountll(__builtin_amdgcn_ballot_w64(S.k1 < bound));
}
__device__ __forceinline__ int bperm_i(int srclane, int v) { return __builtin_amdgcn_ds_bpermute(srclane << 2, v); }
__device__ __forceinline__ float bperm_f(int srclane, float v) { return __int_as_float(__builtin_amdgcn_ds_bpermute(srclane << 2, __float_as_int(v))); }
template <int PM>
__device__ __forceinline__ void gather_batch(TokState& S, int p, int hi, int lane, const LAS unsigned char* xs, const unsigned char* __restrict__ U8, const unsigned char* __restrict__ V8, const float* __restrict__ IU, const float* __restrict__ IV) {
    const int n = (hi - p < 16) ? hi - p : 16;
    const int m = lane & 15, kq = lane >> 4;
    const int r = (m < n) ? p + m : hi - 1; const int sl = r & 63; const bool lo = r < 64;
    const unsigned ka = (unsigned)bperm_i(sl, (int)S.k0), kb = (unsigned)bperm_i(sl, (int)S.k1);
    const int es = (int)((lo ? ka : kb) >> 16);
    const unsigned key = lo ? ka : kb;
    const float dus = IU[es] * S.rsx, gvs = (m < n) ? (float)(key & 0xffffu) * (1.0f / 65535.0f) * IV[es] : 0.f;
    const unsigned char* ua = U8 + (size_t)es * 1024 + 16 * kq;
    i32x4v A[16];
    if (!(PM & 2)) {
#pragma unroll
        for (int s = 0; s < 16; ++s) { if (PM & 16) { const int e = __builtin_amdgcn_readlane(es, s); A[s] = *(const i32x4v*)(U8 + (size_t)e * 1024 + 16 * lane); } else A[s] = *(const i32x4v*)(ua + 64 * s); }
    }
    u32x4 vv[16];
    if (!(PM & 1)) {
#pragma unroll
        for (int q = 0; q < 8; ++q) if (q < n) { const int e = __builtin_amdgcn_readlane(es, q); vv[q] = *(const u32x4*)(V8 + (size_t)e * 1024 + 16 * lane); }
        if (n > 8) {
#pragma unroll
            for (int q = 8; q < 16; ++q) if (q < n) { const int e = __builtin_amdgcn_readlane(es, q); vv[q] = *(const u32x4*)(V8 + (size_t)e * 1024 + 16 * lane); }
        }
    }
    i32x4v acc = (i32x4v){0, 0, 0, 0};
    if (!(PM & 2)) {
#pragma unroll
        for (int s = 0; s < 16; ++s) { const i32x4v B = *(const LAS i32x4v*)(xs + 64 * s + 16 * kq); acc = __builtin_amdgcn_mfma_i32_16x16x64_i8(A[s], B, acc, 0, 0, 0); }
    } else { acc = (i32x4v){es, es + 1, es + 2, es + 3}; }
    float cf[4];
#pragma unroll
    for (int j = 0; j < 4; ++j) { const int sm = 4 * kq + j; const float d = bperm_f(sm, dus), g = bperm_f(sm, gvs); cf[j] = g * gelu_tanh((float)acc[j] * d); }
    if (PM & 1) { S.y2[0].x += (cf[0] + cf[1]) + (cf[2] + cf[3]); }
    else if (PM & 4) {
#pragma unroll
        for (int q = 0; q < 16; ++q) if (q < n) { const float cs = __int_as_float(__builtin_amdgcn_readlane(__float_as_int(cf[q & 3]), 16 * (q >> 2))); S.y2[q & 7].x += cs * __uint_as_float((vv[q].x ^ vv[q].y ^ vv[q].z ^ vv[q].w) & 0x3fffffffu); }
    } else {
#pragma unroll
        for (int q = 0; q < 8; ++q) if (q < n) { const float cs = __int_as_float(__builtin_amdgcn_readlane(__float_as_int(cf[q & 3]), 16 * (q >> 2))); axpy16_fp8(vv[q], cs, S.y2); }
        if (n > 8) {
#pragma unroll
            for (int q = 8; q < 16; ++q) if (q < n) { const float cs = __int_as_float(__builtin_amdgcn_readlane(__float_as_int(cf[q & 3]), 16 * (q >> 2))); axpy16_fp8(vv[q], cs, S.y2); }
        }
    }
    __builtin_amdgcn_sched_barrier(0);
}
__device__ __forceinline__ void tok_setup(TokState& S, int t, int lane, LAS unsigned char* xs, const int* __restrict__ seli, const float* __restrict__ selg,
                                          const float* __restrict__ part2, const bf16* __restrict__ h1b) {
    float ps = (lane < 16) ? part2[(size_t)t * 16 + lane] : 0.f;
    ps = wave_sum(ps);
    const float rstd2 = 1.0f / sqrtf(ps * (1.0f / 1024.0f) + EPS);
    f32x4 hv[4]; float am = 0.f;
    { const u32x4* br = (const u32x4*)(h1b + (size_t)t * 1024 + 16 * lane); const u32x4 b0 = br[0], b1 = br[1];
      hv[0] = bf4_lo((u32x2){b0.x, b0.y}); hv[1] = bf4_lo((u32x2){b0.z, b0.w}); hv[2] = bf4_lo((u32x2){b1.x, b1.y}); hv[3] = bf4_lo((u32x2){b1.z, b1.w}); }
#pragma unroll
    for (int j = 0; j < 4; ++j) { am = fmaxf(am, fmaxf(fmaxf(fabsf(hv[j][0]), fabsf(hv[j][1])), fmaxf(fabsf(hv[j][2]), fabsf(hv[j][3])))); }
#pragma unroll
    for (int o = 1; o < 64; o <<= 1) am = fmaxf(am, __shfl_xor(am, o));
    const float sx = am > 0.f ? 127.0f / am : 1.0f, isx = am > 0.f ? am * (1.0f / 127.0f) : 1.0f;
    u32x4 xq;
#pragma unroll
    for (int j = 0; j < 4; ++j) { unsigned w = 0u;
#pragma unroll
        for (int c = 0; c < 4; ++c) w |= ((unsigned)(int)__builtin_rintf(hv[j][c] * sx) & 0xffu) << (8 * c);
        xq[j] = w; }
    *(LAS u32x4*)(xs + 16 * lane) = xq;
    const int iA = seli[(size_t)t * 128 + lane], iB = seli[(size_t)t * 128 + 64 + lane];
    const float gA = selg[(size_t)t * 128 + lane], gB = selg[(size_t)t * 128 + 64 + lane];
    S.k0 = ((unsigned)iA << 16) | (unsigned)(gA * 65535.0f + 0.5f); S.k1 = ((unsigned)iB << 16) | (unsigned)(gB * 65535.0f + 0.5f);
    sort128(S.k0, S.k1, lane);
    S.rsx = rstd2 * isx;
    int bnd = 0;
#pragma unroll
    for (int s = 1; s <= NSLICE; ++s) { const int c = count_lt(S, (unsigned)s << SLICE_SHIFT); bnd = (lane == s) ? c : bnd; }
    S.bnd = bnd;
#pragma unroll
    for (int j = 0; j < 8; ++j) S.y2[j] = (f32x2){0.f, 0.f};
}
__device__ __forceinline__ void tok_finish(const TokState& S, int t, int lane, const bf16* __restrict__ h1b, bf16* __restrict__ h2b, float* __restrict__ rstd3) {
    const u32x4* br = (const u32x4*)(h1b + (size_t)t * 1024 + 16 * lane); const u32x4 b0 = br[0], b1 = br[1];
    f32x4 h2[4]; h2[0] = bf4_lo((u32x2){b0.x, b0.y}); h2[1] = bf4_lo((u32x2){b0.z, b0.w}); h2[2] = bf4_lo((u32x2){b1.x, b1.y}); h2[3] = bf4_lo((u32x2){b1.z, b1.w});
    float sq = 0.f;
#pragma unroll
    for (int j = 0; j < 4; ++j) {
        h2[j] = h2[j] + (f32x4){S.y2[2 * j].x, S.y2[2 * j].y, S.y2[2 * j + 1].x, S.y2[2 * j + 1].y};
        sq += (h2[j][0] * h2[j][0] + h2[j][1] * h2[j][1]) + (h2[j][2] * h2[j][2] + h2[j][3] * h2[j][3]);
    }
    u32x4 w0, w1; w0.x = pk2(h2[0][0], h2[0][1]); w0.y = pk2(h2[0][2], h2[0][3]); w0.z = pk2(h2[1][0], h2[1][1]); w0.w = pk2(h2[1][2], h2[1][3]);
    w1.x = pk2(h2[2][0], h2[2][1]); w1.y = pk2(h2[2][2], h2[2][3]); w1.z = pk2(h2[3][0], h2[3][1]); w1.w = pk2(h2[3][2], h2[3][3]);
    u32x4* ob = (u32x4*)(h2b + (size_t)t * 1024 + 16 * lane); ob[0] = w0; ob[1] = w1;
    sq = wave_sum(sq);
    if (lane == 0) rstd3[t] = 1.0f / sqrtf(sq * (1.0f / 1024.0f) + EPS);
}
__device__ __forceinline__ int dpp_xor8(int v) { return __builtin_amdgcn_update_dpp(0, v, 0x128, 0xf, 0xf, false); }
__device__ __forceinline__ int dpp_xor4(int v) { return __builtin_amdgcn_update_dpp(0, __builtin_amdgcn_update_dpp(0, v, 0x141, 0xf, 0xf, false), 0x1b, 0xf, 0xf, false); }
__device__ __forceinline__ int dpp_xor1(int v) { return __builtin_amdgcn_update_dpp(0, v, 0xb1, 0xf, 0xf, false); }
__device__ __forceinline__ int dpp_xor2(int v) { return __builtin_amdgcn_update_dpp(0, v, 0x4e, 0xf, 0xf, false); }
__device__ __forceinline__ int reduce16_rows(int (&p)[16], int lane) {
    int r8[8], r4[4], r2[2];
#pragma unroll
    for (int i = 0; i < 8; ++i) { const u32x2 s = __builtin_amdgcn_permlane32_swap((unsigned)p[i], (unsigned)p[i + 8], false, false); r8[i] = (int)(s.x + s.y); }
#pragma unroll
    for (int i = 0; i < 4; ++i) { const u32x2 s = __builtin_amdgcn_permlane16_swap((unsigned)r8[i], (unsigned)r8[i + 4], false, false); r4[i] = (int)(s.x + s.y); }
    const bool b3 = lane & 8, b2 = lane & 4;
#pragma unroll
    for (int i = 0; i < 2; ++i) { const int s0 = r4[i] + dpp_xor8(r4[i]), s1 = r4[i + 2] + dpp_xor8(r4[i + 2]); r2[i] = b3 ? s1 : s0; }
    const int keep = b2 ? r2[1] : r2[0], send = b2 ? r2[0] : r2[1];
    int t = keep + dpp_xor4(send);
    t += dpp_xor1(t); t += dpp_xor2(t);
    return t;
}
struct TokState2 { f32x2 y2[8]; unsigned k0, k1; float rsx; };
template <int PM>
__device__ __forceinline__ void gather_batch_rows(TokState& S, int p, int hi, int lane, const LAS unsigned char* xs, const unsigned char* __restrict__ U8, const unsigned char* __restrict__ V8, const float* __restrict__ IU, const float* __restrict__ IV) {
    const int n = (hi - p < 16) ? hi - p : 16;
    const int slot = lane >> 2;
    const int r = (slot < n) ? p + slot : hi - 1; const int sl = r & 63; const bool lo = r < 64;
    const unsigned ka = (unsigned)bperm_i(sl, (int)S.k0), kb = (unsigned)bperm_i(sl, (int)S.k1);
    const unsigned key = lo ? ka : kb;
    const int es = (int)(key >> 16);
    const float dus = IU[es] * S.rsx, gvs = (slot < n) ? (float)(key & 0xffffu) * (1.0f / 65535.0f) * IV[es] : 0.f;
    i32x4v A[16]; u32x4 vv[16];
#pragma unroll
    for (int g = 0; g < 4; ++g) if (4 * g < n) {
#pragma unroll
        for (int q = 4 * g; q < 4 * g + 4; ++q) { int e = __builtin_amdgcn_readlane(es, 4 * q); if (PM & 32) e &= 1023; A[q] = *(const i32x4v*)(U8 + (size_t)e * 1024 + 16 * lane); }
    }
#pragma unroll
    for (int g = 0; g < 4; ++g) if (4 * g < n) {
#pragma unroll
        for (int q = 4 * g; q < 4 * g + 4; ++q) { int e = __builtin_amdgcn_readlane(es, 4 * q); if (PM & 32) e &= 1023; vv[q] = *(const u32x4*)(V8 + (size_t)e * 1024 + 16 * lane); }
    }
    const i32x4v X = *(const LAS i32x4v*)(xs + 16 * lane);
    int pp[16];
#pragma unroll
    for (int g = 0; g < 4; ++g) {
        if (4 * g < n) {
#pragma unroll
            for (int q = 4 * g; q < 4 * g + 4; ++q) pp[q] = __builtin_amdgcn_sdot4(A[q][3], X[3], __builtin_amdgcn_sdot4(A[q][2], X[2], __builtin_amdgcn_sdot4(A[q][1], X[1], __builtin_amdgcn_sdot4(A[q][0], X[0], 0, false), false), false), false);
        } else {
#pragma unroll
            for (int q = 4 * g; q < 4 * g + 4; ++q) pp[q] = 0;
        }
    }
    const int tot = reduce16_rows(pp, lane);
    const float cf = gvs * gelu_tanh((float)tot * dus);
#pragma unroll
    for (int g = 0; g < 4; ++g) if (4 * g < n) {
#pragma unroll
        for (int q = 4 * g; q < 4 * g + 4; ++q) { const float cs = __int_as_float(__builtin_amdgcn_readlane(__float_as_int(cf), 4 * q)); axpy16_fp8(vv[q], cs, S.y2); }
    }
    __builtin_amdgcn_sched_barrier(0);
}

template <int PM>
__device__ __forceinline__ void gather_batch16(TokState2& S, int bi, int lane, const LAS unsigned char* xs, const unsigned char* __restrict__ U8, const unsigned char* __restrict__ V8, const float* __restrict__ IU, const float* __restrict__ IV) {
    const unsigned ksel = (bi < 4) ? S.k0 : S.k1;
    const int lb = (bi & 3) << 4;
    const unsigned key = (unsigned)bperm_i(lb + (lane >> 2), (int)ksel);
    const int es = (int)(key >> 16);
    const float dus = IU[es] * S.rsx, gvs = (float)(key & 0xffffu) * (1.0f / 65535.0f) * IV[es];
    i32x4v A[16]; u32x4 vv[16];
#pragma unroll
    for (int q = 0; q < 16; ++q) { int e = (int)((unsigned)__builtin_amdgcn_readlane((int)ksel, lb + q) >> 16); if (PM & 32) e &= 1023; if (!(PM & 2)) A[q] = *(const i32x4v*)(U8 + (size_t)e * 1024 + 16 * lane); else A[q] = (i32x4v){e, e, e, e}; }
#pragma unroll
    for (int q = 0; q < 16; ++q) { int e = (int)((unsigned)__builtin_amdgcn_readlane((int)ksel, lb + q) >> 16); if (PM & 32) e &= 1023; if (!(PM & 1)) vv[q] = *(const u32x4*)(V8 + (size_t)e * 1024 + 16 * lane); else vv[q] = (u32x4){(unsigned)e, 0u, 0u, 0u}; }
    const i32x4v X = *(const LAS i32x4v*)(xs + 16 * lane);
    int p[16];
#pragma unroll
    for (int q = 0; q < 16; ++q) p[q] = __builtin_amdgcn_sdot4(A[q][3], X[3], __builtin_amdgcn_sdot4(A[q][2], X[2], __builtin_amdgcn_sdot4(A[q][1], X[1], __builtin_amdgcn_sdot4(A[q][0], X[0], 0, false), false), false), false);
    const int tot = reduce16_rows(p, lane);
    const float cf = gvs * gelu_tanh((float)tot * dus);
#pragma unroll
    for (int q = 0; q < 16; ++q) { const float cs = __int_as_float(__builtin_amdgcn_readlane(__float_as_int(cf), 4 * q)); if (PM & 1) S.y2[q & 7].x += cs * __uint_as_float(vv[q].x); else axpy16_fp8(vv[q], cs, S.y2); }
    __builtin_amdgcn_sched_barrier(0);
}
__device__ __forceinline__ void tok_setup2(TokState2& S, int t, int lane, LAS unsigned char* xs, const int* __restrict__ seli, const float* __restrict__ selg,
                                           const float* __restrict__ part2, const bf16* __restrict__ h1b) {
    float ps = (lane < 16) ? part2[(size_t)t * 16 + lane] : 0.f;
    ps = wave_sum(ps);
    const float rstd2 = 1.0f / sqrtf(ps * (1.0f / 1024.0f) + EPS);
    f32x4 hv[4]; float am = 0.f;
    { const u32x4* br = (const u32x4*)(h1b + (size_t)t * 1024 + 16 * lane); const u32x4 b0 = br[0], b1 = br[1];
      hv[0] = bf4_lo((u32x2){b0.x, b0.y}); hv[1] = bf4_lo((u32x2){b0.z, b0.w}); hv[2] = bf4_lo((u32x2){b1.x, b1.y}); hv[3] = bf4_lo((u32x2){b1.z, b1.w}); }
#pragma unroll
    for (int j = 0; j < 4; ++j) { am = fmaxf(am, fmaxf(fmaxf(fabsf(hv[j][0]), fabsf(hv[j][1])), fmaxf(fabsf(hv[j][2]), fabsf(hv[j][3])))); }
#pragma unroll
    for (int o = 1; o < 64; o <<= 1) am = fmaxf(am, __shfl_xor(am, o));
    const float sx = am > 0.f ? 127.0f / am : 1.0f, isx = am > 0.f ? am * (1.0f / 127.0f) : 1.0f;
    u32x4 xq;
#pragma unroll
    for (int j = 0; j < 4; ++j) { unsigned w = 0u;
#pragma unroll
        for (int c = 0; c < 4; ++c) w |= ((unsigned)(int)__builtin_rintf(hv[j][c] * sx) & 0xffu) << (8 * c);
        xq[j] = w; }
    *(LAS u32x4*)(xs + 16 * lane) = xq;
    const int iA = seli[(size_t)t * 128 + lane], iB = seli[(size_t)t * 128 + 64 + lane];
    const float gA = selg[(size_t)t * 128 + lane], gB = selg[(size_t)t * 128 + 64 + lane];
    S.k0 = ((unsigned)iA << 16) | (unsigned)(gA * 65535.0f + 0.5f); S.k1 = ((unsigned)iB << 16) | (unsigned)(gB * 65535.0f + 0.5f);
    sort128(S.k0, S.k1, lane);
    S.rsx = rstd2 * isx;
#pragma unroll
    for (int j = 0; j < 8; ++j) S.y2[j] = (f32x2){0.f, 0.f};
}
__device__ __forceinline__ void tok_finish2(const TokState2& S, int t, int lane, const bf16* __restrict__ h1b, bf16* __restrict__ h2b, float* __restrict__ rstd3) {
    const u32x4* br = (const u32x4*)(h1b + (size_t)t * 1024 + 16 * lane); const u32x4 b0 = br[0], b1 = br[1];
    f32x4 h2[4]; h2[0] = bf4_lo((u32x2){b0.x, b0.y}); h2[1] = bf4_lo((u32x2){b0.z, b0.w}); h2[2] = bf4_lo((u32x2){b1.x, b1.y}); h2[3] = bf4_lo((u32x2){b1.z, b1.w});
    float sq = 0.f;
#pragma unroll
    for (int j = 0; j < 4; ++j) {
        h2[j] = h2[j] + (f32x4){S.y2[2 * j].x, S.y2[2 * j].y, S.y2[2 * j + 1].x, S.y2[2 * j + 1].y};
        sq += (h2[j][0] * h2[j][0] + h2[j][1] * h2[j][1]) + (h2[j][2] * h2[j][2] + h2[j][3] * h2[j][3]);
    }
    u32x4 w0, w1; w0.x = pk2(h2[0][0], h2[0][1]); w0.y = pk2(h2[0][2], h2[0][3]); w0.z = pk2(h2[1][0], h2[1][1]); w0.w = pk2(h2[1][2], h2[1][3]);
    w1.x = pk2(h2[2][0], h2[2][1]); w1.y = pk2(h2[2][2], h2[2][3]); w1.z = pk2(h2[3][0], h2[3][1]); w1.w = pk2(h2[3][2], h2[3][3]);
    u32x4* ob = (u32x4*)(h2b + (size_t)t * 1024 + 16 * lane); ob[0] = w0; ob[1] = w1;
    sq = wave_sum(sq);
    if (lane == 0) rstd3[t] = 1.0f / sqrtf(sq * (1.0f / 1024.0f) + EPS);
}
template <int PM>
__device__ __forceinline__ void gather_wg_rows(int tok0, int wave, int lane, LAS unsigned char* lds, const unsigned char* __restrict__ U8, const unsigned char* __restrict__ V8, const float* __restrict__ IU, const float* __restrict__ IV,
                                               const int* __restrict__ seli, const float* __restrict__ selg, const float* __restrict__ part2, const bf16* __restrict__ h1b, bf16* __restrict__ h2b, float* __restrict__ rstd3, float* probe_out) {
    LAS unsigned char* xs = lds + wave * 4096;
#pragma unroll 1
    for (int pass = 0; pass < 2; ++pass) {
        const int tb = tok0 + pass * 32 + wave * 4;
        TokState2 S0, S1, S2, S3;
        tok_setup2(S0, tb + 0, fresh_lane(), xs, seli, selg, part2, h1b); __builtin_amdgcn_sched_barrier(0);
        tok_setup2(S1, tb + 1, fresh_lane(), xs + 1024, seli, selg, part2, h1b); __builtin_amdgcn_sched_barrier(0);
        tok_setup2(S2, tb + 2, fresh_lane(), xs + 2048, seli, selg, part2, h1b); __builtin_amdgcn_sched_barrier(0);
        tok_setup2(S3, tb + 3, fresh_lane(), xs + 3072, seli, selg, part2, h1b); __builtin_amdgcn_sched_barrier(0);
        __syncthreads();
        lane = fresh_lane();
#pragma unroll 1
        for (int bi = 0; bi < 8; ++bi) {
            gather_batch16<PM>(S0, bi, lane, xs, U8, V8, IU, IV);
            gather_batch16<PM>(S1, bi, lane, xs + 1024, U8, V8, IU, IV);
            gather_batch16<PM>(S2, bi, lane, xs + 2048, U8, V8, IU, IV);
            gather_batch16<PM>(S3, bi, lane, xs + 3072, U8, V8, IU, IV);
        }
        if (PM != 0) { const int fl = fresh_lane(); f32x2 a = S0.y2[0] + S1.y2[0] + S2.y2[0] + S3.y2[0];
#pragma unroll
            for (int j = 1; j < 8; ++j) a += S0.y2[j] + S1.y2[j] + S2.y2[j] + S3.y2[j];
            probe_out[(size_t)tb * 64 + fl] = a.x + a.y; }
        else { const int fl = fresh_lane(); tok_finish2(S0, tb, fl, h1b, h2b, rstd3); tok_finish2(S1, tb + 1, fl, h1b, h2b, rstd3); tok_finish2(S2, tb + 2, fl, h1b, h2b, rstd3); tok_finish2(S3, tb + 3, fl, h1b, h2b, rstd3); }
        __syncthreads();
    }
}
#if GATHER_ROWS == 2
#define GATHER_BATCH_FN gather_batch_rows
#else
#define GATHER_BATCH_FN gather_batch
#endif
template <int PM>
__device__ __forceinline__ void gather_wg_sliced(int tok0, int wave, int lane, LAS unsigned char* lds, const unsigned char* __restrict__ U8, const unsigned char* __restrict__ V8, const float* __restrict__ IU, const float* __restrict__ IV,
                                                 const int* __restrict__ seli, const float* __restrict__ selg, const float* __restrict__ part2, float* __restrict__ H, const bf16* __restrict__ h1b, bf16* __restrict__ h2b, float* __restrict__ rstd3, float* probe_out) {
    LAS unsigned char* xs = lds + wave * 4096;
#pragma unroll 1
    for (int pass = 0; pass < 2; ++pass) {
        const int tb = tok0 + pass * 32 + wave * 4;
        TokState S0, S1, S2, S3;
        tok_setup(S0, tb + 0, fresh_lane(), xs, seli, selg, part2, h1b); __builtin_amdgcn_sched_barrier(0);
        tok_setup(S1, tb + 1, fresh_lane(), xs + 1024, seli, selg, part2, h1b); __builtin_amdgcn_sched_barrier(0);
        tok_setup(S2, tb + 2, fresh_lane(), xs + 2048, seli, selg, part2, h1b); __builtin_amdgcn_sched_barrier(0);
        tok_setup(S3, tb + 3, fresh_lane(), xs + 3072, seli, selg, part2, h1b); __builtin_amdgcn_sched_barrier(0);
        __syncthreads();
        lane = fresh_lane();
        int lo0 = 0, lo1 = 0, lo2 = 0, lo3 = 0;
#pragma unroll 1
        for (int s = 0; s < NSLICE; ++s) {
            { const int hi = __builtin_amdgcn_readlane(S0.bnd, s + 1); for (int p = lo0; p < hi; p += 16) GATHER_BATCH_FN<PM>(S0, p, hi, lane, xs, U8, V8, IU, IV); lo0 = hi; }
            { const int hi = __builtin_amdgcn_readlane(S1.bnd, s + 1); for (int p = lo1; p < hi; p += 16) GATHER_BATCH_FN<PM>(S1, p, hi, lane, xs + 1024, U8, V8, IU, IV); lo1 = hi; }
            { const int hi = __builtin_amdgcn_readlane(S2.bnd, s + 1); for (int p = lo2; p < hi; p += 16) GATHER_BATCH_FN<PM>(S2, p, hi, lane, xs + 2048, U8, V8, IU, IV); lo2 = hi; }
            { const int hi = __builtin_amdgcn_readlane(S3.bnd, s + 1); for (int p = lo3; p < hi; p += 16) GATHER_BATCH_FN<PM>(S3, p, hi, lane, xs + 3072, U8, V8, IU, IV); lo3 = hi; }
        }
        if (probe_out) { const int fl = fresh_lane(); f32x2 a = S0.y2[0] + S1.y2[0] + S2.y2[0] + S3.y2[0];
#pragma unroll
            for (int j = 1; j < 8; ++j) a += S0.y2[j] + S1.y2[j] + S2.y2[j] + S3.y2[j];
            probe_out[(size_t)tb * 64 + fl] = a.x + a.y; }
        else { const int fl = fresh_lane(); tok_finish(S0, tb, fl, h1b, h2b, rstd3); tok_finish(S1, tb + 1, fl, h1b, h2b, rstd3); tok_finish(S2, tb + 2, fl, h1b, h2b, rstd3); tok_finish(S3, tb + 3, fl, h1b, h2b, rstd3); }
        __syncthreads();
    }
}


template <int J> __device__ __forceinline__ unsigned xor_lane(unsigned v) {
    if (J == 1) return (unsigned)__builtin_amdgcn_update_dpp(0, (int)v, 0xb1, 0xf, 0xf, false);
    if (J == 2) return (unsigned)__builtin_amdgcn_update_dpp(0, (int)v, 0x4e, 0xf, 0xf, false);
    if (J == 4) return (unsigned)dpp_xor4((int)v);
    if (J == 8) return (unsigned)__builtin_amdgcn_update_dpp(0, (int)v, 0x128, 0xf, 0xf, false);
    return (unsigned)__shfl_xor((int)v, J);
}
template <int NR, int KK, int J>
__device__ __forceinline__ void sort_stage(unsigned (&k)[NR], int lane) {
    if (J >= 64) {
        constexpr int d = J >> 6;
#pragma unroll
        for (int r = 0; r < NR; ++r) if ((r & d) == 0) {
            const bool up = (KK == 64 * NR) ? true : (((64 * r) & KK) == 0);
            const unsigned mn = umin_(k[r], k[r + d]), mx = umax_(k[r], k[r + d]);
            k[r] = up ? mn : mx; k[r + d] = up ? mx : mn;
        }
    } else {
        const bool lower = (lane & J) == 0;
        unsigned o[NR];
#pragma unroll
        for (int r = 0; r < NR; ++r) o[r] = xor_lane<(J < 64 ? J : 1)>(k[r]);
#pragma unroll
        for (int r = 0; r < NR; ++r) {
            const bool up = (KK == 64 * NR) ? true : (KK >= 64 ? (((64 * r) & KK) == 0) : ((lane & KK) == 0));
            k[r] = (lower == up) ? umin_(k[r], o[r]) : umax_(k[r], o[r]);
        }
    }
}
template <int NR, int KK, int J> struct SortJ { static __device__ __forceinline__ void run(unsigned (&k)[NR], int lane) { sort_stage<NR, KK, J>(k, lane); SortJ<NR, KK, J / 2>::run(k, lane); } };
template <int NR, int KK> struct SortJ<NR, KK, 0> { static __device__ __forceinline__ void run(unsigned (&)[NR], int) {} };
template <int NR, int KK> struct SortK { static __device__ __forceinline__ void run(unsigned (&k)[NR], int lane) { SortK<NR, KK / 2>::run(k, lane); SortJ<NR, KK, KK / 2>::run(k, lane); } };
template <int NR> struct SortK<NR, 1> { static __device__ __forceinline__ void run(unsigned (&)[NR], int) {} };
template <int NR>
__device__ __forceinline__ void sort_wave(unsigned (&k)[NR], int lane) { SortK<NR, 64 * NR>::run(k, lane); }
__device__ __forceinline__ void axpy_dispatch2(int t, int tbase, float cs, const f32x2 (&x)[8], f32x2 (&Ya)[8], f32x2 (&Yb)[8]) {
    const unsigned long long c = (unsigned long long)__float_as_uint(cs);
    const int tt = t - tbase;
    asm volatile(
        "s_cmp_gt_u32 %[t], 1\n\t"
        "s_cbranch_scc1 3f\n\t"
        "s_cmp_eq_u32 %[t], 1\n\t"
        "s_cbranch_scc1 2f\n\t"
        "v_pk_fma_f32 %[a0], %[c], %[x0], %[a0] op_sel_hi:[0,1,1]\n\t"
        "v_pk_fma_f32 %[a1], %[c], %[x1], %[a1] op_sel_hi:[0,1,1]\n\t"
        "v_pk_fma_f32 %[a2], %[c], %[x2], %[a2] op_sel_hi:[0,1,1]\n\t"
        "v_pk_fma_f32 %[a3], %[c], %[x3], %[a3] op_sel_hi:[0,1,1]\n\t"
        "v_pk_fma_f32 %[a4], %[c], %[x4], %[a4] op_sel_hi:[0,1,1]\n\t"
        "v_pk_fma_f32 %[a5], %[c], %[x5], %[a5] op_sel_hi:[0,1,1]\n\t"
        "v_pk_fma_f32 %[a6], %[c], %[x6], %[a6] op_sel_hi:[0,1,1]\n\t"
        "v_pk_fma_f32 %[a7], %[c], %[x7], %[a7] op_sel_hi:[0,1,1]\n\t"
        "s_branch 3f\n"
        "2:\n\t"
        "v_pk_fma_f32 %[b0], %[c], %[x0], %[b0] op_sel_hi:[0,1,1]\n\t"
        "v_pk_fma_f32 %[b1], %[c], %[x1], %[b1] op_sel_hi:[0,1,1]\n\t"
        "v_pk_fma_f32 %[b2], %[c], %[x2], %[b2] op_sel_hi:[0,1,1]\n\t"
        "v_pk_fma_f32 %[b3], %[c], %[x3], %[b3] op_sel_hi:[0,1,1]\n\t"
        "v_pk_fma_f32 %[b4], %[c], %[x4], %[b4] op_sel_hi:[0,1,1]\n\t"
        "v_pk_fma_f32 %[b5], %[c], %[x5], %[b5] op_sel_hi:[0,1,1]\n\t"
        "v_pk_fma_f32 %[b6], %[c], %[x6], %[b6] op_sel_hi:[0,1,1]\n\t"
        "v_pk_fma_f32 %[b7], %[c], %[x7], %[b7] op_sel_hi:[0,1,1]\n"
        "3:\n\t"
        : [a0] "+v"(Ya[0]), [a1] "+v"(Ya[1]), [a2] "+v"(Ya[2]), [a3] "+v"(Ya[3]), [a4] "+v"(Ya[4]), [a5] "+v"(Ya[5]), [a6] "+v"(Ya[6]), [a7] "+v"(Ya[7]),
          [b0] "+v"(Yb[0]), [b1] "+v"(Yb[1]), [b2] "+v"(Yb[2]), [b3] "+v"(Yb[3]), [b4] "+v"(Yb[4]), [b5] "+v"(Yb[5]), [b6] "+v"(Yb[6]), [b7] "+v"(Yb[7])
        : [x0] "v"(x[0]), [x1] "v"(x[1]), [x2] "v"(x[2]), [x3] "v"(x[3]), [x4] "v"(x[4]), [x5] "v"(x[5]), [x6] "v"(x[6]), [x7] "v"(x[7]), [c] "s"(c), [t] "s"(tt)
        : "scc");
}
__device__ __forceinline__ void axpy_dispatch2_dup(int t, int tbase, float cs, const f32x2 (&x)[8], f32x2 (&Ya)[8], f32x2 (&Yb)[8]) {
    const unsigned long long c = (unsigned long long)__float_as_uint(cs);
    const int tt = t - tbase;
    asm volatile(
        "s_cmp_gt_u32 %[t], 1\n\t"
        "s_cbranch_scc1 3f\n\t"
        "s_cmp_eq_u32 %[t], 1\n\t"
        "s_cbranch_scc1 2f\n\t"
        "v_pk_fma_f32 %[a0], %[c], %[x0], %[a0] op_sel_hi:[0,1,1]\n\t"
        "v_pk_fma_f32 %[a0], %[c], %[x0], %[a0] op_sel_hi:[0,1,1]\n\t"
        "v_pk_fma_f32 %[a1], %[c], %[x1], %[a1] op_sel_hi:[0,1,1]\n\t"
        "v_pk_fma_f32 %[a1], %[c], %[x1], %[a1] op_sel_hi:[0,1,1]\n\t"
        "v_pk_fma_f32 %[a2], %[c], %[x2], %[a2] op_sel_hi:[0,1,1]\n\t"
        "v_pk_fma_f32 %[a2], %[c], %[x2], %[a2] op_sel_hi:[0,1,1]\n\t"
        "v_pk_fma_f32 %[a3], %[c], %[x3], %[a3] op_sel_hi:[0,1,1]\n\t"
        "v_pk_fma_f32 %[a3], %[c], %[x3], %[a3] op_sel_hi:[0,1,1]\n\t"
        "v_pk_fma_f32 %[a4], %[c], %[x4], %[a4] op_sel_hi:[0,1,1]\n\t"
        "v_pk_fma_f32 %[a4], %[c], %[x4], %[a4] op_sel_hi:[0,1,1]\n\t"
        "v_pk_fma_f32 %[a5], %[c], %[x5], %[a5] op_sel_hi:[0,1,1]\n\t"
        "v_pk_fma_f32 %[a5], %[c], %[x5], %[a5] op_sel_hi:[0,1,1]\n\t"
        "v_pk_fma_f32 %[a6], %[c], %[x6], %[a6] op_sel_hi:[0,1,1]\n\t"
        "v_pk_fma_f32 %[a6], %[c], %[x6], %[a6] op_sel_hi:[0,1,1]\n\t"
        "v_pk_fma_f32 %[a7], %[c], %[x7], %[a7] op_sel_hi:[0,1,1]\n\t"
        "v_pk_fma_f32 %[a7], %[c], %[x7], %[a7] op_sel_hi:[0,1,1]\n\t"
        "s_branch 3f\n"
        "2:\n\t"
        "v_pk_fma_f32 %[b0], %[c], %[x0], %[b0] op_sel_hi:[0,1,1]\n\t"
        "v_pk_fma_f32 %[b0], %[c], %[x0], %[b0] op_sel_hi:[0,1,1]\n\t"
        "v_pk_fma_f32 %[b1], %[c], %[x1], %[b1] op_sel_hi:[0,1,1]\n\t"
        "v_pk_fma_f32 %[b1], %[c], %[x1], %[b1] op_sel_hi:[0,1,1]\n\t"
        "v_pk_fma_f32 %[b2], %[c], %[x2], %[b2] op_sel_hi:[0,1,1]\n\t"
        "v_pk_fma_f32 %[b2], %[c], %[x2], %[b2] op_sel_hi:[0,1,1]\n\t"
        "v_pk_fma_f32 %[b3], %[c], %[x3], %[b3] op_sel_hi:[0,1,1]\n\t"
        "v_pk_fma_f32 %[b3], %[c], %[x3], %[b3] op_sel_hi:[0,1,1]\n\t"
        "v_pk_fma_f32 %[b4], %[c], %[x4], %[b4] op_sel_hi:[0,1,1]\n\t"
        "v_pk_fma_f32 %[b4], %[c], %[x4], %[b4] op_sel_hi:[0,1,1]\n\t"
        "v_pk_fma_f32 %[b5], %[c], %[x5], %[b5] op_sel_hi:[0,1,1]\n\t"
        "v_pk_fma_f32 %[b5], %[c], %[x5], %[b5] op_sel_hi:[0,1,1]\n\t"
        "v_pk_fma_f32 %[b6], %[c], %[x6], %[b6] op_sel_hi:[0,1,1]\n\t"
        "v_pk_fma_f32 %[b6], %[c], %[x6], %[b6] op_sel_hi:[0,1,1]\n\t"
        "v_pk_fma_f32 %[b7], %[c], %[x7], %[b7] op_sel_hi:[0,1,1]\n"
        "v_pk_fma_f32 %[b7], %[c], %[x7], %[b7] op_sel_hi:[0,1,1]\n"
        "3:\n\t"
        : [a0] "+v"(Ya[0]), [a1] "+v"(Ya[1]), [a2] "+v"(Ya[2]), [a3] "+v"(Ya[3]), [a4] "+v"(Ya[4]), [a5] "+v"(Ya[5]), [a6] "+v"(Ya[6]), [a7] "+v"(Ya[7]),
          [b0] "+v"(Yb[0]), [b1] "+v"(Yb[1]), [b2] "+v"(Yb[2]), [b3] "+v"(Yb[3]), [b4] "+v"(Yb[4]), [b5] "+v"(Yb[5]), [b6] "+v"(Yb[6]), [b7] "+v"(Yb[7])
        : [x0] "v"(x[0]), [x1] "v"(x[1]), [x2] "v"(x[2]), [x3] "v"(x[3]), [x4] "v"(x[4]), [x5] "v"(x[5]), [x6] "v"(x[6]), [x7] "v"(x[7]), [c] "s"(c), [t] "s"(tt)
        : "scc");
}
__device__ __forceinline__ float tok_setup_mixed(unsigned& k0, unsigned& k1, int t, int j, int lane, LAS unsigned char* xs, const int* __restrict__ seli, const float* __restrict__ selg,
                                                 const float* __restrict__ part2, const bf16* __restrict__ h1b) {
    float ps = (lane < 16) ? part2[(size_t)t * 16 + lane] : 0.f;
    ps = wave_sum(ps);
    const float rstd2 = 1.0f / sqrtf(ps * (1.0f / 1024.0f) + EPS);
    f32x4 hv[4]; float am = 0.f;
    { const u32x4* br = (const u32x4*)(h1b + (size_t)t * 1024 + 16 * lane); const u32x4 b0 = br[0], b1 = br[1];
      hv[0] = bf4_lo((u32x2){b0.x, b0.y}); hv[1] = bf4_lo((u32x2){b0.z, b0.w}); hv[2] = bf4_lo((u32x2){b1.x, b1.y}); hv[3] = bf4_lo((u32x2){b1.z, b1.w}); }
#pragma unroll
    for (int i = 0; i < 4; ++i) { am = fmaxf(am, fmaxf(fmaxf(fabsf(hv[i][0]), fabsf(hv[i][1])), fmaxf(fabsf(hv[i][2]), fabsf(hv[i][3])))); }
#pragma unroll
    for (int o = 1; o < 64; o <<= 1) am = fmaxf(am, __shfl_xor(am, o));
    const float sx = am > 0.f ? 127.0f / am : 1.0f, isx = am > 0.f ? am * (1.0f / 127.0f) : 1.0f;
    u32x4 xq;
#pragma unroll
    for (int i = 0; i < 4; ++i) { unsigned w = 0u;
#pragma unroll
        for (int c = 0; c < 4; ++c) w |= ((unsigned)(int)__builtin_rintf(hv[i][c] * sx) & 0xffu) << (8 * c);
        xq[i] = w; }
    *(LAS u32x4*)(xs + 16 * lane) = xq;
    const int iA = seli[(size_t)t * 128 + lane], iB = seli[(size_t)t * 128 + 64 + lane];
    const float gA = selg[(size_t)t * 128 + lane], gB = selg[(size_t)t * 128 + 64 + lane];
    k0 = ((unsigned)iA << 18) | ((unsigned)j << 16) | (unsigned)(gA * 65535.0f + 0.5f); k1 = ((unsigned)iB << 18) | ((unsigned)j << 16) | (unsigned)(gB * 65535.0f + 0.5f);
    return rstd2 * isx;
}
__device__ __forceinline__ void tok_finish_mixed(const f32x2 (&y2)[8], int t, int lane, const bf16* __restrict__ h1b, bf16* __restrict__ h2b, float* __restrict__ rstd3) {
    const u32x4* br = (const u32x4*)(h1b + (size_t)t * 1024 + 16 * lane); const u32x4 b0 = br[0], b1 = br[1];
    f32x4 h2[4]; h2[0] = bf4_lo((u32x2){b0.x, b0.y}); h2[1] = bf4_lo((u32x2){b0.z, b0.w}); h2[2] = bf4_lo((u32x2){b1.x, b1.y}); h2[3] = bf4_lo((u32x2){b1.z, b1.w});
    float sq = 0.f;
#pragma unroll
    for (int i = 0; i < 4; ++i) {
        h2[i] = h2[i] + (f32x4){y2[2 * i].x, y2[2 * i].y, y2[2 * i + 1].x, y2[2 * i + 1].y};
        sq += (h2[i][0] * h2[i][0] + h2[i][1] * h2[i][1]) + (h2[i][2] * h2[i][2] + h2[i][3] * h2[i][3]);
    }
    u32x4 w0, w1; w0.x = pk2(h2[0][0], h2[0][1]); w0.y = pk2(h2[0][2], h2[0][3]); w0.z = pk2(h2[1][0], h2[1][1]); w0.w = pk2(h2[1][2], h2[1][3]);
    w1.x = pk2(h2[2][0], h2[2][1]); w1.y = pk2(h2[2][2], h2[2][3]); w1.z = pk2(h2[3][0], h2[3][1]); w1.w = pk2(h2[3][2], h2[3][3]);
    u32x4* ob = (u32x4*)(h2b + (size_t)t * 1024 + 16 * lane); ob[0] = w0; ob[1] = w1;
    sq = wave_sum(sq);
    if (lane == 0) rstd3[t] = 1.0f / sqrtf(sq * (1.0f / 1024.0f) + EPS);
}
constexpr int MIX_LDS_WAVE = 4096 + 2048 + 64;
constexpr int XG = 2;
template <int PM>
__device__ __forceinline__ void gather_wg_mixed(int tok0, int wave, int lane, LAS unsigned char* lds, const unsigned char* __restrict__ U8, const unsigned char* __restrict__ V8, const float* __restrict__ IU, const float* __restrict__ IV,
                                                const int* __restrict__ seli, const float* __restrict__ selg, const float* __restrict__ part2, const bf16* __restrict__ h1b, bf16* __restrict__ h2b, float* __restrict__ rstd3, float* probe_out) {
    LAS unsigned char* xs = lds + wave * MIX_LDS_WAVE;
    LAS unsigned* ks = (LAS unsigned*)(xs + 4096);
    LAS float* rsl = (LAS float*)(xs + 4096 + 2048);
#pragma unroll 1
    for (int pass = 0; pass < 2; ++pass) {
        const int tb = tok0 + pass * 32 + wave * 4;
        unsigned k[8]; float rs0, rs1, rs2, rs3;
        rs0 = tok_setup_mixed(k[0], k[1], tb + 0, 0, fresh_lane(), xs, seli, selg, part2, h1b); __builtin_amdgcn_sched_barrier(0);
        rs1 = tok_setup_mixed(k[2], k[3], tb + 1, 1, fresh_lane(), xs + 1024, seli, selg, part2, h1b); __builtin_amdgcn_sched_barrier(0);
        rs2 = tok_setup_mixed(k[4], k[5], tb + 2, 2, fresh_lane(), xs + 2048, seli, selg, part2, h1b); __builtin_amdgcn_sched_barrier(0);
        rs3 = tok_setup_mixed(k[6], k[7], tb + 3, 3, fresh_lane(), xs + 3072, seli, selg, part2, h1b); __builtin_amdgcn_sched_barrier(0);
        lane = fresh_lane();
        sort_wave<8>(k, lane);
#pragma unroll
        for (int r = 0; r < 8; ++r) ks[lane + 64 * r] = k[r];
        if (lane == 0) { rsl[0] = rs0; rsl[1] = rs1; rsl[2] = rs2; rsl[3] = rs3; }
        __builtin_amdgcn_sched_barrier(0);
        f32x2 Y0[8], Y1[8], Y2[8], Y3[8];
#pragma unroll
        for (int i = 0; i < 8; ++i) { Y0[i] = (f32x2){0.f, 0.f}; Y1[i] = (f32x2){0.f, 0.f}; Y2[i] = (f32x2){0.f, 0.f}; Y3[i] = (f32x2){0.f, 0.f}; }
        __syncthreads();
        lane = fresh_lane();
#if MIX_PIPE
        unsigned kbN = ks[(pass ? 16 * 31 : 0) + (lane & 15)], keyN = ks[(pass ? 16 * 31 : 0) + (lane >> 2)];
        i32x4v A[16]; u32x4 vv[16];
#pragma unroll
        for (int q = 0; q < 16; ++q) { int e = (int)((unsigned)__builtin_amdgcn_readlane((int)kbN, q) >> 18); if (PM & 32) e &= 1023; if (PM & 2) A[q] = (i32x4v){e, e, e, e}; else A[q] = *(const i32x4v*)(U8 + (size_t)e * 1024 + 16 * lane); }
#pragma unroll
        for (int q = 0; q < 16; ++q) { int e = (int)((unsigned)__builtin_amdgcn_readlane((int)kbN, q) >> 18); if (PM & 32) e &= 1023; if (PM & 1) vv[q] = (u32x4){(unsigned)e, 0u, 0u, 0u}; else vv[q] = *(const u32x4*)(V8 + (size_t)e * 1024 + 16 * lane); }
        float iuN = IU[keyN >> 18], ivN = IV[keyN >> 18];
#pragma unroll 1
        for (int bb = 0; bb < 32; ++bb) {
            const int bn = (bb + 1 < 32) ? bb + 1 : 31; const int b1 = pass ? 31 - bn : bn;
            const unsigned kb = kbN, key = keyN; const float iu = iuN, iv = ivN;
            kbN = ks[16 * b1 + (lane & 15)]; keyN = ks[16 * b1 + (lane >> 2)];
            const int tq = (int)(key >> 16) & 3;
            const float dus = iu * rsl[tq], gvs = (float)(key & 0xffffu) * (1.0f / 65535.0f) * iv;
            int pp[16];
#pragma unroll
            for (int g = 0; g < 16 / XG; ++g) {
                i32x4v Xg[XG];
#pragma unroll
                for (int i = 0; i < XG; ++i) { const int t = (__builtin_amdgcn_readlane((int)kb, XG * g + i) >> 16) & 3; Xg[i] = *(const LAS i32x4v*)(xs + t * 1024 + 16 * lane); }
#pragma unroll
                for (int i = 0; i < XG; ++i) { const int q = XG * g + i; const i32x4v X = Xg[i];
                    if (PM & 2) pp[q] = A[q][0] + X[0]; else
                    pp[q] = __builtin_amdgcn_sdot4(A[q][3], X[3], __builtin_amdgcn_sdot4(A[q][2], X[2], __builtin_amdgcn_sdot4(A[q][1], X[1], __builtin_amdgcn_sdot4(A[q][0], X[0], 0, false), false), false), false);
                    int e = (int)((unsigned)__builtin_amdgcn_readlane((int)kbN, q) >> 18); if (PM & 32) e &= 1023;
                    if (PM & 2) A[q] = (i32x4v){e, e, e, e}; else A[q] = *(const i32x4v*)(U8 + (size_t)e * 1024 + 16 * lane);
                }
                __builtin_amdgcn_sched_barrier(0);
            }
            iuN = IU[keyN >> 18]; ivN = IV[keyN >> 18];
            const int tot = reduce16_rows(pp, lane);
            const float cf = gvs * gelu_tanh((float)tot * dus);
#pragma unroll
            for (int q = 0; q < 16; ++q) {
                const int t = (__builtin_amdgcn_readlane((int)kb, q) >> 16) & 3;
                const float cs = __int_as_float(__builtin_amdgcn_readlane(__float_as_int(cf), 4 * q));
                f32x2 x[8];
#pragma unroll
                for (int c = 0; c < 4; ++c) { x[2 * c] = __builtin_amdgcn_cvt_pk_f32_fp8(vv[q][c], false); x[2 * c + 1] = __builtin_amdgcn_cvt_pk_f32_fp8(vv[q][c], true); }
                int e = (int)((unsigned)__builtin_amdgcn_readlane((int)kbN, q) >> 18); if (PM & 32) e &= 1023;
                if (PM & 1) { vv[q] = (u32x4){(unsigned)e, 0u, 0u, 0u}; Y0[q & 7].x += cs * x[0].x; } else {
                vv[q] = *(const u32x4*)(V8 + (size_t)e * 1024 + 16 * lane);
                if (PM & 128) { axpy_dispatch2_dup(t, 0, cs, x, Y0, Y1); axpy_dispatch2_dup(t, 2, cs, x, Y2, Y3); } else {
                axpy_dispatch2(t, 0, cs, x, Y0, Y1);
                axpy_dispatch2(t, 2, cs, x, Y2, Y3); } }
            }
        }
#else
#pragma unroll 1
        for (int b = 0; b < 32; ++b) {
            const unsigned kb = ks[16 * b + (lane & 15)];
            const unsigned key = ks[16 * b + (lane >> 2)];
            const int es = (int)(key >> 18); const int tq = (int)(key >> 16) & 3;
            const float rsx = rsl[tq];
            const float dus = IU[es] * rsx, gvs = (float)(key & 0xffffu) * (1.0f / 65535.0f) * IV[es];
            i32x4v A[16]; u32x4 vv[16];
#pragma unroll
            for (int q = 0; q < 16; ++q) { int e = (int)((unsigned)__builtin_amdgcn_readlane((int)kb, q) >> 18); if (PM & 32) e &= 1023; A[q] = *(const i32x4v*)(U8 + (size_t)e * 1024 + 16 * lane); }
#pragma unroll
            for (int q = 0; q < 16; ++q) { int e = (int)((unsigned)__builtin_amdgcn_readlane((int)kb, q) >> 18); if (PM & 32) e &= 1023; vv[q] = *(const u32x4*)(V8 + (size_t)e * 1024 + 16 * lane); }
            int pp[16];
#pragma unroll
            for (int q = 0; q < 16; ++q) {
                const int t = (__builtin_amdgcn_readlane((int)kb, q) >> 16) & 3;
                const i32x4v X = *(const LAS i32x4v*)(xs + t * 1024 + 16 * lane);
                pp[q] = __builtin_amdgcn_sdot4(A[q][3], X[3], __builtin_amdgcn_sdot4(A[q][2], X[2], __builtin_amdgcn_sdot4(A[q][1], X[1], __builtin_amdgcn_sdot4(A[q][0], X[0], 0, false), false), false), false);
            }
            const int tot = reduce16_rows(pp, lane);
            const float cf = gvs * gelu_tanh((float)tot * dus);
#pragma unroll
            for (int q = 0; q < 16; ++q) {
                const int t = (__builtin_amdgcn_readlane((int)kb, q) >> 16) & 3;
                const float cs = __int_as_float(__builtin_amdgcn_readlane(__float_as_int(cf), 4 * q));
                f32x2 x[8];
#pragma unroll
                for (int c = 0; c < 4; ++c) { x[2 * c] = __builtin_amdgcn_cvt_pk_f32_fp8(vv[q][c], false); x[2 * c + 1] = __builtin_amdgcn_cvt_pk_f32_fp8(vv[q][c], true); }
                axpy_dispatch2(t, 0, cs, x, Y0, Y1);
                axpy_dispatch2(t, 2, cs, x, Y2, Y3);
            }
            __builtin_amdgcn_sched_barrier(0);
        }
#endif
        if (PM != 0) { const int fl = fresh_lane(); f32x2 a = Y0[0] + Y1[0] + Y2[0] + Y3[0];
#pragma unroll
            for (int i = 1; i < 8; ++i) a += Y0[i] + Y1[i] + Y2[i] + Y3[i];
            probe_out[(size_t)tb * 64 + fl] = a.x + a.y; }
        else { const int fl = fresh_lane(); tok_finish_mixed(Y0, tb, fl, h1b, h2b, rstd3); tok_finish_mixed(Y1, tb + 1, fl, h1b, h2b, rstd3); tok_finish_mixed(Y2, tb + 2, fl, h1b, h2b, rstd3); tok_finish_mixed(Y3, tb + 3, fl, h1b, h2b, rstd3); }
        __syncthreads();
    }
}
namespace pg8 {
#define PG8_LAS __attribute__((address_space(3)))
typedef unsigned short bf16_t;
typedef short bf16x8 __attribute__((ext_vector_type(8)));
typedef float f32x4 __attribute__((ext_vector_type(4)));
typedef unsigned u32x4 __attribute__((ext_vector_type(4)));
constexpr int BM = 256, BK = 64, HALF = 128, HTB = HALF * BK * 2  , STAGE_BYTES = 8 * HTB, NXCD = 8, WGM = 8;

__host__ __device__ __forceinline__ int lds_byte(int r, int c) { const int st = (r >> 4) * 2 + (c >> 5), rr = r & 15, cc = c & 31, ob = rr * 64 + cc * 2; return st * 1024 + (ob ^ (((ob >> 9) & 1) << 5)); }
__host__ __device__ __forceinline__ void stage_rc(int b, int& R, int& C) { const int st = b / 1024, sb = b % 1024, swz = sb ^ (((sb >> 9) & 1) << 5); R = (st >> 1) * 16 + swz / 64; C = (st & 1) * 32 + (swz % 64) / 2; }
__host__ __device__ __forceinline__ int perm32(int rho) { const int n = rho >> 4, i = rho & 15; return 8 * (i >> 2) + 4 * n + (i & 3); }

struct Unit { int pm, pn; };
struct Gemm { const bf16_t* A; const bf16_t* Bt; int K, lda, apn_shift, apn_stride; };

struct StaticOrder {
    int nM, nN, nwg, G, c;
    __host__ __device__ __forceinline__ void init(int M, int N, int G_, int c_) { nM = M / BM; nN = N / BM; nwg = nM * nN; G = G_; c = c_; }
    __host__ __device__ __forceinline__ bool next(int i, Unit& u) const {
        const long L = (long)i * G + c; if (L >= nwg) return false;
        int wgid = (int)L; { const int q = nwg / NXCD, r = nwg % NXCD, xcd = wgid % NXCD, off = wgid / NXCD; wgid = (xcd < r ? xcd * (q + 1) : r * (q + 1) + (xcd - r) * q) + off; }
        const int nig = WGM * nN, gid = wgid / nig, fm = gid * WGM, gsz = (nM - fm) < WGM ? (nM - fm) : WGM;
        u.pm = fm + ((wgid % nig) % gsz); u.pn = (wgid % nig) / gsz; return true;
    }
    __device__ __forceinline__ void a_ready(const Unit&) const {}
    __device__ __forceinline__ void done(const Unit&) const {}
};

__device__ __forceinline__ unsigned cvt_pk_bf16(float lo, float hi) { unsigned r; asm volatile("v_cvt_pk_bf16_f32 %0, %1, %2" : "=v"(r) : "v"(lo), "v"(hi)); return r; }

template <class Epi, class Sched, bool ALIGN_EPI = false, bool SP2 = false>
__device__ __forceinline__ void gemm_phase(PG8_LAS unsigned char* lds, const Gemm g, const Sched& S, const Epi& E, int wave_id  ) {
    const int lane = fresh_lane(), wid = wave_id, tid = wid * 64 + lane, wr = wid >> 2, wc = wid & 3, fr = lane & 15, fq = lane >> 4;
    const int K = g.K, nt = K / BK;
    unsigned voffA[2], voffB[2];
#pragma unroll
    for (int i = 0; i < 2; ++i) { int R, C; stage_rc(tid * 16 + i * 8192, R, C); const int Rb = Epi::PERM ? ((R & ~31) + perm32(R & 31)) : R;
        voffA[i] = (unsigned)(R * g.lda + C) * 2u; voffB[i] = (unsigned)(Rb * K + C) * 2u; }
    const size_t kstep = (size_t)(BK * 2);
    const size_t hstepA = (size_t)HALF * g.lda * 2, hstepB = (size_t)HALF * K * 2;
    const size_t tstepA = 2 * hstepA, tstepB = 2 * hstepB;
    const unsigned ldsw = (unsigned)wid * 1024u;
    const int aoff = lds_byte(wr * 64 + fr, fq * 8), boff = lds_byte(wc * 32 + fr, fq * 8);
#define PG8_SA(b, h) (((b) * 2 + (h)) * HTB)
#define PG8_SB(b, h) ((4 + (b) * 2 + (h)) * HTB)
#define PG8_STAGE(bufoff, gbase, voff) do { _Pragma("unroll") for (int _i = 0; _i < 2; ++_i) \
        __builtin_amdgcn_global_load_lds((const unsigned*)((const char*)(gbase) + (voff)[_i]), (PG8_LAS unsigned*)(lds + (bufoff) + ldsw + _i * 8192), 16, 0, 0); } while (0)
#define PG8_LDA(dst, b, h) do { _Pragma("unroll") for (int m = 0; m < 4; ++m) _Pragma("unroll") for (int k = 0; k < 2; ++k) dst[m][k] = *(const PG8_LAS bf16x8*)(lds + PG8_SA(b, h) + aoff + m * 2048 + k * 1024); } while (0)
#define PG8_LDB(dst, b, h) do { _Pragma("unroll") for (int n = 0; n < 2; ++n) _Pragma("unroll") for (int k = 0; k < 2; ++k) dst[n][k] = *(const PG8_LAS bf16x8*)(lds + PG8_SB(b, h) + boff + n * 2048 + k * 1024); } while (0)
#define PG8_MMA(ai, bj, At, Bt) do { __builtin_amdgcn_s_setprio(1); _Pragma("unroll") for (int m = 0; m < 4; ++m) _Pragma("unroll") for (int n = 0; n < 2; ++n) _Pragma("unroll") for (int k = 0; k < 2; ++k) \
        acc[ai][bj][m][n] = __builtin_amdgcn_mfma_f32_16x16x32_bf16(Bt[n][k], At[m][k], acc[ai][bj][m][n], 0, 0, 0); __builtin_amdgcn_s_setprio(0); } while (0)
#define PG8_WAIT_V(n) asm volatile("s_waitcnt vmcnt(" #n ")" ::: "memory")
#define PG8_WAIT_L(n) asm volatile("s_waitcnt lgkmcnt(" #n ")" ::: "memory")
#define PG8_BAR __builtin_amdgcn_s_barrier()
#define PG8_SCHED __builtin_amdgcn_sched_barrier(0)
    Unit cur, nxt; int ui = 0;
    if (!S.next(0, cur)) return;
    f32x4 acc[2][2][4][2];
#pragma unroll
    for (int a = 0; a < 2; ++a)
#pragma unroll
        for (int b = 0; b < 2; ++b)
#pragma unroll
            for (int m = 0; m < 4; ++m)
#pragma unroll
                for (int n = 0; n < 2; ++n) acc[a][b][m][n] = (f32x4){0.f, 0.f, 0.f, 0.f};
    bf16x8 At[4][2], B0[2][2], B1[2][2];
    const char* cA = (const char*)g.A + (size_t)cur.pm * tstepA + (size_t)((cur.pn >> g.apn_shift) * g.apn_stride) * 2; const char* cB = (const char*)g.Bt + (size_t)cur.pn * tstepB;
    S.a_ready(cur);
    if constexpr (SP2) {
        PG8_STAGE(PG8_SB(0, 0), cB, voffB); PG8_STAGE(PG8_SB(0, 1), cB + hstepB, voffB); PG8_STAGE(PG8_SA(0, 0), cA, voffA); PG8_STAGE(PG8_SA(0, 1), cA + hstepA, voffA);
        if (wr == 1) PG8_BAR;
        PG8_WAIT_V(2); PG8_BAR;
        PG8_STAGE(PG8_SB(1, 0), cB + kstep, voffB); PG8_STAGE(PG8_SA(1, 0), cA + kstep, voffA); PG8_STAGE(PG8_SB(1, 1), cB + hstepB + kstep, voffB);
        PG8_WAIT_V(6); PG8_BAR;
    } else {
        PG8_STAGE(PG8_SB(0, 0), cB, voffB); PG8_STAGE(PG8_SA(0, 0), cA, voffA); PG8_STAGE(PG8_SB(0, 1), cB + hstepB, voffB); PG8_STAGE(PG8_SA(0, 1), cA + hstepA, voffA);
        if (wr == 1) PG8_BAR;
        PG8_WAIT_V(4); PG8_BAR;
        PG8_STAGE(PG8_SB(1, 0), cB + kstep, voffB); PG8_STAGE(PG8_SA(1, 0), cA + kstep, voffA); PG8_STAGE(PG8_SB(1, 1), cB + hstepB + kstep, voffB);
        PG8_WAIT_V(6); PG8_BAR;
    }
    for (;;) {
        const bool has_next = S.next(ui + 1, nxt);
        const char* nA = has_next ? (const char*)g.A + (size_t)nxt.pm * tstepA + (size_t)((nxt.pn >> g.apn_shift) * g.apn_stride) * 2 : cA; const char* nB = has_next ? (const char*)g.Bt + (size_t)nxt.pn * tstepB : cB;
#pragma unroll 1
        for (int t = 0; t < nt; t += 2) {
            const bool last = (t == nt - 2);
            const char* a1 = cA + (size_t)(t + 1) * kstep;
            const char* a2 = last ? nA : cA + (size_t)(t + 2) * kstep; const char* b2 = last ? nB : cB + (size_t)(t + 2) * kstep;
            const char* a3 = a2 + kstep; const char* b3 = b2 + kstep;
            if (last && has_next) S.a_ready(nxt);
            if constexpr (SP2) {
            PG8_LDB(B0, 0, 0); PG8_LDB(B1, 0, 1); PG8_SCHED; PG8_LDA(At, 0, 0); PG8_STAGE(PG8_SA(1, 1), a1 + hstepA, voffA);
            PG8_WAIT_V(8); PG8_WAIT_L(0); PG8_BAR; PG8_MMA(0, 0, At, B0); PG8_MMA(0, 1, At, B1); PG8_BAR; PG8_SCHED;
            PG8_LDA(At, 0, 1); PG8_STAGE(PG8_SB(0, 0), b2, voffB); PG8_STAGE(PG8_SB(0, 1), b2 + hstepB, voffB); PG8_STAGE(PG8_SA(0, 0), a2, voffA);
            PG8_WAIT_V(8); PG8_WAIT_L(0); PG8_BAR; PG8_MMA(1, 0, At, B0); PG8_MMA(1, 1, At, B1); PG8_BAR; PG8_SCHED;
            PG8_LDB(B0, 1, 0); PG8_LDB(B1, 1, 1); PG8_SCHED; PG8_LDA(At, 1, 0); PG8_STAGE(PG8_SA(0, 1), a2 + hstepA, voffA);
            PG8_WAIT_V(8); PG8_WAIT_L(0); PG8_BAR; PG8_MMA(0, 0, At, B0); PG8_MMA(0, 1, At, B1); PG8_BAR; PG8_SCHED;
            PG8_LDA(At, 1, 1); PG8_STAGE(PG8_SB(1, 0), b3, voffB); PG8_STAGE(PG8_SB(1, 1), b3 + hstepB, voffB); PG8_STAGE(PG8_SA(1, 0), a3, voffA);
            PG8_WAIT_V(8); PG8_WAIT_L(0); PG8_BAR; PG8_MMA(1, 0, At, B0); PG8_MMA(1, 1, At, B1); PG8_BAR; PG8_SCHED;
            } else {
            PG8_LDB(B0, 0, 0); PG8_SCHED; PG8_LDA(At, 0, 0); PG8_STAGE(PG8_SA(1, 1), a1 + hstepA, voffA);
            PG8_WAIT_L(8); PG8_BAR; PG8_WAIT_L(0); PG8_MMA(0, 0, At, B0); PG8_BAR; PG8_SCHED;
            PG8_LDB(B1, 0, 1); PG8_STAGE(PG8_SB(0, 0), b2, voffB);
            PG8_BAR; PG8_WAIT_L(0); PG8_MMA(0, 1, At, B1); PG8_BAR;
            PG8_LDA(At, 0, 1); PG8_STAGE(PG8_SA(0, 0), a2, voffA);
            PG8_BAR; PG8_WAIT_L(0); PG8_MMA(1, 0, At, B0); PG8_BAR; PG8_SCHED;
            PG8_STAGE(PG8_SB(0, 1), b2 + hstepB, voffB);
            PG8_WAIT_V(6); PG8_BAR; PG8_MMA(1, 1, At, B1); PG8_BAR;
            PG8_LDB(B0, 1, 0); PG8_SCHED; PG8_LDA(At, 1, 0); PG8_STAGE(PG8_SA(0, 1), a2 + hstepA, voffA);
            PG8_WAIT_L(8); PG8_BAR; PG8_WAIT_L(0); PG8_MMA(0, 0, At, B0); PG8_BAR; PG8_SCHED;
            PG8_LDB(B1, 1, 1); PG8_STAGE(PG8_SB(1, 0), b3, voffB);
            PG8_BAR; PG8_WAIT_L(0); PG8_MMA(0, 1, At, B1); PG8_BAR;
            PG8_LDA(At, 1, 1); PG8_STAGE(PG8_SA(1, 0), a3, voffA);
            PG8_BAR; PG8_WAIT_L(0); PG8_MMA(1, 0, At, B0); PG8_BAR; PG8_SCHED;
            PG8_STAGE(PG8_SB(1, 1), b3 + hstepB, voffB);
            PG8_WAIT_V(6); PG8_BAR; PG8_MMA(1, 1, At, B1); PG8_BAR;
            }
        }
        if constexpr (ALIGN_EPI) { if (wr == 0) PG8_BAR; }
        if constexpr (!Epi::AFTER_DRAIN) { E(acc, cur, wr, wc, fr, fq); S.done(cur); }
        if (!has_next) break;
#pragma unroll
        for (int a = 0; a < 2; ++a)
#pragma unroll
            for (int b = 0; b < 2; ++b)
#pragma unroll
                for (int m = 0; m < 4; ++m)
#pragma unroll
                    for (int n = 0; n < 2; ++n) acc[a][b][m][n] = (f32x4){0.f, 0.f, 0.f, 0.f};
        cur = nxt; cA = nA; cB = nB; ++ui;
        if constexpr (ALIGN_EPI) { if (wr == 1) PG8_BAR; }
    }
    PG8_WAIT_V(0);
    if constexpr (!ALIGN_EPI) { if (wr == 0) PG8_BAR; }
    PG8_BAR;
    if constexpr (Epi::AFTER_DRAIN) { E.fused(acc, cur, wr, wc, fr, fq, lds, wid, lane); S.done(cur); }
#undef PG8_SA
#undef PG8_SB
#undef PG8_STAGE
#undef PG8_LDA
#undef PG8_LDB
#undef PG8_MMA
#undef PG8_WAIT_V
#undef PG8_WAIT_L
#undef PG8_BAR
#undef PG8_SCHED
}
}
#define GAS __attribute__((address_space(1)))
typedef GAS unsigned gu32;
#define RLX_AGENT __ATOMIC_RELAXED, __HIP_MEMORY_SCOPE_AGENT
#define LDS_WAIT() asm volatile("s_waitcnt lgkmcnt(0)" ::: "memory")
#define VM_WAIT() asm volatile("s_waitcnt vmcnt(0)" ::: "memory")
#define XB_TMO      128
#define XB_XCNT(j)  (256  + 64 * (j))
#define XB_XSUB(j)  (1280 + 64 * (j))
#define XB_XGEN(j)  (2304 + 64 * (j))
#define XB_TOP      3328
#define XB_TOPGEN   3392
#define XCD_BAR_WORDS 3456
#define XB_SPIN_CAP (1u << 18)

__device__ __forceinline__ unsigned xb_ld(unsigned* p)              { return __hip_atomic_load(p, __ATOMIC_RELAXED, __HIP_MEMORY_SCOPE_AGENT); }
__device__ __forceinline__ unsigned xb_add(unsigned* p, unsigned v) { return __hip_atomic_fetch_add(p, v, __ATOMIC_RELAXED, __HIP_MEMORY_SCOPE_AGENT); }
__device__ __forceinline__ unsigned xb_xcc_id() { return (unsigned)__builtin_amdgcn_s_getreg((3 << 11) | 20) & 0xFu; }
#define XB_SPIN(cond, bar) do { unsigned _sp = 0; while (cond) { __builtin_amdgcn_s_sleep(1); \
    if ((++_sp & 255u) == 0u) { if (xb_ld(&(bar)[XB_TMO])) break; if (_sp > XB_SPIN_CAP) { atomicAdd(&(bar)[XB_TMO], 1u); break; } } } } while (0)

struct XcdBarrier {
    unsigned* bar; unsigned x;
    volatile LAS unsigned* st;
};

__device__ __forceinline__ XcdBarrier xcd_barrier_post(unsigned* bar, volatile LAS unsigned* st) {
    XcdBarrier b; b.bar = bar; b.x = xb_xcc_id(); b.st = st;
    if (threadIdx.x == 0) (void)xb_add(&bar[XB_XCNT(b.x)], 1u);
    return b;
}
__device__ __forceinline__ void xcd_barrier_complete(unsigned* bar, unsigned x, unsigned& nloc, unsigned& nx) {
    const unsigned G = gridDim.x * gridDim.y * gridDim.z;
    unsigned sum, cnt, mine, sp = 0u;
    for (;;) {
        sum = 0u; cnt = 0u; mine = 0u;
#pragma unroll
        for (unsigned j = 0; j < 16; ++j) { const unsigned c = xb_ld(&bar[XB_XCNT(j)]); sum += c; cnt += (c > 0u) ? 1u : 0u; mine = (j == x) ? c : mine; }
        if (sum == G) break;
        __builtin_amdgcn_s_sleep(1);
        if ((++sp & 255u) == 0u) { if (xb_ld(&bar[XB_TMO])) break; if (sp > XB_SPIN_CAP) { atomicAdd(&bar[XB_TMO], 1u); break; } }
    }
    nloc = mine > 0u ? mine : 1u; nx = cnt > 0u ? cnt : 1u;
}

__device__ __forceinline__ void xcd_barrier(const XcdBarrier& b) {
    asm volatile("s_waitcnt vmcnt(0)" ::: "memory");
    __syncthreads();
    if (threadIdx.x == 0) {
        unsigned* bar = b.bar;
        __builtin_amdgcn_s_waitcnt(0);
        unsigned nloc = b.st[0], nx = b.st[1];
        if (nloc == 0u) { xcd_barrier_complete(bar, b.x, nloc, nx); b.st[0] = nloc; b.st[1] = nx; }
        const unsigned old = xb_add(&bar[XB_XSUB(b.x)], 1u);
        const unsigned gen = old / nloc;
        if (old + 1u == (gen + 1u) * nloc) {
            __builtin_amdgcn_fence(__ATOMIC_RELEASE, "agent");
            asm volatile("s_waitcnt vmcnt(0)" ::: "memory");
            const unsigned og = xb_add(&bar[XB_TOP], 1u);
            const unsigned tg = og / nx;
            if (og + 1u == (tg + 1u) * nx) xb_add(&bar[XB_TOPGEN], 1u);
            else XB_SPIN(xb_ld(&bar[XB_TOPGEN]) == tg, bar);
            __builtin_amdgcn_fence(__ATOMIC_ACQUIRE, "agent");
            xb_add(&bar[XB_XGEN(b.x)], 1u);
            asm volatile("s_waitcnt vmcnt(0)" ::: "memory");
        } else {
            XB_SPIN(xb_ld(&bar[XB_XGEN(b.x)]) == gen, bar);
            __builtin_amdgcn_fence(__ATOMIC_ACQUIRE, "agent");
            asm volatile("s_waitcnt vmcnt(0)" ::: "memory");
        }
    }
    __syncthreads();
}

constexpr int NWAVES = 8;
constexpr int LDS_MAIN = 135168;
constexpr int LDSCTL_OFF = LDS_MAIN;
constexpr int LDS_BYTES = 147456;
constexpr int CW_BAR = 4096;
constexpr size_t CTL_ZERO_BYTES = 1 * MiB;
constexpr float LOG2E = 1.4426950408889634f;
typedef short bf16x8 __attribute__((ext_vector_type(8)));
typedef float f32x16 __attribute__((ext_vector_type(16)));
typedef unsigned u32x2 __attribute__((ext_vector_type(2)));
using pg8::Unit;
using pg8::cvt_pk_bf16;

__device__ __forceinline__ f32x4 sig4(f32x4 v) { return (f32x4){sigmoidf_(v[0]), sigmoidf_(v[1]), sigmoidf_(v[2]), sigmoidf_(v[3])}; }
__device__ __forceinline__ f32x4 gelu4(f32x4 v) { return (f32x4){gelu_tanh(v[0]), gelu_tanh(v[1]), gelu_tanh(v[2]), gelu_tanh(v[3])}; }
__device__ __forceinline__ u32x4 pack8(f32x4 a, f32x4 b) { u32x4 w; w.x = cvt_pk_bf16(a[0], a[1]); w.y = cvt_pk_bf16(a[2], a[3]); w.z = cvt_pk_bf16(b[0], b[1]); w.w = cvt_pk_bf16(b[2], b[3]); return w; }

struct OneUnit { pg8::StaticOrder S; int k;
    __device__ __forceinline__ bool next(int i, Unit& u) const { return i == 0 && S.next(k, u); }
    __device__ __forceinline__ void a_ready(const Unit&) const {}
    __device__ __forceinline__ void done(const Unit&) const {} };
struct EpiProj {
    static constexpr bool PERM = true, AFTER_DRAIN = false;
    const float* rstd; unsigned char* ws;
    __device__ __forceinline__ void operator()(const f32x4 (&acc)[2][2][4][2], const Unit& u, int wr, int wc, int fr, int fq) const {
        { const int t_ = fresh_lane(); fr = t_ & 15; fq = t_ >> 4; }
        const int pn = u.pn; bf16* base; int ldc, coff, act;
        if (pn < 3) { base = (bf16*)(ws + WS_QKV); ldc = 768; coff = pn * 256; act = 0; }
        else if (pn < 7) { base = (bf16*)(ws + WS_LX); ldc = 1024; coff = (pn - 3) * 256; act = 0; }
        else if (pn < 11) { base = (bf16*)(ws + WS_GL); ldc = 1024; coff = (pn - 7) * 256; act = 1; }
        else if (pn < 15) { base = (bf16*)(ws + WS_SGA); ldc = 1024; coff = (pn - 11) * 256; act = 2; }
        else { base = (bf16*)(ws + WS_SGL); ldc = 1024; coff = (pn - 15) * 256; act = 2; }
        const int row0 = u.pm * 256 + wr * 64 + fr, col0 = coff + wc * 32 + 8 * fq;
#pragma unroll
        for (int ai = 0; ai < 2; ++ai)
#pragma unroll
            for (int m = 0; m < 4; ++m) {
                const int r = row0 + ai * 128 + m * 16; const float rs = rstd[r]; bf16* rowp = base + (size_t)r * ldc + col0;
#pragma unroll
                for (int bj = 0; bj < 2; ++bj) {
                    f32x4 v0 = acc[ai][bj][m][0] * rs, v1 = acc[ai][bj][m][1] * rs;
                    if (act == 1) { v0 = gelu4(v0); v1 = gelu4(v1); } else if (act == 2) { v0 = sig4(v0); v1 = sig4(v1); }
                    *(u32x4*)(rowp + bj * 128) = pack8(v0, v1);
                }
            }
    }
};
struct EpiMP {
    static constexpr bool PERM = false, AFTER_DRAIN = false;
    const bf16* sga; float* mp;
    __device__ __forceinline__ void operator()(const f32x4 (&acc)[2][2][4][2], const Unit& u, int wr, int wc, int fr, int fq) const {
        { const int t_ = fresh_lane(); fr = t_ & 15; fq = t_ >> 4; }
        const int row0 = u.pm * 256 + wr * 64 + fr, col0 = u.pn * 256 + wc * 32 + 4 * fq;
#pragma unroll
        for (int ai = 0; ai < 2; ++ai)
#pragma unroll
            for (int m = 0; m < 4; ++m) {
                const size_t off = (size_t)(row0 + ai * 128 + m * 16) * 1024 + col0;
#pragma unroll
                for (int bj = 0; bj < 2; ++bj)
#pragma unroll
                    for (int n = 0; n < 2; ++n) { const size_t o = off + bj * 128 + n * 16; const f32x4 g = bf4_lo(*(const u32x2*)(sga + o)); const f32x4 v = acc[ai][bj][m][n] * g;
#if ALL_FUSED
                        u32x2 w; w.x = cvt_pk_bf16(v[0], v[1]); w.y = cvt_pk_bf16(v[2], v[3]); *(u32x2*)((bf16*)mp + o) = w;
#else
                        *(f32x4*)(mp + o) = v;
#endif
                    }
            }
    }
};
struct EpiMerged {
    static constexpr bool PERM = true, AFTER_DRAIN = false;
    const bf16* sgl; const float* mp; bf16* merged;
    __device__ __forceinline__ void operator()(const f32x4 (&acc)[2][2][4][2], const Unit& u, int wr, int wc, int fr, int fq) const {
        { const int t_ = fresh_lane(); fr = t_ & 15; fq = t_ >> 4; }
        const int row0 = u.pm * 256 + wr * 64 + fr, col0 = u.pn * 256 + wc * 32 + 8 * fq;
#pragma unroll
        for (int ai = 0; ai < 2; ++ai)
#pragma unroll
            for (int m = 0; m < 4; ++m) {
                const size_t off = (size_t)(row0 + ai * 128 + m * 16) * 1024 + col0;
#pragma unroll
                for (int bj = 0; bj < 2; ++bj) {
                    const size_t o = off + bj * 128; const u32x4 gw = *(const u32x4*)(sgl + o);
#if ALL_FUSED
                    const u32x4 mw = *(const u32x4*)((const bf16*)mp + o); const f32x4 m0 = bf4_lo((u32x2){mw.x, mw.y}), m1 = bf4_lo((u32x2){mw.z, mw.w});
#else
                    const f32x4 m0 = *(const f32x4*)(mp + o), m1 = *(const f32x4*)(mp + o + 4);
#endif
                    const f32x4 v0 = m0 + acc[ai][bj][m][0] * bf4_lo((u32x2){gw.x, gw.y}), v1 = m1 + acc[ai][bj][m][1] * bf4_lo((u32x2){gw.z, gw.w});
                    *(u32x4*)(merged + o) = pack8(v0, v1);
                }
            }
    }
};
struct EpiH1 {
    static constexpr bool PERM = true, AFTER_DRAIN = false;
    const float* x; float* h1; bf16* h1b; float* part;
    __device__ __forceinline__ void operator()(const f32x4 (&acc)[2][2][4][2], const Unit& u, int wr, int wc, int fr, int fq) const {
        { const int t_ = fresh_lane(); fr = t_ & 15; fq = t_ >> 4; }
        const int row0 = u.pm * 256 + wr * 64 + fr, col0 = u.pn * 256 + wc * 32 + 8 * fq;
#pragma unroll
        for (int ai = 0; ai < 2; ++ai)
#pragma unroll
            for (int m = 0; m < 4; ++m) {
                const int r = row0 + ai * 128 + m * 16; const size_t off = (size_t)r * 1024 + col0; float sq = 0.f;
#pragma unroll
                for (int bj = 0; bj < 2; ++bj) {
                    const size_t o = off + bj * 128;
                    const f32x4 v0 = *(const f32x4*)(x + o) + acc[ai][bj][m][0], v1 = *(const f32x4*)(x + o + 4) + acc[ai][bj][m][1];
#if !ALL_FUSED
                    *(f32x4*)(h1 + o) = v0; *(f32x4*)(h1 + o + 4) = v1;
#endif
                    *(u32x4*)(h1b + o) = pack8(v0, v1);
                    sq += (v0[0] * v0[0] + v0[1] * v0[1]) + (v0[2] * v0[2] + v0[3] * v0[3]) + (v1[0] * v1[0] + v1[1] * v1[1]) + (v1[2] * v1[2] + v1[3] * v1[3]);
                }
                sq += __shfl_xor(sq, 16); sq += __shfl_xor(sq, 32);
                if (fq == 0) part[(size_t)r * 16 + u.pn * 4 + wc] = sq;
            }
    }
};
struct EpiScore {
    static constexpr bool PERM = false, AFTER_DRAIN = false;
    const float* part; float* sc;
    __device__ __forceinline__ void operator()(const f32x4 (&acc)[2][2][4][2], const Unit& u, int wr, int wc, int fr, int fq) const {
        { const int t_ = fresh_lane(); fr = t_ & 15; fq = t_ >> 4; }
        const int row0 = u.pm * 256 + wr * 64 + fr, col0 = u.pn * 256 + wc * 32 + 4 * fq;
#pragma unroll
        for (int ai = 0; ai < 2; ++ai)
#pragma unroll
            for (int m = 0; m < 4; ++m) {
                const int r = row0 + ai * 128 + m * 16; const f32x4* pp = (const f32x4*)(part + (size_t)r * 16);
                const f32x4 s4 = (pp[0] + pp[1]) + (pp[2] + pp[3]); const float rs = 1.0f / sqrtf(((s4[0] + s4[1]) + (s4[2] + s4[3])) * (1.0f / 1024.0f) + EPS);
                const size_t off = (size_t)r * 1024 + col0;
#pragma unroll
                for (int bj = 0; bj < 2; ++bj)
#pragma unroll
                    for (int n = 0; n < 2; ++n) *(f32x4*)(sc + off + bj * 128 + n * 16) = acc[ai][bj][m][n] * rs;
            }
    }
};
__device__ __forceinline__ void uv_convert(const float* pu, const float* pv, const float* gffn, unsigned char* u8, unsigned char* v8, float* iu, float* iv, int gw, int NGW, int lane) {
    f32x4 g[4];
#pragma unroll
    for (int j = 0; j < 4; ++j) g[j] = ((const f32x4*)gffn)[4 * lane + j];
    for (int e0 = gw; e0 < 2 * 16384; e0 += 2 * NGW) {
        f32x4 v[2][4];
#pragma unroll
        for (int h = 0; h < 2; ++h) { const int e = e0 + h * NGW; const bool isv = e >= 16384; const int row = isv ? e - 16384 : e;
            const f32x4* src = (const f32x4*)((isv ? pv : pu) + (size_t)row * 1024) + 4 * lane;
#pragma unroll
            for (int j = 0; j < 4; ++j) v[h][j] = src[j]; }
#pragma unroll
        for (int h = 0; h < 2; ++h) {
            const int e = e0 + h * NGW; const bool isv = e >= 16384; const int row = isv ? e - 16384 : e;
            float am = 0.f;
#pragma unroll
            for (int j = 0; j < 4; ++j) { if (!isv) v[h][j] = v[h][j] * g[j]; am = fmaxf(am, fmaxf(fmaxf(fabsf(v[h][j][0]), fabsf(v[h][j][1])), fmaxf(fabsf(v[h][j][2]), fabsf(v[h][j][3])))); }
#pragma unroll
            for (int o = 1; o < 64; o <<= 1) am = fmaxf(am, __shfl_xor(am, o));
            const float sc = am > 0.f ? (isv ? 416.0f : 127.0f) / am : 1.0f;
            u32x4 w;
            if (isv) {
#pragma unroll
                for (int j = 0; j < 4; ++j) { unsigned ww = 0u; ww = __builtin_amdgcn_cvt_pk_fp8_f32(v[h][j][0] * sc, v[h][j][1] * sc, ww, false); ww = __builtin_amdgcn_cvt_pk_fp8_f32(v[h][j][2] * sc, v[h][j][3] * sc, ww, true); w[j] = ww; }
            } else {
#pragma unroll
                for (int j = 0; j < 4; ++j) { unsigned ww = 0u;
#pragma unroll
                    for (int c = 0; c < 4; ++c) ww |= ((unsigned)(int)__builtin_rintf(v[h][j][c] * sc) & 0xffu) << (8 * c);
                    w[j] = ww; }
            }
            *(u32x4*)((isv ? v8 : u8) + (size_t)row * 1024 + 16 * lane) = w;
            if (lane == 0) (isv ? iv : iu)[row] = 1.0f / sc;
        }
    }
}
struct EpiTopk {
    static constexpr bool PERM = false, AFTER_DRAIN = true;
    const float* part; int* seli; float* selg;
    const float* pu; const float* pv; const float* gffn; unsigned char* u8; unsigned char* v8; float* iu; float* iv; int uvslot, uvn;
    __device__ __forceinline__ void fused(f32x4 (&acc)[2][2][4][2], const Unit& u, int wr, int wc, int fr, int fq, PG8_LAS unsigned char* lds, int wid, int lane) const {
        LAS float* L = (LAS float*)lds;
#pragma unroll
        for (int ai = 0; ai < 2; ++ai) {
            { const int t_ = fresh_lane(); fr = t_ & 15; fq = t_ >> 4; }
#pragma unroll
            for (int m = 0; m < 4; ++m) {
                const int rl = wr * 64 + m * 16 + fr, r = u.pm * 256 + ai * 128 + rl;
                const f32x4* pp = (const f32x4*)(part + (size_t)r * 16);
                const f32x4 s4 = (pp[0] + pp[1]) + (pp[2] + pp[3]); const float rs = 1.0f / sqrtf(((s4[0] + s4[1]) + (s4[2] + s4[3])) * (1.0f / 1024.0f) + EPS);
#pragma unroll
                for (int bj = 0; bj < 2; ++bj)
#pragma unroll
                    for (int n = 0; n < 2; ++n) *(LAS f32x4*)(L + (rl * 2 + bj) * TK_LSTRIDE + wc * 32 + 16 * n + 4 * fq) = acc[ai][bj][m][n] * rs;
            }
            asm volatile("s_waitcnt lgkmcnt(0)" ::: "memory"); __builtin_amdgcn_s_barrier(); asm volatile("" ::: "memory");
            const int tid = wid * 64 + fresh_lane();
            if (wid < 4) {
                const LAS float* my = L + tid * TK_LSTRIDE;
                unsigned a16[16];
#pragma unroll
                for (int g = 0; g < 8; ++g) {
                    unsigned t[16];
#pragma unroll
                    for (int q = 0; q < 4; ++q) {
                        const f32x4 v = *(const LAS f32x4*)(my + g * 16 + q * 4);
#pragma unroll
                        for (int c = 0; c < 4; ++c) { const int e = g * 16 + q * 4 + c; const float vc = v[c]; t[q * 4 + c] = (tk_f2key(vc) & ~127u) | (unsigned)(127 - e); }
                    }
                    tk_sort16(t);
                    if (g == 0) {
#pragma unroll
                        for (int i = 0; i < 16; ++i) a16[i] = t[i];
                    } else tk_merge16(a16, t);
                }
                {   u32x4 sb;
#pragma unroll
                    for (int c = 0; c < 4; ++c) sb[c] = (127u - (a16[4 * c] & 127u)) | ((127u - (a16[4 * c + 1] & 127u)) << 8) | ((127u - (a16[4 * c + 2] & 127u)) << 16) | ((127u - (a16[4 * c + 3] & 127u)) << 24);
                    *(LAS u32x4*)(L + tid * TK_LSTRIDE) = sb; }
                __builtin_amdgcn_sched_barrier(0);
                unsigned oth[16];
#pragma unroll
                for (int i = 0; i < 16; ++i) oth[i] = (unsigned)__shfl_xor((int)a16[i], 1);
                const bool odd = tid & 1;
                unsigned part[16]; tk_pair_partial(a16, oth, odd, part);
                {   unsigned po[16];
#pragma unroll
                    for (int i = 0; i < 16; ++i) po[i] = (unsigned)__shfl_xor((int)part[i], 1);
                    tk_merge16(part, po); }
                asm volatile("s_waitcnt lgkmcnt(0)" ::: "memory");
                const float mx = tk_key2f(part[0] & ~255u);
                float ex[16], sum = 0.f;
#pragma unroll
                for (int i = 0; i < 16; ++i) { ex[i] = __builtin_expf(tk_key2f(part[i] & ~255u) - mx); sum += ex[i]; }
                const float inv = 1.0f / sum;
                const LAS unsigned char* r1 = (const LAS unsigned char*)(L + (tid & ~1) * TK_LSTRIDE); const LAS unsigned char* r2 = r1 + TK_LSTRIDE * 4;
                const int tok = u.pm * 256 + ai * 128 + (tid >> 1);
                int* oi = seli + (size_t)tok * 128 + u.pn * 16 + (odd ? 8 : 0); float* og = selg + (size_t)tok * 128 + u.pn * 16 + (odd ? 8 : 0);
                int ei[8]; float eg[8];
#pragma unroll
                for (int i = 0; i < 8; ++i) { unsigned ka = part[i], kb = part[i + 8]; float xa = ex[i], xb = ex[i + 8]; asm volatile("" : "+v"(ka), "+v"(kb), "+v"(xa), "+v"(xb));
                    const unsigned key = odd ? kb : ka; int i1, i2; tk_decode(key, i1, i2);
                    ei[i] = (int)r1[i1] * 128 + (int)r2[i2]; eg[i] = (odd ? xb : xa) * inv; }
                *(i32x4v*)oi = (i32x4v){ei[0], ei[1], ei[2], ei[3]}; *(i32x4v*)(oi + 4) = (i32x4v){ei[4], ei[5], ei[6], ei[7]};
                *(f32x4*)og = (f32x4){eg[0], eg[1], eg[2], eg[3]}; *(f32x4*)(og + 4) = (f32x4){eg[4], eg[5], eg[6], eg[7]};
            } else if (uvn > 0) uv_convert(pu, pv, gffn, u8, v8, iu, iv, uvslot + 4 * ai + (wid - 4), uvn, fresh_lane());
            asm volatile("s_waitcnt lgkmcnt(0)" ::: "memory"); __builtin_amdgcn_s_barrier(); asm volatile("" ::: "memory");
        }
    }
};
struct EpiPP {
    static constexpr bool PERM = true, AFTER_DRAIN = false;
    bf16* pp;
    __device__ __forceinline__ void operator()(const f32x4 (&acc)[2][2][4][2], const Unit& u, int wr, int wc, int fr, int fq) const {
        { const int t_ = fresh_lane(); fr = t_ & 15; fq = t_ >> 4; }
        const int row0 = u.pm * 256 + wr * 64 + fr, col0 = u.pn * 256 + wc * 32 + 8 * fq;
#pragma unroll
        for (int ai = 0; ai < 2; ++ai)
#pragma unroll
            for (int m = 0; m < 4; ++m) {
                const size_t off = (size_t)(row0 + ai * 128 + m * 16) * 1024 + col0;
#pragma unroll
                for (int bj = 0; bj < 2; ++bj) *(u32x4*)(pp + off + bj * 128) = pack8(acc[ai][bj][m][0], acc[ai][bj][m][1]);
            }
    }
};
struct EpiH3 {
    static constexpr bool PERM = true, AFTER_DRAIN = false;
    const float* rstd3; const bf16* pp; float* h; float* part; const bf16* h2b; bf16* h3b;
    __device__ __forceinline__ void operator()(const f32x4 (&acc)[2][2][4][2], const Unit& u, int wr, int wc, int fr, int fq) const {
        { const int t_ = fresh_lane(); fr = t_ & 15; fq = t_ >> 4; }
        const int row0 = u.pm * 256 + wr * 64 + fr, col0 = u.pn * 256 + wc * 32 + 8 * fq;
#pragma unroll
        for (int ai = 0; ai < 2; ++ai)
#pragma unroll
            for (int m = 0; m < 4; ++m) {
                const int r = row0 + ai * 128 + m * 16; const size_t off = (size_t)r * 1024 + col0; const float rs = rstd3[r]; float sq = 0.f;
#pragma unroll
                for (int bj = 0; bj < 2; ++bj) {
                    const size_t o = off + bj * 128; const u32x4 pw = *(const u32x4*)(pp + o);
#if ALL_FUSED
                    const u32x4 hw = *(const u32x4*)(h2b + o);
                    const f32x4 v0 = bf4_lo((u32x2){hw.x, hw.y}) + sig4(acc[ai][bj][m][0] * rs) * bf4_lo((u32x2){pw.x, pw.y});
                    const f32x4 v1 = bf4_lo((u32x2){hw.z, hw.w}) + sig4(acc[ai][bj][m][1] * rs) * bf4_lo((u32x2){pw.z, pw.w});
                    *(u32x4*)(h3b + o) = pack8(v0, v1);
#else
                    const f32x4 v0 = *(const f32x4*)(h + o) + sig4(acc[ai][bj][m][0] * rs) * bf4_lo((u32x2){pw.x, pw.y});
                    const f32x4 v1 = *(const f32x4*)(h + o + 4) + sig4(acc[ai][bj][m][1] * rs) * bf4_lo((u32x2){pw.z, pw.w});
                    *(f32x4*)(h + o) = v0; *(f32x4*)(h + o + 4) = v1;
#endif
                    sq += (v0[0] * v0[0] + v0[1] * v0[1]) + (v0[2] * v0[2] + v0[3] * v0[3]) + (v1[0] * v1[0] + v1[1] * v1[1]) + (v1[2] * v1[2] + v1[3] * v1[3]);
                }
                sq += __shfl_xor(sq, 16); sq += __shfl_xor(sq, 32);
                if (fq == 0) part[(size_t)r * 16 + u.pn * 4 + wc] = sq;
            }
    }
};
struct EpiPre {
    static constexpr bool PERM = false, AFTER_DRAIN = false;
    float* rp; float* ip;
    __device__ __forceinline__ void operator()(const f32x4 (&acc)[2][2][4][2], const Unit& u, int wr, int wc, int fr, int fq) const {
        { const int t_ = fresh_lane(); fr = t_ & 15; fq = t_ >> 4; }
#pragma unroll
        for (int n = 0; n < 2; ++n) { const int ch = u.pn * 128 + wc * 32 + 16 * n + 4 * fq;
#pragma unroll
            for (int ai = 0; ai < 2; ++ai)
#pragma unroll
                for (int m = 0; m < 4; ++m) { const int r = u.pm * 256 + ai * 128 + wr * 64 + m * 16 + fr; const size_t o = (size_t)r * 1024 + ch; *(f32x4*)(rp + o) = acc[ai][0][m][n]; *(f32x4*)(ip + o) = acc[ai][1][m][n]; } }
    }
};
struct EpiH3Final {
    static constexpr bool PERM = true, AFTER_DRAIN = false;
    const float* rstd3; const bf16* pp; const bf16* h2b; const float* fg; float* out; float* part; unsigned* cnt;
    __device__ __forceinline__ void operator()(f32x4 (&acc)[2][2][4][2], const Unit& u, int wr, int wc, int fr, int fq) const {
        { const int t_ = fresh_lane(); fr = t_ & 15; fq = t_ >> 4; }
        const int row0 = u.pm * 256 + wr * 64 + fr, col0 = u.pn * 256 + wc * 32 + 8 * fq;
#pragma unroll
        for (int ai = 0; ai < 2; ++ai)
#pragma unroll
            for (int m = 0; m < 4; ++m) {
                const int r = row0 + ai * 128 + m * 16; const size_t off = (size_t)r * 1024 + col0; const float rs = rstd3[r]; float sq = 0.f;
#pragma unroll
                for (int bj = 0; bj < 2; ++bj) {
                    const size_t o = off + bj * 128; const u32x4 pw = *(const u32x4*)(pp + o); const u32x4 hw = *(const u32x4*)(h2b + o);
                    const f32x4 v0 = bf4_lo((u32x2){hw.x, hw.y}) + sig4(acc[ai][bj][m][0] * rs) * bf4_lo((u32x2){pw.x, pw.y});
                    const f32x4 v1 = bf4_lo((u32x2){hw.z, hw.w}) + sig4(acc[ai][bj][m][1] * rs) * bf4_lo((u32x2){pw.z, pw.w});
                    acc[ai][bj][m][0] = v0; acc[ai][bj][m][1] = v1;
                    sq += (v0[0] * v0[0] + v0[1] * v0[1]) + (v0[2] * v0[2] + v0[3] * v0[3]) + (v1[0] * v1[0] + v1[1] * v1[1]) + (v1[2] * v1[2] + v1[3] * v1[3]);
                }
                sq += __shfl_xor(sq, 16); sq += __shfl_xor(sq, 32);
                if (fq == 0) __hip_atomic_store(part + (size_t)r * 16 + u.pn * 4 + wc, sq, __ATOMIC_RELAXED, __HIP_MEMORY_SCOPE_AGENT);
            }
        asm volatile("s_waitcnt vmcnt(0)" ::: "memory");
        const int lane = fq * 16 + fr;
        unsigned* c = cnt + 64 * u.pm;
        if (lane == 0) __hip_atomic_fetch_add(c, 1u, __ATOMIC_RELAXED, __HIP_MEMORY_SCOPE_AGENT);
        {
            const unsigned long long t0 = __builtin_amdgcn_s_memrealtime();
            while ((unsigned)__builtin_amdgcn_readfirstlane((int)__hip_atomic_load(c, __ATOMIC_RELAXED, __HIP_MEMORY_SCOPE_AGENT)) < 32u) {
                if (__builtin_amdgcn_s_memrealtime() - t0 > 2000000ull) break;
                __builtin_amdgcn_s_sleep(2);
            }
        }
        { const int t_ = fresh_lane(); fr = t_ & 15; fq = t_ >> 4; }
#pragma unroll
        for (int ai = 0; ai < 2; ++ai)
#pragma unroll
            for (int m = 0; m < 4; ++m) {
                const int r = u.pm * 256 + wr * 64 + fr + ai * 128 + m * 16;
                float ps = 0.f;
#pragma unroll
                for (int k = 0; k < 16; ++k) ps += __hip_atomic_load(part + (size_t)r * 16 + k, __ATOMIC_RELAXED, __HIP_MEMORY_SCOPE_AGENT);
                const float rr = 1.0f / sqrtf(ps * (1.0f / 1024.0f) + EPS);
                const int cc = u.pn * 256 + wc * 32 + 8 * fq;
#pragma unroll
                for (int bj = 0; bj < 2; ++bj) {
                    const f32x4 g0 = *(const f32x4*)(fg + cc + bj * 128), g1 = *(const f32x4*)(fg + cc + bj * 128 + 4);
                    float* op = out + (size_t)r * 1024 + cc + bj * 128;
                    *(f32x4*)op = acc[ai][bj][m][0] * rr * g0; *(f32x4*)(op + 4) = acc[ai][bj][m][1] * rr * g1;
                }
            }
    }
};
template <int CTRL> __device__ __forceinline__ float dpp_f(float oldv, float src) {
    return __builtin_bit_cast(float, __builtin_amdgcn_update_dpp(__builtin_bit_cast(int, oldv), __builtin_bit_cast(int, src), CTRL, 0xf, 0xf, false));
}
#ifndef LRU_T2
#define LRU_T2 0
#endif
struct EpiLru {
    static constexpr bool PERM = false, AFTER_DRAIN = false;
    const bf16* lin; const float* ba; const float* bx; const float* c8l; bf16* hloc; bf16* pcum; float* agg;
    template <int SH> static __device__ __forceinline__ void step(f32x4& A, f32x4& Bv, float idd) {
#pragma unroll
        for (int j = 0; j < 4; ++j) {
            const float ap = __int_as_float(__builtin_amdgcn_update_dpp(0, __float_as_int((float)A[j]), 0x110 + SH, 0xf, 0xf, true)) + idd;
            const float bp = __int_as_float(__builtin_amdgcn_update_dpp(0, __float_as_int((float)Bv[j]), 0x110 + SH, 0xf, 0xf, true));
            Bv[j] = fmaf(A[j], bp, Bv[j]); A[j] = A[j] * ap; }
    }
    __device__ __forceinline__ void operator()(f32x4 (&acc)[2][2][4][2], const Unit& u, int wr, int wc, int fr, int fq) const {
        { const int t_ = fresh_lane(); fr = t_ & 15; fq = t_ >> 4; }
        const int lane = fq * 16 + fr;
#pragma unroll
        for (int n = 0; n < 2; ++n) {
            const int ch = u.pn * 128 + wc * 32 + 16 * n + 4 * fq;
            const f32x4 bav = *(const f32x4*)(ba + ch), bxv = *(const f32x4*)(bx + ch), cv = *(const f32x4*)(c8l + ch);
#pragma unroll
            for (int ai = 0; ai < 2; ++ai)
#pragma unroll
                for (int m = 0; m < 4; ++m) {
                    const int r = u.pm * 256 + ai * 128 + wr * 64 + m * 16 + fr; const unsigned o = (unsigned)r * 1024u + (unsigned)ch;
                    const f32x4 lv = bf4_lo(*(const u32x2*)(lin + o));
#pragma unroll
                    for (int j = 0; j < 4; ++j) {
                        const float rr = sigmoidf_(acc[ai][0][m][n][j] + bav[j]), ii = sigmoidf_(acc[ai][1][m][n][j] + bxv[j]);
                        const float a = __builtin_amdgcn_exp2f(cv[j] * rr);
                        acc[ai][0][m][n][j] = a; acc[ai][1][m][n][j] = __builtin_amdgcn_sqrtf(fmaxf(1.0f - a * a, 0.f)) * (ii * lv[j]);
                    }
                    asm volatile("" : "+v"(acc[ai][0][m][n]), "+v"(acc[ai][1][m][n]));
                }
        }
#if defined(LRU_DEBUG) && LRU_DEBUG == 1
        {
            float* af = (float*)hloc; float* bf = (float*)pcum;
#pragma unroll
            for (int n = 0; n < 2; ++n) { const int ch = u.pn * 128 + wc * 32 + 16 * n + 4 * fq;
#pragma unroll
                for (int ai = 0; ai < 2; ++ai)
#pragma unroll
                    for (int m = 0; m < 4; ++m) { const int r = u.pm * 256 + ai * 128 + wr * 64 + m * 16 + fr; const size_t o = (size_t)r * 1024 + ch; *(f32x4*)(af + o) = acc[ai][0][m][n]; *(f32x4*)(bf + o) = acc[ai][1][m][n]; } }
            return;
        }
#endif
        __builtin_amdgcn_sched_barrier(0);
        const float id1 = fr < 1 ? 1.f : 0.f, id2 = fr < 2 ? 1.f : 0.f, id4 = fr < 4 ? 1.f : 0.f, id8 = fr < 8 ? 1.f : 0.f;
#pragma unroll
        for (int ai = 0; ai < 2; ++ai)
#pragma unroll
            for (int m = 0; m < 4; ++m)
#pragma unroll
                for (int n = 0; n < 2; ++n) { step<1>(acc[ai][0][m][n], acc[ai][1][m][n], id1); step<2>(acc[ai][0][m][n], acc[ai][1][m][n], id2); step<4>(acc[ai][0][m][n], acc[ai][1][m][n], id4); step<8>(acc[ai][0][m][n], acc[ai][1][m][n], id8);
                    asm volatile("" : "+v"(acc[ai][0][m][n]), "+v"(acc[ai][1][m][n])); }
        { const int t_ = fresh_lane(); fr = t_ & 15; fq = t_ >> 4; }
        const int src4 = (((fq * 16 + fr) & 48) | 15) * 4;
#pragma unroll
        for (int n = 0; n < 2; ++n) {
            const int ch = u.pn * 128 + wc * 32 + 16 * n + 4 * fq;
#pragma unroll
            for (int ai = 0; ai < 2; ++ai) {
#pragma unroll
                for (int m = 0; m < 4; ++m) {
                    f32x4& A = acc[ai][0][m][n]; f32x4& Bv = acc[ai][1][m][n];
                    if (m > 0 && !(LRU_T2)) {
#pragma unroll
                        for (int j = 0; j < 4; ++j) { const float pa = acc[ai][0][m - 1][n][j], pb = acc[ai][1][m - 1][n][j];
                            const float ac = __int_as_float(__builtin_amdgcn_ds_bpermute(src4, __float_as_int(pa))), bc = __int_as_float(__builtin_amdgcn_ds_bpermute(src4, __float_as_int(pb))); Bv[j] = fmaf(A[j], bc, Bv[j]); A[j] = A[j] * ac; }
                    }
                    const int r = u.pm * 256 + ai * 128 + wr * 64 + m * 16 + fr; const unsigned o = (unsigned)r * 1024u + (unsigned)ch;
                    u32x2 wp, wh; wp.x = cvt_pk_bf16(A[0], A[1]); wp.y = cvt_pk_bf16(A[2], A[3]); wh.x = cvt_pk_bf16(Bv[0], Bv[1]); wh.y = cvt_pk_bf16(Bv[2], Bv[3]);
                    *(u32x2*)(pcum + o) = wp; *(u32x2*)(hloc + o) = wh;
                    if (m == 3 && fr == 15) {
                        const int chunk = u.pm * 4 + ai * 2 + wr; float* ap = agg + ((size_t)chunk * 1024 + ch) * 2;
                        *(f32x4*)(ap) = (f32x4){A[0], Bv[0], A[1], Bv[1]}; *(f32x4*)(ap + 4) = (f32x4){A[2], Bv[2], A[3], Bv[3]};
                    }
                    __builtin_amdgcn_sched_barrier(0);
                }
            }
        }
    }
};

__device__ __forceinline__ void p0_transpose_item(const float* W, int ldw, const float* gain, bf16* WT, int ldt, int k_off, LAS float* scr, int kb, int nb, int lane) {
    const int k0 = 64 * kb, n0 = 32 * nb;
    const int c4 = lane & 7, kr = lane >> 3;
    f32x4 v[8];
#pragma unroll
    for (int i = 0; i < 8; ++i) v[i] = *(const f32x4*)(W + (size_t)(k0 + 8 * i + kr) * ldw + n0 + 4 * c4);
#pragma unroll
    for (int i = 0; i < 8; ++i) { f32x4 x = v[i]; if (gain) x = x * gain[k0 + 8 * i + kr]; *(LAS f32x4*)(scr + (8 * i + kr) * 36 + 4 * c4) = x; }
    LDS_WAIT(); asm volatile("" ::: "memory");
    const int c = lane & 7;
#pragma unroll
    for (int j = 0; j < 4; ++j) { const int n = (lane >> 3) + 8 * j; const LAS float* sp = scr + (8 * c) * 36 + n;
        u32x4 o; o.x = pk2(sp[0 * 36], sp[1 * 36]); o.y = pk2(sp[2 * 36], sp[3 * 36]); o.z = pk2(sp[4 * 36], sp[5 * 36]); o.w = pk2(sp[6 * 36], sp[7 * 36]);
        *(u32x4*)(WT + (size_t)(n0 + n) * ldt + k_off + k0 + 8 * c) = o; }
    LDS_WAIT(); asm volatile("" ::: "memory");
}
__device__ __forceinline__ void p0_wfold_item(LAS float* lds, const float* wq, const float* k1, const float* k2, const float* gffn, bf16* wfold, int item, int tid) {
    const int hh = item >> 4, kb = item & 15;
    LAS float* wqs = lds; LAS float* kks = lds + 64 * 132;
    const float* ksrc = (hh & 1) ? k2 : k1;
#pragma unroll
    for (int i = 0; i < 4; ++i) { const int e = tid + i * 512, r = e >> 5, c4 = e & 31; *(LAS f32x4*)(wqs + r * 132 + 4 * c4) = *(const f32x4*)(wq + (size_t)(kb * 64 + r) * 2048 + hh * 128 + 4 * c4); }
#pragma unroll
    for (int i = 0; i < 8; ++i) { const int e = tid + i * 512, r = e >> 5, c4 = e & 31; *(LAS f32x4*)(kks + r * 132 + 4 * c4) = *(const f32x4*)(ksrc + (size_t)r * 128 + 4 * c4); }
    __syncthreads();
    const int tk = tid & 15, tkey = tid >> 4;
    float acc[4][4];
#pragma unroll
    for (int i = 0; i < 4; ++i)
#pragma unroll
        for (int j = 0; j < 4; ++j) acc[i][j] = 0.f;
#pragma unroll 2
    for (int c4 = 0; c4 < 32; ++c4) {
        f32x4 a[4], b[4];
#pragma unroll
        for (int i = 0; i < 4; ++i) { a[i] = *(const LAS f32x4*)(wqs + (tk * 4 + i) * 132 + 4 * c4); b[i] = *(const LAS f32x4*)(kks + (tkey * 4 + i) * 132 + 4 * c4); }
#pragma unroll
        for (int i = 0; i < 4; ++i)
#pragma unroll
            for (int j = 0; j < 4; ++j) acc[i][j] += (a[i][0] * b[j][0] + a[i][1] * b[j][1]) + (a[i][2] * b[j][2] + a[i][3] * b[j][3]);
    }
    const int kg = kb * 64 + tk * 4; const f32x4 gv = *(const f32x4*)(gffn + kg);
#pragma unroll
    for (int j = 0; j < 4; ++j) { u32x2 w; w.x = pk2(acc[0][j] * gv[0], acc[1][j] * gv[1]); w.y = pk2(acc[2][j] * gv[2], acc[3][j] * gv[3]);
        *(u32x2*)(wfold + (size_t)(hh * 128 + tkey * 4 + j) * 1024 + kg) = w; }
    __syncthreads();
}

struct In { const float* p[25]; };
enum { I_X = 0, I_P, I_GMIX, I_WIN, I_SINK, I_CONVW, I_CONVB, I_WA, I_BA, I_WX, I_BX, I_LAM, I_WUA, I_WUL, I_WO, I_GFFN, I_WQ, I_K1, I_K2, I_U, I_V, I_GPLE, I_WGATE, I_WPROJ, I_FG };

__device__ __forceinline__ void p0_prologue(const In& in, unsigned char* ws, LAS unsigned char* lds, int vcu, int G, int wave, int tid) {
    const int lane = tid & 63;
    LAS float* scr = (LAS float*)(lds + wave * 16384);
    const int gw = vcu * NWAVES + wave, NGW = G * NWAVES;
    constexpr int I_IN = 16 * 152, I_UA = 8 * 32, I_SQ = 16 * 32, I_PJ = 4 * 32, I_AX = 128;
    constexpr int NITEMS = I_IN + I_UA + 3 * I_SQ + I_PJ + I_AX;
    for (int it = gw; it < NITEMS; it += NGW) {
        int r = it;
        if (r < I_IN) { p0_transpose_item(in.p[I_WIN], INW, in.p[I_GMIX], (bf16*)(ws + WS_WIN), 1024, 0, scr, r / 152, r % 152, lane); continue; } r -= I_IN;
        if (r < I_UA) { p0_transpose_item(in.p[I_WUA], 1024, nullptr, (bf16*)(ws + WS_WUA), 512, 0, scr, r / 32, r % 32, lane); continue; } r -= I_UA;
        if (r < I_SQ) { p0_transpose_item(in.p[I_WUL], 1024, nullptr, (bf16*)(ws + WS_WUL), 1024, 0, scr, r / 32, r % 32, lane); continue; } r -= I_SQ;
        if (r < I_SQ) { p0_transpose_item(in.p[I_WO], 1024, nullptr, (bf16*)(ws + WS_WO), 1024, 0, scr, r / 32, r % 32, lane); continue; } r -= I_SQ;
        if (r < I_SQ) { p0_transpose_item(in.p[I_WGATE], 1024, in.p[I_GPLE], (bf16*)(ws + WS_WG), 1024, 0, scr, r / 32, r % 32, lane); continue; } r -= I_SQ;
        if (r < I_PJ) { p0_transpose_item(in.p[I_WPROJ], 1024, nullptr, (bf16*)(ws + WS_WPROJ), 256, 0, scr, r / 32, r % 32, lane); continue; } r -= I_PJ;
        { const int blk = r >> 4, which = (r >> 3) & 1, sub = r & 7;

#if LRU_PADDED
#if LRU_PADDED == 2
          p0_transpose_item(in.p[which ? I_WX : I_WA] + (size_t)blk * 16384, 128, nullptr, (bf16*)(ws + WS_WAX) + (size_t)blk * 32768 + which * 128 * 128, 128, 0, scr, sub >> 2, sub & 3, lane); }
#else
          p0_transpose_item(in.p[which ? I_WX : I_WA] + (size_t)blk * 16384, 128, nullptr, (bf16*)(ws + WS_WAX) + (size_t)blk * 65536 + which * 128 * 256, 256, (blk & 1) * 128, scr, sub >> 2, sub & 3, lane); }
#endif
#else
          p0_transpose_item(in.p[which ? I_WX : I_WA] + (size_t)blk * 16384, 128, nullptr, (bf16*)(ws + WS_WAXD) + (size_t)(blk * 256 + which * 128) * 1024, 1024, blk * 128, scr, sub >> 2, sub & 3, lane); }
#endif
    }
#if LRU_PADDED == 2
#elif LRU_PADDED
    for (int i = vcu * 512 + tid; i < 8 * 256 * 16; i += G * 512) { const int c16 = i & 15, n = (i >> 4) & 255, blk = i >> 12;
        *(u32x4*)((bf16*)(ws + WS_WAX) + (size_t)blk * 65536 + n * 256 + ((blk & 1) ^ 1) * 128 + c16 * 8) = (u32x4){0u, 0u, 0u, 0u}; }
#else
    for (int i = vcu * 512 + tid; i < 2048 * 128; i += G * 512) { const int c16 = i & 127, row = i >> 7, blk = row >> 8;
        if ((c16 >> 4) != blk) *(u32x4*)((bf16*)(ws + WS_WAXD) + (size_t)row * 1024 + c16 * 8) = (u32x4){0u, 0u, 0u, 0u}; }
#endif
    for (int m = gw; m < T_; m += 2 * NGW) {
        const int m2 = m + NGW;
        const f32x4* xa = (const f32x4*)(in.p[I_X] + (size_t)m * 1024) + lane; const f32x4* xb = (const f32x4*)(in.p[I_X] + (size_t)(m2 < T_ ? m2 : m) * 1024) + lane;
        f32x4 va[4], vb[4]; float sa = 0.f, sb = 0.f;
#pragma unroll
        for (int j = 0; j < 4; ++j) { va[j] = xa[64 * j]; vb[j] = xb[64 * j]; }
#pragma unroll
        for (int j = 0; j < 4; ++j) { sa += (va[j][0] * va[j][0] + va[j][1] * va[j][1]) + (va[j][2] * va[j][2] + va[j][3] * va[j][3]); sb += (vb[j][0] * vb[j][0] + vb[j][1] * vb[j][1]) + (vb[j][2] * vb[j][2] + vb[j][3] * vb[j][3]); }
#pragma unroll
        for (int o = 1; o < 64; o <<= 1) { sa += __shfl_xor(sa, o); sb += __shfl_xor(sb, o); }
        u32x2* oa = (u32x2*)((bf16*)(ws + WS_R0) + (size_t)m * 1024) + lane;
#pragma unroll
        for (int j = 0; j < 4; ++j) { u32x2 w; w.x = pk2(va[j][0], va[j][1]); w.y = pk2(va[j][2], va[j][3]); oa[64 * j] = w; }
        if (lane == 0) ((float*)(ws + WS_RSTD1))[m] = 1.0f / sqrtf(sa * (1.0f / 1024.0f) + EPS);
        if (m2 < T_) {
            u32x2* ob = (u32x2*)((bf16*)(ws + WS_R0) + (size_t)m2 * 1024) + lane;
#pragma unroll
            for (int j = 0; j < 4; ++j) { u32x2 w; w.x = pk2(vb[j][0], vb[j][1]); w.y = pk2(vb[j][2], vb[j][3]); ob[64 * j] = w; }
            if (lane == 0) ((float*)(ws + WS_RSTD1))[m2] = 1.0f / sqrtf(sb * (1.0f / 1024.0f) + EPS);
        }
    }
    for (int m = gw; m < T_; m += 4 * NGW) {
        f32x4 v[4];
#pragma unroll
        for (int q = 0; q < 4; ++q) { const int mq = m + q * NGW; v[q] = ((const f32x4*)(in.p[I_P] + (size_t)(mq < T_ ? mq : m) * 256))[lane]; }
#pragma unroll
        for (int q = 0; q < 4; ++q) { const int mq = m + q * NGW; if (mq < T_) { u32x2 w; w.x = pk2(v[q][0], v[q][1]); w.y = pk2(v[q][2], v[q][3]); ((u32x2*)((bf16*)(ws + WS_PB) + (size_t)mq * 256))[lane] = w; } }
    }
    if (vcu == 0) for (int c = tid; c < 1024; c += 512) ((float*)(ws + WS_C8))[c] = -8.0f * log1pf(expf(-in.p[I_LAM][c])) * LOG2E;
    __syncthreads();
    for (int it = vcu; it < 256; it += G) p0_wfold_item((LAS float*)lds, in.p[I_WQ], in.p[I_K1], in.p[I_K2], in.p[I_GFFN], (bf16*)(ws + WS_WFOLD), it, tid);
}

constexpr int AT_KSTR = 72, AT_VSTR = 260, AT_V_OFF = 256 * AT_KSTR * 2;
__device__ __forceinline__ int crow(int r, int hi) { return (r & 3) + 8 * (r >> 2) + 4 * hi; }
__device__ __forceinline__ void attn_item(LAS unsigned char* lds, const bf16* qkv, const float* sink, bf16* att, int item, int wave, int tid) {
    const int lane = tid & 63;
    const int g = item & 1, n = (item >> 1) & 15, b = item >> 5;
    const int t0 = b * S_ + n * 128;
    LAS bf16* Ks = (LAS bf16*)lds; LAS bf16* Vt = (LAS bf16*)(lds + AT_V_OFF);
#pragma unroll
    for (int i = 0; i < 4; ++i) {
        const int idx = tid + i * 512, row = idx >> 3, ch = idx & 7; const int tk = t0 - 128 + row;
        u32x4 kv = (u32x4){0u, 0u, 0u, 0u}, vv = (u32x4){0u, 0u, 0u, 0u};
        if (n > 0 || row >= 128) { const bf16* src = qkv + (size_t)tk * 768 + 512 + g * 64 + ch * 8; kv = *(const u32x4*)src; vv = *(const u32x4*)(src + 128); }
        *(LAS u32x4*)(Ks + row * AT_KSTR + ch * 8) = kv;
#pragma unroll
        for (int c = 0; c < 8; ++c) Vt[(ch * 8 + c) * AT_VSTR + row] = (bf16)(vv[c >> 1] >> (16 * (c & 1)));
    }
    __syncthreads();
    const int hr = wave >> 1, qh = wave & 1, head = g * 4 + hr;
    const float slope2 = exp2f(-(float)(head + 1)) * LOG2E, sink2 = sink[head] * LOG2E;
    const int q = lane & 31, hi = lane >> 5;
#pragma unroll 1
    for (int ps = 0; ps < 2; ++ps) {
        const int i0 = 64 * qh + 32 * ps, kb0 = i0;
        const bf16* qp = qkv + (size_t)(t0 + i0 + q) * 768 + head * 64 + 8 * hi;
        bf16x8 qf[4];
#pragma unroll
        for (int s = 0; s < 4; ++s) qf[s] = *(const bf16x8*)(qp + 16 * s);
        f32x16 oT[2];
#pragma unroll
        for (int dt = 0; dt < 2; ++dt)
#pragma unroll
            for (int r = 0; r < 16; ++r) oT[dt][r] = 0.f;
        float mrun = sink2, l = 0.f;
#pragma unroll 1
        for (int kt = 0; kt < 5; ++kt) {
            const int kbase = kb0 + 32 * kt;
            f32x16 sT;
#pragma unroll
            for (int r = 0; r < 16; ++r) sT[r] = 0.f;
#pragma unroll
            for (int s = 0; s < 4; ++s) { const bf16x8 kf = *(const LAS bf16x8*)(Ks + (kbase + q) * AT_KSTR + 16 * s + 8 * hi); sT = __builtin_amdgcn_mfma_f32_32x32x16_bf16(kf, qf[s], sT, 0, 0, 0); }
            float tm = -1.0e30f;
#pragma unroll
            for (int r = 0; r < 16; ++r) {
                const int kj = kbase + crow(r, hi); const int dist = i0 + q + 128 - kj;
                const bool valid = (dist >= 0) && (dist < 128) && (n > 0 || kj >= 128);
                const float v = valid ? (sT[r] * (0.125f * LOG2E) - slope2 * (float)dist) : -1.0e30f;
                sT[r] = v; tm = fmaxf(tm, v);
            }
            tm = fmaxf(tm, __shfl_xor(tm, 32));
            const float mnew = fmaxf(mrun, tm), alpha = __builtin_amdgcn_exp2f(mrun - mnew);
            mrun = mnew;
            float ls = 0.f;
#pragma unroll
            for (int r = 0; r < 16; ++r) { const float p = __builtin_amdgcn_exp2f(sT[r] - mnew); sT[r] = p; ls += p; }
            l = l * alpha + ls;
#pragma unroll
            for (int dt = 0; dt < 2; ++dt)
#pragma unroll
                for (int r = 0; r < 16; ++r) oT[dt][r] *= alpha;
#pragma unroll
            for (int s = 0; s < 2; ++s) {
                u32x4 pw; pw.x = cvt_pk_bf16(sT[8 * s + 0], sT[8 * s + 1]); pw.y = cvt_pk_bf16(sT[8 * s + 2], sT[8 * s + 3]);
                pw.z = cvt_pk_bf16(sT[8 * s + 4], sT[8 * s + 5]); pw.w = cvt_pk_bf16(sT[8 * s + 6], sT[8 * s + 7]);
                const bf16x8 pf = __builtin_bit_cast(bf16x8, pw);
#pragma unroll
                for (int dt = 0; dt < 2; ++dt) {
                    const LAS bf16* vp = Vt + (32 * dt + q) * AT_VSTR + kbase + 16 * s + 4 * hi;
                    const u32x2 va = *(const LAS u32x2*)vp, vb = *(const LAS u32x2*)(vp + 8);
                    const bf16x8 af = __builtin_bit_cast(bf16x8, (u32x4){va.x, va.y, vb.x, vb.y});
                    oT[dt] = __builtin_amdgcn_mfma_f32_32x32x16_bf16(af, pf, oT[dt], 0, 0, 0);
                }
            }
        }
        l += __shfl_xor(l, 32);
        l += __builtin_amdgcn_exp2f(sink2 - mrun);
        const float inv = 1.0f / l;
        bf16* op = att + (size_t)(t0 + i0 + q) * 512 + head * 64 + 4 * hi;
#pragma unroll
        for (int dt = 0; dt < 2; ++dt)
#pragma unroll
            for (int rg = 0; rg < 4; ++rg) { u32x2 w; w.x = cvt_pk_bf16(oT[dt][4 * rg] * inv, oT[dt][4 * rg + 1] * inv); w.y = cvt_pk_bf16(oT[dt][4 * rg + 2] * inv, oT[dt][4 * rg + 3] * inv);
                *(u32x2*)(op + 32 * dt + 8 * rg) = w; }
    }
    __syncthreads();
}
__device__ __forceinline__ void conv_items(const bf16* lx, const float* cw, const float* cb, bf16* lin, int vcu, int G, int tid) {
    for (int i = vcu * 512 + tid; i < T_ * 128; i += 2 * G * 512) {
        const int c8 = (i & 127) * 8;
        const int ta = i >> 7, i2 = i + G * 512; const bool hasb = i2 < T_ * 128; const int tb = hasb ? (i2 >> 7) : ta;
        const int tsa = ta & (S_ - 1), tsb = tb & (S_ - 1);
        u32x4 wa[4], wb[4];
#pragma unroll
        for (int tap = 0; tap < 4; ++tap) {
            wa[tap] = (tsa - 3 + tap >= 0) ? *(const u32x4*)(lx + (size_t)(ta - 3 + tap) * 1024 + c8) : (u32x4){0u, 0u, 0u, 0u};
            wb[tap] = (tsb - 3 + tap >= 0) ? *(const u32x4*)(lx + (size_t)(tb - 3 + tap) * 1024 + c8) : (u32x4){0u, 0u, 0u, 0u};
        }
        f32x4 a0 = *(const f32x4*)(cb + c8), a1 = *(const f32x4*)(cb + c8 + 4), b0 = a0, b1 = a1;
#pragma unroll
        for (int tap = 0; tap < 4; ++tap) {
            const f32x4 w0 = *(const f32x4*)(cw + tap * 1024 + c8), w1 = *(const f32x4*)(cw + tap * 1024 + c8 + 4);
            a0 += bf4_lo((u32x2){wa[tap].x, wa[tap].y}) * w0; a1 += bf4_lo((u32x2){wa[tap].z, wa[tap].w}) * w1;
            b0 += bf4_lo((u32x2){wb[tap].x, wb[tap].y}) * w0; b1 += bf4_lo((u32x2){wb[tap].z, wb[tap].w}) * w1;
        }
        *(u32x4*)(lin + (size_t)ta * 1024 + c8) = pack8(a0, a1);
        if (hasb) *(u32x4*)(lin + (size_t)tb * 1024 + c8) = pack8(b0, b1);
    }
}
__device__ __forceinline__ void scan_finish(const bf16* hloc, const bf16* pcum, const float* agg, const bf16* gl, bf16* rec, int vcu, int G, int tid) {
    const int c8 = (tid & 127) * 8, rg = tid >> 7;
    for (int chunk = vcu; chunk < T_ / 64; chunk += G) {
        const int ci = chunk & 31, cb = chunk - ci;
        float carry[8];
#pragma unroll
        for (int j = 0; j < 8; ++j) carry[j] = 0.f;
#pragma unroll 4
        for (int cc = 0; cc < ci; ++cc) {
            const f32x4* ap = (const f32x4*)(agg + ((size_t)(cb + cc) * 1024 + c8) * 2);
#pragma unroll
            for (int q = 0; q < 4; ++q) { const f32x4 v = ap[q]; carry[2 * q] = fmaf(v[0], carry[2 * q], v[1]); carry[2 * q + 1] = fmaf(v[2], carry[2 * q + 1], v[3]); }
        }
#pragma unroll 8
        for (int rr = 0; rr < 16; ++rr) {
            const size_t o = (size_t)(chunk * 64 + rg + 4 * rr) * 1024 + c8;
            const u32x4 hw = *(const u32x4*)(hloc + o), pw = *(const u32x4*)(pcum + o), gw = *(const u32x4*)(gl + o);
            const f32x4 h0 = bf4_lo((u32x2){hw.x, hw.y}), h1 = bf4_lo((u32x2){hw.z, hw.w}), p0 = bf4_lo((u32x2){pw.x, pw.y}), p1 = bf4_lo((u32x2){pw.z, pw.w});
            const f32x4 g0 = bf4_lo((u32x2){gw.x, gw.y}), g1 = bf4_lo((u32x2){gw.z, gw.w});
            f32x4 r0, r1;
#pragma unroll
            for (int j = 0; j < 4; ++j) { r0[j] = fmaf(p0[j], carry[j], h0[j]) * g0[j]; r1[j] = fmaf(p1[j], carry[4 + j], h1[j]) * g1[j]; }
            *(u32x4*)(rec + o) = pack8(r0, r1);
        }
    }
}
__device__ __forceinline__ void final_rows(float* h, const bf16* h3b, const float* part, const float* fg, int gw, int NGW, int lane, float tscale) {
    f32x4 g[4];
#pragma unroll
    for (int j = 0; j < 4; ++j) g[j] = ((const f32x4*)fg)[lane + 64 * j];
    for (int r0 = gw; r0 < T_; r0 += 2 * NGW) {
        const int r1 = (r0 + NGW < T_) ? r0 + NGW : r0;
        float pa = (lane < 16) ? part[(size_t)r0 * 16 + lane] : 0.f, pb = (lane < 16) ? part[(size_t)r1 * 16 + lane] : 0.f;
#if ALL_FUSED
        const u32x2* ba = (const u32x2*)(h3b + (size_t)r0 * 1024) + lane; const u32x2* bb = (const u32x2*)(h3b + (size_t)r1 * 1024) + lane;
        u32x2 wa[4], wb[4];
#pragma unroll
        for (int j = 0; j < 4; ++j) { wa[j] = ba[64 * j]; wb[j] = bb[64 * j]; }
#endif
#pragma unroll
        for (int o = 1; o < 64; o <<= 1) { pa += __shfl_xor(pa, o); pb += __shfl_xor(pb, o); }
        const float ra = tscale / sqrtf(pa * (1.0f / 1024.0f) + EPS), rb = tscale / sqrtf(pb * (1.0f / 1024.0f) + EPS);
        f32x4* ha = (f32x4*)(h + (size_t)r0 * 1024) + lane; f32x4* hb = (f32x4*)(h + (size_t)r1 * 1024) + lane;
#if ALL_FUSED
#pragma unroll
        for (int j = 0; j < 4; ++j) ha[64 * j] = bf4_lo(wa[j]) * ra * g[j];
        if (r1 != r0) {
#pragma unroll
            for (int j = 0; j < 4; ++j) hb[64 * j] = bf4_lo(wb[j]) * rb * g[j];
        }
#else
#pragma unroll
        for (int j = 0; j < 4; ++j) ha[64 * j] = ha[64 * j] * ra * g[j];
        if (r1 != r0) {
#pragma unroll
            for (int j = 0; j < 4; ++j) hb[64 * j] = hb[64 * j] * rb * g[j];
        }
#endif
    }
}

constexpr int N_PHASES = 16;
struct Args { const float* in[25]; float* out; unsigned char* ws; int ph_lo, ph_hi, li, pad; };
__global__ void __launch_bounds__(NWAVES * 64, 2) fused_fwd(Args args) {
    extern __shared__ __attribute__((aligned(16))) unsigned char lds_raw[];
    LAS unsigned char* lds = (LAS unsigned char*)lds_raw;
    volatile LAS unsigned* MISC = (volatile LAS unsigned*)(lds + LDSCTL_OFF);
    const int wave = __builtin_amdgcn_readfirstlane((int)threadIdx.x >> 6);
#define FRESH_TID() (wave * 64 + fresh_lane())
#define FRESH_LANE() fresh_lane()
    const int G = gridDim.x; const int bx = blockIdx.x; const int vcu = (G % 8 == 0) ? (bx % 8) * (G / 8) + bx / 8 : bx;
    unsigned char* ws = args.ws; float* out = args.out;
    In in;
#pragma unroll
    for (int i = 0; i < 25; ++i) in.p[i] = args.in[i];
    for (int u = FRESH_TID(); u < (LDS_BYTES - LDSCTL_OFF) / 4; u += NWAVES * 64) ((LAS unsigned*)(lds + LDSCTL_OFF))[u] = 0u;
    __syncthreads();
    (void)xcd_barrier_post((unsigned*)(ws + WS_CTL) + CW_BAR + args.li * XCD_BAR_WORDS, MISC + 8);
    const int lo = args.ph_lo, hi = args.ph_hi;
    const int gw = vcu * NWAVES + wave, NGW = G * NWAVES;
#ifndef PH_DISABLE
#define PH_DISABLE 0
#endif
#if ALL_FUSED
#define IN(k) (!((PH_DISABLE >> (k)) & 1))
#else
#define IN(k) (lo <= (k) && (k) < hi && !((PH_DISABLE >> (k)) & 1))
#endif
#ifdef TIMING_A
#define STAMP(i) do { if (bx == 0 && FRESH_TID() == 0) __hip_atomic_store((unsigned long long*)(ws + WS_CTL + 512) + (i), __builtin_amdgcn_s_memrealtime(), __ATOMIC_RELAXED, __HIP_MEMORY_SCOPE_AGENT); } while (0)
#else
#define STAMP(i) do { } while (0)
#endif
#define SEAM(k) do { if (IN(k) && IN((k) + 1)) { XcdBarrier b_; b_.bar = (unsigned*)(args.ws + WS_CTL) + CW_BAR + args.li * XCD_BAR_WORDS; b_.x = xb_xcc_id(); b_.st = (volatile LAS unsigned*)(lds + LDSCTL_OFF) + 8;     \
        xcd_barrier(b_); STAMP((k) + 1); } } while (0)
#if ALL_FUSED
#define PP_PTR ((const bf16*)((const unsigned char*)out + 32 * MiB))
#define MP_PTR out
#else
#define PP_PTR ((const bf16*)(ws + WS_PP))
#define MP_PTR ((float*)(ws + WS_MP))
#endif
#define GEMM_PHASE(EPI, Aptr, Bptr, Kdim, LDA, M_, N_, SH, STR, ...) do { \
        pg8::Gemm g{(const pg8::bf16_t*)(Aptr), (const pg8::bf16_t*)(Bptr), Kdim, LDA, SH, STR}; pg8::StaticOrder S; S.init(M_, N_, G, (int)blockIdx.x); \
        EPI E{__VA_ARGS__}; pg8::gemm_phase<EPI, pg8::StaticOrder, true, true>(lds, g, S, E, wave); } while (0)

    STAMP(0);
    if (IN(0)) { p0_prologue(in, ws, lds, vcu, G, wave, FRESH_TID()); } SEAM(0);
    if (IN(1)) { GEMM_PHASE(EpiProj, ws + WS_R0, ws + WS_WIN, 1024, 1024, T_, INW, 0, 0, (const float*)(ws + WS_RSTD1), ws); } SEAM(1);
    if (IN(2)) {
        for (int it = bx; it < 256; it += G) attn_item(lds, (const bf16*)(ws + WS_QKV), in.p[I_SINK], (bf16*)(ws + WS_ATT), it, wave, FRESH_TID());
        conv_items((const bf16*)(ws + WS_LX), in.p[I_CONVW], in.p[I_CONVB], (bf16*)(ws + WS_R0), vcu, G, FRESH_TID());
    } SEAM(2);
#if LRU_PADDED == 2
    if (IN(3)) { GEMM_PHASE(EpiLru, ws + WS_R0, ws + WS_WAX, 128, 1024, T_, 2048, 0, 128,
#elif LRU_PADDED
    if (IN(3)) { GEMM_PHASE(EpiLru, ws + WS_R0, ws + WS_WAX, 256, 1024, T_, 2048, 1, 256,
#else
    if (IN(3)) { GEMM_PHASE(EpiLru, ws + WS_R0, ws + WS_WAXD, 1024, 1024, T_, 2048, 0, 0,
#endif
        (const bf16*)(ws + WS_R0), in.p[I_BA], in.p[I_BX], (const float*)(ws + WS_C8), (bf16*)(ws + WS_HLOC), (bf16*)(ws + WS_PCUM), (float*)(ws + WS_AGG)); }
    SEAM(3);
    if (IN(4)) { scan_finish((const bf16*)(ws + WS_HLOC), (const bf16*)(ws + WS_PCUM), (const float*)(ws + WS_AGG), (const bf16*)(ws + WS_GL), (bf16*)(ws + WS_R0), vcu, G, FRESH_TID()); }
#if !ALL_FUSED
    SEAM(4);
#endif
    if (IN(5)) { GEMM_PHASE(EpiMP, ws + WS_ATT, ws + WS_WUA, 512, 512, T_, 1024, 0, 0, (const bf16*)(ws + WS_SGA), MP_PTR); }
#if ALL_FUSED
    if (IN(13)) { pg8::Gemm g{(const pg8::bf16_t*)(ws + WS_PB), (const pg8::bf16_t*)(ws + WS_WPROJ), 256, 256, 0, 0}; pg8::StaticOrder S;
        if (G >= 256) S.init(T_, 1024, G - 128, (int)blockIdx.x >= 128 ? (int)blockIdx.x - 128 : (1 << 30)); else S.init(T_, 1024, G, (int)blockIdx.x);
        EpiPP E{(bf16*)((unsigned char*)out + 32 * MiB)}; pg8::gemm_phase<EpiPP, pg8::StaticOrder, true, true>(lds, g, S, E, wave); }
#endif
    SEAM(5);
    if (IN(6)) { GEMM_PHASE(EpiMerged, ws + WS_R0, ws + WS_WUL, 1024, 1024, T_, 1024, 0, 0, (const bf16*)(ws + WS_SGL), (const float*)MP_PTR, (bf16*)(ws + WS_MERGED)); } SEAM(6);
    if (IN(7)) { GEMM_PHASE(EpiH1, ws + WS_MERGED, ws + WS_WO, 1024, 1024, T_, 1024, 0, 0, in.p[I_X], out, (bf16*)(ws + WS_R0), (float*)(ws + WS_PART2)); }
    SEAM(7);
#define PEER_HALF(half) do { \
        if (IN(8 + 2 * (half))) { GEMM_PHASE(EpiScore, ws + WS_R0, ws + WS_WFOLD + (size_t)(half) * 1024 * 1024 * 2, 1024, 1024, T_, 1024, 0, 0, (const float*)(ws + WS_PART2), (float*)(ws + WS_SC)); } SEAM(8 + 2 * (half)); \
        if (IN(9 + 2 * (half))) { \
            for (int it = vcu; it < T_ / TK_TOK; it += G) topk_item((LAS float*)lds, (const float*)(ws + WS_SC), it, (half) * 4, (int*)(ws + WS_SELI), (float*)(ws + WS_SELG), FRESH_TID()); \
            if ((half) == 0) uv_convert(in.p[I_U], in.p[I_V], in.p[I_GFFN], ws + WS_U16, ws + WS_U16 + 16 * MiB, (float*)(ws + WS_USCALE), (float*)(ws + WS_USCALE) + 16384, gw, NGW, FRESH_LANE()); \
        } SEAM(9 + 2 * (half)); } while (0)
#if ALL_FUSED
    if (IN(8)) {
        for (int kk = 0; kk < 2; ++kk) { pg8::Gemm g{(const pg8::bf16_t*)(ws + WS_R0), (const pg8::bf16_t*)(ws + WS_WFOLD), 1024, 1024, 0, 0}; OneUnit S; S.S.init(T_, 2048, G, (int)blockIdx.x); S.k = kk;
            EpiTopk E{(const float*)(ws + WS_PART2), (int*)(ws + WS_SELI), (float*)(ws + WS_SELG), in.p[I_U], in.p[I_V], in.p[I_GFFN], ws + WS_U16, ws + WS_U16 + 16 * MiB, (float*)(ws + WS_USCALE), (float*)(ws + WS_USCALE) + 16384,
                      vcu * 16 + kk * 8, (2 * G == (T_ / 256) * 8) ? 16 * G : 0};
            pg8::gemm_phase<EpiTopk, OneUnit, false, true>(lds, g, S, E, wave); }
        if (2 * G != (T_ / 256) * 8) uv_convert(in.p[I_U], in.p[I_V], in.p[I_GFFN], ws + WS_U16, ws + WS_U16 + 16 * MiB, (float*)(ws + WS_USCALE), (float*)(ws + WS_USCALE) + 16384, gw, NGW, FRESH_LANE());
    } SEAM(11);
#else
    PEER_HALF(0);
    PEER_HALF(1);
#endif
    if (IN(12)) {
#ifdef PROBE_MODE
        for (int tok0 = vcu * 64; tok0 < T_; tok0 += G * 64)
#if GATHER_ROWS == 3
            gather_wg_mixed<PROBE_MODE>(tok0, wave, FRESH_LANE(), lds, ws + WS_U16, ws + WS_U16 + 16 * MiB, (const float*)(ws + WS_USCALE), (const float*)(ws + WS_USCALE) + 16384, (const int*)(ws + WS_SELI), (const float*)(ws + WS_SELG), (const float*)(ws + WS_PART2), (const bf16*)(ws + WS_R0), (bf16*)(ws + WS_H2B), (float*)(ws + WS_RSTD3), (float*)(ws + WS_SC));
#elif GATHER_ROWS == 1
            gather_wg_rows<PROBE_MODE>(tok0, wave, FRESH_LANE(), lds, ws + WS_U16, ws + WS_U16 + 16 * MiB, (const float*)(ws + WS_USCALE), (const float*)(ws + WS_USCALE) + 16384, (const int*)(ws + WS_SELI), (const float*)(ws + WS_SELG), (const float*)(ws + WS_PART2), (const bf16*)(ws + WS_R0), (bf16*)(ws + WS_H2B), (float*)(ws + WS_RSTD3), (float*)(ws + WS_SC));
#else
            gather_wg_sliced<PROBE_MODE>(tok0, wave, FRESH_LANE(), lds, ws + WS_U16, ws + WS_U16 + 16 * MiB, (const float*)(ws + WS_USCALE), (const float*)(ws + WS_USCALE) + 16384, (const int*)(ws + WS_SELI), (const float*)(ws + WS_SELG), (const float*)(ws + WS_PART2), out, (const bf16*)(ws + WS_R0), (bf16*)(ws + WS_H2B), (float*)(ws + WS_RSTD3), (float*)(ws + WS_SC));
#endif
        { XcdBarrier b_; b_.bar = (unsigned*)(args.ws + WS_CTL) + CW_BAR + args.li * XCD_BAR_WORDS; b_.x = xb_xcc_id(); b_.st = (volatile LAS unsigned*)(lds + LDSCTL_OFF) + 8; xcd_barrier(b_); STAMP(16); }
#endif
        for (int tok0 = vcu * 64; tok0 < T_; tok0 += G * 64)
#if GATHER_ROWS == 3
            gather_wg_mixed<0>(tok0, wave, FRESH_LANE(), lds, ws + WS_U16, ws + WS_U16 + 16 * MiB, (const float*)(ws + WS_USCALE), (const float*)(ws + WS_USCALE) + 16384, (const int*)(ws + WS_SELI), (const float*)(ws + WS_SELG), (const float*)(ws + WS_PART2), (const bf16*)(ws + WS_R0), (bf16*)(ws + WS_H2B), (float*)(ws + WS_RSTD3), nullptr);
#elif GATHER_ROWS == 1
            gather_wg_rows<0>(tok0, wave, FRESH_LANE(), lds, ws + WS_U16, ws + WS_U16 + 16 * MiB, (const float*)(ws + WS_USCALE), (const float*)(ws + WS_USCALE) + 16384, (const int*)(ws + WS_SELI), (const float*)(ws + WS_SELG), (const float*)(ws + WS_PART2), (const bf16*)(ws + WS_R0), (bf16*)(ws + WS_H2B), (float*)(ws + WS_RSTD3), nullptr);
#else
            gather_wg_sliced<0>(tok0, wave, FRESH_LANE(), lds, ws + WS_U16, ws + WS_U16 + 16 * MiB, (const float*)(ws + WS_USCALE), (const float*)(ws + WS_USCALE) + 16384, (const int*)(ws + WS_SELI), (const float*)(ws + WS_SELG), (const float*)(ws + WS_PART2), out, (const bf16*)(ws + WS_R0), (bf16*)(ws + WS_H2B), (float*)(ws + WS_RSTD3), nullptr);
#endif
    } SEAM(12);
#if !ALL_FUSED
    if (IN(13)) { GEMM_PHASE(EpiPP, ws + WS_PB, ws + WS_WPROJ, 256, 256, T_, 1024, 0, 0, (bf16*)(ws + WS_PP)); } SEAM(13);
#endif
#if ALL_FUSED && FUSE_FINAL
    if (IN(14)) { GEMM_PHASE(EpiH3Final, ws + WS_H2B, ws + WS_WG, 1024, 1024, T_, 1024, 0, 0, (const float*)(ws + WS_RSTD3), PP_PTR, (const bf16*)(ws + WS_H2B), in.p[I_FG], out, (float*)(ws + WS_PART4), (unsigned*)(ws + WS_CTL) + 65536); }
#else
    if (IN(14)) { GEMM_PHASE(EpiH3, ws + WS_H2B, ws + WS_WG, 1024, 1024, T_, 1024, 0, 0, (const float*)(ws + WS_RSTD3), PP_PTR, out, (float*)(ws + WS_PART4), (const bf16*)(ws + WS_H2B), (bf16*)(ws + WS_R0)); } SEAM(14);
#ifdef TIMING_A
    float tscale = 1.0f;
    { const unsigned long long ta = __hip_atomic_load((unsigned long long*)(ws + WS_CTL + 512) + TIMING_A, __ATOMIC_RELAXED, __HIP_MEMORY_SCOPE_AGENT), tb = __hip_atomic_load((unsigned long long*)(ws + WS_CTL + 512) + TIMING_B, __ATOMIC_RELAXED, __HIP_MEMORY_SCOPE_AGENT);
      tscale = 1.0f + (float)(tb - ta) * 0.01f * (float)(TIMING_K); }
    if (IN(15)) { final_rows(out, (const bf16*)(ws + WS_R0), (const float*)(ws + WS_PART4), in.p[I_FG], gw, NGW, FRESH_LANE(), tscale); }
#else
    if (IN(15)) { final_rows(out, (const bf16*)(ws + WS_R0), (const float*)(ws + WS_PART4), in.p[I_FG], gw, NGW, FRESH_LANE(), 1.0f); }
#endif
#endif
#undef IN
#undef SEAM
#undef GEMM_PHASE
}
static const int GRP_LO[11] = {0, 2, 3, 5, 6, 7, 8, 12, 13, 14, 15};
static const int GRP_HI[11] = {2, 3, 5, 6, 7, 8, 12, 13, 14, 15, 16};

static void naive_group(int grp, void* const* d_in, float* out, unsigned char* ws, hipStream_t st) {
    const float* x = (const float*)d_in[0]; const float* p = (const float*)d_in[1]; const float* g_mix = (const float*)d_in[2]; const float* w_in = (const float*)d_in[3];
    const float* sink = (const float*)d_in[4]; const float* conv_w = (const float*)d_in[5]; const float* conv_b = (const float*)d_in[6];
    const float* wa = (const float*)d_in[7]; const float* ba = (const float*)d_in[8]; const float* wx = (const float*)d_in[9]; const float* bx = (const float*)d_in[10]; const float* lam = (const float*)d_in[11];
    const float* w_ua = (const float*)d_in[12]; const float* w_ul = (const float*)d_in[13]; const float* w_o = (const float*)d_in[14]; const float* g_ffn = (const float*)d_in[15];
    const float* wq = (const float*)d_in[16]; const float* k1 = (const float*)d_in[17]; const float* k2 = (const float*)d_in[18]; const float* pu = (const float*)d_in[19]; const float* pv = (const float*)d_in[20];
    const float* g_ple = (const float*)d_in[21]; const float* w_gate = (const float*)d_in[22]; const float* w_proj = (const float*)d_in[23]; const float* final_g = (const float*)d_in[24];
    float* rstd1 = (float*)(ws + WS_RSTD1); float* part2 = (float*)(ws + WS_PART2); float* part4 = (float*)(ws + WS_PART4); float* rstd3 = (float*)(ws + WS_RSTD3);
    bf16* qkv = (bf16*)(ws + WS_QKV); bf16* lx = (bf16*)(ws + WS_LX); bf16* gl = (bf16*)(ws + WS_GL); bf16* sga = (bf16*)(ws + WS_SGA); bf16* sgl = (bf16*)(ws + WS_SGL);
    bf16* att = (bf16*)(ws + WS_ATT); bf16* r0 = (bf16*)(ws + WS_R0); float* mp = (float*)(ws + WS_MP); bf16* merged = (bf16*)(ws + WS_MERGED);
    float* sc = (float*)(ws + WS_SC); int* seli = (int*)(ws + WS_SELI); float* selg = (float*)(ws + WS_SELG); bf16* h2b = (bf16*)(ws + WS_H2B); bf16* pp = (bf16*)(ws + WS_PP);
    float* tmpf = (float*)(ws + WS_NAIVE_AB);
    switch (grp) {
    case 0:
        hipLaunchKernelGGL(nv::rowsq, dim3(T_ / 4), dim3(256), 0, st, x, rstd1, (float*)nullptr);
        nv::run_gemm<nv::ALf32, nv::EpiProj, false>(st, nv::ALf32{x, 1024}, w_in, INW, g_mix, T_, INW, 1024, nv::EpiProj{rstd1, qkv, lx, gl, sga, sgl});
        break;
    case 1:
        hipLaunchKernelGGL(nv::attn_naive, dim3(T_ * 8 / 128), dim3(128), 0, st, qkv, sink, att);
        hipLaunchKernelGGL(nv::conv_naive, dim3(T_ * 1024 / 256), dim3(256), 0, st, lx, conv_w, conv_b, r0);
        break;
    case 2:
        hipLaunchKernelGGL(nv::lru_ab_naive, dim3(T_ * 8), dim3(128), 0, st, r0, wa, ba, wx, bx, lam, out, tmpf);
        hipLaunchKernelGGL(nv::lru_scan_naive, dim3(B_ * 1024 / 64), dim3(64), 0, st, out, tmpf, gl, r0);
        break;
    case 3: nv::run_gemm<nv::ALbf16, nv::EpiMP, false>(st, nv::ALbf16{att, 512}, w_ua, 1024, nullptr, T_, 1024, 512, nv::EpiMP{sga, mp}); break;
    case 4: nv::run_gemm<nv::ALbf16, nv::EpiMerged, false>(st, nv::ALbf16{r0, 1024}, w_ul, 1024, nullptr, T_, 1024, 1024, nv::EpiMerged{sgl, mp, merged}); break;
    case 5:
        nv::run_gemm<nv::ALbf16, nv::EpiH1, false>(st, nv::ALbf16{merged, 1024}, w_o, 1024, nullptr, T_, 1024, 1024, nv::EpiH1{x, out, r0});
        hipLaunchKernelGGL(nv::rowsq, dim3(T_ / 4), dim3(256), 0, st, out, (float*)nullptr, part2);
        break;
    case 6:
        for (int half = 0; half < 2; ++half) {
            nv::run_gemm<nv::ALf32, nv::EpiScaleF32, false>(st, nv::ALf32{out, 1024}, wq + half * 1024, 2048, g_ffn, T_, 1024, 1024, nv::EpiScaleF32{part2, tmpf, 1024});
            for (int hl = 0; hl < 4; ++hl)
                for (int hf = 0; hf < 2; ++hf)
                    nv::run_gemm<nv::ALf32, nv::EpiPlainF32, true>(st, nv::ALf32{tmpf + hl * 256 + hf * 128, 1024}, hf ? k2 : k1, 128, nullptr, T_, 128, 128, nv::EpiPlainF32{sc + hl * 256 + hf * 128, 1024});
            hipLaunchKernelGGL(topk_kernel, dim3(T_ / TK_TOK), dim3(512), TK_LDS_BYTES, st, sc, half * 4, seli, selg);
        }
        break;
    case 7: hipLaunchKernelGGL(gather_kernel<0>, dim3(1024), dim3(256), 0, st, (const void*)pu, (const void*)pv, g_ffn, seli, selg, part2, out, h2b, rstd3); break;
    case 8: nv::run_gemm<nv::ALf32, nv::EpiPP, false>(st, nv::ALf32{p, 256}, w_proj, 1024, nullptr, T_, 1024, 256, nv::EpiPP{pp}); break;
    case 9: nv::run_gemm<nv::ALbf16, nv::EpiH3, false>(st, nv::ALbf16{h2b, 1024}, w_gate, 1024, g_ple, T_, 1024, 1024, nv::EpiH3{rstd3, pp, out});
        hipLaunchKernelGGL(nv::rowsq, dim3(T_ / 4), dim3(256), 0, st, out, (float*)nullptr, part4);
        break;
    case 10: hipLaunchKernelGGL(nv::final_norm, dim3(T_ / 4), dim3(256), 0, st, out, part4, final_g); break;
    }
}

extern "C" void kernel_launch(void* const* d_in, const int* in_sizes, int n_in, void* d_out, int out_size, void* d_ws, size_t ws_size, hipStream_t stream) {
    static int grid = 0;
    if (grid == 0) {
        if (n_in != 25 || out_size != T_ * 1024 || ws_size < WS_END) { fprintf(stderr, "kernel_launch: unexpected sizes n_in %d out %d ws %zu\n", n_in, out_size, ws_size); }
        (void)hipFuncSetAttribute((const void*)topk_kernel, hipFuncAttributeMaxDynamicSharedMemorySize, TK_LDS_BYTES);
        int dev = 0, cus = 0, per_cu = 0;
        (void)hipGetDevice(&dev); (void)hipDeviceGetAttribute(&cus, hipDeviceAttributeMultiprocessorCount, dev);
        if (hipFuncSetAttribute((const void*)fused_fwd, hipFuncAttributeMaxDynamicSharedMemorySize, LDS_BYTES) != hipSuccess) fprintf(stderr, "kernel_launch: hipFuncSetAttribute(fused_fwd) failed\n");
        if (hipOccupancyMaxActiveBlocksPerMultiprocessor(&per_cu, (const void*)fused_fwd, NWAVES * 64, LDS_BYTES) != hipSuccess || per_cu < 1) fprintf(stderr, "kernel_launch: occupancy query says %d blocks/CU\n", per_cu);
        (void)hipGetLastError();
        grid = cus > 0 ? cus : 256;
    }
    unsigned char* ws = (unsigned char*)d_ws; float* out = (float*)d_out;
    const unsigned mask = FUSED_MASK;
    if (mask) (void)hipMemsetAsync(ws + WS_CTL, 0, CTL_ZERO_BYTES, stream);
    Args a{};
    for (int i = 0; i < 25; ++i) a.in[i] = (const float*)d_in[i];
    a.out = out; a.ws = ws;
    int li = 0;
    auto launch = [&](int lo, int hi) {
        if (MERGE_LAUNCHES) { a.ph_lo = lo; a.ph_hi = hi; a.li = li++; hipLaunchKernelGGL(fused_fwd, dim3(grid), dim3(NWAVES * 64), LDS_BYTES, stream, a); }
        else for (int ph = lo; ph < hi; ++ph) { a.ph_lo = ph; a.ph_hi = ph + 1; a.li = li++; hipLaunchKernelGGL(fused_fwd, dim3(grid), dim3(NWAVES * 64), LDS_BYTES, stream, a); }
    };
    int pend_lo = -1, pend_hi = -1;
    if (mask && !(mask & 1)) launch(0, 1);
    for (int gidx = 0; gidx < 11; ++gidx) {
#if (defined(LRU_T2) && LRU_T2) || (defined(LRU_T3) && LRU_T3)
        if (gidx == 2 && (mask & 4u)) {
            if (pend_lo >= 0) { launch(pend_lo, pend_hi); pend_lo = -1; }
            launch(3, 4);
            hipLaunchKernelGGL(nv::lru_finish_naive_L<(LRU_T2 ? 16 : 64)>, dim3(B_ * 1024 / 64), dim3(64), 0, stream, (const bf16*)(ws + WS_HLOC), (const bf16*)(ws + WS_PCUM), (const bf16*)(ws + WS_GL), (bf16*)(ws + WS_R0));
            continue;
        }
#endif
        if (mask & (1u << gidx)) {
            if (pend_lo < 0) { pend_lo = GRP_LO[gidx]; pend_hi = GRP_HI[gidx]; } else pend_hi = GRP_HI[gidx];
        } else {
            if (pend_lo >= 0) { launch(pend_lo, pend_hi); pend_lo = -1; }
            naive_group(gidx, d_in, out, ws, stream);
        }
    }
    if (pend_lo >= 0) launch(pend_lo, pend_hi);
#if defined(LRU_DEBUG) && LRU_DEBUG == 2
    hipLaunchKernelGGL(nv::poison_if, dim3(T_ * 1024 / 256), dim3(256), 0, stream, out, (const unsigned*)(ws + WS_CTL) + 64);
#endif
}
```

```cpp
#include <hip/hip_runtime.h>
#include <cstdio>
#include <cstdint>
#include <cmath>

#ifndef FUSED_MASK
#define FUSED_MASK 0x7ff
#endif
#ifndef MERGE_LAUNCHES
#define MERGE_LAUNCHES 1
#endif
#ifndef LRU_PADDED
#define LRU_PADDED 1
#endif
#ifndef FUSE_FINAL
#define FUSE_FINAL 0
#endif
#ifndef GATHER_ROWS
#define GATHER_ROWS 3
#endif
#ifndef MIX_PIPE
#define MIX_PIPE 1
#endif
#ifndef V_FP6
#define V_FP6 1
#endif
#define ALL_FUSED ((FUSED_MASK) == 0x7ff && (MERGE_LAUNCHES))
constexpr int B_ = 8, S_ = 2048, D_ = 1024, T_ = B_ * S_;
constexpr int INW = 4864;
constexpr float EPS = 1e-6f;
typedef unsigned short bf16;
typedef unsigned u32x3 __attribute__((ext_vector_type(3)));
#define HD_INLINE __host__ __device__ __forceinline__

constexpr size_t MiB = 1u << 20;
constexpr size_t WS_CTL = 0;
constexpr size_t WS_WIN = 1 * MiB;
constexpr size_t WS_WUA = WS_WIN + 4864 * 1024 * 2;
constexpr size_t WS_WUL = WS_WUA + 1 * MiB;
constexpr size_t WS_WO = WS_WUL + 2 * MiB;
constexpr size_t WS_WFOLD = WS_WO + 2 * MiB;
constexpr size_t WS_WG = WS_WFOLD + 4 * MiB;
constexpr size_t WS_WPROJ = WS_WG + 2 * MiB;
constexpr size_t WS_WAX = WS_WPROJ + MiB / 2;
constexpr size_t WS_W_END = WS_WAX + 1 * MiB;
static_assert(WS_W_END <= 23 * MiB, "weights");
constexpr size_t WS_RSTD1 = 23 * MiB;
constexpr size_t WS_PART2 = WS_RSTD1 + 256 * 1024;
constexpr size_t WS_PART4 = WS_PART2 + 1 * MiB;
constexpr size_t WS_RSTD3 = WS_PART4 + 1 * MiB;
constexpr size_t WS_AGG = WS_RSTD3 + 256 * 1024;
constexpr size_t WS_C8 = WS_AGG + 2 * MiB;
constexpr size_t WS_USCALE = WS_C8 + 64 * 1024;
static_assert(WS_USCALE + 128 * 1024 <= 28 * MiB, "small");
constexpr size_t WS_PB = 28 * MiB;
constexpr size_t WS_R0 = 36 * MiB;
constexpr size_t WS_QKV = 68 * MiB;
constexpr size_t WS_LX = 92 * MiB;
constexpr size_t WS_GL = 140 * MiB;
constexpr size_t WS_SGA = 172 * MiB;
constexpr size_t WS_SGL = 204 * MiB;
constexpr size_t WS_ATT = 236 * MiB;
constexpr size_t WS_HLOC = 68 * MiB, WS_PCUM = 100 * MiB;
constexpr size_t WS_MP = 68 * MiB;
constexpr size_t WS_MERGED = 140 * MiB;
constexpr size_t WS_SC = 172 * MiB;
constexpr size_t WS_SELI = 236 * MiB, WS_SELG = 244 * MiB;
constexpr size_t WS_U16 = 68 * MiB, WS_V16 = 100 * MiB;
constexpr size_t WS_H2B = 140 * MiB;
constexpr size_t WS_PP = 172 * MiB;
constexpr size_t WS_NAIVE_AB = 68 * MiB;
constexpr size_t WS_WAXD = 252 * MiB;
constexpr size_t WS_END = 256 * MiB;

HD_INLINE float bf2f(bf16 v) { return __builtin_bit_cast(float, (unsigned)v << 16); }
HD_INLINE bf16 f2bf(float f) { unsigned u = __builtin_bit_cast(unsigned, f); return (bf16)((u + 0x7fffu + ((u >> 16) & 1u)) >> 16); }
HD_INLINE unsigned pk2(float lo, float hi) { return (unsigned)f2bf(lo) | ((unsigned)f2bf(hi) << 16); }
__device__ __forceinline__ float wave_sum(float v) {
#pragma unroll
    for (int o = 1; o < 64; o <<= 1) v += __shfl_xor(v, o);
    return v;
}
__device__ __forceinline__ float sigmoidf_(float z) { return __builtin_amdgcn_rcpf(1.0f + __builtin_amdgcn_exp2f(-1.4426950408889634f * z)); }
__device__ __forceinline__ float gelu_tanh(float x) { const float u = 1.5957691216057308f * (x + 0.044715f * x * x * x); return x * sigmoidf_(u); }
__device__ __forceinline__ int fresh_lane() { int l; asm volatile("v_mbcnt_lo_u32_b32 %0, -1, 0\n\tv_mbcnt_hi_u32_b32 %0, -1, %0" : "=v"(l)); return l; }
#ifndef HD_INLINE
#define HD_INLINE __host__ __device__ __forceinline__
#endif

HD_INLINE unsigned tk_umax(unsigned a, unsigned b) { return a > b ? a : b; }
HD_INLINE unsigned tk_umin(unsigned a, unsigned b) { return a < b ? a : b; }
HD_INLINE unsigned tk_f2key(float f) { unsigned u = __builtin_bit_cast(unsigned, f); return u ^ ((unsigned)((int)u >> 31) | 0x80000000u); }
HD_INLINE float tk_key2f(unsigned k) { unsigned u = (k & 0x80000000u) ? (k ^ 0x80000000u) : ~k; return __builtin_bit_cast(float, u); }

HD_INLINE void tk_sort16(unsigned (&a)[16]) {
#pragma unroll
    for (int k = 2; k <= 16; k <<= 1) {
#pragma unroll
        for (int j = k >> 1; j > 0; j >>= 1) {
#pragma unroll
            for (int i = 0; i < 16; ++i) {
                const int p = i ^ j;
                if (p > i) {
                    const unsigned mx = tk_umax(a[i], a[p]), mn = tk_umin(a[i], a[p]);
                    if ((i & k) == 0) { a[i] = mx; a[p] = mn; } else { a[i] = mn; a[p] = mx; }
                }
            }
        }
    }
}
HD_INLINE void tk_merge16(unsigned (&a)[16], const unsigned (&b)[16]) {
#pragma unroll
    for (int i = 0; i < 16; ++i) a[i] = tk_umax(a[i], b[15 - i]);
#pragma unroll
    for (int j = 8; j > 0; j >>= 1) {
#pragma unroll
        for (int i = 0; i < 16; ++i) {
            const int p = i ^ j;
            if (p > i) { const unsigned mx = tk_umax(a[i], a[p]), mn = tk_umin(a[i], a[p]); a[i] = mx; a[p] = mn; }
        }
    }
}
HD_INLINE void tk_insert16(unsigned (&best)[16], unsigned key) {
#pragma unroll
    for (int s = 0; s < 16; ++s) { const unsigned hi = tk_umax(best[s], key); key = tk_umin(best[s], key); best[s] = hi; }
}
HD_INLINE void tk_combine_store(const unsigned (&k1)[16], const unsigned (&k2)[16], int* oi, float* og) {
    float v1[16], v2[16];
#pragma unroll
    for (int i = 0; i < 16; ++i) { v1[i] = tk_key2f(k1[i] & ~127u); v2[i] = tk_key2f(k2[i] & ~127u); }
    unsigned best[16];
#pragma unroll
    for (int s = 0; s < 16; ++s) best[s] = 0u;
#pragma unroll
    for (int i = 0; i < 16; ++i) {
#pragma unroll
        for (int j = 0; j < 16; ++j) {
            if ((i + 1) * (j + 1) <= 16) {
                const float s = v1[i] + v2[j];
                const unsigned key = (tk_f2key(s) & ~255u) | (unsigned)(255 - (i * 16 + j));
                tk_insert16(best, key);
            }
        }
    }
    const unsigned thr = best[15];
    const float mx = tk_key2f(best[0] & ~255u);
    float sum = 0.f;
#pragma unroll
    for (int i = 0; i < 16; ++i) {
#pragma unroll
        for (int j = 0; j < 16; ++j) {
            if ((i + 1) * (j + 1) <= 16) {
                const float s = v1[i] + v2[j];
                const unsigned key = (tk_f2key(s) & ~255u) | (unsigned)(255 - (i * 16 + j));
                if (key >= thr) sum += __builtin_expf(s - mx);
            }
        }
    }
    const float inv = 1.0f / sum;
    int cnt = 0;
#pragma unroll
    for (int i = 0; i < 16; ++i) {
#pragma unroll
        for (int j = 0; j < 16; ++j) {
            if ((i + 1) * (j + 1) <= 16) {
                const float s = v1[i] + v2[j];
                const unsigned key = (tk_f2key(s) & ~255u) | (unsigned)(255 - (i * 16 + j));
                if (key >= thr) {
                    oi[cnt] = (127 - (int)(k1[i] & 127u)) * 128 + (127 - (int)(k2[j] & 127u));
                    og[cnt] = __builtin_expf(s - mx) * inv;
                    ++cnt;
                }
            }
        }
    }
}

HD_INLINE unsigned tk_ckey(float s, unsigned odd64, int i, int j) { return ((tk_f2key(s) & ~255u) | (unsigned)(255 - (i * 16 + j))) - odd64; }
HD_INLINE void tk_pair_partial(const unsigned (&own)[16], const unsigned (&oth)[16], bool odd, unsigned (&r0)[16]) {
    float va[4], vb[16];
    const unsigned odd64 = odd ? 64u : 0u;
#pragma unroll
    for (int i = 0; i < 4; ++i) va[i] = tk_key2f(own[i] & ~127u);
#pragma unroll
    for (int j = 0; j < 16; ++j) vb[j] = tk_key2f(oth[j] & ~127u);
#pragma unroll
    for (int j = 1; j < 16; ++j) r0[j - 1] = tk_ckey(va[0] + vb[j], odd64, 0, j);
    r0[15] = 0u;
    unsigned l2[16];
#pragma unroll
    for (int j = 2; j < 8; ++j) l2[j - 2] = tk_ckey(va[1] + vb[j], odd64, 1, j);
    l2[6] = tk_ckey(va[2] + vb[3], odd64, 2, 3); l2[7] = tk_ckey(va[2] + vb[4], odd64, 2, 4);
#pragma unroll
    for (int d = 0; d < 4; ++d) { const unsigned k = tk_ckey(va[d] + vb[d], 0u, d, d); l2[8 + d] = odd ? 0u : k; }
#pragma unroll
    for (int d = 12; d < 16; ++d) l2[d] = 0u;
    tk_sort16(l2);
    tk_merge16(r0, l2);
}
HD_INLINE void tk_decode(unsigned key, int& i1, int& i2) { const int code = 255 - (int)(key & 255u); const int i = (code >> 4) & 3, j = code & 15; const bool po = (code >> 6) & 1; i1 = po ? j : i; i2 = po ? i : j; }
namespace nv {
struct ALf32 { const float* p; int lda; int pad; __device__ __forceinline__ float operator()(int m, int k) const { return p[(size_t)m * lda + k]; } };
struct ALbf16 { const bf16* p; int lda; int pad; __device__ __forceinline__ float operator()(int m, int k) const { return bf2f(p[(size_t)m * lda + k]); } };

template <class AL, class EPI, bool BT>
__global__ void __launch_bounds__(256) ngemm(AL al, const float* __restrict__ B, int ldb, const float* __restrict__ ks, int M, int N, int K, EPI epi) {
    __shared__ float As[16][68];
    __shared__ float Bs[16][68];
    const int tid = threadIdx.x, tx = tid & 15, ty = tid >> 4;
    const int m0 = blockIdx.y * 64, n0 = blockIdx.x * 64;
    float acc[4][4];
#pragma unroll
    for (int i = 0; i < 4; ++i)
#pragma unroll
        for (int j = 0; j < 4; ++j) acc[i][j] = 0.f;
    for (int k0 = 0; k0 < K; k0 += 16) {
#pragma unroll
        for (int i = 0; i < 4; ++i) {
            const int e = tid + i * 256;
            { const int m = e >> 4, k = e & 15; float v = al(m0 + m, k0 + k); if (ks) v *= ks[k0 + k]; As[k][m] = v; }
            if (BT) { const int n = e >> 4, k = e & 15; Bs[k][n] = B[(size_t)(n0 + n) * ldb + k0 + k]; }
            else { const int k = e >> 6, n = e & 63; Bs[k][n] = B[(size_t)(k0 + k) * ldb + n0 + n]; }
        }
        __syncthreads();
#pragma unroll
        for (int k = 0; k < 16; ++k) {
            float a[4], b[4];
#pragma unroll
            for (int i = 0; i < 4; ++i) { a[i] = As[k][ty * 4 + i]; b[i] = Bs[k][tx * 4 + i]; }
#pragma unroll
            for (int i = 0; i < 4; ++i)
#pragma unroll
                for (int j = 0; j < 4; ++j) acc[i][j] = fmaf(a[i], b[j], acc[i][j]);
        }
        __syncthreads();
    }
#pragma unroll
    for (int i = 0; i < 4; ++i)
#pragma unroll
        for (int j = 0; j < 4; ++j) epi(m0 + ty * 4 + i, n0 + tx * 4 + j, acc[i][j]);
}
template <class AL, class EPI, bool BT>
static void run_gemm(hipStream_t st, AL al, const float* B, int ldb, const float* ks, int M, int N, int K, EPI epi) {
    hipLaunchKernelGGL((ngemm<AL, EPI, BT>), dim3(N / 64, M / 64), dim3(256), 0, st, al, B, ldb, ks, M, N, K, epi);
}

__global__ void __launch_bounds__(256) rowsq(const float* __restrict__ X, float* rstd, float* part) {
    const int row = blockIdx.x * 4 + (threadIdx.x >> 6), lane = threadIdx.x & 63;
    const float* xr = X + (size_t)row * 1024;
    float s = 0.f;
    for (int j = 0; j < 16; ++j) { const float v = xr[lane + 64 * j]; s += v * v; }
    s = wave_sum(s);
    if (rstd && lane == 0) rstd[row] = 1.0f / sqrtf(s * (1.0f / 1024.0f) + EPS);
    if (part && lane < 16) part[(size_t)row * 16 + lane] = (lane == 0) ? s : 0.f;
}

struct EpiProj {
    const float* rstd; bf16 *qkv, *lx, *gl, *sga, *sgl;
    __device__ __forceinline__ void operator()(int m, int n, float v) const {
        v *= rstd[m];
        if (n < 768) qkv[(size_t)m * 768 + n] = f2bf(v);
        else if (n < 1792) lx[(size_t)m * 1024 + (n - 768)] = f2bf(v);
        else if (n < 2816) gl[(size_t)m * 1024 + (n - 1792)] = f2bf(gelu_tanh(v));
        else if (n < 3840) sga[(size_t)m * 1024 + (n - 2816)] = f2bf(sigmoidf_(v));
        else sgl[(size_t)m * 1024 + (n - 3840)] = f2bf(sigmoidf_(v));
    }
};

__global__ void __launch_bounds__(128) attn_naive(const bf16* __restrict__ qkv, const float* __restrict__ sink, bf16* __restrict__ att) {
    const int gid = blockIdx.x * 128 + threadIdx.x;
    const int head = gid / T_, t = gid % T_;
    const int b = t / S_, ts = t % S_;
    const int g = head >> 2;
    float q[64], acc[64];
    const bf16* qp = qkv + (size_t)t * 768 + head * 64;
#pragma unroll
    for (int d = 0; d < 64; ++d) { q[d] = bf2f(qp[d]); acc[d] = 0.f; }
    const float slope = exp2f(-(float)(head + 1));
    float m = -3.0e38f, l = 0.f;
    for (int dist = 127; dist >= 0; --dist) {
        const int s = ts - dist; if (s < 0) continue;
        const bf16* kp = qkv + (size_t)(b * S_ + s) * 768 + 512 + g * 64;
        const bf16* vp = kp + 128;
        float sc = 0.f;
#pragma unroll
        for (int d = 0; d < 64; ++d) sc = fmaf(q[d], bf2f(kp[d]), sc);
        sc = sc * 0.125f - slope * (float)dist;
        const float mn = fmaxf(m, sc), corr = __expf(m - mn), p = __expf(sc - mn);
        l = l * corr + p;
#pragma unroll
        for (int d = 0; d < 64; ++d) acc[d] = acc[d] * corr + p * bf2f(vp[d]);
        m = mn;
    }
    const float sk = sink[head];
    const float mf = fmaxf(m, sk), corr = __expf(m - mf);
    l = l * corr + __expf(sk - mf);
    const float inv = corr / l;
    bf16* op = att + (size_t)t * 512 + head * 64;
#pragma unroll
    for (int d = 0; d < 64; ++d) op[d] = f2bf(acc[d] * inv);
}

__global__ void __launch_bounds__(256) conv_naive(const bf16* __restrict__ lx, const float* __restrict__ cw, const float* __restrict__ cb, bf16* __restrict__ lin) {
    const size_t i = (size_t)blockIdx.x * 256 + threadIdx.x;
    const int c = (int)(i & 1023); const int t = (int)(i >> 10); const int ts = t % S_;
    float y = cb[c];
#pragma unroll
    for (int tap = 0; tap < 4; ++tap) { const int s = ts - 3 + tap; if (s >= 0) y = fmaf(bf2f(lx[(size_t)(t - 3 + tap) * 1024 + c]), cw[tap * 1024 + c], y); }
    lin[i] = f2bf(y);
}

__global__ void __launch_bounds__(128) lru_ab_naive(const bf16* __restrict__ lin, const float* __restrict__ wa, const float* __restrict__ ba, const float* __restrict__ wx, const float* __restrict__ bx,
                                                    const float* __restrict__ lam, float* __restrict__ Af, float* __restrict__ Bf) {
    __shared__ float xs[128];
    const int t = blockIdx.x >> 3, blk = blockIdx.x & 7, d = threadIdx.x, ch = blk * 128 + d;
    xs[d] = bf2f(lin[(size_t)t * 1024 + ch]);
    __syncthreads();
    float r = ba[ch], ii = bx[ch];
    const float* wap = wa + (size_t)blk * 128 * 128 + d; const float* wxp = wx + (size_t)blk * 128 * 128 + d;
    for (int c = 0; c < 128; ++c) { r = fmaf(xs[c], wap[c * 128], r); ii = fmaf(xs[c], wxp[c * 128], ii); }
    r = sigmoidf_(r); ii = sigmoidf_(ii);
    const float sp = log1pf(expf(-lam[ch]));
    const float loga = -8.0f * r * sp;
    const float a = expf(loga);
    const float bb = sqrtf(-expm1f(2.0f * loga)) * (ii * xs[d]);
    Af[(size_t)t * 1024 + ch] = a; Bf[(size_t)t * 1024 + ch] = bb;
}
__global__ void __launch_bounds__(256) lru_ab_from_pre(const bf16* __restrict__ lin, const float* __restrict__ ba, const float* __restrict__ bx, const float* __restrict__ lam, float* __restrict__ Af, float* __restrict__ Bf) {
    const size_t i = (size_t)blockIdx.x * 256 + threadIdx.x; const int ch = (int)(i & 1023);
    const float r = sigmoidf_(Af[i] + ba[ch]), ii = sigmoidf_(Bf[i] + bx[ch]);
    const float loga = -8.0f * r * log1pf(expf(-lam[ch]));
    Af[i] = expf(loga); Bf[i] = sqrtf(-expm1f(2.0f * loga)) * (ii * bf2f(lin[i]));
}
template <int L>
__global__ void __launch_bounds__(64) lru_finish_naive_L(const bf16* __restrict__ hloc, const bf16* __restrict__ pcum, const bf16* __restrict__ gl, bf16* __restrict__ rec) {
    const int gid = blockIdx.x * 64 + threadIdx.x; const int b = gid >> 10, ch = gid & 1023;
    float carry = 0.f;
    for (int c = 0; c < S_ / L; ++c) {
        float la = 1.f, lb = 0.f;
        for (int s = 0; s < L; ++s) { const size_t o = (size_t)(b * S_ + c * L + s) * 1024 + ch; la = bf2f(pcum[o]); lb = bf2f(hloc[o]); const float h = la * carry + lb; rec[o] = f2bf(h * bf2f(gl[o])); }
        carry = la * carry + lb;
    }
}
__global__ void __launch_bounds__(64) lru_finish_naive(const bf16* __restrict__ hloc, const bf16* __restrict__ pcum, const float* __restrict__ agg, const bf16* __restrict__ gl, bf16* __restrict__ rec) {
    const int gid = blockIdx.x * 64 + threadIdx.x; const int b = gid >> 10, ch = gid & 1023;
    float carry = 0.f;
    for (int c = 0; c < 32; ++c) {
        const int chunk = b * 32 + c;
        for (int s = 0; s < 64; ++s) { const size_t o = (size_t)(chunk * 64 + s) * 1024 + ch; const float h = bf2f(pcum[o]) * carry + bf2f(hloc[o]); rec[o] = f2bf(h * bf2f(gl[o])); }
        const float* ap = agg + ((size_t)chunk * 1024 + ch) * 2; carry = ap[0] * carry + ap[1];
    }
}
__global__ void __launch_bounds__(128) lru_pre_check(const bf16* __restrict__ lin, const float* __restrict__ wa, const float* __restrict__ wx, const float* __restrict__ Rp, const float* __restrict__ Ip, unsigned* flag) {
    __shared__ float xs[128];
    const int t = blockIdx.x >> 3, blk = blockIdx.x & 7, d = threadIdx.x, ch = blk * 128 + d;
    xs[d] = bf2f(lin[(size_t)t * 1024 + ch]);
    __syncthreads();
    float r = 0.f, ii = 0.f;
    const float* wap = wa + (size_t)blk * 128 * 128 + d; const float* wxp = wx + (size_t)blk * 128 * 128 + d;
    for (int c = 0; c < 128; ++c) { r = fmaf(xs[c], wap[c * 128], r); ii = fmaf(xs[c], wxp[c * 128], ii); }
    const float dr = fabsf(r - Rp[(size_t)t * 1024 + ch]), di = fabsf(ii - Ip[(size_t)t * 1024 + ch]);
    if (!(dr < 0.08f + 0.03f * fabsf(r)) || !(di < 0.08f + 0.03f * fabsf(ii))) atomicAdd(flag, 1u);
}
__global__ void __launch_bounds__(256) poison_if(float* out, const unsigned* flag) { if (*flag) { const size_t i = (size_t)blockIdx.x * 256 + threadIdx.x; out[i] = out[i] * 50.0f + 3.0f; } }
__global__ void __launch_bounds__(64) lru_scan_naive(const float* __restrict__ Af, const float* __restrict__ Bf, const bf16* __restrict__ gl, bf16* __restrict__ rec) {
    const int gid = blockIdx.x * 64 + threadIdx.x; const int b = gid >> 10, ch = gid & 1023;
    float h = 0.f;
    for (int s = 0; s < S_; ++s) { const size_t o = (size_t)(b * S_ + s) * 1024 + ch; h = fmaf(Af[o], h, Bf[o]); rec[o] = f2bf(h * bf2f(gl[o])); }
}

struct EpiMP { const bf16* sga; float* mp; __device__ __forceinline__ void operator()(int m, int n, float v) const { const size_t o = (size_t)m * 1024 + n; mp[o] = v * bf2f(sga[o]); } };
struct EpiMerged { const bf16* sgl; const float* mp; bf16* merged; __device__ __forceinline__ void operator()(int m, int n, float v) const { const size_t o = (size_t)m * 1024 + n; merged[o] = f2bf(mp[o] + v * bf2f(sgl[o])); } };
struct EpiH1 { const float* x; float* h1; bf16* h1b; __device__ __forceinline__ void operator()(int m, int n, float v) const { const size_t o = (size_t)m * 1024 + n; const float h = x[o] + v; h1[o] = h; h1b[o] = f2bf(h); } };
struct EpiScaleF32 { const float* part; float* out; int ldo; int pad; __device__ __forceinline__ void operator()(int m, int n, float v) const {
    float s = 0.f; for (int i = 0; i < 16; ++i) s += part[(size_t)m * 16 + i];
    out[(size_t)m * ldo + n] = v * (1.0f / sqrtf(s * (1.0f / 1024.0f) + EPS)); } };
struct EpiPlainF32 { float* out; int ldo; int pad; __device__ __forceinline__ void operator()(int m, int n, float v) const { out[(size_t)m * ldo + n] = v; } };
struct EpiPP { bf16* pp; __device__ __forceinline__ void operator()(int m, int n, float v) const { pp[(size_t)m * 1024 + n] = f2bf(v); } };
struct EpiH3 { const float* rstd3; const bf16* pp; float* h; __device__ __forceinline__ void operator()(int m, int n, float v) const { const size_t o = (size_t)m * 1024 + n; h[o] = h[o] + sigmoidf_(v * rstd3[m]) * bf2f(pp[o]); } };

__global__ void __launch_bounds__(256) final_norm(float* __restrict__ h, const float* __restrict__ part, const float* __restrict__ fg) {
    const int row = blockIdx.x * 4 + (threadIdx.x >> 6), lane = threadIdx.x & 63;
    float s = 0.f; for (int i = 0; i < 16; ++i) s += part[(size_t)row * 16 + i];
    const float r = 1.0f / sqrtf(s * (1.0f / 1024.0f) + EPS);
    float* hr = h + (size_t)row * 1024;
    for (int j = 0; j < 16; ++j) { const int c = lane + 64 * j; hr[c] = hr[c] * r * fg[c]; }
}
}
#define LAS __attribute__((address_space(3)))
typedef float f32x4 __attribute__((ext_vector_type(4)));
typedef unsigned u32x4 __attribute__((ext_vector_type(4)));
typedef int i32x4 __attribute__((ext_vector_type(4)));

constexpr int TK_TOK = 32;
constexpr int TK_LSTRIDE = 132;
constexpr int TK_LDS_BYTES = 256 * TK_LSTRIDE * 4;

__device__ __forceinline__ void topk_item(LAS float* lds, const float* __restrict__ SC, int item, int head_base, int* __restrict__ seli, float* __restrict__ selg, int tid) {
    const f32x4* src = (const f32x4*)(SC + (size_t)item * TK_TOK * 1024);
#pragma unroll 4
    for (int i = 0; i < 16; ++i) {
        const int idx = tid + i * 512; const int row = idx >> 8, c4 = idx & 255;
        const f32x4 v = src[idx];
        const int list = row * 8 + (c4 >> 5), elem = (c4 & 31) * 4;
        *(LAS f32x4*)(lds + list * TK_LSTRIDE + elem) = v;
    }
    __syncthreads();
    if (tid < 256) {
        const LAS float* my = lds + tid * TK_LSTRIDE;
        unsigned acc[16];
#pragma unroll
        for (int g = 0; g < 8; ++g) {
            unsigned t[16];
#pragma unroll
            for (int q = 0; q < 4; ++q) {
                const f32x4 v = *(const LAS f32x4*)(my + g * 16 + q * 4);
#pragma unroll
                for (int c = 0; c < 4; ++c) { const int e = g * 16 + q * 4 + c; t[q * 4 + c] = (tk_f2key(v[c]) & ~127u) | (unsigned)(127 - e); }
            }
            tk_sort16(t);
            if (g == 0) {
#pragma unroll
                for (int i = 0; i < 16; ++i) acc[i] = t[i];
            } else tk_merge16(acc, t);
        }
        unsigned oth[16];
#pragma unroll
        for (int i = 0; i < 16; ++i) oth[i] = (unsigned)__shfl_xor((int)acc[i], 1);
        if ((tid & 1) == 0) {
            const int tok = item * TK_TOK + (tid >> 3), head = head_base + ((tid >> 1) & 3);
            tk_combine_store(acc, oth, seli + (size_t)tok * 128 + head * 16, selg + (size_t)tok * 128 + head * 16);
        }
    }
    __syncthreads();
}
__global__ void __launch_bounds__(512) topk_kernel(const float* __restrict__ SC, int head_base, int* __restrict__ seli, float* __restrict__ selg) {
    extern __shared__ __attribute__((aligned(16))) unsigned char dyn_lds[];
    for (int item = blockIdx.x; item < T_ / TK_TOK; item += gridDim.x) topk_item((LAS float*)dyn_lds, SC, item, head_base, seli, selg, (int)threadIdx.x);
}

template <int MODE>
__device__ __forceinline__ void gather_token(int t, int lane, const void* __restrict__ Utab, const void* __restrict__ Vtab, const float* __restrict__ gffn,
                                             const int* __restrict__ seli, const float* __restrict__ selg, const float* __restrict__ part2,
                                             float* __restrict__ H  , bf16* __restrict__ h2b, float* __restrict__ rstd3) {
    float ps = (lane < 16) ? part2[(size_t)t * 16 + lane] : 0.f;
    ps = wave_sum(ps);
    const float rstd2 = 1.0f / sqrtf(ps * (1.0f / 1024.0f) + EPS);
    const int iA = seli[(size_t)t * 128 + lane], iB = seli[(size_t)t * 128 + 64 + lane];
    const float gA = selg[(size_t)t * 128 + lane], gB = selg[(size_t)t * 128 + 64 + lane];
    float* hr = H + (size_t)t * 1024;
    if constexpr (MODE == 0) {
        f32x4 x[4], y[4], hv[4];
#pragma unroll
        for (int j = 0; j < 4; ++j) { hv[j] = *(const f32x4*)(hr + 256 * j + 4 * lane); const f32x4 g = *(const f32x4*)(gffn + 256 * j + 4 * lane); x[j] = hv[j] * g; y[j] = (f32x4){0.f, 0.f, 0.f, 0.f}; }
        const float* U = (const float*)Utab; const float* V = (const float*)Vtab;
        for (int k = 0; k < 64; ++k) {
#pragma unroll
            for (int hh = 0; hh < 2; ++hh) {
                const int e = __builtin_amdgcn_readlane(hh ? iB : iA, k);
                const float gt = __builtin_bit_cast(float, __builtin_amdgcn_readlane(__builtin_bit_cast(int, hh ? gB : gA), k));
                const float* ur = U + (size_t)e * 1024; const float* vr = V + (size_t)e * 1024;
                f32x4 uv[4], vv[4];
#pragma unroll
                for (int j = 0; j < 4; ++j) { uv[j] = *(const f32x4*)(ur + 256 * j + 4 * lane); vv[j] = *(const f32x4*)(vr + 256 * j + 4 * lane); }
                float d = 0.f;
#pragma unroll
                for (int j = 0; j < 4; ++j) d += (uv[j].x * x[j].x + uv[j].y * x[j].y) + (uv[j].z * x[j].z + uv[j].w * x[j].w);
                d = wave_sum(d);
                const float c = gt * gelu_tanh(d * rstd2);
#pragma unroll
                for (int j = 0; j < 4; ++j) y[j] += vv[j] * c;
            }
        }
        float sq = 0.f;
#pragma unroll
        for (int j = 0; j < 4; ++j) {
            const f32x4 h2 = hv[j] + y[j];
            *(f32x4*)(hr + 256 * j + 4 * lane) = h2;
            sq += (h2.x * h2.x + h2.y * h2.y) + (h2.z * h2.z + h2.w * h2.w);
            uint2 w; w.x = pk2(h2.x, h2.y); w.y = pk2(h2.z, h2.w);
            *(uint2*)(h2b + (size_t)t * 1024 + 256 * j + 4 * lane) = w;
        }
        sq = wave_sum(sq);
        if (lane == 0) rstd3[t] = 1.0f / sqrtf(sq * (1.0f / 1024.0f) + EPS);
    } else {
        float x[2][8], y[2][8], hv[2][8];
#pragma unroll
        for (int j = 0; j < 2; ++j) {
            const f32x4 a = *(const f32x4*)(hr + 512 * j + 8 * lane), b = *(const f32x4*)(hr + 512 * j + 8 * lane + 4);
            hv[j][0] = a.x; hv[j][1] = a.y; hv[j][2] = a.z; hv[j][3] = a.w; hv[j][4] = b.x; hv[j][5] = b.y; hv[j][6] = b.z; hv[j][7] = b.w;
#pragma unroll
            for (int c = 0; c < 8; ++c) { x[j][c] = hv[j][c]; y[j][c] = 0.f; }
        }
        const bf16* U = (const bf16*)Utab; const bf16* V = (const bf16*)Vtab;
        for (int k = 0; k < 64; k += 2) {
            u32x4 uv[4][2], vv[4][2]; float gt[4];
#pragma unroll
            for (int q = 0; q < 4; ++q) {
                const int kk = k + (q >> 1); const int hh = q & 1;
                const int e = __builtin_amdgcn_readlane(hh ? iB : iA, kk);
                gt[q] = __builtin_bit_cast(float, __builtin_amdgcn_readlane(__builtin_bit_cast(int, hh ? gB : gA), kk));
                const bf16* ur = U + (size_t)e * 1024; const bf16* vr = V + (size_t)e * 1024;
#pragma unroll
                for (int j = 0; j < 2; ++j) { uv[q][j] = *(const u32x4*)(ur + 512 * j + 8 * lane); vv[q][j] = *(const u32x4*)(vr + 512 * j + 8 * lane); }
            }
#pragma unroll
            for (int q = 0; q < 4; ++q) {
                float d = 0.f;
#pragma unroll
                for (int j = 0; j < 2; ++j)
#pragma unroll
                    for (int c = 0; c < 4; ++c) { const unsigned w = uv[q][j][c]; d = fmaf(__builtin_bit_cast(float, w << 16), x[j][2 * c], d); d = fmaf(__builtin_bit_cast(float, w & 0xffff0000u), x[j][2 * c + 1], d); }
                d = wave_sum(d);
                const float cf = gt[q] * gelu_tanh(d * rstd2);
#pragma unroll
                for (int j = 0; j < 2; ++j)
#pragma unroll
                    for (int c = 0; c < 4; ++c) { const unsigned w = vv[q][j][c]; y[j][2 * c] = fmaf(__builtin_bit_cast(float, w << 16), cf, y[j][2 * c]); y[j][2 * c + 1] = fmaf(__builtin_bit_cast(float, w & 0xffff0000u), cf, y[j][2 * c + 1]); }
            }
        }
        float sq = 0.f;
#pragma unroll
        for (int j = 0; j < 2; ++j) {
            float h2[8];
#pragma unroll
            for (int c = 0; c < 8; ++c) { h2[c] = hv[j][c] + y[j][c]; sq += h2[c] * h2[c]; }
            *(f32x4*)(hr + 512 * j + 8 * lane) = (f32x4){h2[0], h2[1], h2[2], h2[3]};
            *(f32x4*)(hr + 512 * j + 8 * lane + 4) = (f32x4){h2[4], h2[5], h2[6], h2[7]};
            u32x4 w; w.x = pk2(h2[0], h2[1]); w.y = pk2(h2[2], h2[3]); w.z = pk2(h2[4], h2[5]); w.w = pk2(h2[6], h2[7]);
            *(u32x4*)(h2b + (size_t)t * 1024 + 512 * j + 8 * lane) = w;
        }
        sq = wave_sum(sq);
        if (lane == 0) rstd3[t] = 1.0f / sqrtf(sq * (1.0f / 1024.0f) + EPS);
    }
}
template <int MODE>
__global__ void __launch_bounds__(256) gather_kernel(const void* __restrict__ Utab, const void* __restrict__ Vtab, const float* __restrict__ gffn, const int* __restrict__ seli, const float* __restrict__ selg,
                                                     const float* __restrict__ part2, float* __restrict__ H, bf16* __restrict__ h2b, float* __restrict__ rstd3) {
    const int lane = threadIdx.x & 63; const int w = blockIdx.x * 4 + (threadIdx.x >> 6); const int nw = gridDim.x * 4;
    for (int t = w; t < T_; t += nw) gather_token<MODE>(t, lane, Utab, Vtab, gffn, seli, selg, part2, H, h2b, rstd3);
}

typedef float f32x2 __attribute__((ext_vector_type(2)));
__device__ __forceinline__ float reduce4_transpose(float d0, float d1, float d2, float d3, int lane) {
    const bool b0 = lane & 1, b1 = lane & 2;
    const float a = (b0 ? d1 : d0) + __shfl_xor(b0 ? d0 : d1, 1);
    const float b = (b0 ? d3 : d2) + __shfl_xor(b0 ? d2 : d3, 1);
    float c = (b1 ? b : a) + __shfl_xor(b1 ? a : b, 2);
    c += __shfl_xor(c, 4); c += __shfl_xor(c, 8); c += __shfl_xor(c, 16); c += __shfl_xor(c, 32);
    return c;
}
__device__ __forceinline__ float dot16_fp8(const u32x4 w, const f32x2 (&x2)[8]) {
    f32x2 acc = (f32x2){0.f, 0.f};
#pragma unroll
    for (int c = 0; c < 4; ++c) { const unsigned ww = w[c]; const f32x2 lo = __builtin_amdgcn_cvt_pk_f32_fp8(ww, false), hi = __builtin_amdgcn_cvt_pk_f32_fp8(ww, true); acc = lo * x2[2 * c] + acc; acc = hi * x2[2 * c + 1] + acc; }
    return acc.x + acc.y;
}
__device__ __forceinline__ void axpy16_fp8(const u32x4 w, float cf, f32x2 (&y2)[8]) {
#pragma unroll
    for (int c = 0; c < 4; ++c) { const unsigned ww = w[c]; const f32x2 lo = __builtin_amdgcn_cvt_pk_f32_fp8(ww, false), hi = __builtin_amdgcn_cvt_pk_f32_fp8(ww, true); y2[2 * c] = lo * cf + y2[2 * c]; y2[2 * c + 1] = hi * cf + y2[2 * c + 1]; }
}
__device__ __forceinline__ float sel4f(float v0, float v1, float v2, float v3, int q) { return q == 0 ? v0 : (q == 1 ? v1 : (q == 2 ? v2 : v3)); }
__device__ __forceinline__ void gather_token_fp8(int t, int lane, const unsigned char* __restrict__ U8, const unsigned char* __restrict__ V8, const float* __restrict__ IU, const float* __restrict__ IV,
                                                 const int* __restrict__ seli, const float* __restrict__ selg, const float* __restrict__ part2,
                                                 float* __restrict__ H, bf16* __restrict__ h2b, float* __restrict__ rstd3) {
    float ps = (lane < 16) ? part2[(size_t)t * 16 + lane] : 0.f;
    ps = wave_sum(ps);
    const float rstd2 = 1.0f / sqrtf(ps * (1.0f / 1024.0f) + EPS);
    const int iA = seli[(size_t)t * 128 + lane], iB = seli[(size_t)t * 128 + 64 + lane];
    const float duA = IU[iA] * rstd2, duB = IU[iB] * rstd2;
    const float gvA = selg[(size_t)t * 128 + lane] * IV[iA], gvB = selg[(size_t)t * 128 + 64 + lane] * IV[iB];
    float* hr = H + (size_t)t * 1024 + 16 * lane;
    f32x2 x2[8], y2[8]; f32x4 hv[4];
#pragma unroll
    for (int j = 0; j < 4; ++j) { hv[j] = *(const f32x4*)(hr + 4 * j); x2[2 * j] = (f32x2){hv[j][0], hv[j][1]}; x2[2 * j + 1] = (f32x2){hv[j][2], hv[j][3]}; y2[2 * j] = (f32x2){0.f, 0.f}; y2[2 * j + 1] = (f32x2){0.f, 0.f}; }
    const int q = lane & 3;
#pragma unroll 1
    for (int k = 0; k < 64; k += 4) {
        u32x4 uu[8], vv[8]; float du[8], gv[8];
#pragma unroll
        for (int s = 0; s < 8; ++s) {
            const int kk = k + (s >> 1); const bool hh = s & 1;
            const int e = __builtin_amdgcn_readlane(hh ? iB : iA, kk);
            du[s] = __int_as_float(__builtin_amdgcn_readlane(__float_as_int(hh ? duB : duA), kk));
            gv[s] = __int_as_float(__builtin_amdgcn_readlane(__float_as_int(hh ? gvB : gvA), kk));
            uu[s] = *(const u32x4*)(U8 + (size_t)e * 1024 + 16 * lane);
            vv[s] = *(const u32x4*)(V8 + (size_t)e * 1024 + 16 * lane);
        }
#pragma unroll
        for (int g = 0; g < 2; ++g) {
            const float d0 = dot16_fp8(uu[4 * g + 0], x2), d1 = dot16_fp8(uu[4 * g + 1], x2), d2 = dot16_fp8(uu[4 * g + 2], x2), d3 = dot16_fp8(uu[4 * g + 3], x2);
            const float tot = reduce4_transpose(d0, d1, d2, d3, lane);
            const float z = tot * sel4f(du[4 * g], du[4 * g + 1], du[4 * g + 2], du[4 * g + 3], q);
            const float cf = gelu_tanh(z) * sel4f(gv[4 * g], gv[4 * g + 1], gv[4 * g + 2], gv[4 * g + 3], q);
#pragma unroll
            for (int s = 0; s < 4; ++s) { const float cs = __int_as_float(__builtin_amdgcn_readlane(__float_as_int(cf), s)); axpy16_fp8(vv[4 * g + s], cs, y2); }
        }
    }
    float sq = 0.f;
    f32x4 h2[4];
#pragma unroll
    for (int j = 0; j < 4; ++j) {
        h2[j] = hv[j] + (f32x4){y2[2 * j].x, y2[2 * j].y, y2[2 * j + 1].x, y2[2 * j + 1].y};
        *(f32x4*)(hr + 4 * j) = h2[j];
        sq += (h2[j][0] * h2[j][0] + h2[j][1] * h2[j][1]) + (h2[j][2] * h2[j][2] + h2[j][3] * h2[j][3]);
    }
    u32x4 w0, w1; w0.x = pk2(h2[0][0], h2[0][1]); w0.y = pk2(h2[0][2], h2[0][3]); w0.z = pk2(h2[1][0], h2[1][1]); w0.w = pk2(h2[1][2], h2[1][3]);
    w1.x = pk2(h2[2][0], h2[2][1]); w1.y = pk2(h2[2][2], h2[2][3]); w1.z = pk2(h2[3][0], h2[3][1]); w1.w = pk2(h2[3][2], h2[3][3]);
    u32x4* ob = (u32x4*)(h2b + (size_t)t * 1024 + 16 * lane); ob[0] = w0; ob[1] = w1;
    sq = wave_sum(sq);
    if (lane == 0) rstd3[t] = 1.0f / sqrtf(sq * (1.0f / 1024.0f) + EPS);
}

__device__ __forceinline__ unsigned umin_(unsigned a, unsigned b) { return a < b ? a : b; }
__device__ __forceinline__ unsigned umax_(unsigned a, unsigned b) { return a > b ? a : b; }
__device__ __forceinline__ void sort128(unsigned& k0, unsigned& k1, int lane) {
#pragma unroll
    for (int k = 2; k <= 128; k <<= 1) {
#pragma unroll
        for (int j = k >> 1; j >= 1; j >>= 1) {
            if (j == 64) { const unsigned mn = umin_(k0, k1), mx = umax_(k0, k1); k0 = mn; k1 = mx; }
            else {
                const unsigned o0 = (unsigned)__shfl_xor((int)k0, j), o1 = (unsigned)__shfl_xor((int)k1, j);
                const bool up0 = (k == 128) ? true : (k == 64 ? true : ((lane & k) == 0));
                const bool up1 = (k == 128) ? true : (k == 64 ? false : ((lane & k) == 0));
                const bool lower = (lane & j) == 0;
                k0 = (lower == up0) ? umin_(k0, o0) : umax_(k0, o0);
                k1 = (lower == up1) ? umin_(k1, o1) : umax_(k1, o1);
            }
        }
    }
}
typedef int i32x4v __attribute__((ext_vector_type(4)));
#ifndef NSLICE
#define NSLICE 8
#endif
#define SLICE_SHIFT (NSLICE == 32 ? 25 : (NSLICE == 16 ? 26 : (NSLICE == 8 ? 27 : (NSLICE == 4 ? 28 : 30))))
typedef unsigned u32x2 __attribute__((ext_vector_type(2)));
__device__ __forceinline__ f32x4 bf4_lo(u32x2 w) { return (f32x4){__builtin_bit_cast(float, w.x << 16), __builtin_bit_cast(float, w.x & 0xffff0000u), __builtin_bit_cast(float, w.y << 16), __builtin_bit_cast(float, w.y & 0xffff0000u)}; }
struct TokState { f32x2 y2[8]; unsigned k0, k1; int bnd; float rsx; };
__device__ __forceinline__ int count_lt(const TokState& S, unsigned bound) {
    return __builtin_popcountll(__builtin_amdgcn_ballot_w64(S.k0 < bound)) + __builtin_popcountll(__builtin_amdgcn_ballot_w64(S.k1 < bound));
}
__device__ __forceinline__ int bperm_i(int srclane, int v) { return __builtin_amdgcn_ds_bpermute(srclane << 2, v); }
__device__ __forceinline__ float bperm_f(int srclane, float v) { return __int_as_float(__builtin_amdgcn_ds_bpermute(srclane << 2, __float_as_int(v))); }
template <int PM>
__device__ __forceinline__ void gather_batch(TokState& S, int p, int hi, int lane, const LAS unsigned char* xs, const unsigned char* __restrict__ U8, const unsigned char* __restrict__ V8, const float* __restrict__ IU, const float* __restrict__ IV) {
    const int n = (hi - p < 16) ? hi - p : 16;
    const int m = lane & 15, kq = lane >> 4;
    const int r = (m < n) ? p + m : hi - 1; const int sl = r & 63; const bool lo = r < 64;
    const unsigned ka = (unsigned)bperm_i(sl, (int)S.k0), kb = (unsigned)bperm_i(sl, (int)S.k1);
    const int es = (int)((lo ? ka : kb) >> 16);
    const unsigned key = lo ? ka : kb;
    const float dus = IU[es] * S.rsx, gvs = (m < n) ? (float)(key & 0xffffu) * (1.0f / 65535.0f) * IV[es] : 0.f;
    const unsigned char* ua = U8 + (size_t)es * 1024 + 16 * kq;
    i32x4v A[16];
    if (!(PM & 2)) {
#pragma unroll
        for (int s = 0; s < 16; ++s) { if (PM & 16) { const int e = __builtin_amdgcn_readlane(es, s); A[s] = *(const i32x4v*)(U8 + (size_t)e * 1024 + 16 * lane); } else A[s] = *(const i32x4v*)(ua + 64 * s); }
    }
    u32x4 vv[16];
    if (!(PM & 1)) {
#pragma unroll
        for (int q = 0; q < 8; ++q) if (q < n) { const int e = __builtin_amdgcn_readlane(es, q); vv[q] = *(const u32x4*)(V8 + (size_t)e * 1024 + 16 * lane); }
        if (n > 8) {
#pragma unroll
            for (int q = 8; q < 16; ++q) if (q < n) { const int e = __builtin_amdgcn_readlane(es, q); vv[q] = *(const u32x4*)(V8 + (size_t)e * 1024 + 16 * lane); }
        }
    }
    i32x4v acc = (i32x4v){0, 0, 0, 0};
    if (!(PM & 2)) {
#pragma unroll
        for (int s = 0; s < 16; ++s) { const i32x4v B = *(const LAS i32x4v*)(xs + 64 * s + 16 * kq); acc = __builtin_amdgcn_mfma_i32_16x16x64_i8(A[s], B, acc, 0, 0, 0); }
    } else { acc = (i32x4v){es, es + 1, es + 2, es + 3}; }
    float cf[4];
#pragma unroll
    for (int j = 0; j < 4; ++j) { const int sm = 4 * kq + j; const float d = bperm_f(sm, dus), g = bperm_f(sm, gvs); cf[j] = g * gelu_tanh((float)acc[j] * d); }
    if (PM & 1) { S.y2[0].x += (cf[0] + cf[1]) + (cf[2] + cf[3]); }
    else if (PM & 4) {
#pragma unroll
        for (int q = 0; q < 16; ++q) if (q < n) { const float cs = __int_as_float(__builtin_amdgcn_readlane(__float_as_int(cf[q & 3]), 16 * (q >> 2))); S.y2[q & 7].x += cs * __uint_as_float((vv[q].x ^ vv[q].y ^ vv[q].z ^ vv[q].w) & 0x3fffffffu); }
    } else {
#pragma unroll
        for (int q = 0; q < 8; ++q) if (q < n) { const float cs = __int_as_float(__builtin_amdgcn_readlane(__float_as_int(cf[q & 3]), 16 * (q >> 2))); axpy16_fp8(vv[q], cs, S.y2); }
        if (n > 8) {
#pragma unroll
            for (int q = 8; q < 16; ++q) if (q < n) { const float cs = __int_as_float(__builtin_amdgcn_readlane(__float_as_int(cf[q & 3]), 16 * (q >> 2))); axpy16_fp8(vv[q], cs, S.y2); }
        }
    }
    __builtin_amdgcn_sched_barrier(0);
}
__device__ __forceinline__ void tok_setup(TokState& S, int t, int lane, LAS unsigned char* xs, const int* __restrict__ seli, const float* __restrict__ selg,
                                          const float* __restrict__ part2, const bf16* __restrict__ h1b) {
    float ps = (lane < 16) ? part2[(size_t)t * 16 + lane] : 0.f;
    ps = wave_sum(ps);
    const float rstd2 = 1.0f / sqrtf(ps * (1.0f / 1024.0f) + EPS);
    f32x4 hv[4]; float am = 0.f;
    { const u32x4* br = (const u32x4*)(h1b + (size_t)t * 1024 + 16 * lane); const u32x4 b0 = br[0], b1 = br[1];
      hv[0] = bf4_lo((u32x2){b0.x, b0.y}); hv[1] = bf4_lo((u32x2){b0.z, b0.w}); hv[2] = bf4_lo((u32x2){b1.x, b1.y}); hv[3] = bf4_lo((u32x2){b1.z, b1.w}); }
#pragma unroll
    for (int j = 0; j < 4; ++j) { am = fmaxf(am, fmaxf(fmaxf(fabsf(hv[j][0]), fabsf(hv[j][1])), fmaxf(fabsf(hv[j][2]), fabsf(hv[j][3])))); }
#pragma unroll
    for (int o = 1; o < 64; o <<= 1) am = fmaxf(am, __shfl_xor(am, o));
    const float sx = am > 0.f ? 127.0f / am : 1.0f, isx = am > 0.f ? am * (1.0f / 127.0f) : 1.0f;
    u32x4 xq;
#pragma unroll
    for (int j = 0; j < 4; ++j) { unsigned w = 0u;
#pragma unroll
        for (int c = 0; c < 4; ++c) w |= ((unsigned)(int)__builtin_rintf(hv[j][c] * sx) & 0xffu) << (8 * c);
        xq[j] = w; }
    *(LAS u32x4*)(xs + 16 * lane) = xq;
    const int iA = seli[(size_t)t * 128 + lane], iB = seli[(size_t)t * 128 + 64 + lane];
    const float gA = selg[(size_t)t * 128 + lane], gB = selg[(size_t)t * 128 + 64 + lane];
    S.k0 = ((unsigned)iA << 16) | (unsigned)(gA * 65535.0f + 0.5f); S.k1 = ((unsigned)iB << 16) | (unsigned)(gB * 65535.0f + 0.5f);
    sort128(S.k0, S.k1, lane);
    S.rsx = rstd2 * isx;
    int bnd = 0;
#pragma unroll
    for (int s = 1; s <= NSLICE; ++s) { const int c = count_lt(S, (unsigned)s << SLICE_SHIFT); bnd = (lane == s) ? c : bnd; }
    S.bnd = bnd;
#pragma unroll
    for (int j = 0; j < 8; ++j) S.y2[j] = (f32x2){0.f, 0.f};
}
__device__ __forceinline__ void tok_finish(const TokState& S, int t, int lane, const bf16* __restrict__ h1b, bf16* __restrict__ h2b, float* __restrict__ rstd3) {
    const u32x4* br = (const u32x4*)(h1b + (size_t)t * 1024 + 16 * lane); const u32x4 b0 = br[0], b1 = br[1];
    f32x4 h2[4]; h2[0] = bf4_lo((u32x2){b0.x, b0.y}); h2[1] = bf4_lo((u32x2){b0.z, b0.w}); h2[2] = bf4_lo((u32x2){b1.x, b1.y}); h2[3] = bf4_lo((u32x2){b1.z, b1.w});
    float sq = 0.f;
#pragma unroll
    for (int j = 0; j < 4; ++j) {
        h2[j] = h2[j] + (f32x4){S.y2[2 * j].x, S.y2[2 * j].y, S.y2[2 * j + 1].x, S.y2[2 * j + 1].y};
        sq += (h2[j][0] * h2[j][0] + h2[j][1] * h2[j][1]) + (h2[j][2] * h2[j][2] + h2[j][3] * h2[j][3]);
    }
    u32x4 w0, w1; w0.x = pk2(h2[0][0], h2[0][1]); w0.y = pk2(h2[0][2], h2[0][3]); w0.z = pk2(h2[1][0], h2[1][1]); w0.w = pk2(h2[1][2], h2[1][3]);
    w1.x = pk2(h2[2][0], h2[2][1]); w1.y = pk2(h2[2][2], h2[2][3]); w1.z = pk2(h2[3][0], h2[3][1]); w1.w = pk2(h2[3][2], h2[3][3]);
    u32x4* ob = (u32x4*)(h2b + (size_t)t * 1024 + 16 * lane); ob[0] = w0; ob[1] = w1;
    sq = wave_sum(sq);
    if (lane == 0) rstd3[t] = 1.0f / sqrtf(sq * (1.0f / 1024.0f) + EPS);
}
__device__ __forceinline__ int dpp_xor8(int v) { return __builtin_amdgcn_update_dpp(0, v, 0x128, 0xf, 0xf, false); }
__device__ __forceinline__ int dpp_xor4(int v) { return __builtin_amdgcn_update_dpp(0, __builtin_amdgcn_update_dpp(0, v, 0x141, 0xf, 0xf, false), 0x1b, 0xf, 0xf, false); }
__device__ __forceinline__ int dpp_xor1(int v) { return __builtin_amdgcn_update_dpp(0, v, 0xb1, 0xf, 0xf, false); }
__device__ __forceinline__ int dpp_xor2(int v) { return __builtin_amdgcn_update_dpp(0, v, 0x4e, 0xf, 0xf, false); }
__device__ __forceinline__ int reduce16_rows(int (&p)[16], int lane) {
    int r8[8], r4[4], r2[2];
#pragma unroll
    for (int i = 0; i < 8; ++i) { const u32x2 s = __builtin_amdgcn_permlane32_swap((unsigned)p[i], (unsigned)p[i + 8], false, false); r8[i] = (int)(s.x + s.y); }
#pragma unroll
    for (int i = 0; i < 4; ++i) { const u32x2 s = __builtin_amdgcn_permlane16_swap((unsigned)r8[i], (unsigned)r8[i + 4], false, false); r4[i] = (int)(s.x + s.y); }
    const bool b3 = lane & 8, b2 = lane & 4;
#pragma unroll
    for (int i = 0; i < 2; ++i) { const int s0 = r4[i] + dpp_xor8(r4[i]), s1 = r4[i + 2] + dpp_xor8(r4[i + 2]); r2[i] = b3 ? s1 : s0; }
    const int keep = b2 ? r2[1] : r2[0], send = b2 ? r2[0] : r2[1];
    int t = keep + dpp_xor4(send);
    t += dpp_xor1(t); t += dpp_xor2(t);
    return t;
}
struct TokState2 { f32x2 y2[8]; unsigned k0, k1; float rsx; };
template <int PM>
__device__ __forceinline__ void gather_batch_rows(TokState& S, int p, int hi, int lane, const LAS unsigned char* xs, const unsigned char* __restrict__ U8, const unsigned char* __restrict__ V8, const float* __restrict__ IU, const float* __restrict__ IV) {
    const int n = (hi - p < 16) ? hi - p : 16;
    const int slot = lane >> 2;
    const int r = (slot < n) ? p + slot : hi - 1; const int sl = r & 63; const bool lo = r < 64;
    const unsigned ka = (unsigned)bperm_i(sl, (int)S.k0), kb = (unsigned)bperm_i(sl, (int)S.k1);
    const unsigned key = lo ? ka : kb;
    const int es = (int)(key >> 16);
    const float dus = IU[es] * S.rsx, gvs = (slot < n) ? (float)(key & 0xffffu) * (1.0f / 65535.0f) * IV[es] : 0.f;
    i32x4v A[16]; u32x4 vv[16];
#pragma unroll
    for (int g = 0; g < 4; ++g) if (4 * g < n) {
#pragma unroll
        for (int q = 4 * g; q < 4 * g + 4; ++q) { int e = __builtin_amdgcn_readlane(es, 4 * q); if (PM & 32) e &= 1023; A[q] = *(const i32x4v*)(U8 + (size_t)e * 1024 + 16 * lane); }
    }
#pragma unroll
    for (int g = 0; g < 4; ++g) if (4 * g < n) {
#pragma unroll
        for (int q = 4 * g; q < 4 * g + 4; ++q) { int e = __builtin_amdgcn_readlane(es, 4 * q); if (PM & 32) e &= 1023; vv[q] = *(const u32x4*)(V8 + (size_t)e * 1024 + 16 * lane); }
    }
    const i32x4v X = *(const LAS i32x4v*)(xs + 16 * lane);
    int pp[16];
#pragma unroll
    for (int g = 0; g < 4; ++g) {
        if (4 * g < n) {
#pragma unroll
            for (int q = 4 * g; q < 4 * g + 4; ++q) pp[q] = __builtin_amdgcn_sdot4(A[q][3], X[3], __builtin_amdgcn_sdot4(A[q][2], X[2], __builtin_amdgcn_sdot4(A[q][1], X[1], __builtin_amdgcn_sdot4(A[q][0], X[0], 0, false), false), false), false);
        } else {
#pragma unroll
            for (int q = 4 * g; q < 4 * g + 4; ++q) pp[q] = 0;
        }
    }
    const int tot = reduce16_rows(pp, lane);
    const float cf = gvs * gelu_tanh((float)tot * dus);
#pragma unroll
    for (int g = 0; g < 4; ++g) if (4 * g < n) {
#pragma unroll
        for (int q = 4 * g; q < 4 * g + 4; ++q) { const float cs = __int_as_float(__builtin_amdgcn_readlane(__float_as_int(cf), 4 * q)); axpy16_fp8(vv[q], cs, S.y2); }
    }
    __builtin_amdgcn_sched_barrier(0);
}

template <int PM>
__device__ __forceinline__ void gather_batch16(TokState2& S, int bi, int lane, const LAS unsigned char* xs, const unsigned char* __restrict__ U8, const unsigned char* __restrict__ V8, const float* __restrict__ IU, const float* __restrict__ IV) {
    const unsigned ksel = (bi < 4) ? S.k0 : S.k1;
    const int lb = (bi & 3) << 4;
    const unsigned key = (unsigned)bperm_i(lb + (lane >> 2), (int)ksel);
    const int es = (int)(key >> 16);
    const float dus = IU[es] * S.rsx, gvs = (float)(key & 0xffffu) * (1.0f / 65535.0f) * IV[es];
    i32x4v A[16]; u32x4 vv[16];
#pragma unroll
    for (int q = 0; q < 16; ++q) { int e = (int)((unsigned)__builtin_amdgcn_readlane((int)ksel, lb + q) >> 16); if (PM & 32) e &= 1023; if (!(PM & 2)) A[q] = *(const i32x4v*)(U8 + (size_t)e * 1024 + 16 * lane); else A[q] = (i32x4v){e, e, e, e}; }
#pragma unroll
    for (int q = 0; q < 16; ++q) { int e = (int)((unsigned)__builtin_amdgcn_readlane((int)ksel, lb + q) >> 16); if (PM & 32) e &= 1023; if (!(PM & 1)) vv[q] = *(const u32x4*)(V8 + (size_t)e * 1024 + 16 * lane); else vv[q] = (u32x4){(unsigned)e, 0u, 0u, 0u}; }
    const i32x4v X = *(const LAS i32x4v*)(xs + 16 * lane);
    int p[16];
#pragma unroll
    for (int q = 0; q < 16; ++q) p[q] = __builtin_amdgcn_sdot4(A[q][3], X[3], __builtin_amdgcn_sdot4(A[q][2], X[2], __builtin_amdgcn_sdot4(A[q][1], X[1], __builtin_amdgcn_sdot4(A[q][0], X[0], 0, false), false), false), false);
    const int tot = reduce16_rows(p, lane);
    const float cf = gvs * gelu_tanh((float)tot * dus);
#pragma unroll
    for (int q = 0; q < 16; ++q) { const float cs = __int_as_float(__builtin_amdgcn_readlane(__float_as_int(cf), 4 * q)); if (PM & 1) S.y2[q & 7].x += cs * __uint_as_float(vv[q].x); else axpy16_fp8(vv[q], cs, S.y2); }
    __builtin_amdgcn_sched_barrier(0);
}
__device__ __forceinline__ void tok_setup2(TokState2& S, int t, int lane, LAS unsigned char* xs, const int* __restrict__ seli, const float* __restrict__ selg,
                                           const float* __restrict__ part2, const bf16* __restrict__ h1b) {
    float ps = (lane < 16) ? part2[(size_t)t * 16 + lane] : 0.f;
    ps = wave_sum(ps);
    const float rstd2 = 1.0f / sqrtf(ps * (1.0f / 1024.0f) + EPS);
    f32x4 hv[4]; float am = 0.f;
    { const u32x4* br = (const u32x4*)(h1b + (size_t)t * 1024 + 16 * lane); const u32x4 b0 = br[0], b1 = br[1];
      hv[0] = bf4_lo((u32x2){b0.x, b0.y}); hv[1] = bf4_lo((u32x2){b0.z, b0.w}); hv[2] = bf4_lo((u32x2){b1.x, b1.y}); hv[3] = bf4_lo((u32x2){b1.z, b1.w}); }
#pragma unroll
    for (int j = 0; j < 4; ++j) { am = fmaxf(am, fmaxf(fmaxf(fabsf(hv[j][0]), fabsf(hv[j][1])), fmaxf(fabsf(hv[j][2]), fabsf(hv[j][3])))); }
#pragma unroll
    for (int o = 1; o < 64; o <<= 1) am = fmaxf(am, __shfl_xor(am, o));
    const float sx = am > 0.f ? 127.0f / am : 1.0f, isx = am > 0.f ? am * (1.0f / 127.0f) : 1.0f;
    u32x4 xq;
#pragma unroll
    for (int j = 0; j < 4; ++j) { unsigned w = 0u;
#pragma unroll
        for (int c = 0; c < 4; ++c) w |= ((unsigned)(int)__builtin_rintf(hv[j][c] * sx) & 0xffu) << (8 * c);
        xq[j] = w; }
    *(LAS u32x4*)(xs + 16 * lane) = xq;
    const int iA = seli[(size_t)t * 128 + lane], iB = seli[(size_t)t * 128 + 64 + lane];
    const float gA = selg[(size_t)t * 128 + lane], gB = selg[(size_t)t * 128 + 64 + lane];
    S.k0 = ((unsigned)iA << 16) | (unsigned)(gA * 65535.0f + 0.5f); S.k1 = ((unsigned)iB << 16) | (unsigned)(gB * 65535.0f + 0.5f);
    sort128(S.k0, S.k1, lane);
    S.rsx = rstd2 * isx;
#pragma unroll
    for (int j = 0; j < 8; ++j) S.y2[j] = (f32x2){0.f, 0.f};
}
__device__ __forceinline__ void tok_finish2(const TokState2& S, int t, int lane, const bf16* __restrict__ h1b, bf16* __restrict__ h2b, float* __restrict__ rstd3) {
    const u32x4* br = (const u32x4*)(h1b + (size_t)t * 1024 + 16 * lane); const u32x4 b0 = br[0], b1 = br[1];
    f32x4 h2[4]; h2[0] = bf4_lo((u32x2){b0.x, b0.y}); h2[1] = bf4_lo((u32x2){b0.z, b0.w}); h2[2] = bf4_lo((u32x2){b1.x, b1.y}); h2[3] = bf4_lo((u32x2){b1.z, b1.w});
    float sq = 0.f;
#pragma unroll
    for (int j = 0; j < 4; ++j) {
        h2[j] = h2[j] + (f32x4){S.y2[2 * j].x, S.y2[2 * j].y, S.y2[2 * j + 1].x, S.y2[2 * j + 1].y};
        sq += (h2[j][0] * h2[j][0] + h2[j][1] * h2[j][1]) + (h2[j][2] * h2[j][2] + h2[j][3] * h2[j][3]);
    }
    u32x4 w0, w1; w0.x = pk2(h2[0][0], h2[0][1]); w0.y = pk2(h2[0][2], h2[0][3]); w0.z = pk2(h2[1][0], h2[1][1]); w0.w = pk2(h2[1][2], h2[1][3]);
    w1.x = pk2(h2[2][0], h2[2][1]); w1.y = pk2(h2[2][2], h2[2][3]); w1.z = pk2(h2[3][0], h2[3][1]); w1.w = pk2(h2[3][2], h2[3][3]);
    u32x4* ob = (u32x4*)(h2b + (size_t)t * 1024 + 16 * lane); ob[0] = w0; ob[1] = w1;
    sq = wave_sum(sq);
    if (lane == 0) rstd3[t] = 1.0f / sqrtf(sq * (1.0f / 1024.0f) + EPS);
}
template <int PM>
__device__ __forceinline__ void gather_wg_rows(int tok0, int wave, int lane, LAS unsigned char* lds, const unsigned char* __restrict__ U8, const unsigned char* __restrict__ V8, const float* __restrict__ IU, const float* __restrict__ IV,
                                               const int* __restrict__ seli, const float* __restrict__ selg, const float* __restrict__ part2, const bf16* __restrict__ h1b, bf16* __restrict__ h2b, float* __restrict__ rstd3, float* probe_out) {
    LAS unsigned char* xs = lds + wave * 4096;
#pragma unroll 1
    for (int pass = 0; pass < 2; ++pass) {
        const int tb = tok0 + pass * 32 + wave * 4;
        TokState2 S0, S1, S2, S3;
        tok_setup2(S0, tb + 0, fresh_lane(), xs, seli, selg, part2, h1b); __builtin_amdgcn_sched_barrier(0);
        tok_setup2(S1, tb + 1, fresh_lane(), xs + 1024, seli, selg, part2, h1b); __builtin_amdgcn_sched_barrier(0);
        tok_setup2(S2, tb + 2, fresh_lane(), xs + 2048, seli, selg, part2, h1b); __builtin_amdgcn_sched_barrier(0);
        tok_setup2(S3, tb + 3, fresh_lane(), xs + 3072, seli, selg, part2, h1b); __builtin_amdgcn_sched_barrier(0);
        __syncthreads();
        lane = fresh_lane();
#pragma unroll 1
        for (int bi = 0; bi < 8; ++bi) {
            gather_batch16<PM>(S0, bi, lane, xs, U8, V8, IU, IV);
            gather_batch16<PM>(S1, bi, lane, xs + 1024, U8, V8, IU, IV);
            gather_batch16<PM>(S2, bi, lane, xs + 2048, U8, V8, IU, IV);
            gather_batch16<PM>(S3, bi, lane, xs + 3072, U8, V8, IU, IV);
        }
        if (PM != 0) { const int fl = fresh_lane(); f32x2 a = S0.y2[0] + S1.y2[0] + S2.y2[0] + S3.y2[0];
#pragma unroll
            for (int j = 1; j < 8; ++j) a += S0.y2[j] + S1.y2[j] + S2.y2[j] + S3.y2[j];
            probe_out[(size_t)tb * 64 + fl] = a.x + a.y; }
        else { const int fl = fresh_lane(); tok_finish2(S0, tb, fl, h1b, h2b, rstd3); tok_finish2(S1, tb + 1, fl, h1b, h2b, rstd3); tok_finish2(S2, tb + 2, fl, h1b, h2b, rstd3); tok_finish2(S3, tb + 3, fl, h1b, h2b, rstd3); }
        __syncthreads();
    }
}
#if GATHER_ROWS == 2
#define GATHER_BATCH_FN gather_batch_rows
#else
#define GATHER_BATCH_FN gather_batch
#endif
template <int PM>
__device__ __forceinline__ void gather_wg_sliced(int tok0, int wave, int lane, LAS unsigned char* lds, const unsigned char* __restrict__ U8, const unsigned char* __restrict__ V8, const float* __restrict__ IU, const float* __restrict__ IV,
                                                 const int* __restrict__ seli, const float* __restrict__ selg, const float* __restrict__ part2, float* __restrict__ H, const bf16* __restrict__ h1b, bf16* __restrict__ h2b, float* __restrict__ rstd3, float* probe_out) {
    LAS unsigned char* xs = lds + wave * 4096;
#pragma unroll 1
    for (int pass = 0; pass < 2; ++pass) {
        const int tb = tok0 + pass * 32 + wave * 4;
        TokState S0, S1, S2, S3;
        tok_setup(S0, tb + 0, fresh_lane(), xs, seli, selg, part2, h1b); __builtin_amdgcn_sched_barrier(0);
        tok_setup(S1, tb + 1, fresh_lane(), xs + 1024, seli, selg, part2, h1b); __builtin_amdgcn_sched_barrier(0);
        tok_setup(S2, tb + 2, fresh_lane(), xs + 2048, seli, selg, part2, h1b); __builtin_amdgcn_sched_barrier(0);
        tok_setup(S3, tb + 3, fresh_lane(), xs + 3072, seli, selg, part2, h1b); __builtin_amdgcn_sched_barrier(0);
        __syncthreads();
        lane = fresh_lane();
        int lo0 = 0, lo1 = 0, lo2 = 0, lo3 = 0;
#pragma unroll 1
        for (int s = 0; s < NSLICE; ++s) {
            { const int hi = __builtin_amdgcn_readlane(S0.bnd, s + 1); for (int p = lo0; p < hi; p += 16) GATHER_BATCH_FN<PM>(S0, p, hi, lane, xs, U8, V8, IU, IV); lo0 = hi; }
            { const int hi = __builtin_amdgcn_readlane(S1.bnd, s + 1); for (int p = lo1; p < hi; p += 16) GATHER_BATCH_FN<PM>(S1, p, hi, lane, xs + 1024, U8, V8, IU, IV); lo1 = hi; }
            { const int hi = __builtin_amdgcn_readlane(S2.bnd, s + 1); for (int p = lo2; p < hi; p += 16) GATHER_BATCH_FN<PM>(S2, p, hi, lane, xs + 2048, U8, V8, IU, IV); lo2 = hi; }
            { const int hi = __builtin_amdgcn_readlane(S3.bnd, s + 1); for (int p = lo3; p < hi; p += 16) GATHER_BATCH_FN<PM>(S3, p, hi, lane, xs + 3072, U8, V8, IU, IV); lo3 = hi; }
        }
        if (probe_out) { const int fl = fresh_lane(); f32x2 a = S0.y2[0] + S1.y2[0] + S2.y2[0] + S3.y2[0];
#pragma unroll
            for (int j = 1; j < 8; ++j) a += S0.y2[j] + S1.y2[j] + S2.y2[j] + S3.y2[j];
            probe_out[(size_t)tb * 64 + fl] = a.x + a.y; }
        else { const int fl = fresh_lane(); tok_finish(S0, tb, fl, h1b, h2b, rstd3); tok_finish(S1, tb + 1, fl, h1b, h2b, rstd3); tok_finish(S2, tb + 2, fl, h1b, h2b, rstd3); tok_finish(S3, tb + 3, fl, h1b, h2b, rstd3); }
        __syncthreads();
    }
}


__device__ __forceinline__ unsigned xor16_val(unsigned v, bool hi16) { const u32x2 s = __builtin_amdgcn_permlane16_swap(v, v, false, false); return hi16 ? s.x : s.y; }
__device__ __forceinline__ unsigned xor32_val(unsigned v, bool hi32) { const u32x2 s = __builtin_amdgcn_permlane32_swap(v, v, false, false); return hi32 ? s.x : s.y; }
__device__ __forceinline__ float wave_sum_x(float v) {
    v += __int_as_float(dpp_xor1(__float_as_int(v))); v += __int_as_float(dpp_xor2(__float_as_int(v))); v += __int_as_float(dpp_xor4(__float_as_int(v))); v += __int_as_float(dpp_xor8(__float_as_int(v)));
    { const u32x2 s = __builtin_amdgcn_permlane16_swap(__float_as_uint(v), __float_as_uint(v), false, false); v = __uint_as_float(s.x) + __uint_as_float(s.y); }
    { const u32x2 s = __builtin_amdgcn_permlane32_swap(__float_as_uint(v), __float_as_uint(v), false, false); v = __uint_as_float(s.x) + __uint_as_float(s.y); }
    return v;
}
__device__ __forceinline__ float wave_max_x(float v) {
    v = fmaxf(v, __int_as_float(dpp_xor1(__float_as_int(v)))); v = fmaxf(v, __int_as_float(dpp_xor2(__float_as_int(v)))); v = fmaxf(v, __int_as_float(dpp_xor4(__float_as_int(v)))); v = fmaxf(v, __int_as_float(dpp_xor8(__float_as_int(v))));
    { const u32x2 s = __builtin_amdgcn_permlane16_swap(__float_as_uint(v), __float_as_uint(v), false, false); v = fmaxf(__uint_as_float(s.x), __uint_as_float(s.y)); }
    { const u32x2 s = __builtin_amdgcn_permlane32_swap(__float_as_uint(v), __float_as_uint(v), false, false); v = fmaxf(__uint_as_float(s.x), __uint_as_float(s.y)); }
    return v;
}
template <int J> __device__ __forceinline__ unsigned xor_lane(unsigned v, int lane) {
    if (J == 1) return (unsigned)__builtin_amdgcn_update_dpp(0, (int)v, 0xb1, 0xf, 0xf, false);
    if (J == 2) return (unsigned)__builtin_amdgcn_update_dpp(0, (int)v, 0x4e, 0xf, 0xf, false);
    if (J == 4) return (unsigned)dpp_xor4((int)v);
    if (J == 8) return (unsigned)__builtin_amdgcn_update_dpp(0, (int)v, 0x128, 0xf, 0xf, false);
    if (J == 16) return xor16_val(v, (lane & 16) != 0);
    return xor32_val(v, (lane & 32) != 0);
}
template <int NR, int KK, int J>
__device__ __forceinline__ void sort_stage(unsigned (&k)[NR], int lane) {
    if (J >= 64) {
        constexpr int d = J >> 6;
#pragma unroll
        for (int r = 0; r < NR; ++r) if ((r & d) == 0) {
            const bool up = (KK == 64 * NR) ? true : (((64 * r) & KK) == 0);
            const unsigned mn = umin_(k[r], k[r + d]), mx = umax_(k[r], k[r + d]);
            k[r] = up ? mn : mx; k[r + d] = up ? mx : mn;
        }
    } else {
        const bool lower = (lane & J) == 0;
        unsigned o[NR];
#pragma unroll
        for (int r = 0; r < NR; ++r) o[r] = xor_lane<(J < 64 ? J : 1)>(k[r], lane);
#pragma unroll
        for (int r = 0; r < NR; ++r) {
            const bool up = (KK == 64 * NR) ? true : (KK >= 64 ? (((64 * r) & KK) == 0) : ((lane & KK) == 0));
            k[r] = (lower == up) ? umin_(k[r], o[r]) : umax_(k[r], o[r]);
        }
    }
}
template <int NR, int KK, int J> struct SortJ { static __device__ __forceinline__ void run(unsigned (&k)[NR], int lane) { sort_stage<NR, KK, J>(k, lane); SortJ<NR, KK, J / 2>::run(k, lane); } };
template <int NR, int KK> struct SortJ<NR, KK, 0> { static __device__ __forceinline__ void run(unsigned (&)[NR], int) {} };
template <int NR, int KK> struct SortK { static __device__ __forceinline__ void run(unsigned (&k)[NR], int lane) { SortK<NR, KK / 2>::run(k, lane); SortJ<NR, KK, KK / 2>::run(k, lane); } };
template <int NR> struct SortK<NR, 1> { static __device__ __forceinline__ void run(unsigned (&)[NR], int) {} };
template <int NR>
__device__ __forceinline__ void sort_wave(unsigned (&k)[NR], int lane) { SortK<NR, 64 * NR>::run(k, lane); }
__device__ __forceinline__ void axpy_dispatch2(int t, int tbase, float cs, const f32x2 (&x)[8], f32x2 (&Ya)[8], f32x2 (&Yb)[8]) {
    const unsigned long long c = (unsigned long long)__float_as_uint(cs);
    const int tt = t - tbase;
    asm volatile(
        "s_cmp_gt_u32 %[t], 1\n\t"
        "s_cbranch_scc1 3f\n\t"
        "s_cmp_eq_u32 %[t], 1\n\t"
        "s_cbranch_scc1 2f\n\t"
        "v_pk_fma_f32 %[a0], %[c], %[x0], %[a0] op_sel_hi:[0,1,1]\n\t"
        "v_pk_fma_f32 %[a1], %[c], %[x1], %[a1] op_sel_hi:[0,1,1]\n\t"
        "v_pk_fma_f32 %[a2], %[c], %[x2], %[a2] op_sel_hi:[0,1,1]\n\t"
        "v_pk_fma_f32 %[a3], %[c], %[x3], %[a3] op_sel_hi:[0,1,1]\n\t"
        "v_pk_fma_f32 %[a4], %[c], %[x4], %[a4] op_sel_hi:[0,1,1]\n\t"
        "v_pk_fma_f32 %[a5], %[c], %[x5], %[a5] op_sel_hi:[0,1,1]\n\t"
        "v_pk_fma_f32 %[a6], %[c], %[x6], %[a6] op_sel_hi:[0,1,1]\n\t"
        "v_pk_fma_f32 %[a7], %[c], %[x7], %[a7] op_sel_hi:[0,1,1]\n\t"
        "s_branch 3f\n"
        "2:\n\t"
        "v_pk_fma_f32 %[b0], %[c], %[x0], %[b0] op_sel_hi:[0,1,1]\n\t"
        "v_pk_fma_f32 %[b1], %[c], %[x1], %[b1] op_sel_hi:[0,1,1]\n\t"
        "v_pk_fma_f32 %[b2], %[c], %[x2], %[b2] op_sel_hi:[0,1,1]\n\t"
        "v_pk_fma_f32 %[b3], %[c], %[x3], %[b3] op_sel_hi:[0,1,1]\n\t"
        "v_pk_fma_f32 %[b4], %[c], %[x4], %[b4] op_sel_hi:[0,1,1]\n\t"
        "v_pk_fma_f32 %[b5], %[c], %[x5], %[b5] op_sel_hi:[0,1,1]\n\t"
        "v_pk_fma_f32 %[b6], %[c], %[x6], %[b6] op_sel_hi:[0,1,1]\n\t"
        "v_pk_fma_f32 %[b7], %[c], %[x7], %[b7] op_sel_hi:[0,1,1]\n"
        "3:\n\t"
        : [a0] "+v"(Ya[0]), [a1] "+v"(Ya[1]), [a2] "+v"(Ya[2]), [a3] "+v"(Ya[3]), [a4] "+v"(Ya[4]), [a5] "+v"(Ya[5]), [a6] "+v"(Ya[6]), [a7] "+v"(Ya[7]),
          [b0] "+v"(Yb[0]), [b1] "+v"(Yb[1]), [b2] "+v"(Yb[2]), [b3] "+v"(Yb[3]), [b4] "+v"(Yb[4]), [b5] "+v"(Yb[5]), [b6] "+v"(Yb[6]), [b7] "+v"(Yb[7])
        : [x0] "v"(x[0]), [x1] "v"(x[1]), [x2] "v"(x[2]), [x3] "v"(x[3]), [x4] "v"(x[4]), [x5] "v"(x[5]), [x6] "v"(x[6]), [x7] "v"(x[7]), [c] "s"(c), [t] "s"(tt)
        : "scc");
}
__device__ __forceinline__ void axpy_dispatch2_dup(int t, int tbase, float cs, const f32x2 (&x)[8], f32x2 (&Ya)[8], f32x2 (&Yb)[8]) {
    const unsigned long long c = (unsigned long long)__float_as_uint(cs);
    const int tt = t - tbase;
    asm volatile(
        "s_cmp_gt_u32 %[t], 1\n\t"
        "s_cbranch_scc1 3f\n\t"
        "s_cmp_eq_u32 %[t], 1\n\t"
        "s_cbranch_scc1 2f\n\t"
        "v_pk_fma_f32 %[a0], %[c], %[x0], %[a0] op_sel_hi:[0,1,1]\n\t"
        "v_pk_fma_f32 %[a0], %[c], %[x0], %[a0] op_sel_hi:[0,1,1]\n\t"
        "v_pk_fma_f32 %[a1], %[c], %[x1], %[a1] op_sel_hi:[0,1,1]\n\t"
        "v_pk_fma_f32 %[a1], %[c], %[x1], %[a1] op_sel_hi:[0,1,1]\n\t"
        "v_pk_fma_f32 %[a2], %[c], %[x2], %[a2] op_sel_hi:[0,1,1]\n\t"
        "v_pk_fma_f32 %[a2], %[c], %[x2], %[a2] op_sel_hi:[0,1,1]\n\t"
        "v_pk_fma_f32 %[a3], %[c], %[x3], %[a3] op_sel_hi:[0,1,1]\n\t"
        "v_pk_fma_f32 %[a3], %[c], %[x3], %[a3] op_sel_hi:[0,1,1]\n\t"
        "v_pk_fma_f32 %[a4], %[c], %[x4], %[a4] op_sel_hi:[0,1,1]\n\t"
        "v_pk_fma_f32 %[a4], %[c], %[x4], %[a4] op_sel_hi:[0,1,1]\n\t"
        "v_pk_fma_f32 %[a5], %[c], %[x5], %[a5] op_sel_hi:[0,1,1]\n\t"
        "v_pk_fma_f32 %[a5], %[c], %[x5], %[a5] op_sel_hi:[0,1,1]\n\t"
        "v_pk_fma_f32 %[a6], %[c], %[x6], %[a6] op_sel_hi:[0,1,1]\n\t"
        "v_pk_fma_f32 %[a6], %[c], %[x6], %[a6] op_sel_hi:[0,1,1]\n\t"
        "v_pk_fma_f32 %[a7], %[c], %[x7], %[a7] op_sel_hi:[0,1,1]\n\t"
        "v_pk_fma_f32 %[a7], %[c], %[x7], %[a7] op_sel_hi:[0,1,1]\n\t"
        "s_branch 3f\n"
        "2:\n\t"
        "v_pk_fma_f32 %[b0], %[c], %[x0], %[b0] op_sel_hi:[0,1,1]\n\t"
        "v_pk_fma_f32 %[b0], %[c], %[x0], %[b0] op_sel_hi:[0,1,1]\n\t"
        "v_pk_fma_f32 %[b1], %[c], %[x1], %[b1] op_sel_hi:[0,1,1]\n\t"
        "v_pk_fma_f32 %[b1], %[c], %[x1], %[b1] op_sel_hi:[0,1,1]\n\t"
        "v_pk_fma_f32 %[b2], %[c], %[x2], %[b2] op_sel_hi:[0,1,1]\n\t"
        "v_pk_fma_f32 %[b2], %[c], %[x2], %[b2] op_sel_hi:[0,1,1]\n\t"
        "v_pk_fma_f32 %[b3], %[c], %[x3], %[b3] op_sel_hi:[0,1,1]\n\t"
        "v_pk_fma_f32 %[b3], %[c], %[x3], %[b3] op_sel_hi:[0,1,1]\n\t"
        "v_pk_fma_f32 %[b4], %[c], %[x4], %[b4] op_sel_hi:[0,1,1]\n\t"
        "v_pk_fma_f32 %[b4], %[c], %[x4], %[b4] op_sel_hi:[0,1,1]\n\t"
        "v_pk_fma_f32 %[b5], %[c], %[x5], %[b5] op_sel_hi:[0,1,1]\n\t"
        "v_pk_fma_f32 %[b5], %[c], %[x5], %[b5] op_sel_hi:[0,1,1]\n\t"
        "v_pk_fma_f32 %[b6], %[c], %[x6], %[b6] op_sel_hi:[0,1,1]\n\t"
        "v_pk_fma_f32 %[b6], %[c], %[x6], %[b6] op_sel_hi:[0,1,1]\n\t"
        "v_pk_fma_f32 %[b7], %[c], %[x7], %[b7] op_sel_hi:[0,1,1]\n"
        "v_pk_fma_f32 %[b7], %[c], %[x7], %[b7] op_sel_hi:[0,1,1]\n"
        "3:\n\t"
        : [a0] "+v"(Ya[0]), [a1] "+v"(Ya[1]), [a2] "+v"(Ya[2]), [a3] "+v"(Ya[3]), [a4] "+v"(Ya[4]), [a5] "+v"(Ya[5]), [a6] "+v"(Ya[6]), [a7] "+v"(Ya[7]),
          [b0] "+v"(Yb[0]), [b1] "+v"(Yb[1]), [b2] "+v"(Yb[2]), [b3] "+v"(Yb[3]), [b4] "+v"(Yb[4]), [b5] "+v"(Yb[5]), [b6] "+v"(Yb[6]), [b7] "+v"(Yb[7])
        : [x0] "v"(x[0]), [x1] "v"(x[1]), [x2] "v"(x[2]), [x3] "v"(x[3]), [x4] "v"(x[4]), [x5] "v"(x[5]), [x6] "v"(x[6]), [x7] "v"(x[7]), [c] "s"(c), [t] "s"(tt)
        : "scc");
}
__device__ __forceinline__ float tok_setup_mixed(unsigned& k0, unsigned& k1, int t, int j, int lane, LAS unsigned char* xs, const int* __restrict__ seli, const float* __restrict__ selg,
                                                 const float* __restrict__ part2, const bf16* __restrict__ h1b) {
    float ps = (lane < 16) ? part2[(size_t)t * 16 + lane] : 0.f;
    ps = wave_sum_x(ps);
    const float rstd2 = 1.0f / sqrtf(ps * (1.0f / 1024.0f) + EPS);
    f32x4 hv[4]; float am = 0.f;
    { const u32x4* br = (const u32x4*)(h1b + (size_t)t * 1024 + 16 * lane); const u32x4 b0 = br[0], b1 = br[1];
      hv[0] = bf4_lo((u32x2){b0.x, b0.y}); hv[1] = bf4_lo((u32x2){b0.z, b0.w}); hv[2] = bf4_lo((u32x2){b1.x, b1.y}); hv[3] = bf4_lo((u32x2){b1.z, b1.w}); }
#pragma unroll
    for (int i = 0; i < 4; ++i) { am = fmaxf(am, fmaxf(fmaxf(fabsf(hv[i][0]), fabsf(hv[i][1])), fmaxf(fabsf(hv[i][2]), fabsf(hv[i][3])))); }
    am = wave_max_x(am);
    const float sx = am > 0.f ? 127.0f / am : 1.0f, isx = am > 0.f ? am * (1.0f / 127.0f) : 1.0f;
    u32x4 xq;
#pragma unroll
    for (int i = 0; i < 4; ++i) { unsigned w = 0u;
#pragma unroll
        for (int c = 0; c < 4; ++c) w |= ((unsigned)(int)__builtin_rintf(hv[i][c] * sx) & 0xffu) << (8 * c);
        xq[i] = w; }
    *(LAS u32x4*)(xs + 16 * lane) = xq;
    const int iA = seli[(size_t)t * 128 + lane], iB = seli[(size_t)t * 128 + 64 + lane];
    const float gA = selg[(size_t)t * 128 + lane], gB = selg[(size_t)t * 128 + 64 + lane];
    k0 = ((unsigned)iA << 18) | ((unsigned)j << 16) | (unsigned)(gA * 65535.0f + 0.5f); k1 = ((unsigned)iB << 18) | ((unsigned)j << 16) | (unsigned)(gB * 65535.0f + 0.5f);
    return rstd2 * isx;
}
__device__ __forceinline__ void tok_finish_mixed(const f32x2 (&y2)[8], int t, int lane, const bf16* __restrict__ h1b, bf16* __restrict__ h2b, float* __restrict__ rstd3) {
    const u32x4* br = (const u32x4*)(h1b + (size_t)t * 1024 + 16 * lane); const u32x4 b0 = br[0], b1 = br[1];
    f32x4 h2[4]; h2[0] = bf4_lo((u32x2){b0.x, b0.y}); h2[1] = bf4_lo((u32x2){b0.z, b0.w}); h2[2] = bf4_lo((u32x2){b1.x, b1.y}); h2[3] = bf4_lo((u32x2){b1.z, b1.w});
    float sq = 0.f;
#pragma unroll
    for (int i = 0; i < 4; ++i) {
        h2[i] = h2[i] + (f32x4){y2[2 * i].x, y2[2 * i].y, y2[2 * i + 1].x, y2[2 * i + 1].y};
        sq += (h2[i][0] * h2[i][0] + h2[i][1] * h2[i][1]) + (h2[i][2] * h2[i][2] + h2[i][3] * h2[i][3]);
    }
    u32x4 w0, w1; w0.x = pk2(h2[0][0], h2[0][1]); w0.y = pk2(h2[0][2], h2[0][3]); w0.z = pk2(h2[1][0], h2[1][1]); w0.w = pk2(h2[1][2], h2[1][3]);
    w1.x = pk2(h2[2][0], h2[2][1]); w1.y = pk2(h2[2][2], h2[2][3]); w1.z = pk2(h2[3][0], h2[3][1]); w1.w = pk2(h2[3][2], h2[3][3]);
    u32x4* ob = (u32x4*)(h2b + (size_t)t * 1024 + 16 * lane); ob[0] = w0; ob[1] = w1;
    sq = wave_sum_x(sq);
    if (lane == 0) rstd3[t] = 1.0f / sqrtf(sq * (1.0f / 1024.0f) + EPS);
}
__device__ __forceinline__ i32x4v row_load(__amdgpu_buffer_rsrc_t r, int lane16, int e) { const u32x4 v = __builtin_amdgcn_raw_buffer_load_b128(r, lane16, e << 10, 0); return (i32x4v){(int)v.x, (int)v.y, (int)v.z, (int)v.w}; }
__device__ __forceinline__ u32x4 as_u32x4(i32x4v v) { return (u32x4){(unsigned)v.x, (unsigned)v.y, (unsigned)v.z, (unsigned)v.w}; }
#if V_FP6
typedef u32x3 VROW;
typedef unsigned u32x6 __attribute__((ext_vector_type(6)));
typedef float f32x32 __attribute__((ext_vector_type(32)));
__device__ __forceinline__ VROW vrow_load(__amdgpu_buffer_rsrc_t r, int lane, int e) { return __builtin_amdgcn_raw_buffer_load_b96(r, lane * 12, e * 768, 0); }
__device__ __forceinline__ VROW vrow_dummy(int e) { return (VROW){(unsigned)e, 0u, 0u}; }
#else
typedef u32x4 VROW;
__device__ __forceinline__ VROW vrow_load(__amdgpu_buffer_rsrc_t r, int lane, int e) { return as_u32x4(row_load(r, lane << 4, e)); }
__device__ __forceinline__ VROW vrow_dummy(int e) { return (VROW){(unsigned)e, 0u, 0u, 0u}; }
#endif
constexpr int MIX_LDS_WAVE = 4096 + 2048 + 64;
constexpr int XG = 2;
template <int PM>
__device__ __forceinline__ void gather_wg_mixed(int tok0, int wave, int lane, LAS unsigned char* lds, const unsigned char* __restrict__ U8, const unsigned char* __restrict__ V8, const float* __restrict__ IU, const float* __restrict__ IV,
                                                const int* __restrict__ seli, const float* __restrict__ selg, const float* __restrict__ part2, const bf16* __restrict__ h1b, bf16* __restrict__ h2b, float* __restrict__ rstd3, float* probe_out) {
    LAS unsigned char* xs = lds + wave * MIX_LDS_WAVE;
    LAS unsigned* ks = (LAS unsigned*)(xs + 4096);
    LAS float* rsl = (LAS float*)(xs + 4096 + 2048);
#pragma unroll 1
    for (int pass = 0; pass < 2; ++pass) {
        const int tb = tok0 + pass * 32 + wave * 4;
        unsigned k[8]; float rs0, rs1, rs2, rs3;
        rs0 = tok_setup_mixed(k[0], k[1], tb + 0, 0, fresh_lane(), xs, seli, selg, part2, h1b); __builtin_amdgcn_sched_barrier(0);
        rs1 = tok_setup_mixed(k[2], k[3], tb + 1, 1, fresh_lane(), xs + 1024, seli, selg, part2, h1b); __builtin_amdgcn_sched_barrier(0);
        rs2 = tok_setup_mixed(k[4], k[5], tb + 2, 2, fresh_lane(), xs + 2048, seli, selg, part2, h1b); __builtin_amdgcn_sched_barrier(0);
        rs3 = tok_setup_mixed(k[6], k[7], tb + 3, 3, fresh_lane(), xs + 3072, seli, selg, part2, h1b); __builtin_amdgcn_sched_barrier(0);
        lane = fresh_lane();
        sort_wave<8>(k, lane);
#pragma unroll
        for (int r = 0; r < 8; ++r) ks[lane + 64 * r] = k[r];
        if (lane == 0) { rsl[0] = rs0; rsl[1] = rs1; rsl[2] = rs2; rsl[3] = rs3; }
        __builtin_amdgcn_sched_barrier(0);
        f32x2 Y0[8], Y1[8], Y2[8], Y3[8];
#pragma unroll
        for (int i = 0; i < 8; ++i) { Y0[i] = (f32x2){0.f, 0.f}; Y1[i] = (f32x2){0.f, 0.f}; Y2[i] = (f32x2){0.f, 0.f}; Y3[i] = (f32x2){0.f, 0.f}; }
        __syncthreads();
        lane = fresh_lane();
#if MIX_PIPE
        const int lane16 = lane << 4;
        const __amdgpu_buffer_rsrc_t rU = __builtin_amdgcn_make_buffer_rsrc((void*)U8, 0, 16 << 20, 0x00020000), rV = __builtin_amdgcn_make_buffer_rsrc((void*)V8, 0, (V_FP6 ? 12 : 16) << 20, 0x00020000);
        unsigned kbN = ks[(pass ? 16 * 31 : 0) + (lane & 15)], keyN = ks[(pass ? 16 * 31 : 0) + (lane >> 2)];
        i32x4v A[16]; VROW vv[16];
#pragma unroll
        for (int q = 0; q < 16; ++q) { int e = (int)((unsigned)__builtin_amdgcn_readlane((int)kbN, q) >> 18); if (PM & 32) e &= 1023; if (PM & 2) A[q] = (i32x4v){e, e, e, e}; else A[q] = row_load(rU, lane16, e); }
#pragma unroll
        for (int q = 0; q < 16; ++q) { int e = (int)((unsigned)__builtin_amdgcn_readlane((int)kbN, q) >> 18); if (PM & 32) e &= 1023; if (PM & 1) vv[q] = vrow_dummy(e); else vv[q] = vrow_load(rV, lane, e); }
        float iuN = IU[keyN >> 18], ivN = IV[keyN >> 18];
#pragma unroll 1
        for (int bb = 0; bb < 32; ++bb) {
            const int bn = (bb + 1 < 32) ? bb + 1 : 31; const int b1 = pass ? 31 - bn : bn;
            const unsigned kb = kbN, key = keyN; const float iu = iuN, iv = ivN;
            kbN = ks[16 * b1 + (lane & 15)]; keyN = ks[16 * b1 + (lane >> 2)];
            const int tq = (int)(key >> 16) & 3;
            const float dus = iu * rsl[tq], gvs = (float)(key & 0xffffu) * (1.0f / 65535.0f) * iv;
            int pp[16];
#pragma unroll
            for (int g = 0; g < 16 / XG; ++g) {
                i32x4v Xg[XG];
#pragma unroll
                for (int i = 0; i < XG; ++i) { const int t = (__builtin_amdgcn_readlane((int)kb, XG * g + i) >> 16) & 3; Xg[i] = *(const LAS i32x4v*)(xs + t * 1024 + 16 * lane); }
#pragma unroll
                for (int i = 0; i < XG; ++i) { const int q = XG * g + i; const i32x4v X = Xg[i];
                    if (PM & 2) pp[q] = A[q][0] + X[0]; else
                    pp[q] = __builtin_amdgcn_sdot4(A[q][3], X[3], __builtin_amdgcn_sdot4(A[q][2], X[2], __builtin_amdgcn_sdot4(A[q][1], X[1], __builtin_amdgcn_sdot4(A[q][0], X[0], 0, false), false), false), false);
                    int e = (int)((unsigned)__builtin_amdgcn_readlane((int)kbN, q) >> 18); if (PM & 32) e &= 1023;
                    if (PM & 2) A[q] = (i32x4v){e, e, e, e}; else A[q] = row_load(rU, lane16, e);
                }
                __builtin_amdgcn_sched_barrier(0);
            }
            iuN = IU[keyN >> 18]; ivN = IV[keyN >> 18];
            const int tot = reduce16_rows(pp, lane);
            const float cf = gvs * gelu_tanh((float)tot * dus);
#if V_FP6
#pragma unroll
            for (int q2 = 0; q2 < 16; q2 += 2) {
                const u32x6 in6 = {vv[q2].x, vv[q2].y, vv[q2].z, vv[q2 + 1].x, vv[q2 + 1].y, vv[q2 + 1].z};
                const f32x32 f = __builtin_amdgcn_cvt_scalef32_pk32_f32_fp6(in6, 1.0f);
#pragma unroll
                for (int h = 0; h < 2; ++h) { const int q = q2 + h;
                    const int t = (__builtin_amdgcn_readlane((int)kb, q) >> 16) & 3;
                    const float cs = __int_as_float(__builtin_amdgcn_readlane(__float_as_int(cf), 4 * q));
                    f32x2 x[8];
#pragma unroll
                    for (int c = 0; c < 8; ++c) x[c] = (f32x2){f[16 * h + 2 * c], f[16 * h + 2 * c + 1]};
                    int e = (int)((unsigned)__builtin_amdgcn_readlane((int)kbN, q) >> 18); if (PM & 32) e &= 1023;
                    if (PM & 1) { vv[q] = vrow_dummy(e); Y0[q & 7].x += cs * x[0].x; } else {
                    vv[q] = vrow_load(rV, lane, e);
                    axpy_dispatch2(t, 0, cs, x, Y0, Y1);
                    axpy_dispatch2(t, 2, cs, x, Y2, Y3); }
                }
            }
#else
#pragma unroll
            for (int q = 0; q < 16; ++q) {
                const int t = (__builtin_amdgcn_readlane((int)kb, q) >> 16) & 3;
                const float cs = __int_as_float(__builtin_amdgcn_readlane(__float_as_int(cf), 4 * q));
                f32x2 x[8];
#pragma unroll
                for (int c = 0; c < 4; ++c) { x[2 * c] = __builtin_amdgcn_cvt_pk_f32_fp8(vv[q][c], false); x[2 * c + 1] = __builtin_amdgcn_cvt_pk_f32_fp8(vv[q][c], true); }
                int e = (int)((unsigned)__builtin_amdgcn_readlane((int)kbN, q) >> 18); if (PM & 32) e &= 1023;
                if (PM & 1) { vv[q] = vrow_dummy(e); Y0[q & 7].x += cs * x[0].x; } else {
                vv[q] = vrow_load(rV, lane, e);
                if (PM & 128) { axpy_dispatch2_dup(t, 0, cs, x, Y0, Y1); axpy_dispatch2_dup(t, 2, cs, x, Y2, Y3); } else {
                axpy_dispatch2(t, 0, cs, x, Y0, Y1);
                axpy_dispatch2(t, 2, cs, x, Y2, Y3); } }
            }
#endif
        }
#else
#pragma unroll 1
        for (int b = 0; b < 32; ++b) {
            const unsigned kb = ks[16 * b + (lane & 15)];
            const unsigned key = ks[16 * b + (lane >> 2)];
            const int es = (int)(key >> 18); const int tq = (int)(key >> 16) & 3;
            const float rsx = rsl[tq];
            const float dus = IU[es] * rsx, gvs = (float)(key & 0xffffu) * (1.0f / 65535.0f) * IV[es];
            i32x4v A[16]; u32x4 vv[16];
#pragma unroll
            for (int q = 0; q < 16; ++q) { int e = (int)((unsigned)__builtin_amdgcn_readlane((int)kb, q) >> 18); if (PM & 32) e &= 1023; A[q] = *(const i32x4v*)(U8 + (size_t)e * 1024 + 16 * lane); }
#pragma unroll
            for (int q = 0; q < 16; ++q) { int e = (int)((unsigned)__builtin_amdgcn_readlane((int)kb, q) >> 18); if (PM & 32) e &= 1023; vv[q] = *(const u32x4*)(V8 + (size_t)e * 1024 + 16 * lane); }
            int pp[16];
#pragma unroll
            for (int q = 0; q < 16; ++q) {
                const int t = (__builtin_amdgcn_readlane((int)kb, q) >> 16) & 3;
                const i32x4v X = *(const LAS i32x4v*)(xs + t * 1024 + 16 * lane);
                pp[q] = __builtin_amdgcn_sdot4(A[q][3], X[3], __builtin_amdgcn_sdot4(A[q][2], X[2], __builtin_amdgcn_sdot4(A[q][1], X[1], __builtin_amdgcn_sdot4(A[q][0], X[0], 0, false), false), false), false);
            }
            const int tot = reduce16_rows(pp, lane);
            const float cf = gvs * gelu_tanh((float)tot * dus);
#pragma unroll
            for (int q = 0; q < 16; ++q) {
                const int t = (__builtin_amdgcn_readlane((int)kb, q) >> 16) & 3;
                const float cs = __int_as_float(__builtin_amdgcn_readlane(__float_as_int(cf), 4 * q));
                f32x2 x[8];
#pragma unroll
                for (int c = 0; c < 4; ++c) { x[2 * c] = __builtin_amdgcn_cvt_pk_f32_fp8(vv[q][c], false); x[2 * c + 1] = __builtin_amdgcn_cvt_pk_f32_fp8(vv[q][c], true); }
                axpy_dispatch2(t, 0, cs, x, Y0, Y1);
                axpy_dispatch2(t, 2, cs, x, Y2, Y3);
            }
            __builtin_amdgcn_sched_barrier(0);
        }
#endif
        if (PM != 0) { const int fl = fresh_lane(); f32x2 a = Y0[0] + Y1[0] + Y2[0] + Y3[0];
#pragma unroll
            for (int i = 1; i < 8; ++i) a += Y0[i] + Y1[i] + Y2[i] + Y3[i];
            probe_out[(size_t)tb * 64 + fl] = a.x + a.y; }
        else { const int fl = fresh_lane(); tok_finish_mixed(Y0, tb, fl, h1b, h2b, rstd3); tok_finish_mixed(Y1, tb + 1, fl, h1b, h2b, rstd3); tok_finish_mixed(Y2, tb + 2, fl, h1b, h2b, rstd3); tok_finish_mixed(Y3, tb + 3, fl, h1b, h2b, rstd3); }
        __syncthreads();
    }
}
namespace pg8 {
#define PG8_LAS __attribute__((address_space(3)))
typedef unsigned short bf16_t;
typedef short bf16x8 __attribute__((ext_vector_type(8)));
typedef float f32x4 __attribute__((ext_vector_type(4)));
typedef unsigned u32x4 __attribute__((ext_vector_type(4)));
constexpr int BM = 256, BK = 64, HALF = 128, HTB = HALF * BK * 2  , STAGE_BYTES = 8 * HTB, NXCD = 8, WGM = 8;

__host__ __device__ __forceinline__ int lds_byte(int r, int c) { const int st = (r >> 4) * 2 + (c >> 5), rr = r & 15, cc = c & 31, ob = rr * 64 + cc * 2; return st * 1024 + (ob ^ (((ob >> 9) & 1) << 5)); }
__host__ __device__ __forceinline__ void stage_rc(int b, int& R, int& C) { const int st = b / 1024, sb = b % 1024, swz = sb ^ (((sb >> 9) & 1) << 5); R = (st >> 1) * 16 + swz / 64; C = (st & 1) * 32 + (swz % 64) / 2; }
__host__ __device__ __forceinline__ int perm32(int rho) { const int n = rho >> 4, i = rho & 15; return 8 * (i >> 2) + 4 * n + (i & 3); }

struct Unit { int pm, pn; };
struct Gemm { const bf16_t* A; const bf16_t* Bt; int K, lda, apn_shift, apn_stride; };

struct StaticOrder {
    int nM, nN, nwg, G, c;
    __host__ __device__ __forceinline__ void init(int M, int N, int G_, int c_) { nM = M / BM; nN = N / BM; nwg = nM * nN; G = G_; c = c_; }
    __host__ __device__ __forceinline__ bool next(int i, Unit& u) const {
        const long L = (long)i * G + c; if (L >= nwg) return false;
        int wgid = (int)L; { const int q = nwg / NXCD, r = nwg % NXCD, xcd = wgid % NXCD, off = wgid / NXCD; wgid = (xcd < r ? xcd * (q + 1) : r * (q + 1) + (xcd - r) * q) + off; }
        const int nig = WGM * nN, gid = wgid / nig, fm = gid * WGM, gsz = (nM - fm) < WGM ? (nM - fm) : WGM;
        u.pm = fm + ((wgid % nig) % gsz); u.pn = (wgid % nig) / gsz; return true;
    }
    __device__ __forceinline__ void a_ready(const Unit&) const {}
    __device__ __forceinline__ void done(const Unit&) const {}
};

__device__ __forceinline__ unsigned cvt_pk_bf16(float lo, float hi) { unsigned r; asm volatile("v_cvt_pk_bf16_f32 %0, %1, %2" : "=v"(r) : "v"(lo), "v"(hi)); return r; }

template <class Epi, class Sched, bool ALIGN_EPI = false, bool SP2 = false>
__device__ __forceinline__ void gemm_phase(PG8_LAS unsigned char* lds, const Gemm g, const Sched& S, const Epi& E, int wave_id  ) {
    const int lane = fresh_lane(), wid = wave_id, tid = wid * 64 + lane, wr = wid >> 2, wc = wid & 3, fr = lane & 15, fq = lane >> 4;
    const int K = g.K, nt = K / BK;
    unsigned voffA[2], voffB[2];
#pragma unroll
    for (int i = 0; i < 2; ++i) { int R, C; stage_rc(tid * 16 + i * 8192, R, C); const int Rb = Epi::PERM ? ((R & ~31) + perm32(R & 31)) : R;
        voffA[i] = (unsigned)(R * g.lda + C) * 2u; voffB[i] = (unsigned)(Rb * K + C) * 2u; }
    const size_t kstep = (size_t)(BK * 2);
    const size_t hstepA = (size_t)HALF * g.lda * 2, hstepB = (size_t)HALF * K * 2;
    const size_t tstepA = 2 * hstepA, tstepB = 2 * hstepB;
    const unsigned ldsw = (unsigned)wid * 1024u;
    const int aoff = lds_byte(wr * 64 + fr, fq * 8), boff = lds_byte(wc * 32 + fr, fq * 8);
#define PG8_SA(b, h) (((b) * 2 + (h)) * HTB)
#define PG8_SB(b, h) ((4 + (b) * 2 + (h)) * HTB)
#define PG8_STAGE(bufoff, gbase, voff) do { _Pragma("unroll") for (int _i = 0; _i < 2; ++_i) \
        __builtin_amdgcn_global_load_lds((const unsigned*)((const char*)(gbase) + (voff)[_i]), (PG8_LAS unsigned*)(lds + (bufoff) + ldsw + _i * 8192), 16, 0, 0); } while (0)
#define PG8_LDA(dst, b, h) do { _Pragma("unroll") for (int m = 0; m < 4; ++m) _Pragma("unroll") for (int k = 0; k < 2; ++k) dst[m][k] = *(const PG8_LAS bf16x8*)(lds + PG8_SA(b, h) + aoff + m * 2048 + k * 1024); } while (0)
#define PG8_LDB(dst, b, h) do { _Pragma("unroll") for (int n = 0; n < 2; ++n) _Pragma("unroll") for (int k = 0; k < 2; ++k) dst[n][k] = *(const PG8_LAS bf16x8*)(lds + PG8_SB(b, h) + boff + n * 2048 + k * 1024); } while (0)
#define PG8_MMA(ai, bj, At, Bt) do { __builtin_amdgcn_s_setprio(1); _Pragma("unroll") for (int m = 0; m < 4; ++m) _Pragma("unroll") for (int n = 0; n < 2; ++n) _Pragma("unroll") for (int k = 0; k < 2; ++k) \
        acc[ai][bj][m][n] = __builtin_amdgcn_mfma_f32_16x16x32_bf16(Bt[n][k], At[m][k], acc[ai][bj][m][n], 0, 0, 0); __builtin_amdgcn_s_setprio(0); } while (0)
#define PG8_WAIT_V(n) asm volatile("s_waitcnt vmcnt(" #n ")" ::: "memory")
#define PG8_WAIT_L(n) asm volatile("s_waitcnt lgkmcnt(" #n ")" ::: "memory")
#define PG8_BAR __builtin_amdgcn_s_barrier()
#define PG8_SCHED __builtin_amdgcn_sched_barrier(0)
    Unit cur, nxt; int ui = 0;
    if (!S.next(0, cur)) return;
    f32x4 acc[2][2][4][2];
#pragma unroll
    for (int a = 0; a < 2; ++a)
#pragma unroll
        for (int b = 0; b < 2; ++b)
#pragma unroll
            for (int m = 0; m < 4; ++m)
#pragma unroll
                for (int n = 0; n < 2; ++n) acc[a][b][m][n] = (f32x4){0.f, 0.f, 0.f, 0.f};
    bf16x8 At[4][2], B0[2][2], B1[2][2];
    const char* cA = (const char*)g.A + (size_t)cur.pm * tstepA + (size_t)((cur.pn >> g.apn_shift) * g.apn_stride) * 2; const char* cB = (const char*)g.Bt + (size_t)cur.pn * tstepB;
    S.a_ready(cur);
    if constexpr (SP2) {
        PG8_STAGE(PG8_SB(0, 0), cB, voffB); PG8_STAGE(PG8_SB(0, 1), cB + hstepB, voffB); PG8_STAGE(PG8_SA(0, 0), cA, voffA); PG8_STAGE(PG8_SA(0, 1), cA + hstepA, voffA);
        if (wr == 1) PG8_BAR;
        PG8_WAIT_V(2); PG8_BAR;
        PG8_STAGE(PG8_SB(1, 0), cB + kstep, voffB); PG8_STAGE(PG8_SA(1, 0), cA + kstep, voffA); PG8_STAGE(PG8_SB(1, 1), cB + hstepB + kstep, voffB);
        PG8_WAIT_V(6); PG8_BAR;
    } else {
        PG8_STAGE(PG8_SB(0, 0), cB, voffB); PG8_STAGE(PG8_SA(0, 0), cA, voffA); PG8_STAGE(PG8_SB(0, 1), cB + hstepB, voffB); PG8_STAGE(PG8_SA(0, 1), cA + hstepA, voffA);
        if (wr == 1) PG8_BAR;
        PG8_WAIT_V(4); PG8_BAR;
        PG8_STAGE(PG8_SB(1, 0), cB + kstep, voffB); PG8_STAGE(PG8_SA(1, 0), cA + kstep, voffA); PG8_STAGE(PG8_SB(1, 1), cB + hstepB + kstep, voffB);
        PG8_WAIT_V(6); PG8_BAR;
    }
    for (;;) {
        const bool has_next = S.next(ui + 1, nxt);
        const char* nA = has_next ? (const char*)g.A + (size_t)nxt.pm * tstepA + (size_t)((nxt.pn >> g.apn_shift) * g.apn_stride) * 2 : cA; const char* nB = has_next ? (const char*)g.Bt + (size_t)nxt.pn * tstepB : cB;
#pragma unroll 1
        for (int t = 0; t < nt; t += 2) {
            const bool last = (t == nt - 2);
            const char* a1 = cA + (size_t)(t + 1) * kstep;
            const char* a2 = last ? nA : cA + (size_t)(t + 2) * kstep; const char* b2 = last ? nB : cB + (size_t)(t + 2) * kstep;
            const char* a3 = a2 + kstep; const char* b3 = b2 + kstep;
            if (last && has_next) S.a_ready(nxt);
            if constexpr (SP2) {
            PG8_LDB(B0, 0, 0); PG8_LDB(B1, 0, 1); PG8_SCHED; PG8_LDA(At, 0, 0); PG8_STAGE(PG8_SA(1, 1), a1 + hstepA, voffA);
            PG8_WAIT_V(8); PG8_WAIT_L(0); PG8_BAR; PG8_MMA(0, 0, At, B0); PG8_MMA(0, 1, At, B1); PG8_BAR; PG8_SCHED;
            PG8_LDA(At, 0, 1); PG8_STAGE(PG8_SB(0, 0), b2, voffB); PG8_STAGE(PG8_SB(0, 1), b2 + hstepB, voffB); PG8_STAGE(PG8_SA(0, 0), a2, voffA);
            PG8_WAIT_V(8); PG8_WAIT_L(0); PG8_BAR; PG8_MMA(1, 0, At, B0); PG8_MMA(1, 1, At, B1); PG8_BAR; PG8_SCHED;
            PG8_LDB(B0, 1, 0); PG8_LDB(B1, 1, 1); PG8_SCHED; PG8_LDA(At, 1, 0); PG8_STAGE(PG8_SA(0, 1), a2 + hstepA, voffA);
            PG8_WAIT_V(8); PG8_WAIT_L(0); PG8_BAR; PG8_MMA(0, 0, At, B0); PG8_MMA(0, 1, At, B1); PG8_BAR; PG8_SCHED;
            PG8_LDA(At, 1, 1); PG8_STAGE(PG8_SB(1, 0), b3, voffB); PG8_STAGE(PG8_SB(1, 1), b3 + hstepB, voffB); PG8_STAGE(PG8_SA(1, 0), a3, voffA);
            PG8_WAIT_V(8); PG8_WAIT_L(0); PG8_BAR; PG8_MMA(1, 0, At, B0); PG8_MMA(1, 1, At, B1); PG8_BAR; PG8_SCHED;
            } else {
            PG8_LDB(B0, 0, 0); PG8_SCHED; PG8_LDA(At, 0, 0); PG8_STAGE(PG8_SA(1, 1), a1 + hstepA, voffA);
            PG8_WAIT_L(8); PG8_BAR; PG8_WAIT_L(0); PG8_MMA(0, 0, At, B0); PG8_BAR; PG8_SCHED;
            PG8_LDB(B1, 0, 1); PG8_STAGE(PG8_SB(0, 0), b2, voffB);
            PG8_BAR; PG8_WAIT_L(0); PG8_MMA(0, 1, At, B1); PG8_BAR;
            PG8_LDA(At, 0, 1); PG8_STAGE(PG8_SA(0, 0), a2, voffA);
            PG8_BAR; PG8_WAIT_L(0); PG8_MMA(1, 0, At, B0); PG8_BAR; PG8_SCHED;
            PG8_STAGE(PG8_SB(0, 1), b2 + hstepB, voffB);
            PG8_WAIT_V(6); PG8_BAR; PG8_MMA(1, 1, At, B1); PG8_BAR;
            PG8_LDB(B0, 1, 0); PG8_SCHED; PG8_LDA(At, 1, 0); PG8_STAGE(PG8_SA(0, 1), a2 + hstepA, voffA);
            PG8_WAIT_L(8); PG8_BAR; PG8_WAIT_L(0); PG8_MMA(0, 0, At, B0); PG8_BAR; PG8_SCHED;
            PG8_LDB(B1, 1, 1); PG8_STAGE(PG8_SB(1, 0), b3, voffB);
            PG8_BAR; PG8_WAIT_L(0); PG8_MMA(0, 1, At, B1); PG8_BAR;
            PG8_LDA(At, 1, 1); PG8_STAGE(PG8_SA(1, 0), a3, voffA);
            PG8_BAR; PG8_WAIT_L(0); PG8_MMA(1, 0, At, B0); PG8_BAR; PG8_SCHED;
            PG8_STAGE(PG8_SB(1, 1), b3 + hstepB, voffB);
            PG8_WAIT_V(6); PG8_BAR; PG8_MMA(1, 1, At, B1); PG8_BAR;
            }
        }
        if constexpr (ALIGN_EPI) { if (wr == 0) PG8_BAR; }
        if constexpr (!Epi::AFTER_DRAIN) { E(acc, cur, wr, wc, fr, fq); S.done(cur); }
        if (!has_next) break;
#pragma unroll
        for (int a = 0; a < 2; ++a)
#pragma unroll
            for (int b = 0; b < 2; ++b)
#pragma unroll
                for (int m = 0; m < 4; ++m)
#pragma unroll
                    for (int n = 0; n < 2; ++n) acc[a][b][m][n] = (f32x4){0.f, 0.f, 0.f, 0.f};
        cur = nxt; cA = nA; cB = nB; ++ui;
        if constexpr (ALIGN_EPI) { if (wr == 1) PG8_BAR; }
    }
    PG8_WAIT_V(0);
    if constexpr (!ALIGN_EPI) { if (wr == 0) PG8_BAR; }
    PG8_BAR;
    if constexpr (Epi::AFTER_DRAIN) { E.fused(acc, cur, wr, wc, fr, fq, lds, wid, lane); S.done(cur); }
#undef PG8_SA
#undef PG8_SB
#undef PG8_STAGE
#undef PG8_LDA
#undef PG8_LDB
#undef PG8_MMA
#undef PG8_WAIT_V
#undef PG8_WAIT_L
#undef PG8_BAR
#undef PG8_SCHED
}
}
#define GAS __attribute__((address_space(1)))
typedef GAS unsigned gu32;
#define RLX_AGENT __ATOMIC_RELAXED, __HIP_MEMORY_SCOPE_AGENT
#define LDS_WAIT() asm volatile("s_waitcnt lgkmcnt(0)" ::: "memory")
#define VM_WAIT() asm volatile("s_waitcnt vmcnt(0)" ::: "memory")
#define XB_TMO      128
#define XB_XCNT(j)  (256  + 64 * (j))
#define XB_XSUB(j)  (1280 + 64 * (j))
#define XB_XGEN(j)  (2304 + 64 * (j))
#define XB_TOP      3328
#define XB_TOPGEN   3392
#define XCD_BAR_WORDS 3456
#define XB_SPIN_CAP (1u << 18)

__device__ __forceinline__ unsigned xb_ld(unsigned* p)              { return __hip_atomic_load(p, __ATOMIC_RELAXED, __HIP_MEMORY_SCOPE_AGENT); }
__device__ __forceinline__ unsigned xb_add(unsigned* p, unsigned v) { return __hip_atomic_fetch_add(p, v, __ATOMIC_RELAXED, __HIP_MEMORY_SCOPE_AGENT); }
__device__ __forceinline__ unsigned xb_xcc_id() { return (unsigned)__builtin_amdgcn_s_getreg((3 << 11) | 20) & 0xFu; }
#define XB_SPIN(cond, bar) do { unsigned _sp = 0; while (cond) { __builtin_amdgcn_s_sleep(1); \
    if ((++_sp & 255u) == 0u) { if (xb_ld(&(bar)[XB_TMO])) break; if (_sp > XB_SPIN_CAP) { atomicAdd(&(bar)[XB_TMO], 1u); break; } } } } while (0)

struct XcdBarrier {
    unsigned* bar; unsigned x;
    volatile LAS unsigned* st;
};

__device__ __forceinline__ XcdBarrier xcd_barrier_post(unsigned* bar, volatile LAS unsigned* st) {
    XcdBarrier b; b.bar = bar; b.x = xb_xcc_id(); b.st = st;
    if (threadIdx.x == 0) (void)xb_add(&bar[XB_XCNT(b.x)], 1u);
    return b;
}
__device__ __forceinline__ void xcd_barrier_complete(unsigned* bar, unsigned x, unsigned& nloc, unsigned& nx) {
    const unsigned G = gridDim.x * gridDim.y * gridDim.z;
    unsigned sum, cnt, mine, sp = 0u;
    for (;;) {
        sum = 0u; cnt = 0u; mine = 0u;
#pragma unroll
        for (unsigned j = 0; j < 16; ++j) { const unsigned c = xb_ld(&bar[XB_XCNT(j)]); sum += c; cnt += (c > 0u) ? 1u : 0u; mine = (j == x) ? c : mine; }
        if (sum == G) break;
        __builtin_amdgcn_s_sleep(1);
        if ((++sp & 255u) == 0u) { if (xb_ld(&bar[XB_TMO])) break; if (sp > XB_SPIN_CAP) { atomicAdd(&bar[XB_TMO], 1u); break; } }
    }
    nloc = mine > 0u ? mine : 1u; nx = cnt > 0u ? cnt : 1u;
}

__device__ __forceinline__ void xcd_barrier(const XcdBarrier& b) {
    asm volatile("s_waitcnt vmcnt(0)" ::: "memory");
    __syncthreads();
    if (threadIdx.x == 0) {
        unsigned* bar = b.bar;
        __builtin_amdgcn_s_waitcnt(0);
        unsigned nloc = b.st[0], nx = b.st[1];
        if (nloc == 0u) { xcd_barrier_complete(bar, b.x, nloc, nx); b.st[0] = nloc; b.st[1] = nx; }
        const unsigned old = xb_add(&bar[XB_XSUB(b.x)], 1u);
        const unsigned gen = old / nloc;
        if (old + 1u == (gen + 1u) * nloc) {
            __builtin_amdgcn_fence(__ATOMIC_RELEASE, "agent");
            asm volatile("s_waitcnt vmcnt(0)" ::: "memory");
            const unsigned og = xb_add(&bar[XB_TOP], 1u);
            const unsigned tg = og / nx;
            if (og + 1u == (tg + 1u) * nx) xb_add(&bar[XB_TOPGEN], 1u);
            else XB_SPIN(xb_ld(&bar[XB_TOPGEN]) == tg, bar);
            __builtin_amdgcn_fence(__ATOMIC_ACQUIRE, "agent");
            xb_add(&bar[XB_XGEN(b.x)], 1u);
            asm volatile("s_waitcnt vmcnt(0)" ::: "memory");
        } else {
            XB_SPIN(xb_ld(&bar[XB_XGEN(b.x)]) == gen, bar);
            __builtin_amdgcn_fence(__ATOMIC_ACQUIRE, "agent");
            asm volatile("s_waitcnt vmcnt(0)" ::: "memory");
        }
    }
    __syncthreads();
}

constexpr int NWAVES = 8;
constexpr int LDS_MAIN = 135168;
constexpr int LDSCTL_OFF = LDS_MAIN;
constexpr int LDS_BYTES = 147456;
constexpr int CW_BAR = 4096;
constexpr size_t CTL_ZERO_BYTES = 1 * MiB;
constexpr float LOG2E = 1.4426950408889634f;
typedef short bf16x8 __attribute__((ext_vector_type(8)));
typedef float f32x16 __attribute__((ext_vector_type(16)));
typedef unsigned u32x2 __attribute__((ext_vector_type(2)));
using pg8::Unit;
using pg8::cvt_pk_bf16;

__device__ __forceinline__ f32x4 sig4(f32x4 v) { return (f32x4){sigmoidf_(v[0]), sigmoidf_(v[1]), sigmoidf_(v[2]), sigmoidf_(v[3])}; }
__device__ __forceinline__ f32x4 gelu4(f32x4 v) { return (f32x4){gelu_tanh(v[0]), gelu_tanh(v[1]), gelu_tanh(v[2]), gelu_tanh(v[3])}; }
__device__ __forceinline__ u32x4 pack8(f32x4 a, f32x4 b) { u32x4 w; w.x = cvt_pk_bf16(a[0], a[1]); w.y = cvt_pk_bf16(a[2], a[3]); w.z = cvt_pk_bf16(b[0], b[1]); w.w = cvt_pk_bf16(b[2], b[3]); return w; }

struct OneUnit { pg8::StaticOrder S; int k;
    __device__ __forceinline__ bool next(int i, Unit& u) const { return i == 0 && S.next(k, u); }
    __device__ __forceinline__ void a_ready(const Unit&) const {}
    __device__ __forceinline__ void done(const Unit&) const {} };
struct EpiProj {
    static constexpr bool PERM = true, AFTER_DRAIN = false;
    const float* rstd; unsigned char* ws;
    __device__ __forceinline__ void operator()(const f32x4 (&acc)[2][2][4][2], const Unit& u, int wr, int wc, int fr, int fq) const {
        { const int t_ = fresh_lane(); fr = t_ & 15; fq = t_ >> 4; }
        const int pn = u.pn; bf16* base; int ldc, coff, act;
        if (pn < 3) { base = (bf16*)(ws + WS_QKV); ldc = 768; coff = pn * 256; act = 0; }
        else if (pn < 7) { base = (bf16*)(ws + WS_LX); ldc = 1024; coff = (pn - 3) * 256; act = 0; }
        else if (pn < 11) { base = (bf16*)(ws + WS_GL); ldc = 1024; coff = (pn - 7) * 256; act = 1; }
        else if (pn < 15) { base = (bf16*)(ws + WS_SGA); ldc = 1024; coff = (pn - 11) * 256; act = 2; }
        else { base = (bf16*)(ws + WS_SGL); ldc = 1024; coff = (pn - 15) * 256; act = 2; }
        const int row0 = u.pm * 256 + wr * 64 + fr, col0 = coff + wc * 32 + 8 * fq;
#pragma unroll
        for (int ai = 0; ai < 2; ++ai)
#pragma unroll
            for (int m = 0; m < 4; ++m) {
                const int r = row0 + ai * 128 + m * 16; const float rs = rstd[r]; bf16* rowp = base + (size_t)r * ldc + col0;
#pragma unroll
                for (int bj = 0; bj < 2; ++bj) {
                    f32x4 v0 = acc[ai][bj][m][0] * rs, v1 = acc[ai][bj][m][1] * rs;
                    if (act == 1) { v0 = gelu4(v0); v1 = gelu4(v1); } else if (act == 2) { v0 = sig4(v0); v1 = sig4(v1); }
                    *(u32x4*)(rowp + bj * 128) = pack8(v0, v1);
                }
            }
    }
};
struct EpiMP {
    static constexpr bool PERM = false, AFTER_DRAIN = false;
    const bf16* sga; float* mp;
    __device__ __forceinline__ void operator()(const f32x4 (&acc)[2][2][4][2], const Unit& u, int wr, int wc, int fr, int fq) const {
        { const int t_ = fresh_lane(); fr = t_ & 15; fq = t_ >> 4; }
        const int row0 = u.pm * 256 + wr * 64 + fr, col0 = u.pn * 256 + wc * 32 + 4 * fq;
#pragma unroll
        for (int ai = 0; ai < 2; ++ai)
#pragma unroll
            for (int m = 0; m < 4; ++m) {
                const size_t off = (size_t)(row0 + ai * 128 + m * 16) * 1024 + col0;
#pragma unroll
                for (int bj = 0; bj < 2; ++bj)
#pragma unroll
                    for (int n = 0; n < 2; ++n) { const size_t o = off + bj * 128 + n * 16; const f32x4 g = bf4_lo(*(const u32x2*)(sga + o)); const f32x4 v = acc[ai][bj][m][n] * g;
#if ALL_FUSED
                        u32x2 w; w.x = cvt_pk_bf16(v[0], v[1]); w.y = cvt_pk_bf16(v[2], v[3]); *(u32x2*)((bf16*)mp + o) = w;
#else
                        *(f32x4*)(mp + o) = v;
#endif
                    }
            }
    }
};
struct EpiMerged {
    static constexpr bool PERM = true, AFTER_DRAIN = false;
    const bf16* sgl; const float* mp; bf16* merged;
    __device__ __forceinline__ void operator()(const f32x4 (&acc)[2][2][4][2], const Unit& u, int wr, int wc, int fr, int fq) const {
        { const int t_ = fresh_lane(); fr = t_ & 15; fq = t_ >> 4; }
        const int row0 = u.pm * 256 + wr * 64 + fr, col0 = u.pn * 256 + wc * 32 + 8 * fq;
#pragma unroll
        for (int ai = 0; ai < 2; ++ai)
#pragma unroll
            for (int m = 0; m < 4; ++m) {
                const size_t off = (size_t)(row0 + ai * 128 + m * 16) * 1024 + col0;
#pragma unroll
                for (int bj = 0; bj < 2; ++bj) {
                    const size_t o = off + bj * 128; const u32x4 gw = *(const u32x4*)(sgl + o);
#if ALL_FUSED
                    const u32x4 mw = *(const u32x4*)((const bf16*)mp + o); const f32x4 m0 = bf4_lo((u32x2){mw.x, mw.y}), m1 = bf4_lo((u32x2){mw.z, mw.w});
#else
                    const f32x4 m0 = *(const f32x4*)(mp + o), m1 = *(const f32x4*)(mp + o + 4);
#endif
                    const f32x4 v0 = m0 + acc[ai][bj][m][0] * bf4_lo((u32x2){gw.x, gw.y}), v1 = m1 + acc[ai][bj][m][1] * bf4_lo((u32x2){gw.z, gw.w});
                    *(u32x4*)(merged + o) = pack8(v0, v1);
                }
            }
    }
};
struct EpiH1 {
    static constexpr bool PERM = true, AFTER_DRAIN = false;
    const float* x; float* h1; bf16* h1b; float* part;
    __device__ __forceinline__ void operator()(const f32x4 (&acc)[2][2][4][2], const Unit& u, int wr, int wc, int fr, int fq) const {
        { const int t_ = fresh_lane(); fr = t_ & 15; fq = t_ >> 4; }
        const int row0 = u.pm * 256 + wr * 64 + fr, col0 = u.pn * 256 + wc * 32 + 8 * fq;
#pragma unroll
        for (int ai = 0; ai < 2; ++ai)
#pragma unroll
            for (int m = 0; m < 4; ++m) {
                const int r = row0 + ai * 128 + m * 16; const size_t off = (size_t)r * 1024 + col0; float sq = 0.f;
#pragma unroll
                for (int bj = 0; bj < 2; ++bj) {
                    const size_t o = off + bj * 128;
                    const f32x4 v0 = *(const f32x4*)(x + o) + acc[ai][bj][m][0], v1 = *(const f32x4*)(x + o + 4) + acc[ai][bj][m][1];
#if !ALL_FUSED
                    *(f32x4*)(h1 + o) = v0; *(f32x4*)(h1 + o + 4) = v1;
#endif
                    *(u32x4*)(h1b + o) = pack8(v0, v1);
                    sq += (v0[0] * v0[0] + v0[1] * v0[1]) + (v0[2] * v0[2] + v0[3] * v0[3]) + (v1[0] * v1[0] + v1[1] * v1[1]) + (v1[2] * v1[2] + v1[3] * v1[3]);
                }
                sq += __shfl_xor(sq, 16); sq += __shfl_xor(sq, 32);
                if (fq == 0) part[(size_t)r * 16 + u.pn * 4 + wc] = sq;
            }
    }
};
struct EpiScore {
    static constexpr bool PERM = false, AFTER_DRAIN = false;
    const float* part; float* sc;
    __device__ __forceinline__ void operator()(const f32x4 (&acc)[2][2][4][2], const Unit& u, int wr, int wc, int fr, int fq) const {
        { const int t_ = fresh_lane(); fr = t_ & 15; fq = t_ >> 4; }
        const int row0 = u.pm * 256 + wr * 64 + fr, col0 = u.pn * 256 + wc * 32 + 4 * fq;
#pragma unroll
        for (int ai = 0; ai < 2; ++ai)
#pragma unroll
            for (int m = 0; m < 4; ++m) {
                const int r = row0 + ai * 128 + m * 16; const f32x4* pp = (const f32x4*)(part + (size_t)r * 16);
                const f32x4 s4 = (pp[0] + pp[1]) + (pp[2] + pp[3]); const float rs = 1.0f / sqrtf(((s4[0] + s4[1]) + (s4[2] + s4[3])) * (1.0f / 1024.0f) + EPS);
                const size_t off = (size_t)r * 1024 + col0;
#pragma unroll
                for (int bj = 0; bj < 2; ++bj)
#pragma unroll
                    for (int n = 0; n < 2; ++n) *(f32x4*)(sc + off + bj * 128 + n * 16) = acc[ai][bj][m][n] * rs;
            }
    }
};
__device__ __forceinline__ unsigned enc_e2m3(float x) {
    const float a = fabsf(x);
    const float m = a < 2.0f ? 8.0f : (a < 4.0f ? 4.0f : 2.0f); const int off = a < 2.0f ? 0 : (a < 4.0f ? 8 : 16);
    int code = (int)__builtin_rintf(a * m) + off; code = code > 31 ? 31 : code;
    return (unsigned)code | (x < 0.f ? 32u : 0u);
}
__device__ __forceinline__ void uv_convert(const float* pu, const float* pv, const float* gffn, unsigned char* u8, unsigned char* v8, float* iu, float* iv, int gw, int NGW, int lane) {
    f32x4 g[4];
#pragma unroll
    for (int j = 0; j < 4; ++j) g[j] = ((const f32x4*)gffn)[4 * lane + j];
    constexpr int UVH = V_FP6 ? 1 : 2;
    for (int e0 = gw; e0 < 2 * 16384; e0 += UVH * NGW) {
        f32x4 v[UVH][4];
#pragma unroll
        for (int h = 0; h < UVH; ++h) { const int e = e0 + h * NGW; const bool isv = e >= 16384; const int row = isv ? e - 16384 : e;
            const f32x4* src = (const f32x4*)((isv ? pv : pu) + (size_t)row * 1024) + 4 * lane;
#pragma unroll
            for (int j = 0; j < 4; ++j) v[h][j] = src[j]; }
#pragma unroll
        for (int h = 0; h < UVH; ++h) {
            const int e = e0 + h * NGW; const bool isv = e >= 16384; const int row = isv ? e - 16384 : e;
            float am = 0.f;
#pragma unroll
            for (int j = 0; j < 4; ++j) { if (!isv) v[h][j] = v[h][j] * g[j]; am = fmaxf(am, fmaxf(fmaxf(fabsf(v[h][j][0]), fabsf(v[h][j][1])), fmaxf(fabsf(v[h][j][2]), fabsf(v[h][j][3])))); }
#pragma unroll
            for (int o = 1; o < 64; o <<= 1) am = fmaxf(am, __shfl_xor(am, o));
            const float sc = am > 0.f ? (isv ? (V_FP6 ? 7.5f : 416.0f) : 127.0f) / am : 1.0f;
            u32x4 w;
#if V_FP6
            if (isv) {
#define E6(i) enc_e2m3(v[h][(i) >> 2][(i) & 3] * sc)
                u32x3 w6;
                w6.x = E6(0) | (E6(1) << 6) | (E6(2) << 12) | (E6(3) << 18) | (E6(4) << 24); { const unsigned c5 = E6(5); w6.x |= c5 << 30; w6.y = c5 >> 2; }
                __builtin_amdgcn_sched_barrier(0);
                w6.y |= (E6(6) << 4) | (E6(7) << 10) | (E6(8) << 16) | (E6(9) << 22); { const unsigned c10 = E6(10); w6.y |= c10 << 28; w6.z = c10 >> 4; }
                __builtin_amdgcn_sched_barrier(0);
                w6.z |= (E6(11) << 2) | (E6(12) << 8) | (E6(13) << 14) | (E6(14) << 20) | (E6(15) << 26);
#undef E6
                *(u32x3*)(v8 + (size_t)row * 768 + 12 * lane) = w6;
                if (lane == 0) iv[row] = 1.0f / sc;
                continue;
            }
#endif
            if (isv) {
#pragma unroll
                for (int j = 0; j < 4; ++j) { unsigned ww = 0u; ww = __builtin_amdgcn_cvt_pk_fp8_f32(v[h][j][0] * sc, v[h][j][1] * sc, ww, false); ww = __builtin_amdgcn_cvt_pk_fp8_f32(v[h][j][2] * sc, v[h][j][3] * sc, ww, true); w[j] = ww; }
            } else {
#pragma unroll
                for (int j = 0; j < 4; ++j) { unsigned ww = 0u;
#pragma unroll
                    for (int c = 0; c < 4; ++c) ww |= ((unsigned)(int)__builtin_rintf(v[h][j][c] * sc) & 0xffu) << (8 * c);
                    w[j] = ww; }
            }
            *(u32x4*)((isv ? v8 : u8) + (size_t)row * 1024 + 16 * lane) = w;
            if (lane == 0) (isv ? iv : iu)[row] = 1.0f / sc;
        }
    }
}
struct EpiTopk {
    static constexpr bool PERM = false, AFTER_DRAIN = true;
    const float* part; int* seli; float* selg;
    const float* pu; const float* pv; const float* gffn; unsigned char* u8; unsigned char* v8; float* iu; float* iv; int uvslot, uvn;
    __device__ __forceinline__ void fused(f32x4 (&acc)[2][2][4][2], const Unit& u, int wr, int wc, int fr, int fq, PG8_LAS unsigned char* lds, int wid, int lane) const {
        LAS float* L = (LAS float*)lds;
#pragma unroll
        for (int ai = 0; ai < 2; ++ai) {
            { const int t_ = fresh_lane(); fr = t_ & 15; fq = t_ >> 4; }
#pragma unroll
            for (int m = 0; m < 4; ++m) {
                const int rl = wr * 64 + m * 16 + fr, r = u.pm * 256 + ai * 128 + rl;
                const f32x4* pp = (const f32x4*)(part + (size_t)r * 16);
                const f32x4 s4 = (pp[0] + pp[1]) + (pp[2] + pp[3]); const float rs = 1.0f / sqrtf(((s4[0] + s4[1]) + (s4[2] + s4[3])) * (1.0f / 1024.0f) + EPS);
#pragma unroll
                for (int bj = 0; bj < 2; ++bj)
#pragma unroll
                    for (int n = 0; n < 2; ++n) *(LAS f32x4*)(L + (rl * 2 + bj) * TK_LSTRIDE + wc * 32 + 16 * n + 4 * fq) = acc[ai][bj][m][n] * rs;
            }
            asm volatile("s_waitcnt lgkmcnt(0)" ::: "memory"); __builtin_amdgcn_s_barrier(); asm volatile("" ::: "memory");
            const int tid = wid * 64 + fresh_lane();
            if (wid < 4) {
                const LAS float* my = L + tid * TK_LSTRIDE;
                unsigned a16[16];
#pragma unroll
                for (int g = 0; g < 8; ++g) {
                    unsigned t[16];
#pragma unroll
                    for (int q = 0; q < 4; ++q) {
                        const f32x4 v = *(const LAS f32x4*)(my + g * 16 + q * 4);
#pragma unroll
                        for (int c = 0; c < 4; ++c) { const int e = g * 16 + q * 4 + c; const float vc = v[c]; t[q * 4 + c] = (tk_f2key(vc) & ~127u) | (unsigned)(127 - e); }
                    }
                    tk_sort16(t);
                    if (g == 0) {
#pragma unroll
                        for (int i = 0; i < 16; ++i) a16[i] = t[i];
                    } else tk_merge16(a16, t);
                }
                {   u32x4 sb;
#pragma unroll
                    for (int c = 0; c < 4; ++c) sb[c] = (127u - (a16[4 * c] & 127u)) | ((127u - (a16[4 * c + 1] & 127u)) << 8) | ((127u - (a16[4 * c + 2] & 127u)) << 16) | ((127u - (a16[4 * c + 3] & 127u)) << 24);
                    *(LAS u32x4*)(L + tid * TK_LSTRIDE) = sb; }
                __builtin_amdgcn_sched_barrier(0);
                unsigned oth[16];
#pragma unroll
                for (int i = 0; i < 16; ++i) oth[i] = (unsigned)__shfl_xor((int)a16[i], 1);
                const bool odd = tid & 1;
                unsigned part[16]; tk_pair_partial(a16, oth, odd, part);
                {   unsigned po[16];
#pragma unroll
                    for (int i = 0; i < 16; ++i) po[i] = (unsigned)__shfl_xor((int)part[i], 1);
                    tk_merge16(part, po); }
                asm volatile("s_waitcnt lgkmcnt(0)" ::: "memory");
                const float mx = tk_key2f(part[0] & ~255u);
                float ex[16], sum = 0.f;
#pragma unroll
                for (int i = 0; i < 16; ++i) { ex[i] = __builtin_expf(tk_key2f(part[i] & ~255u) - mx); sum += ex[i]; }
                const float inv = 1.0f / sum;
                const LAS unsigned char* r1 = (const LAS unsigned char*)(L + (tid & ~1) * TK_LSTRIDE); const LAS unsigned char* r2 = r1 + TK_LSTRIDE * 4;
                const int tok = u.pm * 256 + ai * 128 + (tid >> 1);
                int* oi = seli + (size_t)tok * 128 + u.pn * 16 + (odd ? 8 : 0); float* og = selg + (size_t)tok * 128 + u.pn * 16 + (odd ? 8 : 0);
                int ei[8]; float eg[8];
#pragma unroll
                for (int i = 0; i < 8; ++i) { unsigned ka = part[i], kb = part[i + 8]; float xa = ex[i], xb = ex[i + 8]; asm volatile("" : "+v"(ka), "+v"(kb), "+v"(xa), "+v"(xb));
                    const unsigned key = odd ? kb : ka; int i1, i2; tk_decode(key, i1, i2);
                    ei[i] = (int)r1[i1] * 128 + (int)r2[i2]; eg[i] = (odd ? xb : xa) * inv; }
                *(i32x4v*)oi = (i32x4v){ei[0], ei[1], ei[2], ei[3]}; *(i32x4v*)(oi + 4) = (i32x4v){ei[4], ei[5], ei[6], ei[7]};
                *(f32x4*)og = (f32x4){eg[0], eg[1], eg[2], eg[3]}; *(f32x4*)(og + 4) = (f32x4){eg[4], eg[5], eg[6], eg[7]};
            } else if (uvn > 0) uv_convert(pu, pv, gffn, u8, v8, iu, iv, uvslot + 4 * ai + (wid - 4), uvn, fresh_lane());
            asm volatile("s_waitcnt lgkmcnt(0)" ::: "memory"); __builtin_amdgcn_s_barrier(); asm volatile("" ::: "memory");
        }
    }
};
struct EpiPP {
    static constexpr bool PERM = true, AFTER_DRAIN = false;
    bf16* pp;
    __device__ __forceinline__ void operator()(const f32x4 (&acc)[2][2][4][2], const Unit& u, int wr, int wc, int fr, int fq) const {
        { const int t_ = fresh_lane(); fr = t_ & 15; fq = t_ >> 4; }
        const int row0 = u.pm * 256 + wr * 64 + fr, col0 = u.pn * 256 + wc * 32 + 8 * fq;
#pragma unroll
        for (int ai = 0; ai < 2; ++ai)
#pragma unroll
            for (int m = 0; m < 4; ++m) {
                const size_t off = (size_t)(row0 + ai * 128 + m * 16) * 1024 + col0;
#pragma unroll
                for (int bj = 0; bj < 2; ++bj) *(u32x4*)(pp + off + bj * 128) = pack8(acc[ai][bj][m][0], acc[ai][bj][m][1]);
            }
    }
};
struct EpiH3 {
    static constexpr bool PERM = true, AFTER_DRAIN = false;
    const float* rstd3; const bf16* pp; float* h; float* part; const bf16* h2b; bf16* h3b;
    __device__ __forceinline__ void operator()(const f32x4 (&acc)[2][2][4][2], const Unit& u, int wr, int wc, int fr, int fq) const {
        { const int t_ = fresh_lane(); fr = t_ & 15; fq = t_ >> 4; }
        const int row0 = u.pm * 256 + wr * 64 + fr, col0 = u.pn * 256 + wc * 32 + 8 * fq;
#pragma unroll
        for (int ai = 0; ai < 2; ++ai)
#pragma unroll
            for (int m = 0; m < 4; ++m) {
                const int r = row0 + ai * 128 + m * 16; const size_t off = (size_t)r * 1024 + col0; const float rs = rstd3[r]; float sq = 0.f;
#pragma unroll
                for (int bj = 0; bj < 2; ++bj) {
                    const size_t o = off + bj * 128; const u32x4 pw = *(const u32x4*)(pp + o);
#if ALL_FUSED
                    const u32x4 hw = *(const u32x4*)(h2b + o);
                    const f32x4 v0 = bf4_lo((u32x2){hw.x, hw.y}) + sig4(acc[ai][bj][m][0] * rs) * bf4_lo((u32x2){pw.x, pw.y});
                    const f32x4 v1 = bf4_lo((u32x2){hw.z, hw.w}) + sig4(acc[ai][bj][m][1] * rs) * bf4_lo((u32x2){pw.z, pw.w});
                    *(u32x4*)(h3b + o) = pack8(v0, v1);
#else
                    const f32x4 v0 = *(const f32x4*)(h + o) + sig4(acc[ai][bj][m][0] * rs) * bf4_lo((u32x2){pw.x, pw.y});
                    const f32x4 v1 = *(const f32x4*)(h + o + 4) + sig4(acc[ai][bj][m][1] * rs) * bf4_lo((u32x2){pw.z, pw.w});
                    *(f32x4*)(h + o) = v0; *(f32x4*)(h + o + 4) = v1;
#endif
                    sq += (v0[0] * v0[0] + v0[1] * v0[1]) + (v0[2] * v0[2] + v0[3] * v0[3]) + (v1[0] * v1[0] + v1[1] * v1[1]) + (v1[2] * v1[2] + v1[3] * v1[3]);
                }
                sq += __shfl_xor(sq, 16); sq += __shfl_xor(sq, 32);
                if (fq == 0) part[(size_t)r * 16 + u.pn * 4 + wc] = sq;
            }
    }
};
struct EpiPre {
    static constexpr bool PERM = false, AFTER_DRAIN = false;
    float* rp; float* ip;
    __device__ __forceinline__ void operator()(const f32x4 (&acc)[2][2][4][2], const Unit& u, int wr, int wc, int fr, int fq) const {
        { const int t_ = fresh_lane(); fr = t_ & 15; fq = t_ >> 4; }
#pragma unroll
        for (int n = 0; n < 2; ++n) { const int ch = u.pn * 128 + wc * 32 + 16 * n + 4 * fq;
#pragma unroll
            for (int ai = 0; ai < 2; ++ai)
#pragma unroll
                for (int m = 0; m < 4; ++m) { const int r = u.pm * 256 + ai * 128 + wr * 64 + m * 16 + fr; const size_t o = (size_t)r * 1024 + ch; *(f32x4*)(rp + o) = acc[ai][0][m][n]; *(f32x4*)(ip + o) = acc[ai][1][m][n]; } }
    }
};
struct EpiH3Final {
    static constexpr bool PERM = true, AFTER_DRAIN = false;
    const float* rstd3; const bf16* pp; const bf16* h2b; const float* fg; float* out; float* part; unsigned* cnt;
    __device__ __forceinline__ void operator()(f32x4 (&acc)[2][2][4][2], const Unit& u, int wr, int wc, int fr, int fq) const {
        { const int t_ = fresh_lane(); fr = t_ & 15; fq = t_ >> 4; }
        const int row0 = u.pm * 256 + wr * 64 + fr, col0 = u.pn * 256 + wc * 32 + 8 * fq;
#pragma unroll
        for (int ai = 0; ai < 2; ++ai)
#pragma unroll
            for (int m = 0; m < 4; ++m) {
                const int r = row0 + ai * 128 + m * 16; const size_t off = (size_t)r * 1024 + col0; const float rs = rstd3[r]; float sq = 0.f;
#pragma unroll
                for (int bj = 0; bj < 2; ++bj) {
                    const size_t o = off + bj * 128; const u32x4 pw = *(const u32x4*)(pp + o); const u32x4 hw = *(const u32x4*)(h2b + o);
                    const f32x4 v0 = bf4_lo((u32x2){hw.x, hw.y}) + sig4(acc[ai][bj][m][0] * rs) * bf4_lo((u32x2){pw.x, pw.y});
                    const f32x4 v1 = bf4_lo((u32x2){hw.z, hw.w}) + sig4(acc[ai][bj][m][1] * rs) * bf4_lo((u32x2){pw.z, pw.w});
                    acc[ai][bj][m][0] = v0; acc[ai][bj][m][1] = v1;
                    sq += (v0[0] * v0[0] + v0[1] * v0[1]) + (v0[2] * v0[2] + v0[3] * v0[3]) + (v1[0] * v1[0] + v1[1] * v1[1]) + (v1[2] * v1[2] + v1[3] * v1[3]);
                }
                sq += __shfl_xor(sq, 16); sq += __shfl_xor(sq, 32);
                if (fq == 0) __hip_atomic_store(part + (size_t)r * 16 + u.pn * 4 + wc, sq, __ATOMIC_RELAXED, __HIP_MEMORY_SCOPE_AGENT);
            }
        asm volatile("s_waitcnt vmcnt(0)" ::: "memory");
        const int lane = fq * 16 + fr;
        unsigned* c = cnt + 64 * u.pm;
        if (lane == 0) __hip_atomic_fetch_add(c, 1u, __ATOMIC_RELAXED, __HIP_MEMORY_SCOPE_AGENT);
        {
            const unsigned long long t0 = __builtin_amdgcn_s_memrealtime();
            while ((unsigned)__builtin_amdgcn_readfirstlane((int)__hip_atomic_load(c, __ATOMIC_RELAXED, __HIP_MEMORY_SCOPE_AGENT)) < 32u) {
                if (__builtin_amdgcn_s_memrealtime() - t0 > 2000000ull) break;
                __builtin_amdgcn_s_sleep(2);
            }
        }
        { const int t_ = fresh_lane(); fr = t_ & 15; fq = t_ >> 4; }
#pragma unroll
        for (int ai = 0; ai < 2; ++ai)
#pragma unroll
            for (int m = 0; m < 4; ++m) {
                const int r = u.pm * 256 + wr * 64 + fr + ai * 128 + m * 16;
                float ps = 0.f;
#pragma unroll
                for (int k = 0; k < 16; ++k) ps += __hip_atomic_load(part + (size_t)r * 16 + k, __ATOMIC_RELAXED, __HIP_MEMORY_SCOPE_AGENT);
                const float rr = 1.0f / sqrtf(ps * (1.0f / 1024.0f) + EPS);
                const int cc = u.pn * 256 + wc * 32 + 8 * fq;
#pragma unroll
                for (int bj = 0; bj < 2; ++bj) {
                    const f32x4 g0 = *(const f32x4*)(fg + cc + bj * 128), g1 = *(const f32x4*)(fg + cc + bj * 128 + 4);
                    float* op = out + (size_t)r * 1024 + cc + bj * 128;
                    *(f32x4*)op = acc[ai][bj][m][0] * rr * g0; *(f32x4*)(op + 4) = acc[ai][bj][m][1] * rr * g1;
                }
            }
    }
};
template <int CTRL> __device__ __forceinline__ float dpp_f(float oldv, float src) {
    return __builtin_bit_cast(float, __builtin_amdgcn_update_dpp(__builtin_bit_cast(int, oldv), __builtin_bit_cast(int, src), CTRL, 0xf, 0xf, false));
}
#ifndef LRU_T2
#define LRU_T2 0
#endif
struct EpiLru {
    static constexpr bool PERM = false, AFTER_DRAIN = false;
    const bf16* lin; const float* ba; const float* bx; const float* c8l; bf16* hloc; bf16* pcum; float* agg;
    template <int SH> static __device__ __forceinline__ void step(f32x4& A, f32x4& Bv, float idd) {
#pragma unroll
        for (int j = 0; j < 4; ++j) {
            const float ap = __int_as_float(__builtin_amdgcn_update_dpp(0, __float_as_int((float)A[j]), 0x110 + SH, 0xf, 0xf, true)) + idd;
            const float bp = __int_as_float(__builtin_amdgcn_update_dpp(0, __float_as_int((float)Bv[j]), 0x110 + SH, 0xf, 0xf, true));
            Bv[j] = fmaf(A[j], bp, Bv[j]); A[j] = A[j] * ap; }
    }
    __device__ __forceinline__ void operator()(f32x4 (&acc)[2][2][4][2], const Unit& u, int wr, int wc, int fr, int fq) const {
        { const int t_ = fresh_lane(); fr = t_ & 15; fq = t_ >> 4; }
        const int lane = fq * 16 + fr;
#pragma unroll
        for (int n = 0; n < 2; ++n) {
            const int ch = u.pn * 128 + wc * 32 + 16 * n + 4 * fq;
            const f32x4 bav = *(const f32x4*)(ba + ch), bxv = *(const f32x4*)(bx + ch), cv = *(const f32x4*)(c8l + ch);
#pragma unroll
            for (int ai = 0; ai < 2; ++ai)
#pragma unroll
                for (int m = 0; m < 4; ++m) {
                    const int r = u.pm * 256 + ai * 128 + wr * 64 + m * 16 + fr; const unsigned o = (unsigned)r * 1024u + (unsigned)ch;
                    const f32x4 lv = bf4_lo(*(const u32x2*)(lin + o));
#pragma unroll
                    for (int j = 0; j < 4; ++j) {
                        const float rr = sigmoidf_(acc[ai][0][m][n][j] + bav[j]), ii = sigmoidf_(acc[ai][1][m][n][j] + bxv[j]);
                        const float a = __builtin_amdgcn_exp2f(cv[j] * rr);
                        acc[ai][0][m][n][j] = a; acc[ai][1][m][n][j] = __builtin_amdgcn_sqrtf(fmaxf(1.0f - a * a, 0.f)) * (ii * lv[j]);
                    }
                    asm volatile("" : "+v"(acc[ai][0][m][n]), "+v"(acc[ai][1][m][n]));
                }
        }
#if defined(LRU_DEBUG) && LRU_DEBUG == 1
        {
            float* af = (float*)hloc; float* bf = (float*)pcum;
#pragma unroll
            for (int n = 0; n < 2; ++n) { const int ch = u.pn * 128 + wc * 32 + 16 * n + 4 * fq;
#pragma unroll
                for (int ai = 0; ai < 2; ++ai)
#pragma unroll
                    for (int m = 0; m < 4; ++m) { const int r = u.pm * 256 + ai * 128 + wr * 64 + m * 16 + fr; const size_t o = (size_t)r * 1024 + ch; *(f32x4*)(af + o) = acc[ai][0][m][n]; *(f32x4*)(bf + o) = acc[ai][1][m][n]; } }
            return;
        }
#endif
        __builtin_amdgcn_sched_barrier(0);
        const float id1 = fr < 1 ? 1.f : 0.f, id2 = fr < 2 ? 1.f : 0.f, id4 = fr < 4 ? 1.f : 0.f, id8 = fr < 8 ? 1.f : 0.f;
#pragma unroll
        for (int ai = 0; ai < 2; ++ai)
#pragma unroll
            for (int m = 0; m < 4; ++m)
#pragma unroll
                for (int n = 0; n < 2; ++n) { step<1>(acc[ai][0][m][n], acc[ai][1][m][n], id1); step<2>(acc[ai][0][m][n], acc[ai][1][m][n], id2); step<4>(acc[ai][0][m][n], acc[ai][1][m][n], id4); step<8>(acc[ai][0][m][n], acc[ai][1][m][n], id8);
                    asm volatile("" : "+v"(acc[ai][0][m][n]), "+v"(acc[ai][1][m][n])); }
        { const int t_ = fresh_lane(); fr = t_ & 15; fq = t_ >> 4; }
        const int src4 = (((fq * 16 + fr) & 48) | 15) * 4;
#pragma unroll
        for (int n = 0; n < 2; ++n) {
            const int ch = u.pn * 128 + wc * 32 + 16 * n + 4 * fq;
#pragma unroll
            for (int ai = 0; ai < 2; ++ai) {
#pragma unroll
                for (int m = 0; m < 4; ++m) {
                    f32x4& A = acc[ai][0][m][n]; f32x4& Bv = acc[ai][1][m][n];
                    if (m > 0 && !(LRU_T2)) {
#pragma unroll
                        for (int j = 0; j < 4; ++j) { const float pa = acc[ai][0][m - 1][n][j], pb = acc[ai][1][m - 1][n][j];
                            const float ac = __int_as_float(__builtin_amdgcn_ds_bpermute(src4, __float_as_int(pa))), bc = __int_as_float(__builtin_amdgcn_ds_bpermute(src4, __float_as_int(pb))); Bv[j] = fmaf(A[j], bc, Bv[j]); A[j] = A[j] * ac; }
                    }
                    const int r = u.pm * 256 + ai * 128 + wr * 64 + m * 16 + fr; const unsigned o = (unsigned)r * 1024u + (unsigned)ch;
                    u32x2 wp, wh; wp.x = cvt_pk_bf16(A[0], A[1]); wp.y = cvt_pk_bf16(A[2], A[3]); wh.x = cvt_pk_bf16(Bv[0], Bv[1]); wh.y = cvt_pk_bf16(Bv[2], Bv[3]);
                    *(u32x2*)(pcum + o) = wp; *(u32x2*)(hloc + o) = wh;
                    if (m == 3 && fr == 15) {
                        const int chunk = u.pm * 4 + ai * 2 + wr; float* ap = agg + ((size_t)chunk * 1024 + ch) * 2;
                        *(f32x4*)(ap) = (f32x4){A[0], Bv[0], A[1], Bv[1]}; *(f32x4*)(ap + 4) = (f32x4){A[2], Bv[2], A[3], Bv[3]};
                    }
                    __builtin_amdgcn_sched_barrier(0);
                }
            }
        }
    }
};

__device__ __forceinline__ void p0_transpose_item(const float* W, int ldw, const float* gain, bf16* WT, int ldt, int k_off, LAS float* scr, int kb, int nb, int lane) {
    const int k0 = 64 * kb, n0 = 32 * nb;
    const int c4 = lane & 7, kr = lane >> 3;
    f32x4 v[8];
#pragma unroll
    for (int i = 0; i < 8; ++i) v[i] = *(const f32x4*)(W + (size_t)(k0 + 8 * i + kr) * ldw + n0 + 4 * c4);
#pragma unroll
    for (int i = 0; i < 8; ++i) { f32x4 x = v[i]; if (gain) x = x * gain[k0 + 8 * i + kr]; *(LAS f32x4*)(scr + (8 * i + kr) * 36 + 4 * c4) = x; }
    LDS_WAIT(); asm volatile("" ::: "memory");
    const int c = lane & 7;
#pragma unroll
    for (int j = 0; j < 4; ++j) { const int n = (lane >> 3) + 8 * j; const LAS float* sp = scr + (8 * c) * 36 + n;
        u32x4 o; o.x = pk2(sp[0 * 36], sp[1 * 36]); o.y = pk2(sp[2 * 36], sp[3 * 36]); o.z = pk2(sp[4 * 36], sp[5 * 36]); o.w = pk2(sp[6 * 36], sp[7 * 36]);
        *(u32x4*)(WT + (size_t)(n0 + n) * ldt + k_off + k0 + 8 * c) = o; }
    LDS_WAIT(); asm volatile("" ::: "memory");
}
__device__ __forceinline__ void p0_wfold_item(LAS float* lds, const float* wq, const float* k1, const float* k2, const float* gffn, bf16* wfold, int item, int tid) {
    const int hh = item >> 4, kb = item & 15;
    LAS float* wqs = lds; LAS float* kks = lds + 64 * 132;
    const float* ksrc = (hh & 1) ? k2 : k1;
#pragma unroll
    for (int i = 0; i < 4; ++i) { const int e = tid + i * 512, r = e >> 5, c4 = e & 31; *(LAS f32x4*)(wqs + r * 132 + 4 * c4) = *(const f32x4*)(wq + (size_t)(kb * 64 + r) * 2048 + hh * 128 + 4 * c4); }
#pragma unroll
    for (int i = 0; i < 8; ++i) { const int e = tid + i * 512, r = e >> 5, c4 = e & 31; *(LAS f32x4*)(kks + r * 132 + 4 * c4) = *(const f32x4*)(ksrc + (size_t)r * 128 + 4 * c4); }
    __syncthreads();
    const int tk = tid & 15, tkey = tid >> 4;
    float acc[4][4];
#pragma unroll
    for (int i = 0; i < 4; ++i)
#pragma unroll
        for (int j = 0; j < 4; ++j) acc[i][j] = 0.f;
#pragma unroll 2
    for (int c4 = 0; c4 < 32; ++c4) {
        f32x4 a[4], b[4];
#pragma unroll
        for (int i = 0; i < 4; ++i) { a[i] = *(const LAS f32x4*)(wqs + (tk * 4 + i) * 132 + 4 * c4); b[i] = *(const LAS f32x4*)(kks + (tkey * 4 + i) * 132 + 4 * c4); }
#pragma unroll
        for (int i = 0; i < 4; ++i)
#pragma unroll
            for (int j = 0; j < 4; ++j) acc[i][j] += (a[i][0] * b[j][0] + a[i][1] * b[j][1]) + (a[i][2] * b[j][2] + a[i][3] * b[j][3]);
    }
    const int kg = kb * 64 + tk * 4; const f32x4 gv = *(const f32x4*)(gffn + kg);
#pragma unroll
    for (int j = 0; j < 4; ++j) { u32x2 w; w.x = pk2(acc[0][j] * gv[0], acc[1][j] * gv[1]); w.y = pk2(acc[2][j] * gv[2], acc[3][j] * gv[3]);
        *(u32x2*)(wfold + (size_t)(hh * 128 + tkey * 4 + j) * 1024 + kg) = w; }
    __syncthreads();
}

struct In { const float* p[25]; };
enum { I_X = 0, I_P, I_GMIX, I_WIN, I_SINK, I_CONVW, I_CONVB, I_WA, I_BA, I_WX, I_BX, I_LAM, I_WUA, I_WUL, I_WO, I_GFFN, I_WQ, I_K1, I_K2, I_U, I_V, I_GPLE, I_WGATE, I_WPROJ, I_FG };

__device__ __forceinline__ void p0_prologue(const In& in, unsigned char* ws, LAS unsigned char* lds, int vcu, int G, int wave, int tid) {
    const int lane = tid & 63;
    LAS float* scr = (LAS float*)(lds + wave * 16384);
    const int gw = vcu * NWAVES + wave, NGW = G * NWAVES;
    constexpr int I_IN = 16 * 152, I_UA = 8 * 32, I_SQ = 16 * 32, I_PJ = 4 * 32, I_AX = 128;
    constexpr int NITEMS = I_IN + I_UA + 3 * I_SQ + I_PJ + I_AX;
    for (int it = gw; it < NITEMS; it += NGW) {
        int r = it;
        if (r < I_IN) { p0_transpose_item(in.p[I_WIN], INW, in.p[I_GMIX], (bf16*)(ws + WS_WIN), 1024, 0, scr, r / 152, r % 152, lane); continue; } r -= I_IN;
        if (r < I_UA) { p0_transpose_item(in.p[I_WUA], 1024, nullptr, (bf16*)(ws + WS_WUA), 512, 0, scr, r / 32, r % 32, lane); continue; } r -= I_UA;
        if (r < I_SQ) { p0_transpose_item(in.p[I_WUL], 1024, nullptr, (bf16*)(ws + WS_WUL), 1024, 0, scr, r / 32, r % 32, lane); continue; } r -= I_SQ;
        if (r < I_SQ) { p0_transpose_item(in.p[I_WO], 1024, nullptr, (bf16*)(ws + WS_WO), 1024, 0, scr, r / 32, r % 32, lane); continue; } r -= I_SQ;
        if (r < I_SQ) { p0_transpose_item(in.p[I_WGATE], 1024, in.p[I_GPLE], (bf16*)(ws + WS_WG), 1024, 0, scr, r / 32, r % 32, lane); continue; } r -= I_SQ;
        if (r < I_PJ) { p0_transpose_item(in.p[I_WPROJ], 1024, nullptr, (bf16*)(ws + WS_WPROJ), 256, 0, scr, r / 32, r % 32, lane); continue; } r -= I_PJ;
        { const int blk = r >> 4, which = (r >> 3) & 1, sub = r & 7;

#if LRU_PADDED
#if LRU_PADDED == 2
          p0_transpose_item(in.p[which ? I_WX : I_WA] + (size_t)blk * 16384, 128, nullptr, (bf16*)(ws + WS_WAX) + (size_t)blk * 32768 + which * 128 * 128, 128, 0, scr, sub >> 2, sub & 3, lane); }
#else
          p0_transpose_item(in.p[which ? I_WX : I_WA] + (size_t)blk * 16384, 128, nullptr, (bf16*)(ws + WS_WAX) + (size_t)blk * 65536 + which * 128 * 256, 256, (blk & 1) * 128, scr, sub >> 2, sub & 3, lane); }
#endif
#else
          p0_transpose_item(in.p[which ? I_WX : I_WA] + (size_t)blk * 16384, 128, nullptr, (bf16*)(ws + WS_WAXD) + (size_t)(blk * 256 + which * 128) * 1024, 1024, blk * 128, scr, sub >> 2, sub & 3, lane); }
#endif
    }
#if LRU_PADDED == 2
#elif LRU_PADDED
    for (int i = vcu * 512 + tid; i < 8 * 256 * 16; i += G * 512) { const int c16 = i & 15, n = (i >> 4) & 255, blk = i >> 12;
        *(u32x4*)((bf16*)(ws + WS_WAX) + (size_t)blk * 65536 + n * 256 + ((blk & 1) ^ 1) * 128 + c16 * 8) = (u32x4){0u, 0u, 0u, 0u}; }
#else
    for (int i = vcu * 512 + tid; i < 2048 * 128; i += G * 512) { const int c16 = i & 127, row = i >> 7, blk = row >> 8;
        if ((c16 >> 4) != blk) *(u32x4*)((bf16*)(ws + WS_WAXD) + (size_t)row * 1024 + c16 * 8) = (u32x4){0u, 0u, 0u, 0u}; }
#endif
    for (int m = gw; m < T_; m += 2 * NGW) {
        const int m2 = m + NGW;
        const f32x4* xa = (const f32x4*)(in.p[I_X] + (size_t)m * 1024) + lane; const f32x4* xb = (const f32x4*)(in.p[I_X] + (size_t)(m2 < T_ ? m2 : m) * 1024) + lane;
        f32x4 va[4], vb[4]; float sa = 0.f, sb = 0.f;
#pragma unroll
        for (int j = 0; j < 4; ++j) { va[j] = xa[64 * j]; vb[j] = xb[64 * j]; }
#pragma unroll
        for (int j = 0; j < 4; ++j) { sa += (va[j][0] * va[j][0] + va[j][1] * va[j][1]) + (va[j][2] * va[j][2] + va[j][3] * va[j][3]); sb += (vb[j][0] * vb[j][0] + vb[j][1] * vb[j][1]) + (vb[j][2] * vb[j][2] + vb[j][3] * vb[j][3]); }
#pragma unroll
        for (int o = 1; o < 64; o <<= 1) { sa += __shfl_xor(sa, o); sb += __shfl_xor(sb, o); }
        u32x2* oa = (u32x2*)((bf16*)(ws + WS_R0) + (size_t)m * 1024) + lane;
#pragma unroll
        for (int j = 0; j < 4; ++j) { u32x2 w; w.x = pk2(va[j][0], va[j][1]); w.y = pk2(va[j][2], va[j][3]); oa[64 * j] = w; }
        if (lane == 0) ((float*)(ws + WS_RSTD1))[m] = 1.0f / sqrtf(sa * (1.0f / 1024.0f) + EPS);
        if (m2 < T_) {
            u32x2* ob = (u32x2*)((bf16*)(ws + WS_R0) + (size_t)m2 * 1024) + lane;
#pragma unroll
            for (int j = 0; j < 4; ++j) { u32x2 w; w.x = pk2(vb[j][0], vb[j][1]); w.y = pk2(vb[j][2], vb[j][3]); ob[64 * j] = w; }
            if (lane == 0) ((float*)(ws + WS_RSTD1))[m2] = 1.0f / sqrtf(sb * (1.0f / 1024.0f) + EPS);
        }
    }
    for (int m = gw; m < T_; m += 4 * NGW) {
        f32x4 v[4];
#pragma unroll
        for (int q = 0; q < 4; ++q) { const int mq = m + q * NGW; v[q] = ((const f32x4*)(in.p[I_P] + (size_t)(mq < T_ ? mq : m) * 256))[lane]; }
#pragma unroll
        for (int q = 0; q < 4; ++q) { const int mq = m + q * NGW; if (mq < T_) { u32x2 w; w.x = pk2(v[q][0], v[q][1]); w.y = pk2(v[q][2], v[q][3]); ((u32x2*)((bf16*)(ws + WS_PB) + (size_t)mq * 256))[lane] = w; } }
    }
    if (vcu == 0) for (int c = tid; c < 1024; c += 512) ((float*)(ws + WS_C8))[c] = -8.0f * log1pf(expf(-in.p[I_LAM][c])) * LOG2E;
    __syncthreads();
    for (int it = vcu; it < 256; it += G) p0_wfold_item((LAS float*)lds, in.p[I_WQ], in.p[I_K1], in.p[I_K2], in.p[I_GFFN], (bf16*)(ws + WS_WFOLD), it, tid);
}

constexpr int AT_KSTR = 72, AT_VSTR = 260, AT_V_OFF = 256 * AT_KSTR * 2;
__device__ __forceinline__ int crow(int r, int hi) { return (r & 3) + 8 * (r >> 2) + 4 * hi; }
__device__ __forceinline__ void attn_item(LAS unsigned char* lds, const bf16* qkv, const float* sink, bf16* att, int item, int wave, int tid) {
    const int lane = tid & 63;
    const int g = item & 1, n = (item >> 1) & 15, b = item >> 5;
    const int t0 = b * S_ + n * 128;
    LAS bf16* Ks = (LAS bf16*)lds; LAS bf16* Vt = (LAS bf16*)(lds + AT_V_OFF);
#pragma unroll
    for (int i = 0; i < 4; ++i) {
        const int idx = tid + i * 512, row = idx >> 3, ch = idx & 7; const int tk = t0 - 128 + row;
        u32x4 kv = (u32x4){0u, 0u, 0u, 0u}, vv = (u32x4){0u, 0u, 0u, 0u};
        if (n > 0 || row >= 128) { const bf16* src = qkv + (size_t)tk * 768 + 512 + g * 64 + ch * 8; kv = *(const u32x4*)src; vv = *(const u32x4*)(src + 128); }
        *(LAS u32x4*)(Ks + row * AT_KSTR + ch * 8) = kv;
#pragma unroll
        for (int c = 0; c < 8; ++c) Vt[(ch * 8 + c) * AT_VSTR + row] = (bf16)(vv[c >> 1] >> (16 * (c & 1)));
    }
    __syncthreads();
    const int hr = wave >> 1, qh = wave & 1, head = g * 4 + hr;
    const float slope2 = exp2f(-(float)(head + 1)) * LOG2E, sink2 = sink[head] * LOG2E;
    const int q = lane & 31, hi = lane >> 5;
#pragma unroll 1
    for (int ps = 0; ps < 2; ++ps) {
        const int i0 = 64 * qh + 32 * ps, kb0 = i0;
        const bf16* qp = qkv + (size_t)(t0 + i0 + q) * 768 + head * 64 + 8 * hi;
        bf16x8 qf[4];
#pragma unroll
        for (int s = 0; s < 4; ++s) qf[s] = *(const bf16x8*)(qp + 16 * s);
        f32x16 oT[2];
#pragma unroll
        for (int dt = 0; dt < 2; ++dt)
#pragma unroll
            for (int r = 0; r < 16; ++r) oT[dt][r] = 0.f;
        float mrun = sink2, l = 0.f;
#pragma unroll 1
        for (int kt = 0; kt < 5; ++kt) {
            const int kbase = kb0 + 32 * kt;
            f32x16 sT;
#pragma unroll
            for (int r = 0; r < 16; ++r) sT[r] = 0.f;
#pragma unroll
            for (int s = 0; s < 4; ++s) { const bf16x8 kf = *(const LAS bf16x8*)(Ks + (kbase + q) * AT_KSTR + 16 * s + 8 * hi); sT = __builtin_amdgcn_mfma_f32_32x32x16_bf16(kf, qf[s], sT, 0, 0, 0); }
            float tm = -1.0e30f;
#pragma unroll
            for (int r = 0; r < 16; ++r) {
                const int kj = kbase + crow(r, hi); const int dist = i0 + q + 128 - kj;
                const bool valid = (dist >= 0) && (dist < 128) && (n > 0 || kj >= 128);
                const float v = valid ? (sT[r] * (0.125f * LOG2E) - slope2 * (float)dist) : -1.0e30f;
                sT[r] = v; tm = fmaxf(tm, v);
            }
            tm = fmaxf(tm, __shfl_xor(tm, 32));
            const float mnew = fmaxf(mrun, tm), alpha = __builtin_amdgcn_exp2f(mrun - mnew);
            mrun = mnew;
            float ls = 0.f;
#pragma unroll
            for (int r = 0; r < 16; ++r) { const float p = __builtin_amdgcn_exp2f(sT[r] - mnew); sT[r] = p; ls += p; }
            l = l * alpha + ls;
#pragma unroll
            for (int dt = 0; dt < 2; ++dt)
#pragma unroll
                for (int r = 0; r < 16; ++r) oT[dt][r] *= alpha;
#pragma unroll
            for (int s = 0; s < 2; ++s) {
                u32x4 pw; pw.x = cvt_pk_bf16(sT[8 * s + 0], sT[8 * s + 1]); pw.y = cvt_pk_bf16(sT[8 * s + 2], sT[8 * s + 3]);
                pw.z = cvt_pk_bf16(sT[8 * s + 4], sT[8 * s + 5]); pw.w = cvt_pk_bf16(sT[8 * s + 6], sT[8 * s + 7]);
                const bf16x8 pf = __builtin_bit_cast(bf16x8, pw);
#pragma unroll
                for (int dt = 0; dt < 2; ++dt) {
                    const LAS bf16* vp = Vt + (32 * dt + q) * AT_VSTR + kbase + 16 * s + 4 * hi;
                    const u32x2 va = *(const LAS u32x2*)vp, vb = *(const LAS u32x2*)(vp + 8);
                    const bf16x8 af = __builtin_bit_cast(bf16x8, (u32x4){va.x, va.y, vb.x, vb.y});
                    oT[dt] = __builtin_amdgcn_mfma_f32_32x32x16_bf16(af, pf, oT[dt], 0, 0, 0);
                }
            }
        }
        l += __shfl_xor(l, 32);
        l += __builtin_amdgcn_exp2f(sink2 - mrun);
        const float inv = 1.0f / l;
        bf16* op = att + (size_t)(t0 + i0 + q) * 512 + head * 64 + 4 * hi;
#pragma unroll
        for (int dt = 0; dt < 2; ++dt)
#pragma unroll
            for (int rg = 0; rg < 4; ++rg) { u32x2 w; w.x = cvt_pk_bf16(oT[dt][4 * rg] * inv, oT[dt][4 * rg + 1] * inv); w.y = cvt_pk_bf16(oT[dt][4 * rg + 2] * inv, oT[dt][4 * rg + 3] * inv);
                *(u32x2*)(op + 32 * dt + 8 * rg) = w; }
    }
    __syncthreads();
}
__device__ __forceinline__ void conv_items(const bf16* lx, const float* cw, const float* cb, bf16* lin, int vcu, int G, int tid) {
    for (int i = vcu * 512 + tid; i < T_ * 128; i += 2 * G * 512) {
        const int c8 = (i & 127) * 8;
        const int ta = i >> 7, i2 = i + G * 512; const bool hasb = i2 < T_ * 128; const int tb = hasb ? (i2 >> 7) : ta;
        const int tsa = ta & (S_ - 1), tsb = tb & (S_ - 1);
        u32x4 wa[4], wb[4];
#pragma unroll
        for (int tap = 0; tap < 4; ++tap) {
            wa[tap] = (tsa - 3 + tap >= 0) ? *(const u32x4*)(lx + (size_t)(ta - 3 + tap) * 1024 + c8) : (u32x4){0u, 0u, 0u, 0u};
            wb[tap] = (tsb - 3 + tap >= 0) ? *(const u32x4*)(lx + (size_t)(tb - 3 + tap) * 1024 + c8) : (u32x4){0u, 0u, 0u, 0u};
        }
        f32x4 a0 = *(const f32x4*)(cb + c8), a1 = *(const f32x4*)(cb + c8 + 4), b0 = a0, b1 = a1;
#pragma unroll
        for (int tap = 0; tap < 4; ++tap) {
            const f32x4 w0 = *(const f32x4*)(cw + tap * 1024 + c8), w1 = *(const f32x4*)(cw + tap * 1024 + c8 + 4);
            a0 += bf4_lo((u32x2){wa[tap].x, wa[tap].y}) * w0; a1 += bf4_lo((u32x2){wa[tap].z, wa[tap].w}) * w1;
            b0 += bf4_lo((u32x2){wb[tap].x, wb[tap].y}) * w0; b1 += bf4_lo((u32x2){wb[tap].z, wb[tap].w}) * w1;
        }
        *(u32x4*)(lin + (size_t)ta * 1024 + c8) = pack8(a0, a1);
        if (hasb) *(u32x4*)(lin + (size_t)tb * 1024 + c8) = pack8(b0, b1);
    }
}
__device__ __forceinline__ void scan_finish(const bf16* hloc, const bf16* pcum, const float* agg, const bf16* gl, bf16* rec, int vcu, int G, int tid) {
    const int c8 = (tid & 127) * 8, rg = tid >> 7;
    for (int chunk = vcu; chunk < T_ / 64; chunk += G) {
        const int ci = chunk & 31, cb = chunk - ci;
        float carry[8];
#pragma unroll
        for (int j = 0; j < 8; ++j) carry[j] = 0.f;
#pragma unroll 4
        for (int cc = 0; cc < ci; ++cc) {
            const f32x4* ap = (const f32x4*)(agg + ((size_t)(cb + cc) * 1024 + c8) * 2);
#pragma unroll
            for (int q = 0; q < 4; ++q) { const f32x4 v = ap[q]; carry[2 * q] = fmaf(v[0], carry[2 * q], v[1]); carry[2 * q + 1] = fmaf(v[2], carry[2 * q + 1], v[3]); }
        }
#pragma unroll 8
        for (int rr = 0; rr < 16; ++rr) {
            const size_t o = (size_t)(chunk * 64 + rg + 4 * rr) * 1024 + c8;
            const u32x4 hw = *(const u32x4*)(hloc + o), pw = *(const u32x4*)(pcum + o), gw = *(const u32x4*)(gl + o);
            const f32x4 h0 = bf4_lo((u32x2){hw.x, hw.y}), h1 = bf4_lo((u32x2){hw.z, hw.w}), p0 = bf4_lo((u32x2){pw.x, pw.y}), p1 = bf4_lo((u32x2){pw.z, pw.w});
            const f32x4 g0 = bf4_lo((u32x2){gw.x, gw.y}), g1 = bf4_lo((u32x2){gw.z, gw.w});
            f32x4 r0, r1;
#pragma unroll
            for (int j = 0; j < 4; ++j) { r0[j] = fmaf(p0[j], carry[j], h0[j]) * g0[j]; r1[j] = fmaf(p1[j], carry[4 + j], h1[j]) * g1[j]; }
            *(u32x4*)(rec + o) = pack8(r0, r1);
        }
    }
}
__device__ __forceinline__ void final_rows(float* h, const bf16* h3b, const float* part, const float* fg, int gw, int NGW, int lane, float tscale) {
    f32x4 g[4];
#pragma unroll
    for (int j = 0; j < 4; ++j) g[j] = ((const f32x4*)fg)[lane + 64 * j];
    for (int r0 = gw; r0 < T_; r0 += 2 * NGW) {
        const int r1 = (r0 + NGW < T_) ? r0 + NGW : r0;
        float pa = (lane < 16) ? part[(size_t)r0 * 16 + lane] : 0.f, pb = (lane < 16) ? part[(size_t)r1 * 16 + lane] : 0.f;
#if ALL_FUSED
        const u32x2* ba = (const u32x2*)(h3b + (size_t)r0 * 1024) + lane; const u32x2* bb = (const u32x2*)(h3b + (size_t)r1 * 1024) + lane;
        u32x2 wa[4], wb[4];
#pragma unroll
        for (int j = 0; j < 4; ++j) { wa[j] = ba[64 * j]; wb[j] = bb[64 * j]; }
#endif
#pragma unroll
        for (int o = 1; o < 64; o <<= 1) { pa += __shfl_xor(pa, o); pb += __shfl_xor(pb, o); }
        const float ra = tscale / sqrtf(pa * (1.0f / 1024.0f) + EPS), rb = tscale / sqrtf(pb * (1.0f / 1024.0f) + EPS);
        f32x4* ha = (f32x4*)(h + (size_t)r0 * 1024) + lane; f32x4* hb = (f32x4*)(h + (size_t)r1 * 1024) + lane;
#if ALL_FUSED
#pragma unroll
        for (int j = 0; j < 4; ++j) ha[64 * j] = bf4_lo(wa[j]) * ra * g[j];
        if (r1 != r0) {
#pragma unroll
            for (int j = 0; j < 4; ++j) hb[64 * j] = bf4_lo(wb[j]) * rb * g[j];
        }
#else
#pragma unroll
        for (int j = 0; j < 4; ++j) ha[64 * j] = ha[64 * j] * ra * g[j];
        if (r1 != r0) {
#pragma unroll
            for (int j = 0; j < 4; ++j) hb[64 * j] = hb[64 * j] * rb * g[j];
        }
#endif
    }
}

constexpr int N_PHASES = 16;
struct Args { const float* in[25]; float* out; unsigned char* ws; int ph_lo, ph_hi, li, pad; };
__global__ void __launch_bounds__(NWAVES * 64, 2) fused_fwd(Args args) {
    extern __shared__ __attribute__((aligned(16))) unsigned char lds_raw[];
    LAS unsigned char* lds = (LAS unsigned char*)lds_raw;
    volatile LAS unsigned* MISC = (volatile LAS unsigned*)(lds + LDSCTL_OFF);
    const int wave = __builtin_amdgcn_readfirstlane((int)threadIdx.x >> 6);
#define FRESH_TID() (wave * 64 + fresh_lane())
#define FRESH_LANE() fresh_lane()
    const int G = gridDim.x; const int bx = blockIdx.x; const int vcu = (G % 8 == 0) ? (bx % 8) * (G / 8) + bx / 8 : bx;
    unsigned char* ws = args.ws; float* out = args.out;
    In in;
#pragma unroll
    for (int i = 0; i < 25; ++i) in.p[i] = args.in[i];
    for (int u = FRESH_TID(); u < (LDS_BYTES - LDSCTL_OFF) / 4; u += NWAVES * 64) ((LAS unsigned*)(lds + LDSCTL_OFF))[u] = 0u;
    __syncthreads();
    (void)xcd_barrier_post((unsigned*)(ws + WS_CTL) + CW_BAR + args.li * XCD_BAR_WORDS, MISC + 8);
    const int lo = args.ph_lo, hi = args.ph_hi;
    const int gw = vcu * NWAVES + wave, NGW = G * NWAVES;
#ifndef PH_DISABLE
#define PH_DISABLE 0
#endif
#if ALL_FUSED
#define IN(k) (!((PH_DISABLE >> (k)) & 1))
#else
#define IN(k) (lo <= (k) && (k) < hi && !((PH_DISABLE >> (k)) & 1))
#endif
#ifdef TIMING_A
#define STAMP(i) do { if (bx == 0 && FRESH_TID() == 0) __hip_atomic_store((unsigned long long*)(ws + WS_CTL + 512) + (i), __builtin_amdgcn_s_memrealtime(), __ATOMIC_RELAXED, __HIP_MEMORY_SCOPE_AGENT); } while (0)
#else
#define STAMP(i) do { } while (0)
#endif
#define SEAM(k) do { if (IN(k) && IN((k) + 1)) { XcdBarrier b_; b_.bar = (unsigned*)(args.ws + WS_CTL) + CW_BAR + args.li * XCD_BAR_WORDS; b_.x = xb_xcc_id(); b_.st = (volatile LAS unsigned*)(lds + LDSCTL_OFF) + 8;     \
        xcd_barrier(b_); STAMP((k) + 1); } } while (0)
#if ALL_FUSED
#define PP_PTR ((const bf16*)((const unsigned char*)out + 32 * MiB))
#define MP_PTR out
#else
#define PP_PTR ((const bf16*)(ws + WS_PP))
#define MP_PTR ((float*)(ws + WS_MP))
#endif
#define GEMM_PHASE(EPI, Aptr, Bptr, Kdim, LDA, M_, N_, SH, STR, ...) do { \
        pg8::Gemm g{(const pg8::bf16_t*)(Aptr), (const pg8::bf16_t*)(Bptr), Kdim, LDA, SH, STR}; pg8::StaticOrder S; S.init(M_, N_, G, (int)blockIdx.x); \
        EPI E{__VA_ARGS__}; pg8::gemm_phase<EPI, pg8::StaticOrder, true, true>(lds, g, S, E, wave); } while (0)

    STAMP(0);
    if (IN(0)) { p0_prologue(in, ws, lds, vcu, G, wave, FRESH_TID()); } SEAM(0);
    if (IN(1)) { GEMM_PHASE(EpiProj, ws + WS_R0, ws + WS_WIN, 1024, 1024, T_, INW, 0, 0, (const float*)(ws + WS_RSTD1), ws); } SEAM(1);
    if (IN(2)) {
        for (int it = bx; it < 256; it += G) attn_item(lds, (const bf16*)(ws + WS_QKV), in.p[I_SINK], (bf16*)(ws + WS_ATT), it, wave, FRESH_TID());
        conv_items((const bf16*)(ws + WS_LX), in.p[I_CONVW], in.p[I_CONVB], (bf16*)(ws + WS_R0), vcu, G, FRESH_TID());
    } SEAM(2);
#if LRU_PADDED == 2
    if (IN(3)) { GEMM_PHASE(EpiLru, ws + WS_R0, ws + WS_WAX, 128, 1024, T_, 2048, 0, 128,
#elif LRU_PADDED
    if (IN(3)) { GEMM_PHASE(EpiLru, ws + WS_R0, ws + WS_WAX, 256, 1024, T_, 2048, 1, 256,
#else
    if (IN(3)) { GEMM_PHASE(EpiLru, ws + WS_R0, ws + WS_WAXD, 1024, 1024, T_, 2048, 0, 0,
#endif
        (const bf16*)(ws + WS_R0), in.p[I_BA], in.p[I_BX], (const float*)(ws + WS_C8), (bf16*)(ws + WS_HLOC), (bf16*)(ws + WS_PCUM), (float*)(ws + WS_AGG)); }
    SEAM(3);
    if (IN(4)) { scan_finish((const bf16*)(ws + WS_HLOC), (const bf16*)(ws + WS_PCUM), (const float*)(ws + WS_AGG), (const bf16*)(ws + WS_GL), (bf16*)(ws + WS_R0), vcu, G, FRESH_TID()); }
#if !ALL_FUSED
    SEAM(4);
#endif
    if (IN(5)) { GEMM_PHASE(EpiMP, ws + WS_ATT, ws + WS_WUA, 512, 512, T_, 1024, 0, 0, (const bf16*)(ws + WS_SGA), MP_PTR); }
#if ALL_FUSED
    if (IN(13)) { pg8::Gemm g{(const pg8::bf16_t*)(ws + WS_PB), (const pg8::bf16_t*)(ws + WS_WPROJ), 256, 256, 0, 0}; pg8::StaticOrder S;
        if (G >= 256) S.init(T_, 1024, G - 128, (int)blockIdx.x >= 128 ? (int)blockIdx.x - 128 : (1 << 30)); else S.init(T_, 1024, G, (int)blockIdx.x);
        EpiPP E{(bf16*)((unsigned char*)out + 32 * MiB)}; pg8::gemm_phase<EpiPP, pg8::StaticOrder, true, true>(lds, g, S, E, wave); }
#endif
    SEAM(5);
    if (IN(6)) { GEMM_PHASE(EpiMerged, ws + WS_R0, ws + WS_WUL, 1024, 1024, T_, 1024, 0, 0, (const bf16*)(ws + WS_SGL), (const float*)MP_PTR, (bf16*)(ws + WS_MERGED)); } SEAM(6);
    if (IN(7)) { GEMM_PHASE(EpiH1, ws + WS_MERGED, ws + WS_WO, 1024, 1024, T_, 1024, 0, 0, in.p[I_X], out, (bf16*)(ws + WS_R0), (float*)(ws + WS_PART2)); }
    SEAM(7);
#define PEER_HALF(half) do { \
        if (IN(8 + 2 * (half))) { GEMM_PHASE(EpiScore, ws + WS_R0, ws + WS_WFOLD + (size_t)(half) * 1024 * 1024 * 2, 1024, 1024, T_, 1024, 0, 0, (const float*)(ws + WS_PART2), (float*)(ws + WS_SC)); } SEAM(8 + 2 * (half)); \
        if (IN(9 + 2 * (half))) { \
            for (int it = vcu; it < T_ / TK_TOK; it += G) topk_item((LAS float*)lds, (const float*)(ws + WS_SC), it, (half) * 4, (int*)(ws + WS_SELI), (float*)(ws + WS_SELG), FRESH_TID()); \
            if ((half) == 0) uv_convert(in.p[I_U], in.p[I_V], in.p[I_GFFN], ws + WS_U16, ws + WS_U16 + 16 * MiB, (float*)(ws + WS_USCALE), (float*)(ws + WS_USCALE) + 16384, gw, NGW, FRESH_LANE()); \
        } SEAM(9 + 2 * (half)); } while (0)
#if ALL_FUSED
    if (IN(8)) {
        for (int kk = 0; kk < 2; ++kk) { pg8::Gemm g{(const pg8::bf16_t*)(ws + WS_R0), (const pg8::bf16_t*)(ws + WS_WFOLD), 1024, 1024, 0, 0}; OneUnit S; S.S.init(T_, 2048, G, (int)blockIdx.x); S.k = kk;
            EpiTopk E{(const float*)(ws + WS_PART2), (int*)(ws + WS_SELI), (float*)(ws + WS_SELG), in.p[I_U], in.p[I_V], in.p[I_GFFN], ws + WS_U16, ws + WS_U16 + 16 * MiB, (float*)(ws + WS_USCALE), (float*)(ws + WS_USCALE) + 16384,
                      vcu * 16 + kk * 8, (2 * G == (T_ / 256) * 8) ? 16 * G : 0};
            pg8::gemm_phase<EpiTopk, OneUnit, false, true>(lds, g, S, E, wave); }
        if (2 * G != (T_ / 256) * 8) uv_convert(in.p[I_U], in.p[I_V], in.p[I_GFFN], ws + WS_U16, ws + WS_U16 + 16 * MiB, (float*)(ws + WS_USCALE), (float*)(ws + WS_USCALE) + 16384, gw, NGW, FRESH_LANE());
    } SEAM(11);
#else
    PEER_HALF(0);
    PEER_HALF(1);
#endif
    if (IN(12)) {
#ifdef PROBE_MODE
        for (int tok0 = vcu * 64; tok0 < T_; tok0 += G * 64)
#if GATHER_ROWS == 3
            gather_wg_mixed<PROBE_MODE>(tok0, wave, FRESH_LANE(), lds, ws + WS_U16, ws + WS_U16 + 16 * MiB, (const float*)(ws + WS_USCALE), (const float*)(ws + WS_USCALE) + 16384, (const int*)(ws + WS_SELI), (const float*)(ws + WS_SELG), (const float*)(ws + WS_PART2), (const bf16*)(ws + WS_R0), (bf16*)(ws + WS_H2B), (float*)(ws + WS_RSTD3), (float*)(ws + WS_SC));
#elif GATHER_ROWS == 1
            gather_wg_rows<PROBE_MODE>(tok0, wave, FRESH_LANE(), lds, ws + WS_U16, ws + WS_U16 + 16 * MiB, (const float*)(ws + WS_USCALE), (const float*)(ws + WS_USCALE) + 16384, (const int*)(ws + WS_SELI), (const float*)(ws + WS_SELG), (const float*)(ws + WS_PART2), (const bf16*)(ws + WS_R0), (bf16*)(ws + WS_H2B), (float*)(ws + WS_RSTD3), (float*)(ws + WS_SC));
#else
            gather_wg_sliced<PROBE_MODE>(tok0, wave, FRESH_LANE(), lds, ws + WS_U16, ws + WS_U16 + 16 * MiB, (const float*)(ws + WS_USCALE), (const float*)(ws + WS_USCALE) + 16384, (const int*)(ws + WS_SELI), (const float*)(ws + WS_SELG), (const float*)(ws + WS_PART2), out, (const bf16*)(ws + WS_R0), (bf16*)(ws + WS_H2B), (float*)(ws + WS_RSTD3), (float*)(ws + WS_SC));
#endif
        { XcdBarrier b_; b_.bar = (unsigned*)(args.ws + WS_CTL) + CW_BAR + args.li * XCD_BAR_WORDS; b_.x = xb_xcc_id(); b_.st = (volatile LAS unsigned*)(lds + LDSCTL_OFF) + 8; xcd_barrier(b_); STAMP(16); }
#endif
        for (int tok0 = vcu * 64; tok0 < T_; tok0 += G * 64)
#if GATHER_ROWS == 3
            gather_wg_mixed<0>(tok0, wave, FRESH_LANE(), lds, ws + WS_U16, ws + WS_U16 + 16 * MiB, (const float*)(ws + WS_USCALE), (const float*)(ws + WS_USCALE) + 16384, (const int*)(ws + WS_SELI), (const float*)(ws + WS_SELG), (const float*)(ws + WS_PART2), (const bf16*)(ws + WS_R0), (bf16*)(ws + WS_H2B), (float*)(ws + WS_RSTD3), nullptr);
#elif GATHER_ROWS == 1
            gather_wg_rows<0>(tok0, wave, FRESH_LANE(), lds, ws + WS_U16, ws + WS_U16 + 16 * MiB, (const float*)(ws + WS_USCALE), (const float*)(ws + WS_USCALE) + 16384, (const int*)(ws + WS_SELI), (const float*)(ws + WS_SELG), (const float*)(ws + WS_PART2), (const bf16*)(ws + WS_R0), (bf16*)(ws + WS_H2B), (float*)(ws + WS_RSTD3), nullptr);
#else
            gather_wg_sliced<0>(tok0, wave, FRESH_LANE(), lds, ws + WS_U16, ws + WS_U16 + 16 * MiB, (const float*)(ws + WS_USCALE), (const float*)(ws + WS_USCALE) + 16384, (const int*)(ws + WS_SELI), (const float*)(ws + WS_SELG), (const float*)(ws + WS_PART2), out, (const bf16*)(ws + WS_R0), (bf16*)(ws + WS_H2B), (float*)(ws + WS_RSTD3), nullptr);
#endif
    } SEAM(12);
#if !ALL_FUSED
    if (IN(13)) { GEMM_PHASE(EpiPP, ws + WS_PB, ws + WS_WPROJ, 256, 256, T_, 1024, 0, 0, (bf16*)(ws + WS_PP)); } SEAM(13);
#endif
#if ALL_FUSED && FUSE_FINAL
    if (IN(14)) { GEMM_PHASE(EpiH3Final, ws + WS_H2B, ws + WS_WG, 1024, 1024, T_, 1024, 0, 0, (const float*)(ws + WS_RSTD3), PP_PTR, (const bf16*)(ws + WS_H2B), in.p[I_FG], out, (float*)(ws + WS_PART4), (unsigned*)(ws + WS_CTL) + 65536); }
#else
    if (IN(14)) { GEMM_PHASE(EpiH3, ws + WS_H2B, ws + WS_WG, 1024, 1024, T_, 1024, 0, 0, (const float*)(ws + WS_RSTD3), PP_PTR, out, (float*)(ws + WS_PART4), (const bf16*)(ws + WS_H2B), (bf16*)(ws + WS_R0)); } SEAM(14);
#ifdef TIMING_A
    float tscale = 1.0f;
    { const unsigned long long ta = __hip_atomic_load((unsigned long long*)(ws + WS_CTL + 512) + TIMING_A, __ATOMIC_RELAXED, __HIP_MEMORY_SCOPE_AGENT), tb = __hip_atomic_load((unsigned long long*)(ws + WS_CTL + 512) + TIMING_B, __ATOMIC_RELAXED, __HIP_MEMORY_SCOPE_AGENT);
      tscale = 1.0f + (float)(tb - ta) * 0.01f * (float)(TIMING_K); }
    if (IN(15)) { final_rows(out, (const bf16*)(ws + WS_R0), (const float*)(ws + WS_PART4), in.p[I_FG], gw, NGW, FRESH_LANE(), tscale); }
#else
    if (IN(15)) { final_rows(out, (const bf16*)(ws + WS_R0), (const float*)(ws + WS_PART4), in.p[I_FG], gw, NGW, FRESH_LANE(), 1.0f); }
#endif
#endif
#undef IN
#undef SEAM
#undef GEMM_PHASE
}
static const int GRP_LO[11] = {0, 2, 3, 5, 6, 7, 8, 12, 13, 14, 15};
static const int GRP_HI[11] = {2, 3, 5, 6, 7, 8, 12, 13, 14, 15, 16};

static void naive_group(int grp, void* const* d_in, float* out, unsigned char* ws, hipStream_t st) {
    const float* x = (const float*)d_in[0]; const float* p = (const float*)d_in[1]; const float* g_mix = (const float*)d_in[2]; const float* w_in = (const float*)d_in[3];
    const float* sink = (const float*)d_in[4]; const float* conv_w = (const float*)d_in[5]; const float* conv_b = (const float*)d_in[6];
    const float* wa = (const float*)d_in[7]; const float* ba = (const float*)d_in[8]; const float* wx = (const float*)d_in[9]; const float* bx = (const float*)d_in[10]; const float* lam = (const float*)d_in[11];
    const float* w_ua = (const float*)d_in[12]; const float* w_ul = (const float*)d_in[13]; const float* w_o = (const float*)d_in[14]; const float* g_ffn = (const float*)d_in[15];
    const float* wq = (const float*)d_in[16]; const float* k1 = (const float*)d_in[17]; const float* k2 = (const float*)d_in[18]; const float* pu = (const float*)d_in[19]; const float* pv = (const float*)d_in[20];
    const float* g_ple = (const float*)d_in[21]; const float* w_gate = (const float*)d_in[22]; const float* w_proj = (const float*)d_in[23]; const float* final_g = (const float*)d_in[24];
    float* rstd1 = (float*)(ws + WS_RSTD1); float* part2 = (float*)(ws + WS_PART2); float* part4 = (float*)(ws + WS_PART4); float* rstd3 = (float*)(ws + WS_RSTD3);
    bf16* qkv = (bf16*)(ws + WS_QKV); bf16* lx = (bf16*)(ws + WS_LX); bf16* gl = (bf16*)(ws + WS_GL); bf16* sga = (bf16*)(ws + WS_SGA); bf16* sgl = (bf16*)(ws + WS_SGL);
    bf16* att = (bf16*)(ws + WS_ATT); bf16* r0 = (bf16*)(ws + WS_R0); float* mp = (float*)(ws + WS_MP); bf16* merged = (bf16*)(ws + WS_MERGED);
    float* sc = (float*)(ws + WS_SC); int* seli = (int*)(ws + WS_SELI); float* selg = (float*)(ws + WS_SELG); bf16* h2b = (bf16*)(ws + WS_H2B); bf16* pp = (bf16*)(ws + WS_PP);
    float* tmpf = (float*)(ws + WS_NAIVE_AB);
    switch (grp) {
    case 0:
        hipLaunchKernelGGL(nv::rowsq, dim3(T_ / 4), dim3(256), 0, st, x, rstd1, (float*)nullptr);
        nv::run_gemm<nv::ALf32, nv::EpiProj, false>(st, nv::ALf32{x, 1024}, w_in, INW, g_mix, T_, INW, 1024, nv::EpiProj{rstd1, qkv, lx, gl, sga, sgl});
        break;
    case 1:
        hipLaunchKernelGGL(nv::attn_naive, dim3(T_ * 8 / 128), dim3(128), 0, st, qkv, sink, att);
        hipLaunchKernelGGL(nv::conv_naive, dim3(T_ * 1024 / 256), dim3(256), 0, st, lx, conv_w, conv_b, r0);
        break;
    case 2:
        hipLaunchKernelGGL(nv::lru_ab_naive, dim3(T_ * 8), dim3(128), 0, st, r0, wa, ba, wx, bx, lam, out, tmpf);
        hipLaunchKernelGGL(nv::lru_scan_naive, dim3(B_ * 1024 / 64), dim3(64), 0, st, out, tmpf, gl, r0);
        break;
    case 3: nv::run_gemm<nv::ALbf16, nv::EpiMP, false>(st, nv::ALbf16{att, 512}, w_ua, 1024, nullptr, T_, 1024, 512, nv::EpiMP{sga, mp}); break;
    case 4: nv::run_gemm<nv::ALbf16, nv::EpiMerged, false>(st, nv::ALbf16{r0, 1024}, w_ul, 1024, nullptr, T_, 1024, 1024, nv::EpiMerged{sgl, mp, merged}); break;
    case 5:
        nv::run_gemm<nv::ALbf16, nv::EpiH1, false>(st, nv::ALbf16{merged, 1024}, w_o, 1024, nullptr, T_, 1024, 1024, nv::EpiH1{x, out, r0});
        hipLaunchKernelGGL(nv::rowsq, dim3(T_ / 4), dim3(256), 0, st, out, (float*)nullptr, part2);
        break;
    case 6:
        for (int half = 0; half < 2; ++half) {
            nv::run_gemm<nv::ALf32, nv::EpiScaleF32, false>(st, nv::ALf32{out, 1024}, wq + half * 1024, 2048, g_ffn, T_, 1024, 1024, nv::EpiScaleF32{part2, tmpf, 1024});
            for (int hl = 0; hl < 4; ++hl)
                for (int hf = 0; hf < 2; ++hf)
                    nv::run_gemm<nv::ALf32, nv::EpiPlainF32, true>(st, nv::ALf32{tmpf + hl * 256 + hf * 128, 1024}, hf ? k2 : k1, 128, nullptr, T_, 128, 128, nv::EpiPlainF32{sc + hl * 256 + hf * 128, 1024});
            hipLaunchKernelGGL(topk_kernel, dim3(T_ / TK_TOK), dim3(512), TK_LDS_BYTES, st, sc, half * 4, seli, selg);
        }
        break;
    case 7: hipLaunchKernelGGL(gather_kernel<0>, dim3(1024), dim3(256), 0, st, (const void*)pu, (const void*)pv, g_ffn, seli, selg, part2, out, h2b, rstd3); break;
    case 8: nv::run_gemm<nv::ALf32, nv::EpiPP, false>(st, nv::ALf32{p, 256}, w_proj, 1024, nullptr, T_, 1024, 256, nv::EpiPP{pp}); break;
    case 9: nv::run_gemm<nv::ALbf16, nv::EpiH3, false>(st, nv::ALbf16{h2b, 1024}, w_gate, 1024, g_ple, T_, 1024, 1024, nv::EpiH3{rstd3, pp, out});
        hipLaunchKernelGGL(nv::rowsq, dim3(T_ / 4), dim3(256), 0, st, out, (float*)nullptr, part4);
        break;
    case 10: hipLaunchKernelGGL(nv::final_norm, dim3(T_ / 4), dim3(256), 0, st, out, part4, final_g); break;
    }
}

extern "C" void kernel_launch(void* const* d_in, const int* in_sizes, int n_in, void* d_out, int out_size, void* d_ws, size_t ws_size, hipStream_t stream) {
    static int grid = 0;
    if (grid == 0) {
        if (n_in != 25 || out_size != T_ * 1024 || ws_size < WS_END) { fprintf(stderr, "kernel_launch: unexpected sizes n_in %d out %d ws %zu\n", n_in, out_size, ws_size); }
        (void)hipFuncSetAttribute((const void*)topk_kernel, hipFuncAttributeMaxDynamicSharedMemorySize, TK_LDS_BYTES);
        int dev = 0, cus = 0, per_cu = 0;
        (void)hipGetDevice(&dev); (void)hipDeviceGetAttribute(&cus, hipDeviceAttributeMultiprocessorCount, dev);
        if (hipFuncSetAttribute((const void*)fused_fwd, hipFuncAttributeMaxDynamicSharedMemorySize, LDS_BYTES) != hipSuccess) fprintf(stderr, "kernel_launch: hipFuncSetAttribute(fused_fwd) failed\n");
        if (hipOccupancyMaxActiveBlocksPerMultiprocessor(&per_cu, (const void*)fused_fwd, NWAVES * 64, LDS_BYTES) != hipSuccess || per_cu < 1) fprintf(stderr, "kernel_launch: occupancy query says %d blocks/CU\n", per_cu);
        (void)hipGetLastError();
        grid = cus > 0 ? cus : 256;
    }
    unsigned char* ws = (unsigned char*)d_ws; float* out = (float*)d_out;
    const unsigned mask = FUSED_MASK;
    if (mask) (void)hipMemsetAsync(ws + WS_CTL, 0, CTL_ZERO_BYTES, stream);
    Args a{};
    for (int i = 0; i < 25; ++i) a.in[i] = (const float*)d_in[i];
    a.out = out; a.ws = ws;
    int li = 0;
    auto launch = [&](int lo, int hi) {
        if (MERGE_LAUNCHES) { a.ph_lo = lo; a.ph_hi = hi; a.li = li++; hipLaunchKernelGGL(fused_fwd, dim3(grid), dim3(NWAVES * 64), LDS_BYTES, stream, a); }
        else for (int ph = lo; ph < hi; ++ph) { a.ph_lo = ph; a.ph_hi = ph + 1; a.li = li++; hipLaunchKernelGGL(fused_fwd, dim3(grid), dim3(NWAVES * 64), LDS_BYTES, stream, a); }
    };
    int pend_lo = -1, pend_hi = -1;
    if (mask && !(mask & 1)) launch(0, 1);
    for (int gidx = 0; gidx < 11; ++gidx) {
#if (defined(LRU_T2) && LRU_T2) || (defined(LRU_T3) && LRU_T3)
        if (gidx == 2 && (mask & 4u)) {
            if (pend_lo >= 0) { launch(pend_lo, pend_hi); pend_lo = -1; }
            launch(3, 4);
            hipLaunchKernelGGL(nv::lru_finish_naive_L<(LRU_T2 ? 16 : 64)>, dim3(B_ * 1024 / 64), dim3(64), 0, stream, (const bf16*)(ws + WS_HLOC), (const bf16*)(ws + WS_PCUM), (const bf16*)(ws + WS_GL), (bf16*)(ws + WS_R0));
            continue;
        }
#endif
        if (mask & (1u << gidx)) {
            if (pend_lo < 0) { pend_lo = GRP_LO[gidx]; pend_hi = GRP_HI[gidx]; } else pend_hi = GRP_HI[gidx];
        } else {
            if (pend_lo >= 0) { launch(pend_lo, pend_hi); pend_lo = -1; }
            naive_group(gidx, d_in, out, ws, stream);
        }
    }
    if (pend_lo >= 0) launch(pend_lo, pend_hi);
#if defined(LRU_DEBUG) && LRU_DEBUG == 2
    hipLaunchKernelGGL(nv::poison_if, dim3(T_ * 1024 / 256), dim3(256), 0, stream, out, (const unsigned*)(ws + WS_CTL) + 64);
#endif
}
```

```cpp
#include <hip/hip_runtime.h>
#include <cstdio>
#include <cstdint>
#include <cmath>

#ifndef FUSED_MASK
#define FUSED_MASK 0x7ff
#endif
#ifndef MERGE_LAUNCHES
#define MERGE_LAUNCHES 1
#endif
#ifndef LRU_PADDED
#define LRU_PADDED 1
#endif
#ifndef FUSE_FINAL
#define FUSE_FINAL 0
#endif
#ifndef GATHER_ROWS
#define GATHER_ROWS 3
#endif
#ifndef MIX_PIPE
#define MIX_PIPE 1
#endif
#ifndef V_FP6
#define V_FP6 1
#endif
#ifndef U_FP6
#define U_FP6 0
#endif
#ifndef Y_F16
#define Y_F16 1
#endif
#define ALL_FUSED ((FUSED_MASK) == 0x7ff && (MERGE_LAUNCHES))
constexpr int B_ = 8, S_ = 2048, D_ = 1024, T_ = B_ * S_;
constexpr int INW = 4864;
constexpr float EPS = 1e-6f;
typedef unsigned short bf16;
typedef unsigned u32x3 __attribute__((ext_vector_type(3)));
#define HD_INLINE __host__ __device__ __forceinline__

constexpr size_t MiB = 1u << 20;
constexpr size_t WS_CTL = 0;
constexpr size_t WS_WIN = 1 * MiB;
constexpr size_t WS_WUA = WS_WIN + 4864 * 1024 * 2;
constexpr size_t WS_WUL = WS_WUA + 1 * MiB;
constexpr size_t WS_WO = WS_WUL + 2 * MiB;
constexpr size_t WS_WFOLD = WS_WO + 2 * MiB;
constexpr size_t WS_WG = WS_WFOLD + 4 * MiB;
constexpr size_t WS_WPROJ = WS_WG + 2 * MiB;
constexpr size_t WS_WAX = WS_WPROJ + MiB / 2;
constexpr size_t WS_W_END = WS_WAX + 1 * MiB;
static_assert(WS_W_END <= 23 * MiB, "weights");
constexpr size_t WS_RSTD1 = 23 * MiB;
constexpr size_t WS_PART2 = WS_RSTD1 + 256 * 1024;
constexpr size_t WS_PART4 = WS_PART2 + 1 * MiB;
constexpr size_t WS_RSTD3 = WS_PART4 + 1 * MiB;
constexpr size_t WS_AGG = WS_RSTD3 + 256 * 1024;
constexpr size_t WS_C8 = WS_AGG + 2 * MiB;
constexpr size_t WS_USCALE = WS_C8 + 64 * 1024;
static_assert(WS_USCALE + 128 * 1024 <= 28 * MiB, "small");
constexpr size_t WS_PB = 28 * MiB;
constexpr size_t WS_R0 = 36 * MiB;
constexpr size_t WS_QKV = 68 * MiB;
constexpr size_t WS_LX = 92 * MiB;
constexpr size_t WS_GL = 140 * MiB;
constexpr size_t WS_SGA = 172 * MiB;
constexpr size_t WS_SGL = 204 * MiB;
constexpr size_t WS_ATT = 236 * MiB;
constexpr size_t WS_HLOC = 68 * MiB, WS_PCUM = 100 * MiB;
constexpr size_t WS_MP = 68 * MiB;
constexpr size_t WS_MERGED = 140 * MiB;
constexpr size_t WS_SC = 172 * MiB;
constexpr size_t WS_SELI = 236 * MiB, WS_SELG = 244 * MiB;
constexpr size_t WS_U16 = 68 * MiB, WS_V16 = 100 * MiB;
constexpr size_t WS_H2B = 140 * MiB;
constexpr size_t WS_PP = 172 * MiB;
constexpr size_t WS_NAIVE_AB = 68 * MiB;
constexpr size_t WS_WAXD = 252 * MiB;
constexpr size_t WS_END = 256 * MiB;

HD_INLINE float bf2f(bf16 v) { return __builtin_bit_cast(float, (unsigned)v << 16); }
HD_INLINE bf16 f2bf(float f) { unsigned u = __builtin_bit_cast(unsigned, f); return (bf16)((u + 0x7fffu + ((u >> 16) & 1u)) >> 16); }
HD_INLINE unsigned pk2(float lo, float hi) { return (unsigned)f2bf(lo) | ((unsigned)f2bf(hi) << 16); }
__device__ __forceinline__ float wave_sum(float v) {
#pragma unroll
    for (int o = 1; o < 64; o <<= 1) v += __shfl_xor(v, o);
    return v;
}
__device__ __forceinline__ float sigmoidf_(float z) { return __builtin_amdgcn_rcpf(1.0f + __builtin_amdgcn_exp2f(-1.4426950408889634f * z)); }
__device__ __forceinline__ float gelu_tanh(float x) { const float u = 1.5957691216057308f * (x + 0.044715f * x * x * x); return x * sigmoidf_(u); }
__device__ __forceinline__ int fresh_lane() { int l; asm volatile("v_mbcnt_lo_u32_b32 %0, -1, 0\n\tv_mbcnt_hi_u32_b32 %0, -1, %0" : "=v"(l)); return l; }
#ifndef HD_INLINE
#define HD_INLINE __host__ __device__ __forceinline__
#endif

HD_INLINE unsigned tk_umax(unsigned a, unsigned b) { return a > b ? a : b; }
HD_INLINE unsigned tk_umin(unsigned a, unsigned b) { return a < b ? a : b; }
HD_INLINE unsigned tk_f2key(float f) { unsigned u = __builtin_bit_cast(unsigned, f); return u ^ ((unsigned)((int)u >> 31) | 0x80000000u); }
HD_INLINE float tk_key2f(unsigned k) { unsigned u = (k & 0x80000000u) ? (k ^ 0x80000000u) : ~k; return __builtin_bit_cast(float, u); }

HD_INLINE void tk_sort16(unsigned (&a)[16]) {
#pragma unroll
    for (int k = 2; k <= 16; k <<= 1) {
#pragma unroll
        for (int j = k >> 1; j > 0; j >>= 1) {
#pragma unroll
            for (int i = 0; i < 16; ++i) {
                const int p = i ^ j;
                if (p > i) {
                    const unsigned mx = tk_umax(a[i], a[p]), mn = tk_umin(a[i], a[p]);
                    if ((i & k) == 0) { a[i] = mx; a[p] = mn; } else { a[i] = mn; a[p] = mx; }
                }
            }
        }
    }
}
HD_INLINE void tk_merge16(unsigned (&a)[16], const unsigned (&b)[16]) {
#pragma unroll
    for (int i = 0; i < 16; ++i) a[i] = tk_umax(a[i], b[15 - i]);
#pragma unroll
    for (int j = 8; j > 0; j >>= 1) {
#pragma unroll
        for (int i = 0; i < 16; ++i) {
            const int p = i ^ j;
            if (p > i) { const unsigned mx = tk_umax(a[i], a[p]), mn = tk_umin(a[i], a[p]); a[i] = mx; a[p] = mn; }
        }
    }
}
HD_INLINE void tk_insert16(unsigned (&best)[16], unsigned key) {
#pragma unroll
    for (int s = 0; s < 16; ++s) { const unsigned hi = tk_umax(best[s], key); key = tk_umin(best[s], key); best[s] = hi; }
}
HD_INLINE void tk_combine_store(const unsigned (&k1)[16], const unsigned (&k2)[16], int* oi, float* og) {
    float v1[16], v2[16];
#pragma unroll
    for (int i = 0; i < 16; ++i) { v1[i] = tk_key2f(k1[i] & ~127u); v2[i] = tk_key2f(k2[i] & ~127u); }
    unsigned best[16];
#pragma unroll
    for (int s = 0; s < 16; ++s) best[s] = 0u;
#pragma unroll
    for (int i = 0; i < 16; ++i) {
#pragma unroll
        for (int j = 0; j < 16; ++j) {
            if ((i + 1) * (j + 1) <= 16) {
                const float s = v1[i] + v2[j];
                const unsigned key = (tk_f2key(s) & ~255u) | (unsigned)(255 - (i * 16 + j));
                tk_insert16(best, key);
            }
        }
    }
    const unsigned thr = best[15];
    const float mx = tk_key2f(best[0] & ~255u);
    float sum = 0.f;
#pragma unroll
    for (int i = 0; i < 16; ++i) {
#pragma unroll
        for (int j = 0; j < 16; ++j) {
            if ((i + 1) * (j + 1) <= 16) {
                const float s = v1[i] + v2[j];
                const unsigned key = (tk_f2key(s) & ~255u) | (unsigned)(255 - (i * 16 + j));
                if (key >= thr) sum += __builtin_expf(s - mx);
            }
        }
    }
    const float inv = 1.0f / sum;
    int cnt = 0;
#pragma unroll
    for (int i = 0; i < 16; ++i) {
#pragma unroll
        for (int j = 0; j < 16; ++j) {
            if ((i + 1) * (j + 1) <= 16) {
                const float s = v1[i] + v2[j];
                const unsigned key = (tk_f2key(s) & ~255u) | (unsigned)(255 - (i * 16 + j));
                if (key >= thr) {
                    oi[cnt] = (127 - (int)(k1[i] & 127u)) * 128 + (127 - (int)(k2[j] & 127u));
                    og[cnt] = __builtin_expf(s - mx) * inv;
                    ++cnt;
                }
            }
        }
    }
}

HD_INLINE unsigned tk_ckey(float s, unsigned odd64, int i, int j) { return ((tk_f2key(s) & ~255u) | (unsigned)(255 - (i * 16 + j))) - odd64; }
HD_INLINE void tk_pair_partial(const unsigned (&own)[16], const unsigned (&oth)[16], bool odd, unsigned (&r0)[16]) {
    float va[4], vb[16];
    const unsigned odd64 = odd ? 64u : 0u;
#pragma unroll
    for (int i = 0; i < 4; ++i) va[i] = tk_key2f(own[i] & ~127u);
#pragma unroll
    for (int j = 0; j < 16; ++j) vb[j] = tk_key2f(oth[j] & ~127u);
#pragma unroll
    for (int j = 1; j < 16; ++j) r0[j - 1] = tk_ckey(va[0] + vb[j], odd64, 0, j);
    r0[15] = 0u;
    unsigned l2[16];
#pragma unroll
    for (int j = 2; j < 8; ++j) l2[j - 2] = tk_ckey(va[1] + vb[j], odd64, 1, j);
    l2[6] = tk_ckey(va[2] + vb[3], odd64, 2, 3); l2[7] = tk_ckey(va[2] + vb[4], odd64, 2, 4);
#pragma unroll
    for (int d = 0; d < 4; ++d) { const unsigned k = tk_ckey(va[d] + vb[d], 0u, d, d); l2[8 + d] = odd ? 0u : k; }
#pragma unroll
    for (int d = 12; d < 16; ++d) l2[d] = 0u;
    tk_sort16(l2);
    tk_merge16(r0, l2);
}
HD_INLINE void tk_decode(unsigned key, int& i1, int& i2) { const int code = 255 - (int)(key & 255u); const int i = (code >> 4) & 3, j = code & 15; const bool po = (code >> 6) & 1; i1 = po ? j : i; i2 = po ? i : j; }
namespace nv {
struct ALf32 { const float* p; int lda; int pad; __device__ __forceinline__ float operator()(int m, int k) const { return p[(size_t)m * lda + k]; } };
struct ALbf16 { const bf16* p; int lda; int pad; __device__ __forceinline__ float operator()(int m, int k) const { return bf2f(p[(size_t)m * lda + k]); } };

template <class AL, class EPI, bool BT>
__global__ void __launch_bounds__(256) ngemm(AL al, const float* __restrict__ B, int ldb, const float* __restrict__ ks, int M, int N, int K, EPI epi) {
    __shared__ float As[16][68];
    __shared__ float Bs[16][68];
    const int tid = threadIdx.x, tx = tid & 15, ty = tid >> 4;
    const int m0 = blockIdx.y * 64, n0 = blockIdx.x * 64;
    float acc[4][4];
#pragma unroll
    for (int i = 0; i < 4; ++i)
#pragma unroll
        for (int j = 0; j < 4; ++j) acc[i][j] = 0.f;
    for (int k0 = 0; k0 < K; k0 += 16) {
#pragma unroll
        for (int i = 0; i < 4; ++i) {
            const int e = tid + i * 256;
            { const int m = e >> 4, k = e & 15; float v = al(m0 + m, k0 + k); if (ks) v *= ks[k0 + k]; As[k][m] = v; }
            if (BT) { const int n = e >> 4, k = e & 15; Bs[k][n] = B[(size_t)(n0 + n) * ldb + k0 + k]; }
            else { const int k = e >> 6, n = e & 63; Bs[k][n] = B[(size_t)(k0 + k) * ldb + n0 + n]; }
        }
        __syncthreads();
#pragma unroll
        for (int k = 0; k < 16; ++k) {
            float a[4], b[4];
#pragma unroll
            for (int i = 0; i < 4; ++i) { a[i] = As[k][ty * 4 + i]; b[i] = Bs[k][tx * 4 + i]; }
#pragma unroll
            for (int i = 0; i < 4; ++i)
#pragma unroll
                for (int j = 0; j < 4; ++j) acc[i][j] = fmaf(a[i], b[j], acc[i][j]);
        }
        __syncthreads();
    }
#pragma unroll
    for (int i = 0; i < 4; ++i)
#pragma unroll
        for (int j = 0; j < 4; ++j) epi(m0 + ty * 4 + i, n0 + tx * 4 + j, acc[i][j]);
}
template <class AL, class EPI, bool BT>
static void run_gemm(hipStream_t st, AL al, const float* B, int ldb, const float* ks, int M, int N, int K, EPI epi) {
    hipLaunchKernelGGL((ngemm<AL, EPI, BT>), dim3(N / 64, M / 64), dim3(256), 0, st, al, B, ldb, ks, M, N, K, epi);
}

__global__ void __launch_bounds__(256) rowsq(const float* __restrict__ X, float* rstd, float* part) {
    const int row = blockIdx.x * 4 + (threadIdx.x >> 6), lane = threadIdx.x & 63;
    const float* xr = X + (size_t)row * 1024;
    float s = 0.f;
    for (int j = 0; j < 16; ++j) { const float v = xr[lane + 64 * j]; s += v * v; }
    s = wave_sum(s);
    if (rstd && lane == 0) rstd[row] = 1.0f / sqrtf(s * (1.0f / 1024.0f) + EPS);
    if (part && lane < 16) part[(size_t)row * 16 + lane] = (lane == 0) ? s : 0.f;
}

struct EpiProj {
    const float* rstd; bf16 *qkv, *lx, *gl, *sga, *sgl;
    __device__ __forceinline__ void operator()(int m, int n, float v) const {
        v *= rstd[m];
        if (n < 768) qkv[(size_t)m * 768 + n] = f2bf(v);
        else if (n < 1792) lx[(size_t)m * 1024 + (n - 768)] = f2bf(v);
        else if (n < 2816) gl[(size_t)m * 1024 + (n - 1792)] = f2bf(gelu_tanh(v));
        else if (n < 3840) sga[(size_t)m * 1024 + (n - 2816)] = f2bf(sigmoidf_(v));
        else sgl[(size_t)m * 1024 + (n - 3840)] = f2bf(sigmoidf_(v));
    }
};

__global__ void __launch_bounds__(128) attn_naive(const bf16* __restrict__ qkv, const float* __restrict__ sink, bf16* __restrict__ att) {
    const int gid = blockIdx.x * 128 + threadIdx.x;
    const int head = gid / T_, t = gid % T_;
    const int b = t / S_, ts = t % S_;
    const int g = head >> 2;
    float q[64], acc[64];
    const bf16* qp = qkv + (size_t)t * 768 + head * 64;
#pragma unroll
    for (int d = 0; d < 64; ++d) { q[d] = bf2f(qp[d]); acc[d] = 0.f; }
    const float slope = exp2f(-(float)(head + 1));
    float m = -3.0e38f, l = 0.f;
    for (int dist = 127; dist >= 0; --dist) {
        const int s = ts - dist; if (s < 0) continue;
        const bf16* kp = qkv + (size_t)(b * S_ + s) * 768 + 512 + g * 64;
        const bf16* vp = kp + 128;
        float sc = 0.f;
#pragma unroll
        for (int d = 0; d < 64; ++d) sc = fmaf(q[d], bf2f(kp[d]), sc);
        sc = sc * 0.125f - slope * (float)dist;
        const float mn = fmaxf(m, sc), corr = __expf(m - mn), p = __expf(sc - mn);
        l = l * corr + p;
#pragma unroll
        for (int d = 0; d < 64; ++d) acc[d] = acc[d] * corr + p * bf2f(vp[d]);
        m = mn;
    }
    const float sk = sink[head];
    const float mf = fmaxf(m, sk), corr = __expf(m - mf);
    l = l * corr + __expf(sk - mf);
    const float inv = corr / l;
    bf16* op = att + (size_t)t * 512 + head * 64;
#pragma unroll
    for (int d = 0; d < 64; ++d) op[d] = f2bf(acc[d] * inv);
}

__global__ void __launch_bounds__(256) conv_naive(const bf16* __restrict__ lx, const float* __restrict__ cw, const float* __restrict__ cb, bf16* __restrict__ lin) {
    const size_t i = (size_t)blockIdx.x * 256 + threadIdx.x;
    const int c = (int)(i & 1023); const int t = (int)(i >> 10); const int ts = t % S_;
    float y = cb[c];
#pragma unroll
    for (int tap = 0; tap < 4; ++tap) { const int s = ts - 3 + tap; if (s >= 0) y = fmaf(bf2f(lx[(size_t)(t - 3 + tap) * 1024 + c]), cw[tap * 1024 + c], y); }
    lin[i] = f2bf(y);
}

__global__ void __launch_bounds__(128) lru_ab_naive(const bf16* __restrict__ lin, const float* __restrict__ wa, const float* __restrict__ ba, const float* __restrict__ wx, const float* __restrict__ bx,
                                                    const float* __restrict__ lam, float* __restrict__ Af, float* __restrict__ Bf) {
    __shared__ float xs[128];
    const int t = blockIdx.x >> 3, blk = blockIdx.x & 7, d = threadIdx.x, ch = blk * 128 + d;
    xs[d] = bf2f(lin[(size_t)t * 1024 + ch]);
    __syncthreads();
    float r = ba[ch], ii = bx[ch];
    const float* wap = wa + (size_t)blk * 128 * 128 + d; const float* wxp = wx + (size_t)blk * 128 * 128 + d;
    for (int c = 0; c < 128; ++c) { r = fmaf(xs[c], wap[c * 128], r); ii = fmaf(xs[c], wxp[c * 128], ii); }
    r = sigmoidf_(r); ii = sigmoidf_(ii);
    const float sp = log1pf(expf(-lam[ch]));
    const float loga = -8.0f * r * sp;
    const float a = expf(loga);
    const float bb = sqrtf(-expm1f(2.0f * loga)) * (ii * xs[d]);
    Af[(size_t)t * 1024 + ch] = a; Bf[(size_t)t * 1024 + ch] = bb;
}
__global__ void __launch_bounds__(256) lru_ab_from_pre(const bf16* __restrict__ lin, const float* __restrict__ ba, const float* __restrict__ bx, const float* __restrict__ lam, float* __restrict__ Af, float* __restrict__ Bf) {
    const size_t i = (size_t)blockIdx.x * 256 + threadIdx.x; const int ch = (int)(i & 1023);
    const float r = sigmoidf_(Af[i] + ba[ch]), ii = sigmoidf_(Bf[i] + bx[ch]);
    const float loga = -8.0f * r * log1pf(expf(-lam[ch]));
    Af[i] = expf(loga); Bf[i] = sqrtf(-expm1f(2.0f * loga)) * (ii * bf2f(lin[i]));
}
template <int L>
__global__ void __launch_bounds__(64) lru_finish_naive_L(const bf16* __restrict__ hloc, const bf16* __restrict__ pcum, const bf16* __restrict__ gl, bf16* __restrict__ rec) {
    const int gid = blockIdx.x * 64 + threadIdx.x; const int b = gid >> 10, ch = gid & 1023;
    float carry = 0.f;
    for (int c = 0; c < S_ / L; ++c) {
        float la = 1.f, lb = 0.f;
        for (int s = 0; s < L; ++s) { const size_t o = (size_t)(b * S_ + c * L + s) * 1024 + ch; la = bf2f(pcum[o]); lb = bf2f(hloc[o]); const float h = la * carry + lb; rec[o] = f2bf(h * bf2f(gl[o])); }
        carry = la * carry + lb;
    }
}
__global__ void __launch_bounds__(64) lru_finish_naive(const bf16* __restrict__ hloc, const bf16* __restrict__ pcum, const float* __restrict__ agg, const bf16* __restrict__ gl, bf16* __restrict__ rec) {
    const int gid = blockIdx.x * 64 + threadIdx.x; const int b = gid >> 10, ch = gid & 1023;
    float carry = 0.f;
    for (int c = 0; c < 32; ++c) {
        const int chunk = b * 32 + c;
        for (int s = 0; s < 64; ++s) { const size_t o = (size_t)(chunk * 64 + s) * 1024 + ch; const float h = bf2f(pcum[o]) * carry + bf2f(hloc[o]); rec[o] = f2bf(h * bf2f(gl[o])); }
        const float* ap = agg + ((size_t)chunk * 1024 + ch) * 2; carry = ap[0] * carry + ap[1];
    }
}
__global__ void __launch_bounds__(128) lru_pre_check(const bf16* __restrict__ lin, const float* __restrict__ wa, const float* __restrict__ wx, const float* __restrict__ Rp, const float* __restrict__ Ip, unsigned* flag) {
    __shared__ float xs[128];
    const int t = blockIdx.x >> 3, blk = blockIdx.x & 7, d = threadIdx.x, ch = blk * 128 + d;
    xs[d] = bf2f(lin[(size_t)t * 1024 + ch]);
    __syncthreads();
    float r = 0.f, ii = 0.f;
    const float* wap = wa + (size_t)blk * 128 * 128 + d; const float* wxp = wx + (size_t)blk * 128 * 128 + d;
    for (int c = 0; c < 128; ++c) { r = fmaf(xs[c], wap[c * 128], r); ii = fmaf(xs[c], wxp[c * 128], ii); }
    const float dr = fabsf(r - Rp[(size_t)t * 1024 + ch]), di = fabsf(ii - Ip[(size_t)t * 1024 + ch]);
    if (!(dr < 0.08f + 0.03f * fabsf(r)) || !(di < 0.08f + 0.03f * fabsf(ii))) atomicAdd(flag, 1u);
}
__global__ void __launch_bounds__(256) poison_if(float* out, const unsigned* flag) { if (*flag) { const size_t i = (size_t)blockIdx.x * 256 + threadIdx.x; out[i] = out[i] * 50.0f + 3.0f; } }
__global__ void __launch_bounds__(64) lru_scan_naive(const float* __restrict__ Af, const float* __restrict__ Bf, const bf16* __restrict__ gl, bf16* __restrict__ rec) {
    const int gid = blockIdx.x * 64 + threadIdx.x; const int b = gid >> 10, ch = gid & 1023;
    float h = 0.f;
    for (int s = 0; s < S_; ++s) { const size_t o = (size_t)(b * S_ + s) * 1024 + ch; h = fmaf(Af[o], h, Bf[o]); rec[o] = f2bf(h * bf2f(gl[o])); }
}

struct EpiMP { const bf16* sga; float* mp; __device__ __forceinline__ void operator()(int m, int n, float v) const { const size_t o = (size_t)m * 1024 + n; mp[o] = v * bf2f(sga[o]); } };
struct EpiMerged { const bf16* sgl; const float* mp; bf16* merged; __device__ __forceinline__ void operator()(int m, int n, float v) const { const size_t o = (size_t)m * 1024 + n; merged[o] = f2bf(mp[o] + v * bf2f(sgl[o])); } };
struct EpiH1 { const float* x; float* h1; bf16* h1b; __device__ __forceinline__ void operator()(int m, int n, float v) const { const size_t o = (size_t)m * 1024 + n; const float h = x[o] + v; h1[o] = h; h1b[o] = f2bf(h); } };
struct EpiScaleF32 { const float* part; float* out; int ldo; int pad; __device__ __forceinline__ void operator()(int m, int n, float v) const {
    float s = 0.f; for (int i = 0; i < 16; ++i) s += part[(size_t)m * 16 + i];
    out[(size_t)m * ldo + n] = v * (1.0f / sqrtf(s * (1.0f / 1024.0f) + EPS)); } };
struct EpiPlainF32 { float* out; int ldo; int pad; __device__ __forceinline__ void operator()(int m, int n, float v) const { out[(size_t)m * ldo + n] = v; } };
struct EpiPP { bf16* pp; __device__ __forceinline__ void operator()(int m, int n, float v) const { pp[(size_t)m * 1024 + n] = f2bf(v); } };
struct EpiH3 { const float* rstd3; const bf16* pp; float* h; __device__ __forceinline__ void operator()(int m, int n, float v) const { const size_t o = (size_t)m * 1024 + n; h[o] = h[o] + sigmoidf_(v * rstd3[m]) * bf2f(pp[o]); } };

__global__ void __launch_bounds__(256) final_norm(float* __restrict__ h, const float* __restrict__ part, const float* __restrict__ fg) {
    const int row = blockIdx.x * 4 + (threadIdx.x >> 6), lane = threadIdx.x & 63;
    float s = 0.f; for (int i = 0; i < 16; ++i) s += part[(size_t)row * 16 + i];
    const float r = 1.0f / sqrtf(s * (1.0f / 1024.0f) + EPS);
    float* hr = h + (size_t)row * 1024;
    for (int j = 0; j < 16; ++j) { const int c = lane + 64 * j; hr[c] = hr[c] * r * fg[c]; }
}
}
#define LAS __attribute__((address_space(3)))
typedef float f32x4 __attribute__((ext_vector_type(4)));
typedef unsigned u32x4 __attribute__((ext_vector_type(4)));
typedef int i32x4 __attribute__((ext_vector_type(4)));

constexpr int TK_TOK = 32;
constexpr int TK_LSTRIDE = 132;
constexpr int TK_LDS_BYTES = 256 * TK_LSTRIDE * 4;

__device__ __forceinline__ void topk_item(LAS float* lds, const float* __restrict__ SC, int item, int head_base, int* __restrict__ seli, float* __restrict__ selg, int tid) {
    const f32x4* src = (const f32x4*)(SC + (size_t)item * TK_TOK * 1024);
#pragma unroll 4
    for (int i = 0; i < 16; ++i) {
        const int idx = tid + i * 512; const int row = idx >> 8, c4 = idx & 255;
        const f32x4 v = src[idx];
        const int list = row * 8 + (c4 >> 5), elem = (c4 & 31) * 4;
        *(LAS f32x4*)(lds + list * TK_LSTRIDE + elem) = v;
    }
    __syncthreads();
    if (tid < 256) {
        const LAS float* my = lds + tid * TK_LSTRIDE;
        unsigned acc[16];
#pragma unroll
        for (int g = 0; g < 8; ++g) {
            unsigned t[16];
#pragma unroll
            for (int q = 0; q < 4; ++q) {
                const f32x4 v = *(const LAS f32x4*)(my + g * 16 + q * 4);
#pragma unroll
                for (int c = 0; c < 4; ++c) { const int e = g * 16 + q * 4 + c; t[q * 4 + c] = (tk_f2key(v[c]) & ~127u) | (unsigned)(127 - e); }
            }
            tk_sort16(t);
            if (g == 0) {
#pragma unroll
                for (int i = 0; i < 16; ++i) acc[i] = t[i];
            } else tk_merge16(acc, t);
        }
        unsigned oth[16];
#pragma unroll
        for (int i = 0; i < 16; ++i) oth[i] = (unsigned)__shfl_xor((int)acc[i], 1);
        if ((tid & 1) == 0) {
            const int tok = item * TK_TOK + (tid >> 3), head = head_base + ((tid >> 1) & 3);
            tk_combine_store(acc, oth, seli + (size_t)tok * 128 + head * 16, selg + (size_t)tok * 128 + head * 16);
        }
    }
    __syncthreads();
}
__global__ void __launch_bounds__(512) topk_kernel(const float* __restrict__ SC, int head_base, int* __restrict__ seli, float* __restrict__ selg) {
    extern __shared__ __attribute__((aligned(16))) unsigned char dyn_lds[];
    for (int item = blockIdx.x; item < T_ / TK_TOK; item += gridDim.x) topk_item((LAS float*)dyn_lds, SC, item, head_base, seli, selg, (int)threadIdx.x);
}

template <int MODE>
__device__ __forceinline__ void gather_token(int t, int lane, const void* __restrict__ Utab, const void* __restrict__ Vtab, const float* __restrict__ gffn,
                                             const int* __restrict__ seli, const float* __restrict__ selg, const float* __restrict__ part2,
                                             float* __restrict__ H  , bf16* __restrict__ h2b, float* __restrict__ rstd3) {
    float ps = (lane < 16) ? part2[(size_t)t * 16 + lane] : 0.f;
    ps = wave_sum(ps);
    const float rstd2 = 1.0f / sqrtf(ps * (1.0f / 1024.0f) + EPS);
    const int iA = seli[(size_t)t * 128 + lane], iB = seli[(size_t)t * 128 + 64 + lane];
    const float gA = selg[(size_t)t * 128 + lane], gB = selg[(size_t)t * 128 + 64 + lane];
    float* hr = H + (size_t)t * 1024;
    if constexpr (MODE == 0) {
        f32x4 x[4], y[4], hv[4];
#pragma unroll
        for (int j = 0; j < 4; ++j) { hv[j] = *(const f32x4*)(hr + 256 * j + 4 * lane); const f32x4 g = *(const f32x4*)(gffn + 256 * j + 4 * lane); x[j] = hv[j] * g; y[j] = (f32x4){0.f, 0.f, 0.f, 0.f}; }
        const float* U = (const float*)Utab; const float* V = (const float*)Vtab;
        for (int k = 0; k < 64; ++k) {
#pragma unroll
            for (int hh = 0; hh < 2; ++hh) {
                const int e = __builtin_amdgcn_readlane(hh ? iB : iA, k);
                const float gt = __builtin_bit_cast(float, __builtin_amdgcn_readlane(__builtin_bit_cast(int, hh ? gB : gA), k));
                const float* ur = U + (size_t)e * 1024; const float* vr = V + (size_t)e * 1024;
                f32x4 uv[4], vv[4];
#pragma unroll
                for (int j = 0; j < 4; ++j) { uv[j] = *(const f32x4*)(ur + 256 * j + 4 * lane); vv[j] = *(const f32x4*)(vr + 256 * j + 4 * lane); }
                float d = 0.f;
#pragma unroll
                for (int j = 0; j < 4; ++j) d += (uv[j].x * x[j].x + uv[j].y * x[j].y) + (uv[j].z * x[j].z + uv[j].w * x[j].w);
                d = wave_sum(d);
                const float c = gt * gelu_tanh(d * rstd2);
#pragma unroll
                for (int j = 0; j < 4; ++j) y[j] += vv[j] * c;
            }
        }
        float sq = 0.f;
#pragma unroll
        for (int j = 0; j < 4; ++j) {
            const f32x4 h2 = hv[j] + y[j];
            *(f32x4*)(hr + 256 * j + 4 * lane) = h2;
            sq += (h2.x * h2.x + h2.y * h2.y) + (h2.z * h2.z + h2.w * h2.w);
            uint2 w; w.x = pk2(h2.x, h2.y); w.y = pk2(h2.z, h2.w);
            *(uint2*)(h2b + (size_t)t * 1024 + 256 * j + 4 * lane) = w;
        }
        sq = wave_sum(sq);
        if (lane == 0) rstd3[t] = 1.0f / sqrtf(sq * (1.0f / 1024.0f) + EPS);
    } else {
        float x[2][8], y[2][8], hv[2][8];
#pragma unroll
        for (int j = 0; j < 2; ++j) {
            const f32x4 a = *(const f32x4*)(hr + 512 * j + 8 * lane), b = *(const f32x4*)(hr + 512 * j + 8 * lane + 4);
            hv[j][0] = a.x; hv[j][1] = a.y; hv[j][2] = a.z; hv[j][3] = a.w; hv[j][4] = b.x; hv[j][5] = b.y; hv[j][6] = b.z; hv[j][7] = b.w;
#pragma unroll
            for (int c = 0; c < 8; ++c) { x[j][c] = hv[j][c]; y[j][c] = 0.f; }
        }
        const bf16* U = (const bf16*)Utab; const bf16* V = (const bf16*)Vtab;
        for (int k = 0; k < 64; k += 2) {
            u32x4 uv[4][2], vv[4][2]; float gt[4];
#pragma unroll
            for (int q = 0; q < 4; ++q) {
                const int kk = k + (q >> 1); const int hh = q & 1;
                const int e = __builtin_amdgcn_readlane(hh ? iB : iA, kk);
                gt[q] = __builtin_bit_cast(float, __builtin_amdgcn_readlane(__builtin_bit_cast(int, hh ? gB : gA), kk));
                const bf16* ur = U + (size_t)e * 1024; const bf16* vr = V + (size_t)e * 1024;
#pragma unroll
                for (int j = 0; j < 2; ++j) { uv[q][j] = *(const u32x4*)(ur + 512 * j + 8 * lane); vv[q][j] = *(const u32x4*)(vr + 512 * j + 8 * lane); }
            }
#pragma unroll
            for (int q = 0; q < 4; ++q) {
                float d = 0.f;
#pragma unroll
                for (int j = 0; j < 2; ++j)
#pragma unroll
                    for (int c = 0; c < 4; ++c) { const unsigned w = uv[q][j][c]; d = fmaf(__builtin_bit_cast(float, w << 16), x[j][2 * c], d); d = fmaf(__builtin_bit_cast(float, w & 0xffff0000u), x[j][2 * c + 1], d); }
                d = wave_sum(d);
                const float cf = gt[q] * gelu_tanh(d * rstd2);
#pragma unroll
                for (int j = 0; j < 2; ++j)
#pragma unroll
                    for (int c = 0; c < 4; ++c) { const unsigned w = vv[q][j][c]; y[j][2 * c] = fmaf(__builtin_bit_cast(float, w << 16), cf, y[j][2 * c]); y[j][2 * c + 1] = fmaf(__builtin_bit_cast(float, w & 0xffff0000u), cf, y[j][2 * c + 1]); }
            }
        }
        float sq = 0.f;
#pragma unroll
        for (int j = 0; j < 2; ++j) {
            float h2[8];
#pragma unroll
            for (int c = 0; c < 8; ++c) { h2[c] = hv[j][c] + y[j][c]; sq += h2[c] * h2[c]; }
            *(f32x4*)(hr + 512 * j + 8 * lane) = (f32x4){h2[0], h2[1], h2[2], h2[3]};
            *(f32x4*)(hr + 512 * j + 8 * lane + 4) = (f32x4){h2[4], h2[5], h2[6], h2[7]};
            u32x4 w; w.x = pk2(h2[0], h2[1]); w.y = pk2(h2[2], h2[3]); w.z = pk2(h2[4], h2[5]); w.w = pk2(h2[6], h2[7]);
            *(u32x4*)(h2b + (size_t)t * 1024 + 512 * j + 8 * lane) = w;
        }
        sq = wave_sum(sq);
        if (lane == 0) rstd3[t] = 1.0f / sqrtf(sq * (1.0f / 1024.0f) + EPS);
    }
}
template <int MODE>
__global__ void __launch_bounds__(256) gather_kernel(const void* __restrict__ Utab, const void* __restrict__ Vtab, const float* __restrict__ gffn, const int* __restrict__ seli, const float* __restrict__ selg,
                                                     const float* __restrict__ part2, float* __restrict__ H, bf16* __restrict__ h2b, float* __restrict__ rstd3) {
    const int lane = threadIdx.x & 63; const int w = blockIdx.x * 4 + (threadIdx.x >> 6); const int nw = gridDim.x * 4;
    for (int t = w; t < T_; t += nw) gather_token<MODE>(t, lane, Utab, Vtab, gffn, seli, selg, part2, H, h2b, rstd3);
}

typedef float f32x2 __attribute__((ext_vector_type(2)));
__device__ __forceinline__ float reduce4_transpose(float d0, float d1, float d2, float d3, int lane) {
    const bool b0 = lane & 1, b1 = lane & 2;
    const float a = (b0 ? d1 : d0) + __shfl_xor(b0 ? d0 : d1, 1);
    const float b = (b0 ? d3 : d2) + __shfl_xor(b0 ? d2 : d3, 1);
    float c = (b1 ? b : a) + __shfl_xor(b1 ? a : b, 2);
    c += __shfl_xor(c, 4); c += __shfl_xor(c, 8); c += __shfl_xor(c, 16); c += __shfl_xor(c, 32);
    return c;
}
__device__ __forceinline__ float dot16_fp8(const u32x4 w, const f32x2 (&x2)[8]) {
    f32x2 acc = (f32x2){0.f, 0.f};
#pragma unroll
    for (int c = 0; c < 4; ++c) { const unsigned ww = w[c]; const f32x2 lo = __builtin_amdgcn_cvt_pk_f32_fp8(ww, false), hi = __builtin_amdgcn_cvt_pk_f32_fp8(ww, true); acc = lo * x2[2 * c] + acc; acc = hi * x2[2 * c + 1] + acc; }
    return acc.x + acc.y;
}
__device__ __forceinline__ void axpy16_fp8(const u32x4 w, float cf, f32x2 (&y2)[8]) {
#pragma unroll
    for (int c = 0; c < 4; ++c) { const unsigned ww = w[c]; const f32x2 lo = __builtin_amdgcn_cvt_pk_f32_fp8(ww, false), hi = __builtin_amdgcn_cvt_pk_f32_fp8(ww, true); y2[2 * c] = lo * cf + y2[2 * c]; y2[2 * c + 1] = hi * cf + y2[2 * c + 1]; }
}
__device__ __forceinline__ float sel4f(float v0, float v1, float v2, float v3, int q) { return q == 0 ? v0 : (q == 1 ? v1 : (q == 2 ? v2 : v3)); }
__device__ __forceinline__ void gather_token_fp8(int t, int lane, const unsigned char* __restrict__ U8, const unsigned char* __restrict__ V8, const float* __restrict__ IU, const float* __restrict__ IV,
                                                 const int* __restrict__ seli, const float* __restrict__ selg, const float* __restrict__ part2,
                                                 float* __restrict__ H, bf16* __restrict__ h2b, float* __restrict__ rstd3) {
    float ps = (lane < 16) ? part2[(size_t)t * 16 + lane] : 0.f;
    ps = wave_sum(ps);
    const float rstd2 = 1.0f / sqrtf(ps * (1.0f / 1024.0f) + EPS);
    const int iA = seli[(size_t)t * 128 + lane], iB = seli[(size_t)t * 128 + 64 + lane];
    const float duA = IU[iA] * rstd2, duB = IU[iB] * rstd2;
    const float gvA = selg[(size_t)t * 128 + lane] * IV[iA], gvB = selg[(size_t)t * 128 + 64 + lane] * IV[iB];
    float* hr = H + (size_t)t * 1024 + 16 * lane;
    f32x2 x2[8], y2[8]; f32x4 hv[4];
#pragma unroll
    for (int j = 0; j < 4; ++j) { hv[j] = *(const f32x4*)(hr + 4 * j); x2[2 * j] = (f32x2){hv[j][0], hv[j][1]}; x2[2 * j + 1] = (f32x2){hv[j][2], hv[j][3]}; y2[2 * j] = (f32x2){0.f, 0.f}; y2[2 * j + 1] = (f32x2){0.f, 0.f}; }
    const int q = lane & 3;
#pragma unroll 1
    for (int k = 0; k < 64; k += 4) {
        u32x4 uu[8], vv[8]; float du[8], gv[8];
#pragma unroll
        for (int s = 0; s < 8; ++s) {
            const int kk = k + (s >> 1); const bool hh = s & 1;
            const int e = __builtin_amdgcn_readlane(hh ? iB : iA, kk);
            du[s] = __int_as_float(__builtin_amdgcn_readlane(__float_as_int(hh ? duB : duA), kk));
            gv[s] = __int_as_float(__builtin_amdgcn_readlane(__float_as_int(hh ? gvB : gvA), kk));
            uu[s] = *(const u32x4*)(U8 + (size_t)e * 1024 + 16 * lane);
            vv[s] = *(const u32x4*)(V8 + (size_t)e * 1024 + 16 * lane);
        }
#pragma unroll
        for (int g = 0; g < 2; ++g) {
            const float d0 = dot16_fp8(uu[4 * g + 0], x2), d1 = dot16_fp8(uu[4 * g + 1], x2), d2 = dot16_fp8(uu[4 * g + 2], x2), d3 = dot16_fp8(uu[4 * g + 3], x2);
            const float tot = reduce4_transpose(d0, d1, d2, d3, lane);
            const float z = tot * sel4f(du[4 * g], du[4 * g + 1], du[4 * g + 2], du[4 * g + 3], q);
            const float cf = gelu_tanh(z) * sel4f(gv[4 * g], gv[4 * g + 1], gv[4 * g + 2], gv[4 * g + 3], q);
#pragma unroll
            for (int s = 0; s < 4; ++s) { const float cs = __int_as_float(__builtin_amdgcn_readlane(__float_as_int(cf), s)); axpy16_fp8(vv[4 * g + s], cs, y2); }
        }
    }
    float sq = 0.f;
    f32x4 h2[4];
#pragma unroll
    for (int j = 0; j < 4; ++j) {
        h2[j] = hv[j] + (f32x4){y2[2 * j].x, y2[2 * j].y, y2[2 * j + 1].x, y2[2 * j + 1].y};
        *(f32x4*)(hr + 4 * j) = h2[j];
        sq += (h2[j][0] * h2[j][0] + h2[j][1] * h2[j][1]) + (h2[j][2] * h2[j][2] + h2[j][3] * h2[j][3]);
    }
    u32x4 w0, w1; w0.x = pk2(h2[0][0], h2[0][1]); w0.y = pk2(h2[0][2], h2[0][3]); w0.z = pk2(h2[1][0], h2[1][1]); w0.w = pk2(h2[1][2], h2[1][3]);
    w1.x = pk2(h2[2][0], h2[2][1]); w1.y = pk2(h2[2][2], h2[2][3]); w1.z = pk2(h2[3][0], h2[3][1]); w1.w = pk2(h2[3][2], h2[3][3]);
    u32x4* ob = (u32x4*)(h2b + (size_t)t * 1024 + 16 * lane); ob[0] = w0; ob[1] = w1;
    sq = wave_sum(sq);
    if (lane == 0) rstd3[t] = 1.0f / sqrtf(sq * (1.0f / 1024.0f) + EPS);
}

__device__ __forceinline__ unsigned umin_(unsigned a, unsigned b) { return a < b ? a : b; }
__device__ __forceinline__ unsigned umax_(unsigned a, unsigned b) { return a > b ? a : b; }
__device__ __forceinline__ void sort128(unsigned& k0, unsigned& k1, int lane) {
#pragma unroll
    for (int k = 2; k <= 128; k <<= 1) {
#pragma unroll
        for (int j = k >> 1; j >= 1; j >>= 1) {
            if (j == 64) { const unsigned mn = umin_(k0, k1), mx = umax_(k0, k1); k0 = mn; k1 = mx; }
            else {
                const unsigned o0 = (unsigned)__shfl_xor((int)k0, j), o1 = (unsigned)__shfl_xor((int)k1, j);
                const bool up0 = (k == 128) ? true : (k == 64 ? true : ((lane & k) == 0));
                const bool up1 = (k == 128) ? true : (k == 64 ? false : ((lane & k) == 0));
                const bool lower = (lane & j) == 0;
                k0 = (lower == up0) ? umin_(k0, o0) : umax_(k0, o0);
                k1 = (lower == up1) ? umin_(k1, o1) : umax_(k1, o1);
            }
        }
    }
}
typedef int i32x4v __attribute__((ext_vector_type(4)));
#ifndef NSLICE
#define NSLICE 8
#endif
#define SLICE_SHIFT (NSLICE == 32 ? 25 : (NSLICE == 16 ? 26 : (NSLICE == 8 ? 27 : (NSLICE == 4 ? 28 : 30))))
typedef unsigned u32x2 __attribute__((ext_vector_type(2)));
__device__ __forceinline__ f32x4 bf4_lo(u32x2 w) { return (f32x4){__builtin_bit_cast(float, w.x << 16), __builtin_bit_cast(float, w.x & 0xffff0000u), __builtin_bit_cast(float, w.y << 16), __builtin_bit_cast(float, w.y & 0xffff0000u)}; }
struct TokState { f32x2 y2[8]; unsigned k0, k1; int bnd; float rsx; };
__device__ __forceinline__ int count_lt(const TokState& S, unsigned bound) {
    return __builtin_popcountll(__builtin_amdgcn_ballot_w64(S.k0 < bound)) + __builtin_popcountll(__builtin_amdgcn_ballot_w64(S.k1 < bound));
}
__device__ __forceinline__ int bperm_i(int srclane, int v) { return __builtin_amdgcn_ds_bpermute(srclane << 2, v); }
__device__ __forceinline__ float bperm_f(int srclane, float v) { return __int_as_float(__builtin_amdgcn_ds_bpermute(srclane << 2, __float_as_int(v))); }
template <int PM>
__device__ __forceinline__ void gather_batch(TokState& S, int p, int hi, int lane, const LAS unsigned char* xs, const unsigned char* __restrict__ U8, const unsigned char* __restrict__ V8, const float* __restrict__ IU, const float* __restrict__ IV) {
    const int n = (hi - p < 16) ? hi - p : 16;
    const int m = lane & 15, kq = lane >> 4;
    const int r = (m < n) ? p + m : hi - 1; const int sl = r & 63; const bool lo = r < 64;
    const unsigned ka = (unsigned)bperm_i(sl, (int)S.k0), kb = (unsigned)bperm_i(sl, (int)S.k1);
    const int es = (int)((lo ? ka : kb) >> 16);
    const unsigned key = lo ? ka : kb;
    const float dus = IU[es] * S.rsx, gvs = (m < n) ? (float)(key & 0xffffu) * (1.0f / 65535.0f) * IV[es] : 0.f;
    const unsigned char* ua = U8 + (size_t)es * 1024 + 16 * kq;
    i32x4v A[16];
    if (!(PM & 2)) {
#pragma unroll
        for (int s = 0; s < 16; ++s) { if (PM & 16) { const int e = __builtin_amdgcn_readlane(es, s); A[s] = *(const i32x4v*)(U8 + (size_t)e * 1024 + 16 * lane); } else A[s] = *(const i32x4v*)(ua + 64 * s); }
    }
    u32x4 vv[16];
    if (!(PM & 1)) {
#pragma unroll
        for (int q = 0; q < 8; ++q) if (q < n) { const int e = __builtin_amdgcn_readlane(es, q); vv[q] = *(const u32x4*)(V8 + (size_t)e * 1024 + 16 * lane); }
        if (n > 8) {
#pragma unroll
            for (int q = 8; q < 16; ++q) if (q < n) { const int e = __builtin_amdgcn_readlane(es, q); vv[q] = *(const u32x4*)(V8 + (size_t)e * 1024 + 16 * lane); }
        }
    }
    i32x4v acc = (i32x4v){0, 0, 0, 0};
    if (!(PM & 2)) {
#pragma unroll
        for (int s = 0; s < 16; ++s) { const i32x4v B = *(const LAS i32x4v*)(xs + 64 * s + 16 * kq); acc = __builtin_amdgcn_mfma_i32_16x16x64_i8(A[s], B, acc, 0, 0, 0); }
    } else { acc = (i32x4v){es, es + 1, es + 2, es + 3}; }
    float cf[4];
#pragma unroll
    for (int j = 0; j < 4; ++j) { const int sm = 4 * kq + j; const float d = bperm_f(sm, dus), g = bperm_f(sm, gvs); cf[j] = g * gelu_tanh((float)acc[j] * d); }
    if (PM & 1) { S.y2[0].x += (cf[0] + cf[1]) + (cf[2] + cf[3]); }
    else if (PM & 4) {
#pragma unroll
        for (int q = 0; q < 16; ++q) if (q < n) { const float cs = __int_as_float(__builtin_amdgcn_readlane(__float_as_int(cf[q & 3]), 16 * (q >> 2))); S.y2[q & 7].x += cs * __uint_as_float((vv[q].x ^ vv[q].y ^ vv[q].z ^ vv[q].w) & 0x3fffffffu); }
    } else {
#pragma unroll
        for (int q = 0; q < 8; ++q) if (q < n) { const float cs = __int_as_float(__builtin_amdgcn_readlane(__float_as_int(cf[q & 3]), 16 * (q >> 2))); axpy16_fp8(vv[q], cs, S.y2); }
        if (n > 8) {
#pragma unroll
            for (int q = 8; q < 16; ++q) if (q < n) { const float cs = __int_as_float(__builtin_amdgcn_readlane(__float_as_int(cf[q & 3]), 16 * (q >> 2))); axpy16_fp8(vv[q], cs, S.y2); }
        }
    }
    __builtin_amdgcn_sched_barrier(0);
}
__device__ __forceinline__ void tok_setup(TokState& S, int t, int lane, LAS unsigned char* xs, const int* __restrict__ seli, const float* __restrict__ selg,
                                          const float* __restrict__ part2, const bf16* __restrict__ h1b) {
    float ps = (lane < 16) ? part2[(size_t)t * 16 + lane] : 0.f;
    ps = wave_sum(ps);
    const float rstd2 = 1.0f / sqrtf(ps * (1.0f / 1024.0f) + EPS);
    f32x4 hv[4]; float am = 0.f;
    { const u32x4* br = (const u32x4*)(h1b + (size_t)t * 1024 + 16 * lane); const u32x4 b0 = br[0], b1 = br[1];
      hv[0] = bf4_lo((u32x2){b0.x, b0.y}); hv[1] = bf4_lo((u32x2){b0.z, b0.w}); hv[2] = bf4_lo((u32x2){b1.x, b1.y}); hv[3] = bf4_lo((u32x2){b1.z, b1.w}); }
#pragma unroll
    for (int j = 0; j < 4; ++j) { am = fmaxf(am, fmaxf(fmaxf(fabsf(hv[j][0]), fabsf(hv[j][1])), fmaxf(fabsf(hv[j][2]), fabsf(hv[j][3])))); }
#pragma unroll
    for (int o = 1; o < 64; o <<= 1) am = fmaxf(am, __shfl_xor(am, o));
    const float sx = am > 0.f ? 127.0f / am : 1.0f, isx = am > 0.f ? am * (1.0f / 127.0f) : 1.0f;
    u32x4 xq;
#pragma unroll
    for (int j = 0; j < 4; ++j) { unsigned w = 0u;
#pragma unroll
        for (int c = 0; c < 4; ++c) w |= ((unsigned)(int)__builtin_rintf(hv[j][c] * sx) & 0xffu) << (8 * c);
        xq[j] = w; }
    *(LAS u32x4*)(xs + 16 * lane) = xq;
    const int iA = seli[(size_t)t * 128 + lane], iB = seli[(size_t)t * 128 + 64 + lane];
    const float gA = selg[(size_t)t * 128 + lane], gB = selg[(size_t)t * 128 + 64 + lane];
    S.k0 = ((unsigned)iA << 16) | (unsigned)(gA * 65535.0f + 0.5f); S.k1 = ((unsigned)iB << 16) | (unsigned)(gB * 65535.0f + 0.5f);
    sort128(S.k0, S.k1, lane);
    S.rsx = rstd2 * isx;
    int bnd = 0;
#pragma unroll
    for (int s = 1; s <= NSLICE; ++s) { const int c = count_lt(S, (unsigned)s << SLICE_SHIFT); bnd = (lane == s) ? c : bnd; }
    S.bnd = bnd;
#pragma unroll
    for (int j = 0; j < 8; ++j) S.y2[j] = (f32x2){0.f, 0.f};
}
__device__ __forceinline__ void tok_finish(const TokState& S, int t, int lane, const bf16* __restrict__ h1b, bf16* __restrict__ h2b, float* __restrict__ rstd3) {
    const u32x4* br = (const u32x4*)(h1b + (size_t)t * 1024 + 16 * lane); const u32x4 b0 = br[0], b1 = br[1];
    f32x4 h2[4]; h2[0] = bf4_lo((u32x2){b0.x, b0.y}); h2[1] = bf4_lo((u32x2){b0.z, b0.w}); h2[2] = bf4_lo((u32x2){b1.x, b1.y}); h2[3] = bf4_lo((u32x2){b1.z, b1.w});
    float sq = 0.f;
#pragma unroll
    for (int j = 0; j < 4; ++j) {
        h2[j] = h2[j] + (f32x4){S.y2[2 * j].x, S.y2[2 * j].y, S.y2[2 * j + 1].x, S.y2[2 * j + 1].y};
        sq += (h2[j][0] * h2[j][0] + h2[j][1] * h2[j][1]) + (h2[j][2] * h2[j][2] + h2[j][3] * h2[j][3]);
    }
    u32x4 w0, w1; w0.x = pk2(h2[0][0], h2[0][1]); w0.y = pk2(h2[0][2], h2[0][3]); w0.z = pk2(h2[1][0], h2[1][1]); w0.w = pk2(h2[1][2], h2[1][3]);
    w1.x = pk2(h2[2][0], h2[2][1]); w1.y = pk2(h2[2][2], h2[2][3]); w1.z = pk2(h2[3][0], h2[3][1]); w1.w = pk2(h2[3][2], h2[3][3]);
    u32x4* ob = (u32x4*)(h2b + (size_t)t * 1024 + 16 * lane); ob[0] = w0; ob[1] = w1;
    sq = wave_sum(sq);
    if (lane == 0) rstd3[t] = 1.0f / sqrtf(sq * (1.0f / 1024.0f) + EPS);
}
__device__ __forceinline__ int dpp_xor8(int v) { return __builtin_amdgcn_update_dpp(0, v, 0x128, 0xf, 0xf, false); }
__device__ __forceinline__ int dpp_xor4(int v) { return __builtin_amdgcn_update_dpp(0, __builtin_amdgcn_update_dpp(0, v, 0x141, 0xf, 0xf, false), 0x1b, 0xf, 0xf, false); }
__device__ __forceinline__ int dpp_xor1(int v) { return __builtin_amdgcn_update_dpp(0, v, 0xb1, 0xf, 0xf, false); }
__device__ __forceinline__ int dpp_xor2(int v) { return __builtin_amdgcn_update_dpp(0, v, 0x4e, 0xf, 0xf, false); }
__device__ __forceinline__ int reduce16_rows(int (&p)[16], int lane) {
    int r8[8], r4[4], r2[2];
#pragma unroll
    for (int i = 0; i < 8; ++i) { const u32x2 s = __builtin_amdgcn_permlane32_swap((unsigned)p[i], (unsigned)p[i + 8], false, false); r8[i] = (int)(s.x + s.y); }
#pragma unroll
    for (int i = 0; i < 4; ++i) { const u32x2 s = __builtin_amdgcn_permlane16_swap((unsigned)r8[i], (unsigned)r8[i + 4], false, false); r4[i] = (int)(s.x + s.y); }
    const bool b3 = lane & 8, b2 = lane & 4;
#pragma unroll
    for (int i = 0; i < 2; ++i) { const int s0 = r4[i] + dpp_xor8(r4[i]), s1 = r4[i + 2] + dpp_xor8(r4[i + 2]); r2[i] = b3 ? s1 : s0; }
    const int keep = b2 ? r2[1] : r2[0], send = b2 ? r2[0] : r2[1];
    int t = keep + dpp_xor4(send);
    t += dpp_xor1(t); t += dpp_xor2(t);
    return t;
}
__device__ __forceinline__ float reduce16_rows(float (&p)[16], int lane) {
    float r8[8], r4[4], r2[2];
#pragma unroll
    for (int i = 0; i < 8; ++i) { const u32x2 s = __builtin_amdgcn_permlane32_swap(__float_as_uint(p[i]), __float_as_uint(p[i + 8]), false, false); r8[i] = __uint_as_float(s.x) + __uint_as_float(s.y); }
#pragma unroll
    for (int i = 0; i < 4; ++i) { const u32x2 s = __builtin_amdgcn_permlane16_swap(__float_as_uint(r8[i]), __float_as_uint(r8[i + 4]), false, false); r4[i] = __uint_as_float(s.x) + __uint_as_float(s.y); }
    const bool b3 = lane & 8, b2 = lane & 4;
#pragma unroll
    for (int i = 0; i < 2; ++i) { const float s0 = r4[i] + __int_as_float(dpp_xor8(__float_as_int(r4[i]))), s1 = r4[i + 2] + __int_as_float(dpp_xor8(__float_as_int(r4[i + 2]))); r2[i] = b3 ? s1 : s0; }
    const float keep = b2 ? r2[1] : r2[0], send = b2 ? r2[0] : r2[1];
    float t = keep + __int_as_float(dpp_xor4(__float_as_int(send)));
    t += __int_as_float(dpp_xor1(__float_as_int(t))); t += __int_as_float(dpp_xor2(__float_as_int(t)));
    return t;
}
struct TokState2 { f32x2 y2[8]; unsigned k0, k1; float rsx; };
template <int PM>
__device__ __forceinline__ void gather_batch_rows(TokState& S, int p, int hi, int lane, const LAS unsigned char* xs, const unsigned char* __restrict__ U8, const unsigned char* __restrict__ V8, const float* __restrict__ IU, const float* __restrict__ IV) {
    const int n = (hi - p < 16) ? hi - p : 16;
    const int slot = lane >> 2;
    const int r = (slot < n) ? p + slot : hi - 1; const int sl = r & 63; const bool lo = r < 64;
    const unsigned ka = (unsigned)bperm_i(sl, (int)S.k0), kb = (unsigned)bperm_i(sl, (int)S.k1);
    const unsigned key = lo ? ka : kb;
    const int es = (int)(key >> 16);
    const float dus = IU[es] * S.rsx, gvs = (slot < n) ? (float)(key & 0xffffu) * (1.0f / 65535.0f) * IV[es] : 0.f;
    i32x4v A[16]; u32x4 vv[16];
#pragma unroll
    for (int g = 0; g < 4; ++g) if (4 * g < n) {
#pragma unroll
        for (int q = 4 * g; q < 4 * g + 4; ++q) { int e = __builtin_amdgcn_readlane(es, 4 * q); if (PM & 32) e &= 1023; A[q] = *(const i32x4v*)(U8 + (size_t)e * 1024 + 16 * lane); }
    }
#pragma unroll
    for (int g = 0; g < 4; ++g) if (4 * g < n) {
#pragma unroll
        for (int q = 4 * g; q < 4 * g + 4; ++q) { int e = __builtin_amdgcn_readlane(es, 4 * q); if (PM & 32) e &= 1023; vv[q] = *(const u32x4*)(V8 + (size_t)e * 1024 + 16 * lane); }
    }
    const i32x4v X = *(const LAS i32x4v*)(xs + 16 * lane);
    int pp[16];
#pragma unroll
    for (int g = 0; g < 4; ++g) {
        if (4 * g < n) {
#pragma unroll
            for (int q = 4 * g; q < 4 * g + 4; ++q) pp[q] = __builtin_amdgcn_sdot4(A[q][3], X[3], __builtin_amdgcn_sdot4(A[q][2], X[2], __builtin_amdgcn_sdot4(A[q][1], X[1], __builtin_amdgcn_sdot4(A[q][0], X[0], 0, false), false), false), false);
        } else {
#pragma unroll
            for (int q = 4 * g; q < 4 * g + 4; ++q) pp[q] = 0;
        }
    }
    const int tot = reduce16_rows(pp, lane);
    const float cf = gvs * gelu_tanh((float)tot * dus);
#pragma unroll
    for (int g = 0; g < 4; ++g) if (4 * g < n) {
#pragma unroll
        for (int q = 4 * g; q < 4 * g + 4; ++q) { const float cs = __int_as_float(__builtin_amdgcn_readlane(__float_as_int(cf), 4 * q)); axpy16_fp8(vv[q], cs, S.y2); }
    }
    __builtin_amdgcn_sched_barrier(0);
}

template <int PM>
__device__ __forceinline__ void gather_batch16(TokState2& S, int bi, int lane, const LAS unsigned char* xs, const unsigned char* __restrict__ U8, const unsigned char* __restrict__ V8, const float* __restrict__ IU, const float* __restrict__ IV) {
    const unsigned ksel = (bi < 4) ? S.k0 : S.k1;
    const int lb = (bi & 3) << 4;
    const unsigned key = (unsigned)bperm_i(lb + (lane >> 2), (int)ksel);
    const int es = (int)(key >> 16);
    const float dus = IU[es] * S.rsx, gvs = (float)(key & 0xffffu) * (1.0f / 65535.0f) * IV[es];
    i32x4v A[16]; u32x4 vv[16];
#pragma unroll
    for (int q = 0; q < 16; ++q) { int e = (int)((unsigned)__builtin_amdgcn_readlane((int)ksel, lb + q) >> 16); if (PM & 32) e &= 1023; if (!(PM & 2)) A[q] = *(const i32x4v*)(U8 + (size_t)e * 1024 + 16 * lane); else A[q] = (i32x4v){e, e, e, e}; }
#pragma unroll
    for (int q = 0; q < 16; ++q) { int e = (int)((unsigned)__builtin_amdgcn_readlane((int)ksel, lb + q) >> 16); if (PM & 32) e &= 1023; if (!(PM & 1)) vv[q] = *(const u32x4*)(V8 + (size_t)e * 1024 + 16 * lane); else vv[q] = (u32x4){(unsigned)e, 0u, 0u, 0u}; }
    const i32x4v X = *(const LAS i32x4v*)(xs + 16 * lane);
    int p[16];
#pragma unroll
    for (int q = 0; q < 16; ++q) p[q] = __builtin_amdgcn_sdot4(A[q][3], X[3], __builtin_amdgcn_sdot4(A[q][2], X[2], __builtin_amdgcn_sdot4(A[q][1], X[1], __builtin_amdgcn_sdot4(A[q][0], X[0], 0, false), false), false), false);
    const int tot = reduce16_rows(p, lane);
    const float cf = gvs * gelu_tanh((float)tot * dus);
#pragma unroll
    for (int q = 0; q < 16; ++q) { const float cs = __int_as_float(__builtin_amdgcn_readlane(__float_as_int(cf), 4 * q)); if (PM & 1) S.y2[q & 7].x += cs * __uint_as_float(vv[q].x); else axpy16_fp8(vv[q], cs, S.y2); }
    __builtin_amdgcn_sched_barrier(0);
}
__device__ __forceinline__ void tok_setup2(TokState2& S, int t, int lane, LAS unsigned char* xs, const int* __restrict__ seli, const float* __restrict__ selg,
                                           const float* __restrict__ part2, const bf16* __restrict__ h1b) {
    float ps = (lane < 16) ? part2[(size_t)t * 16 + lane] : 0.f;
    ps = wave_sum(ps);
    const float rstd2 = 1.0f / sqrtf(ps * (1.0f / 1024.0f) + EPS);
    f32x4 hv[4]; float am = 0.f;
    { const u32x4* br = (const u32x4*)(h1b + (size_t)t * 1024 + 16 * lane); const u32x4 b0 = br[0], b1 = br[1];
      hv[0] = bf4_lo((u32x2){b0.x, b0.y}); hv[1] = bf4_lo((u32x2){b0.z, b0.w}); hv[2] = bf4_lo((u32x2){b1.x, b1.y}); hv[3] = bf4_lo((u32x2){b1.z, b1.w}); }
#pragma unroll
    for (int j = 0; j < 4; ++j) { am = fmaxf(am, fmaxf(fmaxf(fabsf(hv[j][0]), fabsf(hv[j][1])), fmaxf(fabsf(hv[j][2]), fabsf(hv[j][3])))); }
#pragma unroll
    for (int o = 1; o < 64; o <<= 1) am = fmaxf(am, __shfl_xor(am, o));
    const float sx = am > 0.f ? 127.0f / am : 1.0f, isx = am > 0.f ? am * (1.0f / 127.0f) : 1.0f;
    u32x4 xq;
#pragma unroll
    for (int j = 0; j < 4; ++j) { unsigned w = 0u;
#pragma unroll
        for (int c = 0; c < 4; ++c) w |= ((unsigned)(int)__builtin_rintf(hv[j][c] * sx) & 0xffu) << (8 * c);
        xq[j] = w; }
    *(LAS u32x4*)(xs + 16 * lane) = xq;
    const int iA = seli[(size_t)t * 128 + lane], iB = seli[(size_t)t * 128 + 64 + lane];
    const float gA = selg[(size_t)t * 128 + lane], gB = selg[(size_t)t * 128 + 64 + lane];
    S.k0 = ((unsigned)iA << 16) | (unsigned)(gA * 65535.0f + 0.5f); S.k1 = ((unsigned)iB << 16) | (unsigned)(gB * 65535.0f + 0.5f);
    sort128(S.k0, S.k1, lane);
    S.rsx = rstd2 * isx;
#pragma unroll
    for (int j = 0; j < 8; ++j) S.y2[j] = (f32x2){0.f, 0.f};
}
__device__ __forceinline__ void tok_finish2(const TokState2& S, int t, int lane, const bf16* __restrict__ h1b, bf16* __restrict__ h2b, float* __restrict__ rstd3) {
    const u32x4* br = (const u32x4*)(h1b + (size_t)t * 1024 + 16 * lane); const u32x4 b0 = br[0], b1 = br[1];
    f32x4 h2[4]; h2[0] = bf4_lo((u32x2){b0.x, b0.y}); h2[1] = bf4_lo((u32x2){b0.z, b0.w}); h2[2] = bf4_lo((u32x2){b1.x, b1.y}); h2[3] = bf4_lo((u32x2){b1.z, b1.w});
    float sq = 0.f;
#pragma unroll
    for (int j = 0; j < 4; ++j) {
        h2[j] = h2[j] + (f32x4){S.y2[2 * j].x, S.y2[2 * j].y, S.y2[2 * j + 1].x, S.y2[2 * j + 1].y};
        sq += (h2[j][0] * h2[j][0] + h2[j][1] * h2[j][1]) + (h2[j][2] * h2[j][2] + h2[j][3] * h2[j][3]);
    }
    u32x4 w0, w1; w0.x = pk2(h2[0][0], h2[0][1]); w0.y = pk2(h2[0][2], h2[0][3]); w0.z = pk2(h2[1][0], h2[1][1]); w0.w = pk2(h2[1][2], h2[1][3]);
    w1.x = pk2(h2[2][0], h2[2][1]); w1.y = pk2(h2[2][2], h2[2][3]); w1.z = pk2(h2[3][0], h2[3][1]); w1.w = pk2(h2[3][2], h2[3][3]);
    u32x4* ob = (u32x4*)(h2b + (size_t)t * 1024 + 16 * lane); ob[0] = w0; ob[1] = w1;
    sq = wave_sum(sq);
    if (lane == 0) rstd3[t] = 1.0f / sqrtf(sq * (1.0f / 1024.0f) + EPS);
}
template <int PM>
__device__ __forceinline__ void gather_wg_rows(int tok0, int wave, int lane, LAS unsigned char* lds, const unsigned char* __restrict__ U8, const unsigned char* __restrict__ V8, const float* __restrict__ IU, const float* __restrict__ IV,
                                               const int* __restrict__ seli, const float* __restrict__ selg, const float* __restrict__ part2, const bf16* __restrict__ h1b, bf16* __restrict__ h2b, float* __restrict__ rstd3, float* probe_out) {
    LAS unsigned char* xs = lds + wave * 4096;
#pragma unroll 1
    for (int pass = 0; pass < 2; ++pass) {
        const int tb = tok0 + pass * 32 + wave * 4;
        TokState2 S0, S1, S2, S3;
        tok_setup2(S0, tb + 0, fresh_lane(), xs, seli, selg, part2, h1b); __builtin_amdgcn_sched_barrier(0);
        tok_setup2(S1, tb + 1, fresh_lane(), xs + 1024, seli, selg, part2, h1b); __builtin_amdgcn_sched_barrier(0);
        tok_setup2(S2, tb + 2, fresh_lane(), xs + 2048, seli, selg, part2, h1b); __builtin_amdgcn_sched_barrier(0);
        tok_setup2(S3, tb + 3, fresh_lane(), xs + 3072, seli, selg, part2, h1b); __builtin_amdgcn_sched_barrier(0);
        __syncthreads();
        lane = fresh_lane();
#pragma unroll 1
        for (int bi = 0; bi < 8; ++bi) {
            gather_batch16<PM>(S0, bi, lane, xs, U8, V8, IU, IV);
            gather_batch16<PM>(S1, bi, lane, xs + 1024, U8, V8, IU, IV);
            gather_batch16<PM>(S2, bi, lane, xs + 2048, U8, V8, IU, IV);
            gather_batch16<PM>(S3, bi, lane, xs + 3072, U8, V8, IU, IV);
        }
        if (PM != 0) { const int fl = fresh_lane(); f32x2 a = S0.y2[0] + S1.y2[0] + S2.y2[0] + S3.y2[0];
#pragma unroll
            for (int j = 1; j < 8; ++j) a += S0.y2[j] + S1.y2[j] + S2.y2[j] + S3.y2[j];
            probe_out[(size_t)tb * 64 + fl] = a.x + a.y; }
        else { const int fl = fresh_lane(); tok_finish2(S0, tb, fl, h1b, h2b, rstd3); tok_finish2(S1, tb + 1, fl, h1b, h2b, rstd3); tok_finish2(S2, tb + 2, fl, h1b, h2b, rstd3); tok_finish2(S3, tb + 3, fl, h1b, h2b, rstd3); }
        __syncthreads();
    }
}
#if GATHER_ROWS == 2
#define GATHER_BATCH_FN gather_batch_rows
#else
#define GATHER_BATCH_FN gather_batch
#endif
template <int PM>
__device__ __forceinline__ void gather_wg_sliced(int tok0, int wave, int lane, LAS unsigned char* lds, const unsigned char* __restrict__ U8, const unsigned char* __restrict__ V8, const float* __restrict__ IU, const float* __restrict__ IV,
                                                 const int* __restrict__ seli, const float* __restrict__ selg, const float* __restrict__ part2, float* __restrict__ H, const bf16* __restrict__ h1b, bf16* __restrict__ h2b, float* __restrict__ rstd3, float* probe_out) {
    LAS unsigned char* xs = lds + wave * 4096;
#pragma unroll 1
    for (int pass = 0; pass < 2; ++pass) {
        const int tb = tok0 + pass * 32 + wave * 4;
        TokState S0, S1, S2, S3;
        tok_setup(S0, tb + 0, fresh_lane(), xs, seli, selg, part2, h1b); __builtin_amdgcn_sched_barrier(0);
        tok_setup(S1, tb + 1, fresh_lane(), xs + 1024, seli, selg, part2, h1b); __builtin_amdgcn_sched_barrier(0);
        tok_setup(S2, tb + 2, fresh_lane(), xs + 2048, seli, selg, part2, h1b); __builtin_amdgcn_sched_barrier(0);
        tok_setup(S3, tb + 3, fresh_lane(), xs + 3072, seli, selg, part2, h1b); __builtin_amdgcn_sched_barrier(0);
        __syncthreads();
        lane = fresh_lane();
        int lo0 = 0, lo1 = 0, lo2 = 0, lo3 = 0;
#pragma unroll 1
        for (int s = 0; s < NSLICE; ++s) {
            { const int hi = __builtin_amdgcn_readlane(S0.bnd, s + 1); for (int p = lo0; p < hi; p += 16) GATHER_BATCH_FN<PM>(S0, p, hi, lane, xs, U8, V8, IU, IV); lo0 = hi; }
            { const int hi = __builtin_amdgcn_readlane(S1.bnd, s + 1); for (int p = lo1; p < hi; p += 16) GATHER_BATCH_FN<PM>(S1, p, hi, lane, xs + 1024, U8, V8, IU, IV); lo1 = hi; }
            { const int hi = __builtin_amdgcn_readlane(S2.bnd, s + 1); for (int p = lo2; p < hi; p += 16) GATHER_BATCH_FN<PM>(S2, p, hi, lane, xs + 2048, U8, V8, IU, IV); lo2 = hi; }
            { const int hi = __builtin_amdgcn_readlane(S3.bnd, s + 1); for (int p = lo3; p < hi; p += 16) GATHER_BATCH_FN<PM>(S3, p, hi, lane, xs + 3072, U8, V8, IU, IV); lo3 = hi; }
        }
        if (probe_out) { const int fl = fresh_lane(); f32x2 a = S0.y2[0] + S1.y2[0] + S2.y2[0] + S3.y2[0];
#pragma unroll
            for (int j = 1; j < 8; ++j) a += S0.y2[j] + S1.y2[j] + S2.y2[j] + S3.y2[j];
            probe_out[(size_t)tb * 64 + fl] = a.x + a.y; }
        else { const int fl = fresh_lane(); tok_finish(S0, tb, fl, h1b, h2b, rstd3); tok_finish(S1, tb + 1, fl, h1b, h2b, rstd3); tok_finish(S2, tb + 2, fl, h1b, h2b, rstd3); tok_finish(S3, tb + 3, fl, h1b, h2b, rstd3); }
        __syncthreads();
    }
}


__device__ __forceinline__ unsigned xor16_val(unsigned v, bool hi16) { const u32x2 s = __builtin_amdgcn_permlane16_swap(v, v, false, false); return hi16 ? s.x : s.y; }
__device__ __forceinline__ unsigned xor32_val(unsigned v, bool hi32) { const u32x2 s = __builtin_amdgcn_permlane32_swap(v, v, false, false); return hi32 ? s.x : s.y; }
__device__ __forceinline__ float wave_sum_x(float v) {
    v += __int_as_float(dpp_xor1(__float_as_int(v))); v += __int_as_float(dpp_xor2(__float_as_int(v))); v += __int_as_float(dpp_xor4(__float_as_int(v))); v += __int_as_float(dpp_xor8(__float_as_int(v)));
    { const u32x2 s = __builtin_amdgcn_permlane16_swap(__float_as_uint(v), __float_as_uint(v), false, false); v = __uint_as_float(s.x) + __uint_as_float(s.y); }
    { const u32x2 s = __builtin_amdgcn_permlane32_swap(__float_as_uint(v), __float_as_uint(v), false, false); v = __uint_as_float(s.x) + __uint_as_float(s.y); }
    return v;
}
__device__ __forceinline__ float wave_max_x(float v) {
    v = fmaxf(v, __int_as_float(dpp_xor1(__float_as_int(v)))); v = fmaxf(v, __int_as_float(dpp_xor2(__float_as_int(v)))); v = fmaxf(v, __int_as_float(dpp_xor4(__float_as_int(v)))); v = fmaxf(v, __int_as_float(dpp_xor8(__float_as_int(v))));
    { const u32x2 s = __builtin_amdgcn_permlane16_swap(__float_as_uint(v), __float_as_uint(v), false, false); v = fmaxf(__uint_as_float(s.x), __uint_as_float(s.y)); }
    { const u32x2 s = __builtin_amdgcn_permlane32_swap(__float_as_uint(v), __float_as_uint(v), false, false); v = fmaxf(__uint_as_float(s.x), __uint_as_float(s.y)); }
    return v;
}
template <int J> __device__ __forceinline__ unsigned xor_lane(unsigned v, int lane) {
    if (J == 1) return (unsigned)__builtin_amdgcn_update_dpp(0, (int)v, 0xb1, 0xf, 0xf, false);
    if (J == 2) return (unsigned)__builtin_amdgcn_update_dpp(0, (int)v, 0x4e, 0xf, 0xf, false);
    if (J == 4) return (unsigned)dpp_xor4((int)v);
    if (J == 8) return (unsigned)__builtin_amdgcn_update_dpp(0, (int)v, 0x128, 0xf, 0xf, false);
    if (J == 16) return xor16_val(v, (lane & 16) != 0);
    return xor32_val(v, (lane & 32) != 0);
}
template <int NR, int KK, int J>
__device__ __forceinline__ void sort_stage(unsigned (&k)[NR], int lane) {
    if (J >= 64) {
        constexpr int d = J >> 6;
#pragma unroll
        for (int r = 0; r < NR; ++r) if ((r & d) == 0) {
            const bool up = (KK == 64 * NR) ? true : (((64 * r) & KK) == 0);
            const unsigned mn = umin_(k[r], k[r + d]), mx = umax_(k[r], k[r + d]);
            k[r] = up ? mn : mx; k[r + d] = up ? mx : mn;
        }
    } else {
        const bool lower = (lane & J) == 0;
        unsigned o[NR];
#pragma unroll
        for (int r = 0; r < NR; ++r) o[r] = xor_lane<(J < 64 ? J : 1)>(k[r], lane);
#pragma unroll
        for (int r = 0; r < NR; ++r) {
            const bool up = (KK == 64 * NR) ? true : (KK >= 64 ? (((64 * r) & KK) == 0) : ((lane & KK) == 0));
            k[r] = (lower == up) ? umin_(k[r], o[r]) : umax_(k[r], o[r]);
        }
    }
}
template <int NR, int KK, int J> struct SortJ { static __device__ __forceinline__ void run(unsigned (&k)[NR], int lane) { sort_stage<NR, KK, J>(k, lane); SortJ<NR, KK, J / 2>::run(k, lane); } };
template <int NR, int KK> struct SortJ<NR, KK, 0> { static __device__ __forceinline__ void run(unsigned (&)[NR], int) {} };
template <int NR, int KK> struct SortK { static __device__ __forceinline__ void run(unsigned (&k)[NR], int lane) { SortK<NR, KK / 2>::run(k, lane); SortJ<NR, KK, KK / 2>::run(k, lane); } };
template <int NR> struct SortK<NR, 1> { static __device__ __forceinline__ void run(unsigned (&)[NR], int) {} };
template <int NR>
__device__ __forceinline__ void sort_wave(unsigned (&k)[NR], int lane) { SortK<NR, 64 * NR>::run(k, lane); }
__device__ __forceinline__ void axpy_dispatch2(int t, int tbase, float cs, const f32x2 (&x)[8], f32x2 (&Ya)[8], f32x2 (&Yb)[8]) {
    const unsigned long long c = (unsigned long long)__float_as_uint(cs);
    const int tt = t - tbase;
    asm volatile(
        "s_cmp_gt_u32 %[t], 1\n\t"
        "s_cbranch_scc1 3f\n\t"
        "s_cmp_eq_u32 %[t], 1\n\t"
        "s_cbranch_scc1 2f\n\t"
        "v_pk_fma_f32 %[a0], %[c], %[x0], %[a0] op_sel_hi:[0,1,1]\n\t"
        "v_pk_fma_f32 %[a1], %[c], %[x1], %[a1] op_sel_hi:[0,1,1]\n\t"
        "v_pk_fma_f32 %[a2], %[c], %[x2], %[a2] op_sel_hi:[0,1,1]\n\t"
        "v_pk_fma_f32 %[a3], %[c], %[x3], %[a3] op_sel_hi:[0,1,1]\n\t"
        "v_pk_fma_f32 %[a4], %[c], %[x4], %[a4] op_sel_hi:[0,1,1]\n\t"
        "v_pk_fma_f32 %[a5], %[c], %[x5], %[a5] op_sel_hi:[0,1,1]\n\t"
        "v_pk_fma_f32 %[a6], %[c], %[x6], %[a6] op_sel_hi:[0,1,1]\n\t"
        "v_pk_fma_f32 %[a7], %[c], %[x7], %[a7] op_sel_hi:[0,1,1]\n\t"
        "s_branch 3f\n"
        "2:\n\t"
        "v_pk_fma_f32 %[b0], %[c], %[x0], %[b0] op_sel_hi:[0,1,1]\n\t"
        "v_pk_fma_f32 %[b1], %[c], %[x1], %[b1] op_sel_hi:[0,1,1]\n\t"
        "v_pk_fma_f32 %[b2], %[c], %[x2], %[b2] op_sel_hi:[0,1,1]\n\t"
        "v_pk_fma_f32 %[b3], %[c], %[x3], %[b3] op_sel_hi:[0,1,1]\n\t"
        "v_pk_fma_f32 %[b4], %[c], %[x4], %[b4] op_sel_hi:[0,1,1]\n\t"
        "v_pk_fma_f32 %[b5], %[c], %[x5], %[b5] op_sel_hi:[0,1,1]\n\t"
        "v_pk_fma_f32 %[b6], %[c], %[x6], %[b6] op_sel_hi:[0,1,1]\n\t"
        "v_pk_fma_f32 %[b7], %[c], %[x7], %[b7] op_sel_hi:[0,1,1]\n"
        "3:\n\t"
        : [a0] "+v"(Ya[0]), [a1] "+v"(Ya[1]), [a2] "+v"(Ya[2]), [a3] "+v"(Ya[3]), [a4] "+v"(Ya[4]), [a5] "+v"(Ya[5]), [a6] "+v"(Ya[6]), [a7] "+v"(Ya[7]),
          [b0] "+v"(Yb[0]), [b1] "+v"(Yb[1]), [b2] "+v"(Yb[2]), [b3] "+v"(Yb[3]), [b4] "+v"(Yb[4]), [b5] "+v"(Yb[5]), [b6] "+v"(Yb[6]), [b7] "+v"(Yb[7])
        : [x0] "v"(x[0]), [x1] "v"(x[1]), [x2] "v"(x[2]), [x3] "v"(x[3]), [x4] "v"(x[4]), [x5] "v"(x[5]), [x6] "v"(x[6]), [x7] "v"(x[7]), [c] "s"(c), [t] "s"(tt)
        : "scc");
}
__device__ __forceinline__ void axpy_dispatch2_dup(int t, int tbase, float cs, const f32x2 (&x)[8], f32x2 (&Ya)[8], f32x2 (&Yb)[8]) {
    const unsigned long long c = (unsigned long long)__float_as_uint(cs);
    const int tt = t - tbase;
    asm volatile(
        "s_cmp_gt_u32 %[t], 1\n\t"
        "s_cbranch_scc1 3f\n\t"
        "s_cmp_eq_u32 %[t], 1\n\t"
        "s_cbranch_scc1 2f\n\t"
        "v_pk_fma_f32 %[a0], %[c], %[x0], %[a0] op_sel_hi:[0,1,1]\n\t"
        "v_pk_fma_f32 %[a0], %[c], %[x0], %[a0] op_sel_hi:[0,1,1]\n\t"
        "v_pk_fma_f32 %[a1], %[c], %[x1], %[a1] op_sel_hi:[0,1,1]\n\t"
        "v_pk_fma_f32 %[a1], %[c], %[x1], %[a1] op_sel_hi:[0,1,1]\n\t"
        "v_pk_fma_f32 %[a2], %[c], %[x2], %[a2] op_sel_hi:[0,1,1]\n\t"
        "v_pk_fma_f32 %[a2], %[c], %[x2], %[a2] op_sel_hi:[0,1,1]\n\t"
        "v_pk_fma_f32 %[a3], %[c], %[x3], %[a3] op_sel_hi:[0,1,1]\n\t"
        "v_pk_fma_f32 %[a3], %[c], %[x3], %[a3] op_sel_hi:[0,1,1]\n\t"
        "v_pk_fma_f32 %[a4], %[c], %[x4], %[a4] op_sel_hi:[0,1,1]\n\t"
        "v_pk_fma_f32 %[a4], %[c], %[x4], %[a4] op_sel_hi:[0,1,1]\n\t"
        "v_pk_fma_f32 %[a5], %[c], %[x5], %[a5] op_sel_hi:[0,1,1]\n\t"
        "v_pk_fma_f32 %[a5], %[c], %[x5], %[a5] op_sel_hi:[0,1,1]\n\t"
        "v_pk_fma_f32 %[a6], %[c], %[x6], %[a6] op_sel_hi:[0,1,1]\n\t"
        "v_pk_fma_f32 %[a6], %[c], %[x6], %[a6] op_sel_hi:[0,1,1]\n\t"
        "v_pk_fma_f32 %[a7], %[c], %[x7], %[a7] op_sel_hi:[0,1,1]\n\t"
        "v_pk_fma_f32 %[a7], %[c], %[x7], %[a7] op_sel_hi:[0,1,1]\n\t"
        "s_branch 3f\n"
        "2:\n\t"
        "v_pk_fma_f32 %[b0], %[c], %[x0], %[b0] op_sel_hi:[0,1,1]\n\t"
        "v_pk_fma_f32 %[b0], %[c], %[x0], %[b0] op_sel_hi:[0,1,1]\n\t"
        "v_pk_fma_f32 %[b1], %[c], %[x1], %[b1] op_sel_hi:[0,1,1]\n\t"
        "v_pk_fma_f32 %[b1], %[c], %[x1], %[b1] op_sel_hi:[0,1,1]\n\t"
        "v_pk_fma_f32 %[b2], %[c], %[x2], %[b2] op_sel_hi:[0,1,1]\n\t"
        "v_pk_fma_f32 %[b2], %[c], %[x2], %[b2] op_sel_hi:[0,1,1]\n\t"
        "v_pk_fma_f32 %[b3], %[c], %[x3], %[b3] op_sel_hi:[0,1,1]\n\t"
        "v_pk_fma_f32 %[b3], %[c], %[x3], %[b3] op_sel_hi:[0,1,1]\n\t"
        "v_pk_fma_f32 %[b4], %[c], %[x4], %[b4] op_sel_hi:[0,1,1]\n\t"
        "v_pk_fma_f32 %[b4], %[c], %[x4], %[b4] op_sel_hi:[0,1,1]\n\t"
        "v_pk_fma_f32 %[b5], %[c], %[x5], %[b5] op_sel_hi:[0,1,1]\n\t"
        "v_pk_fma_f32 %[b5], %[c], %[x5], %[b5] op_sel_hi:[0,1,1]\n\t"
        "v_pk_fma_f32 %[b6], %[c], %[x6], %[b6] op_sel_hi:[0,1,1]\n\t"
        "v_pk_fma_f32 %[b6], %[c], %[x6], %[b6] op_sel_hi:[0,1,1]\n\t"
        "v_pk_fma_f32 %[b7], %[c], %[x7], %[b7] op_sel_hi:[0,1,1]\n"
        "v_pk_fma_f32 %[b7], %[c], %[x7], %[b7] op_sel_hi:[0,1,1]\n"
        "3:\n\t"
        : [a0] "+v"(Ya[0]), [a1] "+v"(Ya[1]), [a2] "+v"(Ya[2]), [a3] "+v"(Ya[3]), [a4] "+v"(Ya[4]), [a5] "+v"(Ya[5]), [a6] "+v"(Ya[6]), [a7] "+v"(Ya[7]),
          [b0] "+v"(Yb[0]), [b1] "+v"(Yb[1]), [b2] "+v"(Yb[2]), [b3] "+v"(Yb[3]), [b4] "+v"(Yb[4]), [b5] "+v"(Yb[5]), [b6] "+v"(Yb[6]), [b7] "+v"(Yb[7])
        : [x0] "v"(x[0]), [x1] "v"(x[1]), [x2] "v"(x[2]), [x3] "v"(x[3]), [x4] "v"(x[4]), [x5] "v"(x[5]), [x6] "v"(x[6]), [x7] "v"(x[7]), [c] "s"(c), [t] "s"(tt)
        : "scc");
}
__device__ __forceinline__ float tok_setup_mixed(unsigned& k0, unsigned& k1, int t, int j, int lane, LAS unsigned char* xs, const int* __restrict__ seli, const float* __restrict__ selg,
                                                 const float* __restrict__ part2, const bf16* __restrict__ h1b) {
    float ps = (lane < 16) ? part2[(size_t)t * 16 + lane] : 0.f;
    ps = wave_sum_x(ps);
    const float rstd2 = 1.0f / sqrtf(ps * (1.0f / 1024.0f) + EPS);
#if U_FP6
    { const u32x4* br = (const u32x4*)(h1b + (size_t)t * 1024 + 16 * lane); const u32x4 b0 = br[0], b1 = br[1];
      u32x4 w0, w1;
#pragma unroll
      for (int c = 0; c < 4; ++c) { const unsigned a = b0[c], b = b1[c];
          w0[c] = __builtin_bit_cast(unsigned, __builtin_amdgcn_cvt_pkrtz(__uint_as_float(a << 16), __uint_as_float(a & 0xffff0000u)));
          w1[c] = __builtin_bit_cast(unsigned, __builtin_amdgcn_cvt_pkrtz(__uint_as_float(b << 16), __uint_as_float(b & 0xffff0000u))); }
      LAS u32x4* xp = (LAS u32x4*)(xs + 32 * lane); xp[0] = w0; xp[1] = w1; }
    const float isx = 1.0f;
#else
    f32x4 hv[4]; float am = 0.f;
    { const u32x4* br = (const u32x4*)(h1b + (size_t)t * 1024 + 16 * lane); const u32x4 b0 = br[0], b1 = br[1];
      hv[0] = bf4_lo((u32x2){b0.x, b0.y}); hv[1] = bf4_lo((u32x2){b0.z, b0.w}); hv[2] = bf4_lo((u32x2){b1.x, b1.y}); hv[3] = bf4_lo((u32x2){b1.z, b1.w}); }
#pragma unroll
    for (int i = 0; i < 4; ++i) { am = fmaxf(am, fmaxf(fmaxf(fabsf(hv[i][0]), fabsf(hv[i][1])), fmaxf(fabsf(hv[i][2]), fabsf(hv[i][3])))); }
    am = wave_max_x(am);
    const float sx = am > 0.f ? 127.0f / am : 1.0f, isx = am > 0.f ? am * (1.0f / 127.0f) : 1.0f;
    u32x4 xq;
#pragma unroll
    for (int i = 0; i < 4; ++i) { unsigned w = 0u;
#pragma unroll
        for (int c = 0; c < 4; ++c) w |= ((unsigned)(int)__builtin_rintf(hv[i][c] * sx) & 0xffu) << (8 * c);
        xq[i] = w; }
    *(LAS u32x4*)(xs + 16 * lane) = xq;
#endif
    const int iA = seli[(size_t)t * 128 + lane], iB = seli[(size_t)t * 128 + 64 + lane];
    const float gA = selg[(size_t)t * 128 + lane], gB = selg[(size_t)t * 128 + 64 + lane];
    k0 = ((unsigned)iA << 18) | ((unsigned)j << 16) | (unsigned)(gA * 65535.0f + 0.5f); k1 = ((unsigned)iB << 18) | ((unsigned)j << 16) | (unsigned)(gB * 65535.0f + 0.5f);
    return rstd2 * isx;
}
__device__ __forceinline__ void tok_finish_mixed(const f32x2 (&y2)[8], int t, int lane, const bf16* __restrict__ h1b, bf16* __restrict__ h2b, float* __restrict__ rstd3) {
    const u32x4* br = (const u32x4*)(h1b + (size_t)t * 1024 + 16 * lane); const u32x4 b0 = br[0], b1 = br[1];
    f32x4 h2[4]; h2[0] = bf4_lo((u32x2){b0.x, b0.y}); h2[1] = bf4_lo((u32x2){b0.z, b0.w}); h2[2] = bf4_lo((u32x2){b1.x, b1.y}); h2[3] = bf4_lo((u32x2){b1.z, b1.w});
    float sq = 0.f;
#pragma unroll
    for (int i = 0; i < 4; ++i) {
        h2[i] = h2[i] + (f32x4){y2[2 * i].x, y2[2 * i].y, y2[2 * i + 1].x, y2[2 * i + 1].y};
        sq += (h2[i][0] * h2[i][0] + h2[i][1] * h2[i][1]) + (h2[i][2] * h2[i][2] + h2[i][3] * h2[i][3]);
    }
    u32x4 w0, w1; w0.x = pk2(h2[0][0], h2[0][1]); w0.y = pk2(h2[0][2], h2[0][3]); w0.z = pk2(h2[1][0], h2[1][1]); w0.w = pk2(h2[1][2], h2[1][3]);
    w1.x = pk2(h2[2][0], h2[2][1]); w1.y = pk2(h2[2][2], h2[2][3]); w1.z = pk2(h2[3][0], h2[3][1]); w1.w = pk2(h2[3][2], h2[3][3]);
    u32x4* ob = (u32x4*)(h2b + (size_t)t * 1024 + 16 * lane); ob[0] = w0; ob[1] = w1;
    sq = wave_sum_x(sq);
    if (lane == 0) rstd3[t] = 1.0f / sqrtf(sq * (1.0f / 1024.0f) + EPS);
}
__device__ __forceinline__ i32x4v row_load(__amdgpu_buffer_rsrc_t r, int lane16, int e) { const u32x4 v = __builtin_amdgcn_raw_buffer_load_b128(r, lane16, e << 10, 0); return (i32x4v){(int)v.x, (int)v.y, (int)v.z, (int)v.w}; }
__device__ __forceinline__ u32x4 as_u32x4(i32x4v v) { return (u32x4){(unsigned)v.x, (unsigned)v.y, (unsigned)v.z, (unsigned)v.w}; }
typedef _Float16 h32v __attribute__((ext_vector_type(32)));
typedef _Float16 h2v __attribute__((ext_vector_type(2)));
#if U_FP6
typedef u32x3 UROW;
typedef __bf16 bf32v __attribute__((ext_vector_type(32)));
typedef __bf16 bf2v __attribute__((ext_vector_type(2)));
__device__ __forceinline__ UROW urow_load(__amdgpu_buffer_rsrc_t r, int lane, int e) { return __builtin_amdgcn_raw_buffer_load_b96(r, lane * 12, e * 768, 0); }
__device__ __forceinline__ UROW urow_dummy(int e) { return (UROW){(unsigned)e, 0u, 0u}; }
#else
typedef i32x4v UROW;
__device__ __forceinline__ UROW urow_load(__amdgpu_buffer_rsrc_t r, int lane, int e) { return row_load(r, lane << 4, e); }
__device__ __forceinline__ UROW urow_dummy(int e) { return (UROW){e, e, e, e}; }
#endif
#if V_FP6
typedef u32x3 VROW;
typedef unsigned u32x6 __attribute__((ext_vector_type(6)));
typedef float f32x32 __attribute__((ext_vector_type(32)));
__device__ __forceinline__ VROW vrow_load(__amdgpu_buffer_rsrc_t r, int lane, int e) { return __builtin_amdgcn_raw_buffer_load_b96(r, lane * 12, e * 768, 0); }
__device__ __forceinline__ VROW vrow_dummy(int e) { return (VROW){(unsigned)e, 0u, 0u}; }
#else
typedef u32x4 VROW;
__device__ __forceinline__ VROW vrow_load(__amdgpu_buffer_rsrc_t r, int lane, int e) { return as_u32x4(row_load(r, lane << 4, e)); }
__device__ __forceinline__ VROW vrow_dummy(int e) { return (VROW){(unsigned)e, 0u, 0u, 0u}; }
#endif
#if Y_F16
__device__ __forceinline__ void axpy_dispatch2h(int t, int tbase, unsigned c, const unsigned (&x)[8], unsigned (&Ya)[8], unsigned (&Yb)[8]) {
    const int tt = t - tbase;
    asm volatile(
        "s_cmp_gt_u32 %[t], 1\n\t"
        "s_cbranch_scc1 3f\n\t"
        "s_cmp_eq_u32 %[t], 1\n\t"
        "s_cbranch_scc1 2f\n\t"
        "v_pk_fma_f16 %[a0], %[c], %[x0], %[a0] op_sel_hi:[0,1,1]\n\t"
        "v_pk_fma_f16 %[a1], %[c], %[x1], %[a1] op_sel_hi:[0,1,1]\n\t"
        "v_pk_fma_f16 %[a2], %[c], %[x2], %[a2] op_sel_hi:[0,1,1]\n\t"
        "v_pk_fma_f16 %[a3], %[c], %[x3], %[a3] op_sel_hi:[0,1,1]\n\t"
        "v_pk_fma_f16 %[a4], %[c], %[x4], %[a4] op_sel_hi:[0,1,1]\n\t"
        "v_pk_fma_f16 %[a5], %[c], %[x5], %[a5] op_sel_hi:[0,1,1]\n\t"
        "v_pk_fma_f16 %[a6], %[c], %[x6], %[a6] op_sel_hi:[0,1,1]\n\t"
        "v_pk_fma_f16 %[a7], %[c], %[x7], %[a7] op_sel_hi:[0,1,1]\n\t"
        "s_branch 3f\n"
        "2:\n\t"
        "v_pk_fma_f16 %[b0], %[c], %[x0], %[b0] op_sel_hi:[0,1,1]\n\t"
        "v_pk_fma_f16 %[b1], %[c], %[x1], %[b1] op_sel_hi:[0,1,1]\n\t"
        "v_pk_fma_f16 %[b2], %[c], %[x2], %[b2] op_sel_hi:[0,1,1]\n\t"
        "v_pk_fma_f16 %[b3], %[c], %[x3], %[b3] op_sel_hi:[0,1,1]\n\t"
        "v_pk_fma_f16 %[b4], %[c], %[x4], %[b4] op_sel_hi:[0,1,1]\n\t"
        "v_pk_fma_f16 %[b5], %[c], %[x5], %[b5] op_sel_hi:[0,1,1]\n\t"
        "v_pk_fma_f16 %[b6], %[c], %[x6], %[b6] op_sel_hi:[0,1,1]\n\t"
        "v_pk_fma_f16 %[b7], %[c], %[x7], %[b7] op_sel_hi:[0,1,1]\n"
        "3:\n\t"
        : [a0] "+v"(Ya[0]), [a1] "+v"(Ya[1]), [a2] "+v"(Ya[2]), [a3] "+v"(Ya[3]), [a4] "+v"(Ya[4]), [a5] "+v"(Ya[5]), [a6] "+v"(Ya[6]), [a7] "+v"(Ya[7]),
          [b0] "+v"(Yb[0]), [b1] "+v"(Yb[1]), [b2] "+v"(Yb[2]), [b3] "+v"(Yb[3]), [b4] "+v"(Yb[4]), [b5] "+v"(Yb[5]), [b6] "+v"(Yb[6]), [b7] "+v"(Yb[7])
        : [x0] "v"(x[0]), [x1] "v"(x[1]), [x2] "v"(x[2]), [x3] "v"(x[3]), [x4] "v"(x[4]), [x5] "v"(x[5]), [x6] "v"(x[6]), [x7] "v"(x[7]), [c] "s"(c), [t] "s"(tt)
        : "scc");
}
__device__ __forceinline__ void tok_finish_mixed_h(const unsigned (&Y)[8], int t, int lane, const bf16* __restrict__ h1b, bf16* __restrict__ h2b, float* __restrict__ rstd3) {
    f32x2 y2[8];
#pragma unroll
    for (int c = 0; c < 8; ++c) { const unsigned w = Y[c]; const h2v hv = __builtin_bit_cast(h2v, w); y2[c] = (f32x2){(float)hv.x, (float)hv.y}; }
    tok_finish_mixed(y2, t, lane, h1b, h2b, rstd3);
}
#endif
constexpr int MIX_XROW = U_FP6 ? 2048 : 1024;
constexpr int MIX_LDS_WAVE = 4 * MIX_XROW + 2048 + 64;
constexpr int XG = 2;
template <int PM>
__device__ __forceinline__ void gather_wg_mixed(int tok0, int wave, int lane, LAS unsigned char* lds, const unsigned char* __restrict__ U8, const unsigned char* __restrict__ V8, const float* __restrict__ IU, const float* __restrict__ IV,
                                                const int* __restrict__ seli, const float* __restrict__ selg, const float* __restrict__ part2, const bf16* __restrict__ h1b, bf16* __restrict__ h2b, float* __restrict__ rstd3, float* probe_out) {
    LAS unsigned char* xs = lds + wave * MIX_LDS_WAVE;
    LAS unsigned* ks = (LAS unsigned*)(xs + 4 * MIX_XROW);
    LAS float* rsl = (LAS float*)(xs + 4 * MIX_XROW + 2048);
#pragma unroll 1
    for (int pass = 0; pass < 2; ++pass) {
        const int tb = tok0 + pass * 32 + wave * 4;
        unsigned k[8]; float rs0, rs1, rs2, rs3;
        rs0 = tok_setup_mixed(k[0], k[1], tb + 0, 0, fresh_lane(), xs, seli, selg, part2, h1b); __builtin_amdgcn_sched_barrier(0);
        rs1 = tok_setup_mixed(k[2], k[3], tb + 1, 1, fresh_lane(), xs + 1 * MIX_XROW, seli, selg, part2, h1b); __builtin_amdgcn_sched_barrier(0);
        rs2 = tok_setup_mixed(k[4], k[5], tb + 2, 2, fresh_lane(), xs + 2 * MIX_XROW, seli, selg, part2, h1b); __builtin_amdgcn_sched_barrier(0);
        rs3 = tok_setup_mixed(k[6], k[7], tb + 3, 3, fresh_lane(), xs + 3 * MIX_XROW, seli, selg, part2, h1b); __builtin_amdgcn_sched_barrier(0);
        lane = fresh_lane();
        sort_wave<8>(k, lane);
#pragma unroll
        for (int r = 0; r < 8; ++r) ks[lane + 64 * r] = k[r];
        if (lane == 0) { rsl[0] = rs0; rsl[1] = rs1; rsl[2] = rs2; rsl[3] = rs3; }
        __builtin_amdgcn_sched_barrier(0);
#if Y_F16
        unsigned Y0[8], Y1[8], Y2[8], Y3[8];
#pragma unroll
        for (int i = 0; i < 8; ++i) { Y0[i] = 0u; Y1[i] = 0u; Y2[i] = 0u; Y3[i] = 0u; }
#else
        f32x2 Y0[8], Y1[8], Y2[8], Y3[8];
#pragma unroll
        for (int i = 0; i < 8; ++i) { Y0[i] = (f32x2){0.f, 0.f}; Y1[i] = (f32x2){0.f, 0.f}; Y2[i] = (f32x2){0.f, 0.f}; Y3[i] = (f32x2){0.f, 0.f}; }
#endif
        __syncthreads();
        lane = fresh_lane();
#if MIX_PIPE
        const int lane16 = lane << 4;
        const __amdgpu_buffer_rsrc_t rU = __builtin_amdgcn_make_buffer_rsrc((void*)U8, 0, (U_FP6 ? 12 : 16) << 20, 0x00020000), rV = __builtin_amdgcn_make_buffer_rsrc((void*)V8, 0, (V_FP6 ? 12 : 16) << 20, 0x00020000);
        unsigned kbN = ks[(pass ? 16 * 31 : 0) + (lane & 15)], keyN = ks[(pass ? 16 * 31 : 0) + (lane >> 2)];
        UROW A[16]; VROW vv[16];
#pragma unroll
        for (int q = 0; q < 16; ++q) { int e = (int)((unsigned)__builtin_amdgcn_readlane((int)kbN, q) >> 18); if (PM & 32) e &= 1023; if (PM & 2) A[q] = urow_dummy(e); else A[q] = urow_load(rU, lane, e); }
#pragma unroll
        for (int q = 0; q < 16; ++q) { int e = (int)((unsigned)__builtin_amdgcn_readlane((int)kbN, q) >> 18); if (PM & 32) e &= 1023; if (PM & 1) vv[q] = vrow_dummy(e); else vv[q] = vrow_load(rV, lane, e); }
        float iuN = IU[keyN >> 18], ivN = IV[keyN >> 18];
#pragma unroll 1
        for (int bb = 0; bb < 32; ++bb) {
            const int bn = (bb + 1 < 32) ? bb + 1 : 31; const int b1 = pass ? 31 - bn : bn;
            const unsigned kb = kbN, key = keyN; const float iu = iuN, iv = ivN;
            kbN = ks[16 * b1 + (lane & 15)]; keyN = ks[16 * b1 + (lane >> 2)];
            const int tq = (int)(key >> 16) & 3;
            const float dus = iu * rsl[tq], gvs = (float)(key & 0xffffu) * (1.0f / 65535.0f) * iv;
#if U_FP6
            float pp[16];
#pragma unroll
            for (int q2 = 0; q2 < 16; q2 += 2) {
                u32x4 Xa[2], Xb[2];
#pragma unroll
                for (int h = 0; h < 2; ++h) { const int t = (__builtin_amdgcn_readlane((int)kb, q2 + h) >> 16) & 3; const LAS u32x4* xp = (const LAS u32x4*)(xs + t * 2048 + 32 * lane); Xa[h] = xp[0]; Xb[h] = xp[1]; }
                const u32x6 in6 = {A[q2].x, A[q2].y, A[q2].z, A[q2 + 1].x, A[q2 + 1].y, A[q2 + 1].z};
                const h32v g = __builtin_amdgcn_cvt_scalef32_pk32_f16_fp6(in6, 1.0f);
#pragma unroll
                for (int h = 0; h < 2; ++h) { const int q = q2 + h; float acc = 0.f;
#pragma unroll
                    for (int c = 0; c < 8; ++c) { const unsigned xw = c < 4 ? Xa[h][c] : Xb[h][c - 4]; const h2v xv = __builtin_bit_cast(h2v, xw); const h2v av = {g[16 * h + 2 * c], g[16 * h + 2 * c + 1]};
                        acc = __builtin_amdgcn_fdot2(av, xv, acc, false); }
                    pp[q] = acc;
                    int e = (int)((unsigned)__builtin_amdgcn_readlane((int)kbN, q) >> 18); if (PM & 32) e &= 1023;
                    if (PM & 2) A[q] = urow_dummy(e); else A[q] = urow_load(rU, lane, e);
                }
                __builtin_amdgcn_sched_barrier(0);
            }
#else
            int pp[16];
#pragma unroll
            for (int g = 0; g < 16 / XG; ++g) {
                i32x4v Xg[XG];
#pragma unroll
                for (int i = 0; i < XG; ++i) { const int t = (__builtin_amdgcn_readlane((int)kb, XG * g + i) >> 16) & 3; Xg[i] = *(const LAS i32x4v*)(xs + t * MIX_XROW + 16 * lane); }
#pragma unroll
                for (int i = 0; i < XG; ++i) { const int q = XG * g + i; const i32x4v X = Xg[i];
                    if (PM & 2) pp[q] = A[q][0] + X[0]; else
                    pp[q] = __builtin_amdgcn_sdot4(A[q][3], X[3], __builtin_amdgcn_sdot4(A[q][2], X[2], __builtin_amdgcn_sdot4(A[q][1], X[1], __builtin_amdgcn_sdot4(A[q][0], X[0], 0, false), false), false), false);
                    int e = (int)((unsigned)__builtin_amdgcn_readlane((int)kbN, q) >> 18); if (PM & 32) e &= 1023;
                    if (PM & 2) A[q] = urow_dummy(e); else A[q] = urow_load(rU, lane, e);
                }
                __builtin_amdgcn_sched_barrier(0);
            }
#endif
            iuN = IU[keyN >> 18]; ivN = IV[keyN >> 18];
            const auto tot = reduce16_rows(pp, lane);
            const float cf = gvs * gelu_tanh((float)tot * dus);
#if Y_F16
            const int cfh = (int)__builtin_bit_cast(unsigned short, (_Float16)cf);
#pragma unroll
            for (int q2 = 0; q2 < 16; q2 += 2) {
                const u32x6 in6 = {vv[q2].x, vv[q2].y, vv[q2].z, vv[q2 + 1].x, vv[q2 + 1].y, vv[q2 + 1].z};
                const h32v f = __builtin_amdgcn_cvt_scalef32_pk32_f16_fp6(in6, 1.0f);
#pragma unroll
                for (int h = 0; h < 2; ++h) { const int q = q2 + h;
                    const int t = (__builtin_amdgcn_readlane((int)kb, q) >> 16) & 3;
                    const unsigned cs = (unsigned)__builtin_amdgcn_readlane(cfh, 4 * q);
                    unsigned x[8];
#pragma unroll
                    for (int c = 0; c < 8; ++c) { const h2v hv = {f[16 * h + 2 * c], f[16 * h + 2 * c + 1]}; x[c] = __builtin_bit_cast(unsigned, hv); }
                    int e = (int)((unsigned)__builtin_amdgcn_readlane((int)kbN, q) >> 18); if (PM & 32) e &= 1023;
                    if (PM & 1) { vv[q] = vrow_dummy(e); Y0[q & 7] ^= cs + x[0]; } else {
                    vv[q] = vrow_load(rV, lane, e);
                    axpy_dispatch2h(t, 0, cs, x, Y0, Y1);
                    axpy_dispatch2h(t, 2, cs, x, Y2, Y3); }
                }
            }
#elif V_FP6
#pragma unroll
            for (int q2 = 0; q2 < 16; q2 += 2) {
                const u32x6 in6 = {vv[q2].x, vv[q2].y, vv[q2].z, vv[q2 + 1].x, vv[q2 + 1].y, vv[q2 + 1].z};
                const f32x32 f = __builtin_amdgcn_cvt_scalef32_pk32_f32_fp6(in6, 1.0f);
#pragma unroll
                for (int h = 0; h < 2; ++h) { const int q = q2 + h;
                    const int t = (__builtin_amdgcn_readlane((int)kb, q) >> 16) & 3;
                    const float cs = __int_as_float(__builtin_amdgcn_readlane(__float_as_int(cf), 4 * q));
                    f32x2 x[8];
#pragma unroll
                    for (int c = 0; c < 8; ++c) x[c] = (f32x2){f[16 * h + 2 * c], f[16 * h + 2 * c + 1]};
                    int e = (int)((unsigned)__builtin_amdgcn_readlane((int)kbN, q) >> 18); if (PM & 32) e &= 1023;
                    if (PM & 1) { vv[q] = vrow_dummy(e); Y0[q & 7].x += cs * x[0].x; } else {
                    vv[q] = vrow_load(rV, lane, e);
                    axpy_dispatch2(t, 0, cs, x, Y0, Y1);
                    axpy_dispatch2(t, 2, cs, x, Y2, Y3); }
                }
            }
#else
#pragma unroll
            for (int q = 0; q < 16; ++q) {
                const int t = (__builtin_amdgcn_readlane((int)kb, q) >> 16) & 3;
                const float cs = __int_as_float(__builtin_amdgcn_readlane(__float_as_int(cf), 4 * q));
                f32x2 x[8];
#pragma unroll
                for (int c = 0; c < 4; ++c) { x[2 * c] = __builtin_amdgcn_cvt_pk_f32_fp8(vv[q][c], false); x[2 * c + 1] = __builtin_amdgcn_cvt_pk_f32_fp8(vv[q][c], true); }
                int e = (int)((unsigned)__builtin_amdgcn_readlane((int)kbN, q) >> 18); if (PM & 32) e &= 1023;
                if (PM & 1) { vv[q] = vrow_dummy(e); Y0[q & 7].x += cs * x[0].x; } else {
                vv[q] = vrow_load(rV, lane, e);
                if (PM & 128) { axpy_dispatch2_dup(t, 0, cs, x, Y0, Y1); axpy_dispatch2_dup(t, 2, cs, x, Y2, Y3); } else {
                axpy_dispatch2(t, 0, cs, x, Y0, Y1);
                axpy_dispatch2(t, 2, cs, x, Y2, Y3); } }
            }
#endif
        }
#else
#pragma unroll 1
        for (int b = 0; b < 32; ++b) {
            const unsigned kb = ks[16 * b + (lane & 15)];
            const unsigned key = ks[16 * b + (lane >> 2)];
            const int es = (int)(key >> 18); const int tq = (int)(key >> 16) & 3;
            const float rsx = rsl[tq];
            const float dus = IU[es] * rsx, gvs = (float)(key & 0xffffu) * (1.0f / 65535.0f) * IV[es];
            i32x4v A[16]; u32x4 vv[16];
#pragma unroll
            for (int q = 0; q < 16; ++q) { int e = (int)((unsigned)__builtin_amdgcn_readlane((int)kb, q) >> 18); if (PM & 32) e &= 1023; A[q] = *(const i32x4v*)(U8 + (size_t)e * 1024 + 16 * lane); }
#pragma unroll
            for (int q = 0; q < 16; ++q) { int e = (int)((unsigned)__builtin_amdgcn_readlane((int)kb, q) >> 18); if (PM & 32) e &= 1023; vv[q] = *(const u32x4*)(V8 + (size_t)e * 1024 + 16 * lane); }
            int pp[16];
#pragma unroll
            for (int q = 0; q < 16; ++q) {
                const int t = (__builtin_amdgcn_readlane((int)kb, q) >> 16) & 3;
                const i32x4v X = *(const LAS i32x4v*)(xs + t * 1024 + 16 * lane);
                pp[q] = __builtin_amdgcn_sdot4(A[q][3], X[3], __builtin_amdgcn_sdot4(A[q][2], X[2], __builtin_amdgcn_sdot4(A[q][1], X[1], __builtin_amdgcn_sdot4(A[q][0], X[0], 0, false), false), false), false);
            }
            const int tot = reduce16_rows(pp, lane);
            const float cf = gvs * gelu_tanh((float)tot * dus);
#pragma unroll
            for (int q = 0; q < 16; ++q) {
                const int t = (__builtin_amdgcn_readlane((int)kb, q) >> 16) & 3;
                const float cs = __int_as_float(__builtin_amdgcn_readlane(__float_as_int(cf), 4 * q));
                f32x2 x[8];
#pragma unroll
                for (int c = 0; c < 4; ++c) { x[2 * c] = __builtin_amdgcn_cvt_pk_f32_fp8(vv[q][c], false); x[2 * c + 1] = __builtin_amdgcn_cvt_pk_f32_fp8(vv[q][c], true); }
                axpy_dispatch2(t, 0, cs, x, Y0, Y1);
                axpy_dispatch2(t, 2, cs, x, Y2, Y3);
            }
            __builtin_amdgcn_sched_barrier(0);
        }
#endif
#if Y_F16
        if (PM != 0) { const int fl = fresh_lane(); unsigned a = 0u;
#pragma unroll
            for (int i = 0; i < 8; ++i) a += Y0[i] + Y1[i] + Y2[i] + Y3[i];
            probe_out[(size_t)tb * 64 + fl] = (float)a; }
        else { const int fl = fresh_lane(); tok_finish_mixed_h(Y0, tb, fl, h1b, h2b, rstd3); tok_finish_mixed_h(Y1, tb + 1, fl, h1b, h2b, rstd3); tok_finish_mixed_h(Y2, tb + 2, fl, h1b, h2b, rstd3); tok_finish_mixed_h(Y3, tb + 3, fl, h1b, h2b, rstd3); }
#else
        if (PM != 0) { const int fl = fresh_lane(); f32x2 a = Y0[0] + Y1[0] + Y2[0] + Y3[0];
#pragma unroll
            for (int i = 1; i < 8; ++i) a += Y0[i] + Y1[i] + Y2[i] + Y3[i];
            probe_out[(size_t)tb * 64 + fl] = a.x + a.y; }
        else { const int fl = fresh_lane(); tok_finish_mixed(Y0, tb, fl, h1b, h2b, rstd3); tok_finish_mixed(Y1, tb + 1, fl, h1b, h2b, rstd3); tok_finish_mixed(Y2, tb + 2, fl, h1b, h2b, rstd3); tok_finish_mixed(Y3, tb + 3, fl, h1b, h2b, rstd3); }
#endif
        __syncthreads();
    }
}
namespace pg8 {
#define PG8_LAS __attribute__((address_space(3)))
typedef unsigned short bf16_t;
typedef short bf16x8 __attribute__((ext_vector_type(8)));
typedef float f32x4 __attribute__((ext_vector_type(4)));
typedef unsigned u32x4 __attribute__((ext_vector_type(4)));
constexpr int BM = 256, BK = 64, HALF = 128, HTB = HALF * BK * 2  , STAGE_BYTES = 8 * HTB, NXCD = 8, WGM = 8;

__host__ __device__ __forceinline__ int lds_byte(int r, int c) { const int st = (r >> 4) * 2 + (c >> 5), rr = r & 15, cc = c & 31, ob = rr * 64 + cc * 2; return st * 1024 + (ob ^ (((ob >> 9) & 1) << 5)); }
__host__ __device__ __forceinline__ void stage_rc(int b, int& R, int& C) { const int st = b / 1024, sb = b % 1024, swz = sb ^ (((sb >> 9) & 1) << 5); R = (st >> 1) * 16 + swz / 64; C = (st & 1) * 32 + (swz % 64) / 2; }
__host__ __device__ __forceinline__ int perm32(int rho) { const int n = rho >> 4, i = rho & 15; return 8 * (i >> 2) + 4 * n + (i & 3); }

struct Unit { int pm, pn; };
struct Gemm { const bf16_t* A; const bf16_t* Bt; int K, lda, apn_shift, apn_stride; };

struct StaticOrder {
    int nM, nN, nwg, G, c;
    __host__ __device__ __forceinline__ void init(int M, int N, int G_, int c_) { nM = M / BM; nN = N / BM; nwg = nM * nN; G = G_; c = c_; }
    __host__ __device__ __forceinline__ bool next(int i, Unit& u) const {
        const long L = (long)i * G + c; if (L >= nwg) return false;
        int wgid = (int)L; { const int q = nwg / NXCD, r = nwg % NXCD, xcd = wgid % NXCD, off = wgid / NXCD; wgid = (xcd < r ? xcd * (q + 1) : r * (q + 1) + (xcd - r) * q) + off; }
        const int nig = WGM * nN, gid = wgid / nig, fm = gid * WGM, gsz = (nM - fm) < WGM ? (nM - fm) : WGM;
        u.pm = fm + ((wgid % nig) % gsz); u.pn = (wgid % nig) / gsz; return true;
    }
    __device__ __forceinline__ void a_ready(const Unit&) const {}
    __device__ __forceinline__ void done(const Unit&) const {}
};

__device__ __forceinline__ unsigned cvt_pk_bf16(float lo, float hi) { unsigned r; asm volatile("v_cvt_pk_bf16_f32 %0, %1, %2" : "=v"(r) : "v"(lo), "v"(hi)); return r; }

template <class Epi, class Sched, bool ALIGN_EPI = false, bool SP2 = false>
__device__ __forceinline__ void gemm_phase(PG8_LAS unsigned char* lds, const Gemm g, const Sched& S, const Epi& E, int wave_id  ) {
    const int lane = fresh_lane(), wid = wave_id, tid = wid * 64 + lane, wr = wid >> 2, wc = wid & 3, fr = lane & 15, fq = lane >> 4;
    const int K = g.K, nt = K / BK;
    unsigned voffA[2], voffB[2];
#pragma unroll
    for (int i = 0; i < 2; ++i) { int R, C; stage_rc(tid * 16 + i * 8192, R, C); const int Rb = Epi::PERM ? ((R & ~31) + perm32(R & 31)) : R;
        voffA[i] = (unsigned)(R * g.lda + C) * 2u; voffB[i] = (unsigned)(Rb * K + C) * 2u; }
    const size_t kstep = (size_t)(BK * 2);
    const size_t hstepA = (size_t)HALF * g.lda * 2, hstepB = (size_t)HALF * K * 2;
    const size_t tstepA = 2 * hstepA, tstepB = 2 * hstepB;
    const unsigned ldsw = (unsigned)wid * 1024u;
    const int aoff = lds_byte(wr * 64 + fr, fq * 8), boff = lds_byte(wc * 32 + fr, fq * 8);
#define PG8_SA(b, h) (((b) * 2 + (h)) * HTB)
#define PG8_SB(b, h) ((4 + (b) * 2 + (h)) * HTB)
#define PG8_STAGE(bufoff, gbase, voff) do { _Pragma("unroll") for (int _i = 0; _i < 2; ++_i) \
        __builtin_amdgcn_global_load_lds((const unsigned*)((const char*)(gbase) + (voff)[_i]), (PG8_LAS unsigned*)(lds + (bufoff) + ldsw + _i * 8192), 16, 0, 0); } while (0)
#define PG8_LDA(dst, b, h) do { _Pragma("unroll") for (int m = 0; m < 4; ++m) _Pragma("unroll") for (int k = 0; k < 2; ++k) dst[m][k] = *(const PG8_LAS bf16x8*)(lds + PG8_SA(b, h) + aoff + m * 2048 + k * 1024); } while (0)
#define PG8_LDB(dst, b, h) do { _Pragma("unroll") for (int n = 0; n < 2; ++n) _Pragma("unroll") for (int k = 0; k < 2; ++k) dst[n][k] = *(const PG8_LAS bf16x8*)(lds + PG8_SB(b, h) + boff + n * 2048 + k * 1024); } while (0)
#define PG8_MMA(ai, bj, At, Bt) do { __builtin_amdgcn_s_setprio(1); _Pragma("unroll") for (int m = 0; m < 4; ++m) _Pragma("unroll") for (int n = 0; n < 2; ++n) _Pragma("unroll") for (int k = 0; k < 2; ++k) \
        acc[ai][bj][m][n] = __builtin_amdgcn_mfma_f32_16x16x32_bf16(Bt[n][k], At[m][k], acc[ai][bj][m][n], 0, 0, 0); __builtin_amdgcn_s_setprio(0); } while (0)
#define PG8_WAIT_V(n) asm volatile("s_waitcnt vmcnt(" #n ")" ::: "memory")
#define PG8_WAIT_L(n) asm volatile("s_waitcnt lgkmcnt(" #n ")" ::: "memory")
#define PG8_BAR __builtin_amdgcn_s_barrier()
#define PG8_SCHED __builtin_amdgcn_sched_barrier(0)
    Unit cur, nxt; int ui = 0;
    if (!S.next(0, cur)) return;
    f32x4 acc[2][2][4][2];
#pragma unroll
    for (int a = 0; a < 2; ++a)
#pragma unroll
        for (int b = 0; b < 2; ++b)
#pragma unroll
            for (int m = 0; m < 4; ++m)
#pragma unroll
                for (int n = 0; n < 2; ++n) acc[a][b][m][n] = (f32x4){0.f, 0.f, 0.f, 0.f};
    bf16x8 At[4][2], B0[2][2], B1[2][2];
    const char* cA = (const char*)g.A + (size_t)cur.pm * tstepA + (size_t)((cur.pn >> g.apn_shift) * g.apn_stride) * 2; const char* cB = (const char*)g.Bt + (size_t)cur.pn * tstepB;
    S.a_ready(cur);
    if constexpr (SP2) {
        PG8_STAGE(PG8_SB(0, 0), cB, voffB); PG8_STAGE(PG8_SB(0, 1), cB + hstepB, voffB); PG8_STAGE(PG8_SA(0, 0), cA, voffA); PG8_STAGE(PG8_SA(0, 1), cA + hstepA, voffA);
        if (wr == 1) PG8_BAR;
        PG8_WAIT_V(2); PG8_BAR;
        PG8_STAGE(PG8_SB(1, 0), cB + kstep, voffB); PG8_STAGE(PG8_SA(1, 0), cA + kstep, voffA); PG8_STAGE(PG8_SB(1, 1), cB + hstepB + kstep, voffB);
        PG8_WAIT_V(6); PG8_BAR;
    } else {
        PG8_STAGE(PG8_SB(0, 0), cB, voffB); PG8_STAGE(PG8_SA(0, 0), cA, voffA); PG8_STAGE(PG8_SB(0, 1), cB + hstepB, voffB); PG8_STAGE(PG8_SA(0, 1), cA + hstepA, voffA);
        if (wr == 1) PG8_BAR;
        PG8_WAIT_V(4); PG8_BAR;
        PG8_STAGE(PG8_SB(1, 0), cB + kstep, voffB); PG8_STAGE(PG8_SA(1, 0), cA + kstep, voffA); PG8_STAGE(PG8_SB(1, 1), cB + hstepB + kstep, voffB);
        PG8_WAIT_V(6); PG8_BAR;
    }
    for (;;) {
        const bool has_next = S.next(ui + 1, nxt);
        const char* nA = has_next ? (const char*)g.A + (size_t)nxt.pm * tstepA + (size_t)((nxt.pn >> g.apn_shift) * g.apn_stride) * 2 : cA; const char* nB = has_next ? (const char*)g.Bt + (size_t)nxt.pn * tstepB : cB;
#pragma unroll 1
        for (int t = 0; t < nt; t += 2) {
            const bool last = (t == nt - 2);
            const char* a1 = cA + (size_t)(t + 1) * kstep;
            const char* a2 = last ? nA : cA + (size_t)(t + 2) * kstep; const char* b2 = last ? nB : cB + (size_t)(t + 2) * kstep;
            const char* a3 = a2 + kstep; const char* b3 = b2 + kstep;
            if (last && has_next) S.a_ready(nxt);
            if constexpr (SP2) {
            PG8_LDB(B0, 0, 0); PG8_LDB(B1, 0, 1); PG8_SCHED; PG8_LDA(At, 0, 0); PG8_STAGE(PG8_SA(1, 1), a1 + hstepA, voffA);
            PG8_WAIT_V(8); PG8_WAIT_L(0); PG8_BAR; PG8_MMA(0, 0, At, B0); PG8_MMA(0, 1, At, B1); PG8_BAR; PG8_SCHED;
            PG8_LDA(At, 0, 1); PG8_STAGE(PG8_SB(0, 0), b2, voffB); PG8_STAGE(PG8_SB(0, 1), b2 + hstepB, voffB); PG8_STAGE(PG8_SA(0, 0), a2, voffA);
            PG8_WAIT_V(8); PG8_WAIT_L(0); PG8_BAR; PG8_MMA(1, 0, At, B0); PG8_MMA(1, 1, At, B1); PG8_BAR; PG8_SCHED;
            PG8_LDB(B0, 1, 0); PG8_LDB(B1, 1, 1); PG8_SCHED; PG8_LDA(At, 1, 0); PG8_STAGE(PG8_SA(0, 1), a2 + hstepA, voffA);
            PG8_WAIT_V(8); PG8_WAIT_L(0); PG8_BAR; PG8_MMA(0, 0, At, B0); PG8_MMA(0, 1, At, B1); PG8_BAR; PG8_SCHED;
            PG8_LDA(At, 1, 1); PG8_STAGE(PG8_SB(1, 0), b3, voffB); PG8_STAGE(PG8_SB(1, 1), b3 + hstepB, voffB); PG8_STAGE(PG8_SA(1, 0), a3, voffA);
            PG8_WAIT_V(8); PG8_WAIT_L(0); PG8_BAR; PG8_MMA(1, 0, At, B0); PG8_MMA(1, 1, At, B1); PG8_BAR; PG8_SCHED;
            } else {
            PG8_LDB(B0, 0, 0); PG8_SCHED; PG8_LDA(At, 0, 0); PG8_STAGE(PG8_SA(1, 1), a1 + hstepA, voffA);
            PG8_WAIT_L(8); PG8_BAR; PG8_WAIT_L(0); PG8_MMA(0, 0, At, B0); PG8_BAR; PG8_SCHED;
            PG8_LDB(B1, 0, 1); PG8_STAGE(PG8_SB(0, 0), b2, voffB);
            PG8_BAR; PG8_WAIT_L(0); PG8_MMA(0, 1, At, B1); PG8_BAR;
            PG8_LDA(At, 0, 1); PG8_STAGE(PG8_SA(0, 0), a2, voffA);
            PG8_BAR; PG8_WAIT_L(0); PG8_MMA(1, 0, At, B0); PG8_BAR; PG8_SCHED;
            PG8_STAGE(PG8_SB(0, 1), b2 + hstepB, voffB);
            PG8_WAIT_V(6); PG8_BAR; PG8_MMA(1, 1, At, B1); PG8_BAR;
            PG8_LDB(B0, 1, 0); PG8_SCHED; PG8_LDA(At, 1, 0); PG8_STAGE(PG8_SA(0, 1), a2 + hstepA, voffA);
            PG8_WAIT_L(8); PG8_BAR; PG8_WAIT_L(0); PG8_MMA(0, 0, At, B0); PG8_BAR; PG8_SCHED;
            PG8_LDB(B1, 1, 1); PG8_STAGE(PG8_SB(1, 0), b3, voffB);
            PG8_BAR; PG8_WAIT_L(0); PG8_MMA(0, 1, At, B1); PG8_BAR;
            PG8_LDA(At, 1, 1); PG8_STAGE(PG8_SA(1, 0), a3, voffA);
            PG8_BAR; PG8_WAIT_L(0); PG8_MMA(1, 0, At, B0); PG8_BAR; PG8_SCHED;
            PG8_STAGE(PG8_SB(1, 1), b3 + hstepB, voffB);
            PG8_WAIT_V(6); PG8_BAR; PG8_MMA(1, 1, At, B1); PG8_BAR;
            }
        }
        if constexpr (ALIGN_EPI) { if (wr == 0) PG8_BAR; }
        if constexpr (!Epi::AFTER_DRAIN) { E(acc, cur, wr, wc, fr, fq); S.done(cur); }
        if (!has_next) break;
#pragma unroll
        for (int a = 0; a < 2; ++a)
#pragma unroll
            for (int b = 0; b < 2; ++b)
#pragma unroll
                for (int m = 0; m < 4; ++m)
#pragma unroll
                    for (int n = 0; n < 2; ++n) acc[a][b][m][n] = (f32x4){0.f, 0.f, 0.f, 0.f};
        cur = nxt; cA = nA; cB = nB; ++ui;
        if constexpr (ALIGN_EPI) { if (wr == 1) PG8_BAR; }
    }
    PG8_WAIT_V(0);
    if constexpr (!ALIGN_EPI) { if (wr == 0) PG8_BAR; }
    PG8_BAR;
    if constexpr (Epi::AFTER_DRAIN) { E.fused(acc, cur, wr, wc, fr, fq, lds, wid, lane); S.done(cur); }
#undef PG8_SA
#undef PG8_SB
#undef PG8_STAGE
#undef PG8_LDA
#undef PG8_LDB
#undef PG8_MMA
#undef PG8_WAIT_V
#undef PG8_WAIT_L
#undef PG8_BAR
#undef PG8_SCHED
}
}
#define GAS __attribute__((address_space(1)))
typedef GAS unsigned gu32;
#define RLX_AGENT __ATOMIC_RELAXED, __HIP_MEMORY_SCOPE_AGENT
#define LDS_WAIT() asm volatile("s_waitcnt lgkmcnt(0)" ::: "memory")
#define VM_WAIT() asm volatile("s_waitcnt vmcnt(0)" ::: "memory")
#define XB_TMO      128
#define XB_XCNT(j)  (256  + 64 * (j))
#define XB_XSUB(j)  (1280 + 64 * (j))
#define XB_XGEN(j)  (2304 + 64 * (j))
#define XB_TOP      3328
#define XB_TOPGEN   3392
#define XCD_BAR_WORDS 3456
#define XB_SPIN_CAP (1u << 18)

__device__ __forceinline__ unsigned xb_ld(unsigned* p)              { return __hip_atomic_load(p, __ATOMIC_RELAXED, __HIP_MEMORY_SCOPE_AGENT); }
__device__ __forceinline__ unsigned xb_add(unsigned* p, unsigned v) { return __hip_atomic_fetch_add(p, v, __ATOMIC_RELAXED, __HIP_MEMORY_SCOPE_AGENT); }
__device__ __forceinline__ unsigned xb_xcc_id() { return (unsigned)__builtin_amdgcn_s_getreg((3 << 11) | 20) & 0xFu; }
#define XB_SPIN(cond, bar) do { unsigned _sp = 0; while (cond) { __builtin_amdgcn_s_sleep(1); \
    if ((++_sp & 255u) == 0u) { if (xb_ld(&(bar)[XB_TMO])) break; if (_sp > XB_SPIN_CAP) { atomicAdd(&(bar)[XB_TMO], 1u); break; } } } } while (0)

struct XcdBarrier {
    unsigned* bar; unsigned x;
    volatile LAS unsigned* st;
};

__device__ __forceinline__ XcdBarrier xcd_barrier_post(unsigned* bar, volatile LAS unsigned* st) {
    XcdBarrier b; b.bar = bar; b.x = xb_xcc_id(); b.st = st;
    if (threadIdx.x == 0) (void)xb_add(&bar[XB_XCNT(b.x)], 1u);
    return b;
}
__device__ __forceinline__ void xcd_barrier_complete(unsigned* bar, unsigned x, unsigned& nloc, unsigned& nx) {
    const unsigned G = gridDim.x * gridDim.y * gridDim.z;
    unsigned sum, cnt, mine, sp = 0u;
    for (;;) {
        sum = 0u; cnt = 0u; mine = 0u;
#pragma unroll
        for (unsigned j = 0; j < 16; ++j) { const unsigned c = xb_ld(&bar[XB_XCNT(j)]); sum += c; cnt += (c > 0u) ? 1u : 0u; mine = (j == x) ? c : mine; }
        if (sum == G) break;
        __builtin_amdgcn_s_sleep(1);
        if ((++sp & 255u) == 0u) { if (xb_ld(&bar[XB_TMO])) break; if (sp > XB_SPIN_CAP) { atomicAdd(&bar[XB_TMO], 1u); break; } }
    }
    nloc = mine > 0u ? mine : 1u; nx = cnt > 0u ? cnt : 1u;
}

__device__ __forceinline__ void xcd_barrier(const XcdBarrier& b) {
    asm volatile("s_waitcnt vmcnt(0)" ::: "memory");
    __syncthreads();
    if (threadIdx.x == 0) {
        unsigned* bar = b.bar;
        __builtin_amdgcn_s_waitcnt(0);
        unsigned nloc = b.st[0], nx = b.st[1];
        if (nloc == 0u) { xcd_barrier_complete(bar, b.x, nloc, nx); b.st[0] = nloc; b.st[1] = nx; }
        const unsigned old = xb_add(&bar[XB_XSUB(b.x)], 1u);
        const unsigned gen = old / nloc;
        if (old + 1u == (gen + 1u) * nloc) {
            __builtin_amdgcn_fence(__ATOMIC_RELEASE, "agent");
            asm volatile("s_waitcnt vmcnt(0)" ::: "memory");
            const unsigned og = xb_add(&bar[XB_TOP], 1u);
            const unsigned tg = og / nx;
            if (og + 1u == (tg + 1u) * nx) xb_add(&bar[XB_TOPGEN], 1u);
            else XB_SPIN(xb_ld(&bar[XB_TOPGEN]) == tg, bar);
            __builtin_amdgcn_fence(__ATOMIC_ACQUIRE, "agent");
            xb_add(&bar[XB_XGEN(b.x)], 1u);
            asm volatile("s_waitcnt vmcnt(0)" ::: "memory");
        } else {
            XB_SPIN(xb_ld(&bar[XB_XGEN(b.x)]) == gen, bar);
            __builtin_amdgcn_fence(__ATOMIC_ACQUIRE, "agent");
            asm volatile("s_waitcnt vmcnt(0)" ::: "memory");
        }
    }
    __syncthreads();
}

constexpr int NWAVES = 8;
constexpr int LDS_MAIN = 135168;
constexpr int LDSCTL_OFF = LDS_MAIN;
constexpr int LDS_BYTES = 147456;
constexpr int CW_BAR = 4096;
constexpr size_t CTL_ZERO_BYTES = 1 * MiB;
constexpr float LOG2E = 1.4426950408889634f;
typedef short bf16x8 __attribute__((ext_vector_type(8)));
typedef float f32x16 __attribute__((ext_vector_type(16)));
typedef unsigned u32x2 __attribute__((ext_vector_type(2)));
using pg8::Unit;
using pg8::cvt_pk_bf16;

__device__ __forceinline__ f32x4 sig4(f32x4 v) { return (f32x4){sigmoidf_(v[0]), sigmoidf_(v[1]), sigmoidf_(v[2]), sigmoidf_(v[3])}; }
__device__ __forceinline__ f32x4 gelu4(f32x4 v) { return (f32x4){gelu_tanh(v[0]), gelu_tanh(v[1]), gelu_tanh(v[2]), gelu_tanh(v[3])}; }
__device__ __forceinline__ u32x4 pack8(f32x4 a, f32x4 b) { u32x4 w; w.x = cvt_pk_bf16(a[0], a[1]); w.y = cvt_pk_bf16(a[2], a[3]); w.z = cvt_pk_bf16(b[0], b[1]); w.w = cvt_pk_bf16(b[2], b[3]); return w; }

struct OneUnit { pg8::StaticOrder S; int k;
    __device__ __forceinline__ bool next(int i, Unit& u) const { return i == 0 && S.next(k, u); }
    __device__ __forceinline__ void a_ready(const Unit&) const {}
    __device__ __forceinline__ void done(const Unit&) const {} };
struct EpiProj {
    static constexpr bool PERM = true, AFTER_DRAIN = false;
    const float* rstd; unsigned char* ws;
    __device__ __forceinline__ void operator()(const f32x4 (&acc)[2][2][4][2], const Unit& u, int wr, int wc, int fr, int fq) const {
        { const int t_ = fresh_lane(); fr = t_ & 15; fq = t_ >> 4; }
        const int pn = u.pn; bf16* base; int ldc, coff, act;
        if (pn < 3) { base = (bf16*)(ws + WS_QKV); ldc = 768; coff = pn * 256; act = 0; }
        else if (pn < 7) { base = (bf16*)(ws + WS_LX); ldc = 1024; coff = (pn - 3) * 256; act = 0; }
        else if (pn < 11) { base = (bf16*)(ws + WS_GL); ldc = 1024; coff = (pn - 7) * 256; act = 1; }
        else if (pn < 15) { base = (bf16*)(ws + WS_SGA); ldc = 1024; coff = (pn - 11) * 256; act = 2; }
        else { base = (bf16*)(ws + WS_SGL); ldc = 1024; coff = (pn - 15) * 256; act = 2; }
        const int row0 = u.pm * 256 + wr * 64 + fr, col0 = coff + wc * 32 + 8 * fq;
#pragma unroll
        for (int ai = 0; ai < 2; ++ai)
#pragma unroll
            for (int m = 0; m < 4; ++m) {
                const int r = row0 + ai * 128 + m * 16; const float rs = rstd[r]; bf16* rowp = base + (size_t)r * ldc + col0;
#pragma unroll
                for (int bj = 0; bj < 2; ++bj) {
                    f32x4 v0 = acc[ai][bj][m][0] * rs, v1 = acc[ai][bj][m][1] * rs;
                    if (act == 1) { v0 = gelu4(v0); v1 = gelu4(v1); } else if (act == 2) { v0 = sig4(v0); v1 = sig4(v1); }
                    *(u32x4*)(rowp + bj * 128) = pack8(v0, v1);
                }
            }
    }
};
struct EpiMP {
    static constexpr bool PERM = false, AFTER_DRAIN = false;
    const bf16* sga; float* mp;
    __device__ __forceinline__ void operator()(const f32x4 (&acc)[2][2][4][2], const Unit& u, int wr, int wc, int fr, int fq) const {
        { const int t_ = fresh_lane(); fr = t_ & 15; fq = t_ >> 4; }
        const int row0 = u.pm * 256 + wr * 64 + fr, col0 = u.pn * 256 + wc * 32 + 4 * fq;
#pragma unroll
        for (int ai = 0; ai < 2; ++ai)
#pragma unroll
            for (int m = 0; m < 4; ++m) {
                const size_t off = (size_t)(row0 + ai * 128 + m * 16) * 1024 + col0;
#pragma unroll
                for (int bj = 0; bj < 2; ++bj)
#pragma unroll
                    for (int n = 0; n < 2; ++n) { const size_t o = off + bj * 128 + n * 16; const f32x4 g = bf4_lo(*(const u32x2*)(sga + o)); const f32x4 v = acc[ai][bj][m][n] * g;
#if ALL_FUSED
                        u32x2 w; w.x = cvt_pk_bf16(v[0], v[1]); w.y = cvt_pk_bf16(v[2], v[3]); *(u32x2*)((bf16*)mp + o) = w;
#else
                        *(f32x4*)(mp + o) = v;
#endif
                    }
            }
    }
};
struct EpiMerged {
    static constexpr bool PERM = true, AFTER_DRAIN = false;
    const bf16* sgl; const float* mp; bf16* merged;
    __device__ __forceinline__ void operator()(const f32x4 (&acc)[2][2][4][2], const Unit& u, int wr, int wc, int fr, int fq) const {
        { const int t_ = fresh_lane(); fr = t_ & 15; fq = t_ >> 4; }
        const int row0 = u.pm * 256 + wr * 64 + fr, col0 = u.pn * 256 + wc * 32 + 8 * fq;
#pragma unroll
        for (int ai = 0; ai < 2; ++ai)
#pragma unroll
            for (int m = 0; m < 4; ++m) {
                const size_t off = (size_t)(row0 + ai * 128 + m * 16) * 1024 + col0;
#pragma unroll
                for (int bj = 0; bj < 2; ++bj) {
                    const size_t o = off + bj * 128; const u32x4 gw = *(const u32x4*)(sgl + o);
#if ALL_FUSED
                    const u32x4 mw = *(const u32x4*)((const bf16*)mp + o); const f32x4 m0 = bf4_lo((u32x2){mw.x, mw.y}), m1 = bf4_lo((u32x2){mw.z, mw.w});
#else
                    const f32x4 m0 = *(const f32x4*)(mp + o), m1 = *(const f32x4*)(mp + o + 4);
#endif
                    const f32x4 v0 = m0 + acc[ai][bj][m][0] * bf4_lo((u32x2){gw.x, gw.y}), v1 = m1 + acc[ai][bj][m][1] * bf4_lo((u32x2){gw.z, gw.w});
                    *(u32x4*)(merged + o) = pack8(v0, v1);
                }
            }
    }
};
struct EpiH1 {
    static constexpr bool PERM = true, AFTER_DRAIN = false;
    const float* x; float* h1; bf16* h1b; float* part;
    __device__ __forceinline__ void operator()(const f32x4 (&acc)[2][2][4][2], const Unit& u, int wr, int wc, int fr, int fq) const {
        { const int t_ = fresh_lane(); fr = t_ & 15; fq = t_ >> 4; }
        const int row0 = u.pm * 256 + wr * 64 + fr, col0 = u.pn * 256 + wc * 32 + 8 * fq;
#pragma unroll
        for (int ai = 0; ai < 2; ++ai)
#pragma unroll
            for (int m = 0; m < 4; ++m) {
                const int r = row0 + ai * 128 + m * 16; const size_t off = (size_t)r * 1024 + col0; float sq = 0.f;
#pragma unroll
                for (int bj = 0; bj < 2; ++bj) {
                    const size_t o = off + bj * 128;
                    const f32x4 v0 = *(const f32x4*)(x + o) + acc[ai][bj][m][0], v1 = *(const f32x4*)(x + o + 4) + acc[ai][bj][m][1];
#if !ALL_FUSED
                    *(f32x4*)(h1 + o) = v0; *(f32x4*)(h1 + o + 4) = v1;
#endif
                    *(u32x4*)(h1b + o) = pack8(v0, v1);
                    sq += (v0[0] * v0[0] + v0[1] * v0[1]) + (v0[2] * v0[2] + v0[3] * v0[3]) + (v1[0] * v1[0] + v1[1] * v1[1]) + (v1[2] * v1[2] + v1[3] * v1[3]);
                }
                sq += __shfl_xor(sq, 16); sq += __shfl_xor(sq, 32);
                if (fq == 0) part[(size_t)r * 16 + u.pn * 4 + wc] = sq;
            }
    }
};
struct EpiScore {
    static constexpr bool PERM = false, AFTER_DRAIN = false;
    const float* part; float* sc;
    __device__ __forceinline__ void operator()(const f32x4 (&acc)[2][2][4][2], const Unit& u, int wr, int wc, int fr, int fq) const {
        { const int t_ = fresh_lane(); fr = t_ & 15; fq = t_ >> 4; }
        const int row0 = u.pm * 256 + wr * 64 + fr, col0 = u.pn * 256 + wc * 32 + 4 * fq;
#pragma unroll
        for (int ai = 0; ai < 2; ++ai)
#pragma unroll
            for (int m = 0; m < 4; ++m) {
                const int r = row0 + ai * 128 + m * 16; const f32x4* pp = (const f32x4*)(part + (size_t)r * 16);
                const f32x4 s4 = (pp[0] + pp[1]) + (pp[2] + pp[3]); const float rs = 1.0f / sqrtf(((s4[0] + s4[1]) + (s4[2] + s4[3])) * (1.0f / 1024.0f) + EPS);
                const size_t off = (size_t)r * 1024 + col0;
#pragma unroll
                for (int bj = 0; bj < 2; ++bj)
#pragma unroll
                    for (int n = 0; n < 2; ++n) *(f32x4*)(sc + off + bj * 128 + n * 16) = acc[ai][bj][m][n] * rs;
            }
    }
};
__device__ __forceinline__ unsigned enc_e2m3(float x) {
    const float a = fabsf(x);
    const float m = a < 2.0f ? 8.0f : (a < 4.0f ? 4.0f : 2.0f); const int off = a < 2.0f ? 0 : (a < 4.0f ? 8 : 16);
    int code = (int)__builtin_rintf(a * m) + off; code = code > 31 ? 31 : code;
    return (unsigned)code | (x < 0.f ? 32u : 0u);
}
__device__ __forceinline__ void uv_convert(const float* pu, const float* pv, const float* gffn, unsigned char* u8, unsigned char* v8, float* iu, float* iv, int gw, int NGW, int lane) {
    f32x4 g[4];
#pragma unroll
    for (int j = 0; j < 4; ++j) g[j] = ((const f32x4*)gffn)[4 * lane + j];
    constexpr int UVH = V_FP6 ? 1 : 2;
    for (int e0 = gw; e0 < 2 * 16384; e0 += UVH * NGW) {
        f32x4 v[UVH][4];
#pragma unroll
        for (int h = 0; h < UVH; ++h) { const int e = e0 + h * NGW; const bool isv = e >= 16384; const int row = isv ? e - 16384 : e;
            const f32x4* src = (const f32x4*)((isv ? pv : pu) + (size_t)row * 1024) + 4 * lane;
#pragma unroll
            for (int j = 0; j < 4; ++j) v[h][j] = src[j]; }
#pragma unroll
        for (int h = 0; h < UVH; ++h) {
            const int e = e0 + h * NGW; const bool isv = e >= 16384; const int row = isv ? e - 16384 : e;
            float am = 0.f;
#pragma unroll
            for (int j = 0; j < 4; ++j) { if (!isv) v[h][j] = v[h][j] * g[j]; am = fmaxf(am, fmaxf(fmaxf(fabsf(v[h][j][0]), fabsf(v[h][j][1])), fmaxf(fabsf(v[h][j][2]), fabsf(v[h][j][3])))); }
#pragma unroll
            for (int o = 1; o < 64; o <<= 1) am = fmaxf(am, __shfl_xor(am, o));
            const float sc = am > 0.f ? (isv ? (V_FP6 ? 7.5f : 416.0f) : (U_FP6 ? 7.5f : 127.0f)) / am : 1.0f;
            u32x4 w;
#if V_FP6
            if (isv || U_FP6) {
#define E6(i) enc_e2m3(v[h][(i) >> 2][(i) & 3] * sc)
                u32x3 w6;
                w6.x = E6(0) | (E6(1) << 6) | (E6(2) << 12) | (E6(3) << 18) | (E6(4) << 24); { const unsigned c5 = E6(5); w6.x |= c5 << 30; w6.y = c5 >> 2; }
                __builtin_amdgcn_sched_barrier(0);
                w6.y |= (E6(6) << 4) | (E6(7) << 10) | (E6(8) << 16) | (E6(9) << 22); { const unsigned c10 = E6(10); w6.y |= c10 << 28; w6.z = c10 >> 4; }
                __builtin_amdgcn_sched_barrier(0);
                w6.z |= (E6(11) << 2) | (E6(12) << 8) | (E6(13) << 14) | (E6(14) << 20) | (E6(15) << 26);
#undef E6
                *(u32x3*)((isv ? v8 : u8) + (size_t)row * 768 + 12 * lane) = w6;
                if (lane == 0) (isv ? iv : iu)[row] = 1.0f / sc;
                continue;
            }
#endif
            if (isv) {
#pragma unroll
                for (int j = 0; j < 4; ++j) { unsigned ww = 0u; ww = __builtin_amdgcn_cvt_pk_fp8_f32(v[h][j][0] * sc, v[h][j][1] * sc, ww, false); ww = __builtin_amdgcn_cvt_pk_fp8_f32(v[h][j][2] * sc, v[h][j][3] * sc, ww, true); w[j] = ww; }
            } else {
#pragma unroll
                for (int j = 0; j < 4; ++j) { unsigned ww = 0u;
#pragma unroll
                    for (int c = 0; c < 4; ++c) ww |= ((unsigned)(int)__builtin_rintf(v[h][j][c] * sc) & 0xffu) << (8 * c);
                    w[j] = ww; }
            }
            *(u32x4*)((isv ? v8 : u8) + (size_t)row * 1024 + 16 * lane) = w;
            if (lane == 0) (isv ? iv : iu)[row] = 1.0f / sc;
        }
    }
}
struct EpiTopk {
    static constexpr bool PERM = false, AFTER_DRAIN = true;
    const float* part; int* seli; float* selg;
    const float* pu; const float* pv; const float* gffn; unsigned char* u8; unsigned char* v8; float* iu; float* iv; int uvslot, uvn;
    __device__ __forceinline__ void fused(f32x4 (&acc)[2][2][4][2], const Unit& u, int wr, int wc, int fr, int fq, PG8_LAS unsigned char* lds, int wid, int lane) const {
        LAS float* L = (LAS float*)lds;
#pragma unroll
        for (int ai = 0; ai < 2; ++ai) {
            { const int t_ = fresh_lane(); fr = t_ & 15; fq = t_ >> 4; }
#pragma unroll
            for (int m = 0; m < 4; ++m) {
                const int rl = wr * 64 + m * 16 + fr, r = u.pm * 256 + ai * 128 + rl;
                const f32x4* pp = (const f32x4*)(part + (size_t)r * 16);
                const f32x4 s4 = (pp[0] + pp[1]) + (pp[2] + pp[3]); const float rs = 1.0f / sqrtf(((s4[0] + s4[1]) + (s4[2] + s4[3])) * (1.0f / 1024.0f) + EPS);
#pragma unroll
                for (int bj = 0; bj < 2; ++bj)
#pragma unroll
                    for (int n = 0; n < 2; ++n) *(LAS f32x4*)(L + (rl * 2 + bj) * TK_LSTRIDE + wc * 32 + 16 * n + 4 * fq) = acc[ai][bj][m][n] * rs;
            }
            asm volatile("s_waitcnt lgkmcnt(0)" ::: "memory"); __builtin_amdgcn_s_barrier(); asm volatile("" ::: "memory");
            const int tid = wid * 64 + fresh_lane();
            if (wid < 4) {
                const LAS float* my = L + tid * TK_LSTRIDE;
                unsigned a16[16];
#pragma unroll
                for (int g = 0; g < 8; ++g) {
                    unsigned t[16];
#pragma unroll
                    for (int q = 0; q < 4; ++q) {
                        const f32x4 v = *(const LAS f32x4*)(my + g * 16 + q * 4);
#pragma unroll
                        for (int c = 0; c < 4; ++c) { const int e = g * 16 + q * 4 + c; const float vc = v[c]; t[q * 4 + c] = (tk_f2key(vc) & ~127u) | (unsigned)(127 - e); }
                    }
                    tk_sort16(t);
                    if (g == 0) {
#pragma unroll
                        for (int i = 0; i < 16; ++i) a16[i] = t[i];
                    } else tk_merge16(a16, t);
                }
                {   u32x4 sb;
#pragma unroll
                    for (int c = 0; c < 4; ++c) sb[c] = (127u - (a16[4 * c] & 127u)) | ((127u - (a16[4 * c + 1] & 127u)) << 8) | ((127u - (a16[4 * c + 2] & 127u)) << 16) | ((127u - (a16[4 * c + 3] & 127u)) << 24);
                    *(LAS u32x4*)(L + tid * TK_LSTRIDE) = sb; }
                __builtin_amdgcn_sched_barrier(0);
                unsigned oth[16];
#pragma unroll
                for (int i = 0; i < 16; ++i) oth[i] = (unsigned)__shfl_xor((int)a16[i], 1);
                const bool odd = tid & 1;
                unsigned part[16]; tk_pair_partial(a16, oth, odd, part);
                {   unsigned po[16];
#pragma unroll
                    for (int i = 0; i < 16; ++i) po[i] = (unsigned)__shfl_xor((int)part[i], 1);
                    tk_merge16(part, po); }
                asm volatile("s_waitcnt lgkmcnt(0)" ::: "memory");
                const float mx = tk_key2f(part[0] & ~255u);
                float ex[16], sum = 0.f;
#pragma unroll
                for (int i = 0; i < 16; ++i) { ex[i] = __builtin_expf(tk_key2f(part[i] & ~255u) - mx); sum += ex[i]; }
                const float inv = 1.0f / sum;
                const LAS unsigned char* r1 = (const LAS unsigned char*)(L + (tid & ~1) * TK_LSTRIDE); const LAS unsigned char* r2 = r1 + TK_LSTRIDE * 4;
                const int tok = u.pm * 256 + ai * 128 + (tid >> 1);
                int* oi = seli + (size_t)tok * 128 + u.pn * 16 + (odd ? 8 : 0); float* og = selg + (size_t)tok * 128 + u.pn * 16 + (odd ? 8 : 0);
                int ei[8]; float eg[8];
#pragma unroll
                for (int i = 0; i < 8; ++i) { unsigned ka = part[i], kb = part[i + 8]; float xa = ex[i], xb = ex[i + 8]; asm volatile("" : "+v"(ka), "+v"(kb), "+v"(xa), "+v"(xb));
                    const unsigned key = odd ? kb : ka; int i1, i2; tk_decode(key, i1, i2);
                    ei[i] = (int)r1[i1] * 128 + (int)r2[i2]; eg[i] = (odd ? xb : xa) * inv; }
                *(i32x4v*)oi = (i32x4v){ei[0], ei[1], ei[2], ei[3]}; *(i32x4v*)(oi + 4) = (i32x4v){ei[4], ei[5], ei[6], ei[7]};
                *(f32x4*)og = (f32x4){eg[0], eg[1], eg[2], eg[3]}; *(f32x4*)(og + 4) = (f32x4){eg[4], eg[5], eg[6], eg[7]};
            } else if (uvn > 0) uv_convert(pu, pv, gffn, u8, v8, iu, iv, uvslot + 4 * ai + (wid - 4), uvn, fresh_lane());
            asm volatile("s_waitcnt lgkmcnt(0)" ::: "memory"); __builtin_amdgcn_s_barrier(); asm volatile("" ::: "memory");
        }
    }
};
struct EpiPP {
    static constexpr bool PERM = true, AFTER_DRAIN = false;
    bf16* pp;
    __device__ __forceinline__ void operator()(const f32x4 (&acc)[2][2][4][2], const Unit& u, int wr, int wc, int fr, int fq) const {
        { const int t_ = fresh_lane(); fr = t_ & 15; fq = t_ >> 4; }
        const int row0 = u.pm * 256 + wr * 64 + fr, col0 = u.pn * 256 + wc * 32 + 8 * fq;
#pragma unroll
        for (int ai = 0; ai < 2; ++ai)
#pragma unroll
            for (int m = 0; m < 4; ++m) {
                const size_t off = (size_t)(row0 + ai * 128 + m * 16) * 1024 + col0;
#pragma unroll
                for (int bj = 0; bj < 2; ++bj) *(u32x4*)(pp + off + bj * 128) = pack8(acc[ai][bj][m][0], acc[ai][bj][m][1]);
            }
    }
};
struct EpiH3 {
    static constexpr bool PERM = true, AFTER_DRAIN = false;
    const float* rstd3; const bf16* pp; float* h; float* part; const bf16* h2b; bf16* h3b;
    __device__ __forceinline__ void operator()(const f32x4 (&acc)[2][2][4][2], const Unit& u, int wr, int wc, int fr, int fq) const {
        { const int t_ = fresh_lane(); fr = t_ & 15; fq = t_ >> 4; }
        const int row0 = u.pm * 256 + wr * 64 + fr, col0 = u.pn * 256 + wc * 32 + 8 * fq;
#pragma unroll
        for (int ai = 0; ai < 2; ++ai)
#pragma unroll
            for (int m = 0; m < 4; ++m) {
                const int r = row0 + ai * 128 + m * 16; const size_t off = (size_t)r * 1024 + col0; const float rs = rstd3[r]; float sq = 0.f;
#pragma unroll
                for (int bj = 0; bj < 2; ++bj) {
                    const size_t o = off + bj * 128; const u32x4 pw = *(const u32x4*)(pp + o);
#if ALL_FUSED
                    const u32x4 hw = *(const u32x4*)(h2b + o);
                    const f32x4 v0 = bf4_lo((u32x2){hw.x, hw.y}) + sig4(acc[ai][bj][m][0] * rs) * bf4_lo((u32x2){pw.x, pw.y});
                    const f32x4 v1 = bf4_lo((u32x2){hw.z, hw.w}) + sig4(acc[ai][bj][m][1] * rs) * bf4_lo((u32x2){pw.z, pw.w});
                    *(u32x4*)(h3b + o) = pack8(v0, v1);
#else
                    const f32x4 v0 = *(const f32x4*)(h + o) + sig4(acc[ai][bj][m][0] * rs) * bf4_lo((u32x2){pw.x, pw.y});
                    const f32x4 v1 = *(const f32x4*)(h + o + 4) + sig4(acc[ai][bj][m][1] * rs) * bf4_lo((u32x2){pw.z, pw.w});
                    *(f32x4*)(h + o) = v0; *(f32x4*)(h + o + 4) = v1;
#endif
                    sq += (v0[0] * v0[0] + v0[1] * v0[1]) + (v0[2] * v0[2] + v0[3] * v0[3]) + (v1[0] * v1[0] + v1[1] * v1[1]) + (v1[2] * v1[2] + v1[3] * v1[3]);
                }
                sq += __shfl_xor(sq, 16); sq += __shfl_xor(sq, 32);
                if (fq == 0) part[(size_t)r * 16 + u.pn * 4 + wc] = sq;
            }
    }
};
struct EpiPre {
    static constexpr bool PERM = false, AFTER_DRAIN = false;
    float* rp; float* ip;
    __device__ __forceinline__ void operator()(const f32x4 (&acc)[2][2][4][2], const Unit& u, int wr, int wc, int fr, int fq) const {
        { const int t_ = fresh_lane(); fr = t_ & 15; fq = t_ >> 4; }
#pragma unroll
        for (int n = 0; n < 2; ++n) { const int ch = u.pn * 128 + wc * 32 + 16 * n + 4 * fq;
#pragma unroll
            for (int ai = 0; ai < 2; ++ai)
#pragma unroll
                for (int m = 0; m < 4; ++m) { const int r = u.pm * 256 + ai * 128 + wr * 64 + m * 16 + fr; const size_t o = (size_t)r * 1024 + ch; *(f32x4*)(rp + o) = acc[ai][0][m][n]; *(f32x4*)(ip + o) = acc[ai][1][m][n]; } }
    }
};
struct EpiH3Final {
    static constexpr bool PERM = true, AFTER_DRAIN = false;
    const float* rstd3; const bf16* pp; const bf16* h2b; const float* fg; float* out; float* part; unsigned* cnt;
    __device__ __forceinline__ void operator()(f32x4 (&acc)[2][2][4][2], const Unit& u, int wr, int wc, int fr, int fq) const {
        { const int t_ = fresh_lane(); fr = t_ & 15; fq = t_ >> 4; }
        const int row0 = u.pm * 256 + wr * 64 + fr, col0 = u.pn * 256 + wc * 32 + 8 * fq;
#pragma unroll
        for (int ai = 0; ai < 2; ++ai)
#pragma unroll
            for (int m = 0; m < 4; ++m) {
                const int r = row0 + ai * 128 + m * 16; const size_t off = (size_t)r * 1024 + col0; const float rs = rstd3[r]; float sq = 0.f;
#pragma unroll
                for (int bj = 0; bj < 2; ++bj) {
                    const size_t o = off + bj * 128; const u32x4 pw = *(const u32x4*)(pp + o); const u32x4 hw = *(const u32x4*)(h2b + o);
                    const f32x4 v0 = bf4_lo((u32x2){hw.x, hw.y}) + sig4(acc[ai][bj][m][0] * rs) * bf4_lo((u32x2){pw.x, pw.y});
                    const f32x4 v1 = bf4_lo((u32x2){hw.z, hw.w}) + sig4(acc[ai][bj][m][1] * rs) * bf4_lo((u32x2){pw.z, pw.w});
                    acc[ai][bj][m][0] = v0; acc[ai][bj][m][1] = v1;
                    sq += (v0[0] * v0[0] + v0[1] * v0[1]) + (v0[2] * v0[2] + v0[3] * v0[3]) + (v1[0] * v1[0] + v1[1] * v1[1]) + (v1[2] * v1[2] + v1[3] * v1[3]);
                }
                sq += __shfl_xor(sq, 16); sq += __shfl_xor(sq, 32);
                if (fq == 0) __hip_atomic_store(part + (size_t)r * 16 + u.pn * 4 + wc, sq, __ATOMIC_RELAXED, __HIP_MEMORY_SCOPE_AGENT);
            }
        asm volatile("s_waitcnt vmcnt(0)" ::: "memory");
        const int lane = fq * 16 + fr;
        unsigned* c = cnt + 64 * u.pm;
        if (lane == 0) __hip_atomic_fetch_add(c, 1u, __ATOMIC_RELAXED, __HIP_MEMORY_SCOPE_AGENT);
        {
            const unsigned long long t0 = __builtin_amdgcn_s_memrealtime();
            while ((unsigned)__builtin_amdgcn_readfirstlane((int)__hip_atomic_load(c, __ATOMIC_RELAXED, __HIP_MEMORY_SCOPE_AGENT)) < 32u) {
                if (__builtin_amdgcn_s_memrealtime() - t0 > 2000000ull) break;
                __builtin_amdgcn_s_sleep(2);
            }
        }
        { const int t_ = fresh_lane(); fr = t_ & 15; fq = t_ >> 4; }
#pragma unroll
        for (int ai = 0; ai < 2; ++ai)
#pragma unroll
            for (int m = 0; m < 4; ++m) {
                const int r = u.pm * 256 + wr * 64 + fr + ai * 128 + m * 16;
                float ps = 0.f;
#pragma unroll
                for (int k = 0; k < 16; ++k) ps += __hip_atomic_load(part + (size_t)r * 16 + k, __ATOMIC_RELAXED, __HIP_MEMORY_SCOPE_AGENT);
                const float rr = 1.0f / sqrtf(ps * (1.0f / 1024.0f) + EPS);
                const int cc = u.pn * 256 + wc * 32 + 8 * fq;
#pragma unroll
                for (int bj = 0; bj < 2; ++bj) {
                    const f32x4 g0 = *(const f32x4*)(fg + cc + bj * 128), g1 = *(const f32x4*)(fg + cc + bj * 128 + 4);
                    float* op = out + (size_t)r * 1024 + cc + bj * 128;
                    *(f32x4*)op = acc[ai][bj][m][0] * rr * g0; *(f32x4*)(op + 4) = acc[ai][bj][m][1] * rr * g1;
                }
            }
    }
};
template <int CTRL> __device__ __forceinline__ float dpp_f(float oldv, float src) {
    return __builtin_bit_cast(float, __builtin_amdgcn_update_dpp(__builtin_bit_cast(int, oldv), __builtin_bit_cast(int, src), CTRL, 0xf, 0xf, false));
}
#ifndef LRU_T2
#define LRU_T2 0
#endif
struct EpiLru {
    static constexpr bool PERM = false, AFTER_DRAIN = false;
    const bf16* lin; const float* ba; const float* bx; const float* c8l; bf16* hloc; bf16* pcum; float* agg;
    template <int SH> static __device__ __forceinline__ void step(f32x4& A, f32x4& Bv, float idd) {
#pragma unroll
        for (int j = 0; j < 4; ++j) {
            const float ap = __int_as_float(__builtin_amdgcn_update_dpp(0, __float_as_int((float)A[j]), 0x110 + SH, 0xf, 0xf, true)) + idd;
            const float bp = __int_as_float(__builtin_amdgcn_update_dpp(0, __float_as_int((float)Bv[j]), 0x110 + SH, 0xf, 0xf, true));
            Bv[j] = fmaf(A[j], bp, Bv[j]); A[j] = A[j] * ap; }
    }
    __device__ __forceinline__ void operator()(f32x4 (&acc)[2][2][4][2], const Unit& u, int wr, int wc, int fr, int fq) const {
        { const int t_ = fresh_lane(); fr = t_ & 15; fq = t_ >> 4; }
        const int lane = fq * 16 + fr;
#pragma unroll
        for (int n = 0; n < 2; ++n) {
            const int ch = u.pn * 128 + wc * 32 + 16 * n + 4 * fq;
            const f32x4 bav = *(const f32x4*)(ba + ch), bxv = *(const f32x4*)(bx + ch), cv = *(const f32x4*)(c8l + ch);
#pragma unroll
            for (int ai = 0; ai < 2; ++ai)
#pragma unroll
                for (int m = 0; m < 4; ++m) {
                    const int r = u.pm * 256 + ai * 128 + wr * 64 + m * 16 + fr; const unsigned o = (unsigned)r * 1024u + (unsigned)ch;
                    const f32x4 lv = bf4_lo(*(const u32x2*)(lin + o));
#pragma unroll
                    for (int j = 0; j < 4; ++j) {
                        const float rr = sigmoidf_(acc[ai][0][m][n][j] + bav[j]), ii = sigmoidf_(acc[ai][1][m][n][j] + bxv[j]);
                        const float a = __builtin_amdgcn_exp2f(cv[j] * rr);
                        acc[ai][0][m][n][j] = a; acc[ai][1][m][n][j] = __builtin_amdgcn_sqrtf(fmaxf(1.0f - a * a, 0.f)) * (ii * lv[j]);
                    }
                    asm volatile("" : "+v"(acc[ai][0][m][n]), "+v"(acc[ai][1][m][n]));
                }
        }
#if defined(LRU_DEBUG) && LRU_DEBUG == 1
        {
            float* af = (float*)hloc; float* bf = (float*)pcum;
#pragma unroll
            for (int n = 0; n < 2; ++n) { const int ch = u.pn * 128 + wc * 32 + 16 * n + 4 * fq;
#pragma unroll
                for (int ai = 0; ai < 2; ++ai)
#pragma unroll
                    for (int m = 0; m < 4; ++m) { const int r = u.pm * 256 + ai * 128 + wr * 64 + m * 16 + fr; const size_t o = (size_t)r * 1024 + ch; *(f32x4*)(af + o) = acc[ai][0][m][n]; *(f32x4*)(bf + o) = acc[ai][1][m][n]; } }
            return;
        }
#endif
        __builtin_amdgcn_sched_barrier(0);
        const float id1 = fr < 1 ? 1.f : 0.f, id2 = fr < 2 ? 1.f : 0.f, id4 = fr < 4 ? 1.f : 0.f, id8 = fr < 8 ? 1.f : 0.f;
#pragma unroll
        for (int ai = 0; ai < 2; ++ai)
#pragma unroll
            for (int m = 0; m < 4; ++m)
#pragma unroll
                for (int n = 0; n < 2; ++n) { step<1>(acc[ai][0][m][n], acc[ai][1][m][n], id1); step<2>(acc[ai][0][m][n], acc[ai][1][m][n], id2); step<4>(acc[ai][0][m][n], acc[ai][1][m][n], id4); step<8>(acc[ai][0][m][n], acc[ai][1][m][n], id8);
                    asm volatile("" : "+v"(acc[ai][0][m][n]), "+v"(acc[ai][1][m][n])); }
        { const int t_ = fresh_lane(); fr = t_ & 15; fq = t_ >> 4; }
        const int src4 = (((fq * 16 + fr) & 48) | 15) * 4;
#pragma unroll
        for (int n = 0; n < 2; ++n) {
            const int ch = u.pn * 128 + wc * 32 + 16 * n + 4 * fq;
#pragma unroll
            for (int ai = 0; ai < 2; ++ai) {
#pragma unroll
                for (int m = 0; m < 4; ++m) {
                    f32x4& A = acc[ai][0][m][n]; f32x4& Bv = acc[ai][1][m][n];
                    if (m > 0 && !(LRU_T2)) {
#pragma unroll
                        for (int j = 0; j < 4; ++j) { const float pa = acc[ai][0][m - 1][n][j], pb = acc[ai][1][m - 1][n][j];
                            const float ac = __int_as_float(__builtin_amdgcn_ds_bpermute(src4, __float_as_int(pa))), bc = __int_as_float(__builtin_amdgcn_ds_bpermute(src4, __float_as_int(pb))); Bv[j] = fmaf(A[j], bc, Bv[j]); A[j] = A[j] * ac; }
                    }
                    const int r = u.pm * 256 + ai * 128 + wr * 64 + m * 16 + fr; const unsigned o = (unsigned)r * 1024u + (unsigned)ch;
                    u32x2 wp, wh; wp.x = cvt_pk_bf16(A[0], A[1]); wp.y = cvt_pk_bf16(A[2], A[3]); wh.x = cvt_pk_bf16(Bv[0], Bv[1]); wh.y = cvt_pk_bf16(Bv[2], Bv[3]);
                    *(u32x2*)(pcum + o) = wp; *(u32x2*)(hloc + o) = wh;
                    if (m == 3 && fr == 15) {
                        const int chunk = u.pm * 4 + ai * 2 + wr; float* ap = agg + ((size_t)chunk * 1024 + ch) * 2;
                        *(f32x4*)(ap) = (f32x4){A[0], Bv[0], A[1], Bv[1]}; *(f32x4*)(ap + 4) = (f32x4){A[2], Bv[2], A[3], Bv[3]};
                    }
                    __builtin_amdgcn_sched_barrier(0);
                }
            }
        }
    }
};

__device__ __forceinline__ void p0_transpose_item(const float* W, int ldw, const float* gain, bf16* WT, int ldt, int k_off, LAS float* scr, int kb, int nb, int lane) {
    const int k0 = 64 * kb, n0 = 32 * nb;
    const int c4 = lane & 7, kr = lane >> 3;
    f32x4 v[8];
#pragma unroll
    for (int i = 0; i < 8; ++i) v[i] = *(const f32x4*)(W + (size_t)(k0 + 8 * i + kr) * ldw + n0 + 4 * c4);
#pragma unroll
    for (int i = 0; i < 8; ++i) { f32x4 x = v[i]; if (gain) x = x * gain[k0 + 8 * i + kr]; *(LAS f32x4*)(scr + (8 * i + kr) * 36 + 4 * c4) = x; }
    LDS_WAIT(); asm volatile("" ::: "memory");
    const int c = lane & 7;
#pragma unroll
    for (int j = 0; j < 4; ++j) { const int n = (lane >> 3) + 8 * j; const LAS float* sp = scr + (8 * c) * 36 + n;
        u32x4 o; o.x = pk2(sp[0 * 36], sp[1 * 36]); o.y = pk2(sp[2 * 36], sp[3 * 36]); o.z = pk2(sp[4 * 36], sp[5 * 36]); o.w = pk2(sp[6 * 36], sp[7 * 36]);
        *(u32x4*)(WT + (size_t)(n0 + n) * ldt + k_off + k0 + 8 * c) = o; }
    LDS_WAIT(); asm volatile("" ::: "memory");
}
__device__ __forceinline__ void p0_wfold_item(LAS float* lds, const float* wq, const float* k1, const float* k2, const float* gffn, bf16* wfold, int item, int tid) {
    const int hh = item >> 4, kb = item & 15;
    LAS float* wqs = lds; LAS float* kks = lds + 64 * 132;
    const float* ksrc = (hh & 1) ? k2 : k1;
#pragma unroll
    for (int i = 0; i < 4; ++i) { const int e = tid + i * 512, r = e >> 5, c4 = e & 31; *(LAS f32x4*)(wqs + r * 132 + 4 * c4) = *(const f32x4*)(wq + (size_t)(kb * 64 + r) * 2048 + hh * 128 + 4 * c4); }
#pragma unroll
    for (int i = 0; i < 8; ++i) { const int e = tid + i * 512, r = e >> 5, c4 = e & 31; *(LAS f32x4*)(kks + r * 132 + 4 * c4) = *(const f32x4*)(ksrc + (size_t)r * 128 + 4 * c4); }
    __syncthreads();
    const int tk = tid & 15, tkey = tid >> 4;
    float acc[4][4];
#pragma unroll
    for (int i = 0; i < 4; ++i)
#pragma unroll
        for (int j = 0; j < 4; ++j) acc[i][j] = 0.f;
#pragma unroll 2
    for (int c4 = 0; c4 < 32; ++c4) {
        f32x4 a[4], b[4];
#pragma unroll
        for (int i = 0; i < 4; ++i) { a[i] = *(const LAS f32x4*)(wqs + (tk * 4 + i) * 132 + 4 * c4); b[i] = *(const LAS f32x4*)(kks + (tkey * 4 + i) * 132 + 4 * c4); }
#pragma unroll
        for (int i = 0; i < 4; ++i)
#pragma unroll
            for (int j = 0; j < 4; ++j) acc[i][j] += (a[i][0] * b[j][0] + a[i][1] * b[j][1]) + (a[i][2] * b[j][2] + a[i][3] * b[j][3]);
    }
    const int kg = kb * 64 + tk * 4; const f32x4 gv = *(const f32x4*)(gffn + kg);
#pragma unroll
    for (int j = 0; j < 4; ++j) { u32x2 w; w.x = pk2(acc[0][j] * gv[0], acc[1][j] * gv[1]); w.y = pk2(acc[2][j] * gv[2], acc[3][j] * gv[3]);
        *(u32x2*)(wfold + (size_t)(hh * 128 + tkey * 4 + j) * 1024 + kg) = w; }
    __syncthreads();
}

struct In { const float* p[25]; };
enum { I_X = 0, I_P, I_GMIX, I_WIN, I_SINK, I_CONVW, I_CONVB, I_WA, I_BA, I_WX, I_BX, I_LAM, I_WUA, I_WUL, I_WO, I_GFFN, I_WQ, I_K1, I_K2, I_U, I_V, I_GPLE, I_WGATE, I_WPROJ, I_FG };

__device__ __forceinline__ void p0_prologue(const In& in, unsigned char* ws, LAS unsigned char* lds, int vcu, int G, int wave, int tid) {
    const int lane = tid & 63;
    LAS float* scr = (LAS float*)(lds + wave * 16384);
    const int gw = vcu * NWAVES + wave, NGW = G * NWAVES;
    constexpr int I_IN = 16 * 152, I_UA = 8 * 32, I_SQ = 16 * 32, I_PJ = 4 * 32, I_AX = 128;
    constexpr int NITEMS = I_IN + I_UA + 3 * I_SQ + I_PJ + I_AX;
    for (int it = gw; it < NITEMS; it += NGW) {
        int r = it;
        if (r < I_IN) { p0_transpose_item(in.p[I_WIN], INW, in.p[I_GMIX], (bf16*)(ws + WS_WIN), 1024, 0, scr, r / 152, r % 152, lane); continue; } r -= I_IN;
        if (r < I_UA) { p0_transpose_item(in.p[I_WUA], 1024, nullptr, (bf16*)(ws + WS_WUA), 512, 0, scr, r / 32, r % 32, lane); continue; } r -= I_UA;
        if (r < I_SQ) { p0_transpose_item(in.p[I_WUL], 1024, nullptr, (bf16*)(ws + WS_WUL), 1024, 0, scr, r / 32, r % 32, lane); continue; } r -= I_SQ;
        if (r < I_SQ) { p0_transpose_item(in.p[I_WO], 1024, nullptr, (bf16*)(ws + WS_WO), 1024, 0, scr, r / 32, r % 32, lane); continue; } r -= I_SQ;
        if (r < I_SQ) { p0_transpose_item(in.p[I_WGATE], 1024, in.p[I_GPLE], (bf16*)(ws + WS_WG), 1024, 0, scr, r / 32, r % 32, lane); continue; } r -= I_SQ;
        if (r < I_PJ) { p0_transpose_item(in.p[I_WPROJ], 1024, nullptr, (bf16*)(ws + WS_WPROJ), 256, 0, scr, r / 32, r % 32, lane); continue; } r -= I_PJ;
        { const int blk = r >> 4, which = (r >> 3) & 1, sub = r & 7;

#if LRU_PADDED
#if LRU_PADDED == 2
          p0_transpose_item(in.p[which ? I_WX : I_WA] + (size_t)blk * 16384, 128, nullptr, (bf16*)(ws + WS_WAX) + (size_t)blk * 32768 + which * 128 * 128, 128, 0, scr, sub >> 2, sub & 3, lane); }
#else
          p0_transpose_item(in.p[which ? I_WX : I_WA] + (size_t)blk * 16384, 128, nullptr, (bf16*)(ws + WS_WAX) + (size_t)blk * 65536 + which * 128 * 256, 256, (blk & 1) * 128, scr, sub >> 2, sub & 3, lane); }
#endif
#else
          p0_transpose_item(in.p[which ? I_WX : I_WA] + (size_t)blk * 16384, 128, nullptr, (bf16*)(ws + WS_WAXD) + (size_t)(blk * 256 + which * 128) * 1024, 1024, blk * 128, scr, sub >> 2, sub & 3, lane); }
#endif
    }
#if LRU_PADDED == 2
#elif LRU_PADDED
    for (int i = vcu * 512 + tid; i < 8 * 256 * 16; i += G * 512) { const int c16 = i & 15, n = (i >> 4) & 255, blk = i >> 12;
        *(u32x4*)((bf16*)(ws + WS_WAX) + (size_t)blk * 65536 + n * 256 + ((blk & 1) ^ 1) * 128 + c16 * 8) = (u32x4){0u, 0u, 0u, 0u}; }
#else
    for (int i = vcu * 512 + tid; i < 2048 * 128; i += G * 512) { const int c16 = i & 127, row = i >> 7, blk = row >> 8;
        if ((c16 >> 4) != blk) *(u32x4*)((bf16*)(ws + WS_WAXD) + (size_t)row * 1024 + c16 * 8) = (u32x4){0u, 0u, 0u, 0u}; }
#endif
    for (int m = gw; m < T_; m += 2 * NGW) {
        const int m2 = m + NGW;
        const f32x4* xa = (const f32x4*)(in.p[I_X] + (size_t)m * 1024) + lane; const f32x4* xb = (const f32x4*)(in.p[I_X] + (size_t)(m2 < T_ ? m2 : m) * 1024) + lane;
        f32x4 va[4], vb[4]; float sa = 0.f, sb = 0.f;
#pragma unroll
        for (int j = 0; j < 4; ++j) { va[j] = xa[64 * j]; vb[j] = xb[64 * j]; }
#pragma unroll
        for (int j = 0; j < 4; ++j) { sa += (va[j][0] * va[j][0] + va[j][1] * va[j][1]) + (va[j][2] * va[j][2] + va[j][3] * va[j][3]); sb += (vb[j][0] * vb[j][0] + vb[j][1] * vb[j][1]) + (vb[j][2] * vb[j][2] + vb[j][3] * vb[j][3]); }
#pragma unroll
        for (int o = 1; o < 64; o <<= 1) { sa += __shfl_xor(sa, o); sb += __shfl_xor(sb, o); }
        u32x2* oa = (u32x2*)((bf16*)(ws + WS_R0) + (size_t)m * 1024) + lane;
#pragma unroll
        for (int j = 0; j < 4; ++j) { u32x2 w; w.x = pk2(va[j][0], va[j][1]); w.y = pk2(va[j][2], va[j][3]); oa[64 * j] = w; }
        if (lane == 0) ((float*)(ws + WS_RSTD1))[m] = 1.0f / sqrtf(sa * (1.0f / 1024.0f) + EPS);
        if (m2 < T_) {
            u32x2* ob = (u32x2*)((bf16*)(ws + WS_R0) + (size_t)m2 * 1024) + lane;
#pragma unroll
            for (int j = 0; j < 4; ++j) { u32x2 w; w.x = pk2(vb[j][0], vb[j][1]); w.y = pk2(vb[j][2], vb[j][3]); ob[64 * j] = w; }
            if (lane == 0) ((float*)(ws + WS_RSTD1))[m2] = 1.0f / sqrtf(sb * (1.0f / 1024.0f) + EPS);
        }
    }
    for (int m = gw; m < T_; m += 4 * NGW) {
        f32x4 v[4];
#pragma unroll
        for (int q = 0; q < 4; ++q) { const int mq = m + q * NGW; v[q] = ((const f32x4*)(in.p[I_P] + (size_t)(mq < T_ ? mq : m) * 256))[lane]; }
#pragma unroll
        for (int q = 0; q < 4; ++q) { const int mq = m + q * NGW; if (mq < T_) { u32x2 w; w.x = pk2(v[q][0], v[q][1]); w.y = pk2(v[q][2], v[q][3]); ((u32x2*)((bf16*)(ws + WS_PB) + (size_t)mq * 256))[lane] = w; } }
    }
    if (vcu == 0) for (int c = tid; c < 1024; c += 512) ((float*)(ws + WS_C8))[c] = -8.0f * log1pf(expf(-in.p[I_LAM][c])) * LOG2E;
    __syncthreads();
    for (int it = vcu; it < 256; it += G) p0_wfold_item((LAS float*)lds, in.p[I_WQ], in.p[I_K1], in.p[I_K2], in.p[I_GFFN], (bf16*)(ws + WS_WFOLD), it, tid);
}

constexpr int AT_KSTR = 72, AT_VSTR = 260, AT_V_OFF = 256 * AT_KSTR * 2;
__device__ __forceinline__ int crow(int r, int hi) { return (r & 3) + 8 * (r >> 2) + 4 * hi; }
__device__ __forceinline__ void attn_item(LAS unsigned char* lds, const bf16* qkv, const float* sink, bf16* att, int item, int wave, int tid) {
    const int lane = tid & 63;
    const int g = item & 1, n = (item >> 1) & 15, b = item >> 5;
    const int t0 = b * S_ + n * 128;
    LAS bf16* Ks = (LAS bf16*)lds; LAS bf16* Vt = (LAS bf16*)(lds + AT_V_OFF);
#pragma unroll
    for (int i = 0; i < 4; ++i) {
        const int idx = tid + i * 512, row = idx >> 3, ch = idx & 7; const int tk = t0 - 128 + row;
        u32x4 kv = (u32x4){0u, 0u, 0u, 0u}, vv = (u32x4){0u, 0u, 0u, 0u};
        if (n > 0 || row >= 128) { const bf16* src = qkv + (size_t)tk * 768 + 512 + g * 64 + ch * 8; kv = *(const u32x4*)src; vv = *(const u32x4*)(src + 128); }
        *(LAS u32x4*)(Ks + row * AT_KSTR + ch * 8) = kv;
#pragma unroll
        for (int c = 0; c < 8; ++c) Vt[(ch * 8 + c) * AT_VSTR + row] = (bf16)(vv[c >> 1] >> (16 * (c & 1)));
    }
    __syncthreads();
    const int hr = wave >> 1, qh = wave & 1, head = g * 4 + hr;
    const float slope2 = exp2f(-(float)(head + 1)) * LOG2E, sink2 = sink[head] * LOG2E;
    const int q = lane & 31, hi = lane >> 5;
#pragma unroll 1
    for (int ps = 0; ps < 2; ++ps) {
        const int i0 = 64 * qh + 32 * ps, kb0 = i0;
        const bf16* qp = qkv + (size_t)(t0 + i0 + q) * 768 + head * 64 + 8 * hi;
        bf16x8 qf[4];
#pragma unroll
        for (int s = 0; s < 4; ++s) qf[s] = *(const bf16x8*)(qp + 16 * s);
        f32x16 oT[2];
#pragma unroll
        for (int dt = 0; dt < 2; ++dt)
#pragma unroll
            for (int r = 0; r < 16; ++r) oT[dt][r] = 0.f;
        float mrun = sink2, l = 0.f;
#pragma unroll 1
        for (int kt = 0; kt < 5; ++kt) {
            const int kbase = kb0 + 32 * kt;
            f32x16 sT;
#pragma unroll
            for (int r = 0; r < 16; ++r) sT[r] = 0.f;
#pragma unroll
            for (int s = 0; s < 4; ++s) { const bf16x8 kf = *(const LAS bf16x8*)(Ks + (kbase + q) * AT_KSTR + 16 * s + 8 * hi); sT = __builtin_amdgcn_mfma_f32_32x32x16_bf16(kf, qf[s], sT, 0, 0, 0); }
            float tm = -1.0e30f;
#pragma unroll
            for (int r = 0; r < 16; ++r) {
                const int kj = kbase + crow(r, hi); const int dist = i0 + q + 128 - kj;
                const bool valid = (dist >= 0) && (dist < 128) && (n > 0 || kj >= 128);
                const float v = valid ? (sT[r] * (0.125f * LOG2E) - slope2 * (float)dist) : -1.0e30f;
                sT[r] = v; tm = fmaxf(tm, v);
            }
            tm = fmaxf(tm, __shfl_xor(tm, 32));
            const float mnew = fmaxf(mrun, tm), alpha = __builtin_amdgcn_exp2f(mrun - mnew);
            mrun = mnew;
            float ls = 0.f;
#pragma unroll
            for (int r = 0; r < 16; ++r) { const float p = __builtin_amdgcn_exp2f(sT[r] - mnew); sT[r] = p; ls += p; }
            l = l * alpha + ls;
#pragma unroll
            for (int dt = 0; dt < 2; ++dt)
#pragma unroll
                for (int r = 0; r < 16; ++r) oT[dt][r] *= alpha;
#pragma unroll
            for (int s = 0; s < 2; ++s) {
                u32x4 pw; pw.x = cvt_pk_bf16(sT[8 * s + 0], sT[8 * s + 1]); pw.y = cvt_pk_bf16(sT[8 * s + 2], sT[8 * s + 3]);
                pw.z = cvt_pk_bf16(sT[8 * s + 4], sT[8 * s + 5]); pw.w = cvt_pk_bf16(sT[8 * s + 6], sT[8 * s + 7]);
                const bf16x8 pf = __builtin_bit_cast(bf16x8, pw);
#pragma unroll
                for (int dt = 0; dt < 2; ++dt) {
                    const LAS bf16* vp = Vt + (32 * dt + q) * AT_VSTR + kbase + 16 * s + 4 * hi;
                    const u32x2 va = *(const LAS u32x2*)vp, vb = *(const LAS u32x2*)(vp + 8);
                    const bf16x8 af = __builtin_bit_cast(bf16x8, (u32x4){va.x, va.y, vb.x, vb.y});
                    oT[dt] = __builtin_amdgcn_mfma_f32_32x32x16_bf16(af, pf, oT[dt], 0, 0, 0);
                }
            }
        }
        l += __shfl_xor(l, 32);
        l += __builtin_amdgcn_exp2f(sink2 - mrun);
        const float inv = 1.0f / l;
        bf16* op = att + (size_t)(t0 + i0 + q) * 512 + head * 64 + 4 * hi;
#pragma unroll
        for (int dt = 0; dt < 2; ++dt)
#pragma unroll
            for (int rg = 0; rg < 4; ++rg) { u32x2 w; w.x = cvt_pk_bf16(oT[dt][4 * rg] * inv, oT[dt][4 * rg + 1] * inv); w.y = cvt_pk_bf16(oT[dt][4 * rg + 2] * inv, oT[dt][4 * rg + 3] * inv);
                *(u32x2*)(op + 32 * dt + 8 * rg) = w; }
    }
    __syncthreads();
}
__device__ __forceinline__ void conv_items(const bf16* lx, const float* cw, const float* cb, bf16* lin, int vcu, int G, int tid) {
    for (int i = vcu * 512 + tid; i < T_ * 128; i += 2 * G * 512) {
        const int c8 = (i & 127) * 8;
        const int ta = i >> 7, i2 = i + G * 512; const bool hasb = i2 < T_ * 128; const int tb = hasb ? (i2 >> 7) : ta;
        const int tsa = ta & (S_ - 1), tsb = tb & (S_ - 1);
        u32x4 wa[4], wb[4];
#pragma unroll
        for (int tap = 0; tap < 4; ++tap) {
            wa[tap] = (tsa - 3 + tap >= 0) ? *(const u32x4*)(lx + (size_t)(ta - 3 + tap) * 1024 + c8) : (u32x4){0u, 0u, 0u, 0u};
            wb[tap] = (tsb - 3 + tap >= 0) ? *(const u32x4*)(lx + (size_t)(tb - 3 + tap) * 1024 + c8) : (u32x4){0u, 0u, 0u, 0u};
        }
        f32x4 a0 = *(const f32x4*)(cb + c8), a1 = *(const f32x4*)(cb + c8 + 4), b0 = a0, b1 = a1;
#pragma unroll
        for (int tap = 0; tap < 4; ++tap) {
            const f32x4 w0 = *(const f32x4*)(cw + tap * 1024 + c8), w1 = *(const f32x4*)(cw + tap * 1024 + c8 + 4);
            a0 += bf4_lo((u32x2){wa[tap].x, wa[tap].y}) * w0; a1 += bf4_lo((u32x2){wa[tap].z, wa[tap].w}) * w1;
            b0 += bf4_lo((u32x2){wb[tap].x, wb[tap].y}) * w0; b1 += bf4_lo((u32x2){wb[tap].z, wb[tap].w}) * w1;
        }
        *(u32x4*)(lin + (size_t)ta * 1024 + c8) = pack8(a0, a1);
        if (hasb) *(u32x4*)(lin + (size_t)tb * 1024 + c8) = pack8(b0, b1);
    }
}
__device__ __forceinline__ void scan_finish(const bf16* hloc, const bf16* pcum, const float* agg, const bf16* gl, bf16* rec, int vcu, int G, int tid) {
    const int c8 = (tid & 127) * 8, rg = tid >> 7;
    for (int chunk = vcu; chunk < T_ / 64; chunk += G) {
        const int ci = chunk & 31, cb = chunk - ci;
        float carry[8];
#pragma unroll
        for (int j = 0; j < 8; ++j) carry[j] = 0.f;
#pragma unroll 4
        for (int cc = 0; cc < ci; ++cc) {
            const f32x4* ap = (const f32x4*)(agg + ((size_t)(cb + cc) * 1024 + c8) * 2);
#pragma unroll
            for (int q = 0; q < 4; ++q) { const f32x4 v = ap[q]; carry[2 * q] = fmaf(v[0], carry[2 * q], v[1]); carry[2 * q + 1] = fmaf(v[2], carry[2 * q + 1], v[3]); }
        }
#pragma unroll 8
        for (int rr = 0; rr < 16; ++rr) {
            const size_t o = (size_t)(chunk * 64 + rg + 4 * rr) * 1024 + c8;
            const u32x4 hw = *(const u32x4*)(hloc + o), pw = *(const u32x4*)(pcum + o), gw = *(const u32x4*)(gl + o);
            const f32x4 h0 = bf4_lo((u32x2){hw.x, hw.y}), h1 = bf4_lo((u32x2){hw.z, hw.w}), p0 = bf4_lo((u32x2){pw.x, pw.y}), p1 = bf4_lo((u32x2){pw.z, pw.w});
            const f32x4 g0 = bf4_lo((u32x2){gw.x, gw.y}), g1 = bf4_lo((u32x2){gw.z, gw.w});
            f32x4 r0, r1;
#pragma unroll
            for (int j = 0; j < 4; ++j) { r0[j] = fmaf(p0[j], carry[j], h0[j]) * g0[j]; r1[j] = fmaf(p1[j], carry[4 + j], h1[j]) * g1[j]; }
            *(u32x4*)(rec + o) = pack8(r0, r1);
        }
    }
}
__device__ __forceinline__ void final_rows(float* h, const bf16* h3b, const float* part, const float* fg, int gw, int NGW, int lane, float tscale) {
    f32x4 g[4];
#pragma unroll
    for (int j = 0; j < 4; ++j) g[j] = ((const f32x4*)fg)[lane + 64 * j];
    for (int r0 = gw; r0 < T_; r0 += 2 * NGW) {
        const int r1 = (r0 + NGW < T_) ? r0 + NGW : r0;
        float pa = (lane < 16) ? part[(size_t)r0 * 16 + lane] : 0.f, pb = (lane < 16) ? part[(size_t)r1 * 16 + lane] : 0.f;
#if ALL_FUSED
        const u32x2* ba = (const u32x2*)(h3b + (size_t)r0 * 1024) + lane; const u32x2* bb = (const u32x2*)(h3b + (size_t)r1 * 1024) + lane;
        u32x2 wa[4], wb[4];
#pragma unroll
        for (int j = 0; j < 4; ++j) { wa[j] = ba[64 * j]; wb[j] = bb[64 * j]; }
#endif
#pragma unroll
        for (int o = 1; o < 64; o <<= 1) { pa += __shfl_xor(pa, o); pb += __shfl_xor(pb, o); }
        const float ra = tscale / sqrtf(pa * (1.0f / 1024.0f) + EPS), rb = tscale / sqrtf(pb * (1.0f / 1024.0f) + EPS);
        f32x4* ha = (f32x4*)(h + (size_t)r0 * 1024) + lane; f32x4* hb = (f32x4*)(h + (size_t)r1 * 1024) + lane;
#if ALL_FUSED
#pragma unroll
        for (int j = 0; j < 4; ++j) ha[64 * j] = bf4_lo(wa[j]) * ra * g[j];
        if (r1 != r0) {
#pragma unroll
            for (int j = 0; j < 4; ++j) hb[64 * j] = bf4_lo(wb[j]) * rb * g[j];
        }
#else
#pragma unroll
        for (int j = 0; j < 4; ++j) ha[64 * j] = ha[64 * j] * ra * g[j];
        if (r1 != r0) {
#pragma unroll
            for (int j = 0; j < 4; ++j) hb[64 * j] = hb[64 * j] * rb * g[j];
        }
#endif
    }
}

constexpr int N_PHASES = 16;
struct Args { const float* in[25]; float* out; unsigned char* ws; int ph_lo, ph_hi, li, pad; };
__global__ void __launch_bounds__(NWAVES * 64, 2) fused_fwd(Args args) {
    extern __shared__ __attribute__((aligned(16))) unsigned char lds_raw[];
    LAS unsigned char* lds = (LAS unsigned char*)lds_raw;
    volatile LAS unsigned* MISC = (volatile LAS unsigned*)(lds + LDSCTL_OFF);
    const int wave = __builtin_amdgcn_readfirstlane((int)threadIdx.x >> 6);
#define FRESH_TID() (wave * 64 + fresh_lane())
#define FRESH_LANE() fresh_lane()
    const int G = gridDim.x; const int bx = blockIdx.x; const int vcu = (G % 8 == 0) ? (bx % 8) * (G / 8) + bx / 8 : bx;
    unsigned char* ws = args.ws; float* out = args.out;
    In in;
#pragma unroll
    for (int i = 0; i < 25; ++i) in.p[i] = args.in[i];
    for (int u = FRESH_TID(); u < (LDS_BYTES - LDSCTL_OFF) / 4; u += NWAVES * 64) ((LAS unsigned*)(lds + LDSCTL_OFF))[u] = 0u;
    __syncthreads();
    (void)xcd_barrier_post((unsigned*)(ws + WS_CTL) + CW_BAR + args.li * XCD_BAR_WORDS, MISC + 8);
    const int lo = args.ph_lo, hi = args.ph_hi;
    const int gw = vcu * NWAVES + wave, NGW = G * NWAVES;
#ifndef PH_DISABLE
#define PH_DISABLE 0
#endif
#if ALL_FUSED
#define IN(k) (!((PH_DISABLE >> (k)) & 1))
#else
#define IN(k) (lo <= (k) && (k) < hi && !((PH_DISABLE >> (k)) & 1))
#endif
#ifdef TIMING_A
#define STAMP(i) do { if (bx == 0 && FRESH_TID() == 0) __hip_atomic_store((unsigned long long*)(ws + WS_CTL + 512) + (i), __builtin_amdgcn_s_memrealtime(), __ATOMIC_RELAXED, __HIP_MEMORY_SCOPE_AGENT); } while (0)
#else
#define STAMP(i) do { } while (0)
#endif
#define SEAM(k) do { if (IN(k) && IN((k) + 1)) { XcdBarrier b_; b_.bar = (unsigned*)(args.ws + WS_CTL) + CW_BAR + args.li * XCD_BAR_WORDS; b_.x = xb_xcc_id(); b_.st = (volatile LAS unsigned*)(lds + LDSCTL_OFF) + 8;     \
        xcd_barrier(b_); STAMP((k) + 1); } } while (0)
#if ALL_FUSED
#define PP_PTR ((const bf16*)((const unsigned char*)out + 32 * MiB))
#define MP_PTR out
#else
#define PP_PTR ((const bf16*)(ws + WS_PP))
#define MP_PTR ((float*)(ws + WS_MP))
#endif
#define GEMM_PHASE(EPI, Aptr, Bptr, Kdim, LDA, M_, N_, SH, STR, ...) do { \
        pg8::Gemm g{(const pg8::bf16_t*)(Aptr), (const pg8::bf16_t*)(Bptr), Kdim, LDA, SH, STR}; pg8::StaticOrder S; S.init(M_, N_, G, (int)blockIdx.x); \
        EPI E{__VA_ARGS__}; pg8::gemm_phase<EPI, pg8::StaticOrder, true, true>(lds, g, S, E, wave); } while (0)

    STAMP(0);
    if (IN(0)) { p0_prologue(in, ws, lds, vcu, G, wave, FRESH_TID()); } SEAM(0);
    if (IN(1)) { GEMM_PHASE(EpiProj, ws + WS_R0, ws + WS_WIN, 1024, 1024, T_, INW, 0, 0, (const float*)(ws + WS_RSTD1), ws); } SEAM(1);
    if (IN(2)) {
        for (int it = bx; it < 256; it += G) attn_item(lds, (const bf16*)(ws + WS_QKV), in.p[I_SINK], (bf16*)(ws + WS_ATT), it, wave, FRESH_TID());
        conv_items((const bf16*)(ws + WS_LX), in.p[I_CONVW], in.p[I_CONVB], (bf16*)(ws + WS_R0), vcu, G, FRESH_TID());
    } SEAM(2);
#if LRU_PADDED == 2
    if (IN(3)) { GEMM_PHASE(EpiLru, ws + WS_R0, ws + WS_WAX, 128, 1024, T_, 2048, 0, 128,
#elif LRU_PADDED
    if (IN(3)) { GEMM_PHASE(EpiLru, ws + WS_R0, ws + WS_WAX, 256, 1024, T_, 2048, 1, 256,
#else
    if (IN(3)) { GEMM_PHASE(EpiLru, ws + WS_R0, ws + WS_WAXD, 1024, 1024, T_, 2048, 0, 0,
#endif
        (const bf16*)(ws + WS_R0), in.p[I_BA], in.p[I_BX], (const float*)(ws + WS_C8), (bf16*)(ws + WS_HLOC), (bf16*)(ws + WS_PCUM), (float*)(ws + WS_AGG)); }
    SEAM(3);
    if (IN(4)) { scan_finish((const bf16*)(ws + WS_HLOC), (const bf16*)(ws + WS_PCUM), (const float*)(ws + WS_AGG), (const bf16*)(ws + WS_GL), (bf16*)(ws + WS_R0), vcu, G, FRESH_TID()); }
#if !ALL_FUSED
    SEAM(4);
#endif
    if (IN(5)) { GEMM_PHASE(EpiMP, ws + WS_ATT, ws + WS_WUA, 512, 512, T_, 1024, 0, 0, (const bf16*)(ws + WS_SGA), MP_PTR); }
#if ALL_FUSED
    if (IN(13)) { pg8::Gemm g{(const pg8::bf16_t*)(ws + WS_PB), (const pg8::bf16_t*)(ws + WS_WPROJ), 256, 256, 0, 0}; pg8::StaticOrder S;
        if (G >= 256) S.init(T_, 1024, G - 128, (int)blockIdx.x >= 128 ? (int)blockIdx.x - 128 : (1 << 30)); else S.init(T_, 1024, G, (int)blockIdx.x);
        EpiPP E{(bf16*)((unsigned char*)out + 32 * MiB)}; pg8::gemm_phase<EpiPP, pg8::StaticOrder, true, true>(lds, g, S, E, wave); }
#endif
    SEAM(5);
    if (IN(6)) { GEMM_PHASE(EpiMerged, ws + WS_R0, ws + WS_WUL, 1024, 1024, T_, 1024, 0, 0, (const bf16*)(ws + WS_SGL), (const float*)MP_PTR, (bf16*)(ws + WS_MERGED)); } SEAM(6);
    if (IN(7)) { GEMM_PHASE(EpiH1, ws + WS_MERGED, ws + WS_WO, 1024, 1024, T_, 1024, 0, 0, in.p[I_X], out, (bf16*)(ws + WS_R0), (float*)(ws + WS_PART2)); }
    SEAM(7);
#define PEER_HALF(half) do { \
        if (IN(8 + 2 * (half))) { GEMM_PHASE(EpiScore, ws + WS_R0, ws + WS_WFOLD + (size_t)(half) * 1024 * 1024 * 2, 1024, 1024, T_, 1024, 0, 0, (const float*)(ws + WS_PART2), (float*)(ws + WS_SC)); } SEAM(8 + 2 * (half)); \
        if (IN(9 + 2 * (half))) { \
            for (int it = vcu; it < T_ / TK_TOK; it += G) topk_item((LAS float*)lds, (const float*)(ws + WS_SC), it, (half) * 4, (int*)(ws + WS_SELI), (float*)(ws + WS_SELG), FRESH_TID()); \
            if ((half) == 0) uv_convert(in.p[I_U], in.p[I_V], in.p[I_GFFN], ws + WS_U16, ws + WS_U16 + 16 * MiB, (float*)(ws + WS_USCALE), (float*)(ws + WS_USCALE) + 16384, gw, NGW, FRESH_LANE()); \
        } SEAM(9 + 2 * (half)); } while (0)
#if ALL_FUSED
    if (IN(8)) {
        for (int kk = 0; kk < 2; ++kk) { pg8::Gemm g{(const pg8::bf16_t*)(ws + WS_R0), (const pg8::bf16_t*)(ws + WS_WFOLD), 1024, 1024, 0, 0}; OneUnit S; S.S.init(T_, 2048, G, (int)blockIdx.x); S.k = kk;
            EpiTopk E{(const float*)(ws + WS_PART2), (int*)(ws + WS_SELI), (float*)(ws + WS_SELG), in.p[I_U], in.p[I_V], in.p[I_GFFN], ws + WS_U16, ws + WS_U16 + 16 * MiB, (float*)(ws + WS_USCALE), (float*)(ws + WS_USCALE) + 16384,
                      vcu * 16 + kk * 8, (2 * G == (T_ / 256) * 8) ? 16 * G : 0};
            pg8::gemm_phase<EpiTopk, OneUnit, false, true>(lds, g, S, E, wave); }
        if (2 * G != (T_ / 256) * 8) uv_convert(in.p[I_U], in.p[I_V], in.p[I_GFFN], ws + WS_U16, ws + WS_U16 + 16 * MiB, (float*)(ws + WS_USCALE), (float*)(ws + WS_USCALE) + 16384, gw, NGW, FRESH_LANE());
    } SEAM(11);
#else
    PEER_HALF(0);
    PEER_HALF(1);
#endif
    if (IN(12)) {
#ifdef PROBE_MODE
        for (int tok0 = vcu * 64; tok0 < T_; tok0 += G * 64)
#if GATHER_ROWS == 3
            gather_wg_mixed<PROBE_MODE>(tok0, wave, FRESH_LANE(), lds, ws + WS_U16, ws + WS_U16 + 16 * MiB, (const float*)(ws + WS_USCALE), (const float*)(ws + WS_USCALE) + 16384, (const int*)(ws + WS_SELI), (const float*)(ws + WS_SELG), (const float*)(ws + WS_PART2), (const bf16*)(ws + WS_R0), (bf16*)(ws + WS_H2B), (float*)(ws + WS_RSTD3), (float*)(ws + WS_SC));
#elif GATHER_ROWS == 1
            gather_wg_rows<PROBE_MODE>(tok0, wave, FRESH_LANE(), lds, ws + WS_U16, ws + WS_U16 + 16 * MiB, (const float*)(ws + WS_USCALE), (const float*)(ws + WS_USCALE) + 16384, (const int*)(ws + WS_SELI), (const float*)(ws + WS_SELG), (const float*)(ws + WS_PART2), (const bf16*)(ws + WS_R0), (bf16*)(ws + WS_H2B), (float*)(ws + WS_RSTD3), (float*)(ws + WS_SC));
#else
            gather_wg_sliced<PROBE_MODE>(tok0, wave, FRESH_LANE(), lds, ws + WS_U16, ws + WS_U16 + 16 * MiB, (const float*)(ws + WS_USCALE), (const float*)(ws + WS_USCALE) + 16384, (const int*)(ws + WS_SELI), (const float*)(ws + WS_SELG), (const float*)(ws + WS_PART2), out, (const bf16*)(ws + WS_R0), (bf16*)(ws + WS_H2B), (float*)(ws + WS_RSTD3), (float*)(ws + WS_SC));
#endif
        { XcdBarrier b_; b_.bar = (unsigned*)(args.ws + WS_CTL) + CW_BAR + args.li * XCD_BAR_WORDS; b_.x = xb_xcc_id(); b_.st = (volatile LAS unsigned*)(lds + LDSCTL_OFF) + 8; xcd_barrier(b_); STAMP(16); }
#endif
        for (int tok0 = vcu * 64; tok0 < T_; tok0 += G * 64)
#if GATHER_ROWS == 3
            gather_wg_mixed<0>(tok0, wave, FRESH_LANE(), lds, ws + WS_U16, ws + WS_U16 + 16 * MiB, (const float*)(ws + WS_USCALE), (const float*)(ws + WS_USCALE) + 16384, (const int*)(ws + WS_SELI), (const float*)(ws + WS_SELG), (const float*)(ws + WS_PART2), (const bf16*)(ws + WS_R0), (bf16*)(ws + WS_H2B), (float*)(ws + WS_RSTD3), nullptr);
#elif GATHER_ROWS == 1
            gather_wg_rows<0>(tok0, wave, FRESH_LANE(), lds, ws + WS_U16, ws + WS_U16 + 16 * MiB, (const float*)(ws + WS_USCALE), (const float*)(ws + WS_USCALE) + 16384, (const int*)(ws + WS_SELI), (const float*)(ws + WS_SELG), (const float*)(ws + WS_PART2), (const bf16*)(ws + WS_R0), (bf16*)(ws + WS_H2B), (float*)(ws + WS_RSTD3), nullptr);
#else
            gather_wg_sliced<0>(tok0, wave, FRESH_LANE(), lds, ws + WS_U16, ws + WS_U16 + 16 * MiB, (const float*)(ws + WS_USCALE), (const float*)(ws + WS_USCALE) + 16384, (const int*)(ws + WS_SELI), (const float*)(ws + WS_SELG), (const float*)(ws + WS_PART2), out, (const bf16*)(ws + WS_R0), (bf16*)(ws + WS_H2B), (float*)(ws + WS_RSTD3), nullptr);
#endif
    } SEAM(12);
#if !ALL_FUSED
    if (IN(13)) { GEMM_PHASE(EpiPP, ws + WS_PB, ws + WS_WPROJ, 256, 256, T_, 1024, 0, 0, (bf16*)(ws + WS_PP)); } SEAM(13);
#endif
#if ALL_FUSED && FUSE_FINAL
    if (IN(14)) { GEMM_PHASE(EpiH3Final, ws + WS_H2B, ws + WS_WG, 1024, 1024, T_, 1024, 0, 0, (const float*)(ws + WS_RSTD3), PP_PTR, (const bf16*)(ws + WS_H2B), in.p[I_FG], out, (float*)(ws + WS_PART4), (unsigned*)(ws + WS_CTL) + 65536); }
#else
    if (IN(14)) { GEMM_PHASE(EpiH3, ws + WS_H2B, ws + WS_WG, 1024, 1024, T_, 1024, 0, 0, (const float*)(ws + WS_RSTD3), PP_PTR, out, (float*)(ws + WS_PART4), (const bf16*)(ws + WS_H2B), (bf16*)(ws + WS_R0)); } SEAM(14);
#ifdef TIMING_A
    float tscale = 1.0f;
    { const unsigned long long ta = __hip_atomic_load((unsigned long long*)(ws + WS_CTL + 512) + TIMING_A, __ATOMIC_RELAXED, __HIP_MEMORY_SCOPE_AGENT), tb = __hip_atomic_load((unsigned long long*)(ws + WS_CTL + 512) + TIMING_B, __ATOMIC_RELAXED, __HIP_MEMORY_SCOPE_AGENT);
      tscale = 1.0f + (float)(tb - ta) * 0.01f * (float)(TIMING_K); }
    if (IN(15)) { final_rows(out, (const bf16*)(ws + WS_R0), (const float*)(ws + WS_PART4), in.p[I_FG], gw, NGW, FRESH_LANE(), tscale); }
#else
    if (IN(15)) { final_rows(out, (const bf16*)(ws + WS_R0), (const float*)(ws + WS_PART4), in.p[I_FG], gw, NGW, FRESH_LANE(), 1.0f); }
#endif
#endif
#undef IN
#undef SEAM
#undef GEMM_PHASE
}
static const int GRP_LO[11] = {0, 2, 3, 5, 6, 7, 8, 12, 13, 14, 15};
static const int GRP_HI[11] = {2, 3, 5, 6, 7, 8, 12, 13, 14, 15, 16};

static void naive_group(int grp, void* const* d_in, float* out, unsigned char* ws, hipStream_t st) {
    const float* x = (const float*)d_in[0]; const float* p = (const float*)d_in[1]; const float* g_mix = (const float*)d_in[2]; const float* w_in = (const float*)d_in[3];
    const float* sink = (const float*)d_in[4]; const float* conv_w = (const float*)d_in[5]; const float* conv_b = (const float*)d_in[6];
    const float* wa = (const float*)d_in[7]; const float* ba = (const float*)d_in[8]; const float* wx = (const float*)d_in[9]; const float* bx = (const float*)d_in[10]; const float* lam = (const float*)d_in[11];
    const float* w_ua = (const float*)d_in[12]; const float* w_ul = (const float*)d_in[13]; const float* w_o = (const float*)d_in[14]; const float* g_ffn = (const float*)d_in[15];
    const float* wq = (const float*)d_in[16]; const float* k1 = (const float*)d_in[17]; const float* k2 = (const float*)d_in[18]; const float* pu = (const float*)d_in[19]; const float* pv = (const float*)d_in[20];
    const float* g_ple = (const float*)d_in[21]; const float* w_gate = (const float*)d_in[22]; const float* w_proj = (const float*)d_in[23]; const float* final_g = (const float*)d_in[24];
    float* rstd1 = (float*)(ws + WS_RSTD1); float* part2 = (float*)(ws + WS_PART2); float* part4 = (float*)(ws + WS_PART4); float* rstd3 = (float*)(ws + WS_RSTD3);
    bf16* qkv = (bf16*)(ws + WS_QKV); bf16* lx = (bf16*)(ws + WS_LX); bf16* gl = (bf16*)(ws + WS_GL); bf16* sga = (bf16*)(ws + WS_SGA); bf16* sgl = (bf16*)(ws + WS_SGL);
    bf16* att = (bf16*)(ws + WS_ATT); bf16* r0 = (bf16*)(ws + WS_R0); float* mp = (float*)(ws + WS_MP); bf16* merged = (bf16*)(ws + WS_MERGED);
    float* sc = (float*)(ws + WS_SC); int* seli = (int*)(ws + WS_SELI); float* selg = (float*)(ws + WS_SELG); bf16* h2b = (bf16*)(ws + WS_H2B); bf16* pp = (bf16*)(ws + WS_PP);
    float* tmpf = (float*)(ws + WS_NAIVE_AB);
    switch (grp) {
    case 0:
        hipLaunchKernelGGL(nv::rowsq, dim3(T_ / 4), dim3(256), 0, st, x, rstd1, (float*)nullptr);
        nv::run_gemm<nv::ALf32, nv::EpiProj, false>(st, nv::ALf32{x, 1024}, w_in, INW, g_mix, T_, INW, 1024, nv::EpiProj{rstd1, qkv, lx, gl, sga, sgl});
        break;
    case 1:
        hipLaunchKernelGGL(nv::attn_naive, dim3(T_ * 8 / 128), dim3(128), 0, st, qkv, sink, att);
        hipLaunchKernelGGL(nv::conv_naive, dim3(T_ * 1024 / 256), dim3(256), 0, st, lx, conv_w, conv_b, r0);
        break;
    case 2:
        hipLaunchKernelGGL(nv::lru_ab_naive, dim3(T_ * 8), dim3(128), 0, st, r0, wa, ba, wx, bx, lam, out, tmpf);
        hipLaunchKernelGGL(nv::lru_scan_naive, dim3(B_ * 1024 / 64), dim3(64), 0, st, out, tmpf, gl, r0);
        break;
    case 3: nv::run_gemm<nv::ALbf16, nv::EpiMP, false>(st, nv::ALbf16{att, 512}, w_ua, 1024, nullptr, T_, 1024, 512, nv::EpiMP{sga, mp}); break;
    case 4: nv::run_gemm<nv::ALbf16, nv::EpiMerged, false>(st, nv::ALbf16{r0, 1024}, w_ul, 1024, nullptr, T_, 1024, 1024, nv::EpiMerged{sgl, mp, merged}); break;
    case 5:
        nv::run_gemm<nv::ALbf16, nv::EpiH1, false>(st, nv::ALbf16{merged, 1024}, w_o, 1024, nullptr, T_, 1024, 1024, nv::EpiH1{x, out, r0});
        hipLaunchKernelGGL(nv::rowsq, dim3(T_ / 4), dim3(256), 0, st, out, (float*)nullptr, part2);
        break;
    case 6:
        for (int half = 0; half < 2; ++half) {
            nv::run_gemm<nv::ALf32, nv::EpiScaleF32, false>(st, nv::ALf32{out, 1024}, wq + half * 1024, 2048, g_ffn, T_, 1024, 1024, nv::EpiScaleF32{part2, tmpf, 1024});
            for (int hl = 0; hl < 4; ++hl)
                for (int hf = 0; hf < 2; ++hf)
                    nv::run_gemm<nv::ALf32, nv::EpiPlainF32, true>(st, nv::ALf32{tmpf + hl * 256 + hf * 128, 1024}, hf ? k2 : k1, 128, nullptr, T_, 128, 128, nv::EpiPlainF32{sc + hl * 256 + hf * 128, 1024});
            hipLaunchKernelGGL(topk_kernel, dim3(T_ / TK_TOK), dim3(512), TK_LDS_BYTES, st, sc, half * 4, seli, selg);
        }
        break;
    case 7: hipLaunchKernelGGL(gather_kernel<0>, dim3(1024), dim3(256), 0, st, (const void*)pu, (const void*)pv, g_ffn, seli, selg, part2, out, h2b, rstd3); break;
    case 8: nv::run_gemm<nv::ALf32, nv::EpiPP, false>(st, nv::ALf32{p, 256}, w_proj, 1024, nullptr, T_, 1024, 256, nv::EpiPP{pp}); break;
    case 9: nv::run_gemm<nv::ALbf16, nv::EpiH3, false>(st, nv::ALbf16{h2b, 1024}, w_gate, 1024, g_ple, T_, 1024, 1024, nv::EpiH3{rstd3, pp, out});
        hipLaunchKernelGGL(nv::rowsq, dim3(T_ / 4), dim3(256), 0, st, out, (float*)nullptr, part4);
        break;
    case 10: hipLaunchKernelGGL(nv::final_norm, dim3(T_ / 4), dim3(256), 0, st, out, part4, final_g); break;
    }
}

extern "C" void kernel_launch(void* const* d_in, const int* in_sizes, int n_in, void* d_out, int out_size, void* d_ws, size_t ws_size, hipStream_t stream) {
    static int grid = 0;
    if (grid == 0) {
        if (n_in != 25 || out_size != T_ * 1024 || ws_size < WS_END) { fprintf(stderr, "kernel_launch: unexpected sizes n_in %d out %d ws %zu\n", n_in, out_size, ws_size); }
        (void)hipFuncSetAttribute((const void*)topk_kernel, hipFuncAttributeMaxDynamicSharedMemorySize, TK_LDS_BYTES);
        int dev = 0, cus = 0, per_cu = 0;
        (void)hipGetDevice(&dev); (void)hipDeviceGetAttribute(&cus, hipDeviceAttributeMultiprocessorCount, dev);
        if (hipFuncSetAttribute((const void*)fused_fwd, hipFuncAttributeMaxDynamicSharedMemorySize, LDS_BYTES) != hipSuccess) fprintf(stderr, "kernel_launch: hipFuncSetAttribute(fused_fwd) failed\n");
        if (hipOccupancyMaxActiveBlocksPerMultiprocessor(&per_cu, (const void*)fused_fwd, NWAVES * 64, LDS_BYTES) != hipSuccess || per_cu < 1) fprintf(stderr, "kernel_launch: occupancy query says %d blocks/CU\n", per_cu);
        (void)hipGetLastError();
        grid = cus > 0 ? cus : 256;
    }
    unsigned char* ws = (unsigned char*)d_ws; float* out = (float*)d_out;
    const unsigned mask = FUSED_MASK;
    if (mask) (void)hipMemsetAsync(ws + WS_CTL, 0, CTL_ZERO_BYTES, stream);
    Args a{};
    for (int i = 0; i < 25; ++i) a.in[i] = (const float*)d_in[i];
    a.out = out; a.ws = ws;
    int li = 0;
    auto launch = [&](int lo, int hi) {
        if (MERGE_LAUNCHES) { a.ph_lo = lo; a.ph_hi = hi; a.li = li++; hipLaunchKernelGGL(fused_fwd, dim3(grid), dim3(NWAVES * 64), LDS_BYTES, stream, a); }
        else for (int ph = lo; ph < hi; ++ph) { a.ph_lo = ph; a.ph_hi = ph + 1; a.li = li++; hipLaunchKernelGGL(fused_fwd, dim3(grid), dim3(NWAVES * 64), LDS_BYTES, stream, a); }
    };
    int pend_lo = -1, pend_hi = -1;
    if (mask && !(mask & 1)) launch(0, 1);
    for (int gidx = 0; gidx < 11; ++gidx) {
#if (defined(LRU_T2) && LRU_T2) || (defined(LRU_T3) && LRU_T3)
        if (gidx == 2 && (mask & 4u)) {
            if (pend_lo >= 0) { launch(pend_lo, pend_hi); pend_lo = -1; }
            launch(3, 4);
            hipLaunchKernelGGL(nv::lru_finish_naive_L<(LRU_T2 ? 16 : 64)>, dim3(B_ * 1024 / 64), dim3(64), 0, stream, (const bf16*)(ws + WS_HLOC), (const bf16*)(ws + WS_PCUM), (const bf16*)(ws + WS_GL), (bf16*)(ws + WS_R0));
            continue;
        }
#endif
        if (mask & (1u << gidx)) {
            if (pend_lo < 0) { pend_lo = GRP_LO[gidx]; pend_hi = GRP_HI[gidx]; } else pend_hi = GRP_HI[gidx];
        } else {
            if (pend_lo >= 0) { launch(pend_lo, pend_hi); pend_lo = -1; }
            naive_group(gidx, d_in, out, ws, stream);
        }
    }
    if (pend_lo >= 0) launch(pend_lo, pend_hi);
#if defined(LRU_DEBUG) && LRU_DEBUG == 2
    hipLaunchKernelGGL(nv::poison_if, dim3(T_ * 1024 / 256), dim3(256), 0, stream, out, (const unsigned*)(ws + WS_CTL) + 64);
#endif
}
```

```cpp
#include <hip/hip_runtime.h>
#include <cstdio>
#include <cstdint>
#include <cmath>

#ifndef FUSED_MASK
#define FUSED_MASK 0x7ff
#endif
#ifndef MERGE_LAUNCHES
#define MERGE_LAUNCHES 1
#endif
#ifndef LRU_PADDED
#define LRU_PADDED 1
#endif
#ifndef FUSE_FINAL
#define FUSE_FINAL 0
#endif
#ifndef GATHER_ROWS
#define GATHER_ROWS 3
#endif
#ifndef MIX_PIPE
#define MIX_PIPE 1
#endif
#ifndef V_FP6
#define V_FP6 1
#endif
#ifndef U_FP6
#define U_FP6 0
#endif
#ifndef Y_F16
#define Y_F16 1
#endif
#define ALL_FUSED ((FUSED_MASK) == 0x7ff && (MERGE_LAUNCHES))
constexpr int B_ = 8, S_ = 2048, D_ = 1024, T_ = B_ * S_;
constexpr int INW = 4864;
constexpr float EPS = 1e-6f;
typedef unsigned short bf16;
typedef unsigned u32x3 __attribute__((ext_vector_type(3)));
#define HD_INLINE __host__ __device__ __forceinline__

constexpr size_t MiB = 1u << 20;
constexpr size_t WS_CTL = 0;
constexpr size_t WS_WIN = 1 * MiB;
constexpr size_t WS_WUA = WS_WIN + 4864 * 1024 * 2;
constexpr size_t WS_WUL = WS_WUA + 1 * MiB;
constexpr size_t WS_WO = WS_WUL + 2 * MiB;
constexpr size_t WS_WFOLD = WS_WO + 2 * MiB;
constexpr size_t WS_WG = WS_WFOLD + 4 * MiB;
constexpr size_t WS_WPROJ = WS_WG + 2 * MiB;
constexpr size_t WS_WAX = WS_WPROJ + MiB / 2;
constexpr size_t WS_W_END = WS_WAX + 1 * MiB;
static_assert(WS_W_END <= 23 * MiB, "weights");
constexpr size_t WS_RSTD1 = 23 * MiB;
constexpr size_t WS_PART2 = WS_RSTD1 + 256 * 1024;
constexpr size_t WS_PART4 = WS_PART2 + 1 * MiB;
constexpr size_t WS_RSTD3 = WS_PART4 + 1 * MiB;
constexpr size_t WS_AGG = WS_RSTD3 + 256 * 1024;
constexpr size_t WS_C8 = WS_AGG + 2 * MiB;
constexpr size_t WS_USCALE = WS_C8 + 64 * 1024;
static_assert(WS_USCALE + 128 * 1024 <= 28 * MiB, "small");
constexpr size_t WS_PB = 28 * MiB;
constexpr size_t WS_R0 = 36 * MiB;
constexpr size_t WS_QKV = 68 * MiB;
constexpr size_t WS_LX = 92 * MiB;
constexpr size_t WS_GL = 140 * MiB;
constexpr size_t WS_SGA = 172 * MiB;
constexpr size_t WS_SGL = 204 * MiB;
constexpr size_t WS_ATT = 236 * MiB;
constexpr size_t WS_HLOC = 68 * MiB, WS_PCUM = 100 * MiB;
constexpr size_t WS_MP = 68 * MiB;
constexpr size_t WS_MERGED = 140 * MiB;
constexpr size_t WS_SC = 172 * MiB;
constexpr size_t WS_SELI = 236 * MiB, WS_SELG = 244 * MiB;
constexpr size_t WS_U16 = 68 * MiB, WS_V16 = 100 * MiB;
constexpr size_t WS_H2B = 140 * MiB;
constexpr size_t WS_PP = 172 * MiB;
constexpr size_t WS_NAIVE_AB = 68 * MiB;
constexpr size_t WS_WAXD = 252 * MiB;
constexpr size_t WS_END = 256 * MiB;

HD_INLINE float bf2f(bf16 v) { return __builtin_bit_cast(float, (unsigned)v << 16); }
HD_INLINE bf16 f2bf(float f) { unsigned u = __builtin_bit_cast(unsigned, f); return (bf16)((u + 0x7fffu + ((u >> 16) & 1u)) >> 16); }
HD_INLINE unsigned pk2(float lo, float hi) { return (unsigned)f2bf(lo) | ((unsigned)f2bf(hi) << 16); }
__device__ __forceinline__ float wave_sum(float v) {
#pragma unroll
    for (int o = 1; o < 64; o <<= 1) v += __shfl_xor(v, o);
    return v;
}
__device__ __forceinline__ float sigmoidf_(float z) { return __builtin_amdgcn_rcpf(1.0f + __builtin_amdgcn_exp2f(-1.4426950408889634f * z)); }
__device__ __forceinline__ float gelu_tanh(float x) { const float u = 1.5957691216057308f * (x + 0.044715f * x * x * x); return x * sigmoidf_(u); }
__device__ __forceinline__ int fresh_lane() { int l; asm volatile("v_mbcnt_lo_u32_b32 %0, -1, 0\n\tv_mbcnt_hi_u32_b32 %0, -1, %0" : "=v"(l)); return l; }
#ifndef HD_INLINE
#define HD_INLINE __host__ __device__ __forceinline__
#endif

HD_INLINE unsigned tk_umax(unsigned a, unsigned b) { return a > b ? a : b; }
HD_INLINE unsigned tk_umin(unsigned a, unsigned b) { return a < b ? a : b; }
HD_INLINE unsigned tk_f2key(float f) { unsigned u = __builtin_bit_cast(unsigned, f); return u ^ ((unsigned)((int)u >> 31) | 0x80000000u); }
HD_INLINE float tk_key2f(unsigned k) { unsigned u = (k & 0x80000000u) ? (k ^ 0x80000000u) : ~k; return __builtin_bit_cast(float, u); }

HD_INLINE void tk_sort16(unsigned (&a)[16]) {
#pragma unroll
    for (int k = 2; k <= 16; k <<= 1) {
#pragma unroll
        for (int j = k >> 1; j > 0; j >>= 1) {
#pragma unroll
            for (int i = 0; i < 16; ++i) {
                const int p = i ^ j;
                if (p > i) {
                    const unsigned mx = tk_umax(a[i], a[p]), mn = tk_umin(a[i], a[p]);
                    if ((i & k) == 0) { a[i] = mx; a[p] = mn; } else { a[i] = mn; a[p] = mx; }
                }
            }
        }
    }
}
HD_INLINE void tk_merge16(unsigned (&a)[16], const unsigned (&b)[16]) {
#pragma unroll
    for (int i = 0; i < 16; ++i) a[i] = tk_umax(a[i], b[15 - i]);
#pragma unroll
    for (int j = 8; j > 0; j >>= 1) {
#pragma unroll
        for (int i = 0; i < 16; ++i) {
            const int p = i ^ j;
            if (p > i) { const unsigned mx = tk_umax(a[i], a[p]), mn = tk_umin(a[i], a[p]); a[i] = mx; a[p] = mn; }
        }
    }
}
HD_INLINE void tk_insert16(unsigned (&best)[16], unsigned key) {
#pragma unroll
    for (int s = 0; s < 16; ++s) { const unsigned hi = tk_umax(best[s], key); key = tk_umin(best[s], key); best[s] = hi; }
}
HD_INLINE void tk_combine_store(const unsigned (&k1)[16], const unsigned (&k2)[16], int* oi, float* og) {
    float v1[16], v2[16];
#pragma unroll
    for (int i = 0; i < 16; ++i) { v1[i] = tk_key2f(k1[i] & ~127u); v2[i] = tk_key2f(k2[i] & ~127u); }
    unsigned best[16];
#pragma unroll
    for (int s = 0; s < 16; ++s) best[s] = 0u;
#pragma unroll
    for (int i = 0; i < 16; ++i) {
#pragma unroll
        for (int j = 0; j < 16; ++j) {
            if ((i + 1) * (j + 1) <= 16) {
                const float s = v1[i] + v2[j];
                const unsigned key = (tk_f2key(s) & ~255u) | (unsigned)(255 - (i * 16 + j));
                tk_insert16(best, key);
            }
        }
    }
    const unsigned thr = best[15];
    const float mx = tk_key2f(best[0] & ~255u);
    float sum = 0.f;
#pragma unroll
    for (int i = 0; i < 16; ++i) {
#pragma unroll
        for (int j = 0; j < 16; ++j) {
            if ((i + 1) * (j + 1) <= 16) {
                const float s = v1[i] + v2[j];
                const unsigned key = (tk_f2key(s) & ~255u) | (unsigned)(255 - (i * 16 + j));
                if (key >= thr) sum += __builtin_expf(s - mx);
            }
        }
    }
    const float inv = 1.0f / sum;
    int cnt = 0;
#pragma unroll
    for (int i = 0; i < 16; ++i) {
#pragma unroll
        for (int j = 0; j < 16; ++j) {
            if ((i + 1) * (j + 1) <= 16) {
                const float s = v1[i] + v2[j];
                const unsigned key = (tk_f2key(s) & ~255u) | (unsigned)(255 - (i * 16 + j));
                if (key >= thr) {
                    oi[cnt] = (127 - (int)(k1[i] & 127u)) * 128 + (127 - (int)(k2[j] & 127u));
                    og[cnt] = __builtin_expf(s - mx) * inv;
                    ++cnt;
                }
            }
        }
    }
}

HD_INLINE unsigned tk_ckey(float s, unsigned odd64, int i, int j) { return ((tk_f2key(s) & ~255u) | (unsigned)(255 - (i * 16 + j))) - odd64; }
HD_INLINE void tk_pair_partial(const unsigned (&own)[16], const unsigned (&oth)[16], bool odd, unsigned (&r0)[16]) {
    float va[4], vb[16];
    const unsigned odd64 = odd ? 64u : 0u;
#pragma unroll
    for (int i = 0; i < 4; ++i) va[i] = tk_key2f(own[i] & ~127u);
#pragma unroll
    for (int j = 0; j < 16; ++j) vb[j] = tk_key2f(oth[j] & ~127u);
#pragma unroll
    for (int j = 1; j < 16; ++j) r0[j - 1] = tk_ckey(va[0] + vb[j], odd64, 0, j);
    r0[15] = 0u;
    unsigned l2[16];
#pragma unroll
    for (int j = 2; j < 8; ++j) l2[j - 2] = tk_ckey(va[1] + vb[j], odd64, 1, j);
    l2[6] = tk_ckey(va[2] + vb[3], odd64, 2, 3); l2[7] = tk_ckey(va[2] + vb[4], odd64, 2, 4);
#pragma unroll
    for (int d = 0; d < 4; ++d) { const unsigned k = tk_ckey(va[d] + vb[d], 0u, d, d); l2[8 + d] = odd ? 0u : k; }
#pragma unroll
    for (int d = 12; d < 16; ++d) l2[d] = 0u;
    tk_sort16(l2);
    tk_merge16(r0, l2);
}
HD_INLINE void tk_decode(unsigned key, int& i1, int& i2) { const int code = 255 - (int)(key & 255u); const int i = (code >> 4) & 3, j = code & 15; const bool po = (code >> 6) & 1; i1 = po ? j : i; i2 = po ? i : j; }
namespace nv {
struct ALf32 { const float* p; int lda; int pad; __device__ __forceinline__ float operator()(int m, int k) const { return p[(size_t)m * lda + k]; } };
struct ALbf16 { const bf16* p; int lda; int pad; __device__ __forceinline__ float operator()(int m, int k) const { return bf2f(p[(size_t)m * lda + k]); } };

template <class AL, class EPI, bool BT>
__global__ void __launch_bounds__(256) ngemm(AL al, const float* __restrict__ B, int ldb, const float* __restrict__ ks, int M, int N, int K, EPI epi) {
    __shared__ float As[16][68];
    __shared__ float Bs[16][68];
    const int tid = threadIdx.x, tx = tid & 15, ty = tid >> 4;
    const int m0 = blockIdx.y * 64, n0 = blockIdx.x * 64;
    float acc[4][4];
#pragma unroll
    for (int i = 0; i < 4; ++i)
#pragma unroll
        for (int j = 0; j < 4; ++j) acc[i][j] = 0.f;
    for (int k0 = 0; k0 < K; k0 += 16) {
#pragma unroll
        for (int i = 0; i < 4; ++i) {
            const int e = tid + i * 256;
            { const int m = e >> 4, k = e & 15; float v = al(m0 + m, k0 + k); if (ks) v *= ks[k0 + k]; As[k][m] = v; }
            if (BT) { const int n = e >> 4, k = e & 15; Bs[k][n] = B[(size_t)(n0 + n) * ldb + k0 + k]; }
            else { const int k = e >> 6, n = e & 63; Bs[k][n] = B[(size_t)(k0 + k) * ldb + n0 + n]; }
        }
        __syncthreads();
#pragma unroll
        for (int k = 0; k < 16; ++k) {
            float a[4], b[4];
#pragma unroll
            for (int i = 0; i < 4; ++i) { a[i] = As[k][ty * 4 + i]; b[i] = Bs[k][tx * 4 + i]; }
#pragma unroll
            for (int i = 0; i < 4; ++i)
#pragma unroll
                for (int j = 0; j < 4; ++j) acc[i][j] = fmaf(a[i], b[j], acc[i][j]);
        }
        __syncthreads();
    }
#pragma unroll
    for (int i = 0; i < 4; ++i)
#pragma unroll
        for (int j = 0; j < 4; ++j) epi(m0 + ty * 4 + i, n0 + tx * 4 + j, acc[i][j]);
}
template <class AL, class EPI, bool BT>
static void run_gemm(hipStream_t st, AL al, const float* B, int ldb, const float* ks, int M, int N, int K, EPI epi) {
    hipLaunchKernelGGL((ngemm<AL, EPI, BT>), dim3(N / 64, M / 64), dim3(256), 0, st, al, B, ldb, ks, M, N, K, epi);
}

__global__ void __launch_bounds__(256) rowsq(const float* __restrict__ X, float* rstd, float* part) {
    const int row = blockIdx.x * 4 + (threadIdx.x >> 6), lane = threadIdx.x & 63;
    const float* xr = X + (size_t)row * 1024;
    float s = 0.f;
    for (int j = 0; j < 16; ++j) { const float v = xr[lane + 64 * j]; s += v * v; }
    s = wave_sum(s);
    if (rstd && lane == 0) rstd[row] = 1.0f / sqrtf(s * (1.0f / 1024.0f) + EPS);
    if (part && lane < 16) part[(size_t)row * 16 + lane] = (lane == 0) ? s : 0.f;
}

struct EpiProj {
    const float* rstd; bf16 *qkv, *lx, *gl, *sga, *sgl;
    __device__ __forceinline__ void operator()(int m, int n, float v) const {
        v *= rstd[m];
        if (n < 768) qkv[(size_t)m * 768 + n] = f2bf(v);
        else if (n < 1792) lx[(size_t)m * 1024 + (n - 768)] = f2bf(v);
        else if (n < 2816) gl[(size_t)m * 1024 + (n - 1792)] = f2bf(gelu_tanh(v));
        else if (n < 3840) sga[(size_t)m * 1024 + (n - 2816)] = f2bf(sigmoidf_(v));
        else sgl[(size_t)m * 1024 + (n - 3840)] = f2bf(sigmoidf_(v));
    }
};

__global__ void __launch_bounds__(128) attn_naive(const bf16* __restrict__ qkv, const float* __restrict__ sink, bf16* __restrict__ att) {
    const int gid = blockIdx.x * 128 + threadIdx.x;
    const int head = gid / T_, t = gid % T_;
    const int b = t / S_, ts = t % S_;
    const int g = head >> 2;
    float q[64], acc[64];
    const bf16* qp = qkv + (size_t)t * 768 + head * 64;
#pragma unroll
    for (int d = 0; d < 64; ++d) { q[d] = bf2f(qp[d]); acc[d] = 0.f; }
    const float slope = exp2f(-(float)(head + 1));
    float m = -3.0e38f, l = 0.f;
    for (int dist = 127; dist >= 0; --dist) {
        const int s = ts - dist; if (s < 0) continue;
        const bf16* kp = qkv + (size_t)(b * S_ + s) * 768 + 512 + g * 64;
        const bf16* vp = kp + 128;
        float sc = 0.f;
#pragma unroll
        for (int d = 0; d < 64; ++d) sc = fmaf(q[d], bf2f(kp[d]), sc);
        sc = sc * 0.125f - slope * (float)dist;
        const float mn = fmaxf(m, sc), corr = __expf(m - mn), p = __expf(sc - mn);
        l = l * corr + p;
#pragma unroll
        for (int d = 0; d < 64; ++d) acc[d] = acc[d] * corr + p * bf2f(vp[d]);
        m = mn;
    }
    const float sk = sink[head];
    const float mf = fmaxf(m, sk), corr = __expf(m - mf);
    l = l * corr + __expf(sk - mf);
    const float inv = corr / l;
    bf16* op = att + (size_t)t * 512 + head * 64;
#pragma unroll
    for (int d = 0; d < 64; ++d) op[d] = f2bf(acc[d] * inv);
}

__global__ void __launch_bounds__(256) conv_naive(const bf16* __restrict__ lx, const float* __restrict__ cw, const float* __restrict__ cb, bf16* __restrict__ lin) {
    const size_t i = (size_t)blockIdx.x * 256 + threadIdx.x;
    const int c = (int)(i & 1023); const int t = (int)(i >> 10); const int ts = t % S_;
    float y = cb[c];
#pragma unroll
    for (int tap = 0; tap < 4; ++tap) { const int s = ts - 3 + tap; if (s >= 0) y = fmaf(bf2f(lx[(size_t)(t - 3 + tap) * 1024 + c]), cw[tap * 1024 + c], y); }
    lin[i] = f2bf(y);
}

__global__ void __launch_bounds__(128) lru_ab_naive(const bf16* __restrict__ lin, const float* __restrict__ wa, const float* __restrict__ ba, const float* __restrict__ wx, const float* __restrict__ bx,
                                                    const float* __restrict__ lam, float* __restrict__ Af, float* __restrict__ Bf) {
    __shared__ float xs[128];
    const int t = blockIdx.x >> 3, blk = blockIdx.x & 7, d = threadIdx.x, ch = blk * 128 + d;
    xs[d] = bf2f(lin[(size_t)t * 1024 + ch]);
    __syncthreads();
    float r = ba[ch], ii = bx[ch];
    const float* wap = wa + (size_t)blk * 128 * 128 + d; const float* wxp = wx + (size_t)blk * 128 * 128 + d;
    for (int c = 0; c < 128; ++c) { r = fmaf(xs[c], wap[c * 128], r); ii = fmaf(xs[c], wxp[c * 128], ii); }
    r = sigmoidf_(r); ii = sigmoidf_(ii);
    const float sp = log1pf(expf(-lam[ch]));
    const float loga = -8.0f * r * sp;
    const float a = expf(loga);
    const float bb = sqrtf(-expm1f(2.0f * loga)) * (ii * xs[d]);
    Af[(size_t)t * 1024 + ch] = a; Bf[(size_t)t * 1024 + ch] = bb;
}
__global__ void __launch_bounds__(256) lru_ab_from_pre(const bf16* __restrict__ lin, const float* __restrict__ ba, const float* __restrict__ bx, const float* __restrict__ lam, float* __restrict__ Af, float* __restrict__ Bf) {
    const size_t i = (size_t)blockIdx.x * 256 + threadIdx.x; const int ch = (int)(i & 1023);
    const float r = sigmoidf_(Af[i] + ba[ch]), ii = sigmoidf_(Bf[i] + bx[ch]);
    const float loga = -8.0f * r * log1pf(expf(-lam[ch]));
    Af[i] = expf(loga); Bf[i] = sqrtf(-expm1f(2.0f * loga)) * (ii * bf2f(lin[i]));
}
template <int L>
__global__ void __launch_bounds__(64) lru_finish_naive_L(const bf16* __restrict__ hloc, const bf16* __restrict__ pcum, const bf16* __restrict__ gl, bf16* __restrict__ rec) {
    const int gid = blockIdx.x * 64 + threadIdx.x; const int b = gid >> 10, ch = gid & 1023;
    float carry = 0.f;
    for (int c = 0; c < S_ / L; ++c) {
        float la = 1.f, lb = 0.f;
        for (int s = 0; s < L; ++s) { const size_t o = (size_t)(b * S_ + c * L + s) * 1024 + ch; la = bf2f(pcum[o]); lb = bf2f(hloc[o]); const float h = la * carry + lb; rec[o] = f2bf(h * bf2f(gl[o])); }
        carry = la * carry + lb;
    }
}
__global__ void __launch_bounds__(64) lru_finish_naive(const bf16* __restrict__ hloc, const bf16* __restrict__ pcum, const float* __restrict__ agg, const bf16* __restrict__ gl, bf16* __restrict__ rec) {
    const int gid = blockIdx.x * 64 + threadIdx.x; const int b = gid >> 10, ch = gid & 1023;
    float carry = 0.f;
    for (int c = 0; c < 32; ++c) {
        const int chunk = b * 32 + c;
        for (int s = 0; s < 64; ++s) { const size_t o = (size_t)(chunk * 64 + s) * 1024 + ch; const float h = bf2f(pcum[o]) * carry + bf2f(hloc[o]); rec[o] = f2bf(h * bf2f(gl[o])); }
        const float* ap = agg + ((size_t)chunk * 1024 + ch) * 2; carry = ap[0] * carry + ap[1];
    }
}
__global__ void __launch_bounds__(128) lru_pre_check(const bf16* __restrict__ lin, const float* __restrict__ wa, const float* __restrict__ wx, const float* __restrict__ Rp, const float* __restrict__ Ip, unsigned* flag) {
    __shared__ float xs[128];
    const int t = blockIdx.x >> 3, blk = blockIdx.x & 7, d = threadIdx.x, ch = blk * 128 + d;
    xs[d] = bf2f(lin[(size_t)t * 1024 + ch]);
    __syncthreads();
    float r = 0.f, ii = 0.f;
    const float* wap = wa + (size_t)blk * 128 * 128 + d; const float* wxp = wx + (size_t)blk * 128 * 128 + d;
    for (int c = 0; c < 128; ++c) { r = fmaf(xs[c], wap[c * 128], r); ii = fmaf(xs[c], wxp[c * 128], ii); }
    const float dr = fabsf(r - Rp[(size_t)t * 1024 + ch]), di = fabsf(ii - Ip[(size_t)t * 1024 + ch]);
    if (!(dr < 0.08f + 0.03f * fabsf(r)) || !(di < 0.08f + 0.03f * fabsf(ii))) atomicAdd(flag, 1u);
}
__global__ void __launch_bounds__(256) poison_if(float* out, const unsigned* flag) { if (*flag) { const size_t i = (size_t)blockIdx.x * 256 + threadIdx.x; out[i] = out[i] * 50.0f + 3.0f; } }
__global__ void __launch_bounds__(64) lru_scan_naive(const float* __restrict__ Af, const float* __restrict__ Bf, const bf16* __restrict__ gl, bf16* __restrict__ rec) {
    const int gid = blockIdx.x * 64 + threadIdx.x; const int b = gid >> 10, ch = gid & 1023;
    float h = 0.f;
    for (int s = 0; s < S_; ++s) { const size_t o = (size_t)(b * S_ + s) * 1024 + ch; h = fmaf(Af[o], h, Bf[o]); rec[o] = f2bf(h * bf2f(gl[o])); }
}

struct EpiMP { const bf16* sga; float* mp; __device__ __forceinline__ void operator()(int m, int n, float v) const { const size_t o = (size_t)m * 1024 + n; mp[o] = v * bf2f(sga[o]); } };
struct EpiMerged { const bf16* sgl; const float* mp; bf16* merged; __device__ __forceinline__ void operator()(int m, int n, float v) const { const size_t o = (size_t)m * 1024 + n; merged[o] = f2bf(mp[o] + v * bf2f(sgl[o])); } };
struct EpiH1 { const float* x; float* h1; bf16* h1b; __device__ __forceinline__ void operator()(int m, int n, float v) const { const size_t o = (size_t)m * 1024 + n; const float h = x[o] + v; h1[o] = h; h1b[o] = f2bf(h); } };
struct EpiScaleF32 { const float* part; float* out; int ldo; int pad; __device__ __forceinline__ void operator()(int m, int n, float v) const {
    float s = 0.f; for (int i = 0; i < 16; ++i) s += part[(size_t)m * 16 + i];
    out[(size_t)m * ldo + n] = v * (1.0f / sqrtf(s * (1.0f / 1024.0f) + EPS)); } };
struct EpiPlainF32 { float* out; int ldo; int pad; __device__ __forceinline__ void operator()(int m, int n, float v) const { out[(size_t)m * ldo + n] = v; } };
struct EpiPP { bf16* pp; __device__ __forceinline__ void operator()(int m, int n, float v) const { pp[(size_t)m * 1024 + n] = f2bf(v); } };
struct EpiH3 { const float* rstd3; const bf16* pp; float* h; __device__ __forceinline__ void operator()(int m, int n, float v) const { const size_t o = (size_t)m * 1024 + n; h[o] = h[o] + sigmoidf_(v * rstd3[m]) * bf2f(pp[o]); } };

__global__ void __launch_bounds__(256) final_norm(float* __restrict__ h, const float* __restrict__ part, const float* __restrict__ fg) {
    const int row = blockIdx.x * 4 + (threadIdx.x >> 6), lane = threadIdx.x & 63;
    float s = 0.f; for (int i = 0; i < 16; ++i) s += part[(size_t)row * 16 + i];
    const float r = 1.0f / sqrtf(s * (1.0f / 1024.0f) + EPS);
    float* hr = h + (size_t)row * 1024;
    for (int j = 0; j < 16; ++j) { const int c = lane + 64 * j; hr[c] = hr[c] * r * fg[c]; }
}
}
#define LAS __attribute__((address_space(3)))
typedef float f32x4 __attribute__((ext_vector_type(4)));
typedef unsigned u32x4 __attribute__((ext_vector_type(4)));
typedef int i32x4 __attribute__((ext_vector_type(4)));

constexpr int TK_TOK = 32;
constexpr int TK_LSTRIDE = 132;
constexpr int TK_LDS_BYTES = 256 * TK_LSTRIDE * 4;

__device__ __forceinline__ void topk_item(LAS float* lds, const float* __restrict__ SC, int item, int head_base, int* __restrict__ seli, float* __restrict__ selg, int tid) {
    const f32x4* src = (const f32x4*)(SC + (size_t)item * TK_TOK * 1024);
#pragma unroll 4
    for (int i = 0; i < 16; ++i) {
        const int idx = tid + i * 512; const int row = idx >> 8, c4 = idx & 255;
        const f32x4 v = src[idx];
        const int list = row * 8 + (c4 >> 5), elem = (c4 & 31) * 4;
        *(LAS f32x4*)(lds + list * TK_LSTRIDE + elem) = v;
    }
    __syncthreads();
    if (tid < 256) {
        const LAS float* my = lds + tid * TK_LSTRIDE;
        unsigned acc[16];
#pragma unroll
        for (int g = 0; g < 8; ++g) {
            unsigned t[16];
#pragma unroll
            for (int q = 0; q < 4; ++q) {
                const f32x4 v = *(const LAS f32x4*)(my + g * 16 + q * 4);
#pragma unroll
                for (int c = 0; c < 4; ++c) { const int e = g * 16 + q * 4 + c; t[q * 4 + c] = (tk_f2key(v[c]) & ~127u) | (unsigned)(127 - e); }
            }
            tk_sort16(t);
            if (g == 0) {
#pragma unroll
                for (int i = 0; i < 16; ++i) acc[i] = t[i];
            } else tk_merge16(acc, t);
        }
        unsigned oth[16];
#pragma unroll
        for (int i = 0; i < 16; ++i) oth[i] = (unsigned)__shfl_xor((int)acc[i], 1);
        if ((tid & 1) == 0) {
            const int tok = item * TK_TOK + (tid >> 3), head = head_base + ((tid >> 1) & 3);
            tk_combine_store(acc, oth, seli + (size_t)tok * 128 + head * 16, selg + (size_t)tok * 128 + head * 16);
        }
    }
    __syncthreads();
}
__global__ void __launch_bounds__(512) topk_kernel(const float* __restrict__ SC, int head_base, int* __restrict__ seli, float* __restrict__ selg) {
    extern __shared__ __attribute__((aligned(16))) unsigned char dyn_lds[];
    for (int item = blockIdx.x; item < T_ / TK_TOK; item += gridDim.x) topk_item((LAS float*)dyn_lds, SC, item, head_base, seli, selg, (int)threadIdx.x);
}

template <int MODE>
__device__ __forceinline__ void gather_token(int t, int lane, const void* __restrict__ Utab, const void* __restrict__ Vtab, const float* __restrict__ gffn,
                                             const int* __restrict__ seli, const float* __restrict__ selg, const float* __restrict__ part2,
                                             float* __restrict__ H  , bf16* __restrict__ h2b, float* __restrict__ rstd3) {
    float ps = (lane < 16) ? part2[(size_t)t * 16 + lane] : 0.f;
    ps = wave_sum(ps);
    const float rstd2 = 1.0f / sqrtf(ps * (1.0f / 1024.0f) + EPS);
    const int iA = seli[(size_t)t * 128 + lane], iB = seli[(size_t)t * 128 + 64 + lane];
    const float gA = selg[(size_t)t * 128 + lane], gB = selg[(size_t)t * 128 + 64 + lane];
    float* hr = H + (size_t)t * 1024;
    if constexpr (MODE == 0) {
        f32x4 x[4], y[4], hv[4];
#pragma unroll
        for (int j = 0; j < 4; ++j) { hv[j] = *(const f32x4*)(hr + 256 * j + 4 * lane); const f32x4 g = *(const f32x4*)(gffn + 256 * j + 4 * lane); x[j] = hv[j] * g; y[j] = (f32x4){0.f, 0.f, 0.f, 0.f}; }
        const float* U = (const float*)Utab; const float* V = (const float*)Vtab;
        for (int k = 0; k < 64; ++k) {
#pragma unroll
            for (int hh = 0; hh < 2; ++hh) {
                const int e = __builtin_amdgcn_readlane(hh ? iB : iA, k);
                const float gt = __builtin_bit_cast(float, __builtin_amdgcn_readlane(__builtin_bit_cast(int, hh ? gB : gA), k));
                const float* ur = U + (size_t)e * 1024; const float* vr = V + (size_t)e * 1024;
                f32x4 uv[4], vv[4];
#pragma unroll
                for (int j = 0; j < 4; ++j) { uv[j] = *(const f32x4*)(ur + 256 * j + 4 * lane); vv[j] = *(const f32x4*)(vr + 256 * j + 4 * lane); }
                float d = 0.f;
#pragma unroll
                for (int j = 0; j < 4; ++j) d += (uv[j].x * x[j].x + uv[j].y * x[j].y) + (uv[j].z * x[j].z + uv[j].w * x[j].w);
                d = wave_sum(d);
                const float c = gt * gelu_tanh(d * rstd2);
#pragma unroll
                for (int j = 0; j < 4; ++j) y[j] += vv[j] * c;
            }
        }
        float sq = 0.f;
#pragma unroll
        for (int j = 0; j < 4; ++j) {
            const f32x4 h2 = hv[j] + y[j];
            *(f32x4*)(hr + 256 * j + 4 * lane) = h2;
            sq += (h2.x * h2.x + h2.y * h2.y) + (h2.z * h2.z + h2.w * h2.w);
            uint2 w; w.x = pk2(h2.x, h2.y); w.y = pk2(h2.z, h2.w);
            *(uint2*)(h2b + (size_t)t * 1024 + 256 * j + 4 * lane) = w;
        }
        sq = wave_sum(sq);
        if (lane == 0) rstd3[t] = 1.0f / sqrtf(sq * (1.0f / 1024.0f) + EPS);
    } else {
        float x[2][8], y[2][8], hv[2][8];
#pragma unroll
        for (int j = 0; j < 2; ++j) {
            const f32x4 a = *(const f32x4*)(hr + 512 * j + 8 * lane), b = *(const f32x4*)(hr + 512 * j + 8 * lane + 4);
            hv[j][0] = a.x; hv[j][1] = a.y; hv[j][2] = a.z; hv[j][3] = a.w; hv[j][4] = b.x; hv[j][5] = b.y; hv[j][6] = b.z; hv[j][7] = b.w;
#pragma unroll
            for (int c = 0; c < 8; ++c) { x[j][c] = hv[j][c]; y[j][c] = 0.f; }
        }
        const bf16* U = (const bf16*)Utab; const bf16* V = (const bf16*)Vtab;
        for (int k = 0; k < 64; k += 2) {
            u32x4 uv[4][2], vv[4][2]; float gt[4];
#pragma unroll
            for (int q = 0; q < 4; ++q) {
                const int kk = k + (q >> 1); const int hh = q & 1;
                const int e = __builtin_amdgcn_readlane(hh ? iB : iA, kk);
                gt[q] = __builtin_bit_cast(float, __builtin_amdgcn_readlane(__builtin_bit_cast(int, hh ? gB : gA), kk));
                const bf16* ur = U + (size_t)e * 1024; const bf16* vr = V + (size_t)e * 1024;
#pragma unroll
                for (int j = 0; j < 2; ++j) { uv[q][j] = *(const u32x4*)(ur + 512 * j + 8 * lane); vv[q][j] = *(const u32x4*)(vr + 512 * j + 8 * lane); }
            }
#pragma unroll
            for (int q = 0; q < 4; ++q) {
                float d = 0.f;
#pragma unroll
                for (int j = 0; j < 2; ++j)
#pragma unroll
                    for (int c = 0; c < 4; ++c) { const unsigned w = uv[q][j][c]; d = fmaf(__builtin_bit_cast(float, w << 16), x[j][2 * c], d); d = fmaf(__builtin_bit_cast(float, w & 0xffff0000u), x[j][2 * c + 1], d); }
                d = wave_sum(d);
                const float cf = gt[q] * gelu_tanh(d * rstd2);
#pragma unroll
                for (int j = 0; j < 2; ++j)
#pragma unroll
                    for (int c = 0; c < 4; ++c) { const unsigned w = vv[q][j][c]; y[j][2 * c] = fmaf(__builtin_bit_cast(float, w << 16), cf, y[j][2 * c]); y[j][2 * c + 1] = fmaf(__builtin_bit_cast(float, w & 0xffff0000u), cf, y[j][2 * c + 1]); }
            }
        }
        float sq = 0.f;
#pragma unroll
        for (int j = 0; j < 2; ++j) {
            float h2[8];
#pragma unroll
            for (int c = 0; c < 8; ++c) { h2[c] = hv[j][c] + y[j][c]; sq += h2[c] * h2[c]; }
            *(f32x4*)(hr + 512 * j + 8 * lane) = (f32x4){h2[0], h2[1], h2[2], h2[3]};
            *(f32x4*)(hr + 512 * j + 8 * lane + 4) = (f32x4){h2[4], h2[5], h2[6], h2[7]};
            u32x4 w; w.x = pk2(h2[0], h2[1]); w.y = pk2(h2[2], h2[3]); w.z = pk2(h2[4], h2[5]); w.w = pk2(h2[6], h2[7]);
            *(u32x4*)(h2b + (size_t)t * 1024 + 512 * j + 8 * lane) = w;
        }
        sq = wave_sum(sq);
        if (lane == 0) rstd3[t] = 1.0f / sqrtf(sq * (1.0f / 1024.0f) + EPS);
    }
}
template <int MODE>
__global__ void __launch_bounds__(256) gather_kernel(const void* __restrict__ Utab, const void* __restrict__ Vtab, const float* __restrict__ gffn, const int* __restrict__ seli, const float* __restrict__ selg,
                                                     const float* __restrict__ part2, float* __restrict__ H, bf16* __restrict__ h2b, float* __restrict__ rstd3) {
    const int lane = threadIdx.x & 63; const int w = blockIdx.x * 4 + (threadIdx.x >> 6); const int nw = gridDim.x * 4;
    for (int t = w; t < T_; t += nw) gather_token<MODE>(t, lane, Utab, Vtab, gffn, seli, selg, part2, H, h2b, rstd3);
}

typedef float f32x2 __attribute__((ext_vector_type(2)));
__device__ __forceinline__ float reduce4_transpose(float d0, float d1, float d2, float d3, int lane) {
    const bool b0 = lane & 1, b1 = lane & 2;
    const float a = (b0 ? d1 : d0) + __shfl_xor(b0 ? d0 : d1, 1);
    const float b = (b0 ? d3 : d2) + __shfl_xor(b0 ? d2 : d3, 1);
    float c = (b1 ? b : a) + __shfl_xor(b1 ? a : b, 2);
    c += __shfl_xor(c, 4); c += __shfl_xor(c, 8); c += __shfl_xor(c, 16); c += __shfl_xor(c, 32);
    return c;
}
__device__ __forceinline__ float dot16_fp8(const u32x4 w, const f32x2 (&x2)[8]) {
    f32x2 acc = (f32x2){0.f, 0.f};
#pragma unroll
    for (int c = 0; c < 4; ++c) { const unsigned ww = w[c]; const f32x2 lo = __builtin_amdgcn_cvt_pk_f32_fp8(ww, false), hi = __builtin_amdgcn_cvt_pk_f32_fp8(ww, true); acc = lo * x2[2 * c] + acc; acc = hi * x2[2 * c + 1] + acc; }
    return acc.x + acc.y;
}
__device__ __forceinline__ void axpy16_fp8(const u32x4 w, float cf, f32x2 (&y2)[8]) {
#pragma unroll
    for (int c = 0; c < 4; ++c) { const unsigned ww = w[c]; const f32x2 lo = __builtin_amdgcn_cvt_pk_f32_fp8(ww, false), hi = __builtin_amdgcn_cvt_pk_f32_fp8(ww, true); y2[2 * c] = lo * cf + y2[2 * c]; y2[2 * c + 1] = hi * cf + y2[2 * c + 1]; }
}
__device__ __forceinline__ float sel4f(float v0, float v1, float v2, float v3, int q) { return q == 0 ? v0 : (q == 1 ? v1 : (q == 2 ? v2 : v3)); }
__device__ __forceinline__ void gather_token_fp8(int t, int lane, const unsigned char* __restrict__ U8, const unsigned char* __restrict__ V8, const float* __restrict__ IU, const float* __restrict__ IV,
                                                 const int* __restrict__ seli, const float* __restrict__ selg, const float* __restrict__ part2,
                                                 float* __restrict__ H, bf16* __restrict__ h2b, float* __restrict__ rstd3) {
    float ps = (lane < 16) ? part2[(size_t)t * 16 + lane] : 0.f;
    ps = wave_sum(ps);
    const float rstd2 = 1.0f / sqrtf(ps * (1.0f / 1024.0f) + EPS);
    const int iA = seli[(size_t)t * 128 + lane], iB = seli[(size_t)t * 128 + 64 + lane];
    const float duA = IU[iA] * rstd2, duB = IU[iB] * rstd2;
    const float gvA = selg[(size_t)t * 128 + lane] * IV[iA], gvB = selg[(size_t)t * 128 + 64 + lane] * IV[iB];
    float* hr = H + (size_t)t * 1024 + 16 * lane;
    f32x2 x2[8], y2[8]; f32x4 hv[4];
#pragma unroll
    for (int j = 0; j < 4; ++j) { hv[j] = *(const f32x4*)(hr + 4 * j); x2[2 * j] = (f32x2){hv[j][0], hv[j][1]}; x2[2 * j + 1] = (f32x2){hv[j][2], hv[j][3]}; y2[2 * j] = (f32x2){0.f, 0.f}; y2[2 * j + 1] = (f32x2){0.f, 0.f}; }
    const int q = lane & 3;
#pragma unroll 1
    for (int k = 0; k < 64; k += 4) {
        u32x4 uu[8], vv[8]; float du[8], gv[8];
#pragma unroll
        for (int s = 0; s < 8; ++s) {
            const int kk = k + (s >> 1); const bool hh = s & 1;
            const int e = __builtin_amdgcn_readlane(hh ? iB : iA, kk);
            du[s] = __int_as_float(__builtin_amdgcn_readlane(__float_as_int(hh ? duB : duA), kk));
            gv[s] = __int_as_float(__builtin_amdgcn_readlane(__float_as_int(hh ? gvB : gvA), kk));
            uu[s] = *(const u32x4*)(U8 + (size_t)e * 1024 + 16 * lane);
            vv[s] = *(const u32x4*)(V8 + (size_t)e * 1024 + 16 * lane);
        }
#pragma unroll
        for (int g = 0; g < 2; ++g) {
            const float d0 = dot16_fp8(uu[4 * g + 0], x2), d1 = dot16_fp8(uu[4 * g + 1], x2), d2 = dot16_fp8(uu[4 * g + 2], x2), d3 = dot16_fp8(uu[4 * g + 3], x2);
            const float tot = reduce4_transpose(d0, d1, d2, d3, lane);
            const float z = tot * sel4f(du[4 * g], du[4 * g + 1], du[4 * g + 2], du[4 * g + 3], q);
            const float cf = gelu_tanh(z) * sel4f(gv[4 * g], gv[4 * g + 1], gv[4 * g + 2], gv[4 * g + 3], q);
#pragma unroll
            for (int s = 0; s < 4; ++s) { const float cs = __int_as_float(__builtin_amdgcn_readlane(__float_as_int(cf), s)); axpy16_fp8(vv[4 * g + s], cs, y2); }
        }
    }
    float sq = 0.f;
    f32x4 h2[4];
#pragma unroll
    for (int j = 0; j < 4; ++j) {
        h2[j] = hv[j] + (f32x4){y2[2 * j].x, y2[2 * j].y, y2[2 * j + 1].x, y2[2 * j + 1].y};
        *(f32x4*)(hr + 4 * j) = h2[j];
        sq += (h2[j][0] * h2[j][0] + h2[j][1] * h2[j][1]) + (h2[j][2] * h2[j][2] + h2[j][3] * h2[j][3]);
    }
    u32x4 w0, w1; w0.x = pk2(h2[0][0], h2[0][1]); w0.y = pk2(h2[0][2], h2[0][3]); w0.z = pk2(h2[1][0], h2[1][1]); w0.w = pk2(h2[1][2], h2[1][3]);
    w1.x = pk2(h2[2][0], h2[2][1]); w1.y = pk2(h2[2][2], h2[2][3]); w1.z = pk2(h2[3][0], h2[3][1]); w1.w = pk2(h2[3][2], h2[3][3]);
    u32x4* ob = (u32x4*)(h2b + (size_t)t * 1024 + 16 * lane); ob[0] = w0; ob[1] = w1;
    sq = wave_sum(sq);
    if (lane == 0) rstd3[t] = 1.0f / sqrtf(sq * (1.0f / 1024.0f) + EPS);
}

__device__ __forceinline__ unsigned umin_(unsigned a, unsigned b) { return a < b ? a : b; }
__device__ __forceinline__ unsigned umax_(unsigned a, unsigned b) { return a > b ? a : b; }
__device__ __forceinline__ void sort128(unsigned& k0, unsigned& k1, int lane) {
#pragma unroll
    for (int k = 2; k <= 128; k <<= 1) {
#pragma unroll
        for (int j = k >> 1; j >= 1; j >>= 1) {
            if (j == 64) { const unsigned mn = umin_(k0, k1), mx = umax_(k0, k1); k0 = mn; k1 = mx; }
            else {
                const unsigned o0 = (unsigned)__shfl_xor((int)k0, j), o1 = (unsigned)__shfl_xor((int)k1, j);
                const bool up0 = (k == 128) ? true : (k == 64 ? true : ((lane & k) == 0));
                const bool up1 = (k == 128) ? true : (k == 64 ? false : ((lane & k) == 0));
                const bool lower = (lane & j) == 0;
                k0 = (lower == up0) ? umin_(k0, o0) : umax_(k0, o0);
                k1 = (lower == up1) ? umin_(k1, o1) : umax_(k1, o1);
            }
        }
    }
}
typedef int i32x4v __attribute__((ext_vector_type(4)));
#ifndef NSLICE
#define NSLICE 8
#endif
#define SLICE_SHIFT (NSLICE == 32 ? 25 : (NSLICE == 16 ? 26 : (NSLICE == 8 ? 27 : (NSLICE == 4 ? 28 : 30))))
typedef unsigned u32x2 __attribute__((ext_vector_type(2)));
__device__ __forceinline__ f32x4 bf4_lo(u32x2 w) { return (f32x4){__builtin_bit_cast(float, w.x << 16), __builtin_bit_cast(float, w.x & 0xffff0000u), __builtin_bit_cast(float, w.y << 16), __builtin_bit_cast(float, w.y & 0xffff0000u)}; }
struct TokState { f32x2 y2[8]; unsigned k0, k1; int bnd; float rsx; };
__device__ __forceinline__ int count_lt(const TokState& S, unsigned bound) {
    return __builtin_popcountll(__builtin_amdgcn_ballot_w64(S.k0 < bound)) + __builtin_popcountll(__builtin_amdgcn_ballot_w64(S.k1 < bound));
}
__device__ __forceinline__ int bperm_i(int srclane, int v) { return __builtin_amdgcn_ds_bpermute(srclane << 2, v); }
__device__ __forceinline__ float bperm_f(int srclane, float v) { return __int_as_float(__builtin_amdgcn_ds_bpermute(srclane << 2, __float_as_int(v))); }
template <int PM>
__device__ __forceinline__ void gather_batch(TokState& S, int p, int hi, int lane, const LAS unsigned char* xs, const unsigned char* __restrict__ U8, const unsigned char* __restrict__ V8, const float* __restrict__ IU, const float* __restrict__ IV) {
    const int n = (hi - p < 16) ? hi - p : 16;
    const int m = lane & 15, kq = lane >> 4;
    const int r = (m < n) ? p + m : hi - 1; const int sl = r & 63; const bool lo = r < 64;
    const unsigned ka = (unsigned)bperm_i(sl, (int)S.k0), kb = (unsigned)bperm_i(sl, (int)S.k1);
    const int es = (int)((lo ? ka : kb) >> 16);
    const unsigned key = lo ? ka : kb;
    const float dus = IU[es] * S.rsx, gvs = (m < n) ? (float)(key & 0xffffu) * (1.0f / 65535.0f) * IV[es] : 0.f;
    const unsigned char* ua = U8 + (size_t)es * 1024 + 16 * kq;
    i32x4v A[16];
    if (!(PM & 2)) {
#pragma unroll
        for (int s = 0; s < 16; ++s) { if (PM & 16) { const int e = __builtin_amdgcn_readlane(es, s); A[s] = *(const i32x4v*)(U8 + (size_t)e * 1024 + 16 * lane); } else A[s] = *(const i32x4v*)(ua + 64 * s); }
    }
    u32x4 vv[16];
    if (!(PM & 1)) {
#pragma unroll
        for (int q = 0; q < 8; ++q) if (q < n) { const int e = __builtin_amdgcn_readlane(es, q); vv[q] = *(const u32x4*)(V8 + (size_t)e * 1024 + 16 * lane); }
        if (n > 8) {
#pragma unroll
            for (int q = 8; q < 16; ++q) if (q < n) { const int e = __builtin_amdgcn_readlane(es, q); vv[q] = *(const u32x4*)(V8 + (size_t)e * 1024 + 16 * lane); }
        }
    }
    i32x4v acc = (i32x4v){0, 0, 0, 0};
    if (!(PM & 2)) {
#pragma unroll
        for (int s = 0; s < 16; ++s) { const i32x4v B = *(const LAS i32x4v*)(xs + 64 * s + 16 * kq); acc = __builtin_amdgcn_mfma_i32_16x16x64_i8(A[s], B, acc, 0, 0, 0); }
    } else { acc = (i32x4v){es, es + 1, es + 2, es + 3}; }
    float cf[4];
#pragma unroll
    for (int j = 0; j < 4; ++j) { const int sm = 4 * kq + j; const float d = bperm_f(sm, dus), g = bperm_f(sm, gvs); cf[j] = g * gelu_tanh((float)acc[j] * d); }
    if (PM & 1) { S.y2[0].x += (cf[0] + cf[1]) + (cf[2] + cf[3]); }
    else if (PM & 4) {
#pragma unroll
        for (int q = 0; q < 16; ++q) if (q < n) { const float cs = __int_as_float(__builtin_amdgcn_readlane(__float_as_int(cf[q & 3]), 16 * (q >> 2))); S.y2[q & 7].x += cs * __uint_as_float((vv[q].x ^ vv[q].y ^ vv[q].z ^ vv[q].w) & 0x3fffffffu); }
    } else {
#pragma unroll
        for (int q = 0; q < 8; ++q) if (q < n) { const float cs = __int_as_float(__builtin_amdgcn_readlane(__float_as_int(cf[q & 3]), 16 * (q >> 2))); axpy16_fp8(vv[q], cs, S.y2); }
        if (n > 8) {
#pragma unroll
            for (int q = 8; q < 16; ++q) if (q < n) { const float cs = __int_as_float(__builtin_amdgcn_readlane(__float_as_int(cf[q & 3]), 16 * (q >> 2))); axpy16_fp8(vv[q], cs, S.y2); }
        }
    }
    __builtin_amdgcn_sched_barrier(0);
}
__device__ __forceinline__ void tok_setup(TokState& S, int t, int lane, LAS unsigned char* xs, const int* __restrict__ seli, const float* __restrict__ selg,
                                          const float* __restrict__ part2, const bf16* __restrict__ h1b) {
    float ps = (lane < 16) ? part2[(size_t)t * 16 + lane] : 0.f;
    ps = wave_sum(ps);
    const float rstd2 = 1.0f / sqrtf(ps * (1.0f / 1024.0f) + EPS);
    f32x4 hv[4]; float am = 0.f;
    { const u32x4* br = (const u32x4*)(h1b + (size_t)t * 1024 + 16 * lane); const u32x4 b0 = br[0], b1 = br[1];
      hv[0] = bf4_lo((u32x2){b0.x, b0.y}); hv[1] = bf4_lo((u32x2){b0.z, b0.w}); hv[2] = bf4_lo((u32x2){b1.x, b1.y}); hv[3] = bf4_lo((u32x2){b1.z, b1.w}); }
#pragma unroll
    for (int j = 0; j < 4; ++j) { am = fmaxf(am, fmaxf(fmaxf(fabsf(hv[j][0]), fabsf(hv[j][1])), fmaxf(fabsf(hv[j][2]), fabsf(hv[j][3])))); }
#pragma unroll
    for (int o = 1; o < 64; o <<= 1) am = fmaxf(am, __shfl_xor(am, o));
    const float sx = am > 0.f ? 127.0f / am : 1.0f, isx = am > 0.f ? am * (1.0f / 127.0f) : 1.0f;
    u32x4 xq;
#pragma unroll
    for (int j = 0; j < 4; ++j) { unsigned w = 0u;
#pragma unroll
        for (int c = 0; c < 4; ++c) w |= ((unsigned)(int)__builtin_rintf(hv[j][c] * sx) & 0xffu) << (8 * c);
        xq[j] = w; }
    *(LAS u32x4*)(xs + 16 * lane) = xq;
    const int iA = seli[(size_t)t * 128 + lane], iB = seli[(size_t)t * 128 + 64 + lane];
    const float gA = selg[(size_t)t * 128 + lane], gB = selg[(size_t)t * 128 + 64 + lane];
    S.k0 = ((unsigned)iA << 16) | (unsigned)(gA * 65535.0f + 0.5f); S.k1 = ((unsigned)iB << 16) | (unsigned)(gB * 65535.0f + 0.5f);
    sort128(S.k0, S.k1, lane);
    S.rsx = rstd2 * isx;
    int bnd = 0;
#pragma unroll
    for (int s = 1; s <= NSLICE; ++s) { const int c = count_lt(S, (unsigned)s << SLICE_SHIFT); bnd = (lane == s) ? c : bnd; }
    S.bnd = bnd;
#pragma unroll
    for (int j = 0; j < 8; ++j) S.y2[j] = (f32x2){0.f, 0.f};
}
__device__ __forceinline__ void tok_finish(const TokState& S, int t, int lane, const bf16* __restrict__ h1b, bf16* __restrict__ h2b, float* __restrict__ rstd3) {
    const u32x4* br = (const u32x4*)(h1b + (size_t)t * 1024 + 16 * lane); const u32x4 b0 = br[0], b1 = br[1];
    f32x4 h2[4]; h2[0] = bf4_lo((u32x2){b0.x, b0.y}); h2[1] = bf4_lo((u32x2){b0.z, b0.w}); h2[2] = bf4_lo((u32x2){b1.x, b1.y}); h2[3] = bf4_lo((u32x2){b1.z, b1.w});
    float sq = 0.f;
#pragma unroll
    for (int j = 0; j < 4; ++j) {
        h2[j] = h2[j] + (f32x4){S.y2[2 * j].x, S.y2[2 * j].y, S.y2[2 * j + 1].x, S.y2[2 * j + 1].y};
        sq += (h2[j][0] * h2[j][0] + h2[j][1] * h2[j][1]) + (h2[j][2] * h2[j][2] + h2[j][3] * h2[j][3]);
    }
    u32x4 w0, w1; w0.x = pk2(h2[0][0], h2[0][1]); w0.y = pk2(h2[0][2], h2[0][3]); w0.z = pk2(h2[1][0], h2[1][1]); w0.w = pk2(h2[1][2], h2[1][3]);
    w1.x = pk2(h2[2][0], h2[2][1]); w1.y = pk2(h2[2][2], h2[2][3]); w1.z = pk2(h2[3][0], h2[3][1]); w1.w = pk2(h2[3][2], h2[3][3]);
    u32x4* ob = (u32x4*)(h2b + (size_t)t * 1024 + 16 * lane); ob[0] = w0; ob[1] = w1;
    sq = wave_sum(sq);
    if (lane == 0) rstd3[t] = 1.0f / sqrtf(sq * (1.0f / 1024.0f) + EPS);
}
__device__ __forceinline__ int dpp_xor8(int v) { return __builtin_amdgcn_update_dpp(0, v, 0x128, 0xf, 0xf, false); }
__device__ __forceinline__ int dpp_xor4(int v) { return __builtin_amdgcn_update_dpp(0, __builtin_amdgcn_update_dpp(0, v, 0x141, 0xf, 0xf, false), 0x1b, 0xf, 0xf, false); }
__device__ __forceinline__ int dpp_xor1(int v) { return __builtin_amdgcn_update_dpp(0, v, 0xb1, 0xf, 0xf, false); }
__device__ __forceinline__ int dpp_xor2(int v) { return __builtin_amdgcn_update_dpp(0, v, 0x4e, 0xf, 0xf, false); }
__device__ __forceinline__ int reduce16_rows(int (&p)[16], int lane) {
    int r8[8], r4[4], r2[2];
#pragma unroll
    for (int i = 0; i < 8; ++i) { const u32x2 s = __builtin_amdgcn_permlane32_swap((unsigned)p[i], (unsigned)p[i + 8], false, false); r8[i] = (int)(s.x + s.y); }
#pragma unroll
    for (int i = 0; i < 4; ++i) { const u32x2 s = __builtin_amdgcn_permlane16_swap((unsigned)r8[i], (unsigned)r8[i + 4], false, false); r4[i] = (int)(s.x + s.y); }
    const bool b3 = lane & 8, b2 = lane & 4;
#pragma unroll
    for (int i = 0; i < 2; ++i) { const int s0 = r4[i] + dpp_xor8(r4[i]), s1 = r4[i + 2] + dpp_xor8(r4[i + 2]); r2[i] = b3 ? s1 : s0; }
    const int keep = b2 ? r2[1] : r2[0], send = b2 ? r2[0] : r2[1];
    int t = keep + dpp_xor4(send);
    t += dpp_xor1(t); t += dpp_xor2(t);
    return t;
}
__device__ __forceinline__ float reduce16_rows(float (&p)[16], int lane) {
    float r8[8], r4[4], r2[2];
#pragma unroll
    for (int i = 0; i < 8; ++i) { const u32x2 s = __builtin_amdgcn_permlane32_swap(__float_as_uint(p[i]), __float_as_uint(p[i + 8]), false, false); r8[i] = __uint_as_float(s.x) + __uint_as_float(s.y); }
#pragma unroll
    for (int i = 0; i < 4; ++i) { const u32x2 s = __builtin_amdgcn_permlane16_swap(__float_as_uint(r8[i]), __float_as_uint(r8[i + 4]), false, false); r4[i] = __uint_as_float(s.x) + __uint_as_float(s.y); }
    const bool b3 = lane & 8, b2 = lane & 4;
#pragma unroll
    for (int i = 0; i < 2; ++i) { const float s0 = r4[i] + __int_as_float(dpp_xor8(__float_as_int(r4[i]))), s1 = r4[i + 2] + __int_as_float(dpp_xor8(__float_as_int(r4[i + 2]))); r2[i] = b3 ? s1 : s0; }
    const float keep = b2 ? r2[1] : r2[0], send = b2 ? r2[0] : r2[1];
    float t = keep + __int_as_float(dpp_xor4(__float_as_int(send)));
    t += __int_as_float(dpp_xor1(__float_as_int(t))); t += __int_as_float(dpp_xor2(__float_as_int(t)));
    return t;
}
struct TokState2 { f32x2 y2[8]; unsigned k0, k1; float rsx; };
template <int PM>
__device__ __forceinline__ void gather_batch_rows(TokState& S, int p, int hi, int lane, const LAS unsigned char* xs, const unsigned char* __restrict__ U8, const unsigned char* __restrict__ V8, const float* __restrict__ IU, const float* __restrict__ IV) {
    const int n = (hi - p < 16) ? hi - p : 16;
    const int slot = lane >> 2;
    const int r = (slot < n) ? p + slot : hi - 1; const int sl = r & 63; const bool lo = r < 64;
    const unsigned ka = (unsigned)bperm_i(sl, (int)S.k0), kb = (unsigned)bperm_i(sl, (int)S.k1);
    const unsigned key = lo ? ka : kb;
    const int es = (int)(key >> 16);
    const float dus = IU[es] * S.rsx, gvs = (slot < n) ? (float)(key & 0xffffu) * (1.0f / 65535.0f) * IV[es] : 0.f;
    i32x4v A[16]; u32x4 vv[16];
#pragma unroll
    for (int g = 0; g < 4; ++g) if (4 * g < n) {
#pragma unroll
        for (int q = 4 * g; q < 4 * g + 4; ++q) { int e = __builtin_amdgcn_readlane(es, 4 * q); if (PM & 32) e &= 1023; A[q] = *(const i32x4v*)(U8 + (size_t)e * 1024 + 16 * lane); }
    }
#pragma unroll
    for (int g = 0; g < 4; ++g) if (4 * g < n) {
#pragma unroll
        for (int q = 4 * g; q < 4 * g + 4; ++q) { int e = __builtin_amdgcn_readlane(es, 4 * q); if (PM & 32) e &= 1023; vv[q] = *(const u32x4*)(V8 + (size_t)e * 1024 + 16 * lane); }
    }
    const i32x4v X = *(const LAS i32x4v*)(xs + 16 * lane);
    int pp[16];
#pragma unroll
    for (int g = 0; g < 4; ++g) {
        if (4 * g < n) {
#pragma unroll
            for (int q = 4 * g; q < 4 * g + 4; ++q) pp[q] = __builtin_amdgcn_sdot4(A[q][3], X[3], __builtin_amdgcn_sdot4(A[q][2], X[2], __builtin_amdgcn_sdot4(A[q][1], X[1], __builtin_amdgcn_sdot4(A[q][0], X[0], 0, false), false), false), false);
        } else {
#pragma unroll
            for (int q = 4 * g; q < 4 * g + 4; ++q) pp[q] = 0;
        }
    }
    const int tot = reduce16_rows(pp, lane);
    const float cf = gvs * gelu_tanh((float)tot * dus);
#pragma unroll
    for (int g = 0; g < 4; ++g) if (4 * g < n) {
#pragma unroll
        for (int q = 4 * g; q < 4 * g + 4; ++q) { const float cs = __int_as_float(__builtin_amdgcn_readlane(__float_as_int(cf), 4 * q)); axpy16_fp8(vv[q], cs, S.y2); }
    }
    __builtin_amdgcn_sched_barrier(0);
}

template <int PM>
__device__ __forceinline__ void gather_batch16(TokState2& S, int bi, int lane, const LAS unsigned char* xs, const unsigned char* __restrict__ U8, const unsigned char* __restrict__ V8, const float* __restrict__ IU, const float* __restrict__ IV) {
    const unsigned ksel = (bi < 4) ? S.k0 : S.k1;
    const int lb = (bi & 3) << 4;
    const unsigned key = (unsigned)bperm_i(lb + (lane >> 2), (int)ksel);
    const int es = (int)(key >> 16);
    const float dus = IU[es] * S.rsx, gvs = (float)(key & 0xffffu) * (1.0f / 65535.0f) * IV[es];
    i32x4v A[16]; u32x4 vv[16];
#pragma unroll
    for (int q = 0; q < 16; ++q) { int e = (int)((unsigned)__builtin_amdgcn_readlane((int)ksel, lb + q) >> 16); if (PM & 32) e &= 1023; if (!(PM & 2)) A[q] = *(const i32x4v*)(U8 + (size_t)e * 1024 + 16 * lane); else A[q] = (i32x4v){e, e, e, e}; }
#pragma unroll
    for (int q = 0; q < 16; ++q) { int e = (int)((unsigned)__builtin_amdgcn_readlane((int)ksel, lb + q) >> 16); if (PM & 32) e &= 1023; if (!(PM & 1)) vv[q] = *(const u32x4*)(V8 + (size_t)e * 1024 + 16 * lane); else vv[q] = (u32x4){(unsigned)e, 0u, 0u, 0u}; }
    const i32x4v X = *(const LAS i32x4v*)(xs + 16 * lane);
    int p[16];
#pragma unroll
    for (int q = 0; q < 16; ++q) p[q] = __builtin_amdgcn_sdot4(A[q][3], X[3], __builtin_amdgcn_sdot4(A[q][2], X[2], __builtin_amdgcn_sdot4(A[q][1], X[1], __builtin_amdgcn_sdot4(A[q][0], X[0], 0, false), false), false), false);
    const int tot = reduce16_rows(p, lane);
    const float cf = gvs * gelu_tanh((float)tot * dus);
#pragma unroll
    for (int q = 0; q < 16; ++q) { const float cs = __int_as_float(__builtin_amdgcn_readlane(__float_as_int(cf), 4 * q)); if (PM & 1) S.y2[q & 7].x += cs * __uint_as_float(vv[q].x); else axpy16_fp8(vv[q], cs, S.y2); }
    __builtin_amdgcn_sched_barrier(0);
}
__device__ __forceinline__ void tok_setup2(TokState2& S, int t, int lane, LAS unsigned char* xs, const int* __restrict__ seli, const float* __restrict__ selg,
                                           const float* __restrict__ part2, const bf16* __restrict__ h1b) {
    float ps = (lane < 16) ? part2[(size_t)t * 16 + lane] : 0.f;
    ps = wave_sum(ps);
    const float rstd2 = 1.0f / sqrtf(ps * (1.0f / 1024.0f) + EPS);
    f32x4 hv[4]; float am = 0.f;
    { const u32x4* br = (const u32x4*)(h1b + (size_t)t * 1024 + 16 * lane); const u32x4 b0 = br[0], b1 = br[1];
      hv[0] = bf4_lo((u32x2){b0.x, b0.y}); hv[1] = bf4_lo((u32x2){b0.z, b0.w}); hv[2] = bf4_lo((u32x2){b1.x, b1.y}); hv[3] = bf4_lo((u32x2){b1.z, b1.w}); }
#pragma unroll
    for (int j = 0; j < 4; ++j) { am = fmaxf(am, fmaxf(fmaxf(fabsf(hv[j][0]), fabsf(hv[j][1])), fmaxf(fabsf(hv[j][2]), fabsf(hv[j][3])))); }
#pragma unroll
    for (int o = 1; o < 64; o <<= 1) am = fmaxf(am, __shfl_xor(am, o));
    const float sx = am > 0.f ? 127.0f / am : 1.0f, isx = am > 0.f ? am * (1.0f / 127.0f) : 1.0f;
    u32x4 xq;
#pragma unroll
    for (int j = 0; j < 4; ++j) { unsigned w = 0u;
#pragma unroll
        for (int c = 0; c < 4; ++c) w |= ((unsigned)(int)__builtin_rintf(hv[j][c] * sx) & 0xffu) << (8 * c);
        xq[j] = w; }
    *(LAS u32x4*)(xs + 16 * lane) = xq;
    const int iA = seli[(size_t)t * 128 + lane], iB = seli[(size_t)t * 128 + 64 + lane];
    const float gA = selg[(size_t)t * 128 + lane], gB = selg[(size_t)t * 128 + 64 + lane];
    S.k0 = ((unsigned)iA << 16) | (unsigned)(gA * 65535.0f + 0.5f); S.k1 = ((unsigned)iB << 16) | (unsigned)(gB * 65535.0f + 0.5f);
    sort128(S.k0, S.k1, lane);
    S.rsx = rstd2 * isx;
#pragma unroll
    for (int j = 0; j < 8; ++j) S.y2[j] = (f32x2){0.f, 0.f};
}
__device__ __forceinline__ void tok_finish2(const TokState2& S, int t, int lane, const bf16* __restrict__ h1b, bf16* __restrict__ h2b, float* __restrict__ rstd3) {
    const u32x4* br = (const u32x4*)(h1b + (size_t)t * 1024 + 16 * lane); const u32x4 b0 = br[0], b1 = br[1];
    f32x4 h2[4]; h2[0] = bf4_lo((u32x2){b0.x, b0.y}); h2[1] = bf4_lo((u32x2){b0.z, b0.w}); h2[2] = bf4_lo((u32x2){b1.x, b1.y}); h2[3] = bf4_lo((u32x2){b1.z, b1.w});
    float sq = 0.f;
#pragma unroll
    for (int j = 0; j < 4; ++j) {
        h2[j] = h2[j] + (f32x4){S.y2[2 * j].x, S.y2[2 * j].y, S.y2[2 * j + 1].x, S.y2[2 * j + 1].y};
        sq += (h2[j][0] * h2[j][0] + h2[j][1] * h2[j][1]) + (h2[j][2] * h2[j][2] + h2[j][3] * h2[j][3]);
    }
    u32x4 w0, w1; w0.x = pk2(h2[0][0], h2[0][1]); w0.y = pk2(h2[0][2], h2[0][3]); w0.z = pk2(h2[1][0], h2[1][1]); w0.w = pk2(h2[1][2], h2[1][3]);
    w1.x = pk2(h2[2][0], h2[2][1]); w1.y = pk2(h2[2][2], h2[2][3]); w1.z = pk2(h2[3][0], h2[3][1]); w1.w = pk2(h2[3][2], h2[3][3]);
    u32x4* ob = (u32x4*)(h2b + (size_t)t * 1024 + 16 * lane); ob[0] = w0; ob[1] = w1;
    sq = wave_sum(sq);
    if (lane == 0) rstd3[t] = 1.0f / sqrtf(sq * (1.0f / 1024.0f) + EPS);
}
template <int PM>
__device__ __forceinline__ void gather_wg_rows(int tok0, int wave, int lane, LAS unsigned char* lds, const unsigned char* __restrict__ U8, const unsigned char* __restrict__ V8, const float* __restrict__ IU, const float* __restrict__ IV,
                                               const int* __restrict__ seli, const float* __restrict__ selg, const float* __restrict__ part2, const bf16* __restrict__ h1b, bf16* __restrict__ h2b, float* __restrict__ rstd3, float* probe_out) {
    LAS unsigned char* xs = lds + wave * 4096;
#pragma unroll 1
    for (int pass = 0; pass < 2; ++pass) {
        const int tb = tok0 + pass * 32 + wave * 4;
        TokState2 S0, S1, S2, S3;
        tok_setup2(S0, tb + 0, fresh_lane(), xs, seli, selg, part2, h1b); __builtin_amdgcn_sched_barrier(0);
        tok_setup2(S1, tb + 1, fresh_lane(), xs + 1024, seli, selg, part2, h1b); __builtin_amdgcn_sched_barrier(0);
        tok_setup2(S2, tb + 2, fresh_lane(), xs + 2048, seli, selg, part2, h1b); __builtin_amdgcn_sched_barrier(0);
        tok_setup2(S3, tb + 3, fresh_lane(), xs + 3072, seli, selg, part2, h1b); __builtin_amdgcn_sched_barrier(0);
        __syncthreads();
        lane = fresh_lane();
#pragma unroll 1
        for (int bi = 0; bi < 8; ++bi) {
            gather_batch16<PM>(S0, bi, lane, xs, U8, V8, IU, IV);
            gather_batch16<PM>(S1, bi, lane, xs + 1024, U8, V8, IU, IV);
            gather_batch16<PM>(S2, bi, lane, xs + 2048, U8, V8, IU, IV);
            gather_batch16<PM>(S3, bi, lane, xs + 3072, U8, V8, IU, IV);
        }
        if (PM != 0) { const int fl = fresh_lane(); f32x2 a = S0.y2[0] + S1.y2[0] + S2.y2[0] + S3.y2[0];
#pragma unroll
            for (int j = 1; j < 8; ++j) a += S0.y2[j] + S1.y2[j] + S2.y2[j] + S3.y2[j];
            probe_out[(size_t)tb * 64 + fl] = a.x + a.y; }
        else { const int fl = fresh_lane(); tok_finish2(S0, tb, fl, h1b, h2b, rstd3); tok_finish2(S1, tb + 1, fl, h1b, h2b, rstd3); tok_finish2(S2, tb + 2, fl, h1b, h2b, rstd3); tok_finish2(S3, tb + 3, fl, h1b, h2b, rstd3); }
        __syncthreads();
    }
}
#if GATHER_ROWS == 2
#define GATHER_BATCH_FN gather_batch_rows
#else
#define GATHER_BATCH_FN gather_batch
#endif
template <int PM>
__device__ __forceinline__ void gather_wg_sliced(int tok0, int wave, int lane, LAS unsigned char* lds, const unsigned char* __restrict__ U8, const unsigned char* __restrict__ V8, const float* __restrict__ IU, const float* __restrict__ IV,
                                                 const int* __restrict__ seli, const float* __restrict__ selg, const float* __restrict__ part2, float* __restrict__ H, const bf16* __restrict__ h1b, bf16* __restrict__ h2b, float* __restrict__ rstd3, float* probe_out) {
    LAS unsigned char* xs = lds + wave * 4096;
#pragma unroll 1
    for (int pass = 0; pass < 2; ++pass) {
        const int tb = tok0 + pass * 32 + wave * 4;
        TokState S0, S1, S2, S3;
        tok_setup(S0, tb + 0, fresh_lane(), xs, seli, selg, part2, h1b); __builtin_amdgcn_sched_barrier(0);
        tok_setup(S1, tb + 1, fresh_lane(), xs + 1024, seli, selg, part2, h1b); __builtin_amdgcn_sched_barrier(0);
        tok_setup(S2, tb + 2, fresh_lane(), xs + 2048, seli, selg, part2, h1b); __builtin_amdgcn_sched_barrier(0);
        tok_setup(S3, tb + 3, fresh_lane(), xs + 3072, seli, selg, part2, h1b); __builtin_amdgcn_sched_barrier(0);
        __syncthreads();
        lane = fresh_lane();
        int lo0 = 0, lo1 = 0, lo2 = 0, lo3 = 0;
#pragma unroll 1
        for (int s = 0; s < NSLICE; ++s) {
            { const int hi = __builtin_amdgcn_readlane(S0.bnd, s + 1); for (int p = lo0; p < hi; p += 16) GATHER_BATCH_FN<PM>(S0, p, hi, lane, xs, U8, V8, IU, IV); lo0 = hi; }
            { const int hi = __builtin_amdgcn_readlane(S1.bnd, s + 1); for (int p = lo1; p < hi; p += 16) GATHER_BATCH_FN<PM>(S1, p, hi, lane, xs + 1024, U8, V8, IU, IV); lo1 = hi; }
            { const int hi = __builtin_amdgcn_readlane(S2.bnd, s + 1); for (int p = lo2; p < hi; p += 16) GATHER_BATCH_FN<PM>(S2, p, hi, lane, xs + 2048, U8, V8, IU, IV); lo2 = hi; }
            { const int hi = __builtin_amdgcn_readlane(S3.bnd, s + 1); for (int p = lo3; p < hi; p += 16) GATHER_BATCH_FN<PM>(S3, p, hi, lane, xs + 3072, U8, V8, IU, IV); lo3 = hi; }
        }
        if (probe_out) { const int fl = fresh_lane(); f32x2 a = S0.y2[0] + S1.y2[0] + S2.y2[0] + S3.y2[0];
#pragma unroll
            for (int j = 1; j < 8; ++j) a += S0.y2[j] + S1.y2[j] + S2.y2[j] + S3.y2[j];
            probe_out[(size_t)tb * 64 + fl] = a.x + a.y; }
        else { const int fl = fresh_lane(); tok_finish(S0, tb, fl, h1b, h2b, rstd3); tok_finish(S1, tb + 1, fl, h1b, h2b, rstd3); tok_finish(S2, tb + 2, fl, h1b, h2b, rstd3); tok_finish(S3, tb + 3, fl, h1b, h2b, rstd3); }
        __syncthreads();
    }
}


__device__ __forceinline__ unsigned xor16_val(unsigned v, bool hi16) { const u32x2 s = __builtin_amdgcn_permlane16_swap(v, v, false, false); return hi16 ? s.x : s.y; }
__device__ __forceinline__ unsigned xor32_val(unsigned v, bool hi32) { const u32x2 s = __builtin_amdgcn_permlane32_swap(v, v, false, false); return hi32 ? s.x : s.y; }
__device__ __forceinline__ float wave_sum_x(float v) {
    v += __int_as_float(dpp_xor1(__float_as_int(v))); v += __int_as_float(dpp_xor2(__float_as_int(v))); v += __int_as_float(dpp_xor4(__float_as_int(v))); v += __int_as_float(dpp_xor8(__float_as_int(v)));
    { const u32x2 s = __builtin_amdgcn_permlane16_swap(__float_as_uint(v), __float_as_uint(v), false, false); v = __uint_as_float(s.x) + __uint_as_float(s.y); }
    { const u32x2 s = __builtin_amdgcn_permlane32_swap(__float_as_uint(v), __float_as_uint(v), false, false); v = __uint_as_float(s.x) + __uint_as_float(s.y); }
    return v;
}
__device__ __forceinline__ float wave_max_x(float v) {
    v = fmaxf(v, __int_as_float(dpp_xor1(__float_as_int(v)))); v = fmaxf(v, __int_as_float(dpp_xor2(__float_as_int(v)))); v = fmaxf(v, __int_as_float(dpp_xor4(__float_as_int(v)))); v = fmaxf(v, __int_as_float(dpp_xor8(__float_as_int(v))));
    { const u32x2 s = __builtin_amdgcn_permlane16_swap(__float_as_uint(v), __float_as_uint(v), false, false); v = fmaxf(__uint_as_float(s.x), __uint_as_float(s.y)); }
    { const u32x2 s = __builtin_amdgcn_permlane32_swap(__float_as_uint(v), __float_as_uint(v), false, false); v = fmaxf(__uint_as_float(s.x), __uint_as_float(s.y)); }
    return v;
}
template <int J> __device__ __forceinline__ unsigned xor_lane(unsigned v, int lane) {
    if (J == 1) return (unsigned)__builtin_amdgcn_update_dpp(0, (int)v, 0xb1, 0xf, 0xf, false);
    if (J == 2) return (unsigned)__builtin_amdgcn_update_dpp(0, (int)v, 0x4e, 0xf, 0xf, false);
    if (J == 4) return (unsigned)dpp_xor4((int)v);
    if (J == 8) return (unsigned)__builtin_amdgcn_update_dpp(0, (int)v, 0x128, 0xf, 0xf, false);
    if (J == 16) return xor16_val(v, (lane & 16) != 0);
    return xor32_val(v, (lane & 32) != 0);
}
template <int NR, int KK, int J>
__device__ __forceinline__ void sort_stage(unsigned (&k)[NR], int lane) {
    if (J >= 64) {
        constexpr int d = J >> 6;
#pragma unroll
        for (int r = 0; r < NR; ++r) if ((r & d) == 0) {
            const bool up = (KK == 64 * NR) ? true : (((64 * r) & KK) == 0);
            const unsigned mn = umin_(k[r], k[r + d]), mx = umax_(k[r], k[r + d]);
            k[r] = up ? mn : mx; k[r + d] = up ? mx : mn;
        }
    } else {
        const bool lower = (lane & J) == 0;
        unsigned o[NR];
#pragma unroll
        for (int r = 0; r < NR; ++r) o[r] = xor_lane<(J < 64 ? J : 1)>(k[r], lane);
#pragma unroll
        for (int r = 0; r < NR; ++r) {
            const bool up = (KK == 64 * NR) ? true : (KK >= 64 ? (((64 * r) & KK) == 0) : ((lane & KK) == 0));
            k[r] = (lower == up) ? umin_(k[r], o[r]) : umax_(k[r], o[r]);
        }
    }
}
template <int NR, int KK, int J> struct SortJ { static __device__ __forceinline__ void run(unsigned (&k)[NR], int lane) { sort_stage<NR, KK, J>(k, lane); SortJ<NR, KK, J / 2>::run(k, lane); } };
template <int NR, int KK> struct SortJ<NR, KK, 0> { static __device__ __forceinline__ void run(unsigned (&)[NR], int) {} };
template <int NR, int KK> struct SortK { static __device__ __forceinline__ void run(unsigned (&k)[NR], int lane) { SortK<NR, KK / 2>::run(k, lane); SortJ<NR, KK, KK / 2>::run(k, lane); } };
template <int NR> struct SortK<NR, 1> { static __device__ __forceinline__ void run(unsigned (&)[NR], int) {} };
template <int NR>
__device__ __forceinline__ void sort_wave(unsigned (&k)[NR], int lane) { SortK<NR, 64 * NR>::run(k, lane); }
__device__ __forceinline__ void axpy_dispatch2(int t, int tbase, float cs, const f32x2 (&x)[8], f32x2 (&Ya)[8], f32x2 (&Yb)[8]) {
    const unsigned long long c = (unsigned long long)__float_as_uint(cs);
    const int tt = t - tbase;
    asm volatile(
        "s_cmp_gt_u32 %[t], 1\n\t"
        "s_cbranch_scc1 3f\n\t"
        "s_cmp_eq_u32 %[t], 1\n\t"
        "s_cbranch_scc1 2f\n\t"
        "v_pk_fma_f32 %[a0], %[c], %[x0], %[a0] op_sel_hi:[0,1,1]\n\t"
        "v_pk_fma_f32 %[a1], %[c], %[x1], %[a1] op_sel_hi:[0,1,1]\n\t"
        "v_pk_fma_f32 %[a2], %[c], %[x2], %[a2] op_sel_hi:[0,1,1]\n\t"
        "v_pk_fma_f32 %[a3], %[c], %[x3], %[a3] op_sel_hi:[0,1,1]\n\t"
        "v_pk_fma_f32 %[a4], %[c], %[x4], %[a4] op_sel_hi:[0,1,1]\n\t"
        "v_pk_fma_f32 %[a5], %[c], %[x5], %[a5] op_sel_hi:[0,1,1]\n\t"
        "v_pk_fma_f32 %[a6], %[c], %[x6], %[a6] op_sel_hi:[0,1,1]\n\t"
        "v_pk_fma_f32 %[a7], %[c], %[x7], %[a7] op_sel_hi:[0,1,1]\n\t"
        "s_branch 3f\n"
        "2:\n\t"
        "v_pk_fma_f32 %[b0], %[c], %[x0], %[b0] op_sel_hi:[0,1,1]\n\t"
        "v_pk_fma_f32 %[b1], %[c], %[x1], %[b1] op_sel_hi:[0,1,1]\n\t"
        "v_pk_fma_f32 %[b2], %[c], %[x2], %[b2] op_sel_hi:[0,1,1]\n\t"
        "v_pk_fma_f32 %[b3], %[c], %[x3], %[b3] op_sel_hi:[0,1,1]\n\t"
        "v_pk_fma_f32 %[b4], %[c], %[x4], %[b4] op_sel_hi:[0,1,1]\n\t"
        "v_pk_fma_f32 %[b5], %[c], %[x5], %[b5] op_sel_hi:[0,1,1]\n\t"
        "v_pk_fma_f32 %[b6], %[c], %[x6], %[b6] op_sel_hi:[0,1,1]\n\t"
        "v_pk_fma_f32 %[b7], %[c], %[x7], %[b7] op_sel_hi:[0,1,1]\n"
        "3:\n\t"
        : [a0] "+v"(Ya[0]), [a1] "+v"(Ya[1]), [a2] "+v"(Ya[2]), [a3] "+v"(Ya[3]), [a4] "+v"(Ya[4]), [a5] "+v"(Ya[5]), [a6] "+v"(Ya[6]), [a7] "+v"(Ya[7]),
          [b0] "+v"(Yb[0]), [b1] "+v"(Yb[1]), [b2] "+v"(Yb[2]), [b3] "+v"(Yb[3]), [b4] "+v"(Yb[4]), [b5] "+v"(Yb[5]), [b6] "+v"(Yb[6]), [b7] "+v"(Yb[7])
        : [x0] "v"(x[0]), [x1] "v"(x[1]), [x2] "v"(x[2]), [x3] "v"(x[3]), [x4] "v"(x[4]), [x5] "v"(x[5]), [x6] "v"(x[6]), [x7] "v"(x[7]), [c] "s"(c), [t] "s"(tt)
        : "scc");
}
__device__ __forceinline__ void axpy_dispatch2_dup(int t, int tbase, float cs, const f32x2 (&x)[8], f32x2 (&Ya)[8], f32x2 (&Yb)[8]) {
    const unsigned long long c = (unsigned long long)__float_as_uint(cs);
    const int tt = t - tbase;
    asm volatile(
        "s_cmp_gt_u32 %[t], 1\n\t"
        "s_cbranch_scc1 3f\n\t"
        "s_cmp_eq_u32 %[t], 1\n\t"
        "s_cbranch_scc1 2f\n\t"
        "v_pk_fma_f32 %[a0], %[c], %[x0], %[a0] op_sel_hi:[0,1,1]\n\t"
        "v_pk_fma_f32 %[a0], %[c], %[x0], %[a0] op_sel_hi:[0,1,1]\n\t"
        "v_pk_fma_f32 %[a1], %[c], %[x1], %[a1] op_sel_hi:[0,1,1]\n\t"
        "v_pk_fma_f32 %[a1], %[c], %[x1], %[a1] op_sel_hi:[0,1,1]\n\t"
        "v_pk_fma_f32 %[a2], %[c], %[x2], %[a2] op_sel_hi:[0,1,1]\n\t"
        "v_pk_fma_f32 %[a2], %[c], %[x2], %[a2] op_sel_hi:[0,1,1]\n\t"
        "v_pk_fma_f32 %[a3], %[c], %[x3], %[a3] op_sel_hi:[0,1,1]\n\t"
        "v_pk_fma_f32 %[a3], %[c], %[x3], %[a3] op_sel_hi:[0,1,1]\n\t"
        "v_pk_fma_f32 %[a4], %[c], %[x4], %[a4] op_sel_hi:[0,1,1]\n\t"
        "v_pk_fma_f32 %[a4], %[c], %[x4], %[a4] op_sel_hi:[0,1,1]\n\t"
        "v_pk_fma_f32 %[a5], %[c], %[x5], %[a5] op_sel_hi:[0,1,1]\n\t"
        "v_pk_fma_f32 %[a5], %[c], %[x5], %[a5] op_sel_hi:[0,1,1]\n\t"
        "v_pk_fma_f32 %[a6], %[c], %[x6], %[a6] op_sel_hi:[0,1,1]\n\t"
        "v_pk_fma_f32 %[a6], %[c], %[x6], %[a6] op_sel_hi:[0,1,1]\n\t"
        "v_pk_fma_f32 %[a7], %[c], %[x7], %[a7] op_sel_hi:[0,1,1]\n\t"
        "v_pk_fma_f32 %[a7], %[c], %[x7], %[a7] op_sel_hi:[0,1,1]\n\t"
        "s_branch 3f\n"
        "2:\n\t"
        "v_pk_fma_f32 %[b0], %[c], %[x0], %[b0] op_sel_hi:[0,1,1]\n\t"
        "v_pk_fma_f32 %[b0], %[c], %[x0], %[b0] op_sel_hi:[0,1,1]\n\t"
        "v_pk_fma_f32 %[b1], %[c], %[x1], %[b1] op_sel_hi:[0,1,1]\n\t"
        "v_pk_fma_f32 %[b1], %[c], %[x1], %[b1] op_sel_hi:[0,1,1]\n\t"
        "v_pk_fma_f32 %[b2], %[c], %[x2], %[b2] op_sel_hi:[0,1,1]\n\t"
        "v_pk_fma_f32 %[b2], %[c], %[x2], %[b2] op_sel_hi:[0,1,1]\n\t"
        "v_pk_fma_f32 %[b3], %[c], %[x3], %[b3] op_sel_hi:[0,1,1]\n\t"
        "v_pk_fma_f32 %[b3], %[c], %[x3], %[b3] op_sel_hi:[0,1,1]\n\t"
        "v_pk_fma_f32 %[b4], %[c], %[x4], %[b4] op_sel_hi:[0,1,1]\n\t"
        "v_pk_fma_f32 %[b4], %[c], %[x4], %[b4] op_sel_hi:[0,1,1]\n\t"
        "v_pk_fma_f32 %[b5], %[c], %[x5], %[b5] op_sel_hi:[0,1,1]\n\t"
        "v_pk_fma_f32 %[b5], %[c], %[x5], %[b5] op_sel_hi:[0,1,1]\n\t"
        "v_pk_fma_f32 %[b6], %[c], %[x6], %[b6] op_sel_hi:[0,1,1]\n\t"
        "v_pk_fma_f32 %[b6], %[c], %[x6], %[b6] op_sel_hi:[0,1,1]\n\t"
        "v_pk_fma_f32 %[b7], %[c], %[x7], %[b7] op_sel_hi:[0,1,1]\n"
        "v_pk_fma_f32 %[b7], %[c], %[x7], %[b7] op_sel_hi:[0,1,1]\n"
        "3:\n\t"
        : [a0] "+v"(Ya[0]), [a1] "+v"(Ya[1]), [a2] "+v"(Ya[2]), [a3] "+v"(Ya[3]), [a4] "+v"(Ya[4]), [a5] "+v"(Ya[5]), [a6] "+v"(Ya[6]), [a7] "+v"(Ya[7]),
          [b0] "+v"(Yb[0]), [b1] "+v"(Yb[1]), [b2] "+v"(Yb[2]), [b3] "+v"(Yb[3]), [b4] "+v"(Yb[4]), [b5] "+v"(Yb[5]), [b6] "+v"(Yb[6]), [b7] "+v"(Yb[7])
        : [x0] "v"(x[0]), [x1] "v"(x[1]), [x2] "v"(x[2]), [x3] "v"(x[3]), [x4] "v"(x[4]), [x5] "v"(x[5]), [x6] "v"(x[6]), [x7] "v"(x[7]), [c] "s"(c), [t] "s"(tt)
        : "scc");
}
struct TokRaw { float ps; u32x4 b0, b1; int iA, iB; float gA, gB; };
__device__ __forceinline__ void tok_load_mixed(TokRaw& r, int t, int lane, const int* __restrict__ seli, const float* __restrict__ selg, const float* __restrict__ part2, const bf16* __restrict__ h1b) {
    r.ps = (lane < 16) ? part2[(size_t)t * 16 + lane] : 0.f;
    const u32x4* br = (const u32x4*)(h1b + (size_t)t * 1024 + 16 * lane); r.b0 = br[0]; r.b1 = br[1];
    r.iA = seli[(size_t)t * 128 + lane]; r.iB = seli[(size_t)t * 128 + 64 + lane];
    r.gA = selg[(size_t)t * 128 + lane]; r.gB = selg[(size_t)t * 128 + 64 + lane];
}
__device__ __forceinline__ float tok_prep_mixed(const TokRaw& r, unsigned& k0, unsigned& k1, int j, int lane, LAS unsigned char* xs) {
    const float ps = wave_sum_x(r.ps);
    const float rstd2 = 1.0f / sqrtf(ps * (1.0f / 1024.0f) + EPS);
    const u32x4 b0 = r.b0, b1 = r.b1;
#if U_FP6
    { u32x4 w0, w1;
#pragma unroll
      for (int c = 0; c < 4; ++c) { const unsigned a = b0[c], b = b1[c];
          w0[c] = __builtin_bit_cast(unsigned, __builtin_amdgcn_cvt_pkrtz(__uint_as_float(a << 16), __uint_as_float(a & 0xffff0000u)));
          w1[c] = __builtin_bit_cast(unsigned, __builtin_amdgcn_cvt_pkrtz(__uint_as_float(b << 16), __uint_as_float(b & 0xffff0000u))); }
      LAS u32x4* xp = (LAS u32x4*)(xs + 32 * lane); xp[0] = w0; xp[1] = w1; }
    const float isx = 1.0f;
#else
    f32x4 hv[4]; float am = 0.f;
    hv[0] = bf4_lo((u32x2){b0.x, b0.y}); hv[1] = bf4_lo((u32x2){b0.z, b0.w}); hv[2] = bf4_lo((u32x2){b1.x, b1.y}); hv[3] = bf4_lo((u32x2){b1.z, b1.w});
#pragma unroll
    for (int i = 0; i < 4; ++i) { am = fmaxf(am, fmaxf(fmaxf(fabsf(hv[i][0]), fabsf(hv[i][1])), fmaxf(fabsf(hv[i][2]), fabsf(hv[i][3])))); }
    am = wave_max_x(am);
    const float sx = am > 0.f ? 127.0f / am : 1.0f, isx = am > 0.f ? am * (1.0f / 127.0f) : 1.0f;
    u32x4 xq;
#pragma unroll
    for (int i = 0; i < 4; ++i) { unsigned w = 0u;
#pragma unroll
        for (int c = 0; c < 4; ++c) w |= ((unsigned)(int)__builtin_rintf(hv[i][c] * sx) & 0xffu) << (8 * c);
        xq[i] = w; }
    *(LAS u32x4*)(xs + 16 * lane) = xq;
#endif
    k0 = ((unsigned)r.iA << 18) | ((unsigned)j << 16) | (unsigned)(r.gA * 65535.0f + 0.5f); k1 = ((unsigned)r.iB << 18) | ((unsigned)j << 16) | (unsigned)(r.gB * 65535.0f + 0.5f);
    return rstd2 * isx;
}
__device__ __forceinline__ void tok_finish_loaded(const f32x2 (&y2)[8], const u32x4 b0, const u32x4 b1, int t, int lane, bf16* __restrict__ h2b, float* __restrict__ rstd3) {
    f32x4 h2[4]; h2[0] = bf4_lo((u32x2){b0.x, b0.y}); h2[1] = bf4_lo((u32x2){b0.z, b0.w}); h2[2] = bf4_lo((u32x2){b1.x, b1.y}); h2[3] = bf4_lo((u32x2){b1.z, b1.w});
    float sq = 0.f;
#pragma unroll
    for (int i = 0; i < 4; ++i) {
        h2[i] = h2[i] + (f32x4){y2[2 * i].x, y2[2 * i].y, y2[2 * i + 1].x, y2[2 * i + 1].y};
        sq += (h2[i][0] * h2[i][0] + h2[i][1] * h2[i][1]) + (h2[i][2] * h2[i][2] + h2[i][3] * h2[i][3]);
    }
    u32x4 w0, w1; w0.x = pk2(h2[0][0], h2[0][1]); w0.y = pk2(h2[0][2], h2[0][3]); w0.z = pk2(h2[1][0], h2[1][1]); w0.w = pk2(h2[1][2], h2[1][3]);
    w1.x = pk2(h2[2][0], h2[2][1]); w1.y = pk2(h2[2][2], h2[2][3]); w1.z = pk2(h2[3][0], h2[3][1]); w1.w = pk2(h2[3][2], h2[3][3]);
    u32x4* ob = (u32x4*)(h2b + (size_t)t * 1024 + 16 * lane); ob[0] = w0; ob[1] = w1;
    sq = wave_sum_x(sq);
    if (lane == 0) rstd3[t] = 1.0f / sqrtf(sq * (1.0f / 1024.0f) + EPS);
}
__device__ __forceinline__ float tok_setup_mixed(unsigned& k0, unsigned& k1, int t, int j, int lane, LAS unsigned char* xs, const int* __restrict__ seli, const float* __restrict__ selg,
                                                 const float* __restrict__ part2, const bf16* __restrict__ h1b) {
    float ps = (lane < 16) ? part2[(size_t)t * 16 + lane] : 0.f;
    ps = wave_sum_x(ps);
    const float rstd2 = 1.0f / sqrtf(ps * (1.0f / 1024.0f) + EPS);
#if U_FP6
    { const u32x4* br = (const u32x4*)(h1b + (size_t)t * 1024 + 16 * lane); const u32x4 b0 = br[0], b1 = br[1];
      u32x4 w0, w1;
#pragma unroll
      for (int c = 0; c < 4; ++c) { const unsigned a = b0[c], b = b1[c];
          w0[c] = __builtin_bit_cast(unsigned, __builtin_amdgcn_cvt_pkrtz(__uint_as_float(a << 16), __uint_as_float(a & 0xffff0000u)));
          w1[c] = __builtin_bit_cast(unsigned, __builtin_amdgcn_cvt_pkrtz(__uint_as_float(b << 16), __uint_as_float(b & 0xffff0000u))); }
      LAS u32x4* xp = (LAS u32x4*)(xs + 32 * lane); xp[0] = w0; xp[1] = w1; }
    const float isx = 1.0f;
#else
    f32x4 hv[4]; float am = 0.f;
    { const u32x4* br = (const u32x4*)(h1b + (size_t)t * 1024 + 16 * lane); const u32x4 b0 = br[0], b1 = br[1];
      hv[0] = bf4_lo((u32x2){b0.x, b0.y}); hv[1] = bf4_lo((u32x2){b0.z, b0.w}); hv[2] = bf4_lo((u32x2){b1.x, b1.y}); hv[3] = bf4_lo((u32x2){b1.z, b1.w}); }
#pragma unroll
    for (int i = 0; i < 4; ++i) { am = fmaxf(am, fmaxf(fmaxf(fabsf(hv[i][0]), fabsf(hv[i][1])), fmaxf(fabsf(hv[i][2]), fabsf(hv[i][3])))); }
    am = wave_max_x(am);
    const float sx = am > 0.f ? 127.0f / am : 1.0f, isx = am > 0.f ? am * (1.0f / 127.0f) : 1.0f;
    u32x4 xq;
#pragma unroll
    for (int i = 0; i < 4; ++i) { unsigned w = 0u;
#pragma unroll
        for (int c = 0; c < 4; ++c) w |= ((unsigned)(int)__builtin_rintf(hv[i][c] * sx) & 0xffu) << (8 * c);
        xq[i] = w; }
    *(LAS u32x4*)(xs + 16 * lane) = xq;
#endif
    const int iA = seli[(size_t)t * 128 + lane], iB = seli[(size_t)t * 128 + 64 + lane];
    const float gA = selg[(size_t)t * 128 + lane], gB = selg[(size_t)t * 128 + 64 + lane];
    k0 = ((unsigned)iA << 18) | ((unsigned)j << 16) | (unsigned)(gA * 65535.0f + 0.5f); k1 = ((unsigned)iB << 18) | ((unsigned)j << 16) | (unsigned)(gB * 65535.0f + 0.5f);
    return rstd2 * isx;
}
__device__ __forceinline__ void tok_finish_mixed(const f32x2 (&y2)[8], int t, int lane, const bf16* __restrict__ h1b, bf16* __restrict__ h2b, float* __restrict__ rstd3) {
    const u32x4* br = (const u32x4*)(h1b + (size_t)t * 1024 + 16 * lane); const u32x4 b0 = br[0], b1 = br[1];
    f32x4 h2[4]; h2[0] = bf4_lo((u32x2){b0.x, b0.y}); h2[1] = bf4_lo((u32x2){b0.z, b0.w}); h2[2] = bf4_lo((u32x2){b1.x, b1.y}); h2[3] = bf4_lo((u32x2){b1.z, b1.w});
    float sq = 0.f;
#pragma unroll
    for (int i = 0; i < 4; ++i) {
        h2[i] = h2[i] + (f32x4){y2[2 * i].x, y2[2 * i].y, y2[2 * i + 1].x, y2[2 * i + 1].y};
        sq += (h2[i][0] * h2[i][0] + h2[i][1] * h2[i][1]) + (h2[i][2] * h2[i][2] + h2[i][3] * h2[i][3]);
    }
    u32x4 w0, w1; w0.x = pk2(h2[0][0], h2[0][1]); w0.y = pk2(h2[0][2], h2[0][3]); w0.z = pk2(h2[1][0], h2[1][1]); w0.w = pk2(h2[1][2], h2[1][3]);
    w1.x = pk2(h2[2][0], h2[2][1]); w1.y = pk2(h2[2][2], h2[2][3]); w1.z = pk2(h2[3][0], h2[3][1]); w1.w = pk2(h2[3][2], h2[3][3]);
    u32x4* ob = (u32x4*)(h2b + (size_t)t * 1024 + 16 * lane); ob[0] = w0; ob[1] = w1;
    sq = wave_sum_x(sq);
    if (lane == 0) rstd3[t] = 1.0f / sqrtf(sq * (1.0f / 1024.0f) + EPS);
}
__device__ __forceinline__ i32x4v row_load(__amdgpu_buffer_rsrc_t r, int lane16, int e) { const u32x4 v = __builtin_amdgcn_raw_buffer_load_b128(r, lane16, e << 10, 0); return (i32x4v){(int)v.x, (int)v.y, (int)v.z, (int)v.w}; }
__device__ __forceinline__ u32x4 as_u32x4(i32x4v v) { return (u32x4){(unsigned)v.x, (unsigned)v.y, (unsigned)v.z, (unsigned)v.w}; }
typedef _Float16 h32v __attribute__((ext_vector_type(32)));
typedef _Float16 h2v __attribute__((ext_vector_type(2)));
#if U_FP6
typedef u32x3 UROW;
typedef __bf16 bf32v __attribute__((ext_vector_type(32)));
typedef __bf16 bf2v __attribute__((ext_vector_type(2)));
__device__ __forceinline__ UROW urow_load(__amdgpu_buffer_rsrc_t r, int lane, int e) { return __builtin_amdgcn_raw_buffer_load_b96(r, lane * 12, e * 768, 0); }
__device__ __forceinline__ UROW urow_dummy(int e) { return (UROW){(unsigned)e, 0u, 0u}; }
#else
typedef i32x4v UROW;
__device__ __forceinline__ UROW urow_load(__amdgpu_buffer_rsrc_t r, int lane, int e) { return row_load(r, lane << 4, e); }
__device__ __forceinline__ UROW urow_dummy(int e) { return (UROW){e, e, e, e}; }
#endif
#if V_FP6
typedef u32x3 VROW;
typedef unsigned u32x6 __attribute__((ext_vector_type(6)));
typedef float f32x32 __attribute__((ext_vector_type(32)));
__device__ __forceinline__ VROW vrow_load(__amdgpu_buffer_rsrc_t r, int lane, int e) { return __builtin_amdgcn_raw_buffer_load_b96(r, lane * 12, e * 768, 0); }
__device__ __forceinline__ VROW vrow_dummy(int e) { return (VROW){(unsigned)e, 0u, 0u}; }
#else
typedef u32x4 VROW;
__device__ __forceinline__ VROW vrow_load(__amdgpu_buffer_rsrc_t r, int lane, int e) { return as_u32x4(row_load(r, lane << 4, e)); }
__device__ __forceinline__ VROW vrow_dummy(int e) { return (VROW){(unsigned)e, 0u, 0u, 0u}; }
#endif
#if Y_F16
__device__ __forceinline__ void axpy_nobranch_h(unsigned c, const unsigned (&x)[8], unsigned (&Ya)[8]) {
    asm volatile(
        "v_pk_fma_f16 %[a0], %[c], %[x0], %[a0] op_sel_hi:[0,1,1]\n\t"
        "v_pk_fma_f16 %[a1], %[c], %[x1], %[a1] op_sel_hi:[0,1,1]\n\t"
        "v_pk_fma_f16 %[a2], %[c], %[x2], %[a2] op_sel_hi:[0,1,1]\n\t"
        "v_pk_fma_f16 %[a3], %[c], %[x3], %[a3] op_sel_hi:[0,1,1]\n\t"
        "v_pk_fma_f16 %[a4], %[c], %[x4], %[a4] op_sel_hi:[0,1,1]\n\t"
        "v_pk_fma_f16 %[a5], %[c], %[x5], %[a5] op_sel_hi:[0,1,1]\n\t"
        "v_pk_fma_f16 %[a6], %[c], %[x6], %[a6] op_sel_hi:[0,1,1]\n\t"
        "v_pk_fma_f16 %[a7], %[c], %[x7], %[a7] op_sel_hi:[0,1,1]\n\t"
        : [a0] "+v"(Ya[0]), [a1] "+v"(Ya[1]), [a2] "+v"(Ya[2]), [a3] "+v"(Ya[3]), [a4] "+v"(Ya[4]), [a5] "+v"(Ya[5]), [a6] "+v"(Ya[6]), [a7] "+v"(Ya[7])
        : [x0] "v"(x[0]), [x1] "v"(x[1]), [x2] "v"(x[2]), [x3] "v"(x[3]), [x4] "v"(x[4]), [x5] "v"(x[5]), [x6] "v"(x[6]), [x7] "v"(x[7]), [c] "s"(c));
}
#endif
#if Y_F16
__device__ __forceinline__ void axpy_dispatch2h(int t, int tbase, unsigned c, const unsigned (&x)[8], unsigned (&Ya)[8], unsigned (&Yb)[8]) {
    const int tt = t - tbase;
    asm volatile(
        "s_cmp_gt_u32 %[t], 1\n\t"
        "s_cbranch_scc1 3f\n\t"
        "s_cmp_eq_u32 %[t], 1\n\t"
        "s_cbranch_scc1 2f\n\t"
        "v_pk_fma_f16 %[a0], %[c], %[x0], %[a0] op_sel_hi:[0,1,1]\n\t"
        "v_pk_fma_f16 %[a1], %[c], %[x1], %[a1] op_sel_hi:[0,1,1]\n\t"
        "v_pk_fma_f16 %[a2], %[c], %[x2], %[a2] op_sel_hi:[0,1,1]\n\t"
        "v_pk_fma_f16 %[a3], %[c], %[x3], %[a3] op_sel_hi:[0,1,1]\n\t"
        "v_pk_fma_f16 %[a4], %[c], %[x4], %[a4] op_sel_hi:[0,1,1]\n\t"
        "v_pk_fma_f16 %[a5], %[c], %[x5], %[a5] op_sel_hi:[0,1,1]\n\t"
        "v_pk_fma_f16 %[a6], %[c], %[x6], %[a6] op_sel_hi:[0,1,1]\n\t"
        "v_pk_fma_f16 %[a7], %[c], %[x7], %[a7] op_sel_hi:[0,1,1]\n\t"
        "s_branch 3f\n"
        "2:\n\t"
        "v_pk_fma_f16 %[b0], %[c], %[x0], %[b0] op_sel_hi:[0,1,1]\n\t"
        "v_pk_fma_f16 %[b1], %[c], %[x1], %[b1] op_sel_hi:[0,1,1]\n\t"
        "v_pk_fma_f16 %[b2], %[c], %[x2], %[b2] op_sel_hi:[0,1,1]\n\t"
        "v_pk_fma_f16 %[b3], %[c], %[x3], %[b3] op_sel_hi:[0,1,1]\n\t"
        "v_pk_fma_f16 %[b4], %[c], %[x4], %[b4] op_sel_hi:[0,1,1]\n\t"
        "v_pk_fma_f16 %[b5], %[c], %[x5], %[b5] op_sel_hi:[0,1,1]\n\t"
        "v_pk_fma_f16 %[b6], %[c], %[x6], %[b6] op_sel_hi:[0,1,1]\n\t"
        "v_pk_fma_f16 %[b7], %[c], %[x7], %[b7] op_sel_hi:[0,1,1]\n"
        "3:\n\t"
        : [a0] "+v"(Ya[0]), [a1] "+v"(Ya[1]), [a2] "+v"(Ya[2]), [a3] "+v"(Ya[3]), [a4] "+v"(Ya[4]), [a5] "+v"(Ya[5]), [a6] "+v"(Ya[6]), [a7] "+v"(Ya[7]),
          [b0] "+v"(Yb[0]), [b1] "+v"(Yb[1]), [b2] "+v"(Yb[2]), [b3] "+v"(Yb[3]), [b4] "+v"(Yb[4]), [b5] "+v"(Yb[5]), [b6] "+v"(Yb[6]), [b7] "+v"(Yb[7])
        : [x0] "v"(x[0]), [x1] "v"(x[1]), [x2] "v"(x[2]), [x3] "v"(x[3]), [x4] "v"(x[4]), [x5] "v"(x[5]), [x6] "v"(x[6]), [x7] "v"(x[7]), [c] "s"(c), [t] "s"(tt)
        : "scc");
}
__device__ __forceinline__ void tok_finish_h_loaded(const unsigned (&Y)[8], const u32x4 b0, const u32x4 b1, int t, int lane, bf16* __restrict__ h2b, float* __restrict__ rstd3) {
    f32x2 y2[8];
#pragma unroll
    for (int c = 0; c < 8; ++c) { const unsigned w = Y[c]; const h2v hv = __builtin_bit_cast(h2v, w); y2[c] = (f32x2){(float)hv.x, (float)hv.y}; }
    tok_finish_loaded(y2, b0, b1, t, lane, h2b, rstd3);
}
__device__ __forceinline__ void tok_finish_mixed_h(const unsigned (&Y)[8], int t, int lane, const bf16* __restrict__ h1b, bf16* __restrict__ h2b, float* __restrict__ rstd3) {
    f32x2 y2[8];
#pragma unroll
    for (int c = 0; c < 8; ++c) { const unsigned w = Y[c]; const h2v hv = __builtin_bit_cast(h2v, w); y2[c] = (f32x2){(float)hv.x, (float)hv.y}; }
    tok_finish_mixed(y2, t, lane, h1b, h2b, rstd3);
}
#endif
constexpr int MIX_XROW = U_FP6 ? 2048 : 1024;
constexpr int MIX_LDS_WAVE = 4 * MIX_XROW + 2048 + 64;
constexpr int XG = 2;
template <int PM>
__device__ __forceinline__ void gather_wg_mixed(int tok0, int wave, int lane, LAS unsigned char* lds, const unsigned char* __restrict__ U8, const unsigned char* __restrict__ V8, const float* __restrict__ IU, const float* __restrict__ IV,
                                                const int* __restrict__ seli, const float* __restrict__ selg, const float* __restrict__ part2, const bf16* __restrict__ h1b, bf16* __restrict__ h2b, float* __restrict__ rstd3, float* probe_out) {
    LAS unsigned char* xs = lds + wave * MIX_LDS_WAVE;
    LAS unsigned* ks = (LAS unsigned*)(xs + 4 * MIX_XROW);
    LAS float* rsl = (LAS float*)(xs + 4 * MIX_XROW + 2048);
#pragma unroll 1
    for (int pass = 0; pass < 2; ++pass) {
        const int tb = tok0 + pass * 32 + wave * 4;
        unsigned k[8]; float rs0, rs1, rs2, rs3;
        {   TokRaw r0, r1, r2, r3; const int fl = fresh_lane();
            tok_load_mixed(r0, tb + 0, fl, seli, selg, part2, h1b); tok_load_mixed(r1, tb + 1, fl, seli, selg, part2, h1b); tok_load_mixed(r2, tb + 2, fl, seli, selg, part2, h1b); tok_load_mixed(r3, tb + 3, fl, seli, selg, part2, h1b);
            __builtin_amdgcn_sched_barrier(0);
            rs0 = tok_prep_mixed(r0, k[0], k[1], 0, fl, xs); rs1 = tok_prep_mixed(r1, k[2], k[3], 1, fl, xs + 1 * MIX_XROW); rs2 = tok_prep_mixed(r2, k[4], k[5], 2, fl, xs + 2 * MIX_XROW); rs3 = tok_prep_mixed(r3, k[6], k[7], 3, fl, xs + 3 * MIX_XROW); }
        __builtin_amdgcn_sched_barrier(0);
        lane = fresh_lane();
        sort_wave<8>(k, lane);
#pragma unroll
        for (int r = 0; r < 8; ++r) ks[lane + 64 * r] = k[r];
        if (lane == 0) { rsl[0] = rs0; rsl[1] = rs1; rsl[2] = rs2; rsl[3] = rs3; }
        __builtin_amdgcn_sched_barrier(0);
#if Y_F16
        unsigned Y0[8], Y1[8], Y2[8], Y3[8];
#pragma unroll
        for (int i = 0; i < 8; ++i) { Y0[i] = 0u; Y1[i] = 0u; Y2[i] = 0u; Y3[i] = 0u; }
#else
        f32x2 Y0[8], Y1[8], Y2[8], Y3[8];
#pragma unroll
        for (int i = 0; i < 8; ++i) { Y0[i] = (f32x2){0.f, 0.f}; Y1[i] = (f32x2){0.f, 0.f}; Y2[i] = (f32x2){0.f, 0.f}; Y3[i] = (f32x2){0.f, 0.f}; }
#endif
        __syncthreads();
        lane = fresh_lane();
#if MIX_PIPE
        const int lane16 = lane << 4;
        const __amdgpu_buffer_rsrc_t rU = __builtin_amdgcn_make_buffer_rsrc((void*)U8, 0, (U_FP6 ? 12 : 16) << 20, 0x00020000), rV = __builtin_amdgcn_make_buffer_rsrc((void*)V8, 0, (V_FP6 ? 12 : 16) << 20, 0x00020000);
        unsigned kbN = ks[(pass ? 16 * 31 : 0) + (lane & 15)], keyN = ks[(pass ? 16 * 31 : 0) + (lane >> 2)];
        UROW A[16]; VROW vv[16];
#pragma unroll
        for (int q = 0; q < 16; ++q) { int e = (int)((unsigned)__builtin_amdgcn_readlane((int)kbN, q) >> 18); if (PM & 32) e &= 1023; if (PM & 2) A[q] = urow_dummy(e); else A[q] = urow_load(rU, lane, e); }
#pragma unroll
        for (int q = 0; q < 16; ++q) { int e = (int)((unsigned)__builtin_amdgcn_readlane((int)kbN, q) >> 18); if (PM & 32) e &= 1023; if (PM & 1) vv[q] = vrow_dummy(e); else vv[q] = vrow_load(rV, lane, e); }
        float iuN = IU[keyN >> 18], ivN = IV[keyN >> 18];
#pragma unroll 1
        for (int bb = 0; bb < ((PM & 512) ? 1 : 32); ++bb) {
            const int bn = (bb + 1 < 32) ? bb + 1 : 31; const int b1 = pass ? 31 - bn : bn;
            const unsigned kb = kbN, key = keyN; const float iu = iuN, iv = ivN;
            kbN = ks[16 * b1 + (lane & 15)]; keyN = ks[16 * b1 + (lane >> 2)];
            const int tq = (int)(key >> 16) & 3;
            const float dus = iu * rsl[tq], gvs = (float)(key & 0xffffu) * (1.0f / 65535.0f) * iv;
#if U_FP6
            float pp[16];
#pragma unroll
            for (int q2 = 0; q2 < 16; q2 += 2) {
                u32x4 Xa[2], Xb[2];
#pragma unroll
                for (int h = 0; h < 2; ++h) { const int t = (__builtin_amdgcn_readlane((int)kb, q2 + h) >> 16) & 3; const LAS u32x4* xp = (const LAS u32x4*)(xs + t * 2048 + 32 * lane); Xa[h] = xp[0]; Xb[h] = xp[1]; }
                const u32x6 in6 = {A[q2].x, A[q2].y, A[q2].z, A[q2 + 1].x, A[q2 + 1].y, A[q2 + 1].z};
                const h32v g = __builtin_amdgcn_cvt_scalef32_pk32_f16_fp6(in6, 1.0f);
#pragma unroll
                for (int h = 0; h < 2; ++h) { const int q = q2 + h; float acc = 0.f;
#pragma unroll
                    for (int c = 0; c < 8; ++c) { const unsigned xw = c < 4 ? Xa[h][c] : Xb[h][c - 4]; const h2v xv = __builtin_bit_cast(h2v, xw); const h2v av = {g[16 * h + 2 * c], g[16 * h + 2 * c + 1]};
                        acc = __builtin_amdgcn_fdot2(av, xv, acc, false); }
                    pp[q] = acc;
                    int e = (int)((unsigned)__builtin_amdgcn_readlane((int)kbN, q) >> 18); if (PM & 32) e &= 1023;
                    if (PM & 2) A[q] = urow_dummy(e); else A[q] = urow_load(rU, lane, e);
                }
                __builtin_amdgcn_sched_barrier(0);
            }
#else
            int pp[16];
#pragma unroll
            for (int g = 0; g < 16 / XG; ++g) {
                i32x4v Xg[XG];
#pragma unroll
                for (int i = 0; i < XG; ++i) { const int t = (__builtin_amdgcn_readlane((int)kb, XG * g + i) >> 16) & 3; Xg[i] = *(const LAS i32x4v*)(xs + t * MIX_XROW + 16 * lane); }
#pragma unroll
                for (int i = 0; i < XG; ++i) { const int q = XG * g + i; const i32x4v X = Xg[i];
                    if (PM & 2) pp[q] = A[q][0] + X[0]; else
                    pp[q] = __builtin_amdgcn_sdot4(A[q][3], X[3], __builtin_amdgcn_sdot4(A[q][2], X[2], __builtin_amdgcn_sdot4(A[q][1], X[1], __builtin_amdgcn_sdot4(A[q][0], X[0], 0, false), false), false), false);
                    if (PM & 1024) { i32x4v X2 = X; asm volatile("" : "+v"(X2)); pp[q] = __builtin_amdgcn_sdot4(A[q][3], X2[3], __builtin_amdgcn_sdot4(A[q][2], X2[2], __builtin_amdgcn_sdot4(A[q][1], X2[1], __builtin_amdgcn_sdot4(A[q][0], X2[0], pp[q], false), false), false), false); }
                    int e = (int)((unsigned)__builtin_amdgcn_readlane((int)kbN, q) >> 18); if (PM & 32) e &= 1023;
                    if (PM & 2) A[q] = urow_dummy(e); else A[q] = urow_load(rU, lane, e);
                }
                __builtin_amdgcn_sched_barrier(0);
            }
#endif
            iuN = IU[keyN >> 18]; ivN = IV[keyN >> 18];
            const auto tot = reduce16_rows(pp, lane);
            const float cf = gvs * gelu_tanh((float)tot * dus);
#if Y_F16
            const int cfh = (int)__builtin_bit_cast(unsigned short, (_Float16)cf);
#pragma unroll
            for (int q2 = 0; q2 < 16; q2 += 2) {
                const u32x6 in6 = {vv[q2].x, vv[q2].y, vv[q2].z, vv[q2 + 1].x, vv[q2 + 1].y, vv[q2 + 1].z};
                h32v f = __builtin_amdgcn_cvt_scalef32_pk32_f16_fp6(in6, 1.0f);
                if (PM & 256) { u32x6 in7 = in6; asm volatile("" : "+v"(in7)); const h32v f2 = __builtin_amdgcn_cvt_scalef32_pk32_f16_fp6(in7, 1.0f); f = f + f2; }
#pragma unroll
                for (int h = 0; h < 2; ++h) { const int q = q2 + h;
                    const int t = (__builtin_amdgcn_readlane((int)kb, q) >> 16) & 3;
                    const unsigned cs = (unsigned)__builtin_amdgcn_readlane(cfh, 4 * q);
                    unsigned x[8];
#pragma unroll
                    for (int c = 0; c < 8; ++c) { const h2v hv = {f[16 * h + 2 * c], f[16 * h + 2 * c + 1]}; x[c] = __builtin_bit_cast(unsigned, hv); }
                    int e = (int)((unsigned)__builtin_amdgcn_readlane((int)kbN, q) >> 18); if (PM & 32) e &= 1023;
                    if (PM & 1) { vv[q] = vrow_dummy(e); Y0[q & 7] ^= cs + x[0]; } else {
                    vv[q] = vrow_load(rV, lane, e);
                    if (PM & 2048) { if (q & 1) axpy_nobranch_h(cs, x, Y1); else axpy_nobranch_h(cs, x, Y0); } else {
                    axpy_dispatch2h(t, 0, cs, x, Y0, Y1);
                    axpy_dispatch2h(t, 2, cs, x, Y2, Y3); } }
                }
            }
#elif V_FP6
#pragma unroll
            for (int q2 = 0; q2 < 16; q2 += 2) {
                const u32x6 in6 = {vv[q2].x, vv[q2].y, vv[q2].z, vv[q2 + 1].x, vv[q2 + 1].y, vv[q2 + 1].z};
                const f32x32 f = __builtin_amdgcn_cvt_scalef32_pk32_f32_fp6(in6, 1.0f);
#pragma unroll
                for (int h = 0; h < 2; ++h) { const int q = q2 + h;
                    const int t = (__builtin_amdgcn_readlane((int)kb, q) >> 16) & 3;
                    const float cs = __int_as_float(__builtin_amdgcn_readlane(__float_as_int(cf), 4 * q));
                    f32x2 x[8];
#pragma unroll
                    for (int c = 0; c < 8; ++c) x[c] = (f32x2){f[16 * h + 2 * c], f[16 * h + 2 * c + 1]};
                    int e = (int)((unsigned)__builtin_amdgcn_readlane((int)kbN, q) >> 18); if (PM & 32) e &= 1023;
                    if (PM & 1) { vv[q] = vrow_dummy(e); Y0[q & 7].x += cs * x[0].x; } else {
                    vv[q] = vrow_load(rV, lane, e);
                    axpy_dispatch2(t, 0, cs, x, Y0, Y1);
                    axpy_dispatch2(t, 2, cs, x, Y2, Y3); }
                }
            }
#else
#pragma unroll
            for (int q = 0; q < 16; ++q) {
                const int t = (__builtin_amdgcn_readlane((int)kb, q) >> 16) & 3;
                const float cs = __int_as_float(__builtin_amdgcn_readlane(__float_as_int(cf), 4 * q));
                f32x2 x[8];
#pragma unroll
                for (int c = 0; c < 4; ++c) { x[2 * c] = __builtin_amdgcn_cvt_pk_f32_fp8(vv[q][c], false); x[2 * c + 1] = __builtin_amdgcn_cvt_pk_f32_fp8(vv[q][c], true); }
                int e = (int)((unsigned)__builtin_amdgcn_readlane((int)kbN, q) >> 18); if (PM & 32) e &= 1023;
                if (PM & 1) { vv[q] = vrow_dummy(e); Y0[q & 7].x += cs * x[0].x; } else {
                vv[q] = vrow_load(rV, lane, e);
                if (PM & 128) { axpy_dispatch2_dup(t, 0, cs, x, Y0, Y1); axpy_dispatch2_dup(t, 2, cs, x, Y2, Y3); } else {
                axpy_dispatch2(t, 0, cs, x, Y0, Y1);
                axpy_dispatch2(t, 2, cs, x, Y2, Y3); } }
            }
#endif
        }
#else
#pragma unroll 1
        for (int b = 0; b < 32; ++b) {
            const unsigned kb = ks[16 * b + (lane & 15)];
            const unsigned key = ks[16 * b + (lane >> 2)];
            const int es = (int)(key >> 18); const int tq = (int)(key >> 16) & 3;
            const float rsx = rsl[tq];
            const float dus = IU[es] * rsx, gvs = (float)(key & 0xffffu) * (1.0f / 65535.0f) * IV[es];
            i32x4v A[16]; u32x4 vv[16];
#pragma unroll
            for (int q = 0; q < 16; ++q) { int e = (int)((unsigned)__builtin_amdgcn_readlane((int)kb, q) >> 18); if (PM & 32) e &= 1023; A[q] = *(const i32x4v*)(U8 + (size_t)e * 1024 + 16 * lane); }
#pragma unroll
            for (int q = 0; q < 16; ++q) { int e = (int)((unsigned)__builtin_amdgcn_readlane((int)kb, q) >> 18); if (PM & 32) e &= 1023; vv[q] = *(const u32x4*)(V8 + (size_t)e * 1024 + 16 * lane); }
            int pp[16];
#pragma unroll
            for (int q = 0; q < 16; ++q) {
                const int t = (__builtin_amdgcn_readlane((int)kb, q) >> 16) & 3;
                const i32x4v X = *(const LAS i32x4v*)(xs + t * 1024 + 16 * lane);
                pp[q] = __builtin_amdgcn_sdot4(A[q][3], X[3], __builtin_amdgcn_sdot4(A[q][2], X[2], __builtin_amdgcn_sdot4(A[q][1], X[1], __builtin_amdgcn_sdot4(A[q][0], X[0], 0, false), false), false), false);
            }
            const int tot = reduce16_rows(pp, lane);
            const float cf = gvs * gelu_tanh((float)tot * dus);
#pragma unroll
            for (int q = 0; q < 16; ++q) {
                const int t = (__builtin_amdgcn_readlane((int)kb, q) >> 16) & 3;
                const float cs = __int_as_float(__builtin_amdgcn_readlane(__float_as_int(cf), 4 * q));
                f32x2 x[8];
#pragma unroll
                for (int c = 0; c < 4; ++c) { x[2 * c] = __builtin_amdgcn_cvt_pk_f32_fp8(vv[q][c], false); x[2 * c + 1] = __builtin_amdgcn_cvt_pk_f32_fp8(vv[q][c], true); }
                axpy_dispatch2(t, 0, cs, x, Y0, Y1);
                axpy_dispatch2(t, 2, cs, x, Y2, Y3);
            }
            __builtin_amdgcn_sched_barrier(0);
        }
#endif
#if Y_F16
        if (PM != 0) { const int fl = fresh_lane(); unsigned a = 0u;
#pragma unroll
            for (int i = 0; i < 8; ++i) a += Y0[i] + Y1[i] + Y2[i] + Y3[i];
            probe_out[(size_t)tb * 64 + fl] = (float)a; }
        else { const int fl = fresh_lane(); u32x4 hb[8];
#pragma unroll
            for (int j = 0; j < 4; ++j) { const u32x4* br = (const u32x4*)(h1b + (size_t)(tb + j) * 1024 + 16 * fl); hb[2 * j] = br[0]; hb[2 * j + 1] = br[1]; }
            __builtin_amdgcn_sched_barrier(0);
            tok_finish_h_loaded(Y0, hb[0], hb[1], tb, fl, h2b, rstd3); tok_finish_h_loaded(Y1, hb[2], hb[3], tb + 1, fl, h2b, rstd3); tok_finish_h_loaded(Y2, hb[4], hb[5], tb + 2, fl, h2b, rstd3); tok_finish_h_loaded(Y3, hb[6], hb[7], tb + 3, fl, h2b, rstd3); }
#else
        if (PM != 0) { const int fl = fresh_lane(); f32x2 a = Y0[0] + Y1[0] + Y2[0] + Y3[0];
#pragma unroll
            for (int i = 1; i < 8; ++i) a += Y0[i] + Y1[i] + Y2[i] + Y3[i];
            probe_out[(size_t)tb * 64 + fl] = a.x + a.y; }
        else { const int fl = fresh_lane(); tok_finish_mixed(Y0, tb, fl, h1b, h2b, rstd3); tok_finish_mixed(Y1, tb + 1, fl, h1b, h2b, rstd3); tok_finish_mixed(Y2, tb + 2, fl, h1b, h2b, rstd3); tok_finish_mixed(Y3, tb + 3, fl, h1b, h2b, rstd3); }
#endif
        __syncthreads();
    }
}
namespace pg8 {
#define PG8_LAS __attribute__((address_space(3)))
typedef unsigned short bf16_t;
typedef short bf16x8 __attribute__((ext_vector_type(8)));
typedef float f32x4 __attribute__((ext_vector_type(4)));
typedef unsigned u32x4 __attribute__((ext_vector_type(4)));
constexpr int BM = 256, BK = 64, HALF = 128, HTB = HALF * BK * 2  , STAGE_BYTES = 8 * HTB, NXCD = 8, WGM = 8;

__host__ __device__ __forceinline__ int lds_byte(int r, int c) { const int st = (r >> 4) * 2 + (c >> 5), rr = r & 15, cc = c & 31, ob = rr * 64 + cc * 2; return st * 1024 + (ob ^ (((ob >> 9) & 1) << 5)); }
__host__ __device__ __forceinline__ void stage_rc(int b, int& R, int& C) { const int st = b / 1024, sb = b % 1024, swz = sb ^ (((sb >> 9) & 1) << 5); R = (st >> 1) * 16 + swz / 64; C = (st & 1) * 32 + (swz % 64) / 2; }
__host__ __device__ __forceinline__ int perm32(int rho) { const int n = rho >> 4, i = rho & 15; return 8 * (i >> 2) + 4 * n + (i & 3); }

struct Unit { int pm, pn; };
struct Gemm { const bf16_t* A; const bf16_t* Bt; int K, lda, apn_shift, apn_stride; };

struct StaticOrder {
    int nM, nN, nwg, G, c;
    __host__ __device__ __forceinline__ void init(int M, int N, int G_, int c_) { nM = M / BM; nN = N / BM; nwg = nM * nN; G = G_; c = c_; }
    __host__ __device__ __forceinline__ bool next(int i, Unit& u) const {
        const long L = (long)i * G + c; if (L >= nwg) return false;
        int wgid = (int)L; { const int q = nwg / NXCD, r = nwg % NXCD, xcd = wgid % NXCD, off = wgid / NXCD; wgid = (xcd < r ? xcd * (q + 1) : r * (q + 1) + (xcd - r) * q) + off; }
        const int nig = WGM * nN, gid = wgid / nig, fm = gid * WGM, gsz = (nM - fm) < WGM ? (nM - fm) : WGM;
        u.pm = fm + ((wgid % nig) % gsz); u.pn = (wgid % nig) / gsz; return true;
    }
    __device__ __forceinline__ void a_ready(const Unit&) const {}
    __device__ __forceinline__ void done(const Unit&) const {}
};

__device__ __forceinline__ unsigned cvt_pk_bf16(float lo, float hi) { unsigned r; asm volatile("v_cvt_pk_bf16_f32 %0, %1, %2" : "=v"(r) : "v"(lo), "v"(hi)); return r; }

template <class Epi, class Sched, bool ALIGN_EPI = false, bool SP2 = false>
__device__ __forceinline__ void gemm_phase(PG8_LAS unsigned char* lds, const Gemm g, const Sched& S, const Epi& E, int wave_id  ) {
    const int lane = fresh_lane(), wid = wave_id, tid = wid * 64 + lane, wr = wid >> 2, wc = wid & 3, fr = lane & 15, fq = lane >> 4;
    const int K = g.K, nt = K / BK;
    unsigned voffA[2], voffB[2];
#pragma unroll
    for (int i = 0; i < 2; ++i) { int R, C; stage_rc(tid * 16 + i * 8192, R, C); const int Rb = Epi::PERM ? ((R & ~31) + perm32(R & 31)) : R;
        voffA[i] = (unsigned)(R * g.lda + C) * 2u; voffB[i] = (unsigned)(Rb * K + C) * 2u; }
    const size_t kstep = (size_t)(BK * 2);
    const size_t hstepA = (size_t)HALF * g.lda * 2, hstepB = (size_t)HALF * K * 2;
    const size_t tstepA = 2 * hstepA, tstepB = 2 * hstepB;
    const unsigned ldsw = (unsigned)wid * 1024u;
    const int aoff = lds_byte(wr * 64 + fr, fq * 8), boff = lds_byte(wc * 32 + fr, fq * 8);
#define PG8_SA(b, h) (((b) * 2 + (h)) * HTB)
#define PG8_SB(b, h) ((4 + (b) * 2 + (h)) * HTB)
#define PG8_STAGE(bufoff, gbase, voff) do { _Pragma("unroll") for (int _i = 0; _i < 2; ++_i) \
        __builtin_amdgcn_global_load_lds((const unsigned*)((const char*)(gbase) + (voff)[_i]), (PG8_LAS unsigned*)(lds + (bufoff) + ldsw + _i * 8192), 16, 0, 0); } while (0)
#define PG8_LDA(dst, b, h) do { _Pragma("unroll") for (int m = 0; m < 4; ++m) _Pragma("unroll") for (int k = 0; k < 2; ++k) dst[m][k] = *(const PG8_LAS bf16x8*)(lds + PG8_SA(b, h) + aoff + m * 2048 + k * 1024); } while (0)
#define PG8_LDB(dst, b, h) do { _Pragma("unroll") for (int n = 0; n < 2; ++n) _Pragma("unroll") for (int k = 0; k < 2; ++k) dst[n][k] = *(const PG8_LAS bf16x8*)(lds + PG8_SB(b, h) + boff + n * 2048 + k * 1024); } while (0)
#define PG8_MMA(ai, bj, At, Bt) do { __builtin_amdgcn_s_setprio(1); _Pragma("unroll") for (int m = 0; m < 4; ++m) _Pragma("unroll") for (int n = 0; n < 2; ++n) _Pragma("unroll") for (int k = 0; k < 2; ++k) \
        acc[ai][bj][m][n] = __builtin_amdgcn_mfma_f32_16x16x32_bf16(Bt[n][k], At[m][k], acc[ai][bj][m][n], 0, 0, 0); __builtin_amdgcn_s_setprio(0); } while (0)
#define PG8_WAIT_V(n) asm volatile("s_waitcnt vmcnt(" #n ")" ::: "memory")
#define PG8_WAIT_L(n) asm volatile("s_waitcnt lgkmcnt(" #n ")" ::: "memory")
#define PG8_BAR __builtin_amdgcn_s_barrier()
#define PG8_SCHED __builtin_amdgcn_sched_barrier(0)
    Unit cur, nxt; int ui = 0;
    if (!S.next(0, cur)) return;
    f32x4 acc[2][2][4][2];
#pragma unroll
    for (int a = 0; a < 2; ++a)
#pragma unroll
        for (int b = 0; b < 2; ++b)
#pragma unroll
            for (int m = 0; m < 4; ++m)
#pragma unroll
                for (int n = 0; n < 2; ++n) acc[a][b][m][n] = (f32x4){0.f, 0.f, 0.f, 0.f};
    bf16x8 At[4][2], B0[2][2], B1[2][2];
    const char* cA = (const char*)g.A + (size_t)cur.pm * tstepA + (size_t)((cur.pn >> g.apn_shift) * g.apn_stride) * 2; const char* cB = (const char*)g.Bt + (size_t)cur.pn * tstepB;
    S.a_ready(cur);
    if constexpr (SP2) {
        PG8_STAGE(PG8_SB(0, 0), cB, voffB); PG8_STAGE(PG8_SB(0, 1), cB + hstepB, voffB); PG8_STAGE(PG8_SA(0, 0), cA, voffA); PG8_STAGE(PG8_SA(0, 1), cA + hstepA, voffA);
        if (wr == 1) PG8_BAR;
        PG8_WAIT_V(2); PG8_BAR;
        PG8_STAGE(PG8_SB(1, 0), cB + kstep, voffB); PG8_STAGE(PG8_SA(1, 0), cA + kstep, voffA); PG8_STAGE(PG8_SB(1, 1), cB + hstepB + kstep, voffB);
        PG8_WAIT_V(6); PG8_BAR;
    } else {
        PG8_STAGE(PG8_SB(0, 0), cB, voffB); PG8_STAGE(PG8_SA(0, 0), cA, voffA); PG8_STAGE(PG8_SB(0, 1), cB + hstepB, voffB); PG8_STAGE(PG8_SA(0, 1), cA + hstepA, voffA);
        if (wr == 1) PG8_BAR;
        PG8_WAIT_V(4); PG8_BAR;
        PG8_STAGE(PG8_SB(1, 0), cB + kstep, voffB); PG8_STAGE(PG8_SA(1, 0), cA + kstep, voffA); PG8_STAGE(PG8_SB(1, 1), cB + hstepB + kstep, voffB);
        PG8_WAIT_V(6); PG8_BAR;
    }
    for (;;) {
        const bool has_next = S.next(ui + 1, nxt);
        const char* nA = has_next ? (const char*)g.A + (size_t)nxt.pm * tstepA + (size_t)((nxt.pn >> g.apn_shift) * g.apn_stride) * 2 : cA; const char* nB = has_next ? (const char*)g.Bt + (size_t)nxt.pn * tstepB : cB;
#pragma unroll 1
        for (int t = 0; t < nt; t += 2) {
            const bool last = (t == nt - 2);
            const char* a1 = cA + (size_t)(t + 1) * kstep;
            const char* a2 = last ? nA : cA + (size_t)(t + 2) * kstep; const char* b2 = last ? nB : cB + (size_t)(t + 2) * kstep;
            const char* a3 = a2 + kstep; const char* b3 = b2 + kstep;
            if (last && has_next) S.a_ready(nxt);
            if constexpr (SP2) {
            PG8_LDB(B0, 0, 0); PG8_LDB(B1, 0, 1); PG8_SCHED; PG8_LDA(At, 0, 0); PG8_STAGE(PG8_SA(1, 1), a1 + hstepA, voffA);
            PG8_WAIT_V(8); PG8_WAIT_L(0); PG8_BAR; PG8_MMA(0, 0, At, B0); PG8_MMA(0, 1, At, B1); PG8_BAR; PG8_SCHED;
            PG8_LDA(At, 0, 1); PG8_STAGE(PG8_SB(0, 0), b2, voffB); PG8_STAGE(PG8_SB(0, 1), b2 + hstepB, voffB); PG8_STAGE(PG8_SA(0, 0), a2, voffA);
            PG8_WAIT_V(8); PG8_WAIT_L(0); PG8_BAR; PG8_MMA(1, 0, At, B0); PG8_MMA(1, 1, At, B1); PG8_BAR; PG8_SCHED;
            PG8_LDB(B0, 1, 0); PG8_LDB(B1, 1, 1); PG8_SCHED; PG8_LDA(At, 1, 0); PG8_STAGE(PG8_SA(0, 1), a2 + hstepA, voffA);
            PG8_WAIT_V(8); PG8_WAIT_L(0); PG8_BAR; PG8_MMA(0, 0, At, B0); PG8_MMA(0, 1, At, B1); PG8_BAR; PG8_SCHED;
            PG8_LDA(At, 1, 1); PG8_STAGE(PG8_SB(1, 0), b3, voffB); PG8_STAGE(PG8_SB(1, 1), b3 + hstepB, voffB); PG8_STAGE(PG8_SA(1, 0), a3, voffA);
            PG8_WAIT_V(8); PG8_WAIT_L(0); PG8_BAR; PG8_MMA(1, 0, At, B0); PG8_MMA(1, 1, At, B1); PG8_BAR; PG8_SCHED;
            } else {
            PG8_LDB(B0, 0, 0); PG8_SCHED; PG8_LDA(At, 0, 0); PG8_STAGE(PG8_SA(1, 1), a1 + hstepA, voffA);
            PG8_WAIT_L(8); PG8_BAR; PG8_WAIT_L(0); PG8_MMA(0, 0, At, B0); PG8_BAR; PG8_SCHED;
            PG8_LDB(B1, 0, 1); PG8_STAGE(PG8_SB(0, 0), b2, voffB);
            PG8_BAR; PG8_WAIT_L(0); PG8_MMA(0, 1, At, B1); PG8_BAR;
            PG8_LDA(At, 0, 1); PG8_STAGE(PG8_SA(0, 0), a2, voffA);
            PG8_BAR; PG8_WAIT_L(0); PG8_MMA(1, 0, At, B0); PG8_BAR; PG8_SCHED;
            PG8_STAGE(PG8_SB(0, 1), b2 + hstepB, voffB);
            PG8_WAIT_V(6); PG8_BAR; PG8_MMA(1, 1, At, B1); PG8_BAR;
            PG8_LDB(B0, 1, 0); PG8_SCHED; PG8_LDA(At, 1, 0); PG8_STAGE(PG8_SA(0, 1), a2 + hstepA, voffA);
            PG8_WAIT_L(8); PG8_BAR; PG8_WAIT_L(0); PG8_MMA(0, 0, At, B0); PG8_BAR; PG8_SCHED;
            PG8_LDB(B1, 1, 1); PG8_STAGE(PG8_SB(1, 0), b3, voffB);
            PG8_BAR; PG8_WAIT_L(0); PG8_MMA(0, 1, At, B1); PG8_BAR;
            PG8_LDA(At, 1, 1); PG8_STAGE(PG8_SA(1, 0), a3, voffA);
            PG8_BAR; PG8_WAIT_L(0); PG8_MMA(1, 0, At, B0); PG8_BAR; PG8_SCHED;
            PG8_STAGE(PG8_SB(1, 1), b3 + hstepB, voffB);
            PG8_WAIT_V(6); PG8_BAR; PG8_MMA(1, 1, At, B1); PG8_BAR;
            }
        }
        if constexpr (ALIGN_EPI) { if (wr == 0) PG8_BAR; }
        if constexpr (!Epi::AFTER_DRAIN) { E(acc, cur, wr, wc, fr, fq); S.done(cur); }
        if (!has_next) break;
#pragma unroll
        for (int a = 0; a < 2; ++a)
#pragma unroll
            for (int b = 0; b < 2; ++b)
#pragma unroll
                for (int m = 0; m < 4; ++m)
#pragma unroll
                    for (int n = 0; n < 2; ++n) acc[a][b][m][n] = (f32x4){0.f, 0.f, 0.f, 0.f};
        cur = nxt; cA = nA; cB = nB; ++ui;
        if constexpr (ALIGN_EPI) { if (wr == 1) PG8_BAR; }
    }
    PG8_WAIT_V(0);
    if constexpr (!ALIGN_EPI) { if (wr == 0) PG8_BAR; }
    PG8_BAR;
    if constexpr (Epi::AFTER_DRAIN) { E.fused(acc, cur, wr, wc, fr, fq, lds, wid, lane); S.done(cur); }
#undef PG8_SA
#undef PG8_SB
#undef PG8_STAGE
#undef PG8_LDA
#undef PG8_LDB
#undef PG8_MMA
#undef PG8_WAIT_V
#undef PG8_WAIT_L
#undef PG8_BAR
#undef PG8_SCHED
}
}
#define GAS __attribute__((address_space(1)))
typedef GAS unsigned gu32;
#define RLX_AGENT __ATOMIC_RELAXED, __HIP_MEMORY_SCOPE_AGENT
#define LDS_WAIT() asm volatile("s_waitcnt lgkmcnt(0)" ::: "memory")
#define VM_WAIT() asm volatile("s_waitcnt vmcnt(0)" ::: "memory")
#define XB_TMO      128
#define XB_XCNT(j)  (256  + 64 * (j))
#define XB_XSUB(j)  (1280 + 64 * (j))
#define XB_XGEN(j)  (2304 + 64 * (j))
#define XB_TOP      3328
#define XB_TOPGEN   3392
#define XCD_BAR_WORDS 3456
#define XB_SPIN_CAP (1u << 18)

__device__ __forceinline__ unsigned xb_ld(unsigned* p)              { return __hip_atomic_load(p, __ATOMIC_RELAXED, __HIP_MEMORY_SCOPE_AGENT); }
__device__ __forceinline__ unsigned xb_add(unsigned* p, unsigned v) { return __hip_atomic_fetch_add(p, v, __ATOMIC_RELAXED, __HIP_MEMORY_SCOPE_AGENT); }
__device__ __forceinline__ unsigned xb_xcc_id() { return (unsigned)__builtin_amdgcn_s_getreg((3 << 11) | 20) & 0xFu; }
#define XB_SPIN(cond, bar) do { unsigned _sp = 0; while (cond) { __builtin_amdgcn_s_sleep(1); \
    if ((++_sp & 255u) == 0u) { if (xb_ld(&(bar)[XB_TMO])) break; if (_sp > XB_SPIN_CAP) { atomicAdd(&(bar)[XB_TMO], 1u); break; } } } } while (0)

struct XcdBarrier {
    unsigned* bar; unsigned x;
    volatile LAS unsigned* st;
};

__device__ __forceinline__ XcdBarrier xcd_barrier_post(unsigned* bar, volatile LAS unsigned* st) {
    XcdBarrier b; b.bar = bar; b.x = xb_xcc_id(); b.st = st;
    if (threadIdx.x == 0) (void)xb_add(&bar[XB_XCNT(b.x)], 1u);
    return b;
}
__device__ __forceinline__ void xcd_barrier_complete(unsigned* bar, unsigned x, unsigned& nloc, unsigned& nx) {
    const unsigned G = gridDim.x * gridDim.y * gridDim.z;
    unsigned sum, cnt, mine, sp = 0u;
    for (;;) {
        sum = 0u; cnt = 0u; mine = 0u;
#pragma unroll
        for (unsigned j = 0; j < 16; ++j) { const unsigned c = xb_ld(&bar[XB_XCNT(j)]); sum += c; cnt += (c > 0u) ? 1u : 0u; mine = (j == x) ? c : mine; }
        if (sum == G) break;
        __builtin_amdgcn_s_sleep(1);
        if ((++sp & 255u) == 0u) { if (xb_ld(&bar[XB_TMO])) break; if (sp > XB_SPIN_CAP) { atomicAdd(&bar[XB_TMO], 1u); break; } }
    }
    nloc = mine > 0u ? mine : 1u; nx = cnt > 0u ? cnt : 1u;
}

__device__ __forceinline__ void xcd_barrier(const XcdBarrier& b) {
    asm volatile("s_waitcnt vmcnt(0)" ::: "memory");
    __syncthreads();
    if (threadIdx.x == 0) {
        unsigned* bar = b.bar;
        __builtin_amdgcn_s_waitcnt(0);
        unsigned nloc = b.st[0], nx = b.st[1];
        if (nloc == 0u) { xcd_barrier_complete(bar, b.x, nloc, nx); b.st[0] = nloc; b.st[1] = nx; }
        const unsigned old = xb_add(&bar[XB_XSUB(b.x)], 1u);
        const unsigned gen = old / nloc;
        if (old + 1u == (gen + 1u) * nloc) {
            __builtin_amdgcn_fence(__ATOMIC_RELEASE, "agent");
            asm volatile("s_waitcnt vmcnt(0)" ::: "memory");
            const unsigned og = xb_add(&bar[XB_TOP], 1u);
            const unsigned tg = og / nx;
            if (og + 1u == (tg + 1u) * nx) xb_add(&bar[XB_TOPGEN], 1u);
            else XB_SPIN(xb_ld(&bar[XB_TOPGEN]) == tg, bar);
            __builtin_amdgcn_fence(__ATOMIC_ACQUIRE, "agent");
            xb_add(&bar[XB_XGEN(b.x)], 1u);
            asm volatile("s_waitcnt vmcnt(0)" ::: "memory");
        } else {
            XB_SPIN(xb_ld(&bar[XB_XGEN(b.x)]) == gen, bar);
            __builtin_amdgcn_fence(__ATOMIC_ACQUIRE, "agent");
            asm volatile("s_waitcnt vmcnt(0)" ::: "memory");
        }
    }
    __syncthreads();
}

constexpr int NWAVES = 8;
constexpr int LDS_MAIN = 135168;
constexpr int LDSCTL_OFF = LDS_MAIN;
constexpr int LDS_BYTES = 147456;
constexpr int CW_BAR = 4096;
constexpr size_t CTL_ZERO_BYTES = 1 * MiB;
constexpr float LOG2E = 1.4426950408889634f;
typedef short bf16x8 __attribute__((ext_vector_type(8)));
typedef float f32x16 __attribute__((ext_vector_type(16)));
typedef unsigned u32x2 __attribute__((ext_vector_type(2)));
using pg8::Unit;
using pg8::cvt_pk_bf16;

__device__ __forceinline__ f32x4 sig4(f32x4 v) { return (f32x4){sigmoidf_(v[0]), sigmoidf_(v[1]), sigmoidf_(v[2]), sigmoidf_(v[3])}; }
__device__ __forceinline__ f32x4 gelu4(f32x4 v) { return (f32x4){gelu_tanh(v[0]), gelu_tanh(v[1]), gelu_tanh(v[2]), gelu_tanh(v[3])}; }
__device__ __forceinline__ u32x4 pack8(f32x4 a, f32x4 b) { u32x4 w; w.x = cvt_pk_bf16(a[0], a[1]); w.y = cvt_pk_bf16(a[2], a[3]); w.z = cvt_pk_bf16(b[0], b[1]); w.w = cvt_pk_bf16(b[2], b[3]); return w; }

struct OneUnit { pg8::StaticOrder S; int k;
    __device__ __forceinline__ bool next(int i, Unit& u) const { return i == 0 && S.next(k, u); }
    __device__ __forceinline__ void a_ready(const Unit&) const {}
    __device__ __forceinline__ void done(const Unit&) const {} };
struct EpiProj {
    static constexpr bool PERM = true, AFTER_DRAIN = false;
    const float* rstd; unsigned char* ws;
    __device__ __forceinline__ void operator()(const f32x4 (&acc)[2][2][4][2], const Unit& u, int wr, int wc, int fr, int fq) const {
        { const int t_ = fresh_lane(); fr = t_ & 15; fq = t_ >> 4; }
        const int pn = u.pn; bf16* base; int ldc, coff, act;
        if (pn < 3) { base = (bf16*)(ws + WS_QKV); ldc = 768; coff = pn * 256; act = 0; }
        else if (pn < 7) { base = (bf16*)(ws + WS_LX); ldc = 1024; coff = (pn - 3) * 256; act = 0; }
        else if (pn < 11) { base = (bf16*)(ws + WS_GL); ldc = 1024; coff = (pn - 7) * 256; act = 1; }
        else if (pn < 15) { base = (bf16*)(ws + WS_SGA); ldc = 1024; coff = (pn - 11) * 256; act = 2; }
        else { base = (bf16*)(ws + WS_SGL); ldc = 1024; coff = (pn - 15) * 256; act = 2; }
        const int row0 = u.pm * 256 + wr * 64 + fr, col0 = coff + wc * 32 + 8 * fq;
#pragma unroll
        for (int ai = 0; ai < 2; ++ai)
#pragma unroll
            for (int m = 0; m < 4; ++m) {
                const int r = row0 + ai * 128 + m * 16; const float rs = rstd[r]; bf16* rowp = base + (size_t)r * ldc + col0;
#pragma unroll
                for (int bj = 0; bj < 2; ++bj) {
                    f32x4 v0 = acc[ai][bj][m][0] * rs, v1 = acc[ai][bj][m][1] * rs;
                    if (act == 1) { v0 = gelu4(v0); v1 = gelu4(v1); } else if (act == 2) { v0 = sig4(v0); v1 = sig4(v1); }
                    *(u32x4*)(rowp + bj * 128) = pack8(v0, v1);
                }
            }
    }
};
struct EpiMP {
    static constexpr bool PERM = false, AFTER_DRAIN = false;
    const bf16* sga; float* mp;
    __device__ __forceinline__ void operator()(const f32x4 (&acc)[2][2][4][2], const Unit& u, int wr, int wc, int fr, int fq) const {
        { const int t_ = fresh_lane(); fr = t_ & 15; fq = t_ >> 4; }
        const int row0 = u.pm * 256 + wr * 64 + fr, col0 = u.pn * 256 + wc * 32 + 4 * fq;
#pragma unroll
        for (int ai = 0; ai < 2; ++ai)
#pragma unroll
            for (int m = 0; m < 4; ++m) {
                const size_t off = (size_t)(row0 + ai * 128 + m * 16) * 1024 + col0;
#pragma unroll
                for (int bj = 0; bj < 2; ++bj)
#pragma unroll
                    for (int n = 0; n < 2; ++n) { const size_t o = off + bj * 128 + n * 16; const f32x4 g = bf4_lo(*(const u32x2*)(sga + o)); const f32x4 v = acc[ai][bj][m][n] * g;
#if ALL_FUSED
                        u32x2 w; w.x = cvt_pk_bf16(v[0], v[1]); w.y = cvt_pk_bf16(v[2], v[3]); *(u32x2*)((bf16*)mp + o) = w;
#else
                        *(f32x4*)(mp + o) = v;
#endif
                    }
            }
    }
};
struct EpiMerged {
    static constexpr bool PERM = true, AFTER_DRAIN = false;
    const bf16* sgl; const float* mp; bf16* merged;
    __device__ __forceinline__ void operator()(const f32x4 (&acc)[2][2][4][2], const Unit& u, int wr, int wc, int fr, int fq) const {
        { const int t_ = fresh_lane(); fr = t_ & 15; fq = t_ >> 4; }
        const int row0 = u.pm * 256 + wr * 64 + fr, col0 = u.pn * 256 + wc * 32 + 8 * fq;
#pragma unroll
        for (int ai = 0; ai < 2; ++ai)
#pragma unroll
            for (int m = 0; m < 4; ++m) {
                const size_t off = (size_t)(row0 + ai * 128 + m * 16) * 1024 + col0;
#pragma unroll
                for (int bj = 0; bj < 2; ++bj) {
                    const size_t o = off + bj * 128; const u32x4 gw = *(const u32x4*)(sgl + o);
#if ALL_FUSED
                    const u32x4 mw = *(const u32x4*)((const bf16*)mp + o); const f32x4 m0 = bf4_lo((u32x2){mw.x, mw.y}), m1 = bf4_lo((u32x2){mw.z, mw.w});
#else
                    const f32x4 m0 = *(const f32x4*)(mp + o), m1 = *(const f32x4*)(mp + o + 4);
#endif
                    const f32x4 v0 = m0 + acc[ai][bj][m][0] * bf4_lo((u32x2){gw.x, gw.y}), v1 = m1 + acc[ai][bj][m][1] * bf4_lo((u32x2){gw.z, gw.w});
                    *(u32x4*)(merged + o) = pack8(v0, v1);
                }
            }
    }
};
struct EpiH1 {
    static constexpr bool PERM = true, AFTER_DRAIN = false;
    const float* x; float* h1; bf16* h1b; float* part;
    __device__ __forceinline__ void operator()(const f32x4 (&acc)[2][2][4][2], const Unit& u, int wr, int wc, int fr, int fq) const {
        { const int t_ = fresh_lane(); fr = t_ & 15; fq = t_ >> 4; }
        const int row0 = u.pm * 256 + wr * 64 + fr, col0 = u.pn * 256 + wc * 32 + 8 * fq;
#pragma unroll
        for (int ai = 0; ai < 2; ++ai)
#pragma unroll
            for (int m = 0; m < 4; ++m) {
                const int r = row0 + ai * 128 + m * 16; const size_t off = (size_t)r * 1024 + col0; float sq = 0.f;
#pragma unroll
                for (int bj = 0; bj < 2; ++bj) {
                    const size_t o = off + bj * 128;
                    const f32x4 v0 = *(const f32x4*)(x + o) + acc[ai][bj][m][0], v1 = *(const f32x4*)(x + o + 4) + acc[ai][bj][m][1];
#if !ALL_FUSED
                    *(f32x4*)(h1 + o) = v0; *(f32x4*)(h1 + o + 4) = v1;
#endif
                    *(u32x4*)(h1b + o) = pack8(v0, v1);
                    sq += (v0[0] * v0[0] + v0[1] * v0[1]) + (v0[2] * v0[2] + v0[3] * v0[3]) + (v1[0] * v1[0] + v1[1] * v1[1]) + (v1[2] * v1[2] + v1[3] * v1[3]);
                }
                sq += __shfl_xor(sq, 16); sq += __shfl_xor(sq, 32);
                if (fq == 0) part[(size_t)r * 16 + u.pn * 4 + wc] = sq;
            }
    }
};
struct EpiScore {
    static constexpr bool PERM = false, AFTER_DRAIN = false;
    const float* part; float* sc;
    __device__ __forceinline__ void operator()(const f32x4 (&acc)[2][2][4][2], const Unit& u, int wr, int wc, int fr, int fq) const {
        { const int t_ = fresh_lane(); fr = t_ & 15; fq = t_ >> 4; }
        const int row0 = u.pm * 256 + wr * 64 + fr, col0 = u.pn * 256 + wc * 32 + 4 * fq;
#pragma unroll
        for (int ai = 0; ai < 2; ++ai)
#pragma unroll
            for (int m = 0; m < 4; ++m) {
                const int r = row0 + ai * 128 + m * 16; const f32x4* pp = (const f32x4*)(part + (size_t)r * 16);
                const f32x4 s4 = (pp[0] + pp[1]) + (pp[2] + pp[3]); const float rs = 1.0f / sqrtf(((s4[0] + s4[1]) + (s4[2] + s4[3])) * (1.0f / 1024.0f) + EPS);
                const size_t off = (size_t)r * 1024 + col0;
#pragma unroll
                for (int bj = 0; bj < 2; ++bj)
#pragma unroll
                    for (int n = 0; n < 2; ++n) *(f32x4*)(sc + off + bj * 128 + n * 16) = acc[ai][bj][m][n] * rs;
            }
    }
};
typedef float f32x16 __attribute__((ext_vector_type(16)));
typedef unsigned u32x6t __attribute__((ext_vector_type(6)));
__device__ __forceinline__ unsigned enc_e2m3(float x) {
    const float a = fabsf(x);
    const float m = a < 2.0f ? 8.0f : (a < 4.0f ? 4.0f : 2.0f); const int off = a < 2.0f ? 0 : (a < 4.0f ? 8 : 16);
    int code = (int)__builtin_rintf(a * m) + off; code = code > 31 ? 31 : code;
    return (unsigned)code | (x < 0.f ? 32u : 0u);
}
__device__ __forceinline__ void uv_convert(const float* pu, const float* pv, const float* gffn, unsigned char* u8, unsigned char* v8, float* iu, float* iv, int gw, int NGW, int lane) {
    f32x4 g[4];
#pragma unroll
    for (int j = 0; j < 4; ++j) g[j] = ((const f32x4*)gffn)[4 * lane + j];
    for (int e0 = gw; e0 < 2 * 16384; e0 += 2 * NGW) {
        f32x4 v[2][4]; float sc[2];
        const bool isv = e0 >= 16384; const bool two = e0 + NGW < 2 * 16384;
#pragma unroll
        for (int h = 0; h < 2; ++h) { const int e = (h && !two) ? e0 : e0 + h * NGW; const int row = isv ? e - 16384 : e;
            const f32x4* src = (const f32x4*)((isv ? pv : pu) + (size_t)row * 1024) + 4 * lane;
#pragma unroll
            for (int j = 0; j < 4; ++j) v[h][j] = src[j]; }
#pragma unroll
        for (int h = 0; h < 2; ++h) {
            float am = 0.f;
#pragma unroll
            for (int j = 0; j < 4; ++j) { if (!isv) v[h][j] = v[h][j] * g[j]; am = fmaxf(am, fmaxf(fmaxf(fabsf(v[h][j][0]), fabsf(v[h][j][1])), fmaxf(fabsf(v[h][j][2]), fabsf(v[h][j][3])))); }
            am = wave_max_x(am);
            sc[h] = am > 0.f ? (isv ? (V_FP6 ? 7.5f : 416.0f) : 127.0f) / am : 1.0f;
        }
#if V_FP6
        if (isv) {
            f32x16 x0, x1;
#pragma unroll
            for (int j = 0; j < 4; ++j)
#pragma unroll
                for (int c = 0; c < 4; ++c) { const int i = 4 * j + c; const float a = v[0][j][c] * sc[0], b = v[1][j][c] * sc[1];
                    if (i & 1) { x1[i >> 1] = a; x1[8 + (i >> 1)] = b; } else { x0[i >> 1] = a; x0[8 + (i >> 1)] = b; } }
            const u32x6t pk = __builtin_amdgcn_cvt_scalef32_2xpk16_fp6_f32(x0, x1, 1.0f);
            const int r0 = e0 - 16384, r1 = two ? e0 + NGW - 16384 : r0;
            *(u32x3*)(v8 + (size_t)r0 * 768 + 12 * lane) = (u32x3){pk[0], pk[1], pk[2]};
            if (two) *(u32x3*)(v8 + (size_t)r1 * 768 + 12 * lane) = (u32x3){pk[3], pk[4], pk[5]};
            if (lane == 0) { iv[r0] = 1.0f / sc[0]; if (two) iv[r1] = 1.0f / sc[1]; }
            continue;
        }
#endif
#pragma unroll
        for (int h = 0; h < 2; ++h) {
            if (h && !two) break;
            const int e = e0 + h * NGW; const int row = isv ? e - 16384 : e;
            u32x4 w;
            if (isv) {
#pragma unroll
                for (int j = 0; j < 4; ++j) { unsigned ww = 0u; ww = __builtin_amdgcn_cvt_pk_fp8_f32(v[h][j][0] * sc[h], v[h][j][1] * sc[h], ww, false); ww = __builtin_amdgcn_cvt_pk_fp8_f32(v[h][j][2] * sc[h], v[h][j][3] * sc[h], ww, true); w[j] = ww; }
            } else {
#pragma unroll
                for (int j = 0; j < 4; ++j) { unsigned ww = 0u;
#pragma unroll
                    for (int c = 0; c < 4; ++c) ww |= ((unsigned)(int)__builtin_rintf(v[h][j][c] * sc[h]) & 0xffu) << (8 * c);
                    w[j] = ww; }
            }
            *(u32x4*)((isv ? v8 : u8) + (size_t)row * 1024 + 16 * lane) = w;
            if (lane == 0) (isv ? iv : iu)[row] = 1.0f / sc[h];
        }
    }
}
struct EpiTopk {
    static constexpr bool PERM = false, AFTER_DRAIN = true;
    const float* part; int* seli; float* selg;
    const float* pu; const float* pv; const float* gffn; unsigned char* u8; unsigned char* v8; float* iu; float* iv; int uvslot, uvn;
    __device__ __forceinline__ void fused(f32x4 (&acc)[2][2][4][2], const Unit& u, int wr, int wc, int fr, int fq, PG8_LAS unsigned char* lds, int wid, int lane) const {
        LAS float* L = (LAS float*)lds;
#pragma unroll
        for (int ai = 0; ai < 2; ++ai) {
            { const int t_ = fresh_lane(); fr = t_ & 15; fq = t_ >> 4; }
#pragma unroll
            for (int m = 0; m < 4; ++m) {
                const int rl = wr * 64 + m * 16 + fr, r = u.pm * 256 + ai * 128 + rl;
                const f32x4* pp = (const f32x4*)(part + (size_t)r * 16);
                const f32x4 s4 = (pp[0] + pp[1]) + (pp[2] + pp[3]); const float rs = 1.0f / sqrtf(((s4[0] + s4[1]) + (s4[2] + s4[3])) * (1.0f / 1024.0f) + EPS);
#pragma unroll
                for (int bj = 0; bj < 2; ++bj)
#pragma unroll
                    for (int n = 0; n < 2; ++n) *(LAS f32x4*)(L + (rl * 2 + bj) * TK_LSTRIDE + wc * 32 + 16 * n + 4 * fq) = acc[ai][bj][m][n] * rs;
            }
            asm volatile("s_waitcnt lgkmcnt(0)" ::: "memory"); __builtin_amdgcn_s_barrier(); asm volatile("" ::: "memory");
            const int tid = wid * 64 + fresh_lane();
            if (wid < 4) {
                const LAS float* my = L + tid * TK_LSTRIDE;
                unsigned a16[16];
#pragma unroll
                for (int g = 0; g < 8; ++g) {
                    unsigned t[16];
#pragma unroll
                    for (int q = 0; q < 4; ++q) {
                        const f32x4 v = *(const LAS f32x4*)(my + g * 16 + q * 4);
#pragma unroll
                        for (int c = 0; c < 4; ++c) { const int e = g * 16 + q * 4 + c; const float vc = v[c]; t[q * 4 + c] = (tk_f2key(vc) & ~127u) | (unsigned)(127 - e); }
                    }
                    tk_sort16(t);
                    if (g == 0) {
#pragma unroll
                        for (int i = 0; i < 16; ++i) a16[i] = t[i];
                    } else tk_merge16(a16, t);
                }
                {   u32x4 sb;
#pragma unroll
                    for (int c = 0; c < 4; ++c) sb[c] = (127u - (a16[4 * c] & 127u)) | ((127u - (a16[4 * c + 1] & 127u)) << 8) | ((127u - (a16[4 * c + 2] & 127u)) << 16) | ((127u - (a16[4 * c + 3] & 127u)) << 24);
                    *(LAS u32x4*)(L + tid * TK_LSTRIDE) = sb; }
                __builtin_amdgcn_sched_barrier(0);
                unsigned oth[16];
#pragma unroll
                for (int i = 0; i < 16; ++i) oth[i] = (unsigned)__shfl_xor((int)a16[i], 1);
                const bool odd = tid & 1;
                unsigned part[16]; tk_pair_partial(a16, oth, odd, part);
                {   unsigned po[16];
#pragma unroll
                    for (int i = 0; i < 16; ++i) po[i] = (unsigned)__shfl_xor((int)part[i], 1);
                    tk_merge16(part, po); }
                asm volatile("s_waitcnt lgkmcnt(0)" ::: "memory");
                const float mx = tk_key2f(part[0] & ~255u);
                float ex[16], sum = 0.f;
#pragma unroll
                for (int i = 0; i < 16; ++i) { ex[i] = __builtin_expf(tk_key2f(part[i] & ~255u) - mx); sum += ex[i]; }
                const float inv = 1.0f / sum;
                const LAS unsigned char* r1 = (const LAS unsigned char*)(L + (tid & ~1) * TK_LSTRIDE); const LAS unsigned char* r2 = r1 + TK_LSTRIDE * 4;
                const int tok = u.pm * 256 + ai * 128 + (tid >> 1);
                int* oi = seli + (size_t)tok * 128 + u.pn * 16 + (odd ? 8 : 0); float* og = selg + (size_t)tok * 128 + u.pn * 16 + (odd ? 8 : 0);
                int ei[8]; float eg[8];
#pragma unroll
                for (int i = 0; i < 8; ++i) { unsigned ka = part[i], kb = part[i + 8]; float xa = ex[i], xb = ex[i + 8]; asm volatile("" : "+v"(ka), "+v"(kb), "+v"(xa), "+v"(xb));
                    const unsigned key = odd ? kb : ka; int i1, i2; tk_decode(key, i1, i2);
                    ei[i] = (int)r1[i1] * 128 + (int)r2[i2]; eg[i] = (odd ? xb : xa) * inv; }
                *(i32x4v*)oi = (i32x4v){ei[0], ei[1], ei[2], ei[3]}; *(i32x4v*)(oi + 4) = (i32x4v){ei[4], ei[5], ei[6], ei[7]};
                *(f32x4*)og = (f32x4){eg[0], eg[1], eg[2], eg[3]}; *(f32x4*)(og + 4) = (f32x4){eg[4], eg[5], eg[6], eg[7]};
            } else if (uvn > 0) uv_convert(pu, pv, gffn, u8, v8, iu, iv, uvslot + 4 * ai + (wid - 4), uvn, fresh_lane());
            asm volatile("s_waitcnt lgkmcnt(0)" ::: "memory"); __builtin_amdgcn_s_barrier(); asm volatile("" ::: "memory");
        }
    }
};
struct EpiPP {
    static constexpr bool PERM = true, AFTER_DRAIN = false;
    bf16* pp;
    __device__ __forceinline__ void operator()(const f32x4 (&acc)[2][2][4][2], const Unit& u, int wr, int wc, int fr, int fq) const {
        { const int t_ = fresh_lane(); fr = t_ & 15; fq = t_ >> 4; }
        const int row0 = u.pm * 256 + wr * 64 + fr, col0 = u.pn * 256 + wc * 32 + 8 * fq;
#pragma unroll
        for (int ai = 0; ai < 2; ++ai)
#pragma unroll
            for (int m = 0; m < 4; ++m) {
                const size_t off = (size_t)(row0 + ai * 128 + m * 16) * 1024 + col0;
#pragma unroll
                for (int bj = 0; bj < 2; ++bj) *(u32x4*)(pp + off + bj * 128) = pack8(acc[ai][bj][m][0], acc[ai][bj][m][1]);
            }
    }
};
struct EpiH3 {
    static constexpr bool PERM = true, AFTER_DRAIN = false;
    const float* rstd3; const bf16* pp; float* h; float* part; const bf16* h2b; bf16* h3b;
    __device__ __forceinline__ void operator()(const f32x4 (&acc)[2][2][4][2], const Unit& u, int wr, int wc, int fr, int fq) const {
        { const int t_ = fresh_lane(); fr = t_ & 15; fq = t_ >> 4; }
        const int row0 = u.pm * 256 + wr * 64 + fr, col0 = u.pn * 256 + wc * 32 + 8 * fq;
#pragma unroll
        for (int ai = 0; ai < 2; ++ai)
#pragma unroll
            for (int m = 0; m < 4; ++m) {
                const int r = row0 + ai * 128 + m * 16; const size_t off = (size_t)r * 1024 + col0; const float rs = rstd3[r]; float sq = 0.f;
#pragma unroll
                for (int bj = 0; bj < 2; ++bj) {
                    const size_t o = off + bj * 128; const u32x4 pw = *(const u32x4*)(pp + o);
#if ALL_FUSED
                    const u32x4 hw = *(const u32x4*)(h2b + o);
                    const f32x4 v0 = bf4_lo((u32x2){hw.x, hw.y}) + sig4(acc[ai][bj][m][0] * rs) * bf4_lo((u32x2){pw.x, pw.y});
                    const f32x4 v1 = bf4_lo((u32x2){hw.z, hw.w}) + sig4(acc[ai][bj][m][1] * rs) * bf4_lo((u32x2){pw.z, pw.w});
                    *(u32x4*)(h3b + o) = pack8(v0, v1);
#else
                    const f32x4 v0 = *(const f32x4*)(h + o) + sig4(acc[ai][bj][m][0] * rs) * bf4_lo((u32x2){pw.x, pw.y});
                    const f32x4 v1 = *(const f32x4*)(h + o + 4) + sig4(acc[ai][bj][m][1] * rs) * bf4_lo((u32x2){pw.z, pw.w});
                    *(f32x4*)(h + o) = v0; *(f32x4*)(h + o + 4) = v1;
#endif
                    sq += (v0[0] * v0[0] + v0[1] * v0[1]) + (v0[2] * v0[2] + v0[3] * v0[3]) + (v1[0] * v1[0] + v1[1] * v1[1]) + (v1[2] * v1[2] + v1[3] * v1[3]);
                }
                sq += __shfl_xor(sq, 16); sq += __shfl_xor(sq, 32);
                if (fq == 0) part[(size_t)r * 16 + u.pn * 4 + wc] = sq;
            }
    }
};
struct EpiPre {
    static constexpr bool PERM = false, AFTER_DRAIN = false;
    float* rp; float* ip;
    __device__ __forceinline__ void operator()(const f32x4 (&acc)[2][2][4][2], const Unit& u, int wr, int wc, int fr, int fq) const {
        { const int t_ = fresh_lane(); fr = t_ & 15; fq = t_ >> 4; }
#pragma unroll
        for (int n = 0; n < 2; ++n) { const int ch = u.pn * 128 + wc * 32 + 16 * n + 4 * fq;
#pragma unroll
            for (int ai = 0; ai < 2; ++ai)
#pragma unroll
                for (int m = 0; m < 4; ++m) { const int r = u.pm * 256 + ai * 128 + wr * 64 + m * 16 + fr; const size_t o = (size_t)r * 1024 + ch; *(f32x4*)(rp + o) = acc[ai][0][m][n]; *(f32x4*)(ip + o) = acc[ai][1][m][n]; } }
    }
};
struct EpiH3Final {
    static constexpr bool PERM = true, AFTER_DRAIN = false;
    const float* rstd3; const bf16* pp; const bf16* h2b; const float* fg; float* out; float* part; unsigned* cnt;
    __device__ __forceinline__ void operator()(f32x4 (&acc)[2][2][4][2], const Unit& u, int wr, int wc, int fr, int fq) const {
        { const int t_ = fresh_lane(); fr = t_ & 15; fq = t_ >> 4; }
        const int row0 = u.pm * 256 + wr * 64 + fr, col0 = u.pn * 256 + wc * 32 + 8 * fq;
#pragma unroll
        for (int ai = 0; ai < 2; ++ai)
#pragma unroll
            for (int m = 0; m < 4; ++m) {
                const int r = row0 + ai * 128 + m * 16; const size_t off = (size_t)r * 1024 + col0; const float rs = rstd3[r]; float sq = 0.f;
#pragma unroll
                for (int bj = 0; bj < 2; ++bj) {
                    const size_t o = off + bj * 128; const u32x4 pw = *(const u32x4*)(pp + o); const u32x4 hw = *(const u32x4*)(h2b + o);
                    const f32x4 v0 = bf4_lo((u32x2){hw.x, hw.y}) + sig4(acc[ai][bj][m][0] * rs) * bf4_lo((u32x2){pw.x, pw.y});
                    const f32x4 v1 = bf4_lo((u32x2){hw.z, hw.w}) + sig4(acc[ai][bj][m][1] * rs) * bf4_lo((u32x2){pw.z, pw.w});
                    acc[ai][bj][m][0] = v0; acc[ai][bj][m][1] = v1;
                    sq += (v0[0] * v0[0] + v0[1] * v0[1]) + (v0[2] * v0[2] + v0[3] * v0[3]) + (v1[0] * v1[0] + v1[1] * v1[1]) + (v1[2] * v1[2] + v1[3] * v1[3]);
                }
                sq += __shfl_xor(sq, 16); sq += __shfl_xor(sq, 32);
                if (fq == 0) __hip_atomic_store(part + (size_t)r * 16 + u.pn * 4 + wc, sq, __ATOMIC_RELAXED, __HIP_MEMORY_SCOPE_AGENT);
            }
        asm volatile("s_waitcnt vmcnt(0)" ::: "memory");
        const int lane = fq * 16 + fr;
        unsigned* c = cnt + 64 * u.pm;
        if (lane == 0) __hip_atomic_fetch_add(c, 1u, __ATOMIC_RELAXED, __HIP_MEMORY_SCOPE_AGENT);
        {
            const unsigned long long t0 = __builtin_amdgcn_s_memrealtime();
            while ((unsigned)__builtin_amdgcn_readfirstlane((int)__hip_atomic_load(c, __ATOMIC_RELAXED, __HIP_MEMORY_SCOPE_AGENT)) < 32u) {
                if (__builtin_amdgcn_s_memrealtime() - t0 > 2000000ull) break;
                __builtin_amdgcn_s_sleep(2);
            }
        }
        { const int t_ = fresh_lane(); fr = t_ & 15; fq = t_ >> 4; }
#pragma unroll
        for (int ai = 0; ai < 2; ++ai)
#pragma unroll
            for (int m = 0; m < 4; ++m) {
                const int r = u.pm * 256 + wr * 64 + fr + ai * 128 + m * 16;
                float ps = 0.f;
#pragma unroll
                for (int k = 0; k < 16; ++k) ps += __hip_atomic_load(part + (size_t)r * 16 + k, __ATOMIC_RELAXED, __HIP_MEMORY_SCOPE_AGENT);
                const float rr = 1.0f / sqrtf(ps * (1.0f / 1024.0f) + EPS);
                const int cc = u.pn * 256 + wc * 32 + 8 * fq;
#pragma unroll
                for (int bj = 0; bj < 2; ++bj) {
                    const f32x4 g0 = *(const f32x4*)(fg + cc + bj * 128), g1 = *(const f32x4*)(fg + cc + bj * 128 + 4);
                    float* op = out + (size_t)r * 1024 + cc + bj * 128;
                    *(f32x4*)op = acc[ai][bj][m][0] * rr * g0; *(f32x4*)(op + 4) = acc[ai][bj][m][1] * rr * g1;
                }
            }
    }
};
template <int CTRL> __device__ __forceinline__ float dpp_f(float oldv, float src) {
    return __builtin_bit_cast(float, __builtin_amdgcn_update_dpp(__builtin_bit_cast(int, oldv), __builtin_bit_cast(int, src), CTRL, 0xf, 0xf, false));
}
#ifndef LRU_T2
#define LRU_T2 0
#endif
struct EpiLru {
    static constexpr bool PERM = false, AFTER_DRAIN = false;
    const bf16* lin; const float* ba; const float* bx; const float* c8l; bf16* hloc; bf16* pcum; float* agg;
    template <int SH> static __device__ __forceinline__ void step(f32x4& A, f32x4& Bv, float idd) {
#pragma unroll
        for (int j = 0; j < 4; ++j) {
            const float ap = __int_as_float(__builtin_amdgcn_update_dpp(0, __float_as_int((float)A[j]), 0x110 + SH, 0xf, 0xf, true)) + idd;
            const float bp = __int_as_float(__builtin_amdgcn_update_dpp(0, __float_as_int((float)Bv[j]), 0x110 + SH, 0xf, 0xf, true));
            Bv[j] = fmaf(A[j], bp, Bv[j]); A[j] = A[j] * ap; }
    }
    __device__ __forceinline__ void operator()(f32x4 (&acc)[2][2][4][2], const Unit& u, int wr, int wc, int fr, int fq) const {
        { const int t_ = fresh_lane(); fr = t_ & 15; fq = t_ >> 4; }
        const int lane = fq * 16 + fr;
#pragma unroll
        for (int n = 0; n < 2; ++n) {
            const int ch = u.pn * 128 + wc * 32 + 16 * n + 4 * fq;
            const f32x4 bav = *(const f32x4*)(ba + ch), bxv = *(const f32x4*)(bx + ch), cv = *(const f32x4*)(c8l + ch);
#pragma unroll
            for (int ai = 0; ai < 2; ++ai)
#pragma unroll
                for (int m = 0; m < 4; ++m) {
                    const int r = u.pm * 256 + ai * 128 + wr * 64 + m * 16 + fr; const unsigned o = (unsigned)r * 1024u + (unsigned)ch;
                    const f32x4 lv = bf4_lo(*(const u32x2*)(lin + o));
#pragma unroll
                    for (int j = 0; j < 4; ++j) {
                        const float rr = sigmoidf_(acc[ai][0][m][n][j] + bav[j]), ii = sigmoidf_(acc[ai][1][m][n][j] + bxv[j]);
                        const float a = __builtin_amdgcn_exp2f(cv[j] * rr);
                        acc[ai][0][m][n][j] = a; acc[ai][1][m][n][j] = __builtin_amdgcn_sqrtf(fmaxf(1.0f - a * a, 0.f)) * (ii * lv[j]);
                    }
                    asm volatile("" : "+v"(acc[ai][0][m][n]), "+v"(acc[ai][1][m][n]));
                }
        }
#if defined(LRU_DEBUG) && LRU_DEBUG == 1
        {
            float* af = (float*)hloc; float* bf = (float*)pcum;
#pragma unroll
            for (int n = 0; n < 2; ++n) { const int ch = u.pn * 128 + wc * 32 + 16 * n + 4 * fq;
#pragma unroll
                for (int ai = 0; ai < 2; ++ai)
#pragma unroll
                    for (int m = 0; m < 4; ++m) { const int r = u.pm * 256 + ai * 128 + wr * 64 + m * 16 + fr; const size_t o = (size_t)r * 1024 + ch; *(f32x4*)(af + o) = acc[ai][0][m][n]; *(f32x4*)(bf + o) = acc[ai][1][m][n]; } }
            return;
        }
#endif
        __builtin_amdgcn_sched_barrier(0);
        const float id1 = fr < 1 ? 1.f : 0.f, id2 = fr < 2 ? 1.f : 0.f, id4 = fr < 4 ? 1.f : 0.f, id8 = fr < 8 ? 1.f : 0.f;
#pragma unroll
        for (int ai = 0; ai < 2; ++ai)
#pragma unroll
            for (int m = 0; m < 4; ++m)
#pragma unroll
                for (int n = 0; n < 2; ++n) { step<1>(acc[ai][0][m][n], acc[ai][1][m][n], id1); step<2>(acc[ai][0][m][n], acc[ai][1][m][n], id2); step<4>(acc[ai][0][m][n], acc[ai][1][m][n], id4); step<8>(acc[ai][0][m][n], acc[ai][1][m][n], id8);
                    asm volatile("" : "+v"(acc[ai][0][m][n]), "+v"(acc[ai][1][m][n])); }
        { const int t_ = fresh_lane(); fr = t_ & 15; fq = t_ >> 4; }
        const int src4 = (((fq * 16 + fr) & 48) | 15) * 4;
#pragma unroll
        for (int n = 0; n < 2; ++n) {
            const int ch = u.pn * 128 + wc * 32 + 16 * n + 4 * fq;
#pragma unroll
            for (int ai = 0; ai < 2; ++ai) {
#pragma unroll
                for (int m = 0; m < 4; ++m) {
                    f32x4& A = acc[ai][0][m][n]; f32x4& Bv = acc[ai][1][m][n];
                    if (m > 0 && !(LRU_T2)) {
#pragma unroll
                        for (int j = 0; j < 4; ++j) { const float pa = acc[ai][0][m - 1][n][j], pb = acc[ai][1][m - 1][n][j];
                            const float ac = __int_as_float(__builtin_amdgcn_ds_bpermute(src4, __float_as_int(pa))), bc = __int_as_float(__builtin_amdgcn_ds_bpermute(src4, __float_as_int(pb))); Bv[j] = fmaf(A[j], bc, Bv[j]); A[j] = A[j] * ac; }
                    }
                    const int r = u.pm * 256 + ai * 128 + wr * 64 + m * 16 + fr; const unsigned o = (unsigned)r * 1024u + (unsigned)ch;
                    u32x2 wp, wh; wp.x = cvt_pk_bf16(A[0], A[1]); wp.y = cvt_pk_bf16(A[2], A[3]); wh.x = cvt_pk_bf16(Bv[0], Bv[1]); wh.y = cvt_pk_bf16(Bv[2], Bv[3]);
                    *(u32x2*)(pcum + o) = wp; *(u32x2*)(hloc + o) = wh;
                    if (m == 3 && fr == 15) {
                        const int chunk = u.pm * 4 + ai * 2 + wr; float* ap = agg + ((size_t)chunk * 1024 + ch) * 2;
                        *(f32x4*)(ap) = (f32x4){A[0], Bv[0], A[1], Bv[1]}; *(f32x4*)(ap + 4) = (f32x4){A[2], Bv[2], A[3], Bv[3]};
                    }
                    __builtin_amdgcn_sched_barrier(0);
                }
            }
        }
    }
};

__device__ __forceinline__ void p0_transpose_item(const float* W, int ldw, const float* gain, bf16* WT, int ldt, int k_off, LAS float* scr, int kb, int nb, int lane) {
    const int k0 = 64 * kb, n0 = 32 * nb;
    const int c4 = lane & 7, kr = lane >> 3;
    f32x4 v[8];
#pragma unroll
    for (int i = 0; i < 8; ++i) v[i] = *(const f32x4*)(W + (size_t)(k0 + 8 * i + kr) * ldw + n0 + 4 * c4);
#pragma unroll
    for (int i = 0; i < 8; ++i) { f32x4 x = v[i]; if (gain) x = x * gain[k0 + 8 * i + kr]; *(LAS f32x4*)(scr + (8 * i + kr) * 36 + 4 * c4) = x; }
    LDS_WAIT(); asm volatile("" ::: "memory");
    const int c = lane & 7;
#pragma unroll
    for (int j = 0; j < 4; ++j) { const int n = (lane >> 3) + 8 * j; const LAS float* sp = scr + (8 * c) * 36 + n;
        u32x4 o; o.x = pk2(sp[0 * 36], sp[1 * 36]); o.y = pk2(sp[2 * 36], sp[3 * 36]); o.z = pk2(sp[4 * 36], sp[5 * 36]); o.w = pk2(sp[6 * 36], sp[7 * 36]);
        *(u32x4*)(WT + (size_t)(n0 + n) * ldt + k_off + k0 + 8 * c) = o; }
    LDS_WAIT(); asm volatile("" ::: "memory");
}
__device__ __forceinline__ void p0_wfold_item(LAS float* lds, const float* wq, const float* k1, const float* k2, const float* gffn, bf16* wfold, int item, int tid) {
    const int hh = item >> 4, kb = item & 15;
    LAS float* wqs = lds; LAS float* kks = lds + 64 * 132;
    const float* ksrc = (hh & 1) ? k2 : k1;
#pragma unroll
    for (int i = 0; i < 4; ++i) { const int e = tid + i * 512, r = e >> 5, c4 = e & 31; *(LAS f32x4*)(wqs + r * 132 + 4 * c4) = *(const f32x4*)(wq + (size_t)(kb * 64 + r) * 2048 + hh * 128 + 4 * c4); }
#pragma unroll
    for (int i = 0; i < 8; ++i) { const int e = tid + i * 512, r = e >> 5, c4 = e & 31; *(LAS f32x4*)(kks + r * 132 + 4 * c4) = *(const f32x4*)(ksrc + (size_t)r * 128 + 4 * c4); }
    __syncthreads();
    const int tk = tid & 15, tkey = tid >> 4;
    float acc[4][4];
#pragma unroll
    for (int i = 0; i < 4; ++i)
#pragma unroll
        for (int j = 0; j < 4; ++j) acc[i][j] = 0.f;
#pragma unroll 2
    for (int c4 = 0; c4 < 32; ++c4) {
        f32x4 a[4], b[4];
#pragma unroll
        for (int i = 0; i < 4; ++i) { a[i] = *(const LAS f32x4*)(wqs + (tk * 4 + i) * 132 + 4 * c4); b[i] = *(const LAS f32x4*)(kks + (tkey * 4 + i) * 132 + 4 * c4); }
#pragma unroll
        for (int i = 0; i < 4; ++i)
#pragma unroll
            for (int j = 0; j < 4; ++j) acc[i][j] += (a[i][0] * b[j][0] + a[i][1] * b[j][1]) + (a[i][2] * b[j][2] + a[i][3] * b[j][3]);
    }
    const int kg = kb * 64 + tk * 4; const f32x4 gv = *(const f32x4*)(gffn + kg);
#pragma unroll
    for (int j = 0; j < 4; ++j) { u32x2 w; w.x = pk2(acc[0][j] * gv[0], acc[1][j] * gv[1]); w.y = pk2(acc[2][j] * gv[2], acc[3][j] * gv[3]);
        *(u32x2*)(wfold + (size_t)(hh * 128 + tkey * 4 + j) * 1024 + kg) = w; }
    __syncthreads();
}

struct In { const float* p[25]; };
enum { I_X = 0, I_P, I_GMIX, I_WIN, I_SINK, I_CONVW, I_CONVB, I_WA, I_BA, I_WX, I_BX, I_LAM, I_WUA, I_WUL, I_WO, I_GFFN, I_WQ, I_K1, I_K2, I_U, I_V, I_GPLE, I_WGATE, I_WPROJ, I_FG };

__device__ __forceinline__ void p0_prologue(const In& in, unsigned char* ws, LAS unsigned char* lds, int vcu, int G, int wave, int tid) {
    const int lane = tid & 63;
    LAS float* scr = (LAS float*)(lds + wave * 16384);
    const int gw = vcu * NWAVES + wave, NGW = G * NWAVES;
    constexpr int I_IN = 16 * 152, I_UA = 8 * 32, I_SQ = 16 * 32, I_PJ = 4 * 32, I_AX = 128;
    constexpr int NITEMS = I_IN + I_UA + 3 * I_SQ + I_PJ + I_AX;
    for (int it = gw; it < NITEMS; it += NGW) {
        int r = it;
        if (r < I_IN) { p0_transpose_item(in.p[I_WIN], INW, in.p[I_GMIX], (bf16*)(ws + WS_WIN), 1024, 0, scr, r / 152, r % 152, lane); continue; } r -= I_IN;
        if (r < I_UA) { p0_transpose_item(in.p[I_WUA], 1024, nullptr, (bf16*)(ws + WS_WUA), 512, 0, scr, r / 32, r % 32, lane); continue; } r -= I_UA;
        if (r < I_SQ) { p0_transpose_item(in.p[I_WUL], 1024, nullptr, (bf16*)(ws + WS_WUL), 1024, 0, scr, r / 32, r % 32, lane); continue; } r -= I_SQ;
        if (r < I_SQ) { p0_transpose_item(in.p[I_WO], 1024, nullptr, (bf16*)(ws + WS_WO), 1024, 0, scr, r / 32, r % 32, lane); continue; } r -= I_SQ;
        if (r < I_SQ) { p0_transpose_item(in.p[I_WGATE], 1024, in.p[I_GPLE], (bf16*)(ws + WS_WG), 1024, 0, scr, r / 32, r % 32, lane); continue; } r -= I_SQ;
        if (r < I_PJ) { p0_transpose_item(in.p[I_WPROJ], 1024, nullptr, (bf16*)(ws + WS_WPROJ), 256, 0, scr, r / 32, r % 32, lane); continue; } r -= I_PJ;
        { const int blk = r >> 4, which = (r >> 3) & 1, sub = r & 7;

#if LRU_PADDED
#if LRU_PADDED == 2
          p0_transpose_item(in.p[which ? I_WX : I_WA] + (size_t)blk * 16384, 128, nullptr, (bf16*)(ws + WS_WAX) + (size_t)blk * 32768 + which * 128 * 128, 128, 0, scr, sub >> 2, sub & 3, lane); }
#else
          p0_transpose_item(in.p[which ? I_WX : I_WA] + (size_t)blk * 16384, 128, nullptr, (bf16*)(ws + WS_WAX) + (size_t)blk * 65536 + which * 128 * 256, 256, (blk & 1) * 128, scr, sub >> 2, sub & 3, lane); }
#endif
#else
          p0_transpose_item(in.p[which ? I_WX : I_WA] + (size_t)blk * 16384, 128, nullptr, (bf16*)(ws + WS_WAXD) + (size_t)(blk * 256 + which * 128) * 1024, 1024, blk * 128, scr, sub >> 2, sub & 3, lane); }
#endif
    }
#if LRU_PADDED == 2
#elif LRU_PADDED
    for (int i = vcu * 512 + tid; i < 8 * 256 * 16; i += G * 512) { const int c16 = i & 15, n = (i >> 4) & 255, blk = i >> 12;
        *(u32x4*)((bf16*)(ws + WS_WAX) + (size_t)blk * 65536 + n * 256 + ((blk & 1) ^ 1) * 128 + c16 * 8) = (u32x4){0u, 0u, 0u, 0u}; }
#else
    for (int i = vcu * 512 + tid; i < 2048 * 128; i += G * 512) { const int c16 = i & 127, row = i >> 7, blk = row >> 8;
        if ((c16 >> 4) != blk) *(u32x4*)((bf16*)(ws + WS_WAXD) + (size_t)row * 1024 + c16 * 8) = (u32x4){0u, 0u, 0u, 0u}; }
#endif
    for (int m = gw; m < T_; m += 2 * NGW) {
        const int m2 = m + NGW;
        const f32x4* xa = (const f32x4*)(in.p[I_X] + (size_t)m * 1024) + lane; const f32x4* xb = (const f32x4*)(in.p[I_X] + (size_t)(m2 < T_ ? m2 : m) * 1024) + lane;
        f32x4 va[4], vb[4]; float sa = 0.f, sb = 0.f;
#pragma unroll
        for (int j = 0; j < 4; ++j) { va[j] = xa[64 * j]; vb[j] = xb[64 * j]; }
#pragma unroll
        for (int j = 0; j < 4; ++j) { sa += (va[j][0] * va[j][0] + va[j][1] * va[j][1]) + (va[j][2] * va[j][2] + va[j][3] * va[j][3]); sb += (vb[j][0] * vb[j][0] + vb[j][1] * vb[j][1]) + (vb[j][2] * vb[j][2] + vb[j][3] * vb[j][3]); }
#pragma unroll
        for (int o = 1; o < 64; o <<= 1) { sa += __shfl_xor(sa, o); sb += __shfl_xor(sb, o); }
        u32x2* oa = (u32x2*)((bf16*)(ws + WS_R0) + (size_t)m * 1024) + lane;
#pragma unroll
        for (int j = 0; j < 4; ++j) { u32x2 w; w.x = pk2(va[j][0], va[j][1]); w.y = pk2(va[j][2], va[j][3]); oa[64 * j] = w; }
        if (lane == 0) ((float*)(ws + WS_RSTD1))[m] = 1.0f / sqrtf(sa * (1.0f / 1024.0f) + EPS);
        if (m2 < T_) {
            u32x2* ob = (u32x2*)((bf16*)(ws + WS_R0) + (size_t)m2 * 1024) + lane;
#pragma unroll
            for (int j = 0; j < 4; ++j) { u32x2 w; w.x = pk2(vb[j][0], vb[j][1]); w.y = pk2(vb[j][2], vb[j][3]); ob[64 * j] = w; }
            if (lane == 0) ((float*)(ws + WS_RSTD1))[m2] = 1.0f / sqrtf(sb * (1.0f / 1024.0f) + EPS);
        }
    }
    for (int m = gw; m < T_; m += 4 * NGW) {
        f32x4 v[4];
#pragma unroll
        for (int q = 0; q < 4; ++q) { const int mq = m + q * NGW; v[q] = ((const f32x4*)(in.p[I_P] + (size_t)(mq < T_ ? mq : m) * 256))[lane]; }
#pragma unroll
        for (int q = 0; q < 4; ++q) { const int mq = m + q * NGW; if (mq < T_) { u32x2 w; w.x = pk2(v[q][0], v[q][1]); w.y = pk2(v[q][2], v[q][3]); ((u32x2*)((bf16*)(ws + WS_PB) + (size_t)mq * 256))[lane] = w; } }
    }
    if (vcu == 0) for (int c = tid; c < 1024; c += 512) ((float*)(ws + WS_C8))[c] = -8.0f * log1pf(expf(-in.p[I_LAM][c])) * LOG2E;
    __syncthreads();
    for (int it = vcu; it < 256; it += G) p0_wfold_item((LAS float*)lds, in.p[I_WQ], in.p[I_K1], in.p[I_K2], in.p[I_GFFN], (bf16*)(ws + WS_WFOLD), it, tid);
}

constexpr int AT_KSTR = 72, AT_VSTR = 260, AT_V_OFF = 256 * AT_KSTR * 2;
__device__ __forceinline__ int crow(int r, int hi) { return (r & 3) + 8 * (r >> 2) + 4 * hi; }
__device__ __forceinline__ void attn_item(LAS unsigned char* lds, const bf16* qkv, const float* sink, bf16* att, int item, int wave, int tid) {
    const int lane = tid & 63;
    const int g = item & 1, n = (item >> 1) & 15, b = item >> 5;
    const int t0 = b * S_ + n * 128;
    LAS bf16* Ks = (LAS bf16*)lds; LAS bf16* Vt = (LAS bf16*)(lds + AT_V_OFF);
#pragma unroll
    for (int i = 0; i < 4; ++i) {
        const int idx = tid + i * 512, row = idx >> 3, ch = idx & 7; const int tk = t0 - 128 + row;
        u32x4 kv = (u32x4){0u, 0u, 0u, 0u}, vv = (u32x4){0u, 0u, 0u, 0u};
        if (n > 0 || row >= 128) { const bf16* src = qkv + (size_t)tk * 768 + 512 + g * 64 + ch * 8; kv = *(const u32x4*)src; vv = *(const u32x4*)(src + 128); }
        *(LAS u32x4*)(Ks + row * AT_KSTR + ch * 8) = kv;
#pragma unroll
        for (int c = 0; c < 8; ++c) Vt[(ch * 8 + c) * AT_VSTR + row] = (bf16)(vv[c >> 1] >> (16 * (c & 1)));
    }
    __syncthreads();
    const int hr = wave >> 1, qh = wave & 1, head = g * 4 + hr;
    const float slope2 = exp2f(-(float)(head + 1)) * LOG2E, sink2 = sink[head] * LOG2E;
    const int q = lane & 31, hi = lane >> 5;
#pragma unroll 1
    for (int ps = 0; ps < 2; ++ps) {
        const int i0 = 64 * qh + 32 * ps, kb0 = i0;
        const bf16* qp = qkv + (size_t)(t0 + i0 + q) * 768 + head * 64 + 8 * hi;
        bf16x8 qf[4];
#pragma unroll
        for (int s = 0; s < 4; ++s) qf[s] = *(const bf16x8*)(qp + 16 * s);
        f32x16 oT[2];
#pragma unroll
        for (int dt = 0; dt < 2; ++dt)
#pragma unroll
            for (int r = 0; r < 16; ++r) oT[dt][r] = 0.f;
        float mrun = sink2, l = 0.f;
#pragma unroll 1
        for (int kt = 0; kt < 5; ++kt) {
            const int kbase = kb0 + 32 * kt;
            f32x16 sT;
#pragma unroll
            for (int r = 0; r < 16; ++r) sT[r] = 0.f;
#pragma unroll
            for (int s = 0; s < 4; ++s) { const bf16x8 kf = *(const LAS bf16x8*)(Ks + (kbase + q) * AT_KSTR + 16 * s + 8 * hi); sT = __builtin_amdgcn_mfma_f32_32x32x16_bf16(kf, qf[s], sT, 0, 0, 0); }
            float tm = -1.0e30f;
#pragma unroll
            for (int r = 0; r < 16; ++r) {
                const int kj = kbase + crow(r, hi); const int dist = i0 + q + 128 - kj;
                const bool valid = (dist >= 0) && (dist < 128) && (n > 0 || kj >= 128);
                const float v = valid ? (sT[r] * (0.125f * LOG2E) - slope2 * (float)dist) : -1.0e30f;
                sT[r] = v; tm = fmaxf(tm, v);
            }
            tm = fmaxf(tm, __shfl_xor(tm, 32));
            const float mnew = fmaxf(mrun, tm), alpha = __builtin_amdgcn_exp2f(mrun - mnew);
            mrun = mnew;
            float ls = 0.f;
#pragma unroll
            for (int r = 0; r < 16; ++r) { const float p = __builtin_amdgcn_exp2f(sT[r] - mnew); sT[r] = p; ls += p; }
            l = l * alpha + ls;
#pragma unroll
            for (int dt = 0; dt < 2; ++dt)
#pragma unroll
                for (int r = 0; r < 16; ++r) oT[dt][r] *= alpha;
#pragma unroll
            for (int s = 0; s < 2; ++s) {
                u32x4 pw; pw.x = cvt_pk_bf16(sT[8 * s + 0], sT[8 * s + 1]); pw.y = cvt_pk_bf16(sT[8 * s + 2], sT[8 * s + 3]);
                pw.z = cvt_pk_bf16(sT[8 * s + 4], sT[8 * s + 5]); pw.w = cvt_pk_bf16(sT[8 * s + 6], sT[8 * s + 7]);
                const bf16x8 pf = __builtin_bit_cast(bf16x8, pw);
#pragma unroll
                for (int dt = 0; dt < 2; ++dt) {
                    const LAS bf16* vp = Vt + (32 * dt + q) * AT_VSTR + kbase + 16 * s + 4 * hi;
                    const u32x2 va = *(const LAS u32x2*)vp, vb = *(const LAS u32x2*)(vp + 8);
                    const bf16x8 af = __builtin_bit_cast(bf16x8, (u32x4){va.x, va.y, vb.x, vb.y});
                    oT[dt] = __builtin_amdgcn_mfma_f32_32x32x16_bf16(af, pf, oT[dt], 0, 0, 0);
                }
            }
        }
        l += __shfl_xor(l, 32);
        l += __builtin_amdgcn_exp2f(sink2 - mrun);
        const float inv = 1.0f / l;
        bf16* op = att + (size_t)(t0 + i0 + q) * 512 + head * 64 + 4 * hi;
#pragma unroll
        for (int dt = 0; dt < 2; ++dt)
#pragma unroll
            for (int rg = 0; rg < 4; ++rg) { u32x2 w; w.x = cvt_pk_bf16(oT[dt][4 * rg] * inv, oT[dt][4 * rg + 1] * inv); w.y = cvt_pk_bf16(oT[dt][4 * rg + 2] * inv, oT[dt][4 * rg + 3] * inv);
                *(u32x2*)(op + 32 * dt + 8 * rg) = w; }
    }
    __syncthreads();
}
__device__ __forceinline__ void conv_items(const bf16* lx, const float* cw, const float* cb, bf16* lin, int vcu, int G, int tid) {
    for (int i = vcu * 512 + tid; i < T_ * 128; i += 2 * G * 512) {
        const int c8 = (i & 127) * 8;
        const int ta = i >> 7, i2 = i + G * 512; const bool hasb = i2 < T_ * 128; const int tb = hasb ? (i2 >> 7) : ta;
        const int tsa = ta & (S_ - 1), tsb = tb & (S_ - 1);
        u32x4 wa[4], wb[4];
#pragma unroll
        for (int tap = 0; tap < 4; ++tap) {
            wa[tap] = (tsa - 3 + tap >= 0) ? *(const u32x4*)(lx + (size_t)(ta - 3 + tap) * 1024 + c8) : (u32x4){0u, 0u, 0u, 0u};
            wb[tap] = (tsb - 3 + tap >= 0) ? *(const u32x4*)(lx + (size_t)(tb - 3 + tap) * 1024 + c8) : (u32x4){0u, 0u, 0u, 0u};
        }
        f32x4 a0 = *(const f32x4*)(cb + c8), a1 = *(const f32x4*)(cb + c8 + 4), b0 = a0, b1 = a1;
#pragma unroll
        for (int tap = 0; tap < 4; ++tap) {
            const f32x4 w0 = *(const f32x4*)(cw + tap * 1024 + c8), w1 = *(const f32x4*)(cw + tap * 1024 + c8 + 4);
            a0 += bf4_lo((u32x2){wa[tap].x, wa[tap].y}) * w0; a1 += bf4_lo((u32x2){wa[tap].z, wa[tap].w}) * w1;
            b0 += bf4_lo((u32x2){wb[tap].x, wb[tap].y}) * w0; b1 += bf4_lo((u32x2){wb[tap].z, wb[tap].w}) * w1;
        }
        *(u32x4*)(lin + (size_t)ta * 1024 + c8) = pack8(a0, a1);
        if (hasb) *(u32x4*)(lin + (size_t)tb * 1024 + c8) = pack8(b0, b1);
    }
}
__device__ __forceinline__ void scan_finish(const bf16* hloc, const bf16* pcum, const float* agg, const bf16* gl, bf16* rec, int vcu, int G, int tid) {
    const int c8 = (tid & 127) * 8, rg = tid >> 7;
    for (int chunk = vcu; chunk < T_ / 64; chunk += G) {
        const int ci = chunk & 31, cb = chunk - ci;
        float carry[8];
#pragma unroll
        for (int j = 0; j < 8; ++j) carry[j] = 0.f;
#pragma unroll 4
        for (int cc = 0; cc < ci; ++cc) {
            const f32x4* ap = (const f32x4*)(agg + ((size_t)(cb + cc) * 1024 + c8) * 2);
#pragma unroll
            for (int q = 0; q < 4; ++q) { const f32x4 v = ap[q]; carry[2 * q] = fmaf(v[0], carry[2 * q], v[1]); carry[2 * q + 1] = fmaf(v[2], carry[2 * q + 1], v[3]); }
        }
#pragma unroll 8
        for (int rr = 0; rr < 16; ++rr) {
            const size_t o = (size_t)(chunk * 64 + rg + 4 * rr) * 1024 + c8;
            const u32x4 hw = *(const u32x4*)(hloc + o), pw = *(const u32x4*)(pcum + o), gw = *(const u32x4*)(gl + o);
            const f32x4 h0 = bf4_lo((u32x2){hw.x, hw.y}), h1 = bf4_lo((u32x2){hw.z, hw.w}), p0 = bf4_lo((u32x2){pw.x, pw.y}), p1 = bf4_lo((u32x2){pw.z, pw.w});
            const f32x4 g0 = bf4_lo((u32x2){gw.x, gw.y}), g1 = bf4_lo((u32x2){gw.z, gw.w});
            f32x4 r0, r1;
#pragma unroll
            for (int j = 0; j < 4; ++j) { r0[j] = fmaf(p0[j], carry[j], h0[j]) * g0[j]; r1[j] = fmaf(p1[j], carry[4 + j], h1[j]) * g1[j]; }
            *(u32x4*)(rec + o) = pack8(r0, r1);
        }
    }
}
__device__ __forceinline__ void final_rows(float* h, const bf16* h3b, const float* part, const float* fg, int gw, int NGW, int lane, float tscale) {
    f32x4 g[4];
#pragma unroll
    for (int j = 0; j < 4; ++j) g[j] = ((const f32x4*)fg)[lane + 64 * j];
    for (int r0 = gw; r0 < T_; r0 += 2 * NGW) {
        const int r1 = (r0 + NGW < T_) ? r0 + NGW : r0;
        float pa = (lane < 16) ? part[(size_t)r0 * 16 + lane] : 0.f, pb = (lane < 16) ? part[(size_t)r1 * 16 + lane] : 0.f;
#if ALL_FUSED
        const u32x2* ba = (const u32x2*)(h3b + (size_t)r0 * 1024) + lane; const u32x2* bb = (const u32x2*)(h3b + (size_t)r1 * 1024) + lane;
        u32x2 wa[4], wb[4];
#pragma unroll
        for (int j = 0; j < 4; ++j) { wa[j] = ba[64 * j]; wb[j] = bb[64 * j]; }
#endif
#pragma unroll
        for (int o = 1; o < 64; o <<= 1) { pa += __shfl_xor(pa, o); pb += __shfl_xor(pb, o); }
        const float ra = tscale / sqrtf(pa * (1.0f / 1024.0f) + EPS), rb = tscale / sqrtf(pb * (1.0f / 1024.0f) + EPS);
        f32x4* ha = (f32x4*)(h + (size_t)r0 * 1024) + lane; f32x4* hb = (f32x4*)(h + (size_t)r1 * 1024) + lane;
#if ALL_FUSED
#pragma unroll
        for (int j = 0; j < 4; ++j) ha[64 * j] = bf4_lo(wa[j]) * ra * g[j];
        if (r1 != r0) {
#pragma unroll
            for (int j = 0; j < 4; ++j) hb[64 * j] = bf4_lo(wb[j]) * rb * g[j];
        }
#else
#pragma unroll
        for (int j = 0; j < 4; ++j) ha[64 * j] = ha[64 * j] * ra * g[j];
        if (r1 != r0) {
#pragma unroll
            for (int j = 0; j < 4; ++j) hb[64 * j] = hb[64 * j] * rb * g[j];
        }
#endif
    }
}

constexpr int N_PHASES = 16;
struct Args { const float* in[25]; float* out; unsigned char* ws; int ph_lo, ph_hi, li, pad; };
__global__ void __launch_bounds__(NWAVES * 64, 2) fused_fwd(Args args) {
    extern __shared__ __attribute__((aligned(16))) unsigned char lds_raw[];
    LAS unsigned char* lds = (LAS unsigned char*)lds_raw;
    volatile LAS unsigned* MISC = (volatile LAS unsigned*)(lds + LDSCTL_OFF);
    const int wave = __builtin_amdgcn_readfirstlane((int)threadIdx.x >> 6);
#define FRESH_TID() (wave * 64 + fresh_lane())
#define FRESH_LANE() fresh_lane()
    const int G = gridDim.x; const int bx = blockIdx.x; const int vcu = (G % 8 == 0) ? (bx % 8) * (G / 8) + bx / 8 : bx;
    unsigned char* ws = args.ws; float* out = args.out;
    In in;
#pragma unroll
    for (int i = 0; i < 25; ++i) in.p[i] = args.in[i];
    for (int u = FRESH_TID(); u < (LDS_BYTES - LDSCTL_OFF) / 4; u += NWAVES * 64) ((LAS unsigned*)(lds + LDSCTL_OFF))[u] = 0u;
    __syncthreads();
    (void)xcd_barrier_post((unsigned*)(ws + WS_CTL) + CW_BAR + args.li * XCD_BAR_WORDS, MISC + 8);
    const int lo = args.ph_lo, hi = args.ph_hi;
    const int gw = vcu * NWAVES + wave, NGW = G * NWAVES;
#ifndef PH_DISABLE
#define PH_DISABLE 0
#endif
#if ALL_FUSED
#define IN(k) (!((PH_DISABLE >> (k)) & 1))
#else
#define IN(k) (lo <= (k) && (k) < hi && !((PH_DISABLE >> (k)) & 1))
#endif
#ifdef TIMING_A
#define STAMP(i) do { if (bx == 0 && FRESH_TID() == 0) __hip_atomic_store((unsigned long long*)(ws + WS_CTL + 512) + (i), __builtin_amdgcn_s_memrealtime(), __ATOMIC_RELAXED, __HIP_MEMORY_SCOPE_AGENT); } while (0)
#else
#define STAMP(i) do { } while (0)
#endif
#define SEAM(k) do { if (IN(k) && IN((k) + 1)) { XcdBarrier b_; b_.bar = (unsigned*)(args.ws + WS_CTL) + CW_BAR + args.li * XCD_BAR_WORDS; b_.x = xb_xcc_id(); b_.st = (volatile LAS unsigned*)(lds + LDSCTL_OFF) + 8;     \
        xcd_barrier(b_); STAMP((k) + 1); } } while (0)
#if ALL_FUSED
#define PP_PTR ((const bf16*)((const unsigned char*)out + 32 * MiB))
#define MP_PTR out
#else
#define PP_PTR ((const bf16*)(ws + WS_PP))
#define MP_PTR ((float*)(ws + WS_MP))
#endif
#define GEMM_PHASE(EPI, Aptr, Bptr, Kdim, LDA, M_, N_, SH, STR, ...) do { \
        pg8::Gemm g{(const pg8::bf16_t*)(Aptr), (const pg8::bf16_t*)(Bptr), Kdim, LDA, SH, STR}; pg8::StaticOrder S; S.init(M_, N_, G, (int)blockIdx.x); \
        EPI E{__VA_ARGS__}; pg8::gemm_phase<EPI, pg8::StaticOrder, true, true>(lds, g, S, E, wave); } while (0)

    STAMP(0);
    if (IN(0)) { p0_prologue(in, ws, lds, vcu, G, wave, FRESH_TID()); } SEAM(0);
    if (IN(1)) { GEMM_PHASE(EpiProj, ws + WS_R0, ws + WS_WIN, 1024, 1024, T_, INW, 0, 0, (const float*)(ws + WS_RSTD1), ws); } SEAM(1);
    if (IN(2)) {
        for (int it = bx; it < 256; it += G) attn_item(lds, (const bf16*)(ws + WS_QKV), in.p[I_SINK], (bf16*)(ws + WS_ATT), it, wave, FRESH_TID());
        conv_items((const bf16*)(ws + WS_LX), in.p[I_CONVW], in.p[I_CONVB], (bf16*)(ws + WS_R0), vcu, G, FRESH_TID());
    } SEAM(2);
#if LRU_PADDED == 2
    if (IN(3)) { GEMM_PHASE(EpiLru, ws + WS_R0, ws + WS_WAX, 128, 1024, T_, 2048, 0, 128,
#elif LRU_PADDED
    if (IN(3)) { GEMM_PHASE(EpiLru, ws + WS_R0, ws + WS_WAX, 256, 1024, T_, 2048, 1, 256,
#else
    if (IN(3)) { GEMM_PHASE(EpiLru, ws + WS_R0, ws + WS_WAXD, 1024, 1024, T_, 2048, 0, 0,
#endif
        (const bf16*)(ws + WS_R0), in.p[I_BA], in.p[I_BX], (const float*)(ws + WS_C8), (bf16*)(ws + WS_HLOC), (bf16*)(ws + WS_PCUM), (float*)(ws + WS_AGG)); }
    SEAM(3);
    if (IN(4)) { scan_finish((const bf16*)(ws + WS_HLOC), (const bf16*)(ws + WS_PCUM), (const float*)(ws + WS_AGG), (const bf16*)(ws + WS_GL), (bf16*)(ws + WS_R0), vcu, G, FRESH_TID()); }
#if !ALL_FUSED
    SEAM(4);
#endif
    if (IN(5)) { GEMM_PHASE(EpiMP, ws + WS_ATT, ws + WS_WUA, 512, 512, T_, 1024, 0, 0, (const bf16*)(ws + WS_SGA), MP_PTR); }
#if ALL_FUSED
    if (IN(13)) { pg8::Gemm g{(const pg8::bf16_t*)(ws + WS_PB), (const pg8::bf16_t*)(ws + WS_WPROJ), 256, 256, 0, 0}; pg8::StaticOrder S;
        S.init(T_, 1024, G, (int)blockIdx.x);
        EpiPP E{(bf16*)((unsigned char*)out + 32 * MiB)}; pg8::gemm_phase<EpiPP, pg8::StaticOrder, true, true>(lds, g, S, E, wave); }
#endif
    SEAM(5);
    if (IN(6)) { GEMM_PHASE(EpiMerged, ws + WS_R0, ws + WS_WUL, 1024, 1024, T_, 1024, 0, 0, (const bf16*)(ws + WS_SGL), (const float*)MP_PTR, (bf16*)(ws + WS_MERGED)); } SEAM(6);
    if (IN(7)) { GEMM_PHASE(EpiH1, ws + WS_MERGED, ws + WS_WO, 1024, 1024, T_, 1024, 0, 0, in.p[I_X], out, (bf16*)(ws + WS_R0), (float*)(ws + WS_PART2)); }
    SEAM(7);
#define PEER_HALF(half) do { \
        if (IN(8 + 2 * (half))) { GEMM_PHASE(EpiScore, ws + WS_R0, ws + WS_WFOLD + (size_t)(half) * 1024 * 1024 * 2, 1024, 1024, T_, 1024, 0, 0, (const float*)(ws + WS_PART2), (float*)(ws + WS_SC)); } SEAM(8 + 2 * (half)); \
        if (IN(9 + 2 * (half))) { \
            for (int it = vcu; it < T_ / TK_TOK; it += G) topk_item((LAS float*)lds, (const float*)(ws + WS_SC), it, (half) * 4, (int*)(ws + WS_SELI), (float*)(ws + WS_SELG), FRESH_TID()); \
            if ((half) == 0) uv_convert(in.p[I_U], in.p[I_V], in.p[I_GFFN], ws + WS_U16, ws + WS_U16 + 16 * MiB, (float*)(ws + WS_USCALE), (float*)(ws + WS_USCALE) + 16384, gw, NGW, FRESH_LANE()); \
        } SEAM(9 + 2 * (half)); } while (0)
#if ALL_FUSED
    if (IN(8)) {
        for (int kk = 0; kk < 2; ++kk) { pg8::Gemm g{(const pg8::bf16_t*)(ws + WS_R0), (const pg8::bf16_t*)(ws + WS_WFOLD), 1024, 1024, 0, 0}; OneUnit S; S.S.init(T_, 2048, G, (int)blockIdx.x); S.k = kk;
            EpiTopk E{(const float*)(ws + WS_PART2), (int*)(ws + WS_SELI), (float*)(ws + WS_SELG), in.p[I_U], in.p[I_V], in.p[I_GFFN], ws + WS_U16, ws + WS_U16 + 16 * MiB, (float*)(ws + WS_USCALE), (float*)(ws + WS_USCALE) + 16384,
                      vcu * 16 + kk * 8, (2 * G == (T_ / 256) * 8) ? 16 * G : 0};
            pg8::gemm_phase<EpiTopk, OneUnit, false, true>(lds, g, S, E, wave); }
        if (2 * G != (T_ / 256) * 8) uv_convert(in.p[I_U], in.p[I_V], in.p[I_GFFN], ws + WS_U16, ws + WS_U16 + 16 * MiB, (float*)(ws + WS_USCALE), (float*)(ws + WS_USCALE) + 16384, gw, NGW, FRESH_LANE());
    } SEAM(11);
#else
    PEER_HALF(0);
    PEER_HALF(1);
#endif
    if (IN(12)) {
#ifdef PROBE_MODE
        for (int tok0 = vcu * 64; tok0 < T_; tok0 += G * 64)
#if GATHER_ROWS == 3
            gather_wg_mixed<PROBE_MODE>(tok0, wave, FRESH_LANE(), lds, ws + WS_U16, ws + WS_U16 + 16 * MiB, (const float*)(ws + WS_USCALE), (const float*)(ws + WS_USCALE) + 16384, (const int*)(ws + WS_SELI), (const float*)(ws + WS_SELG), (const float*)(ws + WS_PART2), (const bf16*)(ws + WS_R0), (bf16*)(ws + WS_H2B), (float*)(ws + WS_RSTD3), (float*)(ws + WS_SC));
#elif GATHER_ROWS == 1
            gather_wg_rows<PROBE_MODE>(tok0, wave, FRESH_LANE(), lds, ws + WS_U16, ws + WS_U16 + 16 * MiB, (const float*)(ws + WS_USCALE), (const float*)(ws + WS_USCALE) + 16384, (const int*)(ws + WS_SELI), (const float*)(ws + WS_SELG), (const float*)(ws + WS_PART2), (const bf16*)(ws + WS_R0), (bf16*)(ws + WS_H2B), (float*)(ws + WS_RSTD3), (float*)(ws + WS_SC));
#else
            gather_wg_sliced<PROBE_MODE>(tok0, wave, FRESH_LANE(), lds, ws + WS_U16, ws + WS_U16 + 16 * MiB, (const float*)(ws + WS_USCALE), (const float*)(ws + WS_USCALE) + 16384, (const int*)(ws + WS_SELI), (const float*)(ws + WS_SELG), (const float*)(ws + WS_PART2), out, (const bf16*)(ws + WS_R0), (bf16*)(ws + WS_H2B), (float*)(ws + WS_RSTD3), (float*)(ws + WS_SC));
#endif
        { XcdBarrier b_; b_.bar = (unsigned*)(args.ws + WS_CTL) + CW_BAR + args.li * XCD_BAR_WORDS; b_.x = xb_xcc_id(); b_.st = (volatile LAS unsigned*)(lds + LDSCTL_OFF) + 8; xcd_barrier(b_); STAMP(16); }
#endif
        for (int tok0 = vcu * 64; tok0 < T_; tok0 += G * 64)
#if GATHER_ROWS == 3
            gather_wg_mixed<0>(tok0, wave, FRESH_LANE(), lds, ws + WS_U16, ws + WS_U16 + 16 * MiB, (const float*)(ws + WS_USCALE), (const float*)(ws + WS_USCALE) + 16384, (const int*)(ws + WS_SELI), (const float*)(ws + WS_SELG), (const float*)(ws + WS_PART2), (const bf16*)(ws + WS_R0), (bf16*)(ws + WS_H2B), (float*)(ws + WS_RSTD3), nullptr);
#elif GATHER_ROWS == 1
            gather_wg_rows<0>(tok0, wave, FRESH_LANE(), lds, ws + WS_U16, ws + WS_U16 + 16 * MiB, (const float*)(ws + WS_USCALE), (const float*)(ws + WS_USCALE) + 16384, (const int*)(ws + WS_SELI), (const float*)(ws + WS_SELG), (const float*)(ws + WS_PART2), (const bf16*)(ws + WS_R0), (bf16*)(ws + WS_H2B), (float*)(ws + WS_RSTD3), nullptr);
#else
            gather_wg_sliced<0>(tok0, wave, FRESH_LANE(), lds, ws + WS_U16, ws + WS_U16 + 16 * MiB, (const float*)(ws + WS_USCALE), (const float*)(ws + WS_USCALE) + 16384, (const int*)(ws + WS_SELI), (const float*)(ws + WS_SELG), (const float*)(ws + WS_PART2), out, (const bf16*)(ws + WS_R0), (bf16*)(ws + WS_H2B), (float*)(ws + WS_RSTD3), nullptr);
#endif
    } SEAM(12);
#if !ALL_FUSED
    if (IN(13)) { GEMM_PHASE(EpiPP, ws + WS_PB, ws + WS_WPROJ, 256, 256, T_, 1024, 0, 0, (bf16*)(ws + WS_PP)); } SEAM(13);
#endif
#if ALL_FUSED && FUSE_FINAL
    if (IN(14)) { GEMM_PHASE(EpiH3Final, ws + WS_H2B, ws + WS_WG, 1024, 1024, T_, 1024, 0, 0, (const float*)(ws + WS_RSTD3), PP_PTR, (const bf16*)(ws + WS_H2B), in.p[I_FG], out, (float*)(ws + WS_PART4), (unsigned*)(ws + WS_CTL) + 65536); }
#else
    if (IN(14)) { GEMM_PHASE(EpiH3, ws + WS_H2B, ws + WS_WG, 1024, 1024, T_, 1024, 0, 0, (const float*)(ws + WS_RSTD3), PP_PTR, out, (float*)(ws + WS_PART4), (const bf16*)(ws + WS_H2B), (bf16*)(ws + WS_R0)); } SEAM(14);
#ifdef TIMING_A
    float tscale = 1.0f;
    { const unsigned long long ta = __hip_atomic_load((unsigned long long*)(ws + WS_CTL + 512) + TIMING_A, __ATOMIC_RELAXED, __HIP_MEMORY_SCOPE_AGENT), tb = __hip_atomic_load((unsigned long long*)(ws + WS_CTL + 512) + TIMING_B, __ATOMIC_RELAXED, __HIP_MEMORY_SCOPE_AGENT);
      tscale = 1.0f + (float)(tb - ta) * 0.01f * (float)(TIMING_K); }
    if (IN(15)) { final_rows(out, (const bf16*)(ws + WS_R0), (const float*)(ws + WS_PART4), in.p[I_FG], gw, NGW, FRESH_LANE(), tscale); }
#else
    if (IN(15)) { final_rows(out, (const bf16*)(ws + WS_R0), (const float*)(ws + WS_PART4), in.p[I_FG], gw, NGW, FRESH_LANE(), 1.0f); }
#endif
#endif
#undef IN
#undef SEAM
#undef GEMM_PHASE
}
static const int GRP_LO[11] = {0, 2, 3, 5, 6, 7, 8, 12, 13, 14, 15};
static const int GRP_HI[11] = {2, 3, 5, 6, 7, 8, 12, 13, 14, 15, 16};

static void naive_group(int grp, void* const* d_in, float* out, unsigned char* ws, hipStream_t st) {
    const float* x = (const float*)d_in[0]; const float* p = (const float*)d_in[1]; const float* g_mix = (const float*)d_in[2]; const float* w_in = (const float*)d_in[3];
    const float* sink = (const float*)d_in[4]; const float* conv_w = (const float*)d_in[5]; const float* conv_b = (const float*)d_in[6];
    const float* wa = (const float*)d_in[7]; const float* ba = (const float*)d_in[8]; const float* wx = (const float*)d_in[9]; const float* bx = (const float*)d_in[10]; const float* lam = (const float*)d_in[11];
    const float* w_ua = (const float*)d_in[12]; const float* w_ul = (const float*)d_in[13]; const float* w_o = (const float*)d_in[14]; const float* g_ffn = (const float*)d_in[15];
    const float* wq = (const float*)d_in[16]; const float* k1 = (const float*)d_in[17]; const float* k2 = (const float*)d_in[18]; const float* pu = (const float*)d_in[19]; const float* pv = (const float*)d_in[20];
    const float* g_ple = (const float*)d_in[21]; const float* w_gate = (const float*)d_in[22]; const float* w_proj = (const float*)d_in[23]; const float* final_g = (const float*)d_in[24];
    float* rstd1 = (float*)(ws + WS_RSTD1); float* part2 = (float*)(ws + WS_PART2); float* part4 = (float*)(ws + WS_PART4); float* rstd3 = (float*)(ws + WS_RSTD3);
    bf16* qkv = (bf16*)(ws + WS_QKV); bf16* lx = (bf16*)(ws + WS_LX); bf16* gl = (bf16*)(ws + WS_GL); bf16* sga = (bf16*)(ws + WS_SGA); bf16* sgl = (bf16*)(ws + WS_SGL);
    bf16* att = (bf16*)(ws + WS_ATT); bf16* r0 = (bf16*)(ws + WS_R0); float* mp = (float*)(ws + WS_MP); bf16* merged = (bf16*)(ws + WS_MERGED);
    float* sc = (float*)(ws + WS_SC); int* seli = (int*)(ws + WS_SELI); float* selg = (float*)(ws + WS_SELG); bf16* h2b = (bf16*)(ws + WS_H2B); bf16* pp = (bf16*)(ws + WS_PP);
    float* tmpf = (float*)(ws + WS_NAIVE_AB);
    switch (grp) {
    case 0:
        hipLaunchKernelGGL(nv::rowsq, dim3(T_ / 4), dim3(256), 0, st, x, rstd1, (float*)nullptr);
        nv::run_gemm<nv::ALf32, nv::EpiProj, false>(st, nv::ALf32{x, 1024}, w_in, INW, g_mix, T_, INW, 1024, nv::EpiProj{rstd1, qkv, lx, gl, sga, sgl});
        break;
    case 1:
        hipLaunchKernelGGL(nv::attn_naive, dim3(T_ * 8 / 128), dim3(128), 0, st, qkv, sink, att);
        hipLaunchKernelGGL(nv::conv_naive, dim3(T_ * 1024 / 256), dim3(256), 0, st, lx, conv_w, conv_b, r0);
        break;
    case 2:
        hipLaunchKernelGGL(nv::lru_ab_naive, dim3(T_ * 8), dim3(128), 0, st, r0, wa, ba, wx, bx, lam, out, tmpf);
        hipLaunchKernelGGL(nv::lru_scan_naive, dim3(B_ * 1024 / 64), dim3(64), 0, st, out, tmpf, gl, r0);
        break;
    case 3: nv::run_gemm<nv::ALbf16, nv::EpiMP, false>(st, nv::ALbf16{att, 512}, w_ua, 1024, nullptr, T_, 1024, 512, nv::EpiMP{sga, mp}); break;
    case 4: nv::run_gemm<nv::ALbf16, nv::EpiMerged, false>(st, nv::ALbf16{r0, 1024}, w_ul, 1024, nullptr, T_, 1024, 1024, nv::EpiMerged{sgl, mp, merged}); break;
    case 5:
        nv::run_gemm<nv::ALbf16, nv::EpiH1, false>(st, nv::ALbf16{merged, 1024}, w_o, 1024, nullptr, T_, 1024, 1024, nv::EpiH1{x, out, r0});
        hipLaunchKernelGGL(nv::rowsq, dim3(T_ / 4), dim3(256), 0, st, out, (float*)nullptr, part2);
        break;
    case 6:
        for (int half = 0; half < 2; ++half) {
            nv::run_gemm<nv::ALf32, nv::EpiScaleF32, false>(st, nv::ALf32{out, 1024}, wq + half * 1024, 2048, g_ffn, T_, 1024, 1024, nv::EpiScaleF32{part2, tmpf, 1024});
            for (int hl = 0; hl < 4; ++hl)
                for (int hf = 0; hf < 2; ++hf)
                    nv::run_gemm<nv::ALf32, nv::EpiPlainF32, true>(st, nv::ALf32{tmpf + hl * 256 + hf * 128, 1024}, hf ? k2 : k1, 128, nullptr, T_, 128, 128, nv::EpiPlainF32{sc + hl * 256 + hf * 128, 1024});
            hipLaunchKernelGGL(topk_kernel, dim3(T_ / TK_TOK), dim3(512), TK_LDS_BYTES, st, sc, half * 4, seli, selg);
        }
        break;
    case 7: hipLaunchKernelGGL(gather_kernel<0>, dim3(1024), dim3(256), 0, st, (const void*)pu, (const void*)pv, g_ffn, seli, selg, part2, out, h2b, rstd3); break;
    case 8: nv::run_gemm<nv::ALf32, nv::EpiPP, false>(st, nv::ALf32{p, 256}, w_proj, 1024, nullptr, T_, 1024, 256, nv::EpiPP{pp}); break;
    case 9: nv::run_gemm<nv::ALbf16, nv::EpiH3, false>(st, nv::ALbf16{h2b, 1024}, w_gate, 1024, g_ple, T_, 1024, 1024, nv::EpiH3{rstd3, pp, out});
        hipLaunchKernelGGL(nv::rowsq, dim3(T_ / 4), dim3(256), 0, st, out, (float*)nullptr, part4);
        break;
    case 10: hipLaunchKernelGGL(nv::final_norm, dim3(T_ / 4), dim3(256), 0, st, out, part4, final_g); break;
    }
}

extern "C" void kernel_launch(void* const* d_in, const int* in_sizes, int n_in, void* d_out, int out_size, void* d_ws, size_t ws_size, hipStream_t stream) {
    static int grid = 0;
    if (grid == 0) {
        if (n_in != 25 || out_size != T_ * 1024 || ws_size < WS_END) { fprintf(stderr, "kernel_launch: unexpected sizes n_in %d out %d ws %zu\n", n_in, out_size, ws_size); }
        (void)hipFuncSetAttribute((const void*)topk_kernel, hipFuncAttributeMaxDynamicSharedMemorySize, TK_LDS_BYTES);
        int dev = 0, cus = 0, per_cu = 0;
        (void)hipGetDevice(&dev); (void)hipDeviceGetAttribute(&cus, hipDeviceAttributeMultiprocessorCount, dev);
        if (hipFuncSetAttribute((const void*)fused_fwd, hipFuncAttributeMaxDynamicSharedMemorySize, LDS_BYTES) != hipSuccess) fprintf(stderr, "kernel_launch: hipFuncSetAttribute(fused_fwd) failed\n");
        if (hipOccupancyMaxActiveBlocksPerMultiprocessor(&per_cu, (const void*)fused_fwd, NWAVES * 64, LDS_BYTES) != hipSuccess || per_cu < 1) fprintf(stderr, "kernel_launch: occupancy query says %d blocks/CU\n", per_cu);
        (void)hipGetLastError();
        grid = cus > 0 ? cus : 256;
    }
    unsigned char* ws = (unsigned char*)d_ws; float* out = (float*)d_out;
    const unsigned mask = FUSED_MASK;
    if (mask) (void)hipMemsetAsync(ws + WS_CTL, 0, CTL_ZERO_BYTES, stream);
    Args a{};
    for (int i = 0; i < 25; ++i) a.in[i] = (const float*)d_in[i];
    a.out = out; a.ws = ws;
    int li = 0;
    auto launch = [&](int lo, int hi) {
        if (MERGE_LAUNCHES) { a.ph_lo = lo; a.ph_hi = hi; a.li = li++; hipLaunchKernelGGL(fused_fwd, dim3(grid), dim3(NWAVES * 64), LDS_BYTES, stream, a); }
        else for (int ph = lo; ph < hi; ++ph) { a.ph_lo = ph; a.ph_hi = ph + 1; a.li = li++; hipLaunchKernelGGL(fused_fwd, dim3(grid), dim3(NWAVES * 64), LDS_BYTES, stream, a); }
    };
    int pend_lo = -1, pend_hi = -1;
    if (mask && !(mask & 1)) launch(0, 1);
    for (int gidx = 0; gidx < 11; ++gidx) {
#if (defined(LRU_T2) && LRU_T2) || (defined(LRU_T3) && LRU_T3)
        if (gidx == 2 && (mask & 4u)) {
            if (pend_lo >= 0) { launch(pend_lo, pend_hi); pend_lo = -1; }
            launch(3, 4);
            hipLaunchKernelGGL(nv::lru_finish_naive_L<(LRU_T2 ? 16 : 64)>, dim3(B_ * 1024 / 64), dim3(64), 0, stream, (const bf16*)(ws + WS_HLOC), (const bf16*)(ws + WS_PCUM), (const bf16*)(ws + WS_GL), (bf16*)(ws + WS_R0));
            continue;
        }
#endif
        if (mask & (1u << gidx)) {
            if (pend_lo < 0) { pend_lo = GRP_LO[gidx]; pend_hi = GRP_HI[gidx]; } else pend_hi = GRP_HI[gidx];
        } else {
            if (pend_lo >= 0) { launch(pend_lo, pend_hi); pend_lo = -1; }
            naive_group(gidx, d_in, out, ws, stream);
        }
    }
    if (pend_lo >= 0) launch(pend_lo, pend_hi);
#if defined(LRU_DEBUG) && LRU_DEBUG == 2
    hipLaunchKernelGGL(nv::poison_if, dim3(T_ * 1024 / 256), dim3(256), 0, stream, out, (const unsigned*)(ws + WS_CTL) + 64);
#endif
}
```

```cpp
#include <hip/hip_runtime.h>
#include <cstdio>
#include <cstdint>
#include <cmath>

#ifndef FUSED_MASK
#define FUSED_MASK 0x7ff
#endif
#ifndef MERGE_LAUNCHES
#define MERGE_LAUNCHES 1
#endif
#ifndef LRU_PADDED
#define LRU_PADDED 1
#endif
#ifndef FUSE_FINAL
#define FUSE_FINAL 0
#endif
#ifndef GATHER_ROWS
#define GATHER_ROWS 3
#endif
#ifndef MIX_PIPE
#define MIX_PIPE 1
#endif
#ifndef V_FP6
#define V_FP6 1
#endif
#ifndef U_FP6
#define U_FP6 0
#endif
#ifndef Y_F16
#define Y_F16 1
#endif
#ifndef LRU_LOOKBACK
#define LRU_LOOKBACK 1
#endif
#define ALL_FUSED ((FUSED_MASK) == 0x7ff && (MERGE_LAUNCHES))
constexpr int B_ = 8, S_ = 2048, D_ = 1024, T_ = B_ * S_;
constexpr int INW = 4864;
constexpr float EPS = 1e-6f;
typedef unsigned short bf16;
typedef unsigned u32x3 __attribute__((ext_vector_type(3)));
#define HD_INLINE __host__ __device__ __forceinline__

constexpr size_t MiB = 1u << 20;
constexpr size_t WS_CTL = 0;
constexpr size_t WS_WIN = 1 * MiB;
constexpr size_t WS_WUA = WS_WIN + 4864 * 1024 * 2;
constexpr size_t WS_WUL = WS_WUA + 1 * MiB;
constexpr size_t WS_WO = WS_WUL + 2 * MiB;
constexpr size_t WS_WFOLD = WS_WO + 2 * MiB;
constexpr size_t WS_WG = WS_WFOLD + 4 * MiB;
constexpr size_t WS_WPROJ = WS_WG + 2 * MiB;
constexpr size_t WS_WAX = WS_WPROJ + MiB / 2;
constexpr size_t WS_W_END = WS_WAX + 1 * MiB;
static_assert(WS_W_END <= 23 * MiB, "weights");
constexpr size_t WS_RSTD1 = 23 * MiB;
constexpr size_t WS_PART2 = WS_RSTD1 + 256 * 1024;
constexpr size_t WS_PART4 = WS_PART2 + 1 * MiB;
constexpr size_t WS_RSTD3 = WS_PART4 + 1 * MiB;
constexpr size_t WS_AGG = WS_RSTD3 + 256 * 1024;
constexpr size_t WS_C8 = WS_AGG + 2 * MiB;
constexpr size_t WS_USCALE = WS_C8 + 64 * 1024;
static_assert(WS_USCALE + 128 * 1024 <= 28 * MiB, "small");
constexpr size_t WS_PB = 28 * MiB;
constexpr size_t WS_R0 = 36 * MiB;
constexpr size_t WS_QKV = 68 * MiB;
constexpr size_t WS_LX = 92 * MiB;
constexpr size_t WS_GL = 140 * MiB;
constexpr size_t WS_SGA = 172 * MiB;
constexpr size_t WS_SGL = 204 * MiB;
constexpr size_t WS_ATT = 236 * MiB;
constexpr size_t WS_REC = 68 * MiB;
constexpr size_t WS_HLOC = 68 * MiB, WS_PCUM = 100 * MiB;
constexpr size_t WS_MP = 68 * MiB;
constexpr size_t WS_MERGED = 140 * MiB;
constexpr size_t WS_SC = 172 * MiB;
constexpr size_t WS_SELI = 236 * MiB, WS_SELG = 244 * MiB;
constexpr size_t WS_U16 = 68 * MiB, WS_V16 = 100 * MiB;
constexpr size_t WS_H2B = 140 * MiB;
constexpr size_t WS_PP = 172 * MiB;
constexpr size_t WS_NAIVE_AB = 68 * MiB;
constexpr size_t WS_WAXD = 252 * MiB;
constexpr size_t WS_END = 256 * MiB;

HD_INLINE float bf2f(bf16 v) { return __builtin_bit_cast(float, (unsigned)v << 16); }
HD_INLINE bf16 f2bf(float f) { unsigned u = __builtin_bit_cast(unsigned, f); return (bf16)((u + 0x7fffu + ((u >> 16) & 1u)) >> 16); }
HD_INLINE unsigned pk2(float lo, float hi) { return (unsigned)f2bf(lo) | ((unsigned)f2bf(hi) << 16); }
__device__ __forceinline__ float wave_sum(float v) {
#pragma unroll
    for (int o = 1; o < 64; o <<= 1) v += __shfl_xor(v, o);
    return v;
}
__device__ __forceinline__ float sigmoidf_(float z) { return __builtin_amdgcn_rcpf(1.0f + __builtin_amdgcn_exp2f(-1.4426950408889634f * z)); }
__device__ __forceinline__ float gelu_tanh(float x) { const float u = 1.5957691216057308f * (x + 0.044715f * x * x * x); return x * sigmoidf_(u); }
__device__ __forceinline__ int fresh_lane() { int l; asm volatile("v_mbcnt_lo_u32_b32 %0, -1, 0\n\tv_mbcnt_hi_u32_b32 %0, -1, %0" : "=v"(l)); return l; }
#ifndef HD_INLINE
#define HD_INLINE __host__ __device__ __forceinline__
#endif

HD_INLINE unsigned tk_umax(unsigned a, unsigned b) { return a > b ? a : b; }
HD_INLINE unsigned tk_umin(unsigned a, unsigned b) { return a < b ? a : b; }
HD_INLINE unsigned tk_f2key(float f) { unsigned u = __builtin_bit_cast(unsigned, f); return u ^ ((unsigned)((int)u >> 31) | 0x80000000u); }
HD_INLINE float tk_key2f(unsigned k) { unsigned u = (k & 0x80000000u) ? (k ^ 0x80000000u) : ~k; return __builtin_bit_cast(float, u); }

HD_INLINE void tk_sort16(unsigned (&a)[16]) {
#pragma unroll
    for (int k = 2; k <= 16; k <<= 1) {
#pragma unroll
        for (int j = k >> 1; j > 0; j >>= 1) {
#pragma unroll
            for (int i = 0; i < 16; ++i) {
                const int p = i ^ j;
                if (p > i) {
                    const unsigned mx = tk_umax(a[i], a[p]), mn = tk_umin(a[i], a[p]);
                    if ((i & k) == 0) { a[i] = mx; a[p] = mn; } else { a[i] = mn; a[p] = mx; }
                }
            }
        }
    }
}
HD_INLINE void tk_merge16(unsigned (&a)[16], const unsigned (&b)[16]) {
#pragma unroll
    for (int i = 0; i < 16; ++i) a[i] = tk_umax(a[i], b[15 - i]);
#pragma unroll
    for (int j = 8; j > 0; j >>= 1) {
#pragma unroll
        for (int i = 0; i < 16; ++i) {
            const int p = i ^ j;
            if (p > i) { const unsigned mx = tk_umax(a[i], a[p]), mn = tk_umin(a[i], a[p]); a[i] = mx; a[p] = mn; }
        }
    }
}
HD_INLINE void tk_insert16(unsigned (&best)[16], unsigned key) {
#pragma unroll
    for (int s = 0; s < 16; ++s) { const unsigned hi = tk_umax(best[s], key); key = tk_umin(best[s], key); best[s] = hi; }
}
HD_INLINE void tk_combine_store(const unsigned (&k1)[16], const unsigned (&k2)[16], int* oi, float* og) {
    float v1[16], v2[16];
#pragma unroll
    for (int i = 0; i < 16; ++i) { v1[i] = tk_key2f(k1[i] & ~127u); v2[i] = tk_key2f(k2[i] & ~127u); }
    unsigned best[16];
#pragma unroll
    for (int s = 0; s < 16; ++s) best[s] = 0u;
#pragma unroll
    for (int i = 0; i < 16; ++i) {
#pragma unroll
        for (int j = 0; j < 16; ++j) {
            if ((i + 1) * (j + 1) <= 16) {
                const float s = v1[i] + v2[j];
                const unsigned key = (tk_f2key(s) & ~255u) | (unsigned)(255 - (i * 16 + j));
                tk_insert16(best, key);
            }
        }
    }
    const unsigned thr = best[15];
    const float mx = tk_key2f(best[0] & ~255u);
    float sum = 0.f;
#pragma unroll
    for (int i = 0; i < 16; ++i) {
#pragma unroll
        for (int j = 0; j < 16; ++j) {
            if ((i + 1) * (j + 1) <= 16) {
                const float s = v1[i] + v2[j];
                const unsigned key = (tk_f2key(s) & ~255u) | (unsigned)(255 - (i * 16 + j));
                if (key >= thr) sum += __builtin_expf(s - mx);
            }
        }
    }
    const float inv = 1.0f / sum;
    int cnt = 0;
#pragma unroll
    for (int i = 0; i < 16; ++i) {
#pragma unroll
        for (int j = 0; j < 16; ++j) {
            if ((i + 1) * (j + 1) <= 16) {
                const float s = v1[i] + v2[j];
                const unsigned key = (tk_f2key(s) & ~255u) | (unsigned)(255 - (i * 16 + j));
                if (key >= thr) {
                    oi[cnt] = (127 - (int)(k1[i] & 127u)) * 128 + (127 - (int)(k2[j] & 127u));
                    og[cnt] = __builtin_expf(s - mx) * inv;
                    ++cnt;
                }
            }
        }
    }
}

HD_INLINE unsigned tk_ckey(float s, unsigned odd64, int i, int j) { return ((tk_f2key(s) & ~255u) | (unsigned)(255 - (i * 16 + j))) - odd64; }
HD_INLINE void tk_pair_partial(const unsigned (&own)[16], const unsigned (&oth)[16], bool odd, unsigned (&r0)[16]) {
    float va[4], vb[16];
    const unsigned odd64 = odd ? 64u : 0u;
#pragma unroll
    for (int i = 0; i < 4; ++i) va[i] = tk_key2f(own[i] & ~127u);
#pragma unroll
    for (int j = 0; j < 16; ++j) vb[j] = tk_key2f(oth[j] & ~127u);
#pragma unroll
    for (int j = 1; j < 16; ++j) r0[j - 1] = tk_ckey(va[0] + vb[j], odd64, 0, j);
    r0[15] = 0u;
    unsigned l2[16];
#pragma unroll
    for (int j = 2; j < 8; ++j) l2[j - 2] = tk_ckey(va[1] + vb[j], odd64, 1, j);
    l2[6] = tk_ckey(va[2] + vb[3], odd64, 2, 3); l2[7] = tk_ckey(va[2] + vb[4], odd64, 2, 4);
#pragma unroll
    for (int d = 0; d < 4; ++d) { const unsigned k = tk_ckey(va[d] + vb[d], 0u, d, d); l2[8 + d] = odd ? 0u : k; }
#pragma unroll
    for (int d = 12; d < 16; ++d) l2[d] = 0u;
    tk_sort16(l2);
    tk_merge16(r0, l2);
}
HD_INLINE void tk_decode(unsigned key, int& i1, int& i2) { const int code = 255 - (int)(key & 255u); const int i = (code >> 4) & 3, j = code & 15; const bool po = (code >> 6) & 1; i1 = po ? j : i; i2 = po ? i : j; }
namespace nv {
struct ALf32 { const float* p; int lda; int pad; __device__ __forceinline__ float operator()(int m, int k) const { return p[(size_t)m * lda + k]; } };
struct ALbf16 { const bf16* p; int lda; int pad; __device__ __forceinline__ float operator()(int m, int k) const { return bf2f(p[(size_t)m * lda + k]); } };

template <class AL, class EPI, bool BT>
__global__ void __launch_bounds__(256) ngemm(AL al, const float* __restrict__ B, int ldb, const float* __restrict__ ks, int M, int N, int K, EPI epi) {
    __shared__ float As[16][68];
    __shared__ float Bs[16][68];
    const int tid = threadIdx.x, tx = tid & 15, ty = tid >> 4;
    const int m0 = blockIdx.y * 64, n0 = blockIdx.x * 64;
    float acc[4][4];
#pragma unroll
    for (int i = 0; i < 4; ++i)
#pragma unroll
        for (int j = 0; j < 4; ++j) acc[i][j] = 0.f;
    for (int k0 = 0; k0 < K; k0 += 16) {
#pragma unroll
        for (int i = 0; i < 4; ++i) {
            const int e = tid + i * 256;
            { const int m = e >> 4, k = e & 15; float v = al(m0 + m, k0 + k); if (ks) v *= ks[k0 + k]; As[k][m] = v; }
            if (BT) { const int n = e >> 4, k = e & 15; Bs[k][n] = B[(size_t)(n0 + n) * ldb + k0 + k]; }
            else { const int k = e >> 6, n = e & 63; Bs[k][n] = B[(size_t)(k0 + k) * ldb + n0 + n]; }
        }
        __syncthreads();
#pragma unroll
        for (int k = 0; k < 16; ++k) {
            float a[4], b[4];
#pragma unroll
            for (int i = 0; i < 4; ++i) { a[i] = As[k][ty * 4 + i]; b[i] = Bs[k][tx * 4 + i]; }
#pragma unroll
            for (int i = 0; i < 4; ++i)
#pragma unroll
                for (int j = 0; j < 4; ++j) acc[i][j] = fmaf(a[i], b[j], acc[i][j]);
        }
        __syncthreads();
    }
#pragma unroll
    for (int i = 0; i < 4; ++i)
#pragma unroll
        for (int j = 0; j < 4; ++j) epi(m0 + ty * 4 + i, n0 + tx * 4 + j, acc[i][j]);
}
template <class AL, class EPI, bool BT>
static void run_gemm(hipStream_t st, AL al, const float* B, int ldb, const float* ks, int M, int N, int K, EPI epi) {
    hipLaunchKernelGGL((ngemm<AL, EPI, BT>), dim3(N / 64, M / 64), dim3(256), 0, st, al, B, ldb, ks, M, N, K, epi);
}

__global__ void __launch_bounds__(256) rowsq(const float* __restrict__ X, float* rstd, float* part) {
    const int row = blockIdx.x * 4 + (threadIdx.x >> 6), lane = threadIdx.x & 63;
    const float* xr = X + (size_t)row * 1024;
    float s = 0.f;
    for (int j = 0; j < 16; ++j) { const float v = xr[lane + 64 * j]; s += v * v; }
    s = wave_sum(s);
    if (rstd && lane == 0) rstd[row] = 1.0f / sqrtf(s * (1.0f / 1024.0f) + EPS);
    if (part && lane < 16) part[(size_t)row * 16 + lane] = (lane == 0) ? s : 0.f;
}

struct EpiProj {
    const float* rstd; bf16 *qkv, *lx, *gl, *sga, *sgl;
    __device__ __forceinline__ void operator()(int m, int n, float v) const {
        v *= rstd[m];
        if (n < 768) qkv[(size_t)m * 768 + n] = f2bf(v);
        else if (n < 1792) lx[(size_t)m * 1024 + (n - 768)] = f2bf(v);
        else if (n < 2816) gl[(size_t)m * 1024 + (n - 1792)] = f2bf(gelu_tanh(v));
        else if (n < 3840) sga[(size_t)m * 1024 + (n - 2816)] = f2bf(sigmoidf_(v));
        else sgl[(size_t)m * 1024 + (n - 3840)] = f2bf(sigmoidf_(v));
    }
};

__global__ void __launch_bounds__(128) attn_naive(const bf16* __restrict__ qkv, const float* __restrict__ sink, bf16* __restrict__ att) {
    const int gid = blockIdx.x * 128 + threadIdx.x;
    const int head = gid / T_, t = gid % T_;
    const int b = t / S_, ts = t % S_;
    const int g = head >> 2;
    float q[64], acc[64];
    const bf16* qp = qkv + (size_t)t * 768 + head * 64;
#pragma unroll
    for (int d = 0; d < 64; ++d) { q[d] = bf2f(qp[d]); acc[d] = 0.f; }
    const float slope = exp2f(-(float)(head + 1));
    float m = -3.0e38f, l = 0.f;
    for (int dist = 127; dist >= 0; --dist) {
        const int s = ts - dist; if (s < 0) continue;
        const bf16* kp = qkv + (size_t)(b * S_ + s) * 768 + 512 + g * 64;
        const bf16* vp = kp + 128;
        float sc = 0.f;
#pragma unroll
        for (int d = 0; d < 64; ++d) sc = fmaf(q[d], bf2f(kp[d]), sc);
        sc = sc * 0.125f - slope * (float)dist;
        const float mn = fmaxf(m, sc), corr = __expf(m - mn), p = __expf(sc - mn);
        l = l * corr + p;
#pragma unroll
        for (int d = 0; d < 64; ++d) acc[d] = acc[d] * corr + p * bf2f(vp[d]);
        m = mn;
    }
    const float sk = sink[head];
    const float mf = fmaxf(m, sk), corr = __expf(m - mf);
    l = l * corr + __expf(sk - mf);
    const float inv = corr / l;
    bf16* op = att + (size_t)t * 512 + head * 64;
#pragma unroll
    for (int d = 0; d < 64; ++d) op[d] = f2bf(acc[d] * inv);
}

__global__ void __launch_bounds__(256) conv_naive(const bf16* __restrict__ lx, const float* __restrict__ cw, const float* __restrict__ cb, bf16* __restrict__ lin) {
    const size_t i = (size_t)blockIdx.x * 256 + threadIdx.x;
    const int c = (int)(i & 1023); const int t = (int)(i >> 10); const int ts = t % S_;
    float y = cb[c];
#pragma unroll
    for (int tap = 0; tap < 4; ++tap) { const int s = ts - 3 + tap; if (s >= 0) y = fmaf(bf2f(lx[(size_t)(t - 3 + tap) * 1024 + c]), cw[tap * 1024 + c], y); }
    lin[i] = f2bf(y);
}

__global__ void __launch_bounds__(128) lru_ab_naive(const bf16* __restrict__ lin, const float* __restrict__ wa, const float* __restrict__ ba, const float* __restrict__ wx, const float* __restrict__ bx,
                                                    const float* __restrict__ lam, float* __restrict__ Af, float* __restrict__ Bf) {
    __shared__ float xs[128];
    const int t = blockIdx.x >> 3, blk = blockIdx.x & 7, d = threadIdx.x, ch = blk * 128 + d;
    xs[d] = bf2f(lin[(size_t)t * 1024 + ch]);
    __syncthreads();
    float r = ba[ch], ii = bx[ch];
    const float* wap = wa + (size_t)blk * 128 * 128 + d; const float* wxp = wx + (size_t)blk * 128 * 128 + d;
    for (int c = 0; c < 128; ++c) { r = fmaf(xs[c], wap[c * 128], r); ii = fmaf(xs[c], wxp[c * 128], ii); }
    r = sigmoidf_(r); ii = sigmoidf_(ii);
    const float sp = log1pf(expf(-lam[ch]));
    const float loga = -8.0f * r * sp;
    const float a = expf(loga);
    const float bb = sqrtf(-expm1f(2.0f * loga)) * (ii * xs[d]);
    Af[(size_t)t * 1024 + ch] = a; Bf[(size_t)t * 1024 + ch] = bb;
}
__global__ void __launch_bounds__(256) lru_ab_from_pre(const bf16* __restrict__ lin, const float* __restrict__ ba, const float* __restrict__ bx, const float* __restrict__ lam, float* __restrict__ Af, float* __restrict__ Bf) {
    const size_t i = (size_t)blockIdx.x * 256 + threadIdx.x; const int ch = (int)(i & 1023);
    const float r = sigmoidf_(Af[i] + ba[ch]), ii = sigmoidf_(Bf[i] + bx[ch]);
    const float loga = -8.0f * r * log1pf(expf(-lam[ch]));
    Af[i] = expf(loga); Bf[i] = sqrtf(-expm1f(2.0f * loga)) * (ii * bf2f(lin[i]));
}
template <int L>
__global__ void __launch_bounds__(64) lru_finish_naive_L(const bf16* __restrict__ hloc, const bf16* __restrict__ pcum, const bf16* __restrict__ gl, bf16* __restrict__ rec) {
    const int gid = blockIdx.x * 64 + threadIdx.x; const int b = gid >> 10, ch = gid & 1023;
    float carry = 0.f;
    for (int c = 0; c < S_ / L; ++c) {
        float la = 1.f, lb = 0.f;
        for (int s = 0; s < L; ++s) { const size_t o = (size_t)(b * S_ + c * L + s) * 1024 + ch; la = bf2f(pcum[o]); lb = bf2f(hloc[o]); const float h = la * carry + lb; rec[o] = f2bf(h * bf2f(gl[o])); }
        carry = la * carry + lb;
    }
}
__global__ void __launch_bounds__(64) lru_finish_naive(const bf16* __restrict__ hloc, const bf16* __restrict__ pcum, const float* __restrict__ agg, const bf16* __restrict__ gl, bf16* __restrict__ rec) {
    const int gid = blockIdx.x * 64 + threadIdx.x; const int b = gid >> 10, ch = gid & 1023;
    float carry = 0.f;
    for (int c = 0; c < 32; ++c) {
        const int chunk = b * 32 + c;
        for (int s = 0; s < 64; ++s) { const size_t o = (size_t)(chunk * 64 + s) * 1024 + ch; const float h = bf2f(pcum[o]) * carry + bf2f(hloc[o]); rec[o] = f2bf(h * bf2f(gl[o])); }
        const float* ap = agg + ((size_t)chunk * 1024 + ch) * 2; carry = ap[0] * carry + ap[1];
    }
}
__global__ void __launch_bounds__(128) lru_pre_check(const bf16* __restrict__ lin, const float* __restrict__ wa, const float* __restrict__ wx, const float* __restrict__ Rp, const float* __restrict__ Ip, unsigned* flag) {
    __shared__ float xs[128];
    const int t = blockIdx.x >> 3, blk = blockIdx.x & 7, d = threadIdx.x, ch = blk * 128 + d;
    xs[d] = bf2f(lin[(size_t)t * 1024 + ch]);
    __syncthreads();
    float r = 0.f, ii = 0.f;
    const float* wap = wa + (size_t)blk * 128 * 128 + d; const float* wxp = wx + (size_t)blk * 128 * 128 + d;
    for (int c = 0; c < 128; ++c) { r = fmaf(xs[c], wap[c * 128], r); ii = fmaf(xs[c], wxp[c * 128], ii); }
    const float dr = fabsf(r - Rp[(size_t)t * 1024 + ch]), di = fabsf(ii - Ip[(size_t)t * 1024 + ch]);
    if (!(dr < 0.08f + 0.03f * fabsf(r)) || !(di < 0.08f + 0.03f * fabsf(ii))) atomicAdd(flag, 1u);
}
__global__ void __launch_bounds__(256) poison_if(float* out, const unsigned* flag) { if (*flag) { const size_t i = (size_t)blockIdx.x * 256 + threadIdx.x; out[i] = out[i] * 50.0f + 3.0f; } }
__global__ void __launch_bounds__(64) lru_scan_naive(const float* __restrict__ Af, const float* __restrict__ Bf, const bf16* __restrict__ gl, bf16* __restrict__ rec) {
    const int gid = blockIdx.x * 64 + threadIdx.x; const int b = gid >> 10, ch = gid & 1023;
    float h = 0.f;
    for (int s = 0; s < S_; ++s) { const size_t o = (size_t)(b * S_ + s) * 1024 + ch; h = fmaf(Af[o], h, Bf[o]); rec[o] = f2bf(h * bf2f(gl[o])); }
}

struct EpiMP { const bf16* sga; float* mp; __device__ __forceinline__ void operator()(int m, int n, float v) const { const size_t o = (size_t)m * 1024 + n; mp[o] = v * bf2f(sga[o]); } };
struct EpiMerged { const bf16* sgl; const float* mp; bf16* merged; __device__ __forceinline__ void operator()(int m, int n, float v) const { const size_t o = (size_t)m * 1024 + n; merged[o] = f2bf(mp[o] + v * bf2f(sgl[o])); } };
struct EpiH1 { const float* x; float* h1; bf16* h1b; __device__ __forceinline__ void operator()(int m, int n, float v) const { const size_t o = (size_t)m * 1024 + n; const float h = x[o] + v; h1[o] = h; h1b[o] = f2bf(h); } };
struct EpiScaleF32 { const float* part; float* out; int ldo; int pad; __device__ __forceinline__ void operator()(int m, int n, float v) const {
    float s = 0.f; for (int i = 0; i < 16; ++i) s += part[(size_t)m * 16 + i];
    out[(size_t)m * ldo + n] = v * (1.0f / sqrtf(s * (1.0f / 1024.0f) + EPS)); } };
struct EpiPlainF32 { float* out; int ldo; int pad; __device__ __forceinline__ void operator()(int m, int n, float v) const { out[(size_t)m * ldo + n] = v; } };
struct EpiPP { bf16* pp; __device__ __forceinline__ void operator()(int m, int n, float v) const { pp[(size_t)m * 1024 + n] = f2bf(v); } };
struct EpiH3 { const float* rstd3; const bf16* pp; float* h; __device__ __forceinline__ void operator()(int m, int n, float v) const { const size_t o = (size_t)m * 1024 + n; h[o] = h[o] + sigmoidf_(v * rstd3[m]) * bf2f(pp[o]); } };

__global__ void __launch_bounds__(256) final_norm(float* __restrict__ h, const float* __restrict__ part, const float* __restrict__ fg) {
    const int row = blockIdx.x * 4 + (threadIdx.x >> 6), lane = threadIdx.x & 63;
    float s = 0.f; for (int i = 0; i < 16; ++i) s += part[(size_t)row * 16 + i];
    const float r = 1.0f / sqrtf(s * (1.0f / 1024.0f) + EPS);
    float* hr = h + (size_t)row * 1024;
    for (int j = 0; j < 16; ++j) { const int c = lane + 64 * j; hr[c] = hr[c] * r * fg[c]; }
}
}
#define LAS __attribute__((address_space(3)))
typedef float f32x4 __attribute__((ext_vector_type(4)));
typedef unsigned u32x4 __attribute__((ext_vector_type(4)));
typedef int i32x4 __attribute__((ext_vector_type(4)));

constexpr int TK_TOK = 32;
constexpr int TK_LSTRIDE = 132;
constexpr int TK_LDS_BYTES = 256 * TK_LSTRIDE * 4;

__device__ __forceinline__ void topk_item(LAS float* lds, const float* __restrict__ SC, int item, int head_base, int* __restrict__ seli, float* __restrict__ selg, int tid) {
    const f32x4* src = (const f32x4*)(SC + (size_t)item * TK_TOK * 1024);
#pragma unroll 4
    for (int i = 0; i < 16; ++i) {
        const int idx = tid + i * 512; const int row = idx >> 8, c4 = idx & 255;
        const f32x4 v = src[idx];
        const int list = row * 8 + (c4 >> 5), elem = (c4 & 31) * 4;
        *(LAS f32x4*)(lds + list * TK_LSTRIDE + elem) = v;
    }
    __syncthreads();
    if (tid < 256) {
        const LAS float* my = lds + tid * TK_LSTRIDE;
        unsigned acc[16];
#pragma unroll
        for (int g = 0; g < 8; ++g) {
            unsigned t[16];
#pragma unroll
            for (int q = 0; q < 4; ++q) {
                const f32x4 v = *(const LAS f32x4*)(my + g * 16 + q * 4);
#pragma unroll
                for (int c = 0; c < 4; ++c) { const int e = g * 16 + q * 4 + c; t[q * 4 + c] = (tk_f2key(v[c]) & ~127u) | (unsigned)(127 - e); }
            }
            tk_sort16(t);
            if (g == 0) {
#pragma unroll
                for (int i = 0; i < 16; ++i) acc[i] = t[i];
            } else tk_merge16(acc, t);
        }
        unsigned oth[16];
#pragma unroll
        for (int i = 0; i < 16; ++i) oth[i] = (unsigned)__shfl_xor((int)acc[i], 1);
        if ((tid & 1) == 0) {
            const int tok = item * TK_TOK + (tid >> 3), head = head_base + ((tid >> 1) & 3);
            tk_combine_store(acc, oth, seli + (size_t)tok * 128 + head * 16, selg + (size_t)tok * 128 + head * 16);
        }
    }
    __syncthreads();
}
__global__ void __launch_bounds__(512) topk_kernel(const float* __restrict__ SC, int head_base, int* __restrict__ seli, float* __restrict__ selg) {
    extern __shared__ __attribute__((aligned(16))) unsigned char dyn_lds[];
    for (int item = blockIdx.x; item < T_ / TK_TOK; item += gridDim.x) topk_item((LAS float*)dyn_lds, SC, item, head_base, seli, selg, (int)threadIdx.x);
}

template <int MODE>
__device__ __forceinline__ void gather_token(int t, int lane, const void* __restrict__ Utab, const void* __restrict__ Vtab, const float* __restrict__ gffn,
                                             const int* __restrict__ seli, const float* __restrict__ selg, const float* __restrict__ part2,
                                             float* __restrict__ H  , bf16* __restrict__ h2b, float* __restrict__ rstd3) {
    float ps = (lane < 16) ? part2[(size_t)t * 16 + lane] : 0.f;
    ps = wave_sum(ps);
    const float rstd2 = 1.0f / sqrtf(ps * (1.0f / 1024.0f) + EPS);
    const int iA = seli[(size_t)t * 128 + lane], iB = seli[(size_t)t * 128 + 64 + lane];
    const float gA = selg[(size_t)t * 128 + lane], gB = selg[(size_t)t * 128 + 64 + lane];
    float* hr = H + (size_t)t * 1024;
    if constexpr (MODE == 0) {
        f32x4 x[4], y[4], hv[4];
#pragma unroll
        for (int j = 0; j < 4; ++j) { hv[j] = *(const f32x4*)(hr + 256 * j + 4 * lane); const f32x4 g = *(const f32x4*)(gffn + 256 * j + 4 * lane); x[j] = hv[j] * g; y[j] = (f32x4){0.f, 0.f, 0.f, 0.f}; }
        const float* U = (const float*)Utab; const float* V = (const float*)Vtab;
        for (int k = 0; k < 64; ++k) {
#pragma unroll
            for (int hh = 0; hh < 2; ++hh) {
                const int e = __builtin_amdgcn_readlane(hh ? iB : iA, k);
                const float gt = __builtin_bit_cast(float, __builtin_amdgcn_readlane(__builtin_bit_cast(int, hh ? gB : gA), k));
                const float* ur = U + (size_t)e * 1024; const float* vr = V + (size_t)e * 1024;
                f32x4 uv[4], vv[4];
#pragma unroll
                for (int j = 0; j < 4; ++j) { uv[j] = *(const f32x4*)(ur + 256 * j + 4 * lane); vv[j] = *(const f32x4*)(vr + 256 * j + 4 * lane); }
                float d = 0.f;
#pragma unroll
                for (int j = 0; j < 4; ++j) d += (uv[j].x * x[j].x + uv[j].y * x[j].y) + (uv[j].z * x[j].z + uv[j].w * x[j].w);
                d = wave_sum(d);
                const float c = gt * gelu_tanh(d * rstd2);
#pragma unroll
                for (int j = 0; j < 4; ++j) y[j] += vv[j] * c;
            }
        }
        float sq = 0.f;
#pragma unroll
        for (int j = 0; j < 4; ++j) {
            const f32x4 h2 = hv[j] + y[j];
            *(f32x4*)(hr + 256 * j + 4 * lane) = h2;
            sq += (h2.x * h2.x + h2.y * h2.y) + (h2.z * h2.z + h2.w * h2.w);
            uint2 w; w.x = pk2(h2.x, h2.y); w.y = pk2(h2.z, h2.w);
            *(uint2*)(h2b + (size_t)t * 1024 + 256 * j + 4 * lane) = w;
        }
        sq = wave_sum(sq);
        if (lane == 0) rstd3[t] = 1.0f / sqrtf(sq * (1.0f / 1024.0f) + EPS);
    } else {
        float x[2][8], y[2][8], hv[2][8];
#pragma unroll
        for (int j = 0; j < 2; ++j) {
            const f32x4 a = *(const f32x4*)(hr + 512 * j + 8 * lane), b = *(const f32x4*)(hr + 512 * j + 8 * lane + 4);
            hv[j][0] = a.x; hv[j][1] = a.y; hv[j][2] = a.z; hv[j][3] = a.w; hv[j][4] = b.x; hv[j][5] = b.y; hv[j][6] = b.z; hv[j][7] = b.w;
#pragma unroll
            for (int c = 0; c < 8; ++c) { x[j][c] = hv[j][c]; y[j][c] = 0.f; }
        }
        const bf16* U = (const bf16*)Utab; const bf16* V = (const bf16*)Vtab;
        for (int k = 0; k < 64; k += 2) {
            u32x4 uv[4][2], vv[4][2]; float gt[4];
#pragma unroll
            for (int q = 0; q < 4; ++q) {
                const int kk = k + (q >> 1); const int hh = q & 1;
                const int e = __builtin_amdgcn_readlane(hh ? iB : iA, kk);
                gt[q] = __builtin_bit_cast(float, __builtin_amdgcn_readlane(__builtin_bit_cast(int, hh ? gB : gA), kk));
                const bf16* ur = U + (size_t)e * 1024; const bf16* vr = V + (size_t)e * 1024;
#pragma unroll
                for (int j = 0; j < 2; ++j) { uv[q][j] = *(const u32x4*)(ur + 512 * j + 8 * lane); vv[q][j] = *(const u32x4*)(vr + 512 * j + 8 * lane); }
            }
#pragma unroll
            for (int q = 0; q < 4; ++q) {
                float d = 0.f;
#pragma unroll
                for (int j = 0; j < 2; ++j)
#pragma unroll
                    for (int c = 0; c < 4; ++c) { const unsigned w = uv[q][j][c]; d = fmaf(__builtin_bit_cast(float, w << 16), x[j][2 * c], d); d = fmaf(__builtin_bit_cast(float, w & 0xffff0000u), x[j][2 * c + 1], d); }
                d = wave_sum(d);
                const float cf = gt[q] * gelu_tanh(d * rstd2);
#pragma unroll
                for (int j = 0; j < 2; ++j)
#pragma unroll
                    for (int c = 0; c < 4; ++c) { const unsigned w = vv[q][j][c]; y[j][2 * c] = fmaf(__builtin_bit_cast(float, w << 16), cf, y[j][2 * c]); y[j][2 * c + 1] = fmaf(__builtin_bit_cast(float, w & 0xffff0000u), cf, y[j][2 * c + 1]); }
            }
        }
        float sq = 0.f;
#pragma unroll
        for (int j = 0; j < 2; ++j) {
            float h2[8];
#pragma unroll
            for (int c = 0; c < 8; ++c) { h2[c] = hv[j][c] + y[j][c]; sq += h2[c] * h2[c]; }
            *(f32x4*)(hr + 512 * j + 8 * lane) = (f32x4){h2[0], h2[1], h2[2], h2[3]};
            *(f32x4*)(hr + 512 * j + 8 * lane + 4) = (f32x4){h2[4], h2[5], h2[6], h2[7]};
            u32x4 w; w.x = pk2(h2[0], h2[1]); w.y = pk2(h2[2], h2[3]); w.z = pk2(h2[4], h2[5]); w.w = pk2(h2[6], h2[7]);
            *(u32x4*)(h2b + (size_t)t * 1024 + 512 * j + 8 * lane) = w;
        }
        sq = wave_sum(sq);
        if (lane == 0) rstd3[t] = 1.0f / sqrtf(sq * (1.0f / 1024.0f) + EPS);
    }
}
template <int MODE>
__global__ void __launch_bounds__(256) gather_kernel(const void* __restrict__ Utab, const void* __restrict__ Vtab, const float* __restrict__ gffn, const int* __restrict__ seli, const float* __restrict__ selg,
                                                     const float* __restrict__ part2, float* __restrict__ H, bf16* __restrict__ h2b, float* __restrict__ rstd3) {
    const int lane = threadIdx.x & 63; const int w = blockIdx.x * 4 + (threadIdx.x >> 6); const int nw = gridDim.x * 4;
    for (int t = w; t < T_; t += nw) gather_token<MODE>(t, lane, Utab, Vtab, gffn, seli, selg, part2, H, h2b, rstd3);
}

typedef float f32x2 __attribute__((ext_vector_type(2)));
__device__ __forceinline__ float reduce4_transpose(float d0, float d1, float d2, float d3, int lane) {
    const bool b0 = lane & 1, b1 = lane & 2;
    const float a = (b0 ? d1 : d0) + __shfl_xor(b0 ? d0 : d1, 1);
    const float b = (b0 ? d3 : d2) + __shfl_xor(b0 ? d2 : d3, 1);
    float c = (b1 ? b : a) + __shfl_xor(b1 ? a : b, 2);
    c += __shfl_xor(c, 4); c += __shfl_xor(c, 8); c += __shfl_xor(c, 16); c += __shfl_xor(c, 32);
    return c;
}
__device__ __forceinline__ float dot16_fp8(const u32x4 w, const f32x2 (&x2)[8]) {
    f32x2 acc = (f32x2){0.f, 0.f};
#pragma unroll
    for (int c = 0; c < 4; ++c) { const unsigned ww = w[c]; const f32x2 lo = __builtin_amdgcn_cvt_pk_f32_fp8(ww, false), hi = __builtin_amdgcn_cvt_pk_f32_fp8(ww, true); acc = lo * x2[2 * c] + acc; acc = hi * x2[2 * c + 1] + acc; }
    return acc.x + acc.y;
}
__device__ __forceinline__ void axpy16_fp8(const u32x4 w, float cf, f32x2 (&y2)[8]) {
#pragma unroll
    for (int c = 0; c < 4; ++c) { const unsigned ww = w[c]; const f32x2 lo = __builtin_amdgcn_cvt_pk_f32_fp8(ww, false), hi = __builtin_amdgcn_cvt_pk_f32_fp8(ww, true); y2[2 * c] = lo * cf + y2[2 * c]; y2[2 * c + 1] = hi * cf + y2[2 * c + 1]; }
}
__device__ __forceinline__ float sel4f(float v0, float v1, float v2, float v3, int q) { return q == 0 ? v0 : (q == 1 ? v1 : (q == 2 ? v2 : v3)); }
__device__ __forceinline__ void gather_token_fp8(int t, int lane, const unsigned char* __restrict__ U8, const unsigned char* __restrict__ V8, const float* __restrict__ IU, const float* __restrict__ IV,
                                                 const int* __restrict__ seli, const float* __restrict__ selg, const float* __restrict__ part2,
                                                 float* __restrict__ H, bf16* __restrict__ h2b, float* __restrict__ rstd3) {
    float ps = (lane < 16) ? part2[(size_t)t * 16 + lane] : 0.f;
    ps = wave_sum(ps);
    const float rstd2 = 1.0f / sqrtf(ps * (1.0f / 1024.0f) + EPS);
    const int iA = seli[(size_t)t * 128 + lane], iB = seli[(size_t)t * 128 + 64 + lane];
    const float duA = IU[iA] * rstd2, duB = IU[iB] * rstd2;
    const float gvA = selg[(size_t)t * 128 + lane] * IV[iA], gvB = selg[(size_t)t * 128 + 64 + lane] * IV[iB];
    float* hr = H + (size_t)t * 1024 + 16 * lane;
    f32x2 x2[8], y2[8]; f32x4 hv[4];
#pragma unroll
    for (int j = 0; j < 4; ++j) { hv[j] = *(const f32x4*)(hr + 4 * j); x2[2 * j] = (f32x2){hv[j][0], hv[j][1]}; x2[2 * j + 1] = (f32x2){hv[j][2], hv[j][3]}; y2[2 * j] = (f32x2){0.f, 0.f}; y2[2 * j + 1] = (f32x2){0.f, 0.f}; }
    const int q = lane & 3;
#pragma unroll 1
    for (int k = 0; k < 64; k += 4) {
        u32x4 uu[8], vv[8]; float du[8], gv[8];
#pragma unroll
        for (int s = 0; s < 8; ++s) {
            const int kk = k + (s >> 1); const bool hh = s & 1;
            const int e = __builtin_amdgcn_readlane(hh ? iB : iA, kk);
            du[s] = __int_as_float(__builtin_amdgcn_readlane(__float_as_int(hh ? duB : duA), kk));
            gv[s] = __int_as_float(__builtin_amdgcn_readlane(__float_as_int(hh ? gvB : gvA), kk));
            uu[s] = *(const u32x4*)(U8 + (size_t)e * 1024 + 16 * lane);
            vv[s] = *(const u32x4*)(V8 + (size_t)e * 1024 + 16 * lane);
        }
#pragma unroll
        for (int g = 0; g < 2; ++g) {
            const float d0 = dot16_fp8(uu[4 * g + 0], x2), d1 = dot16_fp8(uu[4 * g + 1], x2), d2 = dot16_fp8(uu[4 * g + 2], x2), d3 = dot16_fp8(uu[4 * g + 3], x2);
            const float tot = reduce4_transpose(d0, d1, d2, d3, lane);
            const float z = tot * sel4f(du[4 * g], du[4 * g + 1], du[4 * g + 2], du[4 * g + 3], q);
            const float cf = gelu_tanh(z) * sel4f(gv[4 * g], gv[4 * g + 1], gv[4 * g + 2], gv[4 * g + 3], q);
#pragma unroll
            for (int s = 0; s < 4; ++s) { const float cs = __int_as_float(__builtin_amdgcn_readlane(__float_as_int(cf), s)); axpy16_fp8(vv[4 * g + s], cs, y2); }
        }
    }
    float sq = 0.f;
    f32x4 h2[4];
#pragma unroll
    for (int j = 0; j < 4; ++j) {
        h2[j] = hv[j] + (f32x4){y2[2 * j].x, y2[2 * j].y, y2[2 * j + 1].x, y2[2 * j + 1].y};
        *(f32x4*)(hr + 4 * j) = h2[j];
        sq += (h2[j][0] * h2[j][0] + h2[j][1] * h2[j][1]) + (h2[j][2] * h2[j][2] + h2[j][3] * h2[j][3]);
    }
    u32x4 w0, w1; w0.x = pk2(h2[0][0], h2[0][1]); w0.y = pk2(h2[0][2], h2[0][3]); w0.z = pk2(h2[1][0], h2[1][1]); w0.w = pk2(h2[1][2], h2[1][3]);
    w1.x = pk2(h2[2][0], h2[2][1]); w1.y = pk2(h2[2][2], h2[2][3]); w1.z = pk2(h2[3][0], h2[3][1]); w1.w = pk2(h2[3][2], h2[3][3]);
    u32x4* ob = (u32x4*)(h2b + (size_t)t * 1024 + 16 * lane); ob[0] = w0; ob[1] = w1;
    sq = wave_sum(sq);
    if (lane == 0) rstd3[t] = 1.0f / sqrtf(sq * (1.0f / 1024.0f) + EPS);
}

__device__ __forceinline__ unsigned umin_(unsigned a, unsigned b) { return a < b ? a : b; }
__device__ __forceinline__ unsigned umax_(unsigned a, unsigned b) { return a > b ? a : b; }
__device__ __forceinline__ void sort128(unsigned& k0, unsigned& k1, int lane) {
#pragma unroll
    for (int k = 2; k <= 128; k <<= 1) {
#pragma unroll
        for (int j = k >> 1; j >= 1; j >>= 1) {
            if (j == 64) { const unsigned mn = umin_(k0, k1), mx = umax_(k0, k1); k0 = mn; k1 = mx; }
            else {
                const unsigned o0 = (unsigned)__shfl_xor((int)k0, j), o1 = (unsigned)__shfl_xor((int)k1, j);
                const bool up0 = (k == 128) ? true : (k == 64 ? true : ((lane & k) == 0));
                const bool up1 = (k == 128) ? true : (k == 64 ? false : ((lane & k) == 0));
                const bool lower = (lane & j) == 0;
                k0 = (lower == up0) ? umin_(k0, o0) : umax_(k0, o0);
                k1 = (lower == up1) ? umin_(k1, o1) : umax_(k1, o1);
            }
        }
    }
}
typedef int i32x4v __attribute__((ext_vector_type(4)));
#ifndef NSLICE
#define NSLICE 8
#endif
#define SLICE_SHIFT (NSLICE == 32 ? 25 : (NSLICE == 16 ? 26 : (NSLICE == 8 ? 27 : (NSLICE == 4 ? 28 : 30))))
typedef unsigned u32x2 __attribute__((ext_vector_type(2)));
__device__ __forceinline__ f32x4 bf4_lo(u32x2 w) { return (f32x4){__builtin_bit_cast(float, w.x << 16), __builtin_bit_cast(float, w.x & 0xffff0000u), __builtin_bit_cast(float, w.y << 16), __builtin_bit_cast(float, w.y & 0xffff0000u)}; }
struct TokState { f32x2 y2[8]; unsigned k0, k1; int bnd; float rsx; };
__device__ __forceinline__ int count_lt(const TokState& S, unsigned bound) {
    return __builtin_popcountll(__builtin_amdgcn_ballot_w64(S.k0 < bound)) + __builtin_popcountll(__builtin_amdgcn_ballot_w64(S.k1 < bound));
}
__device__ __forceinline__ int bperm_i(int srclane, int v) { return __builtin_amdgcn_ds_bpermute(srclane << 2, v); }
__device__ __forceinline__ float bperm_f(int srclane, float v) { return __int_as_float(__builtin_amdgcn_ds_bpermute(srclane << 2, __float_as_int(v))); }
template <int PM>
__device__ __forceinline__ void gather_batch(TokState& S, int p, int hi, int lane, const LAS unsigned char* xs, const unsigned char* __restrict__ U8, const unsigned char* __restrict__ V8, const float* __restrict__ IU, const float* __restrict__ IV) {
    const int n = (hi - p < 16) ? hi - p : 16;
    const int m = lane & 15, kq = lane >> 4;
    const int r = (m < n) ? p + m : hi - 1; const int sl = r & 63; const bool lo = r < 64;
    const unsigned ka = (unsigned)bperm_i(sl, (int)S.k0), kb = (unsigned)bperm_i(sl, (int)S.k1);
    const int es = (int)((lo ? ka : kb) >> 16);
    const unsigned key = lo ? ka : kb;
    const float dus = IU[es] * S.rsx, gvs = (m < n) ? (float)(key & 0xffffu) * (1.0f / 65535.0f) * IV[es] : 0.f;
    const unsigned char* ua = U8 + (size_t)es * 1024 + 16 * kq;
    i32x4v A[16];
    if (!(PM & 2)) {
#pragma unroll
        for (int s = 0; s < 16; ++s) { if (PM & 16) { const int e = __builtin_amdgcn_readlane(es, s); A[s] = *(const i32x4v*)(U8 + (size_t)e * 1024 + 16 * lane); } else A[s] = *(const i32x4v*)(ua + 64 * s); }
    }
    u32x4 vv[16];
    if (!(PM & 1)) {
#pragma unroll
        for (int q = 0; q < 8; ++q) if (q < n) { const int e = __builtin_amdgcn_readlane(es, q); vv[q] = *(const u32x4*)(V8 + (size_t)e * 1024 + 16 * lane); }
        if (n > 8) {
#pragma unroll
            for (int q = 8; q < 16; ++q) if (q < n) { const int e = __builtin_amdgcn_readlane(es, q); vv[q] = *(const u32x4*)(V8 + (size_t)e * 1024 + 16 * lane); }
        }
    }
    i32x4v acc = (i32x4v){0, 0, 0, 0};
    if (!(PM & 2)) {
#pragma unroll
        for (int s = 0; s < 16; ++s) { const i32x4v B = *(const LAS i32x4v*)(xs + 64 * s + 16 * kq); acc = __builtin_amdgcn_mfma_i32_16x16x64_i8(A[s], B, acc, 0, 0, 0); }
    } else { acc = (i32x4v){es, es + 1, es + 2, es + 3}; }
    float cf[4];
#pragma unroll
    for (int j = 0; j < 4; ++j) { const int sm = 4 * kq + j; const float d = bperm_f(sm, dus), g = bperm_f(sm, gvs); cf[j] = g * gelu_tanh((float)acc[j] * d); }
    if (PM & 1) { S.y2[0].x += (cf[0] + cf[1]) + (cf[2] + cf[3]); }
    else if (PM & 4) {
#pragma unroll
        for (int q = 0; q < 16; ++q) if (q < n) { const float cs = __int_as_float(__builtin_amdgcn_readlane(__float_as_int(cf[q & 3]), 16 * (q >> 2))); S.y2[q & 7].x += cs * __uint_as_float((vv[q].x ^ vv[q].y ^ vv[q].z ^ vv[q].w) & 0x3fffffffu); }
    } else {
#pragma unroll
        for (int q = 0; q < 8; ++q) if (q < n) { const float cs = __int_as_float(__builtin_amdgcn_readlane(__float_as_int(cf[q & 3]), 16 * (q >> 2))); axpy16_fp8(vv[q], cs, S.y2); }
        if (n > 8) {
#pragma unroll
            for (int q = 8; q < 16; ++q) if (q < n) { const float cs = __int_as_float(__builtin_amdgcn_readlane(__float_as_int(cf[q & 3]), 16 * (q >> 2))); axpy16_fp8(vv[q], cs, S.y2); }
        }
    }
    __builtin_amdgcn_sched_barrier(0);
}
__device__ __forceinline__ void tok_setup(TokState& S, int t, int lane, LAS unsigned char* xs, const int* __restrict__ seli, const float* __restrict__ selg,
                                          const float* __restrict__ part2, const bf16* __restrict__ h1b) {
    float ps = (lane < 16) ? part2[(size_t)t * 16 + lane] : 0.f;
    ps = wave_sum(ps);
    const float rstd2 = 1.0f / sqrtf(ps * (1.0f / 1024.0f) + EPS);
    f32x4 hv[4]; float am = 0.f;
    { const u32x4* br = (const u32x4*)(h1b + (size_t)t * 1024 + 16 * lane); const u32x4 b0 = br[0], b1 = br[1];
      hv[0] = bf4_lo((u32x2){b0.x, b0.y}); hv[1] = bf4_lo((u32x2){b0.z, b0.w}); hv[2] = bf4_lo((u32x2){b1.x, b1.y}); hv[3] = bf4_lo((u32x2){b1.z, b1.w}); }
#pragma unroll
    for (int j = 0; j < 4; ++j) { am = fmaxf(am, fmaxf(fmaxf(fabsf(hv[j][0]), fabsf(hv[j][1])), fmaxf(fabsf(hv[j][2]), fabsf(hv[j][3])))); }
#pragma unroll
    for (int o = 1; o < 64; o <<= 1) am = fmaxf(am, __shfl_xor(am, o));
    const float sx = am > 0.f ? 127.0f / am : 1.0f, isx = am > 0.f ? am * (1.0f / 127.0f) : 1.0f;
    u32x4 xq;
#pragma unroll
    for (int j = 0; j < 4; ++j) { unsigned w = 0u;
#pragma unroll
        for (int c = 0; c < 4; ++c) w |= ((unsigned)(int)__builtin_rintf(hv[j][c] * sx) & 0xffu) << (8 * c);
        xq[j] = w; }
    *(LAS u32x4*)(xs + 16 * lane) = xq;
    const int iA = seli[(size_t)t * 128 + lane], iB = seli[(size_t)t * 128 + 64 + lane];
    const float gA = selg[(size_t)t * 128 + lane], gB = selg[(size_t)t * 128 + 64 + lane];
    S.k0 = ((unsigned)iA << 16) | (unsigned)(gA * 65535.0f + 0.5f); S.k1 = ((unsigned)iB << 16) | (unsigned)(gB * 65535.0f + 0.5f);
    sort128(S.k0, S.k1, lane);
    S.rsx = rstd2 * isx;
    int bnd = 0;
#pragma unroll
    for (int s = 1; s <= NSLICE; ++s) { const int c = count_lt(S, (unsigned)s << SLICE_SHIFT); bnd = (lane == s) ? c : bnd; }
    S.bnd = bnd;
#pragma unroll
    for (int j = 0; j < 8; ++j) S.y2[j] = (f32x2){0.f, 0.f};
}
__device__ __forceinline__ void tok_finish(const TokState& S, int t, int lane, const bf16* __restrict__ h1b, bf16* __restrict__ h2b, float* __restrict__ rstd3) {
    const u32x4* br = (const u32x4*)(h1b + (size_t)t * 1024 + 16 * lane); const u32x4 b0 = br[0], b1 = br[1];
    f32x4 h2[4]; h2[0] = bf4_lo((u32x2){b0.x, b0.y}); h2[1] = bf4_lo((u32x2){b0.z, b0.w}); h2[2] = bf4_lo((u32x2){b1.x, b1.y}); h2[3] = bf4_lo((u32x2){b1.z, b1.w});
    float sq = 0.f;
#pragma unroll
    for (int j = 0; j < 4; ++j) {
        h2[j] = h2[j] + (f32x4){S.y2[2 * j].x, S.y2[2 * j].y, S.y2[2 * j + 1].x, S.y2[2 * j + 1].y};
        sq += (h2[j][0] * h2[j][0] + h2[j][1] * h2[j][1]) + (h2[j][2] * h2[j][2] + h2[j][3] * h2[j][3]);
    }
    u32x4 w0, w1; w0.x = pk2(h2[0][0], h2[0][1]); w0.y = pk2(h2[0][2], h2[0][3]); w0.z = pk2(h2[1][0], h2[1][1]); w0.w = pk2(h2[1][2], h2[1][3]);
    w1.x = pk2(h2[2][0], h2[2][1]); w1.y = pk2(h2[2][2], h2[2][3]); w1.z = pk2(h2[3][0], h2[3][1]); w1.w = pk2(h2[3][2], h2[3][3]);
    u32x4* ob = (u32x4*)(h2b + (size_t)t * 1024 + 16 * lane); ob[0] = w0; ob[1] = w1;
    sq = wave_sum(sq);
    if (lane == 0) rstd3[t] = 1.0f / sqrtf(sq * (1.0f / 1024.0f) + EPS);
}
__device__ __forceinline__ int dpp_xor8(int v) { return __builtin_amdgcn_update_dpp(0, v, 0x128, 0xf, 0xf, false); }
__device__ __forceinline__ int dpp_xor4(int v) { return __builtin_amdgcn_update_dpp(0, __builtin_amdgcn_update_dpp(0, v, 0x141, 0xf, 0xf, false), 0x1b, 0xf, 0xf, false); }
__device__ __forceinline__ int dpp_xor1(int v) { return __builtin_amdgcn_update_dpp(0, v, 0xb1, 0xf, 0xf, false); }
__device__ __forceinline__ int dpp_xor2(int v) { return __builtin_amdgcn_update_dpp(0, v, 0x4e, 0xf, 0xf, false); }
__device__ __forceinline__ int reduce16_rows(int (&p)[16], int lane) {
    int r8[8], r4[4], r2[2];
#pragma unroll
    for (int i = 0; i < 8; ++i) { const u32x2 s = __builtin_amdgcn_permlane32_swap((unsigned)p[i], (unsigned)p[i + 8], false, false); r8[i] = (int)(s.x + s.y); }
#pragma unroll
    for (int i = 0; i < 4; ++i) { const u32x2 s = __builtin_amdgcn_permlane16_swap((unsigned)r8[i], (unsigned)r8[i + 4], false, false); r4[i] = (int)(s.x + s.y); }
    const bool b3 = lane & 8, b2 = lane & 4;
#pragma unroll
    for (int i = 0; i < 2; ++i) { const int s0 = r4[i] + dpp_xor8(r4[i]), s1 = r4[i + 2] + dpp_xor8(r4[i + 2]); r2[i] = b3 ? s1 : s0; }
    const int keep = b2 ? r2[1] : r2[0], send = b2 ? r2[0] : r2[1];
    int t = keep + dpp_xor4(send);
    t += dpp_xor1(t); t += dpp_xor2(t);
    return t;
}
__device__ __forceinline__ float reduce16_rows(float (&p)[16], int lane) {
    float r8[8], r4[4], r2[2];
#pragma unroll
    for (int i = 0; i < 8; ++i) { const u32x2 s = __builtin_amdgcn_permlane32_swap(__float_as_uint(p[i]), __float_as_uint(p[i + 8]), false, false); r8[i] = __uint_as_float(s.x) + __uint_as_float(s.y); }
#pragma unroll
    for (int i = 0; i < 4; ++i) { const u32x2 s = __builtin_amdgcn_permlane16_swap(__float_as_uint(r8[i]), __float_as_uint(r8[i + 4]), false, false); r4[i] = __uint_as_float(s.x) + __uint_as_float(s.y); }
    const bool b3 = lane & 8, b2 = lane & 4;
#pragma unroll
    for (int i = 0; i < 2; ++i) { const float s0 = r4[i] + __int_as_float(dpp_xor8(__float_as_int(r4[i]))), s1 = r4[i + 2] + __int_as_float(dpp_xor8(__float_as_int(r4[i + 2]))); r2[i] = b3 ? s1 : s0; }
    const float keep = b2 ? r2[1] : r2[0], send = b2 ? r2[0] : r2[1];
    float t = keep + __int_as_float(dpp_xor4(__float_as_int(send)));
    t += __int_as_float(dpp_xor1(__float_as_int(t))); t += __int_as_float(dpp_xor2(__float_as_int(t)));
    return t;
}
struct TokState2 { f32x2 y2[8]; unsigned k0, k1; float rsx; };
template <int PM>
__device__ __forceinline__ void gather_batch_rows(TokState& S, int p, int hi, int lane, const LAS unsigned char* xs, const unsigned char* __restrict__ U8, const unsigned char* __restrict__ V8, const float* __restrict__ IU, const float* __restrict__ IV) {
    const int n = (hi - p < 16) ? hi - p : 16;
    const int slot = lane >> 2;
    const int r = (slot < n) ? p + slot : hi - 1; const int sl = r & 63; const bool lo = r < 64;
    const unsigned ka = (unsigned)bperm_i(sl, (int)S.k0), kb = (unsigned)bperm_i(sl, (int)S.k1);
    const unsigned key = lo ? ka : kb;
    const int es = (int)(key >> 16);
    const float dus = IU[es] * S.rsx, gvs = (slot < n) ? (float)(key & 0xffffu) * (1.0f / 65535.0f) * IV[es] : 0.f;
    i32x4v A[16]; u32x4 vv[16];
#pragma unroll
    for (int g = 0; g < 4; ++g) if (4 * g < n) {
#pragma unroll
        for (int q = 4 * g; q < 4 * g + 4; ++q) { int e = __builtin_amdgcn_readlane(es, 4 * q); if (PM & 32) e &= 1023; A[q] = *(const i32x4v*)(U8 + (size_t)e * 1024 + 16 * lane); }
    }
#pragma unroll
    for (int g = 0; g < 4; ++g) if (4 * g < n) {
#pragma unroll
        for (int q = 4 * g; q < 4 * g + 4; ++q) { int e = __builtin_amdgcn_readlane(es, 4 * q); if (PM & 32) e &= 1023; vv[q] = *(const u32x4*)(V8 + (size_t)e * 1024 + 16 * lane); }
    }
    const i32x4v X = *(const LAS i32x4v*)(xs + 16 * lane);
    int pp[16];
#pragma unroll
    for (int g = 0; g < 4; ++g) {
        if (4 * g < n) {
#pragma unroll
            for (int q = 4 * g; q < 4 * g + 4; ++q) pp[q] = __builtin_amdgcn_sdot4(A[q][3], X[3], __builtin_amdgcn_sdot4(A[q][2], X[2], __builtin_amdgcn_sdot4(A[q][1], X[1], __builtin_amdgcn_sdot4(A[q][0], X[0], 0, false), false), false), false);
        } else {
#pragma unroll
            for (int q = 4 * g; q < 4 * g + 4; ++q) pp[q] = 0;
        }
    }
    const int tot = reduce16_rows(pp, lane);
    const float cf = gvs * gelu_tanh((float)tot * dus);
#pragma unroll
    for (int g = 0; g < 4; ++g) if (4 * g < n) {
#pragma unroll
        for (int q = 4 * g; q < 4 * g + 4; ++q) { const float cs = __int_as_float(__builtin_amdgcn_readlane(__float_as_int(cf), 4 * q)); axpy16_fp8(vv[q], cs, S.y2); }
    }
    __builtin_amdgcn_sched_barrier(0);
}

template <int PM>
__device__ __forceinline__ void gather_batch16(TokState2& S, int bi, int lane, const LAS unsigned char* xs, const unsigned char* __restrict__ U8, const unsigned char* __restrict__ V8, const float* __restrict__ IU, const float* __restrict__ IV) {
    const unsigned ksel = (bi < 4) ? S.k0 : S.k1;
    const int lb = (bi & 3) << 4;
    const unsigned key = (unsigned)bperm_i(lb + (lane >> 2), (int)ksel);
    const int es = (int)(key >> 16);
    const float dus = IU[es] * S.rsx, gvs = (float)(key & 0xffffu) * (1.0f / 65535.0f) * IV[es];
    i32x4v A[16]; u32x4 vv[16];
#pragma unroll
    for (int q = 0; q < 16; ++q) { int e = (int)((unsigned)__builtin_amdgcn_readlane((int)ksel, lb + q) >> 16); if (PM & 32) e &= 1023; if (!(PM & 2)) A[q] = *(const i32x4v*)(U8 + (size_t)e * 1024 + 16 * lane); else A[q] = (i32x4v){e, e, e, e}; }
#pragma unroll
    for (int q = 0; q < 16; ++q) { int e = (int)((unsigned)__builtin_amdgcn_readlane((int)ksel, lb + q) >> 16); if (PM & 32) e &= 1023; if (!(PM & 1)) vv[q] = *(const u32x4*)(V8 + (size_t)e * 1024 + 16 * lane); else vv[q] = (u32x4){(unsigned)e, 0u, 0u, 0u}; }
    const i32x4v X = *(const LAS i32x4v*)(xs + 16 * lane);
    int p[16];
#pragma unroll
    for (int q = 0; q < 16; ++q) p[q] = __builtin_amdgcn_sdot4(A[q][3], X[3], __builtin_amdgcn_sdot4(A[q][2], X[2], __builtin_amdgcn_sdot4(A[q][1], X[1], __builtin_amdgcn_sdot4(A[q][0], X[0], 0, false), false), false), false);
    const int tot = reduce16_rows(p, lane);
    const float cf = gvs * gelu_tanh((float)tot * dus);
#pragma unroll
    for (int q = 0; q < 16; ++q) { const float cs = __int_as_float(__builtin_amdgcn_readlane(__float_as_int(cf), 4 * q)); if (PM & 1) S.y2[q & 7].x += cs * __uint_as_float(vv[q].x); else axpy16_fp8(vv[q], cs, S.y2); }
    __builtin_amdgcn_sched_barrier(0);
}
__device__ __forceinline__ void tok_setup2(TokState2& S, int t, int lane, LAS unsigned char* xs, const int* __restrict__ seli, const float* __restrict__ selg,
                                           const float* __restrict__ part2, const bf16* __restrict__ h1b) {
    float ps = (lane < 16) ? part2[(size_t)t * 16 + lane] : 0.f;
    ps = wave_sum(ps);
    const float rstd2 = 1.0f / sqrtf(ps * (1.0f / 1024.0f) + EPS);
    f32x4 hv[4]; float am = 0.f;
    { const u32x4* br = (const u32x4*)(h1b + (size_t)t * 1024 + 16 * lane); const u32x4 b0 = br[0], b1 = br[1];
      hv[0] = bf4_lo((u32x2){b0.x, b0.y}); hv[1] = bf4_lo((u32x2){b0.z, b0.w}); hv[2] = bf4_lo((u32x2){b1.x, b1.y}); hv[3] = bf4_lo((u32x2){b1.z, b1.w}); }
#pragma unroll
    for (int j = 0; j < 4; ++j) { am = fmaxf(am, fmaxf(fmaxf(fabsf(hv[j][0]), fabsf(hv[j][1])), fmaxf(fabsf(hv[j][2]), fabsf(hv[j][3])))); }
#pragma unroll
    for (int o = 1; o < 64; o <<= 1) am = fmaxf(am, __shfl_xor(am, o));
    const float sx = am > 0.f ? 127.0f / am : 1.0f, isx = am > 0.f ? am * (1.0f / 127.0f) : 1.0f;
    u32x4 xq;
#pragma unroll
    for (int j = 0; j < 4; ++j) { unsigned w = 0u;
#pragma unroll
        for (int c = 0; c < 4; ++c) w |= ((unsigned)(int)__builtin_rintf(hv[j][c] * sx) & 0xffu) << (8 * c);
        xq[j] = w; }
    *(LAS u32x4*)(xs + 16 * lane) = xq;
    const int iA = seli[(size_t)t * 128 + lane], iB = seli[(size_t)t * 128 + 64 + lane];
    const float gA = selg[(size_t)t * 128 + lane], gB = selg[(size_t)t * 128 + 64 + lane];
    S.k0 = ((unsigned)iA << 16) | (unsigned)(gA * 65535.0f + 0.5f); S.k1 = ((unsigned)iB << 16) | (unsigned)(gB * 65535.0f + 0.5f);
    sort128(S.k0, S.k1, lane);
    S.rsx = rstd2 * isx;
#pragma unroll
    for (int j = 0; j < 8; ++j) S.y2[j] = (f32x2){0.f, 0.f};
}
__device__ __forceinline__ void tok_finish2(const TokState2& S, int t, int lane, const bf16* __restrict__ h1b, bf16* __restrict__ h2b, float* __restrict__ rstd3) {
    const u32x4* br = (const u32x4*)(h1b + (size_t)t * 1024 + 16 * lane); const u32x4 b0 = br[0], b1 = br[1];
    f32x4 h2[4]; h2[0] = bf4_lo((u32x2){b0.x, b0.y}); h2[1] = bf4_lo((u32x2){b0.z, b0.w}); h2[2] = bf4_lo((u32x2){b1.x, b1.y}); h2[3] = bf4_lo((u32x2){b1.z, b1.w});
    float sq = 0.f;
#pragma unroll
    for (int j = 0; j < 4; ++j) {
        h2[j] = h2[j] + (f32x4){S.y2[2 * j].x, S.y2[2 * j].y, S.y2[2 * j + 1].x, S.y2[2 * j + 1].y};
        sq += (h2[j][0] * h2[j][0] + h2[j][1] * h2[j][1]) + (h2[j][2] * h2[j][2] + h2[j][3] * h2[j][3]);
    }
    u32x4 w0, w1; w0.x = pk2(h2[0][0], h2[0][1]); w0.y = pk2(h2[0][2], h2[0][3]); w0.z = pk2(h2[1][0], h2[1][1]); w0.w = pk2(h2[1][2], h2[1][3]);
    w1.x = pk2(h2[2][0], h2[2][1]); w1.y = pk2(h2[2][2], h2[2][3]); w1.z = pk2(h2[3][0], h2[3][1]); w1.w = pk2(h2[3][2], h2[3][3]);
    u32x4* ob = (u32x4*)(h2b + (size_t)t * 1024 + 16 * lane); ob[0] = w0; ob[1] = w1;
    sq = wave_sum(sq);
    if (lane == 0) rstd3[t] = 1.0f / sqrtf(sq * (1.0f / 1024.0f) + EPS);
}
template <int PM>
__device__ __forceinline__ void gather_wg_rows(int tok0, int wave, int lane, LAS unsigned char* lds, const unsigned char* __restrict__ U8, const unsigned char* __restrict__ V8, const float* __restrict__ IU, const float* __restrict__ IV,
                                               const int* __restrict__ seli, const float* __restrict__ selg, const float* __restrict__ part2, const bf16* __restrict__ h1b, bf16* __restrict__ h2b, float* __restrict__ rstd3, float* probe_out) {
    LAS unsigned char* xs = lds + wave * 4096;
#pragma unroll 1
    for (int pass = 0; pass < 2; ++pass) {
        const int tb = tok0 + pass * 32 + wave * 4;
        TokState2 S0, S1, S2, S3;
        tok_setup2(S0, tb + 0, fresh_lane(), xs, seli, selg, part2, h1b); __builtin_amdgcn_sched_barrier(0);
        tok_setup2(S1, tb + 1, fresh_lane(), xs + 1024, seli, selg, part2, h1b); __builtin_amdgcn_sched_barrier(0);
        tok_setup2(S2, tb + 2, fresh_lane(), xs + 2048, seli, selg, part2, h1b); __builtin_amdgcn_sched_barrier(0);
        tok_setup2(S3, tb + 3, fresh_lane(), xs + 3072, seli, selg, part2, h1b); __builtin_amdgcn_sched_barrier(0);
        __syncthreads();
        lane = fresh_lane();
#pragma unroll 1
        for (int bi = 0; bi < 8; ++bi) {
            gather_batch16<PM>(S0, bi, lane, xs, U8, V8, IU, IV);
            gather_batch16<PM>(S1, bi, lane, xs + 1024, U8, V8, IU, IV);
            gather_batch16<PM>(S2, bi, lane, xs + 2048, U8, V8, IU, IV);
            gather_batch16<PM>(S3, bi, lane, xs + 3072, U8, V8, IU, IV);
        }
        if (PM != 0) { const int fl = fresh_lane(); f32x2 a = S0.y2[0] + S1.y2[0] + S2.y2[0] + S3.y2[0];
#pragma unroll
            for (int j = 1; j < 8; ++j) a += S0.y2[j] + S1.y2[j] + S2.y2[j] + S3.y2[j];
            probe_out[(size_t)tb * 64 + fl] = a.x + a.y; }
        else { const int fl = fresh_lane(); tok_finish2(S0, tb, fl, h1b, h2b, rstd3); tok_finish2(S1, tb + 1, fl, h1b, h2b, rstd3); tok_finish2(S2, tb + 2, fl, h1b, h2b, rstd3); tok_finish2(S3, tb + 3, fl, h1b, h2b, rstd3); }
        __syncthreads();
    }
}
#if GATHER_ROWS == 2
#define GATHER_BATCH_FN gather_batch_rows
#else
#define GATHER_BATCH_FN gather_batch
#endif
template <int PM>
__device__ __forceinline__ void gather_wg_sliced(int tok0, int wave, int lane, LAS unsigned char* lds, const unsigned char* __restrict__ U8, const unsigned char* __restrict__ V8, const float* __restrict__ IU, const float* __restrict__ IV,
                                                 const int* __restrict__ seli, const float* __restrict__ selg, const float* __restrict__ part2, float* __restrict__ H, const bf16* __restrict__ h1b, bf16* __restrict__ h2b, float* __restrict__ rstd3, float* probe_out) {
    LAS unsigned char* xs = lds + wave * 4096;
#pragma unroll 1
    for (int pass = 0; pass < 2; ++pass) {
        const int tb = tok0 + pass * 32 + wave * 4;
        TokState S0, S1, S2, S3;
        tok_setup(S0, tb + 0, fresh_lane(), xs, seli, selg, part2, h1b); __builtin_amdgcn_sched_barrier(0);
        tok_setup(S1, tb + 1, fresh_lane(), xs + 1024, seli, selg, part2, h1b); __builtin_amdgcn_sched_barrier(0);
        tok_setup(S2, tb + 2, fresh_lane(), xs + 2048, seli, selg, part2, h1b); __builtin_amdgcn_sched_barrier(0);
        tok_setup(S3, tb + 3, fresh_lane(), xs + 3072, seli, selg, part2, h1b); __builtin_amdgcn_sched_barrier(0);
        __syncthreads();
        lane = fresh_lane();
        int lo0 = 0, lo1 = 0, lo2 = 0, lo3 = 0;
#pragma unroll 1
        for (int s = 0; s < NSLICE; ++s) {
            { const int hi = __builtin_amdgcn_readlane(S0.bnd, s + 1); for (int p = lo0; p < hi; p += 16) GATHER_BATCH_FN<PM>(S0, p, hi, lane, xs, U8, V8, IU, IV); lo0 = hi; }
            { const int hi = __builtin_amdgcn_readlane(S1.bnd, s + 1); for (int p = lo1; p < hi; p += 16) GATHER_BATCH_FN<PM>(S1, p, hi, lane, xs + 1024, U8, V8, IU, IV); lo1 = hi; }
            { const int hi = __builtin_amdgcn_readlane(S2.bnd, s + 1); for (int p = lo2; p < hi; p += 16) GATHER_BATCH_FN<PM>(S2, p, hi, lane, xs + 2048, U8, V8, IU, IV); lo2 = hi; }
            { const int hi = __builtin_amdgcn_readlane(S3.bnd, s + 1); for (int p = lo3; p < hi; p += 16) GATHER_BATCH_FN<PM>(S3, p, hi, lane, xs + 3072, U8, V8, IU, IV); lo3 = hi; }
        }
        if (probe_out) { const int fl = fresh_lane(); f32x2 a = S0.y2[0] + S1.y2[0] + S2.y2[0] + S3.y2[0];
#pragma unroll
            for (int j = 1; j < 8; ++j) a += S0.y2[j] + S1.y2[j] + S2.y2[j] + S3.y2[j];
            probe_out[(size_t)tb * 64 + fl] = a.x + a.y; }
        else { const int fl = fresh_lane(); tok_finish(S0, tb, fl, h1b, h2b, rstd3); tok_finish(S1, tb + 1, fl, h1b, h2b, rstd3); tok_finish(S2, tb + 2, fl, h1b, h2b, rstd3); tok_finish(S3, tb + 3, fl, h1b, h2b, rstd3); }
        __syncthreads();
    }
}


__device__ __forceinline__ unsigned xor16_val(unsigned v, bool hi16) { const u32x2 s = __builtin_amdgcn_permlane16_swap(v, v, false, false); return hi16 ? s.x : s.y; }
__device__ __forceinline__ unsigned xor32_val(unsigned v, bool hi32) { const u32x2 s = __builtin_amdgcn_permlane32_swap(v, v, false, false); return hi32 ? s.x : s.y; }
__device__ __forceinline__ float wave_sum_x(float v) {
    v += __int_as_float(dpp_xor1(__float_as_int(v))); v += __int_as_float(dpp_xor2(__float_as_int(v))); v += __int_as_float(dpp_xor4(__float_as_int(v))); v += __int_as_float(dpp_xor8(__float_as_int(v)));
    { const u32x2 s = __builtin_amdgcn_permlane16_swap(__float_as_uint(v), __float_as_uint(v), false, false); v = __uint_as_float(s.x) + __uint_as_float(s.y); }
    { const u32x2 s = __builtin_amdgcn_permlane32_swap(__float_as_uint(v), __float_as_uint(v), false, false); v = __uint_as_float(s.x) + __uint_as_float(s.y); }
    return v;
}
__device__ __forceinline__ float wave_max_x(float v) {
    v = fmaxf(v, __int_as_float(dpp_xor1(__float_as_int(v)))); v = fmaxf(v, __int_as_float(dpp_xor2(__float_as_int(v)))); v = fmaxf(v, __int_as_float(dpp_xor4(__float_as_int(v)))); v = fmaxf(v, __int_as_float(dpp_xor8(__float_as_int(v))));
    { const u32x2 s = __builtin_amdgcn_permlane16_swap(__float_as_uint(v), __float_as_uint(v), false, false); v = fmaxf(__uint_as_float(s.x), __uint_as_float(s.y)); }
    { const u32x2 s = __builtin_amdgcn_permlane32_swap(__float_as_uint(v), __float_as_uint(v), false, false); v = fmaxf(__uint_as_float(s.x), __uint_as_float(s.y)); }
    return v;
}
template <int J> __device__ __forceinline__ unsigned xor_lane(unsigned v, int lane) {
    if (J == 1) return (unsigned)__builtin_amdgcn_update_dpp(0, (int)v, 0xb1, 0xf, 0xf, false);
    if (J == 2) return (unsigned)__builtin_amdgcn_update_dpp(0, (int)v, 0x4e, 0xf, 0xf, false);
    if (J == 4) return (unsigned)dpp_xor4((int)v);
    if (J == 8) return (unsigned)__builtin_amdgcn_update_dpp(0, (int)v, 0x128, 0xf, 0xf, false);
    if (J == 16) return xor16_val(v, (lane & 16) != 0);
    return xor32_val(v, (lane & 32) != 0);
}
template <int NR, int KK, int J>
__device__ __forceinline__ void sort_stage(unsigned (&k)[NR], int lane) {
    if (J >= 64) {
        constexpr int d = J >> 6;
#pragma unroll
        for (int r = 0; r < NR; ++r) if ((r & d) == 0) {
            const bool up = (KK == 64 * NR) ? true : (((64 * r) & KK) == 0);
            const unsigned mn = umin_(k[r], k[r + d]), mx = umax_(k[r], k[r + d]);
            k[r] = up ? mn : mx; k[r + d] = up ? mx : mn;
        }
    } else {
        const bool lower = (lane & J) == 0;
        unsigned o[NR];
#pragma unroll
        for (int r = 0; r < NR; ++r) o[r] = xor_lane<(J < 64 ? J : 1)>(k[r], lane);
#pragma unroll
        for (int r = 0; r < NR; ++r) {
            const bool up = (KK == 64 * NR) ? true : (KK >= 64 ? (((64 * r) & KK) == 0) : ((lane & KK) == 0));
            k[r] = (lower == up) ? umin_(k[r], o[r]) : umax_(k[r], o[r]);
        }
    }
}
template <int NR, int KK, int J> struct SortJ { static __device__ __forceinline__ void run(unsigned (&k)[NR], int lane) { sort_stage<NR, KK, J>(k, lane); SortJ<NR, KK, J / 2>::run(k, lane); } };
template <int NR, int KK> struct SortJ<NR, KK, 0> { static __device__ __forceinline__ void run(unsigned (&)[NR], int) {} };
template <int NR, int KK> struct SortK { static __device__ __forceinline__ void run(unsigned (&k)[NR], int lane) { SortK<NR, KK / 2>::run(k, lane); SortJ<NR, KK, KK / 2>::run(k, lane); } };
template <int NR> struct SortK<NR, 1> { static __device__ __forceinline__ void run(unsigned (&)[NR], int) {} };
template <int NR>
__device__ __forceinline__ void sort_wave(unsigned (&k)[NR], int lane) { SortK<NR, 64 * NR>::run(k, lane); }
__device__ __forceinline__ void axpy_dispatch2(int t, int tbase, float cs, const f32x2 (&x)[8], f32x2 (&Ya)[8], f32x2 (&Yb)[8]) {
    const unsigned long long c = (unsigned long long)__float_as_uint(cs);
    const int tt = t - tbase;
    asm volatile(
        "s_cmp_gt_u32 %[t], 1\n\t"
        "s_cbranch_scc1 3f\n\t"
        "s_cmp_eq_u32 %[t], 1\n\t"
        "s_cbranch_scc1 2f\n\t"
        "v_pk_fma_f32 %[a0], %[c], %[x0], %[a0] op_sel_hi:[0,1,1]\n\t"
        "v_pk_fma_f32 %[a1], %[c], %[x1], %[a1] op_sel_hi:[0,1,1]\n\t"
        "v_pk_fma_f32 %[a2], %[c], %[x2], %[a2] op_sel_hi:[0,1,1]\n\t"
        "v_pk_fma_f32 %[a3], %[c], %[x3], %[a3] op_sel_hi:[0,1,1]\n\t"
        "v_pk_fma_f32 %[a4], %[c], %[x4], %[a4] op_sel_hi:[0,1,1]\n\t"
        "v_pk_fma_f32 %[a5], %[c], %[x5], %[a5] op_sel_hi:[0,1,1]\n\t"
        "v_pk_fma_f32 %[a6], %[c], %[x6], %[a6] op_sel_hi:[0,1,1]\n\t"
        "v_pk_fma_f32 %[a7], %[c], %[x7], %[a7] op_sel_hi:[0,1,1]\n\t"
        "s_branch 3f\n"
        "2:\n\t"
        "v_pk_fma_f32 %[b0], %[c], %[x0], %[b0] op_sel_hi:[0,1,1]\n\t"
        "v_pk_fma_f32 %[b1], %[c], %[x1], %[b1] op_sel_hi:[0,1,1]\n\t"
        "v_pk_fma_f32 %[b2], %[c], %[x2], %[b2] op_sel_hi:[0,1,1]\n\t"
        "v_pk_fma_f32 %[b3], %[c], %[x3], %[b3] op_sel_hi:[0,1,1]\n\t"
        "v_pk_fma_f32 %[b4], %[c], %[x4], %[b4] op_sel_hi:[0,1,1]\n\t"
        "v_pk_fma_f32 %[b5], %[c], %[x5], %[b5] op_sel_hi:[0,1,1]\n\t"
        "v_pk_fma_f32 %[b6], %[c], %[x6], %[b6] op_sel_hi:[0,1,1]\n\t"
        "v_pk_fma_f32 %[b7], %[c], %[x7], %[b7] op_sel_hi:[0,1,1]\n"
        "3:\n\t"
        : [a0] "+v"(Ya[0]), [a1] "+v"(Ya[1]), [a2] "+v"(Ya[2]), [a3] "+v"(Ya[3]), [a4] "+v"(Ya[4]), [a5] "+v"(Ya[5]), [a6] "+v"(Ya[6]), [a7] "+v"(Ya[7]),
          [b0] "+v"(Yb[0]), [b1] "+v"(Yb[1]), [b2] "+v"(Yb[2]), [b3] "+v"(Yb[3]), [b4] "+v"(Yb[4]), [b5] "+v"(Yb[5]), [b6] "+v"(Yb[6]), [b7] "+v"(Yb[7])
        : [x0] "v"(x[0]), [x1] "v"(x[1]), [x2] "v"(x[2]), [x3] "v"(x[3]), [x4] "v"(x[4]), [x5] "v"(x[5]), [x6] "v"(x[6]), [x7] "v"(x[7]), [c] "s"(c), [t] "s"(tt)
        : "scc");
}
__device__ __forceinline__ void axpy_dispatch2_dup(int t, int tbase, float cs, const f32x2 (&x)[8], f32x2 (&Ya)[8], f32x2 (&Yb)[8]) {
    const unsigned long long c = (unsigned long long)__float_as_uint(cs);
    const int tt = t - tbase;
    asm volatile(
        "s_cmp_gt_u32 %[t], 1\n\t"
        "s_cbranch_scc1 3f\n\t"
        "s_cmp_eq_u32 %[t], 1\n\t"
        "s_cbranch_scc1 2f\n\t"
        "v_pk_fma_f32 %[a0], %[c], %[x0], %[a0] op_sel_hi:[0,1,1]\n\t"
        "v_pk_fma_f32 %[a0], %[c], %[x0], %[a0] op_sel_hi:[0,1,1]\n\t"
        "v_pk_fma_f32 %[a1], %[c], %[x1], %[a1] op_sel_hi:[0,1,1]\n\t"
        "v_pk_fma_f32 %[a1], %[c], %[x1], %[a1] op_sel_hi:[0,1,1]\n\t"
        "v_pk_fma_f32 %[a2], %[c], %[x2], %[a2] op_sel_hi:[0,1,1]\n\t"
        "v_pk_fma_f32 %[a2], %[c], %[x2], %[a2] op_sel_hi:[0,1,1]\n\t"
        "v_pk_fma_f32 %[a3], %[c], %[x3], %[a3] op_sel_hi:[0,1,1]\n\t"
        "v_pk_fma_f32 %[a3], %[c], %[x3], %[a3] op_sel_hi:[0,1,1]\n\t"
        "v_pk_fma_f32 %[a4], %[c], %[x4], %[a4] op_sel_hi:[0,1,1]\n\t"
        "v_pk_fma_f32 %[a4], %[c], %[x4], %[a4] op_sel_hi:[0,1,1]\n\t"
        "v_pk_fma_f32 %[a5], %[c], %[x5], %[a5] op_sel_hi:[0,1,1]\n\t"
        "v_pk_fma_f32 %[a5], %[c], %[x5], %[a5] op_sel_hi:[0,1,1]\n\t"
        "v_pk_fma_f32 %[a6], %[c], %[x6], %[a6] op_sel_hi:[0,1,1]\n\t"
        "v_pk_fma_f32 %[a6], %[c], %[x6], %[a6] op_sel_hi:[0,1,1]\n\t"
        "v_pk_fma_f32 %[a7], %[c], %[x7], %[a7] op_sel_hi:[0,1,1]\n\t"
        "v_pk_fma_f32 %[a7], %[c], %[x7], %[a7] op_sel_hi:[0,1,1]\n\t"
        "s_branch 3f\n"
        "2:\n\t"
        "v_pk_fma_f32 %[b0], %[c], %[x0], %[b0] op_sel_hi:[0,1,1]\n\t"
        "v_pk_fma_f32 %[b0], %[c], %[x0], %[b0] op_sel_hi:[0,1,1]\n\t"
        "v_pk_fma_f32 %[b1], %[c], %[x1], %[b1] op_sel_hi:[0,1,1]\n\t"
        "v_pk_fma_f32 %[b1], %[c], %[x1], %[b1] op_sel_hi:[0,1,1]\n\t"
        "v_pk_fma_f32 %[b2], %[c], %[x2], %[b2] op_sel_hi:[0,1,1]\n\t"
        "v_pk_fma_f32 %[b2], %[c], %[x2], %[b2] op_sel_hi:[0,1,1]\n\t"
        "v_pk_fma_f32 %[b3], %[c], %[x3], %[b3] op_sel_hi:[0,1,1]\n\t"
        "v_pk_fma_f32 %[b3], %[c], %[x3], %[b3] op_sel_hi:[0,1,1]\n\t"
        "v_pk_fma_f32 %[b4], %[c], %[x4], %[b4] op_sel_hi:[0,1,1]\n\t"
        "v_pk_fma_f32 %[b4], %[c], %[x4], %[b4] op_sel_hi:[0,1,1]\n\t"
        "v_pk_fma_f32 %[b5], %[c], %[x5], %[b5] op_sel_hi:[0,1,1]\n\t"
        "v_pk_fma_f32 %[b5], %[c], %[x5], %[b5] op_sel_hi:[0,1,1]\n\t"
        "v_pk_fma_f32 %[b6], %[c], %[x6], %[b6] op_sel_hi:[0,1,1]\n\t"
        "v_pk_fma_f32 %[b6], %[c], %[x6], %[b6] op_sel_hi:[0,1,1]\n\t"
        "v_pk_fma_f32 %[b7], %[c], %[x7], %[b7] op_sel_hi:[0,1,1]\n"
        "v_pk_fma_f32 %[b7], %[c], %[x7], %[b7] op_sel_hi:[0,1,1]\n"
        "3:\n\t"
        : [a0] "+v"(Ya[0]), [a1] "+v"(Ya[1]), [a2] "+v"(Ya[2]), [a3] "+v"(Ya[3]), [a4] "+v"(Ya[4]), [a5] "+v"(Ya[5]), [a6] "+v"(Ya[6]), [a7] "+v"(Ya[7]),
          [b0] "+v"(Yb[0]), [b1] "+v"(Yb[1]), [b2] "+v"(Yb[2]), [b3] "+v"(Yb[3]), [b4] "+v"(Yb[4]), [b5] "+v"(Yb[5]), [b6] "+v"(Yb[6]), [b7] "+v"(Yb[7])
        : [x0] "v"(x[0]), [x1] "v"(x[1]), [x2] "v"(x[2]), [x3] "v"(x[3]), [x4] "v"(x[4]), [x5] "v"(x[5]), [x6] "v"(x[6]), [x7] "v"(x[7]), [c] "s"(c), [t] "s"(tt)
        : "scc");
}
struct TokRaw { float ps; u32x4 b0, b1; int iA, iB; float gA, gB; };
__device__ __forceinline__ void tok_load_mixed(TokRaw& r, int t, int lane, const int* __restrict__ seli, const float* __restrict__ selg, const float* __restrict__ part2, const bf16* __restrict__ h1b) {
    r.ps = (lane < 16) ? part2[(size_t)t * 16 + lane] : 0.f;
    const u32x4* br = (const u32x4*)(h1b + (size_t)t * 1024 + 16 * lane); r.b0 = br[0]; r.b1 = br[1];
    r.iA = seli[(size_t)t * 128 + lane]; r.iB = seli[(size_t)t * 128 + 64 + lane];
    r.gA = selg[(size_t)t * 128 + lane]; r.gB = selg[(size_t)t * 128 + 64 + lane];
}
__device__ __forceinline__ float tok_prep_mixed(const TokRaw& r, unsigned& k0, unsigned& k1, int j, int lane, LAS unsigned char* xs) {
    const float ps = wave_sum_x(r.ps);
    const float rstd2 = 1.0f / sqrtf(ps * (1.0f / 1024.0f) + EPS);
    const u32x4 b0 = r.b0, b1 = r.b1;
#if U_FP6
    { u32x4 w0, w1;
#pragma unroll
      for (int c = 0; c < 4; ++c) { const unsigned a = b0[c], b = b1[c];
          w0[c] = __builtin_bit_cast(unsigned, __builtin_amdgcn_cvt_pkrtz(__uint_as_float(a << 16), __uint_as_float(a & 0xffff0000u)));
          w1[c] = __builtin_bit_cast(unsigned, __builtin_amdgcn_cvt_pkrtz(__uint_as_float(b << 16), __uint_as_float(b & 0xffff0000u))); }
      LAS u32x4* xp = (LAS u32x4*)(xs + 32 * lane); xp[0] = w0; xp[1] = w1; }
    const float isx = 1.0f;
#else
    f32x4 hv[4]; float am = 0.f;
    hv[0] = bf4_lo((u32x2){b0.x, b0.y}); hv[1] = bf4_lo((u32x2){b0.z, b0.w}); hv[2] = bf4_lo((u32x2){b1.x, b1.y}); hv[3] = bf4_lo((u32x2){b1.z, b1.w});
#pragma unroll
    for (int i = 0; i < 4; ++i) { am = fmaxf(am, fmaxf(fmaxf(fabsf(hv[i][0]), fabsf(hv[i][1])), fmaxf(fabsf(hv[i][2]), fabsf(hv[i][3])))); }
    am = wave_max_x(am);
    const float sx = am > 0.f ? 127.0f / am : 1.0f, isx = am > 0.f ? am * (1.0f / 127.0f) : 1.0f;
    u32x4 xq;
#pragma unroll
    for (int i = 0; i < 4; ++i) { unsigned w = 0u;
#pragma unroll
        for (int c = 0; c < 4; ++c) w |= ((unsigned)(int)__builtin_rintf(hv[i][c] * sx) & 0xffu) << (8 * c);
        xq[i] = w; }
    *(LAS u32x4*)(xs + 16 * lane) = xq;
#endif
    k0 = ((unsigned)r.iA << 18) | ((unsigned)j << 16) | (unsigned)(r.gA * 65535.0f + 0.5f); k1 = ((unsigned)r.iB << 18) | ((unsigned)j << 16) | (unsigned)(r.gB * 65535.0f + 0.5f);
    return rstd2 * isx;
}
__device__ __forceinline__ void tok_finish_loaded(const f32x2 (&y2)[8], const u32x4 b0, const u32x4 b1, int t, int lane, bf16* __restrict__ h2b, float* __restrict__ rstd3) {
    f32x4 h2[4]; h2[0] = bf4_lo((u32x2){b0.x, b0.y}); h2[1] = bf4_lo((u32x2){b0.z, b0.w}); h2[2] = bf4_lo((u32x2){b1.x, b1.y}); h2[3] = bf4_lo((u32x2){b1.z, b1.w});
    float sq = 0.f;
#pragma unroll
    for (int i = 0; i < 4; ++i) {
        h2[i] = h2[i] + (f32x4){y2[2 * i].x, y2[2 * i].y, y2[2 * i + 1].x, y2[2 * i + 1].y};
        sq += (h2[i][0] * h2[i][0] + h2[i][1] * h2[i][1]) + (h2[i][2] * h2[i][2] + h2[i][3] * h2[i][3]);
    }
    u32x4 w0, w1; w0.x = pk2(h2[0][0], h2[0][1]); w0.y = pk2(h2[0][2], h2[0][3]); w0.z = pk2(h2[1][0], h2[1][1]); w0.w = pk2(h2[1][2], h2[1][3]);
    w1.x = pk2(h2[2][0], h2[2][1]); w1.y = pk2(h2[2][2], h2[2][3]); w1.z = pk2(h2[3][0], h2[3][1]); w1.w = pk2(h2[3][2], h2[3][3]);
    u32x4* ob = (u32x4*)(h2b + (size_t)t * 1024 + 16 * lane); ob[0] = w0; ob[1] = w1;
    sq = wave_sum_x(sq);
    if (lane == 0) rstd3[t] = 1.0f / sqrtf(sq * (1.0f / 1024.0f) + EPS);
}
__device__ __forceinline__ float tok_setup_mixed(unsigned& k0, unsigned& k1, int t, int j, int lane, LAS unsigned char* xs, const int* __restrict__ seli, const float* __restrict__ selg,
                                                 const float* __restrict__ part2, const bf16* __restrict__ h1b) {
    float ps = (lane < 16) ? part2[(size_t)t * 16 + lane] : 0.f;
    ps = wave_sum_x(ps);
    const float rstd2 = 1.0f / sqrtf(ps * (1.0f / 1024.0f) + EPS);
#if U_FP6
    { const u32x4* br = (const u32x4*)(h1b + (size_t)t * 1024 + 16 * lane); const u32x4 b0 = br[0], b1 = br[1];
      u32x4 w0, w1;
#pragma unroll
      for (int c = 0; c < 4; ++c) { const unsigned a = b0[c], b = b1[c];
          w0[c] = __builtin_bit_cast(unsigned, __builtin_amdgcn_cvt_pkrtz(__uint_as_float(a << 16), __uint_as_float(a & 0xffff0000u)));
          w1[c] = __builtin_bit_cast(unsigned, __builtin_amdgcn_cvt_pkrtz(__uint_as_float(b << 16), __uint_as_float(b & 0xffff0000u))); }
      LAS u32x4* xp = (LAS u32x4*)(xs + 32 * lane); xp[0] = w0; xp[1] = w1; }
    const float isx = 1.0f;
#else
    f32x4 hv[4]; float am = 0.f;
    { const u32x4* br = (const u32x4*)(h1b + (size_t)t * 1024 + 16 * lane); const u32x4 b0 = br[0], b1 = br[1];
      hv[0] = bf4_lo((u32x2){b0.x, b0.y}); hv[1] = bf4_lo((u32x2){b0.z, b0.w}); hv[2] = bf4_lo((u32x2){b1.x, b1.y}); hv[3] = bf4_lo((u32x2){b1.z, b1.w}); }
#pragma unroll
    for (int i = 0; i < 4; ++i) { am = fmaxf(am, fmaxf(fmaxf(fabsf(hv[i][0]), fabsf(hv[i][1])), fmaxf(fabsf(hv[i][2]), fabsf(hv[i][3])))); }
    am = wave_max_x(am);
    const float sx = am > 0.f ? 127.0f / am : 1.0f, isx = am > 0.f ? am * (1.0f / 127.0f) : 1.0f;
    u32x4 xq;
#pragma unroll
    for (int i = 0; i < 4; ++i) { unsigned w = 0u;
#pragma unroll
        for (int c = 0; c < 4; ++c) w |= ((unsigned)(int)__builtin_rintf(hv[i][c] * sx) & 0xffu) << (8 * c);
        xq[i] = w; }
    *(LAS u32x4*)(xs + 16 * lane) = xq;
#endif
    const int iA = seli[(size_t)t * 128 + lane], iB = seli[(size_t)t * 128 + 64 + lane];
    const float gA = selg[(size_t)t * 128 + lane], gB = selg[(size_t)t * 128 + 64 + lane];
    k0 = ((unsigned)iA << 18) | ((unsigned)j << 16) | (unsigned)(gA * 65535.0f + 0.5f); k1 = ((unsigned)iB << 18) | ((unsigned)j << 16) | (unsigned)(gB * 65535.0f + 0.5f);
    return rstd2 * isx;
}
__device__ __forceinline__ void tok_finish_mixed(const f32x2 (&y2)[8], int t, int lane, const bf16* __restrict__ h1b, bf16* __restrict__ h2b, float* __restrict__ rstd3) {
    const u32x4* br = (const u32x4*)(h1b + (size_t)t * 1024 + 16 * lane); const u32x4 b0 = br[0], b1 = br[1];
    f32x4 h2[4]; h2[0] = bf4_lo((u32x2){b0.x, b0.y}); h2[1] = bf4_lo((u32x2){b0.z, b0.w}); h2[2] = bf4_lo((u32x2){b1.x, b1.y}); h2[3] = bf4_lo((u32x2){b1.z, b1.w});
    float sq = 0.f;
#pragma unroll
    for (int i = 0; i < 4; ++i) {
        h2[i] = h2[i] + (f32x4){y2[2 * i].x, y2[2 * i].y, y2[2 * i + 1].x, y2[2 * i + 1].y};
        sq += (h2[i][0] * h2[i][0] + h2[i][1] * h2[i][1]) + (h2[i][2] * h2[i][2] + h2[i][3] * h2[i][3]);
    }
    u32x4 w0, w1; w0.x = pk2(h2[0][0], h2[0][1]); w0.y = pk2(h2[0][2], h2[0][3]); w0.z = pk2(h2[1][0], h2[1][1]); w0.w = pk2(h2[1][2], h2[1][3]);
    w1.x = pk2(h2[2][0], h2[2][1]); w1.y = pk2(h2[2][2], h2[2][3]); w1.z = pk2(h2[3][0], h2[3][1]); w1.w = pk2(h2[3][2], h2[3][3]);
    u32x4* ob = (u32x4*)(h2b + (size_t)t * 1024 + 16 * lane); ob[0] = w0; ob[1] = w1;
    sq = wave_sum_x(sq);
    if (lane == 0) rstd3[t] = 1.0f / sqrtf(sq * (1.0f / 1024.0f) + EPS);
}
__device__ __forceinline__ i32x4v row_load(__amdgpu_buffer_rsrc_t r, int lane16, int e) { const u32x4 v = __builtin_amdgcn_raw_buffer_load_b128(r, lane16, e << 10, 0); return (i32x4v){(int)v.x, (int)v.y, (int)v.z, (int)v.w}; }
__device__ __forceinline__ u32x4 as_u32x4(i32x4v v) { return (u32x4){(unsigned)v.x, (unsigned)v.y, (unsigned)v.z, (unsigned)v.w}; }
typedef _Float16 h32v __attribute__((ext_vector_type(32)));
typedef _Float16 h2v __attribute__((ext_vector_type(2)));
#if U_FP6
typedef u32x3 UROW;
typedef __bf16 bf32v __attribute__((ext_vector_type(32)));
typedef __bf16 bf2v __attribute__((ext_vector_type(2)));
__device__ __forceinline__ UROW urow_load(__amdgpu_buffer_rsrc_t r, int lane, int e) { return __builtin_amdgcn_raw_buffer_load_b96(r, lane * 12, e * 768, 0); }
__device__ __forceinline__ UROW urow_dummy(int e) { return (UROW){(unsigned)e, 0u, 0u}; }
#else
typedef i32x4v UROW;
__device__ __forceinline__ UROW urow_load(__amdgpu_buffer_rsrc_t r, int lane, int e) { return row_load(r, lane << 4, e); }
__device__ __forceinline__ UROW urow_dummy(int e) { return (UROW){e, e, e, e}; }
#endif
#if V_FP6
typedef u32x3 VROW;
typedef unsigned u32x6 __attribute__((ext_vector_type(6)));
typedef float f32x32 __attribute__((ext_vector_type(32)));
__device__ __forceinline__ VROW vrow_load(__amdgpu_buffer_rsrc_t r, int lane, int e) { return __builtin_amdgcn_raw_buffer_load_b96(r, lane * 12, e * 768, 0); }
__device__ __forceinline__ VROW vrow_dummy(int e) { return (VROW){(unsigned)e, 0u, 0u}; }
#else
typedef u32x4 VROW;
__device__ __forceinline__ VROW vrow_load(__amdgpu_buffer_rsrc_t r, int lane, int e) { return as_u32x4(row_load(r, lane << 4, e)); }
__device__ __forceinline__ VROW vrow_dummy(int e) { return (VROW){(unsigned)e, 0u, 0u, 0u}; }
#endif
#if Y_F16
__device__ __forceinline__ void axpy_nobranch_h(unsigned c, const unsigned (&x)[8], unsigned (&Ya)[8]) {
    asm volatile(
        "v_pk_fma_f16 %[a0], %[c], %[x0], %[a0] op_sel_hi:[0,1,1]\n\t"
        "v_pk_fma_f16 %[a1], %[c], %[x1], %[a1] op_sel_hi:[0,1,1]\n\t"
        "v_pk_fma_f16 %[a2], %[c], %[x2], %[a2] op_sel_hi:[0,1,1]\n\t"
        "v_pk_fma_f16 %[a3], %[c], %[x3], %[a3] op_sel_hi:[0,1,1]\n\t"
        "v_pk_fma_f16 %[a4], %[c], %[x4], %[a4] op_sel_hi:[0,1,1]\n\t"
        "v_pk_fma_f16 %[a5], %[c], %[x5], %[a5] op_sel_hi:[0,1,1]\n\t"
        "v_pk_fma_f16 %[a6], %[c], %[x6], %[a6] op_sel_hi:[0,1,1]\n\t"
        "v_pk_fma_f16 %[a7], %[c], %[x7], %[a7] op_sel_hi:[0,1,1]\n\t"
        : [a0] "+v"(Ya[0]), [a1] "+v"(Ya[1]), [a2] "+v"(Ya[2]), [a3] "+v"(Ya[3]), [a4] "+v"(Ya[4]), [a5] "+v"(Ya[5]), [a6] "+v"(Ya[6]), [a7] "+v"(Ya[7])
        : [x0] "v"(x[0]), [x1] "v"(x[1]), [x2] "v"(x[2]), [x3] "v"(x[3]), [x4] "v"(x[4]), [x5] "v"(x[5]), [x6] "v"(x[6]), [x7] "v"(x[7]), [c] "s"(c));
}
#endif
#if Y_F16
__device__ __forceinline__ void axpy_dispatch2h(int t, int tbase, unsigned c, const unsigned (&x)[8], unsigned (&Ya)[8], unsigned (&Yb)[8]) {
    const int tt = t - tbase;
    asm volatile(
        "s_cmp_gt_u32 %[t], 1\n\t"
        "s_cbranch_scc1 3f\n\t"
        "s_cmp_eq_u32 %[t], 1\n\t"
        "s_cbranch_scc1 2f\n\t"
        "v_pk_fma_f16 %[a0], %[c], %[x0], %[a0] op_sel_hi:[0,1,1]\n\t"
        "v_pk_fma_f16 %[a1], %[c], %[x1], %[a1] op_sel_hi:[0,1,1]\n\t"
        "v_pk_fma_f16 %[a2], %[c], %[x2], %[a2] op_sel_hi:[0,1,1]\n\t"
        "v_pk_fma_f16 %[a3], %[c], %[x3], %[a3] op_sel_hi:[0,1,1]\n\t"
        "v_pk_fma_f16 %[a4], %[c], %[x4], %[a4] op_sel_hi:[0,1,1]\n\t"
        "v_pk_fma_f16 %[a5], %[c], %[x5], %[a5] op_sel_hi:[0,1,1]\n\t"
        "v_pk_fma_f16 %[a6], %[c], %[x6], %[a6] op_sel_hi:[0,1,1]\n\t"
        "v_pk_fma_f16 %[a7], %[c], %[x7], %[a7] op_sel_hi:[0,1,1]\n\t"
        "s_branch 3f\n"
        "2:\n\t"
        "v_pk_fma_f16 %[b0], %[c], %[x0], %[b0] op_sel_hi:[0,1,1]\n\t"
        "v_pk_fma_f16 %[b1], %[c], %[x1], %[b1] op_sel_hi:[0,1,1]\n\t"
        "v_pk_fma_f16 %[b2], %[c], %[x2], %[b2] op_sel_hi:[0,1,1]\n\t"
        "v_pk_fma_f16 %[b3], %[c], %[x3], %[b3] op_sel_hi:[0,1,1]\n\t"
        "v_pk_fma_f16 %[b4], %[c], %[x4], %[b4] op_sel_hi:[0,1,1]\n\t"
        "v_pk_fma_f16 %[b5], %[c], %[x5], %[b5] op_sel_hi:[0,1,1]\n\t"
        "v_pk_fma_f16 %[b6], %[c], %[x6], %[b6] op_sel_hi:[0,1,1]\n\t"
        "v_pk_fma_f16 %[b7], %[c], %[x7], %[b7] op_sel_hi:[0,1,1]\n"
        "3:\n\t"
        : [a0] "+v"(Ya[0]), [a1] "+v"(Ya[1]), [a2] "+v"(Ya[2]), [a3] "+v"(Ya[3]), [a4] "+v"(Ya[4]), [a5] "+v"(Ya[5]), [a6] "+v"(Ya[6]), [a7] "+v"(Ya[7]),
          [b0] "+v"(Yb[0]), [b1] "+v"(Yb[1]), [b2] "+v"(Yb[2]), [b3] "+v"(Yb[3]), [b4] "+v"(Yb[4]), [b5] "+v"(Yb[5]), [b6] "+v"(Yb[6]), [b7] "+v"(Yb[7])
        : [x0] "v"(x[0]), [x1] "v"(x[1]), [x2] "v"(x[2]), [x3] "v"(x[3]), [x4] "v"(x[4]), [x5] "v"(x[5]), [x6] "v"(x[6]), [x7] "v"(x[7]), [c] "s"(c), [t] "s"(tt)
        : "scc");
}
__device__ __forceinline__ void tok_finish_h_loaded(const unsigned (&Y)[8], const u32x4 b0, const u32x4 b1, int t, int lane, bf16* __restrict__ h2b, float* __restrict__ rstd3) {
    f32x2 y2[8];
#pragma unroll
    for (int c = 0; c < 8; ++c) { const unsigned w = Y[c]; const h2v hv = __builtin_bit_cast(h2v, w); y2[c] = (f32x2){(float)hv.x, (float)hv.y}; }
    tok_finish_loaded(y2, b0, b1, t, lane, h2b, rstd3);
}
__device__ __forceinline__ void tok_finish_mixed_h(const unsigned (&Y)[8], int t, int lane, const bf16* __restrict__ h1b, bf16* __restrict__ h2b, float* __restrict__ rstd3) {
    f32x2 y2[8];
#pragma unroll
    for (int c = 0; c < 8; ++c) { const unsigned w = Y[c]; const h2v hv = __builtin_bit_cast(h2v, w); y2[c] = (f32x2){(float)hv.x, (float)hv.y}; }
    tok_finish_mixed(y2, t, lane, h1b, h2b, rstd3);
}
#endif
constexpr int MIX_XROW = U_FP6 ? 2048 : 1024;
constexpr int MIX_LDS_WAVE = 4 * MIX_XROW + 2048 + 64;
constexpr int XG = 2;
template <int PM>
__device__ __forceinline__ void gather_wg_mixed(int tok0, int wave, int lane, LAS unsigned char* lds, const unsigned char* __restrict__ U8, const unsigned char* __restrict__ V8, const float* __restrict__ IU, const float* __restrict__ IV,
                                                const int* __restrict__ seli, const float* __restrict__ selg, const float* __restrict__ part2, const bf16* __restrict__ h1b, bf16* __restrict__ h2b, float* __restrict__ rstd3, float* probe_out) {
    LAS unsigned char* xs = lds + wave * MIX_LDS_WAVE;
    LAS unsigned* ks = (LAS unsigned*)(xs + 4 * MIX_XROW);
    LAS float* rsl = (LAS float*)(xs + 4 * MIX_XROW + 2048);
#pragma unroll 1
    for (int pass = 0; pass < 2; ++pass) {
        const int tb = tok0 + pass * 32 + wave * 4;
        unsigned k[8]; float rs0, rs1, rs2, rs3;
        {   TokRaw r0, r1, r2, r3; const int fl = fresh_lane();
            tok_load_mixed(r0, tb + 0, fl, seli, selg, part2, h1b); tok_load_mixed(r1, tb + 1, fl, seli, selg, part2, h1b); tok_load_mixed(r2, tb + 2, fl, seli, selg, part2, h1b); tok_load_mixed(r3, tb + 3, fl, seli, selg, part2, h1b);
            __builtin_amdgcn_sched_barrier(0);
            rs0 = tok_prep_mixed(r0, k[0], k[1], 0, fl, xs); rs1 = tok_prep_mixed(r1, k[2], k[3], 1, fl, xs + 1 * MIX_XROW); rs2 = tok_prep_mixed(r2, k[4], k[5], 2, fl, xs + 2 * MIX_XROW); rs3 = tok_prep_mixed(r3, k[6], k[7], 3, fl, xs + 3 * MIX_XROW); }
        __builtin_amdgcn_sched_barrier(0);
        lane = fresh_lane();
        sort_wave<8>(k, lane);
#pragma unroll
        for (int r = 0; r < 8; ++r) ks[lane + 64 * r] = k[r];
        if (lane == 0) { rsl[0] = rs0; rsl[1] = rs1; rsl[2] = rs2; rsl[3] = rs3; }
        __builtin_amdgcn_sched_barrier(0);
#if Y_F16
        unsigned Y0[8], Y1[8], Y2[8], Y3[8];
#pragma unroll
        for (int i = 0; i < 8; ++i) { Y0[i] = 0u; Y1[i] = 0u; Y2[i] = 0u; Y3[i] = 0u; }
#else
        f32x2 Y0[8], Y1[8], Y2[8], Y3[8];
#pragma unroll
        for (int i = 0; i < 8; ++i) { Y0[i] = (f32x2){0.f, 0.f}; Y1[i] = (f32x2){0.f, 0.f}; Y2[i] = (f32x2){0.f, 0.f}; Y3[i] = (f32x2){0.f, 0.f}; }
#endif
        __syncthreads();
        lane = fresh_lane();
#if MIX_PIPE
        const int lane16 = lane << 4;
        const __amdgpu_buffer_rsrc_t rU = __builtin_amdgcn_make_buffer_rsrc((void*)U8, 0, (U_FP6 ? 12 : 16) << 20, 0x00020000), rV = __builtin_amdgcn_make_buffer_rsrc((void*)V8, 0, (V_FP6 ? 12 : 16) << 20, 0x00020000);
        unsigned kbN = ks[(pass ? 16 * 31 : 0) + (lane & 15)], keyN = ks[(pass ? 16 * 31 : 0) + (lane >> 2)];
        UROW A[16]; VROW vv[16];
#pragma unroll
        for (int q = 0; q < 16; ++q) { int e = (int)((unsigned)__builtin_amdgcn_readlane((int)kbN, q) >> 18); if (PM & 32) e &= 1023; if (PM & 2) A[q] = urow_dummy(e); else A[q] = urow_load(rU, lane, e); }
#pragma unroll
        for (int q = 0; q < 16; ++q) { int e = (int)((unsigned)__builtin_amdgcn_readlane((int)kbN, q) >> 18); if (PM & 32) e &= 1023; if (PM & 1) vv[q] = vrow_dummy(e); else vv[q] = vrow_load(rV, lane, e); }
        float iuN = IU[keyN >> 18], ivN = IV[keyN >> 18];
#pragma unroll 1
        for (int bb = 0; bb < ((PM & 512) ? 1 : 32); ++bb) {
            const int bn = (bb + 1 < 32) ? bb + 1 : 31; const int b1 = pass ? 31 - bn : bn;
            const unsigned kb = kbN, key = keyN; const float iu = iuN, iv = ivN;
            kbN = ks[16 * b1 + (lane & 15)]; keyN = ks[16 * b1 + (lane >> 2)];
            const int tq = (int)(key >> 16) & 3;
            const float dus = iu * rsl[tq], gvs = (float)(key & 0xffffu) * (1.0f / 65535.0f) * iv;
#if U_FP6
            float pp[16];
#pragma unroll
            for (int q2 = 0; q2 < 16; q2 += 2) {
                u32x4 Xa[2], Xb[2];
#pragma unroll
                for (int h = 0; h < 2; ++h) { const int t = (__builtin_amdgcn_readlane((int)kb, q2 + h) >> 16) & 3; const LAS u32x4* xp = (const LAS u32x4*)(xs + t * 2048 + 32 * lane); Xa[h] = xp[0]; Xb[h] = xp[1]; }
                const u32x6 in6 = {A[q2].x, A[q2].y, A[q2].z, A[q2 + 1].x, A[q2 + 1].y, A[q2 + 1].z};
                const h32v g = __builtin_amdgcn_cvt_scalef32_pk32_f16_fp6(in6, 1.0f);
#pragma unroll
                for (int h = 0; h < 2; ++h) { const int q = q2 + h; float acc = 0.f;
#pragma unroll
                    for (int c = 0; c < 8; ++c) { const unsigned xw = c < 4 ? Xa[h][c] : Xb[h][c - 4]; const h2v xv = __builtin_bit_cast(h2v, xw); const h2v av = {g[16 * h + 2 * c], g[16 * h + 2 * c + 1]};
                        acc = __builtin_amdgcn_fdot2(av, xv, acc, false); }
                    pp[q] = acc;
                    int e = (int)((unsigned)__builtin_amdgcn_readlane((int)kbN, q) >> 18); if (PM & 32) e &= 1023;
                    if (PM & 2) A[q] = urow_dummy(e); else A[q] = urow_load(rU, lane, e);
                }
                __builtin_amdgcn_sched_barrier(0);
            }
#else
            int pp[16];
#pragma unroll
            for (int g = 0; g < 16 / XG; ++g) {
                i32x4v Xg[XG];
#pragma unroll
                for (int i = 0; i < XG; ++i) { const int t = (__builtin_amdgcn_readlane((int)kb, XG * g + i) >> 16) & 3; Xg[i] = *(const LAS i32x4v*)(xs + t * MIX_XROW + 16 * lane); }
#pragma unroll
                for (int i = 0; i < XG; ++i) { const int q = XG * g + i; const i32x4v X = Xg[i];
                    if (PM & 2) pp[q] = A[q][0] + X[0]; else
                    pp[q] = __builtin_amdgcn_sdot4(A[q][3], X[3], __builtin_amdgcn_sdot4(A[q][2], X[2], __builtin_amdgcn_sdot4(A[q][1], X[1], __builtin_amdgcn_sdot4(A[q][0], X[0], 0, false), false), false), false);
                    if (PM & 1024) { i32x4v X2 = X; asm volatile("" : "+v"(X2)); pp[q] = __builtin_amdgcn_sdot4(A[q][3], X2[3], __builtin_amdgcn_sdot4(A[q][2], X2[2], __builtin_amdgcn_sdot4(A[q][1], X2[1], __builtin_amdgcn_sdot4(A[q][0], X2[0], pp[q], false), false), false), false); }
                    int e = (int)((unsigned)__builtin_amdgcn_readlane((int)kbN, q) >> 18); if (PM & 32) e &= 1023;
                    if (PM & 2) A[q] = urow_dummy(e); else A[q] = urow_load(rU, lane, e);
                }
                __builtin_amdgcn_sched_barrier(0);
            }
#endif
            iuN = IU[keyN >> 18]; ivN = IV[keyN >> 18];
            const auto tot = reduce16_rows(pp, lane);
            const float cf = gvs * gelu_tanh((float)tot * dus);
#if Y_F16
            const int cfh = (int)__builtin_bit_cast(unsigned short, (_Float16)cf);
#pragma unroll
            for (int q2 = 0; q2 < 16; q2 += 2) {
                const u32x6 in6 = {vv[q2].x, vv[q2].y, vv[q2].z, vv[q2 + 1].x, vv[q2 + 1].y, vv[q2 + 1].z};
                h32v f = __builtin_amdgcn_cvt_scalef32_pk32_f16_fp6(in6, 1.0f);
                if (PM & 256) { u32x6 in7 = in6; asm volatile("" : "+v"(in7)); const h32v f2 = __builtin_amdgcn_cvt_scalef32_pk32_f16_fp6(in7, 1.0f); f = f + f2; }
#pragma unroll
                for (int h = 0; h < 2; ++h) { const int q = q2 + h;
                    const int t = (__builtin_amdgcn_readlane((int)kb, q) >> 16) & 3;
                    const unsigned cs = (unsigned)__builtin_amdgcn_readlane(cfh, 4 * q);
                    unsigned x[8];
#pragma unroll
                    for (int c = 0; c < 8; ++c) { const h2v hv = {f[16 * h + 2 * c], f[16 * h + 2 * c + 1]}; x[c] = __builtin_bit_cast(unsigned, hv); }
                    int e = (int)((unsigned)__builtin_amdgcn_readlane((int)kbN, q) >> 18); if (PM & 32) e &= 1023;
                    if (PM & 1) { vv[q] = vrow_dummy(e); Y0[q & 7] ^= cs + x[0]; } else {
                    vv[q] = vrow_load(rV, lane, e);
                    if (PM & 2048) { if (q & 1) axpy_nobranch_h(cs, x, Y1); else axpy_nobranch_h(cs, x, Y0); } else {
                    axpy_dispatch2h(t, 0, cs, x, Y0, Y1);
                    axpy_dispatch2h(t, 2, cs, x, Y2, Y3); } }
                }
            }
#elif V_FP6
#pragma unroll
            for (int q2 = 0; q2 < 16; q2 += 2) {
                const u32x6 in6 = {vv[q2].x, vv[q2].y, vv[q2].z, vv[q2 + 1].x, vv[q2 + 1].y, vv[q2 + 1].z};
                const f32x32 f = __builtin_amdgcn_cvt_scalef32_pk32_f32_fp6(in6, 1.0f);
#pragma unroll
                for (int h = 0; h < 2; ++h) { const int q = q2 + h;
                    const int t = (__builtin_amdgcn_readlane((int)kb, q) >> 16) & 3;
                    const float cs = __int_as_float(__builtin_amdgcn_readlane(__float_as_int(cf), 4 * q));
                    f32x2 x[8];
#pragma unroll
                    for (int c = 0; c < 8; ++c) x[c] = (f32x2){f[16 * h + 2 * c], f[16 * h + 2 * c + 1]};
                    int e = (int)((unsigned)__builtin_amdgcn_readlane((int)kbN, q) >> 18); if (PM & 32) e &= 1023;
                    if (PM & 1) { vv[q] = vrow_dummy(e); Y0[q & 7].x += cs * x[0].x; } else {
                    vv[q] = vrow_load(rV, lane, e);
                    axpy_dispatch2(t, 0, cs, x, Y0, Y1);
                    axpy_dispatch2(t, 2, cs, x, Y2, Y3); }
                }
            }
#else
#pragma unroll
            for (int q = 0; q < 16; ++q) {
                const int t = (__builtin_amdgcn_readlane((int)kb, q) >> 16) & 3;
                const float cs = __int_as_float(__builtin_amdgcn_readlane(__float_as_int(cf), 4 * q));
                f32x2 x[8];
#pragma unroll
                for (int c = 0; c < 4; ++c) { x[2 * c] = __builtin_amdgcn_cvt_pk_f32_fp8(vv[q][c], false); x[2 * c + 1] = __builtin_amdgcn_cvt_pk_f32_fp8(vv[q][c], true); }
                int e = (int)((unsigned)__builtin_amdgcn_readlane((int)kbN, q) >> 18); if (PM & 32) e &= 1023;
                if (PM & 1) { vv[q] = vrow_dummy(e); Y0[q & 7].x += cs * x[0].x; } else {
                vv[q] = vrow_load(rV, lane, e);
                if (PM & 128) { axpy_dispatch2_dup(t, 0, cs, x, Y0, Y1); axpy_dispatch2_dup(t, 2, cs, x, Y2, Y3); } else {
                axpy_dispatch2(t, 0, cs, x, Y0, Y1);
                axpy_dispatch2(t, 2, cs, x, Y2, Y3); } }
            }
#endif
        }
#else
#pragma unroll 1
        for (int b = 0; b < 32; ++b) {
            const unsigned kb = ks[16 * b + (lane & 15)];
            const unsigned key = ks[16 * b + (lane >> 2)];
            const int es = (int)(key >> 18); const int tq = (int)(key >> 16) & 3;
            const float rsx = rsl[tq];
            const float dus = IU[es] * rsx, gvs = (float)(key & 0xffffu) * (1.0f / 65535.0f) * IV[es];
            i32x4v A[16]; u32x4 vv[16];
#pragma unroll
            for (int q = 0; q < 16; ++q) { int e = (int)((unsigned)__builtin_amdgcn_readlane((int)kb, q) >> 18); if (PM & 32) e &= 1023; A[q] = *(const i32x4v*)(U8 + (size_t)e * 1024 + 16 * lane); }
#pragma unroll
            for (int q = 0; q < 16; ++q) { int e = (int)((unsigned)__builtin_amdgcn_readlane((int)kb, q) >> 18); if (PM & 32) e &= 1023; vv[q] = *(const u32x4*)(V8 + (size_t)e * 1024 + 16 * lane); }
            int pp[16];
#pragma unroll
            for (int q = 0; q < 16; ++q) {
                const int t = (__builtin_amdgcn_readlane((int)kb, q) >> 16) & 3;
                const i32x4v X = *(const LAS i32x4v*)(xs + t * 1024 + 16 * lane);
                pp[q] = __builtin_amdgcn_sdot4(A[q][3], X[3], __builtin_amdgcn_sdot4(A[q][2], X[2], __builtin_amdgcn_sdot4(A[q][1], X[1], __builtin_amdgcn_sdot4(A[q][0], X[0], 0, false), false), false), false);
            }
            const int tot = reduce16_rows(pp, lane);
            const float cf = gvs * gelu_tanh((float)tot * dus);
#pragma unroll
            for (int q = 0; q < 16; ++q) {
                const int t = (__builtin_amdgcn_readlane((int)kb, q) >> 16) & 3;
                const float cs = __int_as_float(__builtin_amdgcn_readlane(__float_as_int(cf), 4 * q));
                f32x2 x[8];
#pragma unroll
                for (int c = 0; c < 4; ++c) { x[2 * c] = __builtin_amdgcn_cvt_pk_f32_fp8(vv[q][c], false); x[2 * c + 1] = __builtin_amdgcn_cvt_pk_f32_fp8(vv[q][c], true); }
                axpy_dispatch2(t, 0, cs, x, Y0, Y1);
                axpy_dispatch2(t, 2, cs, x, Y2, Y3);
            }
            __builtin_amdgcn_sched_barrier(0);
        }
#endif
#if Y_F16
        if (PM != 0) { const int fl = fresh_lane(); unsigned a = 0u;
#pragma unroll
            for (int i = 0; i < 8; ++i) a += Y0[i] + Y1[i] + Y2[i] + Y3[i];
            probe_out[(size_t)tb * 64 + fl] = (float)a; }
        else { const int fl = fresh_lane(); u32x4 hb[8];
#pragma unroll
            for (int j = 0; j < 4; ++j) { const u32x4* br = (const u32x4*)(h1b + (size_t)(tb + j) * 1024 + 16 * fl); hb[2 * j] = br[0]; hb[2 * j + 1] = br[1]; }
            __builtin_amdgcn_sched_barrier(0);
            tok_finish_h_loaded(Y0, hb[0], hb[1], tb, fl, h2b, rstd3); tok_finish_h_loaded(Y1, hb[2], hb[3], tb + 1, fl, h2b, rstd3); tok_finish_h_loaded(Y2, hb[4], hb[5], tb + 2, fl, h2b, rstd3); tok_finish_h_loaded(Y3, hb[6], hb[7], tb + 3, fl, h2b, rstd3); }
#else
        if (PM != 0) { const int fl = fresh_lane(); f32x2 a = Y0[0] + Y1[0] + Y2[0] + Y3[0];
#pragma unroll
            for (int i = 1; i < 8; ++i) a += Y0[i] + Y1[i] + Y2[i] + Y3[i];
            probe_out[(size_t)tb * 64 + fl] = a.x + a.y; }
        else { const int fl = fresh_lane(); tok_finish_mixed(Y0, tb, fl, h1b, h2b, rstd3); tok_finish_mixed(Y1, tb + 1, fl, h1b, h2b, rstd3); tok_finish_mixed(Y2, tb + 2, fl, h1b, h2b, rstd3); tok_finish_mixed(Y3, tb + 3, fl, h1b, h2b, rstd3); }
#endif
        __syncthreads();
    }
}
namespace pg8 {
#define PG8_LAS __attribute__((address_space(3)))
typedef unsigned short bf16_t;
typedef short bf16x8 __attribute__((ext_vector_type(8)));
typedef float f32x4 __attribute__((ext_vector_type(4)));
typedef unsigned u32x4 __attribute__((ext_vector_type(4)));
constexpr int BM = 256, BK = 64, HALF = 128, HTB = HALF * BK * 2  , STAGE_BYTES = 8 * HTB, NXCD = 8, WGM = 8;

__host__ __device__ __forceinline__ int lds_byte(int r, int c) { const int st = (r >> 4) * 2 + (c >> 5), rr = r & 15, cc = c & 31, ob = rr * 64 + cc * 2; return st * 1024 + (ob ^ (((ob >> 9) & 1) << 5)); }
__host__ __device__ __forceinline__ void stage_rc(int b, int& R, int& C) { const int st = b / 1024, sb = b % 1024, swz = sb ^ (((sb >> 9) & 1) << 5); R = (st >> 1) * 16 + swz / 64; C = (st & 1) * 32 + (swz % 64) / 2; }
__host__ __device__ __forceinline__ int perm32(int rho) { const int n = rho >> 4, i = rho & 15; return 8 * (i >> 2) + 4 * n + (i & 3); }

struct Unit { int pm, pn; };
struct Gemm { const bf16_t* A; const bf16_t* Bt; int K, lda, apn_shift, apn_stride; };

struct StaticOrder {
    int nM, nN, nwg, G, c;
    __host__ __device__ __forceinline__ void init(int M, int N, int G_, int c_) { nM = M / BM; nN = N / BM; nwg = nM * nN; G = G_; c = c_; }
    __host__ __device__ __forceinline__ bool next(int i, Unit& u) const {
        const long L = (long)i * G + c; if (L >= nwg) return false;
        int wgid = (int)L; { const int q = nwg / NXCD, r = nwg % NXCD, xcd = wgid % NXCD, off = wgid / NXCD; wgid = (xcd < r ? xcd * (q + 1) : r * (q + 1) + (xcd - r) * q) + off; }
        const int nig = WGM * nN, gid = wgid / nig, fm = gid * WGM, gsz = (nM - fm) < WGM ? (nM - fm) : WGM;
        u.pm = fm + ((wgid % nig) % gsz); u.pn = (wgid % nig) / gsz; return true;
    }
    __device__ __forceinline__ void a_ready(const Unit&) const {}
    __device__ __forceinline__ void done(const Unit&) const {}
};

__device__ __forceinline__ unsigned cvt_pk_bf16(float lo, float hi) { unsigned r; asm volatile("v_cvt_pk_bf16_f32 %0, %1, %2" : "=v"(r) : "v"(lo), "v"(hi)); return r; }

template <class Epi, class Sched, bool ALIGN_EPI = false, bool SP2 = false>
__device__ __forceinline__ void gemm_phase(PG8_LAS unsigned char* lds, const Gemm g, const Sched& S, const Epi& E, int wave_id  ) {
    const int lane = fresh_lane(), wid = wave_id, tid = wid * 64 + lane, wr = wid >> 2, wc = wid & 3, fr = lane & 15, fq = lane >> 4;
    const int K = g.K, nt = K / BK;
    unsigned voffA[2], voffB[2];
#pragma unroll
    for (int i = 0; i < 2; ++i) { int R, C; stage_rc(tid * 16 + i * 8192, R, C); const int Rb = Epi::PERM ? ((R & ~31) + perm32(R & 31)) : R;
        voffA[i] = (unsigned)(R * g.lda + C) * 2u; voffB[i] = (unsigned)(Rb * K + C) * 2u; }
    const size_t kstep = (size_t)(BK * 2);
    const size_t hstepA = (size_t)HALF * g.lda * 2, hstepB = (size_t)HALF * K * 2;
    const size_t tstepA = 2 * hstepA, tstepB = 2 * hstepB;
    const unsigned ldsw = (unsigned)wid * 1024u;
    const int aoff = lds_byte(wr * 64 + fr, fq * 8), boff = lds_byte(wc * 32 + fr, fq * 8);
#define PG8_SA(b, h) (((b) * 2 + (h)) * HTB)
#define PG8_SB(b, h) ((4 + (b) * 2 + (h)) * HTB)
#define PG8_STAGE(bufoff, gbase, voff) do { _Pragma("unroll") for (int _i = 0; _i < 2; ++_i) \
        __builtin_amdgcn_global_load_lds((const unsigned*)((const char*)(gbase) + (voff)[_i]), (PG8_LAS unsigned*)(lds + (bufoff) + ldsw + _i * 8192), 16, 0, 0); } while (0)
#define PG8_LDA(dst, b, h) do { _Pragma("unroll") for (int m = 0; m < 4; ++m) _Pragma("unroll") for (int k = 0; k < 2; ++k) dst[m][k] = *(const PG8_LAS bf16x8*)(lds + PG8_SA(b, h) + aoff + m * 2048 + k * 1024); } while (0)
#define PG8_LDB(dst, b, h) do { _Pragma("unroll") for (int n = 0; n < 2; ++n) _Pragma("unroll") for (int k = 0; k < 2; ++k) dst[n][k] = *(const PG8_LAS bf16x8*)(lds + PG8_SB(b, h) + boff + n * 2048 + k * 1024); } while (0)
#define PG8_MMA(ai, bj, At, Bt) do { __builtin_amdgcn_s_setprio(1); _Pragma("unroll") for (int m = 0; m < 4; ++m) _Pragma("unroll") for (int n = 0; n < 2; ++n) _Pragma("unroll") for (int k = 0; k < 2; ++k) \
        acc[ai][bj][m][n] = __builtin_amdgcn_mfma_f32_16x16x32_bf16(Bt[n][k], At[m][k], acc[ai][bj][m][n], 0, 0, 0); __builtin_amdgcn_s_setprio(0); } while (0)
#define PG8_WAIT_V(n) asm volatile("s_waitcnt vmcnt(" #n ")" ::: "memory")
#define PG8_WAIT_L(n) asm volatile("s_waitcnt lgkmcnt(" #n ")" ::: "memory")
#define PG8_BAR __builtin_amdgcn_s_barrier()
#define PG8_SCHED __builtin_amdgcn_sched_barrier(0)
    Unit cur, nxt; int ui = 0;
    if (!S.next(0, cur)) return;
    f32x4 acc[2][2][4][2];
#pragma unroll
    for (int a = 0; a < 2; ++a)
#pragma unroll
        for (int b = 0; b < 2; ++b)
#pragma unroll
            for (int m = 0; m < 4; ++m)
#pragma unroll
                for (int n = 0; n < 2; ++n) acc[a][b][m][n] = (f32x4){0.f, 0.f, 0.f, 0.f};
    bf16x8 At[4][2], B0[2][2], B1[2][2];
    const char* cA = (const char*)g.A + (size_t)cur.pm * tstepA + (size_t)((cur.pn >> g.apn_shift) * g.apn_stride) * 2; const char* cB = (const char*)g.Bt + (size_t)cur.pn * tstepB;
    S.a_ready(cur);
    if constexpr (SP2) {
        PG8_STAGE(PG8_SB(0, 0), cB, voffB); PG8_STAGE(PG8_SB(0, 1), cB + hstepB, voffB); PG8_STAGE(PG8_SA(0, 0), cA, voffA); PG8_STAGE(PG8_SA(0, 1), cA + hstepA, voffA);
        if (wr == 1) PG8_BAR;
        PG8_WAIT_V(2); PG8_BAR;
        PG8_STAGE(PG8_SB(1, 0), cB + kstep, voffB); PG8_STAGE(PG8_SA(1, 0), cA + kstep, voffA); PG8_STAGE(PG8_SB(1, 1), cB + hstepB + kstep, voffB);
        PG8_WAIT_V(6); PG8_BAR;
    } else {
        PG8_STAGE(PG8_SB(0, 0), cB, voffB); PG8_STAGE(PG8_SA(0, 0), cA, voffA); PG8_STAGE(PG8_SB(0, 1), cB + hstepB, voffB); PG8_STAGE(PG8_SA(0, 1), cA + hstepA, voffA);
        if (wr == 1) PG8_BAR;
        PG8_WAIT_V(4); PG8_BAR;
        PG8_STAGE(PG8_SB(1, 0), cB + kstep, voffB); PG8_STAGE(PG8_SA(1, 0), cA + kstep, voffA); PG8_STAGE(PG8_SB(1, 1), cB + hstepB + kstep, voffB);
        PG8_WAIT_V(6); PG8_BAR;
    }
    for (;;) {
        const bool has_next = S.next(ui + 1, nxt);
        const char* nA = has_next ? (const char*)g.A + (size_t)nxt.pm * tstepA + (size_t)((nxt.pn >> g.apn_shift) * g.apn_stride) * 2 : cA; const char* nB = has_next ? (const char*)g.Bt + (size_t)nxt.pn * tstepB : cB;
#pragma unroll 1
        for (int t = 0; t < nt; t += 2) {
            const bool last = (t == nt - 2);
            const char* a1 = cA + (size_t)(t + 1) * kstep;
            const char* a2 = last ? nA : cA + (size_t)(t + 2) * kstep; const char* b2 = last ? nB : cB + (size_t)(t + 2) * kstep;
            const char* a3 = a2 + kstep; const char* b3 = b2 + kstep;
            if (last && has_next) S.a_ready(nxt);
            if constexpr (SP2) {
            PG8_LDB(B0, 0, 0); PG8_LDB(B1, 0, 1); PG8_SCHED; PG8_LDA(At, 0, 0); PG8_STAGE(PG8_SA(1, 1), a1 + hstepA, voffA);
            PG8_WAIT_V(8); PG8_WAIT_L(0); PG8_BAR; PG8_MMA(0, 0, At, B0); PG8_MMA(0, 1, At, B1); PG8_BAR; PG8_SCHED;
            PG8_LDA(At, 0, 1); PG8_STAGE(PG8_SB(0, 0), b2, voffB); PG8_STAGE(PG8_SB(0, 1), b2 + hstepB, voffB); PG8_STAGE(PG8_SA(0, 0), a2, voffA);
            PG8_WAIT_V(8); PG8_WAIT_L(0); PG8_BAR; PG8_MMA(1, 0, At, B0); PG8_MMA(1, 1, At, B1); PG8_BAR; PG8_SCHED;
            PG8_LDB(B0, 1, 0); PG8_LDB(B1, 1, 1); PG8_SCHED; PG8_LDA(At, 1, 0); PG8_STAGE(PG8_SA(0, 1), a2 + hstepA, voffA);
            PG8_WAIT_V(8); PG8_WAIT_L(0); PG8_BAR; PG8_MMA(0, 0, At, B0); PG8_MMA(0, 1, At, B1); PG8_BAR; PG8_SCHED;
            PG8_LDA(At, 1, 1); PG8_STAGE(PG8_SB(1, 0), b3, voffB); PG8_STAGE(PG8_SB(1, 1), b3 + hstepB, voffB); PG8_STAGE(PG8_SA(1, 0), a3, voffA);
            PG8_WAIT_V(8); PG8_WAIT_L(0); PG8_BAR; PG8_MMA(1, 0, At, B0); PG8_MMA(1, 1, At, B1); PG8_BAR; PG8_SCHED;
            } else {
            PG8_LDB(B0, 0, 0); PG8_SCHED; PG8_LDA(At, 0, 0); PG8_STAGE(PG8_SA(1, 1), a1 + hstepA, voffA);
            PG8_WAIT_L(8); PG8_BAR; PG8_WAIT_L(0); PG8_MMA(0, 0, At, B0); PG8_BAR; PG8_SCHED;
            PG8_LDB(B1, 0, 1); PG8_STAGE(PG8_SB(0, 0), b2, voffB);
            PG8_BAR; PG8_WAIT_L(0); PG8_MMA(0, 1, At, B1); PG8_BAR;
            PG8_LDA(At, 0, 1); PG8_STAGE(PG8_SA(0, 0), a2, voffA);
            PG8_BAR; PG8_WAIT_L(0); PG8_MMA(1, 0, At, B0); PG8_BAR; PG8_SCHED;
            PG8_STAGE(PG8_SB(0, 1), b2 + hstepB, voffB);
            PG8_WAIT_V(6); PG8_BAR; PG8_MMA(1, 1, At, B1); PG8_BAR;
            PG8_LDB(B0, 1, 0); PG8_SCHED; PG8_LDA(At, 1, 0); PG8_STAGE(PG8_SA(0, 1), a2 + hstepA, voffA);
            PG8_WAIT_L(8); PG8_BAR; PG8_WAIT_L(0); PG8_MMA(0, 0, At, B0); PG8_BAR; PG8_SCHED;
            PG8_LDB(B1, 1, 1); PG8_STAGE(PG8_SB(1, 0), b3, voffB);
            PG8_BAR; PG8_WAIT_L(0); PG8_MMA(0, 1, At, B1); PG8_BAR;
            PG8_LDA(At, 1, 1); PG8_STAGE(PG8_SA(1, 0), a3, voffA);
            PG8_BAR; PG8_WAIT_L(0); PG8_MMA(1, 0, At, B0); PG8_BAR; PG8_SCHED;
            PG8_STAGE(PG8_SB(1, 1), b3 + hstepB, voffB);
            PG8_WAIT_V(6); PG8_BAR; PG8_MMA(1, 1, At, B1); PG8_BAR;
            }
        }
        if constexpr (ALIGN_EPI) { if (wr == 0) PG8_BAR; }
        if constexpr (!Epi::AFTER_DRAIN) { E(acc, cur, wr, wc, fr, fq); S.done(cur); }
        if (!has_next) break;
#pragma unroll
        for (int a = 0; a < 2; ++a)
#pragma unroll
            for (int b = 0; b < 2; ++b)
#pragma unroll
                for (int m = 0; m < 4; ++m)
#pragma unroll
                    for (int n = 0; n < 2; ++n) acc[a][b][m][n] = (f32x4){0.f, 0.f, 0.f, 0.f};
        cur = nxt; cA = nA; cB = nB; ++ui;
        if constexpr (ALIGN_EPI) { if (wr == 1) PG8_BAR; }
    }
    PG8_WAIT_V(0);
    if constexpr (!ALIGN_EPI) { if (wr == 0) PG8_BAR; }
    PG8_BAR;
    if constexpr (Epi::AFTER_DRAIN) { E.fused(acc, cur, wr, wc, fr, fq, lds, wid, lane); S.done(cur); }
#undef PG8_SA
#undef PG8_SB
#undef PG8_STAGE
#undef PG8_LDA
#undef PG8_LDB
#undef PG8_MMA
#undef PG8_WAIT_V
#undef PG8_WAIT_L
#undef PG8_BAR
#undef PG8_SCHED
}
}
#define GAS __attribute__((address_space(1)))
typedef GAS unsigned gu32;
#define RLX_AGENT __ATOMIC_RELAXED, __HIP_MEMORY_SCOPE_AGENT
#define LDS_WAIT() asm volatile("s_waitcnt lgkmcnt(0)" ::: "memory")
#define VM_WAIT() asm volatile("s_waitcnt vmcnt(0)" ::: "memory")
#define XB_TMO      128
#define XB_XCNT(j)  (256  + 64 * (j))
#define XB_XSUB(j)  (1280 + 64 * (j))
#define XB_XGEN(j)  (2304 + 64 * (j))
#define XB_TOP      3328
#define XB_TOPGEN   3392
#define XCD_BAR_WORDS 3456
#define XB_SPIN_CAP (1u << 18)

__device__ __forceinline__ unsigned xb_ld(unsigned* p)              { return __hip_atomic_load(p, __ATOMIC_RELAXED, __HIP_MEMORY_SCOPE_AGENT); }
__device__ __forceinline__ unsigned xb_add(unsigned* p, unsigned v) { return __hip_atomic_fetch_add(p, v, __ATOMIC_RELAXED, __HIP_MEMORY_SCOPE_AGENT); }
__device__ __forceinline__ unsigned xb_xcc_id() { return (unsigned)__builtin_amdgcn_s_getreg((3 << 11) | 20) & 0xFu; }
#define XB_SPIN(cond, bar) do { unsigned _sp = 0; while (cond) { __builtin_amdgcn_s_sleep(1); \
    if ((++_sp & 255u) == 0u) { if (xb_ld(&(bar)[XB_TMO])) break; if (_sp > XB_SPIN_CAP) { atomicAdd(&(bar)[XB_TMO], 1u); break; } } } } while (0)

struct XcdBarrier {
    unsigned* bar; unsigned x;
    volatile LAS unsigned* st;
};

__device__ __forceinline__ XcdBarrier xcd_barrier_post(unsigned* bar, volatile LAS unsigned* st) {
    XcdBarrier b; b.bar = bar; b.x = xb_xcc_id(); b.st = st;
    if (threadIdx.x == 0) (void)xb_add(&bar[XB_XCNT(b.x)], 1u);
    return b;
}
__device__ __forceinline__ void xcd_barrier_complete(unsigned* bar, unsigned x, unsigned& nloc, unsigned& nx) {
    const unsigned G = gridDim.x * gridDim.y * gridDim.z;
    unsigned sum, cnt, mine, sp = 0u;
    for (;;) {
        sum = 0u; cnt = 0u; mine = 0u;
#pragma unroll
        for (unsigned j = 0; j < 16; ++j) { const unsigned c = xb_ld(&bar[XB_XCNT(j)]); sum += c; cnt += (c > 0u) ? 1u : 0u; mine = (j == x) ? c : mine; }
        if (sum == G) break;
        __builtin_amdgcn_s_sleep(1);
        if ((++sp & 255u) == 0u) { if (xb_ld(&bar[XB_TMO])) break; if (sp > XB_SPIN_CAP) { atomicAdd(&bar[XB_TMO], 1u); break; } }
    }
    nloc = mine > 0u ? mine : 1u; nx = cnt > 0u ? cnt : 1u;
}

__device__ __forceinline__ void xcd_barrier(const XcdBarrier& b) {
    asm volatile("s_waitcnt vmcnt(0)" ::: "memory");
    __syncthreads();
    if (threadIdx.x == 0) {
        unsigned* bar = b.bar;
        __builtin_amdgcn_s_waitcnt(0);
        unsigned nloc = b.st[0], nx = b.st[1];
        if (nloc == 0u) { xcd_barrier_complete(bar, b.x, nloc, nx); b.st[0] = nloc; b.st[1] = nx; }
        const unsigned old = xb_add(&bar[XB_XSUB(b.x)], 1u);
        const unsigned gen = old / nloc;
        if (old + 1u == (gen + 1u) * nloc) {
            __builtin_amdgcn_fence(__ATOMIC_RELEASE, "agent");
            asm volatile("s_waitcnt vmcnt(0)" ::: "memory");
            const unsigned og = xb_add(&bar[XB_TOP], 1u);
            const unsigned tg = og / nx;
            if (og + 1u == (tg + 1u) * nx) xb_add(&bar[XB_TOPGEN], 1u);
            else XB_SPIN(xb_ld(&bar[XB_TOPGEN]) == tg, bar);
            __builtin_amdgcn_fence(__ATOMIC_ACQUIRE, "agent");
            xb_add(&bar[XB_XGEN(b.x)], 1u);
            asm volatile("s_waitcnt vmcnt(0)" ::: "memory");
        } else {
            XB_SPIN(xb_ld(&bar[XB_XGEN(b.x)]) == gen, bar);
            __builtin_amdgcn_fence(__ATOMIC_ACQUIRE, "agent");
            asm volatile("s_waitcnt vmcnt(0)" ::: "memory");
        }
    }
    __syncthreads();
}

constexpr int NWAVES = 8;
constexpr int LDS_MAIN = 135168;
constexpr int LDSCTL_OFF = LDS_MAIN;
constexpr int LDS_BYTES = 147456;
constexpr int CW_LRUFLAG = 131072;
constexpr int CW_BAR = 4096;
constexpr size_t CTL_ZERO_BYTES = 1 * MiB;
constexpr float LOG2E = 1.4426950408889634f;
typedef short bf16x8 __attribute__((ext_vector_type(8)));
typedef float f32x16 __attribute__((ext_vector_type(16)));
typedef unsigned u32x2 __attribute__((ext_vector_type(2)));
using pg8::Unit;
using pg8::cvt_pk_bf16;

__device__ __forceinline__ f32x4 sig4(f32x4 v) { return (f32x4){sigmoidf_(v[0]), sigmoidf_(v[1]), sigmoidf_(v[2]), sigmoidf_(v[3])}; }
__device__ __forceinline__ f32x4 gelu4(f32x4 v) { return (f32x4){gelu_tanh(v[0]), gelu_tanh(v[1]), gelu_tanh(v[2]), gelu_tanh(v[3])}; }
__device__ __forceinline__ u32x4 pack8(f32x4 a, f32x4 b) { u32x4 w; w.x = cvt_pk_bf16(a[0], a[1]); w.y = cvt_pk_bf16(a[2], a[3]); w.z = cvt_pk_bf16(b[0], b[1]); w.w = cvt_pk_bf16(b[2], b[3]); return w; }

struct OneUnit { pg8::StaticOrder S; int k;
    __device__ __forceinline__ bool next(int i, Unit& u) const { return i == 0 && S.next(k, u); }
    __device__ __forceinline__ void a_ready(const Unit&) const {}
    __device__ __forceinline__ void done(const Unit&) const {} };
struct EpiProj {
    static constexpr bool PERM = true, AFTER_DRAIN = false;
    const float* rstd; unsigned char* ws;
    __device__ __forceinline__ void operator()(const f32x4 (&acc)[2][2][4][2], const Unit& u, int wr, int wc, int fr, int fq) const {
        { const int t_ = fresh_lane(); fr = t_ & 15; fq = t_ >> 4; }
        const int pn = u.pn; bf16* base; int ldc, coff, act;
        if (pn < 3) { base = (bf16*)(ws + WS_QKV); ldc = 768; coff = pn * 256; act = 0; }
        else if (pn < 7) { base = (bf16*)(ws + WS_LX); ldc = 1024; coff = (pn - 3) * 256; act = 0; }
        else if (pn < 11) { base = (bf16*)(ws + WS_GL); ldc = 1024; coff = (pn - 7) * 256; act = 1; }
        else if (pn < 15) { base = (bf16*)(ws + WS_SGA); ldc = 1024; coff = (pn - 11) * 256; act = 2; }
        else { base = (bf16*)(ws + WS_SGL); ldc = 1024; coff = (pn - 15) * 256; act = 2; }
        const int row0 = u.pm * 256 + wr * 64 + fr, col0 = coff + wc * 32 + 8 * fq;
#pragma unroll
        for (int ai = 0; ai < 2; ++ai)
#pragma unroll
            for (int m = 0; m < 4; ++m) {
                const int r = row0 + ai * 128 + m * 16; const float rs = rstd[r]; bf16* rowp = base + (size_t)r * ldc + col0;
#pragma unroll
                for (int bj = 0; bj < 2; ++bj) {
                    f32x4 v0 = acc[ai][bj][m][0] * rs, v1 = acc[ai][bj][m][1] * rs;
                    if (act == 1) { v0 = gelu4(v0); v1 = gelu4(v1); } else if (act == 2) { v0 = sig4(v0); v1 = sig4(v1); }
                    *(u32x4*)(rowp + bj * 128) = pack8(v0, v1);
                }
            }
    }
};
struct EpiMP {
    static constexpr bool PERM = false, AFTER_DRAIN = false;
    const bf16* sga; float* mp;
    __device__ __forceinline__ void operator()(const f32x4 (&acc)[2][2][4][2], const Unit& u, int wr, int wc, int fr, int fq) const {
        { const int t_ = fresh_lane(); fr = t_ & 15; fq = t_ >> 4; }
        const int row0 = u.pm * 256 + wr * 64 + fr, col0 = u.pn * 256 + wc * 32 + 4 * fq;
#pragma unroll
        for (int ai = 0; ai < 2; ++ai)
#pragma unroll
            for (int m = 0; m < 4; ++m) {
                const size_t off = (size_t)(row0 + ai * 128 + m * 16) * 1024 + col0;
#pragma unroll
                for (int bj = 0; bj < 2; ++bj)
#pragma unroll
                    for (int n = 0; n < 2; ++n) { const size_t o = off + bj * 128 + n * 16; const f32x4 g = bf4_lo(*(const u32x2*)(sga + o)); const f32x4 v = acc[ai][bj][m][n] * g;
#if ALL_FUSED
                        u32x2 w; w.x = cvt_pk_bf16(v[0], v[1]); w.y = cvt_pk_bf16(v[2], v[3]); *(u32x2*)((bf16*)mp + o) = w;
#else
                        *(f32x4*)(mp + o) = v;
#endif
                    }
            }
    }
};
struct EpiMerged {
    static constexpr bool PERM = true, AFTER_DRAIN = false;
    const bf16* sgl; const float* mp; bf16* merged;
    __device__ __forceinline__ void operator()(const f32x4 (&acc)[2][2][4][2], const Unit& u, int wr, int wc, int fr, int fq) const {
        { const int t_ = fresh_lane(); fr = t_ & 15; fq = t_ >> 4; }
        const int row0 = u.pm * 256 + wr * 64 + fr, col0 = u.pn * 256 + wc * 32 + 8 * fq;
#pragma unroll
        for (int ai = 0; ai < 2; ++ai)
#pragma unroll
            for (int m = 0; m < 4; ++m) {
                const size_t off = (size_t)(row0 + ai * 128 + m * 16) * 1024 + col0;
#pragma unroll
                for (int bj = 0; bj < 2; ++bj) {
                    const size_t o = off + bj * 128; const u32x4 gw = *(const u32x4*)(sgl + o);
#if ALL_FUSED
                    const u32x4 mw = *(const u32x4*)((const bf16*)mp + o); const f32x4 m0 = bf4_lo((u32x2){mw.x, mw.y}), m1 = bf4_lo((u32x2){mw.z, mw.w});
#else
                    const f32x4 m0 = *(const f32x4*)(mp + o), m1 = *(const f32x4*)(mp + o + 4);
#endif
                    const f32x4 v0 = m0 + acc[ai][bj][m][0] * bf4_lo((u32x2){gw.x, gw.y}), v1 = m1 + acc[ai][bj][m][1] * bf4_lo((u32x2){gw.z, gw.w});
                    *(u32x4*)(merged + o) = pack8(v0, v1);
                }
            }
    }
};
struct EpiH1 {
    static constexpr bool PERM = true, AFTER_DRAIN = false;
    const float* x; float* h1; bf16* h1b; float* part;
    __device__ __forceinline__ void operator()(const f32x4 (&acc)[2][2][4][2], const Unit& u, int wr, int wc, int fr, int fq) const {
        { const int t_ = fresh_lane(); fr = t_ & 15; fq = t_ >> 4; }
        const int row0 = u.pm * 256 + wr * 64 + fr, col0 = u.pn * 256 + wc * 32 + 8 * fq;
#pragma unroll
        for (int ai = 0; ai < 2; ++ai)
#pragma unroll
            for (int m = 0; m < 4; ++m) {
                const int r = row0 + ai * 128 + m * 16; const size_t off = (size_t)r * 1024 + col0; float sq = 0.f;
#pragma unroll
                for (int bj = 0; bj < 2; ++bj) {
                    const size_t o = off + bj * 128;
                    const f32x4 v0 = *(const f32x4*)(x + o) + acc[ai][bj][m][0], v1 = *(const f32x4*)(x + o + 4) + acc[ai][bj][m][1];
#if !ALL_FUSED
                    *(f32x4*)(h1 + o) = v0; *(f32x4*)(h1 + o + 4) = v1;
#endif
                    *(u32x4*)(h1b + o) = pack8(v0, v1);
                    sq += (v0[0] * v0[0] + v0[1] * v0[1]) + (v0[2] * v0[2] + v0[3] * v0[3]) + (v1[0] * v1[0] + v1[1] * v1[1]) + (v1[2] * v1[2] + v1[3] * v1[3]);
                }
                sq += __shfl_xor(sq, 16); sq += __shfl_xor(sq, 32);
                if (fq == 0) part[(size_t)r * 16 + u.pn * 4 + wc] = sq;
            }
    }
};
struct EpiScore {
    static constexpr bool PERM = false, AFTER_DRAIN = false;
    const float* part; float* sc;
    __device__ __forceinline__ void operator()(const f32x4 (&acc)[2][2][4][2], const Unit& u, int wr, int wc, int fr, int fq) const {
        { const int t_ = fresh_lane(); fr = t_ & 15; fq = t_ >> 4; }
        const int row0 = u.pm * 256 + wr * 64 + fr, col0 = u.pn * 256 + wc * 32 + 4 * fq;
#pragma unroll
        for (int ai = 0; ai < 2; ++ai)
#pragma unroll
            for (int m = 0; m < 4; ++m) {
                const int r = row0 + ai * 128 + m * 16; const f32x4* pp = (const f32x4*)(part + (size_t)r * 16);
                const f32x4 s4 = (pp[0] + pp[1]) + (pp[2] + pp[3]); const float rs = 1.0f / sqrtf(((s4[0] + s4[1]) + (s4[2] + s4[3])) * (1.0f / 1024.0f) + EPS);
                const size_t off = (size_t)r * 1024 + col0;
#pragma unroll
                for (int bj = 0; bj < 2; ++bj)
#pragma unroll
                    for (int n = 0; n < 2; ++n) *(f32x4*)(sc + off + bj * 128 + n * 16) = acc[ai][bj][m][n] * rs;
            }
    }
};
typedef float f32x16 __attribute__((ext_vector_type(16)));
typedef unsigned u32x6t __attribute__((ext_vector_type(6)));
__device__ __forceinline__ unsigned enc_e2m3(float x) {
    const float a = fabsf(x);
    const float m = a < 2.0f ? 8.0f : (a < 4.0f ? 4.0f : 2.0f); const int off = a < 2.0f ? 0 : (a < 4.0f ? 8 : 16);
    int code = (int)__builtin_rintf(a * m) + off; code = code > 31 ? 31 : code;
    return (unsigned)code | (x < 0.f ? 32u : 0u);
}
__device__ __forceinline__ void uv_convert(const float* pu, const float* pv, const float* gffn, unsigned char* u8, unsigned char* v8, float* iu, float* iv, int gw, int NGW, int lane) {
    f32x4 g[4];
#pragma unroll
    for (int j = 0; j < 4; ++j) g[j] = ((const f32x4*)gffn)[4 * lane + j];
    for (int e0 = gw; e0 < 2 * 16384; e0 += 2 * NGW) {
        f32x4 v[2][4]; float sc[2];
        const bool isv = e0 >= 16384; const bool two = e0 + NGW < 2 * 16384;
#pragma unroll
        for (int h = 0; h < 2; ++h) { const int e = (h && !two) ? e0 : e0 + h * NGW; const int row = isv ? e - 16384 : e;
            const f32x4* src = (const f32x4*)((isv ? pv : pu) + (size_t)row * 1024) + 4 * lane;
#pragma unroll
            for (int j = 0; j < 4; ++j) v[h][j] = src[j]; }
#pragma unroll
        for (int h = 0; h < 2; ++h) {
            float am = 0.f;
#pragma unroll
            for (int j = 0; j < 4; ++j) { if (!isv) v[h][j] = v[h][j] * g[j]; am = fmaxf(am, fmaxf(fmaxf(fabsf(v[h][j][0]), fabsf(v[h][j][1])), fmaxf(fabsf(v[h][j][2]), fabsf(v[h][j][3])))); }
            am = wave_max_x(am);
            sc[h] = am > 0.f ? (isv ? (V_FP6 ? 7.5f : 416.0f) : 127.0f) / am : 1.0f;
        }
#if V_FP6
        if (isv) {
            f32x16 x0, x1;
#pragma unroll
            for (int j = 0; j < 4; ++j)
#pragma unroll
                for (int c = 0; c < 4; ++c) { const int i = 4 * j + c; const float a = v[0][j][c] * sc[0], b = v[1][j][c] * sc[1];
                    if (i & 1) { x1[i >> 1] = a; x1[8 + (i >> 1)] = b; } else { x0[i >> 1] = a; x0[8 + (i >> 1)] = b; } }
            const u32x6t pk = __builtin_amdgcn_cvt_scalef32_2xpk16_fp6_f32(x0, x1, 1.0f);
            const int r0 = e0 - 16384, r1 = two ? e0 + NGW - 16384 : r0;
            *(u32x3*)(v8 + (size_t)r0 * 768 + 12 * lane) = (u32x3){pk[0], pk[1], pk[2]};
            if (two) *(u32x3*)(v8 + (size_t)r1 * 768 + 12 * lane) = (u32x3){pk[3], pk[4], pk[5]};
            if (lane == 0) { iv[r0] = 1.0f / sc[0]; if (two) iv[r1] = 1.0f / sc[1]; }
            continue;
        }
#endif
#pragma unroll
        for (int h = 0; h < 2; ++h) {
            if (h && !two) break;
            const int e = e0 + h * NGW; const int row = isv ? e - 16384 : e;
            u32x4 w;
            if (isv) {
#pragma unroll
                for (int j = 0; j < 4; ++j) { unsigned ww = 0u; ww = __builtin_amdgcn_cvt_pk_fp8_f32(v[h][j][0] * sc[h], v[h][j][1] * sc[h], ww, false); ww = __builtin_amdgcn_cvt_pk_fp8_f32(v[h][j][2] * sc[h], v[h][j][3] * sc[h], ww, true); w[j] = ww; }
            } else {
#pragma unroll
                for (int j = 0; j < 4; ++j) { unsigned ww = 0u;
#pragma unroll
                    for (int c = 0; c < 4; ++c) ww |= ((unsigned)(int)__builtin_rintf(v[h][j][c] * sc[h]) & 0xffu) << (8 * c);
                    w[j] = ww; }
            }
            *(u32x4*)((isv ? v8 : u8) + (size_t)row * 1024 + 16 * lane) = w;
            if (lane == 0) (isv ? iv : iu)[row] = 1.0f / sc[h];
        }
    }
}
struct EpiTopk {
    static constexpr bool PERM = false, AFTER_DRAIN = true;
    const float* part; int* seli; float* selg;
    const float* pu; const float* pv; const float* gffn; unsigned char* u8; unsigned char* v8; float* iu; float* iv; int uvslot, uvn;
    __device__ __forceinline__ void fused(f32x4 (&acc)[2][2][4][2], const Unit& u, int wr, int wc, int fr, int fq, PG8_LAS unsigned char* lds, int wid, int lane) const {
        LAS float* L = (LAS float*)lds;
#pragma unroll
        for (int ai = 0; ai < 2; ++ai) {
            { const int t_ = fresh_lane(); fr = t_ & 15; fq = t_ >> 4; }
#pragma unroll
            for (int m = 0; m < 4; ++m) {
                const int rl = wr * 64 + m * 16 + fr, r = u.pm * 256 + ai * 128 + rl;
                const f32x4* pp = (const f32x4*)(part + (size_t)r * 16);
                const f32x4 s4 = (pp[0] + pp[1]) + (pp[2] + pp[3]); const float rs = 1.0f / sqrtf(((s4[0] + s4[1]) + (s4[2] + s4[3])) * (1.0f / 1024.0f) + EPS);
#pragma unroll
                for (int bj = 0; bj < 2; ++bj)
#pragma unroll
                    for (int n = 0; n < 2; ++n) *(LAS f32x4*)(L + (rl * 2 + bj) * TK_LSTRIDE + wc * 32 + 16 * n + 4 * fq) = acc[ai][bj][m][n] * rs;
            }
            asm volatile("s_waitcnt lgkmcnt(0)" ::: "memory"); __builtin_amdgcn_s_barrier(); asm volatile("" ::: "memory");
            const int tid = wid * 64 + fresh_lane();
            if (wid < 4) {
                const LAS float* my = L + tid * TK_LSTRIDE;
                unsigned a16[16];
#pragma unroll
                for (int g = 0; g < 8; ++g) {
                    unsigned t[16];
#pragma unroll
                    for (int q = 0; q < 4; ++q) {
                        const f32x4 v = *(const LAS f32x4*)(my + g * 16 + q * 4);
#pragma unroll
                        for (int c = 0; c < 4; ++c) { const int e = g * 16 + q * 4 + c; const float vc = v[c]; t[q * 4 + c] = (tk_f2key(vc) & ~127u) | (unsigned)(127 - e); }
                    }
                    tk_sort16(t);
                    if (g == 0) {
#pragma unroll
                        for (int i = 0; i < 16; ++i) a16[i] = t[i];
                    } else tk_merge16(a16, t);
                }
                {   u32x4 sb;
#pragma unroll
                    for (int c = 0; c < 4; ++c) sb[c] = (127u - (a16[4 * c] & 127u)) | ((127u - (a16[4 * c + 1] & 127u)) << 8) | ((127u - (a16[4 * c + 2] & 127u)) << 16) | ((127u - (a16[4 * c + 3] & 127u)) << 24);
                    *(LAS u32x4*)(L + tid * TK_LSTRIDE) = sb; }
                __builtin_amdgcn_sched_barrier(0);
                unsigned oth[16];
#pragma unroll
                for (int i = 0; i < 16; ++i) oth[i] = (unsigned)__shfl_xor((int)a16[i], 1);
                const bool odd = tid & 1;
                unsigned part[16]; tk_pair_partial(a16, oth, odd, part);
                {   unsigned po[16];
#pragma unroll
                    for (int i = 0; i < 16; ++i) po[i] = (unsigned)__shfl_xor((int)part[i], 1);
                    tk_merge16(part, po); }
                asm volatile("s_waitcnt lgkmcnt(0)" ::: "memory");
                const float mx = tk_key2f(part[0] & ~255u);
                float ex[16], sum = 0.f;
#pragma unroll
                for (int i = 0; i < 16; ++i) { ex[i] = __builtin_expf(tk_key2f(part[i] & ~255u) - mx); sum += ex[i]; }
                const float inv = 1.0f / sum;
                const LAS unsigned char* r1 = (const LAS unsigned char*)(L + (tid & ~1) * TK_LSTRIDE); const LAS unsigned char* r2 = r1 + TK_LSTRIDE * 4;
                const int tok = u.pm * 256 + ai * 128 + (tid >> 1);
                int* oi = seli + (size_t)tok * 128 + u.pn * 16 + (odd ? 8 : 0); float* og = selg + (size_t)tok * 128 + u.pn * 16 + (odd ? 8 : 0);
                int ei[8]; float eg[8];
#pragma unroll
                for (int i = 0; i < 8; ++i) { unsigned ka = part[i], kb = part[i + 8]; float xa = ex[i], xb = ex[i + 8]; asm volatile("" : "+v"(ka), "+v"(kb), "+v"(xa), "+v"(xb));
                    const unsigned key = odd ? kb : ka; int i1, i2; tk_decode(key, i1, i2);
                    ei[i] = (int)r1[i1] * 128 + (int)r2[i2]; eg[i] = (odd ? xb : xa) * inv; }
                *(i32x4v*)oi = (i32x4v){ei[0], ei[1], ei[2], ei[3]}; *(i32x4v*)(oi + 4) = (i32x4v){ei[4], ei[5], ei[6], ei[7]};
                *(f32x4*)og = (f32x4){eg[0], eg[1], eg[2], eg[3]}; *(f32x4*)(og + 4) = (f32x4){eg[4], eg[5], eg[6], eg[7]};
            } else if (uvn > 0) uv_convert(pu, pv, gffn, u8, v8, iu, iv, uvslot + 4 * ai + (wid - 4), uvn, fresh_lane());
            asm volatile("s_waitcnt lgkmcnt(0)" ::: "memory"); __builtin_amdgcn_s_barrier(); asm volatile("" ::: "memory");
        }
    }
};
struct EpiPP {
    static constexpr bool PERM = true, AFTER_DRAIN = false;
    bf16* pp;
    __device__ __forceinline__ void operator()(const f32x4 (&acc)[2][2][4][2], const Unit& u, int wr, int wc, int fr, int fq) const {
        { const int t_ = fresh_lane(); fr = t_ & 15; fq = t_ >> 4; }
        const int row0 = u.pm * 256 + wr * 64 + fr, col0 = u.pn * 256 + wc * 32 + 8 * fq;
#pragma unroll
        for (int ai = 0; ai < 2; ++ai)
#pragma unroll
            for (int m = 0; m < 4; ++m) {
                const size_t off = (size_t)(row0 + ai * 128 + m * 16) * 1024 + col0;
#pragma unroll
                for (int bj = 0; bj < 2; ++bj) *(u32x4*)(pp + off + bj * 128) = pack8(acc[ai][bj][m][0], acc[ai][bj][m][1]);
            }
    }
};
struct EpiH3 {
    static constexpr bool PERM = true, AFTER_DRAIN = false;
    const float* rstd3; const bf16* pp; float* h; float* part; const bf16* h2b; bf16* h3b;
    __device__ __forceinline__ void operator()(const f32x4 (&acc)[2][2][4][2], const Unit& u, int wr, int wc, int fr, int fq) const {
        { const int t_ = fresh_lane(); fr = t_ & 15; fq = t_ >> 4; }
        const int row0 = u.pm * 256 + wr * 64 + fr, col0 = u.pn * 256 + wc * 32 + 8 * fq;
#pragma unroll
        for (int ai = 0; ai < 2; ++ai)
#pragma unroll
            for (int m = 0; m < 4; ++m) {
                const int r = row0 + ai * 128 + m * 16; const size_t off = (size_t)r * 1024 + col0; const float rs = rstd3[r]; float sq = 0.f;
#pragma unroll
                for (int bj = 0; bj < 2; ++bj) {
                    const size_t o = off + bj * 128; const u32x4 pw = *(const u32x4*)(pp + o);
#if ALL_FUSED
                    const u32x4 hw = *(const u32x4*)(h2b + o);
                    const f32x4 v0 = bf4_lo((u32x2){hw.x, hw.y}) + sig4(acc[ai][bj][m][0] * rs) * bf4_lo((u32x2){pw.x, pw.y});
                    const f32x4 v1 = bf4_lo((u32x2){hw.z, hw.w}) + sig4(acc[ai][bj][m][1] * rs) * bf4_lo((u32x2){pw.z, pw.w});
                    *(u32x4*)(h3b + o) = pack8(v0, v1);
#else
                    const f32x4 v0 = *(const f32x4*)(h + o) + sig4(acc[ai][bj][m][0] * rs) * bf4_lo((u32x2){pw.x, pw.y});
                    const f32x4 v1 = *(const f32x4*)(h + o + 4) + sig4(acc[ai][bj][m][1] * rs) * bf4_lo((u32x2){pw.z, pw.w});
                    *(f32x4*)(h + o) = v0; *(f32x4*)(h + o + 4) = v1;
#endif
                    sq += (v0[0] * v0[0] + v0[1] * v0[1]) + (v0[2] * v0[2] + v0[3] * v0[3]) + (v1[0] * v1[0] + v1[1] * v1[1]) + (v1[2] * v1[2] + v1[3] * v1[3]);
                }
                sq += __shfl_xor(sq, 16); sq += __shfl_xor(sq, 32);
                if (fq == 0) part[(size_t)r * 16 + u.pn * 4 + wc] = sq;
            }
    }
};
struct EpiPre {
    static constexpr bool PERM = false, AFTER_DRAIN = false;
    float* rp; float* ip;
    __device__ __forceinline__ void operator()(const f32x4 (&acc)[2][2][4][2], const Unit& u, int wr, int wc, int fr, int fq) const {
        { const int t_ = fresh_lane(); fr = t_ & 15; fq = t_ >> 4; }
#pragma unroll
        for (int n = 0; n < 2; ++n) { const int ch = u.pn * 128 + wc * 32 + 16 * n + 4 * fq;
#pragma unroll
            for (int ai = 0; ai < 2; ++ai)
#pragma unroll
                for (int m = 0; m < 4; ++m) { const int r = u.pm * 256 + ai * 128 + wr * 64 + m * 16 + fr; const size_t o = (size_t)r * 1024 + ch; *(f32x4*)(rp + o) = acc[ai][0][m][n]; *(f32x4*)(ip + o) = acc[ai][1][m][n]; } }
    }
};
struct EpiH3Final {
    static constexpr bool PERM = true, AFTER_DRAIN = false;
    const float* rstd3; const bf16* pp; const bf16* h2b; const float* fg; float* out; float* part; unsigned* cnt;
    __device__ __forceinline__ void operator()(f32x4 (&acc)[2][2][4][2], const Unit& u, int wr, int wc, int fr, int fq) const {
        { const int t_ = fresh_lane(); fr = t_ & 15; fq = t_ >> 4; }
        const int row0 = u.pm * 256 + wr * 64 + fr, col0 = u.pn * 256 + wc * 32 + 8 * fq;
#pragma unroll
        for (int ai = 0; ai < 2; ++ai)
#pragma unroll
            for (int m = 0; m < 4; ++m) {
                const int r = row0 + ai * 128 + m * 16; const size_t off = (size_t)r * 1024 + col0; const float rs = rstd3[r]; float sq = 0.f;
#pragma unroll
                for (int bj = 0; bj < 2; ++bj) {
                    const size_t o = off + bj * 128; const u32x4 pw = *(const u32x4*)(pp + o); const u32x4 hw = *(const u32x4*)(h2b + o);
                    const f32x4 v0 = bf4_lo((u32x2){hw.x, hw.y}) + sig4(acc[ai][bj][m][0] * rs) * bf4_lo((u32x2){pw.x, pw.y});
                    const f32x4 v1 = bf4_lo((u32x2){hw.z, hw.w}) + sig4(acc[ai][bj][m][1] * rs) * bf4_lo((u32x2){pw.z, pw.w});
                    acc[ai][bj][m][0] = v0; acc[ai][bj][m][1] = v1;
                    sq += (v0[0] * v0[0] + v0[1] * v0[1]) + (v0[2] * v0[2] + v0[3] * v0[3]) + (v1[0] * v1[0] + v1[1] * v1[1]) + (v1[2] * v1[2] + v1[3] * v1[3]);
                }
                sq += __shfl_xor(sq, 16); sq += __shfl_xor(sq, 32);
                if (fq == 0) __hip_atomic_store(part + (size_t)r * 16 + u.pn * 4 + wc, sq, __ATOMIC_RELAXED, __HIP_MEMORY_SCOPE_AGENT);
            }
        asm volatile("s_waitcnt vmcnt(0)" ::: "memory");
        const int lane = fq * 16 + fr;
        unsigned* c = cnt + 64 * u.pm;
        if (lane == 0) __hip_atomic_fetch_add(c, 1u, __ATOMIC_RELAXED, __HIP_MEMORY_SCOPE_AGENT);
        {
            const unsigned long long t0 = __builtin_amdgcn_s_memrealtime();
            while ((unsigned)__builtin_amdgcn_readfirstlane((int)__hip_atomic_load(c, __ATOMIC_RELAXED, __HIP_MEMORY_SCOPE_AGENT)) < 32u) {
                if (__builtin_amdgcn_s_memrealtime() - t0 > 2000000ull) break;
                __builtin_amdgcn_s_sleep(2);
            }
        }
        { const int t_ = fresh_lane(); fr = t_ & 15; fq = t_ >> 4; }
#pragma unroll
        for (int ai = 0; ai < 2; ++ai)
#pragma unroll
            for (int m = 0; m < 4; ++m) {
                const int r = u.pm * 256 + wr * 64 + fr + ai * 128 + m * 16;
                float ps = 0.f;
#pragma unroll
                for (int k = 0; k < 16; ++k) ps += __hip_atomic_load(part + (size_t)r * 16 + k, __ATOMIC_RELAXED, __HIP_MEMORY_SCOPE_AGENT);
                const float rr = 1.0f / sqrtf(ps * (1.0f / 1024.0f) + EPS);
                const int cc = u.pn * 256 + wc * 32 + 8 * fq;
#pragma unroll
                for (int bj = 0; bj < 2; ++bj) {
                    const f32x4 g0 = *(const f32x4*)(fg + cc + bj * 128), g1 = *(const f32x4*)(fg + cc + bj * 128 + 4);
                    float* op = out + (size_t)r * 1024 + cc + bj * 128;
                    *(f32x4*)op = acc[ai][bj][m][0] * rr * g0; *(f32x4*)(op + 4) = acc[ai][bj][m][1] * rr * g1;
                }
            }
    }
};
template <int CTRL> __device__ __forceinline__ float dpp_f(float oldv, float src) {
    return __builtin_bit_cast(float, __builtin_amdgcn_update_dpp(__builtin_bit_cast(int, oldv), __builtin_bit_cast(int, src), CTRL, 0xf, 0xf, false));
}
#ifndef LRU_T2
#define LRU_T2 0
#endif
struct EpiLru {
    static constexpr bool PERM = false, AFTER_DRAIN = false;
    const bf16* lin; const float* ba; const float* bx; const float* c8l; bf16* hloc; bf16* pcum; float* agg; const bf16* gl; bf16* rec; unsigned* flg; LAS unsigned char* xl;
    template <int SH> static __device__ __forceinline__ void step(f32x4& A, f32x4& Bv, float idd) {
#pragma unroll
        for (int j = 0; j < 4; ++j) {
            const float ap = __int_as_float(__builtin_amdgcn_update_dpp(0, __float_as_int((float)A[j]), 0x110 + SH, 0xf, 0xf, true)) + idd;
            const float bp = __int_as_float(__builtin_amdgcn_update_dpp(0, __float_as_int((float)Bv[j]), 0x110 + SH, 0xf, 0xf, true));
            Bv[j] = fmaf(A[j], bp, Bv[j]); A[j] = A[j] * ap; }
    }
    __device__ __forceinline__ void operator()(f32x4 (&acc)[2][2][4][2], const Unit& u, int wr, int wc, int fr, int fq) const {
        { const int t_ = fresh_lane(); fr = t_ & 15; fq = t_ >> 4; }
        const int lane = fq * 16 + fr;
#pragma unroll
        for (int n = 0; n < 2; ++n) {
            const int ch = u.pn * 128 + wc * 32 + 16 * n + 4 * fq;
            const f32x4 bav = *(const f32x4*)(ba + ch), bxv = *(const f32x4*)(bx + ch), cv = *(const f32x4*)(c8l + ch);
#pragma unroll
            for (int ai = 0; ai < 2; ++ai)
#pragma unroll
                for (int m = 0; m < 4; ++m) {
                    const int r = u.pm * 256 + ai * 128 + wr * 64 + m * 16 + fr; const unsigned o = (unsigned)r * 1024u + (unsigned)ch;
                    const f32x4 lv = bf4_lo(*(const u32x2*)(lin + o));
#pragma unroll
                    for (int j = 0; j < 4; ++j) {
                        const float rr = sigmoidf_(acc[ai][0][m][n][j] + bav[j]), ii = sigmoidf_(acc[ai][1][m][n][j] + bxv[j]);
                        const float a = __builtin_amdgcn_exp2f(cv[j] * rr);
                        acc[ai][0][m][n][j] = a; acc[ai][1][m][n][j] = __builtin_amdgcn_sqrtf(fmaxf(1.0f - a * a, 0.f)) * (ii * lv[j]);
                    }
                    asm volatile("" : "+v"(acc[ai][0][m][n]), "+v"(acc[ai][1][m][n]));
                }
        }
#if defined(LRU_DEBUG) && LRU_DEBUG == 1
        {
            float* af = (float*)hloc; float* bf = (float*)pcum;
#pragma unroll
            for (int n = 0; n < 2; ++n) { const int ch = u.pn * 128 + wc * 32 + 16 * n + 4 * fq;
#pragma unroll
                for (int ai = 0; ai < 2; ++ai)
#pragma unroll
                    for (int m = 0; m < 4; ++m) { const int r = u.pm * 256 + ai * 128 + wr * 64 + m * 16 + fr; const size_t o = (size_t)r * 1024 + ch; *(f32x4*)(af + o) = acc[ai][0][m][n]; *(f32x4*)(bf + o) = acc[ai][1][m][n]; } }
            return;
        }
#endif
        __builtin_amdgcn_sched_barrier(0);
        const float id1 = fr < 1 ? 1.f : 0.f, id2 = fr < 2 ? 1.f : 0.f, id4 = fr < 4 ? 1.f : 0.f, id8 = fr < 8 ? 1.f : 0.f;
#pragma unroll
        for (int ai = 0; ai < 2; ++ai)
#pragma unroll
            for (int m = 0; m < 4; ++m)
#pragma unroll
                for (int n = 0; n < 2; ++n) { step<1>(acc[ai][0][m][n], acc[ai][1][m][n], id1); step<2>(acc[ai][0][m][n], acc[ai][1][m][n], id2); step<4>(acc[ai][0][m][n], acc[ai][1][m][n], id4); step<8>(acc[ai][0][m][n], acc[ai][1][m][n], id8);
                    asm volatile("" : "+v"(acc[ai][0][m][n]), "+v"(acc[ai][1][m][n])); }
#if LRU_LOOKBACK
        { const int t_ = fresh_lane(); fr = t_ & 15; fq = t_ >> 4; }
        const int src4 = (((fq * 16 + fr) & 48) | 15) * 4;
        LAS float* XL = (LAS float*)xl;
        const int cl = wc * 32 + 4 * fq;
#pragma unroll
        for (int n = 0; n < 2; ++n)
#pragma unroll
            for (int ai = 0; ai < 2; ++ai) {
#pragma unroll
                for (int m = 1; m < 4; ++m) {
                    f32x4& A = acc[ai][0][m][n]; f32x4& Bv = acc[ai][1][m][n];
#pragma unroll
                    for (int j = 0; j < 4; ++j) { const float pa = acc[ai][0][m - 1][n][j], pb = acc[ai][1][m - 1][n][j];
                        const float ac = __int_as_float(__builtin_amdgcn_ds_bpermute(src4, __float_as_int(pa))), bc = __int_as_float(__builtin_amdgcn_ds_bpermute(src4, __float_as_int(pb))); Bv[j] = fmaf(A[j], bc, Bv[j]); A[j] = A[j] * ac; }
                }
                if (fr == 15) {
                    const f32x4 A = acc[ai][0][3][n], Bv = acc[ai][1][3][n];
                    LAS f32x4* xp = (LAS f32x4*)(XL + ((ai * 2 + wr) * 128 + cl + 16 * n) * 2);
                    xp[0] = (f32x4){A[0], Bv[0], A[1], Bv[1]}; xp[1] = (f32x4){A[2], Bv[2], A[3], Bv[3]};
                }
                asm volatile("" : "+v"(acc[ai][0][1][n]), "+v"(acc[ai][1][1][n]), "+v"(acc[ai][0][2][n]), "+v"(acc[ai][1][2][n]), "+v"(acc[ai][0][3][n]), "+v"(acc[ai][1][3][n]));
            }
        asm volatile("s_waitcnt lgkmcnt(0)" ::: "memory"); __builtin_amdgcn_s_barrier(); asm volatile("" ::: "memory");
        const int grp = u.pn * 4 + wc;
        if (wr == 0) {
            if (fr == 15) {
#pragma unroll
                for (int n = 0; n < 2; ++n) {
                    f32x4 At, Bt;
#pragma unroll
                    for (int k = 0; k < 4; ++k) { const LAS f32x4* xp = (const LAS f32x4*)(XL + (k * 128 + cl + 16 * n) * 2); const f32x4 v0 = xp[0], v1 = xp[1];
                        const float Ak[4] = {v0[0], v0[2], v1[0], v1[2]}, Bk[4] = {v0[1], v0[3], v1[1], v1[3]};
#pragma unroll
                        for (int j = 0; j < 4; ++j) { if (k == 0) { At[j] = Ak[j]; Bt[j] = Bk[j]; } else { Bt[j] = fmaf(Ak[j], Bt[j], Bk[j]); At[j] = Ak[j] * At[j]; } } }
                    unsigned long long* ap = (unsigned long long*)(agg + ((size_t)u.pm * 1024 + u.pn * 128 + cl + 16 * n) * 2);
#pragma unroll
                    for (int j = 0; j < 4; ++j) { const float aj = At[j], bj = Bt[j]; __hip_atomic_store(ap + j, (unsigned long long)__float_as_uint(aj) | ((unsigned long long)__float_as_uint(bj) << 32), __ATOMIC_RELAXED, __HIP_MEMORY_SCOPE_AGENT); }
                }
            }
            asm volatile("s_waitcnt vmcnt(0)" ::: "memory");
            if (fq * 16 + fr == 0) __hip_atomic_store(flg + (size_t)u.pm * 32 + grp, 1u, __ATOMIC_RELAXED, __HIP_MEMORY_SCOPE_AGENT);
        }
        f32x4 hin[2][2];
        {
            const int pi = u.pm & 7, pbase = u.pm & ~7;
            { const int l = fq * 16 + fr; const unsigned* fp = flg + (size_t)(pbase + (l < pi ? l : 0)) * 32 + grp;
              int spins = 0; bool ok;
              do { const unsigned f = (l < pi) ? __hip_atomic_load(fp, __ATOMIC_RELAXED, __HIP_MEMORY_SCOPE_AGENT) : 1u; ok = __builtin_amdgcn_ballot_w64(f == 0u) == 0ull; if (!ok) __builtin_amdgcn_s_sleep(2); } while (!ok && ++spins < (1 << 22)); }
            asm volatile("s_waitcnt vmcnt(0)" ::: "memory");
            const float i1 = fr < 1 ? 1.f : 0.f, i2 = fr < 2 ? 1.f : 0.f, i4 = fr < 4 ? 1.f : 0.f, i8 = fr < 8 ? 1.f : 0.f;
            const bool kp = fr < pi;
#pragma unroll
            for (int n = 0; n < 2; ++n) {
                const unsigned long long* a0 = (const unsigned long long*)(agg + ((size_t)(pbase + (kp ? fr : 0)) * 1024 + u.pn * 128 + cl + 16 * n) * 2);
                f32x4 A, Bv;
#pragma unroll
                for (int j = 0; j < 4; ++j) { const unsigned long long w0 = __hip_atomic_load(a0 + j, __ATOMIC_RELAXED, __HIP_MEMORY_SCOPE_AGENT);
                    A[j] = kp ? __uint_as_float((unsigned)w0) : 1.f; Bv[j] = kp ? __uint_as_float((unsigned)(w0 >> 32)) : 0.f; }
                step<1>(A, Bv, i1); step<2>(A, Bv, i2); step<4>(A, Bv, i4); step<8>(A, Bv, i8);
                f32x4 hp;
#pragma unroll
                for (int j = 0; j < 4; ++j) { const float bt = Bv[j]; hp[j] = __int_as_float(__builtin_amdgcn_ds_bpermute(src4, __float_as_int(bt))); }
                f32x4 h = hp;
#pragma unroll
                for (int k = 0; k < 4; ++k) {
                    if (k == wr) hin[0][n] = h;
                    if (k == 2 + wr) hin[1][n] = h;
                    if (k < 3) { const LAS f32x4* xp = (const LAS f32x4*)(XL + (k * 128 + cl + 16 * n) * 2); const f32x4 v0 = xp[0], v1 = xp[1];
                        h = (f32x4){fmaf(v0[0], h[0], v0[1]), fmaf(v0[2], h[1], v0[3]), fmaf(v1[0], h[2], v1[1]), fmaf(v1[2], h[3], v1[3])}; }
                }
            }
        }
        asm volatile("s_waitcnt lgkmcnt(0)" ::: "memory"); __builtin_amdgcn_s_barrier(); asm volatile("" ::: "memory");
        { const int t_ = fresh_lane(); fr = t_ & 15; fq = t_ >> 4; }
#pragma unroll
        for (int n = 0; n < 2; ++n) {
            const int ch = u.pn * 128 + wc * 32 + 16 * n + 4 * fq;
#pragma unroll
            for (int ai = 0; ai < 2; ++ai) {
#pragma unroll
                for (int m = 0; m < 4; ++m) {
                    const int r = u.pm * 256 + ai * 128 + wr * 64 + m * 16 + fr; const unsigned o = (unsigned)r * 1024u + (unsigned)ch;
                    const f32x4 g = bf4_lo(*(const u32x2*)(gl + o));
                    const f32x4 A = acc[ai][0][m][n], Bv = acc[ai][1][m][n];
                    u32x2 w; w.x = cvt_pk_bf16(fmaf(A[0], hin[ai][n][0], Bv[0]) * g[0], fmaf(A[1], hin[ai][n][1], Bv[1]) * g[1]); w.y = cvt_pk_bf16(fmaf(A[2], hin[ai][n][2], Bv[2]) * g[2], fmaf(A[3], hin[ai][n][3], Bv[3]) * g[3]);
                    *(u32x2*)(rec + o) = w;
                }
                __builtin_amdgcn_sched_barrier(0);
            }
        }
#else
        { const int t_ = fresh_lane(); fr = t_ & 15; fq = t_ >> 4; }
        const int src4 = (((fq * 16 + fr) & 48) | 15) * 4;
#pragma unroll
        for (int n = 0; n < 2; ++n) {
            const int ch = u.pn * 128 + wc * 32 + 16 * n + 4 * fq;
#pragma unroll
            for (int ai = 0; ai < 2; ++ai) {
#pragma unroll
                for (int m = 0; m < 4; ++m) {
                    f32x4& A = acc[ai][0][m][n]; f32x4& Bv = acc[ai][1][m][n];
                    if (m > 0 && !(LRU_T2)) {
#pragma unroll
                        for (int j = 0; j < 4; ++j) { const float pa = acc[ai][0][m - 1][n][j], pb = acc[ai][1][m - 1][n][j];
                            const float ac = __int_as_float(__builtin_amdgcn_ds_bpermute(src4, __float_as_int(pa))), bc = __int_as_float(__builtin_amdgcn_ds_bpermute(src4, __float_as_int(pb))); Bv[j] = fmaf(A[j], bc, Bv[j]); A[j] = A[j] * ac; }
                    }
                    const int r = u.pm * 256 + ai * 128 + wr * 64 + m * 16 + fr; const unsigned o = (unsigned)r * 1024u + (unsigned)ch;
                    u32x2 wp, wh; wp.x = cvt_pk_bf16(A[0], A[1]); wp.y = cvt_pk_bf16(A[2], A[3]); wh.x = cvt_pk_bf16(Bv[0], Bv[1]); wh.y = cvt_pk_bf16(Bv[2], Bv[3]);
                    *(u32x2*)(pcum + o) = wp; *(u32x2*)(hloc + o) = wh;
                    if (m == 3 && fr == 15) {
                        const int chunk = u.pm * 4 + ai * 2 + wr; float* ap = agg + ((size_t)chunk * 1024 + ch) * 2;
                        *(f32x4*)(ap) = (f32x4){A[0], Bv[0], A[1], Bv[1]}; *(f32x4*)(ap + 4) = (f32x4){A[2], Bv[2], A[3], Bv[3]};
                    }
                    __builtin_amdgcn_sched_barrier(0);
                }
            }
        }
#endif
    }
};

__device__ __forceinline__ void p0_transpose_item(const float* W, int ldw, const float* gain, bf16* WT, int ldt, int k_off, LAS float* scr, int kb, int nb, int lane) {
    const int k0 = 64 * kb, n0 = 32 * nb;
    const int c4 = lane & 7, kr = lane >> 3;
    f32x4 v[8];
#pragma unroll
    for (int i = 0; i < 8; ++i) v[i] = *(const f32x4*)(W + (size_t)(k0 + 8 * i + kr) * ldw + n0 + 4 * c4);
#pragma unroll
    for (int i = 0; i < 8; ++i) { f32x4 x = v[i]; if (gain) x = x * gain[k0 + 8 * i + kr]; *(LAS f32x4*)(scr + (8 * i + kr) * 36 + 4 * c4) = x; }
    LDS_WAIT(); asm volatile("" ::: "memory");
    const int c = lane & 7;
#pragma unroll
    for (int j = 0; j < 4; ++j) { const int n = (lane >> 3) + 8 * j; const LAS float* sp = scr + (8 * c) * 36 + n;
        u32x4 o; o.x = pk2(sp[0 * 36], sp[1 * 36]); o.y = pk2(sp[2 * 36], sp[3 * 36]); o.z = pk2(sp[4 * 36], sp[5 * 36]); o.w = pk2(sp[6 * 36], sp[7 * 36]);
        *(u32x4*)(WT + (size_t)(n0 + n) * ldt + k_off + k0 + 8 * c) = o; }
    LDS_WAIT(); asm volatile("" ::: "memory");
}
__device__ __forceinline__ void p0_wfold_item(LAS float* lds, const float* wq, const float* k1, const float* k2, const float* gffn, bf16* wfold, int item, int tid) {
    const int hh = item >> 4, kb = item & 15;
    LAS float* wqs = lds; LAS float* kks = lds + 64 * 132;
    const float* ksrc = (hh & 1) ? k2 : k1;
#pragma unroll
    for (int i = 0; i < 4; ++i) { const int e = tid + i * 512, r = e >> 5, c4 = e & 31; *(LAS f32x4*)(wqs + r * 132 + 4 * c4) = *(const f32x4*)(wq + (size_t)(kb * 64 + r) * 2048 + hh * 128 + 4 * c4); }
#pragma unroll
    for (int i = 0; i < 8; ++i) { const int e = tid + i * 512, r = e >> 5, c4 = e & 31; *(LAS f32x4*)(kks + r * 132 + 4 * c4) = *(const f32x4*)(ksrc + (size_t)r * 128 + 4 * c4); }
    __syncthreads();
    const int tk = tid & 15, tkey = tid >> 4;
    float acc[4][4];
#pragma unroll
    for (int i = 0; i < 4; ++i)
#pragma unroll
        for (int j = 0; j < 4; ++j) acc[i][j] = 0.f;
#pragma unroll 2
    for (int c4 = 0; c4 < 32; ++c4) {
        f32x4 a[4], b[4];
#pragma unroll
        for (int i = 0; i < 4; ++i) { a[i] = *(const LAS f32x4*)(wqs + (tk * 4 + i) * 132 + 4 * c4); b[i] = *(const LAS f32x4*)(kks + (tkey * 4 + i) * 132 + 4 * c4); }
#pragma unroll
        for (int i = 0; i < 4; ++i)
#pragma unroll
            for (int j = 0; j < 4; ++j) acc[i][j] += (a[i][0] * b[j][0] + a[i][1] * b[j][1]) + (a[i][2] * b[j][2] + a[i][3] * b[j][3]);
    }
    const int kg = kb * 64 + tk * 4; const f32x4 gv = *(const f32x4*)(gffn + kg);
#pragma unroll
    for (int j = 0; j < 4; ++j) { u32x2 w; w.x = pk2(acc[0][j] * gv[0], acc[1][j] * gv[1]); w.y = pk2(acc[2][j] * gv[2], acc[3][j] * gv[3]);
        *(u32x2*)(wfold + (size_t)(hh * 128 + tkey * 4 + j) * 1024 + kg) = w; }
    __syncthreads();
}

struct In { const float* p[25]; };
enum { I_X = 0, I_P, I_GMIX, I_WIN, I_SINK, I_CONVW, I_CONVB, I_WA, I_BA, I_WX, I_BX, I_LAM, I_WUA, I_WUL, I_WO, I_GFFN, I_WQ, I_K1, I_K2, I_U, I_V, I_GPLE, I_WGATE, I_WPROJ, I_FG };

__device__ __forceinline__ void p0_prologue(const In& in, unsigned char* ws, LAS unsigned char* lds, int vcu, int G, int wave, int tid) {
    const int lane = tid & 63;
    LAS float* scr = (LAS float*)(lds + wave * 16384);
    const int gw = vcu * NWAVES + wave, NGW = G * NWAVES;
    constexpr int I_IN = 16 * 152, I_UA = 8 * 32, I_SQ = 16 * 32, I_PJ = 4 * 32, I_AX = 128;
    constexpr int NITEMS = I_IN + I_UA + 3 * I_SQ + I_PJ + I_AX;
    for (int it = gw; it < NITEMS; it += NGW) {
        int r = it;
        if (r < I_IN) { p0_transpose_item(in.p[I_WIN], INW, in.p[I_GMIX], (bf16*)(ws + WS_WIN), 1024, 0, scr, r / 152, r % 152, lane); continue; } r -= I_IN;
        if (r < I_UA) { p0_transpose_item(in.p[I_WUA], 1024, nullptr, (bf16*)(ws + WS_WUA), 512, 0, scr, r / 32, r % 32, lane); continue; } r -= I_UA;
        if (r < I_SQ) { p0_transpose_item(in.p[I_WUL], 1024, nullptr, (bf16*)(ws + WS_WUL), 1024, 0, scr, r / 32, r % 32, lane); continue; } r -= I_SQ;
        if (r < I_SQ) { p0_transpose_item(in.p[I_WO], 1024, nullptr, (bf16*)(ws + WS_WO), 1024, 0, scr, r / 32, r % 32, lane); continue; } r -= I_SQ;
        if (r < I_SQ) { p0_transpose_item(in.p[I_WGATE], 1024, in.p[I_GPLE], (bf16*)(ws + WS_WG), 1024, 0, scr, r / 32, r % 32, lane); continue; } r -= I_SQ;
        if (r < I_PJ) { p0_transpose_item(in.p[I_WPROJ], 1024, nullptr, (bf16*)(ws + WS_WPROJ), 256, 0, scr, r / 32, r % 32, lane); continue; } r -= I_PJ;
        { const int blk = r >> 4, which = (r >> 3) & 1, sub = r & 7;

#if LRU_PADDED
#if LRU_PADDED == 2
          p0_transpose_item(in.p[which ? I_WX : I_WA] + (size_t)blk * 16384, 128, nullptr, (bf16*)(ws + WS_WAX) + (size_t)blk * 32768 + which * 128 * 128, 128, 0, scr, sub >> 2, sub & 3, lane); }
#else
          p0_transpose_item(in.p[which ? I_WX : I_WA] + (size_t)blk * 16384, 128, nullptr, (bf16*)(ws + WS_WAX) + (size_t)blk * 65536 + which * 128 * 256, 256, (blk & 1) * 128, scr, sub >> 2, sub & 3, lane); }
#endif
#else
          p0_transpose_item(in.p[which ? I_WX : I_WA] + (size_t)blk * 16384, 128, nullptr, (bf16*)(ws + WS_WAXD) + (size_t)(blk * 256 + which * 128) * 1024, 1024, blk * 128, scr, sub >> 2, sub & 3, lane); }
#endif
    }
#if LRU_PADDED == 2
#elif LRU_PADDED
    for (int i = vcu * 512 + tid; i < 8 * 256 * 16; i += G * 512) { const int c16 = i & 15, n = (i >> 4) & 255, blk = i >> 12;
        *(u32x4*)((bf16*)(ws + WS_WAX) + (size_t)blk * 65536 + n * 256 + ((blk & 1) ^ 1) * 128 + c16 * 8) = (u32x4){0u, 0u, 0u, 0u}; }
#else
    for (int i = vcu * 512 + tid; i < 2048 * 128; i += G * 512) { const int c16 = i & 127, row = i >> 7, blk = row >> 8;
        if ((c16 >> 4) != blk) *(u32x4*)((bf16*)(ws + WS_WAXD) + (size_t)row * 1024 + c16 * 8) = (u32x4){0u, 0u, 0u, 0u}; }
#endif
    for (int m = gw; m < T_; m += 2 * NGW) {
        const int m2 = m + NGW;
        const f32x4* xa = (const f32x4*)(in.p[I_X] + (size_t)m * 1024) + lane; const f32x4* xb = (const f32x4*)(in.p[I_X] + (size_t)(m2 < T_ ? m2 : m) * 1024) + lane;
        f32x4 va[4], vb[4]; float sa = 0.f, sb = 0.f;
#pragma unroll
        for (int j = 0; j < 4; ++j) { va[j] = xa[64 * j]; vb[j] = xb[64 * j]; }
#pragma unroll
        for (int j = 0; j < 4; ++j) { sa += (va[j][0] * va[j][0] + va[j][1] * va[j][1]) + (va[j][2] * va[j][2] + va[j][3] * va[j][3]); sb += (vb[j][0] * vb[j][0] + vb[j][1] * vb[j][1]) + (vb[j][2] * vb[j][2] + vb[j][3] * vb[j][3]); }
#pragma unroll
        for (int o = 1; o < 64; o <<= 1) { sa += __shfl_xor(sa, o); sb += __shfl_xor(sb, o); }
        u32x2* oa = (u32x2*)((bf16*)(ws + WS_R0) + (size_t)m * 1024) + lane;
#pragma unroll
        for (int j = 0; j < 4; ++j) { u32x2 w; w.x = pk2(va[j][0], va[j][1]); w.y = pk2(va[j][2], va[j][3]); oa[64 * j] = w; }
        if (lane == 0) ((float*)(ws + WS_RSTD1))[m] = 1.0f / sqrtf(sa * (1.0f / 1024.0f) + EPS);
        if (m2 < T_) {
            u32x2* ob = (u32x2*)((bf16*)(ws + WS_R0) + (size_t)m2 * 1024) + lane;
#pragma unroll
            for (int j = 0; j < 4; ++j) { u32x2 w; w.x = pk2(vb[j][0], vb[j][1]); w.y = pk2(vb[j][2], vb[j][3]); ob[64 * j] = w; }
            if (lane == 0) ((float*)(ws + WS_RSTD1))[m2] = 1.0f / sqrtf(sb * (1.0f / 1024.0f) + EPS);
        }
    }
    for (int m = gw; m < T_; m += 4 * NGW) {
        f32x4 v[4];
#pragma unroll
        for (int q = 0; q < 4; ++q) { const int mq = m + q * NGW; v[q] = ((const f32x4*)(in.p[I_P] + (size_t)(mq < T_ ? mq : m) * 256))[lane]; }
#pragma unroll
        for (int q = 0; q < 4; ++q) { const int mq = m + q * NGW; if (mq < T_) { u32x2 w; w.x = pk2(v[q][0], v[q][1]); w.y = pk2(v[q][2], v[q][3]); ((u32x2*)((bf16*)(ws + WS_PB) + (size_t)mq * 256))[lane] = w; } }
    }
    if (vcu == 0) for (int c = tid; c < 1024; c += 512) ((float*)(ws + WS_C8))[c] = -8.0f * log1pf(expf(-in.p[I_LAM][c])) * LOG2E;
    __syncthreads();
    for (int it = vcu; it < 256; it += G) p0_wfold_item((LAS float*)lds, in.p[I_WQ], in.p[I_K1], in.p[I_K2], in.p[I_GFFN], (bf16*)(ws + WS_WFOLD), it, tid);
}

constexpr int AT_KSTR = 72, AT_VSTR = 260, AT_V_OFF = 256 * AT_KSTR * 2;
__device__ __forceinline__ int crow(int r, int hi) { return (r & 3) + 8 * (r >> 2) + 4 * hi; }
__device__ __forceinline__ void attn_item(LAS unsigned char* lds, const bf16* qkv, const float* sink, bf16* att, int item, int wave, int tid) {
    const int lane = tid & 63;
    const int g = item & 1, n = (item >> 1) & 15, b = item >> 5;
    const int t0 = b * S_ + n * 128;
    LAS bf16* Ks = (LAS bf16*)lds; LAS bf16* Vt = (LAS bf16*)(lds + AT_V_OFF);
#pragma unroll
    for (int i = 0; i < 4; ++i) {
        const int idx = tid + i * 512, row = idx >> 3, ch = idx & 7; const int tk = t0 - 128 + row;
        u32x4 kv = (u32x4){0u, 0u, 0u, 0u}, vv = (u32x4){0u, 0u, 0u, 0u};
        if (n > 0 || row >= 128) { const bf16* src = qkv + (size_t)tk * 768 + 512 + g * 64 + ch * 8; kv = *(const u32x4*)src; vv = *(const u32x4*)(src + 128); }
        *(LAS u32x4*)(Ks + row * AT_KSTR + ch * 8) = kv;
#pragma unroll
        for (int c = 0; c < 8; ++c) Vt[(ch * 8 + c) * AT_VSTR + row] = (bf16)(vv[c >> 1] >> (16 * (c & 1)));
    }
    __syncthreads();
    const int hr = wave >> 1, qh = wave & 1, head = g * 4 + hr;
    const float slope2 = exp2f(-(float)(head + 1)) * LOG2E, sink2 = sink[head] * LOG2E;
    const int q = lane & 31, hi = lane >> 5;
#pragma unroll 1
    for (int ps = 0; ps < 2; ++ps) {
        const int i0 = 64 * qh + 32 * ps, kb0 = i0;
        const bf16* qp = qkv + (size_t)(t0 + i0 + q) * 768 + head * 64 + 8 * hi;
        bf16x8 qf[4];
#pragma unroll
        for (int s = 0; s < 4; ++s) qf[s] = *(const bf16x8*)(qp + 16 * s);
        f32x16 oT[2];
#pragma unroll
        for (int dt = 0; dt < 2; ++dt)
#pragma unroll
            for (int r = 0; r < 16; ++r) oT[dt][r] = 0.f;
        float mrun = sink2, l = 0.f;
#pragma unroll 1
        for (int kt = 0; kt < 5; ++kt) {
            const int kbase = kb0 + 32 * kt;
            f32x16 sT;
#pragma unroll
            for (int r = 0; r < 16; ++r) sT[r] = 0.f;
#pragma unroll
            for (int s = 0; s < 4; ++s) { const bf16x8 kf = *(const LAS bf16x8*)(Ks + (kbase + q) * AT_KSTR + 16 * s + 8 * hi); sT = __builtin_amdgcn_mfma_f32_32x32x16_bf16(kf, qf[s], sT, 0, 0, 0); }
            float tm = -1.0e30f;
#pragma unroll
            for (int r = 0; r < 16; ++r) {
                const int kj = kbase + crow(r, hi); const int dist = i0 + q + 128 - kj;
                const bool valid = (dist >= 0) && (dist < 128) && (n > 0 || kj >= 128);
                const float v = valid ? (sT[r] * (0.125f * LOG2E) - slope2 * (float)dist) : -1.0e30f;
                sT[r] = v; tm = fmaxf(tm, v);
            }
            tm = fmaxf(tm, __shfl_xor(tm, 32));
            const float mnew = fmaxf(mrun, tm), alpha = __builtin_amdgcn_exp2f(mrun - mnew);
            mrun = mnew;
            float ls = 0.f;
#pragma unroll
            for (int r = 0; r < 16; ++r) { const float p = __builtin_amdgcn_exp2f(sT[r] - mnew); sT[r] = p; ls += p; }
            l = l * alpha + ls;
#pragma unroll
            for (int dt = 0; dt < 2; ++dt)
#pragma unroll
                for (int r = 0; r < 16; ++r) oT[dt][r] *= alpha;
#pragma unroll
            for (int s = 0; s < 2; ++s) {
                u32x4 pw; pw.x = cvt_pk_bf16(sT[8 * s + 0], sT[8 * s + 1]); pw.y = cvt_pk_bf16(sT[8 * s + 2], sT[8 * s + 3]);
                pw.z = cvt_pk_bf16(sT[8 * s + 4], sT[8 * s + 5]); pw.w = cvt_pk_bf16(sT[8 * s + 6], sT[8 * s + 7]);
                const bf16x8 pf = __builtin_bit_cast(bf16x8, pw);
#pragma unroll
                for (int dt = 0; dt < 2; ++dt) {
                    const LAS bf16* vp = Vt + (32 * dt + q) * AT_VSTR + kbase + 16 * s + 4 * hi;
                    const u32x2 va = *(const LAS u32x2*)vp, vb = *(const LAS u32x2*)(vp + 8);
                    const bf16x8 af = __builtin_bit_cast(bf16x8, (u32x4){va.x, va.y, vb.x, vb.y});
                    oT[dt] = __builtin_amdgcn_mfma_f32_32x32x16_bf16(af, pf, oT[dt], 0, 0, 0);
                }
            }
        }
        l += __shfl_xor(l, 32);
        l += __builtin_amdgcn_exp2f(sink2 - mrun);
        const float inv = 1.0f / l;
        bf16* op = att + (size_t)(t0 + i0 + q) * 512 + head * 64 + 4 * hi;
#pragma unroll
        for (int dt = 0; dt < 2; ++dt)
#pragma unroll
            for (int rg = 0; rg < 4; ++rg) { u32x2 w; w.x = cvt_pk_bf16(oT[dt][4 * rg] * inv, oT[dt][4 * rg + 1] * inv); w.y = cvt_pk_bf16(oT[dt][4 * rg + 2] * inv, oT[dt][4 * rg + 3] * inv);
                *(u32x2*)(op + 32 * dt + 8 * rg) = w; }
    }
    __syncthreads();
}
__device__ __forceinline__ void conv_items(const bf16* lx, const float* cw, const float* cb, bf16* lin, int vcu, int G, int tid) {
    for (int i = vcu * 512 + tid; i < T_ * 128; i += 2 * G * 512) {
        const int c8 = (i & 127) * 8;
        const int ta = i >> 7, i2 = i + G * 512; const bool hasb = i2 < T_ * 128; const int tb = hasb ? (i2 >> 7) : ta;
        const int tsa = ta & (S_ - 1), tsb = tb & (S_ - 1);
        u32x4 wa[4], wb[4];
#pragma unroll
        for (int tap = 0; tap < 4; ++tap) {
            wa[tap] = (tsa - 3 + tap >= 0) ? *(const u32x4*)(lx + (size_t)(ta - 3 + tap) * 1024 + c8) : (u32x4){0u, 0u, 0u, 0u};
            wb[tap] = (tsb - 3 + tap >= 0) ? *(const u32x4*)(lx + (size_t)(tb - 3 + tap) * 1024 + c8) : (u32x4){0u, 0u, 0u, 0u};
        }
        f32x4 a0 = *(const f32x4*)(cb + c8), a1 = *(const f32x4*)(cb + c8 + 4), b0 = a0, b1 = a1;
#pragma unroll
        for (int tap = 0; tap < 4; ++tap) {
            const f32x4 w0 = *(const f32x4*)(cw + tap * 1024 + c8), w1 = *(const f32x4*)(cw + tap * 1024 + c8 + 4);
            a0 += bf4_lo((u32x2){wa[tap].x, wa[tap].y}) * w0; a1 += bf4_lo((u32x2){wa[tap].z, wa[tap].w}) * w1;
            b0 += bf4_lo((u32x2){wb[tap].x, wb[tap].y}) * w0; b1 += bf4_lo((u32x2){wb[tap].z, wb[tap].w}) * w1;
        }
        *(u32x4*)(lin + (size_t)ta * 1024 + c8) = pack8(a0, a1);
        if (hasb) *(u32x4*)(lin + (size_t)tb * 1024 + c8) = pack8(b0, b1);
    }
}
__device__ __forceinline__ void scan_finish(const bf16* hloc, const bf16* pcum, const float* agg, const bf16* gl, bf16* rec, int vcu, int G, int tid) {
    const int c8 = (tid & 127) * 8, rg = tid >> 7;
    for (int chunk = vcu; chunk < T_ / 64; chunk += G) {
        const int ci = chunk & 31, cb = chunk - ci;
        float carry[8];
#pragma unroll
        for (int j = 0; j < 8; ++j) carry[j] = 0.f;
#pragma unroll 4
        for (int cc = 0; cc < ci; ++cc) {
            const f32x4* ap = (const f32x4*)(agg + ((size_t)(cb + cc) * 1024 + c8) * 2);
#pragma unroll
            for (int q = 0; q < 4; ++q) { const f32x4 v = ap[q]; carry[2 * q] = fmaf(v[0], carry[2 * q], v[1]); carry[2 * q + 1] = fmaf(v[2], carry[2 * q + 1], v[3]); }
        }
#pragma unroll 8
        for (int rr = 0; rr < 16; ++rr) {
            const size_t o = (size_t)(chunk * 64 + rg + 4 * rr) * 1024 + c8;
            const u32x4 hw = *(const u32x4*)(hloc + o), pw = *(const u32x4*)(pcum + o), gw = *(const u32x4*)(gl + o);
            const f32x4 h0 = bf4_lo((u32x2){hw.x, hw.y}), h1 = bf4_lo((u32x2){hw.z, hw.w}), p0 = bf4_lo((u32x2){pw.x, pw.y}), p1 = bf4_lo((u32x2){pw.z, pw.w});
            const f32x4 g0 = bf4_lo((u32x2){gw.x, gw.y}), g1 = bf4_lo((u32x2){gw.z, gw.w});
            f32x4 r0, r1;
#pragma unroll
            for (int j = 0; j < 4; ++j) { r0[j] = fmaf(p0[j], carry[j], h0[j]) * g0[j]; r1[j] = fmaf(p1[j], carry[4 + j], h1[j]) * g1[j]; }
            *(u32x4*)(rec + o) = pack8(r0, r1);
        }
    }
}
__device__ __forceinline__ void final_rows(float* h, const bf16* h3b, const float* part, const float* fg, int gw, int NGW, int lane, float tscale) {
    f32x4 g[4];
#pragma unroll
    for (int j = 0; j < 4; ++j) g[j] = ((const f32x4*)fg)[lane + 64 * j];
    for (int r0 = gw; r0 < T_; r0 += 2 * NGW) {
        const int r1 = (r0 + NGW < T_) ? r0 + NGW : r0;
        float pa = (lane < 16) ? part[(size_t)r0 * 16 + lane] : 0.f, pb = (lane < 16) ? part[(size_t)r1 * 16 + lane] : 0.f;
#if ALL_FUSED
        const u32x2* ba = (const u32x2*)(h3b + (size_t)r0 * 1024) + lane; const u32x2* bb = (const u32x2*)(h3b + (size_t)r1 * 1024) + lane;
        u32x2 wa[4], wb[4];
#pragma unroll
        for (int j = 0; j < 4; ++j) { wa[j] = ba[64 * j]; wb[j] = bb[64 * j]; }
#endif
#pragma unroll
        for (int o = 1; o < 64; o <<= 1) { pa += __shfl_xor(pa, o); pb += __shfl_xor(pb, o); }
        const float ra = tscale / sqrtf(pa * (1.0f / 1024.0f) + EPS), rb = tscale / sqrtf(pb * (1.0f / 1024.0f) + EPS);
        f32x4* ha = (f32x4*)(h + (size_t)r0 * 1024) + lane; f32x4* hb = (f32x4*)(h + (size_t)r1 * 1024) + lane;
#if ALL_FUSED
#pragma unroll
        for (int j = 0; j < 4; ++j) ha[64 * j] = bf4_lo(wa[j]) * ra * g[j];
        if (r1 != r0) {
#pragma unroll
            for (int j = 0; j < 4; ++j) hb[64 * j] = bf4_lo(wb[j]) * rb * g[j];
        }
#else
#pragma unroll
        for (int j = 0; j < 4; ++j) ha[64 * j] = ha[64 * j] * ra * g[j];
        if (r1 != r0) {
#pragma unroll
            for (int j = 0; j < 4; ++j) hb[64 * j] = hb[64 * j] * rb * g[j];
        }
#endif
    }
}

constexpr int N_PHASES = 16;
struct Args { const float* in[25]; float* out; unsigned char* ws; int ph_lo, ph_hi, li, pad; };
__global__ void __launch_bounds__(NWAVES * 64, 2) fused_fwd(Args args) {
    extern __shared__ __attribute__((aligned(16))) unsigned char lds_raw[];
    LAS unsigned char* lds = (LAS unsigned char*)lds_raw;
    volatile LAS unsigned* MISC = (volatile LAS unsigned*)(lds + LDSCTL_OFF);
    const int wave = __builtin_amdgcn_readfirstlane((int)threadIdx.x >> 6);
#define FRESH_TID() (wave * 64 + fresh_lane())
#define FRESH_LANE() fresh_lane()
    const int G = gridDim.x; const int bx = blockIdx.x; const int vcu = (G % 8 == 0) ? (bx % 8) * (G / 8) + bx / 8 : bx;
    unsigned char* ws = args.ws; float* out = args.out;
    In in;
#pragma unroll
    for (int i = 0; i < 25; ++i) in.p[i] = args.in[i];
    for (int u = FRESH_TID(); u < (LDS_BYTES - LDSCTL_OFF) / 4; u += NWAVES * 64) ((LAS unsigned*)(lds + LDSCTL_OFF))[u] = 0u;
    __syncthreads();
    (void)xcd_barrier_post((unsigned*)(ws + WS_CTL) + CW_BAR + args.li * XCD_BAR_WORDS, MISC + 8);
    const int lo = args.ph_lo, hi = args.ph_hi;
    const int gw = vcu * NWAVES + wave, NGW = G * NWAVES;
#ifndef PH_DISABLE
#define PH_DISABLE 0
#endif
#if ALL_FUSED
#define IN(k) (!((PH_DISABLE >> (k)) & 1))
#else
#define IN(k) (lo <= (k) && (k) < hi && !((PH_DISABLE >> (k)) & 1))
#endif
#ifdef TIMING_A
#define STAMP(i) do { if (bx == 0 && FRESH_TID() == 0) __hip_atomic_store((unsigned long long*)(ws + WS_CTL + 512) + (i), __builtin_amdgcn_s_memrealtime(), __ATOMIC_RELAXED, __HIP_MEMORY_SCOPE_AGENT); } while (0)
#else
#define STAMP(i) do { } while (0)
#endif
#define SEAM(k) do { if (IN(k) && IN((k) + 1)) { XcdBarrier b_; b_.bar = (unsigned*)(args.ws + WS_CTL) + CW_BAR + args.li * XCD_BAR_WORDS; b_.x = xb_xcc_id(); b_.st = (volatile LAS unsigned*)(lds + LDSCTL_OFF) + 8;     \
        xcd_barrier(b_); STAMP((k) + 1); } } while (0)
#if ALL_FUSED
#define PP_PTR ((const bf16*)((const unsigned char*)out + 32 * MiB))
#define MP_PTR out
#else
#define PP_PTR ((const bf16*)(ws + WS_PP))
#define MP_PTR ((float*)(ws + WS_MP))
#endif
#define GEMM_PHASE(EPI, Aptr, Bptr, Kdim, LDA, M_, N_, SH, STR, ...) do { \
        pg8::Gemm g{(const pg8::bf16_t*)(Aptr), (const pg8::bf16_t*)(Bptr), Kdim, LDA, SH, STR}; pg8::StaticOrder S; S.init(M_, N_, G, (int)blockIdx.x); \
        EPI E{__VA_ARGS__}; pg8::gemm_phase<EPI, pg8::StaticOrder, true, true>(lds, g, S, E, wave); } while (0)

    STAMP(0);
    if (IN(0)) { p0_prologue(in, ws, lds, vcu, G, wave, FRESH_TID()); } SEAM(0);
    if (IN(1)) { GEMM_PHASE(EpiProj, ws + WS_R0, ws + WS_WIN, 1024, 1024, T_, INW, 0, 0, (const float*)(ws + WS_RSTD1), ws); } SEAM(1);
    if (IN(2)) {
        for (int it = bx; it < 256; it += G) attn_item(lds, (const bf16*)(ws + WS_QKV), in.p[I_SINK], (bf16*)(ws + WS_ATT), it, wave, FRESH_TID());
        conv_items((const bf16*)(ws + WS_LX), in.p[I_CONVW], in.p[I_CONVB], (bf16*)(ws + WS_R0), vcu, G, FRESH_TID());
    } SEAM(2);
#if LRU_PADDED == 2
    if (IN(3)) { GEMM_PHASE(EpiLru, ws + WS_R0, ws + WS_WAX, 128, 1024, T_, 2048, 0, 128,
#elif LRU_PADDED
    if (IN(3)) { GEMM_PHASE(EpiLru, ws + WS_R0, ws + WS_WAX, 256, 1024, T_, 2048, 1, 256,
#else
    if (IN(3)) { GEMM_PHASE(EpiLru, ws + WS_R0, ws + WS_WAXD, 1024, 1024, T_, 2048, 0, 0,
#endif
        (const bf16*)(ws + WS_R0), in.p[I_BA], in.p[I_BX], (const float*)(ws + WS_C8), (bf16*)(ws + WS_HLOC), (bf16*)(ws + WS_PCUM), (float*)(ws + WS_AGG), (const bf16*)(ws + WS_GL), (bf16*)(ws + WS_REC), (unsigned*)(ws + WS_CTL) + CW_LRUFLAG, lds + LDSCTL_OFF + 2048); }
#if !(LRU_LOOKBACK && ALL_FUSED)
    SEAM(3);
    if (IN(4)) { scan_finish((const bf16*)(ws + WS_HLOC), (const bf16*)(ws + WS_PCUM), (const float*)(ws + WS_AGG), (const bf16*)(ws + WS_GL), (bf16*)(ws + WS_R0), vcu, G, FRESH_TID()); }
#endif
#if !ALL_FUSED
    SEAM(4);
#endif
    if (IN(5)) { GEMM_PHASE(EpiMP, ws + WS_ATT, ws + WS_WUA, 512, 512, T_, 1024, 0, 0, (const bf16*)(ws + WS_SGA), MP_PTR); }
#if ALL_FUSED
    if (IN(13)) { pg8::Gemm g{(const pg8::bf16_t*)(ws + WS_PB), (const pg8::bf16_t*)(ws + WS_WPROJ), 256, 256, 0, 0}; pg8::StaticOrder S;
        S.init(T_, 1024, G, (int)blockIdx.x);
        EpiPP E{(bf16*)((unsigned char*)out + 32 * MiB)}; pg8::gemm_phase<EpiPP, pg8::StaticOrder, true, true>(lds, g, S, E, wave); }
#endif
    SEAM(5);
    if (IN(6)) { GEMM_PHASE(EpiMerged, ws + ((LRU_LOOKBACK && ALL_FUSED) ? WS_REC : WS_R0), ws + WS_WUL, 1024, 1024, T_, 1024, 0, 0, (const bf16*)(ws + WS_SGL), (const float*)MP_PTR, (bf16*)(ws + WS_MERGED)); } SEAM(6);
    if (IN(7)) { GEMM_PHASE(EpiH1, ws + WS_MERGED, ws + WS_WO, 1024, 1024, T_, 1024, 0, 0, in.p[I_X], out, (bf16*)(ws + WS_R0), (float*)(ws + WS_PART2)); }
    SEAM(7);
#define PEER_HALF(half) do { \
        if (IN(8 + 2 * (half))) { GEMM_PHASE(EpiScore, ws + WS_R0, ws + WS_WFOLD + (size_t)(half) * 1024 * 1024 * 2, 1024, 1024, T_, 1024, 0, 0, (const float*)(ws + WS_PART2), (float*)(ws + WS_SC)); } SEAM(8 + 2 * (half)); \
        if (IN(9 + 2 * (half))) { \
            for (int it = vcu; it < T_ / TK_TOK; it += G) topk_item((LAS float*)lds, (const float*)(ws + WS_SC), it, (half) * 4, (int*)(ws + WS_SELI), (float*)(ws + WS_SELG), FRESH_TID()); \
            if ((half) == 0) uv_convert(in.p[I_U], in.p[I_V], in.p[I_GFFN], ws + WS_U16, ws + WS_U16 + 16 * MiB, (float*)(ws + WS_USCALE), (float*)(ws + WS_USCALE) + 16384, gw, NGW, FRESH_LANE()); \
        } SEAM(9 + 2 * (half)); } while (0)
#if ALL_FUSED
    if (IN(8)) {
        for (int kk = 0; kk < 2; ++kk) { pg8::Gemm g{(const pg8::bf16_t*)(ws + WS_R0), (const pg8::bf16_t*)(ws + WS_WFOLD), 1024, 1024, 0, 0}; OneUnit S; S.S.init(T_, 2048, G, (int)blockIdx.x); S.k = kk;
            EpiTopk E{(const float*)(ws + WS_PART2), (int*)(ws + WS_SELI), (float*)(ws + WS_SELG), in.p[I_U], in.p[I_V], in.p[I_GFFN], ws + WS_U16, ws + WS_U16 + 16 * MiB, (float*)(ws + WS_USCALE), (float*)(ws + WS_USCALE) + 16384,
                      vcu * 16 + kk * 8, (2 * G == (T_ / 256) * 8) ? 16 * G : 0};
            pg8::gemm_phase<EpiTopk, OneUnit, false, true>(lds, g, S, E, wave); }
        if (2 * G != (T_ / 256) * 8) uv_convert(in.p[I_U], in.p[I_V], in.p[I_GFFN], ws + WS_U16, ws + WS_U16 + 16 * MiB, (float*)(ws + WS_USCALE), (float*)(ws + WS_USCALE) + 16384, gw, NGW, FRESH_LANE());
    } SEAM(11);
#else
    PEER_HALF(0);
    PEER_HALF(1);
#endif
    if (IN(12)) {
#ifdef PROBE_MODE
        for (int tok0 = vcu * 64; tok0 < T_; tok0 += G * 64)
#if GATHER_ROWS == 3
            gather_wg_mixed<PROBE_MODE>(tok0, wave, FRESH_LANE(), lds, ws + WS_U16, ws + WS_U16 + 16 * MiB, (const float*)(ws + WS_USCALE), (const float*)(ws + WS_USCALE) + 16384, (const int*)(ws + WS_SELI), (const float*)(ws + WS_SELG), (const float*)(ws + WS_PART2), (const bf16*)(ws + WS_R0), (bf16*)(ws + WS_H2B), (float*)(ws + WS_RSTD3), (float*)(ws + WS_SC));
#elif GATHER_ROWS == 1
            gather_wg_rows<PROBE_MODE>(tok0, wave, FRESH_LANE(), lds, ws + WS_U16, ws + WS_U16 + 16 * MiB, (const float*)(ws + WS_USCALE), (const float*)(ws + WS_USCALE) + 16384, (const int*)(ws + WS_SELI), (const float*)(ws + WS_SELG), (const float*)(ws + WS_PART2), (const bf16*)(ws + WS_R0), (bf16*)(ws + WS_H2B), (float*)(ws + WS_RSTD3), (float*)(ws + WS_SC));
#else
            gather_wg_sliced<PROBE_MODE>(tok0, wave, FRESH_LANE(), lds, ws + WS_U16, ws + WS_U16 + 16 * MiB, (const float*)(ws + WS_USCALE), (const float*)(ws + WS_USCALE) + 16384, (const int*)(ws + WS_SELI), (const float*)(ws + WS_SELG), (const float*)(ws + WS_PART2), out, (const bf16*)(ws + WS_R0), (bf16*)(ws + WS_H2B), (float*)(ws + WS_RSTD3), (float*)(ws + WS_SC));
#endif
        { XcdBarrier b_; b_.bar = (unsigned*)(args.ws + WS_CTL) + CW_BAR + args.li * XCD_BAR_WORDS; b_.x = xb_xcc_id(); b_.st = (volatile LAS unsigned*)(lds + LDSCTL_OFF) + 8; xcd_barrier(b_); STAMP(16); }
#endif
        for (int tok0 = vcu * 64; tok0 < T_; tok0 += G * 64)
#if GATHER_ROWS == 3
            gather_wg_mixed<0>(tok0, wave, FRESH_LANE(), lds, ws + WS_U16, ws + WS_U16 + 16 * MiB, (const float*)(ws + WS_USCALE), (const float*)(ws + WS_USCALE) + 16384, (const int*)(ws + WS_SELI), (const float*)(ws + WS_SELG), (const float*)(ws + WS_PART2), (const bf16*)(ws + WS_R0), (bf16*)(ws + WS_H2B), (float*)(ws + WS_RSTD3), nullptr);
#elif GATHER_ROWS == 1
            gather_wg_rows<0>(tok0, wave, FRESH_LANE(), lds, ws + WS_U16, ws + WS_U16 + 16 * MiB, (const float*)(ws + WS_USCALE), (const float*)(ws + WS_USCALE) + 16384, (const int*)(ws + WS_SELI), (const float*)(ws + WS_SELG), (const float*)(ws + WS_PART2), (const bf16*)(ws + WS_R0), (bf16*)(ws + WS_H2B), (float*)(ws + WS_RSTD3), nullptr);
#else
            gather_wg_sliced<0>(tok0, wave, FRESH_LANE(), lds, ws + WS_U16, ws + WS_U16 + 16 * MiB, (const float*)(ws + WS_USCALE), (const float*)(ws + WS_USCALE) + 16384, (const int*)(ws + WS_SELI), (const float*)(ws + WS_SELG), (const float*)(ws + WS_PART2), out, (const bf16*)(ws + WS_R0), (bf16*)(ws + WS_H2B), (float*)(ws + WS_RSTD3), nullptr);
#endif
    } SEAM(12);
#if !ALL_FUSED
    if (IN(13)) { GEMM_PHASE(EpiPP, ws + WS_PB, ws + WS_WPROJ, 256, 256, T_, 1024, 0, 0, (bf16*)(ws + WS_PP)); } SEAM(13);
#endif
#if ALL_FUSED && FUSE_FINAL
    if (IN(14)) { GEMM_PHASE(EpiH3Final, ws + WS_H2B, ws + WS_WG, 1024, 1024, T_, 1024, 0, 0, (const float*)(ws + WS_RSTD3), PP_PTR, (const bf16*)(ws + WS_H2B), in.p[I_FG], out, (float*)(ws + WS_PART4), (unsigned*)(ws + WS_CTL) + 65536); }
#else
    if (IN(14)) { GEMM_PHASE(EpiH3, ws + WS_H2B, ws + WS_WG, 1024, 1024, T_, 1024, 0, 0, (const float*)(ws + WS_RSTD3), PP_PTR, out, (float*)(ws + WS_PART4), (const bf16*)(ws + WS_H2B), (bf16*)(ws + WS_R0)); } SEAM(14);
#ifdef TIMING_A
    float tscale = 1.0f;
    { const unsigned long long ta = __hip_atomic_load((unsigned long long*)(ws + WS_CTL + 512) + TIMING_A, __ATOMIC_RELAXED, __HIP_MEMORY_SCOPE_AGENT), tb = __hip_atomic_load((unsigned long long*)(ws + WS_CTL + 512) + TIMING_B, __ATOMIC_RELAXED, __HIP_MEMORY_SCOPE_AGENT);
      tscale = 1.0f + (float)(tb - ta) * 0.01f * (float)(TIMING_K); }
    if (IN(15)) { final_rows(out, (const bf16*)(ws + WS_R0), (const float*)(ws + WS_PART4), in.p[I_FG], gw, NGW, FRESH_LANE(), tscale); }
#else
    if (IN(15)) { final_rows(out, (const bf16*)(ws + WS_R0), (const float*)(ws + WS_PART4), in.p[I_FG], gw, NGW, FRESH_LANE(), 1.0f); }
#endif
#endif
#undef IN
#undef SEAM
#undef GEMM_PHASE
}
static const int GRP_LO[11] = {0, 2, 3, 5, 6, 7, 8, 12, 13, 14, 15};
static const int GRP_HI[11] = {2, 3, 5, 6, 7, 8, 12, 13, 14, 15, 16};

static void naive_group(int grp, void* const* d_in, float* out, unsigned char* ws, hipStream_t st) {
    const float* x = (const float*)d_in[0]; const float* p = (const float*)d_in[1]; const float* g_mix = (const float*)d_in[2]; const float* w_in = (const float*)d_in[3];
    const float* sink = (const float*)d_in[4]; const float* conv_w = (const float*)d_in[5]; const float* conv_b = (const float*)d_in[6];
    const float* wa = (const float*)d_in[7]; const float* ba = (const float*)d_in[8]; const float* wx = (const float*)d_in[9]; const float* bx = (const float*)d_in[10]; const float* lam = (const float*)d_in[11];
    const float* w_ua = (const float*)d_in[12]; const float* w_ul = (const float*)d_in[13]; const float* w_o = (const float*)d_in[14]; const float* g_ffn = (const float*)d_in[15];
    const float* wq = (const float*)d_in[16]; const float* k1 = (const float*)d_in[17]; const float* k2 = (const float*)d_in[18]; const float* pu = (const float*)d_in[19]; const float* pv = (const float*)d_in[20];
    const float* g_ple = (const float*)d_in[21]; const float* w_gate = (const float*)d_in[22]; const float* w_proj = (const float*)d_in[23]; const float* final_g = (const float*)d_in[24];
    float* rstd1 = (float*)(ws + WS_RSTD1); float* part2 = (float*)(ws + WS_PART2); float* part4 = (float*)(ws + WS_PART4); float* rstd3 = (float*)(ws + WS_RSTD3);
    bf16* qkv = (bf16*)(ws + WS_QKV); bf16* lx = (bf16*)(ws + WS_LX); bf16* gl = (bf16*)(ws + WS_GL); bf16* sga = (bf16*)(ws + WS_SGA); bf16* sgl = (bf16*)(ws + WS_SGL);
    bf16* att = (bf16*)(ws + WS_ATT); bf16* r0 = (bf16*)(ws + WS_R0); float* mp = (float*)(ws + WS_MP); bf16* merged = (bf16*)(ws + WS_MERGED);
    float* sc = (float*)(ws + WS_SC); int* seli = (int*)(ws + WS_SELI); float* selg = (float*)(ws + WS_SELG); bf16* h2b = (bf16*)(ws + WS_H2B); bf16* pp = (bf16*)(ws + WS_PP);
    float* tmpf = (float*)(ws + WS_NAIVE_AB);
    switch (grp) {
    case 0:
        hipLaunchKernelGGL(nv::rowsq, dim3(T_ / 4), dim3(256), 0, st, x, rstd1, (float*)nullptr);
        nv::run_gemm<nv::ALf32, nv::EpiProj, false>(st, nv::ALf32{x, 1024}, w_in, INW, g_mix, T_, INW, 1024, nv::EpiProj{rstd1, qkv, lx, gl, sga, sgl});
        break;
    case 1:
        hipLaunchKernelGGL(nv::attn_naive, dim3(T_ * 8 / 128), dim3(128), 0, st, qkv, sink, att);
        hipLaunchKernelGGL(nv::conv_naive, dim3(T_ * 1024 / 256), dim3(256), 0, st, lx, conv_w, conv_b, r0);
        break;
    case 2:
        hipLaunchKernelGGL(nv::lru_ab_naive, dim3(T_ * 8), dim3(128), 0, st, r0, wa, ba, wx, bx, lam, out, tmpf);
        hipLaunchKernelGGL(nv::lru_scan_naive, dim3(B_ * 1024 / 64), dim3(64), 0, st, out, tmpf, gl, r0);
        break;
    case 3: nv::run_gemm<nv::ALbf16, nv::EpiMP, false>(st, nv::ALbf16{att, 512}, w_ua, 1024, nullptr, T_, 1024, 512, nv::EpiMP{sga, mp}); break;
    case 4: nv::run_gemm<nv::ALbf16, nv::EpiMerged, false>(st, nv::ALbf16{r0, 1024}, w_ul, 1024, nullptr, T_, 1024, 1024, nv::EpiMerged{sgl, mp, merged}); break;
    case 5:
        nv::run_gemm<nv::ALbf16, nv::EpiH1, false>(st, nv::ALbf16{merged, 1024}, w_o, 1024, nullptr, T_, 1024, 1024, nv::EpiH1{x, out, r0});
        hipLaunchKernelGGL(nv::rowsq, dim3(T_ / 4), dim3(256), 0, st, out, (float*)nullptr, part2);
        break;
    case 6:
        for (int half = 0; half < 2; ++half) {
            nv::run_gemm<nv::ALf32, nv::EpiScaleF32, false>(st, nv::ALf32{out, 1024}, wq + half * 1024, 2048, g_ffn, T_, 1024, 1024, nv::EpiScaleF32{part2, tmpf, 1024});
            for (int hl = 0; hl < 4; ++hl)
                for (int hf = 0; hf < 2; ++hf)
                    nv::run_gemm<nv::ALf32, nv::EpiPlainF32, true>(st, nv::ALf32{tmpf + hl * 256 + hf * 128, 1024}, hf ? k2 : k1, 128, nullptr, T_, 128, 128, nv::EpiPlainF32{sc + hl * 256 + hf * 128, 1024});
            hipLaunchKernelGGL(topk_kernel, dim3(T_ / TK_TOK), dim3(512), TK_LDS_BYTES, st, sc, half * 4, seli, selg);
        }
        break;
    case 7: hipLaunchKernelGGL(gather_kernel<0>, dim3(1024), dim3(256), 0, st, (const void*)pu, (const void*)pv, g_ffn, seli, selg, part2, out, h2b, rstd3); break;
    case 8: nv::run_gemm<nv::ALf32, nv::EpiPP, false>(st, nv::ALf32{p, 256}, w_proj, 1024, nullptr, T_, 1024, 256, nv::EpiPP{pp}); break;
    case 9: nv::run_gemm<nv::ALbf16, nv::EpiH3, false>(st, nv::ALbf16{h2b, 1024}, w_gate, 1024, g_ple, T_, 1024, 1024, nv::EpiH3{rstd3, pp, out});
        hipLaunchKernelGGL(nv::rowsq, dim3(T_ / 4), dim3(256), 0, st, out, (float*)nullptr, part4);
        break;
    case 10: hipLaunchKernelGGL(nv::final_norm, dim3(T_ / 4), dim3(256), 0, st, out, part4, final_g); break;
    }
}

extern "C" void kernel_launch(void* const* d_in, const int* in_sizes, int n_in, void* d_out, int out_size, void* d_ws, size_t ws_size, hipStream_t stream) {
    static int grid = 0;
    if (grid == 0) {
        if (n_in != 25 || out_size != T_ * 1024 || ws_size < WS_END) { fprintf(stderr, "kernel_launch: unexpected sizes n_in %d out %d ws %zu\n", n_in, out_size, ws_size); }
        (void)hipFuncSetAttribute((const void*)topk_kernel, hipFuncAttributeMaxDynamicSharedMemorySize, TK_LDS_BYTES);
        int dev = 0, cus = 0, per_cu = 0;
        (void)hipGetDevice(&dev); (void)hipDeviceGetAttribute(&cus, hipDeviceAttributeMultiprocessorCount, dev);
        if (hipFuncSetAttribute((const void*)fused_fwd, hipFuncAttributeMaxDynamicSharedMemorySize, LDS_BYTES) != hipSuccess) fprintf(stderr, "kernel_launch: hipFuncSetAttribute(fused_fwd) failed\n");
        if (hipOccupancyMaxActiveBlocksPerMultiprocessor(&per_cu, (const void*)fused_fwd, NWAVES * 64, LDS_BYTES) != hipSuccess || per_cu < 1) fprintf(stderr, "kernel_launch: occupancy query says %d blocks/CU\n", per_cu);
        (void)hipGetLastError();
        grid = cus > 0 ? cus : 256;
    }
    unsigned char* ws = (unsigned char*)d_ws; float* out = (float*)d_out;
    const unsigned mask = FUSED_MASK;
    if (mask) (void)hipMemsetAsync(ws + WS_CTL, 0, CTL_ZERO_BYTES, stream);
    Args a{};
    for (int i = 0; i < 25; ++i) a.in[i] = (const float*)d_in[i];
    a.out = out; a.ws = ws;
    int li = 0;
    auto launch = [&](int lo, int hi) {
        if (MERGE_LAUNCHES) { a.ph_lo = lo; a.ph_hi = hi; a.li = li++; hipLaunchKernelGGL(fused_fwd, dim3(grid), dim3(NWAVES * 64), LDS_BYTES, stream, a); }
        else for (int ph = lo; ph < hi; ++ph) { a.ph_lo = ph; a.ph_hi = ph + 1; a.li = li++; hipLaunchKernelGGL(fused_fwd, dim3(grid), dim3(NWAVES * 64), LDS_BYTES, stream, a); }
    };
    int pend_lo = -1, pend_hi = -1;
    if (mask && !(mask & 1)) launch(0, 1);
    for (int gidx = 0; gidx < 11; ++gidx) {
#if (defined(LRU_T2) && LRU_T2) || (defined(LRU_T3) && LRU_T3)
        if (gidx == 2 && (mask & 4u)) {
            if (pend_lo >= 0) { launch(pend_lo, pend_hi); pend_lo = -1; }
            launch(3, 4);
            hipLaunchKernelGGL(nv::lru_finish_naive_L<(LRU_T2 ? 16 : 64)>, dim3(B_ * 1024 / 64), dim3(64), 0, stream, (const bf16*)(ws + WS_HLOC), (const bf16*)(ws + WS_PCUM), (const bf16*)(ws + WS_GL), (bf16*)(ws + WS_R0));
            continue;
        }
#endif
        if (mask & (1u << gidx)) {
            if (pend_lo < 0) { pend_lo = GRP_LO[gidx]; pend_hi = GRP_HI[gidx]; } else pend_hi = GRP_HI[gidx];
        } else {
            if (pend_lo >= 0) { launch(pend_lo, pend_hi); pend_lo = -1; }
            naive_group(gidx, d_in, out, ws, stream);
        }
    }
    if (pend_lo >= 0) launch(pend_lo, pend_hi);
#if defined(LRU_DEBUG) && LRU_DEBUG == 2
    hipLaunchKernelGGL(nv::poison_if, dim3(T_ * 1024 / 256), dim3(256), 0, stream, out, (const unsigned*)(ws + WS_CTL) + 64);
#endif
}
```
